# Optimizing an MI355X kernel written in HIP

```python
import math
import jax, jax.numpy as jnp
from jax import lax
import numpy as np

D_MODEL = 1024
BATCH = 4
SEQ = 4096
DEPTH = 1

MLA_HEADS = 8
MLA_Q_LORA = 256
MLA_KV_LORA = 128
MLA_NOPE = 64
MLA_ROPE = 32
MLA_V = 64
MLA_QK = MLA_NOPE + MLA_ROPE
MLA_WIDTH = MLA_HEADS * MLA_V
ROPE_THETA = 10000.0
FOX_HEADS = 8
FOX_HEAD_DIM = 64
FOX_WIDTH = FOX_HEADS * FOX_HEAD_DIM
Q_BLOCK = 128
IN_SPLIT_SIZES = (MLA_Q_LORA, MLA_KV_LORA, MLA_ROPE, FOX_WIDTH, FOX_WIDTH, FOX_WIDTH, FOX_HEADS, D_MODEL, D_MODEL)
IN_COLS = MLA_Q_LORA + MLA_KV_LORA + MLA_ROPE + 3 * FOX_WIDTH + FOX_HEADS + 2 * D_MODEL
N_EXPERTS = 64
N_GROUPS = 8
TOPK_GROUPS = 4
TOP_K = 6
D_EXPERT = 256
D_SHARED = 256
ROUTED_SCALE = 2.5
EXPERT_BLOCK = 128
N_MOD = 6
NORM_EPS = 1e-6
NEG_INF = -1e30

kernel_name = 'adaln_mla_fox_gated_hybrid_moe'


def rms_norm(x, gain):
    xf = x.astype(jnp.float32)
    y = xf * lax.rsqrt(jnp.mean(xf * xf, axis=-1, keepdims=True) + NORM_EPS)
    return (y * gain.astype(jnp.float32)).astype(x.dtype)


def split_cols(t, sizes):
    out, start = [], 0
    for n in sizes:
        out.append(t[..., start:start + n])
        start += n
    return out


def apply_rope(x, positions):
    half = x.shape[-1] // 2
    inv_freq = jnp.power(ROPE_THETA, -jnp.arange(half, dtype=jnp.float32) / half)
    ang = positions.astype(jnp.float32)[:, None, :, None] * inv_freq
    cos = jnp.cos(ang).astype(x.dtype)
    sin = jnp.sin(ang).astype(x.dtype)
    x1, x2 = x[..., :half], x[..., half:]
    return jnp.concatenate([x1 * cos - x2 * sin, x2 * cos + x1 * sin], axis=-1)


def causal_block_attention(q, k, v, scale, decay=None):
    B, H, S, _ = q.shape
    dv = v.shape[-1]
    nblk = S // Q_BLOCK

    def to_blocks(t):
        return jnp.moveaxis(t.reshape((B, H, nblk, Q_BLOCK) + t.shape[3:]), 2, 0)

    key_pos = jnp.arange(S)

    def one_block(xs):
        i, qb = xs[0], xs[1]
        logits = jnp.einsum('bhqd,bhkd->bhqk', qb, k).astype(jnp.float32) * scale
        if decay is not None:
            logits = logits + xs[2][..., :, None] - decay[:, :, None, :]
        q_pos = i * Q_BLOCK + jnp.arange(Q_BLOCK)
        logits = jnp.where(key_pos[None, :] <= q_pos[:, None], logits, NEG_INF)
        p = jax.nn.softmax(logits, axis=-1).astype(v.dtype)
        return jnp.einsum('bhqk,bhkd->bhqd', p, v)

    xs = (jnp.arange(nblk), to_blocks(q))
    if decay is not None:
        xs = xs + (to_blocks(decay),)
    out = lax.map(one_block, xs)
    return jnp.moveaxis(out, 0, 2).reshape(B, H, S, dv)


def hybrid_mixer(h, positions, w_in, b_forget, g_q_lat, w_q_up, g_kv_lat, w_kv_up, w_o_mla, w_o_fox, w_out):
    B, S, _ = h.shape
    proj = h @ w_in
    q_lat, kv_lat, k_rope, fq, fk, fv, f_logit, gate_a, gate_b = split_cols(proj, IN_SPLIT_SIZES)

    q = (rms_norm(q_lat, g_q_lat) @ w_q_up).reshape(B, S, MLA_HEADS, MLA_QK).transpose(0, 2, 1, 3)
    q_nope, q_pe = q[..., :MLA_NOPE], apply_rope(q[..., MLA_NOPE:], positions)
    kv = (rms_norm(kv_lat, g_kv_lat) @ w_kv_up).reshape(B, S, MLA_HEADS, MLA_NOPE + MLA_V).transpose(0, 2, 1, 3)
    k_nope, v_mla = kv[..., :MLA_NOPE], kv[..., MLA_NOPE:]
    k_pe = apply_rope(k_rope[:, None, :, :], positions)
    q_mla = jnp.concatenate([q_nope, q_pe], axis=-1)
    k_mla = jnp.concatenate([k_nope, jnp.broadcast_to(k_pe, (B, MLA_HEADS, S, MLA_ROPE))], axis=-1)
    o_mla = causal_block_attention(q_mla, k_mla, v_mla, 1.0 / math.sqrt(MLA_QK))
    o_mla = o_mla.transpose(0, 2, 1, 3).reshape(B, S, MLA_WIDTH)

    def heads(t):
        return t.reshape(B, S, FOX_HEADS, FOX_HEAD_DIM).transpose(0, 2, 1, 3)

    log_f = jax.nn.log_sigmoid((f_logit + b_forget).astype(jnp.float32))
    cum_log_f = jnp.cumsum(log_f, axis=1).transpose(0, 2, 1)
    o_fox = causal_block_attention(heads(fq), heads(fk), heads(fv), 1.0 / math.sqrt(FOX_HEAD_DIM), cum_log_f)
    o_fox = o_fox.transpose(0, 2, 1, 3).reshape(B, S, FOX_WIDTH)

    merged = jax.nn.sigmoid(gate_a) * (o_mla @ w_o_mla) + jax.nn.sigmoid(gate_b) * (o_fox @ w_o_fox)
    return merged @ w_out


def moe_ffn(h, w_router, b_router, w_exp_gate, w_exp_up, w_exp_down, w_sh_gate, w_sh_up, w_sh_down):
    B, S, D = h.shape
    T = B * S
    xf = h.reshape(T, D)

    scores = jax.nn.sigmoid((xf @ w_router).astype(jnp.float32))
    choice = scores + b_router.astype(jnp.float32)
    group_score = lax.top_k(choice.reshape(T, N_GROUPS, N_EXPERTS // N_GROUPS), 2)[0].sum(-1)
    _, group_idx = lax.top_k(group_score, TOPK_GROUPS)
    group_keep = (group_idx[..., None] == jnp.arange(N_GROUPS)).any(axis=-2)
    expert_keep = jnp.repeat(group_keep, N_EXPERTS // N_GROUPS, axis=-1)
    _, expert_idx = lax.top_k(jnp.where(expert_keep, choice, NEG_INF), TOP_K)
    gate = jnp.take_along_axis(scores, expert_idx, axis=-1)
    gate = (gate / gate.sum(-1, keepdims=True) * ROUTED_SCALE).astype(h.dtype)

    n_assign = T * TOP_K
    flat_e = expert_idx.reshape(-1).astype(jnp.int32)
    flat_tok = jnp.arange(n_assign, dtype=jnp.int32) // TOP_K
    order = jnp.argsort(flat_e)
    se, stok, sgate = flat_e[order], flat_tok[order], gate.reshape(-1)[order]
    counts = jnp.zeros((N_EXPERTS,), jnp.int32).at[flat_e].add(1)
    padded = (counts + EXPERT_BLOCK - 1) // EXPERT_BLOCK * EXPERT_BLOCK
    start = jnp.cumsum(counts) - counts
    pend = jnp.cumsum(padded)
    pstart = pend - padded
    dest = pstart[se] + jnp.arange(n_assign, dtype=jnp.int32) - start[se]
    n_blocks = (n_assign + EXPERT_BLOCK - 1) // EXPERT_BLOCK + N_EXPERTS
    n_rows = n_blocks * EXPERT_BLOCK
    row_tok = jnp.full((n_rows,), T, jnp.int32).at[dest].set(stok)
    row_gate = jnp.zeros((n_rows,), h.dtype).at[dest].set(sgate)
    block_e = jnp.minimum(
        jnp.searchsorted(pend, jnp.arange(n_blocks, dtype=jnp.int32) * EXPERT_BLOCK, side='right'),
        N_EXPERTS - 1)
    x_pad = jnp.concatenate([xf, jnp.zeros((1, D), xf.dtype)], axis=0)

    def expert_block(xs):
        tok, g, e = xs
        xb = x_pad[tok]
        hb = jax.nn.silu(xb @ w_exp_gate[e]) * (xb @ w_exp_up[e])
        return (hb @ w_exp_down[e]) * g[:, None]

    yb = lax.map(expert_block, (row_tok.reshape(n_blocks, EXPERT_BLOCK),
                                row_gate.reshape(n_blocks, EXPERT_BLOCK), block_e))
    routed = jax.ops.segment_sum(yb.reshape(n_rows, D), row_tok, num_segments=T + 1)[:T]
    shared = (jax.nn.silu(xf @ w_sh_gate) * (xf @ w_sh_up)) @ w_sh_down
    return (shared + routed).reshape(B, S, D)


def dense_init(k, shape, fan_in, scale=1.0):
    return scale * fan_in ** -0.5 * jax.random.normal(k, shape, jnp.float32)


def setup_inputs(seed: int = 0) -> dict:
    key = jax.random.key(seed)
    ks = jax.random.split(key, 25)
    L, D, E = DEPTH, D_MODEL, N_EXPERTS

    def gain(k, shape):
        return 1.0 + 0.02 * jax.random.normal(k, shape, jnp.float32)

    offset = jax.random.randint(ks[2], (BATCH, 1), 0, 1024, dtype=jnp.int32)
    return {
        'x': jax.random.normal(ks[0], (BATCH, SEQ, D), jnp.float32),
        'c': jax.random.normal(ks[1], (BATCH, D), jnp.float32),
        'positions': jnp.arange(SEQ, dtype=jnp.int32)[None, :] + offset,
        'w_mod': dense_init(ks[3], (L, D, N_MOD * D), D, 0.5),
        'b_mod': 0.02 * jax.random.normal(ks[4], (L, N_MOD * D), jnp.float32),
        'g_mix_norm': gain(ks[5], (L, D)),
        'w_in': dense_init(ks[6], (L, D, IN_COLS), D),
        'b_forget': 1.0 + 3.0 * jax.random.uniform(ks[7], (L, FOX_HEADS), jnp.float32),
        'g_q_lat': gain(ks[8], (L, MLA_Q_LORA)),
        'w_q_up': dense_init(ks[9], (L, MLA_Q_LORA, MLA_HEADS * MLA_QK), MLA_Q_LORA),
        'g_kv_lat': gain(ks[10], (L, MLA_KV_LORA)),
        'w_kv_up': dense_init(ks[11], (L, MLA_KV_LORA, MLA_HEADS * (MLA_NOPE + MLA_V)), MLA_KV_LORA),
        'w_o_mla': dense_init(ks[12], (L, MLA_WIDTH, D), MLA_WIDTH),
        'w_o_fox': dense_init(ks[13], (L, FOX_WIDTH, D), FOX_WIDTH),
        'w_out': dense_init(ks[14], (L, D, D), D),
        'g_ffn_norm': gain(ks[15], (L, D)),
        'w_router': dense_init(ks[16], (L, D, E), D),
        'b_router': 0.01 * jax.random.normal(ks[17], (L, E), jnp.float32),
        'w_exp_gate': dense_init(ks[18], (L, E, D, D_EXPERT), D),
        'w_exp_up': dense_init(ks[19], (L, E, D, D_EXPERT), D),
        'w_exp_down': dense_init(ks[20], (L, E, D_EXPERT, D), D_EXPERT),
        'w_sh_gate': dense_init(ks[21], (L, D, D_SHARED), D),
        'w_sh_up': dense_init(ks[22], (L, D, D_SHARED), D),
        'w_sh_down': dense_init(ks[23], (L, D_SHARED, D), D_SHARED),
        'g_final': gain(ks[24], (D,)),
    }


def reference(x, c, positions, w_mod, b_mod, g_mix_norm, w_in, b_forget, g_q_lat, w_q_up, g_kv_lat,
              w_kv_up, w_o_mla, w_o_fox, w_out, g_ffn_norm, w_router, b_router, w_exp_gate, w_exp_up,
              w_exp_down, w_sh_gate, w_sh_up, w_sh_down, g_final):
    cond = jax.nn.silu(c)
    for l in range(DEPTH):
        mod = cond @ w_mod[l] + b_mod[l]
        shift_m, scale_m, gate_m, shift_f, scale_f, gate_f = [m[:, None, :] for m in jnp.split(mod, N_MOD, axis=-1)]
        h = rms_norm(x, g_mix_norm[l]) * (1.0 + scale_m) + shift_m
        x = x + gate_m * hybrid_mixer(h, positions, w_in[l], b_forget[l], g_q_lat[l], w_q_up[l], g_kv_lat[l],
                                      w_kv_up[l], w_o_mla[l], w_o_fox[l], w_out[l])
        h = rms_norm(x, g_ffn_norm[l]) * (1.0 + scale_f) + shift_f
        x = x + gate_f * moe_ffn(h, w_router[l], b_router[l], w_exp_gate[l], w_exp_up[l], w_exp_down[l],
                                 w_sh_gate[l], w_sh_up[l], w_sh_down[l])
    return rms_norm(x, g_final)
```

```cpp
#include <hip/hip_runtime.h>
#include <cstdio>
#include <cstdint>
#include <type_traits>

#ifndef MK_ONE_LAUNCH
#define MK_ONE_LAUNCH 1
#endif

#ifndef PROBE_DUP
#define PROBE_DUP -1
#endif
#ifndef ATT_TUNED_FOX
#define ATT_TUNED_FOX 1
#endif
#ifndef ATT_TUNED_MLA
#define ATT_TUNED_MLA 1
#endif
#ifndef PROBE_VAR
#define PROBE_VAR 0
#endif
#define GAS __attribute__((address_space(1)))
#define LAS __attribute__((address_space(3)))
typedef unsigned short bf16;
typedef short bf16x8 __attribute__((ext_vector_type(8)));
typedef short s16x4 __attribute__((ext_vector_type(4)));
typedef float f32x2 __attribute__((ext_vector_type(2)));
typedef float f32x4 __attribute__((ext_vector_type(4)));
typedef float f32x16 __attribute__((ext_vector_type(16)));
typedef unsigned u32x2 __attribute__((ext_vector_type(2)));
typedef unsigned u32x4 __attribute__((ext_vector_type(4)));
typedef GAS unsigned gu32;

constexpr int NB = 4, SEQ = 4096, T = NB * SEQ, D = 1024;
constexpr int NIN = 4096;
constexpr int QLORA = 256, KVLORA = 128, KVPAD = 256, ROPE = 32, NHEAD = 8, HD = 64, MQK = 96;
constexpr int NEXP = 64, TOPK = 6, DEXP = 256;
constexpr float EPS = 1e-6f;
constexpr float LOG2E = 1.4426950408889634f;
constexpr float C2F = 0.125f * LOG2E;
constexpr float C2M = 0.10206207261596577f * LOG2E;
constexpr int LISTCAP = T;

constexpr size_t MiB = 1u << 20;
constexpr size_t WS_CTL = 0, CTL_ZERO_BYTES = 1 * MiB;
constexpr size_t WS_EIDX = 262144, WS_GATEW = 393216;
constexpr size_t WS_WIN = 1 * MiB, WS_WQ = 9 * MiB, WS_WKV = 9 * MiB + 512 * 1024, WS_WOM = 10 * MiB, WS_WOF = 11 * MiB, WS_WOUT = 12 * MiB;
constexpr size_t WS_WSGU = 14 * MiB, WS_WSD = 15 * MiB, WS_WR = 15 * MiB + 512 * 1024, WS_MOD = 15 * MiB + 640 * 1024;
constexpr size_t WS_WD = 16 * MiB;
constexpr size_t WS_HB = 48 * MiB;
constexpr size_t WS_FQ = 48 * MiB, WS_FK = 64 * MiB, WS_FV = 80 * MiB, WS_QLAT = 96 * MiB, WS_KVLAT = 104 * MiB;
constexpr size_t WS_OFOX = WS_FQ, WS_OMLA = WS_QLAT;
static_assert(WS_FK - WS_FQ == (size_t)T * 512 * 2 && WS_FV - WS_FK == (size_t)T * 512 * 2, "fq|fk|fv contiguous");
constexpr size_t WS_Y = 112 * MiB;
constexpr size_t WS_WGU = 112 * MiB;
constexpr size_t WS_H = 176 * MiB;
constexpr size_t WS_QMLA = WS_H;
constexpr size_t WS_GATES = 208 * MiB;
constexpr size_t WS_KN = 272 * MiB, WS_VM = 288 * MiB, WS_KPE = 304 * MiB;
constexpr size_t WS_MERGED = WS_KN;
constexpr size_t WS_LIST = 304 * MiB;
constexpr size_t WS_END = 306 * MiB;
constexpr size_t DO_MODP = 4 * MiB;
constexpr size_t DO_ROPE = 0, DO_LOGF = 2 * MiB, DO_CUMF = 2 * MiB + 512 * 1024, DO_SSQQ = 3 * MiB, DO_SSQKV = 3 * MiB + 256 * 1024;

constexpr int CW_TMO = 0;
constexpr int CW_BAR = 4096;
constexpr int CW_CNT = 8192;
constexpr int CW_KM = 12288;
constexpr int CW_Q = 12544;

constexpr int RING_BYTES = 131072;
constexpr int LDSCTL_OFF = RING_BYTES;
constexpr int MISC_OFF = LDSCTL_OFF + 320;
constexpr int MOETAB_OFF = LDSCTL_OFF + 1024;
constexpr int LDS_BYTES = 147456;

constexpr int NWAVES = 8;

#define LDS_WAIT() asm volatile("s_waitcnt lgkmcnt(0)" ::: "memory")
#define VM_WAIT() asm volatile("s_waitcnt vmcnt(0)" ::: "memory")
#define RLX_AGENT __ATOMIC_RELAXED, __HIP_MEMORY_SCOPE_AGENT
__device__ __forceinline__ unsigned f2bf(float f) { unsigned u = __builtin_bit_cast(unsigned, f); return (u + 0x7fffu + ((u >> 16) & 1u)) >> 16; }
__device__ __forceinline__ float bf2f(unsigned h) { return __builtin_bit_cast(float, h << 16); }
__device__ __forceinline__ unsigned pk2(float lo, float hi) { return f2bf(lo) | (f2bf(hi) << 16); }
__device__ __forceinline__ unsigned cvt_pk_bf16(float lo, float hi) { unsigned r; asm volatile("v_cvt_pk_bf16_f32 %0, %1, %2" : "=v"(r) : "v"(lo), "v"(hi)); return r; }
__device__ __forceinline__ u32x4 pack8(f32x4 a, f32x4 b) { u32x4 w; w.x = cvt_pk_bf16(a[0], a[1]); w.y = cvt_pk_bf16(a[2], a[3]); w.z = cvt_pk_bf16(b[0], b[1]); w.w = cvt_pk_bf16(b[2], b[3]); return w; }
__device__ __forceinline__ void unpack8(u32x4 w, f32x4& a, f32x4& b) {
    a = (f32x4){bf2f(w.x & 0xffffu), bf2f(w.x >> 16), bf2f(w.y & 0xffffu), bf2f(w.y >> 16)};
    b = (f32x4){bf2f(w.z & 0xffffu), bf2f(w.z >> 16), bf2f(w.w & 0xffffu), bf2f(w.w >> 16)};
}
__device__ __forceinline__ float wave_sum(float v) {
#pragma unroll
    for (int o = 1; o < 64; o <<= 1) v += __shfl_xor(v, o);
    return v;
}
__device__ __forceinline__ float wave_max(float v) {
#pragma unroll
    for (int o = 1; o < 64; o <<= 1) v = fmaxf(v, __shfl_xor(v, o));
    return v;
}
template <int CTRL> __device__ __forceinline__ float dppf(float v) { return __builtin_bit_cast(float, __builtin_amdgcn_update_dpp(0, __builtin_bit_cast(int, v), CTRL, 0xf, 0xf, true)); }
__device__ __forceinline__ float max8(float v) { v = fmaxf(v, dppf<0xB1>(v)); v = fmaxf(v, dppf<0x4E>(v)); v = fmaxf(v, dppf<0x141>(v)); return v; }
__device__ __forceinline__ float wave_max_f(float v) { v = max8(v); v = fmaxf(v, dppf<0x140>(v)); v = fmaxf(v, __shfl_xor(v, 16)); v = fmaxf(v, __shfl_xor(v, 32)); return v; }
__device__ __forceinline__ float wave_sum_f(float v) { v += dppf<0xB1>(v); v += dppf<0x4E>(v); v += dppf<0x141>(v); v += dppf<0x140>(v); v += __shfl_xor(v, 16); v += __shfl_xor(v, 32); return v; }
__device__ __forceinline__ float sigmoidf_(float x) { return 1.f / (1.f + __expf(-x)); }
__device__ __forceinline__ float siluf_(float x) { return x / (1.f + __expf(-x)); }

namespace pg8 {
constexpr int BM = 256, BK = 64, HALF = 128, HTB = HALF * BK * 2, NXCD = 8, WGM = 8;
__host__ __device__ __forceinline__ int lds_byte(int r, int c) { const int st = (r >> 4) * 2 + (c >> 5), rr = r & 15, cc = c & 31, ob = rr * 64 + cc * 2; return st * 1024 + (ob ^ (((ob >> 9) & 1) << 5)); }
__host__ __device__ __forceinline__ void stage_rc(int b, int& R, int& C) { const int st = b / 1024, sb = b % 1024, swz = sb ^ (((sb >> 9) & 1) << 5); R = (st >> 1) * 16 + swz / 64; C = (st & 1) * 32 + (swz % 64) / 2; }
__host__ __device__ __forceinline__ int perm32(int rho) { const int n = rho >> 4, i = rho & 15; return 8 * (i >> 2) + 4 * n + (i & 3); }

struct Unit { int pm, pn, e, aux, n; };

struct StaticOrder {
    static constexpr bool GATHER = false;
    const char* A; const char* Bt; int K;
    int nM, nN, nwg, G, c;
    __device__ void init(const void* A_, const void* Bt_, int M, int N, int K_, int G_, int c_) { A = (const char*)A_; Bt = (const char*)Bt_; K = K_; nM = M / BM; nN = N / BM; nwg = nM * nN; G = G_; c = c_; }
    __device__ bool next(int i, Unit& u) const {
        const long L = (long)i * G + c; if (L >= nwg) return false;
        int wgid = (int)L; { const int q = nwg / NXCD, r = nwg % NXCD, xcd = wgid % NXCD, off = wgid / NXCD; wgid = (xcd < r ? xcd * (q + 1) : r * (q + 1) + (xcd - r) * q) + off; }
        const int nig = WGM * nN, gid = wgid / nig, fm = gid * WGM, gsz = (nM - fm) < WGM ? (nM - fm) : WGM;
        u.pm = fm + ((wgid % nig) % gsz); u.pn = (wgid % nig) / gsz; u.e = 0; u.aux = 0; u.n = BM; return true;
    }
    __device__ __forceinline__ const char* a_ptr(const Unit& u) const { return A + (size_t)u.pm * BM * K * 2; }
    __device__ __forceinline__ const char* b_ptr(const Unit& u) const { return Bt + (size_t)u.pn * BM * K * 2; }
    __device__ __forceinline__ unsigned a_row(const Unit&, int r) const { return (unsigned)r; }
};

template <class Epi, class Sched, bool ALIGN_EPI>
__device__ __forceinline__ void gemm_phase(LAS unsigned char* lds, const Sched& S, const Epi& E) {
    int tid = threadIdx.x; asm volatile("" : "+v"(tid));
    const int wid = __builtin_amdgcn_readfirstlane(tid >> 6), lane = tid & 63, wr = wid >> 2, wc = wid & 3, fr = lane & 15, fq = lane >> 4;
    const int K = S.K, nt = K / BK;
    unsigned voffB[2], voffA[2];
#pragma unroll
    for (int i = 0; i < 2; ++i) { int R, C; stage_rc(tid * 16 + i * 8192, R, C); const int Rb = (R & ~31) + perm32(R & 31);
        voffA[i] = (unsigned)(R * K + C) * 2u; voffB[i] = (unsigned)(Rb * K + C) * 2u; }
    unsigned vA[2][2], vN[2][2];
    const size_t kstep = (size_t)(BK * 2);
    const size_t hstep = (size_t)HALF * K * 2;
    const unsigned ldsw = (unsigned)wid * 1024u;
    const int aoff = lds_byte(wr * 64 + fr, fq * 8), boff = lds_byte(wc * 32 + fr, fq * 8);
#define PG8_SA(b, h) (((b) * 2 + (h)) * HTB)
#define PG8_SB(b, h) ((4 + (b) * 2 + (h)) * HTB)
#define PG8_STAGE(bufoff, gbase, voff) do { _Pragma("unroll") for (int _i = 0; _i < 2; ++_i) \
        __builtin_amdgcn_global_load_lds((const unsigned*)((const char*)(gbase) + (voff)[_i]), (LAS unsigned*)(lds + (bufoff) + ldsw + _i * 8192), 16, 0, 0); } while (0)
#define PG8_STAGE_A(bufoff, gbase, h, nx) do { if constexpr (Sched::GATHER) { if (nx) PG8_STAGE(bufoff, gbase, vN[h]); else PG8_STAGE(bufoff, gbase, vA[h]); } \
        else PG8_STAGE(bufoff, (const char*)(gbase) + (h) * hstep, voffA); } while (0)
#define PG8_LDA(dst, b, h) do { _Pragma("unroll") for (int m = 0; m < 4; ++m) _Pragma("unroll") for (int k = 0; k < 2; ++k) dst[m][k] = *(const LAS bf16x8*)(lds + PG8_SA(b, h) + aoff + m * 2048 + k * 1024); } while (0)
#define PG8_LDB(dst, b, h) do { _Pragma("unroll") for (int n = 0; n < 2; ++n) _Pragma("unroll") for (int k = 0; k < 2; ++k) dst[n][k] = *(const LAS bf16x8*)(lds + PG8_SB(b, h) + boff + n * 2048 + k * 1024); } while (0)
#define PG8_MMA(ai, bj, At, Bt) do { __builtin_amdgcn_s_setprio(1); _Pragma("unroll") for (int m = 0; m < 4; ++m) _Pragma("unroll") for (int n = 0; n < 2; ++n) _Pragma("unroll") for (int k = 0; k < 2; ++k) \
        acc[ai][bj][m][n] = __builtin_amdgcn_mfma_f32_16x16x32_bf16(Bt[n][k], At[m][k], acc[ai][bj][m][n], 0, 0, 0); __builtin_amdgcn_s_setprio(0); } while (0)
#define PG8_WAIT_V(n) asm volatile("s_waitcnt vmcnt(" #n ")" ::: "memory")
#define PG8_WAIT_L(n) asm volatile("s_waitcnt lgkmcnt(" #n ")" ::: "memory")
#define PG8_BAR __builtin_amdgcn_s_barrier()
#define PG8_SCHED __builtin_amdgcn_sched_barrier(0)
#define PG8_SETV(dst, u) do { _Pragma("unroll") for (int _h = 0; _h < 2; ++_h) _Pragma("unroll") for (int _i = 0; _i < 2; ++_i) { int R_, C_; stage_rc(tid * 16 + _i * 8192, R_, C_); \
        dst[_h][_i] = (S.a_row(u, _h * HALF + R_) * (unsigned)K + (unsigned)C_) * 2u; } } while (0)
    Unit cur, nxt; int ui = 0;
    if (!S.next(0, cur)) return;
    f32x4 acc[2][2][4][2];
#pragma unroll
    for (int a = 0; a < 2; ++a)
#pragma unroll
        for (int b = 0; b < 2; ++b)
#pragma unroll
            for (int m = 0; m < 4; ++m)
#pragma unroll
                for (int n = 0; n < 2; ++n) acc[a][b][m][n] = (f32x4){0.f, 0.f, 0.f, 0.f};
    bf16x8 At[4][2], B0[2][2], B1[2][2];
    const char* cA = S.a_ptr(cur); const char* cB = S.b_ptr(cur);
    if constexpr (Sched::GATHER) { PG8_SETV(vA, cur); }
    PG8_STAGE(PG8_SB(0, 0), cB, voffB); PG8_STAGE(PG8_SB(0, 1), cB + hstep, voffB); PG8_STAGE_A(PG8_SA(0, 0), cA, 0, false); PG8_STAGE_A(PG8_SA(0, 1), cA, 1, false);
    if (wr == 1) PG8_BAR;
    PG8_WAIT_V(2); PG8_BAR;
    PG8_STAGE(PG8_SB(1, 0), cB + kstep, voffB); PG8_STAGE_A(PG8_SA(1, 0), cA + kstep, 0, false); PG8_STAGE(PG8_SB(1, 1), cB + hstep + kstep, voffB);
    PG8_WAIT_V(6); PG8_BAR;
    for (;;) {
        const bool has_next = S.next(ui + 1, nxt);
        const char* nA = has_next ? S.a_ptr(nxt) : cA; const char* nB = has_next ? S.b_ptr(nxt) : cB;
        if constexpr (Sched::GATHER) { if (has_next) { PG8_SETV(vN, nxt); } else {
#pragma unroll
            for (int h = 0; h < 2; ++h)
#pragma unroll
                for (int i = 0; i < 2; ++i) vN[h][i] = vA[h][i]; } }
        for (int t = 0; t < nt; t += 2) {
            const bool last = (t == nt - 2);
            if constexpr (Epi::MIDK) { if (t == nt / 2) E.mid(acc, cur, wr, wc, fr, fq); }
            const char* a1 = cA + (size_t)(t + 1) * kstep;
            const char* a2 = last ? nA : cA + (size_t)(t + 2) * kstep; const char* b2 = last ? nB : cB + (size_t)(t + 2) * kstep;
            const char* a3 = a2 + kstep; const char* b3 = b2 + kstep;
            PG8_LDB(B0, 0, 0); PG8_LDB(B1, 0, 1); PG8_SCHED; PG8_LDA(At, 0, 0); PG8_STAGE_A(PG8_SA(1, 1), a1, 1, false);
            PG8_WAIT_V(8); PG8_WAIT_L(0); PG8_BAR; PG8_MMA(0, 0, At, B0); PG8_MMA(0, 1, At, B1); PG8_BAR; PG8_SCHED;
            PG8_LDA(At, 0, 1); PG8_STAGE(PG8_SB(0, 0), b2, voffB); PG8_STAGE(PG8_SB(0, 1), b2 + hstep, voffB); PG8_STAGE_A(PG8_SA(0, 0), a2, 0, last);
            PG8_WAIT_V(8); PG8_WAIT_L(0); PG8_BAR; PG8_MMA(1, 0, At, B0); PG8_MMA(1, 1, At, B1); PG8_BAR; PG8_SCHED;
            PG8_LDB(B0, 1, 0); PG8_LDB(B1, 1, 1); PG8_SCHED; PG8_LDA(At, 1, 0); PG8_STAGE_A(PG8_SA(0, 1), a2, 1, last);
            PG8_WAIT_V(8); PG8_WAIT_L(0); PG8_BAR; PG8_MMA(0, 0, At, B0); PG8_MMA(0, 1, At, B1); PG8_BAR; PG8_SCHED;
            PG8_LDA(At, 1, 1); PG8_STAGE(PG8_SB(1, 0), b3, voffB); PG8_STAGE(PG8_SB(1, 1), b3 + hstep, voffB); PG8_STAGE_A(PG8_SA(1, 0), a3, 0, last);
            PG8_WAIT_V(8); PG8_WAIT_L(0); PG8_BAR; PG8_MMA(1, 0, At, B0); PG8_MMA(1, 1, At, B1); PG8_BAR; PG8_SCHED;
        }
        if constexpr (ALIGN_EPI) { if (wr == 0) PG8_BAR; }
        E(acc, cur, wr, wc, fr, fq);
        if (!has_next) break;
#pragma unroll
        for (int a = 0; a < 2; ++a)
#pragma unroll
            for (int b = 0; b < 2; ++b)
#pragma unroll
                for (int m = 0; m < 4; ++m)
#pragma unroll
                    for (int n = 0; n < 2; ++n) acc[a][b][m][n] = (f32x4){0.f, 0.f, 0.f, 0.f};
        cur = nxt; cA = nA; cB = nB; ++ui;
        if constexpr (Sched::GATHER) {
#pragma unroll
            for (int h = 0; h < 2; ++h)
#pragma unroll
                for (int i = 0; i < 2; ++i) vA[h][i] = vN[h][i]; }
        if constexpr (ALIGN_EPI) { if (wr == 1) PG8_BAR; }
    }
    PG8_WAIT_V(0);
    if constexpr (!ALIGN_EPI) { if (wr == 0) PG8_BAR; }
    PG8_BAR;
#undef PG8_SA
#undef PG8_SB
#undef PG8_STAGE
#undef PG8_STAGE_A
#undef PG8_LDA
#undef PG8_LDB
#undef PG8_MMA
#undef PG8_WAIT_V
#undef PG8_WAIT_L
#undef PG8_BAR
#undef PG8_SCHED
#undef PG8_SETV
}
}
using pg8::Unit;

#define EPI_ROWS(ai, m) for (int ai = 0; ai < 2; ++ai) for (int m = 0; m < 4; ++m)

struct EpiInProj {
    static constexpr bool MIDK = false;
    bf16 *qlat, *kvlat, *kpe, *fq, *gates; float *logf, *ssqq, *ssqkv; const float* ropetab; const float* bforget;
    __device__ __forceinline__ void operator()(const f32x4 (&acc)[2][2][4][2], const Unit& u, int wr, int wc, int fr, int fq_) const {
        const int pn = u.pn, row0 = u.pm * 256 + wr * 64 + fr, c0 = wc * 32 + 8 * fq_;
#pragma unroll
        for (int ai = 0; ai < 2; ++ai)
#pragma unroll
            for (int m = 0; m < 4; ++m) {
                const int row = row0 + ai * 128 + m * 16;
                if (pn == 0) {
                    float s = 0.f;
#pragma unroll
                    for (int bj = 0; bj < 2; ++bj) { const f32x4 v0 = acc[ai][bj][m][0], v1 = acc[ai][bj][m][1];
                        s += (v0[0] * v0[0] + v0[1] * v0[1]) + (v0[2] * v0[2] + v0[3] * v0[3]) + (v1[0] * v1[0] + v1[1] * v1[1]) + (v1[2] * v1[2] + v1[3] * v1[3]);
                        *(u32x4*)(qlat + (size_t)row * QLORA + c0 + 128 * bj) = pack8(v0, v1); }
                    s += __shfl_xor(s, 16); s += __shfl_xor(s, 32);
                    if (fq_ == 0) ssqq[row * 4 + wc] = s;
                } else if (pn == 1) {
                    { const f32x4 v0 = acc[ai][0][m][0], v1 = acc[ai][0][m][1];
                      float s = (v0[0] * v0[0] + v0[1] * v0[1]) + (v0[2] * v0[2] + v0[3] * v0[3]) + (v1[0] * v1[0] + v1[1] * v1[1]) + (v1[2] * v1[2] + v1[3] * v1[3]);
                      *(u32x4*)(kvlat + (size_t)row * KVPAD + c0) = pack8(v0, v1);
                      s += __shfl_xor(s, 16); s += __shfl_xor(s, 32);
                      if (fq_ == 0) ssqkv[row * 4 + wc] = s; }
                    { const f32x4 v0 = acc[ai][1][m][0], v1 = acc[ai][1][m][1];
                      *(u32x4*)(kvlat + (size_t)row * KVPAD + 128 + c0) = (u32x4){0u, 0u, 0u, 0u};
                      if (wc == 0) {
                          const f32x4* tb = (const f32x4*)(ropetab + ((size_t)row * 16 + 4 * fq_) * 2);
                          const f32x4 t0 = tb[0], t1 = tb[1];
                          f32x4 o1, o2;
                          o1[0] = v0[0] * t0[0] - v1[0] * t0[1]; o2[0] = v1[0] * t0[0] + v0[0] * t0[1];
                          o1[1] = v0[1] * t0[2] - v1[1] * t0[3]; o2[1] = v1[1] * t0[2] + v0[1] * t0[3];
                          o1[2] = v0[2] * t1[0] - v1[2] * t1[1]; o2[2] = v1[2] * t1[0] + v0[2] * t1[1];
                          o1[3] = v0[3] * t1[2] - v1[3] * t1[3]; o2[3] = v1[3] * t1[2] + v0[3] * t1[3];
                          *(u32x4*)(kpe + (size_t)row * ROPE + 8 * fq_) = pack8(o1, o2);
                      } else if (wc == 1 && fq_ == 0) {
                          f32x4 l0, l1;
#pragma unroll
                          for (int h = 0; h < 4; ++h) { const float z0 = v0[h] + bforget[h], z1 = v1[h] + bforget[4 + h];
                              l0[h] = (fminf(z0, 0.f) - log1pf(expf(-fabsf(z0)))) * LOG2E; l1[h] = (fminf(z1, 0.f) - log1pf(expf(-fabsf(z1)))) * LOG2E; }
                          *(f32x4*)(logf + (size_t)row * 8) = l0; *(f32x4*)(logf + (size_t)row * 8 + 4) = l1;
                      } }
                } else if (pn < 8) {
                    bf16* dst = fq + (size_t)((pn - 2) >> 1) * ((size_t)T * 512); const float sc = (pn < 4) ? C2F : 1.f;
#pragma unroll
                    for (int bj = 0; bj < 2; ++bj) *(u32x4*)(dst + (size_t)row * 512 + (pn & 1) * 256 + c0 + 128 * bj) = pack8(acc[ai][bj][m][0] * sc, acc[ai][bj][m][1] * sc);
                } else {
#pragma unroll
                    for (int bj = 0; bj < 2; ++bj) { f32x4 v0 = acc[ai][bj][m][0], v1 = acc[ai][bj][m][1];
#pragma unroll
                        for (int q = 0; q < 4; ++q) { v0[q] = fmaxf(sigmoidf_(v0[q]), 1e-30f); v1[q] = fmaxf(sigmoidf_(v1[q]), 1e-30f); }
                        *(u32x4*)(gates + (size_t)row * 2048 + (pn - 8) * 256 + c0 + 128 * bj) = pack8(v0, v1); }
                }
            }
    }
};

struct EpiQup {
    static constexpr bool MIDK = false;
    bf16* q; const float* ssqq; const float* ropetab;
    __device__ __forceinline__ void operator()(const f32x4 (&acc)[2][2][4][2], const Unit& u, int wr, int wc, int fr, int fq_) const {
        const int row0 = u.pm * 256 + wr * 64 + fr, c0 = u.pn * 256 + wc * 32 + 8 * fq_;
#pragma unroll
        for (int ai = 0; ai < 2; ++ai)
#pragma unroll
            for (int m = 0; m < 4; ++m) {
                const int row = row0 + ai * 128 + m * 16;
                const f32x4 sq = *(const f32x4*)(ssqq + row * 4);
                const float rs = rsqrtf(((sq[0] + sq[1]) + (sq[2] + sq[3])) * (1.f / QLORA) + EPS) * C2M;
#pragma unroll
                for (int bj = 0; bj < 2; ++bj) {
                    const int col = c0 + 128 * bj, j = col % MQK;
                    f32x4 v0 = acc[ai][bj][m][0] * rs, v1 = acc[ai][bj][m][1] * rs;
                    if (j >= 64) { const int g = (j - 64) >> 3;
                        const f32x4* tb = (const f32x4*)(ropetab + ((size_t)row * 16 + 4 * g) * 2);
                        const f32x4 t0 = tb[0], t1 = tb[1];
                        f32x4 o1, o2;
                        o1[0] = v0[0] * t0[0] - v1[0] * t0[1]; o2[0] = v1[0] * t0[0] + v0[0] * t0[1];
                        o1[1] = v0[1] * t0[2] - v1[1] * t0[3]; o2[1] = v1[1] * t0[2] + v0[1] * t0[3];
                        o1[2] = v0[2] * t1[0] - v1[2] * t1[1]; o2[2] = v1[2] * t1[0] + v0[2] * t1[1];
                        o1[3] = v0[3] * t1[2] - v1[3] * t1[3]; o2[3] = v1[3] * t1[2] + v0[3] * t1[3];
                        v0 = o1; v1 = o2; }
                    *(u32x4*)(q + (size_t)row * 768 + col) = pack8(v0, v1);
                }
            }
    }
};

struct EpiKVup {
    static constexpr bool MIDK = false;
    bf16 *kn, *vm; const float* ssqkv;
    __device__ __forceinline__ void operator()(const f32x4 (&acc)[2][2][4][2], const Unit& u, int wr, int wc, int fr, int fq_) const {
        const int row0 = u.pm * 256 + wr * 64 + fr, c0 = u.pn * 256 + wc * 32 + 8 * fq_;
        bf16* dst = (u.pn < 2) ? kn : vm; const int cb = (u.pn & 1) * 256 + wc * 32 + 8 * fq_;
        (void)c0;
#pragma unroll
        for (int ai = 0; ai < 2; ++ai)
#pragma unroll
            for (int m = 0; m < 4; ++m) {
                const int row = row0 + ai * 128 + m * 16;
                const f32x4 sq = *(const f32x4*)(ssqkv + row * 4);
                const float rs = rsqrtf(((sq[0] + sq[1]) + (sq[2] + sq[3])) * (1.f / KVLORA) + EPS);
#pragma unroll
                for (int bj = 0; bj < 2; ++bj) *(u32x4*)(dst + (size_t)row * 512 + cb + 128 * bj) = pack8(acc[ai][bj][m][0] * rs, acc[ai][bj][m][1] * rs);
            }
    }
};

struct EpiPartA {
    static constexpr bool MIDK = false;
    float* part; const bf16* gates;
    __device__ __forceinline__ void operator()(const f32x4 (&acc)[2][2][4][2], const Unit& u, int wr, int wc, int fr, int fq_) const {
        const int row0 = u.pm * 256 + wr * 64 + fr, c0 = u.pn * 256 + wc * 32 + 8 * fq_;
#pragma unroll
        for (int ai = 0; ai < 2; ++ai)
#pragma unroll
            for (int m = 0; m < 4; ++m) {
                const int row = row0 + ai * 128 + m * 16;
#pragma unroll
                for (int bj = 0; bj < 2; ++bj) { const int col = c0 + 128 * bj;
                    f32x4 g0, g1; unpack8(*(const u32x4*)(gates + (size_t)row * 2048 + col), g0, g1);
                    *(f32x4*)(part + (size_t)row * D + col) = g0 * acc[ai][bj][m][0]; *(f32x4*)(part + (size_t)row * D + col + 4) = g1 * acc[ai][bj][m][1]; }
            }
    }
};
struct EpiMerged {
    static constexpr bool MIDK = false;
    const float* part; const bf16* gates; bf16* merged;
    __device__ __forceinline__ void operator()(const f32x4 (&acc)[2][2][4][2], const Unit& u, int wr, int wc, int fr, int fq_) const {
        const int row0 = u.pm * 256 + wr * 64 + fr, c0 = u.pn * 256 + wc * 32 + 8 * fq_;
#pragma unroll
        for (int ai = 0; ai < 2; ++ai)
#pragma unroll
            for (int m = 0; m < 4; ++m) {
                const int row = row0 + ai * 128 + m * 16;
#pragma unroll
                for (int bj = 0; bj < 2; ++bj) { const int col = c0 + 128 * bj;
                    f32x4 g0, g1; unpack8(*(const u32x4*)(gates + (size_t)row * 2048 + 1024 + col), g0, g1);
                    const f32x4 p0 = *(const f32x4*)(part + (size_t)row * D + col), p1 = *(const f32x4*)(part + (size_t)row * D + col + 4);
                    *(u32x4*)(merged + (size_t)row * D + col) = pack8(p0 + g0 * acc[ai][bj][m][0], p1 + g1 * acc[ai][bj][m][1]); }
            }
    }
};
struct EpiMergedCat {
    static constexpr bool MIDK = true;
    const bf16* gates; bf16* merged;
    __device__ __forceinline__ void mid(f32x4 (&acc)[2][2][4][2], const Unit& u, int wr, int wc, int fr, int fq_) const {
        int row0 = u.pm * 256 + wr * 64 + fr, c0 = u.pn * 256 + wc * 32 + 8 * fq_;
        asm volatile("" : "+v"(row0), "+v"(c0));
#pragma unroll
        for (int ai = 0; ai < 2; ++ai)
#pragma unroll
            for (int m = 0; m < 4; ++m) { const int row = row0 + ai * 128 + m * 16;
#pragma unroll
                for (int bj = 0; bj < 2; ++bj) { const int col = c0 + 128 * bj;
                    f32x4 a0, a1, b0, b1; unpack8(*(const u32x4*)(gates + (size_t)row * 2048 + col), a0, a1); unpack8(*(const u32x4*)(gates + (size_t)row * 2048 + 1024 + col), b0, b1);
#pragma unroll
                    for (int q = 0; q < 4; ++q) { acc[ai][bj][m][0][q] *= a0[q] * __builtin_amdgcn_rcpf(b0[q]); acc[ai][bj][m][1][q] *= a1[q] * __builtin_amdgcn_rcpf(b1[q]); } }
                asm volatile("" ::: "memory"); }
    }
    __device__ __forceinline__ void operator()(const f32x4 (&acc)[2][2][4][2], const Unit& u, int wr, int wc, int fr, int fq_) const {
        const int row0 = u.pm * 256 + wr * 64 + fr, c0 = u.pn * 256 + wc * 32 + 8 * fq_;
#pragma unroll
        for (int ai = 0; ai < 2; ++ai)
#pragma unroll
            for (int m = 0; m < 4; ++m) { const int row = row0 + ai * 128 + m * 16;
#pragma unroll
                for (int bj = 0; bj < 2; ++bj) { const int col = c0 + 128 * bj;
                    f32x4 b0, b1; unpack8(*(const u32x4*)(gates + (size_t)row * 2048 + 1024 + col), b0, b1);
                    *(u32x4*)(merged + (size_t)row * D + col) = pack8(b0 * acc[ai][bj][m][0], b1 * acc[ai][bj][m][1]); } }
    }
};
struct EpiOut {
    static constexpr bool MIDK = false;
    const float* x; float* x1; const float* mod; float* ssq1;
    __device__ __forceinline__ void operator()(const f32x4 (&acc)[2][2][4][2], const Unit& u, int wr, int wc, int fr, int fq_) const {
        const int row0 = u.pm * 256 + wr * 64 + fr, c0 = u.pn * 256 + wc * 32 + 8 * fq_;
        const float* gm = mod + (size_t)((u.pm * 256) / SEQ) * 6 * D + 2 * D;
        f32x4 g[2][2];
#pragma unroll
        for (int bj = 0; bj < 2; ++bj) { g[bj][0] = *(const f32x4*)(gm + c0 + 128 * bj); g[bj][1] = *(const f32x4*)(gm + c0 + 128 * bj + 4); }
#pragma unroll
        for (int ai = 0; ai < 2; ++ai)
#pragma unroll
            for (int m = 0; m < 4; ++m) { const int row = row0 + ai * 128 + m * 16; float sq = 0.f;
#pragma unroll
                for (int bj = 0; bj < 2; ++bj) { const int col = c0 + 128 * bj;
                    const f32x4 x0 = __builtin_nontemporal_load((const f32x4*)(x + (size_t)row * D + col)), x1v = __builtin_nontemporal_load((const f32x4*)(x + (size_t)row * D + col + 4));
                    const f32x4 r0 = x0 + g[bj][0] * acc[ai][bj][m][0], r1 = x1v + g[bj][1] * acc[ai][bj][m][1];
                    *(f32x4*)(x1 + (size_t)row * D + col) = r0; *(f32x4*)(x1 + (size_t)row * D + col + 4) = r1;
                    sq += (r0[0] * r0[0] + r0[1] * r0[1]) + (r0[2] * r0[2] + r0[3] * r0[3]) + (r1[0] * r1[0] + r1[1] * r1[1]) + (r1[2] * r1[2] + r1[3] * r1[3]); }
                sq += __shfl_xor(sq, 16); sq += __shfl_xor(sq, 32);
                if (fq_ == 0) ssq1[(size_t)row * 16 + 4 * u.pn + wc] = sq; }
    }
};
struct EpiHb {
    static constexpr bool MIDK = false;
    bf16* hb;
    __device__ __forceinline__ void operator()(const f32x4 (&acc)[2][2][4][2], const Unit& u, int wr, int wc, int fr, int fq_) const {
        const int row0 = u.pm * 256 + wr * 64 + fr, c0 = u.pn * 128 + wc * 32 + 8 * fq_;
#pragma unroll
        for (int ai = 0; ai < 2; ++ai)
#pragma unroll
            for (int m = 0; m < 4; ++m) { const int row = row0 + ai * 128 + m * 16;
                f32x4 h0, h1;
#pragma unroll
                for (int q = 0; q < 4; ++q) { h0[q] = siluf_(acc[ai][0][m][0][q]) * acc[ai][1][m][0][q]; h1[q] = siluf_(acc[ai][0][m][1][q]) * acc[ai][1][m][1][q]; }
                *(u32x4*)(hb + (size_t)row * DEXP + c0) = pack8(h0, h1); }
    }
};
struct EpiDown {
    static constexpr bool MIDK = false;
    bf16* Y; float* out; float* outw; const float* mod; const unsigned short* list; const unsigned char* eidx; const float* gatew;
    __device__ __forceinline__ void operator()(const f32x4 (&acc)[2][2][4][2], const Unit& u, int wr, int wc, int fr, int fq_) const {
        const int c0 = u.pn * 256 + wc * 32 + 8 * fq_;
#pragma unroll
        for (int ai = 0; ai < 2; ++ai)
#pragma unroll
            for (int m = 0; m < 4; ++m) {
                const int rl = wr * 64 + fr + ai * 128 + m * 16, idx = u.aux * 256 + rl;
                if (u.e == NEXP) {
                    const int t = idx; const float* gf = mod + (size_t)(t / SEQ) * 6 * D + 5 * D;
#pragma unroll
                    for (int bj = 0; bj < 2; ++bj) { const int col = c0 + 128 * bj; const float* o = out + (size_t)t * D + col; float* ow = outw + (size_t)t * D + col;
                        const f32x4 g0 = *(const f32x4*)(gf + col), g1 = *(const f32x4*)(gf + col + 4);
                        const f32x4 x0 = *(const f32x4*)o, x1v = *(const f32x4*)(o + 4);
                        *(f32x4*)ow = x0 + g0 * acc[ai][bj][m][0]; *(f32x4*)(ow + 4) = x1v + g1 * acc[ai][bj][m][1]; }
                } else if (idx < u.n) {
                    const int t = list[(size_t)u.e * LISTCAP + idx];
                    const u32x2 ev = *(const u32x2*)(eidx + (size_t)t * 8);
                    int k = 0;
#pragma unroll
                    for (int q = 1; q < TOPK; ++q) { const unsigned b = (q < 4) ? ((ev.x >> (8 * q)) & 0xffu) : ((ev.y >> (8 * (q - 4))) & 0xffu); if ((int)b == u.e) k = q; }
                    const float w = gatew[(size_t)t * 8 + k];
#pragma unroll
                    for (int bj = 0; bj < 2; ++bj) *(u32x4*)(Y + ((size_t)t * TOPK + k) * D + c0 + 128 * bj) = pack8(acc[ai][bj][m][0] * w, acc[ai][bj][m][1] * w);
                }
            }
    }
};

template <int NT, bool GATHER_>
struct MoeOrder {
    static constexpr bool GATHER = GATHER_;
    const char* A; const char* Bt; const char* Bsh; int K; size_t bstride;
    const unsigned short* list; volatile LAS int* tab;
    int G, c;
    __device__ bool next(int i, Unit& u) const {
        int ti, pn_;
        if ((G & 7) == 0) { const int x = c & 7, j = i * (G >> 3) + (c >> 3); ti = (j / NT) * 8 + x; pn_ = j % NT; if (ti >= tab[65]) return false; }
        else { const int total = tab[65] * NT; const long L = (long)i * G + c; if (L >= total) return false; ti = (int)L / NT; pn_ = (int)L % NT; }
        u.pn = pn_; u.pm = ti;
        const int e = __builtin_amdgcn_readfirstlane(tab[132 + ti]);
        u.e = e; u.aux = __builtin_amdgcn_readfirstlane(ti - tab[e]); u.n = __builtin_amdgcn_readfirstlane(tab[66 + e]); return true;
    }
    __device__ __forceinline__ const char* a_ptr(const Unit& u) const { return GATHER ? A : A + (size_t)u.pm * 256 * K * 2; }
    __device__ __forceinline__ const char* b_ptr(const Unit& u) const { return (u.e == NEXP ? Bsh : Bt + (size_t)u.e * bstride) + (size_t)u.pn * 256 * K * 2; }
    __device__ __forceinline__ unsigned a_row(const Unit& u, int r) const {
        if (!GATHER) return (unsigned)r;
        const int idx = u.aux * 256 + r;
        if (u.e == NEXP) return (unsigned)idx;
        return (idx < u.n) ? (unsigned)list[(size_t)u.e * LISTCAP + idx] : 0u;
    }
};

struct UpOrder {
    static constexpr bool GATHER = false;
    const char* Aq; const char* Bq; const char* Akv; const char* Bkv; int K; int G, c;
    __device__ bool next(int i, Unit& u) const {
        int L = i * G + c; if (L >= 448) return false;
        if (L < 256) { u.e = 1; u.pm = L >> 2; u.pn = L & 3; } else { L -= 256; u.e = 0; u.pm = L / 3; u.pn = L % 3; }
        u.aux = 0; u.n = 256; return true; }
    __device__ __forceinline__ const char* a_ptr(const Unit& u) const { return (u.e ? Akv : Aq) + (size_t)u.pm * 256 * K * 2; }
    __device__ __forceinline__ const char* b_ptr(const Unit& u) const { return (u.e ? Bkv : Bq) + (size_t)u.pn * 256 * K * 2; }
    __device__ __forceinline__ unsigned a_row(const Unit&, int r) const { return (unsigned)r; }
};
struct EpiUp {
    static constexpr bool MIDK = false;
    EpiQup q; EpiKVup kv;
    __device__ __forceinline__ void operator()(const f32x4 (&acc)[2][2][4][2], const Unit& u, int wr, int wc, int fr, int fq_) const { if (u.e) kv(acc, u, wr, wc, fr, fq_); else q(acc, u, wr, wc, fr, fq_); }
};

struct SharedDownOrder {
    static constexpr bool GATHER = false;
    const char* A; const char* Bt; int K; int G, c;
    __device__ bool next(int i, Unit& u) const { const int L = i * G + c; if (L >= (T / 256) * 4) return false; u.pm = L >> 2; u.pn = L & 3; u.e = NEXP; u.aux = L >> 2; u.n = 256; return true; }
    __device__ __forceinline__ const char* a_ptr(const Unit& u) const { return A + (size_t)u.pm * 256 * K * 2; }
    __device__ __forceinline__ const char* b_ptr(const Unit& u) const { return Bt + (size_t)u.pn * 256 * K * 2; }
    __device__ __forceinline__ unsigned a_row(const Unit&, int r) const { return (unsigned)r; }
};

namespace att {
constexpr int KSLOT = 12288, VSLOT = 8192;
constexpr int L_K = 0, L_V = 3 * KSLOT, L_F = L_V + 2 * VSLOT, L_WS = L_F + 3 * 256, L_OST = L_WS + 2048, L_END = L_OST + 8 * 4096;
static_assert(L_END <= RING_BYTES, "attention LDS");
__device__ __forceinline__ int crow(int r, int hi) { return (r & 3) + 8 * (r >> 2) + 4 * hi; }
__device__ __forceinline__ float max3f(float a, float b, float c) { return fmaxf(fmaxf(a, b), c); }
__device__ __forceinline__ float rowmax(const f32x16& p0, const f32x16& p1) {
    float a = max3f(p0[0], p0[1], p1[0]), b = max3f(p0[2], p0[3], p1[1]); a = max3f(a, p1[2], p1[3]);
#pragma unroll
    for (int r = 4; r < 16; r += 4) { a = max3f(a, p0[r], p0[r + 1]); b = max3f(b, p0[r + 2], p0[r + 3]); a = max3f(a, p1[r], p1[r + 1]); b = max3f(b, p1[r + 2], p1[r + 3]); }
    const float m = fmaxf(a, b);
    auto rr = __builtin_amdgcn_permlane32_swap(__float_as_uint(m), __float_as_uint(m), false, false);
    return fmaxf(__uint_as_float(rr[0]), __uint_as_float(rr[1]));
}
__device__ __forceinline__ void cmask(f32x16& p0, f32x16& p1, int jb, int qrel, int hi) {
    const float NEG = -INFINITY; const int kb = 64 * jb + 4 * hi;
#pragma unroll
    for (int r = 0; r < 16; ++r) { const int kv = kb + (r & 3) + 8 * (r >> 2); if (kv > qrel) p0[r] = NEG; if (kv + 32 > qrel) p1[r] = NEG; }
}
__device__ __forceinline__ void pv(f32x16* o, int vb, bf16x8 pa0, bf16x8 pa1, bf16x8 pa2, bf16x8 pa3) {
#pragma unroll
    for (int d0 = 0; d0 < 2; ++d0) { s16x4 lo[4], hi[4];
#pragma unroll
        for (int ks = 0; ks < 4; ++ks) {
            asm volatile("ds_read_b64_tr_b16 %0,%1 offset:%c2" : "=&v"(lo[ks]) : "v"(vb), "i"(d0 * 4096 + ks * 1024) : "memory");
            asm volatile("ds_read_b64_tr_b16 %0,%1 offset:%c2" : "=&v"(hi[ks]) : "v"(vb), "i"(d0 * 4096 + ks * 1024 + 512) : "memory"); }
        asm volatile("s_waitcnt lgkmcnt(0)" ::: "memory"); __builtin_amdgcn_sched_barrier(0);
#define PK(k) (bf16x8){lo[k][0], lo[k][1], lo[k][2], lo[k][3], hi[k][0], hi[k][1], hi[k][2], hi[k][3]}
        o[d0] = __builtin_amdgcn_mfma_f32_32x32x16_bf16(pa0, PK(0), o[d0], 0, 0, 0);
        o[d0] = __builtin_amdgcn_mfma_f32_32x32x16_bf16(pa1, PK(1), o[d0], 0, 0, 0);
        o[d0] = __builtin_amdgcn_mfma_f32_32x32x16_bf16(pa2, PK(2), o[d0], 0, 0, 0);
        o[d0] = __builtin_amdgcn_mfma_f32_32x32x16_bf16(pa3, PK(3), o[d0], 0, 0, 0);
#undef PK
    }
}
__device__ __forceinline__ unsigned cvtpk_s(float lo, float hi) { return cvt_pk_bf16(lo, hi); }

template <int DQK, bool DECAY, int THRL>
__device__ __forceinline__ void attn_unit(int b, int h, int qb, const bf16* Q, int QP, const bf16* Kn, const bf16* Kpe, const bf16* V, const float* cumF, bf16* O, int OP, LAS unsigned char* lds) {
    constexpr int ND0 = DQK / 16;
    int tid = threadIdx.x; asm volatile("" : "+v"(tid));
    const int lane = tid & 63, r32 = lane & 31, hi = lane >> 5; const int wid = __builtin_amdgcn_readfirstlane(tid >> 6);
    const long rowbase = (long)b * SEQ; const int q0 = qb * 256;
    const bf16* Qw = Q + (rowbase + q0 + wid * 32) * QP + h * DQK;
    const bf16* Kh = Kn + rowbase * 512 + h * 64; const bf16* Vh = V + rowbase * 512 + h * 64;
    const bf16* Kp = Kpe + rowbase * ROPE;
    const float* Fh = DECAY ? cumF + ((size_t)b * NHEAD + h) * SEQ : nullptr;
    LAS float* wsf = (LAS float*)(lds + L_WS) + wid * 64;
    const bf16* ksrc0 = Kh + (long)lane * 512 + wid * 8;
    const bf16* ksrc1 = Kp + (long)lane * ROPE + (wid & 3) * 8;
    const bf16* vsrc = Vh + (long)(16 * (wid & 3) + (lane >> 2)) * 512 + (wid >> 2) * 32 + (lane & 3) * 8;
    const int NT = (q0 + 256) / 64;
#define ATT_DMA_K(i_, s) do { const int t_ = NT - 1 - (i_); \
        __builtin_amdgcn_global_load_lds((const unsigned*)(ksrc0 + (long)t_ * 64 * 512), (LAS unsigned*)(lds + L_K + (s) * KSLOT + wid * 1024), 16, 0, 0); \
        if (DQK == 96 && wid < 4) __builtin_amdgcn_global_load_lds((const unsigned*)(ksrc1 + (long)t_ * 64 * ROPE), (LAS unsigned*)(lds + L_K + (s) * KSLOT + (8 + wid) * 1024), 16, 0, 0); \
        if (DECAY && wid == 7) __builtin_amdgcn_global_load_lds((const unsigned*)(Fh + t_ * 64 + lane), (LAS unsigned*)(lds + L_F + (s) * 256), 4, 0, 0); } while (0)
#define ATT_DMA_V(i_, s) do { const int t_ = NT - 1 - (i_); \
        __builtin_amdgcn_global_load_lds((const unsigned*)(vsrc + (long)t_ * 64 * 512), (LAS unsigned*)(lds + L_V + (s) * VSLOT + wid * 1024), 16, 0, 0); } while (0)
    ATT_DMA_K(0, 0); ATT_DMA_V(0, 0); ATT_DMA_K(1, 1);
    bf16x8 qr[ND0];
#pragma unroll
    for (int d0 = 0; d0 < ND0; ++d0) qr[d0] = *(const bf16x8*)(Qw + (long)r32 * QP + d0 * 16 + hi * 8);
    float fq_l = 0.f; if (DECAY) fq_l = Fh[q0 + wid * 32 + r32];
    float mhat = 0.f, l_reg = 0.f; bool started = false; f32x16 o[2]; o[0] = f32x16{}; o[1] = f32x16{};
    const int qrel = wid * 32 + r32;
    const int vb0 = (int)(uintptr_t)(lds + L_V) + ((lane >> 4) & 1) * 32 + (lane & 3) * 8 + (4 * hi + ((lane & 15) >> 2)) * 64;
#define ATT_QK(P0, P1, ks_) do { const float base_ = fq_l - mhat; \
        if (DECAY) { const LAS f32x4* fk_ = (const LAS f32x4*)(lds + L_F + (ks_) * 256); \
            _Pragma("unroll") for (int g = 0; g < 4; ++g) { const f32x4 a_ = fk_[2 * g + hi], c_ = fk_[8 + 2 * g + hi]; \
                _Pragma("unroll") for (int q = 0; q < 4; ++q) { P0[4 * g + q] = base_ - a_[q]; P1[4 * g + q] = base_ - c_[q]; } } } \
        else { _Pragma("unroll") for (int r = 0; r < 16; ++r) { P0[r] = base_; P1[r] = base_; } } \
        const LAS unsigned char* kb_ = lds + L_K + (ks_) * KSLOT + hi * 1024 + r32 * 16; \
        _Pragma("unroll") for (int d0 = 0; d0 < ND0; ++d0) { \
            const bf16x8 b0_ = *(const LAS bf16x8*)(kb_ + d0 * 2048), b1_ = *(const LAS bf16x8*)(kb_ + d0 * 2048 + 512); \
            P0 = __builtin_amdgcn_mfma_f32_32x32x16_bf16(b0_, qr[d0], P0, 0, 0, 0); P1 = __builtin_amdgcn_mfma_f32_32x32x16_bf16(b1_, qr[d0], P1, 0, 0, 0); } } while (0)
    f32x16 p0, p1, n0, n1;
    int ks_cur = 0, ks_nxt = 1, ks_ld = 2;
    for (int i = 0; i < NT; ++i) {
        const int vs = i & 1;
        VM_WAIT(); __syncthreads();
        if (i + 2 < NT) ATT_DMA_K(i + 2, ks_ld);
        if (i + 1 < NT) ATT_DMA_V(i + 1, vs ^ 1);
        if (i == 0) ATT_QK(p0, p1, 0);
        if (i + 1 < NT) ATT_QK(n0, n1, ks_nxt);
        const int jb = 3 - i;
        if (jb >= 0) cmask(p0, p1, jb, qrel, hi);
        const float rm = rowmax(p0, p1);
        bool resc = false; float dl = 0.f; const bool was_started = started;
        if (jb >= 0) {
            const bool fin = rm > -INFINITY;
            dl = started ? fmaxf(rm, 0.f) : (fin ? rm : 0.f); started = started || fin; resc = true;
        } else if (__any(rm > (float)THRL)) { dl = fmaxf(rm, 0.f); resc = true; }
        if (resc) { mhat += dl;
#pragma unroll
            for (int r = 0; r < 16; ++r) { p0[r] -= dl; p1[r] -= dl; }
            if (i + 1 < NT) {
#pragma unroll
                for (int r = 0; r < 16; ++r) { n0[r] -= dl; n1[r] -= dl; } }
            const float f = was_started ? __builtin_amdgcn_exp2f(-dl) : 1.f; l_reg *= f; if (hi == 0) wsf[r32] = f; }
        float sacc = 0.f;
#pragma unroll
        for (int r = 0; r < 16; ++r) { p0[r] = __builtin_amdgcn_exp2f(p0[r]); p1[r] = __builtin_amdgcn_exp2f(p1[r]); sacc += p0[r] + p1[r]; }
        l_reg += sacc;
        if (resc) { LDS_WAIT();
#pragma unroll
            for (int d_ = 0; d_ < 2; ++d_)
#pragma unroll
                for (int r = 0; r < 16; ++r) o[d_][r] *= wsf[crow(r, hi)]; }
        u32x4 pw0, pw1, pw2, pw3;
        pw0 = (u32x4){cvtpk_s(p0[0], p0[1]), cvtpk_s(p0[2], p0[3]), cvtpk_s(p0[4], p0[5]), cvtpk_s(p0[6], p0[7])};
        pw1 = (u32x4){cvtpk_s(p0[8], p0[9]), cvtpk_s(p0[10], p0[11]), cvtpk_s(p0[12], p0[13]), cvtpk_s(p0[14], p0[15])};
        pw2 = (u32x4){cvtpk_s(p1[0], p1[1]), cvtpk_s(p1[2], p1[3]), cvtpk_s(p1[4], p1[5]), cvtpk_s(p1[6], p1[7])};
        pw3 = (u32x4){cvtpk_s(p1[8], p1[9]), cvtpk_s(p1[10], p1[11]), cvtpk_s(p1[12], p1[13]), cvtpk_s(p1[14], p1[15])};
        __builtin_amdgcn_sched_barrier(0);
        pv(o, vb0 + vs * VSLOT, __builtin_bit_cast(bf16x8, pw0), __builtin_bit_cast(bf16x8, pw1), __builtin_bit_cast(bf16x8, pw2), __builtin_bit_cast(bf16x8, pw3));
        p0 = n0; p1 = n1;
        { const int t_ = ks_cur; ks_cur = ks_nxt; ks_nxt = ks_ld; ks_ld = t_; }
    }
    { auto rr = __builtin_amdgcn_permlane32_swap(__float_as_uint(l_reg), __float_as_uint(l_reg), false, false); l_reg = __uint_as_float(rr[0]) + __uint_as_float(rr[1]); }
    if (hi == 0) wsf[32 + r32] = l_reg; LDS_WAIT();
    float rli[16];
#pragma unroll
    for (int r = 0; r < 16; ++r) rli[r] = __builtin_amdgcn_rcpf(wsf[32 + crow(r, hi)]);
    bf16* Ow = O + (rowbase + q0 + wid * 32) * OP + h * 64;
    { LAS bf16* stg = (LAS bf16*)(lds + L_OST) + wid * 2048;
#pragma unroll
      for (int r = 0; r < 16; ++r) { const int orow = crow(r, hi);
#pragma unroll
          for (int d0 = 0; d0 < 2; ++d0) stg[orow * 64 + d0 * 32 + r32] = (bf16)f2bf(o[d0][r] * rli[r]); }
      LDS_WAIT();
#pragma unroll
      for (int i = 0; i < 4; ++i) { const int row = i * 8 + (lane >> 3), ch = lane & 7; const u32x4 v = *(const LAS u32x4*)(stg + row * 64 + ch * 8); *(u32x4*)(Ow + (long)row * OP + ch * 8) = v; } }
    LDS_WAIT(); __syncthreads();
#undef ATT_DMA_K
#undef ATT_DMA_V
#undef ATT_QK
}

constexpr int T_KSLOT = 12288, T_VSLOT = 8192, T_NSLOT = 3;
constexpr int T_K = 0, T_V = T_NSLOT * T_KSLOT, T_F = T_V + T_NSLOT * T_VSLOT, T_WS = T_F + T_NSLOT * 256, T_OST = T_WS + 2048, T_END = T_OST + 8 * 4096;
static_assert(T_END <= RING_BYTES, "attention LDS (hand-interleaved unit)");
typedef __attribute__((address_space(3))) const char* lds_cptr;
typedef short v4i16_t __attribute__((ext_vector_type(4)));
__device__ __forceinline__ s16x4 vtr(lds_cptr p) { return __builtin_bit_cast(s16x4, __builtin_amdgcn_ds_read_tr16_b64_v4i16((__attribute__((address_space(3))) v4i16_t*)p)); }
__device__ __forceinline__ void kload2(bf16x8* kf, lds_cptr kp, int j) { kf[2 * j] = *(const __attribute__((address_space(3))) bf16x8*)(kp + j * 2048); kf[2 * j + 1] = *(const __attribute__((address_space(3))) bf16x8*)(kp + j * 2048 + 512); }
#define TW_BAR(N) asm volatile("s_waitcnt vmcnt(" #N ") lgkmcnt(0)\n\ts_barrier" ::: "memory")
#define TSB() __builtin_amdgcn_sched_barrier(0)

template <int DQK, bool DECAY, int THRL>
__device__ __forceinline__ void attn_unit_t(int b, int h, int qb, const bf16* Q, int QP, const bf16* Kn, const bf16* Kpe, const bf16* V, const float* cumF, float kmax2, bf16* O, int OP, LAS unsigned char* lds) {
    constexpr int ND0 = DQK / 16;
    constexpr bool INPL = DECAY || (DQK == 96);
    int tid = threadIdx.x; asm volatile("" : "+v"(tid));
    const int lane = tid & 63, r32 = lane & 31, hi = lane >> 5; const int wid = __builtin_amdgcn_readfirstlane(tid >> 6);
    const long rowbase = (long)b * SEQ; const int q0 = qb * 256;
    const bf16* Qw = Q + (rowbase + q0 + wid * 32) * QP + h * DQK;
    const bf16* Kh = Kn + rowbase * 512 + h * 64; const bf16* Vh = V + rowbase * 512 + h * 64;
    const bf16* Kp = Kpe + rowbase * ROPE;
    const float* Fh = DECAY ? cumF + ((size_t)b * NHEAD + h) * SEQ : nullptr;
    LAS float* wsf = (LAS float*)(lds + T_WS) + wid * 64;
    const bf16* ksrc0 = Kh + (long)lane * 512 + wid * 8;
    const bf16* ksrc1 = Kp + (long)lane * ROPE + (wid & 3) * 8;
    const bf16* vsrc = Vh + (long)(16 * (wid & 3) + (lane >> 2)) * 512 + (wid >> 2) * 32 + (lane & 3) * 8;
    const int NTS = (q0 + 256) / 64;
#define TDMA_K(i_, sk) do { const int t_ = NTS - 1 - (i_); \
        __builtin_amdgcn_global_load_lds((const unsigned*)(ksrc0 + (long)t_ * 64 * 512), (LAS unsigned*)(lds + T_K + (sk) * T_KSLOT + wid * 1024), 16, 0, 0); \
        if (DECAY) __builtin_amdgcn_global_load_lds((const unsigned*)(Fh + t_ * 64 + lane), (LAS unsigned*)(lds + T_F + (sk) * 256), 4, 0, 0); \
        else __builtin_amdgcn_global_load_lds((const unsigned*)(ksrc1 + (long)t_ * 64 * ROPE), (LAS unsigned*)(lds + T_K + (sk) * T_KSLOT + (8 + (wid & 3)) * 1024), 16, 0, 0); } while (0)
#define TDMA_V(i_, sv) do { const int t_ = NTS - 1 - (i_); \
        __builtin_amdgcn_global_load_lds((const unsigned*)(vsrc + (long)t_ * 64 * 512), (LAS unsigned*)(lds + T_V + (sv) * T_VSLOT + wid * 1024), 16, 0, 0); } while (0)
    TDMA_K(0, 0); TDMA_V(0, 0); TDMA_K(1, 1);
    bf16x8 qr[ND0];
#pragma unroll
    for (int d0 = 0; d0 < ND0; ++d0) qr[d0] = *(const bf16x8*)(Qw + (long)r32 * QP + d0 * 16 + hi * 8);
    float fq_l = 0.f; if (DECAY) fq_l = Fh[q0 + wid * 32 + r32];
    float ftile = 0.f; if (DECAY) ftile = Fh[(lane < NTS ? lane : NTS - 1) * 64 + 63];
    float mhat = 0.f, l_reg = 0.f; f32x16 o[2]; o[0] = f32x16{}; o[1] = f32x16{};
    f32x16 negm = f32x16{}; asm volatile("" : "+v"(negm));
    const int qrel = wid * 32 + r32, i0 = 3 - (wid >> 1);
    const lds_cptr shm3 = (lds_cptr)lds; const lds_cptr kp0 = shm3 + T_K + hi * 1024 + r32 * 16;
    const lds_cptr vp0 = shm3 + T_V + ((lane >> 4) & 1) * 32 + (lane & 3) * 8 + (4 * hi + ((lane & 15) >> 2)) * 64;
    const int vb0 = (int)(uintptr_t)(lds + T_V) + ((lane >> 4) & 1) * 32 + (lane & 3) * 8 + (4 * hi + ((lane & 15) >> 2)) * 64;
    bool resc = false;
    bf16x8 kf[2 * ND0];
    f32x16 pA0, pA1, pB0, pB1;
    int sl_prev = 0, sl_cur = 0, sl_next = 1;
#define TROT() do { sl_prev = sl_cur; sl_cur = sl_next; sl_next = (sl_next == T_NSLOT - 1) ? 0 : sl_next + 1; } while (0)
#define TBIAS(X0, X1, fs_) do { if (DECAY) { const float base_ = fq_l - mhat; const LAS f32x4* fk_ = (const LAS f32x4*)(lds + T_F + (fs_) * 256); \
        _Pragma("unroll") for (int g = 0; g < 4; ++g) { const f32x4 a_ = fk_[2 * g + hi], c_ = fk_[8 + 2 * g + hi]; \
            _Pragma("unroll") for (int q = 0; q < 4; ++q) { X0[4 * g + q] = base_ - a_[q]; X1[4 * g + q] = base_ - c_[q]; } } } \
        else if (INPL) { const float nm_ = -mhat; _Pragma("unroll") for (int r = 0; r < 16; ++r) { X0[r] = nm_; X1[r] = nm_; } } } while (0)
#define TCIN(X) (INPL ? X : negm)
#define TRESC() do { if (resc) { asm volatile("s_waitcnt lgkmcnt(0)" ::: "memory"); \
        _Pragma("unroll") for (int d_ = 0; d_ < 2; ++d_) _Pragma("unroll") for (int r = 0; r < 16; ++r) o[d_][r] *= wsf[crow(r, hi)]; } } while (0)
#define TDECIDE(C0, C1, i_) do { \
        float a_ = max3f(C0[0], C0[1], C1[0]), b_ = max3f(C0[2], C0[3], C1[1]); a_ = max3f(a_, C1[2], C1[3]); \
        _Pragma("unroll") for (int r = 4; r < 16; r += 4) { a_ = max3f(a_, C0[r], C0[r + 1]); b_ = max3f(b_, C0[r + 2], C0[r + 3]); a_ = max3f(a_, C1[r], C1[r + 1]); b_ = max3f(b_, C1[r + 2], C1[r + 3]); } \
        float rm_ = fmaxf(a_, b_); { auto rr_ = __builtin_amdgcn_permlane32_swap(__float_as_uint(rm_), __float_as_uint(rm_), false, false); rm_ = fmaxf(__uint_as_float(rr_[0]), __uint_as_float(rr_[1])); } \
        resc = false; \
        if ((i_) == i0) { const float dl_ = rm_; mhat += dl_; \
            _Pragma("unroll") for (int r = 0; r < 16; ++r) { C0[r] -= dl_; C1[r] -= dl_; } \
            if (!INPL) { _Pragma("unroll") for (int r = 0; r < 16; ++r) negm[r] = -mhat; asm volatile("" : "+v"(negm)); } } \
        else if (__builtin_expect(__any(rm_ > (float)THRL), 0)) { const float dl_ = fmaxf(rm_, 0.f); mhat += dl_; \
            _Pragma("unroll") for (int r = 0; r < 16; ++r) { C0[r] -= dl_; C1[r] -= dl_; } \
            if (!INPL) { _Pragma("unroll") for (int r = 0; r < 16; ++r) negm[r] = -mhat; asm volatile("" : "+v"(negm)); } \
            const float f_ = __builtin_amdgcn_exp2f(-dl_); l_reg *= f_; if (hi == 0) wsf[r32] = f_; resc = true; } } while (0)
    TDMA_K(2, 2);
    TW_BAR(5);
    int NT = NTS;
    if (DECAY) {
        const float bound = 2.f * __builtin_sqrtf(kmax2) * 1.0001f + 1.f + (Fh[q0] - ftile);
        const unsigned long long need = __ballot(lane < NTS && bound >= -160.f);
        const int tmin = need ? (int)__builtin_ctzll(need) : NTS - 1;
        NT = NTS - tmin; NT += NT & 1; if (NT < 8) NT = 8; if (NT > NTS) NT = NTS;
        NT = __builtin_amdgcn_readfirstlane(NT); }
    TBIAS(pA0, pA1, 0);
    { const lds_cptr kb = kp0;
#pragma unroll
      for (int d0 = 0; d0 < ND0; ++d0) { const bf16x8 b0 = *(const __attribute__((address_space(3))) bf16x8*)(kb + d0 * 2048), b1 = *(const __attribute__((address_space(3))) bf16x8*)(kb + d0 * 2048 + 512);
          if (d0 == 0) { pA0 = __builtin_amdgcn_mfma_f32_32x32x16_bf16(b0, qr[0], TCIN(pA0), 0, 0, 0); pA1 = __builtin_amdgcn_mfma_f32_32x32x16_bf16(b1, qr[0], TCIN(pA1), 0, 0, 0); }
          else { pA0 = __builtin_amdgcn_mfma_f32_32x32x16_bf16(b0, qr[d0], pA0, 0, 0, 0); pA1 = __builtin_amdgcn_mfma_f32_32x32x16_bf16(b1, qr[d0], pA1, 0, 0, 0); } } }
    cmask(pA0, pA1, 3, qrel, hi);
    TDECIDE(pA0, pA1, 0);
#pragma unroll
    for (int r = 0; r < 16; ++r) { pA0[r] = __builtin_amdgcn_exp2f(pA0[r]); pA1[r] = __builtin_amdgcn_exp2f(pA1[r]); }
    TW_BAR(0);
    TDMA_K(3, 0); TDMA_V(1, 1);
    TROT();
#pragma unroll
    for (int j = 0; j < ND0; ++j) kload2(kf, kp0 + sl_cur * T_KSLOT, j);
    TBIAS(pB0, pB1, sl_cur);
    TW_BAR(3);
    s16x4 vlo[8], vhi[8]; u32x4 pw0, pw1, pw2, pw3;
#define TPKW(P, B) cvt_pk_bf16(P[B], P[B + 1])
#define TPAF(k) __builtin_bit_cast(bf16x8, pw##k)
#define TVFR(i) (bf16x8){vlo[i][0], vlo[i][1], vlo[i][2], vlo[i][3], vhi[i][0], vhi[i][1], vhi[i][2], vhi[i][3]}
#define TPIN(x) asm volatile("" : "+v"(x))
#define TGAPA(MF, A0, A1, A2, A3, W0, W1, PW) do { MF; sacc += A0; sacc += A1; sacc += A2; sacc += A3; TPIN(sacc); W0; W1; TPIN(PW); TSB(); } while (0)
#define TEX(v) __builtin_amdgcn_exp2f(v)
#define TGAPB(MF, X, B) do { MF; X[B] = TEX(X[B]); X[B + 1] = TEX(X[B + 1]); X[B + 2] = TEX(X[B + 2]); X[B + 3] = TEX(X[B + 3]); TPIN(X); TSB(); } while (0)
#define TVRD(i) do { vlo[i] = vtr(vp_ + (((i) >> 2) * 4096 + ((i) & 3) * 1024)); vhi[i] = vtr(vp_ + (((i) >> 2) * 4096 + ((i) & 3) * 1024 + 512)); } while (0)
#define TKRD(G, j) do { if (G) { kload2(kf, kp0 + sl_next * T_KSLOT, j); TSB(); } } while (0)
#define TMF(a, b, c) __builtin_amdgcn_mfma_f32_32x32x16_bf16(a, b, c, 0, 0, 0)
#define TSTEP(C0, C1, P0, P1, i_, MJB, GK, GV, GL) do { TSB(); \
        const lds_cptr vp_ = vp0 + sl_prev * T_VSLOT; \
        TVRD(0); TSB(); float sacc = (P0[0] + P0[1]); \
        TGAPA(C0 = TMF(kf[0], qr[0], TCIN(C0)), P0[2], P0[3], P0[4], P0[5],     pw0[0] = TPKW(P0, 0), pw0[1] = TPKW(P0, 2), pw0); \
        TVRD(4); TSB(); TGAPA(C1 = TMF(kf[1], qr[0], TCIN(C1)), P0[6], P0[7], P0[8], P0[9],     pw0[2] = TPKW(P0, 4), pw0[3] = TPKW(P0, 6), pw0); \
        TVRD(1); TSB(); TGAPA(C0 = TMF(kf[2], qr[1], C0),   P0[10], P0[11], P0[12], P0[13], pw1[0] = TPKW(P0, 8), pw1[1] = TPKW(P0, 10), pw1); \
        TVRD(5); TSB(); TGAPA(C1 = TMF(kf[3], qr[1], C1),   P0[14], P0[15], P1[0], P1[1],   pw1[2] = TPKW(P0, 12), pw1[3] = TPKW(P0, 14), pw1); \
        TVRD(2); TSB(); TGAPA(C0 = TMF(kf[4], qr[2], C0),   P1[2], P1[3], P1[4], P1[5],     pw2[0] = TPKW(P1, 0), pw2[1] = TPKW(P1, 2), pw2); \
        TVRD(6); TSB(); TGAPA(C1 = TMF(kf[5], qr[2], C1),   P1[6], P1[7], P1[8], P1[9],     pw2[2] = TPKW(P1, 4), pw2[3] = TPKW(P1, 6), pw2); \
        TVRD(3); TSB(); TGAPA(C0 = TMF(kf[6], qr[3], C0),   P1[10], P1[11], P1[12], P1[13], pw3[0] = TPKW(P1, 8), pw3[1] = TPKW(P1, 10), pw3); \
        TVRD(7); TSB(); TGAPA(C1 = TMF(kf[7], qr[3], C1),   P1[14], P1[15], 0.f, 0.f,       pw3[2] = TPKW(P1, 12), pw3[3] = TPKW(P1, 14), pw3); \
        if (ND0 == 6) { C0 = TMF(kf[2 * ND0 - 4], qr[ND0 - 2], C0); C1 = TMF(kf[2 * ND0 - 3], qr[ND0 - 2], C1); C0 = TMF(kf[2 * ND0 - 2], qr[ND0 - 1], C0); C1 = TMF(kf[2 * ND0 - 1], qr[ND0 - 1], C1); TSB(); } \
        l_reg += sacc; \
        if (GK) { TDMA_K((i_) + 3, sl_cur); } if (GV) { TDMA_V((i_) + 1, sl_next); } \
        if ((MJB) >= 0) cmask(C0, C1, (MJB), qrel, hi); \
        TDECIDE(C0, C1, i_); \
        TSB(); \
        TGAPB(o[0] = TMF(TPAF(0), TVFR(0), o[0]), C0, 0); \
        TKRD(GL, 0); TGAPB(o[1] = TMF(TPAF(0), TVFR(4), o[1]), C0, 4); \
        TKRD(GL, 1); TGAPB(o[0] = TMF(TPAF(1), TVFR(1), o[0]), C0, 8); \
        TKRD(GL, 2); TGAPB(o[1] = TMF(TPAF(1), TVFR(5), o[1]), C0, 12); \
        TKRD(GL, 3); TGAPB(o[0] = TMF(TPAF(2), TVFR(2), o[0]), C1, 0); \
        if (ND0 == 6) { TKRD(GL, ND0 - 2); } TGAPB(o[1] = TMF(TPAF(2), TVFR(6), o[1]), C1, 4); \
        if (ND0 == 6) { TKRD(GL, ND0 - 1); } TGAPB(o[0] = TMF(TPAF(3), TVFR(3), o[0]), C1, 8); \
        TGAPB(o[1] = TMF(TPAF(3), TVFR(7), o[1]), C1, 12); \
        if (GL) { TBIAS(P0, P1, sl_next); } \
    } while (0)
#define TENDW(tt) do { if ((tt) + 3 < NT) { TW_BAR(3); } else if ((tt) + 2 < NT) { TW_BAR(1); } else { TW_BAR(0); } } while (0)
    TSTEP(pB0, pB1, pA0, pA1, 1, 2, (1 + 3 < NT), true, true); TENDW(1); TRESC(); TROT();
    TSTEP(pA0, pA1, pB0, pB1, 2, 1, (2 + 3 < NT), true, true); TENDW(2); TRESC(); TROT();
    {
        TSTEP(pB0, pB1, pA0, pA1, 3, 0, (3 + 3 < NT), true, true); TENDW(3); TRESC(); TROT();
        int i = 4;
        for (; i + 2 < NT; i += 2) {
            TSTEP(pA0, pA1, pB0, pB1, i, -1, (i + 3 < NT), true, true);                         TENDW(i);     TRESC(); TROT();
            TSTEP(pB0, pB1, pA0, pA1, i + 1, -1, (i + 4 < NT), (i + 2 < NT), (i + 2 < NT));     TENDW(i + 1); TRESC(); TROT();
        }
        TSTEP(pA0, pA1, pB0, pB1, NT - 2, -1, false, true, true); TENDW(NT - 2); TRESC(); TROT();
        TSTEP(pB0, pB1, pA0, pA1, NT - 1, -1, false, false, false); TRESC();
    }
    { float sacc = pB0[0] + pB0[1];
#pragma unroll
      for (int r = 2; r < 16; ++r) sacc += pB0[r];
#pragma unroll
      for (int r = 0; r < 16; ++r) sacc += pB1[r];
      l_reg += sacc;
      pw0 = (u32x4){TPKW(pB0, 0), TPKW(pB0, 2), TPKW(pB0, 4), TPKW(pB0, 6)}; pw1 = (u32x4){TPKW(pB0, 8), TPKW(pB0, 10), TPKW(pB0, 12), TPKW(pB0, 14)};
      pw2 = (u32x4){TPKW(pB1, 0), TPKW(pB1, 2), TPKW(pB1, 4), TPKW(pB1, 6)}; pw3 = (u32x4){TPKW(pB1, 8), TPKW(pB1, 10), TPKW(pB1, 12), TPKW(pB1, 14)};
      TSB(); pv(o, vb0 + sl_cur * T_VSLOT, TPAF(0), TPAF(1), TPAF(2), TPAF(3)); }
    { auto rr = __builtin_amdgcn_permlane32_swap(__float_as_uint(l_reg), __float_as_uint(l_reg), false, false); l_reg = __uint_as_float(rr[0]) + __uint_as_float(rr[1]); }
    if (hi == 0) wsf[32 + r32] = l_reg; asm volatile("s_waitcnt lgkmcnt(0)" ::: "memory");
    float rli[16];
#pragma unroll
    for (int r = 0; r < 16; ++r) rli[r] = __builtin_amdgcn_rcpf(wsf[32 + crow(r, hi)]);
    bf16* Ow = O + (rowbase + q0 + wid * 32) * OP + h * 64;
    { LAS bf16* stg = (LAS bf16*)(lds + T_OST) + wid * 2048;
#pragma unroll
      for (int r = 0; r < 16; ++r) { const int orow = crow(r, hi);
#pragma unroll
          for (int d0 = 0; d0 < 2; ++d0) stg[orow * 64 + d0 * 32 + r32] = (bf16)f2bf(o[d0][r] * rli[r]); }
      asm volatile("s_waitcnt lgkmcnt(0)" ::: "memory");
#pragma unroll
      for (int i = 0; i < 4; ++i) { const int row = i * 8 + (lane >> 3), ch = lane & 7; const u32x4 v = *(const LAS u32x4*)(stg + row * 64 + ch * 8); *(u32x4*)(Ow + (long)row * OP + ch * 8) = v; } }
    asm volatile("s_waitcnt lgkmcnt(0)\n\ts_barrier" ::: "memory");
#undef TDMA_K
#undef TDMA_V
#undef TROT
#undef TBIAS
#undef TCIN
#undef TRESC
#undef TDECIDE
#undef TPKW
#undef TPAF
#undef TVFR
#undef TPIN
#undef TGAPA
#undef TEX
#undef TGAPB
#undef TVRD
#undef TKRD
#undef TMF
#undef TSTEP
#undef TENDW
}
#undef TW_BAR
#undef TSB
}

namespace dn {
constexpr int CHB = 64 * 256 * 2;
__device__ __forceinline__ int nloc(int i) { return 16 * ((i >> 2) & 1) + (i & 3) + 4 * (i >> 3); }
template <bool NOTRAFFIC>
__device__ __forceinline__ void down_phase(LAS unsigned char* lds, const bf16* HBp, const bf16* Wd, const bf16* Wsd, volatile LAS int* tab, const u32x2* meta, unsigned char* Yp, unsigned char* trash, int G, int c) {
    int tid = threadIdx.x; asm volatile("" : "+v"(tid));
    const int wid = __builtin_amdgcn_readfirstlane(tid >> 6), lane = tid & 63, j = lane & 31, hi = lane >> 5;
    const int U = tab[65] * 8;
    const int u_lo = (int)(((long)c * U) / G), u_hi = (int)(((long)(c + 1) * U) / G);
    if (u_lo >= u_hi) return;
#define DN_DEC(u_, e_, hf_, ci_) do { e_ = __builtin_amdgcn_readfirstlane(tab[132 + ((u_) >> 3)]); const int ul_ = __builtin_amdgcn_readfirstlane((u_) - 8 * tab[e_]), nc_ = __builtin_amdgcn_readfirstlane(4 * (tab[e_ + 1] - tab[e_])); hf_ = (ul_ >= nc_) ? 1 : 0; ci_ = ul_ - hf_ * nc_; } while (0)
    unsigned dvo;
    { const int r_ = lane >> 3; dvo = (unsigned)(r_ * DEXP + (((lane & 7) ^ ((r_ >> 1) & 7)) * 8)) * 2u; }
#define DN_DMA(u_, buf_) do { int e__, hf__, ci__; DN_DEC(u_, e__, hf__, ci__); (void)hf__; const bf16* gb_ = HBp + ((size_t)tab[e__] * 256 + (size_t)ci__ * 64) * DEXP; \
        _Pragma("unroll") for (int i_ = 0; i_ < 4; ++i_) { const int q_ = wid * 4 + i_, kb_ = q_ >> 3, g_ = q_ & 7; \
            __builtin_amdgcn_global_load_lds((const unsigned*)((const char*)(gb_ + (size_t)(8 * g_) * DEXP + kb_ * 64) + ((g_ & 1) ? (dvo ^ 64u) : dvo)), (LAS unsigned*)(lds + (buf_) * CHB + kb_ * 8192 + g_ * 1024), 16, 0, 0); } } while (0)
    int rowb[2], fx[2];
#pragma unroll
    for (int rt = 0; rt < 2; ++rt) { const int row = 32 * rt + j, f = (row >> 1) & 7;
        rowb[rt] = (int)(uintptr_t)lds + row * 128 + ((hi ^ (f & 1)) * 16); fx[rt] = (f & 6) * 16; }
    DN_DMA(u_lo, 0); if (u_lo + 1 < u_hi) DN_DMA(u_lo + 1, 1); else DN_DMA(u_lo, 1); if (u_lo + 2 < u_hi) DN_DMA(u_lo + 2, 2); else DN_DMA(u_lo, 2);
    int u = u_lo;
    while (u < u_hi) {
      int e, hf, ci0; DN_DEC(u, e, hf, ci0);
      const int nc = __builtin_amdgcn_readfirstlane(4 * (tab[e + 1] - tab[e])), ne = __builtin_amdgcn_readfirstlane(tab[66 + e]);
      int seg_end = 8 * tab[e] + (hf + 1) * nc; seg_end = __builtin_amdgcn_readfirstlane(seg_end < u_hi ? seg_end : u_hi);
      bf16x8 wfr[2][16];
#pragma unroll
      for (int nt = 0; nt < 2; ++nt) { const bf16* wp = ((e == NEXP) ? Wsd : Wd + (size_t)e * D * DEXP) + (size_t)(512 * hf + 64 * wid + 32 * nt + nloc(j)) * DEXP + 8 * hi;
#pragma unroll
          for (int ks = 0; ks < 16; ++ks) wfr[nt][ks] = *(const bf16x8*)(wp + 16 * ks); }
      bool first = true;
      for (; u < seg_end; ++u) {
        const int buf = (u - u_lo) & 3; (void)ci0;
        const int cidx = __builtin_amdgcn_readfirstlane((u - 8 * tab[e]) - hf * nc);
        u32x2 mt[2];
#pragma unroll
        for (int rt = 0; rt < 2; ++rt) { int pos = 64 * cidx + 32 * rt + j; const bool in = pos < ne; const int sp = pos; pos = (in && e != NEXP) ? pos : 0; const u32x2 m = meta[(size_t)(e == NEXP ? 0 : e) * LISTCAP + pos];
            mt[rt] = !in ? (u32x2){0xffffffffu, 0u} : (e == NEXP) ? (u32x2){(unsigned)(sp * (TOPK + 1) + TOPK), 0x3f800000u} : m; }
        if (first) { __builtin_amdgcn_s_waitcnt(0x0F70); first = false; }
        else { asm volatile("s_waitcnt vmcnt(26)" ::: "memory"); }
        LDS_WAIT(); __builtin_amdgcn_s_barrier();
        { const int un = (u + 3 < u_hi) ? u + 3 : u; DN_DMA(un, (buf + 3) & 3); }
        f32x16 acc[2][2];
#pragma unroll
        for (int rt = 0; rt < 2; ++rt)
#pragma unroll
            for (int nt = 0; nt < 2; ++nt) acc[rt][nt] = f32x16{};
#define DN_RD(dst, ks_) do { _Pragma("unroll") for (int rt = 0; rt < 2; ++rt) \
            asm volatile("ds_read_b128 %0, %1 offset:%c2" : "=&v"(dst[rt]) : "v"(rowb[rt] + ((32 * ((ks_) & 3)) ^ fx[rt]) + buf * CHB), "i"(((ks_) >> 2) * 8192) : "memory"); } while (0)
#define DN_WAIT(n_, x_) asm volatile("s_waitcnt lgkmcnt(" #n_ ")" : "+v"(x_[0]), "+v"(x_[1]) :: "memory")
        bf16x8 hfa[2], hfb[2];
        DN_RD(hfa, 0);
#pragma unroll
        for (int ks = 0; ks < 16; ks += 2) {
            DN_RD(hfb, ks + 1);
            DN_WAIT(2, hfa);
#pragma unroll
            for (int rt = 0; rt < 2; ++rt)
#pragma unroll
                for (int nt = 0; nt < 2; ++nt) acc[rt][nt] = __builtin_amdgcn_mfma_f32_32x32x16_bf16(wfr[nt][ks], hfa[rt], acc[rt][nt], 0, 0, 0);
            __builtin_amdgcn_sched_barrier(0);
            if (ks + 2 < 16) { DN_RD(hfa, ks + 2); DN_WAIT(2, hfb); } else { DN_WAIT(0, hfb); }
#pragma unroll
            for (int rt = 0; rt < 2; ++rt)
#pragma unroll
                for (int nt = 0; nt < 2; ++nt) acc[rt][nt] = __builtin_amdgcn_mfma_f32_32x32x16_bf16(wfr[nt][ks + 1], hfb[rt], acc[rt][nt], 0, 0, 0);
            __builtin_amdgcn_sched_barrier(0);
        }
#undef DN_RD
#undef DN_WAIT
        const int col0 = 512 * hf + 64 * wid + 16 * hi;
#pragma unroll
        for (int rt = 0; rt < 2; ++rt) { const bool ok = !NOTRAFFIC && mt[rt].x != 0xffffffffu; unsigned char* yd = ok ? Yp + (size_t)mt[rt].x * D : trash; const float w = ok ? __uint_as_float(mt[rt].y) : 0.f;
#pragma unroll
            for (int nt = 0; nt < 2; ++nt) { u32x4 o;
#pragma unroll
                for (int q = 0; q < 4; ++q) { int v = __builtin_amdgcn_cvt_pk_fp8_f32(acc[rt][nt][4 * q] * w, acc[rt][nt][4 * q + 1] * w, 0, false);
                    v = __builtin_amdgcn_cvt_pk_fp8_f32(acc[rt][nt][4 * q + 2] * w, acc[rt][nt][4 * q + 3] * w, v, true); o[q] = (unsigned)v; }
                *(u32x4*)(yd + col0 + 32 * nt) = o; } }
      }
    }
    VM_WAIT(); LDS_WAIT(); __builtin_amdgcn_s_barrier();
#undef DN_DMA
#undef DN_DEC
}
}

#define XB_TMO      128
#define XB_XCNT(j)  (256  + 64 * (j))
#define XB_XSUB(j)  (1280 + 64 * (j))
#define XB_XGEN(j)  (2304 + 64 * (j))
#define XB_TOP      3328
#define XB_TOPGEN   3392
#define XCD_BAR_WORDS 3456
#define XB_SPIN_CAP (1u << 18)
__device__ __forceinline__ unsigned xb_ld(unsigned* p)              { return __hip_atomic_load(p, __ATOMIC_RELAXED, __HIP_MEMORY_SCOPE_AGENT); }
__device__ __forceinline__ unsigned xb_add(unsigned* p, unsigned v) { return __hip_atomic_fetch_add(p, v, __ATOMIC_RELAXED, __HIP_MEMORY_SCOPE_AGENT); }
__device__ __forceinline__ unsigned xb_xcc_id() { return (unsigned)__builtin_amdgcn_s_getreg((3 << 11) | 20) & 0xFu; }
#define XB_SPIN(cond, bar) do { unsigned _sp = 0; while (cond) { __builtin_amdgcn_s_sleep(1); \
    if ((++_sp & 255u) == 0u) { if (xb_ld(&(bar)[XB_TMO])) break; if (_sp > XB_SPIN_CAP) { atomicAdd(&(bar)[XB_TMO], 1u); break; } } } } while (0)
struct XcdBarrier { unsigned* bar; unsigned x; volatile LAS unsigned* st; };
__device__ __forceinline__ XcdBarrier xcd_barrier_post(unsigned* bar, volatile LAS unsigned* st) {
    XcdBarrier b; b.bar = bar; b.x = xb_xcc_id(); b.st = st;
    if (threadIdx.x == 0) (void)xb_add(&bar[XB_XCNT(b.x)], 1u);
    return b;
}
__device__ __forceinline__ void xcd_barrier_complete(unsigned* bar, unsigned x, unsigned& nloc, unsigned& nx) {
    const unsigned G = gridDim.x * gridDim.y * gridDim.z;
    unsigned sum, cnt, mine, sp = 0u;
    for (;;) {
        sum = 0u; cnt = 0u; mine = 0u;
#pragma unroll
        for (unsigned j = 0; j < 16; ++j) { const unsigned c = xb_ld(&bar[XB_XCNT(j)]); sum += c; cnt += (c > 0u) ? 1u : 0u; mine = (j == x) ? c : mine; }
        if (sum == G) break;
        __builtin_amdgcn_s_sleep(1);
        if ((++sp & 255u) == 0u) { if (xb_ld(&bar[XB_TMO])) break; if (sp > XB_SPIN_CAP) { atomicAdd(&bar[XB_TMO], 1u); break; } }
    }
    nloc = mine > 0u ? mine : 1u; nx = cnt > 0u ? cnt : 1u;
}
__device__ __forceinline__ void xcd_barrier(const XcdBarrier& b) {
    asm volatile("s_waitcnt vmcnt(0)" ::: "memory");
    __syncthreads();
    if (threadIdx.x == 0) {
        unsigned* bar = b.bar;
        __builtin_amdgcn_s_waitcnt(0);
        unsigned nloc = b.st[0], nx = b.st[1];
        if (nloc == 0u) { xcd_barrier_complete(bar, b.x, nloc, nx); b.st[0] = nloc; b.st[1] = nx; }
        const unsigned old = xb_add(&bar[XB_XSUB(b.x)], 1u);
        const unsigned gen = old / nloc;
        if (old + 1u == (gen + 1u) * nloc) {
            __builtin_amdgcn_fence(__ATOMIC_RELEASE, "agent");
            asm volatile("s_waitcnt vmcnt(0)" ::: "memory");
            const unsigned og = xb_add(&bar[XB_TOP], 1u);
            const unsigned tg = og / nx;
            if (og + 1u == (tg + 1u) * nx) xb_add(&bar[XB_TOPGEN], 1u);
            else XB_SPIN(xb_ld(&bar[XB_TOPGEN]) == tg, bar);
            __builtin_amdgcn_fence(__ATOMIC_ACQUIRE, "agent");
            xb_add(&bar[XB_XGEN(b.x)], 1u);
            asm volatile("s_waitcnt vmcnt(0)" ::: "memory");
        } else {
            XB_SPIN(xb_ld(&bar[XB_XGEN(b.x)]) == gen, bar);
            __builtin_amdgcn_fence(__ATOMIC_ACQUIRE, "agent");
            asm volatile("s_waitcnt vmcnt(0)" ::: "memory");
        }
    }
    __syncthreads();
}

struct Args { const void* in[25]; float* out; unsigned char* ws; int ph_lo, ph_hi; };

struct Frame {
    LAS unsigned char* lds;
    int tid, lane, wave, vcu, G;
};

template <class ColFn>
__device__ __forceinline__ void cvt_item(int ldw, int Ksrc, const float* kscale, bf16* WT, int Kd, LAS float* scr, int kb, int nb, int lane, ColFn colp) {
    const int k0 = 64 * kb, n0 = 32 * nb;
    const float* cp = colp(n0 + (lane & 31));
    float vv[32], sv[32];
#pragma unroll
    for (int i = 0; i < 32; ++i) { const int k = k0 + 2 * i + (lane >> 5);
        vv[i] = (cp != nullptr && k < Ksrc) ? cp[(size_t)k * ldw] : 0.f;
        sv[i] = (kscale != nullptr && k < Ksrc) ? kscale[k] : 1.f; }
#pragma unroll
    for (int i = 0; i < 32; ++i) scr[(2 * i + (lane >> 5)) * 33 + (lane & 31)] = vv[i] * sv[i];
    LDS_WAIT(); asm volatile("" ::: "memory");
    const int c = lane & 7;
#pragma unroll
    for (int j = 0; j < 4; ++j) { const int n = (lane >> 3) + 8 * j; const LAS float* s = scr + (8 * c) * 33 + n;
        u32x4 o; o.x = pk2(s[0 * 33], s[1 * 33]); o.y = pk2(s[2 * 33], s[3 * 33]); o.z = pk2(s[4 * 33], s[5 * 33]); o.w = pk2(s[6 * 33], s[7 * 33]);
        *(u32x4*)(WT + (size_t)(n0 + n) * Kd + k0 + 8 * c) = o; }
    LDS_WAIT(); asm volatile("" ::: "memory");
}
__device__ __forceinline__ void cvt64_item(const float* src, int ldw, bf16* dst, int Kd, LAS unsigned char* scr, int lane) {
    f32x4 v[16];
    const float* sp = src + (size_t)(lane >> 4) * ldw + 4 * (lane & 15);
#pragma unroll
    for (int i = 0; i < 16; ++i) v[i] = __builtin_nontemporal_load((const f32x4*)(sp + (size_t)(4 * i) * ldw));
#pragma unroll
    for (int i = 0; i < 16; ++i) { const int k = 4 * i + (lane >> 4);
#pragma unroll
        for (int q = 0; q < 4; q += 2) { const unsigned pk = cvt_pk_bf16(v[i][q], v[i][q + 1]);
#pragma unroll
            for (int h2 = 0; h2 < 2; ++h2) { const int n = 4 * (lane & 15) + q + h2; *(LAS bf16*)(scr + n * 128 + (((k >> 3) ^ ((n >> 2) & 7)) << 4) + (k & 7) * 2) = (bf16)(h2 ? (pk >> 16) : (pk & 0xffffu)); } } }
    LDS_WAIT(); asm volatile("" ::: "memory");
#pragma unroll
    for (int j = 0; j < 8; ++j) { const int p = j * 64 + lane, n = p >> 3, c = p & 7;
        const u32x4 o = *(const LAS u32x4*)(scr + n * 128 + ((c ^ ((n >> 2) & 7)) << 4));
        __builtin_nontemporal_store(o, (u32x4*)(dst + (size_t)n * Kd + c * 8)); }
    LDS_WAIT(); asm volatile("" ::: "memory");
}
__device__ __forceinline__ int ropedim(int jj) { const int g = jj >> 3, u = jj & 7; return (u < 4) ? 4 * g + u : 16 + 4 * g + (u - 4); }

__device__ __forceinline__ void sincos_acc(float af, float& sn, float& cs) {
    const double a = (double)af; const double kq = __builtin_rint(a * 0.63661977236758134308);
    const double r = (a - kq * 1.57079632679489655800) - kq * 6.123233995736766036e-17;
    const double r2 = r * r;
    const double sp = r * (1.0 + r2 * (-1.66666666666666324348e-01 + r2 * (8.33333333332248946124e-03 + r2 * (-1.98412698298579493134e-04 + r2 * (2.75573137070700676789e-06 + r2 * (-2.50507602534068634195e-08 + r2 * 1.58969099521155010221e-10))))));
    const double cp = 1.0 + r2 * (-0.5 + r2 * (4.16666666666666019037e-02 + r2 * (-1.38888888888741095749e-03 + r2 * (2.48015872894767294178e-05 + r2 * (-2.75573143513906633035e-07 + r2 * (2.08757232129817482790e-09 + r2 * -1.13596475577881948265e-11))))));
    const int q = (int)((long long)kq & 3);
    const double s_ = (q == 0) ? sp : (q == 1) ? cp : (q == 2) ? -sp : -cp;
    const double c_ = (q == 0) ? cp : (q == 1) ? -sp : (q == 2) ? -cp : sp;
    sn = (float)s_; cs = (float)c_;
}

__global__ void __launch_bounds__(NWAVES * 64, 2) fwd(Args args) {
    extern __shared__ __attribute__((aligned(16))) unsigned char lds_raw[];
    Frame F;
    F.lds = (LAS unsigned char*)lds_raw;
    F.tid = threadIdx.x; F.lane = F.tid & 63; F.wave = __builtin_amdgcn_readfirstlane(F.tid >> 6);
    F.G = gridDim.x; { const int bx = blockIdx.x; F.vcu = (F.G % 8 == 0) ? (bx % 8) * (F.G / 8) + bx / 8 : bx; }
    volatile LAS unsigned* MISC = (volatile LAS unsigned*)(F.lds + MISC_OFF);
    unsigned char* ws = args.ws;
    gu32* ctl = (gu32*)(ws + WS_CTL);
#define X_IN ((const float*)AP->in[0])
#define cvec ((const float*)AP->in[1])
#define positions ((const int*)AP->in[2])
#define w_mod ((const float*)AP->in[3])
#define b_mod ((const float*)AP->in[4])
#define g_mix ((const float*)AP->in[5])
#define w_in ((const float*)AP->in[6])
#define b_forget ((const float*)AP->in[7])
#define g_q_lat ((const float*)AP->in[8])
#define w_q_up ((const float*)AP->in[9])
#define g_kv_lat ((const float*)AP->in[10])
#define w_kv_up ((const float*)AP->in[11])
#define w_o_mla ((const float*)AP->in[12])
#define w_o_fox ((const float*)AP->in[13])
#define w_out ((const float*)AP->in[14])
#define g_ffn ((const float*)AP->in[15])
#define w_router ((const float*)AP->in[16])
#define b_router ((const float*)AP->in[17])
#define w_exp_gate ((const float*)AP->in[18])
#define w_exp_up ((const float*)AP->in[19])
#define w_exp_down ((const float*)AP->in[20])
#define w_sh_gate ((const float*)AP->in[21])
#define w_sh_up ((const float*)AP->in[22])
#define w_sh_down ((const float*)AP->in[23])
#define g_final ((const float*)AP->in[24])
#define Win_t ((bf16*)(ws + WS_WIN))
#define Wq_t ((bf16*)(ws + WS_WQ))
#define Wkv_t ((bf16*)(ws + WS_WKV))
#define Wom_t ((bf16*)(ws + WS_WOM))
#define Wof_t ((bf16*)(ws + WS_WOF))
#define Wout_t ((bf16*)(ws + WS_WOUT))
#define Wsgu_t ((bf16*)(ws + WS_WSGU))
#define Wsd_t ((bf16*)(ws + WS_WSD))
#define Wr_f ((bf16*)(ws + WS_WR))
#define mod ((float*)(ws + WS_MOD))
#define Wd_t ((bf16*)(ws + WS_WD))
#define Wgu_t ((bf16*)(ws + WS_WGU))
#define HB ((bf16*)(ws + WS_HB))
#define FQ ((bf16*)(ws + WS_FQ))
#define FK ((bf16*)(ws + WS_FK))
#define FV ((bf16*)(ws + WS_FV))
#define QLAT ((bf16*)(ws + WS_QLAT))
#define KVLAT ((bf16*)(ws + WS_KVLAT))
#define OFOX ((bf16*)(ws + WS_OFOX))
#define OCAT ((bf16*)((unsigned char*)out + 32 * MiB))
#define OMLA ((bf16*)(ws + WS_OMLA))
#define Y ((bf16*)(ws + WS_Y))
#define H ((bf16*)(ws + WS_H))
#define QMLA ((bf16*)(ws + WS_QMLA))
#define GATES ((bf16*)(ws + WS_GATES))
#define KN ((bf16*)(ws + WS_KN))
#define VM ((bf16*)(ws + WS_VM))
#define KPE ((bf16*)(ws + WS_KPE))
#define MERGED ((bf16*)(ws + WS_MERGED))
#define LIST ((unsigned short*)(ws + WS_LIST))
#define META ((u32x2*)(ws + WS_WIN))
#define EIDX ((unsigned char*)(ws + WS_EIDX))
#define GATEW ((float*)(ws + WS_GATEW))
#define ROPETAB ((float*)((unsigned char*)out + DO_ROPE))
#define LOGF ((float*)((unsigned char*)out + DO_LOGF))
#define CUMF ((float*)((unsigned char*)out + DO_CUMF))
#define SSQQ ((float*)((unsigned char*)out + DO_SSQQ))
#define SSQKV ((float*)((unsigned char*)out + DO_SSQKV))
#define MODP ((float*)((unsigned char*)out + DO_MODP))
#define SSQ1 ((float*)(ws + WS_FQ))
    float* const out = args.out;
#define PHASE_ENV const __attribute__((address_space(4))) Args* AP; { auto kp_ = __builtin_amdgcn_kernarg_segment_ptr(); asm volatile("" : "+s"(kp_)); AP = (const __attribute__((address_space(4))) Args*)kp_; } \
    unsigned char* const ws = AP->ws; float* const out = AP->out; (void)ws; (void)out;
    for (int u = F.tid; u < (LDS_BYTES - LDSCTL_OFF) / 4; u += NWAVES * 64) ((LAS unsigned*)(F.lds + LDSCTL_OFF))[u] = 0u;
    __syncthreads();
    XcdBarrier bar; bar.bar = (unsigned*)(ctl + CW_BAR); bar.x = 0; bar.st = nullptr;
    if (MK_ONE_LAUNCH) bar = xcd_barrier_post((unsigned*)(ctl + CW_BAR), MISC + 8);
    const int lo = args.ph_lo, hi = args.ph_hi;
#define IN(k) (lo <= (k) && (k) < hi)
#define BOTH(k) (IN(k) && IN((k) + 1))
#define GRID_BAR() do { if (MK_ONE_LAUNCH) xcd_barrier(bar); } while (0)
#define DUP_BAR() do { if (dummy) xcd_barrier(bar); } while (0)
    const int gw = F.vcu * NWAVES + F.wave, NGW = F.G * NWAVES;

    for (int rep = 0; rep < ((PROBE_DUP == 0) ? 2 : 1); ++rep) if (IN(0)) { PHASE_ENV const bool dummy = (PROBE_DUP == 0) && rep == 0; (void)dummy;
        if (!(dummy && (PROBE_VAR == 1 || PROBE_VAR == 4 || PROBE_VAR == 5))) {
            LAS float* cond = (LAS float*)F.lds;
            for (int i = F.tid; i < NB * D; i += NWAVES * 64) { const float c = cvec[i]; cond[i] = c / (1.f + __expf(-c)); }
            __syncthreads();
            for (int it = F.wave * F.G + F.vcu; it < 96 * 16; it += NWAVES * F.G) { const int cg = it % 96, kq = it / 96, col = cg * 64 + F.lane;
                float a4[4] = {0.f, 0.f, 0.f, 0.f};
                const float* wp = w_mod + (size_t)(64 * kq) * (6 * D) + col;
                float wv[64];
#pragma unroll
                for (int kk = 0; kk < 64; ++kk) wv[kk] = __builtin_nontemporal_load(wp + (size_t)kk * (6 * D));
#pragma unroll
                for (int kk = 0; kk < 64; ++kk) {
#pragma unroll
                    for (int b = 0; b < 4; ++b) a4[b] += wv[kk] * cond[b * D + 64 * kq + kk]; }
#pragma unroll
                for (int b = 0; b < 4; ++b) MODP[((size_t)kq * 4 + b) * (6 * D) + col] = a4[b]; }
            __syncthreads();
        }
        if (!(dummy && (PROBE_VAR == 1 || PROBE_VAR == 3 || PROBE_VAR == 5))) for (int i = gw * 64 + F.lane; i < T * 16; i += NGW * 64) { const int t = i >> 4, j = i & 15;
            const float invf = (((j >> 2) == 0) ? 1.f : ((j >> 2) == 1) ? 0.1f : ((j >> 2) == 2) ? 0.01f : 0.001f) * (((j & 3) == 0) ? 1.f : ((j & 3) == 1) ? 0.5623413251903491f : ((j & 3) == 2) ? 0.31622776601683794f : 0.17782794100389228f);
            const float ang = (float)positions[t] * invf; float sn, cs; sincos_acc(ang, sn, cs);
            *(f32x2*)(ROPETAB + (size_t)i * 2) = (f32x2){cs, sn}; }
        for (int o = gw * 64 + F.lane; o < NEXP * D; o += NGW * 64) { const int piece = o >> 3, kk = o & 7, ln = piece & 63, grp = piece >> 6, ntl = grp & 3, j = grp >> 2;
            const int n = ntl * 16 + (ln & 15), k = j * 32 + (ln >> 4) * 8 + kk; Wr_f[o] = (bf16)f2bf(w_router[(size_t)k * NEXP + n]); }
        {
            LAS unsigned char* scr8 = F.lds + 32768 + F.wave * 9216;
            constexpr int F_IN = 62 * 16, F_O = 16 * 8, F_OUT = 16 * 16, F_SGU = 8 * 16, F_SD = 16 * 4, F_EGU = NEXP * F_SGU, F_ED = NEXP * F_SD;
            constexpr int NFAST = F_IN + 2 * F_O + F_OUT + F_SGU + F_SD + F_EGU + F_ED;
            if (!(dummy && PROBE_VAR >= 2)) for (int it = gw; it < NFAST; it += NGW) {
                int r = it;
                if (r < F_EGU) { const int e = r / F_SGU, rr = r % F_SGU, nb = rr & 7, kb = rr >> 3, pn = nb >> 2, c0 = (nb & 3) * 64;
                    const float* wsrc = (c0 < 128) ? w_exp_gate + (size_t)e * D * DEXP + pn * 128 + c0 : w_exp_up + (size_t)e * D * DEXP + pn * 128 + (c0 - 128);
                    cvt64_item(wsrc + (size_t)(64 * kb) * DEXP, DEXP, Wgu_t + (size_t)e * 512 * D + (size_t)(64 * nb) * D + 64 * kb, D, scr8, F.lane); continue; } r -= F_EGU;
                if (r < F_ED) { const int e = r / F_SD, rr = r % F_SD, nb = rr & 15, kb = rr >> 4;
                    cvt64_item(w_exp_down + (size_t)e * DEXP * D + (size_t)(64 * kb) * D + 64 * nb, D, Wd_t + (size_t)e * D * DEXP + (size_t)(64 * nb) * DEXP + 64 * kb, DEXP, scr8, F.lane); continue; } r -= F_ED;
                if (r < F_IN) { int nb = r % 62; const int kb = r / 62; if (nb >= 6) nb += 2; const int n0 = 64 * nb;
                    const int src = (n0 < 384) ? n0 : (n0 < 2048) ? 416 + (n0 - 512) : 1960 + (n0 - 2048);
                    cvt64_item(w_in + (size_t)(64 * kb) * 4008 + src, 4008, Win_t + (size_t)n0 * D + 64 * kb, D, scr8, F.lane); continue; } r -= F_IN;
                if (r < F_O) { const int nb = r & 15, kb = r >> 4; cvt64_item(w_o_mla + (size_t)(64 * kb) * D + 64 * nb, D, Wom_t + (size_t)(64 * nb) * D + 64 * kb, D, scr8, F.lane); continue; } r -= F_O;
                if (r < F_O) { const int nb = r & 15, kb = r >> 4; cvt64_item(w_o_fox + (size_t)(64 * kb) * D + 64 * nb, D, Wom_t + (size_t)(64 * nb) * D + 512 + 64 * kb, D, scr8, F.lane); continue; } r -= F_O;
                if (r < F_OUT) { const int nb = r & 15, kb = r >> 4; cvt64_item(w_out + (size_t)(64 * kb) * D + 64 * nb, D, Wout_t + (size_t)(64 * nb) * D + 64 * kb, D, scr8, F.lane); continue; } r -= F_OUT;
                if (r < F_SGU) { const int nb = r >> 4, kb = r & 15, pn = nb >> 2, c0 = (nb & 3) * 64;
                    const float* wsrc = (c0 < 128) ? w_sh_gate + pn * 128 + c0 : w_sh_up + pn * 128 + (c0 - 128);
                    cvt64_item(wsrc + (size_t)(64 * kb) * DEXP, DEXP, Wsgu_t + (size_t)(64 * nb) * D + 64 * kb, D, scr8, F.lane); continue; } r -= F_SGU;
                { const int nb = r >> 2, kb = r & 3; cvt64_item(w_sh_down + (size_t)(64 * kb) * D + 64 * nb, D, Wsd_t + (size_t)(64 * nb) * DEXP + 64 * kb, DEXP, scr8, F.lane); }
            }
            LAS float* scr = (LAS float*)(F.lds + 32768 + F.wave * 9216);
            constexpr int I_INS = 4 * (D / 64), I_Q = (768 / 32) * (QLORA / 64), I_KV = (1024 / 32) * (KVPAD / 64), NSLOW = I_INS + I_Q + I_KV;
            if (!(dummy && (PROBE_VAR == 1 || PROBE_VAR == 3 || PROBE_VAR == 4))) for (int it = F.wave * F.G + F.vcu; it < NSLOW; it += NGW) {
                int r = it;
                if (r < I_INS) { const int nb = 12 + (r & 3), kb = r >> 2;
                    cvt_item(4008, D, nullptr, Win_t, D, scr, kb, nb, F.lane, [&](int n) -> const float* {
                        int src; if (n < 416) src = 384 + ropedim(n - 384); else if (n < 424) src = 1952 + (n - 416); else src = -1;
                        return src < 0 ? nullptr : w_in + src; }); continue; } r -= I_INS;
                if (r < I_Q) { const int nblk = 768 / 32;
                    cvt_item(768, QLORA, g_q_lat, Wq_t, QLORA, scr, r / nblk, r % nblk, F.lane, [&](int n) -> const float* {
                        const int hh = n / MQK, j = n % MQK; return w_q_up + hh * MQK + (j < 64 ? j : 64 + ropedim(j - 64)); }); continue; } r -= I_Q;
                { const int nblk = 1024 / 32;
                    cvt_item(1024, KVLORA, g_kv_lat, Wkv_t, KVPAD, scr, r / nblk, r % nblk, F.lane, [&](int n) -> const float* {
                        return (n < 512) ? w_kv_up + (n >> 6) * 128 + (n & 63) : w_kv_up + ((n - 512) >> 6) * 128 + 64 + (n & 63); }); }
            }
        }
        if (BOTH(0)) GRID_BAR();
    }

    for (int rep = 0; rep < ((PROBE_DUP == 1) ? 2 : 1); ++rep) if (IN(1)) { PHASE_ENV const bool dummy = (PROBE_DUP == 1) && rep == 0; (void)dummy;
        if (F.vcu < 48) { const int idx = F.vcu * 512 + F.tid, b = idx / (6 * D), col = idx % (6 * D); float sm = b_mod[col];
#pragma unroll
            for (int p = 0; p < 16; ++p) sm += MODP[((size_t)p * 4 + b) * (6 * D) + col];
            mod[idx] = sm; }
        LAS float* vg1 = (LAS float*)F.lds; LAS float* vs1 = (LAS float*)(F.lds + 4096);
        for (int grp = F.vcu; grp < T / 64; grp += F.G) {
            const int b = (grp * 64) / SEQ;
            __syncthreads();
            for (int k = F.tid; k < D; k += NWAVES * 64) { float s0 = b_mod[k], s1 = b_mod[D + k];
#pragma unroll
                for (int p = 0; p < 16; ++p) { s0 += MODP[((size_t)p * 4 + b) * (6 * D) + k]; s1 += MODP[((size_t)p * 4 + b) * (6 * D) + D + k]; }
                vs1[k] = s0; vg1[k] = g_mix[k] * (1.f + s1); }
            __syncthreads();
#pragma unroll 2
            for (int rr = 0; rr < 8; ++rr) { const int m = grp * 64 + F.wave * 8 + rr;
                const f32x4* xr = (const f32x4*)(X_IN + (size_t)m * D) + F.lane;
                f32x4 v[4]; float s = 0.f;
#pragma unroll
                for (int j = 0; j < 4; ++j) { v[j] = __builtin_nontemporal_load(xr + 64 * j); s += (v[j].x * v[j].x + v[j].y * v[j].y) + (v[j].z * v[j].z + v[j].w * v[j].w); }
                const float rstd = rsqrtf(wave_sum(s) * (1.f / D) + EPS);
                unsigned long long* o8 = (unsigned long long*)(H + (size_t)m * D) + F.lane;
#pragma unroll
                for (int j = 0; j < 4; ++j) { const int c = 4 * F.lane + 256 * j;
                    const f32x4 g = *(const LAS f32x4*)(vg1 + c), d = *(const LAS f32x4*)(vs1 + c);
                    const f32x4 r = v[j] * rstd * g + d;
                    o8[64 * j] = (unsigned long long)pk2(r.x, r.y) | ((unsigned long long)pk2(r.z, r.w) << 32); } }
        }
        if (BOTH(1)) GRID_BAR();
    }

    for (int rep = 0; rep < ((PROBE_DUP == 2) ? 2 : 1); ++rep) if (IN(2)) { PHASE_ENV const bool dummy = (PROBE_DUP == 2) && rep == 0; (void)dummy;
        pg8::StaticOrder S; S.init(H, Win_t, T, NIN, D, F.G, (int)blockIdx.x);
        EpiInProj E{QLAT, KVLAT, KPE, FQ, GATES, LOGF, SSQQ, SSQKV, ROPETAB, b_forget};
        pg8::gemm_phase<EpiInProj, pg8::StaticOrder, true>(F.lds, S, E);
        if (BOTH(2)) GRID_BAR();
    }

    for (int rep = 0; rep < ((PROBE_DUP == 3) ? 2 : 1); ++rep) if (IN(3)) { PHASE_ENV const bool dummy = (PROBE_DUP == 3) && rep == 0; (void)dummy;
        {
            const int bb = F.vcu & 3; float mx = 0.f, mq = 0.f;
            for (int r = (F.vcu >> 2) * NWAVES + F.wave; r < SEQ; r += (F.G >> 2) * NWAVES) { f32x4 k0, k1, q0v, q1v; unpack8(*(const u32x4*)(FK + ((size_t)bb * SEQ + r) * 512 + 8 * F.lane), k0, k1);
                unpack8(*(const u32x4*)(FQ + ((size_t)bb * SEQ + r) * 512 + 8 * F.lane), q0v, q1v);
                float sq = (k0[0] * k0[0] + k0[1] * k0[1]) + (k0[2] * k0[2] + k0[3] * k0[3]) + (k1[0] * k1[0] + k1[1] * k1[1]) + (k1[2] * k1[2] + k1[3] * k1[3]);
                float sqq = (q0v[0] * q0v[0] + q0v[1] * q0v[1]) + (q0v[2] * q0v[2] + q0v[3] * q0v[3]) + (q1v[0] * q1v[0] + q1v[1] * q1v[1]) + (q1v[2] * q1v[2] + q1v[3] * q1v[3]);
                sq += dppf<0xB1>(sq); sq += dppf<0x4E>(sq); sq += dppf<0x141>(sq);
                sqq += dppf<0xB1>(sqq); sqq += dppf<0x4E>(sqq); sqq += dppf<0x141>(sqq);
                mx = fmaxf(mx, sq); mq = fmaxf(mq, sqq); }
            LAS float* kml = (LAS float*)F.lds;
            if ((F.lane & 7) == 0) { kml[F.wave * 8 + (F.lane >> 3)] = mx; kml[64 + F.wave * 8 + (F.lane >> 3)] = mq; }
            __syncthreads();
            if (F.tid < 2 * NHEAD) { const int hh = F.tid & 7, qk = F.tid >> 3; float m2 = 0.f;
#pragma unroll
                for (int w = 0; w < NWAVES; ++w) m2 = fmaxf(m2, kml[qk * 64 + w * 8 + hh]);
                atomicMax((unsigned*)(ctl + CW_KM + qk * 32 + bb * NHEAD + hh), __float_as_uint(m2)); }
            __syncthreads();
        }
        if (F.vcu < NB) {
            const int b = F.vcu, h = F.wave; const float* src = LOGF + ((size_t)b * SEQ + 64 * F.lane) * 8 + h;
            float v[64]; float run = 0.f;
#pragma unroll
            for (int i = 0; i < 64; ++i) v[i] = src[i * 8];
#pragma unroll
            for (int i = 0; i < 64; ++i) { run += v[i]; v[i] = run; }
            float incl = run;
#pragma unroll
            for (int o = 1; o < 64; o <<= 1) { const float n = __shfl_up(incl, o); if (F.lane >= o) incl += n; }
            const float excl = incl - run;
            float* dst = CUMF + ((size_t)b * NHEAD + h) * SEQ + 64 * F.lane;
#pragma unroll
            for (int i = 0; i < 64; i += 4) *(f32x4*)(dst + i) = (f32x4){v[i] + excl, v[i + 1] + excl, v[i + 2] + excl, v[i + 3] + excl};
        }
        { UpOrder S{(const char*)QLAT, (const char*)Wq_t, (const char*)KVLAT, (const char*)Wkv_t, QLORA, F.G, (int)blockIdx.x};
          EpiUp E{EpiQup{QMLA, SSQQ, ROPETAB}, EpiKVup{KN, VM, SSQKV}};
          pg8::gemm_phase<EpiUp, UpOrder, true>(F.lds, S, E); }
        if (BOTH(3)) GRID_BAR();
    }

    for (int rep = 0; rep < ((PROBE_DUP == 4) ? 2 : 1); ++rep) if (IN(4)) { PHASE_ENV const bool dummy = (PROBE_DUP == 4) && rep == 0; (void)dummy;
        {
            const bool xq = (F.G % 8) == 0; const int x = xq ? (int)(blockIdx.x & 7) : 0, nunits = xq ? 128 : 1024;
            gu32* qh = ctl + CW_Q + 64 * x + (dummy ? 16 : 0);
            volatile LAS unsigned* qw = (volatile LAS unsigned*)(F.lds + MISC_OFF + 64);
            for (;;) {
                if (F.tid == 0) qw[0] = __hip_atomic_fetch_add(qh, 1u, RLX_AGENT);
                __syncthreads();
                const int r = (int)qw[0];
                if (r >= nunits) break;
                int qb, type, b, h;
                if (xq) { qb = 15 - (r >> 3); type = (r >> 2) & 1; b = r & 3; h = (x + 3 * b) & 7; }
                else { qb = 15 - (r >> 6); type = (r >> 5) & 1; b = (r >> 3) & 3; h = r & 7; }
                if (type == 0) { if (ATT_TUNED_FOX && qb != 0) att::attn_unit_t<64, true, 8>(b, h, qb, FQ, 512, FK, KPE, FV, CUMF, __uint_as_float(__hip_atomic_load((unsigned*)(ctl + CW_KM + b * NHEAD + h), RLX_AGENT)) * __uint_as_float(__hip_atomic_load((unsigned*)(ctl + CW_KM + 32 + b * NHEAD + h), RLX_AGENT)), (dummy ? (bf16*)((unsigned char*)out + 4 * MiB) : OCAT) + 512, D, F.lds);
                                 else att::attn_unit<64, true, 8>(b, h, qb, FQ, 512, FK, KPE, FV, CUMF, (dummy ? (bf16*)((unsigned char*)out + 4 * MiB) : OCAT) + 512, D, F.lds); }
                else { if (ATT_TUNED_MLA && qb != 0) att::attn_unit_t<96, false, 8>(b, h, qb, QMLA, 768, KN, KPE, VM, nullptr, 0.f, dummy ? (bf16*)((unsigned char*)out + 4 * MiB) : OCAT, D, F.lds);
                       else att::attn_unit<96, false, 8>(b, h, qb, QMLA, 768, KN, KPE, VM, nullptr, dummy ? (bf16*)((unsigned char*)out + 4 * MiB) : OCAT, D, F.lds); }
            }
        }
        if (BOTH(4)) GRID_BAR();
    }

    for (int rep = 0; rep < ((PROBE_DUP == 5) ? 2 : 1); ++rep) if (IN(5)) { PHASE_ENV const bool dummy = (PROBE_DUP == 5) && rep == 0; (void)dummy;
        pg8::StaticOrder S; S.init(OCAT, Wom_t, T, D, D, F.G, (int)blockIdx.x);
        EpiMergedCat E{GATES, MERGED};
        pg8::gemm_phase<EpiMergedCat, pg8::StaticOrder, true>(F.lds, S, E);
        if (BOTH(5)) GRID_BAR();
    }

    for (int rep = 0; rep < ((PROBE_DUP == 6) ? 2 : 1); ++rep) if (IN(6)) { PHASE_ENV const bool dummy = (PROBE_DUP == 6) && rep == 0; (void)dummy;
        pg8::StaticOrder S; S.init(MERGED, Wout_t, T, D, D, F.G, (int)blockIdx.x);
        EpiOut E{X_IN, out, mod, SSQ1};
        pg8::gemm_phase<EpiOut, pg8::StaticOrder, true>(F.lds, S, E);
        if (BOTH(6)) GRID_BAR();
    }

    for (int rep = 0; rep < ((PROBE_DUP == 7) ? 2 : 1); ++rep) if (IN(7)) { PHASE_ENV const bool dummy = (PROBE_DUP == 7) && rep == 0; (void)dummy;
        LAS unsigned char* wrl = F.lds;
        LAS float* vg = (LAS float*)(F.lds + LDSCTL_OFF + 6144);
        LAS float* vs = (LAS float*)(F.lds + LDSCTL_OFF + 10240);
        LAS float* stg = (LAS float*)(F.lds) + F.wave * 512;
        LAS int* cntw = (LAS int*)(F.lds + 16384);
        LAS int* basel = (LAS int*)(F.lds + 16384 + 2048);
        static_assert(LDSCTL_OFF + 10240 + 4096 <= LDS_BYTES && MOETAB_OFF + 4700 <= LDSCTL_OFF + 6144, "P7 LDS map");
        const float my_bias = b_router[F.lane];
        for (int grp = F.vcu; grp < T / 64; grp += F.G) {
            const int b = (grp * 64) / SEQ;
            __syncthreads();
#pragma unroll
            for (int i = 0; i < 16; ++i) __builtin_amdgcn_global_load_lds((const unsigned*)((const char*)Wr_f + (F.wave * 16 + i) * 1024 + F.lane * 16), (LAS unsigned*)(wrl + (F.wave * 16 + i) * 1024), 16, 0, 0);
            for (int i = F.tid; i < D; i += NWAVES * 64) { vg[i] = g_ffn[i] * (1.f + mod[(size_t)b * 6 * D + 4 * D + i]); vs[i] = mod[(size_t)b * 6 * D + 3 * D + i]; }
            const int t0 = grp * 64 + F.wave * 8;
            float rs_mine;
            { const float* sp = SSQ1 + (size_t)(t0 + (F.lane & 7)) * 16; const f32x4 a = *(const f32x4*)sp, b4 = *(const f32x4*)(sp + 4), c4 = *(const f32x4*)(sp + 8), d4 = *(const f32x4*)(sp + 12);
              const float ssum = (((a[0] + a[1]) + (a[2] + a[3])) + ((b4[0] + b4[1]) + (b4[2] + b4[3]))) + (((c4[0] + c4[1]) + (c4[2] + c4[3])) + ((d4[0] + d4[1]) + (d4[2] + d4[3])));
              rs_mine = rsqrtf(ssum * (1.f / D) + EPS); }
            VM_WAIT(); __syncthreads();
            const int r16 = F.lane & 15, kg = F.lane >> 4, myrow = t0 + (r16 & 7);
            const float* xrow = out + (size_t)myrow * D + 8 * kg;
            f32x4 lacc[4] = {{0.f, 0.f, 0.f, 0.f}, {0.f, 0.f, 0.f, 0.f}, {0.f, 0.f, 0.f, 0.f}, {0.f, 0.f, 0.f, 0.f}};
            f32x4 xq[16][2];
#pragma unroll
            for (int p = 0; p < 16; ++p) { xq[p][0] = *(const f32x4*)(xrow + 32 * p); xq[p][1] = *(const f32x4*)(xrow + 32 * p + 4); }
            for (int j4 = 0; j4 < 32; j4 += 16) {
#pragma unroll
                for (int p = 0; p < 16; ++p) { const int j = j4 + p, k = 32 * j + 8 * kg;
                    const f32x4 x0 = xq[p][0], x1v = xq[p][1];
                    if (j4 + 16 < 32) { xq[p][0] = *(const f32x4*)(xrow + 32 * (j + 16)); xq[p][1] = *(const f32x4*)(xrow + 32 * (j + 16) + 4); }
                    const f32x4 g0 = *(const LAS f32x4*)(vg + k), g1 = *(const LAS f32x4*)(vg + k + 4), s0 = *(const LAS f32x4*)(vs + k), s1 = *(const LAS f32x4*)(vs + k + 4);
                    const f32x4 h0 = x0 * rs_mine * g0 + s0, h1 = x1v * rs_mine * g1 + s1;
                    const u32x4 hw = pack8(h0, h1);
                    f32x4 a0, a1; unpack8(hw, a0, a1);
                    const u32x4 lw = pack8(h0 - a0, h1 - a1);
                    if (r16 < 8) *(u32x4*)(H + (size_t)myrow * D + k) = hw;
                    const bf16x8 Ah = __builtin_bit_cast(bf16x8, hw), Al = __builtin_bit_cast(bf16x8, lw);
#pragma unroll
                    for (int ntl = 0; ntl < 4; ++ntl) { const bf16x8 Wf = *(const LAS bf16x8*)(wrl + ((j * 4 + ntl) * 64 + F.lane) * 16);
                        lacc[ntl] = __builtin_amdgcn_mfma_f32_16x16x32_bf16(Wf, Ah, lacc[ntl], 0, 0, 0);
                        lacc[ntl] = __builtin_amdgcn_mfma_f32_16x16x32_bf16(Wf, Al, lacc[ntl], 0, 0, 0); } }
            }
            __syncthreads();
            if (r16 < 8) {
#pragma unroll
                for (int ntl = 0; ntl < 4; ++ntl) *(LAS f32x4*)(stg + r16 * 64 + 16 * ntl + 4 * kg) = lacc[ntl]; }
            LDS_WAIT();
            int cnt = 0; unsigned selbits = 0u, selks = 0u;
            for (int j = 0; j < 8; ++j) {
                const float logit = stg[j * 64 + F.lane];
                const float sc = 1.f / (1.f + expf(-logit));
                const float ch = sc + my_bias;
                const float m1 = max8(ch);
                const unsigned long long eq = __ballot(ch == m1);
                const unsigned gm = (unsigned)(eq >> (F.lane & ~7)) & 0xffu;
                const int first = __builtin_ctz(gm);
                const float c2 = max8(((F.lane & 7) == first) ? -INFINITY : ch);
                const float gs = m1 + c2; const int myg = F.lane >> 3;
                int rank = 0;
#pragma unroll
                for (int g = 0; g < 8; ++g) { const float o = __builtin_bit_cast(float, __builtin_amdgcn_readlane(__builtin_bit_cast(int, gs), 8 * g)); rank += (o > gs || (o == gs && g < myg)) ? 1 : 0; }
                float mc = (rank < 4) ? ch : -1e30f;
                int selk = -1;
#pragma unroll
                for (int k = 0; k < TOPK; ++k) { const float mx = wave_max_f(mc); const unsigned long long bl = __ballot(mc == mx); const int fl = __builtin_ctzll(bl);
                    if (F.lane == fl) { selk = k; mc = -INFINITY; } }
                const float ssum = wave_sum_f(selk >= 0 ? sc : 0.f);
                if (selk >= 0) { const int t = t0 + j; EIDX[(size_t)t * 8 + selk] = (unsigned char)F.lane; GATEW[(size_t)t * 8 + selk] = sc / ssum * 2.5f; ++cnt; selbits |= 1u << j; selks |= (unsigned)selk << (3 * j); }
            }
            cntw[F.wave * 64 + F.lane] = cnt;
            __syncthreads();
            if (F.wave == 0) { int tot = 0;
#pragma unroll
                for (int w = 0; w < 8; ++w) tot += cntw[w * 64 + F.lane];
                basel[F.lane] = (int)__hip_atomic_fetch_add((unsigned*)(ctl + (dummy ? CW_CNT + 2048 : CW_CNT) + 16 * F.lane), (unsigned)tot, RLX_AGENT); }
            __syncthreads();
            int pos = basel[F.lane];
            for (int w = 0; w < F.wave; ++w) pos += cntw[w * 64 + F.lane];
#pragma unroll
            for (int j = 0; j < 8; ++j) if ((selbits >> j) & 1u) { const int k = (selks >> (3 * j)) & 7, t = t0 + j;
                LIST[(size_t)F.lane * LISTCAP + pos] = (unsigned short)t;
                META[(size_t)F.lane * LISTCAP + pos] = (u32x2){(unsigned)(t * (TOPK + 1) + k), __float_as_uint(GATEW[(size_t)t * 8 + k])}; ++pos; }
        }
        __syncthreads();
        if (BOTH(7)) GRID_BAR();
    }

    volatile LAS int* tab = (volatile LAS int*)(F.lds + MOETAB_OFF);
    if (IN(8) || IN(9)) {
        __syncthreads();
        if (F.wave == 0) {
            const int n = (int)__hip_atomic_load((unsigned*)(ctl + CW_CNT + 16 * F.lane), RLX_AGENT);
            const int tiles = (n + 255) >> 8; int incl = tiles;
#pragma unroll
            for (int o = 1; o < 64; o <<= 1) { const int v = __shfl_up(incl, o); if (F.lane >= o) incl += v; }
            tab[F.lane] = incl - tiles; tab[66 + F.lane] = n;
            if (F.lane == 63) { tab[64] = incl; tab[65] = incl + T / 256; tab[66 + 64] = T; }
        }
        __syncthreads();
        { const int ti = F.tid; int e = 0;
          for (int q = 0; q <= NEXP; ++q) if (tab[q] <= ti) e = q;
          tab[132 + ti] = e; }
        __syncthreads();
    }
    for (int rep = 0; rep < ((PROBE_DUP == 8) ? 2 : 1); ++rep) if (IN(8)) { PHASE_ENV const bool dummy = (PROBE_DUP == 8) && rep == 0; (void)dummy;
        MoeOrder<2, true> S{(const char*)H, (const char*)Wgu_t, (const char*)Wsgu_t, D, (size_t)512 * D * 2, LIST, tab, F.G, (int)blockIdx.x};
        EpiHb E{HB};
        pg8::gemm_phase<EpiHb, MoeOrder<2, true>, true>(F.lds, S, E);
        if (BOTH(8)) GRID_BAR();
    }
    for (int rep = 0; rep < ((PROBE_DUP == 9) ? 2 : 1); ++rep) if (IN(9)) { PHASE_ENV const bool dummy = (PROBE_DUP == 9) && rep == 0; (void)dummy;
        if (dummy && PROBE_VAR == 1) dn::down_phase<true>(F.lds, HB, Wd_t, Wsd_t, tab, META, (unsigned char*)Y, (unsigned char*)(ws + WS_CTL + 900 * 1024), F.G, (int)blockIdx.x);
        else dn::down_phase<false>(F.lds, HB, Wd_t, Wsd_t, tab, META, (unsigned char*)Y, (unsigned char*)(ws + WS_CTL + 900 * 1024), F.G, (int)blockIdx.x);
        if (BOTH(9)) GRID_BAR();
    }

    for (int rep = 0; rep < ((PROBE_DUP == 10) ? 2 : 1); ++rep) if (IN(10)) { PHASE_ENV const bool dummy = (PROBE_DUP == 10) && rep == 0; (void)dummy;
        for (int m = gw; m < T; m += NGW) {
            const int b = m / SEQ; const float* gf = mod + (size_t)b * 6 * D + 5 * D;
            f32x4* xr = (f32x4*)(out + (size_t)m * D) + F.lane;
            f32x4* xw = dummy ? (f32x4*)((float*)HB + (size_t)m * D) + F.lane : xr;
            f32x4 v[4]; float s = 0.f;
#pragma unroll
            for (int j = 0; j < 4; ++j) { const int c = 4 * F.lane + 256 * j;
                f32x4 y = {0.f, 0.f, 0.f, 0.f};
#pragma unroll
                for (int k = 0; k < TOPK + 1; ++k) { const int w = __builtin_nontemporal_load((const int*)((const unsigned char*)Y + ((size_t)m * (TOPK + 1) + k) * D + c));
                    const f32x2 lo = __builtin_amdgcn_cvt_pk_f32_fp8(w, false), hi2 = __builtin_amdgcn_cvt_pk_f32_fp8(w, true);
                    y += (f32x4){lo.x, lo.y, hi2.x, hi2.y}; }
                v[j] = __builtin_nontemporal_load(xr + 64 * j) + *(const f32x4*)(gf + c) * y;
                s += (v[j].x * v[j].x + v[j].y * v[j].y) + (v[j].z * v[j].z + v[j].w * v[j].w); }
            const float rstd = rsqrtf(wave_sum(s) * (1.f / D) + EPS);
#pragma unroll
            for (int j = 0; j < 4; ++j) __builtin_nontemporal_store(v[j] * rstd * *(const f32x4*)(g_final + 4 * F.lane + 256 * j), xw + 64 * j);
        }
    }
#undef IN
#undef BOTH
#undef GRID_BAR
}

constexpr int NPHASE = 11;
extern "C" void kernel_launch(void* const* d_in, const int* in_sizes, int n_in, void* d_out, int out_size, void* d_ws, size_t ws_size, hipStream_t stream) {
    static int grid = 0;
    if (grid == 0) {
        if (n_in != 25 || out_size != T * D || ws_size < WS_END) { fprintf(stderr, "kernel_launch: unexpected shapes (n_in %d out %d ws %zu need %zu)\n", n_in, out_size, ws_size, (size_t)WS_END); grid = -1; return; }
        int dev = 0, cus = 0;
        if (hipGetDevice(&dev) != hipSuccess || hipDeviceGetAttribute(&cus, hipDeviceAttributeMultiprocessorCount, dev) != hipSuccess) { grid = -1; return; }
        if (hipFuncSetAttribute((const void*)fwd, hipFuncAttributeMaxDynamicSharedMemorySize, LDS_BYTES) != hipSuccess) { fprintf(stderr, "kernel_launch: hipFuncSetAttribute failed\n"); grid = -1; return; }
        int per_cu = 0;
        if (hipOccupancyMaxActiveBlocksPerMultiprocessor(&per_cu, (const void*)fwd, NWAVES * 64, LDS_BYTES) != hipSuccess || per_cu < 1) { fprintf(stderr, "kernel_launch: occupancy query says %d\n", per_cu); }
        (void)hipGetLastError();
        grid = cus;
    }
    if (grid < 0) return;
    (void)in_sizes;
    if (hipMemsetAsync((char*)d_ws + WS_CTL, 0, CTL_ZERO_BYTES, stream) != hipSuccess) return;
    Args a{};
    for (int i = 0; i < 25; ++i) a.in[i] = d_in[i];
    a.out = (float*)d_out; a.ws = (unsigned char*)d_ws;
#if MK_ONE_LAUNCH
    a.ph_lo = 0; a.ph_hi = NPHASE;
    hipLaunchKernelGGL(fwd, dim3(grid), dim3(NWAVES * 64), LDS_BYTES, stream, a);
#else
    for (int p = 0; p < NPHASE; ++p) { a.ph_lo = p; a.ph_hi = p + 1; hipLaunchKernelGGL(fwd, dim3(grid), dim3(NWAVES * 64), LDS_BYTES, stream, a); }
#endif
}
```

```cpp
#include <hip/hip_runtime.h>
#include <cstdio>
#include <cstdint>
#include <type_traits>

#ifndef MK_ONE_LAUNCH
#define MK_ONE_LAUNCH 1
#endif

#ifndef PROBE_DUP
#define PROBE_DUP -1
#endif
#ifndef ATT_TUNED_FOX
#define ATT_TUNED_FOX 1
#endif
#ifndef ATT_TUNED_MLA
#define ATT_TUNED_MLA 1
#endif
#ifndef PROBE_VAR
#define PROBE_VAR 0
#endif
#define GAS __attribute__((address_space(1)))
#define LAS __attribute__((address_space(3)))
typedef unsigned short bf16;
typedef short bf16x8 __attribute__((ext_vector_type(8)));
typedef short s16x4 __attribute__((ext_vector_type(4)));
typedef float f32x2 __attribute__((ext_vector_type(2)));
typedef float f32x4 __attribute__((ext_vector_type(4)));
typedef float f32x16 __attribute__((ext_vector_type(16)));
typedef unsigned u32x2 __attribute__((ext_vector_type(2)));
typedef unsigned u32x4 __attribute__((ext_vector_type(4)));
typedef GAS unsigned gu32;
typedef int v8i32_t __attribute__((ext_vector_type(8)));
typedef int v4i32_t __attribute__((ext_vector_type(4)));

constexpr int NB = 4, SEQ = 4096, T = NB * SEQ, D = 1024;
constexpr int NIN = 4096;
constexpr int QLORA = 256, KVLORA = 128, KVPAD = 256, ROPE = 32, NHEAD = 8, HD = 64, MQK = 96;
constexpr int NEXP = 64, TOPK = 6, DEXP = 256;
constexpr float EPS = 1e-6f;
constexpr float LOG2E = 1.4426950408889634f;
constexpr float C2F = 0.125f * LOG2E;
constexpr float C2M = 0.10206207261596577f * LOG2E;
constexpr int LISTCAP = T;
constexpr float WSCALE8 = 64.f;

constexpr size_t MiB = 1u << 20;
constexpr size_t WS_CTL = 0, CTL_ZERO_BYTES = 1 * MiB;
constexpr size_t WS_EIDX = 262144, WS_GATEW = 393216;
constexpr size_t WS_WIN = 1 * MiB, WS_WQ = 9 * MiB, WS_WKV = 9 * MiB + 512 * 1024, WS_WOM = 10 * MiB, WS_WOF = 11 * MiB, WS_WOUT = 12 * MiB;
constexpr size_t WS_WSGU = 14 * MiB, WS_WSD = 15 * MiB, WS_WR = 15 * MiB + 512 * 1024, WS_MOD = 15 * MiB + 640 * 1024;
constexpr size_t WS_WD = 16 * MiB;
constexpr size_t WS_HB = 48 * MiB;
constexpr size_t WS_FQ = 48 * MiB, WS_FK = 64 * MiB, WS_FV = 80 * MiB, WS_QLAT = 96 * MiB, WS_KVLAT = 104 * MiB;
constexpr size_t WS_OFOX = WS_FQ, WS_OMLA = WS_QLAT;
static_assert(WS_FK - WS_FQ == (size_t)T * 512 * 2 && WS_FV - WS_FK == (size_t)T * 512 * 2, "fq|fk|fv contiguous");
constexpr size_t WS_Y = 112 * MiB;
constexpr size_t WS_WGU = 112 * MiB;
constexpr size_t WS_H = 176 * MiB;
constexpr size_t WS_QMLA = WS_H;
constexpr size_t WS_GATES = 208 * MiB;
constexpr size_t WS_KN = 272 * MiB, WS_VM = 288 * MiB, WS_KPE = 304 * MiB;
constexpr size_t WS_MERGED = WS_KN;
constexpr size_t WS_LIST = 304 * MiB;
constexpr size_t WS_END = 306 * MiB;
constexpr size_t DO_MODP = 4 * MiB;
constexpr size_t DO_ROPE = 0, DO_LOGF = 2 * MiB, DO_CUMF = 2 * MiB + 512 * 1024, DO_SSQQ = 3 * MiB, DO_SSQKV = 3 * MiB + 256 * 1024;

constexpr int CW_TMO = 0;
constexpr int CW_BAR = 4096;
constexpr int CW_CNT = 8192;
constexpr int CW_KM = 12288;
constexpr int CW_Q = 12544;

constexpr int RING_BYTES = 131072;
constexpr int LDSCTL_OFF = RING_BYTES;
constexpr int MISC_OFF = LDSCTL_OFF + 320;
constexpr int MOETAB_OFF = LDSCTL_OFF + 1024;
constexpr int LDS_BYTES = 147456;

constexpr int NWAVES = 8;

#define LDS_WAIT() asm volatile("s_waitcnt lgkmcnt(0)" ::: "memory")
#define VM_WAIT() asm volatile("s_waitcnt vmcnt(0)" ::: "memory")
#define RLX_AGENT __ATOMIC_RELAXED, __HIP_MEMORY_SCOPE_AGENT
__device__ __forceinline__ unsigned f2bf(float f) { unsigned u = __builtin_bit_cast(unsigned, f); return (u + 0x7fffu + ((u >> 16) & 1u)) >> 16; }
__device__ __forceinline__ float bf2f(unsigned h) { return __builtin_bit_cast(float, h << 16); }
__device__ __forceinline__ unsigned pk2(float lo, float hi) { return f2bf(lo) | (f2bf(hi) << 16); }
__device__ __forceinline__ unsigned cvt_pk_bf16(float lo, float hi) { unsigned r; asm volatile("v_cvt_pk_bf16_f32 %0, %1, %2" : "=v"(r) : "v"(lo), "v"(hi)); return r; }
__device__ __forceinline__ u32x4 pack8(f32x4 a, f32x4 b) { u32x4 w; w.x = cvt_pk_bf16(a[0], a[1]); w.y = cvt_pk_bf16(a[2], a[3]); w.z = cvt_pk_bf16(b[0], b[1]); w.w = cvt_pk_bf16(b[2], b[3]); return w; }
__device__ __forceinline__ void unpack8(u32x4 w, f32x4& a, f32x4& b) {
    a = (f32x4){bf2f(w.x & 0xffffu), bf2f(w.x >> 16), bf2f(w.y & 0xffffu), bf2f(w.y >> 16)};
    b = (f32x4){bf2f(w.z & 0xffffu), bf2f(w.z >> 16), bf2f(w.w & 0xffffu), bf2f(w.w >> 16)};
}
__device__ __forceinline__ float wave_sum(float v) {
#pragma unroll
    for (int o = 1; o < 64; o <<= 1) v += __shfl_xor(v, o);
    return v;
}
__device__ __forceinline__ float wave_max(float v) {
#pragma unroll
    for (int o = 1; o < 64; o <<= 1) v = fmaxf(v, __shfl_xor(v, o));
    return v;
}
template <int CTRL> __device__ __forceinline__ float dppf(float v) { return __builtin_bit_cast(float, __builtin_amdgcn_update_dpp(0, __builtin_bit_cast(int, v), CTRL, 0xf, 0xf, true)); }
__device__ __forceinline__ float max8(float v) { v = fmaxf(v, dppf<0xB1>(v)); v = fmaxf(v, dppf<0x4E>(v)); v = fmaxf(v, dppf<0x141>(v)); return v; }
__device__ __forceinline__ float wave_max_f(float v) { v = max8(v); v = fmaxf(v, dppf<0x140>(v)); v = fmaxf(v, __shfl_xor(v, 16)); v = fmaxf(v, __shfl_xor(v, 32)); return v; }
__device__ __forceinline__ float wave_sum_f(float v) { v += dppf<0xB1>(v); v += dppf<0x4E>(v); v += dppf<0x141>(v); v += dppf<0x140>(v); v += __shfl_xor(v, 16); v += __shfl_xor(v, 32); return v; }
__device__ __forceinline__ float sigmoidf_(float x) { return 1.f / (1.f + __expf(-x)); }
__device__ __forceinline__ float siluf_(float x) { return x / (1.f + __expf(-x)); }

namespace pg8 {
constexpr int BM = 256, BK = 64, HALF = 128, HTB = HALF * BK * 2, NXCD = 8, WGM = 8;
__host__ __device__ __forceinline__ int lds_byte(int r, int c) { const int st = (r >> 4) * 2 + (c >> 5), rr = r & 15, cc = c & 31, ob = rr * 64 + cc * 2; return st * 1024 + (ob ^ (((ob >> 9) & 1) << 5)); }
__host__ __device__ __forceinline__ void stage_rc(int b, int& R, int& C) { const int st = b / 1024, sb = b % 1024, swz = sb ^ (((sb >> 9) & 1) << 5); R = (st >> 1) * 16 + swz / 64; C = (st & 1) * 32 + (swz % 64) / 2; }
__host__ __device__ __forceinline__ int perm32(int rho) { const int n = rho >> 4, i = rho & 15; return 8 * (i >> 2) + 4 * n + (i & 3); }

struct Unit { int pm, pn, e, aux, n; };

struct StaticOrder {
    static constexpr bool GATHER = false;
    const char* A; const char* Bt; int K;
    int nM, nN, nwg, G, c;
    __device__ void init(const void* A_, const void* Bt_, int M, int N, int K_, int G_, int c_) { A = (const char*)A_; Bt = (const char*)Bt_; K = K_; nM = M / BM; nN = N / BM; nwg = nM * nN; G = G_; c = c_; }
    __device__ bool next(int i, Unit& u) const {
        const long L = (long)i * G + c; if (L >= nwg) return false;
        int wgid = (int)L; { const int q = nwg / NXCD, r = nwg % NXCD, xcd = wgid % NXCD, off = wgid / NXCD; wgid = (xcd < r ? xcd * (q + 1) : r * (q + 1) + (xcd - r) * q) + off; }
        const int nig = WGM * nN, gid = wgid / nig, fm = gid * WGM, gsz = (nM - fm) < WGM ? (nM - fm) : WGM;
        u.pm = fm + ((wgid % nig) % gsz); u.pn = (wgid % nig) / gsz; u.e = 0; u.aux = 0; u.n = BM; return true;
    }
    __device__ __forceinline__ const char* a_ptr(const Unit& u) const { return A + (size_t)u.pm * BM * K * 2; }
    __device__ __forceinline__ const char* b_ptr(const Unit& u) const { return Bt + (size_t)u.pn * BM * K * 2; }
    __device__ __forceinline__ unsigned a_row(const Unit&, int r) const { return (unsigned)r; }
};

template <class Epi, class Sched, bool ALIGN_EPI, bool FP8 = false>
__device__ __forceinline__ void gemm_phase(LAS unsigned char* lds, const Sched& S, const Epi& E) {
    int tid = threadIdx.x; asm volatile("" : "+v"(tid));
    const int wid = __builtin_amdgcn_readfirstlane(tid >> 6), lane = tid & 63, wr = wid >> 2, wc = wid & 3, fr = lane & 15, fq = lane >> 4;
    const int K = S.K, nt = K / BK;
    unsigned voffB[2], voffA[2];
#pragma unroll
    for (int i = 0; i < 2; ++i) { int R, C; stage_rc(tid * 16 + i * 8192, R, C); const int Rb = (R & ~31) + perm32(R & 31);
        voffA[i] = (unsigned)(R * K + C) * 2u; voffB[i] = (unsigned)(Rb * K + C) * 2u; }
    unsigned vA[2][2], vN[2][2];
    const size_t kstep = (size_t)(BK * 2);
    const size_t hstep = (size_t)HALF * K * 2;
    const unsigned ldsw = (unsigned)wid * 1024u;
    const int aoff = lds_byte(wr * 64 + fr, fq * 8), boff = lds_byte(wc * 32 + fr, fq * 8);
#define PG8_SA(b, h) (((b) * 2 + (h)) * HTB)
#define PG8_SB(b, h) ((4 + (b) * 2 + (h)) * HTB)
#define PG8_STAGE(bufoff, gbase, voff) do { _Pragma("unroll") for (int _i = 0; _i < 2; ++_i) \
        __builtin_amdgcn_global_load_lds((const unsigned*)((const char*)(gbase) + (voff)[_i]), (LAS unsigned*)(lds + (bufoff) + ldsw + _i * 8192), 16, 0, 0); } while (0)
#define PG8_STAGE_A(bufoff, gbase, h, nx) do { if constexpr (Sched::GATHER) { const unsigned vs_[2] = {(nx) ? vN[h][0] : vA[h][0], (nx) ? vN[h][1] : vA[h][1]}; PG8_STAGE(bufoff, gbase, vs_); }     \
        else PG8_STAGE(bufoff, (const char*)(gbase) + (h) * hstep, voffA); } while (0)
#define PG8_LDA(dst, b, h) do { _Pragma("unroll") for (int m = 0; m < 4; ++m) { if constexpr (FP8) { dst##8[m].lo = *(const LAS v4i32_t*)(lds + PG8_SA(b, h) + aoff + m * 2048); dst##8[m].hi = *(const LAS v4i32_t*)(lds + PG8_SA(b, h) + aoff + m * 2048 + 1024); } \
        else { _Pragma("unroll") for (int k = 0; k < 2; ++k) dst[m][k] = *(const LAS bf16x8*)(lds + PG8_SA(b, h) + aoff + m * 2048 + k * 1024); } } } while (0)
#define PG8_LDB(dst, b, h) do { _Pragma("unroll") for (int n = 0; n < 2; ++n) { if constexpr (FP8) { dst##8[n].lo = *(const LAS v4i32_t*)(lds + PG8_SB(b, h) + boff + n * 2048); dst##8[n].hi = *(const LAS v4i32_t*)(lds + PG8_SB(b, h) + boff + n * 2048 + 1024); } \
        else { _Pragma("unroll") for (int k = 0; k < 2; ++k) dst[n][k] = *(const LAS bf16x8*)(lds + PG8_SB(b, h) + boff + n * 2048 + k * 1024); } } } while (0)
#define PG8_MMA(ai, bj, At, Bt) do { __builtin_amdgcn_s_setprio(1); _Pragma("unroll") for (int m = 0; m < 4; ++m) _Pragma("unroll") for (int n = 0; n < 2; ++n) { \
        if constexpr (FP8) asm volatile("v_mfma_scale_f32_16x16x128_f8f6f4 %0, %1, %2, %0, %3, %3 op_sel_hi:[0,0,0]" : "+v"(acc[ai][bj][m][n]) : "v"(Bt##8[n]), "v"(At##8[m]), "v"(sc1_));     \
        else { _Pragma("unroll") for (int k = 0; k < 2; ++k) acc[ai][bj][m][n] = __builtin_amdgcn_mfma_f32_16x16x32_bf16(Bt[n][k], At[m][k], acc[ai][bj][m][n], 0, 0, 0); } } \
        __builtin_amdgcn_s_setprio(0); } while (0)
#define PG8_WAIT_V(n) asm volatile("s_waitcnt vmcnt(" #n ")" ::: "memory")
#define PG8_WAIT_L(n) asm volatile("s_waitcnt lgkmcnt(" #n ")" ::: "memory")
#define PG8_BAR __builtin_amdgcn_s_barrier()
#define PG8_SCHED __builtin_amdgcn_sched_barrier(0)
#define PG8_SETV(dst, u) do { _Pragma("unroll") for (int _h = 0; _h < 2; ++_h) _Pragma("unroll") for (int _i = 0; _i < 2; ++_i) { int R_, C_; stage_rc(tid * 16 + _i * 8192, R_, C_); \
        dst[_h][_i] = (S.a_row(u, _h * HALF + R_) * (unsigned)K + (unsigned)C_) * 2u; } } while (0)
    Unit cur, nxt; int ui = 0;
    if (!S.next(0, cur)) return;
    f32x4 acc[2][2][4][2];
#define PG8_ZERO() do { _Pragma("unroll") for (int a = 0; a < 2; ++a) _Pragma("unroll") for (int b = 0; b < 2; ++b) _Pragma("unroll") for (int m = 0; m < 4; ++m) _Pragma("unroll") for (int n = 0; n < 2; ++n) { \
        if constexpr (FP8) asm volatile("v_mov_b32 %0, 0\n\tv_mov_b32 %1, 0\n\tv_mov_b32 %2, 0\n\tv_mov_b32 %3, 0" : "=v"(acc[a][b][m][n][0]), "=v"(acc[a][b][m][n][1]), "=v"(acc[a][b][m][n][2]), "=v"(acc[a][b][m][n][3])); \
        else acc[a][b][m][n] = (f32x4){0.f, 0.f, 0.f, 0.f}; } } while (0)
    PG8_ZERO();
    unsigned sc1_ = 0x7f7f7f7fu; asm volatile("" : "+v"(sc1_));
    (void)sc1_;
    bf16x8 At[4][2], B0[2][2], B1[2][2];
    v8i32_t At8[4], B08[2], B18[2];
    (void)At; (void)B0; (void)B1; (void)At8; (void)B08; (void)B18;
    const char* cA = S.a_ptr(cur); const char* cB = S.b_ptr(cur);
    if constexpr (Sched::GATHER) { PG8_SETV(vA, cur); }
    PG8_STAGE(PG8_SB(0, 0), cB, voffB); PG8_STAGE(PG8_SB(0, 1), cB + hstep, voffB); PG8_STAGE_A(PG8_SA(0, 0), cA, 0, false); PG8_STAGE_A(PG8_SA(0, 1), cA, 1, false);
    if (wr == 1) PG8_BAR;
    PG8_WAIT_V(2); PG8_BAR;
    PG8_STAGE(PG8_SB(1, 0), cB + kstep, voffB); PG8_STAGE_A(PG8_SA(1, 0), cA + kstep, 0, false); PG8_STAGE(PG8_SB(1, 1), cB + hstep + kstep, voffB);
    PG8_WAIT_V(6); PG8_BAR;
    for (;;) {
        const bool has_next = S.next(ui + 1, nxt);
        const char* nA = has_next ? S.a_ptr(nxt) : cA; const char* nB = has_next ? S.b_ptr(nxt) : cB;
        if constexpr (Sched::GATHER) { if (has_next) { PG8_SETV(vN, nxt); } else {
#pragma unroll
            for (int h = 0; h < 2; ++h)
#pragma unroll
                for (int i = 0; i < 2; ++i) vN[h][i] = vA[h][i]; } }
        for (int t = 0; t < nt; t += 2) {
            const bool last = (t == nt - 2);
            if constexpr (Epi::MIDK) { if (t == nt / 2) E.mid(acc, cur, wr, wc, fr, fq); }
            const char* a1 = cA + (size_t)(t + 1) * kstep;
            const char* a2 = last ? nA : cA + (size_t)(t + 2) * kstep; const char* b2 = last ? nB : cB + (size_t)(t + 2) * kstep;
            const char* a3 = a2 + kstep; const char* b3 = b2 + kstep;
            PG8_LDB(B0, 0, 0); PG8_LDB(B1, 0, 1); PG8_SCHED; PG8_LDA(At, 0, 0); PG8_STAGE_A(PG8_SA(1, 1), a1, 1, false);
            PG8_WAIT_V(8); PG8_WAIT_L(0); PG8_BAR; PG8_MMA(0, 0, At, B0); PG8_MMA(0, 1, At, B1); PG8_BAR; PG8_SCHED;
            PG8_LDA(At, 0, 1); PG8_STAGE(PG8_SB(0, 0), b2, voffB); PG8_STAGE(PG8_SB(0, 1), b2 + hstep, voffB); PG8_STAGE_A(PG8_SA(0, 0), a2, 0, last);
            PG8_WAIT_V(8); PG8_WAIT_L(0); PG8_BAR; PG8_MMA(1, 0, At, B0); PG8_MMA(1, 1, At, B1); PG8_BAR; PG8_SCHED;
            PG8_LDB(B0, 1, 0); PG8_LDB(B1, 1, 1); PG8_SCHED; PG8_LDA(At, 1, 0); PG8_STAGE_A(PG8_SA(0, 1), a2, 1, last);
            PG8_WAIT_V(8); PG8_WAIT_L(0); PG8_BAR; PG8_MMA(0, 0, At, B0); PG8_MMA(0, 1, At, B1); PG8_BAR; PG8_SCHED;
            PG8_LDA(At, 1, 1); PG8_STAGE(PG8_SB(1, 0), b3, voffB); PG8_STAGE(PG8_SB(1, 1), b3 + hstep, voffB); PG8_STAGE_A(PG8_SA(1, 0), a3, 0, last);
            PG8_WAIT_V(8); PG8_WAIT_L(0); PG8_BAR; PG8_MMA(1, 0, At, B0); PG8_MMA(1, 1, At, B1); PG8_BAR; PG8_SCHED;
        }
        if constexpr (ALIGN_EPI) { if (wr == 0) PG8_BAR; }
        if constexpr (FP8) asm volatile("s_nop 15\n\ts_nop 7" ::: "memory");
        E(acc, cur, wr, wc, fr, fq);
        if (!has_next) break;
        PG8_ZERO();
        cur = nxt; cA = nA; cB = nB; ++ui;
        if constexpr (Sched::GATHER) {
#pragma unroll
            for (int h = 0; h < 2; ++h)
#pragma unroll
                for (int i = 0; i < 2; ++i) vA[h][i] = vN[h][i]; }
        if constexpr (ALIGN_EPI) { if (wr == 1) PG8_BAR; }
    }
    PG8_WAIT_V(0);
    if constexpr (!ALIGN_EPI) { if (wr == 0) PG8_BAR; }
    PG8_BAR;
#undef PG8_SA
#undef PG8_SB
#undef PG8_STAGE
#undef PG8_STAGE_A
#undef PG8_LDA
#undef PG8_LDB
#undef PG8_MMA
#undef PG8_ZERO
#undef PG8_WAIT_V
#undef PG8_WAIT_L
#undef PG8_BAR
#undef PG8_SCHED
#undef PG8_SETV
}
}
using pg8::Unit;

#define EPI_ROWS(ai, m) for (int ai = 0; ai < 2; ++ai) for (int m = 0; m < 4; ++m)

struct EpiInProj {
    static constexpr bool MIDK = false;
    bf16 *qlat, *kvlat, *kpe, *fq, *gates; float *logf, *ssqq, *ssqkv; const float* ropetab; const float* bforget;
    __device__ __forceinline__ void operator()(const f32x4 (&acc)[2][2][4][2], const Unit& u, int wr, int wc, int fr, int fq_) const {
        const int pn = u.pn, row0 = u.pm * 256 + wr * 64 + fr, c0 = wc * 32 + 8 * fq_;
#pragma unroll
        for (int ai = 0; ai < 2; ++ai)
#pragma unroll
            for (int m = 0; m < 4; ++m) {
                const int row = row0 + ai * 128 + m * 16;
                if (pn == 0) {
                    float s = 0.f;
#pragma unroll
                    for (int bj = 0; bj < 2; ++bj) { const f32x4 v0 = acc[ai][bj][m][0], v1 = acc[ai][bj][m][1];
                        s += (v0[0] * v0[0] + v0[1] * v0[1]) + (v0[2] * v0[2] + v0[3] * v0[3]) + (v1[0] * v1[0] + v1[1] * v1[1]) + (v1[2] * v1[2] + v1[3] * v1[3]);
                        *(u32x4*)(qlat + (size_t)row * QLORA + c0 + 128 * bj) = pack8(v0, v1); }
                    s += __shfl_xor(s, 16); s += __shfl_xor(s, 32);
                    if (fq_ == 0) ssqq[row * 4 + wc] = s;
                } else if (pn == 1) {
                    { const f32x4 v0 = acc[ai][0][m][0], v1 = acc[ai][0][m][1];
                      float s = (v0[0] * v0[0] + v0[1] * v0[1]) + (v0[2] * v0[2] + v0[3] * v0[3]) + (v1[0] * v1[0] + v1[1] * v1[1]) + (v1[2] * v1[2] + v1[3] * v1[3]);
                      *(u32x4*)(kvlat + (size_t)row * KVPAD + c0) = pack8(v0, v1);
                      s += __shfl_xor(s, 16); s += __shfl_xor(s, 32);
                      if (fq_ == 0) ssqkv[row * 4 + wc] = s; }
                    { const f32x4 v0 = acc[ai][1][m][0], v1 = acc[ai][1][m][1];
                      *(u32x4*)(kvlat + (size_t)row * KVPAD + 128 + c0) = (u32x4){0u, 0u, 0u, 0u};
                      if (wc == 0) {
                          const f32x4* tb = (const f32x4*)(ropetab + ((size_t)row * 16 + 4 * fq_) * 2);
                          const f32x4 t0 = tb[0], t1 = tb[1];
                          f32x4 o1, o2;
                          o1[0] = v0[0] * t0[0] - v1[0] * t0[1]; o2[0] = v1[0] * t0[0] + v0[0] * t0[1];
                          o1[1] = v0[1] * t0[2] - v1[1] * t0[3]; o2[1] = v1[1] * t0[2] + v0[1] * t0[3];
                          o1[2] = v0[2] * t1[0] - v1[2] * t1[1]; o2[2] = v1[2] * t1[0] + v0[2] * t1[1];
                          o1[3] = v0[3] * t1[2] - v1[3] * t1[3]; o2[3] = v1[3] * t1[2] + v0[3] * t1[3];
                          *(u32x4*)(kpe + (size_t)row * ROPE + 8 * fq_) = pack8(o1, o2);
                      } else if (wc == 1 && fq_ == 0) {
                          f32x4 l0, l1;
#pragma unroll
                          for (int h = 0; h < 4; ++h) { const float z0 = v0[h] + bforget[h], z1 = v1[h] + bforget[4 + h];
                              l0[h] = (fminf(z0, 0.f) - log1pf(expf(-fabsf(z0)))) * LOG2E; l1[h] = (fminf(z1, 0.f) - log1pf(expf(-fabsf(z1)))) * LOG2E; }
                          *(f32x4*)(logf + (size_t)row * 8) = l0; *(f32x4*)(logf + (size_t)row * 8 + 4) = l1;
                      } }
                } else if (pn < 8) {
                    bf16* dst = fq + (size_t)((pn - 2) >> 1) * ((size_t)T * 512); const float sc = (pn < 4) ? C2F : 1.f;
#pragma unroll
                    for (int bj = 0; bj < 2; ++bj) *(u32x4*)(dst + (size_t)row * 512 + (pn & 1) * 256 + c0 + 128 * bj) = pack8(acc[ai][bj][m][0] * sc, acc[ai][bj][m][1] * sc);
                } else {
#pragma unroll
                    for (int bj = 0; bj < 2; ++bj) { f32x4 v0 = acc[ai][bj][m][0], v1 = acc[ai][bj][m][1];
#pragma unroll
                        for (int q = 0; q < 4; ++q) { v0[q] = fmaxf(sigmoidf_(v0[q]), 1e-30f); v1[q] = fmaxf(sigmoidf_(v1[q]), 1e-30f); }
                        *(u32x4*)(gates + (size_t)row * 2048 + (pn - 8) * 256 + c0 + 128 * bj) = pack8(v0, v1); }
                }
            }
    }
};

struct EpiQup {
    static constexpr bool MIDK = false;
    bf16* q; const float* ssqq; const float* ropetab;
    __device__ __forceinline__ void operator()(const f32x4 (&acc)[2][2][4][2], const Unit& u, int wr, int wc, int fr, int fq_) const {
        const int row0 = u.pm * 256 + wr * 64 + fr, c0 = u.pn * 256 + wc * 32 + 8 * fq_;
#pragma unroll
        for (int ai = 0; ai < 2; ++ai)
#pragma unroll
            for (int m = 0; m < 4; ++m) {
                const int row = row0 + ai * 128 + m * 16;
                const f32x4 sq = *(const f32x4*)(ssqq + row * 4);
                const float rs = rsqrtf(((sq[0] + sq[1]) + (sq[2] + sq[3])) * (1.f / QLORA) + EPS) * C2M;
#pragma unroll
                for (int bj = 0; bj < 2; ++bj) {
                    const int col = c0 + 128 * bj, j = col % MQK;
                    f32x4 v0 = acc[ai][bj][m][0] * rs, v1 = acc[ai][bj][m][1] * rs;
                    if (j >= 64) { const int g = (j - 64) >> 3;
                        const f32x4* tb = (const f32x4*)(ropetab + ((size_t)row * 16 + 4 * g) * 2);
                        const f32x4 t0 = tb[0], t1 = tb[1];
                        f32x4 o1, o2;
                        o1[0] = v0[0] * t0[0] - v1[0] * t0[1]; o2[0] = v1[0] * t0[0] + v0[0] * t0[1];
                        o1[1] = v0[1] * t0[2] - v1[1] * t0[3]; o2[1] = v1[1] * t0[2] + v0[1] * t0[3];
                        o1[2] = v0[2] * t1[0] - v1[2] * t1[1]; o2[2] = v1[2] * t1[0] + v0[2] * t1[1];
                        o1[3] = v0[3] * t1[2] - v1[3] * t1[3]; o2[3] = v1[3] * t1[2] + v0[3] * t1[3];
                        v0 = o1; v1 = o2; }
                    *(u32x4*)(q + (size_t)row * 768 + col) = pack8(v0, v1);
                }
            }
    }
};

struct EpiKVup {
    static constexpr bool MIDK = false;
    bf16 *kn, *vm; const float* ssqkv;
    __device__ __forceinline__ void operator()(const f32x4 (&acc)[2][2][4][2], const Unit& u, int wr, int wc, int fr, int fq_) const {
        const int row0 = u.pm * 256 + wr * 64 + fr, c0 = u.pn * 256 + wc * 32 + 8 * fq_;
        bf16* dst = (u.pn < 2) ? kn : vm; const int cb = (u.pn & 1) * 256 + wc * 32 + 8 * fq_;
        (void)c0;
#pragma unroll
        for (int ai = 0; ai < 2; ++ai)
#pragma unroll
            for (int m = 0; m < 4; ++m) {
                const int row = row0 + ai * 128 + m * 16;
                const f32x4 sq = *(const f32x4*)(ssqkv + row * 4);
                const float rs = rsqrtf(((sq[0] + sq[1]) + (sq[2] + sq[3])) * (1.f / KVLORA) + EPS);
#pragma unroll
                for (int bj = 0; bj < 2; ++bj) *(u32x4*)(dst + (size_t)row * 512 + cb + 128 * bj) = pack8(acc[ai][bj][m][0] * rs, acc[ai][bj][m][1] * rs);
            }
    }
};

struct EpiPartA {
    static constexpr bool MIDK = false;
    float* part; const bf16* gates;
    __device__ __forceinline__ void operator()(const f32x4 (&acc)[2][2][4][2], const Unit& u, int wr, int wc, int fr, int fq_) const {
        const int row0 = u.pm * 256 + wr * 64 + fr, c0 = u.pn * 256 + wc * 32 + 8 * fq_;
#pragma unroll
        for (int ai = 0; ai < 2; ++ai)
#pragma unroll
            for (int m = 0; m < 4; ++m) {
                const int row = row0 + ai * 128 + m * 16;
#pragma unroll
                for (int bj = 0; bj < 2; ++bj) { const int col = c0 + 128 * bj;
                    f32x4 g0, g1; unpack8(*(const u32x4*)(gates + (size_t)row * 2048 + col), g0, g1);
                    *(f32x4*)(part + (size_t)row * D + col) = g0 * acc[ai][bj][m][0]; *(f32x4*)(part + (size_t)row * D + col + 4) = g1 * acc[ai][bj][m][1]; }
            }
    }
};
struct EpiMerged {
    static constexpr bool MIDK = false;
    const float* part; const bf16* gates; bf16* merged;
    __device__ __forceinline__ void operator()(const f32x4 (&acc)[2][2][4][2], const Unit& u, int wr, int wc, int fr, int fq_) const {
        const int row0 = u.pm * 256 + wr * 64 + fr, c0 = u.pn * 256 + wc * 32 + 8 * fq_;
#pragma unroll
        for (int ai = 0; ai < 2; ++ai)
#pragma unroll
            for (int m = 0; m < 4; ++m) {
                const int row = row0 + ai * 128 + m * 16;
#pragma unroll
                for (int bj = 0; bj < 2; ++bj) { const int col = c0 + 128 * bj;
                    f32x4 g0, g1; unpack8(*(const u32x4*)(gates + (size_t)row * 2048 + 1024 + col), g0, g1);
                    const f32x4 p0 = *(const f32x4*)(part + (size_t)row * D + col), p1 = *(const f32x4*)(part + (size_t)row * D + col + 4);
                    *(u32x4*)(merged + (size_t)row * D + col) = pack8(p0 + g0 * acc[ai][bj][m][0], p1 + g1 * acc[ai][bj][m][1]); }
            }
    }
};
struct EpiMergedCat {
    static constexpr bool MIDK = true;
    const bf16* gates; bf16* merged;
    __device__ __forceinline__ void mid(f32x4 (&acc)[2][2][4][2], const Unit& u, int wr, int wc, int fr, int fq_) const {
        int row0 = u.pm * 256 + wr * 64 + fr, c0 = u.pn * 256 + wc * 32 + 8 * fq_;
        asm volatile("" : "+v"(row0), "+v"(c0));
#pragma unroll
        for (int ai = 0; ai < 2; ++ai)
#pragma unroll
            for (int m = 0; m < 4; ++m) { const int row = row0 + ai * 128 + m * 16;
#pragma unroll
                for (int bj = 0; bj < 2; ++bj) { const int col = c0 + 128 * bj;
                    f32x4 a0, a1, b0, b1; unpack8(*(const u32x4*)(gates + (size_t)row * 2048 + col), a0, a1); unpack8(*(const u32x4*)(gates + (size_t)row * 2048 + 1024 + col), b0, b1);
#pragma unroll
                    for (int q = 0; q < 4; ++q) { acc[ai][bj][m][0][q] *= a0[q] * __builtin_amdgcn_rcpf(b0[q]); acc[ai][bj][m][1][q] *= a1[q] * __builtin_amdgcn_rcpf(b1[q]); } }
                asm volatile("" ::: "memory"); }
    }
    __device__ __forceinline__ void operator()(const f32x4 (&acc)[2][2][4][2], const Unit& u, int wr, int wc, int fr, int fq_) const {
        const int row0 = u.pm * 256 + wr * 64 + fr, c0 = u.pn * 256 + wc * 32 + 8 * fq_;
#pragma unroll
        for (int ai = 0; ai < 2; ++ai)
#pragma unroll
            for (int m = 0; m < 4; ++m) { const int row = row0 + ai * 128 + m * 16;
#pragma unroll
                for (int bj = 0; bj < 2; ++bj) { const int col = c0 + 128 * bj;
                    f32x4 b0, b1; unpack8(*(const u32x4*)(gates + (size_t)row * 2048 + 1024 + col), b0, b1);
                    *(u32x4*)(merged + (size_t)row * D + col) = pack8(b0 * acc[ai][bj][m][0], b1 * acc[ai][bj][m][1]); } }
    }
};
struct EpiOut {
    static constexpr bool MIDK = false;
    const float* x; float* x1; const float* mod; float* ssq1;
    __device__ __forceinline__ void operator()(const f32x4 (&acc)[2][2][4][2], const Unit& u, int wr, int wc, int fr, int fq_) const {
        const int row0 = u.pm * 256 + wr * 64 + fr, c0 = u.pn * 256 + wc * 32 + 8 * fq_;
        const float* gm = mod + (size_t)((u.pm * 256) / SEQ) * 6 * D + 2 * D;
        f32x4 g[2][2];
#pragma unroll
        for (int bj = 0; bj < 2; ++bj) { g[bj][0] = *(const f32x4*)(gm + c0 + 128 * bj); g[bj][1] = *(const f32x4*)(gm + c0 + 128 * bj + 4); }
#pragma unroll
        for (int ai = 0; ai < 2; ++ai)
#pragma unroll
            for (int m = 0; m < 4; ++m) { const int row = row0 + ai * 128 + m * 16; float sq = 0.f;
#pragma unroll
                for (int bj = 0; bj < 2; ++bj) { const int col = c0 + 128 * bj;
                    const f32x4 x0 = __builtin_nontemporal_load((const f32x4*)(x + (size_t)row * D + col)), x1v = __builtin_nontemporal_load((const f32x4*)(x + (size_t)row * D + col + 4));
                    const f32x4 r0 = x0 + g[bj][0] * acc[ai][bj][m][0], r1 = x1v + g[bj][1] * acc[ai][bj][m][1];
                    *(f32x4*)(x1 + (size_t)row * D + col) = r0; *(f32x4*)(x1 + (size_t)row * D + col + 4) = r1;
                    sq += (r0[0] * r0[0] + r0[1] * r0[1]) + (r0[2] * r0[2] + r0[3] * r0[3]) + (r1[0] * r1[0] + r1[1] * r1[1]) + (r1[2] * r1[2] + r1[3] * r1[3]); }
                sq += __shfl_xor(sq, 16); sq += __shfl_xor(sq, 32);
                if (fq_ == 0) ssq1[(size_t)row * 16 + 4 * u.pn + wc] = sq; }
    }
};
struct EpiHb {
    static constexpr bool MIDK = false;
    bf16* hb; float sc;
    __device__ __forceinline__ void operator()(const f32x4 (&acc)[2][2][4][2], const Unit& u, int wr, int wc, int fr, int fq_) const {
        const int row0 = u.pm * 256 + wr * 64 + fr, c0 = u.pn * 128 + wc * 32 + 8 * fq_;
#pragma unroll
        for (int ai = 0; ai < 2; ++ai)
#pragma unroll
            for (int m = 0; m < 4; ++m) { const int row = row0 + ai * 128 + m * 16;
                f32x4 h0, h1;
#pragma unroll
                for (int q = 0; q < 4; ++q) { h0[q] = siluf_(acc[ai][0][m][0][q] * sc) * (acc[ai][1][m][0][q] * sc); h1[q] = siluf_(acc[ai][0][m][1][q] * sc) * (acc[ai][1][m][1][q] * sc); }
                *(u32x4*)(hb + (size_t)row * DEXP + c0) = pack8(h0, h1); }
    }
};
struct EpiDown {
    static constexpr bool MIDK = false;
    bf16* Y; float* out; float* outw; const float* mod; const unsigned short* list; const unsigned char* eidx; const float* gatew;
    __device__ __forceinline__ void operator()(const f32x4 (&acc)[2][2][4][2], const Unit& u, int wr, int wc, int fr, int fq_) const {
        const int c0 = u.pn * 256 + wc * 32 + 8 * fq_;
#pragma unroll
        for (int ai = 0; ai < 2; ++ai)
#pragma unroll
            for (int m = 0; m < 4; ++m) {
                const int rl = wr * 64 + fr + ai * 128 + m * 16, idx = u.aux * 256 + rl;
                if (u.e == NEXP) {
                    const int t = idx; const float* gf = mod + (size_t)(t / SEQ) * 6 * D + 5 * D;
#pragma unroll
                    for (int bj = 0; bj < 2; ++bj) { const int col = c0 + 128 * bj; const float* o = out + (size_t)t * D + col; float* ow = outw + (size_t)t * D + col;
                        const f32x4 g0 = *(const f32x4*)(gf + col), g1 = *(const f32x4*)(gf + col + 4);
                        const f32x4 x0 = *(const f32x4*)o, x1v = *(const f32x4*)(o + 4);
                        *(f32x4*)ow = x0 + g0 * acc[ai][bj][m][0]; *(f32x4*)(ow + 4) = x1v + g1 * acc[ai][bj][m][1]; }
                } else if (idx < u.n) {
                    const int t = list[(size_t)u.e * LISTCAP + idx];
                    const u32x2 ev = *(const u32x2*)(eidx + (size_t)t * 8);
                    int k = 0;
#pragma unroll
                    for (int q = 1; q < TOPK; ++q) { const unsigned b = (q < 4) ? ((ev.x >> (8 * q)) & 0xffu) : ((ev.y >> (8 * (q - 4))) & 0xffu); if ((int)b == u.e) k = q; }
                    const float w = gatew[(size_t)t * 8 + k];
#pragma unroll
                    for (int bj = 0; bj < 2; ++bj) *(u32x4*)(Y + ((size_t)t * TOPK + k) * D + c0 + 128 * bj) = pack8(acc[ai][bj][m][0] * w, acc[ai][bj][m][1] * w);
                }
            }
    }
};

template <int NT, bool GATHER_>
struct MoeOrder {
    static constexpr bool GATHER = GATHER_;
    const char* A; const char* Bt; const char* Bsh; int K; size_t bstride;
    const unsigned short* list; volatile LAS int* tab;
    int G, c;
    __device__ bool next(int i, Unit& u) const {
        int ti, pn_;
        if ((G & 7) == 0) { const int x = c & 7, j = i * (G >> 3) + (c >> 3); ti = (j / NT) * 8 + x; pn_ = j % NT; if (ti >= tab[65]) return false; }
        else { const int total = tab[65] * NT; const long L = (long)i * G + c; if (L >= total) return false; ti = (int)L / NT; pn_ = (int)L % NT; }
        u.pn = pn_; u.pm = ti;
        const int e = __builtin_amdgcn_readfirstlane(tab[132 + ti]);
        u.e = e; u.aux = __builtin_amdgcn_readfirstlane(ti - tab[e]); u.n = __builtin_amdgcn_readfirstlane(tab[66 + e]); return true;
    }
    __device__ __forceinline__ const char* a_ptr(const Unit& u) const { return GATHER ? A : A + (size_t)u.pm * 256 * K * 2; }
    __device__ __forceinline__ const char* b_ptr(const Unit& u) const { return (u.e == NEXP ? Bsh : Bt + (size_t)u.e * bstride) + (size_t)u.pn * 256 * K * 2; }
    __device__ __forceinline__ unsigned a_row(const Unit& u, int r) const {
        if (!GATHER) return (unsigned)r;
        const int idx = u.aux * 256 + r;
        if (u.e == NEXP) return (unsigned)idx;
        return (idx < u.n) ? (unsigned)list[(size_t)u.e * LISTCAP + idx] : 0u;
    }
};

struct UpOrder {
    static constexpr bool GATHER = false;
    const char* Aq; const char* Bq; const char* Akv; const char* Bkv; int K; int G, c;
    __device__ bool next(int i, Unit& u) const {
        int L = i * G + c; if (L >= 448) return false;
        if (L < 256) { u.e = 1; u.pm = L >> 2; u.pn = L & 3; } else { L -= 256; u.e = 0; u.pm = L / 3; u.pn = L % 3; }
        u.aux = 0; u.n = 256; return true; }
    __device__ __forceinline__ const char* a_ptr(const Unit& u) const { return (u.e ? Akv : Aq) + (size_t)u.pm * 256 * K * 2; }
    __device__ __forceinline__ const char* b_ptr(const Unit& u) const { return (u.e ? Bkv : Bq) + (size_t)u.pn * 256 * K * 2; }
    __device__ __forceinline__ unsigned a_row(const Unit&, int r) const { return (unsigned)r; }
};
struct EpiUp {
    static constexpr bool MIDK = false;
    EpiQup q; EpiKVup kv;
    __device__ __forceinline__ void operator()(const f32x4 (&acc)[2][2][4][2], const Unit& u, int wr, int wc, int fr, int fq_) const { if (u.e) kv(acc, u, wr, wc, fr, fq_); else q(acc, u, wr, wc, fr, fq_); }
};

struct SharedDownOrder {
    static constexpr bool GATHER = false;
    const char* A; const char* Bt; int K; int G, c;
    __device__ bool next(int i, Unit& u) const { const int L = i * G + c; if (L >= (T / 256) * 4) return false; u.pm = L >> 2; u.pn = L & 3; u.e = NEXP; u.aux = L >> 2; u.n = 256; return true; }
    __device__ __forceinline__ const char* a_ptr(const Unit& u) const { return A + (size_t)u.pm * 256 * K * 2; }
    __device__ __forceinline__ const char* b_ptr(const Unit& u) const { return Bt + (size_t)u.pn * 256 * K * 2; }
    __device__ __forceinline__ unsigned a_row(const Unit&, int r) const { return (unsigned)r; }
};

namespace att {
constexpr int KSLOT = 12288, VSLOT = 8192;
constexpr int L_K = 0, L_V = 3 * KSLOT, L_F = L_V + 2 * VSLOT, L_WS = L_F + 3 * 256, L_OST = L_WS + 2048, L_END = L_OST + 8 * 4096;
static_assert(L_END <= RING_BYTES, "attention LDS");
__device__ __forceinline__ int crow(int r, int hi) { return (r & 3) + 8 * (r >> 2) + 4 * hi; }
__device__ __forceinline__ float max3f(float a, float b, float c) { return fmaxf(fmaxf(a, b), c); }
__device__ __forceinline__ float rowmax(const f32x16& p0, const f32x16& p1) {
    float a = max3f(p0[0], p0[1], p1[0]), b = max3f(p0[2], p0[3], p1[1]); a = max3f(a, p1[2], p1[3]);
#pragma unroll
    for (int r = 4; r < 16; r += 4) { a = max3f(a, p0[r], p0[r + 1]); b = max3f(b, p0[r + 2], p0[r + 3]); a = max3f(a, p1[r], p1[r + 1]); b = max3f(b, p1[r + 2], p1[r + 3]); }
    const float m = fmaxf(a, b);
    auto rr = __builtin_amdgcn_permlane32_swap(__float_as_uint(m), __float_as_uint(m), false, false);
    return fmaxf(__uint_as_float(rr[0]), __uint_as_float(rr[1]));
}
__device__ __forceinline__ void cmask(f32x16& p0, f32x16& p1, int jb, int qrel, int hi) {
    const float NEG = -INFINITY; const int kb = 64 * jb + 4 * hi;
#pragma unroll
    for (int r = 0; r < 16; ++r) { const int kv = kb + (r & 3) + 8 * (r >> 2); if (kv > qrel) p0[r] = NEG; if (kv + 32 > qrel) p1[r] = NEG; }
}
__device__ __forceinline__ void pv(f32x16* o, int vb, bf16x8 pa0, bf16x8 pa1, bf16x8 pa2, bf16x8 pa3) {
#pragma unroll
    for (int d0 = 0; d0 < 2; ++d0) { s16x4 lo[4], hi[4];
#pragma unroll
        for (int ks = 0; ks < 4; ++ks) {
            asm volatile("ds_read_b64_tr_b16 %0,%1 offset:%c2" : "=&v"(lo[ks]) : "v"(vb), "i"(d0 * 4096 + ks * 1024) : "memory");
            asm volatile("ds_read_b64_tr_b16 %0,%1 offset:%c2" : "=&v"(hi[ks]) : "v"(vb), "i"(d0 * 4096 + ks * 1024 + 512) : "memory"); }
        asm volatile("s_waitcnt lgkmcnt(0)" ::: "memory"); __builtin_amdgcn_sched_barrier(0);
#define PK(k) (bf16x8){lo[k][0], lo[k][1], lo[k][2], lo[k][3], hi[k][0], hi[k][1], hi[k][2], hi[k][3]}
        o[d0] = __builtin_amdgcn_mfma_f32_32x32x16_bf16(pa0, PK(0), o[d0], 0, 0, 0);
        o[d0] = __builtin_amdgcn_mfma_f32_32x32x16_bf16(pa1, PK(1), o[d0], 0, 0, 0);
        o[d0] = __builtin_amdgcn_mfma_f32_32x32x16_bf16(pa2, PK(2), o[d0], 0, 0, 0);
        o[d0] = __builtin_amdgcn_mfma_f32_32x32x16_bf16(pa3, PK(3), o[d0], 0, 0, 0);
#undef PK
    }
}
__device__ __forceinline__ unsigned cvtpk_s(float lo, float hi) { return cvt_pk_bf16(lo, hi); }

template <int DQK, bool DECAY, int THRL>
__device__ __forceinline__ void attn_unit(int b, int h, int qb, const bf16* Q, int QP, const bf16* Kn, const bf16* Kpe, const bf16* V, const float* cumF, bf16* O, int OP, LAS unsigned char* lds) {
    constexpr int ND0 = DQK / 16;
    int tid = threadIdx.x; asm volatile("" : "+v"(tid));
    const int lane = tid & 63, r32 = lane & 31, hi = lane >> 5; const int wid = __builtin_amdgcn_readfirstlane(tid >> 6);
    const long rowbase = (long)b * SEQ; const int q0 = qb * 256;
    const bf16* Qw = Q + (rowbase + q0 + wid * 32) * QP + h * DQK;
    const bf16* Kh = Kn + rowbase * 512 + h * 64; const bf16* Vh = V + rowbase * 512 + h * 64;
    const bf16* Kp = Kpe + rowbase * ROPE;
    const float* Fh = DECAY ? cumF + ((size_t)b * NHEAD + h) * SEQ : nullptr;
    LAS float* wsf = (LAS float*)(lds + L_WS) + wid * 64;
    const bf16* ksrc0 = Kh + (long)lane * 512 + wid * 8;
    const bf16* ksrc1 = Kp + (long)lane * ROPE + (wid & 3) * 8;
    const bf16* vsrc = Vh + (long)(16 * (wid & 3) + (lane >> 2)) * 512 + (wid >> 2) * 32 + (lane & 3) * 8;
    const int NT = (q0 + 256) / 64;
#define ATT_DMA_K(i_, s) do { const int t_ = NT - 1 - (i_); \
        __builtin_amdgcn_global_load_lds((const unsigned*)(ksrc0 + (long)t_ * 64 * 512), (LAS unsigned*)(lds + L_K + (s) * KSLOT + wid * 1024), 16, 0, 0); \
        if (DQK == 96 && wid < 4) __builtin_amdgcn_global_load_lds((const unsigned*)(ksrc1 + (long)t_ * 64 * ROPE), (LAS unsigned*)(lds + L_K + (s) * KSLOT + (8 + wid) * 1024), 16, 0, 0); \
        if (DECAY && wid == 7) __builtin_amdgcn_global_load_lds((const unsigned*)(Fh + t_ * 64 + lane), (LAS unsigned*)(lds + L_F + (s) * 256), 4, 0, 0); } while (0)
#define ATT_DMA_V(i_, s) do { const int t_ = NT - 1 - (i_); \
        __builtin_amdgcn_global_load_lds((const unsigned*)(vsrc + (long)t_ * 64 * 512), (LAS unsigned*)(lds + L_V + (s) * VSLOT + wid * 1024), 16, 0, 0); } while (0)
    ATT_DMA_K(0, 0); ATT_DMA_V(0, 0); ATT_DMA_K(1, 1);
    bf16x8 qr[ND0];
#pragma unroll
    for (int d0 = 0; d0 < ND0; ++d0) qr[d0] = *(const bf16x8*)(Qw + (long)r32 * QP + d0 * 16 + hi * 8);
    float fq_l = 0.f; if (DECAY) fq_l = Fh[q0 + wid * 32 + r32];
    float mhat = 0.f, l_reg = 0.f; bool started = false; f32x16 o[2]; o[0] = f32x16{}; o[1] = f32x16{};
    const int qrel = wid * 32 + r32;
    const int vb0 = (int)(uintptr_t)(lds + L_V) + ((lane >> 4) & 1) * 32 + (lane & 3) * 8 + (4 * hi + ((lane & 15) >> 2)) * 64;
#define ATT_QK(P0, P1, ks_) do { const float base_ = fq_l - mhat; \
        if (DECAY) { const LAS f32x4* fk_ = (const LAS f32x4*)(lds + L_F + (ks_) * 256); \
            _Pragma("unroll") for (int g = 0; g < 4; ++g) { const f32x4 a_ = fk_[2 * g + hi], c_ = fk_[8 + 2 * g + hi]; \
                _Pragma("unroll") for (int q = 0; q < 4; ++q) { P0[4 * g + q] = base_ - a_[q]; P1[4 * g + q] = base_ - c_[q]; } } } \
        else { _Pragma("unroll") for (int r = 0; r < 16; ++r) { P0[r] = base_; P1[r] = base_; } } \
        const LAS unsigned char* kb_ = lds + L_K + (ks_) * KSLOT + hi * 1024 + r32 * 16; \
        _Pragma("unroll") for (int d0 = 0; d0 < ND0; ++d0) { \
            const bf16x8 b0_ = *(const LAS bf16x8*)(kb_ + d0 * 2048), b1_ = *(const LAS bf16x8*)(kb_ + d0 * 2048 + 512); \
            P0 = __builtin_amdgcn_mfma_f32_32x32x16_bf16(b0_, qr[d0], P0, 0, 0, 0); P1 = __builtin_amdgcn_mfma_f32_32x32x16_bf16(b1_, qr[d0], P1, 0, 0, 0); } } while (0)
    f32x16 p0, p1, n0, n1;
    int ks_cur = 0, ks_nxt = 1, ks_ld = 2;
    for (int i = 0; i < NT; ++i) {
        const int vs = i & 1;
        VM_WAIT(); __syncthreads();
        if (i + 2 < NT) ATT_DMA_K(i + 2, ks_ld);
        if (i + 1 < NT) ATT_DMA_V(i + 1, vs ^ 1);
        if (i == 0) ATT_QK(p0, p1, 0);
        if (i + 1 < NT) ATT_QK(n0, n1, ks_nxt);
        const int jb = 3 - i;
        if (jb >= 0) cmask(p0, p1, jb, qrel, hi);
        const float rm = rowmax(p0, p1);
        bool resc = false; float dl = 0.f; const bool was_started = started;
        if (jb >= 0) {
            const bool fin = rm > -INFINITY;
            dl = started ? fmaxf(rm, 0.f) : (fin ? rm : 0.f); started = started || fin; resc = true;
        } else if (__any(rm > (float)THRL)) { dl = fmaxf(rm, 0.f); resc = true; }
        if (resc) { mhat += dl;
#pragma unroll
            for (int r = 0; r < 16; ++r) { p0[r] -= dl; p1[r] -= dl; }
            if (i + 1 < NT) {
#pragma unroll
                for (int r = 0; r < 16; ++r) { n0[r] -= dl; n1[r] -= dl; } }
            const float f = was_started ? __builtin_amdgcn_exp2f(-dl) : 1.f; l_reg *= f; if (hi == 0) wsf[r32] = f; }
        float sacc = 0.f;
#pragma unroll
        for (int r = 0; r < 16; ++r) { p0[r] = __builtin_amdgcn_exp2f(p0[r]); p1[r] = __builtin_amdgcn_exp2f(p1[r]); sacc += p0[r] + p1[r]; }
        l_reg += sacc;
        if (resc) { LDS_WAIT();
#pragma unroll
            for (int d_ = 0; d_ < 2; ++d_)
#pragma unroll
                for (int r = 0; r < 16; ++r) o[d_][r] *= wsf[crow(r, hi)]; }
        u32x4 pw0, pw1, pw2, pw3;
        pw0 = (u32x4){cvtpk_s(p0[0], p0[1]), cvtpk_s(p0[2], p0[3]), cvtpk_s(p0[4], p0[5]), cvtpk_s(p0[6], p0[7])};
        pw1 = (u32x4){cvtpk_s(p0[8], p0[9]), cvtpk_s(p0[10], p0[11]), cvtpk_s(p0[12], p0[13]), cvtpk_s(p0[14], p0[15])};
        pw2 = (u32x4){cvtpk_s(p1[0], p1[1]), cvtpk_s(p1[2], p1[3]), cvtpk_s(p1[4], p1[5]), cvtpk_s(p1[6], p1[7])};
        pw3 = (u32x4){cvtpk_s(p1[8], p1[9]), cvtpk_s(p1[10], p1[11]), cvtpk_s(p1[12], p1[13]), cvtpk_s(p1[14], p1[15])};
        __builtin_amdgcn_sched_barrier(0);
        pv(o, vb0 + vs * VSLOT, __builtin_bit_cast(bf16x8, pw0), __builtin_bit_cast(bf16x8, pw1), __builtin_bit_cast(bf16x8, pw2), __builtin_bit_cast(bf16x8, pw3));
        p0 = n0; p1 = n1;
        { const int t_ = ks_cur; ks_cur = ks_nxt; ks_nxt = ks_ld; ks_ld = t_; }
    }
    { auto rr = __builtin_amdgcn_permlane32_swap(__float_as_uint(l_reg), __float_as_uint(l_reg), false, false); l_reg = __uint_as_float(rr[0]) + __uint_as_float(rr[1]); }
    if (hi == 0) wsf[32 + r32] = l_reg; LDS_WAIT();
    float rli[16];
#pragma unroll
    for (int r = 0; r < 16; ++r) rli[r] = __builtin_amdgcn_rcpf(wsf[32 + crow(r, hi)]);
    bf16* Ow = O + (rowbase + q0 + wid * 32) * OP + h * 64;
    { LAS bf16* stg = (LAS bf16*)(lds + L_OST) + wid * 2048;
#pragma unroll
      for (int r = 0; r < 16; ++r) { const int orow = crow(r, hi);
#pragma unroll
          for (int d0 = 0; d0 < 2; ++d0) stg[orow * 64 + d0 * 32 + r32] = (bf16)f2bf(o[d0][r] * rli[r]); }
      LDS_WAIT();
#pragma unroll
      for (int i = 0; i < 4; ++i) { const int row = i * 8 + (lane >> 3), ch = lane & 7; const u32x4 v = *(const LAS u32x4*)(stg + row * 64 + ch * 8); *(u32x4*)(Ow + (long)row * OP + ch * 8) = v; } }
    LDS_WAIT(); __syncthreads();
#undef ATT_DMA_K
#undef ATT_DMA_V
#undef ATT_QK
}

constexpr int T_KSLOT = 12288, T_VSLOT = 8192, T_NSLOT = 3;
constexpr int T_K = 0, T_V = T_NSLOT * T_KSLOT, T_F = T_V + T_NSLOT * T_VSLOT, T_WS = T_F + T_NSLOT * 256, T_OST = T_WS + 2048, T_END = T_OST + 8 * 4096;
static_assert(T_END <= RING_BYTES, "attention LDS (hand-interleaved unit)");
typedef __attribute__((address_space(3))) const char* lds_cptr;
typedef short v4i16_t __attribute__((ext_vector_type(4)));
__device__ __forceinline__ s16x4 vtr(lds_cptr p) { return __builtin_bit_cast(s16x4, __builtin_amdgcn_ds_read_tr16_b64_v4i16((__attribute__((address_space(3))) v4i16_t*)p)); }
__device__ __forceinline__ void kload2(bf16x8* kf, lds_cptr kp, int j) { kf[2 * j] = *(const __attribute__((address_space(3))) bf16x8*)(kp + j * 2048); kf[2 * j + 1] = *(const __attribute__((address_space(3))) bf16x8*)(kp + j * 2048 + 512); }
#define TW_BAR(N) asm volatile("s_waitcnt vmcnt(" #N ") lgkmcnt(0)\n\ts_barrier" ::: "memory")
#define TSB() __builtin_amdgcn_sched_barrier(0)

template <int DQK, bool DECAY, int THRL>
__device__ __forceinline__ void attn_unit_t(int b, int h, int qb, const bf16* Q, int QP, const bf16* Kn, const bf16* Kpe, const bf16* V, const float* cumF, float kmax2, bf16* O, int OP, LAS unsigned char* lds) {
    constexpr int ND0 = DQK / 16;
    constexpr bool INPL = DECAY || (DQK == 96);
    int tid = threadIdx.x; asm volatile("" : "+v"(tid));
    const int lane = tid & 63, r32 = lane & 31, hi = lane >> 5; const int wid = __builtin_amdgcn_readfirstlane(tid >> 6);
    const long rowbase = (long)b * SEQ; const int q0 = qb * 256;
    const bf16* Qw = Q + (rowbase + q0 + wid * 32) * QP + h * DQK;
    const bf16* Kh = Kn + rowbase * 512 + h * 64; const bf16* Vh = V + rowbase * 512 + h * 64;
    const bf16* Kp = Kpe + rowbase * ROPE;
    const float* Fh = DECAY ? cumF + ((size_t)b * NHEAD + h) * SEQ : nullptr;
    LAS float* wsf = (LAS float*)(lds + T_WS) + wid * 64;
    const bf16* ksrc0 = Kh + (long)lane * 512 + wid * 8;
    const bf16* ksrc1 = Kp + (long)lane * ROPE + (wid & 3) * 8;
    const bf16* vsrc = Vh + (long)(16 * (wid & 3) + (lane >> 2)) * 512 + (wid >> 2) * 32 + (lane & 3) * 8;
    const int NTS = (q0 + 256) / 64;
#define TDMA_K(i_, sk) do { const int t_ = NTS - 1 - (i_); \
        __builtin_amdgcn_global_load_lds((const unsigned*)(ksrc0 + (long)t_ * 64 * 512), (LAS unsigned*)(lds + T_K + (sk) * T_KSLOT + wid * 1024), 16, 0, 0); \
        if (DECAY) __builtin_amdgcn_global_load_lds((const unsigned*)(Fh + t_ * 64 + lane), (LAS unsigned*)(lds + T_F + (sk) * 256), 4, 0, 0); \
        else __builtin_amdgcn_global_load_lds((const unsigned*)(ksrc1 + (long)t_ * 64 * ROPE), (LAS unsigned*)(lds + T_K + (sk) * T_KSLOT + (8 + (wid & 3)) * 1024), 16, 0, 0); } while (0)
#define TDMA_V(i_, sv) do { const int t_ = NTS - 1 - (i_); \
        __builtin_amdgcn_global_load_lds((const unsigned*)(vsrc + (long)t_ * 64 * 512), (LAS unsigned*)(lds + T_V + (sv) * T_VSLOT + wid * 1024), 16, 0, 0); } while (0)
    TDMA_K(0, 0); TDMA_V(0, 0); TDMA_K(1, 1);
    bf16x8 qr[ND0];
#pragma unroll
    for (int d0 = 0; d0 < ND0; ++d0) qr[d0] = *(const bf16x8*)(Qw + (long)r32 * QP + d0 * 16 + hi * 8);
    float fq_l = 0.f; if (DECAY) fq_l = Fh[q0 + wid * 32 + r32];
    float ftile = 0.f; if (DECAY) ftile = Fh[(lane < NTS ? lane : NTS - 1) * 64 + 63];
    float mhat = 0.f, l_reg = 0.f; f32x16 o[2]; o[0] = f32x16{}; o[1] = f32x16{};
    f32x16 negm = f32x16{}; asm volatile("" : "+v"(negm));
    const int qrel = wid * 32 + r32, i0 = 3 - (wid >> 1);
    const lds_cptr shm3 = (lds_cptr)lds; const lds_cptr kp0 = shm3 + T_K + hi * 1024 + r32 * 16;
    const lds_cptr vp0 = shm3 + T_V + ((lane >> 4) & 1) * 32 + (lane & 3) * 8 + (4 * hi + ((lane & 15) >> 2)) * 64;
    const int vb0 = (int)(uintptr_t)(lds + T_V) + ((lane >> 4) & 1) * 32 + (lane & 3) * 8 + (4 * hi + ((lane & 15) >> 2)) * 64;
    bool resc = false;
    bf16x8 kf[2 * ND0];
    f32x16 pA0, pA1, pB0, pB1;
    int sl_prev = 0, sl_cur = 0, sl_next = 1;
#define TROT() do { sl_prev = sl_cur; sl_cur = sl_next; sl_next = (sl_next == T_NSLOT - 1) ? 0 : sl_next + 1; } while (0)
#define TBIAS(X0, X1, fs_) do { if (DECAY) { const float base_ = fq_l - mhat; const LAS f32x4* fk_ = (const LAS f32x4*)(lds + T_F + (fs_) * 256); \
        _Pragma("unroll") for (int g = 0; g < 4; ++g) { const f32x4 a_ = fk_[2 * g + hi], c_ = fk_[8 + 2 * g + hi]; \
            _Pragma("unroll") for (int q = 0; q < 4; ++q) { X0[4 * g + q] = base_ - a_[q]; X1[4 * g + q] = base_ - c_[q]; } } } \
        else if (INPL) { const float nm_ = -mhat; _Pragma("unroll") for (int r = 0; r < 16; ++r) { X0[r] = nm_; X1[r] = nm_; } } } while (0)
#define TCIN(X) (INPL ? X : negm)
#define TRESC() do { if (resc) { asm volatile("s_waitcnt lgkmcnt(0)" ::: "memory"); \
        _Pragma("unroll") for (int d_ = 0; d_ < 2; ++d_) _Pragma("unroll") for (int r = 0; r < 16; ++r) o[d_][r] *= wsf[crow(r, hi)]; } } while (0)
#define TDECIDE(C0, C1, i_) do { \
        float a_ = max3f(C0[0], C0[1], C1[0]), b_ = max3f(C0[2], C0[3], C1[1]); a_ = max3f(a_, C1[2], C1[3]); \
        _Pragma("unroll") for (int r = 4; r < 16; r += 4) { a_ = max3f(a_, C0[r], C0[r + 1]); b_ = max3f(b_, C0[r + 2], C0[r + 3]); a_ = max3f(a_, C1[r], C1[r + 1]); b_ = max3f(b_, C1[r + 2], C1[r + 3]); } \
        float rm_ = fmaxf(a_, b_); { auto rr_ = __builtin_amdgcn_permlane32_swap(__float_as_uint(rm_), __float_as_uint(rm_), false, false); rm_ = fmaxf(__uint_as_float(rr_[0]), __uint_as_float(rr_[1])); } \
        resc = false; \
        if ((i_) == i0) { const float dl_ = rm_; mhat += dl_; \
            _Pragma("unroll") for (int r = 0; r < 16; ++r) { C0[r] -= dl_; C1[r] -= dl_; } \
            if (!INPL) { _Pragma("unroll") for (int r = 0; r < 16; ++r) negm[r] = -mhat; asm volatile("" : "+v"(negm)); } } \
        else if (__builtin_expect(__any(rm_ > (float)THRL), 0)) { const float dl_ = fmaxf(rm_, 0.f); mhat += dl_; \
            _Pragma("unroll") for (int r = 0; r < 16; ++r) { C0[r] -= dl_; C1[r] -= dl_; } \
            if (!INPL) { _Pragma("unroll") for (int r = 0; r < 16; ++r) negm[r] = -mhat; asm volatile("" : "+v"(negm)); } \
            const float f_ = __builtin_amdgcn_exp2f(-dl_); l_reg *= f_; if (hi == 0) wsf[r32] = f_; resc = true; } } while (0)
    TDMA_K(2, 2);
    TW_BAR(5);
    int NT = NTS;
    if (DECAY) {
        const float bound = 2.f * __builtin_sqrtf(kmax2) * 1.0001f + 1.f + (Fh[q0] - ftile);
        const unsigned long long need = __ballot(lane < NTS && bound >= -160.f);
        const int tmin = need ? (int)__builtin_ctzll(need) : NTS - 1;
        NT = NTS - tmin; NT += NT & 1; if (NT < 8) NT = 8; if (NT > NTS) NT = NTS;
        NT = __builtin_amdgcn_readfirstlane(NT); }
    TBIAS(pA0, pA1, 0);
    { const lds_cptr kb = kp0;
#pragma unroll
      for (int d0 = 0; d0 < ND0; ++d0) { const bf16x8 b0 = *(const __attribute__((address_space(3))) bf16x8*)(kb + d0 * 2048), b1 = *(const __attribute__((address_space(3))) bf16x8*)(kb + d0 * 2048 + 512);
          if (d0 == 0) { pA0 = __builtin_amdgcn_mfma_f32_32x32x16_bf16(b0, qr[0], TCIN(pA0), 0, 0, 0); pA1 = __builtin_amdgcn_mfma_f32_32x32x16_bf16(b1, qr[0], TCIN(pA1), 0, 0, 0); }
          else { pA0 = __builtin_amdgcn_mfma_f32_32x32x16_bf16(b0, qr[d0], pA0, 0, 0, 0); pA1 = __builtin_amdgcn_mfma_f32_32x32x16_bf16(b1, qr[d0], pA1, 0, 0, 0); } } }
    cmask(pA0, pA1, 3, qrel, hi);
    TDECIDE(pA0, pA1, 0);
#pragma unroll
    for (int r = 0; r < 16; ++r) { pA0[r] = __builtin_amdgcn_exp2f(pA0[r]); pA1[r] = __builtin_amdgcn_exp2f(pA1[r]); }
    TW_BAR(0);
    TDMA_K(3, 0); TDMA_V(1, 1);
    TROT();
#pragma unroll
    for (int j = 0; j < ND0; ++j) kload2(kf, kp0 + sl_cur * T_KSLOT, j);
    TBIAS(pB0, pB1, sl_cur);
    TW_BAR(3);
    s16x4 vlo[8], vhi[8]; u32x4 pw0, pw1, pw2, pw3;
#define TPKW(P, B) cvt_pk_bf16(P[B], P[B + 1])
#define TPAF(k) __builtin_bit_cast(bf16x8, pw##k)
#define TVFR(i) (bf16x8){vlo[i][0], vlo[i][1], vlo[i][2], vlo[i][3], vhi[i][0], vhi[i][1], vhi[i][2], vhi[i][3]}
#define TPIN(x) asm volatile("" : "+v"(x))
#define TGAPA(MF, A0, A1, A2, A3, W0, W1, PW) do { MF; sacc += A0; sacc += A1; sacc += A2; sacc += A3; TPIN(sacc); W0; W1; TPIN(PW); TSB(); } while (0)
#define TEX(v) __builtin_amdgcn_exp2f(v)
#define TGAPB(MF, X, B) do { MF; X[B] = TEX(X[B]); X[B + 1] = TEX(X[B + 1]); X[B + 2] = TEX(X[B + 2]); X[B + 3] = TEX(X[B + 3]); TPIN(X); TSB(); } while (0)
#define TVRD(i) do { vlo[i] = vtr(vp_ + (((i) >> 2) * 4096 + ((i) & 3) * 1024)); vhi[i] = vtr(vp_ + (((i) >> 2) * 4096 + ((i) & 3) * 1024 + 512)); } while (0)
#define TKRD(G, j) do { if (G) { kload2(kf, kp0 + sl_next * T_KSLOT, j); TSB(); } } while (0)
#define TMF(a, b, c) __builtin_amdgcn_mfma_f32_32x32x16_bf16(a, b, c, 0, 0, 0)
#define TSTEP(C0, C1, P0, P1, i_, MJB, GK, GV, GL) do { TSB(); \
        const lds_cptr vp_ = vp0 + sl_prev * T_VSLOT; \
        TVRD(0); TSB(); float sacc = (P0[0] + P0[1]); \
        TGAPA(C0 = TMF(kf[0], qr[0], TCIN(C0)), P0[2], P0[3], P0[4], P0[5],     pw0[0] = TPKW(P0, 0), pw0[1] = TPKW(P0, 2), pw0); \
        TVRD(4); TSB(); TGAPA(C1 = TMF(kf[1], qr[0], TCIN(C1)), P0[6], P0[7], P0[8], P0[9],     pw0[2] = TPKW(P0, 4), pw0[3] = TPKW(P0, 6), pw0); \
        TVRD(1); TSB(); TGAPA(C0 = TMF(kf[2], qr[1], C0),   P0[10], P0[11], P0[12], P0[13], pw1[0] = TPKW(P0, 8), pw1[1] = TPKW(P0, 10), pw1); \
        TVRD(5); TSB(); TGAPA(C1 = TMF(kf[3], qr[1], C1),   P0[14], P0[15], P1[0], P1[1],   pw1[2] = TPKW(P0, 12), pw1[3] = TPKW(P0, 14), pw1); \
        TVRD(2); TSB(); TGAPA(C0 = TMF(kf[4], qr[2], C0),   P1[2], P1[3], P1[4], P1[5],     pw2[0] = TPKW(P1, 0), pw2[1] = TPKW(P1, 2), pw2); \
        TVRD(6); TSB(); TGAPA(C1 = TMF(kf[5], qr[2], C1),   P1[6], P1[7], P1[8], P1[9],     pw2[2] = TPKW(P1, 4), pw2[3] = TPKW(P1, 6), pw2); \
        TVRD(3); TSB(); TGAPA(C0 = TMF(kf[6], qr[3], C0),   P1[10], P1[11], P1[12], P1[13], pw3[0] = TPKW(P1, 8), pw3[1] = TPKW(P1, 10), pw3); \
        TVRD(7); TSB(); TGAPA(C1 = TMF(kf[7], qr[3], C1),   P1[14], P1[15], 0.f, 0.f,       pw3[2] = TPKW(P1, 12), pw3[3] = TPKW(P1, 14), pw3); \
        if (ND0 == 6) { C0 = TMF(kf[2 * ND0 - 4], qr[ND0 - 2], C0); C1 = TMF(kf[2 * ND0 - 3], qr[ND0 - 2], C1); C0 = TMF(kf[2 * ND0 - 2], qr[ND0 - 1], C0); C1 = TMF(kf[2 * ND0 - 1], qr[ND0 - 1], C1); TSB(); } \
        l_reg += sacc; \
        if (GK) { TDMA_K((i_) + 3, sl_cur); } if (GV) { TDMA_V((i_) + 1, sl_next); } \
        if ((MJB) >= 0) cmask(C0, C1, (MJB), qrel, hi); \
        TDECIDE(C0, C1, i_); \
        TSB(); \
        TGAPB(o[0] = TMF(TPAF(0), TVFR(0), o[0]), C0, 0); \
        TKRD(GL, 0); TGAPB(o[1] = TMF(TPAF(0), TVFR(4), o[1]), C0, 4); \
        TKRD(GL, 1); TGAPB(o[0] = TMF(TPAF(1), TVFR(1), o[0]), C0, 8); \
        TKRD(GL, 2); TGAPB(o[1] = TMF(TPAF(1), TVFR(5), o[1]), C0, 12); \
        TKRD(GL, 3); TGAPB(o[0] = TMF(TPAF(2), TVFR(2), o[0]), C1, 0); \
        if (ND0 == 6) { TKRD(GL, ND0 - 2); } TGAPB(o[1] = TMF(TPAF(2), TVFR(6), o[1]), C1, 4); \
        if (ND0 == 6) { TKRD(GL, ND0 - 1); } TGAPB(o[0] = TMF(TPAF(3), TVFR(3), o[0]), C1, 8); \
        TGAPB(o[1] = TMF(TPAF(3), TVFR(7), o[1]), C1, 12); \
        if (GL) { TBIAS(P0, P1, sl_next); } \
    } while (0)
#define TENDW(tt) do { if ((tt) + 3 < NT) { TW_BAR(3); } else if ((tt) + 2 < NT) { TW_BAR(1); } else { TW_BAR(0); } } while (0)
    TSTEP(pB0, pB1, pA0, pA1, 1, 2, (1 + 3 < NT), true, true); TENDW(1); TRESC(); TROT();
    TSTEP(pA0, pA1, pB0, pB1, 2, 1, (2 + 3 < NT), true, true); TENDW(2); TRESC(); TROT();
    {
        TSTEP(pB0, pB1, pA0, pA1, 3, 0, (3 + 3 < NT), true, true); TENDW(3); TRESC(); TROT();
        int i = 4;
        for (; i + 2 < NT; i += 2) {
            TSTEP(pA0, pA1, pB0, pB1, i, -1, (i + 3 < NT), true, true);                         TENDW(i);     TRESC(); TROT();
            TSTEP(pB0, pB1, pA0, pA1, i + 1, -1, (i + 4 < NT), (i + 2 < NT), (i + 2 < NT));     TENDW(i + 1); TRESC(); TROT();
        }
        TSTEP(pA0, pA1, pB0, pB1, NT - 2, -1, false, true, true); TENDW(NT - 2); TRESC(); TROT();
        TSTEP(pB0, pB1, pA0, pA1, NT - 1, -1, false, false, false); TRESC();
    }
    { float sacc = pB0[0] + pB0[1];
#pragma unroll
      for (int r = 2; r < 16; ++r) sacc += pB0[r];
#pragma unroll
      for (int r = 0; r < 16; ++r) sacc += pB1[r];
      l_reg += sacc;
      pw0 = (u32x4){TPKW(pB0, 0), TPKW(pB0, 2), TPKW(pB0, 4), TPKW(pB0, 6)}; pw1 = (u32x4){TPKW(pB0, 8), TPKW(pB0, 10), TPKW(pB0, 12), TPKW(pB0, 14)};
      pw2 = (u32x4){TPKW(pB1, 0), TPKW(pB1, 2), TPKW(pB1, 4), TPKW(pB1, 6)}; pw3 = (u32x4){TPKW(pB1, 8), TPKW(pB1, 10), TPKW(pB1, 12), TPKW(pB1, 14)};
      TSB(); pv(o, vb0 + sl_cur * T_VSLOT, TPAF(0), TPAF(1), TPAF(2), TPAF(3)); }
    { auto rr = __builtin_amdgcn_permlane32_swap(__float_as_uint(l_reg), __float_as_uint(l_reg), false, false); l_reg = __uint_as_float(rr[0]) + __uint_as_float(rr[1]); }
    if (hi == 0) wsf[32 + r32] = l_reg; asm volatile("s_waitcnt lgkmcnt(0)" ::: "memory");
    float rli[16];
#pragma unroll
    for (int r = 0; r < 16; ++r) rli[r] = __builtin_amdgcn_rcpf(wsf[32 + crow(r, hi)]);
    bf16* Ow = O + (rowbase + q0 + wid * 32) * OP + h * 64;
    { LAS bf16* stg = (LAS bf16*)(lds + T_OST) + wid * 2048;
#pragma unroll
      for (int r = 0; r < 16; ++r) { const int orow = crow(r, hi);
#pragma unroll
          for (int d0 = 0; d0 < 2; ++d0) stg[orow * 64 + d0 * 32 + r32] = (bf16)f2bf(o[d0][r] * rli[r]); }
      asm volatile("s_waitcnt lgkmcnt(0)" ::: "memory");
#pragma unroll
      for (int i = 0; i < 4; ++i) { const int row = i * 8 + (lane >> 3), ch = lane & 7; const u32x4 v = *(const LAS u32x4*)(stg + row * 64 + ch * 8); *(u32x4*)(Ow + (long)row * OP + ch * 8) = v; } }
    asm volatile("s_waitcnt lgkmcnt(0)\n\ts_barrier" ::: "memory");
#undef TDMA_K
#undef TDMA_V
#undef TROT
#undef TBIAS
#undef TCIN
#undef TRESC
#undef TDECIDE
#undef TPKW
#undef TPAF
#undef TVFR
#undef TPIN
#undef TGAPA
#undef TEX
#undef TGAPB
#undef TVRD
#undef TKRD
#undef TMF
#undef TSTEP
#undef TENDW
}
#undef TW_BAR
#undef TSB
}

namespace dn {
constexpr int CHB = 64 * 256 * 2;
__device__ __forceinline__ int nloc(int i) { return 16 * ((i >> 2) & 1) + (i & 3) + 4 * (i >> 3); }
template <bool NOTRAFFIC>
__device__ __forceinline__ void down_phase(LAS unsigned char* lds, const bf16* HBp, const bf16* Wd, const bf16* Wsd, volatile LAS int* tab, const u32x2* meta, unsigned char* Yp, unsigned char* trash, int G, int c) {
    int tid = threadIdx.x; asm volatile("" : "+v"(tid));
    const int wid = __builtin_amdgcn_readfirstlane(tid >> 6), lane = tid & 63, j = lane & 31, hi = lane >> 5;
    const int U = tab[65] * 8;
    const int u_lo = (int)(((long)c * U) / G), u_hi = (int)(((long)(c + 1) * U) / G);
    if (u_lo >= u_hi) return;
#define DN_DEC(u_, e_, hf_, ci_) do { e_ = __builtin_amdgcn_readfirstlane(tab[132 + ((u_) >> 3)]); const int ul_ = __builtin_amdgcn_readfirstlane((u_) - 8 * tab[e_]), nc_ = __builtin_amdgcn_readfirstlane(4 * (tab[e_ + 1] - tab[e_])); hf_ = (ul_ >= nc_) ? 1 : 0; ci_ = ul_ - hf_ * nc_; } while (0)
    unsigned dvo;
    { const int r_ = lane >> 3; dvo = (unsigned)(r_ * DEXP + (((lane & 7) ^ ((r_ >> 1) & 7)) * 8)) * 2u; }
#define DN_DMA(u_, buf_) do { int e__, hf__, ci__; DN_DEC(u_, e__, hf__, ci__); (void)hf__; const bf16* gb_ = HBp + ((size_t)tab[e__] * 256 + (size_t)ci__ * 64) * DEXP; \
        _Pragma("unroll") for (int i_ = 0; i_ < 4; ++i_) { const int q_ = wid * 4 + i_, kb_ = q_ >> 3, g_ = q_ & 7; \
            __builtin_amdgcn_global_load_lds((const unsigned*)((const char*)(gb_ + (size_t)(8 * g_) * DEXP + kb_ * 64) + ((g_ & 1) ? (dvo ^ 64u) : dvo)), (LAS unsigned*)(lds + (buf_) * CHB + kb_ * 8192 + g_ * 1024), 16, 0, 0); } } while (0)
    int rowb[2], fx[2];
#pragma unroll
    for (int rt = 0; rt < 2; ++rt) { const int row = 32 * rt + j, f = (row >> 1) & 7;
        rowb[rt] = (int)(uintptr_t)lds + row * 128 + ((hi ^ (f & 1)) * 16); fx[rt] = (f & 6) * 16; }
    DN_DMA(u_lo, 0); if (u_lo + 1 < u_hi) DN_DMA(u_lo + 1, 1); else DN_DMA(u_lo, 1); if (u_lo + 2 < u_hi) DN_DMA(u_lo + 2, 2); else DN_DMA(u_lo, 2);
    int u = u_lo;
    while (u < u_hi) {
      int e, hf, ci0; DN_DEC(u, e, hf, ci0);
      const int nc = __builtin_amdgcn_readfirstlane(4 * (tab[e + 1] - tab[e])), ne = __builtin_amdgcn_readfirstlane(tab[66 + e]);
      int seg_end = 8 * tab[e] + (hf + 1) * nc; seg_end = __builtin_amdgcn_readfirstlane(seg_end < u_hi ? seg_end : u_hi);
      bf16x8 wfr[2][16];
#pragma unroll
      for (int nt = 0; nt < 2; ++nt) { const bf16* wp = ((e == NEXP) ? Wsd : Wd + (size_t)e * D * DEXP) + (size_t)(512 * hf + 64 * wid + 32 * nt + nloc(j)) * DEXP + 8 * hi;
#pragma unroll
          for (int ks = 0; ks < 16; ++ks) wfr[nt][ks] = *(const bf16x8*)(wp + 16 * ks); }
      bool first = true;
      for (; u < seg_end; ++u) {
        const int buf = (u - u_lo) & 3; (void)ci0;
        const int cidx = __builtin_amdgcn_readfirstlane((u - 8 * tab[e]) - hf * nc);
        u32x2 mt[2];
#pragma unroll
        for (int rt = 0; rt < 2; ++rt) { int pos = 64 * cidx + 32 * rt + j; const bool in = pos < ne; const int sp = pos; pos = (in && e != NEXP) ? pos : 0; const u32x2 m = meta[(size_t)(e == NEXP ? 0 : e) * LISTCAP + pos];
            mt[rt] = !in ? (u32x2){0xffffffffu, 0u} : (e == NEXP) ? (u32x2){(unsigned)(sp * (TOPK + 1) + TOPK), 0x3f800000u} : m; }
        if (first) { __builtin_amdgcn_s_waitcnt(0x0F70); first = false; }
        else { asm volatile("s_waitcnt vmcnt(26)" ::: "memory"); }
        LDS_WAIT(); __builtin_amdgcn_s_barrier();
        { const int un = (u + 3 < u_hi) ? u + 3 : u; DN_DMA(un, (buf + 3) & 3); }
        f32x16 acc[2][2];
#pragma unroll
        for (int rt = 0; rt < 2; ++rt)
#pragma unroll
            for (int nt = 0; nt < 2; ++nt) acc[rt][nt] = f32x16{};
#define DN_RD(dst, ks_) do { _Pragma("unroll") for (int rt = 0; rt < 2; ++rt) \
            asm volatile("ds_read_b128 %0, %1 offset:%c2" : "=&v"(dst[rt]) : "v"(rowb[rt] + ((32 * ((ks_) & 3)) ^ fx[rt]) + buf * CHB), "i"(((ks_) >> 2) * 8192) : "memory"); } while (0)
#define DN_WAIT(n_, x_) asm volatile("s_waitcnt lgkmcnt(" #n_ ")" : "+v"(x_[0]), "+v"(x_[1]) :: "memory")
        bf16x8 hfa[2], hfb[2];
        DN_RD(hfa, 0);
#pragma unroll
        for (int ks = 0; ks < 16; ks += 2) {
            DN_RD(hfb, ks + 1);
            DN_WAIT(2, hfa);
#pragma unroll
            for (int rt = 0; rt < 2; ++rt)
#pragma unroll
                for (int nt = 0; nt < 2; ++nt) acc[rt][nt] = __builtin_amdgcn_mfma_f32_32x32x16_bf16(wfr[nt][ks], hfa[rt], acc[rt][nt], 0, 0, 0);
            __builtin_amdgcn_sched_barrier(0);
            if (ks + 2 < 16) { DN_RD(hfa, ks + 2); DN_WAIT(2, hfb); } else { DN_WAIT(0, hfb); }
#pragma unroll
            for (int rt = 0; rt < 2; ++rt)
#pragma unroll
                for (int nt = 0; nt < 2; ++nt) acc[rt][nt] = __builtin_amdgcn_mfma_f32_32x32x16_bf16(wfr[nt][ks + 1], hfb[rt], acc[rt][nt], 0, 0, 0);
            __builtin_amdgcn_sched_barrier(0);
        }
#undef DN_RD
#undef DN_WAIT
        const int col0 = 512 * hf + 64 * wid + 16 * hi;
#pragma unroll
        for (int rt = 0; rt < 2; ++rt) { const bool ok = !NOTRAFFIC && mt[rt].x != 0xffffffffu; unsigned char* yd = ok ? Yp + (size_t)mt[rt].x * D : trash; const float w = ok ? __uint_as_float(mt[rt].y) : 0.f;
#pragma unroll
            for (int nt = 0; nt < 2; ++nt) { u32x4 o;
#pragma unroll
                for (int q = 0; q < 4; ++q) { int v = __builtin_amdgcn_cvt_pk_fp8_f32(acc[rt][nt][4 * q] * w, acc[rt][nt][4 * q + 1] * w, 0, false);
                    v = __builtin_amdgcn_cvt_pk_fp8_f32(acc[rt][nt][4 * q + 2] * w, acc[rt][nt][4 * q + 3] * w, v, true); o[q] = (unsigned)v; }
                *(u32x4*)(yd + col0 + 32 * nt) = o; } }
      }
    }
    VM_WAIT(); LDS_WAIT(); __builtin_amdgcn_s_barrier();
#undef DN_DMA
#undef DN_DEC
}
}

#define XB_TMO      128
#define XB_XCNT(j)  (256  + 64 * (j))
#define XB_XSUB(j)  (1280 + 64 * (j))
#define XB_XGEN(j)  (2304 + 64 * (j))
#define XB_TOP      3328
#define XB_TOPGEN   3392
#define XCD_BAR_WORDS 3456
#define XB_SPIN_CAP (1u << 18)
__device__ __forceinline__ unsigned xb_ld(unsigned* p)              { return __hip_atomic_load(p, __ATOMIC_RELAXED, __HIP_MEMORY_SCOPE_AGENT); }
__device__ __forceinline__ unsigned xb_add(unsigned* p, unsigned v) { return __hip_atomic_fetch_add(p, v, __ATOMIC_RELAXED, __HIP_MEMORY_SCOPE_AGENT); }
__device__ __forceinline__ unsigned xb_xcc_id() { return (unsigned)__builtin_amdgcn_s_getreg((3 << 11) | 20) & 0xFu; }
#define XB_SPIN(cond, bar) do { unsigned _sp = 0; while (cond) { __builtin_amdgcn_s_sleep(1); \
    if ((++_sp & 255u) == 0u) { if (xb_ld(&(bar)[XB_TMO])) break; if (_sp > XB_SPIN_CAP) { atomicAdd(&(bar)[XB_TMO], 1u); break; } } } } while (0)
struct XcdBarrier { unsigned* bar; unsigned x; volatile LAS unsigned* st; };
__device__ __forceinline__ XcdBarrier xcd_barrier_post(unsigned* bar, volatile LAS unsigned* st) {
    XcdBarrier b; b.bar = bar; b.x = xb_xcc_id(); b.st = st;
    if (threadIdx.x == 0) (void)xb_add(&bar[XB_XCNT(b.x)], 1u);
    return b;
}
__device__ __forceinline__ void xcd_barrier_complete(unsigned* bar, unsigned x, unsigned& nloc, unsigned& nx) {
    const unsigned G = gridDim.x * gridDim.y * gridDim.z;
    unsigned sum, cnt, mine, sp = 0u;
    for (;;) {
        sum = 0u; cnt = 0u; mine = 0u;
#pragma unroll
        for (unsigned j = 0; j < 16; ++j) { const unsigned c = xb_ld(&bar[XB_XCNT(j)]); sum += c; cnt += (c > 0u) ? 1u : 0u; mine = (j == x) ? c : mine; }
        if (sum == G) break;
        __builtin_amdgcn_s_sleep(1);
        if ((++sp & 255u) == 0u) { if (xb_ld(&bar[XB_TMO])) break; if (sp > XB_SPIN_CAP) { atomicAdd(&bar[XB_TMO], 1u); break; } }
    }
    nloc = mine > 0u ? mine : 1u; nx = cnt > 0u ? cnt : 1u;
}
__device__ __forceinline__ void xcd_barrier(const XcdBarrier& b) {
    asm volatile("s_waitcnt vmcnt(0)" ::: "memory");
    __syncthreads();
    if (threadIdx.x == 0) {
        unsigned* bar = b.bar;
        __builtin_amdgcn_s_waitcnt(0);
        unsigned nloc = b.st[0], nx = b.st[1];
        if (nloc == 0u) { xcd_barrier_complete(bar, b.x, nloc, nx); b.st[0] = nloc; b.st[1] = nx; }
        const unsigned old = xb_add(&bar[XB_XSUB(b.x)], 1u);
        const unsigned gen = old / nloc;
        if (old + 1u == (gen + 1u) * nloc) {
            __builtin_amdgcn_fence(__ATOMIC_RELEASE, "agent");
            asm volatile("s_waitcnt vmcnt(0)" ::: "memory");
            const unsigned og = xb_add(&bar[XB_TOP], 1u);
            const unsigned tg = og / nx;
            if (og + 1u == (tg + 1u) * nx) xb_add(&bar[XB_TOPGEN], 1u);
            else XB_SPIN(xb_ld(&bar[XB_TOPGEN]) == tg, bar);
            __builtin_amdgcn_fence(__ATOMIC_ACQUIRE, "agent");
            xb_add(&bar[XB_XGEN(b.x)], 1u);
            asm volatile("s_waitcnt vmcnt(0)" ::: "memory");
        } else {
            XB_SPIN(xb_ld(&bar[XB_XGEN(b.x)]) == gen, bar);
            __builtin_amdgcn_fence(__ATOMIC_ACQUIRE, "agent");
            asm volatile("s_waitcnt vmcnt(0)" ::: "memory");
        }
    }
    __syncthreads();
}

struct Args { const void* in[25]; float* out; unsigned char* ws; int ph_lo, ph_hi; };

struct Frame {
    LAS unsigned char* lds;
    int tid, lane, wave, vcu, G;
};

template <class ColFn>
__device__ __forceinline__ void cvt_item(int ldw, int Ksrc, const float* kscale, bf16* WT, int Kd, LAS float* scr, int kb, int nb, int lane, ColFn colp) {
    const int k0 = 64 * kb, n0 = 32 * nb;
    const float* cp = colp(n0 + (lane & 31));
    float vv[32], sv[32];
#pragma unroll
    for (int i = 0; i < 32; ++i) { const int k = k0 + 2 * i + (lane >> 5);
        vv[i] = (cp != nullptr && k < Ksrc) ? cp[(size_t)k * ldw] : 0.f;
        sv[i] = (kscale != nullptr && k < Ksrc) ? kscale[k] : 1.f; }
#pragma unroll
    for (int i = 0; i < 32; ++i) scr[(2 * i + (lane >> 5)) * 33 + (lane & 31)] = vv[i] * sv[i];
    LDS_WAIT(); asm volatile("" ::: "memory");
    const int c = lane & 7;
#pragma unroll
    for (int j = 0; j < 4; ++j) { const int n = (lane >> 3) + 8 * j; const LAS float* s = scr + (8 * c) * 33 + n;
        u32x4 o; o.x = pk2(s[0 * 33], s[1 * 33]); o.y = pk2(s[2 * 33], s[3 * 33]); o.z = pk2(s[4 * 33], s[5 * 33]); o.w = pk2(s[6 * 33], s[7 * 33]);
        *(u32x4*)(WT + (size_t)(n0 + n) * Kd + k0 + 8 * c) = o; }
    LDS_WAIT(); asm volatile("" ::: "memory");
}
__device__ __forceinline__ void cvt64_item(const float* src, int ldw, bf16* dst, int Kd, LAS unsigned char* scr, int lane) {
    f32x4 v[16];
    const float* sp = src + (size_t)(lane >> 4) * ldw + 4 * (lane & 15);
#pragma unroll
    for (int i = 0; i < 16; ++i) v[i] = __builtin_nontemporal_load((const f32x4*)(sp + (size_t)(4 * i) * ldw));
#pragma unroll
    for (int i = 0; i < 16; ++i) { const int k = 4 * i + (lane >> 4);
#pragma unroll
        for (int q = 0; q < 4; ++q) { const int n = 4 * (lane & 15) + q; *(LAS bf16*)(scr + n * 128 + (((k >> 3) ^ ((n >> 2) & 7)) << 4) + (k & 7) * 2) = (bf16)f2bf(v[i][q]); } }
    LDS_WAIT(); asm volatile("" ::: "memory");
#pragma unroll
    for (int j = 0; j < 8; ++j) { const int p = j * 64 + lane, n = p >> 3, c = p & 7;
        const u32x4 o = *(const LAS u32x4*)(scr + n * 128 + ((c ^ ((n >> 2) & 7)) << 4));
        __builtin_nontemporal_store(o, (u32x4*)(dst + (size_t)n * Kd + c * 8)); }
    LDS_WAIT(); asm volatile("" ::: "memory");
}
__device__ __forceinline__ void cvt64_item8(const float* src, int ldw, unsigned char* dst, int Kd8, LAS unsigned char* scr, int lane, float scale) {
    f32x4 v[16];
    const float* sp = src + (size_t)(lane >> 4) * ldw + 4 * (lane & 15);
#pragma unroll
    for (int i = 0; i < 16; ++i) v[i] = __builtin_nontemporal_load((const f32x4*)(sp + (size_t)(4 * i) * ldw));
#pragma unroll
    for (int i = 0; i < 16; ++i) { const int k = 4 * i + (lane >> 4);
#pragma unroll
        for (int q = 0; q < 4; q += 2) { const unsigned pk = (unsigned)__builtin_amdgcn_cvt_pk_fp8_f32(v[i][q] * scale, v[i][q + 1] * scale, 0, false);
#pragma unroll
            for (int h2 = 0; h2 < 2; ++h2) { const int n = 4 * (lane & 15) + q + h2; *(LAS unsigned char*)(scr + n * 64 + (((k >> 4) ^ ((n >> 2) & 3)) << 4) + (k & 15)) = (unsigned char)(h2 ? (pk >> 8) : pk); } } }
    LDS_WAIT(); asm volatile("" ::: "memory");
#pragma unroll
    for (int j = 0; j < 4; ++j) { const int p = j * 64 + lane, n = p >> 2, c = p & 3;
        const u32x4 o = *(const LAS u32x4*)(scr + n * 64 + ((c ^ ((n >> 2) & 3)) << 4));
        __builtin_nontemporal_store(o, (u32x4*)(dst + (size_t)n * Kd8 + c * 16)); }
    LDS_WAIT(); asm volatile("" ::: "memory");
}
__device__ __forceinline__ int ropedim(int jj) { const int g = jj >> 3, u = jj & 7; return (u < 4) ? 4 * g + u : 16 + 4 * g + (u - 4); }

__device__ __forceinline__ void sincos_acc(float af, float& sn, float& cs) {
    const double a = (double)af; const double kq = __builtin_rint(a * 0.63661977236758134308);
    const double r = (a - kq * 1.57079632679489655800) - kq * 6.123233995736766036e-17;
    const double r2 = r * r;
    const double sp = r * (1.0 + r2 * (-1.66666666666666324348e-01 + r2 * (8.33333333332248946124e-03 + r2 * (-1.98412698298579493134e-04 + r2 * (2.75573137070700676789e-06 + r2 * (-2.50507602534068634195e-08 + r2 * 1.58969099521155010221e-10))))));
    const double cp = 1.0 + r2 * (-0.5 + r2 * (4.16666666666666019037e-02 + r2 * (-1.38888888888741095749e-03 + r2 * (2.48015872894767294178e-05 + r2 * (-2.75573143513906633035e-07 + r2 * (2.08757232129817482790e-09 + r2 * -1.13596475577881948265e-11))))));
    const int q = (int)((long long)kq & 3);
    const double s_ = (q == 0) ? sp : (q == 1) ? cp : (q == 2) ? -sp : -cp;
    const double c_ = (q == 0) ? cp : (q == 1) ? -sp : (q == 2) ? -cp : sp;
    sn = (float)s_; cs = (float)c_;
}

__global__ void __launch_bounds__(NWAVES * 64, 2) fwd(Args args) {
    extern __shared__ __attribute__((aligned(16))) unsigned char lds_raw[];
    Frame F;
    F.lds = (LAS unsigned char*)lds_raw;
    F.tid = threadIdx.x; F.lane = F.tid & 63; F.wave = __builtin_amdgcn_readfirstlane(F.tid >> 6);
    F.G = gridDim.x; { const int bx = blockIdx.x; F.vcu = (F.G % 8 == 0) ? (bx % 8) * (F.G / 8) + bx / 8 : bx; }
    volatile LAS unsigned* MISC = (volatile LAS unsigned*)(F.lds + MISC_OFF);
    unsigned char* ws = args.ws;
    gu32* ctl = (gu32*)(ws + WS_CTL);
#define X_IN ((const float*)AP->in[0])
#define cvec ((const float*)AP->in[1])
#define positions ((const int*)AP->in[2])
#define w_mod ((const float*)AP->in[3])
#define b_mod ((const float*)AP->in[4])
#define g_mix ((const float*)AP->in[5])
#define w_in ((const float*)AP->in[6])
#define b_forget ((const float*)AP->in[7])
#define g_q_lat ((const float*)AP->in[8])
#define w_q_up ((const float*)AP->in[9])
#define g_kv_lat ((const float*)AP->in[10])
#define w_kv_up ((const float*)AP->in[11])
#define w_o_mla ((const float*)AP->in[12])
#define w_o_fox ((const float*)AP->in[13])
#define w_out ((const float*)AP->in[14])
#define g_ffn ((const float*)AP->in[15])
#define w_router ((const float*)AP->in[16])
#define b_router ((const float*)AP->in[17])
#define w_exp_gate ((const float*)AP->in[18])
#define w_exp_up ((const float*)AP->in[19])
#define w_exp_down ((const float*)AP->in[20])
#define w_sh_gate ((const float*)AP->in[21])
#define w_sh_up ((const float*)AP->in[22])
#define w_sh_down ((const float*)AP->in[23])
#define g_final ((const float*)AP->in[24])
#define Win_t ((bf16*)(ws + WS_WIN))
#define Wq_t ((bf16*)(ws + WS_WQ))
#define Wkv_t ((bf16*)(ws + WS_WKV))
#define Wom_t ((bf16*)(ws + WS_WOM))
#define Wof_t ((bf16*)(ws + WS_WOF))
#define Wout_t ((bf16*)(ws + WS_WOUT))
#define Wsgu_t ((bf16*)(ws + WS_WSGU))
#define Wsd_t ((bf16*)(ws + WS_WSD))
#define Wr_f ((bf16*)(ws + WS_WR))
#define mod ((float*)(ws + WS_MOD))
#define Wd_t ((bf16*)(ws + WS_WD))
#define Wgu_t ((bf16*)(ws + WS_WGU))
#define HB ((bf16*)(ws + WS_HB))
#define FQ ((bf16*)(ws + WS_FQ))
#define FK ((bf16*)(ws + WS_FK))
#define FV ((bf16*)(ws + WS_FV))
#define QLAT ((bf16*)(ws + WS_QLAT))
#define KVLAT ((bf16*)(ws + WS_KVLAT))
#define OFOX ((bf16*)(ws + WS_OFOX))
#define OCAT ((bf16*)((unsigned char*)out + 32 * MiB))
#define OMLA ((bf16*)(ws + WS_OMLA))
#define Y ((bf16*)(ws + WS_Y))
#define H ((bf16*)(ws + WS_H))
#define QMLA ((bf16*)(ws + WS_QMLA))
#define GATES ((bf16*)(ws + WS_GATES))
#define KN ((bf16*)(ws + WS_KN))
#define VM ((bf16*)(ws + WS_VM))
#define KPE ((bf16*)(ws + WS_KPE))
#define MERGED ((bf16*)(ws + WS_MERGED))
#define LIST ((unsigned short*)(ws + WS_LIST))
#define Wgu8 ((unsigned char*)(ws + WS_WGU))
#define Wsgu8 ((unsigned char*)(ws + WS_WSGU))
#define H8 ((unsigned char*)(ws + WS_H))
#define META ((u32x2*)(ws + WS_WIN))
#define EIDX ((unsigned char*)(ws + WS_EIDX))
#define GATEW ((float*)(ws + WS_GATEW))
#define ROPETAB ((float*)((unsigned char*)out + DO_ROPE))
#define LOGF ((float*)((unsigned char*)out + DO_LOGF))
#define CUMF ((float*)((unsigned char*)out + DO_CUMF))
#define SSQQ ((float*)((unsigned char*)out + DO_SSQQ))
#define SSQKV ((float*)((unsigned char*)out + DO_SSQKV))
#define MODP ((float*)((unsigned char*)out + DO_MODP))
#define SSQ1 ((float*)(ws + WS_FQ))
    float* const out = args.out;
#define PHASE_ENV const __attribute__((address_space(4))) Args* AP; { auto kp_ = __builtin_amdgcn_kernarg_segment_ptr(); asm volatile("" : "+s"(kp_)); AP = (const __attribute__((address_space(4))) Args*)kp_; } \
    unsigned char* const ws = AP->ws; float* const out = AP->out; (void)ws; (void)out;
    for (int u = F.tid; u < (LDS_BYTES - LDSCTL_OFF) / 4; u += NWAVES * 64) ((LAS unsigned*)(F.lds + LDSCTL_OFF))[u] = 0u;
    __syncthreads();
    XcdBarrier bar; bar.bar = (unsigned*)(ctl + CW_BAR); bar.x = 0; bar.st = nullptr;
    if (MK_ONE_LAUNCH) bar = xcd_barrier_post((unsigned*)(ctl + CW_BAR), MISC + 8);
    const int lo = args.ph_lo, hi = args.ph_hi;
#define IN(k) (lo <= (k) && (k) < hi)
#define BOTH(k) (IN(k) && IN((k) + 1))
#define GRID_BAR() do { if (MK_ONE_LAUNCH) xcd_barrier(bar); } while (0)
#define DUP_BAR() do { if (dummy) xcd_barrier(bar); } while (0)
    const int gw = F.vcu * NWAVES + F.wave, NGW = F.G * NWAVES;

    for (int rep = 0; rep < ((PROBE_DUP == 0) ? 2 : 1); ++rep) if (IN(0)) { PHASE_ENV const bool dummy = (PROBE_DUP == 0) && rep == 0; (void)dummy;
        if (!(dummy && (PROBE_VAR == 1 || PROBE_VAR == 4 || PROBE_VAR == 5))) {
            LAS float* cond = (LAS float*)F.lds;
            for (int i = F.tid; i < NB * D; i += NWAVES * 64) { const float c = cvec[i]; cond[i] = c / (1.f + __expf(-c)); }
            __syncthreads();
            for (int it = F.wave * F.G + F.vcu; it < 96 * 16; it += NWAVES * F.G) { const int cg = it % 96, kq = it / 96, col = cg * 64 + F.lane;
                float a4[4] = {0.f, 0.f, 0.f, 0.f};
                const float* wp = w_mod + (size_t)(64 * kq) * (6 * D) + col;
                float wv[64];
#pragma unroll
                for (int kk = 0; kk < 64; ++kk) wv[kk] = __builtin_nontemporal_load(wp + (size_t)kk * (6 * D));
#pragma unroll
                for (int kk = 0; kk < 64; ++kk) {
#pragma unroll
                    for (int b = 0; b < 4; ++b) a4[b] += wv[kk] * cond[b * D + 64 * kq + kk]; }
#pragma unroll
                for (int b = 0; b < 4; ++b) MODP[((size_t)kq * 4 + b) * (6 * D) + col] = a4[b]; }
            __syncthreads();
        }
        if (!(dummy && (PROBE_VAR == 1 || PROBE_VAR == 3 || PROBE_VAR == 5))) for (int i = gw * 64 + F.lane; i < T * 16; i += NGW * 64) { const int t = i >> 4, j = i & 15;
            const float invf = (((j >> 2) == 0) ? 1.f : ((j >> 2) == 1) ? 0.1f : ((j >> 2) == 2) ? 0.01f : 0.001f) * (((j & 3) == 0) ? 1.f : ((j & 3) == 1) ? 0.5623413251903491f : ((j & 3) == 2) ? 0.31622776601683794f : 0.17782794100389228f);
            const float ang = (float)positions[t] * invf; float sn, cs; sincos_acc(ang, sn, cs);
            *(f32x2*)(ROPETAB + (size_t)i * 2) = (f32x2){cs, sn}; }
        for (int o = gw * 64 + F.lane; o < NEXP * D; o += NGW * 64) { const int piece = o >> 3, kk = o & 7, ln = piece & 63, grp = piece >> 6, ntl = grp & 3, j = grp >> 2;
            const int n = ntl * 16 + (ln & 15), k = j * 32 + (ln >> 4) * 8 + kk; Wr_f[o] = (bf16)f2bf(w_router[(size_t)k * NEXP + n]); }
        {
            LAS unsigned char* scr8 = F.lds + 32768 + F.wave * 9216;
            constexpr int F_IN = 62 * 16, F_O = 16 * 8, F_OUT = 16 * 16, F_SGU = 8 * 16, F_SD = 16 * 4, F_EGU = NEXP * F_SGU, F_ED = NEXP * F_SD;
            constexpr int NFAST = F_IN + 2 * F_O + F_OUT + F_SGU + F_SD + F_EGU + F_ED;
            if (!(dummy && PROBE_VAR >= 2)) for (int it = gw; it < NFAST; it += NGW) {
                int r = it;
                if (r < F_EGU) { const int e = r / F_SGU, rr = r % F_SGU, nb = rr & 7, kb = rr >> 3, pn = nb >> 2, c0 = (nb & 3) * 64;
                    const float* wsrc = (c0 < 128) ? w_exp_gate + (size_t)e * D * DEXP + pn * 128 + c0 : w_exp_up + (size_t)e * D * DEXP + pn * 128 + (c0 - 128);
                    cvt64_item8(wsrc + (size_t)(64 * kb) * DEXP, DEXP, Wgu8 + (size_t)e * 512 * D + (size_t)(64 * nb) * D + 64 * kb, D, scr8, F.lane, WSCALE8); continue; } r -= F_EGU;
                if (r < F_ED) { const int e = r / F_SD, rr = r % F_SD, nb = rr & 15, kb = rr >> 4;
                    cvt64_item(w_exp_down + (size_t)e * DEXP * D + (size_t)(64 * kb) * D + 64 * nb, D, Wd_t + (size_t)e * D * DEXP + (size_t)(64 * nb) * DEXP + 64 * kb, DEXP, scr8, F.lane); continue; } r -= F_ED;
                if (r < F_IN) { int nb = r % 62; const int kb = r / 62; if (nb >= 6) nb += 2; const int n0 = 64 * nb;
                    const int src = (n0 < 384) ? n0 : (n0 < 2048) ? 416 + (n0 - 512) : 1960 + (n0 - 2048);
                    cvt64_item(w_in + (size_t)(64 * kb) * 4008 + src, 4008, Win_t + (size_t)n0 * D + 64 * kb, D, scr8, F.lane); continue; } r -= F_IN;
                if (r < F_O) { const int nb = r & 15, kb = r >> 4; cvt64_item(w_o_mla + (size_t)(64 * kb) * D + 64 * nb, D, Wom_t + (size_t)(64 * nb) * D + 64 * kb, D, scr8, F.lane); continue; } r -= F_O;
                if (r < F_O) { const int nb = r & 15, kb = r >> 4; cvt64_item(w_o_fox + (size_t)(64 * kb) * D + 64 * nb, D, Wom_t + (size_t)(64 * nb) * D + 512 + 64 * kb, D, scr8, F.lane); continue; } r -= F_O;
                if (r < F_OUT) { const int nb = r & 15, kb = r >> 4; cvt64_item(w_out + (size_t)(64 * kb) * D + 64 * nb, D, Wout_t + (size_t)(64 * nb) * D + 64 * kb, D, scr8, F.lane); continue; } r -= F_OUT;
                if (r < F_SGU) { const int nb = r >> 4, kb = r & 15, pn = nb >> 2, c0 = (nb & 3) * 64;
                    const float* wsrc = (c0 < 128) ? w_sh_gate + pn * 128 + c0 : w_sh_up + pn * 128 + (c0 - 128);
                    cvt64_item8(wsrc + (size_t)(64 * kb) * DEXP, DEXP, Wsgu8 + (size_t)(64 * nb) * D + 64 * kb, D, scr8, F.lane, WSCALE8); continue; } r -= F_SGU;
                { const int nb = r >> 2, kb = r & 3; cvt64_item(w_sh_down + (size_t)(64 * kb) * D + 64 * nb, D, Wsd_t + (size_t)(64 * nb) * DEXP + 64 * kb, DEXP, scr8, F.lane); }
            }
            LAS float* scr = (LAS float*)(F.lds + 32768 + F.wave * 9216);
            constexpr int I_INS = 4 * (D / 64), I_Q = (768 / 32) * (QLORA / 64), I_KV = (1024 / 32) * (KVPAD / 64), NSLOW = I_INS + I_Q + I_KV;
            if (!(dummy && (PROBE_VAR == 1 || PROBE_VAR == 3 || PROBE_VAR == 4))) for (int it = F.wave * F.G + F.vcu; it < NSLOW; it += NGW) {
                int r = it;
                if (r < I_INS) { const int nb = 12 + (r & 3), kb = r >> 2;
                    cvt_item(4008, D, nullptr, Win_t, D, scr, kb, nb, F.lane, [&](int n) -> const float* {
                        int src; if (n < 416) src = 384 + ropedim(n - 384); else if (n < 424) src = 1952 + (n - 416); else src = -1;
                        return src < 0 ? nullptr : w_in + src; }); continue; } r -= I_INS;
                if (r < I_Q) { const int nblk = 768 / 32;
                    cvt_item(768, QLORA, g_q_lat, Wq_t, QLORA, scr, r / nblk, r % nblk, F.lane, [&](int n) -> const float* {
                        const int hh = n / MQK, j = n % MQK; return w_q_up + hh * MQK + (j < 64 ? j : 64 + ropedim(j - 64)); }); continue; } r -= I_Q;
                { const int nblk = 1024 / 32;
                    cvt_item(1024, KVLORA, g_kv_lat, Wkv_t, KVPAD, scr, r / nblk, r % nblk, F.lane, [&](int n) -> const float* {
                        return (n < 512) ? w_kv_up + (n >> 6) * 128 + (n & 63) : w_kv_up + ((n - 512) >> 6) * 128 + 64 + (n & 63); }); }
            }
        }
        if (BOTH(0)) GRID_BAR();
    }

    for (int rep = 0; rep < ((PROBE_DUP == 1) ? 2 : 1); ++rep) if (IN(1)) { PHASE_ENV const bool dummy = (PROBE_DUP == 1) && rep == 0; (void)dummy;
        if (F.vcu < 48) { const int idx = F.vcu * 512 + F.tid, b = idx / (6 * D), col = idx % (6 * D); float sm = b_mod[col];
#pragma unroll
            for (int p = 0; p < 16; ++p) sm += MODP[((size_t)p * 4 + b) * (6 * D) + col];
            mod[idx] = sm; }
        LAS float* vg1 = (LAS float*)F.lds; LAS float* vs1 = (LAS float*)(F.lds + 4096);
        for (int grp = F.vcu; grp < T / 64; grp += F.G) {
            const int b = (grp * 64) / SEQ;
            __syncthreads();
            for (int k = F.tid; k < D; k += NWAVES * 64) { float s0 = b_mod[k], s1 = b_mod[D + k];
#pragma unroll
                for (int p = 0; p < 16; ++p) { s0 += MODP[((size_t)p * 4 + b) * (6 * D) + k]; s1 += MODP[((size_t)p * 4 + b) * (6 * D) + D + k]; }
                vs1[k] = s0; vg1[k] = g_mix[k] * (1.f + s1); }
            __syncthreads();
#pragma unroll 2
            for (int rr = 0; rr < 8; ++rr) { const int m = grp * 64 + F.wave * 8 + rr;
                const f32x4* xr = (const f32x4*)(X_IN + (size_t)m * D) + F.lane;
                f32x4 v[4]; float s = 0.f;
#pragma unroll
                for (int j = 0; j < 4; ++j) { v[j] = __builtin_nontemporal_load(xr + 64 * j); s += (v[j].x * v[j].x + v[j].y * v[j].y) + (v[j].z * v[j].z + v[j].w * v[j].w); }
                const float rstd = rsqrtf(wave_sum(s) * (1.f / D) + EPS);
                unsigned long long* o8 = (unsigned long long*)(H + (size_t)m * D) + F.lane;
#pragma unroll
                for (int j = 0; j < 4; ++j) { const int c = 4 * F.lane + 256 * j;
                    const f32x4 g = *(const LAS f32x4*)(vg1 + c), d = *(const LAS f32x4*)(vs1 + c);
                    const f32x4 r = v[j] * rstd * g + d;
                    o8[64 * j] = (unsigned long long)pk2(r.x, r.y) | ((unsigned long long)pk2(r.z, r.w) << 32); } }
        }
        if (BOTH(1)) GRID_BAR();
    }

    for (int rep = 0; rep < ((PROBE_DUP == 2) ? 2 : 1); ++rep) if (IN(2)) { PHASE_ENV const bool dummy = (PROBE_DUP == 2) && rep == 0; (void)dummy;
        pg8::StaticOrder S; S.init(H, Win_t, T, NIN, D, F.G, (int)blockIdx.x);
        EpiInProj E{QLAT, KVLAT, KPE, FQ, GATES, LOGF, SSQQ, SSQKV, ROPETAB, b_forget};
        pg8::gemm_phase<EpiInProj, pg8::StaticOrder, true>(F.lds, S, E);
        if (BOTH(2)) GRID_BAR();
    }

    for (int rep = 0; rep < ((PROBE_DUP == 3) ? 2 : 1); ++rep) if (IN(3)) { PHASE_ENV const bool dummy = (PROBE_DUP == 3) && rep == 0; (void)dummy;
        {
            const int bb = F.vcu & 3; float mx = 0.f, mq = 0.f;
            for (int r = (F.vcu >> 2) * NWAVES + F.wave; r < SEQ; r += (F.G >> 2) * NWAVES) { f32x4 k0, k1, q0v, q1v; unpack8(*(const u32x4*)(FK + ((size_t)bb * SEQ + r) * 512 + 8 * F.lane), k0, k1);
                unpack8(*(const u32x4*)(FQ + ((size_t)bb * SEQ + r) * 512 + 8 * F.lane), q0v, q1v);
                float sq = (k0[0] * k0[0] + k0[1] * k0[1]) + (k0[2] * k0[2] + k0[3] * k0[3]) + (k1[0] * k1[0] + k1[1] * k1[1]) + (k1[2] * k1[2] + k1[3] * k1[3]);
                float sqq = (q0v[0] * q0v[0] + q0v[1] * q0v[1]) + (q0v[2] * q0v[2] + q0v[3] * q0v[3]) + (q1v[0] * q1v[0] + q1v[1] * q1v[1]) + (q1v[2] * q1v[2] + q1v[3] * q1v[3]);
                sq += dppf<0xB1>(sq); sq += dppf<0x4E>(sq); sq += dppf<0x141>(sq);
                sqq += dppf<0xB1>(sqq); sqq += dppf<0x4E>(sqq); sqq += dppf<0x141>(sqq);
                mx = fmaxf(mx, sq); mq = fmaxf(mq, sqq); }
            LAS float* kml = (LAS float*)F.lds;
            if ((F.lane & 7) == 0) { kml[F.wave * 8 + (F.lane >> 3)] = mx; kml[64 + F.wave * 8 + (F.lane >> 3)] = mq; }
            __syncthreads();
            if (F.tid < 2 * NHEAD) { const int hh = F.tid & 7, qk = F.tid >> 3; float m2 = 0.f;
#pragma unroll
                for (int w = 0; w < NWAVES; ++w) m2 = fmaxf(m2, kml[qk * 64 + w * 8 + hh]);
                atomicMax((unsigned*)(ctl + CW_KM + qk * 32 + bb * NHEAD + hh), __float_as_uint(m2)); }
            __syncthreads();
        }
        if (F.vcu < NB) {
            const int b = F.vcu, h = F.wave; const float* src = LOGF + ((size_t)b * SEQ + 64 * F.lane) * 8 + h;
            float v[64]; float run = 0.f;
#pragma unroll
            for (int i = 0; i < 64; ++i) v[i] = src[i * 8];
#pragma unroll
            for (int i = 0; i < 64; ++i) { run += v[i]; v[i] = run; }
            float incl = run;
#pragma unroll
            for (int o = 1; o < 64; o <<= 1) { const float n = __shfl_up(incl, o); if (F.lane >= o) incl += n; }
            const float excl = incl - run;
            float* dst = CUMF + ((size_t)b * NHEAD + h) * SEQ + 64 * F.lane;
#pragma unroll
            for (int i = 0; i < 64; i += 4) *(f32x4*)(dst + i) = (f32x4){v[i] + excl, v[i + 1] + excl, v[i + 2] + excl, v[i + 3] + excl};
        }
        { UpOrder S{(const char*)QLAT, (const char*)Wq_t, (const char*)KVLAT, (const char*)Wkv_t, QLORA, F.G, (int)blockIdx.x};
          EpiUp E{EpiQup{QMLA, SSQQ, ROPETAB}, EpiKVup{KN, VM, SSQKV}};
          pg8::gemm_phase<EpiUp, UpOrder, true>(F.lds, S, E); }
        if (BOTH(3)) GRID_BAR();
    }

    for (int rep = 0; rep < ((PROBE_DUP == 4) ? 2 : 1); ++rep) if (IN(4)) { PHASE_ENV const bool dummy = (PROBE_DUP == 4) && rep == 0; (void)dummy;
        {
            const bool xq = (F.G % 8) == 0; const int x = xq ? (int)(blockIdx.x & 7) : 0, nunits = xq ? 128 : 1024;
            gu32* qh = ctl + CW_Q + 64 * x + (dummy ? 16 : 0);
            volatile LAS unsigned* qw = (volatile LAS unsigned*)(F.lds + MISC_OFF + 64);
            for (;;) {
                if (F.tid == 0) qw[0] = __hip_atomic_fetch_add(qh, 1u, RLX_AGENT);
                __syncthreads();
                const int r = (int)qw[0];
                if (r >= nunits) break;
                int qb, type, b, h;
                if (xq) { qb = 15 - (r >> 3); type = (r >> 2) & 1; b = r & 3; h = (x + 3 * b) & 7; }
                else { qb = 15 - (r >> 6); type = (r >> 5) & 1; b = (r >> 3) & 3; h = r & 7; }
                if (type == 0) { if (ATT_TUNED_FOX && qb != 0) att::attn_unit_t<64, true, 8>(b, h, qb, FQ, 512, FK, KPE, FV, CUMF, __uint_as_float(__hip_atomic_load((unsigned*)(ctl + CW_KM + b * NHEAD + h), RLX_AGENT)) * __uint_as_float(__hip_atomic_load((unsigned*)(ctl + CW_KM + 32 + b * NHEAD + h), RLX_AGENT)), (dummy ? (bf16*)((unsigned char*)out + 4 * MiB) : OCAT) + 512, D, F.lds);
                                 else att::attn_unit<64, true, 8>(b, h, qb, FQ, 512, FK, KPE, FV, CUMF, (dummy ? (bf16*)((unsigned char*)out + 4 * MiB) : OCAT) + 512, D, F.lds); }
                else { if (ATT_TUNED_MLA && qb != 0) att::attn_unit_t<96, false, 8>(b, h, qb, QMLA, 768, KN, KPE, VM, nullptr, 0.f, dummy ? (bf16*)((unsigned char*)out + 4 * MiB) : OCAT, D, F.lds);
                       else att::attn_unit<96, false, 8>(b, h, qb, QMLA, 768, KN, KPE, VM, nullptr, dummy ? (bf16*)((unsigned char*)out + 4 * MiB) : OCAT, D, F.lds); }
            }
        }
        if (BOTH(4)) GRID_BAR();
    }

    for (int rep = 0; rep < ((PROBE_DUP == 5) ? 2 : 1); ++rep) if (IN(5)) { PHASE_ENV const bool dummy = (PROBE_DUP == 5) && rep == 0; (void)dummy;
        pg8::StaticOrder S; S.init(OCAT, Wom_t, T, D, D, F.G, (int)blockIdx.x);
        EpiMergedCat E{GATES, MERGED};
        pg8::gemm_phase<EpiMergedCat, pg8::StaticOrder, true>(F.lds, S, E);
        if (BOTH(5)) GRID_BAR();
    }

    for (int rep = 0; rep < ((PROBE_DUP == 6) ? 2 : 1); ++rep) if (IN(6)) { PHASE_ENV const bool dummy = (PROBE_DUP == 6) && rep == 0; (void)dummy;
        pg8::StaticOrder S; S.init(MERGED, Wout_t, T, D, D, F.G, (int)blockIdx.x);
        EpiOut E{X_IN, out, mod, SSQ1};
        pg8::gemm_phase<EpiOut, pg8::StaticOrder, true>(F.lds, S, E);
        if (BOTH(6)) GRID_BAR();
    }

    for (int rep = 0; rep < ((PROBE_DUP == 7) ? 2 : 1); ++rep) if (IN(7)) { PHASE_ENV const bool dummy = (PROBE_DUP == 7) && rep == 0; (void)dummy;
        LAS unsigned char* wrl = F.lds;
        LAS float* vg = (LAS float*)(F.lds + LDSCTL_OFF + 6144);
        LAS float* vs = (LAS float*)(F.lds + LDSCTL_OFF + 10240);
        LAS float* stg = (LAS float*)(F.lds) + F.wave * 512;
        LAS int* cntw = (LAS int*)(F.lds + 16384);
        LAS int* basel = (LAS int*)(F.lds + 16384 + 2048);
        static_assert(LDSCTL_OFF + 10240 + 4096 <= LDS_BYTES && MOETAB_OFF + 4700 <= LDSCTL_OFF + 6144, "P7 LDS map");
        const float my_bias = b_router[F.lane];
        for (int grp = F.vcu; grp < T / 64; grp += F.G) {
            const int b = (grp * 64) / SEQ;
            __syncthreads();
#pragma unroll
            for (int i = 0; i < 16; ++i) __builtin_amdgcn_global_load_lds((const unsigned*)((const char*)Wr_f + (F.wave * 16 + i) * 1024 + F.lane * 16), (LAS unsigned*)(wrl + (F.wave * 16 + i) * 1024), 16, 0, 0);
            for (int i = F.tid; i < D; i += NWAVES * 64) { vg[i] = g_ffn[i] * (1.f + mod[(size_t)b * 6 * D + 4 * D + i]); vs[i] = mod[(size_t)b * 6 * D + 3 * D + i]; }
            const int t0 = grp * 64 + F.wave * 8;
            float rs_mine;
            { const float* sp = SSQ1 + (size_t)(t0 + (F.lane & 7)) * 16; const f32x4 a = *(const f32x4*)sp, b4 = *(const f32x4*)(sp + 4), c4 = *(const f32x4*)(sp + 8), d4 = *(const f32x4*)(sp + 12);
              const float ssum = (((a[0] + a[1]) + (a[2] + a[3])) + ((b4[0] + b4[1]) + (b4[2] + b4[3]))) + (((c4[0] + c4[1]) + (c4[2] + c4[3])) + ((d4[0] + d4[1]) + (d4[2] + d4[3])));
              rs_mine = rsqrtf(ssum * (1.f / D) + EPS); }
            VM_WAIT(); __syncthreads();
            const int r16 = F.lane & 15, kg = F.lane >> 4, myrow = t0 + (r16 & 7);
            const float* xrow = out + (size_t)myrow * D + 8 * kg;
            f32x4 lacc[4] = {{0.f, 0.f, 0.f, 0.f}, {0.f, 0.f, 0.f, 0.f}, {0.f, 0.f, 0.f, 0.f}, {0.f, 0.f, 0.f, 0.f}};
            f32x4 xq[16][2];
#pragma unroll
            for (int p = 0; p < 16; ++p) { xq[p][0] = *(const f32x4*)(xrow + 32 * p); xq[p][1] = *(const f32x4*)(xrow + 32 * p + 4); }
            for (int j4 = 0; j4 < 32; j4 += 16) {
#pragma unroll
                for (int p = 0; p < 16; ++p) { const int j = j4 + p, k = 32 * j + 8 * kg;
                    const f32x4 x0 = xq[p][0], x1v = xq[p][1];
                    if (j4 + 16 < 32) { xq[p][0] = *(const f32x4*)(xrow + 32 * (j + 16)); xq[p][1] = *(const f32x4*)(xrow + 32 * (j + 16) + 4); }
                    const f32x4 g0 = *(const LAS f32x4*)(vg + k), g1 = *(const LAS f32x4*)(vg + k + 4), s0 = *(const LAS f32x4*)(vs + k), s1 = *(const LAS f32x4*)(vs + k + 4);
                    const f32x4 h0 = x0 * rs_mine * g0 + s0, h1 = x1v * rs_mine * g1 + s1;
                    const u32x4 hw = pack8(h0, h1);
                    f32x4 a0, a1; unpack8(hw, a0, a1);
                    const u32x4 lw = pack8(h0 - a0, h1 - a1);
                    if (r16 < 8) { u32x2 h8; int p_ = __builtin_amdgcn_cvt_pk_fp8_f32(h0[0], h0[1], 0, false); p_ = __builtin_amdgcn_cvt_pk_fp8_f32(h0[2], h0[3], p_, true); h8.x = (unsigned)p_;
                        p_ = __builtin_amdgcn_cvt_pk_fp8_f32(h1[0], h1[1], 0, false); p_ = __builtin_amdgcn_cvt_pk_fp8_f32(h1[2], h1[3], p_, true); h8.y = (unsigned)p_;
                        *(u32x2*)(H8 + (size_t)myrow * D + k) = h8; }
                    const bf16x8 Ah = __builtin_bit_cast(bf16x8, hw), Al = __builtin_bit_cast(bf16x8, lw);
#pragma unroll
                    for (int ntl = 0; ntl < 4; ++ntl) { const bf16x8 Wf = *(const LAS bf16x8*)(wrl + ((j * 4 + ntl) * 64 + F.lane) * 16);
                        lacc[ntl] = __builtin_amdgcn_mfma_f32_16x16x32_bf16(Wf, Ah, lacc[ntl], 0, 0, 0);
                        lacc[ntl] = __builtin_amdgcn_mfma_f32_16x16x32_bf16(Wf, Al, lacc[ntl], 0, 0, 0); } }
            }
            __syncthreads();
            if (r16 < 8) {
#pragma unroll
                for (int ntl = 0; ntl < 4; ++ntl) *(LAS f32x4*)(stg + r16 * 64 + 16 * ntl + 4 * kg) = lacc[ntl]; }
            LDS_WAIT();
            int cnt = 0; unsigned selbits = 0u, selks = 0u;
            for (int j = 0; j < 8; ++j) {
                const float logit = stg[j * 64 + F.lane];
                const float sc = 1.f / (1.f + expf(-logit));
                const float ch = sc + my_bias;
                const float m1 = max8(ch);
                const unsigned long long eq = __ballot(ch == m1);
                const unsigned gm = (unsigned)(eq >> (F.lane & ~7)) & 0xffu;
                const int first = __builtin_ctz(gm);
                const float c2 = max8(((F.lane & 7) == first) ? -INFINITY : ch);
                const float gs = m1 + c2; const int myg = F.lane >> 3;
                int rank = 0;
#pragma unroll
                for (int g = 0; g < 8; ++g) { const float o = __builtin_bit_cast(float, __builtin_amdgcn_readlane(__builtin_bit_cast(int, gs), 8 * g)); rank += (o > gs || (o == gs && g < myg)) ? 1 : 0; }
                float mc = (rank < 4) ? ch : -1e30f;
                int selk = -1;
#pragma unroll
                for (int k = 0; k < TOPK; ++k) { const float mx = wave_max_f(mc); const unsigned long long bl = __ballot(mc == mx); const int fl = __builtin_ctzll(bl);
                    if (F.lane == fl) { selk = k; mc = -INFINITY; } }
                const float ssum = wave_sum_f(selk >= 0 ? sc : 0.f);
                if (selk >= 0) { const int t = t0 + j; EIDX[(size_t)t * 8 + selk] = (unsigned char)F.lane; GATEW[(size_t)t * 8 + selk] = sc / ssum * 2.5f; ++cnt; selbits |= 1u << j; selks |= (unsigned)selk << (3 * j); }
            }
            cntw[F.wave * 64 + F.lane] = cnt;
            __syncthreads();
            if (F.wave == 0) { int tot = 0;
#pragma unroll
                for (int w = 0; w < 8; ++w) tot += cntw[w * 64 + F.lane];
                basel[F.lane] = (int)__hip_atomic_fetch_add((unsigned*)(ctl + (dummy ? CW_CNT + 2048 : CW_CNT) + 16 * F.lane), (unsigned)tot, RLX_AGENT); }
            __syncthreads();
            int pos = basel[F.lane];
            for (int w = 0; w < F.wave; ++w) pos += cntw[w * 64 + F.lane];
#pragma unroll
            for (int j = 0; j < 8; ++j) if ((selbits >> j) & 1u) { const int k = (selks >> (3 * j)) & 7, t = t0 + j;
                LIST[(size_t)F.lane * LISTCAP + pos] = (unsigned short)t;
                META[(size_t)F.lane * LISTCAP + pos] = (u32x2){(unsigned)(t * (TOPK + 1) + k), __float_as_uint(GATEW[(size_t)t * 8 + k])}; ++pos; }
        }
        __syncthreads();
        if (BOTH(7)) GRID_BAR();
    }

    volatile LAS int* tab = (volatile LAS int*)(F.lds + MOETAB_OFF);
    if (IN(8) || IN(9)) {
        __syncthreads();
        if (F.wave == 0) {
            const int n = (int)__hip_atomic_load((unsigned*)(ctl + CW_CNT + 16 * F.lane), RLX_AGENT);
            const int tiles = (n + 255) >> 8; int incl = tiles;
#pragma unroll
            for (int o = 1; o < 64; o <<= 1) { const int v = __shfl_up(incl, o); if (F.lane >= o) incl += v; }
            tab[F.lane] = incl - tiles; tab[66 + F.lane] = n;
            if (F.lane == 63) { tab[64] = incl; tab[65] = incl + T / 256; tab[66 + 64] = T; }
        }
        __syncthreads();
        { const int ti = F.tid; int e = 0;
          for (int q = 0; q <= NEXP; ++q) if (tab[q] <= ti) e = q;
          tab[132 + ti] = e; }
        __syncthreads();
    }
    for (int rep = 0; rep < ((PROBE_DUP == 8) ? 2 : 1); ++rep) if (IN(8)) { PHASE_ENV const bool dummy = (PROBE_DUP == 8) && rep == 0; (void)dummy;
        MoeOrder<2, true> S{(const char*)H8, (const char*)Wgu8, (const char*)Wsgu8, D / 2, (size_t)512 * D, LIST, tab, F.G, (int)blockIdx.x};
        EpiHb E{HB, 1.f / WSCALE8};
        pg8::gemm_phase<EpiHb, MoeOrder<2, true>, true, true>(F.lds, S, E);
        if (BOTH(8)) GRID_BAR();
    }
    for (int rep = 0; rep < ((PROBE_DUP == 9) ? 2 : 1); ++rep) if (IN(9)) { PHASE_ENV const bool dummy = (PROBE_DUP == 9) && rep == 0; (void)dummy;
        if (dummy && PROBE_VAR == 1) dn::down_phase<true>(F.lds, HB, Wd_t, Wsd_t, tab, META, (unsigned char*)Y, (unsigned char*)(ws + WS_CTL + 900 * 1024), F.G, (int)blockIdx.x);
        else dn::down_phase<false>(F.lds, HB, Wd_t, Wsd_t, tab, META, (unsigned char*)Y, (unsigned char*)(ws + WS_CTL + 900 * 1024), F.G, (int)blockIdx.x);
        if (BOTH(9)) GRID_BAR();
    }

    for (int rep = 0; rep < ((PROBE_DUP == 10) ? 2 : 1); ++rep) if (IN(10)) { PHASE_ENV const bool dummy = (PROBE_DUP == 10) && rep == 0; (void)dummy;
        for (int m = gw; m < T; m += NGW) {
            const int b = m / SEQ; const float* gf = mod + (size_t)b * 6 * D + 5 * D;
            f32x4* xr = (f32x4*)(out + (size_t)m * D) + F.lane;
            f32x4* xw = dummy ? (f32x4*)((float*)HB + (size_t)m * D) + F.lane : xr;
            f32x4 v[4]; float s = 0.f;
#pragma unroll
            for (int j = 0; j < 4; ++j) { const int c = 4 * F.lane + 256 * j;
                f32x4 y = {0.f, 0.f, 0.f, 0.f};
#pragma unroll
                for (int k = 0; k < TOPK + 1; ++k) { const int w = __builtin_nontemporal_load((const int*)((const unsigned char*)Y + ((size_t)m * (TOPK + 1) + k) * D + c));
                    const f32x2 lo = __builtin_amdgcn_cvt_pk_f32_fp8(w, false), hi2 = __builtin_amdgcn_cvt_pk_f32_fp8(w, true);
                    y += (f32x4){lo.x, lo.y, hi2.x, hi2.y}; }
                v[j] = __builtin_nontemporal_load(xr + 64 * j) + *(const f32x4*)(gf + c) * y;
                s += (v[j].x * v[j].x + v[j].y * v[j].y) + (v[j].z * v[j].z + v[j].w * v[j].w); }
            const float rstd = rsqrtf(wave_sum(s) * (1.f / D) + EPS);
#pragma unroll
            for (int j = 0; j < 4; ++j) __builtin_nontemporal_store(v[j] * rstd * *(const f32x4*)(g_final + 4 * F.lane + 256 * j), xw + 64 * j);
        }
    }
#undef IN
#undef BOTH
#undef GRID_BAR
}

constexpr int NPHASE = 11;
extern "C" void kernel_launch(void* const* d_in, const int* in_sizes, int n_in, void* d_out, int out_size, void* d_ws, size_t ws_size, hipStream_t stream) {
    static int grid = 0;
    if (grid == 0) {
        if (n_in != 25 || out_size != T * D || ws_size < WS_END) { fprintf(stderr, "kernel_launch: unexpected shapes (n_in %d out %d ws %zu need %zu)\n", n_in, out_size, ws_size, (size_t)WS_END); grid = -1; return; }
        int dev = 0, cus = 0;
        if (hipGetDevice(&dev) != hipSuccess || hipDeviceGetAttribute(&cus, hipDeviceAttributeMultiprocessorCount, dev) != hipSuccess) { grid = -1; return; }
        if (hipFuncSetAttribute((const void*)fwd, hipFuncAttributeMaxDynamicSharedMemorySize, LDS_BYTES) != hipSuccess) { fprintf(stderr, "kernel_launch: hipFuncSetAttribute failed\n"); grid = -1; return; }
        int per_cu = 0;
        if (hipOccupancyMaxActiveBlocksPerMultiprocessor(&per_cu, (const void*)fwd, NWAVES * 64, LDS_BYTES) != hipSuccess || per_cu < 1) { fprintf(stderr, "kernel_launch: occupancy query says %d\n", per_cu); }
        (void)hipGetLastError();
        grid = cus;
    }
    if (grid < 0) return;
    (void)in_sizes;
    if (hipMemsetAsync((char*)d_ws + WS_CTL, 0, CTL_ZERO_BYTES, stream) != hipSuccess) return;
    Args a{};
    for (int i = 0; i < 25; ++i) a.in[i] = d_in[i];
    a.out = (float*)d_out; a.ws = (unsigned char*)d_ws;
#if MK_ONE_LAUNCH
    a.ph_lo = 0; a.ph_hi = NPHASE;
    hipLaunchKernelGGL(fwd, dim3(grid), dim3(NWAVES * 64), LDS_BYTES, stream, a);
#else
    for (int p = 0; p < NPHASE; ++p) { a.ph_lo = p; a.ph_hi = p + 1; hipLaunchKernelGGL(fwd, dim3(grid), dim3(NWAVES * 64), LDS_BYTES, stream, a); }
#endif
}
```

```cpp
#include <hip/hip_runtime.h>
#include <cstdio>
#include <cstdint>
#include <type_traits>

#ifndef MK_ONE_LAUNCH
#define MK_ONE_LAUNCH 1
#endif

#ifndef PROBE_DUP
#define PROBE_DUP -1
#endif
#ifndef ATT_TUNED_FOX
#define ATT_TUNED_FOX 1
#endif
#ifndef ATT_TUNED_MLA
#define ATT_TUNED_MLA 1
#endif
#ifndef PROBE_VAR
#define PROBE_VAR 0
#endif
#define GAS __attribute__((address_space(1)))
#define LAS __attribute__((address_space(3)))
typedef unsigned short bf16;
typedef short bf16x8 __attribute__((ext_vector_type(8)));
typedef short s16x4 __attribute__((ext_vector_type(4)));
typedef float f32x2 __attribute__((ext_vector_type(2)));
typedef float f32x4 __attribute__((ext_vector_type(4)));
typedef float f32x16 __attribute__((ext_vector_type(16)));
typedef unsigned u32x2 __attribute__((ext_vector_type(2)));
typedef unsigned u32x4 __attribute__((ext_vector_type(4)));
typedef GAS unsigned gu32;
typedef int v8i32_t __attribute__((ext_vector_type(8)));
typedef int v4i32_t __attribute__((ext_vector_type(4)));

constexpr int NB = 4, SEQ = 4096, T = NB * SEQ, D = 1024;
constexpr int NIN = 4096;
constexpr int QLORA = 256, KVLORA = 128, KVPAD = 256, ROPE = 32, NHEAD = 8, HD = 64, MQK = 96;
constexpr int NEXP = 64, TOPK = 6, DEXP = 256;
constexpr float EPS = 1e-6f;
constexpr float LOG2E = 1.4426950408889634f;
constexpr float C2F = 0.125f * LOG2E;
constexpr float C2M = 0.10206207261596577f * LOG2E;
constexpr int LISTCAP = T;
constexpr float OSCALE8 = 8.f;
constexpr float WSCALE8 = 64.f;

constexpr size_t MiB = 1u << 20;
constexpr size_t WS_CTL = 0, CTL_ZERO_BYTES = 1 * MiB;
constexpr size_t WS_EIDX = 262144, WS_GATEW = 393216;
constexpr size_t WS_WIN = 1 * MiB, WS_WQ = 9 * MiB, WS_WKV = 9 * MiB + 512 * 1024, WS_WOM = 10 * MiB, WS_WOF = 11 * MiB, WS_WOUT = 12 * MiB;
constexpr size_t WS_WSGU = 14 * MiB, WS_WSD = 15 * MiB, WS_WR = 15 * MiB + 512 * 1024, WS_MOD = 15 * MiB + 640 * 1024;
constexpr size_t WS_WD = 16 * MiB;
constexpr size_t WS_HB = 48 * MiB;
constexpr size_t WS_FQ = 48 * MiB, WS_FK = 64 * MiB, WS_FV = 80 * MiB, WS_QLAT = 96 * MiB, WS_KVLAT = 104 * MiB;
constexpr size_t WS_OFOX = WS_FQ, WS_OMLA = WS_QLAT;
static_assert(WS_FK - WS_FQ == (size_t)T * 512 * 2 && WS_FV - WS_FK == (size_t)T * 512 * 2, "fq|fk|fv contiguous");
constexpr size_t WS_Y = 112 * MiB;
constexpr size_t WS_WGU = 112 * MiB;
constexpr size_t WS_H = 176 * MiB;
constexpr size_t WS_QMLA = WS_H;
constexpr size_t WS_GATES = 208 * MiB;
constexpr size_t WS_KN = 272 * MiB, WS_VM = 288 * MiB, WS_KPE = 304 * MiB;
constexpr size_t WS_MERGED = WS_KN;
constexpr size_t WS_LIST = 304 * MiB;
constexpr size_t WS_END = 306 * MiB;
constexpr size_t DO_MODP = 4 * MiB;
constexpr size_t DO_ROPE = 0, DO_LOGF = 2 * MiB, DO_CUMF = 2 * MiB + 512 * 1024, DO_SSQQ = 3 * MiB, DO_SSQKV = 3 * MiB + 256 * 1024;

constexpr int CW_TMO = 0;
constexpr int CW_BAR = 4096;
constexpr int CW_CNT = 8192;
constexpr int CW_KM = 12288;
constexpr int CW_Q = 12544;

constexpr int RING_BYTES = 131072;
constexpr int LDSCTL_OFF = RING_BYTES;
constexpr int MISC_OFF = LDSCTL_OFF + 320;
constexpr int MOETAB_OFF = LDSCTL_OFF + 1024;
constexpr int LDS_BYTES = 147456;

constexpr int NWAVES = 8;

#define LDS_WAIT() asm volatile("s_waitcnt lgkmcnt(0)" ::: "memory")
#define VM_WAIT() asm volatile("s_waitcnt vmcnt(0)" ::: "memory")
#define RLX_AGENT __ATOMIC_RELAXED, __HIP_MEMORY_SCOPE_AGENT
__device__ __forceinline__ unsigned f2bf(float f) { unsigned u = __builtin_bit_cast(unsigned, f); return (u + 0x7fffu + ((u >> 16) & 1u)) >> 16; }
__device__ __forceinline__ float bf2f(unsigned h) { return __builtin_bit_cast(float, h << 16); }
__device__ __forceinline__ unsigned pk2(float lo, float hi) { return f2bf(lo) | (f2bf(hi) << 16); }
__device__ __forceinline__ unsigned cvt_pk_bf16(float lo, float hi) { unsigned r; asm volatile("v_cvt_pk_bf16_f32 %0, %1, %2" : "=v"(r) : "v"(lo), "v"(hi)); return r; }
__device__ __forceinline__ u32x4 pack8(f32x4 a, f32x4 b) { u32x4 w; w.x = cvt_pk_bf16(a[0], a[1]); w.y = cvt_pk_bf16(a[2], a[3]); w.z = cvt_pk_bf16(b[0], b[1]); w.w = cvt_pk_bf16(b[2], b[3]); return w; }
__device__ __forceinline__ void unpack8(u32x4 w, f32x4& a, f32x4& b) {
    a = (f32x4){bf2f(w.x & 0xffffu), bf2f(w.x >> 16), bf2f(w.y & 0xffffu), bf2f(w.y >> 16)};
    b = (f32x4){bf2f(w.z & 0xffffu), bf2f(w.z >> 16), bf2f(w.w & 0xffffu), bf2f(w.w >> 16)};
}
__device__ __forceinline__ float wave_sum(float v) {
#pragma unroll
    for (int o = 1; o < 64; o <<= 1) v += __shfl_xor(v, o);
    return v;
}
__device__ __forceinline__ float wave_max(float v) {
#pragma unroll
    for (int o = 1; o < 64; o <<= 1) v = fmaxf(v, __shfl_xor(v, o));
    return v;
}
template <int CTRL> __device__ __forceinline__ float dppf(float v) { return __builtin_bit_cast(float, __builtin_amdgcn_update_dpp(0, __builtin_bit_cast(int, v), CTRL, 0xf, 0xf, true)); }
__device__ __forceinline__ float max8(float v) { v = fmaxf(v, dppf<0xB1>(v)); v = fmaxf(v, dppf<0x4E>(v)); v = fmaxf(v, dppf<0x141>(v)); return v; }
__device__ __forceinline__ float wave_max_f(float v) { v = max8(v); v = fmaxf(v, dppf<0x140>(v)); v = fmaxf(v, __shfl_xor(v, 16)); v = fmaxf(v, __shfl_xor(v, 32)); return v; }
__device__ __forceinline__ float wave_sum_f(float v) { v += dppf<0xB1>(v); v += dppf<0x4E>(v); v += dppf<0x141>(v); v += dppf<0x140>(v); v += __shfl_xor(v, 16); v += __shfl_xor(v, 32); return v; }
__device__ __forceinline__ float sigmoidf_(float x) { return 1.f / (1.f + __expf(-x)); }
__device__ __forceinline__ float siluf_(float x) { return x / (1.f + __expf(-x)); }

namespace pg8 {
constexpr int BM = 256, BK = 64, HALF = 128, HTB = HALF * BK * 2, NXCD = 8, WGM = 8;
__host__ __device__ __forceinline__ int lds_byte(int r, int c) { const int st = (r >> 4) * 2 + (c >> 5), rr = r & 15, cc = c & 31, ob = rr * 64 + cc * 2; return st * 1024 + (ob ^ (((ob >> 9) & 1) << 5)); }
__host__ __device__ __forceinline__ void stage_rc(int b, int& R, int& C) { const int st = b / 1024, sb = b % 1024, swz = sb ^ (((sb >> 9) & 1) << 5); R = (st >> 1) * 16 + swz / 64; C = (st & 1) * 32 + (swz % 64) / 2; }
__host__ __device__ __forceinline__ int perm32(int rho) { const int n = rho >> 4, i = rho & 15; return 8 * (i >> 2) + 4 * n + (i & 3); }

struct Unit { int pm, pn, e, aux, n; };

struct StaticOrder {
    static constexpr bool GATHER = false;
    const char* A; const char* Bt; int K;
    int nM, nN, nwg, G, c;
    __device__ void init(const void* A_, const void* Bt_, int M, int N, int K_, int G_, int c_) { A = (const char*)A_; Bt = (const char*)Bt_; K = K_; nM = M / BM; nN = N / BM; nwg = nM * nN; G = G_; c = c_; }
    __device__ bool next(int i, Unit& u) const {
        const long L = (long)i * G + c; if (L >= nwg) return false;
        int wgid = (int)L; { const int q = nwg / NXCD, r = nwg % NXCD, xcd = wgid % NXCD, off = wgid / NXCD; wgid = (xcd < r ? xcd * (q + 1) : r * (q + 1) + (xcd - r) * q) + off; }
        const int nig = WGM * nN, gid = wgid / nig, fm = gid * WGM, gsz = (nM - fm) < WGM ? (nM - fm) : WGM;
        u.pm = fm + ((wgid % nig) % gsz); u.pn = (wgid % nig) / gsz; u.e = 0; u.aux = 0; u.n = BM; return true;
    }
    __device__ __forceinline__ const char* a_ptr(const Unit& u) const { return A + (size_t)u.pm * BM * K * 2; }
    __device__ __forceinline__ const char* b_ptr(const Unit& u) const { return Bt + (size_t)u.pn * BM * K * 2; }
    __device__ __forceinline__ unsigned a_row(const Unit&, int r) const { return (unsigned)r; }
};

template <class Epi, class Sched, bool ALIGN_EPI, bool FP8 = false>
__device__ __forceinline__ void gemm_phase(LAS unsigned char* lds, const Sched& S, const Epi& E) {
    int tid = threadIdx.x; asm volatile("" : "+v"(tid));
    const int wid = __builtin_amdgcn_readfirstlane(tid >> 6), lane = tid & 63, wr = wid >> 2, wc = wid & 3, fr = lane & 15, fq = lane >> 4;
    const int K = S.K, nt = K / BK;
    unsigned voffB[2], voffA[2];
#pragma unroll
    for (int i = 0; i < 2; ++i) { int R, C; stage_rc(tid * 16 + i * 8192, R, C); const int Rb = (R & ~31) + perm32(R & 31);
        voffA[i] = (unsigned)(R * K + C) * 2u; voffB[i] = (unsigned)(Rb * K + C) * 2u; }
    unsigned vA[2][2], vN[2][2];
    const size_t kstep = (size_t)(BK * 2);
    const size_t hstep = (size_t)HALF * K * 2;
    const unsigned ldsw = (unsigned)wid * 1024u;
    const int aoff = lds_byte(wr * 64 + fr, fq * 8), boff = lds_byte(wc * 32 + fr, fq * 8);
#define PG8_SA(b, h) (((b) * 2 + (h)) * HTB)
#define PG8_SB(b, h) ((4 + (b) * 2 + (h)) * HTB)
#define PG8_STAGE(bufoff, gbase, voff) do { _Pragma("unroll") for (int _i = 0; _i < 2; ++_i) \
        __builtin_amdgcn_global_load_lds((const unsigned*)((const char*)(gbase) + (voff)[_i]), (LAS unsigned*)(lds + (bufoff) + ldsw + _i * 8192), 16, 0, 0); } while (0)
#define PG8_STAGE_A(bufoff, gbase, h, nx) do { if constexpr (Sched::GATHER) { const unsigned vs_[2] = {(nx) ? vN[h][0] : vA[h][0], (nx) ? vN[h][1] : vA[h][1]}; PG8_STAGE(bufoff, gbase, vs_); }     \
        else PG8_STAGE(bufoff, (const char*)(gbase) + (h) * hstep, voffA); } while (0)
#define PG8_LDA(dst, b, h) do { _Pragma("unroll") for (int m = 0; m < 4; ++m) { if constexpr (FP8) { dst##8[m].lo = *(const LAS v4i32_t*)(lds + PG8_SA(b, h) + aoff + m * 2048); dst##8[m].hi = *(const LAS v4i32_t*)(lds + PG8_SA(b, h) + aoff + m * 2048 + 1024); } \
        else { _Pragma("unroll") for (int k = 0; k < 2; ++k) dst[m][k] = *(const LAS bf16x8*)(lds + PG8_SA(b, h) + aoff + m * 2048 + k * 1024); } } } while (0)
#define PG8_LDB(dst, b, h) do { _Pragma("unroll") for (int n = 0; n < 2; ++n) { if constexpr (FP8) { dst##8[n].lo = *(const LAS v4i32_t*)(lds + PG8_SB(b, h) + boff + n * 2048); dst##8[n].hi = *(const LAS v4i32_t*)(lds + PG8_SB(b, h) + boff + n * 2048 + 1024); } \
        else { _Pragma("unroll") for (int k = 0; k < 2; ++k) dst[n][k] = *(const LAS bf16x8*)(lds + PG8_SB(b, h) + boff + n * 2048 + k * 1024); } } } while (0)
#define PG8_MMA(ai, bj, At, Bt) do { __builtin_amdgcn_s_setprio(1); _Pragma("unroll") for (int m = 0; m < 4; ++m) _Pragma("unroll") for (int n = 0; n < 2; ++n) { \
        if constexpr (FP8) asm volatile("v_mfma_scale_f32_16x16x128_f8f6f4 %0, %1, %2, %0, %3, %3 op_sel_hi:[0,0,0]" : "+v"(acc[ai][bj][m][n]) : "v"(Bt##8[n]), "v"(At##8[m]), "v"(sc1_));     \
        else { _Pragma("unroll") for (int k = 0; k < 2; ++k) acc[ai][bj][m][n] = __builtin_amdgcn_mfma_f32_16x16x32_bf16(Bt[n][k], At[m][k], acc[ai][bj][m][n], 0, 0, 0); } } \
        __builtin_amdgcn_s_setprio(0); } while (0)
#define PG8_WAIT_V(n) asm volatile("s_waitcnt vmcnt(" #n ")" ::: "memory")
#define PG8_WAIT_L(n) asm volatile("s_waitcnt lgkmcnt(" #n ")" ::: "memory")
#define PG8_BAR __builtin_amdgcn_s_barrier()
#define PG8_SCHED __builtin_amdgcn_sched_barrier(0)
#define PG8_SETV(dst, u) do { _Pragma("unroll") for (int _h = 0; _h < 2; ++_h) _Pragma("unroll") for (int _i = 0; _i < 2; ++_i) { int R_, C_; stage_rc(tid * 16 + _i * 8192, R_, C_); \
        dst[_h][_i] = (S.a_row(u, _h * HALF + R_) * (unsigned)K + (unsigned)C_) * 2u; } } while (0)
    Unit cur, nxt; int ui = 0;
    if (!S.next(0, cur)) return;
    f32x4 acc[2][2][4][2];
#define PG8_ZERO() do { _Pragma("unroll") for (int a = 0; a < 2; ++a) _Pragma("unroll") for (int b = 0; b < 2; ++b) _Pragma("unroll") for (int m = 0; m < 4; ++m) _Pragma("unroll") for (int n = 0; n < 2; ++n) { \
        if constexpr (FP8) asm volatile("v_mov_b32 %0, 0\n\tv_mov_b32 %1, 0\n\tv_mov_b32 %2, 0\n\tv_mov_b32 %3, 0" : "=v"(acc[a][b][m][n][0]), "=v"(acc[a][b][m][n][1]), "=v"(acc[a][b][m][n][2]), "=v"(acc[a][b][m][n][3])); \
        else acc[a][b][m][n] = (f32x4){0.f, 0.f, 0.f, 0.f}; } } while (0)
    PG8_ZERO();
    unsigned sc1_ = 0x7f7f7f7fu; asm volatile("" : "+v"(sc1_));
    (void)sc1_;
    bf16x8 At[4][2], B0[2][2], B1[2][2];
    v8i32_t At8[4], B08[2], B18[2];
    (void)At; (void)B0; (void)B1; (void)At8; (void)B08; (void)B18;
    const char* cA = S.a_ptr(cur); const char* cB = S.b_ptr(cur);
    if constexpr (Sched::GATHER) { PG8_SETV(vA, cur); }
    PG8_STAGE(PG8_SB(0, 0), cB, voffB); PG8_STAGE(PG8_SB(0, 1), cB + hstep, voffB); PG8_STAGE_A(PG8_SA(0, 0), cA, 0, false); PG8_STAGE_A(PG8_SA(0, 1), cA, 1, false);
    if (wr == 1) PG8_BAR;
    PG8_WAIT_V(2); PG8_BAR;
    PG8_STAGE(PG8_SB(1, 0), cB + kstep, voffB); PG8_STAGE_A(PG8_SA(1, 0), cA + kstep, 0, false); PG8_STAGE(PG8_SB(1, 1), cB + hstep + kstep, voffB);
    PG8_WAIT_V(6); PG8_BAR;
    for (;;) {
        const bool has_next = S.next(ui + 1, nxt);
        const char* nA = has_next ? S.a_ptr(nxt) : cA; const char* nB = has_next ? S.b_ptr(nxt) : cB;
        if constexpr (Sched::GATHER) { if (has_next) { PG8_SETV(vN, nxt); } else {
#pragma unroll
            for (int h = 0; h < 2; ++h)
#pragma unroll
                for (int i = 0; i < 2; ++i) vN[h][i] = vA[h][i]; } }
        for (int t = 0; t < nt; t += 2) {
            const bool last = (t == nt - 2);
            if constexpr (Epi::MIDK) { if (t == nt / 2) E.mid(acc, cur, wr, wc, fr, fq); }
            const char* a1 = cA + (size_t)(t + 1) * kstep;
            const char* a2 = last ? nA : cA + (size_t)(t + 2) * kstep; const char* b2 = last ? nB : cB + (size_t)(t + 2) * kstep;
            const char* a3 = a2 + kstep; const char* b3 = b2 + kstep;
            PG8_LDB(B0, 0, 0); PG8_LDB(B1, 0, 1); PG8_SCHED; PG8_LDA(At, 0, 0); PG8_STAGE_A(PG8_SA(1, 1), a1, 1, false);
            PG8_WAIT_V(8); PG8_WAIT_L(0); PG8_BAR; PG8_MMA(0, 0, At, B0); PG8_MMA(0, 1, At, B1); PG8_BAR; PG8_SCHED;
            PG8_LDA(At, 0, 1); PG8_STAGE(PG8_SB(0, 0), b2, voffB); PG8_STAGE(PG8_SB(0, 1), b2 + hstep, voffB); PG8_STAGE_A(PG8_SA(0, 0), a2, 0, last);
            PG8_WAIT_V(8); PG8_WAIT_L(0); PG8_BAR; PG8_MMA(1, 0, At, B0); PG8_MMA(1, 1, At, B1); PG8_BAR; PG8_SCHED;
            PG8_LDB(B0, 1, 0); PG8_LDB(B1, 1, 1); PG8_SCHED; PG8_LDA(At, 1, 0); PG8_STAGE_A(PG8_SA(0, 1), a2, 1, last);
            PG8_WAIT_V(8); PG8_WAIT_L(0); PG8_BAR; PG8_MMA(0, 0, At, B0); PG8_MMA(0, 1, At, B1); PG8_BAR; PG8_SCHED;
            PG8_LDA(At, 1, 1); PG8_STAGE(PG8_SB(1, 0), b3, voffB); PG8_STAGE(PG8_SB(1, 1), b3 + hstep, voffB); PG8_STAGE_A(PG8_SA(1, 0), a3, 0, last);
            PG8_WAIT_V(8); PG8_WAIT_L(0); PG8_BAR; PG8_MMA(1, 0, At, B0); PG8_MMA(1, 1, At, B1); PG8_BAR; PG8_SCHED;
        }
        if constexpr (ALIGN_EPI) { if (wr == 0) PG8_BAR; }
        if constexpr (FP8) asm volatile("s_nop 15\n\ts_nop 7" ::: "memory");
        E(acc, cur, wr, wc, fr, fq);
        if (!has_next) break;
        PG8_ZERO();
        cur = nxt; cA = nA; cB = nB; ++ui;
        if constexpr (Sched::GATHER) {
#pragma unroll
            for (int h = 0; h < 2; ++h)
#pragma unroll
                for (int i = 0; i < 2; ++i) vA[h][i] = vN[h][i]; }
        if constexpr (ALIGN_EPI) { if (wr == 1) PG8_BAR; }
    }
    PG8_WAIT_V(0);
    if constexpr (!ALIGN_EPI) { if (wr == 0) PG8_BAR; }
    PG8_BAR;
#undef PG8_SA
#undef PG8_SB
#undef PG8_STAGE
#undef PG8_STAGE_A
#undef PG8_LDA
#undef PG8_LDB
#undef PG8_MMA
#undef PG8_ZERO
#undef PG8_WAIT_V
#undef PG8_WAIT_L
#undef PG8_BAR
#undef PG8_SCHED
#undef PG8_SETV
}
}
using pg8::Unit;

#define EPI_ROWS(ai, m) for (int ai = 0; ai < 2; ++ai) for (int m = 0; m < 4; ++m)

struct EpiInProj {
    static constexpr bool MIDK = false;
    bf16 *qlat, *kvlat, *kpe, *fq, *gates; float *logf, *ssqq, *ssqkv; const float* ropetab; const float* bforget;
    __device__ __forceinline__ void operator()(const f32x4 (&acc)[2][2][4][2], const Unit& u, int wr, int wc, int fr, int fq_) const {
        const int pn = u.pn, row0 = u.pm * 256 + wr * 64 + fr, c0 = wc * 32 + 8 * fq_;
#pragma unroll
        for (int ai = 0; ai < 2; ++ai)
#pragma unroll
            for (int m = 0; m < 4; ++m) {
                const int row = row0 + ai * 128 + m * 16;
                if (pn == 0) {
                    float s = 0.f;
#pragma unroll
                    for (int bj = 0; bj < 2; ++bj) { const f32x4 v0 = acc[ai][bj][m][0], v1 = acc[ai][bj][m][1];
                        s += (v0[0] * v0[0] + v0[1] * v0[1]) + (v0[2] * v0[2] + v0[3] * v0[3]) + (v1[0] * v1[0] + v1[1] * v1[1]) + (v1[2] * v1[2] + v1[3] * v1[3]);
                        *(u32x4*)(qlat + (size_t)row * QLORA + c0 + 128 * bj) = pack8(v0, v1); }
                    s += __shfl_xor(s, 16); s += __shfl_xor(s, 32);
                    if (fq_ == 0) ssqq[row * 4 + wc] = s;
                } else if (pn == 1) {
                    { const f32x4 v0 = acc[ai][0][m][0], v1 = acc[ai][0][m][1];
                      float s = (v0[0] * v0[0] + v0[1] * v0[1]) + (v0[2] * v0[2] + v0[3] * v0[3]) + (v1[0] * v1[0] + v1[1] * v1[1]) + (v1[2] * v1[2] + v1[3] * v1[3]);
                      *(u32x4*)(kvlat + (size_t)row * KVPAD + c0) = pack8(v0, v1);
                      s += __shfl_xor(s, 16); s += __shfl_xor(s, 32);
                      if (fq_ == 0) ssqkv[row * 4 + wc] = s; }
                    { const f32x4 v0 = acc[ai][1][m][0], v1 = acc[ai][1][m][1];
                      *(u32x4*)(kvlat + (size_t)row * KVPAD + 128 + c0) = (u32x4){0u, 0u, 0u, 0u};
                      if (wc == 0) {
                          const f32x4* tb = (const f32x4*)(ropetab + ((size_t)row * 16 + 4 * fq_) * 2);
                          const f32x4 t0 = tb[0], t1 = tb[1];
                          f32x4 o1, o2;
                          o1[0] = v0[0] * t0[0] - v1[0] * t0[1]; o2[0] = v1[0] * t0[0] + v0[0] * t0[1];
                          o1[1] = v0[1] * t0[2] - v1[1] * t0[3]; o2[1] = v1[1] * t0[2] + v0[1] * t0[3];
                          o1[2] = v0[2] * t1[0] - v1[2] * t1[1]; o2[2] = v1[2] * t1[0] + v0[2] * t1[1];
                          o1[3] = v0[3] * t1[2] - v1[3] * t1[3]; o2[3] = v1[3] * t1[2] + v0[3] * t1[3];
                          *(u32x4*)(kpe + (size_t)row * ROPE + 8 * fq_) = pack8(o1, o2);
                      } else if (wc == 1 && fq_ == 0) {
                          f32x4 l0, l1;
#pragma unroll
                          for (int h = 0; h < 4; ++h) { const float z0 = v0[h] + bforget[h], z1 = v1[h] + bforget[4 + h];
                              l0[h] = (fminf(z0, 0.f) - log1pf(expf(-fabsf(z0)))) * LOG2E; l1[h] = (fminf(z1, 0.f) - log1pf(expf(-fabsf(z1)))) * LOG2E; }
                          *(f32x4*)(logf + (size_t)row * 8) = l0; *(f32x4*)(logf + (size_t)row * 8 + 4) = l1;
                      } }
                } else if (pn < 8) {
                    bf16* dst = fq + (size_t)((pn - 2) >> 1) * ((size_t)T * 512); const float sc = (pn < 4) ? C2F : 1.f;
#pragma unroll
                    for (int bj = 0; bj < 2; ++bj) *(u32x4*)(dst + (size_t)row * 512 + (pn & 1) * 256 + c0 + 128 * bj) = pack8(acc[ai][bj][m][0] * sc, acc[ai][bj][m][1] * sc);
                } else {
#pragma unroll
                    for (int bj = 0; bj < 2; ++bj) { f32x4 v0 = acc[ai][bj][m][0], v1 = acc[ai][bj][m][1];
#pragma unroll
                        for (int q = 0; q < 4; ++q) { v0[q] = fmaxf(sigmoidf_(v0[q]), 1e-30f); v1[q] = fmaxf(sigmoidf_(v1[q]), 1e-30f); }
                        *(u32x4*)(gates + (size_t)row * 2048 + (pn - 8) * 256 + c0 + 128 * bj) = pack8(v0, v1); }
                }
            }
    }
};

struct EpiQup {
    static constexpr bool MIDK = false;
    bf16* q; const float* ssqq; const float* ropetab;
    __device__ __forceinline__ void operator()(const f32x4 (&acc)[2][2][4][2], const Unit& u, int wr, int wc, int fr, int fq_) const {
        const int row0 = u.pm * 256 + wr * 64 + fr, c0 = u.pn * 256 + wc * 32 + 8 * fq_;
#pragma unroll
        for (int ai = 0; ai < 2; ++ai)
#pragma unroll
            for (int m = 0; m < 4; ++m) {
                const int row = row0 + ai * 128 + m * 16;
                const f32x4 sq = *(const f32x4*)(ssqq + row * 4);
                const float rs = rsqrtf(((sq[0] + sq[1]) + (sq[2] + sq[3])) * (1.f / QLORA) + EPS) * C2M;
#pragma unroll
                for (int bj = 0; bj < 2; ++bj) {
                    const int col = c0 + 128 * bj, j = col % MQK;
                    f32x4 v0 = acc[ai][bj][m][0] * rs, v1 = acc[ai][bj][m][1] * rs;
                    if (j >= 64) { const int g = (j - 64) >> 3;
                        const f32x4* tb = (const f32x4*)(ropetab + ((size_t)row * 16 + 4 * g) * 2);
                        const f32x4 t0 = tb[0], t1 = tb[1];
                        f32x4 o1, o2;
                        o1[0] = v0[0] * t0[0] - v1[0] * t0[1]; o2[0] = v1[0] * t0[0] + v0[0] * t0[1];
                        o1[1] = v0[1] * t0[2] - v1[1] * t0[3]; o2[1] = v1[1] * t0[2] + v0[1] * t0[3];
                        o1[2] = v0[2] * t1[0] - v1[2] * t1[1]; o2[2] = v1[2] * t1[0] + v0[2] * t1[1];
                        o1[3] = v0[3] * t1[2] - v1[3] * t1[3]; o2[3] = v1[3] * t1[2] + v0[3] * t1[3];
                        v0 = o1; v1 = o2; }
                    *(u32x4*)(q + (size_t)row * 768 + col) = pack8(v0, v1);
                }
            }
    }
};

struct EpiKVup {
    static constexpr bool MIDK = false;
    bf16 *kn, *vm; const float* ssqkv;
    __device__ __forceinline__ void operator()(const f32x4 (&acc)[2][2][4][2], const Unit& u, int wr, int wc, int fr, int fq_) const {
        const int row0 = u.pm * 256 + wr * 64 + fr, c0 = u.pn * 256 + wc * 32 + 8 * fq_;
        bf16* dst = (u.pn < 2) ? kn : vm; const int cb = (u.pn & 1) * 256 + wc * 32 + 8 * fq_;
        (void)c0;
#pragma unroll
        for (int ai = 0; ai < 2; ++ai)
#pragma unroll
            for (int m = 0; m < 4; ++m) {
                const int row = row0 + ai * 128 + m * 16;
                const f32x4 sq = *(const f32x4*)(ssqkv + row * 4);
                const float rs = rsqrtf(((sq[0] + sq[1]) + (sq[2] + sq[3])) * (1.f / KVLORA) + EPS);
#pragma unroll
                for (int bj = 0; bj < 2; ++bj) *(u32x4*)(dst + (size_t)row * 512 + cb + 128 * bj) = pack8(acc[ai][bj][m][0] * rs, acc[ai][bj][m][1] * rs);
            }
    }
};

struct EpiPartA {
    static constexpr bool MIDK = false;
    float* part; const bf16* gates;
    __device__ __forceinline__ void operator()(const f32x4 (&acc)[2][2][4][2], const Unit& u, int wr, int wc, int fr, int fq_) const {
        const int row0 = u.pm * 256 + wr * 64 + fr, c0 = u.pn * 256 + wc * 32 + 8 * fq_;
#pragma unroll
        for (int ai = 0; ai < 2; ++ai)
#pragma unroll
            for (int m = 0; m < 4; ++m) {
                const int row = row0 + ai * 128 + m * 16;
#pragma unroll
                for (int bj = 0; bj < 2; ++bj) { const int col = c0 + 128 * bj;
                    f32x4 g0, g1; unpack8(*(const u32x4*)(gates + (size_t)row * 2048 + col), g0, g1);
                    *(f32x4*)(part + (size_t)row * D + col) = g0 * acc[ai][bj][m][0]; *(f32x4*)(part + (size_t)row * D + col + 4) = g1 * acc[ai][bj][m][1]; }
            }
    }
};
struct EpiMerged {
    static constexpr bool MIDK = false;
    const float* part; const bf16* gates; bf16* merged;
    __device__ __forceinline__ void operator()(const f32x4 (&acc)[2][2][4][2], const Unit& u, int wr, int wc, int fr, int fq_) const {
        const int row0 = u.pm * 256 + wr * 64 + fr, c0 = u.pn * 256 + wc * 32 + 8 * fq_;
#pragma unroll
        for (int ai = 0; ai < 2; ++ai)
#pragma unroll
            for (int m = 0; m < 4; ++m) {
                const int row = row0 + ai * 128 + m * 16;
#pragma unroll
                for (int bj = 0; bj < 2; ++bj) { const int col = c0 + 128 * bj;
                    f32x4 g0, g1; unpack8(*(const u32x4*)(gates + (size_t)row * 2048 + 1024 + col), g0, g1);
                    const f32x4 p0 = *(const f32x4*)(part + (size_t)row * D + col), p1 = *(const f32x4*)(part + (size_t)row * D + col + 4);
                    *(u32x4*)(merged + (size_t)row * D + col) = pack8(p0 + g0 * acc[ai][bj][m][0], p1 + g1 * acc[ai][bj][m][1]); }
            }
    }
};
struct EpiMergedCat {
    static constexpr bool MIDK = true;
    const bf16* gates; unsigned char* merged; float sc;
    __device__ __forceinline__ void mid(f32x4 (&acc)[2][2][4][2], const Unit& u, int wr, int wc, int fr, int fq_) const {
        int row0 = u.pm * 256 + wr * 64 + fr, c0 = u.pn * 256 + wc * 32 + 8 * fq_;
        asm volatile("" : "+v"(row0), "+v"(c0));
#pragma unroll
        for (int ai = 0; ai < 2; ++ai)
#pragma unroll
            for (int m = 0; m < 4; ++m) { const int row = row0 + ai * 128 + m * 16;
#pragma unroll
                for (int bj = 0; bj < 2; ++bj) { const int col = c0 + 128 * bj;
                    f32x4 a0, a1, b0, b1; unpack8(*(const u32x4*)(gates + (size_t)row * 2048 + col), a0, a1); unpack8(*(const u32x4*)(gates + (size_t)row * 2048 + 1024 + col), b0, b1);
#pragma unroll
                    for (int q = 0; q < 4; ++q) { acc[ai][bj][m][0][q] *= a0[q] * __builtin_amdgcn_rcpf(b0[q]); acc[ai][bj][m][1][q] *= a1[q] * __builtin_amdgcn_rcpf(b1[q]); } }
                asm volatile("" ::: "memory"); }
    }
    __device__ __forceinline__ void operator()(const f32x4 (&acc)[2][2][4][2], const Unit& u, int wr, int wc, int fr, int fq_) const {
        const int row0 = u.pm * 256 + wr * 64 + fr, c0 = u.pn * 256 + wc * 32 + 8 * fq_;
#pragma unroll
        for (int ai = 0; ai < 2; ++ai)
#pragma unroll
            for (int m = 0; m < 4; ++m) { const int row = row0 + ai * 128 + m * 16;
#pragma unroll
                for (int bj = 0; bj < 2; ++bj) { const int col = c0 + 128 * bj;
                    f32x4 b0, b1; unpack8(*(const u32x4*)(gates + (size_t)row * 2048 + 1024 + col), b0, b1);
                    const f32x4 v0 = b0 * acc[ai][bj][m][0] * sc, v1 = b1 * acc[ai][bj][m][1] * sc;
                    u32x2 o; int p_ = __builtin_amdgcn_cvt_pk_fp8_f32(v0[0], v0[1], 0, false); p_ = __builtin_amdgcn_cvt_pk_fp8_f32(v0[2], v0[3], p_, true); o.x = (unsigned)p_;
                    p_ = __builtin_amdgcn_cvt_pk_fp8_f32(v1[0], v1[1], 0, false); p_ = __builtin_amdgcn_cvt_pk_fp8_f32(v1[2], v1[3], p_, true); o.y = (unsigned)p_;
                    *(u32x2*)(merged + (size_t)row * D + col) = o; } }
    }
};
struct EpiOut {
    static constexpr bool MIDK = false;
    const float* x; float* x1; const float* mod; float* ssq1; float sc;
    __device__ __forceinline__ void operator()(const f32x4 (&acc)[2][2][4][2], const Unit& u, int wr, int wc, int fr, int fq_) const {
        const int row0 = u.pm * 256 + wr * 64 + fr, c0 = u.pn * 256 + wc * 32 + 8 * fq_;
        const float* gm = mod + (size_t)((u.pm * 256) / SEQ) * 6 * D + 2 * D;
        f32x4 g[2][2];
#pragma unroll
        for (int bj = 0; bj < 2; ++bj) { g[bj][0] = *(const f32x4*)(gm + c0 + 128 * bj) * sc; g[bj][1] = *(const f32x4*)(gm + c0 + 128 * bj + 4) * sc; }
#pragma unroll
        for (int ai = 0; ai < 2; ++ai)
#pragma unroll
            for (int m = 0; m < 4; ++m) { const int row = row0 + ai * 128 + m * 16; float sq = 0.f;
#pragma unroll
                for (int bj = 0; bj < 2; ++bj) { const int col = c0 + 128 * bj;
                    const f32x4 x0 = __builtin_nontemporal_load((const f32x4*)(x + (size_t)row * D + col)), x1v = __builtin_nontemporal_load((const f32x4*)(x + (size_t)row * D + col + 4));
                    const f32x4 r0 = x0 + g[bj][0] * acc[ai][bj][m][0], r1 = x1v + g[bj][1] * acc[ai][bj][m][1];
                    *(f32x4*)(x1 + (size_t)row * D + col) = r0; *(f32x4*)(x1 + (size_t)row * D + col + 4) = r1;
                    sq += (r0[0] * r0[0] + r0[1] * r0[1]) + (r0[2] * r0[2] + r0[3] * r0[3]) + (r1[0] * r1[0] + r1[1] * r1[1]) + (r1[2] * r1[2] + r1[3] * r1[3]); }
                sq += __shfl_xor(sq, 16); sq += __shfl_xor(sq, 32);
                if (fq_ == 0) ssq1[(size_t)row * 16 + 4 * u.pn + wc] = sq; }
    }
};
struct EpiHb {
    static constexpr bool MIDK = false;
    bf16* hb; float sc;
    __device__ __forceinline__ void operator()(const f32x4 (&acc)[2][2][4][2], const Unit& u, int wr, int wc, int fr, int fq_) const {
        const int row0 = u.pm * 256 + wr * 64 + fr, c0 = u.pn * 128 + wc * 32 + 8 * fq_;
#pragma unroll
        for (int ai = 0; ai < 2; ++ai)
#pragma unroll
            for (int m = 0; m < 4; ++m) { const int row = row0 + ai * 128 + m * 16;
                f32x4 h0, h1;
#pragma unroll
                for (int q = 0; q < 4; ++q) { h0[q] = siluf_(acc[ai][0][m][0][q] * sc) * (acc[ai][1][m][0][q] * sc); h1[q] = siluf_(acc[ai][0][m][1][q] * sc) * (acc[ai][1][m][1][q] * sc); }
                *(u32x4*)(hb + (size_t)row * DEXP + c0) = pack8(h0, h1); }
    }
};
struct EpiDown {
    static constexpr bool MIDK = false;
    bf16* Y; float* out; float* outw; const float* mod; const unsigned short* list; const unsigned char* eidx; const float* gatew;
    __device__ __forceinline__ void operator()(const f32x4 (&acc)[2][2][4][2], const Unit& u, int wr, int wc, int fr, int fq_) const {
        const int c0 = u.pn * 256 + wc * 32 + 8 * fq_;
#pragma unroll
        for (int ai = 0; ai < 2; ++ai)
#pragma unroll
            for (int m = 0; m < 4; ++m) {
                const int rl = wr * 64 + fr + ai * 128 + m * 16, idx = u.aux * 256 + rl;
                if (u.e == NEXP) {
                    const int t = idx; const float* gf = mod + (size_t)(t / SEQ) * 6 * D + 5 * D;
#pragma unroll
                    for (int bj = 0; bj < 2; ++bj) { const int col = c0 + 128 * bj; const float* o = out + (size_t)t * D + col; float* ow = outw + (size_t)t * D + col;
                        const f32x4 g0 = *(const f32x4*)(gf + col), g1 = *(const f32x4*)(gf + col + 4);
                        const f32x4 x0 = *(const f32x4*)o, x1v = *(const f32x4*)(o + 4);
                        *(f32x4*)ow = x0 + g0 * acc[ai][bj][m][0]; *(f32x4*)(ow + 4) = x1v + g1 * acc[ai][bj][m][1]; }
                } else if (idx < u.n) {
                    const int t = list[(size_t)u.e * LISTCAP + idx];
                    const u32x2 ev = *(const u32x2*)(eidx + (size_t)t * 8);
                    int k = 0;
#pragma unroll
                    for (int q = 1; q < TOPK; ++q) { const unsigned b = (q < 4) ? ((ev.x >> (8 * q)) & 0xffu) : ((ev.y >> (8 * (q - 4))) & 0xffu); if ((int)b == u.e) k = q; }
                    const float w = gatew[(size_t)t * 8 + k];
#pragma unroll
                    for (int bj = 0; bj < 2; ++bj) *(u32x4*)(Y + ((size_t)t * TOPK + k) * D + c0 + 128 * bj) = pack8(acc[ai][bj][m][0] * w, acc[ai][bj][m][1] * w);
                }
            }
    }
};

template <int NT, bool GATHER_>
struct MoeOrder {
    static constexpr bool GATHER = GATHER_;
    const char* A; const char* Bt; const char* Bsh; int K; size_t bstride;
    const unsigned short* list; volatile LAS int* tab;
    int G, c;
    __device__ bool next(int i, Unit& u) const {
        int ti, pn_;
        if ((G & 7) == 0) { const int x = c & 7, j = i * (G >> 3) + (c >> 3); ti = (j / NT) * 8 + x; pn_ = j % NT; if (ti >= tab[65]) return false; }
        else { const int total = tab[65] * NT; const long L = (long)i * G + c; if (L >= total) return false; ti = (int)L / NT; pn_ = (int)L % NT; }
        u.pn = pn_; u.pm = ti;
        const int e = __builtin_amdgcn_readfirstlane(tab[132 + ti]);
        u.e = e; u.aux = __builtin_amdgcn_readfirstlane(ti - tab[e]); u.n = __builtin_amdgcn_readfirstlane(tab[66 + e]); return true;
    }
    __device__ __forceinline__ const char* a_ptr(const Unit& u) const { return GATHER ? A : A + (size_t)u.pm * 256 * K * 2; }
    __device__ __forceinline__ const char* b_ptr(const Unit& u) const { return (u.e == NEXP ? Bsh : Bt + (size_t)u.e * bstride) + (size_t)u.pn * 256 * K * 2; }
    __device__ __forceinline__ unsigned a_row(const Unit& u, int r) const {
        if (!GATHER) return (unsigned)r;
        const int idx = u.aux * 256 + r;
        if (u.e == NEXP) return (unsigned)idx;
        return (idx < u.n) ? (unsigned)list[(size_t)u.e * LISTCAP + idx] : 0u;
    }
};

struct UpOrder {
    static constexpr bool GATHER = false;
    const char* Aq; const char* Bq; const char* Akv; const char* Bkv; int K; int G, c;
    __device__ bool next(int i, Unit& u) const {
        int L = i * G + c; if (L >= 448) return false;
        if (L < 256) { u.e = 1; u.pm = L >> 2; u.pn = L & 3; } else { L -= 256; u.e = 0; u.pm = L / 3; u.pn = L % 3; }
        u.aux = 0; u.n = 256; return true; }
    __device__ __forceinline__ const char* a_ptr(const Unit& u) const { return (u.e ? Akv : Aq) + (size_t)u.pm * 256 * K * 2; }
    __device__ __forceinline__ const char* b_ptr(const Unit& u) const { return (u.e ? Bkv : Bq) + (size_t)u.pn * 256 * K * 2; }
    __device__ __forceinline__ unsigned a_row(const Unit&, int r) const { return (unsigned)r; }
};
struct EpiUp {
    static constexpr bool MIDK = false;
    EpiQup q; EpiKVup kv;
    __device__ __forceinline__ void operator()(const f32x4 (&acc)[2][2][4][2], const Unit& u, int wr, int wc, int fr, int fq_) const { if (u.e) kv(acc, u, wr, wc, fr, fq_); else q(acc, u, wr, wc, fr, fq_); }
};

struct SharedDownOrder {
    static constexpr bool GATHER = false;
    const char* A; const char* Bt; int K; int G, c;
    __device__ bool next(int i, Unit& u) const { const int L = i * G + c; if (L >= (T / 256) * 4) return false; u.pm = L >> 2; u.pn = L & 3; u.e = NEXP; u.aux = L >> 2; u.n = 256; return true; }
    __device__ __forceinline__ const char* a_ptr(const Unit& u) const { return A + (size_t)u.pm * 256 * K * 2; }
    __device__ __forceinline__ const char* b_ptr(const Unit& u) const { return Bt + (size_t)u.pn * 256 * K * 2; }
    __device__ __forceinline__ unsigned a_row(const Unit&, int r) const { return (unsigned)r; }
};

namespace att {
constexpr int KSLOT = 12288, VSLOT = 8192;
constexpr int L_K = 0, L_V = 3 * KSLOT, L_F = L_V + 2 * VSLOT, L_WS = L_F + 3 * 256, L_OST = L_WS + 2048, L_END = L_OST + 8 * 4096;
static_assert(L_END <= RING_BYTES, "attention LDS");
__device__ __forceinline__ int crow(int r, int hi) { return (r & 3) + 8 * (r >> 2) + 4 * hi; }
__device__ __forceinline__ float max3f(float a, float b, float c) { return fmaxf(fmaxf(a, b), c); }
__device__ __forceinline__ float rowmax(const f32x16& p0, const f32x16& p1) {
    float a = max3f(p0[0], p0[1], p1[0]), b = max3f(p0[2], p0[3], p1[1]); a = max3f(a, p1[2], p1[3]);
#pragma unroll
    for (int r = 4; r < 16; r += 4) { a = max3f(a, p0[r], p0[r + 1]); b = max3f(b, p0[r + 2], p0[r + 3]); a = max3f(a, p1[r], p1[r + 1]); b = max3f(b, p1[r + 2], p1[r + 3]); }
    const float m = fmaxf(a, b);
    auto rr = __builtin_amdgcn_permlane32_swap(__float_as_uint(m), __float_as_uint(m), false, false);
    return fmaxf(__uint_as_float(rr[0]), __uint_as_float(rr[1]));
}
__device__ __forceinline__ void cmask(f32x16& p0, f32x16& p1, int jb, int qrel, int hi) {
    const float NEG = -INFINITY; const int kb = 64 * jb + 4 * hi;
#pragma unroll
    for (int r = 0; r < 16; ++r) { const int kv = kb + (r & 3) + 8 * (r >> 2); if (kv > qrel) p0[r] = NEG; if (kv + 32 > qrel) p1[r] = NEG; }
}
__device__ __forceinline__ void pv(f32x16* o, int vb, bf16x8 pa0, bf16x8 pa1, bf16x8 pa2, bf16x8 pa3) {
#pragma unroll
    for (int d0 = 0; d0 < 2; ++d0) { s16x4 lo[4], hi[4];
#pragma unroll
        for (int ks = 0; ks < 4; ++ks) {
            asm volatile("ds_read_b64_tr_b16 %0,%1 offset:%c2" : "=&v"(lo[ks]) : "v"(vb), "i"(d0 * 4096 + ks * 1024) : "memory");
            asm volatile("ds_read_b64_tr_b16 %0,%1 offset:%c2" : "=&v"(hi[ks]) : "v"(vb), "i"(d0 * 4096 + ks * 1024 + 512) : "memory"); }
        asm volatile("s_waitcnt lgkmcnt(0)" ::: "memory"); __builtin_amdgcn_sched_barrier(0);
#define PK(k) (bf16x8){lo[k][0], lo[k][1], lo[k][2], lo[k][3], hi[k][0], hi[k][1], hi[k][2], hi[k][3]}
        o[d0] = __builtin_amdgcn_mfma_f32_32x32x16_bf16(pa0, PK(0), o[d0], 0, 0, 0);
        o[d0] = __builtin_amdgcn_mfma_f32_32x32x16_bf16(pa1, PK(1), o[d0], 0, 0, 0);
        o[d0] = __builtin_amdgcn_mfma_f32_32x32x16_bf16(pa2, PK(2), o[d0], 0, 0, 0);
        o[d0] = __builtin_amdgcn_mfma_f32_32x32x16_bf16(pa3, PK(3), o[d0], 0, 0, 0);
#undef PK
    }
}
__device__ __forceinline__ unsigned cvtpk_s(float lo, float hi) { return cvt_pk_bf16(lo, hi); }

template <int DQK, bool DECAY, int THRL>
__device__ __forceinline__ void attn_unit(int b, int h, int qb, const bf16* Q, int QP, const bf16* Kn, const bf16* Kpe, const bf16* V, const float* cumF, bf16* O, int OP, LAS unsigned char* lds) {
    constexpr int ND0 = DQK / 16;
    int tid = threadIdx.x; asm volatile("" : "+v"(tid));
    const int lane = tid & 63, r32 = lane & 31, hi = lane >> 5; const int wid = __builtin_amdgcn_readfirstlane(tid >> 6);
    const long rowbase = (long)b * SEQ; const int q0 = qb * 256;
    const bf16* Qw = Q + (rowbase + q0 + wid * 32) * QP + h * DQK;
    const bf16* Kh = Kn + rowbase * 512 + h * 64; const bf16* Vh = V + rowbase * 512 + h * 64;
    const bf16* Kp = Kpe + rowbase * ROPE;
    const float* Fh = DECAY ? cumF + ((size_t)b * NHEAD + h) * SEQ : nullptr;
    LAS float* wsf = (LAS float*)(lds + L_WS) + wid * 64;
    const bf16* ksrc0 = Kh + (long)lane * 512 + wid * 8;
    const bf16* ksrc1 = Kp + (long)lane * ROPE + (wid & 3) * 8;
    const bf16* vsrc = Vh + (long)(16 * (wid & 3) + (lane >> 2)) * 512 + (wid >> 2) * 32 + (lane & 3) * 8;
    const int NT = (q0 + 256) / 64;
#define ATT_DMA_K(i_, s) do { const int t_ = NT - 1 - (i_); \
        __builtin_amdgcn_global_load_lds((const unsigned*)(ksrc0 + (long)t_ * 64 * 512), (LAS unsigned*)(lds + L_K + (s) * KSLOT + wid * 1024), 16, 0, 0); \
        if (DQK == 96 && wid < 4) __builtin_amdgcn_global_load_lds((const unsigned*)(ksrc1 + (long)t_ * 64 * ROPE), (LAS unsigned*)(lds + L_K + (s) * KSLOT + (8 + wid) * 1024), 16, 0, 0); \
        if (DECAY && wid == 7) __builtin_amdgcn_global_load_lds((const unsigned*)(Fh + t_ * 64 + lane), (LAS unsigned*)(lds + L_F + (s) * 256), 4, 0, 0); } while (0)
#define ATT_DMA_V(i_, s) do { const int t_ = NT - 1 - (i_); \
        __builtin_amdgcn_global_load_lds((const unsigned*)(vsrc + (long)t_ * 64 * 512), (LAS unsigned*)(lds + L_V + (s) * VSLOT + wid * 1024), 16, 0, 0); } while (0)
    ATT_DMA_K(0, 0); ATT_DMA_V(0, 0); ATT_DMA_K(1, 1);
    bf16x8 qr[ND0];
#pragma unroll
    for (int d0 = 0; d0 < ND0; ++d0) qr[d0] = *(const bf16x8*)(Qw + (long)r32 * QP + d0 * 16 + hi * 8);
    float fq_l = 0.f; if (DECAY) fq_l = Fh[q0 + wid * 32 + r32];
    float mhat = 0.f, l_reg = 0.f; bool started = false; f32x16 o[2]; o[0] = f32x16{}; o[1] = f32x16{};
    const int qrel = wid * 32 + r32;
    const int vb0 = (int)(uintptr_t)(lds + L_V) + ((lane >> 4) & 1) * 32 + (lane & 3) * 8 + (4 * hi + ((lane & 15) >> 2)) * 64;
#define ATT_QK(P0, P1, ks_) do { const float base_ = fq_l - mhat; \
        if (DECAY) { const LAS f32x4* fk_ = (const LAS f32x4*)(lds + L_F + (ks_) * 256); \
            _Pragma("unroll") for (int g = 0; g < 4; ++g) { const f32x4 a_ = fk_[2 * g + hi], c_ = fk_[8 + 2 * g + hi]; \
                _Pragma("unroll") for (int q = 0; q < 4; ++q) { P0[4 * g + q] = base_ - a_[q]; P1[4 * g + q] = base_ - c_[q]; } } } \
        else { _Pragma("unroll") for (int r = 0; r < 16; ++r) { P0[r] = base_; P1[r] = base_; } } \
        const LAS unsigned char* kb_ = lds + L_K + (ks_) * KSLOT + hi * 1024 + r32 * 16; \
        _Pragma("unroll") for (int d0 = 0; d0 < ND0; ++d0) { \
            const bf16x8 b0_ = *(const LAS bf16x8*)(kb_ + d0 * 2048), b1_ = *(const LAS bf16x8*)(kb_ + d0 * 2048 + 512); \
            P0 = __builtin_amdgcn_mfma_f32_32x32x16_bf16(b0_, qr[d0], P0, 0, 0, 0); P1 = __builtin_amdgcn_mfma_f32_32x32x16_bf16(b1_, qr[d0], P1, 0, 0, 0); } } while (0)
    f32x16 p0, p1, n0, n1;
    int ks_cur = 0, ks_nxt = 1, ks_ld = 2;
    for (int i = 0; i < NT; ++i) {
        const int vs = i & 1;
        VM_WAIT(); __syncthreads();
        if (i + 2 < NT) ATT_DMA_K(i + 2, ks_ld);
        if (i + 1 < NT) ATT_DMA_V(i + 1, vs ^ 1);
        if (i == 0) ATT_QK(p0, p1, 0);
        if (i + 1 < NT) ATT_QK(n0, n1, ks_nxt);
        const int jb = 3 - i;
        if (jb >= 0) cmask(p0, p1, jb, qrel, hi);
        const float rm = rowmax(p0, p1);
        bool resc = false; float dl = 0.f; const bool was_started = started;
        if (jb >= 0) {
            const bool fin = rm > -INFINITY;
            dl = started ? fmaxf(rm, 0.f) : (fin ? rm : 0.f); started = started || fin; resc = true;
        } else if (__any(rm > (float)THRL)) { dl = fmaxf(rm, 0.f); resc = true; }
        if (resc) { mhat += dl;
#pragma unroll
            for (int r = 0; r < 16; ++r) { p0[r] -= dl; p1[r] -= dl; }
            if (i + 1 < NT) {
#pragma unroll
                for (int r = 0; r < 16; ++r) { n0[r] -= dl; n1[r] -= dl; } }
            const float f = was_started ? __builtin_amdgcn_exp2f(-dl) : 1.f; l_reg *= f; if (hi == 0) wsf[r32] = f; }
        float sacc = 0.f;
#pragma unroll
        for (int r = 0; r < 16; ++r) { p0[r] = __builtin_amdgcn_exp2f(p0[r]); p1[r] = __builtin_amdgcn_exp2f(p1[r]); sacc += p0[r] + p1[r]; }
        l_reg += sacc;
        if (resc) { LDS_WAIT();
#pragma unroll
            for (int d_ = 0; d_ < 2; ++d_)
#pragma unroll
                for (int r = 0; r < 16; ++r) o[d_][r] *= wsf[crow(r, hi)]; }
        u32x4 pw0, pw1, pw2, pw3;
        pw0 = (u32x4){cvtpk_s(p0[0], p0[1]), cvtpk_s(p0[2], p0[3]), cvtpk_s(p0[4], p0[5]), cvtpk_s(p0[6], p0[7])};
        pw1 = (u32x4){cvtpk_s(p0[8], p0[9]), cvtpk_s(p0[10], p0[11]), cvtpk_s(p0[12], p0[13]), cvtpk_s(p0[14], p0[15])};
        pw2 = (u32x4){cvtpk_s(p1[0], p1[1]), cvtpk_s(p1[2], p1[3]), cvtpk_s(p1[4], p1[5]), cvtpk_s(p1[6], p1[7])};
        pw3 = (u32x4){cvtpk_s(p1[8], p1[9]), cvtpk_s(p1[10], p1[11]), cvtpk_s(p1[12], p1[13]), cvtpk_s(p1[14], p1[15])};
        __builtin_amdgcn_sched_barrier(0);
        pv(o, vb0 + vs * VSLOT, __builtin_bit_cast(bf16x8, pw0), __builtin_bit_cast(bf16x8, pw1), __builtin_bit_cast(bf16x8, pw2), __builtin_bit_cast(bf16x8, pw3));
        p0 = n0; p1 = n1;
        { const int t_ = ks_cur; ks_cur = ks_nxt; ks_nxt = ks_ld; ks_ld = t_; }
    }
    { auto rr = __builtin_amdgcn_permlane32_swap(__float_as_uint(l_reg), __float_as_uint(l_reg), false, false); l_reg = __uint_as_float(rr[0]) + __uint_as_float(rr[1]); }
    if (hi == 0) wsf[32 + r32] = l_reg; LDS_WAIT();
    float rli[16];
#pragma unroll
    for (int r = 0; r < 16; ++r) rli[r] = __builtin_amdgcn_rcpf(wsf[32 + crow(r, hi)]);
    unsigned char* Ow = (unsigned char*)O + (rowbase + q0 + wid * 32) * OP + h * 64;
    { LAS unsigned char* stg = lds + L_OST + wid * 4096;
#pragma unroll
      for (int r = 0; r < 16; ++r) { const int orow = crow(r, hi);
#pragma unroll
          for (int d0 = 0; d0 < 2; ++d0) { const float ov = o[d0][r] * rli[r] * OSCALE8; stg[orow * 64 + d0 * 32 + r32] = (unsigned char)__builtin_amdgcn_cvt_pk_fp8_f32(ov, ov, 0, false); } }
      LDS_WAIT();
#pragma unroll
      for (int i = 0; i < 2; ++i) { const int row = i * 16 + (lane >> 2), ch = lane & 3; const u32x4 v = *(const LAS u32x4*)(stg + row * 64 + ch * 16); *(u32x4*)(Ow + (long)row * OP + ch * 16) = v; } }
    LDS_WAIT(); __syncthreads();
#undef ATT_DMA_K
#undef ATT_DMA_V
#undef ATT_QK
}

constexpr int T_KSLOT = 12288, T_VSLOT = 8192, T_NSLOT = 3;
constexpr int T_K = 0, T_V = T_NSLOT * T_KSLOT, T_F = T_V + T_NSLOT * T_VSLOT, T_WS = T_F + T_NSLOT * 256, T_OST = T_WS + 2048, T_END = T_OST + 8 * 4096;
static_assert(T_END <= RING_BYTES, "attention LDS (hand-interleaved unit)");
typedef __attribute__((address_space(3))) const char* lds_cptr;
typedef short v4i16_t __attribute__((ext_vector_type(4)));
__device__ __forceinline__ s16x4 vtr(lds_cptr p) { return __builtin_bit_cast(s16x4, __builtin_amdgcn_ds_read_tr16_b64_v4i16((__attribute__((address_space(3))) v4i16_t*)p)); }
__device__ __forceinline__ void kload2(bf16x8* kf, lds_cptr kp, int j) { kf[2 * j] = *(const __attribute__((address_space(3))) bf16x8*)(kp + j * 2048); kf[2 * j + 1] = *(const __attribute__((address_space(3))) bf16x8*)(kp + j * 2048 + 512); }
#define TW_BAR(N) asm volatile("s_waitcnt vmcnt(" #N ") lgkmcnt(0)\n\ts_barrier" ::: "memory")
#define TSB() __builtin_amdgcn_sched_barrier(0)

template <int DQK, bool DECAY, int THRL>
__device__ __forceinline__ void attn_unit_t(int b, int h, int qb, const bf16* Q, int QP, const bf16* Kn, const bf16* Kpe, const bf16* V, const float* cumF, float kmax2, bf16* O, int OP, LAS unsigned char* lds) {
    constexpr int ND0 = DQK / 16;
    constexpr bool INPL = DECAY || (DQK == 96);
    int tid = threadIdx.x; asm volatile("" : "+v"(tid));
    const int lane = tid & 63, r32 = lane & 31, hi = lane >> 5; const int wid = __builtin_amdgcn_readfirstlane(tid >> 6);
    const long rowbase = (long)b * SEQ; const int q0 = qb * 256;
    const bf16* Qw = Q + (rowbase + q0 + wid * 32) * QP + h * DQK;
    const bf16* Kh = Kn + rowbase * 512 + h * 64; const bf16* Vh = V + rowbase * 512 + h * 64;
    const bf16* Kp = Kpe + rowbase * ROPE;
    const float* Fh = DECAY ? cumF + ((size_t)b * NHEAD + h) * SEQ : nullptr;
    LAS float* wsf = (LAS float*)(lds + T_WS) + wid * 64;
    const bf16* ksrc0 = Kh + (long)lane * 512 + wid * 8;
    const bf16* ksrc1 = Kp + (long)lane * ROPE + (wid & 3) * 8;
    const bf16* vsrc = Vh + (long)(16 * (wid & 3) + (lane >> 2)) * 512 + (wid >> 2) * 32 + (lane & 3) * 8;
    const int NTS = (q0 + 256) / 64;
#define TDMA_K(i_, sk) do { const int t_ = NTS - 1 - (i_); \
        __builtin_amdgcn_global_load_lds((const unsigned*)(ksrc0 + (long)t_ * 64 * 512), (LAS unsigned*)(lds + T_K + (sk) * T_KSLOT + wid * 1024), 16, 0, 0); \
        if (DECAY) __builtin_amdgcn_global_load_lds((const unsigned*)(Fh + t_ * 64 + lane), (LAS unsigned*)(lds + T_F + (sk) * 256), 4, 0, 0); \
        else __builtin_amdgcn_global_load_lds((const unsigned*)(ksrc1 + (long)t_ * 64 * ROPE), (LAS unsigned*)(lds + T_K + (sk) * T_KSLOT + (8 + (wid & 3)) * 1024), 16, 0, 0); } while (0)
#define TDMA_V(i_, sv) do { const int t_ = NTS - 1 - (i_); \
        __builtin_amdgcn_global_load_lds((const unsigned*)(vsrc + (long)t_ * 64 * 512), (LAS unsigned*)(lds + T_V + (sv) * T_VSLOT + wid * 1024), 16, 0, 0); } while (0)
    TDMA_K(0, 0); TDMA_V(0, 0); TDMA_K(1, 1);
    bf16x8 qr[ND0];
#pragma unroll
    for (int d0 = 0; d0 < ND0; ++d0) qr[d0] = *(const bf16x8*)(Qw + (long)r32 * QP + d0 * 16 + hi * 8);
    float fq_l = 0.f; if (DECAY) fq_l = Fh[q0 + wid * 32 + r32];
    float ftile = 0.f; if (DECAY) ftile = Fh[(lane < NTS ? lane : NTS - 1) * 64 + 63];
    float mhat = 0.f, l_reg = 0.f; f32x16 o[2]; o[0] = f32x16{}; o[1] = f32x16{};
    f32x16 negm = f32x16{}; asm volatile("" : "+v"(negm));
    const int qrel = wid * 32 + r32, i0 = 3 - (wid >> 1);
    const lds_cptr shm3 = (lds_cptr)lds; const lds_cptr kp0 = shm3 + T_K + hi * 1024 + r32 * 16;
    const lds_cptr vp0 = shm3 + T_V + ((lane >> 4) & 1) * 32 + (lane & 3) * 8 + (4 * hi + ((lane & 15) >> 2)) * 64;
    const int vb0 = (int)(uintptr_t)(lds + T_V) + ((lane >> 4) & 1) * 32 + (lane & 3) * 8 + (4 * hi + ((lane & 15) >> 2)) * 64;
    bool resc = false;
    bf16x8 kf[2 * ND0];
    f32x16 pA0, pA1, pB0, pB1;
    int sl_prev = 0, sl_cur = 0, sl_next = 1;
#define TROT() do { sl_prev = sl_cur; sl_cur = sl_next; sl_next = (sl_next == T_NSLOT - 1) ? 0 : sl_next + 1; } while (0)
#define TBIAS(X0, X1, fs_) do { if (DECAY) { const float base_ = fq_l - mhat; const LAS f32x4* fk_ = (const LAS f32x4*)(lds + T_F + (fs_) * 256); \
        _Pragma("unroll") for (int g = 0; g < 4; ++g) { const f32x4 a_ = fk_[2 * g + hi], c_ = fk_[8 + 2 * g + hi]; \
            _Pragma("unroll") for (int q = 0; q < 4; ++q) { X0[4 * g + q] = base_ - a_[q]; X1[4 * g + q] = base_ - c_[q]; } } } \
        else if (INPL) { const float nm_ = -mhat; _Pragma("unroll") for (int r = 0; r < 16; ++r) { X0[r] = nm_; X1[r] = nm_; } } } while (0)
#define TCIN(X) (INPL ? X : negm)
#define TRESC() do { if (resc) { asm volatile("s_waitcnt lgkmcnt(0)" ::: "memory"); \
        _Pragma("unroll") for (int d_ = 0; d_ < 2; ++d_) _Pragma("unroll") for (int r = 0; r < 16; ++r) o[d_][r] *= wsf[crow(r, hi)]; } } while (0)
#define TDECIDE(C0, C1, i_) do { \
        float a_ = max3f(C0[0], C0[1], C1[0]), b_ = max3f(C0[2], C0[3], C1[1]); a_ = max3f(a_, C1[2], C1[3]); \
        _Pragma("unroll") for (int r = 4; r < 16; r += 4) { a_ = max3f(a_, C0[r], C0[r + 1]); b_ = max3f(b_, C0[r + 2], C0[r + 3]); a_ = max3f(a_, C1[r], C1[r + 1]); b_ = max3f(b_, C1[r + 2], C1[r + 3]); } \
        float rm_ = fmaxf(a_, b_); { auto rr_ = __builtin_amdgcn_permlane32_swap(__float_as_uint(rm_), __float_as_uint(rm_), false, false); rm_ = fmaxf(__uint_as_float(rr_[0]), __uint_as_float(rr_[1])); } \
        resc = false; \
        if ((i_) == i0) { const float dl_ = rm_; mhat += dl_; \
            _Pragma("unroll") for (int r = 0; r < 16; ++r) { C0[r] -= dl_; C1[r] -= dl_; } \
            if (!INPL) { _Pragma("unroll") for (int r = 0; r < 16; ++r) negm[r] = -mhat; asm volatile("" : "+v"(negm)); } } \
        else if (__builtin_expect(__any(rm_ > (float)THRL), 0)) { const float dl_ = fmaxf(rm_, 0.f); mhat += dl_; \
            _Pragma("unroll") for (int r = 0; r < 16; ++r) { C0[r] -= dl_; C1[r] -= dl_; } \
            if (!INPL) { _Pragma("unroll") for (int r = 0; r < 16; ++r) negm[r] = -mhat; asm volatile("" : "+v"(negm)); } \
            const float f_ = __builtin_amdgcn_exp2f(-dl_); l_reg *= f_; if (hi == 0) wsf[r32] = f_; resc = true; } } while (0)
    TDMA_K(2, 2);
    TW_BAR(5);
    int NT = NTS;
    if (DECAY) {
        const float bound = 2.f * __builtin_sqrtf(kmax2) * 1.0001f + 1.f + (Fh[q0] - ftile);
        const unsigned long long need = __ballot(lane < NTS && bound >= -160.f);
        const int tmin = need ? (int)__builtin_ctzll(need) : NTS - 1;
        NT = NTS - tmin; NT += NT & 1; if (NT < 8) NT = 8; if (NT > NTS) NT = NTS;
        NT = __builtin_amdgcn_readfirstlane(NT); }
    TBIAS(pA0, pA1, 0);
    { const lds_cptr kb = kp0;
#pragma unroll
      for (int d0 = 0; d0 < ND0; ++d0) { const bf16x8 b0 = *(const __attribute__((address_space(3))) bf16x8*)(kb + d0 * 2048), b1 = *(const __attribute__((address_space(3))) bf16x8*)(kb + d0 * 2048 + 512);
          if (d0 == 0) { pA0 = __builtin_amdgcn_mfma_f32_32x32x16_bf16(b0, qr[0], TCIN(pA0), 0, 0, 0); pA1 = __builtin_amdgcn_mfma_f32_32x32x16_bf16(b1, qr[0], TCIN(pA1), 0, 0, 0); }
          else { pA0 = __builtin_amdgcn_mfma_f32_32x32x16_bf16(b0, qr[d0], pA0, 0, 0, 0); pA1 = __builtin_amdgcn_mfma_f32_32x32x16_bf16(b1, qr[d0], pA1, 0, 0, 0); } } }
    cmask(pA0, pA1, 3, qrel, hi);
    TDECIDE(pA0, pA1, 0);
#pragma unroll
    for (int r = 0; r < 16; ++r) { pA0[r] = __builtin_amdgcn_exp2f(pA0[r]); pA1[r] = __builtin_amdgcn_exp2f(pA1[r]); }
    TW_BAR(0);
    TDMA_K(3, 0); TDMA_V(1, 1);
    TROT();
#pragma unroll
    for (int j = 0; j < ND0; ++j) kload2(kf, kp0 + sl_cur * T_KSLOT, j);
    TBIAS(pB0, pB1, sl_cur);
    TW_BAR(3);
    s16x4 vlo[8], vhi[8]; u32x4 pw0, pw1, pw2, pw3;
#define TPKW(P, B) cvt_pk_bf16(P[B], P[B + 1])
#define TPAF(k) __builtin_bit_cast(bf16x8, pw##k)
#define TVFR(i) (bf16x8){vlo[i][0], vlo[i][1], vlo[i][2], vlo[i][3], vhi[i][0], vhi[i][1], vhi[i][2], vhi[i][3]}
#define TPIN(x) asm volatile("" : "+v"(x))
#define TGAPA(MF, A0, A1, A2, A3, W0, W1, PW) do { MF; sacc += A0; sacc += A1; sacc += A2; sacc += A3; TPIN(sacc); W0; W1; TPIN(PW); TSB(); } while (0)
#define TEX(v) __builtin_amdgcn_exp2f(v)
#define TGAPB(MF, X, B) do { MF; X[B] = TEX(X[B]); X[B + 1] = TEX(X[B + 1]); X[B + 2] = TEX(X[B + 2]); X[B + 3] = TEX(X[B + 3]); TPIN(X); TSB(); } while (0)
#define TVRD(i) do { vlo[i] = vtr(vp_ + (((i) >> 2) * 4096 + ((i) & 3) * 1024)); vhi[i] = vtr(vp_ + (((i) >> 2) * 4096 + ((i) & 3) * 1024 + 512)); } while (0)
#define TKRD(G, j) do { if (G) { kload2(kf, kp0 + sl_next * T_KSLOT, j); TSB(); } } while (0)
#define TMF(a, b, c) __builtin_amdgcn_mfma_f32_32x32x16_bf16(a, b, c, 0, 0, 0)
#define TSTEP(C0, C1, P0, P1, i_, MJB, GK, GV, GL) do { TSB(); \
        const lds_cptr vp_ = vp0 + sl_prev * T_VSLOT; \
        TVRD(0); TSB(); float sacc = (P0[0] + P0[1]); \
        TGAPA(C0 = TMF(kf[0], qr[0], TCIN(C0)), P0[2], P0[3], P0[4], P0[5],     pw0[0] = TPKW(P0, 0), pw0[1] = TPKW(P0, 2), pw0); \
        TVRD(4); TSB(); TGAPA(C1 = TMF(kf[1], qr[0], TCIN(C1)), P0[6], P0[7], P0[8], P0[9],     pw0[2] = TPKW(P0, 4), pw0[3] = TPKW(P0, 6), pw0); \
        TVRD(1); TSB(); TGAPA(C0 = TMF(kf[2], qr[1], C0),   P0[10], P0[11], P0[12], P0[13], pw1[0] = TPKW(P0, 8), pw1[1] = TPKW(P0, 10), pw1); \
        TVRD(5); TSB(); TGAPA(C1 = TMF(kf[3], qr[1], C1),   P0[14], P0[15], P1[0], P1[1],   pw1[2] = TPKW(P0, 12), pw1[3] = TPKW(P0, 14), pw1); \
        TVRD(2); TSB(); TGAPA(C0 = TMF(kf[4], qr[2], C0),   P1[2], P1[3], P1[4], P1[5],     pw2[0] = TPKW(P1, 0), pw2[1] = TPKW(P1, 2), pw2); \
        TVRD(6); TSB(); TGAPA(C1 = TMF(kf[5], qr[2], C1),   P1[6], P1[7], P1[8], P1[9],     pw2[2] = TPKW(P1, 4), pw2[3] = TPKW(P1, 6), pw2); \
        TVRD(3); TSB(); TGAPA(C0 = TMF(kf[6], qr[3], C0),   P1[10], P1[11], P1[12], P1[13], pw3[0] = TPKW(P1, 8), pw3[1] = TPKW(P1, 10), pw3); \
        TVRD(7); TSB(); TGAPA(C1 = TMF(kf[7], qr[3], C1),   P1[14], P1[15], 0.f, 0.f,       pw3[2] = TPKW(P1, 12), pw3[3] = TPKW(P1, 14), pw3); \
        if (ND0 == 6) { C0 = TMF(kf[2 * ND0 - 4], qr[ND0 - 2], C0); C1 = TMF(kf[2 * ND0 - 3], qr[ND0 - 2], C1); C0 = TMF(kf[2 * ND0 - 2], qr[ND0 - 1], C0); C1 = TMF(kf[2 * ND0 - 1], qr[ND0 - 1], C1); TSB(); } \
        l_reg += sacc; \
        if (GK) { TDMA_K((i_) + 3, sl_cur); } if (GV) { TDMA_V((i_) + 1, sl_next); } \
        if ((MJB) >= 0) cmask(C0, C1, (MJB), qrel, hi); \
        TDECIDE(C0, C1, i_); \
        TSB(); \
        TGAPB(o[0] = TMF(TPAF(0), TVFR(0), o[0]), C0, 0); \
        TKRD(GL, 0); TGAPB(o[1] = TMF(TPAF(0), TVFR(4), o[1]), C0, 4); \
        TKRD(GL, 1); TGAPB(o[0] = TMF(TPAF(1), TVFR(1), o[0]), C0, 8); \
        TKRD(GL, 2); TGAPB(o[1] = TMF(TPAF(1), TVFR(5), o[1]), C0, 12); \
        TKRD(GL, 3); TGAPB(o[0] = TMF(TPAF(2), TVFR(2), o[0]), C1, 0); \
        if (ND0 == 6) { TKRD(GL, ND0 - 2); } TGAPB(o[1] = TMF(TPAF(2), TVFR(6), o[1]), C1, 4); \
        if (ND0 == 6) { TKRD(GL, ND0 - 1); } TGAPB(o[0] = TMF(TPAF(3), TVFR(3), o[0]), C1, 8); \
        TGAPB(o[1] = TMF(TPAF(3), TVFR(7), o[1]), C1, 12); \
        if (GL) { TBIAS(P0, P1, sl_next); } \
    } while (0)
#define TENDW(tt) do { if ((tt) + 3 < NT) { TW_BAR(3); } else if ((tt) + 2 < NT) { TW_BAR(1); } else { TW_BAR(0); } } while (0)
    TSTEP(pB0, pB1, pA0, pA1, 1, 2, (1 + 3 < NT), true, true); TENDW(1); TRESC(); TROT();
    TSTEP(pA0, pA1, pB0, pB1, 2, 1, (2 + 3 < NT), true, true); TENDW(2); TRESC(); TROT();
    {
        TSTEP(pB0, pB1, pA0, pA1, 3, 0, (3 + 3 < NT), true, true); TENDW(3); TRESC(); TROT();
        int i = 4;
        for (; i + 2 < NT; i += 2) {
            TSTEP(pA0, pA1, pB0, pB1, i, -1, (i + 3 < NT), true, true);                         TENDW(i);     TRESC(); TROT();
            TSTEP(pB0, pB1, pA0, pA1, i + 1, -1, (i + 4 < NT), (i + 2 < NT), (i + 2 < NT));     TENDW(i + 1); TRESC(); TROT();
        }
        TSTEP(pA0, pA1, pB0, pB1, NT - 2, -1, false, true, true); TENDW(NT - 2); TRESC(); TROT();
        TSTEP(pB0, pB1, pA0, pA1, NT - 1, -1, false, false, false); TRESC();
    }
    { float sacc = pB0[0] + pB0[1];
#pragma unroll
      for (int r = 2; r < 16; ++r) sacc += pB0[r];
#pragma unroll
      for (int r = 0; r < 16; ++r) sacc += pB1[r];
      l_reg += sacc;
      pw0 = (u32x4){TPKW(pB0, 0), TPKW(pB0, 2), TPKW(pB0, 4), TPKW(pB0, 6)}; pw1 = (u32x4){TPKW(pB0, 8), TPKW(pB0, 10), TPKW(pB0, 12), TPKW(pB0, 14)};
      pw2 = (u32x4){TPKW(pB1, 0), TPKW(pB1, 2), TPKW(pB1, 4), TPKW(pB1, 6)}; pw3 = (u32x4){TPKW(pB1, 8), TPKW(pB1, 10), TPKW(pB1, 12), TPKW(pB1, 14)};
      TSB(); pv(o, vb0 + sl_cur * T_VSLOT, TPAF(0), TPAF(1), TPAF(2), TPAF(3)); }
    { auto rr = __builtin_amdgcn_permlane32_swap(__float_as_uint(l_reg), __float_as_uint(l_reg), false, false); l_reg = __uint_as_float(rr[0]) + __uint_as_float(rr[1]); }
    if (hi == 0) wsf[32 + r32] = l_reg; asm volatile("s_waitcnt lgkmcnt(0)" ::: "memory");
    float rli[16];
#pragma unroll
    for (int r = 0; r < 16; ++r) rli[r] = __builtin_amdgcn_rcpf(wsf[32 + crow(r, hi)]);
    unsigned char* Ow = (unsigned char*)O + (rowbase + q0 + wid * 32) * OP + h * 64;
    { LAS unsigned char* stg = lds + T_OST + wid * 4096;
#pragma unroll
      for (int r = 0; r < 16; ++r) { const int orow = crow(r, hi);
#pragma unroll
          for (int d0 = 0; d0 < 2; ++d0) { const float ov = o[d0][r] * rli[r] * OSCALE8; stg[orow * 64 + d0 * 32 + r32] = (unsigned char)__builtin_amdgcn_cvt_pk_fp8_f32(ov, ov, 0, false); } }
      asm volatile("s_waitcnt lgkmcnt(0)" ::: "memory");
#pragma unroll
      for (int i = 0; i < 2; ++i) { const int row = i * 16 + (lane >> 2), ch = lane & 3; const u32x4 v = *(const LAS u32x4*)(stg + row * 64 + ch * 16); *(u32x4*)(Ow + (long)row * OP + ch * 16) = v; } }
    asm volatile("s_waitcnt lgkmcnt(0)\n\ts_barrier" ::: "memory");
#undef TDMA_K
#undef TDMA_V
#undef TROT
#undef TBIAS
#undef TCIN
#undef TRESC
#undef TDECIDE
#undef TPKW
#undef TPAF
#undef TVFR
#undef TPIN
#undef TGAPA
#undef TEX
#undef TGAPB
#undef TVRD
#undef TKRD
#undef TMF
#undef TSTEP
#undef TENDW
}
#undef TW_BAR
#undef TSB
}

namespace dn {
constexpr int CHB = 64 * 256 * 2;
__device__ __forceinline__ int nloc(int i) { return 16 * ((i >> 2) & 1) + (i & 3) + 4 * (i >> 3); }
template <bool NOTRAFFIC>
__device__ __forceinline__ void down_phase(LAS unsigned char* lds, const bf16* HBp, const bf16* Wd, const bf16* Wsd, volatile LAS int* tab, const u32x2* meta, unsigned char* Yp, unsigned char* trash, int G, int c) {
    int tid = threadIdx.x; asm volatile("" : "+v"(tid));
    const int wid = __builtin_amdgcn_readfirstlane(tid >> 6), lane = tid & 63, j = lane & 31, hi = lane >> 5;
    const int U = tab[65] * 8;
    const int u_lo = (int)(((long)c * U) / G), u_hi = (int)(((long)(c + 1) * U) / G);
    if (u_lo >= u_hi) return;
#define DN_DEC(u_, e_, hf_, ci_) do { e_ = __builtin_amdgcn_readfirstlane(tab[132 + ((u_) >> 3)]); const int ul_ = __builtin_amdgcn_readfirstlane((u_) - 8 * tab[e_]), nc_ = __builtin_amdgcn_readfirstlane(4 * (tab[e_ + 1] - tab[e_])); hf_ = (ul_ >= nc_) ? 1 : 0; ci_ = ul_ - hf_ * nc_; } while (0)
    unsigned dvo;
    { const int r_ = lane >> 3; dvo = (unsigned)(r_ * DEXP + (((lane & 7) ^ ((r_ >> 1) & 7)) * 8)) * 2u; }
#define DN_DMA(u_, buf_) do { int e__, hf__, ci__; DN_DEC(u_, e__, hf__, ci__); (void)hf__; const bf16* gb_ = HBp + ((size_t)tab[e__] * 256 + (size_t)ci__ * 64) * DEXP; \
        _Pragma("unroll") for (int i_ = 0; i_ < 4; ++i_) { const int q_ = wid * 4 + i_, kb_ = q_ >> 3, g_ = q_ & 7; \
            __builtin_amdgcn_global_load_lds((const unsigned*)((const char*)(gb_ + (size_t)(8 * g_) * DEXP + kb_ * 64) + ((g_ & 1) ? (dvo ^ 64u) : dvo)), (LAS unsigned*)(lds + (buf_) * CHB + kb_ * 8192 + g_ * 1024), 16, 0, 0); } } while (0)
    int rowb[2], fx[2];
#pragma unroll
    for (int rt = 0; rt < 2; ++rt) { const int row = 32 * rt + j, f = (row >> 1) & 7;
        rowb[rt] = (int)(uintptr_t)lds + row * 128 + ((hi ^ (f & 1)) * 16); fx[rt] = (f & 6) * 16; }
    DN_DMA(u_lo, 0); if (u_lo + 1 < u_hi) DN_DMA(u_lo + 1, 1); else DN_DMA(u_lo, 1); if (u_lo + 2 < u_hi) DN_DMA(u_lo + 2, 2); else DN_DMA(u_lo, 2);
    int u = u_lo;
    while (u < u_hi) {
      int e, hf, ci0; DN_DEC(u, e, hf, ci0);
      const int nc = __builtin_amdgcn_readfirstlane(4 * (tab[e + 1] - tab[e])), ne = __builtin_amdgcn_readfirstlane(tab[66 + e]);
      int seg_end = 8 * tab[e] + (hf + 1) * nc; seg_end = __builtin_amdgcn_readfirstlane(seg_end < u_hi ? seg_end : u_hi);
      bf16x8 wfr[2][16];
#pragma unroll
      for (int nt = 0; nt < 2; ++nt) { const bf16* wp = ((e == NEXP) ? Wsd : Wd + (size_t)e * D * DEXP) + (size_t)(512 * hf + 64 * wid + 32 * nt + nloc(j)) * DEXP + 8 * hi;
#pragma unroll
          for (int ks = 0; ks < 16; ++ks) wfr[nt][ks] = *(const bf16x8*)(wp + 16 * ks); }
      bool first = true;
      for (; u < seg_end; ++u) {
        const int buf = (u - u_lo) & 3; (void)ci0;
        const int cidx = __builtin_amdgcn_readfirstlane((u - 8 * tab[e]) - hf * nc);
        u32x2 mt[2];
#pragma unroll
        for (int rt = 0; rt < 2; ++rt) { int pos = 64 * cidx + 32 * rt + j; const bool in = pos < ne; const int sp = pos; pos = (in && e != NEXP) ? pos : 0; const u32x2 m = meta[(size_t)(e == NEXP ? 0 : e) * LISTCAP + pos];
            mt[rt] = !in ? (u32x2){0xffffffffu, 0u} : (e == NEXP) ? (u32x2){(unsigned)(sp * (TOPK + 1) + TOPK), 0x3f800000u} : m; }
        if (first) { __builtin_amdgcn_s_waitcnt(0x0F70); first = false; }
        else { asm volatile("s_waitcnt vmcnt(26)" ::: "memory"); }
        LDS_WAIT(); __builtin_amdgcn_s_barrier();
        { const int un = (u + 3 < u_hi) ? u + 3 : u; DN_DMA(un, (buf + 3) & 3); }
        f32x16 acc[2][2];
#pragma unroll
        for (int rt = 0; rt < 2; ++rt)
#pragma unroll
            for (int nt = 0; nt < 2; ++nt) acc[rt][nt] = f32x16{};
#define DN_RD(dst, ks_) do { _Pragma("unroll") for (int rt = 0; rt < 2; ++rt) \
            asm volatile("ds_read_b128 %0, %1 offset:%c2" : "=&v"(dst[rt]) : "v"(rowb[rt] + ((32 * ((ks_) & 3)) ^ fx[rt]) + buf * CHB), "i"(((ks_) >> 2) * 8192) : "memory"); } while (0)
#define DN_WAIT(n_, x_) asm volatile("s_waitcnt lgkmcnt(" #n_ ")" : "+v"(x_[0]), "+v"(x_[1]) :: "memory")
        bf16x8 hfa[2], hfb[2];
        DN_RD(hfa, 0);
#pragma unroll
        for (int ks = 0; ks < 16; ks += 2) {
            DN_RD(hfb, ks + 1);
            DN_WAIT(2, hfa);
#pragma unroll
            for (int rt = 0; rt < 2; ++rt)
#pragma unroll
                for (int nt = 0; nt < 2; ++nt) acc[rt][nt] = __builtin_amdgcn_mfma_f32_32x32x16_bf16(wfr[nt][ks], hfa[rt], acc[rt][nt], 0, 0, 0);
            __builtin_amdgcn_sched_barrier(0);
            if (ks + 2 < 16) { DN_RD(hfa, ks + 2); DN_WAIT(2, hfb); } else { DN_WAIT(0, hfb); }
#pragma unroll
            for (int rt = 0; rt < 2; ++rt)
#pragma unroll
                for (int nt = 0; nt < 2; ++nt) acc[rt][nt] = __builtin_amdgcn_mfma_f32_32x32x16_bf16(wfr[nt][ks + 1], hfb[rt], acc[rt][nt], 0, 0, 0);
            __builtin_amdgcn_sched_barrier(0);
        }
#undef DN_RD
#undef DN_WAIT
        const int col0 = 512 * hf + 64 * wid + 16 * hi;
#pragma unroll
        for (int rt = 0; rt < 2; ++rt) { const bool ok = !NOTRAFFIC && mt[rt].x != 0xffffffffu; unsigned char* yd = ok ? Yp + (size_t)mt[rt].x * D : trash; const float w = ok ? __uint_as_float(mt[rt].y) : 0.f;
#pragma unroll
            for (int nt = 0; nt < 2; ++nt) { u32x4 o;
#pragma unroll
                for (int q = 0; q < 4; ++q) { int v = __builtin_amdgcn_cvt_pk_fp8_f32(acc[rt][nt][4 * q] * w, acc[rt][nt][4 * q + 1] * w, 0, false);
                    v = __builtin_amdgcn_cvt_pk_fp8_f32(acc[rt][nt][4 * q + 2] * w, acc[rt][nt][4 * q + 3] * w, v, true); o[q] = (unsigned)v; }
                *(u32x4*)(yd + col0 + 32 * nt) = o; } }
      }
    }
    VM_WAIT(); LDS_WAIT(); __builtin_amdgcn_s_barrier();
#undef DN_DMA
#undef DN_DEC
}
}

#define XB_TMO      128
#define XB_XCNT(j)  (256  + 64 * (j))
#define XB_XSUB(j)  (1280 + 64 * (j))
#define XB_XGEN(j)  (2304 + 64 * (j))
#define XB_TOP      3328
#define XB_TOPGEN   3392
#define XCD_BAR_WORDS 3456
#define XB_SPIN_CAP (1u << 18)
__device__ __forceinline__ unsigned xb_ld(unsigned* p)              { return __hip_atomic_load(p, __ATOMIC_RELAXED, __HIP_MEMORY_SCOPE_AGENT); }
__device__ __forceinline__ unsigned xb_add(unsigned* p, unsigned v) { return __hip_atomic_fetch_add(p, v, __ATOMIC_RELAXED, __HIP_MEMORY_SCOPE_AGENT); }
__device__ __forceinline__ unsigned xb_xcc_id() { return (unsigned)__builtin_amdgcn_s_getreg((3 << 11) | 20) & 0xFu; }
#define XB_SPIN(cond, bar) do { unsigned _sp = 0; while (cond) { __builtin_amdgcn_s_sleep(1); \
    if ((++_sp & 255u) == 0u) { if (xb_ld(&(bar)[XB_TMO])) break; if (_sp > XB_SPIN_CAP) { atomicAdd(&(bar)[XB_TMO], 1u); break; } } } } while (0)
struct XcdBarrier { unsigned* bar; unsigned x; volatile LAS unsigned* st; };
__device__ __forceinline__ XcdBarrier xcd_barrier_post(unsigned* bar, volatile LAS unsigned* st) {
    XcdBarrier b; b.bar = bar; b.x = xb_xcc_id(); b.st = st;
    if (threadIdx.x == 0) (void)xb_add(&bar[XB_XCNT(b.x)], 1u);
    return b;
}
__device__ __forceinline__ void xcd_barrier_complete(unsigned* bar, unsigned x, unsigned& nloc, unsigned& nx) {
    const unsigned G = gridDim.x * gridDim.y * gridDim.z;
    unsigned sum, cnt, mine, sp = 0u;
    for (;;) {
        sum = 0u; cnt = 0u; mine = 0u;
#pragma unroll
        for (unsigned j = 0; j < 16; ++j) { const unsigned c = xb_ld(&bar[XB_XCNT(j)]); sum += c; cnt += (c > 0u) ? 1u : 0u; mine = (j == x) ? c : mine; }
        if (sum == G) break;
        __builtin_amdgcn_s_sleep(1);
        if ((++sp & 255u) == 0u) { if (xb_ld(&bar[XB_TMO])) break; if (sp > XB_SPIN_CAP) { atomicAdd(&bar[XB_TMO], 1u); break; } }
    }
    nloc = mine > 0u ? mine : 1u; nx = cnt > 0u ? cnt : 1u;
}
__device__ __forceinline__ void xcd_barrier(const XcdBarrier& b) {
    asm volatile("s_waitcnt vmcnt(0)" ::: "memory");
    __syncthreads();
    if (threadIdx.x == 0) {
        unsigned* bar = b.bar;
        __builtin_amdgcn_s_waitcnt(0);
        unsigned nloc = b.st[0], nx = b.st[1];
        if (nloc == 0u) { xcd_barrier_complete(bar, b.x, nloc, nx); b.st[0] = nloc; b.st[1] = nx; }
        const unsigned old = xb_add(&bar[XB_XSUB(b.x)], 1u);
        const unsigned gen = old / nloc;
        if (old + 1u == (gen + 1u) * nloc) {
            __builtin_amdgcn_fence(__ATOMIC_RELEASE, "agent");
            asm volatile("s_waitcnt vmcnt(0)" ::: "memory");
            const unsigned og = xb_add(&bar[XB_TOP], 1u);
            const unsigned tg = og / nx;
            if (og + 1u == (tg + 1u) * nx) xb_add(&bar[XB_TOPGEN], 1u);
            else XB_SPIN(xb_ld(&bar[XB_TOPGEN]) == tg, bar);
            __builtin_amdgcn_fence(__ATOMIC_ACQUIRE, "agent");
            xb_add(&bar[XB_XGEN(b.x)], 1u);
            asm volatile("s_waitcnt vmcnt(0)" ::: "memory");
        } else {
            XB_SPIN(xb_ld(&bar[XB_XGEN(b.x)]) == gen, bar);
            __builtin_amdgcn_fence(__ATOMIC_ACQUIRE, "agent");
            asm volatile("s_waitcnt vmcnt(0)" ::: "memory");
        }
    }
    __syncthreads();
}

struct Args { const void* in[25]; float* out; unsigned char* ws; int ph_lo, ph_hi; };

struct Frame {
    LAS unsigned char* lds;
    int tid, lane, wave, vcu, G;
};

template <class ColFn>
__device__ __forceinline__ void cvt_item(int ldw, int Ksrc, const float* kscale, bf16* WT, int Kd, LAS float* scr, int kb, int nb, int lane, ColFn colp) {
    const int k0 = 64 * kb, n0 = 32 * nb;
    const float* cp = colp(n0 + (lane & 31));
    float vv[32], sv[32];
#pragma unroll
    for (int i = 0; i < 32; ++i) { const int k = k0 + 2 * i + (lane >> 5);
        vv[i] = (cp != nullptr && k < Ksrc) ? cp[(size_t)k * ldw] : 0.f;
        sv[i] = (kscale != nullptr && k < Ksrc) ? kscale[k] : 1.f; }
#pragma unroll
    for (int i = 0; i < 32; ++i) scr[(2 * i + (lane >> 5)) * 33 + (lane & 31)] = vv[i] * sv[i];
    LDS_WAIT(); asm volatile("" ::: "memory");
    const int c = lane & 7;
#pragma unroll
    for (int j = 0; j < 4; ++j) { const int n = (lane >> 3) + 8 * j; const LAS float* s = scr + (8 * c) * 33 + n;
        u32x4 o; o.x = pk2(s[0 * 33], s[1 * 33]); o.y = pk2(s[2 * 33], s[3 * 33]); o.z = pk2(s[4 * 33], s[5 * 33]); o.w = pk2(s[6 * 33], s[7 * 33]);
        *(u32x4*)(WT + (size_t)(n0 + n) * Kd + k0 + 8 * c) = o; }
    LDS_WAIT(); asm volatile("" ::: "memory");
}
__device__ __forceinline__ void cvt64_item(const float* src, int ldw, bf16* dst, int Kd, LAS unsigned char* scr, int lane) {
    f32x4 v[16];
    const float* sp = src + (size_t)(lane >> 4) * ldw + 4 * (lane & 15);
#pragma unroll
    for (int i = 0; i < 16; ++i) v[i] = __builtin_nontemporal_load((const f32x4*)(sp + (size_t)(4 * i) * ldw));
#pragma unroll
    for (int i = 0; i < 16; ++i) { const int k = 4 * i + (lane >> 4);
#pragma unroll
        for (int q = 0; q < 4; ++q) { const int n = 4 * (lane & 15) + q; *(LAS bf16*)(scr + n * 128 + (((k >> 3) ^ ((n >> 2) & 7)) << 4) + (k & 7) * 2) = (bf16)f2bf(v[i][q]); } }
    LDS_WAIT(); asm volatile("" ::: "memory");
#pragma unroll
    for (int j = 0; j < 8; ++j) { const int p = j * 64 + lane, n = p >> 3, c = p & 7;
        const u32x4 o = *(const LAS u32x4*)(scr + n * 128 + ((c ^ ((n >> 2) & 7)) << 4));
        __builtin_nontemporal_store(o, (u32x4*)(dst + (size_t)n * Kd + c * 8)); }
    LDS_WAIT(); asm volatile("" ::: "memory");
}
__device__ __forceinline__ void cvt64_item8(const float* src, int ldw, unsigned char* dst, int Kd8, LAS unsigned char* scr, int lane, float scale) {
    f32x4 v[16];
    const float* sp = src + (size_t)(lane >> 4) * ldw + 4 * (lane & 15);
#pragma unroll
    for (int i = 0; i < 16; ++i) v[i] = __builtin_nontemporal_load((const f32x4*)(sp + (size_t)(4 * i) * ldw));
#pragma unroll
    for (int i = 0; i < 16; ++i) { const int k = 4 * i + (lane >> 4);
#pragma unroll
        for (int q = 0; q < 4; q += 2) { const unsigned pk = (unsigned)__builtin_amdgcn_cvt_pk_fp8_f32(v[i][q] * scale, v[i][q + 1] * scale, 0, false);
#pragma unroll
            for (int h2 = 0; h2 < 2; ++h2) { const int n = 4 * (lane & 15) + q + h2; *(LAS unsigned char*)(scr + n * 64 + (((k >> 4) ^ ((n >> 2) & 3)) << 4) + (k & 15)) = (unsigned char)(h2 ? (pk >> 8) : pk); } } }
    LDS_WAIT(); asm volatile("" ::: "memory");
#pragma unroll
    for (int j = 0; j < 4; ++j) { const int p = j * 64 + lane, n = p >> 2, c = p & 3;
        const u32x4 o = *(const LAS u32x4*)(scr + n * 64 + ((c ^ ((n >> 2) & 3)) << 4));
        __builtin_nontemporal_store(o, (u32x4*)(dst + (size_t)n * Kd8 + c * 16)); }
    LDS_WAIT(); asm volatile("" ::: "memory");
}
__device__ __forceinline__ int ropedim(int jj) { const int g = jj >> 3, u = jj & 7; return (u < 4) ? 4 * g + u : 16 + 4 * g + (u - 4); }

__device__ __forceinline__ void sincos_acc(float af, float& sn, float& cs) {
    const double a = (double)af; const double kq = __builtin_rint(a * 0.63661977236758134308);
    const double r = (a - kq * 1.57079632679489655800) - kq * 6.123233995736766036e-17;
    const double r2 = r * r;
    const double sp = r * (1.0 + r2 * (-1.66666666666666324348e-01 + r2 * (8.33333333332248946124e-03 + r2 * (-1.98412698298579493134e-04 + r2 * (2.75573137070700676789e-06 + r2 * (-2.50507602534068634195e-08 + r2 * 1.58969099521155010221e-10))))));
    const double cp = 1.0 + r2 * (-0.5 + r2 * (4.16666666666666019037e-02 + r2 * (-1.38888888888741095749e-03 + r2 * (2.48015872894767294178e-05 + r2 * (-2.75573143513906633035e-07 + r2 * (2.08757232129817482790e-09 + r2 * -1.13596475577881948265e-11))))));
    const int q = (int)((long long)kq & 3);
    const double s_ = (q == 0) ? sp : (q == 1) ? cp : (q == 2) ? -sp : -cp;
    const double c_ = (q == 0) ? cp : (q == 1) ? -sp : (q == 2) ? -cp : sp;
    sn = (float)s_; cs = (float)c_;
}

__global__ void __launch_bounds__(NWAVES * 64, 2) fwd(Args args) {
    extern __shared__ __attribute__((aligned(16))) unsigned char lds_raw[];
    Frame F;
    F.lds = (LAS unsigned char*)lds_raw;
    F.tid = threadIdx.x; F.lane = F.tid & 63; F.wave = __builtin_amdgcn_readfirstlane(F.tid >> 6);
    F.G = gridDim.x; { const int bx = blockIdx.x; F.vcu = (F.G % 8 == 0) ? (bx % 8) * (F.G / 8) + bx / 8 : bx; }
    volatile LAS unsigned* MISC = (volatile LAS unsigned*)(F.lds + MISC_OFF);
    unsigned char* ws = args.ws;
    gu32* ctl = (gu32*)(ws + WS_CTL);
#define X_IN ((const float*)AP->in[0])
#define cvec ((const float*)AP->in[1])
#define positions ((const int*)AP->in[2])
#define w_mod ((const float*)AP->in[3])
#define b_mod ((const float*)AP->in[4])
#define g_mix ((const float*)AP->in[5])
#define w_in ((const float*)AP->in[6])
#define b_forget ((const float*)AP->in[7])
#define g_q_lat ((const float*)AP->in[8])
#define w_q_up ((const float*)AP->in[9])
#define g_kv_lat ((const float*)AP->in[10])
#define w_kv_up ((const float*)AP->in[11])
#define w_o_mla ((const float*)AP->in[12])
#define w_o_fox ((const float*)AP->in[13])
#define w_out ((const float*)AP->in[14])
#define g_ffn ((const float*)AP->in[15])
#define w_router ((const float*)AP->in[16])
#define b_router ((const float*)AP->in[17])
#define w_exp_gate ((const float*)AP->in[18])
#define w_exp_up ((const float*)AP->in[19])
#define w_exp_down ((const float*)AP->in[20])
#define w_sh_gate ((const float*)AP->in[21])
#define w_sh_up ((const float*)AP->in[22])
#define w_sh_down ((const float*)AP->in[23])
#define g_final ((const float*)AP->in[24])
#define Win_t ((bf16*)(ws + WS_WIN))
#define Wq_t ((bf16*)(ws + WS_WQ))
#define Wkv_t ((bf16*)(ws + WS_WKV))
#define Wom_t ((bf16*)(ws + WS_WOM))
#define Wof_t ((bf16*)(ws + WS_WOF))
#define Wout_t ((bf16*)(ws + WS_WOUT))
#define Wsgu_t ((bf16*)(ws + WS_WSGU))
#define Wsd_t ((bf16*)(ws + WS_WSD))
#define Wr_f ((bf16*)(ws + WS_WR))
#define mod ((float*)(ws + WS_MOD))
#define Wd_t ((bf16*)(ws + WS_WD))
#define Wgu_t ((bf16*)(ws + WS_WGU))
#define HB ((bf16*)(ws + WS_HB))
#define FQ ((bf16*)(ws + WS_FQ))
#define FK ((bf16*)(ws + WS_FK))
#define FV ((bf16*)(ws + WS_FV))
#define QLAT ((bf16*)(ws + WS_QLAT))
#define KVLAT ((bf16*)(ws + WS_KVLAT))
#define OFOX ((bf16*)(ws + WS_OFOX))
#define OCAT ((bf16*)((unsigned char*)out + 32 * MiB))
#define OMLA ((bf16*)(ws + WS_OMLA))
#define Y ((bf16*)(ws + WS_Y))
#define H ((bf16*)(ws + WS_H))
#define QMLA ((bf16*)(ws + WS_QMLA))
#define GATES ((bf16*)(ws + WS_GATES))
#define KN ((bf16*)(ws + WS_KN))
#define VM ((bf16*)(ws + WS_VM))
#define KPE ((bf16*)(ws + WS_KPE))
#define MERGED ((bf16*)(ws + WS_MERGED))
#define LIST ((unsigned short*)(ws + WS_LIST))
#define Wgu8 ((unsigned char*)(ws + WS_WGU))
#define Wsgu8 ((unsigned char*)(ws + WS_WSGU))
#define H8 ((unsigned char*)(ws + WS_H))
#define META ((u32x2*)(ws + WS_WIN))
#define EIDX ((unsigned char*)(ws + WS_EIDX))
#define GATEW ((float*)(ws + WS_GATEW))
#define ROPETAB ((float*)((unsigned char*)out + DO_ROPE))
#define LOGF ((float*)((unsigned char*)out + DO_LOGF))
#define CUMF ((float*)((unsigned char*)out + DO_CUMF))
#define SSQQ ((float*)((unsigned char*)out + DO_SSQQ))
#define SSQKV ((float*)((unsigned char*)out + DO_SSQKV))
#define MODP ((float*)((unsigned char*)out + DO_MODP))
#define SSQ1 ((float*)(ws + WS_FQ))
    float* const out = args.out;
#define PHASE_ENV const __attribute__((address_space(4))) Args* AP; { auto kp_ = __builtin_amdgcn_kernarg_segment_ptr(); asm volatile("" : "+s"(kp_)); AP = (const __attribute__((address_space(4))) Args*)kp_; } \
    unsigned char* const ws = AP->ws; float* const out = AP->out; (void)ws; (void)out;
    for (int u = F.tid; u < (LDS_BYTES - LDSCTL_OFF) / 4; u += NWAVES * 64) ((LAS unsigned*)(F.lds + LDSCTL_OFF))[u] = 0u;
    __syncthreads();
    XcdBarrier bar; bar.bar = (unsigned*)(ctl + CW_BAR); bar.x = 0; bar.st = nullptr;
    if (MK_ONE_LAUNCH) bar = xcd_barrier_post((unsigned*)(ctl + CW_BAR), MISC + 8);
    const int lo = args.ph_lo, hi = args.ph_hi;
#define IN(k) (lo <= (k) && (k) < hi)
#define BOTH(k) (IN(k) && IN((k) + 1))
#define GRID_BAR() do { if (MK_ONE_LAUNCH) xcd_barrier(bar); } while (0)
#define DUP_BAR() do { if (dummy) xcd_barrier(bar); } while (0)
    const int gw = F.vcu * NWAVES + F.wave, NGW = F.G * NWAVES;

    for (int rep = 0; rep < ((PROBE_DUP == 0) ? 2 : 1); ++rep) if (IN(0)) { PHASE_ENV const bool dummy = (PROBE_DUP == 0) && rep == 0; (void)dummy;
        if (!(dummy && (PROBE_VAR == 1 || PROBE_VAR == 4 || PROBE_VAR == 5))) {
            LAS float* cond = (LAS float*)F.lds;
            for (int i = F.tid; i < NB * D; i += NWAVES * 64) { const float c = cvec[i]; cond[i] = c / (1.f + __expf(-c)); }
            __syncthreads();
            for (int it = F.wave * F.G + F.vcu; it < 96 * 16; it += NWAVES * F.G) { const int cg = it % 96, kq = it / 96, col = cg * 64 + F.lane;
                float a4[4] = {0.f, 0.f, 0.f, 0.f};
                const float* wp = w_mod + (size_t)(64 * kq) * (6 * D) + col;
                float wv[64];
#pragma unroll
                for (int kk = 0; kk < 64; ++kk) wv[kk] = __builtin_nontemporal_load(wp + (size_t)kk * (6 * D));
#pragma unroll
                for (int kk = 0; kk < 64; ++kk) {
#pragma unroll
                    for (int b = 0; b < 4; ++b) a4[b] += wv[kk] * cond[b * D + 64 * kq + kk]; }
#pragma unroll
                for (int b = 0; b < 4; ++b) MODP[((size_t)kq * 4 + b) * (6 * D) + col] = a4[b]; }
            __syncthreads();
        }
        if (!(dummy && (PROBE_VAR == 1 || PROBE_VAR == 3 || PROBE_VAR == 5))) for (int i = gw * 64 + F.lane; i < T * 16; i += NGW * 64) { const int t = i >> 4, j = i & 15;
            const float invf = (((j >> 2) == 0) ? 1.f : ((j >> 2) == 1) ? 0.1f : ((j >> 2) == 2) ? 0.01f : 0.001f) * (((j & 3) == 0) ? 1.f : ((j & 3) == 1) ? 0.5623413251903491f : ((j & 3) == 2) ? 0.31622776601683794f : 0.17782794100389228f);
            const float ang = (float)positions[t] * invf; float sn, cs; sincos_acc(ang, sn, cs);
            *(f32x2*)(ROPETAB + (size_t)i * 2) = (f32x2){cs, sn}; }
        for (int o = gw * 64 + F.lane; o < NEXP * D; o += NGW * 64) { const int piece = o >> 3, kk = o & 7, ln = piece & 63, grp = piece >> 6, ntl = grp & 3, j = grp >> 2;
            const int n = ntl * 16 + (ln & 15), k = j * 32 + (ln >> 4) * 8 + kk; Wr_f[o] = (bf16)f2bf(w_router[(size_t)k * NEXP + n]); }
        {
            LAS unsigned char* scr8 = F.lds + 32768 + F.wave * 9216;
            constexpr int F_IN = 62 * 16, F_O = 16 * 8, F_OUT = 16 * 16, F_SGU = 8 * 16, F_SD = 16 * 4, F_EGU = NEXP * F_SGU, F_ED = NEXP * F_SD;
            constexpr int NFAST = F_IN + 2 * F_O + F_OUT + F_SGU + F_SD + F_EGU + F_ED;
            if (!(dummy && PROBE_VAR >= 2)) for (int it = gw; it < NFAST; it += NGW) {
                int r = it;
                if (r < F_EGU) { const int e = r / F_SGU, rr = r % F_SGU, nb = rr & 7, kb = rr >> 3, pn = nb >> 2, c0 = (nb & 3) * 64;
                    const float* wsrc = (c0 < 128) ? w_exp_gate + (size_t)e * D * DEXP + pn * 128 + c0 : w_exp_up + (size_t)e * D * DEXP + pn * 128 + (c0 - 128);
                    cvt64_item8(wsrc + (size_t)(64 * kb) * DEXP, DEXP, Wgu8 + (size_t)e * 512 * D + (size_t)(64 * nb) * D + 64 * kb, D, scr8, F.lane, WSCALE8); continue; } r -= F_EGU;
                if (r < F_ED) { const int e = r / F_SD, rr = r % F_SD, nb = rr & 15, kb = rr >> 4;
                    cvt64_item(w_exp_down + (size_t)e * DEXP * D + (size_t)(64 * kb) * D + 64 * nb, D, Wd_t + (size_t)e * D * DEXP + (size_t)(64 * nb) * DEXP + 64 * kb, DEXP, scr8, F.lane); continue; } r -= F_ED;
                if (r < F_IN) { int nb = r % 62; const int kb = r / 62; if (nb >= 6) nb += 2; const int n0 = 64 * nb;
                    const int src = (n0 < 384) ? n0 : (n0 < 2048) ? 416 + (n0 - 512) : 1960 + (n0 - 2048);
                    cvt64_item(w_in + (size_t)(64 * kb) * 4008 + src, 4008, Win_t + (size_t)n0 * D + 64 * kb, D, scr8, F.lane); continue; } r -= F_IN;
                if (r < F_O) { const int nb = r & 15, kb = r >> 4; cvt64_item8(w_o_mla + (size_t)(64 * kb) * D + 64 * nb, D, (unsigned char*)Wom_t + (size_t)(64 * nb) * D + 64 * kb, D, scr8, F.lane, WSCALE8); continue; } r -= F_O;
                if (r < F_O) { const int nb = r & 15, kb = r >> 4; cvt64_item8(w_o_fox + (size_t)(64 * kb) * D + 64 * nb, D, (unsigned char*)Wom_t + (size_t)(64 * nb) * D + 512 + 64 * kb, D, scr8, F.lane, WSCALE8); continue; } r -= F_O;
                if (r < F_OUT) { const int nb = r & 15, kb = r >> 4; cvt64_item8(w_out + (size_t)(64 * kb) * D + 64 * nb, D, (unsigned char*)Wout_t + (size_t)(64 * nb) * D + 64 * kb, D, scr8, F.lane, WSCALE8); continue; } r -= F_OUT;
                if (r < F_SGU) { const int nb = r >> 4, kb = r & 15, pn = nb >> 2, c0 = (nb & 3) * 64;
                    const float* wsrc = (c0 < 128) ? w_sh_gate + pn * 128 + c0 : w_sh_up + pn * 128 + (c0 - 128);
                    cvt64_item8(wsrc + (size_t)(64 * kb) * DEXP, DEXP, Wsgu8 + (size_t)(64 * nb) * D + 64 * kb, D, scr8, F.lane, WSCALE8); continue; } r -= F_SGU;
                { const int nb = r >> 2, kb = r & 3; cvt64_item(w_sh_down + (size_t)(64 * kb) * D + 64 * nb, D, Wsd_t + (size_t)(64 * nb) * DEXP + 64 * kb, DEXP, scr8, F.lane); }
            }
            LAS float* scr = (LAS float*)(F.lds + 32768 + F.wave * 9216);
            constexpr int I_INS = 4 * (D / 64), I_Q = (768 / 32) * (QLORA / 64), I_KV = (1024 / 32) * (KVPAD / 64), NSLOW = I_INS + I_Q + I_KV;
            if (!(dummy && (PROBE_VAR == 1 || PROBE_VAR == 3 || PROBE_VAR == 4))) for (int it = F.wave * F.G + F.vcu; it < NSLOW; it += NGW) {
                int r = it;
                if (r < I_INS) { const int nb = 12 + (r & 3), kb = r >> 2;
                    cvt_item(4008, D, nullptr, Win_t, D, scr, kb, nb, F.lane, [&](int n) -> const float* {
                        int src; if (n < 416) src = 384 + ropedim(n - 384); else if (n < 424) src = 1952 + (n - 416); else src = -1;
                        return src < 0 ? nullptr : w_in + src; }); continue; } r -= I_INS;
                if (r < I_Q) { const int nblk = 768 / 32;
                    cvt_item(768, QLORA, g_q_lat, Wq_t, QLORA, scr, r / nblk, r % nblk, F.lane, [&](int n) -> const float* {
                        const int hh = n / MQK, j = n % MQK; return w_q_up + hh * MQK + (j < 64 ? j : 64 + ropedim(j - 64)); }); continue; } r -= I_Q;
                { const int nblk = 1024 / 32;
                    cvt_item(1024, KVLORA, g_kv_lat, Wkv_t, KVPAD, scr, r / nblk, r % nblk, F.lane, [&](int n) -> const float* {
                        return (n < 512) ? w_kv_up + (n >> 6) * 128 + (n & 63) : w_kv_up + ((n - 512) >> 6) * 128 + 64 + (n & 63); }); }
            }
        }
        if (BOTH(0)) GRID_BAR();
    }

    for (int rep = 0; rep < ((PROBE_DUP == 1) ? 2 : 1); ++rep) if (IN(1)) { PHASE_ENV const bool dummy = (PROBE_DUP == 1) && rep == 0; (void)dummy;
        if (F.vcu < 48) { const int idx = F.vcu * 512 + F.tid, b = idx / (6 * D), col = idx % (6 * D); float sm = b_mod[col];
#pragma unroll
            for (int p = 0; p < 16; ++p) sm += MODP[((size_t)p * 4 + b) * (6 * D) + col];
            mod[idx] = sm; }
        LAS float* vg1 = (LAS float*)F.lds; LAS float* vs1 = (LAS float*)(F.lds + 4096);
        for (int grp = F.vcu; grp < T / 64; grp += F.G) {
            const int b = (grp * 64) / SEQ;
            __syncthreads();
            for (int k = F.tid; k < D; k += NWAVES * 64) { float s0 = b_mod[k], s1 = b_mod[D + k];
#pragma unroll
                for (int p = 0; p < 16; ++p) { s0 += MODP[((size_t)p * 4 + b) * (6 * D) + k]; s1 += MODP[((size_t)p * 4 + b) * (6 * D) + D + k]; }
                vs1[k] = s0; vg1[k] = g_mix[k] * (1.f + s1); }
            __syncthreads();
#pragma unroll 2
            for (int rr = 0; rr < 8; ++rr) { const int m = grp * 64 + F.wave * 8 + rr;
                const f32x4* xr = (const f32x4*)(X_IN + (size_t)m * D) + F.lane;
                f32x4 v[4]; float s = 0.f;
#pragma unroll
                for (int j = 0; j < 4; ++j) { v[j] = __builtin_nontemporal_load(xr + 64 * j); s += (v[j].x * v[j].x + v[j].y * v[j].y) + (v[j].z * v[j].z + v[j].w * v[j].w); }
                const float rstd = rsqrtf(wave_sum(s) * (1.f / D) + EPS);
                unsigned long long* o8 = (unsigned long long*)(H + (size_t)m * D) + F.lane;
#pragma unroll
                for (int j = 0; j < 4; ++j) { const int c = 4 * F.lane + 256 * j;
                    const f32x4 g = *(const LAS f32x4*)(vg1 + c), d = *(const LAS f32x4*)(vs1 + c);
                    const f32x4 r = v[j] * rstd * g + d;
                    o8[64 * j] = (unsigned long long)pk2(r.x, r.y) | ((unsigned long long)pk2(r.z, r.w) << 32); } }
        }
        if (BOTH(1)) GRID_BAR();
    }

    for (int rep = 0; rep < ((PROBE_DUP == 2) ? 2 : 1); ++rep) if (IN(2)) { PHASE_ENV const bool dummy = (PROBE_DUP == 2) && rep == 0; (void)dummy;
        pg8::StaticOrder S; S.init(H, Win_t, T, NIN, D, F.G, (int)blockIdx.x);
        EpiInProj E{QLAT, KVLAT, KPE, FQ, GATES, LOGF, SSQQ, SSQKV, ROPETAB, b_forget};
        pg8::gemm_phase<EpiInProj, pg8::StaticOrder, true>(F.lds, S, E);
        if (BOTH(2)) GRID_BAR();
    }

    for (int rep = 0; rep < ((PROBE_DUP == 3) ? 2 : 1); ++rep) if (IN(3)) { PHASE_ENV const bool dummy = (PROBE_DUP == 3) && rep == 0; (void)dummy;
        {
            const int bb = F.vcu & 3; float mx = 0.f, mq = 0.f;
            for (int r = (F.vcu >> 2) * NWAVES + F.wave; r < SEQ; r += (F.G >> 2) * NWAVES) { f32x4 k0, k1, q0v, q1v; unpack8(*(const u32x4*)(FK + ((size_t)bb * SEQ + r) * 512 + 8 * F.lane), k0, k1);
                unpack8(*(const u32x4*)(FQ + ((size_t)bb * SEQ + r) * 512 + 8 * F.lane), q0v, q1v);
                float sq = (k0[0] * k0[0] + k0[1] * k0[1]) + (k0[2] * k0[2] + k0[3] * k0[3]) + (k1[0] * k1[0] + k1[1] * k1[1]) + (k1[2] * k1[2] + k1[3] * k1[3]);
                float sqq = (q0v[0] * q0v[0] + q0v[1] * q0v[1]) + (q0v[2] * q0v[2] + q0v[3] * q0v[3]) + (q1v[0] * q1v[0] + q1v[1] * q1v[1]) + (q1v[2] * q1v[2] + q1v[3] * q1v[3]);
                sq += dppf<0xB1>(sq); sq += dppf<0x4E>(sq); sq += dppf<0x141>(sq);
                sqq += dppf<0xB1>(sqq); sqq += dppf<0x4E>(sqq); sqq += dppf<0x141>(sqq);
                mx = fmaxf(mx, sq); mq = fmaxf(mq, sqq); }
            LAS float* kml = (LAS float*)F.lds;
            if ((F.lane & 7) == 0) { kml[F.wave * 8 + (F.lane >> 3)] = mx; kml[64 + F.wave * 8 + (F.lane >> 3)] = mq; }
            __syncthreads();
            if (F.tid < 2 * NHEAD) { const int hh = F.tid & 7, qk = F.tid >> 3; float m2 = 0.f;
#pragma unroll
                for (int w = 0; w < NWAVES; ++w) m2 = fmaxf(m2, kml[qk * 64 + w * 8 + hh]);
                atomicMax((unsigned*)(ctl + CW_KM + qk * 32 + bb * NHEAD + hh), __float_as_uint(m2)); }
            __syncthreads();
        }
        if (F.vcu < NB) {
            const int b = F.vcu, h = F.wave; const float* src = LOGF + ((size_t)b * SEQ + 64 * F.lane) * 8 + h;
            float v[64]; float run = 0.f;
#pragma unroll
            for (int i = 0; i < 64; ++i) v[i] = src[i * 8];
#pragma unroll
            for (int i = 0; i < 64; ++i) { run += v[i]; v[i] = run; }
            float incl = run;
#pragma unroll
            for (int o = 1; o < 64; o <<= 1) { const float n = __shfl_up(incl, o); if (F.lane >= o) incl += n; }
            const float excl = incl - run;
            float* dst = CUMF + ((size_t)b * NHEAD + h) * SEQ + 64 * F.lane;
#pragma unroll
            for (int i = 0; i < 64; i += 4) *(f32x4*)(dst + i) = (f32x4){v[i] + excl, v[i + 1] + excl, v[i + 2] + excl, v[i + 3] + excl};
        }
        { UpOrder S{(const char*)QLAT, (const char*)Wq_t, (const char*)KVLAT, (const char*)Wkv_t, QLORA, F.G, (int)blockIdx.x};
          EpiUp E{EpiQup{QMLA, SSQQ, ROPETAB}, EpiKVup{KN, VM, SSQKV}};
          pg8::gemm_phase<EpiUp, UpOrder, true>(F.lds, S, E); }
        if (BOTH(3)) GRID_BAR();
    }

    for (int rep = 0; rep < ((PROBE_DUP == 4) ? 2 : 1); ++rep) if (IN(4)) { PHASE_ENV const bool dummy = (PROBE_DUP == 4) && rep == 0; (void)dummy;
        {
            const bool xq = (F.G % 8) == 0; const int x = xq ? (int)(blockIdx.x & 7) : 0, nunits = xq ? 128 : 1024;
            gu32* qh = ctl + CW_Q + 64 * x + (dummy ? 16 : 0);
            volatile LAS unsigned* qw = (volatile LAS unsigned*)(F.lds + MISC_OFF + 64);
            for (;;) {
                if (F.tid == 0) qw[0] = __hip_atomic_fetch_add(qh, 1u, RLX_AGENT);
                __syncthreads();
                const int r = (int)qw[0];
                if (r >= nunits) break;
                int qb, type, b, h;
                if (xq) { qb = 15 - (r >> 3); type = (r >> 2) & 1; b = r & 3; h = (x + 3 * b) & 7; }
                else { qb = 15 - (r >> 6); type = (r >> 5) & 1; b = (r >> 3) & 3; h = r & 7; }
                if (type == 0) { if (ATT_TUNED_FOX && qb != 0) att::attn_unit_t<64, true, 8>(b, h, qb, FQ, 512, FK, KPE, FV, CUMF, __uint_as_float(__hip_atomic_load((unsigned*)(ctl + CW_KM + b * NHEAD + h), RLX_AGENT)) * __uint_as_float(__hip_atomic_load((unsigned*)(ctl + CW_KM + 32 + b * NHEAD + h), RLX_AGENT)), (bf16*)((unsigned char*)(dummy ? (bf16*)((unsigned char*)out + 4 * MiB) : OCAT) + 512), D, F.lds);
                                 else att::attn_unit<64, true, 8>(b, h, qb, FQ, 512, FK, KPE, FV, CUMF, (bf16*)((unsigned char*)(dummy ? (bf16*)((unsigned char*)out + 4 * MiB) : OCAT) + 512), D, F.lds); }
                else { if (ATT_TUNED_MLA && qb != 0) att::attn_unit_t<96, false, 8>(b, h, qb, QMLA, 768, KN, KPE, VM, nullptr, 0.f, dummy ? (bf16*)((unsigned char*)out + 4 * MiB) : OCAT, D, F.lds);
                       else att::attn_unit<96, false, 8>(b, h, qb, QMLA, 768, KN, KPE, VM, nullptr, dummy ? (bf16*)((unsigned char*)out + 4 * MiB) : OCAT, D, F.lds); }
            }
        }
        if (BOTH(4)) GRID_BAR();
    }

    for (int rep = 0; rep < ((PROBE_DUP == 5) ? 2 : 1); ++rep) if (IN(5)) { PHASE_ENV const bool dummy = (PROBE_DUP == 5) && rep == 0; (void)dummy;
        pg8::StaticOrder S; S.init(OCAT, Wom_t, T, D, D / 2, F.G, (int)blockIdx.x);
        EpiMergedCat E{GATES, (unsigned char*)MERGED, 1.f / WSCALE8};
        pg8::gemm_phase<EpiMergedCat, pg8::StaticOrder, true, true>(F.lds, S, E);
        if (BOTH(5)) GRID_BAR();
    }

    for (int rep = 0; rep < ((PROBE_DUP == 6) ? 2 : 1); ++rep) if (IN(6)) { PHASE_ENV const bool dummy = (PROBE_DUP == 6) && rep == 0; (void)dummy;
        pg8::StaticOrder S; S.init(MERGED, Wout_t, T, D, D / 2, F.G, (int)blockIdx.x);
        EpiOut E{X_IN, out, mod, SSQ1, 1.f / (OSCALE8 * WSCALE8)};
        pg8::gemm_phase<EpiOut, pg8::StaticOrder, true, true>(F.lds, S, E);
        if (BOTH(6)) GRID_BAR();
    }

    for (int rep = 0; rep < ((PROBE_DUP == 7) ? 2 : 1); ++rep) if (IN(7)) { PHASE_ENV const bool dummy = (PROBE_DUP == 7) && rep == 0; (void)dummy;
        LAS unsigned char* wrl = F.lds;
        LAS float* vg = (LAS float*)(F.lds + LDSCTL_OFF + 6144);
        LAS float* vs = (LAS float*)(F.lds + LDSCTL_OFF + 10240);
        LAS float* stg = (LAS float*)(F.lds) + F.wave * 512;
        LAS int* cntw = (LAS int*)(F.lds + 16384);
        LAS int* basel = (LAS int*)(F.lds + 16384 + 2048);
        static_assert(LDSCTL_OFF + 10240 + 4096 <= LDS_BYTES && MOETAB_OFF + 4700 <= LDSCTL_OFF + 6144, "P7 LDS map");
        const float my_bias = b_router[F.lane];
        for (int grp = F.vcu; grp < T / 64; grp += F.G) {
            const int b = (grp * 64) / SEQ;
            __syncthreads();
#pragma unroll
            for (int i = 0; i < 16; ++i) __builtin_amdgcn_global_load_lds((const unsigned*)((const char*)Wr_f + (F.wave * 16 + i) * 1024 + F.lane * 16), (LAS unsigned*)(wrl + (F.wave * 16 + i) * 1024), 16, 0, 0);
            for (int i = F.tid; i < D; i += NWAVES * 64) { vg[i] = g_ffn[i] * (1.f + mod[(size_t)b * 6 * D + 4 * D + i]); vs[i] = mod[(size_t)b * 6 * D + 3 * D + i]; }
            const int t0 = grp * 64 + F.wave * 8;
            float rs_mine;
            { const float* sp = SSQ1 + (size_t)(t0 + (F.lane & 7)) * 16; const f32x4 a = *(const f32x4*)sp, b4 = *(const f32x4*)(sp + 4), c4 = *(const f32x4*)(sp + 8), d4 = *(const f32x4*)(sp + 12);
              const float ssum = (((a[0] + a[1]) + (a[2] + a[3])) + ((b4[0] + b4[1]) + (b4[2] + b4[3]))) + (((c4[0] + c4[1]) + (c4[2] + c4[3])) + ((d4[0] + d4[1]) + (d4[2] + d4[3])));
              rs_mine = rsqrtf(ssum * (1.f / D) + EPS); }
            VM_WAIT(); __syncthreads();
            const int r16 = F.lane & 15, kg = F.lane >> 4, myrow = t0 + (r16 & 7);
            const float* xrow = out + (size_t)myrow * D + 8 * kg;
            f32x4 lacc[4] = {{0.f, 0.f, 0.f, 0.f}, {0.f, 0.f, 0.f, 0.f}, {0.f, 0.f, 0.f, 0.f}, {0.f, 0.f, 0.f, 0.f}};
            f32x4 xq[16][2];
#pragma unroll
            for (int p = 0; p < 16; ++p) { xq[p][0] = *(const f32x4*)(xrow + 32 * p); xq[p][1] = *(const f32x4*)(xrow + 32 * p + 4); }
            for (int j4 = 0; j4 < 32; j4 += 16) {
#pragma unroll
                for (int p = 0; p < 16; ++p) { const int j = j4 + p, k = 32 * j + 8 * kg;
                    const f32x4 x0 = xq[p][0], x1v = xq[p][1];
                    if (j4 + 16 < 32) { xq[p][0] = *(const f32x4*)(xrow + 32 * (j + 16)); xq[p][1] = *(const f32x4*)(xrow + 32 * (j + 16) + 4); }
                    const f32x4 g0 = *(const LAS f32x4*)(vg + k), g1 = *(const LAS f32x4*)(vg + k + 4), s0 = *(const LAS f32x4*)(vs + k), s1 = *(const LAS f32x4*)(vs + k + 4);
                    const f32x4 h0 = x0 * rs_mine * g0 + s0, h1 = x1v * rs_mine * g1 + s1;
                    const u32x4 hw = pack8(h0, h1);
                    f32x4 a0, a1; unpack8(hw, a0, a1);
                    const u32x4 lw = pack8(h0 - a0, h1 - a1);
                    if (r16 < 8) { u32x2 h8; int p_ = __builtin_amdgcn_cvt_pk_fp8_f32(h0[0], h0[1], 0, false); p_ = __builtin_amdgcn_cvt_pk_fp8_f32(h0[2], h0[3], p_, true); h8.x = (unsigned)p_;
                        p_ = __builtin_amdgcn_cvt_pk_fp8_f32(h1[0], h1[1], 0, false); p_ = __builtin_amdgcn_cvt_pk_fp8_f32(h1[2], h1[3], p_, true); h8.y = (unsigned)p_;
                        *(u32x2*)(H8 + (size_t)myrow * D + k) = h8; }
                    const bf16x8 Ah = __builtin_bit_cast(bf16x8, hw), Al = __builtin_bit_cast(bf16x8, lw);
#pragma unroll
                    for (int ntl = 0; ntl < 4; ++ntl) { const bf16x8 Wf = *(const LAS bf16x8*)(wrl + ((j * 4 + ntl) * 64 + F.lane) * 16);
                        lacc[ntl] = __builtin_amdgcn_mfma_f32_16x16x32_bf16(Wf, Ah, lacc[ntl], 0, 0, 0);
                        lacc[ntl] = __builtin_amdgcn_mfma_f32_16x16x32_bf16(Wf, Al, lacc[ntl], 0, 0, 0); } }
            }
            __syncthreads();
            if (r16 < 8) {
#pragma unroll
                for (int ntl = 0; ntl < 4; ++ntl) *(LAS f32x4*)(stg + r16 * 64 + 16 * ntl + 4 * kg) = lacc[ntl]; }
            LDS_WAIT();
            int cnt = 0; unsigned selbits = 0u, selks = 0u;
            for (int j = 0; j < 8; ++j) {
                const float logit = stg[j * 64 + F.lane];
                const float sc = 1.f / (1.f + expf(-logit));
                const float ch = sc + my_bias;
                const float m1 = max8(ch);
                const unsigned long long eq = __ballot(ch == m1);
                const unsigned gm = (unsigned)(eq >> (F.lane & ~7)) & 0xffu;
                const int first = __builtin_ctz(gm);
                const float c2 = max8(((F.lane & 7) == first) ? -INFINITY : ch);
                const float gs = m1 + c2; const int myg = F.lane >> 3;
                int rank = 0;
#pragma unroll
                for (int g = 0; g < 8; ++g) { const float o = __builtin_bit_cast(float, __builtin_amdgcn_readlane(__builtin_bit_cast(int, gs), 8 * g)); rank += (o > gs || (o == gs && g < myg)) ? 1 : 0; }
                float mc = (rank < 4) ? ch : -1e30f;
                int selk = -1;
#pragma unroll
                for (int k = 0; k < TOPK; ++k) { const float mx = wave_max_f(mc); const unsigned long long bl = __ballot(mc == mx); const int fl = __builtin_ctzll(bl);
                    if (F.lane == fl) { selk = k; mc = -INFINITY; } }
                const float ssum = wave_sum_f(selk >= 0 ? sc : 0.f);
                if (selk >= 0) { const int t = t0 + j; EIDX[(size_t)t * 8 + selk] = (unsigned char)F.lane; GATEW[(size_t)t * 8 + selk] = sc / ssum * 2.5f; ++cnt; selbits |= 1u << j; selks |= (unsigned)selk << (3 * j); }
            }
            cntw[F.wave * 64 + F.lane] = cnt;
            __syncthreads();
            if (F.wave == 0) { int tot = 0;
#pragma unroll
                for (int w = 0; w < 8; ++w) tot += cntw[w * 64 + F.lane];
                basel[F.lane] = (int)__hip_atomic_fetch_add((unsigned*)(ctl + (dummy ? CW_CNT + 2048 : CW_CNT) + 16 * F.lane), (unsigned)tot, RLX_AGENT); }
            __syncthreads();
            int pos = basel[F.lane];
            for (int w = 0; w < F.wave; ++w) pos += cntw[w * 64 + F.lane];
#pragma unroll
            for (int j = 0; j < 8; ++j) if ((selbits >> j) & 1u) { const int k = (selks >> (3 * j)) & 7, t = t0 + j;
                LIST[(size_t)F.lane * LISTCAP + pos] = (unsigned short)t;
                META[(size_t)F.lane * LISTCAP + pos] = (u32x2){(unsigned)(t * (TOPK + 1) + k), __float_as_uint(GATEW[(size_t)t * 8 + k])}; ++pos; }
        }
        __syncthreads();
        if (BOTH(7)) GRID_BAR();
    }

    volatile LAS int* tab = (volatile LAS int*)(F.lds + MOETAB_OFF);
    if (IN(8) || IN(9)) {
        __syncthreads();
        if (F.wave == 0) {
            const int n = (int)__hip_atomic_load((unsigned*)(ctl + CW_CNT + 16 * F.lane), RLX_AGENT);
            const int tiles = (n + 255) >> 8; int incl = tiles;
#pragma unroll
            for (int o = 1; o < 64; o <<= 1) { const int v = __shfl_up(incl, o); if (F.lane >= o) incl += v; }
            tab[F.lane] = incl - tiles; tab[66 + F.lane] = n;
            if (F.lane == 63) { tab[64] = incl; tab[65] = incl + T / 256; tab[66 + 64] = T; }
        }
        __syncthreads();
        { const int ti = F.tid; int e = 0;
          for (int q = 0; q <= NEXP; ++q) if (tab[q] <= ti) e = q;
          tab[132 + ti] = e; }
        __syncthreads();
    }
    for (int rep = 0; rep < ((PROBE_DUP == 8) ? 2 : 1); ++rep) if (IN(8)) { PHASE_ENV const bool dummy = (PROBE_DUP == 8) && rep == 0; (void)dummy;
        MoeOrder<2, true> S{(const char*)H8, (const char*)Wgu8, (const char*)Wsgu8, D / 2, (size_t)512 * D, LIST, tab, F.G, (int)blockIdx.x};
        EpiHb E{HB, 1.f / WSCALE8};
        pg8::gemm_phase<EpiHb, MoeOrder<2, true>, true, true>(F.lds, S, E);
        if (BOTH(8)) GRID_BAR();
    }
    for (int rep = 0; rep < ((PROBE_DUP == 9) ? 2 : 1); ++rep) if (IN(9)) { PHASE_ENV const bool dummy = (PROBE_DUP == 9) && rep == 0; (void)dummy;
        if (dummy && PROBE_VAR == 1) dn::down_phase<true>(F.lds, HB, Wd_t, Wsd_t, tab, META, (unsigned char*)Y, (unsigned char*)(ws + WS_CTL + 900 * 1024), F.G, (int)blockIdx.x);
        else dn::down_phase<false>(F.lds, HB, Wd_t, Wsd_t, tab, META, (unsigned char*)Y, (unsigned char*)(ws + WS_CTL + 900 * 1024), F.G, (int)blockIdx.x);
        if (BOTH(9)) GRID_BAR();
    }

    for (int rep = 0; rep < ((PROBE_DUP == 10) ? 2 : 1); ++rep) if (IN(10)) { PHASE_ENV const bool dummy = (PROBE_DUP == 10) && rep == 0; (void)dummy;
        int ln10 = F.lane; asm volatile("" : "+v"(ln10));
        for (int m = gw; m < T; m += NGW) {
            const int b = m / SEQ; const float* gf = mod + (size_t)b * 6 * D + 5 * D;
            f32x4* xr = (f32x4*)(out + (size_t)m * D) + ln10;
            f32x4* xw = dummy ? (f32x4*)((float*)HB + (size_t)m * D) + ln10 : xr;
            f32x4 v[4]; float s = 0.f;
#pragma unroll
            for (int j = 0; j < 4; ++j) { const int c = 4 * ln10 + 256 * j;
                f32x4 y = {0.f, 0.f, 0.f, 0.f};
#pragma unroll
                for (int k = 0; k < TOPK + 1; ++k) { const int w = __builtin_nontemporal_load((const int*)((const unsigned char*)Y + ((size_t)m * (TOPK + 1) + k) * D + c));
                    const f32x2 lo = __builtin_amdgcn_cvt_pk_f32_fp8(w, false), hi2 = __builtin_amdgcn_cvt_pk_f32_fp8(w, true);
                    y += (f32x4){lo.x, lo.y, hi2.x, hi2.y}; }
                v[j] = __builtin_nontemporal_load(xr + 64 * j) + *(const f32x4*)(gf + c) * y;
                s += (v[j].x * v[j].x + v[j].y * v[j].y) + (v[j].z * v[j].z + v[j].w * v[j].w); }
            const float rstd = rsqrtf(wave_sum(s) * (1.f / D) + EPS);
#pragma unroll
            for (int j = 0; j < 4; ++j) __builtin_nontemporal_store(v[j] * rstd * *(const f32x4*)(g_final + 4 * ln10 + 256 * j), xw + 64 * j);
        }
    }
#undef IN
#undef BOTH
#undef GRID_BAR
}

constexpr int NPHASE = 11;
extern "C" void kernel_launch(void* const* d_in, const int* in_sizes, int n_in, void* d_out, int out_size, void* d_ws, size_t ws_size, hipStream_t stream) {
    static int grid = 0;
    if (grid == 0) {
        if (n_in != 25 || out_size != T * D || ws_size < WS_END) { fprintf(stderr, "kernel_launch: unexpected shapes (n_in %d out %d ws %zu need %zu)\n", n_in, out_size, ws_size, (size_t)WS_END); grid = -1; return; }
        int dev = 0, cus = 0;
        if (hipGetDevice(&dev) != hipSuccess || hipDeviceGetAttribute(&cus, hipDeviceAttributeMultiprocessorCount, dev) != hipSuccess) { grid = -1; return; }
        if (hipFuncSetAttribute((const void*)fwd, hipFuncAttributeMaxDynamicSharedMemorySize, LDS_BYTES) != hipSuccess) { fprintf(stderr, "kernel_launch: hipFuncSetAttribute failed\n"); grid = -1; return; }
        int per_cu = 0;
        if (hipOccupancyMaxActiveBlocksPerMultiprocessor(&per_cu, (const void*)fwd, NWAVES * 64, LDS_BYTES) != hipSuccess || per_cu < 1) { fprintf(stderr, "kernel_launch: occupancy query says %d\n", per_cu); }
        (void)hipGetLastError();
        grid = cus;
    }
    if (grid < 0) return;
    (void)in_sizes;
    if (hipMemsetAsync((char*)d_ws + WS_CTL, 0, CTL_ZERO_BYTES, stream) != hipSuccess) return;
    Args a{};
    for (int i = 0; i < 25; ++i) a.in[i] = d_in[i];
    a.out = (float*)d_out; a.ws = (unsigned char*)d_ws;
#if MK_ONE_LAUNCH
    a.ph_lo = 0; a.ph_hi = NPHASE;
    hipLaunchKernelGGL(fwd, dim3(grid), dim3(NWAVES * 64), LDS_BYTES, stream, a);
#else
    for (int p = 0; p < NPHASE; ++p) { a.ph_lo = p; a.ph_hi = p + 1; hipLaunchKernelGGL(fwd, dim3(grid), dim3(NWAVES * 64), LDS_BYTES, stream, a); }
#endif
}
```

```cpp
#include <hip/hip_runtime.h>
#include <cstdio>
#include <cstdint>
#include <type_traits>

#ifndef MK_ONE_LAUNCH
#define MK_ONE_LAUNCH 1
#endif

#ifndef PROBE_DUP
#define PROBE_DUP -1
#endif
#ifndef ATT_TUNED_FOX
#define ATT_TUNED_FOX 1
#endif
#ifndef ATT_TUNED_MLA
#define ATT_TUNED_MLA 1
#endif
#ifndef PROBE_VAR
#define PROBE_VAR 0
#endif
#define GAS __attribute__((address_space(1)))
#define LAS __attribute__((address_space(3)))
typedef unsigned short bf16;
typedef short bf16x8 __attribute__((ext_vector_type(8)));
typedef short s16x4 __attribute__((ext_vector_type(4)));
typedef float f32x2 __attribute__((ext_vector_type(2)));
typedef float f32x4 __attribute__((ext_vector_type(4)));
typedef float f32x16 __attribute__((ext_vector_type(16)));
typedef unsigned u32x2 __attribute__((ext_vector_type(2)));
typedef unsigned u32x4 __attribute__((ext_vector_type(4)));
typedef GAS unsigned gu32;
typedef int v8i32_t __attribute__((ext_vector_type(8)));
typedef int v4i32_t __attribute__((ext_vector_type(4)));

constexpr int NB = 4, SEQ = 4096, T = NB * SEQ, D = 1024;
constexpr int NIN = 4096;
constexpr int QLORA = 256, KVLORA = 128, KVPAD = 256, ROPE = 32, NHEAD = 8, HD = 64, MQK = 96;
constexpr int NEXP = 64, TOPK = 6, DEXP = 256;
constexpr float EPS = 1e-6f;
constexpr float LOG2E = 1.4426950408889634f;
constexpr float C2F = 0.125f * LOG2E;
constexpr float C2M = 0.10206207261596577f * LOG2E;
constexpr int LISTCAP = T;
constexpr float HSCALE8 = 8.f;
constexpr float OSCALE8 = 8.f;
constexpr float WSCALE8 = 64.f;

constexpr size_t MiB = 1u << 20;
constexpr size_t WS_CTL = 0, CTL_ZERO_BYTES = 1 * MiB;
constexpr size_t WS_EIDX = 262144, WS_GATEW = 393216;
constexpr size_t WS_WIN = 1 * MiB, WS_WQ = 9 * MiB, WS_WKV = 9 * MiB + 512 * 1024, WS_WOM = 10 * MiB, WS_WOF = 11 * MiB, WS_WOUT = 12 * MiB;
constexpr size_t WS_WSGU = 14 * MiB, WS_WSD = 15 * MiB, WS_WR = 15 * MiB + 512 * 1024, WS_MOD = 15 * MiB + 640 * 1024;
constexpr size_t WS_WD = 16 * MiB;
constexpr size_t WS_HB = 48 * MiB;
constexpr size_t WS_FQ = 48 * MiB, WS_FK = 64 * MiB, WS_FV = 80 * MiB, WS_QLAT = 96 * MiB, WS_KVLAT = 104 * MiB;
constexpr size_t WS_OFOX = WS_FQ, WS_OMLA = WS_QLAT;
static_assert(WS_FK - WS_FQ == (size_t)T * 512 * 2 && WS_FV - WS_FK == (size_t)T * 512 * 2, "fq|fk|fv contiguous");
constexpr size_t WS_Y = 112 * MiB;
constexpr size_t WS_WGU = 112 * MiB;
constexpr size_t WS_H = 176 * MiB;
constexpr size_t WS_QMLA = WS_H;
constexpr size_t WS_GATES = 208 * MiB;
constexpr size_t WS_KN = 272 * MiB, WS_VM = 288 * MiB, WS_KPE = 304 * MiB;
constexpr size_t WS_MERGED = WS_KN;
constexpr size_t WS_LIST = 304 * MiB;
constexpr size_t WS_END = 306 * MiB;
constexpr size_t DO_MODP = 4 * MiB;
constexpr size_t DO_ROPE = 0, DO_LOGF = 2 * MiB, DO_CUMF = 2 * MiB + 512 * 1024, DO_SSQQ = 3 * MiB, DO_SSQKV = 3 * MiB + 256 * 1024;

constexpr int CW_TMO = 0;
constexpr int CW_BAR = 4096;
constexpr int CW_CNT = 8192;
constexpr int CW_KM = 12288;
constexpr int CW_Q = 12544;

constexpr int RING_BYTES = 131072;
constexpr int LDSCTL_OFF = RING_BYTES;
constexpr int MISC_OFF = LDSCTL_OFF + 320;
constexpr int MOETAB_OFF = LDSCTL_OFF + 1024;
constexpr int LDS_BYTES = 147456;

constexpr int NWAVES = 8;

#define LDS_WAIT() asm volatile("s_waitcnt lgkmcnt(0)" ::: "memory")
#define VM_WAIT() asm volatile("s_waitcnt vmcnt(0)" ::: "memory")
#define RLX_AGENT __ATOMIC_RELAXED, __HIP_MEMORY_SCOPE_AGENT
__device__ __forceinline__ unsigned f2bf(float f) { unsigned u = __builtin_bit_cast(unsigned, f); return (u + 0x7fffu + ((u >> 16) & 1u)) >> 16; }
__device__ __forceinline__ float bf2f(unsigned h) { return __builtin_bit_cast(float, h << 16); }
__device__ __forceinline__ unsigned pk2(float lo, float hi) { return f2bf(lo) | (f2bf(hi) << 16); }
__device__ __forceinline__ unsigned cvt_pk_bf16(float lo, float hi) { unsigned r; asm volatile("v_cvt_pk_bf16_f32 %0, %1, %2" : "=v"(r) : "v"(lo), "v"(hi)); return r; }
__device__ __forceinline__ u32x4 pack8(f32x4 a, f32x4 b) { u32x4 w; w.x = cvt_pk_bf16(a[0], a[1]); w.y = cvt_pk_bf16(a[2], a[3]); w.z = cvt_pk_bf16(b[0], b[1]); w.w = cvt_pk_bf16(b[2], b[3]); return w; }
__device__ __forceinline__ void unpack8(u32x4 w, f32x4& a, f32x4& b) {
    a = (f32x4){bf2f(w.x & 0xffffu), bf2f(w.x >> 16), bf2f(w.y & 0xffffu), bf2f(w.y >> 16)};
    b = (f32x4){bf2f(w.z & 0xffffu), bf2f(w.z >> 16), bf2f(w.w & 0xffffu), bf2f(w.w >> 16)};
}
__device__ __forceinline__ float wave_sum(float v) {
#pragma unroll
    for (int o = 1; o < 64; o <<= 1) v += __shfl_xor(v, o);
    return v;
}
__device__ __forceinline__ float wave_max(float v) {
#pragma unroll
    for (int o = 1; o < 64; o <<= 1) v = fmaxf(v, __shfl_xor(v, o));
    return v;
}
template <int CTRL> __device__ __forceinline__ float dppf(float v) { return __builtin_bit_cast(float, __builtin_amdgcn_update_dpp(0, __builtin_bit_cast(int, v), CTRL, 0xf, 0xf, true)); }
__device__ __forceinline__ float max8(float v) { v = fmaxf(v, dppf<0xB1>(v)); v = fmaxf(v, dppf<0x4E>(v)); v = fmaxf(v, dppf<0x141>(v)); return v; }
__device__ __forceinline__ float wave_max_f(float v) { v = max8(v); v = fmaxf(v, dppf<0x140>(v)); v = fmaxf(v, __shfl_xor(v, 16)); v = fmaxf(v, __shfl_xor(v, 32)); return v; }
__device__ __forceinline__ float wave_sum_f(float v) { v += dppf<0xB1>(v); v += dppf<0x4E>(v); v += dppf<0x141>(v); v += dppf<0x140>(v); v += __shfl_xor(v, 16); v += __shfl_xor(v, 32); return v; }
__device__ __forceinline__ float sigmoidf_(float x) { return __builtin_amdgcn_rcpf(1.f + __builtin_amdgcn_exp2f(-LOG2E * x)); }
__device__ __forceinline__ float siluf_(float x) { return x * __builtin_amdgcn_rcpf(1.f + __builtin_amdgcn_exp2f(-LOG2E * x)); }

namespace pg8 {
constexpr int BM = 256, BK = 64, HALF = 128, HTB = HALF * BK * 2, NXCD = 8, WGM = 8;
__host__ __device__ __forceinline__ int lds_byte(int r, int c) { const int st = (r >> 4) * 2 + (c >> 5), rr = r & 15, cc = c & 31, ob = rr * 64 + cc * 2; return st * 1024 + (ob ^ (((ob >> 9) & 1) << 5)); }
__host__ __device__ __forceinline__ void stage_rc(int b, int& R, int& C) { const int st = b / 1024, sb = b % 1024, swz = sb ^ (((sb >> 9) & 1) << 5); R = (st >> 1) * 16 + swz / 64; C = (st & 1) * 32 + (swz % 64) / 2; }
__host__ __device__ __forceinline__ int perm32(int rho) { const int n = rho >> 4, i = rho & 15; return 8 * (i >> 2) + 4 * n + (i & 3); }

struct Unit { int pm, pn, e, aux, n; };

struct StaticOrder {
    static constexpr bool GATHER = false;
    const char* A; const char* Bt; int K;
    int nM, nN, nwg, G, c;
    __device__ void init(const void* A_, const void* Bt_, int M, int N, int K_, int G_, int c_) { A = (const char*)A_; Bt = (const char*)Bt_; K = K_; nM = M / BM; nN = N / BM; nwg = nM * nN; G = G_; c = c_; }
    __device__ bool next(int i, Unit& u) const {
        const long L = (long)i * G + c; if (L >= nwg) return false;
        int wgid = (int)L; { const int q = nwg / NXCD, r = nwg % NXCD, xcd = wgid % NXCD, off = wgid / NXCD; wgid = (xcd < r ? xcd * (q + 1) : r * (q + 1) + (xcd - r) * q) + off; }
        const int nig = WGM * nN, gid = wgid / nig, fm = gid * WGM, gsz = (nM - fm) < WGM ? (nM - fm) : WGM;
        u.pm = fm + ((wgid % nig) % gsz); u.pn = (wgid % nig) / gsz; u.e = 0; u.aux = 0; u.n = BM; return true;
    }
    __device__ __forceinline__ const char* a_ptr(const Unit& u) const { return A + (size_t)u.pm * BM * K * 2; }
    __device__ __forceinline__ const char* b_ptr(const Unit& u) const { return Bt + (size_t)u.pn * BM * K * 2; }
    __device__ __forceinline__ unsigned a_row(const Unit&, int r) const { return (unsigned)r; }
};

template <class Epi, class Sched, bool ALIGN_EPI, bool FP8 = false>
__device__ __forceinline__ void gemm_phase(LAS unsigned char* lds, const Sched& S, const Epi& E) {
    int tid = threadIdx.x; asm volatile("" : "+v"(tid));
    const int wid = __builtin_amdgcn_readfirstlane(tid >> 6), lane = tid & 63, wr = wid >> 2, wc = wid & 3, fr = lane & 15, fq = lane >> 4;
    const int K = S.K, nt = K / BK;
    unsigned voffB[2], voffA[2];
#pragma unroll
    for (int i = 0; i < 2; ++i) { int R, C; stage_rc(tid * 16 + i * 8192, R, C); const int Rb = (R & ~31) + perm32(R & 31);
        voffA[i] = (unsigned)(R * K + C) * 2u; voffB[i] = (unsigned)(Rb * K + C) * 2u; }
    unsigned vA[2][2], vN[2][2];
    const size_t kstep = (size_t)(BK * 2);
    const size_t hstep = (size_t)HALF * K * 2;
    const unsigned ldsw = (unsigned)wid * 1024u;
    const int aoff = lds_byte(wr * 64 + fr, fq * 8), boff = lds_byte(wc * 32 + fr, fq * 8);
#define PG8_SA(b, h) (((b) * 2 + (h)) * HTB)
#define PG8_SB(b, h) ((4 + (b) * 2 + (h)) * HTB)
#define PG8_STAGE(bufoff, gbase, voff) do { _Pragma("unroll") for (int _i = 0; _i < 2; ++_i) \
        __builtin_amdgcn_global_load_lds((const unsigned*)((const char*)(gbase) + (voff)[_i]), (LAS unsigned*)(lds + (bufoff) + ldsw + _i * 8192), 16, 0, 0); } while (0)
#define PG8_STAGE_A(bufoff, gbase, h, nx) do { if constexpr (Sched::GATHER) { const unsigned vs_[2] = {(nx) ? vN[h][0] : vA[h][0], (nx) ? vN[h][1] : vA[h][1]}; PG8_STAGE(bufoff, gbase, vs_); }     \
        else PG8_STAGE(bufoff, (const char*)(gbase) + (h) * hstep, voffA); } while (0)
#define PG8_LDA(dst, b, h) do { _Pragma("unroll") for (int m = 0; m < 4; ++m) { if constexpr (FP8) { dst##8[m].lo = *(const LAS v4i32_t*)(lds + PG8_SA(b, h) + aoff + m * 2048); dst##8[m].hi = *(const LAS v4i32_t*)(lds + PG8_SA(b, h) + aoff + m * 2048 + 1024); } \
        else { _Pragma("unroll") for (int k = 0; k < 2; ++k) dst[m][k] = *(const LAS bf16x8*)(lds + PG8_SA(b, h) + aoff + m * 2048 + k * 1024); } } } while (0)
#define PG8_LDB(dst, b, h) do { _Pragma("unroll") for (int n = 0; n < 2; ++n) { if constexpr (FP8) { dst##8[n].lo = *(const LAS v4i32_t*)(lds + PG8_SB(b, h) + boff + n * 2048); dst##8[n].hi = *(const LAS v4i32_t*)(lds + PG8_SB(b, h) + boff + n * 2048 + 1024); } \
        else { _Pragma("unroll") for (int k = 0; k < 2; ++k) dst[n][k] = *(const LAS bf16x8*)(lds + PG8_SB(b, h) + boff + n * 2048 + k * 1024); } } } while (0)
#define PG8_MMA(ai, bj, At, Bt) do { __builtin_amdgcn_s_setprio(1); _Pragma("unroll") for (int m = 0; m < 4; ++m) _Pragma("unroll") for (int n = 0; n < 2; ++n) { \
        if constexpr (FP8) asm volatile("v_mfma_scale_f32_16x16x128_f8f6f4 %0, %1, %2, %0, %3, %3 op_sel_hi:[0,0,0]" : "+v"(acc[ai][bj][m][n]) : "v"(Bt##8[n]), "v"(At##8[m]), "v"(sc1_));     \
        else { _Pragma("unroll") for (int k = 0; k < 2; ++k) acc[ai][bj][m][n] = __builtin_amdgcn_mfma_f32_16x16x32_bf16(Bt[n][k], At[m][k], acc[ai][bj][m][n], 0, 0, 0); } } \
        __builtin_amdgcn_s_setprio(0); } while (0)
#define PG8_WAIT_V(n) asm volatile("s_waitcnt vmcnt(" #n ")" ::: "memory")
#define PG8_WAIT_L(n) asm volatile("s_waitcnt lgkmcnt(" #n ")" ::: "memory")
#define PG8_BAR __builtin_amdgcn_s_barrier()
#define PG8_SCHED __builtin_amdgcn_sched_barrier(0)
#define PG8_SETV(dst, u) do { _Pragma("unroll") for (int _h = 0; _h < 2; ++_h) _Pragma("unroll") for (int _i = 0; _i < 2; ++_i) { int R_, C_; stage_rc(tid * 16 + _i * 8192, R_, C_); \
        dst[_h][_i] = (S.a_row(u, _h * HALF + R_) * (unsigned)K + (unsigned)C_) * 2u; } } while (0)
    Unit cur, nxt; int ui = 0;
    if (!S.next(0, cur)) return;
    f32x4 acc[2][2][4][2];
#define PG8_ZERO() do { _Pragma("unroll") for (int a = 0; a < 2; ++a) _Pragma("unroll") for (int b = 0; b < 2; ++b) _Pragma("unroll") for (int m = 0; m < 4; ++m) _Pragma("unroll") for (int n = 0; n < 2; ++n) { \
        if constexpr (FP8) asm volatile("v_mov_b32 %0, 0\n\tv_mov_b32 %1, 0\n\tv_mov_b32 %2, 0\n\tv_mov_b32 %3, 0" : "=v"(acc[a][b][m][n][0]), "=v"(acc[a][b][m][n][1]), "=v"(acc[a][b][m][n][2]), "=v"(acc[a][b][m][n][3])); \
        else acc[a][b][m][n] = (f32x4){0.f, 0.f, 0.f, 0.f}; } } while (0)
    PG8_ZERO();
    unsigned sc1_ = 0x7f7f7f7fu; asm volatile("" : "+v"(sc1_));
    (void)sc1_;
    bf16x8 At[4][2], B0[2][2], B1[2][2];
    v8i32_t At8[4], B08[2], B18[2];
    (void)At; (void)B0; (void)B1; (void)At8; (void)B08; (void)B18;
    const char* cA = S.a_ptr(cur); const char* cB = S.b_ptr(cur);
    if constexpr (Sched::GATHER) { PG8_SETV(vA, cur); }
    PG8_STAGE(PG8_SB(0, 0), cB, voffB); PG8_STAGE(PG8_SB(0, 1), cB + hstep, voffB); PG8_STAGE_A(PG8_SA(0, 0), cA, 0, false); PG8_STAGE_A(PG8_SA(0, 1), cA, 1, false);
    if (wr == 1) PG8_BAR;
    PG8_WAIT_V(2); PG8_BAR;
    PG8_STAGE(PG8_SB(1, 0), cB + kstep, voffB); PG8_STAGE_A(PG8_SA(1, 0), cA + kstep, 0, false); PG8_STAGE(PG8_SB(1, 1), cB + hstep + kstep, voffB);
    PG8_WAIT_V(6); PG8_BAR;
    for (;;) {
        const bool has_next = S.next(ui + 1, nxt);
        const char* nA = has_next ? S.a_ptr(nxt) : cA; const char* nB = has_next ? S.b_ptr(nxt) : cB;
        if constexpr (Sched::GATHER) { if (has_next) { PG8_SETV(vN, nxt); } else {
#pragma unroll
            for (int h = 0; h < 2; ++h)
#pragma unroll
                for (int i = 0; i < 2; ++i) vN[h][i] = vA[h][i]; } }
        for (int t = 0; t < nt; t += 2) {
            const bool last = (t == nt - 2);
            if constexpr (Epi::MIDK) { if (t == nt / 2) E.mid(acc, cur, wr, wc, fr, fq); }
            const char* a1 = cA + (size_t)(t + 1) * kstep;
            const char* a2 = last ? nA : cA + (size_t)(t + 2) * kstep; const char* b2 = last ? nB : cB + (size_t)(t + 2) * kstep;
            const char* a3 = a2 + kstep; const char* b3 = b2 + kstep;
            PG8_LDB(B0, 0, 0); PG8_LDB(B1, 0, 1); PG8_SCHED; PG8_LDA(At, 0, 0); PG8_STAGE_A(PG8_SA(1, 1), a1, 1, false);
            PG8_WAIT_V(8); PG8_WAIT_L(0); PG8_BAR; PG8_MMA(0, 0, At, B0); PG8_MMA(0, 1, At, B1); PG8_BAR; PG8_SCHED;
            PG8_LDA(At, 0, 1); PG8_STAGE(PG8_SB(0, 0), b2, voffB); PG8_STAGE(PG8_SB(0, 1), b2 + hstep, voffB); PG8_STAGE_A(PG8_SA(0, 0), a2, 0, last);
            PG8_WAIT_V(8); PG8_WAIT_L(0); PG8_BAR; PG8_MMA(1, 0, At, B0); PG8_MMA(1, 1, At, B1); PG8_BAR; PG8_SCHED;
            PG8_LDB(B0, 1, 0); PG8_LDB(B1, 1, 1); PG8_SCHED; PG8_LDA(At, 1, 0); PG8_STAGE_A(PG8_SA(0, 1), a2, 1, last);
            PG8_WAIT_V(8); PG8_WAIT_L(0); PG8_BAR; PG8_MMA(0, 0, At, B0); PG8_MMA(0, 1, At, B1); PG8_BAR; PG8_SCHED;
            PG8_LDA(At, 1, 1); PG8_STAGE(PG8_SB(1, 0), b3, voffB); PG8_STAGE(PG8_SB(1, 1), b3 + hstep, voffB); PG8_STAGE_A(PG8_SA(1, 0), a3, 0, last);
            PG8_WAIT_V(8); PG8_WAIT_L(0); PG8_BAR; PG8_MMA(1, 0, At, B0); PG8_MMA(1, 1, At, B1); PG8_BAR; PG8_SCHED;
        }
        if constexpr (ALIGN_EPI) { if (wr == 0) PG8_BAR; }
        if constexpr (FP8) { asm volatile("s_nop 15\n\ts_nop 7" ::: "memory"); __builtin_amdgcn_sched_barrier(0); }
        E(acc, cur, wr, wc, fr, fq);
        if (!has_next) break;
        PG8_ZERO();
        cur = nxt; cA = nA; cB = nB; ++ui;
        if constexpr (Sched::GATHER) {
#pragma unroll
            for (int h = 0; h < 2; ++h)
#pragma unroll
                for (int i = 0; i < 2; ++i) vA[h][i] = vN[h][i]; }
        if constexpr (ALIGN_EPI) { if (wr == 1) PG8_BAR; }
    }
    PG8_WAIT_V(0);
    if constexpr (!ALIGN_EPI) { if (wr == 0) PG8_BAR; }
    PG8_BAR;
#undef PG8_SA
#undef PG8_SB
#undef PG8_STAGE
#undef PG8_STAGE_A
#undef PG8_LDA
#undef PG8_LDB
#undef PG8_MMA
#undef PG8_ZERO
#undef PG8_WAIT_V
#undef PG8_WAIT_L
#undef PG8_BAR
#undef PG8_SCHED
#undef PG8_SETV
}
}
using pg8::Unit;

#define EPI_ROWS(ai, m) for (int ai = 0; ai < 2; ++ai) for (int m = 0; m < 4; ++m)

struct EpiInProj {
    static constexpr bool MIDK = false;
    bf16 *qlat, *kvlat, *kpe, *fq, *gates; float *logf, *ssqq, *ssqkv; const float* ropetab; const float* bforget; bool skip; int rowmul;
    __device__ __forceinline__ void operator()(const f32x4 (&acc)[2][2][4][2], const Unit& u, int wr, int wc, int fr, int fq_) const {
        if (skip) return;
        const int pn = u.pn, row0 = u.pm * 256 + wr * 64 + fr, c0 = wc * 32 + 8 * fq_;
        if (pn >= 8) {
            bf16* gp = gates + (size_t)(pn - 8) * 256 + c0;
#pragma unroll
            for (int ai = 0; ai < 2; ++ai)
#pragma unroll
                for (int m = 0; m < 4; ++m) { const int row = row0 + ai * 128 + m * 16;
#pragma unroll
                    for (int bj = 0; bj < 2; ++bj) { f32x4 v0 = acc[ai][bj][m][0], v1 = acc[ai][bj][m][1];
#pragma unroll
                        for (int q = 0; q < 4; ++q) { v0[q] = fmaxf(sigmoidf_(v0[q]), 1e-30f); v1[q] = fmaxf(sigmoidf_(v1[q]), 1e-30f); }
                        *(u32x4*)(gp + (size_t)row * 2048 + 128 * bj) = pack8(v0, v1); } }
        } else if (pn >= 2) {
            bf16* dst = fq + (size_t)((pn - 2) >> 1) * ((size_t)T * 512) + (pn & 1) * 256 + c0; const float sc = (pn < 4) ? C2F : 1.f;
#pragma unroll
            for (int ai = 0; ai < 2; ++ai)
#pragma unroll
                for (int m = 0; m < 4; ++m) { const int row = row0 + ai * 128 + m * 16;
#pragma unroll
                    for (int bj = 0; bj < 2; ++bj) *(u32x4*)(dst + (size_t)row * 512 + 128 * bj) = pack8(acc[ai][bj][m][0] * sc, acc[ai][bj][m][1] * sc); }
        } else if (pn == 0) {
#pragma unroll
            for (int ai = 0; ai < 2; ++ai)
#pragma unroll
                for (int m = 0; m < 4; ++m) { const int row = row0 + ai * 128 + m * 16; float s = 0.f;
#pragma unroll
                    for (int bj = 0; bj < 2; ++bj) { const f32x4 v0 = acc[ai][bj][m][0], v1 = acc[ai][bj][m][1];
                        s += (v0[0] * v0[0] + v0[1] * v0[1]) + (v0[2] * v0[2] + v0[3] * v0[3]) + (v1[0] * v1[0] + v1[1] * v1[1]) + (v1[2] * v1[2] + v1[3] * v1[3]);
                        *(u32x4*)(qlat + (size_t)row * QLORA + c0 + 128 * bj) = pack8(v0, v1); }
                    s += __shfl_xor(s, 16); s += __shfl_xor(s, 32);
                    if (fq_ == 0) ssqq[row * 4 + wc] = s; }
        } else {
#pragma unroll
            for (int ai = 0; ai < 2; ++ai)
#pragma unroll
                for (int m = 0; m < 4; ++m) { const int row = row0 + ai * 128 + m * 16;
                    { const f32x4 v0 = acc[ai][0][m][0], v1 = acc[ai][0][m][1];
                      float s = (v0[0] * v0[0] + v0[1] * v0[1]) + (v0[2] * v0[2] + v0[3] * v0[3]) + (v1[0] * v1[0] + v1[1] * v1[1]) + (v1[2] * v1[2] + v1[3] * v1[3]);
                      *(u32x4*)(kvlat + (size_t)row * KVPAD + c0) = pack8(v0, v1);
                      s += __shfl_xor(s, 16); s += __shfl_xor(s, 32);
                      if (fq_ == 0) ssqkv[row * 4 + wc] = s; }
                    { const f32x4 v0 = acc[ai][1][m][0], v1 = acc[ai][1][m][1];
                      *(u32x4*)(kvlat + (size_t)row * KVPAD + 128 + c0) = (u32x4){0u, 0u, 0u, 0u};
                      if (wc == 0) {
                          const f32x4* tb = (const f32x4*)(ropetab + ((size_t)row * 16 + 4 * fq_) * 2);
                          const f32x4 t0 = tb[0], t1 = tb[1];
                          f32x4 o1, o2;
                          o1[0] = v0[0] * t0[0] - v1[0] * t0[1]; o2[0] = v1[0] * t0[0] + v0[0] * t0[1];
                          o1[1] = v0[1] * t0[2] - v1[1] * t0[3]; o2[1] = v1[1] * t0[2] + v0[1] * t0[3];
                          o1[2] = v0[2] * t1[0] - v1[2] * t1[1]; o2[2] = v1[2] * t1[0] + v0[2] * t1[1];
                          o1[3] = v0[3] * t1[2] - v1[3] * t1[3]; o2[3] = v1[3] * t1[2] + v0[3] * t1[3];
                          *(u32x4*)(kpe + (size_t)row * ROPE + 8 * fq_) = pack8(o1, o2);
                      } else if (wc == 1 && fq_ == 0) {
                          f32x4 l0, l1;
#pragma unroll
                          for (int h = 0; h < 4; ++h) { const float z0 = v0[h] + bforget[h], z1 = v1[h] + bforget[4 + h];
                              l0[h] = -__builtin_amdgcn_logf(1.f + __builtin_amdgcn_exp2f(-LOG2E * z0)); l1[h] = -__builtin_amdgcn_logf(1.f + __builtin_amdgcn_exp2f(-LOG2E * z1)); }
                          *(f32x4*)(logf + (size_t)row * 8) = l0; *(f32x4*)(logf + (size_t)row * 8 + 4) = l1;
                      } } }
        }
        (void)rowmul;
    }
};

struct EpiQup {
    static constexpr bool MIDK = false;
    bf16* q; const float* ssqq; const float* ropetab;
    __device__ __forceinline__ void operator()(const f32x4 (&acc)[2][2][4][2], const Unit& u, int wr, int wc, int fr, int fq_) const {
        const int row0 = u.pm * 256 + wr * 64 + fr, c0 = u.pn * 256 + wc * 32 + 8 * fq_;
#pragma unroll
        for (int ai = 0; ai < 2; ++ai)
#pragma unroll
            for (int m = 0; m < 4; ++m) {
                const int row = row0 + ai * 128 + m * 16;
                const f32x4 sq = *(const f32x4*)(ssqq + row * 4);
                const float rs = rsqrtf(((sq[0] + sq[1]) + (sq[2] + sq[3])) * (1.f / QLORA) + EPS) * C2M;
#pragma unroll
                for (int bj = 0; bj < 2; ++bj) {
                    const int col = c0 + 128 * bj, j = col % MQK;
                    f32x4 v0 = acc[ai][bj][m][0] * rs, v1 = acc[ai][bj][m][1] * rs;
                    if (j >= 64) { const int g = (j - 64) >> 3;
                        const f32x4* tb = (const f32x4*)(ropetab + ((size_t)row * 16 + 4 * g) * 2);
                        const f32x4 t0 = tb[0], t1 = tb[1];
                        f32x4 o1, o2;
                        o1[0] = v0[0] * t0[0] - v1[0] * t0[1]; o2[0] = v1[0] * t0[0] + v0[0] * t0[1];
                        o1[1] = v0[1] * t0[2] - v1[1] * t0[3]; o2[1] = v1[1] * t0[2] + v0[1] * t0[3];
                        o1[2] = v0[2] * t1[0] - v1[2] * t1[1]; o2[2] = v1[2] * t1[0] + v0[2] * t1[1];
                        o1[3] = v0[3] * t1[2] - v1[3] * t1[3]; o2[3] = v1[3] * t1[2] + v0[3] * t1[3];
                        v0 = o1; v1 = o2; }
                    *(u32x4*)(q + (size_t)row * 768 + col) = pack8(v0, v1);
                }
            }
    }
};

struct EpiKVup {
    static constexpr bool MIDK = false;
    bf16 *kn, *vm; const float* ssqkv;
    __device__ __forceinline__ void operator()(const f32x4 (&acc)[2][2][4][2], const Unit& u, int wr, int wc, int fr, int fq_) const {
        const int row0 = u.pm * 256 + wr * 64 + fr, c0 = u.pn * 256 + wc * 32 + 8 * fq_;
        bf16* dst = (u.pn < 2) ? kn : vm; const int cb = (u.pn & 1) * 256 + wc * 32 + 8 * fq_;
        (void)c0;
#pragma unroll
        for (int ai = 0; ai < 2; ++ai)
#pragma unroll
            for (int m = 0; m < 4; ++m) {
                const int row = row0 + ai * 128 + m * 16;
                const f32x4 sq = *(const f32x4*)(ssqkv + row * 4);
                const float rs = rsqrtf(((sq[0] + sq[1]) + (sq[2] + sq[3])) * (1.f / KVLORA) + EPS);
#pragma unroll
                for (int bj = 0; bj < 2; ++bj) *(u32x4*)(dst + (size_t)row * 512 + cb + 128 * bj) = pack8(acc[ai][bj][m][0] * rs, acc[ai][bj][m][1] * rs);
            }
    }
};

struct EpiPartA {
    static constexpr bool MIDK = false;
    float* part; const bf16* gates;
    __device__ __forceinline__ void operator()(const f32x4 (&acc)[2][2][4][2], const Unit& u, int wr, int wc, int fr, int fq_) const {
        const int row0 = u.pm * 256 + wr * 64 + fr, c0 = u.pn * 256 + wc * 32 + 8 * fq_;
#pragma unroll
        for (int ai = 0; ai < 2; ++ai)
#pragma unroll
            for (int m = 0; m < 4; ++m) {
                const int row = row0 + ai * 128 + m * 16;
#pragma unroll
                for (int bj = 0; bj < 2; ++bj) { const int col = c0 + 128 * bj;
                    f32x4 g0, g1; unpack8(*(const u32x4*)(gates + (size_t)row * 2048 + col), g0, g1);
                    *(f32x4*)(part + (size_t)row * D + col) = g0 * acc[ai][bj][m][0]; *(f32x4*)(part + (size_t)row * D + col + 4) = g1 * acc[ai][bj][m][1]; }
            }
    }
};
struct EpiMerged {
    static constexpr bool MIDK = false;
    const float* part; const bf16* gates; bf16* merged;
    __device__ __forceinline__ void operator()(const f32x4 (&acc)[2][2][4][2], const Unit& u, int wr, int wc, int fr, int fq_) const {
        const int row0 = u.pm * 256 + wr * 64 + fr, c0 = u.pn * 256 + wc * 32 + 8 * fq_;
#pragma unroll
        for (int ai = 0; ai < 2; ++ai)
#pragma unroll
            for (int m = 0; m < 4; ++m) {
                const int row = row0 + ai * 128 + m * 16;
#pragma unroll
                for (int bj = 0; bj < 2; ++bj) { const int col = c0 + 128 * bj;
                    f32x4 g0, g1; unpack8(*(const u32x4*)(gates + (size_t)row * 2048 + 1024 + col), g0, g1);
                    const f32x4 p0 = *(const f32x4*)(part + (size_t)row * D + col), p1 = *(const f32x4*)(part + (size_t)row * D + col + 4);
                    *(u32x4*)(merged + (size_t)row * D + col) = pack8(p0 + g0 * acc[ai][bj][m][0], p1 + g1 * acc[ai][bj][m][1]); }
            }
    }
};
struct EpiMergedCat {
    static constexpr bool MIDK = true;
    const bf16* gates; unsigned char* merged; float sc;
    __device__ __forceinline__ void mid(f32x4 (&acc)[2][2][4][2], const Unit& u, int wr, int wc, int fr, int fq_) const {
        int row0 = u.pm * 256 + wr * 64 + fr, c0 = u.pn * 256 + wc * 32 + 8 * fq_;
        asm volatile("" : "+v"(row0), "+v"(c0));
#pragma unroll
        for (int ai = 0; ai < 2; ++ai)
#pragma unroll
            for (int m = 0; m < 4; ++m) { const int row = row0 + ai * 128 + m * 16;
#pragma unroll
                for (int bj = 0; bj < 2; ++bj) { const int col = c0 + 128 * bj;
                    f32x4 a0, a1, b0, b1; unpack8(*(const u32x4*)(gates + (size_t)row * 2048 + col), a0, a1); unpack8(*(const u32x4*)(gates + (size_t)row * 2048 + 1024 + col), b0, b1);
#pragma unroll
                    for (int q = 0; q < 4; ++q) { acc[ai][bj][m][0][q] *= a0[q] * __builtin_amdgcn_rcpf(b0[q]); acc[ai][bj][m][1][q] *= a1[q] * __builtin_amdgcn_rcpf(b1[q]); } }
                asm volatile("" ::: "memory"); }
    }
    __device__ __forceinline__ void operator()(const f32x4 (&acc)[2][2][4][2], const Unit& u, int wr, int wc, int fr, int fq_) const {
        const int row0 = u.pm * 256 + wr * 64 + fr, c0 = u.pn * 256 + wc * 32 + 8 * fq_;
#pragma unroll
        for (int ai = 0; ai < 2; ++ai)
#pragma unroll
            for (int m = 0; m < 4; ++m) { const int row = row0 + ai * 128 + m * 16;
#pragma unroll
                for (int bj = 0; bj < 2; ++bj) { const int col = c0 + 128 * bj;
                    f32x4 b0, b1; unpack8(*(const u32x4*)(gates + (size_t)row * 2048 + 1024 + col), b0, b1);
                    const f32x4 v0 = b0 * acc[ai][bj][m][0] * sc, v1 = b1 * acc[ai][bj][m][1] * sc;
                    u32x2 o; int p_ = __builtin_amdgcn_cvt_pk_fp8_f32(v0[0], v0[1], 0, false); p_ = __builtin_amdgcn_cvt_pk_fp8_f32(v0[2], v0[3], p_, true); o.x = (unsigned)p_;
                    p_ = __builtin_amdgcn_cvt_pk_fp8_f32(v1[0], v1[1], 0, false); p_ = __builtin_amdgcn_cvt_pk_fp8_f32(v1[2], v1[3], p_, true); o.y = (unsigned)p_;
                    *(u32x2*)(merged + (size_t)row * D + col) = o; } }
    }
};
struct EpiOut {
    static constexpr bool MIDK = false;
    const float* x; float* x1; const float* mod; float* ssq1; float sc;
    __device__ __forceinline__ void operator()(const f32x4 (&acc)[2][2][4][2], const Unit& u, int wr, int wc, int fr, int fq_) const {
        const int row0 = u.pm * 256 + wr * 64 + fr, c0 = u.pn * 256 + wc * 32 + 8 * fq_;
        const float* gm = mod + (size_t)((u.pm * 256) / SEQ) * 6 * D + 2 * D;
        f32x4 g[2][2];
#pragma unroll
        for (int bj = 0; bj < 2; ++bj) { g[bj][0] = *(const f32x4*)(gm + c0 + 128 * bj) * sc; g[bj][1] = *(const f32x4*)(gm + c0 + 128 * bj + 4) * sc; }
#pragma unroll
        for (int ai = 0; ai < 2; ++ai)
#pragma unroll
            for (int m = 0; m < 4; ++m) { const int row = row0 + ai * 128 + m * 16; float sq = 0.f;
#pragma unroll
                for (int bj = 0; bj < 2; ++bj) { const int col = c0 + 128 * bj;
                    const f32x4 x0 = __builtin_nontemporal_load((const f32x4*)(x + (size_t)row * D + col)), x1v = __builtin_nontemporal_load((const f32x4*)(x + (size_t)row * D + col + 4));
                    const f32x4 r0 = x0 + g[bj][0] * acc[ai][bj][m][0], r1 = x1v + g[bj][1] * acc[ai][bj][m][1];
                    *(f32x4*)(x1 + (size_t)row * D + col) = r0; *(f32x4*)(x1 + (size_t)row * D + col + 4) = r1;
                    sq += (r0[0] * r0[0] + r0[1] * r0[1]) + (r0[2] * r0[2] + r0[3] * r0[3]) + (r1[0] * r1[0] + r1[1] * r1[1]) + (r1[2] * r1[2] + r1[3] * r1[3]); }
                sq += __shfl_xor(sq, 16); sq += __shfl_xor(sq, 32);
                if (fq_ == 0) ssq1[(size_t)row * 16 + 4 * u.pn + wc] = sq; }
    }
};
struct EpiHb {
    static constexpr bool MIDK = false;
    unsigned char* hb; float sc;
    __device__ __forceinline__ void operator()(const f32x4 (&acc)[2][2][4][2], const Unit& u, int wr, int wc, int fr, int fq_) const {
        const int row0 = u.pm * 256 + wr * 64 + fr, c0 = u.pn * 128 + wc * 32 + 8 * fq_;
#pragma unroll
        for (int ai = 0; ai < 2; ++ai)
#pragma unroll
            for (int m = 0; m < 4; ++m) { const int row = row0 + ai * 128 + m * 16;
                f32x4 h0, h1;
#pragma unroll
                for (int q = 0; q < 4; ++q) { h0[q] = siluf_(acc[ai][0][m][0][q] * sc) * (acc[ai][1][m][0][q] * (sc * HSCALE8)); h1[q] = siluf_(acc[ai][0][m][1][q] * sc) * (acc[ai][1][m][1][q] * (sc * HSCALE8)); }
                u32x2 o; int p_ = __builtin_amdgcn_cvt_pk_fp8_f32(h0[0], h0[1], 0, false); p_ = __builtin_amdgcn_cvt_pk_fp8_f32(h0[2], h0[3], p_, true); o.x = (unsigned)p_;
                p_ = __builtin_amdgcn_cvt_pk_fp8_f32(h1[0], h1[1], 0, false); p_ = __builtin_amdgcn_cvt_pk_fp8_f32(h1[2], h1[3], p_, true); o.y = (unsigned)p_;
                *(u32x2*)(hb + (size_t)row * DEXP + c0) = o; }
    }
};
struct EpiDown {
    static constexpr bool MIDK = false;
    bf16* Y; float* out; float* outw; const float* mod; const unsigned short* list; const unsigned char* eidx; const float* gatew;
    __device__ __forceinline__ void operator()(const f32x4 (&acc)[2][2][4][2], const Unit& u, int wr, int wc, int fr, int fq_) const {
        const int c0 = u.pn * 256 + wc * 32 + 8 * fq_;
#pragma unroll
        for (int ai = 0; ai < 2; ++ai)
#pragma unroll
            for (int m = 0; m < 4; ++m) {
                const int rl = wr * 64 + fr + ai * 128 + m * 16, idx = u.aux * 256 + rl;
                if (u.e == NEXP) {
                    const int t = idx; const float* gf = mod + (size_t)(t / SEQ) * 6 * D + 5 * D;
#pragma unroll
                    for (int bj = 0; bj < 2; ++bj) { const int col = c0 + 128 * bj; const float* o = out + (size_t)t * D + col; float* ow = outw + (size_t)t * D + col;
                        const f32x4 g0 = *(const f32x4*)(gf + col), g1 = *(const f32x4*)(gf + col + 4);
                        const f32x4 x0 = *(const f32x4*)o, x1v = *(const f32x4*)(o + 4);
                        *(f32x4*)ow = x0 + g0 * acc[ai][bj][m][0]; *(f32x4*)(ow + 4) = x1v + g1 * acc[ai][bj][m][1]; }
                } else if (idx < u.n) {
                    const int t = list[(size_t)u.e * LISTCAP + idx];
                    const u32x2 ev = *(const u32x2*)(eidx + (size_t)t * 8);
                    int k = 0;
#pragma unroll
                    for (int q = 1; q < TOPK; ++q) { const unsigned b = (q < 4) ? ((ev.x >> (8 * q)) & 0xffu) : ((ev.y >> (8 * (q - 4))) & 0xffu); if ((int)b == u.e) k = q; }
                    const float w = gatew[(size_t)t * 8 + k];
#pragma unroll
                    for (int bj = 0; bj < 2; ++bj) *(u32x4*)(Y + ((size_t)t * TOPK + k) * D + c0 + 128 * bj) = pack8(acc[ai][bj][m][0] * w, acc[ai][bj][m][1] * w);
                }
            }
    }
};

template <int NT, bool GATHER_>
struct MoeOrder {
    static constexpr bool GATHER = GATHER_;
    const char* A; const char* Bt; const char* Bsh; int K; size_t bstride;
    const unsigned short* list; volatile LAS int* tab;
    int G, c;
    __device__ bool next(int i, Unit& u) const {
        int ti, pn_;
        if ((G & 7) == 0) { const int x = c & 7, j = i * (G >> 3) + (c >> 3); ti = (j / NT) * 8 + x; pn_ = j % NT; if (ti >= tab[65]) return false; }
        else { const int total = tab[65] * NT; const long L = (long)i * G + c; if (L >= total) return false; ti = (int)L / NT; pn_ = (int)L % NT; }
        u.pn = pn_; u.pm = ti;
        const int e = __builtin_amdgcn_readfirstlane(tab[132 + ti]);
        u.e = e; u.aux = __builtin_amdgcn_readfirstlane(ti - tab[e]); u.n = __builtin_amdgcn_readfirstlane(tab[66 + e]); return true;
    }
    __device__ __forceinline__ const char* a_ptr(const Unit& u) const { return GATHER ? A : A + (size_t)u.pm * 256 * K * 2; }
    __device__ __forceinline__ const char* b_ptr(const Unit& u) const { return (u.e == NEXP ? Bsh : Bt + (size_t)u.e * bstride) + (size_t)u.pn * 256 * K * 2; }
    __device__ __forceinline__ unsigned a_row(const Unit& u, int r) const {
        if (!GATHER) return (unsigned)r;
        const int idx = u.aux * 256 + r;
        if (u.e == NEXP) return (unsigned)idx;
        return (idx < u.n) ? (unsigned)list[(size_t)u.e * LISTCAP + idx] : 0u;
    }
};

struct UpOrder {
    static constexpr bool GATHER = false;
    const char* Aq; const char* Bq; const char* Akv; const char* Bkv; int K; int G, c;
    __device__ bool next(int i, Unit& u) const {
        int L = i * G + c; if (L >= 448) return false;
        if (L < 256) { u.e = 1; u.pm = L >> 2; u.pn = L & 3; } else { L -= 256; u.e = 0; u.pm = L / 3; u.pn = L % 3; }
        u.aux = 0; u.n = 256; return true; }
    __device__ __forceinline__ const char* a_ptr(const Unit& u) const { return (u.e ? Akv : Aq) + (size_t)u.pm * 256 * K * 2; }
    __device__ __forceinline__ const char* b_ptr(const Unit& u) const { return (u.e ? Bkv : Bq) + (size_t)u.pn * 256 * K * 2; }
    __device__ __forceinline__ unsigned a_row(const Unit&, int r) const { return (unsigned)r; }
};
struct EpiUp {
    static constexpr bool MIDK = false;
    EpiQup q; EpiKVup kv;
    __device__ __forceinline__ void operator()(const f32x4 (&acc)[2][2][4][2], const Unit& u, int wr, int wc, int fr, int fq_) const { if (u.e) kv(acc, u, wr, wc, fr, fq_); else q(acc, u, wr, wc, fr, fq_); }
};

struct SharedDownOrder {
    static constexpr bool GATHER = false;
    const char* A; const char* Bt; int K; int G, c;
    __device__ bool next(int i, Unit& u) const { const int L = i * G + c; if (L >= (T / 256) * 4) return false; u.pm = L >> 2; u.pn = L & 3; u.e = NEXP; u.aux = L >> 2; u.n = 256; return true; }
    __device__ __forceinline__ const char* a_ptr(const Unit& u) const { return A + (size_t)u.pm * 256 * K * 2; }
    __device__ __forceinline__ const char* b_ptr(const Unit& u) const { return Bt + (size_t)u.pn * 256 * K * 2; }
    __device__ __forceinline__ unsigned a_row(const Unit&, int r) const { return (unsigned)r; }
};

namespace att {
constexpr int KSLOT = 12288, VSLOT = 8192;
constexpr int L_K = 0, L_V = 3 * KSLOT, L_F = L_V + 2 * VSLOT, L_WS = L_F + 3 * 256, L_OST = L_WS + 2048, L_END = L_OST + 8 * 4096;
static_assert(L_END <= RING_BYTES, "attention LDS");
__device__ __forceinline__ int crow(int r, int hi) { return (r & 3) + 8 * (r >> 2) + 4 * hi; }
__device__ __forceinline__ float max3f(float a, float b, float c) { return fmaxf(fmaxf(a, b), c); }
__device__ __forceinline__ float rowmax(const f32x16& p0, const f32x16& p1) {
    float a = max3f(p0[0], p0[1], p1[0]), b = max3f(p0[2], p0[3], p1[1]); a = max3f(a, p1[2], p1[3]);
#pragma unroll
    for (int r = 4; r < 16; r += 4) { a = max3f(a, p0[r], p0[r + 1]); b = max3f(b, p0[r + 2], p0[r + 3]); a = max3f(a, p1[r], p1[r + 1]); b = max3f(b, p1[r + 2], p1[r + 3]); }
    const float m = fmaxf(a, b);
    auto rr = __builtin_amdgcn_permlane32_swap(__float_as_uint(m), __float_as_uint(m), false, false);
    return fmaxf(__uint_as_float(rr[0]), __uint_as_float(rr[1]));
}
__device__ __forceinline__ void cmask(f32x16& p0, f32x16& p1, int jb, int qrel, int hi) {
    const float NEG = -INFINITY; const int kb = 64 * jb + 4 * hi;
#pragma unroll
    for (int r = 0; r < 16; ++r) { const int kv = kb + (r & 3) + 8 * (r >> 2); if (kv > qrel) p0[r] = NEG; if (kv + 32 > qrel) p1[r] = NEG; }
}
__device__ __forceinline__ void pv(f32x16* o, int vb, bf16x8 pa0, bf16x8 pa1, bf16x8 pa2, bf16x8 pa3) {
#pragma unroll
    for (int d0 = 0; d0 < 2; ++d0) { s16x4 lo[4], hi[4];
#pragma unroll
        for (int ks = 0; ks < 4; ++ks) {
            asm volatile("ds_read_b64_tr_b16 %0,%1 offset:%c2" : "=&v"(lo[ks]) : "v"(vb), "i"(d0 * 4096 + ks * 1024) : "memory");
            asm volatile("ds_read_b64_tr_b16 %0,%1 offset:%c2" : "=&v"(hi[ks]) : "v"(vb), "i"(d0 * 4096 + ks * 1024 + 512) : "memory"); }
        asm volatile("s_waitcnt lgkmcnt(0)" ::: "memory"); __builtin_amdgcn_sched_barrier(0);
#define PK(k) (bf16x8){lo[k][0], lo[k][1], lo[k][2], lo[k][3], hi[k][0], hi[k][1], hi[k][2], hi[k][3]}
        o[d0] = __builtin_amdgcn_mfma_f32_32x32x16_bf16(pa0, PK(0), o[d0], 0, 0, 0);
        o[d0] = __builtin_amdgcn_mfma_f32_32x32x16_bf16(pa1, PK(1), o[d0], 0, 0, 0);
        o[d0] = __builtin_amdgcn_mfma_f32_32x32x16_bf16(pa2, PK(2), o[d0], 0, 0, 0);
        o[d0] = __builtin_amdgcn_mfma_f32_32x32x16_bf16(pa3, PK(3), o[d0], 0, 0, 0);
#undef PK
    }
}
__device__ __forceinline__ unsigned cvtpk_s(float lo, float hi) { return cvt_pk_bf16(lo, hi); }

template <int DQK, bool DECAY, int THRL>
__device__ __forceinline__ void attn_unit(int b, int h, int qb, const bf16* Q, int QP, const bf16* Kn, const bf16* Kpe, const bf16* V, const float* cumF, bf16* O, int OP, LAS unsigned char* lds) {
    constexpr int ND0 = DQK / 16;
    int tid = threadIdx.x; asm volatile("" : "+v"(tid));
    const int lane = tid & 63, r32 = lane & 31, hi = lane >> 5; const int wid = __builtin_amdgcn_readfirstlane(tid >> 6);
    const long rowbase = (long)b * SEQ; const int q0 = qb * 256;
    const bf16* Qw = Q + (rowbase + q0 + wid * 32) * QP + h * DQK;
    const bf16* Kh = Kn + rowbase * 512 + h * 64; const bf16* Vh = V + rowbase * 512 + h * 64;
    const bf16* Kp = Kpe + rowbase * ROPE;
    const float* Fh = DECAY ? cumF + ((size_t)b * NHEAD + h) * SEQ : nullptr;
    LAS float* wsf = (LAS float*)(lds + L_WS) + wid * 64;
    const bf16* ksrc0 = Kh + (long)lane * 512 + wid * 8;
    const bf16* ksrc1 = Kp + (long)lane * ROPE + (wid & 3) * 8;
    const bf16* vsrc = Vh + (long)(16 * (wid & 3) + (lane >> 2)) * 512 + (wid >> 2) * 32 + (lane & 3) * 8;
    const int NT = (q0 + 256) / 64;
#define ATT_DMA_K(i_, s) do { const int t_ = NT - 1 - (i_); \
        __builtin_amdgcn_global_load_lds((const unsigned*)(ksrc0 + (long)t_ * 64 * 512), (LAS unsigned*)(lds + L_K + (s) * KSLOT + wid * 1024), 16, 0, 0); \
        if (DQK == 96 && wid < 4) __builtin_amdgcn_global_load_lds((const unsigned*)(ksrc1 + (long)t_ * 64 * ROPE), (LAS unsigned*)(lds + L_K + (s) * KSLOT + (8 + wid) * 1024), 16, 0, 0); \
        if (DECAY && wid == 7) __builtin_amdgcn_global_load_lds((const unsigned*)(Fh + t_ * 64 + lane), (LAS unsigned*)(lds + L_F + (s) * 256), 4, 0, 0); } while (0)
#define ATT_DMA_V(i_, s) do { const int t_ = NT - 1 - (i_); \
        __builtin_amdgcn_global_load_lds((const unsigned*)(vsrc + (long)t_ * 64 * 512), (LAS unsigned*)(lds + L_V + (s) * VSLOT + wid * 1024), 16, 0, 0); } while (0)
    ATT_DMA_K(0, 0); ATT_DMA_V(0, 0); ATT_DMA_K(1, 1);
    bf16x8 qr[ND0];
#pragma unroll
    for (int d0 = 0; d0 < ND0; ++d0) qr[d0] = *(const bf16x8*)(Qw + (long)r32 * QP + d0 * 16 + hi * 8);
    float fq_l = 0.f; if (DECAY) fq_l = Fh[q0 + wid * 32 + r32];
    float mhat = 0.f, l_reg = 0.f; bool started = false; f32x16 o[2]; o[0] = f32x16{}; o[1] = f32x16{};
    const int qrel = wid * 32 + r32;
    const int vb0 = (int)(uintptr_t)(lds + L_V) + ((lane >> 4) & 1) * 32 + (lane & 3) * 8 + (4 * hi + ((lane & 15) >> 2)) * 64;
#define ATT_QK(P0, P1, ks_) do { const float base_ = fq_l - mhat; \
        if (DECAY) { const LAS f32x4* fk_ = (const LAS f32x4*)(lds + L_F + (ks_) * 256); \
            _Pragma("unroll") for (int g = 0; g < 4; ++g) { const f32x4 a_ = fk_[2 * g + hi], c_ = fk_[8 + 2 * g + hi]; \
                _Pragma("unroll") for (int q = 0; q < 4; ++q) { P0[4 * g + q] = base_ - a_[q]; P1[4 * g + q] = base_ - c_[q]; } } } \
        else { _Pragma("unroll") for (int r = 0; r < 16; ++r) { P0[r] = base_; P1[r] = base_; } } \
        const LAS unsigned char* kb_ = lds + L_K + (ks_) * KSLOT + hi * 1024 + r32 * 16; \
        _Pragma("unroll") for (int d0 = 0; d0 < ND0; ++d0) { \
            const bf16x8 b0_ = *(const LAS bf16x8*)(kb_ + d0 * 2048), b1_ = *(const LAS bf16x8*)(kb_ + d0 * 2048 + 512); \
            P0 = __builtin_amdgcn_mfma_f32_32x32x16_bf16(b0_, qr[d0], P0, 0, 0, 0); P1 = __builtin_amdgcn_mfma_f32_32x32x16_bf16(b1_, qr[d0], P1, 0, 0, 0); } } while (0)
    f32x16 p0, p1, n0, n1;
    int ks_cur = 0, ks_nxt = 1, ks_ld = 2;
    for (int i = 0; i < NT; ++i) {
        const int vs = i & 1;
        VM_WAIT(); __syncthreads();
        if (i + 2 < NT) ATT_DMA_K(i + 2, ks_ld);
        if (i + 1 < NT) ATT_DMA_V(i + 1, vs ^ 1);
        if (i == 0) ATT_QK(p0, p1, 0);
        if (i + 1 < NT) ATT_QK(n0, n1, ks_nxt);
        const int jb = 3 - i;
        if (jb >= 0) cmask(p0, p1, jb, qrel, hi);
        const float rm = rowmax(p0, p1);
        bool resc = false; float dl = 0.f; const bool was_started = started;
        if (jb >= 0) {
            const bool fin = rm > -INFINITY;
            dl = started ? fmaxf(rm, 0.f) : (fin ? rm : 0.f); started = started || fin; resc = true;
        } else if (__any(rm > (float)THRL)) { dl = fmaxf(rm, 0.f); resc = true; }
        if (resc) { mhat += dl;
#pragma unroll
            for (int r = 0; r < 16; ++r) { p0[r] -= dl; p1[r] -= dl; }
            if (i + 1 < NT) {
#pragma unroll
                for (int r = 0; r < 16; ++r) { n0[r] -= dl; n1[r] -= dl; } }
            const float f = was_started ? __builtin_amdgcn_exp2f(-dl) : 1.f; l_reg *= f; if (hi == 0) wsf[r32] = f; }
        float sacc = 0.f;
#pragma unroll
        for (int r = 0; r < 16; ++r) { p0[r] = __builtin_amdgcn_exp2f(p0[r]); p1[r] = __builtin_amdgcn_exp2f(p1[r]); sacc += p0[r] + p1[r]; }
        l_reg += sacc;
        if (resc) { LDS_WAIT();
#pragma unroll
            for (int d_ = 0; d_ < 2; ++d_)
#pragma unroll
                for (int r = 0; r < 16; ++r) o[d_][r] *= wsf[crow(r, hi)]; }
        u32x4 pw0, pw1, pw2, pw3;
        pw0 = (u32x4){cvtpk_s(p0[0], p0[1]), cvtpk_s(p0[2], p0[3]), cvtpk_s(p0[4], p0[5]), cvtpk_s(p0[6], p0[7])};
        pw1 = (u32x4){cvtpk_s(p0[8], p0[9]), cvtpk_s(p0[10], p0[11]), cvtpk_s(p0[12], p0[13]), cvtpk_s(p0[14], p0[15])};
        pw2 = (u32x4){cvtpk_s(p1[0], p1[1]), cvtpk_s(p1[2], p1[3]), cvtpk_s(p1[4], p1[5]), cvtpk_s(p1[6], p1[7])};
        pw3 = (u32x4){cvtpk_s(p1[8], p1[9]), cvtpk_s(p1[10], p1[11]), cvtpk_s(p1[12], p1[13]), cvtpk_s(p1[14], p1[15])};
        __builtin_amdgcn_sched_barrier(0);
        pv(o, vb0 + vs * VSLOT, __builtin_bit_cast(bf16x8, pw0), __builtin_bit_cast(bf16x8, pw1), __builtin_bit_cast(bf16x8, pw2), __builtin_bit_cast(bf16x8, pw3));
        p0 = n0; p1 = n1;
        { const int t_ = ks_cur; ks_cur = ks_nxt; ks_nxt = ks_ld; ks_ld = t_; }
    }
    { auto rr = __builtin_amdgcn_permlane32_swap(__float_as_uint(l_reg), __float_as_uint(l_reg), false, false); l_reg = __uint_as_float(rr[0]) + __uint_as_float(rr[1]); }
    if (hi == 0) wsf[32 + r32] = l_reg; LDS_WAIT();
    float rli[16];
#pragma unroll
    for (int r = 0; r < 16; ++r) rli[r] = __builtin_amdgcn_rcpf(wsf[32 + crow(r, hi)]);
    unsigned char* Ow = (unsigned char*)O + (rowbase + q0 + wid * 32) * OP + h * 64;
    { LAS unsigned char* stg = lds + L_OST + wid * 4096;
#pragma unroll
      for (int r = 0; r < 16; ++r) { const int orow = crow(r, hi);
#pragma unroll
          for (int d0 = 0; d0 < 2; ++d0) { const float ov = o[d0][r] * rli[r] * OSCALE8; stg[orow * 64 + d0 * 32 + r32] = (unsigned char)__builtin_amdgcn_cvt_pk_fp8_f32(ov, ov, 0, false); } }
      LDS_WAIT();
#pragma unroll
      for (int i = 0; i < 2; ++i) { const int row = i * 16 + (lane >> 2), ch = lane & 3; const u32x4 v = *(const LAS u32x4*)(stg + row * 64 + ch * 16); *(u32x4*)(Ow + (long)row * OP + ch * 16) = v; } }
    LDS_WAIT(); __syncthreads();
#undef ATT_DMA_K
#undef ATT_DMA_V
#undef ATT_QK
}

constexpr int T_KSLOT = 12288, T_VSLOT = 8192, T_NSLOT = 3;
constexpr int T_K = 0, T_V = T_NSLOT * T_KSLOT, T_F = T_V + T_NSLOT * T_VSLOT, T_WS = T_F + T_NSLOT * 256, T_OST = T_WS + 2048, T_END = T_OST + 8 * 4096;
static_assert(T_END <= RING_BYTES, "attention LDS (hand-interleaved unit)");
typedef __attribute__((address_space(3))) const char* lds_cptr;
typedef short v4i16_t __attribute__((ext_vector_type(4)));
__device__ __forceinline__ s16x4 vtr(lds_cptr p) { return __builtin_bit_cast(s16x4, __builtin_amdgcn_ds_read_tr16_b64_v4i16((__attribute__((address_space(3))) v4i16_t*)p)); }
__device__ __forceinline__ void kload2(bf16x8* kf, lds_cptr kp, int j) { kf[2 * j] = *(const __attribute__((address_space(3))) bf16x8*)(kp + j * 2048); kf[2 * j + 1] = *(const __attribute__((address_space(3))) bf16x8*)(kp + j * 2048 + 512); }
#define TW_BAR(N) asm volatile("s_waitcnt vmcnt(" #N ") lgkmcnt(0)\n\ts_barrier" ::: "memory")
#define TSB() __builtin_amdgcn_sched_barrier(0)

template <int DQK, bool DECAY, int THRL>
__device__ __forceinline__ void attn_unit_t(int b, int h, int qb, const bf16* Q, int QP, const bf16* Kn, const bf16* Kpe, const bf16* V, const float* cumF, float kmax2, bf16* O, int OP, LAS unsigned char* lds) {
    constexpr int ND0 = DQK / 16;
    constexpr bool INPL = DECAY || (DQK == 96);
    int tid = threadIdx.x; asm volatile("" : "+v"(tid));
    const int lane = tid & 63, r32 = lane & 31, hi = lane >> 5; const int wid = __builtin_amdgcn_readfirstlane(tid >> 6);
    const long rowbase = (long)b * SEQ; const int q0 = qb * 256;
    const bf16* Qw = Q + (rowbase + q0 + wid * 32) * QP + h * DQK;
    const bf16* Kh = Kn + rowbase * 512 + h * 64; const bf16* Vh = V + rowbase * 512 + h * 64;
    const bf16* Kp = Kpe + rowbase * ROPE;
    const float* Fh = DECAY ? cumF + ((size_t)b * NHEAD + h) * SEQ : nullptr;
    LAS float* wsf = (LAS float*)(lds + T_WS) + wid * 64;
    const bf16* ksrc0 = Kh + (long)lane * 512 + wid * 8;
    const bf16* ksrc1 = Kp + (long)lane * ROPE + (wid & 3) * 8;
    const bf16* vsrc = Vh + (long)(16 * (wid & 3) + (lane >> 2)) * 512 + (wid >> 2) * 32 + (lane & 3) * 8;
    const int NTS = (q0 + 256) / 64;
#define TDMA_K(i_, sk) do { const int t_ = NTS - 1 - (i_); \
        __builtin_amdgcn_global_load_lds((const unsigned*)(ksrc0 + (long)t_ * 64 * 512), (LAS unsigned*)(lds + T_K + (sk) * T_KSLOT + wid * 1024), 16, 0, 0); \
        if (DECAY) __builtin_amdgcn_global_load_lds((const unsigned*)(Fh + t_ * 64 + lane), (LAS unsigned*)(lds + T_F + (sk) * 256), 4, 0, 0); \
        else __builtin_amdgcn_global_load_lds((const unsigned*)(ksrc1 + (long)t_ * 64 * ROPE), (LAS unsigned*)(lds + T_K + (sk) * T_KSLOT + (8 + (wid & 3)) * 1024), 16, 0, 0); } while (0)
#define TDMA_V(i_, sv) do { const int t_ = NTS - 1 - (i_); \
        __builtin_amdgcn_global_load_lds((const unsigned*)(vsrc + (long)t_ * 64 * 512), (LAS unsigned*)(lds + T_V + (sv) * T_VSLOT + wid * 1024), 16, 0, 0); } while (0)
    TDMA_K(0, 0); TDMA_V(0, 0); TDMA_K(1, 1);
    bf16x8 qr[ND0];
#pragma unroll
    for (int d0 = 0; d0 < ND0; ++d0) qr[d0] = *(const bf16x8*)(Qw + (long)r32 * QP + d0 * 16 + hi * 8);
    float fq_l = 0.f; if (DECAY) fq_l = Fh[q0 + wid * 32 + r32];
    float ftile = 0.f; if (DECAY) ftile = Fh[(lane < NTS ? lane : NTS - 1) * 64 + 63];
    float mhat = 0.f, l_reg = 0.f; f32x16 o[2]; o[0] = f32x16{}; o[1] = f32x16{};
    f32x16 negm = f32x16{}; asm volatile("" : "+v"(negm));
    const int qrel = wid * 32 + r32, i0 = 3 - (wid >> 1);
    const lds_cptr shm3 = (lds_cptr)lds; const lds_cptr kp0 = shm3 + T_K + hi * 1024 + r32 * 16;
    const lds_cptr vp0 = shm3 + T_V + ((lane >> 4) & 1) * 32 + (lane & 3) * 8 + (4 * hi + ((lane & 15) >> 2)) * 64;
    const int vb0 = (int)(uintptr_t)(lds + T_V) + ((lane >> 4) & 1) * 32 + (lane & 3) * 8 + (4 * hi + ((lane & 15) >> 2)) * 64;
    bool resc = false;
    bf16x8 kf[2 * ND0];
    f32x16 pA0, pA1, pB0, pB1;
    int sl_prev = 0, sl_cur = 0, sl_next = 1;
#define TROT() do { sl_prev = sl_cur; sl_cur = sl_next; sl_next = (sl_next == T_NSLOT - 1) ? 0 : sl_next + 1; } while (0)
#define TBIAS(X0, X1, fs_) do { if (DECAY) { const float base_ = fq_l - mhat; const LAS f32x4* fk_ = (const LAS f32x4*)(lds + T_F + (fs_) * 256); \
        _Pragma("unroll") for (int g = 0; g < 4; ++g) { const f32x4 a_ = fk_[2 * g + hi], c_ = fk_[8 + 2 * g + hi]; \
            _Pragma("unroll") for (int q = 0; q < 4; ++q) { X0[4 * g + q] = base_ - a_[q]; X1[4 * g + q] = base_ - c_[q]; } } } \
        else if (INPL) { const float nm_ = -mhat; _Pragma("unroll") for (int r = 0; r < 16; ++r) { X0[r] = nm_; X1[r] = nm_; } } } while (0)
#define TCIN(X) (INPL ? X : negm)
#define TRESC() do { if (resc) { asm volatile("s_waitcnt lgkmcnt(0)" ::: "memory"); \
        _Pragma("unroll") for (int d_ = 0; d_ < 2; ++d_) _Pragma("unroll") for (int r = 0; r < 16; ++r) o[d_][r] *= wsf[crow(r, hi)]; } } while (0)
#define TDECIDE(C0, C1, i_) do { \
        float a_ = max3f(C0[0], C0[1], C1[0]), b_ = max3f(C0[2], C0[3], C1[1]); a_ = max3f(a_, C1[2], C1[3]); \
        _Pragma("unroll") for (int r = 4; r < 16; r += 4) { a_ = max3f(a_, C0[r], C0[r + 1]); b_ = max3f(b_, C0[r + 2], C0[r + 3]); a_ = max3f(a_, C1[r], C1[r + 1]); b_ = max3f(b_, C1[r + 2], C1[r + 3]); } \
        float rm_ = fmaxf(a_, b_); { auto rr_ = __builtin_amdgcn_permlane32_swap(__float_as_uint(rm_), __float_as_uint(rm_), false, false); rm_ = fmaxf(__uint_as_float(rr_[0]), __uint_as_float(rr_[1])); } \
        resc = false; \
        if ((i_) == i0) { const float dl_ = rm_; mhat += dl_; \
            _Pragma("unroll") for (int r = 0; r < 16; ++r) { C0[r] -= dl_; C1[r] -= dl_; } \
            if (!INPL) { _Pragma("unroll") for (int r = 0; r < 16; ++r) negm[r] = -mhat; asm volatile("" : "+v"(negm)); } } \
        else if (__builtin_expect(__any(rm_ > (float)THRL), 0)) { const float dl_ = fmaxf(rm_, 0.f); mhat += dl_; \
            _Pragma("unroll") for (int r = 0; r < 16; ++r) { C0[r] -= dl_; C1[r] -= dl_; } \
            if (!INPL) { _Pragma("unroll") for (int r = 0; r < 16; ++r) negm[r] = -mhat; asm volatile("" : "+v"(negm)); } \
            const float f_ = __builtin_amdgcn_exp2f(-dl_); l_reg *= f_; if (hi == 0) wsf[r32] = f_; resc = true; } } while (0)
    TDMA_K(2, 2);
    TW_BAR(5);
    int NT = NTS;
    if (DECAY) {
        const float bound = 2.f * __builtin_sqrtf(kmax2) * 1.0001f + 1.f + (Fh[q0] - ftile);
        const unsigned long long need = __ballot(lane < NTS && bound >= -160.f);
        const int tmin = need ? (int)__builtin_ctzll(need) : NTS - 1;
        NT = NTS - tmin; NT += NT & 1; if (NT < 8) NT = 8; if (NT > NTS) NT = NTS;
        NT = __builtin_amdgcn_readfirstlane(NT); }
    TBIAS(pA0, pA1, 0);
    { const lds_cptr kb = kp0;
#pragma unroll
      for (int d0 = 0; d0 < ND0; ++d0) { const bf16x8 b0 = *(const __attribute__((address_space(3))) bf16x8*)(kb + d0 * 2048), b1 = *(const __attribute__((address_space(3))) bf16x8*)(kb + d0 * 2048 + 512);
          if (d0 == 0) { pA0 = __builtin_amdgcn_mfma_f32_32x32x16_bf16(b0, qr[0], TCIN(pA0), 0, 0, 0); pA1 = __builtin_amdgcn_mfma_f32_32x32x16_bf16(b1, qr[0], TCIN(pA1), 0, 0, 0); }
          else { pA0 = __builtin_amdgcn_mfma_f32_32x32x16_bf16(b0, qr[d0], pA0, 0, 0, 0); pA1 = __builtin_amdgcn_mfma_f32_32x32x16_bf16(b1, qr[d0], pA1, 0, 0, 0); } } }
    cmask(pA0, pA1, 3, qrel, hi);
    TDECIDE(pA0, pA1, 0);
#pragma unroll
    for (int r = 0; r < 16; ++r) { pA0[r] = __builtin_amdgcn_exp2f(pA0[r]); pA1[r] = __builtin_amdgcn_exp2f(pA1[r]); }
    TW_BAR(0);
    TDMA_K(3, 0); TDMA_V(1, 1);
    TROT();
#pragma unroll
    for (int j = 0; j < ND0; ++j) kload2(kf, kp0 + sl_cur * T_KSLOT, j);
    TBIAS(pB0, pB1, sl_cur);
    TW_BAR(3);
    s16x4 vlo[8], vhi[8]; u32x4 pw0, pw1, pw2, pw3;
#define TPKW(P, B) cvt_pk_bf16(P[B], P[B + 1])
#define TPAF(k) __builtin_bit_cast(bf16x8, pw##k)
#define TVFR(i) (bf16x8){vlo[i][0], vlo[i][1], vlo[i][2], vlo[i][3], vhi[i][0], vhi[i][1], vhi[i][2], vhi[i][3]}
#define TPIN(x) asm volatile("" : "+v"(x))
#define TGAPA(MF, A0, A1, A2, A3, W0, W1, PW) do { MF; sacc += A0; sacc += A1; sacc += A2; sacc += A3; TPIN(sacc); W0; W1; TPIN(PW); TSB(); } while (0)
#define TEX(v) __builtin_amdgcn_exp2f(v)
#define TGAPB(MF, X, B) do { MF; X[B] = TEX(X[B]); X[B + 1] = TEX(X[B + 1]); X[B + 2] = TEX(X[B + 2]); X[B + 3] = TEX(X[B + 3]); TPIN(X); TSB(); } while (0)
#define TVRD(i) do { vlo[i] = vtr(vp_ + (((i) >> 2) * 4096 + ((i) & 3) * 1024)); vhi[i] = vtr(vp_ + (((i) >> 2) * 4096 + ((i) & 3) * 1024 + 512)); } while (0)
#define TKRD(G, j) do { if (G) { kload2(kf, kp0 + sl_next * T_KSLOT, j); TSB(); } } while (0)
#define TMF(a, b, c) __builtin_amdgcn_mfma_f32_32x32x16_bf16(a, b, c, 0, 0, 0)
#define TSTEP(C0, C1, P0, P1, i_, MJB, GK, GV, GL) do { TSB(); \
        const lds_cptr vp_ = vp0 + sl_prev * T_VSLOT; \
        TVRD(0); TSB(); float sacc = (P0[0] + P0[1]); \
        TGAPA(C0 = TMF(kf[0], qr[0], TCIN(C0)), P0[2], P0[3], P0[4], P0[5],     pw0[0] = TPKW(P0, 0), pw0[1] = TPKW(P0, 2), pw0); \
        TVRD(4); TSB(); TGAPA(C1 = TMF(kf[1], qr[0], TCIN(C1)), P0[6], P0[7], P0[8], P0[9],     pw0[2] = TPKW(P0, 4), pw0[3] = TPKW(P0, 6), pw0); \
        TVRD(1); TSB(); TGAPA(C0 = TMF(kf[2], qr[1], C0),   P0[10], P0[11], P0[12], P0[13], pw1[0] = TPKW(P0, 8), pw1[1] = TPKW(P0, 10), pw1); \
        TVRD(5); TSB(); TGAPA(C1 = TMF(kf[3], qr[1], C1),   P0[14], P0[15], P1[0], P1[1],   pw1[2] = TPKW(P0, 12), pw1[3] = TPKW(P0, 14), pw1); \
        TVRD(2); TSB(); TGAPA(C0 = TMF(kf[4], qr[2], C0),   P1[2], P1[3], P1[4], P1[5],     pw2[0] = TPKW(P1, 0), pw2[1] = TPKW(P1, 2), pw2); \
        TVRD(6); TSB(); TGAPA(C1 = TMF(kf[5], qr[2], C1),   P1[6], P1[7], P1[8], P1[9],     pw2[2] = TPKW(P1, 4), pw2[3] = TPKW(P1, 6), pw2); \
        TVRD(3); TSB(); TGAPA(C0 = TMF(kf[6], qr[3], C0),   P1[10], P1[11], P1[12], P1[13], pw3[0] = TPKW(P1, 8), pw3[1] = TPKW(P1, 10), pw3); \
        TVRD(7); TSB(); TGAPA(C1 = TMF(kf[7], qr[3], C1),   P1[14], P1[15], 0.f, 0.f,       pw3[2] = TPKW(P1, 12), pw3[3] = TPKW(P1, 14), pw3); \
        if (ND0 == 6) { C0 = TMF(kf[2 * ND0 - 4], qr[ND0 - 2], C0); C1 = TMF(kf[2 * ND0 - 3], qr[ND0 - 2], C1); C0 = TMF(kf[2 * ND0 - 2], qr[ND0 - 1], C0); C1 = TMF(kf[2 * ND0 - 1], qr[ND0 - 1], C1); TSB(); } \
        l_reg += sacc; \
        if (GK) { TDMA_K((i_) + 3, sl_cur); } if (GV) { TDMA_V((i_) + 1, sl_next); } \
        if ((MJB) >= 0) cmask(C0, C1, (MJB), qrel, hi); \
        TDECIDE(C0, C1, i_); \
        TSB(); \
        TGAPB(o[0] = TMF(TPAF(0), TVFR(0), o[0]), C0, 0); \
        TKRD(GL, 0); TGAPB(o[1] = TMF(TPAF(0), TVFR(4), o[1]), C0, 4); \
        TKRD(GL, 1); TGAPB(o[0] = TMF(TPAF(1), TVFR(1), o[0]), C0, 8); \
        TKRD(GL, 2); TGAPB(o[1] = TMF(TPAF(1), TVFR(5), o[1]), C0, 12); \
        TKRD(GL, 3); TGAPB(o[0] = TMF(TPAF(2), TVFR(2), o[0]), C1, 0); \
        if (ND0 == 6) { TKRD(GL, ND0 - 2); } TGAPB(o[1] = TMF(TPAF(2), TVFR(6), o[1]), C1, 4); \
        if (ND0 == 6) { TKRD(GL, ND0 - 1); } TGAPB(o[0] = TMF(TPAF(3), TVFR(3), o[0]), C1, 8); \
        TGAPB(o[1] = TMF(TPAF(3), TVFR(7), o[1]), C1, 12); \
        if (GL) { TBIAS(P0, P1, sl_next); } \
    } while (0)
#define TENDW(tt) do { if ((tt) + 3 < NT) { TW_BAR(3); } else if ((tt) + 2 < NT) { TW_BAR(1); } else { TW_BAR(0); } } while (0)
    {
        int i = 1;
        for (; i + 2 < NT; i += 2) {
            TSTEP(pB0, pB1, pA0, pA1, i, 3 - i, (i + 3 < NT), true, true);         TENDW(i);     TRESC(); TROT();
            TSTEP(pA0, pA1, pB0, pB1, i + 1, 2 - i, (i + 4 < NT), true, true);     TENDW(i + 1); TRESC(); TROT();
        }
        TSTEP(pB0, pB1, pA0, pA1, NT - 1, -1, false, false, false); TRESC();
    }
    { float sacc = pB0[0] + pB0[1];
#pragma unroll
      for (int r = 2; r < 16; ++r) sacc += pB0[r];
#pragma unroll
      for (int r = 0; r < 16; ++r) sacc += pB1[r];
      l_reg += sacc;
      pw0 = (u32x4){TPKW(pB0, 0), TPKW(pB0, 2), TPKW(pB0, 4), TPKW(pB0, 6)}; pw1 = (u32x4){TPKW(pB0, 8), TPKW(pB0, 10), TPKW(pB0, 12), TPKW(pB0, 14)};
      pw2 = (u32x4){TPKW(pB1, 0), TPKW(pB1, 2), TPKW(pB1, 4), TPKW(pB1, 6)}; pw3 = (u32x4){TPKW(pB1, 8), TPKW(pB1, 10), TPKW(pB1, 12), TPKW(pB1, 14)};
      TSB(); pv(o, vb0 + sl_cur * T_VSLOT, TPAF(0), TPAF(1), TPAF(2), TPAF(3)); }
    { auto rr = __builtin_amdgcn_permlane32_swap(__float_as_uint(l_reg), __float_as_uint(l_reg), false, false); l_reg = __uint_as_float(rr[0]) + __uint_as_float(rr[1]); }
    if (hi == 0) wsf[32 + r32] = l_reg; asm volatile("s_waitcnt lgkmcnt(0)" ::: "memory");
    float rli[16];
#pragma unroll
    for (int r = 0; r < 16; ++r) rli[r] = __builtin_amdgcn_rcpf(wsf[32 + crow(r, hi)]);
    unsigned char* Ow = (unsigned char*)O + (rowbase + q0 + wid * 32) * OP + h * 64;
    { LAS unsigned char* stg = lds + T_OST + wid * 4096;
#pragma unroll
      for (int r = 0; r < 16; ++r) { const int orow = crow(r, hi);
#pragma unroll
          for (int d0 = 0; d0 < 2; ++d0) { const float ov = o[d0][r] * rli[r] * OSCALE8; stg[orow * 64 + d0 * 32 + r32] = (unsigned char)__builtin_amdgcn_cvt_pk_fp8_f32(ov, ov, 0, false); } }
      asm volatile("s_waitcnt lgkmcnt(0)" ::: "memory");
#pragma unroll
      for (int i = 0; i < 2; ++i) { const int row = i * 16 + (lane >> 2), ch = lane & 3; const u32x4 v = *(const LAS u32x4*)(stg + row * 64 + ch * 16); *(u32x4*)(Ow + (long)row * OP + ch * 16) = v; } }
    asm volatile("s_waitcnt lgkmcnt(0)\n\ts_barrier" ::: "memory");
#undef TDMA_K
#undef TDMA_V
#undef TROT
#undef TBIAS
#undef TCIN
#undef TRESC
#undef TDECIDE
#undef TPKW
#undef TPAF
#undef TVFR
#undef TPIN
#undef TGAPA
#undef TEX
#undef TGAPB
#undef TVRD
#undef TKRD
#undef TMF
#undef TSTEP
#undef TENDW
}
#undef TW_BAR
#undef TSB
}

namespace dn {
constexpr int CHB = 64 * 256;
constexpr int NSLOT = 8, AHEAD = 7;
__device__ __forceinline__ int nloc(int i) { return 16 * ((i >> 2) & 1) + (i & 3) + 4 * (i >> 3); }
template <bool NOTRAFFIC>
__device__ __forceinline__ void down_phase(LAS unsigned char* lds, const unsigned char* HBp, const unsigned char* Wd, const unsigned char* Wsd, volatile LAS int* tab, const u32x2* meta, unsigned char* Yp, unsigned char* trash, int G, int c) {
    int tid = threadIdx.x; asm volatile("" : "+v"(tid));
    const int wid = __builtin_amdgcn_readfirstlane(tid >> 6), lane = tid & 63, j = lane & 31, hi = lane >> 5;
    const int U = tab[65] * 8;
    const int u_lo = (int)(((long)c * U) / G), u_hi = (int)(((long)(c + 1) * U) / G);
    if (u_lo >= u_hi) return;
#define DN_DEC(u_, e_, hf_, ci_) do { e_ = __builtin_amdgcn_readfirstlane(tab[132 + ((u_) >> 3)]); const int ul_ = __builtin_amdgcn_readfirstlane((u_) - 8 * tab[e_]), nc_ = __builtin_amdgcn_readfirstlane(4 * (tab[e_ + 1] - tab[e_])); hf_ = (ul_ >= nc_) ? 1 : 0; ci_ = ul_ - hf_ * nc_; } while (0)
    unsigned dvo; { const int r_ = lane >> 3, f_ = ((r_ >> 1) & 3) << 1; dvo = (unsigned)(r_ * 256 + (((lane & 7) ^ f_) * 16)); }
#define DN_DMA(u_, buf_) do { int e__, hf__, ci__; DN_DEC(u_, e__, hf__, ci__); (void)hf__; const unsigned char* gb_ = HBp + ((size_t)tab[e__] * 256 + (size_t)ci__ * 64) * DEXP; \
        _Pragma("unroll") for (int i_ = 0; i_ < 2; ++i_) { const int q_ = wid * 2 + i_, kb_ = q_ >> 3, g_ = q_ & 7; \
            __builtin_amdgcn_global_load_lds((const unsigned*)(gb_ + (size_t)(8 * g_) * DEXP + kb_ * 128 + dvo), (LAS unsigned*)(lds + (buf_) * CHB + kb_ * 8192 + g_ * 1024), 16, 0, 0); } } while (0)
    int rowb[2], fx[2];
#pragma unroll
    for (int rt = 0; rt < 2; ++rt) { const int row = 32 * rt + j; rowb[rt] = (int)(uintptr_t)lds + row * 128; fx[rt] = (((row >> 1) & 3) << 1) * 16; }
    unsigned sc1 = 0x7f7f7f7fu; asm volatile("" : "+v"(sc1));
#pragma unroll
    for (int p = 0; p < AHEAD; ++p) { const int un = (u_lo + p < u_hi) ? u_lo + p : u_lo; DN_DMA(un, p); }
    int u = u_lo;
    while (u < u_hi) {
      int e, hf, ci0; DN_DEC(u, e, hf, ci0);
      const int nc = __builtin_amdgcn_readfirstlane(4 * (tab[e + 1] - tab[e])), ne = __builtin_amdgcn_readfirstlane(tab[66 + e]);
      int seg_end = 8 * tab[e] + (hf + 1) * nc; seg_end = __builtin_amdgcn_readfirstlane(seg_end < u_hi ? seg_end : u_hi);
      v8i32_t wfr[2][4];
#pragma unroll
      for (int nt = 0; nt < 2; ++nt) { const unsigned char* wp = ((e == NEXP) ? Wsd : Wd + (size_t)e * D * DEXP) + (size_t)(512 * hf + 64 * wid + 32 * nt + nloc(j)) * DEXP + 32 * hi;
#pragma unroll
          for (int ks = 0; ks < 4; ++ks) { wfr[nt][ks].lo = *(const v4i32_t*)(wp + 64 * ks); wfr[nt][ks].hi = *(const v4i32_t*)(wp + 64 * ks + 16); } }
      bool first = true;
      for (; u < seg_end; ++u) {
        const int buf = (u - u_lo) & (NSLOT - 1); (void)ci0;
        const int cidx = __builtin_amdgcn_readfirstlane((u - 8 * tab[e]) - hf * nc);
        u32x2 mt[2];
#pragma unroll
        for (int rt = 0; rt < 2; ++rt) { int pos = 64 * cidx + 32 * rt + j; const bool in = pos < ne; const int sp = pos; pos = (in && e != NEXP) ? pos : 0; const u32x2 m = meta[(size_t)(e == NEXP ? 0 : e) * LISTCAP + pos];
            mt[rt] = !in ? (u32x2){0xffffffffu, 0u} : (e == NEXP) ? (u32x2){(unsigned)(sp * (TOPK + 1) + TOPK), 0x3f800000u} : m; }
        if (first) { __builtin_amdgcn_s_waitcnt(0x0F70); first = false; }
        else { asm volatile("s_waitcnt vmcnt(54)" ::: "memory"); }
        LDS_WAIT(); __builtin_amdgcn_s_barrier();
        { const int un = (u + AHEAD < u_hi) ? u + AHEAD : u; DN_DMA(un, (buf + AHEAD) & (NSLOT - 1)); }
        f32x16 acc[2][2];
#pragma unroll
        for (int rt = 0; rt < 2; ++rt)
#pragma unroll
            for (int nt = 0; nt < 2; ++nt) asm volatile("v_mov_b32 %0, 0\n\tv_mov_b32 %1, 0\n\tv_mov_b32 %2, 0\n\tv_mov_b32 %3, 0\n\tv_mov_b32 %4, 0\n\tv_mov_b32 %5, 0\n\tv_mov_b32 %6, 0\n\tv_mov_b32 %7, 0\n\tv_mov_b32 %8, 0\n\tv_mov_b32 %9, 0\n\tv_mov_b32 %10, 0\n\tv_mov_b32 %11, 0\n\tv_mov_b32 %12, 0\n\tv_mov_b32 %13, 0\n\tv_mov_b32 %14, 0\n\tv_mov_b32 %15, 0"
                : "=v"(acc[rt][nt][0]), "=v"(acc[rt][nt][1]), "=v"(acc[rt][nt][2]), "=v"(acc[rt][nt][3]), "=v"(acc[rt][nt][4]), "=v"(acc[rt][nt][5]), "=v"(acc[rt][nt][6]), "=v"(acc[rt][nt][7]),
                  "=v"(acc[rt][nt][8]), "=v"(acc[rt][nt][9]), "=v"(acc[rt][nt][10]), "=v"(acc[rt][nt][11]), "=v"(acc[rt][nt][12]), "=v"(acc[rt][nt][13]), "=v"(acc[rt][nt][14]), "=v"(acc[rt][nt][15]));
        v8i32_t ha0, ha1, hb0, hb1;
        const int ad0 = rowb[0] + buf * CHB, ad1 = rowb[1] + buf * CHB;
#define DN_RDA(ks_) do { \
            asm volatile("ds_read_b128 v[192:195], %1 offset:%c2\n\tds_read_b128 v[196:199], %1 offset:%c3" : "={v[192:199]}"(ha0) : "v"(ad0 + ((64 * ((ks_) & 1) + 32 * hi) ^ fx[0])), "i"(((ks_) >> 1) * 8192), "i"(((ks_) >> 1) * 8192 + 16) : "memory"); \
            asm volatile("ds_read_b128 v[200:203], %1 offset:%c2\n\tds_read_b128 v[204:207], %1 offset:%c3" : "={v[200:207]}"(ha1) : "v"(ad1 + ((64 * ((ks_) & 1) + 32 * hi) ^ fx[1])), "i"(((ks_) >> 1) * 8192), "i"(((ks_) >> 1) * 8192 + 16) : "memory"); } while (0)
#define DN_RDB(ks_) do { \
            asm volatile("ds_read_b128 v[208:211], %1 offset:%c2\n\tds_read_b128 v[212:215], %1 offset:%c3" : "={v[208:215]}"(hb0) : "v"(ad0 + ((64 * ((ks_) & 1) + 32 * hi) ^ fx[0])), "i"(((ks_) >> 1) * 8192), "i"(((ks_) >> 1) * 8192 + 16) : "memory"); \
            asm volatile("ds_read_b128 v[216:219], %1 offset:%c2\n\tds_read_b128 v[220:223], %1 offset:%c3" : "={v[216:223]}"(hb1) : "v"(ad1 + ((64 * ((ks_) & 1) + 32 * hi) ^ fx[1])), "i"(((ks_) >> 1) * 8192), "i"(((ks_) >> 1) * 8192 + 16) : "memory"); } while (0)
#define DN_MF(W_, ACC_, H_, REG_, WAIT_) asm volatile(WAIT_ "v_mfma_scale_f32_32x32x64_f8f6f4 %0, %1, %2, %0, %3, %3 op_sel_hi:[0,0,0]" : "+v"(ACC_) : "v"(W_), REG_(H_), "v"(sc1))
        DN_RDA(0);
#pragma unroll
        for (int ks = 0; ks < 4; ks += 2) {
            DN_RDB(ks + 1);
            DN_MF(wfr[0][ks], acc[0][0], ha0, "{v[192:199]}", "s_waitcnt lgkmcnt(4)\n\t"); DN_MF(wfr[1][ks], acc[0][1], ha0, "{v[192:199]}", "");
            DN_MF(wfr[0][ks], acc[1][0], ha1, "{v[200:207]}", ""); DN_MF(wfr[1][ks], acc[1][1], ha1, "{v[200:207]}", "");
            if (ks + 2 < 4) { DN_RDA(ks + 2);
                DN_MF(wfr[0][ks + 1], acc[0][0], hb0, "{v[208:215]}", "s_waitcnt lgkmcnt(4)\n\t"); }
            else { DN_MF(wfr[0][ks + 1], acc[0][0], hb0, "{v[208:215]}", "s_waitcnt lgkmcnt(0)\n\t"); }
            DN_MF(wfr[1][ks + 1], acc[0][1], hb0, "{v[208:215]}", "");
            DN_MF(wfr[0][ks + 1], acc[1][0], hb1, "{v[216:223]}", ""); DN_MF(wfr[1][ks + 1], acc[1][1], hb1, "{v[216:223]}", "");
        }
#undef DN_RDA
#undef DN_RDB
#undef DN_MF
        asm volatile("s_nop 15\n\ts_nop 7" : "+v"(acc[0][0]), "+v"(acc[0][1]), "+v"(acc[1][0]), "+v"(acc[1][1]) :: "memory");
        __builtin_amdgcn_sched_barrier(0);
        const int col0 = 512 * hf + 64 * wid + 16 * hi;
#pragma unroll
        for (int rt = 0; rt < 2; ++rt) { const bool ok = !NOTRAFFIC && mt[rt].x != 0xffffffffu; unsigned char* yd = ok ? Yp + (size_t)mt[rt].x * D : trash; const float w = ok ? __uint_as_float(mt[rt].y) * (1.f / (HSCALE8 * WSCALE8)) : 0.f;
#pragma unroll
            for (int nt = 0; nt < 2; ++nt) { u32x4 o;
#pragma unroll
                for (int q = 0; q < 4; ++q) { int v = __builtin_amdgcn_cvt_pk_fp8_f32(acc[rt][nt][4 * q] * w, acc[rt][nt][4 * q + 1] * w, 0, false);
                    v = __builtin_amdgcn_cvt_pk_fp8_f32(acc[rt][nt][4 * q + 2] * w, acc[rt][nt][4 * q + 3] * w, v, true); o[q] = (unsigned)v; }
                *(u32x4*)(yd + col0 + 32 * nt) = o; } }
      }
    }
    VM_WAIT(); LDS_WAIT(); __builtin_amdgcn_s_barrier();
#undef DN_DMA
#undef DN_DEC
}
}

namespace up {
__device__ __forceinline__ int nloc(int i) { return 16 * ((i >> 2) & 1) + (i & 3) + 4 * (i >> 3); }
__device__ __forceinline__ void up_phase(LAS unsigned char* lds, const bf16* QL, const bf16* KVL, const bf16* Wq, const bf16* Wkv, const float* ssqq, const float* ssqkv, const float* ropetab,
                                         bf16* Qo, bf16* KNo, bf16* VMo, int G, int c) {
    int tid = threadIdx.x; asm volatile("" : "+v"(tid));
    const int wid = __builtin_amdgcn_readfirstlane(tid >> 6), lane = tid & 63, j = lane & 31, hi = lane >> 5;
    for (int grp = c; grp < T / 64; grp += G) {
        const int row0 = grp * 64;
        { const int r_ = lane >> 3, p_ = lane & 7;
#pragma unroll
          for (int i = 0; i < 6; ++i) { const int q_ = wid * 6 + i;
              const bool isq = q_ < 32; const int rem = isq ? q_ : q_ - 32, kb = rem >> 3, g = rem & 7, f_ = (4 * (g & 1) + (r_ >> 1)) & 7;
              __builtin_amdgcn_global_load_lds((const unsigned*)((isq ? QL : KVL) + (size_t)(row0 + 8 * g + r_) * 256 + kb * 64 + ((p_ ^ f_) * 8)), (LAS unsigned*)(lds + (isq ? 0 : 32768) + kb * 8192 + g * 1024), 16, 0, 0); } }
        float rsq[2], rskv[2];
#pragma unroll
        for (int rt = 0; rt < 2; ++rt) { const int row = row0 + 32 * rt + j; const f32x4 a = *(const f32x4*)(ssqq + (size_t)row * 4), b4 = *(const f32x4*)(ssqkv + (size_t)row * 4);
            rsq[rt] = rsqrtf(((a[0] + a[1]) + (a[2] + a[3])) * (1.f / QLORA) + EPS) * C2M; rskv[rt] = rsqrtf(((b4[0] + b4[1]) + (b4[2] + b4[3])) * (1.f / KVLORA) + EPS); }
        const unsigned lane16 = (unsigned)lane * 16u;
        bf16x8 wA[16];
#define UP_LOADW(WB_, Wp_, col_, KS_) do { const char* wb_ = (const char*)(Wp_) + (size_t)__builtin_amdgcn_readfirstlane((col_) >> 5) * (KS_) * 1024;     \
            _Pragma("unroll") for (int ks = 0; ks < (KS_); ++ks) wA[(WB_) + ks] = *(const bf16x8*)(wb_ + ks * 1024 + lane16); } while (0)
#define UP_STEP(WB_, ISQ_, col_, KS_) do { f32x16 acc[2]; acc[0] = f32x16{}; acc[1] = f32x16{}; \
            _Pragma("unroll") for (int ks = 0; ks < (KS_); ++ks) { bf16x8 af[2]; \
                _Pragma("unroll") for (int rt = 0; rt < 2; ++rt) { const int row = 32 * rt + j, cc = 2 * (ks & 3) + hi; \
                    af[rt] = *(const LAS bf16x8*)(lds + ((ISQ_) ? 0 : 32768) + (ks >> 2) * 8192 + row * 128 + ((cc ^ ((row >> 1) & 7)) * 16)); } \
                _Pragma("unroll") for (int rt = 0; rt < 2; ++rt) acc[rt] = __builtin_amdgcn_mfma_f32_32x32x16_bf16(wA[(WB_) + ks], af[rt], acc[rt], 0, 0, 0); } \
            _Pragma("unroll") for (int rt = 0; rt < 2; ++rt) { const int row = row0 + 32 * rt + j; const float r_s = (ISQ_) ? rsq[rt] : rskv[rt]; const int col = (col_) + 16 * hi; \
                float v[16]; _Pragma("unroll") for (int r = 0; r < 16; ++r) v[r] = acc[rt][r] * r_s; \
                bf16* dst; \
                if (ISQ_) { const int jh = col % MQK; \
                    if (jh >= 64) { const int g0 = (jh - 64) >> 3; const f32x4* tb = (const f32x4*)(ropetab + ((size_t)row * 16 + 4 * g0) * 2); \
                        _Pragma("unroll") for (int gg = 0; gg < 2; ++gg) { const f32x4 t0 = tb[2 * gg], t1 = tb[2 * gg + 1]; float* w_ = v + 8 * gg; \
                            const float cs[4] = {t0[0], t0[2], t1[0], t1[2]}, sn[4] = {t0[1], t0[3], t1[1], t1[3]}; \
                            _Pragma("unroll") for (int q = 0; q < 4; ++q) { const float x1 = w_[q], x2 = w_[4 + q]; w_[q] = x1 * cs[q] - x2 * sn[q]; w_[4 + q] = x2 * cs[q] + x1 * sn[q]; } } } \
                    dst = Qo + (size_t)row * 768 + col; } \
                else dst = (col >= 512 ? VMo + (col - 512) : KNo + col) + (size_t)row * 512; \
                *(u32x4*)dst = (u32x4){cvt_pk_bf16(v[0], v[1]), cvt_pk_bf16(v[2], v[3]), cvt_pk_bf16(v[4], v[5]), cvt_pk_bf16(v[6], v[7])}; \
                *(u32x4*)(dst + 8) = (u32x4){cvt_pk_bf16(v[8], v[9]), cvt_pk_bf16(v[10], v[11]), cvt_pk_bf16(v[12], v[13]), cvt_pk_bf16(v[14], v[15])}; } } while (0)
        const int cq = 96 * wid, ckv = 128 * wid;
#define UP_SB() __builtin_amdgcn_sched_barrier(0)
        UP_LOADW(0, Wq, cq, 16);
        VM_WAIT(); __syncthreads();
        UP_STEP(0, true, cq, 16);        UP_SB(); UP_LOADW(0, Wq, cq + 32, 16); UP_SB();
        UP_STEP(0, true, cq + 32, 16);   UP_SB(); UP_LOADW(0, Wq, cq + 64, 16); UP_SB();
        UP_STEP(0, true, cq + 64, 16);   UP_SB(); UP_LOADW(0, Wkv, ckv, 8); UP_LOADW(8, Wkv, ckv + 32, 8); UP_SB();
        UP_STEP(0, false, ckv, 8);       UP_SB(); UP_LOADW(0, Wkv, ckv + 64, 8); UP_SB();
        UP_STEP(8, false, ckv + 32, 8);  UP_SB(); UP_LOADW(8, Wkv, ckv + 96, 8); UP_SB();
        UP_STEP(0, false, ckv + 64, 8);  UP_SB();
        UP_STEP(8, false, ckv + 96, 8);
#undef UP_SB
#undef UP_LOADW
#undef UP_STEP
        __syncthreads();
    }
}
}

#define XB_TMO      128
#define XB_XCNT(j)  (256  + 64 * (j))
#define XB_XSUB(j)  (1280 + 64 * (j))
#define XB_XGEN(j)  (2304 + 64 * (j))
#define XB_TOP      3328
#define XB_TOPGEN   3392
#define XCD_BAR_WORDS 3456
#define XB_SPIN_CAP (1u << 18)
__device__ __forceinline__ unsigned xb_ld(unsigned* p)              { return __hip_atomic_load(p, __ATOMIC_RELAXED, __HIP_MEMORY_SCOPE_AGENT); }
__device__ __forceinline__ unsigned xb_add(unsigned* p, unsigned v) { return __hip_atomic_fetch_add(p, v, __ATOMIC_RELAXED, __HIP_MEMORY_SCOPE_AGENT); }
__device__ __forceinline__ unsigned xb_xcc_id() { return (unsigned)__builtin_amdgcn_s_getreg((3 << 11) | 20) & 0xFu; }
#define XB_SPIN(cond, bar) do { unsigned _sp = 0; while (cond) { __builtin_amdgcn_s_sleep(1); \
    if ((++_sp & 255u) == 0u) { if (xb_ld(&(bar)[XB_TMO])) break; if (_sp > XB_SPIN_CAP) { atomicAdd(&(bar)[XB_TMO], 1u); break; } } } } while (0)
struct XcdBarrier { unsigned* bar; unsigned x; volatile LAS unsigned* st; };
__device__ __forceinline__ XcdBarrier xcd_barrier_post(unsigned* bar, volatile LAS unsigned* st) {
    XcdBarrier b; b.bar = bar; b.x = xb_xcc_id(); b.st = st;
    if (threadIdx.x == 0) (void)xb_add(&bar[XB_XCNT(b.x)], 1u);
    return b;
}
__device__ __forceinline__ void xcd_barrier_complete(unsigned* bar, unsigned x, unsigned& nloc, unsigned& nx) {
    const unsigned G = gridDim.x * gridDim.y * gridDim.z;
    unsigned sum, cnt, mine, sp = 0u;
    for (;;) {
        sum = 0u; cnt = 0u; mine = 0u;
#pragma unroll
        for (unsigned j = 0; j < 16; ++j) { const unsigned c = xb_ld(&bar[XB_XCNT(j)]); sum += c; cnt += (c > 0u) ? 1u : 0u; mine = (j == x) ? c : mine; }
        if (sum == G) break;
        __builtin_amdgcn_s_sleep(1);
        if ((++sp & 255u) == 0u) { if (xb_ld(&bar[XB_TMO])) break; if (sp > XB_SPIN_CAP) { atomicAdd(&bar[XB_TMO], 1u); break; } }
    }
    nloc = mine > 0u ? mine : 1u; nx = cnt > 0u ? cnt : 1u;
}
__device__ __forceinline__ void xcd_barrier(const XcdBarrier& b) {
    asm volatile("s_waitcnt vmcnt(0)" ::: "memory");
    __syncthreads();
    if (threadIdx.x == 0) {
        unsigned* bar = b.bar;
        __builtin_amdgcn_s_waitcnt(0);
        unsigned nloc = b.st[0], nx = b.st[1];
        if (nloc == 0u) { xcd_barrier_complete(bar, b.x, nloc, nx); b.st[0] = nloc; b.st[1] = nx; }
        const unsigned old = xb_add(&bar[XB_XSUB(b.x)], 1u);
        const unsigned gen = old / nloc;
        if (old + 1u == (gen + 1u) * nloc) {
            __builtin_amdgcn_fence(__ATOMIC_RELEASE, "agent");
            asm volatile("s_waitcnt vmcnt(0)" ::: "memory");
            const unsigned og = xb_add(&bar[XB_TOP], 1u);
            const unsigned tg = og / nx;
            if (og + 1u == (tg + 1u) * nx) xb_add(&bar[XB_TOPGEN], 1u);
            else XB_SPIN(xb_ld(&bar[XB_TOPGEN]) == tg, bar);
            __builtin_amdgcn_fence(__ATOMIC_ACQUIRE, "agent");
            xb_add(&bar[XB_XGEN(b.x)], 1u);
            asm volatile("s_waitcnt vmcnt(0)" ::: "memory");
        } else {
            XB_SPIN(xb_ld(&bar[XB_XGEN(b.x)]) == gen, bar);
            __builtin_amdgcn_fence(__ATOMIC_ACQUIRE, "agent");
            asm volatile("s_waitcnt vmcnt(0)" ::: "memory");
        }
    }
    __syncthreads();
}

struct Args { const void* in[25]; float* out; unsigned char* ws; int ph_lo, ph_hi; };

struct Frame {
    LAS unsigned char* lds;
    int tid, lane, wave, vcu, G;
};

template <class ColFn>
__device__ __forceinline__ void cvt_item(int ldw, int Ksrc, const float* kscale, bf16* WT, int Kd, LAS float* scr, int kb, int nb, int lane, ColFn colp) {
    const int k0 = 64 * kb, n0 = 32 * nb;
    const float* cp = colp(n0 + (lane & 31));
    float vv[32], sv[32];
#pragma unroll
    for (int i = 0; i < 32; ++i) { const int k = k0 + 2 * i + (lane >> 5);
        vv[i] = (cp != nullptr && k < Ksrc) ? cp[(size_t)k * ldw] : 0.f;
        sv[i] = (kscale != nullptr && k < Ksrc) ? kscale[k] : 1.f; }
#pragma unroll
    for (int i = 0; i < 32; ++i) scr[(2 * i + (lane >> 5)) * 33 + (lane & 31)] = vv[i] * sv[i];
    LDS_WAIT(); asm volatile("" ::: "memory");
    const int c = lane & 7;
#pragma unroll
    for (int j = 0; j < 4; ++j) { const int n = (lane >> 3) + 8 * j; const LAS float* s = scr + (8 * c) * 33 + n;
        u32x4 o; o.x = pk2(s[0 * 33], s[1 * 33]); o.y = pk2(s[2 * 33], s[3 * 33]); o.z = pk2(s[4 * 33], s[5 * 33]); o.w = pk2(s[6 * 33], s[7 * 33]);
        *(u32x4*)(WT + (size_t)(n0 + n) * Kd + k0 + 8 * c) = o; }
    LDS_WAIT(); asm volatile("" ::: "memory");
}
__device__ __forceinline__ void cvt64_item(const float* src, int ldw, bf16* dst, int Kd, LAS unsigned char* scr, int lane) {
    f32x4 v[16];
    const float* sp = src + (size_t)(lane >> 4) * ldw + 4 * (lane & 15);
#pragma unroll
    for (int i = 0; i < 16; ++i) v[i] = __builtin_nontemporal_load((const f32x4*)(sp + (size_t)(4 * i) * ldw));
#pragma unroll
    for (int i = 0; i < 16; ++i) { const int k = 4 * i + (lane >> 4);
#pragma unroll
        for (int q = 0; q < 4; ++q) { const int n = 4 * (lane & 15) + q; *(LAS bf16*)(scr + n * 128 + (((k >> 3) ^ ((n >> 2) & 7)) << 4) + (k & 7) * 2) = (bf16)f2bf(v[i][q]); } }
    LDS_WAIT(); asm volatile("" ::: "memory");
#pragma unroll
    for (int j = 0; j < 8; ++j) { const int p = j * 64 + lane, n = p >> 3, c = p & 7;
        const u32x4 o = *(const LAS u32x4*)(scr + n * 128 + ((c ^ ((n >> 2) & 7)) << 4));
        __builtin_nontemporal_store(o, (u32x4*)(dst + (size_t)n * Kd + c * 8)); }
    LDS_WAIT(); asm volatile("" ::: "memory");
}
__device__ __forceinline__ void cvt64_item8(const float* src, int ldw, unsigned char* dst, int Kd8, LAS unsigned char* scr, int lane, float scale) {
    f32x4 v[16];
    const float* sp = src + (size_t)(16 * (lane >> 4)) * ldw + 4 * (lane & 15);
#pragma unroll
    for (int i = 0; i < 16; ++i) v[i] = __builtin_nontemporal_load((const f32x4*)(sp + (size_t)i * ldw));
#pragma unroll
    for (int q = 0; q < 4; ++q) { u32x4 o;
#pragma unroll
        for (int g = 0; g < 4; ++g) { int p_ = __builtin_amdgcn_cvt_pk_fp8_f32(v[4 * g][q] * scale, v[4 * g + 1][q] * scale, 0, false); p_ = __builtin_amdgcn_cvt_pk_fp8_f32(v[4 * g + 2][q] * scale, v[4 * g + 3][q] * scale, p_, true); o[g] = (unsigned)p_; }
        *(LAS u32x4*)(scr + (4 * (lane & 15) + q) * 80 + (lane >> 4) * 16) = o; }
    LDS_WAIT(); asm volatile("" ::: "memory");
#pragma unroll
    for (int j = 0; j < 4; ++j) { const int p = j * 64 + lane, n = p >> 2, c = p & 3;
        const u32x4 o = *(const LAS u32x4*)(scr + n * 80 + c * 16);
        __builtin_nontemporal_store(o, (u32x4*)(dst + (size_t)n * Kd8 + c * 16)); }
    LDS_WAIT(); asm volatile("" ::: "memory");
}
__device__ __forceinline__ int ropedim(int jj) { const int g = jj >> 3, u = jj & 7; return (u < 4) ? 4 * g + u : 16 + 4 * g + (u - 4); }

__device__ __forceinline__ void sincos_acc(float af, float& sn, float& cs) {
    const double a = (double)af; const double kq = __builtin_rint(a * 0.63661977236758134308);
    const double r = (a - kq * 1.57079632679489655800) - kq * 6.123233995736766036e-17;
    const double r2 = r * r;
    const double sp = r * (1.0 + r2 * (-1.66666666666666324348e-01 + r2 * (8.33333333332248946124e-03 + r2 * (-1.98412698298579493134e-04 + r2 * (2.75573137070700676789e-06 + r2 * (-2.50507602534068634195e-08 + r2 * 1.58969099521155010221e-10))))));
    const double cp = 1.0 + r2 * (-0.5 + r2 * (4.16666666666666019037e-02 + r2 * (-1.38888888888741095749e-03 + r2 * (2.48015872894767294178e-05 + r2 * (-2.75573143513906633035e-07 + r2 * (2.08757232129817482790e-09 + r2 * -1.13596475577881948265e-11))))));
    const int q = (int)((long long)kq & 3);
    const double s_ = (q == 0) ? sp : (q == 1) ? cp : (q == 2) ? -sp : -cp;
    const double c_ = (q == 0) ? cp : (q == 1) ? -sp : (q == 2) ? -cp : sp;
    sn = (float)s_; cs = (float)c_;
}

__global__ void __launch_bounds__(NWAVES * 64, 2) fwd(Args args) {
    extern __shared__ __attribute__((aligned(16))) unsigned char lds_raw[];
    Frame F;
    F.lds = (LAS unsigned char*)lds_raw;
    F.tid = threadIdx.x; F.lane = F.tid & 63; F.wave = __builtin_amdgcn_readfirstlane(F.tid >> 6);
    F.G = gridDim.x; { const int bx = blockIdx.x; F.vcu = (F.G % 8 == 0) ? (bx % 8) * (F.G / 8) + bx / 8 : bx; }
    volatile LAS unsigned* MISC = (volatile LAS unsigned*)(F.lds + MISC_OFF);
    unsigned char* ws = args.ws;
    gu32* ctl = (gu32*)(ws + WS_CTL);
#define X_IN ((const float*)AP->in[0])
#define cvec ((const float*)AP->in[1])
#define positions ((const int*)AP->in[2])
#define w_mod ((const float*)AP->in[3])
#define b_mod ((const float*)AP->in[4])
#define g_mix ((const float*)AP->in[5])
#define w_in ((const float*)AP->in[6])
#define b_forget ((const float*)AP->in[7])
#define g_q_lat ((const float*)AP->in[8])
#define w_q_up ((const float*)AP->in[9])
#define g_kv_lat ((const float*)AP->in[10])
#define w_kv_up ((const float*)AP->in[11])
#define w_o_mla ((const float*)AP->in[12])
#define w_o_fox ((const float*)AP->in[13])
#define w_out ((const float*)AP->in[14])
#define g_ffn ((const float*)AP->in[15])
#define w_router ((const float*)AP->in[16])
#define b_router ((const float*)AP->in[17])
#define w_exp_gate ((const float*)AP->in[18])
#define w_exp_up ((const float*)AP->in[19])
#define w_exp_down ((const float*)AP->in[20])
#define w_sh_gate ((const float*)AP->in[21])
#define w_sh_up ((const float*)AP->in[22])
#define w_sh_down ((const float*)AP->in[23])
#define g_final ((const float*)AP->in[24])
#define Win_t ((bf16*)(ws + WS_WIN))
#define Wq_t ((bf16*)(ws + WS_WQ))
#define Wkv_t ((bf16*)(ws + WS_WKV))
#define Wom_t ((bf16*)(ws + WS_WOM))
#define Wof_t ((bf16*)(ws + WS_WOF))
#define Wout_t ((bf16*)(ws + WS_WOUT))
#define Wsgu_t ((bf16*)(ws + WS_WSGU))
#define Wsd_t ((bf16*)(ws + WS_WSD))
#define Wr_f ((bf16*)(ws + WS_WR))
#define mod ((float*)(ws + WS_MOD))
#define Wd_t ((bf16*)(ws + WS_WD))
#define Wgu_t ((bf16*)(ws + WS_WGU))
#define HB ((bf16*)(ws + WS_HB))
#define FQ ((bf16*)(ws + WS_FQ))
#define FK ((bf16*)(ws + WS_FK))
#define FV ((bf16*)(ws + WS_FV))
#define QLAT ((bf16*)(ws + WS_QLAT))
#define KVLAT ((bf16*)(ws + WS_KVLAT))
#define OFOX ((bf16*)(ws + WS_OFOX))
#define OCAT ((bf16*)((unsigned char*)out + 32 * MiB))
#define OMLA ((bf16*)(ws + WS_OMLA))
#define Y ((bf16*)(ws + WS_Y))
#define H ((bf16*)(ws + WS_H))
#define QMLA ((bf16*)(ws + WS_QMLA))
#define GATES ((bf16*)(ws + WS_GATES))
#define KN ((bf16*)(ws + WS_KN))
#define VM ((bf16*)(ws + WS_VM))
#define KPE ((bf16*)(ws + WS_KPE))
#define MERGED ((bf16*)(ws + WS_MERGED))
#define LIST ((unsigned short*)(ws + WS_LIST))
#define Wgu8 ((unsigned char*)(ws + WS_WGU))
#define Wsgu8 ((unsigned char*)(ws + WS_WSGU))
#define H8 ((unsigned char*)(ws + WS_H))
#define META ((u32x2*)(ws + WS_WIN))
#define EIDX ((unsigned char*)(ws + WS_EIDX))
#define GATEW ((float*)(ws + WS_GATEW))
#define ROPETAB ((float*)((unsigned char*)out + DO_ROPE))
#define LOGF ((float*)((unsigned char*)out + DO_LOGF))
#define CUMF ((float*)((unsigned char*)out + DO_CUMF))
#define SSQQ ((float*)((unsigned char*)out + DO_SSQQ))
#define SSQKV ((float*)((unsigned char*)out + DO_SSQKV))
#define MODP ((float*)((unsigned char*)out + DO_MODP))
#define SSQ1 ((float*)(ws + WS_FQ))
    float* const out = args.out;
#define PHASE_ENV const __attribute__((address_space(4))) Args* AP; { auto kp_ = __builtin_amdgcn_kernarg_segment_ptr(); asm volatile("" : "+s"(kp_)); AP = (const __attribute__((address_space(4))) Args*)kp_; } \
    unsigned char* const ws = AP->ws; float* const out = AP->out; (void)ws; (void)out;
    for (int u = F.tid; u < (LDS_BYTES - LDSCTL_OFF) / 4; u += NWAVES * 64) ((LAS unsigned*)(F.lds + LDSCTL_OFF))[u] = 0u;
    __syncthreads();
    XcdBarrier bar; bar.bar = (unsigned*)(ctl + CW_BAR); bar.x = 0; bar.st = nullptr;
    if (MK_ONE_LAUNCH) bar = xcd_barrier_post((unsigned*)(ctl + CW_BAR), MISC + 8);
    const int lo = args.ph_lo, hi = args.ph_hi;
#define IN(k) (lo <= (k) && (k) < hi)
#define BOTH(k) (IN(k) && IN((k) + 1))
#define GRID_BAR() do { if (MK_ONE_LAUNCH) xcd_barrier(bar); } while (0)
#define DUP_BAR() do { if (dummy) xcd_barrier(bar); } while (0)
    const int gw = F.vcu * NWAVES + F.wave, NGW = F.G * NWAVES;

    for (int rep = 0; rep < ((PROBE_DUP == 0) ? 2 : 1); ++rep) if (IN(0)) { PHASE_ENV const bool dummy = (PROBE_DUP == 0) && rep == 0; (void)dummy;
        if (!(dummy && (PROBE_VAR == 1 || PROBE_VAR == 4 || PROBE_VAR == 5))) {
            LAS float* cond = (LAS float*)F.lds;
            for (int i = F.tid; i < NB * D; i += NWAVES * 64) { const float c = cvec[i]; cond[i] = c / (1.f + __expf(-c)); }
            __syncthreads();
            for (int it = F.wave * F.G + F.vcu; it < 96 * 16; it += NWAVES * F.G) { const int cg = it % 96, kq = it / 96, col = cg * 64 + F.lane;
                float a4[4] = {0.f, 0.f, 0.f, 0.f};
                const float* wp = w_mod + (size_t)(64 * kq) * (6 * D) + col;
                float wv[64];
#pragma unroll
                for (int kk = 0; kk < 64; ++kk) wv[kk] = __builtin_nontemporal_load(wp + (size_t)kk * (6 * D));
#pragma unroll
                for (int kk = 0; kk < 64; ++kk) {
#pragma unroll
                    for (int b = 0; b < 4; ++b) a4[b] += wv[kk] * cond[b * D + 64 * kq + kk]; }
#pragma unroll
                for (int b = 0; b < 4; ++b) MODP[((size_t)kq * 4 + b) * (6 * D) + col] = a4[b]; }
            __syncthreads();
        }
        if (!(dummy && (PROBE_VAR == 1 || PROBE_VAR == 3 || PROBE_VAR == 5))) for (int i = gw * 64 + F.lane; i < T * 16; i += NGW * 64) { const int t = i >> 4, j = i & 15;
            const float invf = (((j >> 2) == 0) ? 1.f : ((j >> 2) == 1) ? 0.1f : ((j >> 2) == 2) ? 0.01f : 0.001f) * (((j & 3) == 0) ? 1.f : ((j & 3) == 1) ? 0.5623413251903491f : ((j & 3) == 2) ? 0.31622776601683794f : 0.17782794100389228f);
            const float ang = (float)positions[t] * invf; float sn, cs; sincos_acc(ang, sn, cs);
            *(f32x2*)(ROPETAB + (size_t)i * 2) = (f32x2){cs, sn}; }
        for (int o = gw * 64 + F.lane; o < NEXP * D; o += NGW * 64) { const int piece = o >> 3, kk = o & 7, ln = piece & 63, grp = piece >> 6, ntl = grp & 3, j = grp >> 2;
            const int n = ntl * 16 + (ln & 15), k = j * 32 + (ln >> 4) * 8 + kk; Wr_f[o] = (bf16)f2bf(w_router[(size_t)k * NEXP + n]); }
        {
            LAS unsigned char* scr8 = F.lds + 32768 + F.wave * 9216;
            constexpr int F_IN = 62 * 16, F_O = 16 * 8, F_OUT = 16 * 16, F_SGU = 8 * 16, F_SD = 16 * 4, F_EGU = NEXP * F_SGU, F_ED = NEXP * F_SD;
            constexpr int NFAST = F_IN + 2 * F_O + F_OUT + F_SGU + F_SD + F_EGU + F_ED;
            if (!(dummy && PROBE_VAR >= 2)) for (int it = gw; it < NFAST; it += NGW) {
                int r = it;
                if (r < F_EGU) { const int e = r / F_SGU, rr = r % F_SGU, nb = rr & 7, kb = rr >> 3, pn = nb >> 2, c0 = (nb & 3) * 64;
                    const float* wsrc = (c0 < 128) ? w_exp_gate + (size_t)e * D * DEXP + pn * 128 + c0 : w_exp_up + (size_t)e * D * DEXP + pn * 128 + (c0 - 128);
                    cvt64_item8(wsrc + (size_t)(64 * kb) * DEXP, DEXP, Wgu8 + (size_t)e * 512 * D + (size_t)(64 * nb) * D + 64 * kb, D, scr8, F.lane, WSCALE8); continue; } r -= F_EGU;
                if (r < F_ED) { const int e = r / F_SD, rr = r % F_SD, nb = rr & 15, kb = rr >> 4;
                    cvt64_item8(w_exp_down + (size_t)e * DEXP * D + (size_t)(64 * kb) * D + 64 * nb, D, (unsigned char*)Wd_t + (size_t)e * D * DEXP + (size_t)(64 * nb) * DEXP + 64 * kb, DEXP, scr8, F.lane, WSCALE8); continue; } r -= F_ED;
                if (r < F_IN) { int nb = r % 62; const int kb = r / 62; if (nb >= 6) nb += 2; const int n0 = 64 * nb;
                    const int src = (n0 < 384) ? n0 : (n0 < 2048) ? 416 + (n0 - 512) : 1960 + (n0 - 2048);
                    cvt64_item(w_in + (size_t)(64 * kb) * 4008 + src, 4008, Win_t + (size_t)n0 * D + 64 * kb, D, scr8, F.lane); continue; } r -= F_IN;
                if (r < F_O) { const int nb = r & 15, kb = r >> 4; cvt64_item8(w_o_mla + (size_t)(64 * kb) * D + 64 * nb, D, (unsigned char*)Wom_t + (size_t)(64 * nb) * D + 64 * kb, D, scr8, F.lane, WSCALE8); continue; } r -= F_O;
                if (r < F_O) { const int nb = r & 15, kb = r >> 4; cvt64_item8(w_o_fox + (size_t)(64 * kb) * D + 64 * nb, D, (unsigned char*)Wom_t + (size_t)(64 * nb) * D + 512 + 64 * kb, D, scr8, F.lane, WSCALE8); continue; } r -= F_O;
                if (r < F_OUT) { const int nb = r & 15, kb = r >> 4; cvt64_item8(w_out + (size_t)(64 * kb) * D + 64 * nb, D, (unsigned char*)Wout_t + (size_t)(64 * nb) * D + 64 * kb, D, scr8, F.lane, WSCALE8); continue; } r -= F_OUT;
                if (r < F_SGU) { const int nb = r >> 4, kb = r & 15, pn = nb >> 2, c0 = (nb & 3) * 64;
                    const float* wsrc = (c0 < 128) ? w_sh_gate + pn * 128 + c0 : w_sh_up + pn * 128 + (c0 - 128);
                    cvt64_item8(wsrc + (size_t)(64 * kb) * DEXP, DEXP, Wsgu8 + (size_t)(64 * nb) * D + 64 * kb, D, scr8, F.lane, WSCALE8); continue; } r -= F_SGU;
                { const int nb = r >> 2, kb = r & 3; cvt64_item8(w_sh_down + (size_t)(64 * kb) * D + 64 * nb, D, (unsigned char*)Wsd_t + (size_t)(64 * nb) * DEXP + 64 * kb, DEXP, scr8, F.lane, WSCALE8); }
            }
            LAS float* scr = (LAS float*)(F.lds + 32768 + F.wave * 9216);
            constexpr int I_INS = 4 * (D / 64), NSLOW = I_INS;
            if (!(dummy && (PROBE_VAR == 1 || PROBE_VAR == 3 || PROBE_VAR == 4))) for (int it = F.wave * F.G + F.vcu; it < NSLOW; it += NGW) {
                const int nb = 12 + (it & 3), kb = it >> 2;
                cvt_item(4008, D, nullptr, Win_t, D, scr, kb, nb, F.lane, [&](int n) -> const float* {
                    int src; if (n < 416) src = 384 + ropedim(n - 384); else if (n < 424) src = 1952 + (n - 416); else src = -1;
                    return src < 0 ? nullptr : w_in + src; });
            }
            if (!(dummy && (PROBE_VAR == 1 || PROBE_VAR == 3 || PROBE_VAR == 4))) {
                for (int o = gw * 64 + F.lane; o < 768 * QLORA; o += NGW * 64) { const int cb = o >> 13, rem = o & 8191, ks = rem >> 9, ln = (rem >> 3) & 63, e = rem & 7;
                    const int n = cb * 32 + up::nloc(ln & 31), k = 16 * ks + 8 * (ln >> 5) + e, hh = n / MQK, jj = n % MQK, sc = hh * MQK + (jj < 64 ? jj : 64 + ropedim(jj - 64));
                    Wq_t[o] = (bf16)f2bf(w_q_up[(size_t)k * 768 + sc] * g_q_lat[k]); }
                for (int o = gw * 64 + F.lane; o < 1024 * KVLORA; o += NGW * 64) { const int cb = o >> 12, rem = o & 4095, ks = rem >> 9, ln = (rem >> 3) & 63, e = rem & 7;
                    const int n = cb * 32 + up::nloc(ln & 31), k = 16 * ks + 8 * (ln >> 5) + e, sc = (n < 512) ? (n >> 6) * 128 + (n & 63) : ((n - 512) >> 6) * 128 + 64 + (n & 63);
                    Wkv_t[o] = (bf16)f2bf(w_kv_up[(size_t)k * 1024 + sc] * g_kv_lat[k]); }
            }
        }
        if (BOTH(0)) GRID_BAR();
    }

    for (int rep = 0; rep < ((PROBE_DUP == 1) ? 2 : 1); ++rep) if (IN(1)) { PHASE_ENV const bool dummy = (PROBE_DUP == 1) && rep == 0; (void)dummy;
        if (F.vcu < 48) { const int idx = F.vcu * 512 + F.tid, b = idx / (6 * D), col = idx % (6 * D); float sm = b_mod[col];
#pragma unroll
            for (int p = 0; p < 16; ++p) sm += MODP[((size_t)p * 4 + b) * (6 * D) + col];
            mod[idx] = sm; }
        LAS float* vg1 = (LAS float*)F.lds; LAS float* vs1 = (LAS float*)(F.lds + 4096);
        for (int grp = F.vcu; grp < T / 64; grp += F.G) {
            const int b = (grp * 64) / SEQ;
            __syncthreads();
            for (int k = F.tid; k < D; k += NWAVES * 64) { float s0 = b_mod[k], s1 = b_mod[D + k];
#pragma unroll
                for (int p = 0; p < 16; ++p) { s0 += MODP[((size_t)p * 4 + b) * (6 * D) + k]; s1 += MODP[((size_t)p * 4 + b) * (6 * D) + D + k]; }
                vs1[k] = s0; vg1[k] = g_mix[k] * (1.f + s1); }
            __syncthreads();
#pragma unroll 2
            for (int rr = 0; rr < 8; ++rr) { const int m = grp * 64 + F.wave * 8 + rr;
                const f32x4* xr = (const f32x4*)(X_IN + (size_t)m * D) + F.lane;
                f32x4 v[4]; float s = 0.f;
#pragma unroll
                for (int j = 0; j < 4; ++j) { v[j] = __builtin_nontemporal_load(xr + 64 * j); s += (v[j].x * v[j].x + v[j].y * v[j].y) + (v[j].z * v[j].z + v[j].w * v[j].w); }
                const float rstd = rsqrtf(wave_sum(s) * (1.f / D) + EPS);
                unsigned long long* o8 = (unsigned long long*)(H + (size_t)m * D) + F.lane;
#pragma unroll
                for (int j = 0; j < 4; ++j) { const int c = 4 * F.lane + 256 * j;
                    const f32x4 g = *(const LAS f32x4*)(vg1 + c), d = *(const LAS f32x4*)(vs1 + c);
                    const f32x4 r = v[j] * rstd * g + d;
                    o8[64 * j] = (unsigned long long)pk2(r.x, r.y) | ((unsigned long long)pk2(r.z, r.w) << 32); } }
        }
        if (BOTH(1)) GRID_BAR();
    }

    for (int rep = 0; rep < ((PROBE_DUP == 2) ? 2 : 1); ++rep) if (IN(2)) { PHASE_ENV const bool dummy = (PROBE_DUP == 2) && rep == 0; (void)dummy;
        pg8::StaticOrder S; S.init(H, Win_t, T, NIN, D, F.G, (int)blockIdx.x);
        EpiInProj E{QLAT, KVLAT, KPE, FQ, GATES, LOGF, SSQQ, SSQKV, ROPETAB, b_forget, dummy && (PROBE_VAR == 1), (dummy && PROBE_VAR == 2) ? 0 : (dummy && PROBE_VAR == 3) ? 2 : 1};
        pg8::gemm_phase<EpiInProj, pg8::StaticOrder, true>(F.lds, S, E);
        if (BOTH(2)) GRID_BAR();
    }

    for (int rep = 0; rep < ((PROBE_DUP == 3) ? 2 : 1); ++rep) if (IN(3)) { PHASE_ENV const bool dummy = (PROBE_DUP == 3) && rep == 0; (void)dummy;
        if (!(dummy && (PROBE_VAR == 2 || PROBE_VAR == 3))) {
            const int bb = F.vcu & 3; float mx = 0.f, mq = 0.f;
            for (int r = (F.vcu >> 2) * NWAVES + F.wave; r < SEQ; r += (F.G >> 2) * NWAVES) { f32x4 k0, k1, q0v, q1v; unpack8(*(const u32x4*)(FK + ((size_t)bb * SEQ + r) * 512 + 8 * F.lane), k0, k1);
                unpack8(*(const u32x4*)(FQ + ((size_t)bb * SEQ + r) * 512 + 8 * F.lane), q0v, q1v);
                float sq = (k0[0] * k0[0] + k0[1] * k0[1]) + (k0[2] * k0[2] + k0[3] * k0[3]) + (k1[0] * k1[0] + k1[1] * k1[1]) + (k1[2] * k1[2] + k1[3] * k1[3]);
                float sqq = (q0v[0] * q0v[0] + q0v[1] * q0v[1]) + (q0v[2] * q0v[2] + q0v[3] * q0v[3]) + (q1v[0] * q1v[0] + q1v[1] * q1v[1]) + (q1v[2] * q1v[2] + q1v[3] * q1v[3]);
                sq += dppf<0xB1>(sq); sq += dppf<0x4E>(sq); sq += dppf<0x141>(sq);
                sqq += dppf<0xB1>(sqq); sqq += dppf<0x4E>(sqq); sqq += dppf<0x141>(sqq);
                mx = fmaxf(mx, sq); mq = fmaxf(mq, sqq); }
            LAS float* kml = (LAS float*)F.lds;
            if ((F.lane & 7) == 0) { kml[F.wave * 8 + (F.lane >> 3)] = mx; kml[64 + F.wave * 8 + (F.lane >> 3)] = mq; }
            __syncthreads();
            if (F.tid < 2 * NHEAD) { const int hh = F.tid & 7, qk = F.tid >> 3; float m2 = 0.f;
#pragma unroll
                for (int w = 0; w < NWAVES; ++w) m2 = fmaxf(m2, kml[qk * 64 + w * 8 + hh]);
                atomicMax((unsigned*)(ctl + CW_KM + qk * 32 + bb * NHEAD + hh), __float_as_uint(m2)); }
            __syncthreads();
        }
        if (F.vcu < NB * NHEAD && !(dummy && (PROBE_VAR == 1 || PROBE_VAR == 3))) {
            const int b = F.vcu >> 3, h = F.vcu & 7; const float* src = LOGF + ((size_t)b * SEQ + 8 * F.tid) * 8 + h;
            float v[8]; float run = 0.f;
#pragma unroll
            for (int i = 0; i < 8; ++i) v[i] = src[i * 8];
#pragma unroll
            for (int i = 0; i < 8; ++i) { run += v[i]; v[i] = run; }
            float incl = run;
#pragma unroll
            for (int o = 1; o < 64; o <<= 1) { const float n = __shfl_up(incl, o); if (F.lane >= o) incl += n; }
            LAS float* wt = (LAS float*)F.lds;
            if (F.lane == 63) wt[F.wave] = incl;
            __syncthreads();
            float woff = 0.f;
#pragma unroll
            for (int w = 0; w < NWAVES; ++w) woff += (w < F.wave) ? wt[w] : 0.f;
            const float excl = woff + incl - run;
            float* dst = CUMF + ((size_t)b * NHEAD + h) * SEQ + 8 * F.tid;
            *(f32x4*)dst = (f32x4){v[0] + excl, v[1] + excl, v[2] + excl, v[3] + excl}; *(f32x4*)(dst + 4) = (f32x4){v[4] + excl, v[5] + excl, v[6] + excl, v[7] + excl};
            __syncthreads();
        }
        if (!(dummy && (PROBE_VAR == 1 || PROBE_VAR == 2))) up::up_phase(F.lds, QLAT, KVLAT, Wq_t, Wkv_t, SSQQ, SSQKV, ROPETAB, QMLA, KN, VM, F.G, (int)blockIdx.x);
        if (BOTH(3)) GRID_BAR();
    }

    for (int rep = 0; rep < ((PROBE_DUP == 4) ? 2 : 1); ++rep) if (IN(4)) { PHASE_ENV const bool dummy = (PROBE_DUP == 4) && rep == 0; (void)dummy;
        {
            const bool xq = (F.G % 8) == 0; const int x = xq ? (int)(blockIdx.x & 7) : 0, nunits = xq ? 128 : 1024;
            gu32* qh = ctl + CW_Q + 64 * x + (dummy ? 16 : 0);
            volatile LAS unsigned* qw = (volatile LAS unsigned*)(F.lds + MISC_OFF + 64);
            for (;;) {
                if (F.tid == 0) qw[0] = __hip_atomic_fetch_add(qh, 1u, RLX_AGENT);
                __syncthreads();
                const int r = (int)qw[0];
                if (r >= nunits) break;
                int qb, type, b, h;
                if (xq) { qb = 15 - (r >> 3); type = (r >> 2) & 1; b = r & 3; h = (x + 3 * b) & 7; }
                else { qb = 15 - (r >> 6); type = (r >> 5) & 1; b = (r >> 3) & 3; h = r & 7; }
                if (type == 0) { if (ATT_TUNED_FOX && qb != 0) att::attn_unit_t<64, true, 8>(b, h, qb, FQ, 512, FK, KPE, FV, CUMF, __uint_as_float(__hip_atomic_load((unsigned*)(ctl + CW_KM + b * NHEAD + h), RLX_AGENT)) * __uint_as_float(__hip_atomic_load((unsigned*)(ctl + CW_KM + 32 + b * NHEAD + h), RLX_AGENT)), (bf16*)((unsigned char*)(dummy ? (bf16*)((unsigned char*)out + 4 * MiB) : OCAT) + 512), D, F.lds);
                                 else att::attn_unit<64, true, 8>(b, h, qb, FQ, 512, FK, KPE, FV, CUMF, (bf16*)((unsigned char*)(dummy ? (bf16*)((unsigned char*)out + 4 * MiB) : OCAT) + 512), D, F.lds); }
                else { if (ATT_TUNED_MLA && qb != 0) att::attn_unit_t<96, false, 8>(b, h, qb, QMLA, 768, KN, KPE, VM, nullptr, 0.f, dummy ? (bf16*)((unsigned char*)out + 4 * MiB) : OCAT, D, F.lds);
                       else att::attn_unit<96, false, 8>(b, h, qb, QMLA, 768, KN, KPE, VM, nullptr, dummy ? (bf16*)((unsigned char*)out + 4 * MiB) : OCAT, D, F.lds); }
            }
        }
        if (BOTH(4)) GRID_BAR();
    }

    for (int rep = 0; rep < ((PROBE_DUP == 5) ? 2 : 1); ++rep) if (IN(5)) { PHASE_ENV const bool dummy = (PROBE_DUP == 5) && rep == 0; (void)dummy;
        pg8::StaticOrder S; S.init(OCAT, Wom_t, T, D, D / 2, F.G, (int)blockIdx.x);
        EpiMergedCat E{GATES, (unsigned char*)MERGED, 1.f / WSCALE8};
        pg8::gemm_phase<EpiMergedCat, pg8::StaticOrder, true, true>(F.lds, S, E);
        if (BOTH(5)) GRID_BAR();
    }

    for (int rep = 0; rep < ((PROBE_DUP == 6) ? 2 : 1); ++rep) if (IN(6)) { PHASE_ENV const bool dummy = (PROBE_DUP == 6) && rep == 0; (void)dummy;
        pg8::StaticOrder S; S.init(MERGED, Wout_t, T, D, D / 2, F.G, (int)blockIdx.x);
        EpiOut E{X_IN, out, mod, SSQ1, 1.f / (OSCALE8 * WSCALE8)};
        pg8::gemm_phase<EpiOut, pg8::StaticOrder, true, true>(F.lds, S, E);
        if (BOTH(6)) GRID_BAR();
    }

    for (int rep = 0; rep < ((PROBE_DUP == 7) ? 2 : 1); ++rep) if (IN(7)) { PHASE_ENV const bool dummy = (PROBE_DUP == 7) && rep == 0; (void)dummy;
        LAS unsigned char* wrl = F.lds;
        LAS float* vg = (LAS float*)(F.lds + LDSCTL_OFF + 6144);
        LAS float* vs = (LAS float*)(F.lds + LDSCTL_OFF + 10240);
        LAS float* stg = (LAS float*)(F.lds) + F.wave * 512;
        LAS int* cntw = (LAS int*)(F.lds + 16384);
        LAS int* basel = (LAS int*)(F.lds + 16384 + 2048);
        static_assert(LDSCTL_OFF + 10240 + 4096 <= LDS_BYTES && MOETAB_OFF + 4700 <= LDSCTL_OFF + 6144, "P7 LDS map");
        const float my_bias = b_router[F.lane];
        for (int grp = F.vcu; grp < T / 64; grp += F.G) {
            const int b = (grp * 64) / SEQ;
            __syncthreads();
#pragma unroll
            for (int i = 0; i < 16; ++i) __builtin_amdgcn_global_load_lds((const unsigned*)((const char*)Wr_f + (F.wave * 16 + i) * 1024 + F.lane * 16), (LAS unsigned*)(wrl + (F.wave * 16 + i) * 1024), 16, 0, 0);
            for (int i = F.tid; i < D; i += NWAVES * 64) { vg[i] = g_ffn[i] * (1.f + mod[(size_t)b * 6 * D + 4 * D + i]); vs[i] = mod[(size_t)b * 6 * D + 3 * D + i]; }
            const int t0 = grp * 64 + F.wave * 8;
            float rs_mine;
            { const float* sp = SSQ1 + (size_t)(t0 + (F.lane & 7)) * 16; const f32x4 a = *(const f32x4*)sp, b4 = *(const f32x4*)(sp + 4), c4 = *(const f32x4*)(sp + 8), d4 = *(const f32x4*)(sp + 12);
              const float ssum = (((a[0] + a[1]) + (a[2] + a[3])) + ((b4[0] + b4[1]) + (b4[2] + b4[3]))) + (((c4[0] + c4[1]) + (c4[2] + c4[3])) + ((d4[0] + d4[1]) + (d4[2] + d4[3])));
              rs_mine = rsqrtf(ssum * (1.f / D) + EPS); }
            VM_WAIT(); __syncthreads();
            const int r16 = F.lane & 15, kg = F.lane >> 4, myrow = t0 + (r16 & 7);
            const float* xrow = out + (size_t)myrow * D + 8 * kg;
            f32x4 lacc[4] = {{0.f, 0.f, 0.f, 0.f}, {0.f, 0.f, 0.f, 0.f}, {0.f, 0.f, 0.f, 0.f}, {0.f, 0.f, 0.f, 0.f}};
            f32x4 xq[16][2];
#pragma unroll
            for (int p = 0; p < 16; ++p) { xq[p][0] = *(const f32x4*)(xrow + 32 * p); xq[p][1] = *(const f32x4*)(xrow + 32 * p + 4); }
            for (int j4 = 0; j4 < 32; j4 += 16) {
#pragma unroll
                for (int p = 0; p < 16; ++p) { const int j = j4 + p, k = 32 * j + 8 * kg;
                    const f32x4 x0 = xq[p][0], x1v = xq[p][1];
                    if (j4 + 16 < 32) { xq[p][0] = *(const f32x4*)(xrow + 32 * (j + 16)); xq[p][1] = *(const f32x4*)(xrow + 32 * (j + 16) + 4); }
                    const f32x4 g0 = *(const LAS f32x4*)(vg + k), g1 = *(const LAS f32x4*)(vg + k + 4), s0 = *(const LAS f32x4*)(vs + k), s1 = *(const LAS f32x4*)(vs + k + 4);
                    const f32x4 h0 = x0 * rs_mine * g0 + s0, h1 = x1v * rs_mine * g1 + s1;
                    const u32x4 hw = pack8(h0, h1);
                    f32x4 a0, a1; unpack8(hw, a0, a1);
                    const u32x4 lw = pack8(h0 - a0, h1 - a1);
                    if (r16 < 8) { u32x2 h8; int p_ = __builtin_amdgcn_cvt_pk_fp8_f32(h0[0], h0[1], 0, false); p_ = __builtin_amdgcn_cvt_pk_fp8_f32(h0[2], h0[3], p_, true); h8.x = (unsigned)p_;
                        p_ = __builtin_amdgcn_cvt_pk_fp8_f32(h1[0], h1[1], 0, false); p_ = __builtin_amdgcn_cvt_pk_fp8_f32(h1[2], h1[3], p_, true); h8.y = (unsigned)p_;
                        *(u32x2*)(H8 + (size_t)myrow * D + k) = h8; }
                    const bf16x8 Ah = __builtin_bit_cast(bf16x8, hw), Al = __builtin_bit_cast(bf16x8, lw);
#pragma unroll
                    for (int ntl = 0; ntl < 4; ++ntl) { const bf16x8 Wf = *(const LAS bf16x8*)(wrl + ((j * 4 + ntl) * 64 + F.lane) * 16);
                        lacc[ntl] = __builtin_amdgcn_mfma_f32_16x16x32_bf16(Wf, Ah, lacc[ntl], 0, 0, 0);
                        lacc[ntl] = __builtin_amdgcn_mfma_f32_16x16x32_bf16(Wf, Al, lacc[ntl], 0, 0, 0); } }
            }
            __syncthreads();
            if (r16 < 8) {
#pragma unroll
                for (int ntl = 0; ntl < 4; ++ntl) *(LAS f32x4*)(stg + r16 * 64 + 16 * ntl + 4 * kg) = lacc[ntl]; }
            LDS_WAIT();
            int cnt = 0; unsigned selbits = 0u, selks = 0u;
            for (int j = 0; j < 8; ++j) {
                const float logit = stg[j * 64 + F.lane];
                const float sc = 1.f / (1.f + expf(-logit));
                const float ch = sc + my_bias;
                const float m1 = max8(ch);
                const unsigned long long eq = __ballot(ch == m1);
                const unsigned gm = (unsigned)(eq >> (F.lane & ~7)) & 0xffu;
                const int first = __builtin_ctz(gm);
                const float c2 = max8(((F.lane & 7) == first) ? -INFINITY : ch);
                const float gs = m1 + c2; const int myg = F.lane >> 3;
                int rank = 0;
#pragma unroll
                for (int g = 0; g < 8; ++g) { const float o = __builtin_bit_cast(float, __builtin_amdgcn_readlane(__builtin_bit_cast(int, gs), 8 * g)); rank += (o > gs || (o == gs && g < myg)) ? 1 : 0; }
                float mc = (rank < 4) ? ch : -1e30f;
                int selk = -1;
#pragma unroll
                for (int k = 0; k < TOPK; ++k) { const float mx = wave_max_f(mc); const unsigned long long bl = __ballot(mc == mx); const int fl = __builtin_ctzll(bl);
                    if (F.lane == fl) { selk = k; mc = -INFINITY; } }
                const float ssum = wave_sum_f(selk >= 0 ? sc : 0.f);
                if (selk >= 0) { const int t = t0 + j; EIDX[(size_t)t * 8 + selk] = (unsigned char)F.lane; GATEW[(size_t)t * 8 + selk] = sc / ssum * 2.5f; ++cnt; selbits |= 1u << j; selks |= (unsigned)selk << (3 * j); }
            }
            cntw[F.wave * 64 + F.lane] = cnt;
            __syncthreads();
            if (F.wave == 0) { int tot = 0;
#pragma unroll
                for (int w = 0; w < 8; ++w) tot += cntw[w * 64 + F.lane];
                basel[F.lane] = (int)__hip_atomic_fetch_add((unsigned*)(ctl + (dummy ? CW_CNT + 2048 : CW_CNT) + 16 * F.lane), (unsigned)tot, RLX_AGENT); }
            __syncthreads();
            int pos = basel[F.lane];
            for (int w = 0; w < F.wave; ++w) pos += cntw[w * 64 + F.lane];
#pragma unroll
            for (int j = 0; j < 8; ++j) if ((selbits >> j) & 1u) { const int k = (selks >> (3 * j)) & 7, t = t0 + j;
                LIST[(size_t)F.lane * LISTCAP + pos] = (unsigned short)t;
                META[(size_t)F.lane * LISTCAP + pos] = (u32x2){(unsigned)(t * (TOPK + 1) + k), __float_as_uint(GATEW[(size_t)t * 8 + k])}; ++pos; }
        }
        __syncthreads();
        if (BOTH(7)) GRID_BAR();
    }

    volatile LAS int* tab = (volatile LAS int*)(F.lds + MOETAB_OFF);
    if (IN(8) || IN(9)) {
        __syncthreads();
        if (F.wave == 0) {
            const int n = (int)__hip_atomic_load((unsigned*)(ctl + CW_CNT + 16 * F.lane), RLX_AGENT);
            const int tiles = (n + 255) >> 8; int incl = tiles;
#pragma unroll
            for (int o = 1; o < 64; o <<= 1) { const int v = __shfl_up(incl, o); if (F.lane >= o) incl += v; }
            tab[F.lane] = incl - tiles; tab[66 + F.lane] = n;
            if (F.lane == 63) { tab[64] = incl; tab[65] = incl + T / 256; tab[66 + 64] = T; }
        }
        __syncthreads();
        { const int ti = F.tid; int e = 0;
          for (int q = 0; q <= NEXP; ++q) if (tab[q] <= ti) e = q;
          tab[132 + ti] = e; }
        __syncthreads();
    }
    for (int rep = 0; rep < ((PROBE_DUP == 8) ? 2 : 1); ++rep) if (IN(8)) { PHASE_ENV const bool dummy = (PROBE_DUP == 8) && rep == 0; (void)dummy;
        MoeOrder<2, true> S{(const char*)H8, (const char*)Wgu8, (const char*)Wsgu8, D / 2, (size_t)512 * D, LIST, tab, F.G, (int)blockIdx.x};
        EpiHb E{(unsigned char*)HB, 1.f / WSCALE8};
        pg8::gemm_phase<EpiHb, MoeOrder<2, true>, true, true>(F.lds, S, E);
        if (BOTH(8)) GRID_BAR();
    }
    for (int rep = 0; rep < ((PROBE_DUP == 9) ? 2 : 1); ++rep) if (IN(9)) { PHASE_ENV const bool dummy = (PROBE_DUP == 9) && rep == 0; (void)dummy;
        if (dummy && PROBE_VAR == 1) dn::down_phase<true>(F.lds, (const unsigned char*)HB, (const unsigned char*)Wd_t, (const unsigned char*)Wsd_t, tab, META, (unsigned char*)Y, (unsigned char*)(ws + WS_CTL + 900 * 1024), F.G, (int)blockIdx.x);
        else dn::down_phase<false>(F.lds, (const unsigned char*)HB, (const unsigned char*)Wd_t, (const unsigned char*)Wsd_t, tab, META, (unsigned char*)Y, (unsigned char*)(ws + WS_CTL + 900 * 1024), F.G, (int)blockIdx.x);
        if (BOTH(9)) GRID_BAR();
    }

    for (int rep = 0; rep < ((PROBE_DUP == 10) ? 2 : 1); ++rep) if (IN(10)) { PHASE_ENV const bool dummy = (PROBE_DUP == 10) && rep == 0; (void)dummy;
        int ln10 = F.lane; asm volatile("" : "+v"(ln10));
        for (int m = gw; m < T; m += NGW) {
            const int b = m / SEQ; const float* gf = mod + (size_t)b * 6 * D + 5 * D;
            f32x4* xr = (f32x4*)(out + (size_t)m * D) + ln10;
            f32x4* xw = dummy ? (f32x4*)((float*)HB + (size_t)m * D) + ln10 : xr;
            f32x4 v[4]; float s = 0.f;
#pragma unroll
            for (int j = 0; j < 4; ++j) { const int c = 4 * ln10 + 256 * j;
                f32x4 y = {0.f, 0.f, 0.f, 0.f};
#pragma unroll
                for (int k = 0; k < TOPK + 1; ++k) { const int w = __builtin_nontemporal_load((const int*)((const unsigned char*)Y + ((size_t)m * (TOPK + 1) + k) * D + c));
                    const f32x2 lo = __builtin_amdgcn_cvt_pk_f32_fp8(w, false), hi2 = __builtin_amdgcn_cvt_pk_f32_fp8(w, true);
                    y += (f32x4){lo.x, lo.y, hi2.x, hi2.y}; }
                v[j] = __builtin_nontemporal_load(xr + 64 * j) + *(const f32x4*)(gf + c) * y;
                s += (v[j].x * v[j].x + v[j].y * v[j].y) + (v[j].z * v[j].z + v[j].w * v[j].w); }
            const float rstd = rsqrtf(wave_sum(s) * (1.f / D) + EPS);
#pragma unroll
            for (int j = 0; j < 4; ++j) __builtin_nontemporal_store(v[j] * rstd * *(const f32x4*)(g_final + 4 * ln10 + 256 * j), xw + 64 * j);
        }
    }
#undef IN
#undef BOTH
#undef GRID_BAR
}

constexpr int NPHASE = 11;
extern "C" void kernel_launch(void* const* d_in, const int* in_sizes, int n_in, void* d_out, int out_size, void* d_ws, size_t ws_size, hipStream_t stream) {
    static int grid = 0;
    if (grid == 0) {
        if (n_in != 25 || out_size != T * D || ws_size < WS_END) { fprintf(stderr, "kernel_launch: unexpected shapes (n_in %d out %d ws %zu need %zu)\n", n_in, out_size, ws_size, (size_t)WS_END); grid = -1; return; }
        int dev = 0, cus = 0;
        if (hipGetDevice(&dev) != hipSuccess || hipDeviceGetAttribute(&cus, hipDeviceAttributeMultiprocessorCount, dev) != hipSuccess) { grid = -1; return; }
        if (hipFuncSetAttribute((const void*)fwd, hipFuncAttributeMaxDynamicSharedMemorySize, LDS_BYTES) != hipSuccess) { fprintf(stderr, "kernel_launch: hipFuncSetAttribute failed\n"); grid = -1; return; }
        int per_cu = 0;
        if (hipOccupancyMaxActiveBlocksPerMultiprocessor(&per_cu, (const void*)fwd, NWAVES * 64, LDS_BYTES) != hipSuccess || per_cu < 1) { fprintf(stderr, "kernel_launch: occupancy query says %d\n", per_cu); }
        (void)hipGetLastError();
        grid = cus;
    }
    if (grid < 0) return;
    (void)in_sizes;
    if (hipMemsetAsync((char*)d_ws + WS_CTL, 0, CTL_ZERO_BYTES, stream) != hipSuccess) return;
    Args a{};
    for (int i = 0; i < 25; ++i) a.in[i] = d_in[i];
    a.out = (float*)d_out; a.ws = (unsigned char*)d_ws;
#if MK_ONE_LAUNCH
    a.ph_lo = 0; a.ph_hi = NPHASE;
    hipLaunchKernelGGL(fwd, dim3(grid), dim3(NWAVES * 64), LDS_BYTES, stream, a);
#else
    for (int p = 0; p < NPHASE; ++p) { a.ph_lo = p; a.ph_hi = p + 1; hipLaunchKernelGGL(fwd, dim3(grid), dim3(NWAVES * 64), LDS_BYTES, stream, a); }
#endif
}
```

```cpp
#include <hip/hip_runtime.h>
#include <cstdio>
#include <cstdint>
#include <type_traits>

#ifndef MK_ONE_LAUNCH
#ifndef CONV_A0
#define CONV_A0 28
#endif
#define MK_ONE_LAUNCH 1
#endif

#ifndef PROBE_DUP
#define PROBE_DUP -1
#endif
#ifndef ATT_TUNED_FOX
#define ATT_TUNED_FOX 1
#endif
#ifndef ATT_TUNED_MLA
#define ATT_TUNED_MLA 1
#endif
#ifndef PROBE_VAR
#define PROBE_VAR 0
#endif
#define GAS __attribute__((address_space(1)))
#define LAS __attribute__((address_space(3)))
typedef unsigned short bf16;
typedef short bf16x8 __attribute__((ext_vector_type(8)));
typedef short s16x4 __attribute__((ext_vector_type(4)));
typedef float f32x2 __attribute__((ext_vector_type(2)));
typedef float f32x4 __attribute__((ext_vector_type(4)));
typedef float f32x16 __attribute__((ext_vector_type(16)));
typedef unsigned u32x2 __attribute__((ext_vector_type(2)));
typedef unsigned u32x4 __attribute__((ext_vector_type(4)));
typedef GAS unsigned gu32;
typedef int v8i32_t __attribute__((ext_vector_type(8)));
typedef int v4i32_t __attribute__((ext_vector_type(4)));

constexpr int NB = 4, SEQ = 4096, T = NB * SEQ, D = 1024;
constexpr int NIN = 4096;
constexpr int QLORA = 256, KVLORA = 128, KVPAD = 256, ROPE = 32, NHEAD = 8, HD = 64, MQK = 96;
constexpr int NEXP = 64, TOPK = 6, DEXP = 256;
constexpr float EPS = 1e-6f;
constexpr float LOG2E = 1.4426950408889634f;
constexpr float C2F = 0.125f * LOG2E;
constexpr float C2M = 0.10206207261596577f * LOG2E;
constexpr int LISTCAP = T;
constexpr float HSCALE8 = 8.f;
constexpr float OSCALE8 = 8.f;
constexpr float WSCALE8 = 64.f;

constexpr size_t MiB = 1u << 20;
constexpr size_t WS_CTL = 0, CTL_ZERO_BYTES = 1 * MiB;
constexpr size_t WS_EIDX = 262144, WS_GATEW = 393216;
constexpr size_t WS_WIN = 1 * MiB, WS_WQ = 9 * MiB, WS_WKV = 9 * MiB + 512 * 1024, WS_WOM = 10 * MiB, WS_WOF = 11 * MiB, WS_WOUT = 12 * MiB;
constexpr size_t WS_WSGU = 14 * MiB, WS_WSD = 15 * MiB, WS_WR = 15 * MiB + 512 * 1024, WS_MOD = 15 * MiB + 640 * 1024;
constexpr size_t WS_WD = 16 * MiB;
constexpr size_t WS_HB = 48 * MiB;
constexpr size_t WS_FQ = 48 * MiB, WS_FK = 64 * MiB, WS_FV = 80 * MiB, WS_QLAT = 96 * MiB, WS_KVLAT = 104 * MiB;
constexpr size_t WS_OFOX = WS_FQ, WS_OMLA = WS_QLAT;
static_assert(WS_FK - WS_FQ == (size_t)T * 512 * 2 && WS_FV - WS_FK == (size_t)T * 512 * 2, "fq|fk|fv contiguous");
constexpr size_t WS_Y = 112 * MiB;
constexpr size_t WS_WGU = 112 * MiB;
constexpr size_t WS_H = 176 * MiB;
constexpr size_t WS_QMLA = WS_H;
constexpr size_t WS_GATES = 208 * MiB;
constexpr size_t WS_KN = 272 * MiB, WS_VM = 288 * MiB, WS_KPE = 304 * MiB;
constexpr size_t WS_MERGED = WS_KN;
constexpr size_t WS_LIST = 304 * MiB;
constexpr size_t WS_END = 306 * MiB;
constexpr size_t DO_MODP = 4 * MiB;
constexpr size_t DO_ROPE = 0, DO_LOGF = 2 * MiB, DO_CUMF = 2 * MiB + 512 * 1024, DO_SSQQ = 3 * MiB, DO_SSQKV = 3 * MiB + 256 * 1024;

constexpr int CW_TMO = 0;
constexpr int CW_BAR = 4096;
constexpr int CW_CNT = 8192;
constexpr int CW_KM = 12288;
constexpr int CW_Q = 12544;

constexpr int RING_BYTES = 131072;
constexpr int LDSCTL_OFF = RING_BYTES;
constexpr int MISC_OFF = LDSCTL_OFF + 320;
constexpr int MOETAB_OFF = LDSCTL_OFF + 1024;
constexpr int LDS_BYTES = 147456;

constexpr int NWAVES = 8;

#define LDS_WAIT() asm volatile("s_waitcnt lgkmcnt(0)" ::: "memory")
#define VM_WAIT() asm volatile("s_waitcnt vmcnt(0)" ::: "memory")
#define RLX_AGENT __ATOMIC_RELAXED, __HIP_MEMORY_SCOPE_AGENT
__device__ __forceinline__ unsigned f2bf(float f) { unsigned u = __builtin_bit_cast(unsigned, f); return (u + 0x7fffu + ((u >> 16) & 1u)) >> 16; }
__device__ __forceinline__ float bf2f(unsigned h) { return __builtin_bit_cast(float, h << 16); }
__device__ __forceinline__ unsigned pk2(float lo, float hi) { return f2bf(lo) | (f2bf(hi) << 16); }
__device__ __forceinline__ unsigned cvt_pk_bf16(float lo, float hi) { unsigned r; asm volatile("v_cvt_pk_bf16_f32 %0, %1, %2" : "=v"(r) : "v"(lo), "v"(hi)); return r; }
__device__ __forceinline__ u32x4 pack8(f32x4 a, f32x4 b) { u32x4 w; w.x = cvt_pk_bf16(a[0], a[1]); w.y = cvt_pk_bf16(a[2], a[3]); w.z = cvt_pk_bf16(b[0], b[1]); w.w = cvt_pk_bf16(b[2], b[3]); return w; }
__device__ __forceinline__ void unpack8(u32x4 w, f32x4& a, f32x4& b) {
    a = (f32x4){bf2f(w.x & 0xffffu), bf2f(w.x >> 16), bf2f(w.y & 0xffffu), bf2f(w.y >> 16)};
    b = (f32x4){bf2f(w.z & 0xffffu), bf2f(w.z >> 16), bf2f(w.w & 0xffffu), bf2f(w.w >> 16)};
}
__device__ __forceinline__ float wave_sum(float v) {
#pragma unroll
    for (int o = 1; o < 64; o <<= 1) v += __shfl_xor(v, o);
    return v;
}
__device__ __forceinline__ float wave_max(float v) {
#pragma unroll
    for (int o = 1; o < 64; o <<= 1) v = fmaxf(v, __shfl_xor(v, o));
    return v;
}
template <int CTRL> __device__ __forceinline__ float dppf(float v) { return __builtin_bit_cast(float, __builtin_amdgcn_update_dpp(0, __builtin_bit_cast(int, v), CTRL, 0xf, 0xf, true)); }
__device__ __forceinline__ float max8(float v) { v = fmaxf(v, dppf<0xB1>(v)); v = fmaxf(v, dppf<0x4E>(v)); v = fmaxf(v, dppf<0x141>(v)); return v; }
__device__ __forceinline__ float wave_max_f(float v) { v = max8(v); v = fmaxf(v, dppf<0x140>(v)); v = fmaxf(v, __shfl_xor(v, 16)); v = fmaxf(v, __shfl_xor(v, 32)); return v; }
__device__ __forceinline__ float wave_sum_f(float v) { v += dppf<0xB1>(v); v += dppf<0x4E>(v); v += dppf<0x141>(v); v += dppf<0x140>(v); v += __shfl_xor(v, 16); v += __shfl_xor(v, 32); return v; }
__device__ __forceinline__ float sigmoidf_(float x) { return __builtin_amdgcn_rcpf(1.f + __builtin_amdgcn_exp2f(-LOG2E * x)); }
__device__ __forceinline__ float siluf_(float x) { return x * __builtin_amdgcn_rcpf(1.f + __builtin_amdgcn_exp2f(-LOG2E * x)); }

namespace pg8 {
constexpr int BM = 256, BK = 64, HALF = 128, HTB = HALF * BK * 2, NXCD = 8, WGM = 8;
__host__ __device__ __forceinline__ int lds_byte(int r, int c) { const int st = (r >> 4) * 2 + (c >> 5), rr = r & 15, cc = c & 31, ob = rr * 64 + cc * 2; return st * 1024 + (ob ^ (((ob >> 9) & 1) << 5)); }
__host__ __device__ __forceinline__ void stage_rc(int b, int& R, int& C) { const int st = b / 1024, sb = b % 1024, swz = sb ^ (((sb >> 9) & 1) << 5); R = (st >> 1) * 16 + swz / 64; C = (st & 1) * 32 + (swz % 64) / 2; }
__host__ __device__ __forceinline__ int perm32(int rho) { const int n = rho >> 4, i = rho & 15; return 8 * (i >> 2) + 4 * n + (i & 3); }

struct Unit { int pm, pn, e, aux, n; };

struct StaticOrder {
    static constexpr bool GATHER = false;
    const char* A; const char* Bt; int K;
    int nM, nN, nwg, G, c;
    __device__ void init(const void* A_, const void* Bt_, int M, int N, int K_, int G_, int c_) { A = (const char*)A_; Bt = (const char*)Bt_; K = K_; nM = M / BM; nN = N / BM; nwg = nM * nN; G = G_; c = c_; }
    __device__ bool next(int i, Unit& u) const {
        const long L = (long)i * G + c; if (L >= nwg) return false;
        int wgid = (int)L; { const int q = nwg / NXCD, r = nwg % NXCD, xcd = wgid % NXCD, off = wgid / NXCD; wgid = (xcd < r ? xcd * (q + 1) : r * (q + 1) + (xcd - r) * q) + off; }
        const int nig = WGM * nN, gid = wgid / nig, fm = gid * WGM, gsz = (nM - fm) < WGM ? (nM - fm) : WGM;
        u.pm = fm + ((wgid % nig) % gsz); u.pn = (wgid % nig) / gsz; u.e = 0; u.aux = 0; u.n = BM; return true;
    }
    __device__ __forceinline__ const char* a_ptr(const Unit& u) const { return A + (size_t)u.pm * BM * K * 2; }
    __device__ __forceinline__ const char* b_ptr(const Unit& u) const { return Bt + (size_t)u.pn * BM * K * 2; }
    __device__ __forceinline__ unsigned a_row(const Unit&, int r) const { return (unsigned)r; }
};

template <class Epi, class Sched, bool ALIGN_EPI, bool FP8 = false>
__device__ __forceinline__ void gemm_phase(LAS unsigned char* lds, const Sched& S, const Epi& E) {
    int tid = threadIdx.x; asm volatile("" : "+v"(tid));
    const int wid = __builtin_amdgcn_readfirstlane(tid >> 6), lane = tid & 63, wr = wid >> 2, wc = wid & 3, fr = lane & 15, fq = lane >> 4;
    const int K = S.K, nt = K / BK;
    unsigned voffB[2], voffA[2];
#pragma unroll
    for (int i = 0; i < 2; ++i) { int R, C; stage_rc(tid * 16 + i * 8192, R, C); const int Rb = (R & ~31) + perm32(R & 31);
        voffA[i] = (unsigned)(R * K + C) * 2u; voffB[i] = (unsigned)(Rb * K + C) * 2u; }
    unsigned vA[2][2], vN[2][2];
    const size_t kstep = (size_t)(BK * 2);
    const size_t hstep = (size_t)HALF * K * 2;
    const unsigned ldsw = (unsigned)wid * 1024u;
    const int aoff = lds_byte(wr * 64 + fr, fq * 8), boff = lds_byte(wc * 32 + fr, fq * 8);
#define PG8_SA(b, h) (((b) * 2 + (h)) * HTB)
#define PG8_SB(b, h) ((4 + (b) * 2 + (h)) * HTB)
#define PG8_STAGE(bufoff, gbase, voff) do { _Pragma("unroll") for (int _i = 0; _i < 2; ++_i) \
        __builtin_amdgcn_global_load_lds((const unsigned*)((const char*)(gbase) + (voff)[_i]), (LAS unsigned*)(lds + (bufoff) + ldsw + _i * 8192), 16, 0, 0); } while (0)
#define PG8_STAGE_A(bufoff, gbase, h, nx) do { if constexpr (Sched::GATHER) { const unsigned vs_[2] = {(nx) ? vN[h][0] : vA[h][0], (nx) ? vN[h][1] : vA[h][1]}; PG8_STAGE(bufoff, gbase, vs_); }     \
        else PG8_STAGE(bufoff, (const char*)(gbase) + (h) * hstep, voffA); } while (0)
#define PG8_LDA(dst, b, h) do { _Pragma("unroll") for (int m = 0; m < 4; ++m) { if constexpr (FP8) { dst##8[m].lo = *(const LAS v4i32_t*)(lds + PG8_SA(b, h) + aoff + m * 2048); dst##8[m].hi = *(const LAS v4i32_t*)(lds + PG8_SA(b, h) + aoff + m * 2048 + 1024); } \
        else { _Pragma("unroll") for (int k = 0; k < 2; ++k) dst[m][k] = *(const LAS bf16x8*)(lds + PG8_SA(b, h) + aoff + m * 2048 + k * 1024); } } } while (0)
#define PG8_LDB(dst, b, h) do { _Pragma("unroll") for (int n = 0; n < 2; ++n) { if constexpr (FP8) { dst##8[n].lo = *(const LAS v4i32_t*)(lds + PG8_SB(b, h) + boff + n * 2048); dst##8[n].hi = *(const LAS v4i32_t*)(lds + PG8_SB(b, h) + boff + n * 2048 + 1024); } \
        else { _Pragma("unroll") for (int k = 0; k < 2; ++k) dst[n][k] = *(const LAS bf16x8*)(lds + PG8_SB(b, h) + boff + n * 2048 + k * 1024); } } } while (0)
#define PG8_MMA(ai, bj, At, Bt) do { __builtin_amdgcn_s_setprio(1); _Pragma("unroll") for (int m = 0; m < 4; ++m) _Pragma("unroll") for (int n = 0; n < 2; ++n) { \
        if constexpr (FP8) asm volatile("v_mfma_scale_f32_16x16x128_f8f6f4 %0, %1, %2, %0, %3, %3 op_sel_hi:[0,0,0]" : "+v"(acc[ai][bj][m][n]) : "v"(Bt##8[n]), "v"(At##8[m]), "v"(sc1_));     \
        else { _Pragma("unroll") for (int k = 0; k < 2; ++k) acc[ai][bj][m][n] = __builtin_amdgcn_mfma_f32_16x16x32_bf16(Bt[n][k], At[m][k], acc[ai][bj][m][n], 0, 0, 0); } } \
        __builtin_amdgcn_s_setprio(0); } while (0)
#define PG8_WAIT_V(n) asm volatile("s_waitcnt vmcnt(" #n ")" ::: "memory")
#define PG8_WAIT_L(n) asm volatile("s_waitcnt lgkmcnt(" #n ")" ::: "memory")
#define PG8_BAR __builtin_amdgcn_s_barrier()
#define PG8_SCHED __builtin_amdgcn_sched_barrier(0)
#define PG8_SETV(dst, u) do { _Pragma("unroll") for (int _h = 0; _h < 2; ++_h) _Pragma("unroll") for (int _i = 0; _i < 2; ++_i) { int R_, C_; stage_rc(tid * 16 + _i * 8192, R_, C_); \
        dst[_h][_i] = (S.a_row(u, _h * HALF + R_) * (unsigned)K + (unsigned)C_) * 2u; } } while (0)
    Unit cur, nxt; int ui = 0;
    if (!S.next(0, cur)) return;
    f32x4 acc[2][2][4][2];
#define PG8_ZERO() do { _Pragma("unroll") for (int a = 0; a < 2; ++a) _Pragma("unroll") for (int b = 0; b < 2; ++b) _Pragma("unroll") for (int m = 0; m < 4; ++m) _Pragma("unroll") for (int n = 0; n < 2; ++n) { \
        if constexpr (FP8) asm volatile("v_mov_b32 %0, 0\n\tv_mov_b32 %1, 0\n\tv_mov_b32 %2, 0\n\tv_mov_b32 %3, 0" : "=v"(acc[a][b][m][n][0]), "=v"(acc[a][b][m][n][1]), "=v"(acc[a][b][m][n][2]), "=v"(acc[a][b][m][n][3])); \
        else acc[a][b][m][n] = (f32x4){0.f, 0.f, 0.f, 0.f}; } } while (0)
    PG8_ZERO();
    unsigned sc1_ = 0x7f7f7f7fu; asm volatile("" : "+v"(sc1_));
    (void)sc1_;
    bf16x8 At[4][2], B0[2][2], B1[2][2];
    v8i32_t At8[4], B08[2], B18[2];
    (void)At; (void)B0; (void)B1; (void)At8; (void)B08; (void)B18;
    const char* cA = S.a_ptr(cur); const char* cB = S.b_ptr(cur);
    if constexpr (Sched::GATHER) { PG8_SETV(vA, cur); }
    PG8_STAGE(PG8_SB(0, 0), cB, voffB); PG8_STAGE(PG8_SB(0, 1), cB + hstep, voffB); PG8_STAGE_A(PG8_SA(0, 0), cA, 0, false); PG8_STAGE_A(PG8_SA(0, 1), cA, 1, false);
    if (wr == 1) PG8_BAR;
    PG8_WAIT_V(2); PG8_BAR;
    PG8_STAGE(PG8_SB(1, 0), cB + kstep, voffB); PG8_STAGE_A(PG8_SA(1, 0), cA + kstep, 0, false); PG8_STAGE(PG8_SB(1, 1), cB + hstep + kstep, voffB);
    PG8_WAIT_V(6); PG8_BAR;
    for (;;) {
        const bool has_next = S.next(ui + 1, nxt);
        const char* nA = has_next ? S.a_ptr(nxt) : cA; const char* nB = has_next ? S.b_ptr(nxt) : cB;
        if constexpr (Sched::GATHER) { if (has_next) { PG8_SETV(vN, nxt); } else {
#pragma unroll
            for (int h = 0; h < 2; ++h)
#pragma unroll
                for (int i = 0; i < 2; ++i) vN[h][i] = vA[h][i]; } }
        for (int t = 0; t < nt; t += 2) {
            const bool last = (t == nt - 2);
            if constexpr (Epi::MIDK) { if (t == nt / 2) E.mid(acc, cur, wr, wc, fr, fq); }
            const char* a1 = cA + (size_t)(t + 1) * kstep;
            const char* a2 = last ? nA : cA + (size_t)(t + 2) * kstep; const char* b2 = last ? nB : cB + (size_t)(t + 2) * kstep;
            const char* a3 = a2 + kstep; const char* b3 = b2 + kstep;
            PG8_LDB(B0, 0, 0); PG8_LDB(B1, 0, 1); PG8_SCHED; PG8_LDA(At, 0, 0); PG8_STAGE_A(PG8_SA(1, 1), a1, 1, false);
            PG8_WAIT_V(8); PG8_WAIT_L(0); PG8_BAR; PG8_MMA(0, 0, At, B0); PG8_MMA(0, 1, At, B1); PG8_BAR; PG8_SCHED;
            PG8_LDA(At, 0, 1); PG8_STAGE(PG8_SB(0, 0), b2, voffB); PG8_STAGE(PG8_SB(0, 1), b2 + hstep, voffB); PG8_STAGE_A(PG8_SA(0, 0), a2, 0, last);
            PG8_WAIT_V(8); PG8_WAIT_L(0); PG8_BAR; PG8_MMA(1, 0, At, B0); PG8_MMA(1, 1, At, B1); PG8_BAR; PG8_SCHED;
            PG8_LDB(B0, 1, 0); PG8_LDB(B1, 1, 1); PG8_SCHED; PG8_LDA(At, 1, 0); PG8_STAGE_A(PG8_SA(0, 1), a2, 1, last);
            PG8_WAIT_V(8); PG8_WAIT_L(0); PG8_BAR; PG8_MMA(0, 0, At, B0); PG8_MMA(0, 1, At, B1); PG8_BAR; PG8_SCHED;
            PG8_LDA(At, 1, 1); PG8_STAGE(PG8_SB(1, 0), b3, voffB); PG8_STAGE(PG8_SB(1, 1), b3 + hstep, voffB); PG8_STAGE_A(PG8_SA(1, 0), a3, 0, last);
            PG8_WAIT_V(8); PG8_WAIT_L(0); PG8_BAR; PG8_MMA(1, 0, At, B0); PG8_MMA(1, 1, At, B1); PG8_BAR; PG8_SCHED;
        }
        if constexpr (ALIGN_EPI) { if (wr == 0) PG8_BAR; }
        if constexpr (FP8) { asm volatile("s_nop 15\n\ts_nop 7" ::: "memory"); __builtin_amdgcn_sched_barrier(0); }
        E(acc, cur, wr, wc, fr, fq);
        if (!has_next) break;
        PG8_ZERO();
        cur = nxt; cA = nA; cB = nB; ++ui;
        if constexpr (Sched::GATHER) {
#pragma unroll
            for (int h = 0; h < 2; ++h)
#pragma unroll
                for (int i = 0; i < 2; ++i) vA[h][i] = vN[h][i]; }
        if constexpr (ALIGN_EPI) { if (wr == 1) PG8_BAR; }
    }
    PG8_WAIT_V(0);
    if constexpr (!ALIGN_EPI) { if (wr == 0) PG8_BAR; }
    PG8_BAR;
#undef PG8_SA
#undef PG8_SB
#undef PG8_STAGE
#undef PG8_STAGE_A
#undef PG8_LDA
#undef PG8_LDB
#undef PG8_MMA
#undef PG8_ZERO
#undef PG8_WAIT_V
#undef PG8_WAIT_L
#undef PG8_BAR
#undef PG8_SCHED
#undef PG8_SETV
}
}
using pg8::Unit;

#define EPI_ROWS(ai, m) for (int ai = 0; ai < 2; ++ai) for (int m = 0; m < 4; ++m)

struct EpiInProj {
    static constexpr bool MIDK = false;
    bf16 *qlat, *kvlat, *kpe, *fq, *gates; float *logf, *ssqq, *ssqkv; const float* ropetab; const float* bforget; bool skip; int rowmul;
    __device__ __forceinline__ void operator()(const f32x4 (&acc)[2][2][4][2], const Unit& u, int wr, int wc, int fr, int fq_) const {
        if (skip) return;
        const int pn = u.pn, row0 = u.pm * 256 + wr * 64 + fr, c0 = wc * 32 + 8 * fq_;
        if (pn >= 8) {
            bf16* gp = gates + (size_t)(pn - 8) * 256 + c0;
#pragma unroll
            for (int ai = 0; ai < 2; ++ai)
#pragma unroll
                for (int m = 0; m < 4; ++m) { const int row = row0 + ai * 128 + m * 16;
#pragma unroll
                    for (int bj = 0; bj < 2; ++bj) { f32x4 v0 = acc[ai][bj][m][0], v1 = acc[ai][bj][m][1];
#pragma unroll
                        for (int q = 0; q < 4; ++q) { v0[q] = fmaxf(sigmoidf_(v0[q]), 1e-30f); v1[q] = fmaxf(sigmoidf_(v1[q]), 1e-30f); }
                        *(u32x4*)(gp + (size_t)row * 2048 + 128 * bj) = pack8(v0, v1); } }
        } else if (pn >= 2) {
            bf16* dst = fq + (size_t)((pn - 2) >> 1) * ((size_t)T * 512) + (pn & 1) * 256 + c0; const float sc = (pn < 4) ? C2F : 1.f;
#pragma unroll
            for (int ai = 0; ai < 2; ++ai)
#pragma unroll
                for (int m = 0; m < 4; ++m) { const int row = row0 + ai * 128 + m * 16;
#pragma unroll
                    for (int bj = 0; bj < 2; ++bj) *(u32x4*)(dst + (size_t)row * 512 + 128 * bj) = pack8(acc[ai][bj][m][0] * sc, acc[ai][bj][m][1] * sc); }
        } else if (pn == 0) {
#pragma unroll
            for (int ai = 0; ai < 2; ++ai)
#pragma unroll
                for (int m = 0; m < 4; ++m) { const int row = row0 + ai * 128 + m * 16; float s = 0.f;
#pragma unroll
                    for (int bj = 0; bj < 2; ++bj) { const f32x4 v0 = acc[ai][bj][m][0], v1 = acc[ai][bj][m][1];
                        s += (v0[0] * v0[0] + v0[1] * v0[1]) + (v0[2] * v0[2] + v0[3] * v0[3]) + (v1[0] * v1[0] + v1[1] * v1[1]) + (v1[2] * v1[2] + v1[3] * v1[3]);
                        *(u32x4*)(qlat + (size_t)row * QLORA + c0 + 128 * bj) = pack8(v0, v1); }
                    s += __shfl_xor(s, 16); s += __shfl_xor(s, 32);
                    if (fq_ == 0) ssqq[row * 4 + wc] = s; }
        } else {
#pragma unroll
            for (int ai = 0; ai < 2; ++ai)
#pragma unroll
                for (int m = 0; m < 4; ++m) { const int row = row0 + ai * 128 + m * 16;
                    { const f32x4 v0 = acc[ai][0][m][0], v1 = acc[ai][0][m][1];
                      float s = (v0[0] * v0[0] + v0[1] * v0[1]) + (v0[2] * v0[2] + v0[3] * v0[3]) + (v1[0] * v1[0] + v1[1] * v1[1]) + (v1[2] * v1[2] + v1[3] * v1[3]);
                      *(u32x4*)(kvlat + (size_t)row * KVPAD + c0) = pack8(v0, v1);
                      s += __shfl_xor(s, 16); s += __shfl_xor(s, 32);
                      if (fq_ == 0) ssqkv[row * 4 + wc] = s; }
                    { const f32x4 v0 = acc[ai][1][m][0], v1 = acc[ai][1][m][1];
                      *(u32x4*)(kvlat + (size_t)row * KVPAD + 128 + c0) = (u32x4){0u, 0u, 0u, 0u};
                      if (wc == 0) {
                          const f32x4* tb = (const f32x4*)(ropetab + ((size_t)row * 16 + 4 * fq_) * 2);
                          const f32x4 t0 = tb[0], t1 = tb[1];
                          f32x4 o1, o2;
                          o1[0] = v0[0] * t0[0] - v1[0] * t0[1]; o2[0] = v1[0] * t0[0] + v0[0] * t0[1];
                          o1[1] = v0[1] * t0[2] - v1[1] * t0[3]; o2[1] = v1[1] * t0[2] + v0[1] * t0[3];
                          o1[2] = v0[2] * t1[0] - v1[2] * t1[1]; o2[2] = v1[2] * t1[0] + v0[2] * t1[1];
                          o1[3] = v0[3] * t1[2] - v1[3] * t1[3]; o2[3] = v1[3] * t1[2] + v0[3] * t1[3];
                          *(u32x4*)(kpe + (size_t)row * ROPE + 8 * fq_) = pack8(o1, o2);
                      } else if (wc == 1 && fq_ == 0) {
                          f32x4 l0, l1;
#pragma unroll
                          for (int h = 0; h < 4; ++h) { const float z0 = v0[h] + bforget[h], z1 = v1[h] + bforget[4 + h];
                              l0[h] = -__builtin_amdgcn_logf(1.f + __builtin_amdgcn_exp2f(-LOG2E * z0)); l1[h] = -__builtin_amdgcn_logf(1.f + __builtin_amdgcn_exp2f(-LOG2E * z1)); }
                          *(f32x4*)(logf + (size_t)row * 8) = l0; *(f32x4*)(logf + (size_t)row * 8 + 4) = l1;
                      } } }
        }
        (void)rowmul;
    }
};

struct EpiQup {
    static constexpr bool MIDK = false;
    bf16* q; const float* ssqq; const float* ropetab;
    __device__ __forceinline__ void operator()(const f32x4 (&acc)[2][2][4][2], const Unit& u, int wr, int wc, int fr, int fq_) const {
        const int row0 = u.pm * 256 + wr * 64 + fr, c0 = u.pn * 256 + wc * 32 + 8 * fq_;
#pragma unroll
        for (int ai = 0; ai < 2; ++ai)
#pragma unroll
            for (int m = 0; m < 4; ++m) {
                const int row = row0 + ai * 128 + m * 16;
                const f32x4 sq = *(const f32x4*)(ssqq + row * 4);
                const float rs = rsqrtf(((sq[0] + sq[1]) + (sq[2] + sq[3])) * (1.f / QLORA) + EPS) * C2M;
#pragma unroll
                for (int bj = 0; bj < 2; ++bj) {
                    const int col = c0 + 128 * bj, j = col % MQK;
                    f32x4 v0 = acc[ai][bj][m][0] * rs, v1 = acc[ai][bj][m][1] * rs;
                    if (j >= 64) { const int g = (j - 64) >> 3;
                        const f32x4* tb = (const f32x4*)(ropetab + ((size_t)row * 16 + 4 * g) * 2);
                        const f32x4 t0 = tb[0], t1 = tb[1];
                        f32x4 o1, o2;
                        o1[0] = v0[0] * t0[0] - v1[0] * t0[1]; o2[0] = v1[0] * t0[0] + v0[0] * t0[1];
                        o1[1] = v0[1] * t0[2] - v1[1] * t0[3]; o2[1] = v1[1] * t0[2] + v0[1] * t0[3];
                        o1[2] = v0[2] * t1[0] - v1[2] * t1[1]; o2[2] = v1[2] * t1[0] + v0[2] * t1[1];
                        o1[3] = v0[3] * t1[2] - v1[3] * t1[3]; o2[3] = v1[3] * t1[2] + v0[3] * t1[3];
                        v0 = o1; v1 = o2; }
                    *(u32x4*)(q + (size_t)row * 768 + col) = pack8(v0, v1);
                }
            }
    }
};

struct EpiKVup {
    static constexpr bool MIDK = false;
    bf16 *kn, *vm; const float* ssqkv;
    __device__ __forceinline__ void operator()(const f32x4 (&acc)[2][2][4][2], const Unit& u, int wr, int wc, int fr, int fq_) const {
        const int row0 = u.pm * 256 + wr * 64 + fr, c0 = u.pn * 256 + wc * 32 + 8 * fq_;
        bf16* dst = (u.pn < 2) ? kn : vm; const int cb = (u.pn & 1) * 256 + wc * 32 + 8 * fq_;
        (void)c0;
#pragma unroll
        for (int ai = 0; ai < 2; ++ai)
#pragma unroll
            for (int m = 0; m < 4; ++m) {
                const int row = row0 + ai * 128 + m * 16;
                const f32x4 sq = *(const f32x4*)(ssqkv + row * 4);
                const float rs = rsqrtf(((sq[0] + sq[1]) + (sq[2] + sq[3])) * (1.f / KVLORA) + EPS);
#pragma unroll
                for (int bj = 0; bj < 2; ++bj) *(u32x4*)(dst + (size_t)row * 512 + cb + 128 * bj) = pack8(acc[ai][bj][m][0] * rs, acc[ai][bj][m][1] * rs);
            }
    }
};

struct EpiPartA {
    static constexpr bool MIDK = false;
    float* part; const bf16* gates;
    __device__ __forceinline__ void operator()(const f32x4 (&acc)[2][2][4][2], const Unit& u, int wr, int wc, int fr, int fq_) const {
        const int row0 = u.pm * 256 + wr * 64 + fr, c0 = u.pn * 256 + wc * 32 + 8 * fq_;
#pragma unroll
        for (int ai = 0; ai < 2; ++ai)
#pragma unroll
            for (int m = 0; m < 4; ++m) {
                const int row = row0 + ai * 128 + m * 16;
#pragma unroll
                for (int bj = 0; bj < 2; ++bj) { const int col = c0 + 128 * bj;
                    f32x4 g0, g1; unpack8(*(const u32x4*)(gates + (size_t)row * 2048 + col), g0, g1);
                    *(f32x4*)(part + (size_t)row * D + col) = g0 * acc[ai][bj][m][0]; *(f32x4*)(part + (size_t)row * D + col + 4) = g1 * acc[ai][bj][m][1]; }
            }
    }
};
struct EpiMerged {
    static constexpr bool MIDK = false;
    const float* part; const bf16* gates; bf16* merged;
    __device__ __forceinline__ void operator()(const f32x4 (&acc)[2][2][4][2], const Unit& u, int wr, int wc, int fr, int fq_) const {
        const int row0 = u.pm * 256 + wr * 64 + fr, c0 = u.pn * 256 + wc * 32 + 8 * fq_;
#pragma unroll
        for (int ai = 0; ai < 2; ++ai)
#pragma unroll
            for (int m = 0; m < 4; ++m) {
                const int row = row0 + ai * 128 + m * 16;
#pragma unroll
                for (int bj = 0; bj < 2; ++bj) { const int col = c0 + 128 * bj;
                    f32x4 g0, g1; unpack8(*(const u32x4*)(gates + (size_t)row * 2048 + 1024 + col), g0, g1);
                    const f32x4 p0 = *(const f32x4*)(part + (size_t)row * D + col), p1 = *(const f32x4*)(part + (size_t)row * D + col + 4);
                    *(u32x4*)(merged + (size_t)row * D + col) = pack8(p0 + g0 * acc[ai][bj][m][0], p1 + g1 * acc[ai][bj][m][1]); }
            }
    }
};
struct EpiMergedCat {
    static constexpr bool MIDK = true;
    const bf16* gates; unsigned char* merged; float sc;
    __device__ __forceinline__ void mid(f32x4 (&acc)[2][2][4][2], const Unit& u, int wr, int wc, int fr, int fq_) const {
        int row0 = u.pm * 256 + wr * 64 + fr, c0 = u.pn * 256 + wc * 32 + 8 * fq_;
        asm volatile("" : "+v"(row0), "+v"(c0));
#pragma unroll
        for (int ai = 0; ai < 2; ++ai)
#pragma unroll
            for (int m = 0; m < 4; ++m) { const int row = row0 + ai * 128 + m * 16;
#pragma unroll
                for (int bj = 0; bj < 2; ++bj) { const int col = c0 + 128 * bj;
                    f32x4 a0, a1, b0, b1; unpack8(*(const u32x4*)(gates + (size_t)row * 2048 + col), a0, a1); unpack8(*(const u32x4*)(gates + (size_t)row * 2048 + 1024 + col), b0, b1);
#pragma unroll
                    for (int q = 0; q < 4; ++q) { acc[ai][bj][m][0][q] *= a0[q] * __builtin_amdgcn_rcpf(b0[q]); acc[ai][bj][m][1][q] *= a1[q] * __builtin_amdgcn_rcpf(b1[q]); } }
                asm volatile("" ::: "memory"); }
    }
    __device__ __forceinline__ void operator()(const f32x4 (&acc)[2][2][4][2], const Unit& u, int wr, int wc, int fr, int fq_) const {
        const int row0 = u.pm * 256 + wr * 64 + fr, c0 = u.pn * 256 + wc * 32 + 8 * fq_;
#pragma unroll
        for (int ai = 0; ai < 2; ++ai)
#pragma unroll
            for (int m = 0; m < 4; ++m) { const int row = row0 + ai * 128 + m * 16;
#pragma unroll
                for (int bj = 0; bj < 2; ++bj) { const int col = c0 + 128 * bj;
                    f32x4 b0, b1; unpack8(*(const u32x4*)(gates + (size_t)row * 2048 + 1024 + col), b0, b1);
                    const f32x4 v0 = b0 * acc[ai][bj][m][0] * sc, v1 = b1 * acc[ai][bj][m][1] * sc;
                    u32x2 o; int p_ = __builtin_amdgcn_cvt_pk_fp8_f32(v0[0], v0[1], 0, false); p_ = __builtin_amdgcn_cvt_pk_fp8_f32(v0[2], v0[3], p_, true); o.x = (unsigned)p_;
                    p_ = __builtin_amdgcn_cvt_pk_fp8_f32(v1[0], v1[1], 0, false); p_ = __builtin_amdgcn_cvt_pk_fp8_f32(v1[2], v1[3], p_, true); o.y = (unsigned)p_;
                    *(u32x2*)(merged + (size_t)row * D + col) = o; } }
    }
};
struct EpiOut {
    static constexpr bool MIDK = false;
    const float* x; float* x1; const float* mod; float* ssq1; float sc;
    __device__ __forceinline__ void operator()(const f32x4 (&acc)[2][2][4][2], const Unit& u, int wr, int wc, int fr, int fq_) const {
        const int row0 = u.pm * 256 + wr * 64 + fr, c0 = u.pn * 256 + wc * 32 + 8 * fq_;
        const float* gm = mod + (size_t)((u.pm * 256) / SEQ) * 6 * D + 2 * D;
        f32x4 g[2][2];
#pragma unroll
        for (int bj = 0; bj < 2; ++bj) { g[bj][0] = *(const f32x4*)(gm + c0 + 128 * bj) * sc; g[bj][1] = *(const f32x4*)(gm + c0 + 128 * bj + 4) * sc; }
#pragma unroll
        for (int ai = 0; ai < 2; ++ai)
#pragma unroll
            for (int m = 0; m < 4; ++m) { const int row = row0 + ai * 128 + m * 16; float sq = 0.f;
#pragma unroll
                for (int bj = 0; bj < 2; ++bj) { const int col = c0 + 128 * bj;
                    const f32x4 x0 = __builtin_nontemporal_load((const f32x4*)(x + (size_t)row * D + col)), x1v = __builtin_nontemporal_load((const f32x4*)(x + (size_t)row * D + col + 4));
                    const f32x4 r0 = x0 + g[bj][0] * acc[ai][bj][m][0], r1 = x1v + g[bj][1] * acc[ai][bj][m][1];
                    *(f32x4*)(x1 + (size_t)row * D + col) = r0; *(f32x4*)(x1 + (size_t)row * D + col + 4) = r1;
                    sq += (r0[0] * r0[0] + r0[1] * r0[1]) + (r0[2] * r0[2] + r0[3] * r0[3]) + (r1[0] * r1[0] + r1[1] * r1[1]) + (r1[2] * r1[2] + r1[3] * r1[3]); }
                sq += __shfl_xor(sq, 16); sq += __shfl_xor(sq, 32);
                if (fq_ == 0) ssq1[(size_t)row * 16 + 4 * u.pn + wc] = sq; }
    }
};
struct EpiHb {
    static constexpr bool MIDK = false;
    unsigned char* hb; float sc;
    __device__ __forceinline__ void operator()(const f32x4 (&acc)[2][2][4][2], const Unit& u, int wr, int wc, int fr, int fq_) const {
        const int row0 = u.pm * 256 + wr * 64 + fr, c0 = u.pn * 128 + wc * 32 + 8 * fq_;
#pragma unroll
        for (int ai = 0; ai < 2; ++ai)
#pragma unroll
            for (int m = 0; m < 4; ++m) { const int row = row0 + ai * 128 + m * 16;
                f32x4 h0, h1;
#pragma unroll
                for (int q = 0; q < 4; ++q) { h0[q] = siluf_(acc[ai][0][m][0][q] * sc) * (acc[ai][1][m][0][q] * (sc * HSCALE8)); h1[q] = siluf_(acc[ai][0][m][1][q] * sc) * (acc[ai][1][m][1][q] * (sc * HSCALE8)); }
                u32x2 o; int p_ = __builtin_amdgcn_cvt_pk_fp8_f32(h0[0], h0[1], 0, false); p_ = __builtin_amdgcn_cvt_pk_fp8_f32(h0[2], h0[3], p_, true); o.x = (unsigned)p_;
                p_ = __builtin_amdgcn_cvt_pk_fp8_f32(h1[0], h1[1], 0, false); p_ = __builtin_amdgcn_cvt_pk_fp8_f32(h1[2], h1[3], p_, true); o.y = (unsigned)p_;
                *(u32x2*)(hb + (size_t)row * DEXP + c0) = o; }
    }
};
struct EpiDown {
    static constexpr bool MIDK = false;
    bf16* Y; float* out; float* outw; const float* mod; const unsigned short* list; const unsigned char* eidx; const float* gatew;
    __device__ __forceinline__ void operator()(const f32x4 (&acc)[2][2][4][2], const Unit& u, int wr, int wc, int fr, int fq_) const {
        const int c0 = u.pn * 256 + wc * 32 + 8 * fq_;
#pragma unroll
        for (int ai = 0; ai < 2; ++ai)
#pragma unroll
            for (int m = 0; m < 4; ++m) {
                const int rl = wr * 64 + fr + ai * 128 + m * 16, idx = u.aux * 256 + rl;
                if (u.e == NEXP) {
                    const int t = idx; const float* gf = mod + (size_t)(t / SEQ) * 6 * D + 5 * D;
#pragma unroll
                    for (int bj = 0; bj < 2; ++bj) { const int col = c0 + 128 * bj; const float* o = out + (size_t)t * D + col; float* ow = outw + (size_t)t * D + col;
                        const f32x4 g0 = *(const f32x4*)(gf + col), g1 = *(const f32x4*)(gf + col + 4);
                        const f32x4 x0 = *(const f32x4*)o, x1v = *(const f32x4*)(o + 4);
                        *(f32x4*)ow = x0 + g0 * acc[ai][bj][m][0]; *(f32x4*)(ow + 4) = x1v + g1 * acc[ai][bj][m][1]; }
                } else if (idx < u.n) {
                    const int t = list[(size_t)u.e * LISTCAP + idx];
                    const u32x2 ev = *(const u32x2*)(eidx + (size_t)t * 8);
                    int k = 0;
#pragma unroll
                    for (int q = 1; q < TOPK; ++q) { const unsigned b = (q < 4) ? ((ev.x >> (8 * q)) & 0xffu) : ((ev.y >> (8 * (q - 4))) & 0xffu); if ((int)b == u.e) k = q; }
                    const float w = gatew[(size_t)t * 8 + k];
#pragma unroll
                    for (int bj = 0; bj < 2; ++bj) *(u32x4*)(Y + ((size_t)t * TOPK + k) * D + c0 + 128 * bj) = pack8(acc[ai][bj][m][0] * w, acc[ai][bj][m][1] * w);
                }
            }
    }
};

template <int NT, bool GATHER_>
struct MoeOrder {
    static constexpr bool GATHER = GATHER_;
    const char* A; const char* Bt; const char* Bsh; int K; size_t bstride;
    const unsigned short* list; volatile LAS int* tab;
    int G, c;
    __device__ bool next(int i, Unit& u) const {
        int ti, pn_;
        if ((G & 7) == 0) { const int x = c & 7, j = i * (G >> 3) + (c >> 3); ti = (j / NT) * 8 + x; pn_ = j % NT; if (ti >= tab[65]) return false; }
        else { const int total = tab[65] * NT; const long L = (long)i * G + c; if (L >= total) return false; ti = (int)L / NT; pn_ = (int)L % NT; }
        u.pn = pn_; u.pm = ti;
        const int e = __builtin_amdgcn_readfirstlane(tab[132 + ti]);
        u.e = e; u.aux = __builtin_amdgcn_readfirstlane(ti - tab[e]); u.n = __builtin_amdgcn_readfirstlane(tab[66 + e]); return true;
    }
    __device__ __forceinline__ const char* a_ptr(const Unit& u) const { return GATHER ? A : A + (size_t)u.pm * 256 * K * 2; }
    __device__ __forceinline__ const char* b_ptr(const Unit& u) const { return (u.e == NEXP ? Bsh : Bt + (size_t)u.e * bstride) + (size_t)u.pn * 256 * K * 2; }
    __device__ __forceinline__ unsigned a_row(const Unit& u, int r) const {
        if (!GATHER) return (unsigned)r;
        const int idx = u.aux * 256 + r;
        if (u.e == NEXP) return (unsigned)idx;
        return (idx < u.n) ? (unsigned)list[(size_t)u.e * LISTCAP + idx] : 0u;
    }
};

struct UpOrder {
    static constexpr bool GATHER = false;
    const char* Aq; const char* Bq; const char* Akv; const char* Bkv; int K; int G, c;
    __device__ bool next(int i, Unit& u) const {
        int L = i * G + c; if (L >= 448) return false;
        if (L < 256) { u.e = 1; u.pm = L >> 2; u.pn = L & 3; } else { L -= 256; u.e = 0; u.pm = L / 3; u.pn = L % 3; }
        u.aux = 0; u.n = 256; return true; }
    __device__ __forceinline__ const char* a_ptr(const Unit& u) const { return (u.e ? Akv : Aq) + (size_t)u.pm * 256 * K * 2; }
    __device__ __forceinline__ const char* b_ptr(const Unit& u) const { return (u.e ? Bkv : Bq) + (size_t)u.pn * 256 * K * 2; }
    __device__ __forceinline__ unsigned a_row(const Unit&, int r) const { return (unsigned)r; }
};
struct EpiUp {
    static constexpr bool MIDK = false;
    EpiQup q; EpiKVup kv;
    __device__ __forceinline__ void operator()(const f32x4 (&acc)[2][2][4][2], const Unit& u, int wr, int wc, int fr, int fq_) const { if (u.e) kv(acc, u, wr, wc, fr, fq_); else q(acc, u, wr, wc, fr, fq_); }
};

struct SharedDownOrder {
    static constexpr bool GATHER = false;
    const char* A; const char* Bt; int K; int G, c;
    __device__ bool next(int i, Unit& u) const { const int L = i * G + c; if (L >= (T / 256) * 4) return false; u.pm = L >> 2; u.pn = L & 3; u.e = NEXP; u.aux = L >> 2; u.n = 256; return true; }
    __device__ __forceinline__ const char* a_ptr(const Unit& u) const { return A + (size_t)u.pm * 256 * K * 2; }
    __device__ __forceinline__ const char* b_ptr(const Unit& u) const { return Bt + (size_t)u.pn * 256 * K * 2; }
    __device__ __forceinline__ unsigned a_row(const Unit&, int r) const { return (unsigned)r; }
};

namespace att {
constexpr int KSLOT = 12288, VSLOT = 8192;
constexpr int L_K = 0, L_V = 3 * KSLOT, L_F = L_V + 2 * VSLOT, L_WS = L_F + 3 * 256, L_OST = L_WS + 2048, L_END = L_OST + 8 * 4096;
static_assert(L_END <= RING_BYTES, "attention LDS");
__device__ __forceinline__ int crow(int r, int hi) { return (r & 3) + 8 * (r >> 2) + 4 * hi; }
__device__ __forceinline__ float max3f(float a, float b, float c) { return fmaxf(fmaxf(a, b), c); }
__device__ __forceinline__ float rowmax(const f32x16& p0, const f32x16& p1) {
    float a = max3f(p0[0], p0[1], p1[0]), b = max3f(p0[2], p0[3], p1[1]); a = max3f(a, p1[2], p1[3]);
#pragma unroll
    for (int r = 4; r < 16; r += 4) { a = max3f(a, p0[r], p0[r + 1]); b = max3f(b, p0[r + 2], p0[r + 3]); a = max3f(a, p1[r], p1[r + 1]); b = max3f(b, p1[r + 2], p1[r + 3]); }
    const float m = fmaxf(a, b);
    auto rr = __builtin_amdgcn_permlane32_swap(__float_as_uint(m), __float_as_uint(m), false, false);
    return fmaxf(__uint_as_float(rr[0]), __uint_as_float(rr[1]));
}
__device__ __forceinline__ void cmask(f32x16& p0, f32x16& p1, int jb, int qrel, int hi) {
    const float NEG = -INFINITY; const int kb = 64 * jb + 4 * hi;
#pragma unroll
    for (int r = 0; r < 16; ++r) { const int kv = kb + (r & 3) + 8 * (r >> 2); if (kv > qrel) p0[r] = NEG; if (kv + 32 > qrel) p1[r] = NEG; }
}
__device__ __forceinline__ void pv(f32x16* o, int vb, bf16x8 pa0, bf16x8 pa1, bf16x8 pa2, bf16x8 pa3) {
#pragma unroll
    for (int d0 = 0; d0 < 2; ++d0) { s16x4 lo[4], hi[4];
#pragma unroll
        for (int ks = 0; ks < 4; ++ks) {
            asm volatile("ds_read_b64_tr_b16 %0,%1 offset:%c2" : "=&v"(lo[ks]) : "v"(vb), "i"(d0 * 4096 + ks * 1024) : "memory");
            asm volatile("ds_read_b64_tr_b16 %0,%1 offset:%c2" : "=&v"(hi[ks]) : "v"(vb), "i"(d0 * 4096 + ks * 1024 + 512) : "memory"); }
        asm volatile("s_waitcnt lgkmcnt(0)" ::: "memory"); __builtin_amdgcn_sched_barrier(0);
#define PK(k) (bf16x8){lo[k][0], lo[k][1], lo[k][2], lo[k][3], hi[k][0], hi[k][1], hi[k][2], hi[k][3]}
        o[d0] = __builtin_amdgcn_mfma_f32_32x32x16_bf16(pa0, PK(0), o[d0], 0, 0, 0);
        o[d0] = __builtin_amdgcn_mfma_f32_32x32x16_bf16(pa1, PK(1), o[d0], 0, 0, 0);
        o[d0] = __builtin_amdgcn_mfma_f32_32x32x16_bf16(pa2, PK(2), o[d0], 0, 0, 0);
        o[d0] = __builtin_amdgcn_mfma_f32_32x32x16_bf16(pa3, PK(3), o[d0], 0, 0, 0);
#undef PK
    }
}
__device__ __forceinline__ unsigned cvtpk_s(float lo, float hi) { return cvt_pk_bf16(lo, hi); }

template <int DQK, bool DECAY, int THRL>
__device__ __forceinline__ void attn_unit(int b, int h, int qb, const bf16* Q, int QP, const bf16* Kn, const bf16* Kpe, const bf16* V, const float* cumF, bf16* O, int OP, LAS unsigned char* lds) {
    constexpr int ND0 = DQK / 16;
    int tid = threadIdx.x; asm volatile("" : "+v"(tid));
    const int lane = tid & 63, r32 = lane & 31, hi = lane >> 5; const int wid = __builtin_amdgcn_readfirstlane(tid >> 6);
    const long rowbase = (long)b * SEQ; const int q0 = qb * 256;
    const bf16* Qw = Q + (rowbase + q0 + wid * 32) * QP + h * DQK;
    const bf16* Kh = Kn + rowbase * 512 + h * 64; const bf16* Vh = V + rowbase * 512 + h * 64;
    const bf16* Kp = Kpe + rowbase * ROPE;
    const float* Fh = DECAY ? cumF + ((size_t)b * NHEAD + h) * SEQ : nullptr;
    LAS float* wsf = (LAS float*)(lds + L_WS) + wid * 64;
    const bf16* ksrc0 = Kh + (long)lane * 512 + wid * 8;
    const bf16* ksrc1 = Kp + (long)lane * ROPE + (wid & 3) * 8;
    const bf16* vsrc = Vh + (long)(16 * (wid & 3) + (lane >> 2)) * 512 + (wid >> 2) * 32 + (lane & 3) * 8;
    const int NT = (q0 + 256) / 64;
#define ATT_DMA_K(i_, s) do { const int t_ = NT - 1 - (i_); \
        __builtin_amdgcn_global_load_lds((const unsigned*)(ksrc0 + (long)t_ * 64 * 512), (LAS unsigned*)(lds + L_K + (s) * KSLOT + wid * 1024), 16, 0, 0); \
        if (DQK == 96 && wid < 4) __builtin_amdgcn_global_load_lds((const unsigned*)(ksrc1 + (long)t_ * 64 * ROPE), (LAS unsigned*)(lds + L_K + (s) * KSLOT + (8 + wid) * 1024), 16, 0, 0); \
        if (DECAY && wid == 7) __builtin_amdgcn_global_load_lds((const unsigned*)(Fh + t_ * 64 + lane), (LAS unsigned*)(lds + L_F + (s) * 256), 4, 0, 0); } while (0)
#define ATT_DMA_V(i_, s) do { const int t_ = NT - 1 - (i_); \
        __builtin_amdgcn_global_load_lds((const unsigned*)(vsrc + (long)t_ * 64 * 512), (LAS unsigned*)(lds + L_V + (s) * VSLOT + wid * 1024), 16, 0, 0); } while (0)
    ATT_DMA_K(0, 0); ATT_DMA_V(0, 0); ATT_DMA_K(1, 1);
    bf16x8 qr[ND0];
#pragma unroll
    for (int d0 = 0; d0 < ND0; ++d0) qr[d0] = *(const bf16x8*)(Qw + (long)r32 * QP + d0 * 16 + hi * 8);
    float fq_l = 0.f; if (DECAY) fq_l = Fh[q0 + wid * 32 + r32];
    float mhat = 0.f, l_reg = 0.f; bool started = false; f32x16 o[2]; o[0] = f32x16{}; o[1] = f32x16{};
    const int qrel = wid * 32 + r32;
    const int vb0 = (int)(uintptr_t)(lds + L_V) + ((lane >> 4) & 1) * 32 + (lane & 3) * 8 + (4 * hi + ((lane & 15) >> 2)) * 64;
#define ATT_QK(P0, P1, ks_) do { const float base_ = fq_l - mhat; \
        if (DECAY) { const LAS f32x4* fk_ = (const LAS f32x4*)(lds + L_F + (ks_) * 256); \
            _Pragma("unroll") for (int g = 0; g < 4; ++g) { const f32x4 a_ = fk_[2 * g + hi], c_ = fk_[8 + 2 * g + hi]; \
                _Pragma("unroll") for (int q = 0; q < 4; ++q) { P0[4 * g + q] = base_ - a_[q]; P1[4 * g + q] = base_ - c_[q]; } } } \
        else { _Pragma("unroll") for (int r = 0; r < 16; ++r) { P0[r] = base_; P1[r] = base_; } } \
        const LAS unsigned char* kb_ = lds + L_K + (ks_) * KSLOT + hi * 1024 + r32 * 16; \
        _Pragma("unroll") for (int d0 = 0; d0 < ND0; ++d0) { \
            const bf16x8 b0_ = *(const LAS bf16x8*)(kb_ + d0 * 2048), b1_ = *(const LAS bf16x8*)(kb_ + d0 * 2048 + 512); \
            P0 = __builtin_amdgcn_mfma_f32_32x32x16_bf16(b0_, qr[d0], P0, 0, 0, 0); P1 = __builtin_amdgcn_mfma_f32_32x32x16_bf16(b1_, qr[d0], P1, 0, 0, 0); } } while (0)
    f32x16 p0, p1, n0, n1;
    int ks_cur = 0, ks_nxt = 1, ks_ld = 2;
    for (int i = 0; i < NT; ++i) {
        const int vs = i & 1;
        VM_WAIT(); __syncthreads();
        if (i + 2 < NT) ATT_DMA_K(i + 2, ks_ld);
        if (i + 1 < NT) ATT_DMA_V(i + 1, vs ^ 1);
        if (i == 0) ATT_QK(p0, p1, 0);
        if (i + 1 < NT) ATT_QK(n0, n1, ks_nxt);
        const int jb = 3 - i;
        if (jb >= 0) cmask(p0, p1, jb, qrel, hi);
        const float rm = rowmax(p0, p1);
        bool resc = false; float dl = 0.f; const bool was_started = started;
        if (jb >= 0) {
            const bool fin = rm > -INFINITY;
            dl = started ? fmaxf(rm, 0.f) : (fin ? rm : 0.f); started = started || fin; resc = true;
        } else if (__any(rm > (float)THRL)) { dl = fmaxf(rm, 0.f); resc = true; }
        if (resc) { mhat += dl;
#pragma unroll
            for (int r = 0; r < 16; ++r) { p0[r] -= dl; p1[r] -= dl; }
            if (i + 1 < NT) {
#pragma unroll
                for (int r = 0; r < 16; ++r) { n0[r] -= dl; n1[r] -= dl; } }
            const float f = was_started ? __builtin_amdgcn_exp2f(-dl) : 1.f; l_reg *= f; if (hi == 0) wsf[r32] = f; }
        float sacc = 0.f;
#pragma unroll
        for (int r = 0; r < 16; ++r) { p0[r] = __builtin_amdgcn_exp2f(p0[r]); p1[r] = __builtin_amdgcn_exp2f(p1[r]); sacc += p0[r] + p1[r]; }
        l_reg += sacc;
        if (resc) { LDS_WAIT();
#pragma unroll
            for (int d_ = 0; d_ < 2; ++d_)
#pragma unroll
                for (int r = 0; r < 16; ++r) o[d_][r] *= wsf[crow(r, hi)]; }
        u32x4 pw0, pw1, pw2, pw3;
        pw0 = (u32x4){cvtpk_s(p0[0], p0[1]), cvtpk_s(p0[2], p0[3]), cvtpk_s(p0[4], p0[5]), cvtpk_s(p0[6], p0[7])};
        pw1 = (u32x4){cvtpk_s(p0[8], p0[9]), cvtpk_s(p0[10], p0[11]), cvtpk_s(p0[12], p0[13]), cvtpk_s(p0[14], p0[15])};
        pw2 = (u32x4){cvtpk_s(p1[0], p1[1]), cvtpk_s(p1[2], p1[3]), cvtpk_s(p1[4], p1[5]), cvtpk_s(p1[6], p1[7])};
        pw3 = (u32x4){cvtpk_s(p1[8], p1[9]), cvtpk_s(p1[10], p1[11]), cvtpk_s(p1[12], p1[13]), cvtpk_s(p1[14], p1[15])};
        __builtin_amdgcn_sched_barrier(0);
        pv(o, vb0 + vs * VSLOT, __builtin_bit_cast(bf16x8, pw0), __builtin_bit_cast(bf16x8, pw1), __builtin_bit_cast(bf16x8, pw2), __builtin_bit_cast(bf16x8, pw3));
        p0 = n0; p1 = n1;
        { const int t_ = ks_cur; ks_cur = ks_nxt; ks_nxt = ks_ld; ks_ld = t_; }
    }
    { auto rr = __builtin_amdgcn_permlane32_swap(__float_as_uint(l_reg), __float_as_uint(l_reg), false, false); l_reg = __uint_as_float(rr[0]) + __uint_as_float(rr[1]); }
    if (hi == 0) wsf[32 + r32] = l_reg; LDS_WAIT();
    float rli[16];
#pragma unroll
    for (int r = 0; r < 16; ++r) rli[r] = __builtin_amdgcn_rcpf(wsf[32 + crow(r, hi)]);
    unsigned char* Ow = (unsigned char*)O + (rowbase + q0 + wid * 32) * OP + h * 64;
    { LAS unsigned char* stg = lds + L_OST + wid * 4096;
#pragma unroll
      for (int r = 0; r < 16; ++r) { const int orow = crow(r, hi);
#pragma unroll
          for (int d0 = 0; d0 < 2; ++d0) { const float ov = o[d0][r] * rli[r] * OSCALE8; stg[orow * 64 + d0 * 32 + r32] = (unsigned char)__builtin_amdgcn_cvt_pk_fp8_f32(ov, ov, 0, false); } }
      LDS_WAIT();
#pragma unroll
      for (int i = 0; i < 2; ++i) { const int row = i * 16 + (lane >> 2), ch = lane & 3; const u32x4 v = *(const LAS u32x4*)(stg + row * 64 + ch * 16); *(u32x4*)(Ow + (long)row * OP + ch * 16) = v; } }
    LDS_WAIT(); __syncthreads();
#undef ATT_DMA_K
#undef ATT_DMA_V
#undef ATT_QK
}

constexpr int T_KSLOT = 12288, T_VSLOT = 8192, T_NSLOT = 3;
constexpr int T_K = 0, T_V = T_NSLOT * T_KSLOT, T_F = T_V + T_NSLOT * T_VSLOT, T_WS = T_F + T_NSLOT * 256, T_OST = T_WS + 2048, T_END = T_OST + 8 * 4096;
static_assert(T_END <= RING_BYTES, "attention LDS (hand-interleaved unit)");
typedef __attribute__((address_space(3))) const char* lds_cptr;
typedef short v4i16_t __attribute__((ext_vector_type(4)));
__device__ __forceinline__ s16x4 vtr(lds_cptr p) { return __builtin_bit_cast(s16x4, __builtin_amdgcn_ds_read_tr16_b64_v4i16((__attribute__((address_space(3))) v4i16_t*)p)); }
__device__ __forceinline__ void kload2(bf16x8* kf, lds_cptr kp, int j) { kf[2 * j] = *(const __attribute__((address_space(3))) bf16x8*)(kp + j * 2048); kf[2 * j + 1] = *(const __attribute__((address_space(3))) bf16x8*)(kp + j * 2048 + 512); }
#define TW_BAR(N) asm volatile("s_waitcnt vmcnt(" #N ") lgkmcnt(0)\n\ts_barrier" ::: "memory")
#define TSB() __builtin_amdgcn_sched_barrier(0)

template <int DQK, bool DECAY, int THRL>
__device__ __forceinline__ void attn_unit_t(int b, int h, int qb, const bf16* Q, int QP, const bf16* Kn, const bf16* Kpe, const bf16* V, const float* cumF, float kmax2, bf16* O, int OP, LAS unsigned char* lds) {
    constexpr int ND0 = DQK / 16;
    constexpr bool INPL = DECAY || (DQK == 96);
    int tid = threadIdx.x; asm volatile("" : "+v"(tid));
    const int lane = tid & 63, r32 = lane & 31, hi = lane >> 5; const int wid = __builtin_amdgcn_readfirstlane(tid >> 6);
    const long rowbase = (long)b * SEQ; const int q0 = qb * 256;
    const bf16* Qw = Q + (rowbase + q0 + wid * 32) * QP + h * DQK;
    const bf16* Kh = Kn + rowbase * 512 + h * 64; const bf16* Vh = V + rowbase * 512 + h * 64;
    const bf16* Kp = Kpe + rowbase * ROPE;
    const float* Fh = DECAY ? cumF + ((size_t)b * NHEAD + h) * SEQ : nullptr;
    LAS float* wsf = (LAS float*)(lds + T_WS) + wid * 64;
    const bf16* ksrc0 = Kh + (long)lane * 512 + wid * 8;
    const bf16* ksrc1 = Kp + (long)lane * ROPE + (wid & 3) * 8;
    const bf16* vsrc = Vh + (long)(16 * (wid & 3) + (lane >> 2)) * 512 + (wid >> 2) * 32 + (lane & 3) * 8;
    const int NTS = (q0 + 256) / 64;
#define TDMA_K(i_, sk) do { const int t_ = NTS - 1 - (i_); \
        __builtin_amdgcn_global_load_lds((const unsigned*)(ksrc0 + (long)t_ * 64 * 512), (LAS unsigned*)(lds + T_K + (sk) * T_KSLOT + wid * 1024), 16, 0, 0); \
        if (DECAY) __builtin_amdgcn_global_load_lds((const unsigned*)(Fh + t_ * 64 + lane), (LAS unsigned*)(lds + T_F + (sk) * 256), 4, 0, 0); \
        else __builtin_amdgcn_global_load_lds((const unsigned*)(ksrc1 + (long)t_ * 64 * ROPE), (LAS unsigned*)(lds + T_K + (sk) * T_KSLOT + (8 + (wid & 3)) * 1024), 16, 0, 0); } while (0)
#define TDMA_V(i_, sv) do { const int t_ = NTS - 1 - (i_); \
        __builtin_amdgcn_global_load_lds((const unsigned*)(vsrc + (long)t_ * 64 * 512), (LAS unsigned*)(lds + T_V + (sv) * T_VSLOT + wid * 1024), 16, 0, 0); } while (0)
    TDMA_K(0, 0); TDMA_V(0, 0); TDMA_K(1, 1);
    bf16x8 qr[ND0];
#pragma unroll
    for (int d0 = 0; d0 < ND0; ++d0) qr[d0] = *(const bf16x8*)(Qw + (long)r32 * QP + d0 * 16 + hi * 8);
    float fq_l = 0.f; if (DECAY) fq_l = Fh[q0 + wid * 32 + r32];
    float ftile = 0.f; if (DECAY) ftile = Fh[(lane < NTS ? lane : NTS - 1) * 64 + 63];
    float mhat = 0.f, l_reg = 0.f; f32x16 o[2]; o[0] = f32x16{}; o[1] = f32x16{};
    f32x16 negm = f32x16{}; asm volatile("" : "+v"(negm));
    const int qrel = wid * 32 + r32, i0 = 3 - (wid >> 1);
    const lds_cptr shm3 = (lds_cptr)lds; const lds_cptr kp0 = shm3 + T_K + hi * 1024 + r32 * 16;
    const lds_cptr vp0 = shm3 + T_V + ((lane >> 4) & 1) * 32 + (lane & 3) * 8 + (4 * hi + ((lane & 15) >> 2)) * 64;
    const int vb0 = (int)(uintptr_t)(lds + T_V) + ((lane >> 4) & 1) * 32 + (lane & 3) * 8 + (4 * hi + ((lane & 15) >> 2)) * 64;
    bool resc = false;
    bf16x8 kf[2 * ND0];
    f32x16 pA0, pA1, pB0, pB1;
    int sl_prev = 0, sl_cur = 0, sl_next = 1;
#define TROT() do { sl_prev = sl_cur; sl_cur = sl_next; sl_next = (sl_next == T_NSLOT - 1) ? 0 : sl_next + 1; } while (0)
#define TBIAS(X0, X1, fs_) do { if (DECAY) { const float base_ = fq_l - mhat; const LAS f32x4* fk_ = (const LAS f32x4*)(lds + T_F + (fs_) * 256); \
        _Pragma("unroll") for (int g = 0; g < 4; ++g) { const f32x4 a_ = fk_[2 * g + hi], c_ = fk_[8 + 2 * g + hi]; \
            _Pragma("unroll") for (int q = 0; q < 4; ++q) { X0[4 * g + q] = base_ - a_[q]; X1[4 * g + q] = base_ - c_[q]; } } } \
        else if (INPL) { const float nm_ = -mhat; _Pragma("unroll") for (int r = 0; r < 16; ++r) { X0[r] = nm_; X1[r] = nm_; } } } while (0)
#define TCIN(X) (INPL ? X : negm)
#define TRESC() do { if (resc) { asm volatile("s_waitcnt lgkmcnt(0)" ::: "memory"); \
        _Pragma("unroll") for (int d_ = 0; d_ < 2; ++d_) _Pragma("unroll") for (int r = 0; r < 16; ++r) o[d_][r] *= wsf[crow(r, hi)]; } } while (0)
#define TDECIDE(C0, C1, i_) do { \
        float a_ = max3f(C0[0], C0[1], C1[0]), b_ = max3f(C0[2], C0[3], C1[1]); a_ = max3f(a_, C1[2], C1[3]); \
        _Pragma("unroll") for (int r = 4; r < 16; r += 4) { a_ = max3f(a_, C0[r], C0[r + 1]); b_ = max3f(b_, C0[r + 2], C0[r + 3]); a_ = max3f(a_, C1[r], C1[r + 1]); b_ = max3f(b_, C1[r + 2], C1[r + 3]); } \
        float rm_ = fmaxf(a_, b_); { auto rr_ = __builtin_amdgcn_permlane32_swap(__float_as_uint(rm_), __float_as_uint(rm_), false, false); rm_ = fmaxf(__uint_as_float(rr_[0]), __uint_as_float(rr_[1])); } \
        resc = false; \
        if ((i_) == i0) { const float dl_ = rm_; mhat += dl_; \
            _Pragma("unroll") for (int r = 0; r < 16; ++r) { C0[r] -= dl_; C1[r] -= dl_; } \
            if (!INPL) { _Pragma("unroll") for (int r = 0; r < 16; ++r) negm[r] = -mhat; asm volatile("" : "+v"(negm)); } } \
        else if (__builtin_expect(__any(rm_ > (float)THRL), 0)) { const float dl_ = fmaxf(rm_, 0.f); mhat += dl_; \
            _Pragma("unroll") for (int r = 0; r < 16; ++r) { C0[r] -= dl_; C1[r] -= dl_; } \
            if (!INPL) { _Pragma("unroll") for (int r = 0; r < 16; ++r) negm[r] = -mhat; asm volatile("" : "+v"(negm)); } \
            const float f_ = __builtin_amdgcn_exp2f(-dl_); l_reg *= f_; if (hi == 0) wsf[r32] = f_; resc = true; } } while (0)
    TDMA_K(2, 2);
    TW_BAR(5);
    int NT = NTS;
    if (DECAY) {
        const float bound = 2.f * __builtin_sqrtf(kmax2) * 1.0001f + 1.f + (Fh[q0] - ftile);
        const unsigned long long need = __ballot(lane < NTS && bound >= -160.f);
        const int tmin = need ? (int)__builtin_ctzll(need) : NTS - 1;
        NT = NTS - tmin; NT += NT & 1; if (NT < 8) NT = 8; if (NT > NTS) NT = NTS;
        NT = __builtin_amdgcn_readfirstlane(NT); }
    TBIAS(pA0, pA1, 0);
    { const lds_cptr kb = kp0;
#pragma unroll
      for (int d0 = 0; d0 < ND0; ++d0) { const bf16x8 b0 = *(const __attribute__((address_space(3))) bf16x8*)(kb + d0 * 2048), b1 = *(const __attribute__((address_space(3))) bf16x8*)(kb + d0 * 2048 + 512);
          if (d0 == 0) { pA0 = __builtin_amdgcn_mfma_f32_32x32x16_bf16(b0, qr[0], TCIN(pA0), 0, 0, 0); pA1 = __builtin_amdgcn_mfma_f32_32x32x16_bf16(b1, qr[0], TCIN(pA1), 0, 0, 0); }
          else { pA0 = __builtin_amdgcn_mfma_f32_32x32x16_bf16(b0, qr[d0], pA0, 0, 0, 0); pA1 = __builtin_amdgcn_mfma_f32_32x32x16_bf16(b1, qr[d0], pA1, 0, 0, 0); } } }
    cmask(pA0, pA1, 3, qrel, hi);
    TDECIDE(pA0, pA1, 0);
#pragma unroll
    for (int r = 0; r < 16; ++r) { pA0[r] = __builtin_amdgcn_exp2f(pA0[r]); pA1[r] = __builtin_amdgcn_exp2f(pA1[r]); }
    TW_BAR(0);
    TDMA_K(3, 0); TDMA_V(1, 1);
    TROT();
#pragma unroll
    for (int j = 0; j < ND0; ++j) kload2(kf, kp0 + sl_cur * T_KSLOT, j);
    TBIAS(pB0, pB1, sl_cur);
    TW_BAR(3);
    s16x4 vlo[8], vhi[8]; u32x4 pw0, pw1, pw2, pw3;
#define TPKW(P, B) cvt_pk_bf16(P[B], P[B + 1])
#define TPAF(k) __builtin_bit_cast(bf16x8, pw##k)
#define TVFR(i) (bf16x8){vlo[i][0], vlo[i][1], vlo[i][2], vlo[i][3], vhi[i][0], vhi[i][1], vhi[i][2], vhi[i][3]}
#define TPIN(x) asm volatile("" : "+v"(x))
#define TGAPA(MF, A0, A1, A2, A3, W0, W1, PW) do { MF; sacc += A0; sacc += A1; sacc += A2; sacc += A3; TPIN(sacc); W0; W1; TPIN(PW); TSB(); } while (0)
#define TEX(v) __builtin_amdgcn_exp2f(v)
#define TGAPB(MF, X, B) do { MF; X[B] = TEX(X[B]); X[B + 1] = TEX(X[B + 1]); X[B + 2] = TEX(X[B + 2]); X[B + 3] = TEX(X[B + 3]); TPIN(X); TSB(); } while (0)
#define TVRD(i) do { vlo[i] = vtr(vp_ + (((i) >> 2) * 4096 + ((i) & 3) * 1024)); vhi[i] = vtr(vp_ + (((i) >> 2) * 4096 + ((i) & 3) * 1024 + 512)); } while (0)
#define TKRD(G, j) do { if (G) { kload2(kf, kp0 + sl_next * T_KSLOT, j); TSB(); } } while (0)
#define TMF(a, b, c) __builtin_amdgcn_mfma_f32_32x32x16_bf16(a, b, c, 0, 0, 0)
#define TSTEP(C0, C1, P0, P1, i_, MJB, GK, GV, GL) do { TSB(); \
        const lds_cptr vp_ = vp0 + sl_prev * T_VSLOT; \
        TVRD(0); TSB(); float sacc = (P0[0] + P0[1]); \
        TGAPA(C0 = TMF(kf[0], qr[0], TCIN(C0)), P0[2], P0[3], P0[4], P0[5],     pw0[0] = TPKW(P0, 0), pw0[1] = TPKW(P0, 2), pw0); \
        TVRD(4); TSB(); TGAPA(C1 = TMF(kf[1], qr[0], TCIN(C1)), P0[6], P0[7], P0[8], P0[9],     pw0[2] = TPKW(P0, 4), pw0[3] = TPKW(P0, 6), pw0); \
        TVRD(1); TSB(); TGAPA(C0 = TMF(kf[2], qr[1], C0),   P0[10], P0[11], P0[12], P0[13], pw1[0] = TPKW(P0, 8), pw1[1] = TPKW(P0, 10), pw1); \
        TVRD(5); TSB(); TGAPA(C1 = TMF(kf[3], qr[1], C1),   P0[14], P0[15], P1[0], P1[1],   pw1[2] = TPKW(P0, 12), pw1[3] = TPKW(P0, 14), pw1); \
        TVRD(2); TSB(); TGAPA(C0 = TMF(kf[4], qr[2], C0),   P1[2], P1[3], P1[4], P1[5],     pw2[0] = TPKW(P1, 0), pw2[1] = TPKW(P1, 2), pw2); \
        TVRD(6); TSB(); TGAPA(C1 = TMF(kf[5], qr[2], C1),   P1[6], P1[7], P1[8], P1[9],     pw2[2] = TPKW(P1, 4), pw2[3] = TPKW(P1, 6), pw2); \
        TVRD(3); TSB(); TGAPA(C0 = TMF(kf[6], qr[3], C0),   P1[10], P1[11], P1[12], P1[13], pw3[0] = TPKW(P1, 8), pw3[1] = TPKW(P1, 10), pw3); \
        TVRD(7); TSB(); TGAPA(C1 = TMF(kf[7], qr[3], C1),   P1[14], P1[15], 0.f, 0.f,       pw3[2] = TPKW(P1, 12), pw3[3] = TPKW(P1, 14), pw3); \
        if (ND0 == 6) { C0 = TMF(kf[2 * ND0 - 4], qr[ND0 - 2], C0); C1 = TMF(kf[2 * ND0 - 3], qr[ND0 - 2], C1); C0 = TMF(kf[2 * ND0 - 2], qr[ND0 - 1], C0); C1 = TMF(kf[2 * ND0 - 1], qr[ND0 - 1], C1); TSB(); } \
        l_reg += sacc; \
        if (GK) { TDMA_K((i_) + 3, sl_cur); } if (GV) { TDMA_V((i_) + 1, sl_next); } \
        if ((MJB) >= 0) cmask(C0, C1, (MJB), qrel, hi); \
        TDECIDE(C0, C1, i_); \
        TSB(); \
        TGAPB(o[0] = TMF(TPAF(0), TVFR(0), o[0]), C0, 0); \
        TKRD(GL, 0); TGAPB(o[1] = TMF(TPAF(0), TVFR(4), o[1]), C0, 4); \
        TKRD(GL, 1); TGAPB(o[0] = TMF(TPAF(1), TVFR(1), o[0]), C0, 8); \
        TKRD(GL, 2); TGAPB(o[1] = TMF(TPAF(1), TVFR(5), o[1]), C0, 12); \
        TKRD(GL, 3); TGAPB(o[0] = TMF(TPAF(2), TVFR(2), o[0]), C1, 0); \
        if (ND0 == 6) { TKRD(GL, ND0 - 2); } TGAPB(o[1] = TMF(TPAF(2), TVFR(6), o[1]), C1, 4); \
        if (ND0 == 6) { TKRD(GL, ND0 - 1); } TGAPB(o[0] = TMF(TPAF(3), TVFR(3), o[0]), C1, 8); \
        TGAPB(o[1] = TMF(TPAF(3), TVFR(7), o[1]), C1, 12); \
        if (GL) { TBIAS(P0, P1, sl_next); } \
    } while (0)
#define TENDW(tt) do { if ((tt) + 3 < NT) { TW_BAR(3); } else if ((tt) + 2 < NT) { TW_BAR(1); } else { TW_BAR(0); } } while (0)
    TSTEP(pB0, pB1, pA0, pA1, 1, 2, (1 + 3 < NT), true, true); TENDW(1); TRESC(); TROT();
    TSTEP(pA0, pA1, pB0, pB1, 2, 1, (2 + 3 < NT), true, true); TENDW(2); TRESC(); TROT();
    {
        TSTEP(pB0, pB1, pA0, pA1, 3, 0, (3 + 3 < NT), true, true); TENDW(3); TRESC(); TROT();
        int i = 4;
        for (; i + 2 < NT; i += 2) {
            TSTEP(pA0, pA1, pB0, pB1, i, -1, (i + 3 < NT), true, true);                         TENDW(i);     TRESC(); TROT();
            TSTEP(pB0, pB1, pA0, pA1, i + 1, -1, (i + 4 < NT), (i + 2 < NT), (i + 2 < NT));     TENDW(i + 1); TRESC(); TROT();
        }
        TSTEP(pA0, pA1, pB0, pB1, NT - 2, -1, false, true, true); TENDW(NT - 2); TRESC(); TROT();
        TSTEP(pB0, pB1, pA0, pA1, NT - 1, -1, false, false, false); TRESC();
    }
    { float sacc = pB0[0] + pB0[1];
#pragma unroll
      for (int r = 2; r < 16; ++r) sacc += pB0[r];
#pragma unroll
      for (int r = 0; r < 16; ++r) sacc += pB1[r];
      l_reg += sacc;
      pw0 = (u32x4){TPKW(pB0, 0), TPKW(pB0, 2), TPKW(pB0, 4), TPKW(pB0, 6)}; pw1 = (u32x4){TPKW(pB0, 8), TPKW(pB0, 10), TPKW(pB0, 12), TPKW(pB0, 14)};
      pw2 = (u32x4){TPKW(pB1, 0), TPKW(pB1, 2), TPKW(pB1, 4), TPKW(pB1, 6)}; pw3 = (u32x4){TPKW(pB1, 8), TPKW(pB1, 10), TPKW(pB1, 12), TPKW(pB1, 14)};
      TSB(); pv(o, vb0 + sl_cur * T_VSLOT, TPAF(0), TPAF(1), TPAF(2), TPAF(3)); }
    { auto rr = __builtin_amdgcn_permlane32_swap(__float_as_uint(l_reg), __float_as_uint(l_reg), false, false); l_reg = __uint_as_float(rr[0]) + __uint_as_float(rr[1]); }
    if (hi == 0) wsf[32 + r32] = l_reg; asm volatile("s_waitcnt lgkmcnt(0)" ::: "memory");
    float rli[16];
#pragma unroll
    for (int r = 0; r < 16; ++r) rli[r] = __builtin_amdgcn_rcpf(wsf[32 + crow(r, hi)]);
    unsigned char* Ow = (unsigned char*)O + (rowbase + q0 + wid * 32) * OP + h * 64;
    { LAS unsigned char* stg = lds + T_OST + wid * 4096;
#pragma unroll
      for (int r = 0; r < 16; ++r) { const int orow = crow(r, hi);
#pragma unroll
          for (int d0 = 0; d0 < 2; ++d0) { const float ov = o[d0][r] * rli[r] * OSCALE8; stg[orow * 64 + d0 * 32 + r32] = (unsigned char)__builtin_amdgcn_cvt_pk_fp8_f32(ov, ov, 0, false); } }
      asm volatile("s_waitcnt lgkmcnt(0)" ::: "memory");
#pragma unroll
      for (int i = 0; i < 2; ++i) { const int row = i * 16 + (lane >> 2), ch = lane & 3; const u32x4 v = *(const LAS u32x4*)(stg + row * 64 + ch * 16); *(u32x4*)(Ow + (long)row * OP + ch * 16) = v; } }
    asm volatile("s_waitcnt lgkmcnt(0)\n\ts_barrier" ::: "memory");
#undef TDMA_K
#undef TDMA_V
#undef TROT
#undef TBIAS
#undef TCIN
#undef TRESC
#undef TDECIDE
#undef TPKW
#undef TPAF
#undef TVFR
#undef TPIN
#undef TGAPA
#undef TEX
#undef TGAPB
#undef TVRD
#undef TKRD
#undef TMF
#undef TSTEP
#undef TENDW
}
#undef TW_BAR
#undef TSB
}

namespace dn {
constexpr int CHB = 64 * 256;
constexpr int NSLOT = 8, AHEAD = 7;
__device__ __forceinline__ int nloc(int i) { return 16 * ((i >> 2) & 1) + (i & 3) + 4 * (i >> 3); }
template <bool NOTRAFFIC>
__device__ __forceinline__ void down_phase(LAS unsigned char* lds, const unsigned char* HBp, const unsigned char* Wd, const unsigned char* Wsd, volatile LAS int* tab, const u32x2* meta, unsigned char* Yp, unsigned char* trash, int G, int c) {
    int tid = threadIdx.x; asm volatile("" : "+v"(tid));
    const int wid = __builtin_amdgcn_readfirstlane(tid >> 6), lane = tid & 63, j = lane & 31, hi = lane >> 5;
    const int U = tab[65] * 8;
    const int u_lo = (int)(((long)c * U) / G), u_hi = (int)(((long)(c + 1) * U) / G);
    if (u_lo >= u_hi) return;
#define DN_DEC(u_, e_, hf_, ci_) do { e_ = __builtin_amdgcn_readfirstlane(tab[132 + ((u_) >> 3)]); const int ul_ = __builtin_amdgcn_readfirstlane((u_) - 8 * tab[e_]), nc_ = __builtin_amdgcn_readfirstlane(4 * (tab[e_ + 1] - tab[e_])); hf_ = (ul_ >= nc_) ? 1 : 0; ci_ = ul_ - hf_ * nc_; } while (0)
    unsigned dvo; { const int r_ = lane >> 3, f_ = ((r_ >> 1) & 3) << 1; dvo = (unsigned)(r_ * 256 + (((lane & 7) ^ f_) * 16)); }
#define DN_DMA(u_, buf_) do { int e__, hf__, ci__; DN_DEC(u_, e__, hf__, ci__); (void)hf__; const unsigned char* gb_ = HBp + ((size_t)tab[e__] * 256 + (size_t)ci__ * 64) * DEXP; \
        _Pragma("unroll") for (int i_ = 0; i_ < 2; ++i_) { const int q_ = wid * 2 + i_, kb_ = q_ >> 3, g_ = q_ & 7; \
            __builtin_amdgcn_global_load_lds((const unsigned*)(gb_ + (size_t)(8 * g_) * DEXP + kb_ * 128 + dvo), (LAS unsigned*)(lds + (buf_) * CHB + kb_ * 8192 + g_ * 1024), 16, 0, 0); } } while (0)
    int rowb[2], fx[2];
#pragma unroll
    for (int rt = 0; rt < 2; ++rt) { const int row = 32 * rt + j; rowb[rt] = (int)(uintptr_t)lds + row * 128; fx[rt] = (((row >> 1) & 3) << 1) * 16; }
    unsigned sc1 = 0x7f7f7f7fu; asm volatile("" : "+v"(sc1));
#pragma unroll
    for (int p = 0; p < AHEAD; ++p) { const int un = (u_lo + p < u_hi) ? u_lo + p : u_lo; DN_DMA(un, p); }
    int u = u_lo;
    while (u < u_hi) {
      int e, hf, ci0; DN_DEC(u, e, hf, ci0);
      const int nc = __builtin_amdgcn_readfirstlane(4 * (tab[e + 1] - tab[e])), ne = __builtin_amdgcn_readfirstlane(tab[66 + e]);
      int seg_end = 8 * tab[e] + (hf + 1) * nc; seg_end = __builtin_amdgcn_readfirstlane(seg_end < u_hi ? seg_end : u_hi);
      v8i32_t wfr[2][4];
#pragma unroll
      for (int nt = 0; nt < 2; ++nt) { const unsigned char* wp = ((e == NEXP) ? Wsd : Wd + (size_t)e * D * DEXP) + (size_t)(512 * hf + 64 * wid + 32 * nt + nloc(j)) * DEXP + 32 * hi;
#pragma unroll
          for (int ks = 0; ks < 4; ++ks) { wfr[nt][ks].lo = *(const v4i32_t*)(wp + 64 * ks); wfr[nt][ks].hi = *(const v4i32_t*)(wp + 64 * ks + 16); } }
      bool first = true;
      for (; u < seg_end; ++u) {
        const int buf = (u - u_lo) & (NSLOT - 1); (void)ci0;
        const int cidx = __builtin_amdgcn_readfirstlane((u - 8 * tab[e]) - hf * nc);
        u32x2 mt[2];
#pragma unroll
        for (int rt = 0; rt < 2; ++rt) { int pos = 64 * cidx + 32 * rt + j; const bool in = pos < ne; const int sp = pos; pos = (in && e != NEXP) ? pos : 0; const u32x2 m = meta[(size_t)(e == NEXP ? 0 : e) * LISTCAP + pos];
            mt[rt] = !in ? (u32x2){0xffffffffu, 0u} : (e == NEXP) ? (u32x2){(unsigned)(sp * (TOPK + 1) + TOPK), 0x3f800000u} : m; }
        if (first) { __builtin_amdgcn_s_waitcnt(0x0F70); first = false; }
        else { asm volatile("s_waitcnt vmcnt(54)" ::: "memory"); }
        LDS_WAIT(); __builtin_amdgcn_s_barrier();
        { const int un = (u + AHEAD < u_hi) ? u + AHEAD : u; DN_DMA(un, (buf + AHEAD) & (NSLOT - 1)); }
        f32x16 acc[2][2];
#pragma unroll
        for (int rt = 0; rt < 2; ++rt)
#pragma unroll
            for (int nt = 0; nt < 2; ++nt) asm volatile("v_mov_b32 %0, 0\n\tv_mov_b32 %1, 0\n\tv_mov_b32 %2, 0\n\tv_mov_b32 %3, 0\n\tv_mov_b32 %4, 0\n\tv_mov_b32 %5, 0\n\tv_mov_b32 %6, 0\n\tv_mov_b32 %7, 0\n\tv_mov_b32 %8, 0\n\tv_mov_b32 %9, 0\n\tv_mov_b32 %10, 0\n\tv_mov_b32 %11, 0\n\tv_mov_b32 %12, 0\n\tv_mov_b32 %13, 0\n\tv_mov_b32 %14, 0\n\tv_mov_b32 %15, 0"
                : "=v"(acc[rt][nt][0]), "=v"(acc[rt][nt][1]), "=v"(acc[rt][nt][2]), "=v"(acc[rt][nt][3]), "=v"(acc[rt][nt][4]), "=v"(acc[rt][nt][5]), "=v"(acc[rt][nt][6]), "=v"(acc[rt][nt][7]),
                  "=v"(acc[rt][nt][8]), "=v"(acc[rt][nt][9]), "=v"(acc[rt][nt][10]), "=v"(acc[rt][nt][11]), "=v"(acc[rt][nt][12]), "=v"(acc[rt][nt][13]), "=v"(acc[rt][nt][14]), "=v"(acc[rt][nt][15]));
        v8i32_t ha0, ha1, hb0, hb1;
        const int ad0 = rowb[0] + buf * CHB, ad1 = rowb[1] + buf * CHB;
#define DN_RDA(ks_) do { \
            asm volatile("ds_read_b128 v[192:195], %1 offset:%c2\n\tds_read_b128 v[196:199], %1 offset:%c3" : "={v[192:199]}"(ha0) : "v"(ad0 + ((64 * ((ks_) & 1) + 32 * hi) ^ fx[0])), "i"(((ks_) >> 1) * 8192), "i"(((ks_) >> 1) * 8192 + 16) : "memory"); \
            asm volatile("ds_read_b128 v[200:203], %1 offset:%c2\n\tds_read_b128 v[204:207], %1 offset:%c3" : "={v[200:207]}"(ha1) : "v"(ad1 + ((64 * ((ks_) & 1) + 32 * hi) ^ fx[1])), "i"(((ks_) >> 1) * 8192), "i"(((ks_) >> 1) * 8192 + 16) : "memory"); } while (0)
#define DN_RDB(ks_) do { \
            asm volatile("ds_read_b128 v[208:211], %1 offset:%c2\n\tds_read_b128 v[212:215], %1 offset:%c3" : "={v[208:215]}"(hb0) : "v"(ad0 + ((64 * ((ks_) & 1) + 32 * hi) ^ fx[0])), "i"(((ks_) >> 1) * 8192), "i"(((ks_) >> 1) * 8192 + 16) : "memory"); \
            asm volatile("ds_read_b128 v[216:219], %1 offset:%c2\n\tds_read_b128 v[220:223], %1 offset:%c3" : "={v[216:223]}"(hb1) : "v"(ad1 + ((64 * ((ks_) & 1) + 32 * hi) ^ fx[1])), "i"(((ks_) >> 1) * 8192), "i"(((ks_) >> 1) * 8192 + 16) : "memory"); } while (0)
#define DN_MF(W_, ACC_, H_, REG_, WAIT_) asm volatile(WAIT_ "v_mfma_scale_f32_32x32x64_f8f6f4 %0, %1, %2, %0, %3, %3 op_sel_hi:[0,0,0]" : "+v"(ACC_) : "v"(W_), REG_(H_), "v"(sc1))
        DN_RDA(0);
#pragma unroll
        for (int ks = 0; ks < 4; ks += 2) {
            DN_RDB(ks + 1);
            DN_MF(wfr[0][ks], acc[0][0], ha0, "{v[192:199]}", "s_waitcnt lgkmcnt(4)\n\t"); DN_MF(wfr[1][ks], acc[0][1], ha0, "{v[192:199]}", "");
            DN_MF(wfr[0][ks], acc[1][0], ha1, "{v[200:207]}", ""); DN_MF(wfr[1][ks], acc[1][1], ha1, "{v[200:207]}", "");
            if (ks + 2 < 4) { DN_RDA(ks + 2);
                DN_MF(wfr[0][ks + 1], acc[0][0], hb0, "{v[208:215]}", "s_waitcnt lgkmcnt(4)\n\t"); }
            else { DN_MF(wfr[0][ks + 1], acc[0][0], hb0, "{v[208:215]}", "s_waitcnt lgkmcnt(0)\n\t"); }
            DN_MF(wfr[1][ks + 1], acc[0][1], hb0, "{v[208:215]}", "");
            DN_MF(wfr[0][ks + 1], acc[1][0], hb1, "{v[216:223]}", ""); DN_MF(wfr[1][ks + 1], acc[1][1], hb1, "{v[216:223]}", "");
        }
#undef DN_RDA
#undef DN_RDB
#undef DN_MF
        asm volatile("s_nop 15\n\ts_nop 7" : "+v"(acc[0][0]), "+v"(acc[0][1]), "+v"(acc[1][0]), "+v"(acc[1][1]) :: "memory");
        __builtin_amdgcn_sched_barrier(0);
        const int col0 = 512 * hf + 64 * wid + 16 * hi;
#pragma unroll
        for (int rt = 0; rt < 2; ++rt) { const bool ok = !NOTRAFFIC && mt[rt].x != 0xffffffffu; unsigned char* yd = ok ? Yp + (size_t)mt[rt].x * D : trash; const float w = ok ? __uint_as_float(mt[rt].y) * (1.f / (HSCALE8 * WSCALE8)) : 0.f;
#pragma unroll
            for (int nt = 0; nt < 2; ++nt) { u32x4 o;
#pragma unroll
                for (int q = 0; q < 4; ++q) { int v = __builtin_amdgcn_cvt_pk_fp8_f32(acc[rt][nt][4 * q] * w, acc[rt][nt][4 * q + 1] * w, 0, false);
                    v = __builtin_amdgcn_cvt_pk_fp8_f32(acc[rt][nt][4 * q + 2] * w, acc[rt][nt][4 * q + 3] * w, v, true); o[q] = (unsigned)v; }
                *(u32x4*)(yd + col0 + 32 * nt) = o; } }
      }
    }
    VM_WAIT(); LDS_WAIT(); __builtin_amdgcn_s_barrier();
#undef DN_DMA
#undef DN_DEC
}
}

namespace up {
__device__ __forceinline__ int nloc(int i) { return 16 * ((i >> 2) & 1) + (i & 3) + 4 * (i >> 3); }
__device__ __forceinline__ void up_phase(LAS unsigned char* lds, const bf16* QL, const bf16* KVL, const bf16* Wq, const bf16* Wkv, const float* ssqq, const float* ssqkv, const float* ropetab,
                                         bf16* Qo, bf16* KNo, bf16* VMo, int G, int c) {
    int tid = threadIdx.x; asm volatile("" : "+v"(tid));
    const int wid = __builtin_amdgcn_readfirstlane(tid >> 6), lane = tid & 63, j = lane & 31, hi = lane >> 5;
    for (int grp = c; grp < T / 64; grp += G) {
        const int row0 = grp * 64;
        { const int r_ = lane >> 3, p_ = lane & 7;
#pragma unroll
          for (int i = 0; i < 6; ++i) { const int q_ = wid * 6 + i;
              const bool isq = q_ < 32; const int rem = isq ? q_ : q_ - 32, kb = rem >> 3, g = rem & 7, f_ = (4 * (g & 1) + (r_ >> 1)) & 7;
              __builtin_amdgcn_global_load_lds((const unsigned*)((isq ? QL : KVL) + (size_t)(row0 + 8 * g + r_) * 256 + kb * 64 + ((p_ ^ f_) * 8)), (LAS unsigned*)(lds + (isq ? 0 : 32768) + kb * 8192 + g * 1024), 16, 0, 0); } }
        float rsq[2], rskv[2];
#pragma unroll
        for (int rt = 0; rt < 2; ++rt) { const int row = row0 + 32 * rt + j; const f32x4 a = *(const f32x4*)(ssqq + (size_t)row * 4), b4 = *(const f32x4*)(ssqkv + (size_t)row * 4);
            rsq[rt] = rsqrtf(((a[0] + a[1]) + (a[2] + a[3])) * (1.f / QLORA) + EPS) * C2M; rskv[rt] = rsqrtf(((b4[0] + b4[1]) + (b4[2] + b4[3])) * (1.f / KVLORA) + EPS); }
        const unsigned lane16 = (unsigned)lane * 16u;
        bf16x8 wA[16];
#define UP_LOADW(WB_, Wp_, col_, KS_) do { const char* wb_ = (const char*)(Wp_) + (size_t)__builtin_amdgcn_readfirstlane((col_) >> 5) * (KS_) * 1024;     \
            _Pragma("unroll") for (int ks = 0; ks < (KS_); ++ks) wA[(WB_) + ks] = *(const bf16x8*)(wb_ + ks * 1024 + lane16); } while (0)
#define UP_STEP(WB_, ISQ_, col_, KS_) do { f32x16 acc[2]; acc[0] = f32x16{}; acc[1] = f32x16{}; \
            _Pragma("unroll") for (int ks = 0; ks < (KS_); ++ks) { bf16x8 af[2]; \
                _Pragma("unroll") for (int rt = 0; rt < 2; ++rt) { const int row = 32 * rt + j, cc = 2 * (ks & 3) + hi; \
                    af[rt] = *(const LAS bf16x8*)(lds + ((ISQ_) ? 0 : 32768) + (ks >> 2) * 8192 + row * 128 + ((cc ^ ((row >> 1) & 7)) * 16)); } \
                _Pragma("unroll") for (int rt = 0; rt < 2; ++rt) acc[rt] = __builtin_amdgcn_mfma_f32_32x32x16_bf16(wA[(WB_) + ks], af[rt], acc[rt], 0, 0, 0); } \
            _Pragma("unroll") for (int rt = 0; rt < 2; ++rt) { const int row = row0 + 32 * rt + j; const float r_s = (ISQ_) ? rsq[rt] : rskv[rt]; const int col = (col_) + 16 * hi; \
                float v[16]; _Pragma("unroll") for (int r = 0; r < 16; ++r) v[r] = acc[rt][r] * r_s; \
                bf16* dst; \
                if (ISQ_) { const int jh = col % MQK; \
                    if (jh >= 64) { const int g0 = (jh - 64) >> 3; const f32x4* tb = (const f32x4*)(ropetab + ((size_t)row * 16 + 4 * g0) * 2); \
                        _Pragma("unroll") for (int gg = 0; gg < 2; ++gg) { const f32x4 t0 = tb[2 * gg], t1 = tb[2 * gg + 1]; float* w_ = v + 8 * gg; \
                            const float cs[4] = {t0[0], t0[2], t1[0], t1[2]}, sn[4] = {t0[1], t0[3], t1[1], t1[3]}; \
                            _Pragma("unroll") for (int q = 0; q < 4; ++q) { const float x1 = w_[q], x2 = w_[4 + q]; w_[q] = x1 * cs[q] - x2 * sn[q]; w_[4 + q] = x2 * cs[q] + x1 * sn[q]; } } } \
                    dst = Qo + (size_t)row * 768 + col; } \
                else dst = (col >= 512 ? VMo + (col - 512) : KNo + col) + (size_t)row * 512; \
                *(u32x4*)dst = (u32x4){cvt_pk_bf16(v[0], v[1]), cvt_pk_bf16(v[2], v[3]), cvt_pk_bf16(v[4], v[5]), cvt_pk_bf16(v[6], v[7])}; \
                *(u32x4*)(dst + 8) = (u32x4){cvt_pk_bf16(v[8], v[9]), cvt_pk_bf16(v[10], v[11]), cvt_pk_bf16(v[12], v[13]), cvt_pk_bf16(v[14], v[15])}; } } while (0)
        const int cq = 96 * wid, ckv = 128 * wid;
#define UP_SB() __builtin_amdgcn_sched_barrier(0)
        UP_LOADW(0, Wq, cq, 16);
        VM_WAIT(); __syncthreads();
        UP_STEP(0, true, cq, 16);        UP_SB(); UP_LOADW(0, Wq, cq + 32, 16); UP_SB();
        UP_STEP(0, true, cq + 32, 16);   UP_SB(); UP_LOADW(0, Wq, cq + 64, 16); UP_SB();
        UP_STEP(0, true, cq + 64, 16);   UP_SB(); UP_LOADW(0, Wkv, ckv, 8); UP_LOADW(8, Wkv, ckv + 32, 8); UP_SB();
        UP_STEP(0, false, ckv, 8);       UP_SB(); UP_LOADW(0, Wkv, ckv + 64, 8); UP_SB();
        UP_STEP(8, false, ckv + 32, 8);  UP_SB(); UP_LOADW(8, Wkv, ckv + 96, 8); UP_SB();
        UP_STEP(0, false, ckv + 64, 8);  UP_SB();
        UP_STEP(8, false, ckv + 96, 8);
#undef UP_SB
#undef UP_LOADW
#undef UP_STEP
        __syncthreads();
    }
}
}

#define XB_TMO      128
#define XB_XCNT(j)  (256  + 64 * (j))
#define XB_XSUB(j)  (1280 + 64 * (j))
#define XB_XGEN(j)  (2304 + 64 * (j))
#define XB_TOP      3328
#define XB_TOPGEN   3392
#define XCD_BAR_WORDS 3456
#define XB_SPIN_CAP (1u << 18)
__device__ __forceinline__ unsigned xb_ld(unsigned* p)              { return __hip_atomic_load(p, __ATOMIC_RELAXED, __HIP_MEMORY_SCOPE_AGENT); }
__device__ __forceinline__ unsigned xb_add(unsigned* p, unsigned v) { return __hip_atomic_fetch_add(p, v, __ATOMIC_RELAXED, __HIP_MEMORY_SCOPE_AGENT); }
__device__ __forceinline__ unsigned xb_xcc_id() { return (unsigned)__builtin_amdgcn_s_getreg((3 << 11) | 20) & 0xFu; }
#define XB_SPIN(cond, bar) do { unsigned _sp = 0; while (cond) { __builtin_amdgcn_s_sleep(1); \
    if ((++_sp & 255u) == 0u) { if (xb_ld(&(bar)[XB_TMO])) break; if (_sp > XB_SPIN_CAP) { atomicAdd(&(bar)[XB_TMO], 1u); break; } } } } while (0)
struct XcdBarrier { unsigned* bar; unsigned x; volatile LAS unsigned* st; };
__device__ __forceinline__ XcdBarrier xcd_barrier_post(unsigned* bar, volatile LAS unsigned* st) {
    XcdBarrier b; b.bar = bar; b.x = xb_xcc_id(); b.st = st;
    if (threadIdx.x == 0) (void)xb_add(&bar[XB_XCNT(b.x)], 1u);
    return b;
}
__device__ __forceinline__ void xcd_barrier_complete(unsigned* bar, unsigned x, unsigned& nloc, unsigned& nx) {
    const unsigned G = gridDim.x * gridDim.y * gridDim.z;
    unsigned sum, cnt, mine, sp = 0u;
    for (;;) {
        sum = 0u; cnt = 0u; mine = 0u;
#pragma unroll
        for (unsigned j = 0; j < 16; ++j) { const unsigned c = xb_ld(&bar[XB_XCNT(j)]); sum += c; cnt += (c > 0u) ? 1u : 0u; mine = (j == x) ? c : mine; }
        if (sum == G) break;
        __builtin_amdgcn_s_sleep(1);
        if ((++sp & 255u) == 0u) { if (xb_ld(&bar[XB_TMO])) break; if (sp > XB_SPIN_CAP) { atomicAdd(&bar[XB_TMO], 1u); break; } }
    }
    nloc = mine > 0u ? mine : 1u; nx = cnt > 0u ? cnt : 1u;
}
__device__ __forceinline__ void xcd_barrier(const XcdBarrier& b) {
    asm volatile("s_waitcnt vmcnt(0)" ::: "memory");
    __syncthreads();
    if (threadIdx.x == 0) {
        unsigned* bar = b.bar;
        __builtin_amdgcn_s_waitcnt(0);
        unsigned nloc = b.st[0], nx = b.st[1];
        if (nloc == 0u) { xcd_barrier_complete(bar, b.x, nloc, nx); b.st[0] = nloc; b.st[1] = nx; }
        const unsigned old = xb_add(&bar[XB_XSUB(b.x)], 1u);
        const unsigned gen = old / nloc;
        if (old + 1u == (gen + 1u) * nloc) {
            __builtin_amdgcn_fence(__ATOMIC_RELEASE, "agent");
            asm volatile("s_waitcnt vmcnt(0)" ::: "memory");
            const unsigned og = xb_add(&bar[XB_TOP], 1u);
            const unsigned tg = og / nx;
            if (og + 1u == (tg + 1u) * nx) xb_add(&bar[XB_TOPGEN], 1u);
            else XB_SPIN(xb_ld(&bar[XB_TOPGEN]) == tg, bar);
            __builtin_amdgcn_fence(__ATOMIC_ACQUIRE, "agent");
            xb_add(&bar[XB_XGEN(b.x)], 1u);
            asm volatile("s_waitcnt vmcnt(0)" ::: "memory");
        } else {
            XB_SPIN(xb_ld(&bar[XB_XGEN(b.x)]) == gen, bar);
            __builtin_amdgcn_fence(__ATOMIC_ACQUIRE, "agent");
            asm volatile("s_waitcnt vmcnt(0)" ::: "memory");
        }
    }
    __syncthreads();
}

struct Args { const void* in[25]; float* out; unsigned char* ws; int ph_lo, ph_hi; };

struct Frame {
    LAS unsigned char* lds;
    int tid, lane, wave, vcu, G;
};

template <class ColFn>
__device__ __forceinline__ void cvt_item(int ldw, int Ksrc, const float* kscale, bf16* WT, int Kd, LAS float* scr, int kb, int nb, int lane, ColFn colp) {
    const int k0 = 64 * kb, n0 = 32 * nb;
    const float* cp = colp(n0 + (lane & 31));
    float vv[32], sv[32];
#pragma unroll
    for (int i = 0; i < 32; ++i) { const int k = k0 + 2 * i + (lane >> 5);
        vv[i] = (cp != nullptr && k < Ksrc) ? cp[(size_t)k * ldw] : 0.f;
        sv[i] = (kscale != nullptr && k < Ksrc) ? kscale[k] : 1.f; }
#pragma unroll
    for (int i = 0; i < 32; ++i) scr[(2 * i + (lane >> 5)) * 33 + (lane & 31)] = vv[i] * sv[i];
    LDS_WAIT(); asm volatile("" ::: "memory");
    const int c = lane & 7;
#pragma unroll
    for (int j = 0; j < 4; ++j) { const int n = (lane >> 3) + 8 * j; const LAS float* s = scr + (8 * c) * 33 + n;
        u32x4 o; o.x = pk2(s[0 * 33], s[1 * 33]); o.y = pk2(s[2 * 33], s[3 * 33]); o.z = pk2(s[4 * 33], s[5 * 33]); o.w = pk2(s[6 * 33], s[7 * 33]);
        *(u32x4*)(WT + (size_t)(n0 + n) * Kd + k0 + 8 * c) = o; }
    LDS_WAIT(); asm volatile("" ::: "memory");
}
__device__ __forceinline__ void cvt64_item(const float* src, int ldw, bf16* dst, int Kd, LAS unsigned char* scr, int lane) {
    f32x4 v[16];
    const float* sp = src + (size_t)(lane >> 4) * ldw + 4 * (lane & 15);
#pragma unroll
    for (int i = 0; i < 16; ++i) v[i] = __builtin_nontemporal_load((const f32x4*)(sp + (size_t)(4 * i) * ldw));
#pragma unroll
    for (int i = 0; i < 16; ++i) { const int k = 4 * i + (lane >> 4);
#pragma unroll
        for (int q = 0; q < 4; ++q) { const int n = 4 * (lane & 15) + q; *(LAS bf16*)(scr + n * 128 + (((k >> 3) ^ ((n >> 2) & 7)) << 4) + (k & 7) * 2) = (bf16)f2bf(v[i][q]); } }
    LDS_WAIT(); asm volatile("" ::: "memory");
#pragma unroll
    for (int j = 0; j < 8; ++j) { const int p = j * 64 + lane, n = p >> 3, c = p & 7;
        const u32x4 o = *(const LAS u32x4*)(scr + n * 128 + ((c ^ ((n >> 2) & 7)) << 4));
        __builtin_nontemporal_store(o, (u32x4*)(dst + (size_t)n * Kd + c * 8)); }
    LDS_WAIT(); asm volatile("" ::: "memory");
}
__device__ __forceinline__ void cvt64_item8(const float* src, int ldw, unsigned char* dst, int Kd8, LAS unsigned char* scr, int lane, float scale) {
    f32x4 v[16];
    const float* sp = src + (size_t)(16 * (lane >> 4)) * ldw + 4 * (lane & 15);
#pragma unroll
    for (int i = 0; i < 16; ++i) v[i] = __builtin_nontemporal_load((const f32x4*)(sp + (size_t)i * ldw));
#pragma unroll
    for (int q = 0; q < 4; ++q) { u32x4 o;
#pragma unroll
        for (int g = 0; g < 4; ++g) { int p_ = __builtin_amdgcn_cvt_pk_fp8_f32(v[4 * g][q] * scale, v[4 * g + 1][q] * scale, 0, false); p_ = __builtin_amdgcn_cvt_pk_fp8_f32(v[4 * g + 2][q] * scale, v[4 * g + 3][q] * scale, p_, true); o[g] = (unsigned)p_; }
        *(LAS u32x4*)(scr + (4 * (lane & 15) + q) * 80 + (lane >> 4) * 16) = o; }
    LDS_WAIT(); asm volatile("" ::: "memory");
#pragma unroll
    for (int j = 0; j < 4; ++j) { const int p = j * 64 + lane, n = p >> 2, c = p & 3;
        const u32x4 o = *(const LAS u32x4*)(scr + n * 80 + c * 16);
        __builtin_nontemporal_store(o, (u32x4*)(dst + (size_t)n * Kd8 + c * 16)); }
    LDS_WAIT(); asm volatile("" ::: "memory");
}
__device__ __forceinline__ int ropedim(int jj) { const int g = jj >> 3, u = jj & 7; return (u < 4) ? 4 * g + u : 16 + 4 * g + (u - 4); }

__device__ __forceinline__ void sincos_acc(float af, float& sn, float& cs) {
    const double a = (double)af; const double kq = __builtin_rint(a * 0.63661977236758134308);
    const double r = (a - kq * 1.57079632679489655800) - kq * 6.123233995736766036e-17;
    const double r2 = r * r;
    const double sp = r * (1.0 + r2 * (-1.66666666666666324348e-01 + r2 * (8.33333333332248946124e-03 + r2 * (-1.98412698298579493134e-04 + r2 * (2.75573137070700676789e-06 + r2 * (-2.50507602534068634195e-08 + r2 * 1.58969099521155010221e-10))))));
    const double cp = 1.0 + r2 * (-0.5 + r2 * (4.16666666666666019037e-02 + r2 * (-1.38888888888741095749e-03 + r2 * (2.48015872894767294178e-05 + r2 * (-2.75573143513906633035e-07 + r2 * (2.08757232129817482790e-09 + r2 * -1.13596475577881948265e-11))))));
    const int q = (int)((long long)kq & 3);
    const double s_ = (q == 0) ? sp : (q == 1) ? cp : (q == 2) ? -sp : -cp;
    const double c_ = (q == 0) ? cp : (q == 1) ? -sp : (q == 2) ? -cp : sp;
    sn = (float)s_; cs = (float)c_;
}

__global__ void __launch_bounds__(NWAVES * 64, 2) fwd(Args args) {
    extern __shared__ __attribute__((aligned(16))) unsigned char lds_raw[];
    Frame F;
    F.lds = (LAS unsigned char*)lds_raw;
    F.tid = threadIdx.x; F.lane = F.tid & 63; F.wave = __builtin_amdgcn_readfirstlane(F.tid >> 6);
    F.G = gridDim.x; { const int bx = blockIdx.x; F.vcu = (F.G % 8 == 0) ? (bx % 8) * (F.G / 8) + bx / 8 : bx; }
    volatile LAS unsigned* MISC = (volatile LAS unsigned*)(F.lds + MISC_OFF);
    unsigned char* ws = args.ws;
    gu32* ctl = (gu32*)(ws + WS_CTL);
#define X_IN ((const float*)AP->in[0])
#define cvec ((const float*)AP->in[1])
#define positions ((const int*)AP->in[2])
#define w_mod ((const float*)AP->in[3])
#define b_mod ((const float*)AP->in[4])
#define g_mix ((const float*)AP->in[5])
#define w_in ((const float*)AP->in[6])
#define b_forget ((const float*)AP->in[7])
#define g_q_lat ((const float*)AP->in[8])
#define w_q_up ((const float*)AP->in[9])
#define g_kv_lat ((const float*)AP->in[10])
#define w_kv_up ((const float*)AP->in[11])
#define w_o_mla ((const float*)AP->in[12])
#define w_o_fox ((const float*)AP->in[13])
#define w_out ((const float*)AP->in[14])
#define g_ffn ((const float*)AP->in[15])
#define w_router ((const float*)AP->in[16])
#define b_router ((const float*)AP->in[17])
#define w_exp_gate ((const float*)AP->in[18])
#define w_exp_up ((const float*)AP->in[19])
#define w_exp_down ((const float*)AP->in[20])
#define w_sh_gate ((const float*)AP->in[21])
#define w_sh_up ((const float*)AP->in[22])
#define w_sh_down ((const float*)AP->in[23])
#define g_final ((const float*)AP->in[24])
#define Win_t ((bf16*)(ws + WS_WIN))
#define Wq_t ((bf16*)(ws + WS_WQ))
#define Wkv_t ((bf16*)(ws + WS_WKV))
#define Wom_t ((bf16*)(ws + WS_WOM))
#define Wof_t ((bf16*)(ws + WS_WOF))
#define Wout_t ((bf16*)(ws + WS_WOUT))
#define Wsgu_t ((bf16*)(ws + WS_WSGU))
#define Wsd_t ((bf16*)(ws + WS_WSD))
#define Wr_f ((bf16*)(ws + WS_WR))
#define mod ((float*)(ws + WS_MOD))
#define Wd_t ((bf16*)(ws + WS_WD))
#define Wgu_t ((bf16*)(ws + WS_WGU))
#define HB ((bf16*)(ws + WS_HB))
#define FQ ((bf16*)(ws + WS_FQ))
#define FK ((bf16*)(ws + WS_FK))
#define FV ((bf16*)(ws + WS_FV))
#define QLAT ((bf16*)(ws + WS_QLAT))
#define KVLAT ((bf16*)(ws + WS_KVLAT))
#define OFOX ((bf16*)(ws + WS_OFOX))
#define OCAT ((bf16*)((unsigned char*)out + 32 * MiB))
#define OMLA ((bf16*)(ws + WS_OMLA))
#define Y ((bf16*)(ws + WS_Y))
#define H ((bf16*)(ws + WS_H))
#define QMLA ((bf16*)(ws + WS_QMLA))
#define GATES ((bf16*)(ws + WS_GATES))
#define KN ((bf16*)(ws + WS_KN))
#define VM ((bf16*)(ws + WS_VM))
#define KPE ((bf16*)(ws + WS_KPE))
#define MERGED ((bf16*)(ws + WS_MERGED))
#define LIST ((unsigned short*)(ws + WS_LIST))
#define Wgu8 ((unsigned char*)(ws + WS_WGU))
#define Wsgu8 ((unsigned char*)(ws + WS_WSGU))
#define H8 ((unsigned char*)(ws + WS_H))
#define META ((u32x2*)(ws + WS_WIN))
#define EIDX ((unsigned char*)(ws + WS_EIDX))
#define GATEW ((float*)(ws + WS_GATEW))
#define ROPETAB ((float*)((unsigned char*)out + DO_ROPE))
#define LOGF ((float*)((unsigned char*)out + DO_LOGF))
#define CUMF ((float*)((unsigned char*)out + DO_CUMF))
#define SSQQ ((float*)((unsigned char*)out + DO_SSQQ))
#define SSQKV ((float*)((unsigned char*)out + DO_SSQKV))
#define MODP ((float*)((unsigned char*)out + DO_MODP))
#define SSQ1 ((float*)(ws + WS_FQ))
    float* const out = args.out;
#define PHASE_ENV const __attribute__((address_space(4))) Args* AP; { auto kp_ = __builtin_amdgcn_kernarg_segment_ptr(); asm volatile("" : "+s"(kp_)); AP = (const __attribute__((address_space(4))) Args*)kp_; } \
    unsigned char* const ws = AP->ws; float* const out = AP->out; (void)ws; (void)out;
    for (int u = F.tid; u < (LDS_BYTES - LDSCTL_OFF) / 4; u += NWAVES * 64) ((LAS unsigned*)(F.lds + LDSCTL_OFF))[u] = 0u;
    __syncthreads();
    XcdBarrier bar; bar.bar = (unsigned*)(ctl + CW_BAR); bar.x = 0; bar.st = nullptr;
    if (MK_ONE_LAUNCH) bar = xcd_barrier_post((unsigned*)(ctl + CW_BAR), MISC + 8);
    const int lo = args.ph_lo, hi = args.ph_hi;
#define IN(k) (lo <= (k) && (k) < hi)
#define BOTH(k) (IN(k) && IN((k) + 1))
#define GRID_BAR() do { if (MK_ONE_LAUNCH) xcd_barrier(bar); } while (0)
#define DUP_BAR() do { if (dummy) xcd_barrier(bar); } while (0)
    const int gw = F.vcu * NWAVES + F.wave, NGW = F.G * NWAVES;

    for (int rep = 0; rep < ((PROBE_DUP == 0) ? 2 : 1); ++rep) if (IN(0)) { PHASE_ENV const bool dummy = (PROBE_DUP == 0) && rep == 0; (void)dummy;
        if (!(dummy && (PROBE_VAR == 1 || PROBE_VAR == 4 || PROBE_VAR == 5))) {
            LAS float* cond = (LAS float*)F.lds;
            for (int i = F.tid; i < NB * D; i += NWAVES * 64) { const float c = cvec[i]; cond[i] = c / (1.f + __expf(-c)); }
            __syncthreads();
            for (int it = F.wave * F.G + F.vcu; it < 96 * 16; it += NWAVES * F.G) { const int cg = it % 96, kq = it / 96, col = cg * 64 + F.lane;
                float a4[4] = {0.f, 0.f, 0.f, 0.f};
                const float* wp = w_mod + (size_t)(64 * kq) * (6 * D) + col;
                float wv[64];
#pragma unroll
                for (int kk = 0; kk < 64; ++kk) wv[kk] = __builtin_nontemporal_load(wp + (size_t)kk * (6 * D));
#pragma unroll
                for (int kk = 0; kk < 64; ++kk) {
#pragma unroll
                    for (int b = 0; b < 4; ++b) a4[b] += wv[kk] * cond[b * D + 64 * kq + kk]; }
#pragma unroll
                for (int b = 0; b < 4; ++b) MODP[((size_t)kq * 4 + b) * (6 * D) + col] = a4[b]; }
            __syncthreads();
        }
        if (!(dummy && (PROBE_VAR == 1 || PROBE_VAR == 3 || PROBE_VAR == 5))) for (int i = gw * 64 + F.lane; i < T * 16; i += NGW * 64) { const int t = i >> 4, j = i & 15;
            const float invf = (((j >> 2) == 0) ? 1.f : ((j >> 2) == 1) ? 0.1f : ((j >> 2) == 2) ? 0.01f : 0.001f) * (((j & 3) == 0) ? 1.f : ((j & 3) == 1) ? 0.5623413251903491f : ((j & 3) == 2) ? 0.31622776601683794f : 0.17782794100389228f);
            const float ang = (float)positions[t] * invf; float sn, cs; sincos_acc(ang, sn, cs);
            *(f32x2*)(ROPETAB + (size_t)i * 2) = (f32x2){cs, sn}; }
        for (int o = gw * 64 + F.lane; o < NEXP * D; o += NGW * 64) { const int piece = o >> 3, kk = o & 7, ln = piece & 63, grp = piece >> 6, ntl = grp & 3, j = grp >> 2;
            const int n = ntl * 16 + (ln & 15), k = j * 32 + (ln >> 4) * 8 + kk; Wr_f[o] = (bf16)f2bf(w_router[(size_t)k * NEXP + n]); }
        {
            LAS unsigned char* scr8 = F.lds + 32768 + F.wave * 9216;
            constexpr int F_IN = 62 * 16;
            if (!(dummy && PROBE_VAR >= 2)) for (int it = gw; it < F_IN; it += NGW) {
                int nb = it % 62; const int kb = it / 62; if (nb >= 6) nb += 2; const int n0 = 64 * nb;
                const int src = (n0 < 384) ? n0 : (n0 < 2048) ? 416 + (n0 - 512) : 1960 + (n0 - 2048);
                cvt64_item(w_in + (size_t)(64 * kb) * 4008 + src, 4008, Win_t + (size_t)n0 * D + 64 * kb, D, scr8, F.lane);
            }
            LAS float* scr = (LAS float*)(F.lds + 32768 + F.wave * 9216);
            constexpr int I_INS = 4 * (D / 64), NSLOW = I_INS;
            if (!(dummy && (PROBE_VAR == 1 || PROBE_VAR == 3 || PROBE_VAR == 4))) for (int it = F.wave * F.G + F.vcu; it < NSLOW; it += NGW) {
                const int nb = 12 + (it & 3), kb = it >> 2;
                cvt_item(4008, D, nullptr, Win_t, D, scr, kb, nb, F.lane, [&](int n) -> const float* {
                    int src; if (n < 416) src = 384 + ropedim(n - 384); else if (n < 424) src = 1952 + (n - 416); else src = -1;
                    return src < 0 ? nullptr : w_in + src; });
            }
            if (!(dummy && (PROBE_VAR == 1 || PROBE_VAR == 3 || PROBE_VAR == 4))) {
                for (int o = gw * 64 + F.lane; o < 768 * QLORA; o += NGW * 64) { const int cb = o >> 13, rem = o & 8191, ks = rem >> 9, ln = (rem >> 3) & 63, e = rem & 7;
                    const int n = cb * 32 + up::nloc(ln & 31), k = 16 * ks + 8 * (ln >> 5) + e, hh = n / MQK, jj = n % MQK, sc = hh * MQK + (jj < 64 ? jj : 64 + ropedim(jj - 64));
                    Wq_t[o] = (bf16)f2bf(w_q_up[(size_t)k * 768 + sc] * g_q_lat[k]); }
                for (int o = gw * 64 + F.lane; o < 1024 * KVLORA; o += NGW * 64) { const int cb = o >> 12, rem = o & 4095, ks = rem >> 9, ln = (rem >> 3) & 63, e = rem & 7;
                    const int n = cb * 32 + up::nloc(ln & 31), k = 16 * ks + 8 * (ln >> 5) + e, sc = (n < 512) ? (n >> 6) * 128 + (n & 63) : ((n - 512) >> 6) * 128 + 64 + (n & 63);
                    Wkv_t[o] = (bf16)f2bf(w_kv_up[(size_t)k * 1024 + sc] * g_kv_lat[k]); }
            }
        }
        if (BOTH(0)) GRID_BAR();
    }

    for (int rep = 0; rep < ((PROBE_DUP == 1) ? 2 : 1); ++rep) if (IN(1)) { PHASE_ENV const bool dummy = (PROBE_DUP == 1) && rep == 0; (void)dummy;
        if (F.vcu < 48) { const int idx = F.vcu * 512 + F.tid, b = idx / (6 * D), col = idx % (6 * D); float sm = b_mod[col];
#pragma unroll
            for (int p = 0; p < 16; ++p) sm += MODP[((size_t)p * 4 + b) * (6 * D) + col];
            mod[idx] = sm; }
        LAS float* vg1 = (LAS float*)F.lds; LAS float* vs1 = (LAS float*)(F.lds + 4096);
        for (int grp = F.vcu; grp < T / 64; grp += F.G) {
            const int b = (grp * 64) / SEQ;
            __syncthreads();
            for (int k = F.tid; k < D; k += NWAVES * 64) { float s0 = b_mod[k], s1 = b_mod[D + k];
#pragma unroll
                for (int p = 0; p < 16; ++p) { s0 += MODP[((size_t)p * 4 + b) * (6 * D) + k]; s1 += MODP[((size_t)p * 4 + b) * (6 * D) + D + k]; }
                vs1[k] = s0; vg1[k] = g_mix[k] * (1.f + s1); }
            __syncthreads();
#pragma unroll 2
            for (int rr = 0; rr < 8; ++rr) { const int m = grp * 64 + F.wave * 8 + rr;
                const f32x4* xr = (const f32x4*)(X_IN + (size_t)m * D) + F.lane;
                f32x4 v[4]; float s = 0.f;
#pragma unroll
                for (int j = 0; j < 4; ++j) { v[j] = __builtin_nontemporal_load(xr + 64 * j); s += (v[j].x * v[j].x + v[j].y * v[j].y) + (v[j].z * v[j].z + v[j].w * v[j].w); }
                const float rstd = rsqrtf(wave_sum(s) * (1.f / D) + EPS);
                unsigned long long* o8 = (unsigned long long*)(H + (size_t)m * D) + F.lane;
#pragma unroll
                for (int j = 0; j < 4; ++j) { const int c = 4 * F.lane + 256 * j;
                    const f32x4 g = *(const LAS f32x4*)(vg1 + c), d = *(const LAS f32x4*)(vs1 + c);
                    const f32x4 r = v[j] * rstd * g + d;
                    o8[64 * j] = (unsigned long long)pk2(r.x, r.y) | ((unsigned long long)pk2(r.z, r.w) << 32); } }
        }
        if (BOTH(1)) GRID_BAR();
    }

    for (int rep = 0; rep < ((PROBE_DUP == 2) ? 2 : 1); ++rep) if (IN(2)) { PHASE_ENV const bool dummy = (PROBE_DUP == 2) && rep == 0; (void)dummy;
        pg8::StaticOrder S; S.init(H, Win_t, T, NIN, D, F.G, (int)blockIdx.x);
        EpiInProj E{QLAT, KVLAT, KPE, FQ, GATES, LOGF, SSQQ, SSQKV, ROPETAB, b_forget, dummy && (PROBE_VAR == 1), (dummy && PROBE_VAR == 2) ? 0 : (dummy && PROBE_VAR == 3) ? 2 : 1};
        pg8::gemm_phase<EpiInProj, pg8::StaticOrder, true>(F.lds, S, E);
        if (BOTH(2)) GRID_BAR();
    }

    for (int rep = 0; rep < ((PROBE_DUP == 3) ? 2 : 1); ++rep) if (IN(3)) { PHASE_ENV const bool dummy = (PROBE_DUP == 3) && rep == 0; (void)dummy;
        if (!(dummy && (PROBE_VAR == 2 || PROBE_VAR == 3))) {
            const int bb = F.vcu & 3; float mx = 0.f, mq = 0.f;
            for (int r = (F.vcu >> 2) * NWAVES + F.wave; r < SEQ; r += (F.G >> 2) * NWAVES) { f32x4 k0, k1, q0v, q1v; unpack8(*(const u32x4*)(FK + ((size_t)bb * SEQ + r) * 512 + 8 * F.lane), k0, k1);
                unpack8(*(const u32x4*)(FQ + ((size_t)bb * SEQ + r) * 512 + 8 * F.lane), q0v, q1v);
                float sq = (k0[0] * k0[0] + k0[1] * k0[1]) + (k0[2] * k0[2] + k0[3] * k0[3]) + (k1[0] * k1[0] + k1[1] * k1[1]) + (k1[2] * k1[2] + k1[3] * k1[3]);
                float sqq = (q0v[0] * q0v[0] + q0v[1] * q0v[1]) + (q0v[2] * q0v[2] + q0v[3] * q0v[3]) + (q1v[0] * q1v[0] + q1v[1] * q1v[1]) + (q1v[2] * q1v[2] + q1v[3] * q1v[3]);
                sq += dppf<0xB1>(sq); sq += dppf<0x4E>(sq); sq += dppf<0x141>(sq);
                sqq += dppf<0xB1>(sqq); sqq += dppf<0x4E>(sqq); sqq += dppf<0x141>(sqq);
                mx = fmaxf(mx, sq); mq = fmaxf(mq, sqq); }
            LAS float* kml = (LAS float*)F.lds;
            if ((F.lane & 7) == 0) { kml[F.wave * 8 + (F.lane >> 3)] = mx; kml[64 + F.wave * 8 + (F.lane >> 3)] = mq; }
            __syncthreads();
            if (F.tid < 2 * NHEAD) { const int hh = F.tid & 7, qk = F.tid >> 3; float m2 = 0.f;
#pragma unroll
                for (int w = 0; w < NWAVES; ++w) m2 = fmaxf(m2, kml[qk * 64 + w * 8 + hh]);
                atomicMax((unsigned*)(ctl + CW_KM + qk * 32 + bb * NHEAD + hh), __float_as_uint(m2)); }
            __syncthreads();
        }
        if (F.vcu < NB * NHEAD && !(dummy && (PROBE_VAR == 1 || PROBE_VAR == 3))) {
            const int b = F.vcu >> 3, h = F.vcu & 7; const float* src = LOGF + ((size_t)b * SEQ + 8 * F.tid) * 8 + h;
            float v[8]; float run = 0.f;
#pragma unroll
            for (int i = 0; i < 8; ++i) v[i] = src[i * 8];
#pragma unroll
            for (int i = 0; i < 8; ++i) { run += v[i]; v[i] = run; }
            float incl = run;
#pragma unroll
            for (int o = 1; o < 64; o <<= 1) { const float n = __shfl_up(incl, o); if (F.lane >= o) incl += n; }
            LAS float* wt = (LAS float*)F.lds;
            if (F.lane == 63) wt[F.wave] = incl;
            __syncthreads();
            float woff = 0.f;
#pragma unroll
            for (int w = 0; w < NWAVES; ++w) woff += (w < F.wave) ? wt[w] : 0.f;
            const float excl = woff + incl - run;
            float* dst = CUMF + ((size_t)b * NHEAD + h) * SEQ + 8 * F.tid;
            *(f32x4*)dst = (f32x4){v[0] + excl, v[1] + excl, v[2] + excl, v[3] + excl}; *(f32x4*)(dst + 4) = (f32x4){v[4] + excl, v[5] + excl, v[6] + excl, v[7] + excl};
            __syncthreads();
        }
        if (!(dummy && (PROBE_VAR == 1 || PROBE_VAR == 2))) up::up_phase(F.lds, QLAT, KVLAT, Wq_t, Wkv_t, SSQQ, SSQKV, ROPETAB, QMLA, KN, VM, F.G, (int)blockIdx.x);
        if (BOTH(3)) GRID_BAR();
    }

    for (int rep = 0; rep < ((PROBE_DUP == 4) ? 2 : 1); ++rep) if (IN(4)) { PHASE_ENV const bool dummy = (PROBE_DUP == 4) && rep == 0; (void)dummy;
        {
            const bool xq = (F.G % 8) == 0; const int x = xq ? (int)(blockIdx.x & 7) : 0, nunits = xq ? 128 : 1024;
            constexpr int F_O = 16 * 8, F_OUT = 16 * 16, F_SGU = 8 * 16, F_SD = 16 * 4, F_EGU = NEXP * F_SGU, F_ED = NEXP * F_SD;
            constexpr int NCONV = F_EGU + F_ED + 2 * F_O + F_OUT + F_SGU + F_SD, NCBATCH = (NCONV + 31) / 32;
            const int NQ = xq ? 8 : 1, ncb = (NCBATCH - x + NQ - 1) / NQ, A0 = xq ? CONV_A0 : 8 * CONV_A0;
            gu32* qh = ctl + CW_Q + 64 * x + (dummy ? 16 : 0);
            volatile LAS unsigned* qw = (volatile LAS unsigned*)(F.lds + MISC_OFF + 64);
            for (int nit = 0;; ++nit) {
                if (F.tid == 0) qw[nit & 1] = __hip_atomic_fetch_add(qh, 1u, RLX_AGENT);
                __syncthreads();
                int r = __builtin_amdgcn_readfirstlane((int)qw[nit & 1]);
                if (r >= nunits + ncb) break;
                if (r >= A0 && r < A0 + ncb) { const int cb = x + NQ * (r - A0);
                    LAS unsigned char* scr8 = F.lds + 32768 + F.wave * 9216;
                    int ln_ = F.lane; asm volatile("" : "+v"(ln_));
                    for (int kr = 0; kr < 4; ++kr) { int it = 32 * cb + 8 * kr + F.wave; if (it >= NCONV) break;
                        const float* src; unsigned char* dst; int ldw, kd8;
                        if (it < F_EGU) { const int e = it / F_SGU, rr = it % F_SGU, nb = rr & 7, kb = rr >> 3, pn = nb >> 2, c0 = (nb & 3) * 64;
                            src = ((c0 < 128) ? w_exp_gate : w_exp_up) + (size_t)e * D * DEXP + pn * 128 + (c0 & 127) + (size_t)(64 * kb) * DEXP; ldw = DEXP;
                            dst = Wgu8 + (size_t)e * 512 * D + (size_t)(64 * nb) * D + 64 * kb; kd8 = D; }
                        else if ((it -= F_EGU) < F_ED) { const int e = it / F_SD, rr = it % F_SD, nb = rr & 15, kb = rr >> 4;
                            src = w_exp_down + (size_t)e * DEXP * D + (size_t)(64 * kb) * D + 64 * nb; ldw = D; dst = (unsigned char*)Wd_t + (size_t)e * D * DEXP + (size_t)(64 * nb) * DEXP + 64 * kb; kd8 = DEXP; }
                        else if ((it -= F_ED) < 2 * F_O) { const int fx = it >= F_O, i2 = it - (fx ? F_O : 0), nb = i2 & 15, kb = i2 >> 4;
                            src = (fx ? w_o_fox : w_o_mla) + (size_t)(64 * kb) * D + 64 * nb; ldw = D; dst = (unsigned char*)Wom_t + (size_t)(64 * nb) * D + (fx ? 512 : 0) + 64 * kb; kd8 = D; }
                        else if ((it -= 2 * F_O) < F_OUT) { const int nb = it & 15, kb = it >> 4; src = w_out + (size_t)(64 * kb) * D + 64 * nb; ldw = D; dst = (unsigned char*)Wout_t + (size_t)(64 * nb) * D + 64 * kb; kd8 = D; }
                        else if ((it -= F_OUT) < F_SGU) { const int nb = it >> 4, kb = it & 15, pn = nb >> 2, c0 = (nb & 3) * 64;
                            src = ((c0 < 128) ? w_sh_gate : w_sh_up) + pn * 128 + (c0 & 127) + (size_t)(64 * kb) * DEXP; ldw = DEXP; dst = Wsgu8 + (size_t)(64 * nb) * D + 64 * kb; kd8 = D; }
                        else { it -= F_SGU; const int nb = it >> 2, kb = it & 3; src = w_sh_down + (size_t)(64 * kb) * D + 64 * nb; ldw = D; dst = (unsigned char*)Wsd_t + (size_t)(64 * nb) * DEXP + 64 * kb; kd8 = DEXP; }
                        cvt64_item8(src, ldw, dst, kd8, scr8, ln_, WSCALE8);
                    }
                    continue; }
                if (r >= A0) r -= ncb;
                int qb, type, b, h;
                if (xq) { qb = 15 - (r >> 3); type = (r >> 2) & 1; b = r & 3; h = (x + 3 * b) & 7; }
                else { qb = 15 - (r >> 6); type = (r >> 5) & 1; b = (r >> 3) & 3; h = r & 7; }
                if (type == 0) { if (ATT_TUNED_FOX && qb != 0) att::attn_unit_t<64, true, 8>(b, h, qb, FQ, 512, FK, KPE, FV, CUMF, __uint_as_float(__hip_atomic_load((unsigned*)(ctl + CW_KM + b * NHEAD + h), RLX_AGENT)) * __uint_as_float(__hip_atomic_load((unsigned*)(ctl + CW_KM + 32 + b * NHEAD + h), RLX_AGENT)), (bf16*)((unsigned char*)(dummy ? (bf16*)((unsigned char*)out + 4 * MiB) : OCAT) + 512), D, F.lds);
                                 else att::attn_unit<64, true, 8>(b, h, qb, FQ, 512, FK, KPE, FV, CUMF, (bf16*)((unsigned char*)(dummy ? (bf16*)((unsigned char*)out + 4 * MiB) : OCAT) + 512), D, F.lds); }
                else { if (ATT_TUNED_MLA && qb != 0) att::attn_unit_t<96, false, 8>(b, h, qb, QMLA, 768, KN, KPE, VM, nullptr, 0.f, dummy ? (bf16*)((unsigned char*)out + 4 * MiB) : OCAT, D, F.lds);
                       else att::attn_unit<96, false, 8>(b, h, qb, QMLA, 768, KN, KPE, VM, nullptr, dummy ? (bf16*)((unsigned char*)out + 4 * MiB) : OCAT, D, F.lds); }
            }
        }
        if (BOTH(4)) GRID_BAR();
    }

    for (int rep = 0; rep < ((PROBE_DUP == 5) ? 2 : 1); ++rep) if (IN(5)) { PHASE_ENV const bool dummy = (PROBE_DUP == 5) && rep == 0; (void)dummy;
        pg8::StaticOrder S; S.init(OCAT, Wom_t, T, D, D / 2, F.G, (int)blockIdx.x);
        EpiMergedCat E{GATES, (unsigned char*)MERGED, 1.f / WSCALE8};
        pg8::gemm_phase<EpiMergedCat, pg8::StaticOrder, true, true>(F.lds, S, E);
        if (BOTH(5)) GRID_BAR();
    }

    for (int rep = 0; rep < ((PROBE_DUP == 6) ? 2 : 1); ++rep) if (IN(6)) { PHASE_ENV const bool dummy = (PROBE_DUP == 6) && rep == 0; (void)dummy;
        pg8::StaticOrder S; S.init(MERGED, Wout_t, T, D, D / 2, F.G, (int)blockIdx.x);
        EpiOut E{X_IN, out, mod, SSQ1, 1.f / (OSCALE8 * WSCALE8)};
        pg8::gemm_phase<EpiOut, pg8::StaticOrder, true, true>(F.lds, S, E);
        if (BOTH(6)) GRID_BAR();
    }

    for (int rep = 0; rep < ((PROBE_DUP == 7) ? 2 : 1); ++rep) if (IN(7)) { PHASE_ENV const bool dummy = (PROBE_DUP == 7) && rep == 0; (void)dummy;
        LAS unsigned char* wrl = F.lds;
        LAS float* vg = (LAS float*)(F.lds + LDSCTL_OFF + 6144);
        LAS float* vs = (LAS float*)(F.lds + LDSCTL_OFF + 10240);
        LAS float* stg = (LAS float*)(F.lds) + F.wave * 512;
        LAS int* cntw = (LAS int*)(F.lds + 16384);
        LAS int* basel = (LAS int*)(F.lds + 16384 + 2048);
        static_assert(LDSCTL_OFF + 10240 + 4096 <= LDS_BYTES && MOETAB_OFF + 4700 <= LDSCTL_OFF + 6144, "P7 LDS map");
        const float my_bias = b_router[F.lane];
        for (int grp = F.vcu; grp < T / 64; grp += F.G) {
            const int b = (grp * 64) / SEQ;
            __syncthreads();
#pragma unroll
            for (int i = 0; i < 16; ++i) __builtin_amdgcn_global_load_lds((const unsigned*)((const char*)Wr_f + (F.wave * 16 + i) * 1024 + F.lane * 16), (LAS unsigned*)(wrl + (F.wave * 16 + i) * 1024), 16, 0, 0);
            for (int i = F.tid; i < D; i += NWAVES * 64) { vg[i] = g_ffn[i] * (1.f + mod[(size_t)b * 6 * D + 4 * D + i]); vs[i] = mod[(size_t)b * 6 * D + 3 * D + i]; }
            const int t0 = grp * 64 + F.wave * 8;
            float rs_mine;
            { const float* sp = SSQ1 + (size_t)(t0 + (F.lane & 7)) * 16; const f32x4 a = *(const f32x4*)sp, b4 = *(const f32x4*)(sp + 4), c4 = *(const f32x4*)(sp + 8), d4 = *(const f32x4*)(sp + 12);
              const float ssum = (((a[0] + a[1]) + (a[2] + a[3])) + ((b4[0] + b4[1]) + (b4[2] + b4[3]))) + (((c4[0] + c4[1]) + (c4[2] + c4[3])) + ((d4[0] + d4[1]) + (d4[2] + d4[3])));
              rs_mine = rsqrtf(ssum * (1.f / D) + EPS); }
            VM_WAIT(); __syncthreads();
            const int r16 = F.lane & 15, kg = F.lane >> 4, myrow = t0 + (r16 & 7);
            const float* xrow = out + (size_t)myrow * D + 8 * kg;
            f32x4 lacc[4] = {{0.f, 0.f, 0.f, 0.f}, {0.f, 0.f, 0.f, 0.f}, {0.f, 0.f, 0.f, 0.f}, {0.f, 0.f, 0.f, 0.f}};
            f32x4 xq[16][2];
#pragma unroll
            for (int p = 0; p < 16; ++p) { xq[p][0] = *(const f32x4*)(xrow + 32 * p); xq[p][1] = *(const f32x4*)(xrow + 32 * p + 4); }
            for (int j4 = 0; j4 < 32; j4 += 16) {
#pragma unroll
                for (int p = 0; p < 16; ++p) { const int j = j4 + p, k = 32 * j + 8 * kg;
                    const f32x4 x0 = xq[p][0], x1v = xq[p][1];
                    if (j4 + 16 < 32) { xq[p][0] = *(const f32x4*)(xrow + 32 * (j + 16)); xq[p][1] = *(const f32x4*)(xrow + 32 * (j + 16) + 4); }
                    const f32x4 g0 = *(const LAS f32x4*)(vg + k), g1 = *(const LAS f32x4*)(vg + k + 4), s0 = *(const LAS f32x4*)(vs + k), s1 = *(const LAS f32x4*)(vs + k + 4);
                    const f32x4 h0 = x0 * rs_mine * g0 + s0, h1 = x1v * rs_mine * g1 + s1;
                    const u32x4 hw = pack8(h0, h1);
                    f32x4 a0, a1; unpack8(hw, a0, a1);
                    const u32x4 lw = pack8(h0 - a0, h1 - a1);
                    if (r16 < 8) { u32x2 h8; int p_ = __builtin_amdgcn_cvt_pk_fp8_f32(h0[0], h0[1], 0, false); p_ = __builtin_amdgcn_cvt_pk_fp8_f32(h0[2], h0[3], p_, true); h8.x = (unsigned)p_;
                        p_ = __builtin_amdgcn_cvt_pk_fp8_f32(h1[0], h1[1], 0, false); p_ = __builtin_amdgcn_cvt_pk_fp8_f32(h1[2], h1[3], p_, true); h8.y = (unsigned)p_;
                        *(u32x2*)(H8 + (size_t)myrow * D + k) = h8; }
                    const bf16x8 Ah = __builtin_bit_cast(bf16x8, hw), Al = __builtin_bit_cast(bf16x8, lw);
#pragma unroll
                    for (int ntl = 0; ntl < 4; ++ntl) { const bf16x8 Wf = *(const LAS bf16x8*)(wrl + ((j * 4 + ntl) * 64 + F.lane) * 16);
                        lacc[ntl] = __builtin_amdgcn_mfma_f32_16x16x32_bf16(Wf, Ah, lacc[ntl], 0, 0, 0);
                        lacc[ntl] = __builtin_amdgcn_mfma_f32_16x16x32_bf16(Wf, Al, lacc[ntl], 0, 0, 0); } }
            }
            __syncthreads();
            if (r16 < 8) {
#pragma unroll
                for (int ntl = 0; ntl < 4; ++ntl) *(LAS f32x4*)(stg + r16 * 64 + 16 * ntl + 4 * kg) = lacc[ntl]; }
            LDS_WAIT();
            int cnt = 0; unsigned selbits = 0u, selks = 0u;
            for (int j = 0; j < 8; ++j) {
                const float logit = stg[j * 64 + F.lane];
                const float sc = 1.f / (1.f + expf(-logit));
                const float ch = sc + my_bias;
                const float m1 = max8(ch);
                const unsigned long long eq = __ballot(ch == m1);
                const unsigned gm = (unsigned)(eq >> (F.lane & ~7)) & 0xffu;
                const int first = __builtin_ctz(gm);
                const float c2 = max8(((F.lane & 7) == first) ? -INFINITY : ch);
                const float gs = m1 + c2; const int myg = F.lane >> 3;
                int rank = 0;
#pragma unroll
                for (int g = 0; g < 8; ++g) { const float o = __builtin_bit_cast(float, __builtin_amdgcn_readlane(__builtin_bit_cast(int, gs), 8 * g)); rank += (o > gs || (o == gs && g < myg)) ? 1 : 0; }
                float mc = (rank < 4) ? ch : -1e30f;
                int selk = -1;
#pragma unroll
                for (int k = 0; k < TOPK; ++k) { const float mx = wave_max_f(mc); const unsigned long long bl = __ballot(mc == mx); const int fl = __builtin_ctzll(bl);
                    if (F.lane == fl) { selk = k; mc = -INFINITY; } }
                const float ssum = wave_sum_f(selk >= 0 ? sc : 0.f);
                if (selk >= 0) { const int t = t0 + j; EIDX[(size_t)t * 8 + selk] = (unsigned char)F.lane; GATEW[(size_t)t * 8 + selk] = sc / ssum * 2.5f; ++cnt; selbits |= 1u << j; selks |= (unsigned)selk << (3 * j); }
            }
            cntw[F.wave * 64 + F.lane] = cnt;
            __syncthreads();
            if (F.wave == 0) { int tot = 0;
#pragma unroll
                for (int w = 0; w < 8; ++w) tot += cntw[w * 64 + F.lane];
                basel[F.lane] = (int)__hip_atomic_fetch_add((unsigned*)(ctl + (dummy ? CW_CNT + 2048 : CW_CNT) + 16 * F.lane), (unsigned)tot, RLX_AGENT); }
            __syncthreads();
            int pos = basel[F.lane];
            for (int w = 0; w < F.wave; ++w) pos += cntw[w * 64 + F.lane];
#pragma unroll
            for (int j = 0; j < 8; ++j) if ((selbits >> j) & 1u) { const int k = (selks >> (3 * j)) & 7, t = t0 + j;
                LIST[(size_t)F.lane * LISTCAP + pos] = (unsigned short)t;
                META[(size_t)F.lane * LISTCAP + pos] = (u32x2){(unsigned)(t * (TOPK + 1) + k), __float_as_uint(GATEW[(size_t)t * 8 + k])}; ++pos; }
        }
        __syncthreads();
        if (BOTH(7)) GRID_BAR();
    }

    volatile LAS int* tab = (volatile LAS int*)(F.lds + MOETAB_OFF);
    if (IN(8) || IN(9)) {
        __syncthreads();
        if (F.wave == 0) {
            const int n = (int)__hip_atomic_load((unsigned*)(ctl + CW_CNT + 16 * F.lane), RLX_AGENT);
            const int tiles = (n + 255) >> 8; int incl = tiles;
#pragma unroll
            for (int o = 1; o < 64; o <<= 1) { const int v = __shfl_up(incl, o); if (F.lane >= o) incl += v; }
            tab[F.lane] = incl - tiles; tab[66 + F.lane] = n;
            if (F.lane == 63) { tab[64] = incl; tab[65] = incl + T / 256; tab[66 + 64] = T; }
        }
        __syncthreads();
        { const int ti = F.tid; int e = 0;
          for (int q = 0; q <= NEXP; ++q) if (tab[q] <= ti) e = q;
          tab[132 + ti] = e; }
        __syncthreads();
    }
    for (int rep = 0; rep < ((PROBE_DUP == 8) ? 2 : 1); ++rep) if (IN(8)) { PHASE_ENV const bool dummy = (PROBE_DUP == 8) && rep == 0; (void)dummy;
        MoeOrder<2, true> S{(const char*)H8, (const char*)Wgu8, (const char*)Wsgu8, D / 2, (size_t)512 * D, LIST, tab, F.G, (int)blockIdx.x};
        EpiHb E{(unsigned char*)HB, 1.f / WSCALE8};
        pg8::gemm_phase<EpiHb, MoeOrder<2, true>, true, true>(F.lds, S, E);
        if (BOTH(8)) GRID_BAR();
    }
    for (int rep = 0; rep < ((PROBE_DUP == 9) ? 2 : 1); ++rep) if (IN(9)) { PHASE_ENV const bool dummy = (PROBE_DUP == 9) && rep == 0; (void)dummy;
        if (dummy && PROBE_VAR == 1) dn::down_phase<true>(F.lds, (const unsigned char*)HB, (const unsigned char*)Wd_t, (const unsigned char*)Wsd_t, tab, META, (unsigned char*)Y, (unsigned char*)(ws + WS_CTL + 900 * 1024), F.G, (int)blockIdx.x);
        else dn::down_phase<false>(F.lds, (const unsigned char*)HB, (const unsigned char*)Wd_t, (const unsigned char*)Wsd_t, tab, META, (unsigned char*)Y, (unsigned char*)(ws + WS_CTL + 900 * 1024), F.G, (int)blockIdx.x);
        if (BOTH(9)) GRID_BAR();
    }

    for (int rep = 0; rep < ((PROBE_DUP == 10) ? 2 : 1); ++rep) if (IN(10)) { PHASE_ENV const bool dummy = (PROBE_DUP == 10) && rep == 0; (void)dummy;
        int ln10 = F.lane; asm volatile("" : "+v"(ln10));
        for (int m = gw; m < T; m += NGW) {
            const int b = m / SEQ; const float* gf = mod + (size_t)b * 6 * D + 5 * D;
            f32x4* xr = (f32x4*)(out + (size_t)m * D) + ln10;
            f32x4* xw = dummy ? (f32x4*)((float*)HB + (size_t)m * D) + ln10 : xr;
            f32x4 v[4]; float s = 0.f;
#pragma unroll
            for (int j = 0; j < 4; ++j) { const int c = 4 * ln10 + 256 * j;
                f32x4 y = {0.f, 0.f, 0.f, 0.f};
#pragma unroll
                for (int k = 0; k < TOPK + 1; ++k) { const int w = __builtin_nontemporal_load((const int*)((const unsigned char*)Y + ((size_t)m * (TOPK + 1) + k) * D + c));
                    const f32x2 lo = __builtin_amdgcn_cvt_pk_f32_fp8(w, false), hi2 = __builtin_amdgcn_cvt_pk_f32_fp8(w, true);
                    y += (f32x4){lo.x, lo.y, hi2.x, hi2.y}; }
                v[j] = __builtin_nontemporal_load(xr + 64 * j) + *(const f32x4*)(gf + c) * y;
                s += (v[j].x * v[j].x + v[j].y * v[j].y) + (v[j].z * v[j].z + v[j].w * v[j].w); }
            const float rstd = rsqrtf(wave_sum(s) * (1.f / D) + EPS);
#pragma unroll
            for (int j = 0; j < 4; ++j) __builtin_nontemporal_store(v[j] * rstd * *(const f32x4*)(g_final + 4 * ln10 + 256 * j), xw + 64 * j);
        }
    }
#undef IN
#undef BOTH
#undef GRID_BAR
}

constexpr int NPHASE = 11;
extern "C" void kernel_launch(void* const* d_in, const int* in_sizes, int n_in, void* d_out, int out_size, void* d_ws, size_t ws_size, hipStream_t stream) {
    static int grid = 0;
    if (grid == 0) {
        if (n_in != 25 || out_size != T * D || ws_size < WS_END) { fprintf(stderr, "kernel_launch: unexpected shapes (n_in %d out %d ws %zu need %zu)\n", n_in, out_size, ws_size, (size_t)WS_END); grid = -1; return; }
        int dev = 0, cus = 0;
        if (hipGetDevice(&dev) != hipSuccess || hipDeviceGetAttribute(&cus, hipDeviceAttributeMultiprocessorCount, dev) != hipSuccess) { grid = -1; return; }
        if (hipFuncSetAttribute((const void*)fwd, hipFuncAttributeMaxDynamicSharedMemorySize, LDS_BYTES) != hipSuccess) { fprintf(stderr, "kernel_launch: hipFuncSetAttribute failed\n"); grid = -1; return; }
        int per_cu = 0;
        if (hipOccupancyMaxActiveBlocksPerMultiprocessor(&per_cu, (const void*)fwd, NWAVES * 64, LDS_BYTES) != hipSuccess || per_cu < 1) { fprintf(stderr, "kernel_launch: occupancy query says %d\n", per_cu); }
        (void)hipGetLastError();
        grid = cus;
    }
    if (grid < 0) return;
    (void)in_sizes;
    if (hipMemsetAsync((char*)d_ws + WS_CTL, 0, CTL_ZERO_BYTES, stream) != hipSuccess) return;
    Args a{};
    for (int i = 0; i < 25; ++i) a.in[i] = d_in[i];
    a.out = (float*)d_out; a.ws = (unsigned char*)d_ws;
#if MK_ONE_LAUNCH
    a.ph_lo = 0; a.ph_hi = NPHASE;
    hipLaunchKernelGGL(fwd, dim3(grid), dim3(NWAVES * 64), LDS_BYTES, stream, a);
#else
    for (int p = 0; p < NPHASE; ++p) { a.ph_lo = p; a.ph_hi = p + 1; hipLaunchKernelGGL(fwd, dim3(grid), dim3(NWAVES * 64), LDS_BYTES, stream, a); }
#endif
}
```

```cpp
#include <hip/hip_runtime.h>
#include <cstdio>
#include <cstdint>
#include <type_traits>

#ifndef MK_ONE_LAUNCH
#ifndef CONV_A0
#define CONV_A0 28
#endif
#define MK_ONE_LAUNCH 1
#endif

#ifndef PROBE_DUP
#define PROBE_DUP -1
#endif
#ifndef ATT_TUNED_FOX
#define ATT_TUNED_FOX 1
#endif
#ifndef ATT_TUNED_MLA
#define ATT_TUNED_MLA 1
#endif
#ifndef PROBE_VAR
#define PROBE_VAR 0
#endif
#define GAS __attribute__((address_space(1)))
#define LAS __attribute__((address_space(3)))
typedef unsigned short bf16;
typedef short bf16x8 __attribute__((ext_vector_type(8)));
typedef short s16x4 __attribute__((ext_vector_type(4)));
typedef float f32x2 __attribute__((ext_vector_type(2)));
typedef float f32x4 __attribute__((ext_vector_type(4)));
typedef float f32x16 __attribute__((ext_vector_type(16)));
typedef unsigned u32x2 __attribute__((ext_vector_type(2)));
typedef unsigned u32x4 __attribute__((ext_vector_type(4)));
typedef GAS unsigned gu32;
typedef int v8i32_t __attribute__((ext_vector_type(8)));
typedef int v4i32_t __attribute__((ext_vector_type(4)));

constexpr int NB = 4, SEQ = 4096, T = NB * SEQ, D = 1024;
constexpr int NIN = 4096;
constexpr int QLORA = 256, KVLORA = 128, KVPAD = 256, ROPE = 32, NHEAD = 8, HD = 64, MQK = 96;
constexpr int NEXP = 64, TOPK = 6, DEXP = 256;
constexpr float EPS = 1e-6f;
constexpr float LOG2E = 1.4426950408889634f;
constexpr float C2F = 0.125f * LOG2E;
constexpr float C2M = 0.10206207261596577f * LOG2E;
constexpr int LISTCAP = T;
constexpr float HSCALE8 = 8.f;
constexpr float OSCALE8 = 8.f;
constexpr float WSCALE8 = 64.f;

constexpr size_t MiB = 1u << 20;
constexpr size_t WS_CTL = 0, CTL_ZERO_BYTES = 1 * MiB;
constexpr size_t WS_EIDX = 262144, WS_GATEW = 393216;
constexpr size_t WS_WIN = 1 * MiB, WS_WQ = 9 * MiB, WS_WKV = 9 * MiB + 512 * 1024, WS_WOM = 10 * MiB, WS_WOF = 11 * MiB, WS_WOUT = 12 * MiB;
constexpr size_t WS_WSGU = 14 * MiB, WS_WSD = 15 * MiB, WS_WR = 15 * MiB + 512 * 1024, WS_MOD = 15 * MiB + 640 * 1024;
constexpr size_t WS_WD = 16 * MiB;
constexpr size_t WS_HB = 48 * MiB;
constexpr size_t WS_FQ = 48 * MiB, WS_FK = 64 * MiB, WS_FV = 80 * MiB, WS_QLAT = 96 * MiB, WS_KVLAT = 104 * MiB;
constexpr size_t WS_OFOX = WS_FQ, WS_OMLA = WS_QLAT;
static_assert(WS_FK - WS_FQ == (size_t)T * 512 * 2 && WS_FV - WS_FK == (size_t)T * 512 * 2, "fq|fk|fv contiguous");
constexpr size_t WS_Y = 112 * MiB;
constexpr size_t WS_WGU = 112 * MiB;
constexpr size_t WS_H = 176 * MiB;
constexpr size_t WS_QMLA = WS_H;
constexpr size_t WS_GATES = 208 * MiB;
constexpr size_t WS_KN = 272 * MiB, WS_VM = 288 * MiB, WS_KPE = 304 * MiB;
constexpr size_t WS_MERGED = WS_KN;
constexpr size_t WS_LIST = 304 * MiB;
constexpr size_t WS_END = 306 * MiB;
constexpr size_t DO_MODP = 4 * MiB;
constexpr size_t DO_ROPE = 0, DO_LOGF = 2 * MiB, DO_CUMF = 2 * MiB + 512 * 1024, DO_SSQQ = 3 * MiB, DO_SSQKV = 3 * MiB + 256 * 1024;

constexpr int CW_TMO = 0;
constexpr int CW_BAR = 4096;
constexpr int CW_CNT = 8192;
constexpr int CW_KM = 12288;
constexpr int CW_Q = 12544;

constexpr int RING_BYTES = 131072;
constexpr int LDSCTL_OFF = RING_BYTES;
constexpr int MISC_OFF = LDSCTL_OFF + 320;
constexpr int MOETAB_OFF = LDSCTL_OFF + 1024;
constexpr int LDS_BYTES = 147456;

constexpr int NWAVES = 8;

#define LDS_WAIT() asm volatile("s_waitcnt lgkmcnt(0)" ::: "memory")
#define VM_WAIT() asm volatile("s_waitcnt vmcnt(0)" ::: "memory")
#define RLX_AGENT __ATOMIC_RELAXED, __HIP_MEMORY_SCOPE_AGENT
__device__ __forceinline__ unsigned f2bf(float f) { unsigned u = __builtin_bit_cast(unsigned, f); return (u + 0x7fffu + ((u >> 16) & 1u)) >> 16; }
__device__ __forceinline__ float bf2f(unsigned h) { return __builtin_bit_cast(float, h << 16); }
__device__ __forceinline__ unsigned pk2(float lo, float hi) { return f2bf(lo) | (f2bf(hi) << 16); }
__device__ __forceinline__ unsigned cvt_pk_bf16(float lo, float hi) { unsigned r; asm volatile("v_cvt_pk_bf16_f32 %0, %1, %2" : "=v"(r) : "v"(lo), "v"(hi)); return r; }
__device__ __forceinline__ u32x4 pack8(f32x4 a, f32x4 b) { u32x4 w; w.x = cvt_pk_bf16(a[0], a[1]); w.y = cvt_pk_bf16(a[2], a[3]); w.z = cvt_pk_bf16(b[0], b[1]); w.w = cvt_pk_bf16(b[2], b[3]); return w; }
__device__ __forceinline__ void unpack8(u32x4 w, f32x4& a, f32x4& b) {
    a = (f32x4){bf2f(w.x & 0xffffu), bf2f(w.x >> 16), bf2f(w.y & 0xffffu), bf2f(w.y >> 16)};
    b = (f32x4){bf2f(w.z & 0xffffu), bf2f(w.z >> 16), bf2f(w.w & 0xffffu), bf2f(w.w >> 16)};
}
__device__ __forceinline__ float wave_sum(float v) {
#pragma unroll
    for (int o = 1; o < 64; o <<= 1) v += __shfl_xor(v, o);
    return v;
}
__device__ __forceinline__ float wave_max(float v) {
#pragma unroll
    for (int o = 1; o < 64; o <<= 1) v = fmaxf(v, __shfl_xor(v, o));
    return v;
}
template <int CTRL> __device__ __forceinline__ float dppf(float v) { return __builtin_bit_cast(float, __builtin_amdgcn_update_dpp(0, __builtin_bit_cast(int, v), CTRL, 0xf, 0xf, true)); }
__device__ __forceinline__ float max8(float v) { v = fmaxf(v, dppf<0xB1>(v)); v = fmaxf(v, dppf<0x4E>(v)); v = fmaxf(v, dppf<0x141>(v)); return v; }
__device__ __forceinline__ float wave_max_f(float v) { v = max8(v); v = fmaxf(v, dppf<0x140>(v)); v = fmaxf(v, __shfl_xor(v, 16)); v = fmaxf(v, __shfl_xor(v, 32)); return v; }
__device__ __forceinline__ float wave_sum_f(float v) { v += dppf<0xB1>(v); v += dppf<0x4E>(v); v += dppf<0x141>(v); v += dppf<0x140>(v); v += __shfl_xor(v, 16); v += __shfl_xor(v, 32); return v; }
__device__ __forceinline__ float sigmoidf_(float x) { return __builtin_amdgcn_rcpf(1.f + __builtin_amdgcn_exp2f(-LOG2E * x)); }
__device__ __forceinline__ float siluf_(float x) { return x * __builtin_amdgcn_rcpf(1.f + __builtin_amdgcn_exp2f(-LOG2E * x)); }

namespace pg8 {
constexpr int BM = 256, BK = 64, HALF = 128, HTB = HALF * BK * 2, NXCD = 8, WGM = 8;
__host__ __device__ __forceinline__ int lds_byte(int r, int c) { const int st = (r >> 4) * 2 + (c >> 5), rr = r & 15, cc = c & 31, ob = rr * 64 + cc * 2; return st * 1024 + (ob ^ (((ob >> 9) & 1) << 5)); }
__host__ __device__ __forceinline__ void stage_rc(int b, int& R, int& C) { const int st = b / 1024, sb = b % 1024, swz = sb ^ (((sb >> 9) & 1) << 5); R = (st >> 1) * 16 + swz / 64; C = (st & 1) * 32 + (swz % 64) / 2; }
__host__ __device__ __forceinline__ int perm32(int rho) { const int n = rho >> 4, i = rho & 15; return 8 * (i >> 2) + 4 * n + (i & 3); }

struct Unit { int pm, pn, e, aux, n; };

struct StaticOrder {
    static constexpr bool GATHER = false;
    const char* A; const char* Bt; int K;
    int nM, nN, nwg, G, c;
    __device__ void init(const void* A_, const void* Bt_, int M, int N, int K_, int G_, int c_) { A = (const char*)A_; Bt = (const char*)Bt_; K = K_; nM = M / BM; nN = N / BM; nwg = nM * nN; G = G_; c = c_; }
    __device__ bool next(int i, Unit& u) const {
        const long L = (long)i * G + c; if (L >= nwg) return false;
        int wgid = (int)L; { const int q = nwg / NXCD, r = nwg % NXCD, xcd = wgid % NXCD, off = wgid / NXCD; wgid = (xcd < r ? xcd * (q + 1) : r * (q + 1) + (xcd - r) * q) + off; }
        const int nig = WGM * nN, gid = wgid / nig, fm = gid * WGM, gsz = (nM - fm) < WGM ? (nM - fm) : WGM;
        u.pm = fm + ((wgid % nig) % gsz); u.pn = (wgid % nig) / gsz; u.e = 0; u.aux = 0; u.n = BM; return true;
    }
    __device__ __forceinline__ const char* a_ptr(const Unit& u) const { return A + (size_t)u.pm * BM * K * 2; }
    __device__ __forceinline__ const char* b_ptr(const Unit& u) const { return Bt + (size_t)u.pn * BM * K * 2; }
    __device__ __forceinline__ unsigned a_row(const Unit&, int r) const { return (unsigned)r; }
};

template <class Epi, class Sched, bool ALIGN_EPI, bool FP8 = false>
__device__ __forceinline__ void gemm_phase(LAS unsigned char* lds, const Sched& S, const Epi& E) {
    int tid = threadIdx.x; asm volatile("" : "+v"(tid));
    const int wid = __builtin_amdgcn_readfirstlane(tid >> 6), lane = tid & 63, wr = wid >> 2, wc = wid & 3, fr = lane & 15, fq = lane >> 4;
    const int K = S.K, nt = K / BK;
    unsigned voffB[2], voffA[2];
#pragma unroll
    for (int i = 0; i < 2; ++i) { int R, C; stage_rc(tid * 16 + i * 8192, R, C); const int Rb = (R & ~31) + perm32(R & 31);
        voffA[i] = (unsigned)(R * K + C) * 2u; voffB[i] = (unsigned)(Rb * K + C) * 2u; }
    unsigned vA[2][2], vN[2][2];
    const size_t kstep = (size_t)(BK * 2);
    const size_t hstep = (size_t)HALF * K * 2;
    const unsigned ldsw = (unsigned)wid * 1024u;
    const int aoff = lds_byte(wr * 64 + fr, fq * 8), boff = lds_byte(wc * 32 + fr, fq * 8);
#define PG8_SA(b, h) (((b) * 2 + (h)) * HTB)
#define PG8_SB(b, h) ((4 + (b) * 2 + (h)) * HTB)
#define PG8_STAGE(bufoff, gbase, voff) do { _Pragma("unroll") for (int _i = 0; _i < 2; ++_i) \
        __builtin_amdgcn_global_load_lds((const unsigned*)((const char*)(gbase) + (voff)[_i]), (LAS unsigned*)(lds + (bufoff) + ldsw + _i * 8192), 16, 0, 0); } while (0)
#define PG8_STAGE_A(bufoff, gbase, h, nx) do { if constexpr (Sched::GATHER) { const unsigned vs_[2] = {(nx) ? vN[h][0] : vA[h][0], (nx) ? vN[h][1] : vA[h][1]}; PG8_STAGE(bufoff, gbase, vs_); }     \
        else PG8_STAGE(bufoff, (const char*)(gbase) + (h) * hstep, voffA); } while (0)
#define PG8_LDA(dst, b, h) do { _Pragma("unroll") for (int m = 0; m < 4; ++m) { if constexpr (FP8) { dst##8[m].lo = *(const LAS v4i32_t*)(lds + PG8_SA(b, h) + aoff + m * 2048); dst##8[m].hi = *(const LAS v4i32_t*)(lds + PG8_SA(b, h) + aoff + m * 2048 + 1024); } \
        else { _Pragma("unroll") for (int k = 0; k < 2; ++k) dst[m][k] = *(const LAS bf16x8*)(lds + PG8_SA(b, h) + aoff + m * 2048 + k * 1024); } } } while (0)
#define PG8_LDB(dst, b, h) do { _Pragma("unroll") for (int n = 0; n < 2; ++n) { if constexpr (FP8) { dst##8[n].lo = *(const LAS v4i32_t*)(lds + PG8_SB(b, h) + boff + n * 2048); dst##8[n].hi = *(const LAS v4i32_t*)(lds + PG8_SB(b, h) + boff + n * 2048 + 1024); } \
        else { _Pragma("unroll") for (int k = 0; k < 2; ++k) dst[n][k] = *(const LAS bf16x8*)(lds + PG8_SB(b, h) + boff + n * 2048 + k * 1024); } } } while (0)
#define PG8_MMA(ai, bj, At, Bt) do { __builtin_amdgcn_s_setprio(1); _Pragma("unroll") for (int m = 0; m < 4; ++m) _Pragma("unroll") for (int n = 0; n < 2; ++n) { \
        if constexpr (FP8) asm volatile("v_mfma_scale_f32_16x16x128_f8f6f4 %0, %1, %2, %0, %3, %3 op_sel_hi:[0,0,0]" : "+v"(acc[ai][bj][m][n]) : "v"(Bt##8[n]), "v"(At##8[m]), "v"(sc1_));     \
        else { _Pragma("unroll") for (int k = 0; k < 2; ++k) acc[ai][bj][m][n] = __builtin_amdgcn_mfma_f32_16x16x32_bf16(Bt[n][k], At[m][k], acc[ai][bj][m][n], 0, 0, 0); } } \
        __builtin_amdgcn_s_setprio(0); } while (0)
#define PG8_WAIT_V(n) asm volatile("s_waitcnt vmcnt(" #n ")" ::: "memory")
#define PG8_WAIT_L(n) asm volatile("s_waitcnt lgkmcnt(" #n ")" ::: "memory")
#define PG8_BAR __builtin_amdgcn_s_barrier()
#define PG8_SCHED __builtin_amdgcn_sched_barrier(0)
#define PG8_SETV(dst, u) do { _Pragma("unroll") for (int _h = 0; _h < 2; ++_h) _Pragma("unroll") for (int _i = 0; _i < 2; ++_i) { int R_, C_; stage_rc(tid * 16 + _i * 8192, R_, C_); \
        dst[_h][_i] = (S.a_row(u, _h * HALF + R_) * (unsigned)K + (unsigned)C_) * 2u; } } while (0)
    Unit cur, nxt; int ui = 0;
    if (!S.next(0, cur)) return;
    f32x4 acc[2][2][4][2];
#define PG8_ZERO() do { _Pragma("unroll") for (int a = 0; a < 2; ++a) _Pragma("unroll") for (int b = 0; b < 2; ++b) _Pragma("unroll") for (int m = 0; m < 4; ++m) _Pragma("unroll") for (int n = 0; n < 2; ++n) { \
        if constexpr (FP8) asm volatile("v_mov_b32 %0, 0\n\tv_mov_b32 %1, 0\n\tv_mov_b32 %2, 0\n\tv_mov_b32 %3, 0" : "=v"(acc[a][b][m][n][0]), "=v"(acc[a][b][m][n][1]), "=v"(acc[a][b][m][n][2]), "=v"(acc[a][b][m][n][3])); \
        else acc[a][b][m][n] = (f32x4){0.f, 0.f, 0.f, 0.f}; } } while (0)
    PG8_ZERO();
    unsigned sc1_ = 0x7f7f7f7fu; asm volatile("" : "+v"(sc1_));
    (void)sc1_;
    bf16x8 At[4][2], B0[2][2], B1[2][2];
    v8i32_t At8[4], B08[2], B18[2];
    (void)At; (void)B0; (void)B1; (void)At8; (void)B08; (void)B18;
    const char* cA = S.a_ptr(cur); const char* cB = S.b_ptr(cur);
    if constexpr (Sched::GATHER) { PG8_SETV(vA, cur); }
    PG8_STAGE(PG8_SB(0, 0), cB, voffB); PG8_STAGE(PG8_SB(0, 1), cB + hstep, voffB); PG8_STAGE_A(PG8_SA(0, 0), cA, 0, false); PG8_STAGE_A(PG8_SA(0, 1), cA, 1, false);
    if (wr == 1) PG8_BAR;
    PG8_WAIT_V(2); PG8_BAR;
    PG8_STAGE(PG8_SB(1, 0), cB + kstep, voffB); PG8_STAGE_A(PG8_SA(1, 0), cA + kstep, 0, false); PG8_STAGE(PG8_SB(1, 1), cB + hstep + kstep, voffB);
    PG8_WAIT_V(6); PG8_BAR;
    for (;;) {
        const bool has_next = S.next(ui + 1, nxt);
        const char* nA = has_next ? S.a_ptr(nxt) : cA; const char* nB = has_next ? S.b_ptr(nxt) : cB;
        if constexpr (Sched::GATHER) { if (has_next) { PG8_SETV(vN, nxt); } else {
#pragma unroll
            for (int h = 0; h < 2; ++h)
#pragma unroll
                for (int i = 0; i < 2; ++i) vN[h][i] = vA[h][i]; } }
        for (int t = 0; t < nt; t += 2) {
            const bool last = (t == nt - 2);
            if constexpr (Epi::MIDK) { if (t == nt / 2) E.mid(acc, cur, wr, wc, fr, fq); }
            const char* a1 = cA + (size_t)(t + 1) * kstep;
            const char* a2 = last ? nA : cA + (size_t)(t + 2) * kstep; const char* b2 = last ? nB : cB + (size_t)(t + 2) * kstep;
            const char* a3 = a2 + kstep; const char* b3 = b2 + kstep;
            PG8_LDB(B0, 0, 0); PG8_LDB(B1, 0, 1); PG8_SCHED; PG8_LDA(At, 0, 0); PG8_STAGE_A(PG8_SA(1, 1), a1, 1, false);
            PG8_WAIT_V(8); PG8_WAIT_L(0); PG8_BAR; PG8_MMA(0, 0, At, B0); PG8_MMA(0, 1, At, B1); PG8_BAR; PG8_SCHED;
            PG8_LDA(At, 0, 1); PG8_STAGE(PG8_SB(0, 0), b2, voffB); PG8_STAGE(PG8_SB(0, 1), b2 + hstep, voffB); PG8_STAGE_A(PG8_SA(0, 0), a2, 0, last);
            PG8_WAIT_V(8); PG8_WAIT_L(0); PG8_BAR; PG8_MMA(1, 0, At, B0); PG8_MMA(1, 1, At, B1); PG8_BAR; PG8_SCHED;
            PG8_LDB(B0, 1, 0); PG8_LDB(B1, 1, 1); PG8_SCHED; PG8_LDA(At, 1, 0); PG8_STAGE_A(PG8_SA(0, 1), a2, 1, last);
            PG8_WAIT_V(8); PG8_WAIT_L(0); PG8_BAR; PG8_MMA(0, 0, At, B0); PG8_MMA(0, 1, At, B1); PG8_BAR; PG8_SCHED;
            PG8_LDA(At, 1, 1); PG8_STAGE(PG8_SB(1, 0), b3, voffB); PG8_STAGE(PG8_SB(1, 1), b3 + hstep, voffB); PG8_STAGE_A(PG8_SA(1, 0), a3, 0, last);
            PG8_WAIT_V(8); PG8_WAIT_L(0); PG8_BAR; PG8_MMA(1, 0, At, B0); PG8_MMA(1, 1, At, B1); PG8_BAR; PG8_SCHED;
        }
        if constexpr (ALIGN_EPI) { if (wr == 0) PG8_BAR; }
        if constexpr (FP8) { asm volatile("s_nop 15\n\ts_nop 7" ::: "memory"); __builtin_amdgcn_sched_barrier(0); }
        E(acc, cur, wr, wc, fr, fq);
        if (!has_next) break;
        PG8_ZERO();
        cur = nxt; cA = nA; cB = nB; ++ui;
        if constexpr (Sched::GATHER) {
#pragma unroll
            for (int h = 0; h < 2; ++h)
#pragma unroll
                for (int i = 0; i < 2; ++i) vA[h][i] = vN[h][i]; }
        if constexpr (ALIGN_EPI) { if (wr == 1) PG8_BAR; }
    }
    PG8_WAIT_V(0);
    if constexpr (!ALIGN_EPI) { if (wr == 0) PG8_BAR; }
    PG8_BAR;
#undef PG8_SA
#undef PG8_SB
#undef PG8_STAGE
#undef PG8_STAGE_A
#undef PG8_LDA
#undef PG8_LDB
#undef PG8_MMA
#undef PG8_ZERO
#undef PG8_WAIT_V
#undef PG8_WAIT_L
#undef PG8_BAR
#undef PG8_SCHED
#undef PG8_SETV
}
}
using pg8::Unit;

#define EPI_ROWS(ai, m) for (int ai = 0; ai < 2; ++ai) for (int m = 0; m < 4; ++m)

struct EpiInProj {
    static constexpr bool MIDK = false;
    bf16 *qlat, *kvlat, *kpe, *fq, *gates; float *logf, *ssqq, *ssqkv; const float* ropetab; const float* bforget; bool skip; int rowmul;
    __device__ __forceinline__ void operator()(const f32x4 (&acc)[2][2][4][2], const Unit& u, int wr, int wc, int fr, int fq_) const {
        if (skip) return;
        const int pn = u.pn, row0 = u.pm * 256 + wr * 64 + fr, c0 = wc * 32 + 8 * fq_;
        if (pn >= 8) {
            bf16* gp = gates + (size_t)(pn - 8) * 256 + c0;
#pragma unroll
            for (int ai = 0; ai < 2; ++ai)
#pragma unroll
                for (int m = 0; m < 4; ++m) { const int row = row0 + ai * 128 + m * 16;
#pragma unroll
                    for (int bj = 0; bj < 2; ++bj) { f32x4 v0 = acc[ai][bj][m][0], v1 = acc[ai][bj][m][1];
#pragma unroll
                        for (int q = 0; q < 4; ++q) { v0[q] = fmaxf(sigmoidf_(v0[q]), 1e-30f); v1[q] = fmaxf(sigmoidf_(v1[q]), 1e-30f); }
                        *(u32x4*)(gp + (size_t)row * 2048 + 128 * bj) = pack8(v0, v1); } }
        } else if (pn >= 2) {
            bf16* dst = fq + (size_t)((pn - 2) >> 1) * ((size_t)T * 512) + (pn & 1) * 256 + c0; const float sc = (pn < 4) ? C2F : 1.f;
#pragma unroll
            for (int ai = 0; ai < 2; ++ai)
#pragma unroll
                for (int m = 0; m < 4; ++m) { const int row = row0 + ai * 128 + m * 16;
#pragma unroll
                    for (int bj = 0; bj < 2; ++bj) *(u32x4*)(dst + (size_t)row * 512 + 128 * bj) = pack8(acc[ai][bj][m][0] * sc, acc[ai][bj][m][1] * sc); }
        } else if (pn == 0) {
#pragma unroll
            for (int ai = 0; ai < 2; ++ai)
#pragma unroll
                for (int m = 0; m < 4; ++m) { const int row = row0 + ai * 128 + m * 16; float s = 0.f;
#pragma unroll
                    for (int bj = 0; bj < 2; ++bj) { const f32x4 v0 = acc[ai][bj][m][0], v1 = acc[ai][bj][m][1];
                        s += (v0[0] * v0[0] + v0[1] * v0[1]) + (v0[2] * v0[2] + v0[3] * v0[3]) + (v1[0] * v1[0] + v1[1] * v1[1]) + (v1[2] * v1[2] + v1[3] * v1[3]);
                        *(u32x4*)(qlat + (size_t)row * QLORA + c0 + 128 * bj) = pack8(v0, v1); }
                    s += __shfl_xor(s, 16); s += __shfl_xor(s, 32);
                    if (fq_ == 0) ssqq[row * 4 + wc] = s; }
        } else {
#pragma unroll
            for (int ai = 0; ai < 2; ++ai)
#pragma unroll
                for (int m = 0; m < 4; ++m) { const int row = row0 + ai * 128 + m * 16;
                    { const f32x4 v0 = acc[ai][0][m][0], v1 = acc[ai][0][m][1];
                      float s = (v0[0] * v0[0] + v0[1] * v0[1]) + (v0[2] * v0[2] + v0[3] * v0[3]) + (v1[0] * v1[0] + v1[1] * v1[1]) + (v1[2] * v1[2] + v1[3] * v1[3]);
                      *(u32x4*)(kvlat + (size_t)row * KVPAD + c0) = pack8(v0, v1);
                      s += __shfl_xor(s, 16); s += __shfl_xor(s, 32);
                      if (fq_ == 0) ssqkv[row * 4 + wc] = s; }
                    { const f32x4 v0 = acc[ai][1][m][0], v1 = acc[ai][1][m][1];
                      *(u32x4*)(kvlat + (size_t)row * KVPAD + 128 + c0) = (u32x4){0u, 0u, 0u, 0u};
                      if (wc == 0) {
                          const f32x4* tb = (const f32x4*)(ropetab + ((size_t)row * 16 + 4 * fq_) * 2);
                          const f32x4 t0 = tb[0], t1 = tb[1];
                          f32x4 o1, o2;
                          o1[0] = v0[0] * t0[0] - v1[0] * t0[1]; o2[0] = v1[0] * t0[0] + v0[0] * t0[1];
                          o1[1] = v0[1] * t0[2] - v1[1] * t0[3]; o2[1] = v1[1] * t0[2] + v0[1] * t0[3];
                          o1[2] = v0[2] * t1[0] - v1[2] * t1[1]; o2[2] = v1[2] * t1[0] + v0[2] * t1[1];
                          o1[3] = v0[3] * t1[2] - v1[3] * t1[3]; o2[3] = v1[3] * t1[2] + v0[3] * t1[3];
                          *(u32x4*)(kpe + (size_t)row * ROPE + 8 * fq_) = pack8(o1, o2);
                      } else if (wc == 1 && fq_ == 0) {
                          f32x4 l0, l1;
#pragma unroll
                          for (int h = 0; h < 4; ++h) { const float z0 = v0[h] + bforget[h], z1 = v1[h] + bforget[4 + h];
                              l0[h] = -__builtin_amdgcn_logf(1.f + __builtin_amdgcn_exp2f(-LOG2E * z0)); l1[h] = -__builtin_amdgcn_logf(1.f + __builtin_amdgcn_exp2f(-LOG2E * z1)); }
                          *(f32x4*)(logf + (size_t)row * 8) = l0; *(f32x4*)(logf + (size_t)row * 8 + 4) = l1;
                      } } }
        }
        (void)rowmul;
    }
};

struct EpiQup {
    static constexpr bool MIDK = false;
    bf16* q; const float* ssqq; const float* ropetab;
    __device__ __forceinline__ void operator()(const f32x4 (&acc)[2][2][4][2], const Unit& u, int wr, int wc, int fr, int fq_) const {
        const int row0 = u.pm * 256 + wr * 64 + fr, c0 = u.pn * 256 + wc * 32 + 8 * fq_;
#pragma unroll
        for (int ai = 0; ai < 2; ++ai)
#pragma unroll
            for (int m = 0; m < 4; ++m) {
                const int row = row0 + ai * 128 + m * 16;
                const f32x4 sq = *(const f32x4*)(ssqq + row * 4);
                const float rs = rsqrtf(((sq[0] + sq[1]) + (sq[2] + sq[3])) * (1.f / QLORA) + EPS) * C2M;
#pragma unroll
                for (int bj = 0; bj < 2; ++bj) {
                    const int col = c0 + 128 * bj, j = col % MQK;
                    f32x4 v0 = acc[ai][bj][m][0] * rs, v1 = acc[ai][bj][m][1] * rs;
                    if (j >= 64) { const int g = (j - 64) >> 3;
                        const f32x4* tb = (const f32x4*)(ropetab + ((size_t)row * 16 + 4 * g) * 2);
                        const f32x4 t0 = tb[0], t1 = tb[1];
                        f32x4 o1, o2;
                        o1[0] = v0[0] * t0[0] - v1[0] * t0[1]; o2[0] = v1[0] * t0[0] + v0[0] * t0[1];
                        o1[1] = v0[1] * t0[2] - v1[1] * t0[3]; o2[1] = v1[1] * t0[2] + v0[1] * t0[3];
                        o1[2] = v0[2] * t1[0] - v1[2] * t1[1]; o2[2] = v1[2] * t1[0] + v0[2] * t1[1];
                        o1[3] = v0[3] * t1[2] - v1[3] * t1[3]; o2[3] = v1[3] * t1[2] + v0[3] * t1[3];
                        v0 = o1; v1 = o2; }
                    *(u32x4*)(q + (size_t)row * 768 + col) = pack8(v0, v1);
                }
            }
    }
};

struct EpiKVup {
    static constexpr bool MIDK = false;
    bf16 *kn, *vm; const float* ssqkv;
    __device__ __forceinline__ void operator()(const f32x4 (&acc)[2][2][4][2], const Unit& u, int wr, int wc, int fr, int fq_) const {
        const int row0 = u.pm * 256 + wr * 64 + fr, c0 = u.pn * 256 + wc * 32 + 8 * fq_;
        bf16* dst = (u.pn < 2) ? kn : vm; const int cb = (u.pn & 1) * 256 + wc * 32 + 8 * fq_;
        (void)c0;
#pragma unroll
        for (int ai = 0; ai < 2; ++ai)
#pragma unroll
            for (int m = 0; m < 4; ++m) {
                const int row = row0 + ai * 128 + m * 16;
                const f32x4 sq = *(const f32x4*)(ssqkv + row * 4);
                const float rs = rsqrtf(((sq[0] + sq[1]) + (sq[2] + sq[3])) * (1.f / KVLORA) + EPS);
#pragma unroll
                for (int bj = 0; bj < 2; ++bj) *(u32x4*)(dst + (size_t)row * 512 + cb + 128 * bj) = pack8(acc[ai][bj][m][0] * rs, acc[ai][bj][m][1] * rs);
            }
    }
};

struct EpiPartA {
    static constexpr bool MIDK = false;
    float* part; const bf16* gates;
    __device__ __forceinline__ void operator()(const f32x4 (&acc)[2][2][4][2], const Unit& u, int wr, int wc, int fr, int fq_) const {
        const int row0 = u.pm * 256 + wr * 64 + fr, c0 = u.pn * 256 + wc * 32 + 8 * fq_;
#pragma unroll
        for (int ai = 0; ai < 2; ++ai)
#pragma unroll
            for (int m = 0; m < 4; ++m) {
                const int row = row0 + ai * 128 + m * 16;
#pragma unroll
                for (int bj = 0; bj < 2; ++bj) { const int col = c0 + 128 * bj;
                    f32x4 g0, g1; unpack8(*(const u32x4*)(gates + (size_t)row * 2048 + col), g0, g1);
                    *(f32x4*)(part + (size_t)row * D + col) = g0 * acc[ai][bj][m][0]; *(f32x4*)(part + (size_t)row * D + col + 4) = g1 * acc[ai][bj][m][1]; }
            }
    }
};
struct EpiMerged {
    static constexpr bool MIDK = false;
    const float* part; const bf16* gates; bf16* merged;
    __device__ __forceinline__ void operator()(const f32x4 (&acc)[2][2][4][2], const Unit& u, int wr, int wc, int fr, int fq_) const {
        const int row0 = u.pm * 256 + wr * 64 + fr, c0 = u.pn * 256 + wc * 32 + 8 * fq_;
#pragma unroll
        for (int ai = 0; ai < 2; ++ai)
#pragma unroll
            for (int m = 0; m < 4; ++m) {
                const int row = row0 + ai * 128 + m * 16;
#pragma unroll
                for (int bj = 0; bj < 2; ++bj) { const int col = c0 + 128 * bj;
                    f32x4 g0, g1; unpack8(*(const u32x4*)(gates + (size_t)row * 2048 + 1024 + col), g0, g1);
                    const f32x4 p0 = *(const f32x4*)(part + (size_t)row * D + col), p1 = *(const f32x4*)(part + (size_t)row * D + col + 4);
                    *(u32x4*)(merged + (size_t)row * D + col) = pack8(p0 + g0 * acc[ai][bj][m][0], p1 + g1 * acc[ai][bj][m][1]); }
            }
    }
};
struct EpiMergedCat {
    static constexpr bool MIDK = true;
    const bf16* gates; unsigned char* merged; float sc;
    __device__ __forceinline__ void mid(f32x4 (&acc)[2][2][4][2], const Unit& u, int wr, int wc, int fr, int fq_) const {
        int row0 = u.pm * 256 + wr * 64 + fr, c0 = u.pn * 256 + wc * 32 + 8 * fq_;
        asm volatile("" : "+v"(row0), "+v"(c0));
#pragma unroll
        for (int ai = 0; ai < 2; ++ai)
#pragma unroll
            for (int m = 0; m < 4; ++m) { const int row = row0 + ai * 128 + m * 16;
#pragma unroll
                for (int bj = 0; bj < 2; ++bj) { const int col = c0 + 128 * bj;
                    f32x4 a0, a1, b0, b1; unpack8(*(const u32x4*)(gates + (size_t)row * 2048 + col), a0, a1); unpack8(*(const u32x4*)(gates + (size_t)row * 2048 + 1024 + col), b0, b1);
#pragma unroll
                    for (int q = 0; q < 4; ++q) { acc[ai][bj][m][0][q] *= a0[q] * __builtin_amdgcn_rcpf(b0[q]); acc[ai][bj][m][1][q] *= a1[q] * __builtin_amdgcn_rcpf(b1[q]); } }
                asm volatile("" ::: "memory"); }
    }
    __device__ __forceinline__ void operator()(const f32x4 (&acc)[2][2][4][2], const Unit& u, int wr, int wc, int fr, int fq_) const {
        const int row0 = u.pm * 256 + wr * 64 + fr, c0 = u.pn * 256 + wc * 32 + 8 * fq_;
#pragma unroll
        for (int ai = 0; ai < 2; ++ai)
#pragma unroll
            for (int m = 0; m < 4; ++m) { const int row = row0 + ai * 128 + m * 16;
#pragma unroll
                for (int bj = 0; bj < 2; ++bj) { const int col = c0 + 128 * bj;
                    f32x4 b0, b1; unpack8(*(const u32x4*)(gates + (size_t)row * 2048 + 1024 + col), b0, b1);
                    const f32x4 v0 = b0 * acc[ai][bj][m][0] * sc, v1 = b1 * acc[ai][bj][m][1] * sc;
                    u32x2 o; int p_ = __builtin_amdgcn_cvt_pk_fp8_f32(v0[0], v0[1], 0, false); p_ = __builtin_amdgcn_cvt_pk_fp8_f32(v0[2], v0[3], p_, true); o.x = (unsigned)p_;
                    p_ = __builtin_amdgcn_cvt_pk_fp8_f32(v1[0], v1[1], 0, false); p_ = __builtin_amdgcn_cvt_pk_fp8_f32(v1[2], v1[3], p_, true); o.y = (unsigned)p_;
                    *(u32x2*)(merged + (size_t)row * D + col) = o; } }
    }
};
struct EpiOut {
    static constexpr bool MIDK = false;
    const float* x; float* x1; const float* mod; float* ssq1; float sc;
    __device__ __forceinline__ void operator()(const f32x4 (&acc)[2][2][4][2], const Unit& u, int wr, int wc, int fr, int fq_) const {
        const int row0 = u.pm * 256 + wr * 64 + fr, c0 = u.pn * 256 + wc * 32 + 8 * fq_;
        const float* gm = mod + (size_t)((u.pm * 256) / SEQ) * 6 * D + 2 * D;
        f32x4 g[2][2];
#pragma unroll
        for (int bj = 0; bj < 2; ++bj) { g[bj][0] = *(const f32x4*)(gm + c0 + 128 * bj) * sc; g[bj][1] = *(const f32x4*)(gm + c0 + 128 * bj + 4) * sc; }
#pragma unroll
        for (int ai = 0; ai < 2; ++ai)
#pragma unroll
            for (int m = 0; m < 4; ++m) { const int row = row0 + ai * 128 + m * 16; float sq = 0.f;
#pragma unroll
                for (int bj = 0; bj < 2; ++bj) { const int col = c0 + 128 * bj;
                    const f32x4 x0 = __builtin_nontemporal_load((const f32x4*)(x + (size_t)row * D + col)), x1v = __builtin_nontemporal_load((const f32x4*)(x + (size_t)row * D + col + 4));
                    const f32x4 r0 = x0 + g[bj][0] * acc[ai][bj][m][0], r1 = x1v + g[bj][1] * acc[ai][bj][m][1];
                    *(f32x4*)(x1 + (size_t)row * D + col) = r0; *(f32x4*)(x1 + (size_t)row * D + col + 4) = r1;
                    sq += (r0[0] * r0[0] + r0[1] * r0[1]) + (r0[2] * r0[2] + r0[3] * r0[3]) + (r1[0] * r1[0] + r1[1] * r1[1]) + (r1[2] * r1[2] + r1[3] * r1[3]); }
                sq += __shfl_xor(sq, 16); sq += __shfl_xor(sq, 32);
                if (fq_ == 0) ssq1[(size_t)row * 16 + 4 * u.pn + wc] = sq; }
    }
};
struct EpiHb {
    static constexpr bool MIDK = false;
    unsigned char* hb; float sc;
    __device__ __forceinline__ void operator()(const f32x4 (&acc)[2][2][4][2], const Unit& u, int wr, int wc, int fr, int fq_) const {
        const int row0 = u.pm * 256 + wr * 64 + fr, c0 = u.pn * 128 + wc * 32 + 8 * fq_;
#pragma unroll
        for (int ai = 0; ai < 2; ++ai)
#pragma unroll
            for (int m = 0; m < 4; ++m) { const int row = row0 + ai * 128 + m * 16;
                f32x4 h0, h1;
#pragma unroll
                for (int q = 0; q < 4; ++q) { h0[q] = siluf_(acc[ai][0][m][0][q] * sc) * (acc[ai][1][m][0][q] * (sc * HSCALE8)); h1[q] = siluf_(acc[ai][0][m][1][q] * sc) * (acc[ai][1][m][1][q] * (sc * HSCALE8)); }
                u32x2 o; int p_ = __builtin_amdgcn_cvt_pk_fp8_f32(h0[0], h0[1], 0, false); p_ = __builtin_amdgcn_cvt_pk_fp8_f32(h0[2], h0[3], p_, true); o.x = (unsigned)p_;
                p_ = __builtin_amdgcn_cvt_pk_fp8_f32(h1[0], h1[1], 0, false); p_ = __builtin_amdgcn_cvt_pk_fp8_f32(h1[2], h1[3], p_, true); o.y = (unsigned)p_;
                *(u32x2*)(hb + (size_t)row * DEXP + c0) = o; }
    }
};
struct EpiDown {
    static constexpr bool MIDK = false;
    bf16* Y; float* out; float* outw; const float* mod; const unsigned short* list; const unsigned char* eidx; const float* gatew;
    __device__ __forceinline__ void operator()(const f32x4 (&acc)[2][2][4][2], const Unit& u, int wr, int wc, int fr, int fq_) const {
        const int c0 = u.pn * 256 + wc * 32 + 8 * fq_;
#pragma unroll
        for (int ai = 0; ai < 2; ++ai)
#pragma unroll
            for (int m = 0; m < 4; ++m) {
                const int rl = wr * 64 + fr + ai * 128 + m * 16, idx = u.aux * 256 + rl;
                if (u.e == NEXP) {
                    const int t = idx; const float* gf = mod + (size_t)(t / SEQ) * 6 * D + 5 * D;
#pragma unroll
                    for (int bj = 0; bj < 2; ++bj) { const int col = c0 + 128 * bj; const float* o = out + (size_t)t * D + col; float* ow = outw + (size_t)t * D + col;
                        const f32x4 g0 = *(const f32x4*)(gf + col), g1 = *(const f32x4*)(gf + col + 4);
                        const f32x4 x0 = *(const f32x4*)o, x1v = *(const f32x4*)(o + 4);
                        *(f32x4*)ow = x0 + g0 * acc[ai][bj][m][0]; *(f32x4*)(ow + 4) = x1v + g1 * acc[ai][bj][m][1]; }
                } else if (idx < u.n) {
                    const int t = list[(size_t)u.e * LISTCAP + idx];
                    const u32x2 ev = *(const u32x2*)(eidx + (size_t)t * 8);
                    int k = 0;
#pragma unroll
                    for (int q = 1; q < TOPK; ++q) { const unsigned b = (q < 4) ? ((ev.x >> (8 * q)) & 0xffu) : ((ev.y >> (8 * (q - 4))) & 0xffu); if ((int)b == u.e) k = q; }
                    const float w = gatew[(size_t)t * 8 + k];
#pragma unroll
                    for (int bj = 0; bj < 2; ++bj) *(u32x4*)(Y + ((size_t)t * TOPK + k) * D + c0 + 128 * bj) = pack8(acc[ai][bj][m][0] * w, acc[ai][bj][m][1] * w);
                }
            }
    }
};

template <int NT, bool GATHER_>
struct MoeOrder {
    static constexpr bool GATHER = GATHER_;
    const char* A; const char* Bt; const char* Bsh; int K; size_t bstride;
    const unsigned short* list; volatile LAS int* tab;
    int G, c;
    __device__ bool next(int i, Unit& u) const {
        int ti, pn_;
        if ((G & 7) == 0) { const int x = c & 7, j = i * (G >> 3) + (c >> 3); ti = (j / NT) * 8 + x; pn_ = j % NT; if (ti >= tab[65]) return false; }
        else { const int total = tab[65] * NT; const long L = (long)i * G + c; if (L >= total) return false; ti = (int)L / NT; pn_ = (int)L % NT; }
        u.pn = pn_; u.pm = ti;
        const int e = __builtin_amdgcn_readfirstlane(tab[132 + ti]);
        u.e = e; u.aux = __builtin_amdgcn_readfirstlane(ti - tab[e]); u.n = __builtin_amdgcn_readfirstlane(tab[66 + e]); return true;
    }
    __device__ __forceinline__ const char* a_ptr(const Unit& u) const { return GATHER ? A : A + (size_t)u.pm * 256 * K * 2; }
    __device__ __forceinline__ const char* b_ptr(const Unit& u) const { return (u.e == NEXP ? Bsh : Bt + (size_t)u.e * bstride) + (size_t)u.pn * 256 * K * 2; }
    __device__ __forceinline__ unsigned a_row(const Unit& u, int r) const {
        if (!GATHER) return (unsigned)r;
        const int idx = u.aux * 256 + r;
        if (u.e == NEXP) return (unsigned)idx;
        return (idx < u.n) ? (unsigned)list[(size_t)u.e * LISTCAP + idx] : 0u;
    }
};

struct UpOrder {
    static constexpr bool GATHER = false;
    const char* Aq; const char* Bq; const char* Akv; const char* Bkv; int K; int G, c;
    __device__ bool next(int i, Unit& u) const {
        int L = i * G + c; if (L >= 448) return false;
        if (L < 256) { u.e = 1; u.pm = L >> 2; u.pn = L & 3; } else { L -= 256; u.e = 0; u.pm = L / 3; u.pn = L % 3; }
        u.aux = 0; u.n = 256; return true; }
    __device__ __forceinline__ const char* a_ptr(const Unit& u) const { return (u.e ? Akv : Aq) + (size_t)u.pm * 256 * K * 2; }
    __device__ __forceinline__ const char* b_ptr(const Unit& u) const { return (u.e ? Bkv : Bq) + (size_t)u.pn * 256 * K * 2; }
    __device__ __forceinline__ unsigned a_row(const Unit&, int r) const { return (unsigned)r; }
};
struct EpiUp {
    static constexpr bool MIDK = false;
    EpiQup q; EpiKVup kv;
    __device__ __forceinline__ void operator()(const f32x4 (&acc)[2][2][4][2], const Unit& u, int wr, int wc, int fr, int fq_) const { if (u.e) kv(acc, u, wr, wc, fr, fq_); else q(acc, u, wr, wc, fr, fq_); }
};

struct SharedDownOrder {
    static constexpr bool GATHER = false;
    const char* A; const char* Bt; int K; int G, c;
    __device__ bool next(int i, Unit& u) const { const int L = i * G + c; if (L >= (T / 256) * 4) return false; u.pm = L >> 2; u.pn = L & 3; u.e = NEXP; u.aux = L >> 2; u.n = 256; return true; }
    __device__ __forceinline__ const char* a_ptr(const Unit& u) const { return A + (size_t)u.pm * 256 * K * 2; }
    __device__ __forceinline__ const char* b_ptr(const Unit& u) const { return Bt + (size_t)u.pn * 256 * K * 2; }
    __device__ __forceinline__ unsigned a_row(const Unit&, int r) const { return (unsigned)r; }
};

namespace att {
constexpr int KSLOT = 12288, VSLOT = 8192;
constexpr int L_K = 0, L_V = 3 * KSLOT, L_F = L_V + 2 * VSLOT, L_WS = L_F + 3 * 256, L_OST = L_WS + 2048, L_END = L_OST + 8 * 4096;
static_assert(L_END <= RING_BYTES, "attention LDS");
__device__ __forceinline__ int crow(int r, int hi) { return (r & 3) + 8 * (r >> 2) + 4 * hi; }
__device__ __forceinline__ float max3f(float a, float b, float c) { return fmaxf(fmaxf(a, b), c); }
__device__ __forceinline__ float rowmax(const f32x16& p0, const f32x16& p1) {
    float a = max3f(p0[0], p0[1], p1[0]), b = max3f(p0[2], p0[3], p1[1]); a = max3f(a, p1[2], p1[3]);
#pragma unroll
    for (int r = 4; r < 16; r += 4) { a = max3f(a, p0[r], p0[r + 1]); b = max3f(b, p0[r + 2], p0[r + 3]); a = max3f(a, p1[r], p1[r + 1]); b = max3f(b, p1[r + 2], p1[r + 3]); }
    const float m = fmaxf(a, b);
    auto rr = __builtin_amdgcn_permlane32_swap(__float_as_uint(m), __float_as_uint(m), false, false);
    return fmaxf(__uint_as_float(rr[0]), __uint_as_float(rr[1]));
}
__device__ __forceinline__ void cmask(f32x16& p0, f32x16& p1, int jb, int qrel, int hi) {
    const float NEG = -INFINITY; const int kb = 64 * jb + 4 * hi;
#pragma unroll
    for (int r = 0; r < 16; ++r) { const int kv = kb + (r & 3) + 8 * (r >> 2); if (kv > qrel) p0[r] = NEG; if (kv + 32 > qrel) p1[r] = NEG; }
}
__device__ __forceinline__ void pv(f32x16* o, int vb, bf16x8 pa0, bf16x8 pa1, bf16x8 pa2, bf16x8 pa3) {
#pragma unroll
    for (int d0 = 0; d0 < 2; ++d0) { s16x4 lo[4], hi[4];
#pragma unroll
        for (int ks = 0; ks < 4; ++ks) {
            asm volatile("ds_read_b64_tr_b16 %0,%1 offset:%c2" : "=&v"(lo[ks]) : "v"(vb), "i"(d0 * 4096 + ks * 1024) : "memory");
            asm volatile("ds_read_b64_tr_b16 %0,%1 offset:%c2" : "=&v"(hi[ks]) : "v"(vb), "i"(d0 * 4096 + ks * 1024 + 512) : "memory"); }
        asm volatile("s_waitcnt lgkmcnt(0)" ::: "memory"); __builtin_amdgcn_sched_barrier(0);
#define PK(k) (bf16x8){lo[k][0], lo[k][1], lo[k][2], lo[k][3], hi[k][0], hi[k][1], hi[k][2], hi[k][3]}
        o[d0] = __builtin_amdgcn_mfma_f32_32x32x16_bf16(pa0, PK(0), o[d0], 0, 0, 0);
        o[d0] = __builtin_amdgcn_mfma_f32_32x32x16_bf16(pa1, PK(1), o[d0], 0, 0, 0);
        o[d0] = __builtin_amdgcn_mfma_f32_32x32x16_bf16(pa2, PK(2), o[d0], 0, 0, 0);
        o[d0] = __builtin_amdgcn_mfma_f32_32x32x16_bf16(pa3, PK(3), o[d0], 0, 0, 0);
#undef PK
    }
}
__device__ __forceinline__ unsigned cvtpk_s(float lo, float hi) { return cvt_pk_bf16(lo, hi); }

template <int DQK, bool DECAY, int THRL>
__device__ __forceinline__ void attn_unit(int b, int h, int qb, const bf16* Q, int QP, const bf16* Kn, const bf16* Kpe, const bf16* V, const float* cumF, bf16* O, int OP, LAS unsigned char* lds) {
    constexpr int ND0 = DQK / 16;
    int tid = threadIdx.x; asm volatile("" : "+v"(tid));
    const int lane = tid & 63, r32 = lane & 31, hi = lane >> 5; const int wid = __builtin_amdgcn_readfirstlane(tid >> 6);
    const long rowbase = (long)b * SEQ; const int q0 = qb * 256;
    const bf16* Qw = Q + (rowbase + q0 + wid * 32) * QP + h * DQK;
    const bf16* Kh = Kn + rowbase * 512 + h * 64; const bf16* Vh = V + rowbase * 512 + h * 64;
    const bf16* Kp = Kpe + rowbase * ROPE;
    const float* Fh = DECAY ? cumF + ((size_t)b * NHEAD + h) * SEQ : nullptr;
    LAS float* wsf = (LAS float*)(lds + L_WS) + wid * 64;
    const bf16* ksrc0 = Kh + (long)lane * 512 + wid * 8;
    const bf16* ksrc1 = Kp + (long)lane * ROPE + (wid & 3) * 8;
    const bf16* vsrc = Vh + (long)(16 * (wid & 3) + (lane >> 2)) * 512 + (wid >> 2) * 32 + (lane & 3) * 8;
    const int NT = (q0 + 256) / 64;
#define ATT_DMA_K(i_, s) do { const int t_ = NT - 1 - (i_); \
        __builtin_amdgcn_global_load_lds((const unsigned*)(ksrc0 + (long)t_ * 64 * 512), (LAS unsigned*)(lds + L_K + (s) * KSLOT + wid * 1024), 16, 0, 0); \
        if (DQK == 96 && wid < 4) __builtin_amdgcn_global_load_lds((const unsigned*)(ksrc1 + (long)t_ * 64 * ROPE), (LAS unsigned*)(lds + L_K + (s) * KSLOT + (8 + wid) * 1024), 16, 0, 0); \
        if (DECAY && wid == 7) __builtin_amdgcn_global_load_lds((const unsigned*)(Fh + t_ * 64 + lane), (LAS unsigned*)(lds + L_F + (s) * 256), 4, 0, 0); } while (0)
#define ATT_DMA_V(i_, s) do { const int t_ = NT - 1 - (i_); \
        __builtin_amdgcn_global_load_lds((const unsigned*)(vsrc + (long)t_ * 64 * 512), (LAS unsigned*)(lds + L_V + (s) * VSLOT + wid * 1024), 16, 0, 0); } while (0)
    ATT_DMA_K(0, 0); ATT_DMA_V(0, 0); ATT_DMA_K(1, 1);
    bf16x8 qr[ND0];
#pragma unroll
    for (int d0 = 0; d0 < ND0; ++d0) qr[d0] = *(const bf16x8*)(Qw + (long)r32 * QP + d0 * 16 + hi * 8);
    float fq_l = 0.f; if (DECAY) fq_l = Fh[q0 + wid * 32 + r32];
    float mhat = 0.f, l_reg = 0.f; bool started = false; f32x16 o[2]; o[0] = f32x16{}; o[1] = f32x16{};
    const int qrel = wid * 32 + r32;
    const int vb0 = (int)(uintptr_t)(lds + L_V) + ((lane >> 4) & 1) * 32 + (lane & 3) * 8 + (4 * hi + ((lane & 15) >> 2)) * 64;
#define ATT_QK(P0, P1, ks_) do { const float base_ = fq_l - mhat; \
        if (DECAY) { const LAS f32x4* fk_ = (const LAS f32x4*)(lds + L_F + (ks_) * 256); \
            _Pragma("unroll") for (int g = 0; g < 4; ++g) { const f32x4 a_ = fk_[2 * g + hi], c_ = fk_[8 + 2 * g + hi]; \
                _Pragma("unroll") for (int q = 0; q < 4; ++q) { P0[4 * g + q] = base_ - a_[q]; P1[4 * g + q] = base_ - c_[q]; } } } \
        else { _Pragma("unroll") for (int r = 0; r < 16; ++r) { P0[r] = base_; P1[r] = base_; } } \
        const LAS unsigned char* kb_ = lds + L_K + (ks_) * KSLOT + hi * 1024 + r32 * 16; \
        _Pragma("unroll") for (int d0 = 0; d0 < ND0; ++d0) { \
            const bf16x8 b0_ = *(const LAS bf16x8*)(kb_ + d0 * 2048), b1_ = *(const LAS bf16x8*)(kb_ + d0 * 2048 + 512); \
            P0 = __builtin_amdgcn_mfma_f32_32x32x16_bf16(b0_, qr[d0], P0, 0, 0, 0); P1 = __builtin_amdgcn_mfma_f32_32x32x16_bf16(b1_, qr[d0], P1, 0, 0, 0); } } while (0)
    f32x16 p0, p1, n0, n1;
    int ks_cur = 0, ks_nxt = 1, ks_ld = 2;
    for (int i = 0; i < NT; ++i) {
        const int vs = i & 1;
        VM_WAIT(); __syncthreads();
        if (i + 2 < NT) ATT_DMA_K(i + 2, ks_ld);
        if (i + 1 < NT) ATT_DMA_V(i + 1, vs ^ 1);
        if (i == 0) ATT_QK(p0, p1, 0);
        if (i + 1 < NT) ATT_QK(n0, n1, ks_nxt);
        const int jb = 3 - i;
        if (jb >= 0) cmask(p0, p1, jb, qrel, hi);
        const float rm = rowmax(p0, p1);
        bool resc = false; float dl = 0.f; const bool was_started = started;
        if (jb >= 0) {
            const bool fin = rm > -INFINITY;
            dl = started ? fmaxf(rm, 0.f) : (fin ? rm : 0.f); started = started || fin; resc = true;
        } else if (__any(rm > (float)THRL)) { dl = fmaxf(rm, 0.f); resc = true; }
        if (resc) { mhat += dl;
#pragma unroll
            for (int r = 0; r < 16; ++r) { p0[r] -= dl; p1[r] -= dl; }
            if (i + 1 < NT) {
#pragma unroll
                for (int r = 0; r < 16; ++r) { n0[r] -= dl; n1[r] -= dl; } }
            const float f = was_started ? __builtin_amdgcn_exp2f(-dl) : 1.f; l_reg *= f; if (hi == 0) wsf[r32] = f; }
        float sacc = 0.f;
#pragma unroll
        for (int r = 0; r < 16; ++r) { p0[r] = __builtin_amdgcn_exp2f(p0[r]); p1[r] = __builtin_amdgcn_exp2f(p1[r]); sacc += p0[r] + p1[r]; }
        l_reg += sacc;
        if (resc) { LDS_WAIT();
#pragma unroll
            for (int d_ = 0; d_ < 2; ++d_)
#pragma unroll
                for (int r = 0; r < 16; ++r) o[d_][r] *= wsf[crow(r, hi)]; }
        u32x4 pw0, pw1, pw2, pw3;
        pw0 = (u32x4){cvtpk_s(p0[0], p0[1]), cvtpk_s(p0[2], p0[3]), cvtpk_s(p0[4], p0[5]), cvtpk_s(p0[6], p0[7])};
        pw1 = (u32x4){cvtpk_s(p0[8], p0[9]), cvtpk_s(p0[10], p0[11]), cvtpk_s(p0[12], p0[13]), cvtpk_s(p0[14], p0[15])};
        pw2 = (u32x4){cvtpk_s(p1[0], p1[1]), cvtpk_s(p1[2], p1[3]), cvtpk_s(p1[4], p1[5]), cvtpk_s(p1[6], p1[7])};
        pw3 = (u32x4){cvtpk_s(p1[8], p1[9]), cvtpk_s(p1[10], p1[11]), cvtpk_s(p1[12], p1[13]), cvtpk_s(p1[14], p1[15])};
        __builtin_amdgcn_sched_barrier(0);
        pv(o, vb0 + vs * VSLOT, __builtin_bit_cast(bf16x8, pw0), __builtin_bit_cast(bf16x8, pw1), __builtin_bit_cast(bf16x8, pw2), __builtin_bit_cast(bf16x8, pw3));
        p0 = n0; p1 = n1;
        { const int t_ = ks_cur; ks_cur = ks_nxt; ks_nxt = ks_ld; ks_ld = t_; }
    }
    { auto rr = __builtin_amdgcn_permlane32_swap(__float_as_uint(l_reg), __float_as_uint(l_reg), false, false); l_reg = __uint_as_float(rr[0]) + __uint_as_float(rr[1]); }
    if (hi == 0) wsf[32 + r32] = l_reg; LDS_WAIT();
    float rli[16];
#pragma unroll
    for (int r = 0; r < 16; ++r) rli[r] = __builtin_amdgcn_rcpf(wsf[32 + crow(r, hi)]);
    unsigned char* Ow = (unsigned char*)O + (rowbase + q0 + wid * 32) * OP + h * 64;
    { LAS unsigned char* stg = lds + L_OST + wid * 4096;
#pragma unroll
      for (int r = 0; r < 16; ++r) { const int orow = crow(r, hi);
#pragma unroll
          for (int d0 = 0; d0 < 2; ++d0) { const float ov = o[d0][r] * rli[r] * OSCALE8; stg[orow * 64 + d0 * 32 + r32] = (unsigned char)__builtin_amdgcn_cvt_pk_fp8_f32(ov, ov, 0, false); } }
      LDS_WAIT();
#pragma unroll
      for (int i = 0; i < 2; ++i) { const int row = i * 16 + (lane >> 2), ch = lane & 3; const u32x4 v = *(const LAS u32x4*)(stg + row * 64 + ch * 16); *(u32x4*)(Ow + (long)row * OP + ch * 16) = v; } }
    LDS_WAIT(); __syncthreads();
#undef ATT_DMA_K
#undef ATT_DMA_V
#undef ATT_QK
}

constexpr int T_KSLOT = 12288, T_VSLOT = 8192, T_NSLOT = 3;
constexpr int T_K = 0, T_V = T_NSLOT * T_KSLOT, T_F = T_V + T_NSLOT * T_VSLOT, T_WS = T_F + T_NSLOT * 256, T_OST = T_WS + 2048, T_END = T_OST + 8 * 4096;
static_assert(T_END <= RING_BYTES, "attention LDS (hand-interleaved unit)");
typedef __attribute__((address_space(3))) const char* lds_cptr;
typedef short v4i16_t __attribute__((ext_vector_type(4)));
__device__ __forceinline__ s16x4 vtr(lds_cptr p) { return __builtin_bit_cast(s16x4, __builtin_amdgcn_ds_read_tr16_b64_v4i16((__attribute__((address_space(3))) v4i16_t*)p)); }
__device__ __forceinline__ void kload2(bf16x8* kf, lds_cptr kp, int j) { kf[2 * j] = *(const __attribute__((address_space(3))) bf16x8*)(kp + j * 2048); kf[2 * j + 1] = *(const __attribute__((address_space(3))) bf16x8*)(kp + j * 2048 + 512); }
#define TW_BAR(N) asm volatile("s_waitcnt vmcnt(" #N ") lgkmcnt(0)\n\ts_barrier" ::: "memory")
#define TSB() __builtin_amdgcn_sched_barrier(0)

template <int DQK, bool DECAY, int THRL>
__device__ __forceinline__ void attn_unit_t(int b, int h, int qb, const bf16* Q, int QP, const bf16* Kn, const bf16* Kpe, const bf16* V, const float* cumF, float kmax2, bf16* O, int OP, LAS unsigned char* lds) {
    constexpr int ND0 = DQK / 16;
    constexpr bool INPL = DECAY || (DQK == 96);
    int tid = threadIdx.x; asm volatile("" : "+v"(tid));
    const int lane = tid & 63, r32 = lane & 31, hi = lane >> 5; const int wid = __builtin_amdgcn_readfirstlane(tid >> 6);
    const long rowbase = (long)b * SEQ; const int q0 = qb * 256;
    const bf16* Qw = Q + (rowbase + q0 + wid * 32) * QP + h * DQK;
    const bf16* Kh = Kn + rowbase * 512 + h * 64; const bf16* Vh = V + rowbase * 512 + h * 64;
    const bf16* Kp = Kpe + rowbase * ROPE;
    const float* Fh = DECAY ? cumF + ((size_t)b * NHEAD + h) * SEQ : nullptr;
    LAS float* wsf = (LAS float*)(lds + T_WS) + wid * 64;
    const bf16* ksrc0 = Kh + (long)lane * 512 + wid * 8;
    const bf16* ksrc1 = Kp + (long)lane * ROPE + (wid & 3) * 8;
    const bf16* vsrc = Vh + (long)(16 * (wid & 3) + (lane >> 2)) * 512 + (wid >> 2) * 32 + (lane & 3) * 8;
    const int NTS = (q0 + 256) / 64;
#define TDMA_K(i_, sk) do { const int t_ = NTS - 1 - (i_); \
        __builtin_amdgcn_global_load_lds((const unsigned*)(ksrc0 + (long)t_ * 64 * 512), (LAS unsigned*)(lds + T_K + (sk) * T_KSLOT + wid * 1024), 16, 0, 0); \
        if (DECAY) __builtin_amdgcn_global_load_lds((const unsigned*)(Fh + t_ * 64 + lane), (LAS unsigned*)(lds + T_F + (sk) * 256), 4, 0, 0); \
        else __builtin_amdgcn_global_load_lds((const unsigned*)(ksrc1 + (long)t_ * 64 * ROPE), (LAS unsigned*)(lds + T_K + (sk) * T_KSLOT + (8 + (wid & 3)) * 1024), 16, 0, 0); } while (0)
#define TDMA_V(i_, sv) do { const int t_ = NTS - 1 - (i_); \
        __builtin_amdgcn_global_load_lds((const unsigned*)(vsrc + (long)t_ * 64 * 512), (LAS unsigned*)(lds + T_V + (sv) * T_VSLOT + wid * 1024), 16, 0, 0); } while (0)
    TDMA_K(0, 0); TDMA_V(0, 0); TDMA_K(1, 1);
    bf16x8 qr[ND0];
#pragma unroll
    for (int d0 = 0; d0 < ND0; ++d0) qr[d0] = *(const bf16x8*)(Qw + (long)r32 * QP + d0 * 16 + hi * 8);
    float fq_l = 0.f; if (DECAY) fq_l = Fh[q0 + wid * 32 + r32];
    float ftile = 0.f; if (DECAY) ftile = Fh[(lane < NTS ? lane : NTS - 1) * 64 + 63];
    float mhat = 0.f, l_reg = 0.f; f32x16 o[2]; o[0] = f32x16{}; o[1] = f32x16{};
    f32x16 negm = f32x16{}; asm volatile("" : "+v"(negm));
    const int qrel = wid * 32 + r32, i0 = 3 - (wid >> 1);
    const lds_cptr shm3 = (lds_cptr)lds; const lds_cptr kp0 = shm3 + T_K + hi * 1024 + r32 * 16;
    const lds_cptr vp0 = shm3 + T_V + ((lane >> 4) & 1) * 32 + (lane & 3) * 8 + (4 * hi + ((lane & 15) >> 2)) * 64;
    const int vb0 = (int)(uintptr_t)(lds + T_V) + ((lane >> 4) & 1) * 32 + (lane & 3) * 8 + (4 * hi + ((lane & 15) >> 2)) * 64;
    bool resc = false;
    bf16x8 kf[2 * ND0];
    f32x16 pA0, pA1, pB0, pB1;
    int sl_prev = 0, sl_cur = 0, sl_next = 1;
#define TROT() do { sl_prev = sl_cur; sl_cur = sl_next; sl_next = (sl_next == T_NSLOT - 1) ? 0 : sl_next + 1; } while (0)
#define TBIAS(X0, X1, fs_) do { if (DECAY) { const float base_ = fq_l - mhat; const LAS f32x4* fk_ = (const LAS f32x4*)(lds + T_F + (fs_) * 256); \
        _Pragma("unroll") for (int g = 0; g < 4; ++g) { const f32x4 a_ = fk_[2 * g + hi], c_ = fk_[8 + 2 * g + hi]; \
            _Pragma("unroll") for (int q = 0; q < 4; ++q) { X0[4 * g + q] = base_ - a_[q]; X1[4 * g + q] = base_ - c_[q]; } } } \
        else if (INPL) { const float nm_ = -mhat; _Pragma("unroll") for (int r = 0; r < 16; ++r) { X0[r] = nm_; X1[r] = nm_; } } } while (0)
#define TCIN(X) (INPL ? X : negm)
#define TRESC() do { if (resc) { asm volatile("s_waitcnt lgkmcnt(0)" ::: "memory"); \
        _Pragma("unroll") for (int d_ = 0; d_ < 2; ++d_) _Pragma("unroll") for (int r = 0; r < 16; ++r) o[d_][r] *= wsf[crow(r, hi)]; } } while (0)
#define TDECIDE(C0, C1, i_) do { \
        float a_ = max3f(C0[0], C0[1], C1[0]), b_ = max3f(C0[2], C0[3], C1[1]); a_ = max3f(a_, C1[2], C1[3]); \
        _Pragma("unroll") for (int r = 4; r < 16; r += 4) { a_ = max3f(a_, C0[r], C0[r + 1]); b_ = max3f(b_, C0[r + 2], C0[r + 3]); a_ = max3f(a_, C1[r], C1[r + 1]); b_ = max3f(b_, C1[r + 2], C1[r + 3]); } \
        float rm_ = fmaxf(a_, b_); { auto rr_ = __builtin_amdgcn_permlane32_swap(__float_as_uint(rm_), __float_as_uint(rm_), false, false); rm_ = fmaxf(__uint_as_float(rr_[0]), __uint_as_float(rr_[1])); } \
        resc = false; \
        if ((i_) == i0) { const float dl_ = rm_; mhat += dl_; \
            _Pragma("unroll") for (int r = 0; r < 16; ++r) { C0[r] -= dl_; C1[r] -= dl_; } \
            if (!INPL) { _Pragma("unroll") for (int r = 0; r < 16; ++r) negm[r] = -mhat; asm volatile("" : "+v"(negm)); } } \
        else if (__builtin_expect(__any(rm_ > (float)THRL), 0)) { const float dl_ = fmaxf(rm_, 0.f); mhat += dl_; \
            _Pragma("unroll") for (int r = 0; r < 16; ++r) { C0[r] -= dl_; C1[r] -= dl_; } \
            if (!INPL) { _Pragma("unroll") for (int r = 0; r < 16; ++r) negm[r] = -mhat; asm volatile("" : "+v"(negm)); } \
            const float f_ = __builtin_amdgcn_exp2f(-dl_); l_reg *= f_; if (hi == 0) wsf[r32] = f_; resc = true; } } while (0)
    TDMA_K(2, 2);
    TW_BAR(5);
    int NT = NTS;
    if (DECAY) {
        const float bound = 2.f * __builtin_sqrtf(kmax2) * 1.0001f + 1.f + (Fh[q0] - ftile);
        const unsigned long long need = __ballot(lane < NTS && bound >= -160.f);
        const int tmin = need ? (int)__builtin_ctzll(need) : NTS - 1;
        NT = NTS - tmin; NT += NT & 1; if (NT < 8) NT = 8; if (NT > NTS) NT = NTS;
        NT = __builtin_amdgcn_readfirstlane(NT); }
    TBIAS(pA0, pA1, 0);
    { const lds_cptr kb = kp0;
#pragma unroll
      for (int d0 = 0; d0 < ND0; ++d0) { const bf16x8 b0 = *(const __attribute__((address_space(3))) bf16x8*)(kb + d0 * 2048), b1 = *(const __attribute__((address_space(3))) bf16x8*)(kb + d0 * 2048 + 512);
          if (d0 == 0) { pA0 = __builtin_amdgcn_mfma_f32_32x32x16_bf16(b0, qr[0], TCIN(pA0), 0, 0, 0); pA1 = __builtin_amdgcn_mfma_f32_32x32x16_bf16(b1, qr[0], TCIN(pA1), 0, 0, 0); }
          else { pA0 = __builtin_amdgcn_mfma_f32_32x32x16_bf16(b0, qr[d0], pA0, 0, 0, 0); pA1 = __builtin_amdgcn_mfma_f32_32x32x16_bf16(b1, qr[d0], pA1, 0, 0, 0); } } }
    cmask(pA0, pA1, 3, qrel, hi);
    TDECIDE(pA0, pA1, 0);
#pragma unroll
    for (int r = 0; r < 16; ++r) { pA0[r] = __builtin_amdgcn_exp2f(pA0[r]); pA1[r] = __builtin_amdgcn_exp2f(pA1[r]); }
    TW_BAR(0);
    TDMA_K(3, 0); TDMA_V(1, 1);
    TROT();
#pragma unroll
    for (int j = 0; j < ND0; ++j) kload2(kf, kp0 + sl_cur * T_KSLOT, j);
    TBIAS(pB0, pB1, sl_cur);
    TW_BAR(3);
    s16x4 vlo[8], vhi[8]; u32x4 pw0, pw1, pw2, pw3;
#define TPKW(P, B) cvt_pk_bf16(P[B], P[B + 1])
#define TPAF(k) __builtin_bit_cast(bf16x8, pw##k)
#define TVFR(i) (bf16x8){vlo[i][0], vlo[i][1], vlo[i][2], vlo[i][3], vhi[i][0], vhi[i][1], vhi[i][2], vhi[i][3]}
#define TPIN(x) asm volatile("" : "+v"(x))
#define TGAPA(MF, A0, A1, A2, A3, W0, W1, PW) do { MF; sacc += A0; sacc += A1; sacc += A2; sacc += A3; TPIN(sacc); W0; W1; TPIN(PW); TSB(); } while (0)
#define TEX(v) __builtin_amdgcn_exp2f(v)
#define TGAPB(MF, X, B) do { MF; X[B] = TEX(X[B]); X[B + 1] = TEX(X[B + 1]); X[B + 2] = TEX(X[B + 2]); X[B + 3] = TEX(X[B + 3]); TPIN(X); TSB(); } while (0)
#define TVRD(i) do { vlo[i] = vtr(vp_ + (((i) >> 2) * 4096 + ((i) & 3) * 1024)); vhi[i] = vtr(vp_ + (((i) >> 2) * 4096 + ((i) & 3) * 1024 + 512)); } while (0)
#define TKRD(G, j) do { if (G) { kload2(kf, kp0 + sl_next * T_KSLOT, j); TSB(); } } while (0)
#define TMF(a, b, c) __builtin_amdgcn_mfma_f32_32x32x16_bf16(a, b, c, 0, 0, 0)
#define TSTEP(C0, C1, P0, P1, i_, MJB, GK, GV, GL) do { TSB(); \
        const lds_cptr vp_ = vp0 + sl_prev * T_VSLOT; \
        TVRD(0); TSB(); float sacc = (P0[0] + P0[1]); \
        TGAPA(C0 = TMF(kf[0], qr[0], TCIN(C0)), P0[2], P0[3], P0[4], P0[5],     pw0[0] = TPKW(P0, 0), pw0[1] = TPKW(P0, 2), pw0); \
        TVRD(4); TSB(); TGAPA(C1 = TMF(kf[1], qr[0], TCIN(C1)), P0[6], P0[7], P0[8], P0[9],     pw0[2] = TPKW(P0, 4), pw0[3] = TPKW(P0, 6), pw0); \
        TVRD(1); TSB(); TGAPA(C0 = TMF(kf[2], qr[1], C0),   P0[10], P0[11], P0[12], P0[13], pw1[0] = TPKW(P0, 8), pw1[1] = TPKW(P0, 10), pw1); \
        TVRD(5); TSB(); TGAPA(C1 = TMF(kf[3], qr[1], C1),   P0[14], P0[15], P1[0], P1[1],   pw1[2] = TPKW(P0, 12), pw1[3] = TPKW(P0, 14), pw1); \
        TVRD(2); TSB(); TGAPA(C0 = TMF(kf[4], qr[2], C0),   P1[2], P1[3], P1[4], P1[5],     pw2[0] = TPKW(P1, 0), pw2[1] = TPKW(P1, 2), pw2); \
        TVRD(6); TSB(); TGAPA(C1 = TMF(kf[5], qr[2], C1),   P1[6], P1[7], P1[8], P1[9],     pw2[2] = TPKW(P1, 4), pw2[3] = TPKW(P1, 6), pw2); \
        TVRD(3); TSB(); TGAPA(C0 = TMF(kf[6], qr[3], C0),   P1[10], P1[11], P1[12], P1[13], pw3[0] = TPKW(P1, 8), pw3[1] = TPKW(P1, 10), pw3); \
        TVRD(7); TSB(); TGAPA(C1 = TMF(kf[7], qr[3], C1),   P1[14], P1[15], 0.f, 0.f,       pw3[2] = TPKW(P1, 12), pw3[3] = TPKW(P1, 14), pw3); \
        if (ND0 == 6) { C0 = TMF(kf[2 * ND0 - 4], qr[ND0 - 2], C0); C1 = TMF(kf[2 * ND0 - 3], qr[ND0 - 2], C1); C0 = TMF(kf[2 * ND0 - 2], qr[ND0 - 1], C0); C1 = TMF(kf[2 * ND0 - 1], qr[ND0 - 1], C1); TSB(); } \
        l_reg += sacc; \
        if (GK) { TDMA_K((i_) + 3, sl_cur); } if (GV) { TDMA_V((i_) + 1, sl_next); } \
        if ((MJB) >= 0) cmask(C0, C1, (MJB), qrel, hi); \
        TDECIDE(C0, C1, i_); \
        TSB(); \
        TGAPB(o[0] = TMF(TPAF(0), TVFR(0), o[0]), C0, 0); \
        TKRD(GL, 0); TGAPB(o[1] = TMF(TPAF(0), TVFR(4), o[1]), C0, 4); \
        TKRD(GL, 1); TGAPB(o[0] = TMF(TPAF(1), TVFR(1), o[0]), C0, 8); \
        TKRD(GL, 2); TGAPB(o[1] = TMF(TPAF(1), TVFR(5), o[1]), C0, 12); \
        TKRD(GL, 3); TGAPB(o[0] = TMF(TPAF(2), TVFR(2), o[0]), C1, 0); \
        if (ND0 == 6) { TKRD(GL, ND0 - 2); } TGAPB(o[1] = TMF(TPAF(2), TVFR(6), o[1]), C1, 4); \
        if (ND0 == 6) { TKRD(GL, ND0 - 1); } TGAPB(o[0] = TMF(TPAF(3), TVFR(3), o[0]), C1, 8); \
        TGAPB(o[1] = TMF(TPAF(3), TVFR(7), o[1]), C1, 12); \
        if (GL) { TBIAS(P0, P1, sl_next); } \
    } while (0)
#define TENDW(tt) do { if ((tt) + 3 < NT) { TW_BAR(3); } else if ((tt) + 2 < NT) { TW_BAR(1); } else { TW_BAR(0); } } while (0)
    TSTEP(pB0, pB1, pA0, pA1, 1, 2, (1 + 3 < NT), true, true); TENDW(1); TRESC(); TROT();
    TSTEP(pA0, pA1, pB0, pB1, 2, 1, (2 + 3 < NT), true, true); TENDW(2); TRESC(); TROT();
    {
        TSTEP(pB0, pB1, pA0, pA1, 3, 0, (3 + 3 < NT), true, true); TENDW(3); TRESC(); TROT();
        int i = 4;
        for (; i + 2 < NT; i += 2) {
            TSTEP(pA0, pA1, pB0, pB1, i, -1, (i + 3 < NT), true, true);                         TENDW(i);     TRESC(); TROT();
            TSTEP(pB0, pB1, pA0, pA1, i + 1, -1, (i + 4 < NT), (i + 2 < NT), (i + 2 < NT));     TENDW(i + 1); TRESC(); TROT();
        }
        TSTEP(pA0, pA1, pB0, pB1, NT - 2, -1, false, true, true); TENDW(NT - 2); TRESC(); TROT();
        TSTEP(pB0, pB1, pA0, pA1, NT - 1, -1, false, false, false); TRESC();
    }
    { float sacc = pB0[0] + pB0[1];
#pragma unroll
      for (int r = 2; r < 16; ++r) sacc += pB0[r];
#pragma unroll
      for (int r = 0; r < 16; ++r) sacc += pB1[r];
      l_reg += sacc;
      pw0 = (u32x4){TPKW(pB0, 0), TPKW(pB0, 2), TPKW(pB0, 4), TPKW(pB0, 6)}; pw1 = (u32x4){TPKW(pB0, 8), TPKW(pB0, 10), TPKW(pB0, 12), TPKW(pB0, 14)};
      pw2 = (u32x4){TPKW(pB1, 0), TPKW(pB1, 2), TPKW(pB1, 4), TPKW(pB1, 6)}; pw3 = (u32x4){TPKW(pB1, 8), TPKW(pB1, 10), TPKW(pB1, 12), TPKW(pB1, 14)};
      TSB(); pv(o, vb0 + sl_cur * T_VSLOT, TPAF(0), TPAF(1), TPAF(2), TPAF(3)); }
    { auto rr = __builtin_amdgcn_permlane32_swap(__float_as_uint(l_reg), __float_as_uint(l_reg), false, false); l_reg = __uint_as_float(rr[0]) + __uint_as_float(rr[1]); }
    if (hi == 0) wsf[32 + r32] = l_reg; asm volatile("s_waitcnt lgkmcnt(0)" ::: "memory");
    float rli[16];
#pragma unroll
    for (int r = 0; r < 16; ++r) rli[r] = __builtin_amdgcn_rcpf(wsf[32 + crow(r, hi)]);
    unsigned char* Ow = (unsigned char*)O + (rowbase + q0 + wid * 32) * OP + h * 64;
    { LAS unsigned char* stg = lds + T_OST + wid * 4096;
#pragma unroll
      for (int r = 0; r < 16; ++r) { const int orow = crow(r, hi);
#pragma unroll
          for (int d0 = 0; d0 < 2; ++d0) { const float ov = o[d0][r] * rli[r] * OSCALE8; stg[orow * 64 + d0 * 32 + r32] = (unsigned char)__builtin_amdgcn_cvt_pk_fp8_f32(ov, ov, 0, false); } }
      asm volatile("s_waitcnt lgkmcnt(0)" ::: "memory");
#pragma unroll
      for (int i = 0; i < 2; ++i) { const int row = i * 16 + (lane >> 2), ch = lane & 3; const u32x4 v = *(const LAS u32x4*)(stg + row * 64 + ch * 16); *(u32x4*)(Ow + (long)row * OP + ch * 16) = v; } }
    asm volatile("s_waitcnt lgkmcnt(0)\n\ts_barrier" ::: "memory");
#undef TDMA_K
#undef TDMA_V
#undef TROT
#undef TBIAS
#undef TCIN
#undef TRESC
#undef TDECIDE
#undef TPKW
#undef TPAF
#undef TVFR
#undef TPIN
#undef TGAPA
#undef TEX
#undef TGAPB
#undef TVRD
#undef TKRD
#undef TMF
#undef TSTEP
#undef TENDW
}
#undef TW_BAR
#undef TSB
}

namespace dn {
constexpr int CHB = 64 * 256;
constexpr int NSLOT = 8, AHEAD = 7;
__device__ __forceinline__ int nloc(int i) { return 16 * ((i >> 2) & 1) + (i & 3) + 4 * (i >> 3); }
template <bool NOTRAFFIC>
__device__ __forceinline__ void down_phase(LAS unsigned char* lds, const unsigned char* HBp, const unsigned char* Wd, const unsigned char* Wsd, volatile LAS int* tab, const u32x2* meta, unsigned char* Yp, unsigned char* trash, int G, int c) {
    int tid = threadIdx.x; asm volatile("" : "+v"(tid));
    const int wid = __builtin_amdgcn_readfirstlane(tid >> 6), lane = tid & 63, j = lane & 31, hi = lane >> 5;
    const int U = tab[65] * 8;
    const int u_lo = (int)(((long)c * U) / G), u_hi = (int)(((long)(c + 1) * U) / G);
    if (u_lo >= u_hi) return;
#define DN_DEC(u_, e_, hf_, ci_) do { e_ = __builtin_amdgcn_readfirstlane(tab[132 + ((u_) >> 3)]); const int ul_ = __builtin_amdgcn_readfirstlane((u_) - 8 * tab[e_]), nc_ = __builtin_amdgcn_readfirstlane(4 * (tab[e_ + 1] - tab[e_])); hf_ = (ul_ >= nc_) ? 1 : 0; ci_ = ul_ - hf_ * nc_; } while (0)
    unsigned dvo; { const int r_ = lane >> 3, f_ = ((r_ >> 1) & 3) << 1; dvo = (unsigned)(r_ * 256 + (((lane & 7) ^ f_) * 16)); }
#define DN_DMA(u_, buf_) do { int e__, hf__, ci__; DN_DEC(u_, e__, hf__, ci__); (void)hf__; const unsigned char* gb_ = HBp + ((size_t)tab[e__] * 256 + (size_t)ci__ * 64) * DEXP; \
        _Pragma("unroll") for (int i_ = 0; i_ < 2; ++i_) { const int q_ = wid * 2 + i_, kb_ = q_ >> 3, g_ = q_ & 7; \
            __builtin_amdgcn_global_load_lds((const unsigned*)(gb_ + (size_t)(8 * g_) * DEXP + kb_ * 128 + dvo), (LAS unsigned*)(lds + (buf_) * CHB + kb_ * 8192 + g_ * 1024), 16, 0, 0); } } while (0)
    int rowb[2], fx[2];
#pragma unroll
    for (int rt = 0; rt < 2; ++rt) { const int row = 32 * rt + j; rowb[rt] = (int)(uintptr_t)lds + row * 128; fx[rt] = (((row >> 1) & 3) << 1) * 16; }
    unsigned sc1 = 0x7f7f7f7fu; asm volatile("" : "+v"(sc1));
#pragma unroll
    for (int p = 0; p < AHEAD; ++p) { const int un = (u_lo + p < u_hi) ? u_lo + p : u_lo; DN_DMA(un, p); }
    int u = u_lo;
    while (u < u_hi) {
      int e, hf, ci0; DN_DEC(u, e, hf, ci0);
      const int nc = __builtin_amdgcn_readfirstlane(4 * (tab[e + 1] - tab[e])), ne = __builtin_amdgcn_readfirstlane(tab[66 + e]);
      int seg_end = 8 * tab[e] + (hf + 1) * nc; seg_end = __builtin_amdgcn_readfirstlane(seg_end < u_hi ? seg_end : u_hi);
      v8i32_t wfr[2][4];
#pragma unroll
      for (int nt = 0; nt < 2; ++nt) { const unsigned char* wp = ((e == NEXP) ? Wsd : Wd + (size_t)e * D * DEXP) + (size_t)(512 * hf + 64 * wid + 32 * nt + nloc(j)) * DEXP + 32 * hi;
#pragma unroll
          for (int ks = 0; ks < 4; ++ks) { wfr[nt][ks].lo = *(const v4i32_t*)(wp + 64 * ks); wfr[nt][ks].hi = *(const v4i32_t*)(wp + 64 * ks + 16); } }
      bool first = true;
      for (; u < seg_end; ++u) {
        const int buf = (u - u_lo) & (NSLOT - 1); (void)ci0;
        const int cidx = __builtin_amdgcn_readfirstlane((u - 8 * tab[e]) - hf * nc);
        u32x2 mt[2];
#pragma unroll
        for (int rt = 0; rt < 2; ++rt) { int pos = 64 * cidx + 32 * rt + j; const bool in = pos < ne; const int sp = pos; pos = (in && e != NEXP) ? pos : 0; const u32x2 m = meta[(size_t)(e == NEXP ? 0 : e) * LISTCAP + pos];
            mt[rt] = !in ? (u32x2){0xffffffffu, 0u} : (e == NEXP) ? (u32x2){(unsigned)(sp * (TOPK + 1) + TOPK), 0x3f800000u} : m; }
        if (first) { __builtin_amdgcn_s_waitcnt(0x0F70); first = false; }
        else { asm volatile("s_waitcnt vmcnt(54)" ::: "memory"); }
        LDS_WAIT(); __builtin_amdgcn_s_barrier();
        { const int un = (u + AHEAD < u_hi) ? u + AHEAD : u; DN_DMA(un, (buf + AHEAD) & (NSLOT - 1)); }
        f32x16 acc[2][2];
#pragma unroll
        for (int rt = 0; rt < 2; ++rt)
#pragma unroll
            for (int nt = 0; nt < 2; ++nt) asm volatile("v_mov_b32 %0, 0\n\tv_mov_b32 %1, 0\n\tv_mov_b32 %2, 0\n\tv_mov_b32 %3, 0\n\tv_mov_b32 %4, 0\n\tv_mov_b32 %5, 0\n\tv_mov_b32 %6, 0\n\tv_mov_b32 %7, 0\n\tv_mov_b32 %8, 0\n\tv_mov_b32 %9, 0\n\tv_mov_b32 %10, 0\n\tv_mov_b32 %11, 0\n\tv_mov_b32 %12, 0\n\tv_mov_b32 %13, 0\n\tv_mov_b32 %14, 0\n\tv_mov_b32 %15, 0"
                : "=v"(acc[rt][nt][0]), "=v"(acc[rt][nt][1]), "=v"(acc[rt][nt][2]), "=v"(acc[rt][nt][3]), "=v"(acc[rt][nt][4]), "=v"(acc[rt][nt][5]), "=v"(acc[rt][nt][6]), "=v"(acc[rt][nt][7]),
                  "=v"(acc[rt][nt][8]), "=v"(acc[rt][nt][9]), "=v"(acc[rt][nt][10]), "=v"(acc[rt][nt][11]), "=v"(acc[rt][nt][12]), "=v"(acc[rt][nt][13]), "=v"(acc[rt][nt][14]), "=v"(acc[rt][nt][15]));
        v8i32_t ha0, ha1, hb0, hb1;
        const int ad0 = rowb[0] + buf * CHB, ad1 = rowb[1] + buf * CHB;
#define DN_RDA(ks_) do { \
            asm volatile("ds_read_b128 v[192:195], %1 offset:%c2\n\tds_read_b128 v[196:199], %1 offset:%c3" : "={v[192:199]}"(ha0) : "v"(ad0 + ((64 * ((ks_) & 1) + 32 * hi) ^ fx[0])), "i"(((ks_) >> 1) * 8192), "i"(((ks_) >> 1) * 8192 + 16) : "memory"); \
            asm volatile("ds_read_b128 v[200:203], %1 offset:%c2\n\tds_read_b128 v[204:207], %1 offset:%c3" : "={v[200:207]}"(ha1) : "v"(ad1 + ((64 * ((ks_) & 1) + 32 * hi) ^ fx[1])), "i"(((ks_) >> 1) * 8192), "i"(((ks_) >> 1) * 8192 + 16) : "memory"); } while (0)
#define DN_RDB(ks_) do { \
            asm volatile("ds_read_b128 v[208:211], %1 offset:%c2\n\tds_read_b128 v[212:215], %1 offset:%c3" : "={v[208:215]}"(hb0) : "v"(ad0 + ((64 * ((ks_) & 1) + 32 * hi) ^ fx[0])), "i"(((ks_) >> 1) * 8192), "i"(((ks_) >> 1) * 8192 + 16) : "memory"); \
            asm volatile("ds_read_b128 v[216:219], %1 offset:%c2\n\tds_read_b128 v[220:223], %1 offset:%c3" : "={v[216:223]}"(hb1) : "v"(ad1 + ((64 * ((ks_) & 1) + 32 * hi) ^ fx[1])), "i"(((ks_) >> 1) * 8192), "i"(((ks_) >> 1) * 8192 + 16) : "memory"); } while (0)
#define DN_MF(W_, ACC_, H_, REG_, WAIT_) asm volatile(WAIT_ "v_mfma_scale_f32_32x32x64_f8f6f4 %0, %1, %2, %0, %3, %3 op_sel_hi:[0,0,0]" : "+v"(ACC_) : "v"(W_), REG_(H_), "v"(sc1))
        DN_RDA(0);
#pragma unroll
        for (int ks = 0; ks < 4; ks += 2) {
            DN_RDB(ks + 1);
            DN_MF(wfr[0][ks], acc[0][0], ha0, "{v[192:199]}", "s_waitcnt lgkmcnt(4)\n\t"); DN_MF(wfr[1][ks], acc[0][1], ha0, "{v[192:199]}", "");
            DN_MF(wfr[0][ks], acc[1][0], ha1, "{v[200:207]}", ""); DN_MF(wfr[1][ks], acc[1][1], ha1, "{v[200:207]}", "");
            if (ks + 2 < 4) { DN_RDA(ks + 2);
                DN_MF(wfr[0][ks + 1], acc[0][0], hb0, "{v[208:215]}", "s_waitcnt lgkmcnt(4)\n\t"); }
            else { DN_MF(wfr[0][ks + 1], acc[0][0], hb0, "{v[208:215]}", "s_waitcnt lgkmcnt(0)\n\t"); }
            DN_MF(wfr[1][ks + 1], acc[0][1], hb0, "{v[208:215]}", "");
            DN_MF(wfr[0][ks + 1], acc[1][0], hb1, "{v[216:223]}", ""); DN_MF(wfr[1][ks + 1], acc[1][1], hb1, "{v[216:223]}", "");
        }
#undef DN_RDA
#undef DN_RDB
#undef DN_MF
        asm volatile("s_nop 15\n\ts_nop 7" : "+v"(acc[0][0]), "+v"(acc[0][1]), "+v"(acc[1][0]), "+v"(acc[1][1]) :: "memory");
        __builtin_amdgcn_sched_barrier(0);
        const int col0 = 512 * hf + 64 * wid + 16 * hi;
#pragma unroll
        for (int rt = 0; rt < 2; ++rt) { const bool ok = !NOTRAFFIC && mt[rt].x != 0xffffffffu; unsigned char* yd = ok ? Yp + (size_t)mt[rt].x * D : trash; const float w = ok ? __uint_as_float(mt[rt].y) * (1.f / (HSCALE8 * WSCALE8)) : 0.f;
#pragma unroll
            for (int nt = 0; nt < 2; ++nt) { u32x4 o;
#pragma unroll
                for (int q = 0; q < 4; ++q) { int v = __builtin_amdgcn_cvt_pk_fp8_f32(acc[rt][nt][4 * q] * w, acc[rt][nt][4 * q + 1] * w, 0, false);
                    v = __builtin_amdgcn_cvt_pk_fp8_f32(acc[rt][nt][4 * q + 2] * w, acc[rt][nt][4 * q + 3] * w, v, true); o[q] = (unsigned)v; }
                *(u32x4*)(yd + col0 + 32 * nt) = o; } }
      }
    }
    VM_WAIT(); LDS_WAIT(); __builtin_amdgcn_s_barrier();
#undef DN_DMA
#undef DN_DEC
}
}

namespace up {
__device__ __forceinline__ int nloc(int i) { return 16 * ((i >> 2) & 1) + (i & 3) + 4 * (i >> 3); }
__device__ __forceinline__ void up_phase(LAS unsigned char* lds, const bf16* QL, const bf16* KVL, const bf16* Wq, const bf16* Wkv, const float* ssqq, const float* ssqkv, const float* ropetab,
                                         bf16* Qo, bf16* KNo, bf16* VMo, int G, int c) {
    int tid = threadIdx.x; asm volatile("" : "+v"(tid));
    const int wid = __builtin_amdgcn_readfirstlane(tid >> 6), lane = tid & 63, j = lane & 31, hi = lane >> 5;
    for (int grp = c; grp < T / 64; grp += G) {
        const int row0 = grp * 64;
        { const int r_ = lane >> 3, p_ = lane & 7;
#pragma unroll
          for (int i = 0; i < 6; ++i) { const int q_ = wid * 6 + i;
              const bool isq = q_ < 32; const int rem = isq ? q_ : q_ - 32, kb = rem >> 3, g = rem & 7, f_ = (4 * (g & 1) + (r_ >> 1)) & 7;
              __builtin_amdgcn_global_load_lds((const unsigned*)((isq ? QL : KVL) + (size_t)(row0 + 8 * g + r_) * 256 + kb * 64 + ((p_ ^ f_) * 8)), (LAS unsigned*)(lds + (isq ? 0 : 32768) + kb * 8192 + g * 1024), 16, 0, 0); } }
        float rsq[2], rskv[2];
#pragma unroll
        for (int rt = 0; rt < 2; ++rt) { const int row = row0 + 32 * rt + j; const f32x4 a = *(const f32x4*)(ssqq + (size_t)row * 4), b4 = *(const f32x4*)(ssqkv + (size_t)row * 4);
            rsq[rt] = rsqrtf(((a[0] + a[1]) + (a[2] + a[3])) * (1.f / QLORA) + EPS) * C2M; rskv[rt] = rsqrtf(((b4[0] + b4[1]) + (b4[2] + b4[3])) * (1.f / KVLORA) + EPS); }
        const unsigned lane16 = (unsigned)lane * 16u;
        bf16x8 wA[16];
#define UP_LOADW(WB_, Wp_, col_, KS_) do { const char* wb_ = (const char*)(Wp_) + (size_t)__builtin_amdgcn_readfirstlane((col_) >> 5) * (KS_) * 1024;     \
            _Pragma("unroll") for (int ks = 0; ks < (KS_); ++ks) wA[(WB_) + ks] = *(const bf16x8*)(wb_ + ks * 1024 + lane16); } while (0)
#define UP_STEP(WB_, ISQ_, col_, KS_) do { f32x16 acc[2]; acc[0] = f32x16{}; acc[1] = f32x16{}; \
            _Pragma("unroll") for (int ks = 0; ks < (KS_); ++ks) { bf16x8 af[2]; \
                _Pragma("unroll") for (int rt = 0; rt < 2; ++rt) { const int row = 32 * rt + j, cc = 2 * (ks & 3) + hi; \
                    af[rt] = *(const LAS bf16x8*)(lds + ((ISQ_) ? 0 : 32768) + (ks >> 2) * 8192 + row * 128 + ((cc ^ ((row >> 1) & 7)) * 16)); } \
                _Pragma("unroll") for (int rt = 0; rt < 2; ++rt) acc[rt] = __builtin_amdgcn_mfma_f32_32x32x16_bf16(wA[(WB_) + ks], af[rt], acc[rt], 0, 0, 0); } \
            _Pragma("unroll") for (int rt = 0; rt < 2; ++rt) { const int row = row0 + 32 * rt + j; const float r_s = (ISQ_) ? rsq[rt] : rskv[rt]; const int col = (col_) + 16 * hi; \
                float v[16]; _Pragma("unroll") for (int r = 0; r < 16; ++r) v[r] = acc[rt][r] * r_s; \
                bf16* dst; \
                if (ISQ_) { const int jh = col % MQK; \
                    if (jh >= 64) { const int g0 = (jh - 64) >> 3; const f32x4* tb = (const f32x4*)(ropetab + ((size_t)row * 16 + 4 * g0) * 2); \
                        _Pragma("unroll") for (int gg = 0; gg < 2; ++gg) { const f32x4 t0 = tb[2 * gg], t1 = tb[2 * gg + 1]; float* w_ = v + 8 * gg; \
                            const float cs[4] = {t0[0], t0[2], t1[0], t1[2]}, sn[4] = {t0[1], t0[3], t1[1], t1[3]}; \
                            _Pragma("unroll") for (int q = 0; q < 4; ++q) { const float x1 = w_[q], x2 = w_[4 + q]; w_[q] = x1 * cs[q] - x2 * sn[q]; w_[4 + q] = x2 * cs[q] + x1 * sn[q]; } } } \
                    dst = Qo + (size_t)row * 768 + col; } \
                else dst = (col >= 512 ? VMo + (col - 512) : KNo + col) + (size_t)row * 512; \
                *(u32x4*)dst = (u32x4){cvt_pk_bf16(v[0], v[1]), cvt_pk_bf16(v[2], v[3]), cvt_pk_bf16(v[4], v[5]), cvt_pk_bf16(v[6], v[7])}; \
                *(u32x4*)(dst + 8) = (u32x4){cvt_pk_bf16(v[8], v[9]), cvt_pk_bf16(v[10], v[11]), cvt_pk_bf16(v[12], v[13]), cvt_pk_bf16(v[14], v[15])}; } } while (0)
        const int cq = 96 * wid, ckv = 128 * wid;
#define UP_SB() __builtin_amdgcn_sched_barrier(0)
        UP_LOADW(0, Wq, cq, 16);
        VM_WAIT(); __syncthreads();
        UP_STEP(0, true, cq, 16);        UP_SB(); UP_LOADW(0, Wq, cq + 32, 16); UP_SB();
        UP_STEP(0, true, cq + 32, 16);   UP_SB(); UP_LOADW(0, Wq, cq + 64, 16); UP_SB();
        UP_STEP(0, true, cq + 64, 16);   UP_SB(); UP_LOADW(0, Wkv, ckv, 8); UP_LOADW(8, Wkv, ckv + 32, 8); UP_SB();
        UP_STEP(0, false, ckv, 8);       UP_SB(); UP_LOADW(0, Wkv, ckv + 64, 8); UP_SB();
        UP_STEP(8, false, ckv + 32, 8);  UP_SB(); UP_LOADW(8, Wkv, ckv + 96, 8); UP_SB();
        UP_STEP(0, false, ckv + 64, 8);  UP_SB();
        UP_STEP(8, false, ckv + 96, 8);
#undef UP_SB
#undef UP_LOADW
#undef UP_STEP
        __syncthreads();
    }
}
}

#define XB_TMO      128
#define XB_XCNT(j)  (256  + 64 * (j))
#define XB_XSUB(j)  (1280 + 64 * (j))
#define XB_XGEN(j)  (2304 + 64 * (j))
#define XB_TOP      3328
#define XB_TOPGEN   3392
#define XCD_BAR_WORDS 3456
#define XB_SPIN_CAP (1u << 18)
__device__ __forceinline__ unsigned xb_ld(unsigned* p)              { return __hip_atomic_load(p, __ATOMIC_RELAXED, __HIP_MEMORY_SCOPE_AGENT); }
__device__ __forceinline__ unsigned xb_add(unsigned* p, unsigned v) { return __hip_atomic_fetch_add(p, v, __ATOMIC_RELAXED, __HIP_MEMORY_SCOPE_AGENT); }
__device__ __forceinline__ unsigned xb_xcc_id() { return (unsigned)__builtin_amdgcn_s_getreg((3 << 11) | 20) & 0xFu; }
#define XB_SPIN(cond, bar) do { unsigned _sp = 0; while (cond) { __builtin_amdgcn_s_sleep(1); \
    if ((++_sp & 255u) == 0u) { if (xb_ld(&(bar)[XB_TMO])) break; if (_sp > XB_SPIN_CAP) { atomicAdd(&(bar)[XB_TMO], 1u); break; } } } } while (0)
struct XcdBarrier { unsigned* bar; unsigned x; volatile LAS unsigned* st; };
__device__ __forceinline__ XcdBarrier xcd_barrier_post(unsigned* bar, volatile LAS unsigned* st) {
    XcdBarrier b; b.bar = bar; b.x = xb_xcc_id(); b.st = st;
    if (threadIdx.x == 0) (void)xb_add(&bar[XB_XCNT(b.x)], 1u);
    return b;
}
__device__ __forceinline__ void xcd_barrier_complete(unsigned* bar, unsigned x, unsigned& nloc, unsigned& nx) {
    const unsigned G = gridDim.x * gridDim.y * gridDim.z;
    unsigned sum, cnt, mine, sp = 0u;
    for (;;) {
        sum = 0u; cnt = 0u; mine = 0u;
#pragma unroll
        for (unsigned j = 0; j < 16; ++j) { const unsigned c = xb_ld(&bar[XB_XCNT(j)]); sum += c; cnt += (c > 0u) ? 1u : 0u; mine = (j == x) ? c : mine; }
        if (sum == G) break;
        __builtin_amdgcn_s_sleep(1);
        if ((++sp & 255u) == 0u) { if (xb_ld(&bar[XB_TMO])) break; if (sp > XB_SPIN_CAP) { atomicAdd(&bar[XB_TMO], 1u); break; } }
    }
    nloc = mine > 0u ? mine : 1u; nx = cnt > 0u ? cnt : 1u;
}
__device__ __forceinline__ void xcd_barrier(const XcdBarrier& b) {
    asm volatile("s_waitcnt vmcnt(0)" ::: "memory");
    __syncthreads();
    if (threadIdx.x == 0) {
        unsigned* bar = b.bar;
        __builtin_amdgcn_s_waitcnt(0);
        unsigned nloc = b.st[0], nx = b.st[1];
        if (nloc == 0u) { xcd_barrier_complete(bar, b.x, nloc, nx); b.st[0] = nloc; b.st[1] = nx; }
        const unsigned old = xb_add(&bar[XB_XSUB(b.x)], 1u);
        const unsigned gen = old / nloc;
        if (old + 1u == (gen + 1u) * nloc) {
            __builtin_amdgcn_fence(__ATOMIC_RELEASE, "agent");
            asm volatile("s_waitcnt vmcnt(0)" ::: "memory");
            const unsigned og = xb_add(&bar[XB_TOP], 1u);
            const unsigned tg = og / nx;
            if (og + 1u == (tg + 1u) * nx) xb_add(&bar[XB_TOPGEN], 1u);
            else XB_SPIN(xb_ld(&bar[XB_TOPGEN]) == tg, bar);
            __builtin_amdgcn_fence(__ATOMIC_ACQUIRE, "agent");
            xb_add(&bar[XB_XGEN(b.x)], 1u);
            asm volatile("s_waitcnt vmcnt(0)" ::: "memory");
        } else {
            XB_SPIN(xb_ld(&bar[XB_XGEN(b.x)]) == gen, bar);
            __builtin_amdgcn_fence(__ATOMIC_ACQUIRE, "agent");
            asm volatile("s_waitcnt vmcnt(0)" ::: "memory");
        }
    }
    __syncthreads();
}

struct Args { const void* in[25]; float* out; unsigned char* ws; int ph_lo, ph_hi; };

struct Frame {
    LAS unsigned char* lds;
    int tid, lane, wave, vcu, G;
};

template <class ColFn>
__device__ __forceinline__ void cvt_item(int ldw, int Ksrc, const float* kscale, bf16* WT, int Kd, LAS float* scr, int kb, int nb, int lane, ColFn colp) {
    const int k0 = 64 * kb, n0 = 32 * nb;
    const float* cp = colp(n0 + (lane & 31));
    float vv[32], sv[32];
#pragma unroll
    for (int i = 0; i < 32; ++i) { const int k = k0 + 2 * i + (lane >> 5);
        vv[i] = (cp != nullptr && k < Ksrc) ? cp[(size_t)k * ldw] : 0.f;
        sv[i] = (kscale != nullptr && k < Ksrc) ? kscale[k] : 1.f; }
#pragma unroll
    for (int i = 0; i < 32; ++i) scr[(2 * i + (lane >> 5)) * 33 + (lane & 31)] = vv[i] * sv[i];
    LDS_WAIT(); asm volatile("" ::: "memory");
    const int c = lane & 7;
#pragma unroll
    for (int j = 0; j < 4; ++j) { const int n = (lane >> 3) + 8 * j; const LAS float* s = scr + (8 * c) * 33 + n;
        u32x4 o; o.x = pk2(s[0 * 33], s[1 * 33]); o.y = pk2(s[2 * 33], s[3 * 33]); o.z = pk2(s[4 * 33], s[5 * 33]); o.w = pk2(s[6 * 33], s[7 * 33]);
        *(u32x4*)(WT + (size_t)(n0 + n) * Kd + k0 + 8 * c) = o; }
    LDS_WAIT(); asm volatile("" ::: "memory");
}
__device__ __forceinline__ void cvt64_item(const float* src, int ldw, bf16* dst, int Kd, LAS unsigned char* scr, int lane) {
    f32x4 v[16];
    const float* sp = src + (size_t)(lane >> 4) * ldw + 4 * (lane & 15);
#pragma unroll
    for (int i = 0; i < 16; ++i) v[i] = __builtin_nontemporal_load((const f32x4*)(sp + (size_t)(4 * i) * ldw));
#pragma unroll
    for (int i = 0; i < 16; ++i) { const int k = 4 * i + (lane >> 4);
#pragma unroll
        for (int q = 0; q < 4; ++q) { const int n = 4 * (lane & 15) + q; *(LAS bf16*)(scr + n * 128 + (((k >> 3) ^ ((n >> 2) & 7)) << 4) + (k & 7) * 2) = (bf16)f2bf(v[i][q]); } }
    LDS_WAIT(); asm volatile("" ::: "memory");
#pragma unroll
    for (int j = 0; j < 8; ++j) { const int p = j * 64 + lane, n = p >> 3, c = p & 7;
        const u32x4 o = *(const LAS u32x4*)(scr + n * 128 + ((c ^ ((n >> 2) & 7)) << 4));
        __builtin_nontemporal_store(o, (u32x4*)(dst + (size_t)n * Kd + c * 8)); }
    LDS_WAIT(); asm volatile("" ::: "memory");
}
__device__ __forceinline__ void cvt64_item8(const float* src, int ldw, unsigned char* dst, int Kd8, LAS unsigned char* scr, int lane, float scale) {
    f32x4 v[16];
    const float* sp = src + (size_t)(16 * (lane >> 4)) * ldw + 4 * (lane & 15);
#pragma unroll
    for (int i = 0; i < 16; ++i) v[i] = __builtin_nontemporal_load((const f32x4*)(sp + (size_t)i * ldw));
#pragma unroll
    for (int q = 0; q < 4; ++q) { u32x4 o;
#pragma unroll
        for (int g = 0; g < 4; ++g) { int p_ = __builtin_amdgcn_cvt_pk_fp8_f32(v[4 * g][q] * scale, v[4 * g + 1][q] * scale, 0, false); p_ = __builtin_amdgcn_cvt_pk_fp8_f32(v[4 * g + 2][q] * scale, v[4 * g + 3][q] * scale, p_, true); o[g] = (unsigned)p_; }
        *(LAS u32x4*)(scr + (4 * (lane & 15) + q) * 80 + (lane >> 4) * 16) = o; }
    LDS_WAIT(); asm volatile("" ::: "memory");
#pragma unroll
    for (int j = 0; j < 4; ++j) { const int p = j * 64 + lane, n = p >> 2, c = p & 3;
        const u32x4 o = *(const LAS u32x4*)(scr + n * 80 + c * 16);
        __builtin_nontemporal_store(o, (u32x4*)(dst + (size_t)n * Kd8 + c * 16)); }
    LDS_WAIT(); asm volatile("" ::: "memory");
}
__device__ __forceinline__ int ropedim(int jj) { const int g = jj >> 3, u = jj & 7; return (u < 4) ? 4 * g + u : 16 + 4 * g + (u - 4); }

__device__ __forceinline__ void sincos_acc(float af, float& sn, float& cs) {
    const double a = (double)af; const double kq = __builtin_rint(a * 0.63661977236758134308);
    const double r = (a - kq * 1.57079632679489655800) - kq * 6.123233995736766036e-17;
    const double r2 = r * r;
    const double sp = r * (1.0 + r2 * (-1.66666666666666324348e-01 + r2 * (8.33333333332248946124e-03 + r2 * (-1.98412698298579493134e-04 + r2 * (2.75573137070700676789e-06 + r2 * (-2.50507602534068634195e-08 + r2 * 1.58969099521155010221e-10))))));
    const double cp = 1.0 + r2 * (-0.5 + r2 * (4.16666666666666019037e-02 + r2 * (-1.38888888888741095749e-03 + r2 * (2.48015872894767294178e-05 + r2 * (-2.75573143513906633035e-07 + r2 * (2.08757232129817482790e-09 + r2 * -1.13596475577881948265e-11))))));
    const int q = (int)((long long)kq & 3);
    const double s_ = (q == 0) ? sp : (q == 1) ? cp : (q == 2) ? -sp : -cp;
    const double c_ = (q == 0) ? cp : (q == 1) ? -sp : (q == 2) ? -cp : sp;
    sn = (float)s_; cs = (float)c_;
}

__global__ void __launch_bounds__(NWAVES * 64, 2) fwd(Args args) {
    extern __shared__ __attribute__((aligned(16))) unsigned char lds_raw[];
    Frame F;
    F.lds = (LAS unsigned char*)lds_raw;
    F.tid = threadIdx.x; F.lane = F.tid & 63; F.wave = __builtin_amdgcn_readfirstlane(F.tid >> 6);
    F.G = gridDim.x; { const int bx = blockIdx.x; F.vcu = (F.G % 8 == 0) ? (bx % 8) * (F.G / 8) + bx / 8 : bx; }
    volatile LAS unsigned* MISC = (volatile LAS unsigned*)(F.lds + MISC_OFF);
    unsigned char* ws = args.ws;
    gu32* ctl = (gu32*)(ws + WS_CTL);
#define X_IN ((const float*)AP->in[0])
#define cvec ((const float*)AP->in[1])
#define positions ((const int*)AP->in[2])
#define w_mod ((const float*)AP->in[3])
#define b_mod ((const float*)AP->in[4])
#define g_mix ((const float*)AP->in[5])
#define w_in ((const float*)AP->in[6])
#define b_forget ((const float*)AP->in[7])
#define g_q_lat ((const float*)AP->in[8])
#define w_q_up ((const float*)AP->in[9])
#define g_kv_lat ((const float*)AP->in[10])
#define w_kv_up ((const float*)AP->in[11])
#define w_o_mla ((const float*)AP->in[12])
#define w_o_fox ((const float*)AP->in[13])
#define w_out ((const float*)AP->in[14])
#define g_ffn ((const float*)AP->in[15])
#define w_router ((const float*)AP->in[16])
#define b_router ((const float*)AP->in[17])
#define w_exp_gate ((const float*)AP->in[18])
#define w_exp_up ((const float*)AP->in[19])
#define w_exp_down ((const float*)AP->in[20])
#define w_sh_gate ((const float*)AP->in[21])
#define w_sh_up ((const float*)AP->in[22])
#define w_sh_down ((const float*)AP->in[23])
#define g_final ((const float*)AP->in[24])
#define Win_t ((bf16*)(ws + WS_WIN))
#define Wq_t ((bf16*)(ws + WS_WQ))
#define Wkv_t ((bf16*)(ws + WS_WKV))
#define Wom_t ((bf16*)(ws + WS_WOM))
#define Wof_t ((bf16*)(ws + WS_WOF))
#define Wout_t ((bf16*)(ws + WS_WOUT))
#define Wsgu_t ((bf16*)(ws + WS_WSGU))
#define Wsd_t ((bf16*)(ws + WS_WSD))
#define Wr_f ((bf16*)(ws + WS_WR))
#define mod ((float*)(ws + WS_MOD))
#define Wd_t ((bf16*)(ws + WS_WD))
#define Wgu_t ((bf16*)(ws + WS_WGU))
#define HB ((bf16*)(ws + WS_HB))
#define FQ ((bf16*)(ws + WS_FQ))
#define FK ((bf16*)(ws + WS_FK))
#define FV ((bf16*)(ws + WS_FV))
#define QLAT ((bf16*)(ws + WS_QLAT))
#define KVLAT ((bf16*)(ws + WS_KVLAT))
#define OFOX ((bf16*)(ws + WS_OFOX))
#define OCAT ((bf16*)((unsigned char*)out + 32 * MiB))
#define OMLA ((bf16*)(ws + WS_OMLA))
#define Y ((bf16*)(ws + WS_Y))
#define H ((bf16*)(ws + WS_H))
#define QMLA ((bf16*)(ws + WS_QMLA))
#define GATES ((bf16*)(ws + WS_GATES))
#define KN ((bf16*)(ws + WS_KN))
#define VM ((bf16*)(ws + WS_VM))
#define KPE ((bf16*)(ws + WS_KPE))
#define MERGED ((bf16*)(ws + WS_MERGED))
#define LIST ((unsigned short*)(ws + WS_LIST))
#define Wgu8 ((unsigned char*)(ws + WS_WGU))
#define Wsgu8 ((unsigned char*)(ws + WS_WSGU))
#define H8 ((unsigned char*)(ws + WS_H))
#define META ((u32x2*)(ws + WS_WIN))
#define EIDX ((unsigned char*)(ws + WS_EIDX))
#define GATEW ((float*)(ws + WS_GATEW))
#define ROPETAB ((float*)((unsigned char*)out + DO_ROPE))
#define LOGF ((float*)((unsigned char*)out + DO_LOGF))
#define CUMF ((float*)((unsigned char*)out + DO_CUMF))
#define SSQQ ((float*)((unsigned char*)out + DO_SSQQ))
#define SSQKV ((float*)((unsigned char*)out + DO_SSQKV))
#define MODP ((float*)((unsigned char*)out + DO_MODP))
#define SSQ1 ((float*)(ws + WS_FQ))
    float* const out = args.out;
#define PHASE_ENV const __attribute__((address_space(4))) Args* AP; { auto kp_ = __builtin_amdgcn_kernarg_segment_ptr(); asm volatile("" : "+s"(kp_)); AP = (const __attribute__((address_space(4))) Args*)kp_; } \
    unsigned char* const ws = AP->ws; float* const out = AP->out; (void)ws; (void)out;
    for (int u = F.tid; u < (LDS_BYTES - LDSCTL_OFF) / 4; u += NWAVES * 64) ((LAS unsigned*)(F.lds + LDSCTL_OFF))[u] = 0u;
    __syncthreads();
    XcdBarrier bar; bar.bar = (unsigned*)(ctl + CW_BAR); bar.x = 0; bar.st = nullptr;
    if (MK_ONE_LAUNCH) bar = xcd_barrier_post((unsigned*)(ctl + CW_BAR), MISC + 8);
    const int lo = args.ph_lo, hi = args.ph_hi;
#define IN(k) (lo <= (k) && (k) < hi)
#define BOTH(k) (IN(k) && IN((k) + 1))
#define GRID_BAR() do { if (MK_ONE_LAUNCH) xcd_barrier(bar); } while (0)
#define DUP_BAR() do { if (dummy) xcd_barrier(bar); } while (0)
    const int gw = F.vcu * NWAVES + F.wave, NGW = F.G * NWAVES;

    for (int rep = 0; rep < ((PROBE_DUP == 0) ? 2 : 1); ++rep) if (IN(0)) { PHASE_ENV const bool dummy = (PROBE_DUP == 0) && rep == 0; (void)dummy;
        if (!(dummy && (PROBE_VAR == 1 || PROBE_VAR == 4 || PROBE_VAR == 5))) {
            LAS float* cond = (LAS float*)F.lds;
            for (int i = F.tid; i < NB * D; i += NWAVES * 64) { const float c = cvec[i]; cond[i] = c / (1.f + __expf(-c)); }
            __syncthreads();
            for (int it = F.wave * F.G + F.vcu; it < 96 * 16; it += NWAVES * F.G) { const int cg = it % 96, kq = it / 96, col = cg * 64 + F.lane;
                float a4[4] = {0.f, 0.f, 0.f, 0.f};
                const float* wp = w_mod + (size_t)(64 * kq) * (6 * D) + col;
                float wv[64];
#pragma unroll
                for (int kk = 0; kk < 64; ++kk) wv[kk] = __builtin_nontemporal_load(wp + (size_t)kk * (6 * D));
#pragma unroll
                for (int kk = 0; kk < 64; ++kk) {
#pragma unroll
                    for (int b = 0; b < 4; ++b) a4[b] += wv[kk] * cond[b * D + 64 * kq + kk]; }
#pragma unroll
                for (int b = 0; b < 4; ++b) MODP[((size_t)kq * 4 + b) * (6 * D) + col] = a4[b]; }
            __syncthreads();
        }
        if (!(dummy && (PROBE_VAR == 1 || PROBE_VAR == 3 || PROBE_VAR == 5))) for (int i = gw * 64 + F.lane; i < T * 16; i += NGW * 64) { const int t = i >> 4, j = i & 15;
            const float invf = (((j >> 2) == 0) ? 1.f : ((j >> 2) == 1) ? 0.1f : ((j >> 2) == 2) ? 0.01f : 0.001f) * (((j & 3) == 0) ? 1.f : ((j & 3) == 1) ? 0.5623413251903491f : ((j & 3) == 2) ? 0.31622776601683794f : 0.17782794100389228f);
            const float ang = (float)positions[t] * invf; float sn, cs; sincos_acc(ang, sn, cs);
            *(f32x2*)(ROPETAB + (size_t)i * 2) = (f32x2){cs, sn}; }
        for (int o = gw * 64 + F.lane; o < NEXP * D; o += NGW * 64) { const int piece = o >> 3, kk = o & 7, ln = piece & 63, grp = piece >> 6, ntl = grp & 3, j = grp >> 2;
            const int n = ntl * 16 + (ln & 15), k = j * 32 + (ln >> 4) * 8 + kk; Wr_f[o] = (bf16)f2bf(w_router[(size_t)k * NEXP + n]); }
        {
            LAS unsigned char* scr8 = F.lds + 32768 + F.wave * 9216;
            constexpr int F_IN = 62 * 16;
            if (!(dummy && PROBE_VAR >= 2)) for (int it = gw; it < F_IN; it += NGW) {
                int nb = it % 62; const int kb = it / 62; if (nb >= 6) nb += 2; const int n0 = 64 * nb;
                const int src = (n0 < 384) ? n0 : (n0 < 2048) ? 416 + (n0 - 512) : 1960 + (n0 - 2048);
                cvt64_item(w_in + (size_t)(64 * kb) * 4008 + src, 4008, Win_t + (size_t)n0 * D + 64 * kb, D, scr8, F.lane);
            }
            LAS float* scr = (LAS float*)(F.lds + 32768 + F.wave * 9216);
            constexpr int I_INS = 4 * (D / 64), NSLOW = I_INS;
            if (!(dummy && (PROBE_VAR == 1 || PROBE_VAR == 3 || PROBE_VAR == 4))) for (int it = F.wave * F.G + F.vcu; it < NSLOW; it += NGW) {
                const int nb = 12 + (it & 3), kb = it >> 2;
                cvt_item(4008, D, nullptr, Win_t, D, scr, kb, nb, F.lane, [&](int n) -> const float* {
                    int src; if (n < 416) src = 384 + ropedim(n - 384); else if (n < 424) src = 1952 + (n - 416); else src = -1;
                    return src < 0 ? nullptr : w_in + src; });
            }
            if (!(dummy && (PROBE_VAR == 1 || PROBE_VAR == 3 || PROBE_VAR == 4))) {
                for (int o = gw * 64 + F.lane; o < 768 * QLORA; o += NGW * 64) { const int cb = o >> 13, rem = o & 8191, ks = rem >> 9, ln = (rem >> 3) & 63, e = rem & 7;
                    const int n = cb * 32 + up::nloc(ln & 31), k = 16 * ks + 8 * (ln >> 5) + e, hh = n / MQK, jj = n % MQK, sc = hh * MQK + (jj < 64 ? jj : 64 + ropedim(jj - 64));
                    Wq_t[o] = (bf16)f2bf(w_q_up[(size_t)k * 768 + sc] * g_q_lat[k]); }
                for (int o = gw * 64 + F.lane; o < 1024 * KVLORA; o += NGW * 64) { const int cb = o >> 12, rem = o & 4095, ks = rem >> 9, ln = (rem >> 3) & 63, e = rem & 7;
                    const int n = cb * 32 + up::nloc(ln & 31), k = 16 * ks + 8 * (ln >> 5) + e, sc = (n < 512) ? (n >> 6) * 128 + (n & 63) : ((n - 512) >> 6) * 128 + 64 + (n & 63);
                    Wkv_t[o] = (bf16)f2bf(w_kv_up[(size_t)k * 1024 + sc] * g_kv_lat[k]); }
            }
        }
        if (BOTH(0)) GRID_BAR();
    }

    for (int rep = 0; rep < ((PROBE_DUP == 1) ? 2 : 1); ++rep) if (IN(1)) { PHASE_ENV const bool dummy = (PROBE_DUP == 1) && rep == 0; (void)dummy;
        if (F.vcu < 48) { const int idx = F.vcu * 512 + F.tid, b = idx / (6 * D), col = idx % (6 * D); float sm = b_mod[col];
#pragma unroll
            for (int p = 0; p < 16; ++p) sm += MODP[((size_t)p * 4 + b) * (6 * D) + col];
            mod[idx] = sm; }
        LAS float* vg1 = (LAS float*)F.lds; LAS float* vs1 = (LAS float*)(F.lds + 4096);
        for (int grp = F.vcu; grp < T / 64; grp += F.G) {
            const int b = (grp * 64) / SEQ;
            __syncthreads();
            for (int k = F.tid; k < D; k += NWAVES * 64) { float s0 = b_mod[k], s1 = b_mod[D + k];
#pragma unroll
                for (int p = 0; p < 16; ++p) { s0 += MODP[((size_t)p * 4 + b) * (6 * D) + k]; s1 += MODP[((size_t)p * 4 + b) * (6 * D) + D + k]; }
                vs1[k] = s0; vg1[k] = g_mix[k] * (1.f + s1); }
            __syncthreads();
#pragma unroll 2
            for (int rr = 0; rr < 8; ++rr) { const int m = grp * 64 + F.wave * 8 + rr;
                const f32x4* xr = (const f32x4*)(X_IN + (size_t)m * D) + F.lane;
                f32x4 v[4]; float s = 0.f;
#pragma unroll
                for (int j = 0; j < 4; ++j) { v[j] = __builtin_nontemporal_load(xr + 64 * j); s += (v[j].x * v[j].x + v[j].y * v[j].y) + (v[j].z * v[j].z + v[j].w * v[j].w); }
                const float rstd = rsqrtf(wave_sum(s) * (1.f / D) + EPS);
                unsigned long long* o8 = (unsigned long long*)(H + (size_t)m * D) + F.lane;
#pragma unroll
                for (int j = 0; j < 4; ++j) { const int c = 4 * F.lane + 256 * j;
                    const f32x4 g = *(const LAS f32x4*)(vg1 + c), d = *(const LAS f32x4*)(vs1 + c);
                    const f32x4 r = v[j] * rstd * g + d;
                    o8[64 * j] = (unsigned long long)pk2(r.x, r.y) | ((unsigned long long)pk2(r.z, r.w) << 32); } }
        }
        if (BOTH(1)) GRID_BAR();
    }

    for (int rep = 0; rep < ((PROBE_DUP == 2) ? 2 : 1); ++rep) if (IN(2)) { PHASE_ENV const bool dummy = (PROBE_DUP == 2) && rep == 0; (void)dummy;
        pg8::StaticOrder S; S.init(H, Win_t, T, NIN, D, F.G, (int)blockIdx.x);
        EpiInProj E{QLAT, KVLAT, KPE, FQ, GATES, LOGF, SSQQ, SSQKV, ROPETAB, b_forget, dummy && (PROBE_VAR == 1), (dummy && PROBE_VAR == 2) ? 0 : (dummy && PROBE_VAR == 3) ? 2 : 1};
        pg8::gemm_phase<EpiInProj, pg8::StaticOrder, true>(F.lds, S, E);
        if (BOTH(2)) GRID_BAR();
    }

    for (int rep = 0; rep < ((PROBE_DUP == 3) ? 2 : 1); ++rep) if (IN(3)) { PHASE_ENV const bool dummy = (PROBE_DUP == 3) && rep == 0; (void)dummy;
        if (!(dummy && (PROBE_VAR == 2 || PROBE_VAR == 3))) {
            const int bb = F.vcu & 3; float mx = 0.f, mq = 0.f;
            for (int r = (F.vcu >> 2) * NWAVES + F.wave; r < SEQ; r += (F.G >> 2) * NWAVES) { f32x4 k0, k1, q0v, q1v; unpack8(*(const u32x4*)(FK + ((size_t)bb * SEQ + r) * 512 + 8 * F.lane), k0, k1);
                unpack8(*(const u32x4*)(FQ + ((size_t)bb * SEQ + r) * 512 + 8 * F.lane), q0v, q1v);
                float sq = (k0[0] * k0[0] + k0[1] * k0[1]) + (k0[2] * k0[2] + k0[3] * k0[3]) + (k1[0] * k1[0] + k1[1] * k1[1]) + (k1[2] * k1[2] + k1[3] * k1[3]);
                float sqq = (q0v[0] * q0v[0] + q0v[1] * q0v[1]) + (q0v[2] * q0v[2] + q0v[3] * q0v[3]) + (q1v[0] * q1v[0] + q1v[1] * q1v[1]) + (q1v[2] * q1v[2] + q1v[3] * q1v[3]);
                sq += dppf<0xB1>(sq); sq += dppf<0x4E>(sq); sq += dppf<0x141>(sq);
                sqq += dppf<0xB1>(sqq); sqq += dppf<0x4E>(sqq); sqq += dppf<0x141>(sqq);
                mx = fmaxf(mx, sq); mq = fmaxf(mq, sqq); }
            LAS float* kml = (LAS float*)F.lds;
            if ((F.lane & 7) == 0) { kml[F.wave * 8 + (F.lane >> 3)] = mx; kml[64 + F.wave * 8 + (F.lane >> 3)] = mq; }
            __syncthreads();
            if (F.tid < 2 * NHEAD) { const int hh = F.tid & 7, qk = F.tid >> 3; float m2 = 0.f;
#pragma unroll
                for (int w = 0; w < NWAVES; ++w) m2 = fmaxf(m2, kml[qk * 64 + w * 8 + hh]);
                atomicMax((unsigned*)(ctl + CW_KM + qk * 32 + bb * NHEAD + hh), __float_as_uint(m2)); }
            __syncthreads();
        }
        if (F.vcu < NB * NHEAD && !(dummy && (PROBE_VAR == 1 || PROBE_VAR == 3))) {
            const int b = F.vcu >> 3, h = F.vcu & 7; const float* src = LOGF + ((size_t)b * SEQ + 8 * F.tid) * 8 + h;
            float v[8]; float run = 0.f;
#pragma unroll
            for (int i = 0; i < 8; ++i) v[i] = src[i * 8];
#pragma unroll
            for (int i = 0; i < 8; ++i) { run += v[i]; v[i] = run; }
            float incl = run;
#pragma unroll
            for (int o = 1; o < 64; o <<= 1) { const float n = __shfl_up(incl, o); if (F.lane >= o) incl += n; }
            LAS float* wt = (LAS float*)F.lds;
            if (F.lane == 63) wt[F.wave] = incl;
            __syncthreads();
            float woff = 0.f;
#pragma unroll
            for (int w = 0; w < NWAVES; ++w) woff += (w < F.wave) ? wt[w] : 0.f;
            const float excl = woff + incl - run;
            float* dst = CUMF + ((size_t)b * NHEAD + h) * SEQ + 8 * F.tid;
            *(f32x4*)dst = (f32x4){v[0] + excl, v[1] + excl, v[2] + excl, v[3] + excl}; *(f32x4*)(dst + 4) = (f32x4){v[4] + excl, v[5] + excl, v[6] + excl, v[7] + excl};
            __syncthreads();
        }
        if (!(dummy && (PROBE_VAR == 1 || PROBE_VAR == 2))) up::up_phase(F.lds, QLAT, KVLAT, Wq_t, Wkv_t, SSQQ, SSQKV, ROPETAB, QMLA, KN, VM, F.G, (int)blockIdx.x);
        if (BOTH(3)) GRID_BAR();
    }

    for (int rep = 0; rep < ((PROBE_DUP == 4) ? 2 : 1); ++rep) if (IN(4)) { PHASE_ENV const bool dummy = (PROBE_DUP == 4) && rep == 0; (void)dummy;
        {
            const bool xq = (F.G % 8) == 0; const int x = xq ? (int)(blockIdx.x & 7) : 0, nunits = xq ? 128 : 1024;
            constexpr int F_O = 16 * 8, F_OUT = 16 * 16, F_SGU = 8 * 16, F_SD = 16 * 4, F_EGU = NEXP * F_SGU, F_ED = NEXP * F_SD;
            constexpr int NCONV = F_EGU + F_ED + 2 * F_O + F_OUT + F_SGU + F_SD, NCBATCH = (NCONV + 31) / 32;
            const int NQ = xq ? 8 : 1, ncb = (NCBATCH - x + NQ - 1) / NQ, A0 = xq ? CONV_A0 : 8 * CONV_A0;
            gu32* qh = ctl + CW_Q + 64 * x + (dummy ? 16 : 0);
            volatile LAS unsigned* qw = (volatile LAS unsigned*)(F.lds + MISC_OFF + 64);
            for (int nit = 0;; ++nit) {
                if (F.tid == 0) qw[nit & 1] = __hip_atomic_fetch_add(qh, 1u, RLX_AGENT);
                __syncthreads();
                int r = __builtin_amdgcn_readfirstlane((int)qw[nit & 1]);
                if (r >= nunits + ncb) break;
                if (r >= A0 && r < A0 + ncb) { const int cb = x + NQ * (r - A0);
                    LAS unsigned char* scr8 = F.lds + 32768 + F.wave * 9216;
                    int ln_ = F.lane; asm volatile("" : "+v"(ln_));
                    for (int kr = 0; kr < 4; ++kr) { int it = 32 * cb + 8 * kr + F.wave; if (it >= NCONV) break;
                        const float* src; unsigned char* dst; int ldw, kd8;
                        if (it < F_EGU) { const int e = it / F_SGU, rr = it % F_SGU, nb = rr & 7, kb = rr >> 3, pn = nb >> 2, c0 = (nb & 3) * 64;
                            src = ((c0 < 128) ? w_exp_gate : w_exp_up) + (size_t)e * D * DEXP + pn * 128 + (c0 & 127) + (size_t)(64 * kb) * DEXP; ldw = DEXP;
                            dst = Wgu8 + (size_t)e * 512 * D + (size_t)(64 * nb) * D + 64 * kb; kd8 = D; }
                        else if ((it -= F_EGU) < F_ED) { const int e = it / F_SD, rr = it % F_SD, nb = rr & 15, kb = rr >> 4;
                            src = w_exp_down + (size_t)e * DEXP * D + (size_t)(64 * kb) * D + 64 * nb; ldw = D; dst = (unsigned char*)Wd_t + (size_t)e * D * DEXP + (size_t)(64 * nb) * DEXP + 64 * kb; kd8 = DEXP; }
                        else if ((it -= F_ED) < 2 * F_O) { const int fx = it >= F_O, i2 = it - (fx ? F_O : 0), nb = i2 & 15, kb = i2 >> 4;
                            src = (fx ? w_o_fox : w_o_mla) + (size_t)(64 * kb) * D + 64 * nb; ldw = D; dst = (unsigned char*)Wom_t + (size_t)(64 * nb) * D + (fx ? 512 : 0) + 64 * kb; kd8 = D; }
                        else if ((it -= 2 * F_O) < F_OUT) { const int nb = it & 15, kb = it >> 4; src = w_out + (size_t)(64 * kb) * D + 64 * nb; ldw = D; dst = (unsigned char*)Wout_t + (size_t)(64 * nb) * D + 64 * kb; kd8 = D; }
                        else if ((it -= F_OUT) < F_SGU) { const int nb = it >> 4, kb = it & 15, pn = nb >> 2, c0 = (nb & 3) * 64;
                            src = ((c0 < 128) ? w_sh_gate : w_sh_up) + pn * 128 + (c0 & 127) + (size_t)(64 * kb) * DEXP; ldw = DEXP; dst = Wsgu8 + (size_t)(64 * nb) * D + 64 * kb; kd8 = D; }
                        else { it -= F_SGU; const int nb = it >> 2, kb = it & 3; src = w_sh_down + (size_t)(64 * kb) * D + 64 * nb; ldw = D; dst = (unsigned char*)Wsd_t + (size_t)(64 * nb) * DEXP + 64 * kb; kd8 = DEXP; }
                        cvt64_item8(src, ldw, dst, kd8, scr8, ln_, WSCALE8);
                    }
                    continue; }
                if (r >= A0) r -= ncb;
                int qb, type, b, h;
                if (xq) { qb = 15 - (r >> 3); type = (r >> 2) & 1; b = r & 3; h = (x + 3 * b) & 7; }
                else { qb = 15 - (r >> 6); type = (r >> 5) & 1; b = (r >> 3) & 3; h = r & 7; }
                if (type == 0) { if (ATT_TUNED_FOX && qb != 0) att::attn_unit_t<64, true, 8>(b, h, qb, FQ, 512, FK, KPE, FV, CUMF, __uint_as_float(__hip_atomic_load((unsigned*)(ctl + CW_KM + b * NHEAD + h), RLX_AGENT)) * __uint_as_float(__hip_atomic_load((unsigned*)(ctl + CW_KM + 32 + b * NHEAD + h), RLX_AGENT)), (bf16*)((unsigned char*)(dummy ? (bf16*)((unsigned char*)out + 4 * MiB) : OCAT) + 512), D, F.lds);
                                 else att::attn_unit<64, true, 8>(b, h, qb, FQ, 512, FK, KPE, FV, CUMF, (bf16*)((unsigned char*)(dummy ? (bf16*)((unsigned char*)out + 4 * MiB) : OCAT) + 512), D, F.lds); }
                else { if (ATT_TUNED_MLA && qb != 0) att::attn_unit_t<96, false, 8>(b, h, qb, QMLA, 768, KN, KPE, VM, nullptr, 0.f, dummy ? (bf16*)((unsigned char*)out + 4 * MiB) : OCAT, D, F.lds);
                       else att::attn_unit<96, false, 8>(b, h, qb, QMLA, 768, KN, KPE, VM, nullptr, dummy ? (bf16*)((unsigned char*)out + 4 * MiB) : OCAT, D, F.lds); }
            }
        }
        if (BOTH(4)) GRID_BAR();
    }

    for (int rep = 0; rep < ((PROBE_DUP == 5) ? 2 : 1); ++rep) if (IN(5)) { PHASE_ENV const bool dummy = (PROBE_DUP == 5) && rep == 0; (void)dummy;
        pg8::StaticOrder S; S.init(OCAT, Wom_t, T, D, D / 2, F.G, (int)blockIdx.x);
        EpiMergedCat E{GATES, (unsigned char*)MERGED, 1.f / WSCALE8};
        pg8::gemm_phase<EpiMergedCat, pg8::StaticOrder, true, true>(F.lds, S, E);
        if (BOTH(5)) GRID_BAR();
    }

    for (int rep = 0; rep < ((PROBE_DUP == 6) ? 2 : 1); ++rep) if (IN(6)) { PHASE_ENV const bool dummy = (PROBE_DUP == 6) && rep == 0; (void)dummy;
        pg8::StaticOrder S; S.init(MERGED, Wout_t, T, D, D / 2, F.G, (int)blockIdx.x);
        EpiOut E{X_IN, out, mod, SSQ1, 1.f / (OSCALE8 * WSCALE8)};
        pg8::gemm_phase<EpiOut, pg8::StaticOrder, true, true>(F.lds, S, E);
        if (BOTH(6)) GRID_BAR();
    }

    for (int rep = 0; rep < ((PROBE_DUP == 7) ? 2 : 1); ++rep) if (IN(7)) { PHASE_ENV const bool dummy = (PROBE_DUP == 7) && rep == 0; (void)dummy;
        LAS unsigned char* wrl = F.lds;
        LAS float* vg = (LAS float*)(F.lds + LDSCTL_OFF + 6144);
        LAS float* vs = (LAS float*)(F.lds + LDSCTL_OFF + 10240);
        LAS int* cntw = (LAS int*)(F.lds + 32768);
        LAS int* basel = (LAS int*)(F.lds + 32768 + 2048);
        static_assert(LDSCTL_OFF + 10240 + 4096 <= LDS_BYTES && MOETAB_OFF + 4700 <= LDSCTL_OFF + 6144, "P7 LDS map");
        const float my_bias = b_router[F.lane];
        for (int grp = F.vcu; grp < T / 64; grp += F.G) {
            const int b = (grp * 64) / SEQ;
            __syncthreads();
#pragma unroll
            for (int i = 0; i < 16; ++i) __builtin_amdgcn_global_load_lds((const unsigned*)((const char*)Wr_f + (F.wave * 16 + i) * 1024 + F.lane * 16), (LAS unsigned*)(wrl + (F.wave * 16 + i) * 1024), 16, 0, 0);
            for (int i = F.tid; i < D; i += NWAVES * 64) { vg[i] = g_ffn[i] * (1.f + mod[(size_t)b * 6 * D + 4 * D + i]); vs[i] = mod[(size_t)b * 6 * D + 3 * D + i]; }
            const int tp = grp * 64 + (F.wave & 3) * 16, kh = F.wave >> 2, t0 = tp + kh * 8;
            const int r16 = F.lane & 15, kg = F.lane >> 4, myrow = tp + r16;
            float rs_mine;
            { const float* sp = SSQ1 + (size_t)myrow * 16; const f32x4 a = *(const f32x4*)sp, b4 = *(const f32x4*)(sp + 4), c4 = *(const f32x4*)(sp + 8), d4 = *(const f32x4*)(sp + 12);
              const float ssum = (((a[0] + a[1]) + (a[2] + a[3])) + ((b4[0] + b4[1]) + (b4[2] + b4[3]))) + (((c4[0] + c4[1]) + (c4[2] + c4[3])) + ((d4[0] + d4[1]) + (d4[2] + d4[3])));
              rs_mine = rsqrtf(ssum * (1.f / D) + EPS); }
            const float* xrow = out + (size_t)myrow * D + 512 * kh + 8 * kg;
            f32x4 lacc[4] = {{0.f, 0.f, 0.f, 0.f}, {0.f, 0.f, 0.f, 0.f}, {0.f, 0.f, 0.f, 0.f}, {0.f, 0.f, 0.f, 0.f}};
            f32x4 xq[8][2];
#pragma unroll
            for (int p = 0; p < 8; ++p) { xq[p][0] = *(const f32x4*)(xrow + 32 * p); xq[p][1] = *(const f32x4*)(xrow + 32 * p + 4); }
            VM_WAIT(); __syncthreads();
#pragma unroll
            for (int p = 0; p < 16; ++p) { const int j = 16 * kh + p, k = 32 * j + 8 * kg;
                const f32x4 x0 = xq[p & 7][0], x1v = xq[p & 7][1];
                if (p + 8 < 16) { xq[p & 7][0] = *(const f32x4*)(xrow + 32 * (p + 8)); xq[p & 7][1] = *(const f32x4*)(xrow + 32 * (p + 8) + 4); }
                const f32x4 g0 = *(const LAS f32x4*)(vg + k), g1 = *(const LAS f32x4*)(vg + k + 4), s0 = *(const LAS f32x4*)(vs + k), s1 = *(const LAS f32x4*)(vs + k + 4);
                const f32x4 h0 = x0 * rs_mine * g0 + s0, h1 = x1v * rs_mine * g1 + s1;
                const u32x4 hw = pack8(h0, h1);
                f32x4 a0, a1; unpack8(hw, a0, a1);
                const u32x4 lw = pack8(h0 - a0, h1 - a1);
                { u32x2 h8; int p_ = __builtin_amdgcn_cvt_pk_fp8_f32(h0[0], h0[1], 0, false); p_ = __builtin_amdgcn_cvt_pk_fp8_f32(h0[2], h0[3], p_, true); h8.x = (unsigned)p_;
                    p_ = __builtin_amdgcn_cvt_pk_fp8_f32(h1[0], h1[1], 0, false); p_ = __builtin_amdgcn_cvt_pk_fp8_f32(h1[2], h1[3], p_, true); h8.y = (unsigned)p_;
                    *(u32x2*)(H8 + (size_t)myrow * D + k) = h8; }
                const bf16x8 Ah = __builtin_bit_cast(bf16x8, hw), Al = __builtin_bit_cast(bf16x8, lw);
#pragma unroll
                for (int ntl = 0; ntl < 4; ++ntl) { const bf16x8 Wf = *(const LAS bf16x8*)(wrl + ((j * 4 + ntl) * 64 + F.lane) * 16);
                    lacc[ntl] = __builtin_amdgcn_mfma_f32_16x16x32_bf16(Wf, Ah, lacc[ntl], 0, 0, 0);
                    lacc[ntl] = __builtin_amdgcn_mfma_f32_16x16x32_bf16(Wf, Al, lacc[ntl], 0, 0, 0); } }
            __syncthreads();
            {   LAS float* stw = (LAS float*)F.lds + (((F.wave & 3) * 2 + kh) * 16 + r16) * 64;
#pragma unroll
                for (int ntl = 0; ntl < 4; ++ntl) *(LAS f32x4*)(stw + 16 * ntl + 4 * kg) = lacc[ntl]; }
            __syncthreads();
            LAS float* stg = (LAS float*)F.lds + ((F.wave & 3) * 32 + kh * 8) * 64;
            int cnt = 0; unsigned selbits = 0u, selks = 0u;
            for (int j = 0; j < 8; ++j) {
                const float logit = stg[j * 64 + F.lane] + stg[(16 + j) * 64 + F.lane];
                const float sc = 1.f / (1.f + expf(-logit));
                const float ch = sc + my_bias;
                const float m1 = max8(ch);
                const unsigned long long eq = __ballot(ch == m1);
                const unsigned gm = (unsigned)(eq >> (F.lane & ~7)) & 0xffu;
                const int first = __builtin_ctz(gm);
                const float c2 = max8(((F.lane & 7) == first) ? -INFINITY : ch);
                const float gs = m1 + c2; const int myg = F.lane >> 3;
                int rank = 0;
#pragma unroll
                for (int g = 0; g < 8; ++g) { const float o = __builtin_bit_cast(float, __builtin_amdgcn_readlane(__builtin_bit_cast(int, gs), 8 * g)); rank += (o > gs || (o == gs && g < myg)) ? 1 : 0; }
                float mc = (rank < 4) ? ch : -1e30f;
                int selk = -1;
#pragma unroll
                for (int k = 0; k < TOPK; ++k) { const float mx = wave_max_f(mc); const unsigned long long bl = __ballot(mc == mx); const int fl = __builtin_ctzll(bl);
                    if (F.lane == fl) { selk = k; mc = -INFINITY; } }
                const float ssum = wave_sum_f(selk >= 0 ? sc : 0.f);
                if (selk >= 0) { const int t = t0 + j; EIDX[(size_t)t * 8 + selk] = (unsigned char)F.lane; GATEW[(size_t)t * 8 + selk] = sc / ssum * 2.5f; ++cnt; selbits |= 1u << j; selks |= (unsigned)selk << (3 * j); }
            }
            cntw[F.wave * 64 + F.lane] = cnt;
            __syncthreads();
            if (F.wave == 0) { int tot = 0;
#pragma unroll
                for (int w = 0; w < 8; ++w) tot += cntw[w * 64 + F.lane];
                basel[F.lane] = (int)__hip_atomic_fetch_add((unsigned*)(ctl + (dummy ? CW_CNT + 2048 : CW_CNT) + 16 * F.lane), (unsigned)tot, RLX_AGENT); }
            __syncthreads();
            int pos = basel[F.lane];
            for (int w = 0; w < F.wave; ++w) pos += cntw[w * 64 + F.lane];
#pragma unroll
            for (int j = 0; j < 8; ++j) if ((selbits >> j) & 1u) { const int k = (selks >> (3 * j)) & 7, t = t0 + j;
                LIST[(size_t)F.lane * LISTCAP + pos] = (unsigned short)t;
                META[(size_t)F.lane * LISTCAP + pos] = (u32x2){(unsigned)(t * (TOPK + 1) + k), __float_as_uint(GATEW[(size_t)t * 8 + k])}; ++pos; }
        }
        __syncthreads();
        if (BOTH(7)) GRID_BAR();
    }

    volatile LAS int* tab = (volatile LAS int*)(F.lds + MOETAB_OFF);
    if (IN(8) || IN(9)) {
        __syncthreads();
        if (F.wave == 0) {
            const int n = (int)__hip_atomic_load((unsigned*)(ctl + CW_CNT + 16 * F.lane), RLX_AGENT);
            const int tiles = (n + 255) >> 8; int incl = tiles;
#pragma unroll
            for (int o = 1; o < 64; o <<= 1) { const int v = __shfl_up(incl, o); if (F.lane >= o) incl += v; }
            tab[F.lane] = incl - tiles; tab[66 + F.lane] = n;
            if (F.lane == 63) { tab[64] = incl; tab[65] = incl + T / 256; tab[66 + 64] = T; }
        }
        __syncthreads();
        { const int ti = F.tid; int e = 0;
          for (int q = 0; q <= NEXP; ++q) if (tab[q] <= ti) e = q;
          tab[132 + ti] = e; }
        __syncthreads();
    }
    for (int rep = 0; rep < ((PROBE_DUP == 8) ? 2 : 1); ++rep) if (IN(8)) { PHASE_ENV const bool dummy = (PROBE_DUP == 8) && rep == 0; (void)dummy;
        MoeOrder<2, true> S{(const char*)H8, (const char*)Wgu8, (const char*)Wsgu8, D / 2, (size_t)512 * D, LIST, tab, F.G, (int)blockIdx.x};
        EpiHb E{(unsigned char*)HB, 1.f / WSCALE8};
        pg8::gemm_phase<EpiHb, MoeOrder<2, true>, true, true>(F.lds, S, E);
        if (BOTH(8)) GRID_BAR();
    }
    for (int rep = 0; rep < ((PROBE_DUP == 9) ? 2 : 1); ++rep) if (IN(9)) { PHASE_ENV const bool dummy = (PROBE_DUP == 9) && rep == 0; (void)dummy;
        if (dummy && PROBE_VAR == 1) dn::down_phase<true>(F.lds, (const unsigned char*)HB, (const unsigned char*)Wd_t, (const unsigned char*)Wsd_t, tab, META, (unsigned char*)Y, (unsigned char*)(ws + WS_CTL + 900 * 1024), F.G, (int)blockIdx.x);
        else dn::down_phase<false>(F.lds, (const unsigned char*)HB, (const unsigned char*)Wd_t, (const unsigned char*)Wsd_t, tab, META, (unsigned char*)Y, (unsigned char*)(ws + WS_CTL + 900 * 1024), F.G, (int)blockIdx.x);
        if (BOTH(9)) GRID_BAR();
    }

    for (int rep = 0; rep < ((PROBE_DUP == 10) ? 2 : 1); ++rep) if (IN(10)) { PHASE_ENV const bool dummy = (PROBE_DUP == 10) && rep == 0; (void)dummy;
        int ln10 = F.lane; asm volatile("" : "+v"(ln10));
        for (int m = gw; m < T; m += NGW) {
            const int b = m / SEQ; const float* gf = mod + (size_t)b * 6 * D + 5 * D;
            f32x4* xr = (f32x4*)(out + (size_t)m * D) + ln10;
            f32x4* xw = dummy ? (f32x4*)((float*)HB + (size_t)m * D) + ln10 : xr;
            f32x4 v[4]; float s = 0.f;
#pragma unroll
            for (int j = 0; j < 4; ++j) { const int c = 4 * ln10 + 256 * j;
                f32x4 y = {0.f, 0.f, 0.f, 0.f};
#pragma unroll
                for (int k = 0; k < TOPK + 1; ++k) { const int w = __builtin_nontemporal_load((const int*)((const unsigned char*)Y + ((size_t)m * (TOPK + 1) + k) * D + c));
                    const f32x2 lo = __builtin_amdgcn_cvt_pk_f32_fp8(w, false), hi2 = __builtin_amdgcn_cvt_pk_f32_fp8(w, true);
                    y += (f32x4){lo.x, lo.y, hi2.x, hi2.y}; }
                v[j] = __builtin_nontemporal_load(xr + 64 * j) + *(const f32x4*)(gf + c) * y;
                s += (v[j].x * v[j].x + v[j].y * v[j].y) + (v[j].z * v[j].z + v[j].w * v[j].w); }
            const float rstd = rsqrtf(wave_sum(s) * (1.f / D) + EPS);
#pragma unroll
            for (int j = 0; j < 4; ++j) __builtin_nontemporal_store(v[j] * rstd * *(const f32x4*)(g_final + 4 * ln10 + 256 * j), xw + 64 * j);
        }
    }
#undef IN
#undef BOTH
#undef GRID_BAR
}

constexpr int NPHASE = 11;
extern "C" void kernel_launch(void* const* d_in, const int* in_sizes, int n_in, void* d_out, int out_size, void* d_ws, size_t ws_size, hipStream_t stream) {
    static int grid = 0;
    if (grid == 0) {
        if (n_in != 25 || out_size != T * D || ws_size < WS_END) { fprintf(stderr, "kernel_launch: unexpected shapes (n_in %d out %d ws %zu need %zu)\n", n_in, out_size, ws_size, (size_t)WS_END); grid = -1; return; }
        int dev = 0, cus = 0;
        if (hipGetDevice(&dev) != hipSuccess || hipDeviceGetAttribute(&cus, hipDeviceAttributeMultiprocessorCount, dev) != hipSuccess) { grid = -1; return; }
        if (hipFuncSetAttribute((const void*)fwd, hipFuncAttributeMaxDynamicSharedMemorySize, LDS_BYTES) != hipSuccess) { fprintf(stderr, "kernel_launch: hipFuncSetAttribute failed\n"); grid = -1; return; }
        int per_cu = 0;
        if (hipOccupancyMaxActiveBlocksPerMultiprocessor(&per_cu, (const void*)fwd, NWAVES * 64, LDS_BYTES) != hipSuccess || per_cu < 1) { fprintf(stderr, "kernel_launch: occupancy query says %d\n", per_cu); }
        (void)hipGetLastError();
        grid = cus;
    }
    if (grid < 0) return;
    (void)in_sizes;
    if (hipMemsetAsync((char*)d_ws + WS_CTL, 0, CTL_ZERO_BYTES, stream) != hipSuccess) return;
    Args a{};
    for (int i = 0; i < 25; ++i) a.in[i] = d_in[i];
    a.out = (float*)d_out; a.ws = (unsigned char*)d_ws;
#if MK_ONE_LAUNCH
    a.ph_lo = 0; a.ph_hi = NPHASE;
    hipLaunchKernelGGL(fwd, dim3(grid), dim3(NWAVES * 64), LDS_BYTES, stream, a);
#else
    for (int p = 0; p < NPHASE; ++p) { a.ph_lo = p; a.ph_hi = p + 1; hipLaunchKernelGGL(fwd, dim3(grid), dim3(NWAVES * 64), LDS_BYTES, stream, a); }
#endif
}
```

```cpp
#include <hip/hip_runtime.h>
#include <cstdio>
#include <cstdint>
#include <type_traits>

#ifndef MK_ONE_LAUNCH
#ifndef CONV_A0
#define CONV_A0 28
#endif
#define MK_ONE_LAUNCH 1
#endif

#ifndef PROBE_DUP
#define PROBE_DUP -1
#endif
#ifndef ATT_TUNED_FOX
#define ATT_TUNED_FOX 1
#endif
#ifndef ATT_TUNED_MLA
#define ATT_TUNED_MLA 1
#endif
#ifndef PROBE_VAR
#define PROBE_VAR 0
#endif
#define GAS __attribute__((address_space(1)))
#define LAS __attribute__((address_space(3)))
typedef unsigned short bf16;
typedef short bf16x8 __attribute__((ext_vector_type(8)));
typedef short s16x4 __attribute__((ext_vector_type(4)));
typedef float f32x2 __attribute__((ext_vector_type(2)));
typedef float f32x4 __attribute__((ext_vector_type(4)));
typedef float f32x16 __attribute__((ext_vector_type(16)));
typedef unsigned u32x2 __attribute__((ext_vector_type(2)));
typedef unsigned u32x4 __attribute__((ext_vector_type(4)));
typedef GAS unsigned gu32;
typedef int v8i32_t __attribute__((ext_vector_type(8)));
typedef int v4i32_t __attribute__((ext_vector_type(4)));

constexpr int NB = 4, SEQ = 4096, T = NB * SEQ, D = 1024;
constexpr int NIN = 4096;
constexpr int QLORA = 256, KVLORA = 128, KVPAD = 256, ROPE = 32, NHEAD = 8, HD = 64, MQK = 96;
constexpr int NEXP = 64, TOPK = 6, DEXP = 256;
constexpr float EPS = 1e-6f;
constexpr float LOG2E = 1.4426950408889634f;
constexpr float C2F = 0.125f * LOG2E;
constexpr float C2M = 0.10206207261596577f * LOG2E;
constexpr int LISTCAP = T;
constexpr float HSCALE8 = 8.f;
constexpr float OSCALE8 = 8.f;
constexpr float WSCALE8 = 64.f;

constexpr size_t MiB = 1u << 20;
constexpr size_t WS_CTL = 0, CTL_ZERO_BYTES = 1 * MiB;
constexpr size_t WS_EIDX = 262144, WS_GATEW = 393216;
constexpr size_t WS_WIN = 1 * MiB, WS_WQ = 9 * MiB, WS_WKV = 9 * MiB + 512 * 1024, WS_WOM = 10 * MiB, WS_WOF = 11 * MiB, WS_WOUT = 12 * MiB;
constexpr size_t WS_WSGU = 14 * MiB, WS_WSD = 15 * MiB, WS_WR = 15 * MiB + 512 * 1024, WS_MOD = 15 * MiB + 640 * 1024;
constexpr size_t WS_WD = 16 * MiB;
constexpr size_t WS_HB = 48 * MiB;
constexpr size_t WS_FQ = 48 * MiB, WS_FK = 64 * MiB, WS_FV = 80 * MiB, WS_QLAT = 96 * MiB, WS_KVLAT = 104 * MiB;
constexpr size_t WS_OFOX = WS_FQ, WS_OMLA = WS_QLAT;
static_assert(WS_FK - WS_FQ == (size_t)T * 512 * 2 && WS_FV - WS_FK == (size_t)T * 512 * 2, "fq|fk|fv contiguous");
constexpr size_t WS_Y = 112 * MiB;
constexpr size_t WS_WGU = 112 * MiB;
constexpr size_t WS_H = 176 * MiB;
constexpr size_t WS_QMLA = WS_H;
constexpr size_t WS_GATES = 208 * MiB;
constexpr size_t WS_KN = 272 * MiB, WS_VM = 288 * MiB, WS_KPE = 304 * MiB;
constexpr size_t WS_MERGED = WS_KN;
constexpr size_t WS_LIST = 304 * MiB;
constexpr size_t WS_END = 306 * MiB;
constexpr size_t DO_MODP = 4 * MiB;
constexpr size_t DO_ROPE = 0, DO_LOGF = 2 * MiB, DO_CUMF = 2 * MiB + 512 * 1024, DO_SSQQ = 3 * MiB, DO_SSQKV = 3 * MiB + 256 * 1024;

constexpr int CW_TMO = 0;
constexpr int CW_BAR = 4096;
constexpr int CW_CNT = 8192;
constexpr int CW_KM = 12288;
constexpr int CW_Q = 12544;

constexpr int RING_BYTES = 131072;
constexpr int LDSCTL_OFF = RING_BYTES;
constexpr int MISC_OFF = LDSCTL_OFF + 320;
constexpr int MOETAB_OFF = LDSCTL_OFF + 1024;
constexpr int LDS_BYTES = 147456;

constexpr int NWAVES = 8;

#define LDS_WAIT() asm volatile("s_waitcnt lgkmcnt(0)" ::: "memory")
#define VM_WAIT() asm volatile("s_waitcnt vmcnt(0)" ::: "memory")
#define RLX_AGENT __ATOMIC_RELAXED, __HIP_MEMORY_SCOPE_AGENT
__device__ __forceinline__ unsigned f2bf(float f) { unsigned u = __builtin_bit_cast(unsigned, f); return (u + 0x7fffu + ((u >> 16) & 1u)) >> 16; }
__device__ __forceinline__ float bf2f(unsigned h) { return __builtin_bit_cast(float, h << 16); }
__device__ __forceinline__ unsigned pk2(float lo, float hi) { return f2bf(lo) | (f2bf(hi) << 16); }
__device__ __forceinline__ unsigned cvt_pk_bf16(float lo, float hi) { unsigned r; asm volatile("v_cvt_pk_bf16_f32 %0, %1, %2" : "=v"(r) : "v"(lo), "v"(hi)); return r; }
__device__ __forceinline__ u32x4 pack8(f32x4 a, f32x4 b) { u32x4 w; w.x = cvt_pk_bf16(a[0], a[1]); w.y = cvt_pk_bf16(a[2], a[3]); w.z = cvt_pk_bf16(b[0], b[1]); w.w = cvt_pk_bf16(b[2], b[3]); return w; }
__device__ __forceinline__ void unpack8(u32x4 w, f32x4& a, f32x4& b) {
    a = (f32x4){bf2f(w.x & 0xffffu), bf2f(w.x >> 16), bf2f(w.y & 0xffffu), bf2f(w.y >> 16)};
    b = (f32x4){bf2f(w.z & 0xffffu), bf2f(w.z >> 16), bf2f(w.w & 0xffffu), bf2f(w.w >> 16)};
}
__device__ __forceinline__ float wave_sum(float v) {
#pragma unroll
    for (int o = 1; o < 64; o <<= 1) v += __shfl_xor(v, o);
    return v;
}
__device__ __forceinline__ float wave_max(float v) {
#pragma unroll
    for (int o = 1; o < 64; o <<= 1) v = fmaxf(v, __shfl_xor(v, o));
    return v;
}
template <int CTRL> __device__ __forceinline__ float dppf(float v) { return __builtin_bit_cast(float, __builtin_amdgcn_update_dpp(0, __builtin_bit_cast(int, v), CTRL, 0xf, 0xf, true)); }
__device__ __forceinline__ float max8(float v) { v = fmaxf(v, dppf<0xB1>(v)); v = fmaxf(v, dppf<0x4E>(v)); v = fmaxf(v, dppf<0x141>(v)); return v; }
__device__ __forceinline__ float wave_max_f(float v) { v = max8(v); v = fmaxf(v, dppf<0x140>(v)); v = fmaxf(v, __shfl_xor(v, 16)); v = fmaxf(v, __shfl_xor(v, 32)); return v; }
__device__ __forceinline__ float wave_sum_f(float v) { v += dppf<0xB1>(v); v += dppf<0x4E>(v); v += dppf<0x141>(v); v += dppf<0x140>(v); v += __shfl_xor(v, 16); v += __shfl_xor(v, 32); return v; }
__device__ __forceinline__ float sigmoidf_(float x) { return __builtin_amdgcn_rcpf(1.f + __builtin_amdgcn_exp2f(-LOG2E * x)); }
__device__ __forceinline__ float siluf_(float x) { return x * __builtin_amdgcn_rcpf(1.f + __builtin_amdgcn_exp2f(-LOG2E * x)); }

namespace pg8 {
constexpr int BM = 256, BK = 64, HALF = 128, HTB = HALF * BK * 2, NXCD = 8, WGM = 8;
__host__ __device__ __forceinline__ int lds_byte(int r, int c) { const int st = (r >> 4) * 2 + (c >> 5), rr = r & 15, cc = c & 31, ob = rr * 64 + cc * 2; return st * 1024 + (ob ^ (((ob >> 9) & 1) << 5)); }
__host__ __device__ __forceinline__ void stage_rc(int b, int& R, int& C) { const int st = b / 1024, sb = b % 1024, swz = sb ^ (((sb >> 9) & 1) << 5); R = (st >> 1) * 16 + swz / 64; C = (st & 1) * 32 + (swz % 64) / 2; }
__host__ __device__ __forceinline__ int perm32(int rho) { const int n = rho >> 4, i = rho & 15; return 8 * (i >> 2) + 4 * n + (i & 3); }

struct Unit { int pm, pn, e, aux, n; };

struct StaticOrder {
    static constexpr bool GATHER = false;
    const char* A; const char* Bt; int K;
    int nM, nN, nwg, G, c;
    __device__ void init(const void* A_, const void* Bt_, int M, int N, int K_, int G_, int c_) { A = (const char*)A_; Bt = (const char*)Bt_; K = K_; nM = M / BM; nN = N / BM; nwg = nM * nN; G = G_; c = c_; }
    __device__ bool next(int i, Unit& u) const {
        const long L = (long)i * G + c; if (L >= nwg) return false;
        int wgid = (int)L; { const int q = nwg / NXCD, r = nwg % NXCD, xcd = wgid % NXCD, off = wgid / NXCD; wgid = (xcd < r ? xcd * (q + 1) : r * (q + 1) + (xcd - r) * q) + off; }
        const int nig = WGM * nN, gid = wgid / nig, fm = gid * WGM, gsz = (nM - fm) < WGM ? (nM - fm) : WGM;
        u.pm = fm + ((wgid % nig) % gsz); u.pn = (wgid % nig) / gsz; u.e = 0; u.aux = 0; u.n = BM; return true;
    }
    __device__ __forceinline__ const char* a_ptr(const Unit& u) const { return A + (size_t)u.pm * BM * K * 2; }
    __device__ __forceinline__ const char* b_ptr(const Unit& u) const { return Bt + (size_t)u.pn * BM * K * 2; }
    __device__ __forceinline__ unsigned a_row(const Unit&, int r) const { return (unsigned)r; }
};

template <class Epi, class Sched, bool ALIGN_EPI, bool FP8 = false>
__device__ __forceinline__ void gemm_phase(LAS unsigned char* lds, const Sched& S, const Epi& E) {
    int tid = threadIdx.x; asm volatile("" : "+v"(tid));
    const int wid = __builtin_amdgcn_readfirstlane(tid >> 6), lane = tid & 63, wr = wid >> 2, wc = wid & 3, fr = lane & 15, fq = lane >> 4;
    const int K = S.K, nt = K / BK;
    unsigned voffB[2], voffA[2];
#pragma unroll
    for (int i = 0; i < 2; ++i) { int R, C; stage_rc(tid * 16 + i * 8192, R, C); const int Rb = (R & ~31) + perm32(R & 31);
        voffA[i] = (unsigned)(R * K + C) * 2u; voffB[i] = (unsigned)(Rb * K + C) * 2u; }
    unsigned vA[2][2], vN[2][2];
    const size_t kstep = (size_t)(BK * 2);
    const size_t hstep = (size_t)HALF * K * 2;
    const unsigned ldsw = (unsigned)wid * 1024u;
    const int aoff = lds_byte(wr * 64 + fr, fq * 8), boff = lds_byte(wc * 32 + fr, fq * 8);
#define PG8_SA(b, h) (((b) * 2 + (h)) * HTB)
#define PG8_SB(b, h) ((4 + (b) * 2 + (h)) * HTB)
#define PG8_STAGE(bufoff, gbase, voff) do { _Pragma("unroll") for (int _i = 0; _i < 2; ++_i) \
        __builtin_amdgcn_global_load_lds((const unsigned*)((const char*)(gbase) + (voff)[_i]), (LAS unsigned*)(lds + (bufoff) + ldsw + _i * 8192), 16, 0, 0); } while (0)
#define PG8_STAGE_A(bufoff, gbase, h, nx) do { if constexpr (Sched::GATHER) { const unsigned vs_[2] = {(nx) ? vN[h][0] : vA[h][0], (nx) ? vN[h][1] : vA[h][1]}; PG8_STAGE(bufoff, gbase, vs_); }     \
        else PG8_STAGE(bufoff, (const char*)(gbase) + (h) * hstep, voffA); } while (0)
#define PG8_LDA(dst, b, h) do { _Pragma("unroll") for (int m = 0; m < 4; ++m) { if constexpr (FP8) { dst##8[m].lo = *(const LAS v4i32_t*)(lds + PG8_SA(b, h) + aoff + m * 2048); dst##8[m].hi = *(const LAS v4i32_t*)(lds + PG8_SA(b, h) + aoff + m * 2048 + 1024); } \
        else { _Pragma("unroll") for (int k = 0; k < 2; ++k) dst[m][k] = *(const LAS bf16x8*)(lds + PG8_SA(b, h) + aoff + m * 2048 + k * 1024); } } } while (0)
#define PG8_LDB(dst, b, h) do { _Pragma("unroll") for (int n = 0; n < 2; ++n) { if constexpr (FP8) { dst##8[n].lo = *(const LAS v4i32_t*)(lds + PG8_SB(b, h) + boff + n * 2048); dst##8[n].hi = *(const LAS v4i32_t*)(lds + PG8_SB(b, h) + boff + n * 2048 + 1024); } \
        else { _Pragma("unroll") for (int k = 0; k < 2; ++k) dst[n][k] = *(const LAS bf16x8*)(lds + PG8_SB(b, h) + boff + n * 2048 + k * 1024); } } } while (0)
#define PG8_MMA(ai, bj, At, Bt) do { __builtin_amdgcn_s_setprio(1); _Pragma("unroll") for (int m = 0; m < 4; ++m) _Pragma("unroll") for (int n = 0; n < 2; ++n) { \
        if constexpr (FP8) asm volatile("v_mfma_scale_f32_16x16x128_f8f6f4 %0, %1, %2, %0, %3, %3 op_sel_hi:[0,0,0]" : "+v"(acc[ai][bj][m][n]) : "v"(Bt##8[n]), "v"(At##8[m]), "v"(sc1_));     \
        else { _Pragma("unroll") for (int k = 0; k < 2; ++k) acc[ai][bj][m][n] = __builtin_amdgcn_mfma_f32_16x16x32_bf16(Bt[n][k], At[m][k], acc[ai][bj][m][n], 0, 0, 0); } } \
        __builtin_amdgcn_s_setprio(0); } while (0)
#define PG8_WAIT_V(n) asm volatile("s_waitcnt vmcnt(" #n ")" ::: "memory")
#define PG8_WAIT_L(n) asm volatile("s_waitcnt lgkmcnt(" #n ")" ::: "memory")
#define PG8_BAR __builtin_amdgcn_s_barrier()
#define PG8_SCHED __builtin_amdgcn_sched_barrier(0)
#define PG8_SETV(dst, u) do { _Pragma("unroll") for (int _h = 0; _h < 2; ++_h) _Pragma("unroll") for (int _i = 0; _i < 2; ++_i) { int R_, C_; stage_rc(tid * 16 + _i * 8192, R_, C_); \
        dst[_h][_i] = (S.a_row(u, _h * HALF + R_) * (unsigned)K + (unsigned)C_) * 2u; } } while (0)
    Unit cur, nxt; int ui = 0;
    if (!S.next(0, cur)) return;
    f32x4 acc[2][2][4][2];
#define PG8_ZERO() do { _Pragma("unroll") for (int a = 0; a < 2; ++a) _Pragma("unroll") for (int b = 0; b < 2; ++b) _Pragma("unroll") for (int m = 0; m < 4; ++m) _Pragma("unroll") for (int n = 0; n < 2; ++n) { \
        if constexpr (FP8) asm volatile("v_mov_b32 %0, 0\n\tv_mov_b32 %1, 0\n\tv_mov_b32 %2, 0\n\tv_mov_b32 %3, 0" : "=v"(acc[a][b][m][n][0]), "=v"(acc[a][b][m][n][1]), "=v"(acc[a][b][m][n][2]), "=v"(acc[a][b][m][n][3])); \
        else acc[a][b][m][n] = (f32x4){0.f, 0.f, 0.f, 0.f}; } } while (0)
    PG8_ZERO();
    unsigned sc1_ = 0x7f7f7f7fu; asm volatile("" : "+v"(sc1_));
    (void)sc1_;
    bf16x8 At[4][2], B0[2][2], B1[2][2];
    v8i32_t At8[4], B08[2], B18[2];
    (void)At; (void)B0; (void)B1; (void)At8; (void)B08; (void)B18;
    const char* cA = S.a_ptr(cur); const char* cB = S.b_ptr(cur);
    if constexpr (Sched::GATHER) { PG8_SETV(vA, cur); }
    PG8_STAGE(PG8_SB(0, 0), cB, voffB); PG8_STAGE(PG8_SB(0, 1), cB + hstep, voffB); PG8_STAGE_A(PG8_SA(0, 0), cA, 0, false); PG8_STAGE_A(PG8_SA(0, 1), cA, 1, false);
    if (wr == 1) PG8_BAR;
    PG8_WAIT_V(2); PG8_BAR;
    PG8_STAGE(PG8_SB(1, 0), cB + kstep, voffB); PG8_STAGE_A(PG8_SA(1, 0), cA + kstep, 0, false); PG8_STAGE(PG8_SB(1, 1), cB + hstep + kstep, voffB);
    PG8_WAIT_V(6); PG8_BAR;
    for (;;) {
        const bool has_next = S.next(ui + 1, nxt);
        const char* nA = has_next ? S.a_ptr(nxt) : cA; const char* nB = has_next ? S.b_ptr(nxt) : cB;
        if constexpr (Sched::GATHER) { if (has_next) { PG8_SETV(vN, nxt); } else {
#pragma unroll
            for (int h = 0; h < 2; ++h)
#pragma unroll
                for (int i = 0; i < 2; ++i) vN[h][i] = vA[h][i]; } }
        for (int t = 0; t < nt; t += 2) {
            const bool last = (t == nt - 2);
            if constexpr (Epi::MIDK) { if (t == nt / 2) E.mid(acc, cur, wr, wc, fr, fq); }
            const char* a1 = cA + (size_t)(t + 1) * kstep;
            const char* a2 = last ? nA : cA + (size_t)(t + 2) * kstep; const char* b2 = last ? nB : cB + (size_t)(t + 2) * kstep;
            const char* a3 = a2 + kstep; const char* b3 = b2 + kstep;
            PG8_LDB(B0, 0, 0); PG8_LDB(B1, 0, 1); PG8_SCHED; PG8_LDA(At, 0, 0); PG8_STAGE_A(PG8_SA(1, 1), a1, 1, false);
            PG8_WAIT_V(8); PG8_WAIT_L(0); PG8_BAR; PG8_MMA(0, 0, At, B0); PG8_MMA(0, 1, At, B1); PG8_BAR; PG8_SCHED;
            PG8_LDA(At, 0, 1); PG8_STAGE(PG8_SB(0, 0), b2, voffB); PG8_STAGE(PG8_SB(0, 1), b2 + hstep, voffB); PG8_STAGE_A(PG8_SA(0, 0), a2, 0, last);
            PG8_WAIT_V(8); PG8_WAIT_L(0); PG8_BAR; PG8_MMA(1, 0, At, B0); PG8_MMA(1, 1, At, B1); PG8_BAR; PG8_SCHED;
            PG8_LDB(B0, 1, 0); PG8_LDB(B1, 1, 1); PG8_SCHED; PG8_LDA(At, 1, 0); PG8_STAGE_A(PG8_SA(0, 1), a2, 1, last);
            PG8_WAIT_V(8); PG8_WAIT_L(0); PG8_BAR; PG8_MMA(0, 0, At, B0); PG8_MMA(0, 1, At, B1); PG8_BAR; PG8_SCHED;
            PG8_LDA(At, 1, 1); PG8_STAGE(PG8_SB(1, 0), b3, voffB); PG8_STAGE(PG8_SB(1, 1), b3 + hstep, voffB); PG8_STAGE_A(PG8_SA(1, 0), a3, 0, last);
            PG8_WAIT_V(8); PG8_WAIT_L(0); PG8_BAR; PG8_MMA(1, 0, At, B0); PG8_MMA(1, 1, At, B1); PG8_BAR; PG8_SCHED;
        }
        if constexpr (ALIGN_EPI) { if (wr == 0) PG8_BAR; }
        if constexpr (FP8) { asm volatile("s_nop 15\n\ts_nop 7" ::: "memory"); __builtin_amdgcn_sched_barrier(0); }
        E(acc, cur, wr, wc, fr, fq);
        if (!has_next) break;
        PG8_ZERO();
        cur = nxt; cA = nA; cB = nB; ++ui;
        if constexpr (Sched::GATHER) {
#pragma unroll
            for (int h = 0; h < 2; ++h)
#pragma unroll
                for (int i = 0; i < 2; ++i) vA[h][i] = vN[h][i]; }
        if constexpr (ALIGN_EPI) { if (wr == 1) PG8_BAR; }
    }
    PG8_WAIT_V(0);
    if constexpr (!ALIGN_EPI) { if (wr == 0) PG8_BAR; }
    PG8_BAR;
#undef PG8_SA
#undef PG8_SB
#undef PG8_STAGE
#undef PG8_STAGE_A
#undef PG8_LDA
#undef PG8_LDB
#undef PG8_MMA
#undef PG8_ZERO
#undef PG8_WAIT_V
#undef PG8_WAIT_L
#undef PG8_BAR
#undef PG8_SCHED
#undef PG8_SETV
}
}
using pg8::Unit;

#define EPI_ROWS(ai, m) for (int ai = 0; ai < 2; ++ai) for (int m = 0; m < 4; ++m)

struct EpiInProj {
    static constexpr bool MIDK = false;
    bf16 *qlat, *kvlat, *kpe, *fq, *gates; float *logf, *ssqq, *ssqkv; const float* ropetab; const float* bforget; bool skip; int rowmul;
    __device__ __forceinline__ void operator()(const f32x4 (&acc)[2][2][4][2], const Unit& u, int wr, int wc, int fr, int fq_) const {
        if (skip) return;
        const int pn = u.pn, row0 = u.pm * 256 + wr * 64 + fr, c0 = wc * 32 + 8 * fq_;
        if (pn >= 8) {
            bf16* gp = gates + (size_t)(pn - 8) * 256 + c0;
#pragma unroll
            for (int ai = 0; ai < 2; ++ai)
#pragma unroll
                for (int m = 0; m < 4; ++m) { const int row = row0 + ai * 128 + m * 16;
#pragma unroll
                    for (int bj = 0; bj < 2; ++bj) { f32x4 v0 = acc[ai][bj][m][0], v1 = acc[ai][bj][m][1];
#pragma unroll
                        for (int q = 0; q < 4; ++q) { v0[q] = fmaxf(sigmoidf_(v0[q]), 1e-30f); v1[q] = fmaxf(sigmoidf_(v1[q]), 1e-30f); }
                        *(u32x4*)(gp + (size_t)row * 2048 + 128 * bj) = pack8(v0, v1); } }
        } else if (pn >= 2) {
            bf16* dst = fq + (size_t)((pn - 2) >> 1) * ((size_t)T * 512) + (pn & 1) * 256 + c0; const float sc = (pn < 4) ? C2F : 1.f;
#pragma unroll
            for (int ai = 0; ai < 2; ++ai)
#pragma unroll
                for (int m = 0; m < 4; ++m) { const int row = row0 + ai * 128 + m * 16;
#pragma unroll
                    for (int bj = 0; bj < 2; ++bj) *(u32x4*)(dst + (size_t)row * 512 + 128 * bj) = pack8(acc[ai][bj][m][0] * sc, acc[ai][bj][m][1] * sc); }
        } else if (pn == 0) {
#pragma unroll
            for (int ai = 0; ai < 2; ++ai)
#pragma unroll
                for (int m = 0; m < 4; ++m) { const int row = row0 + ai * 128 + m * 16; float s = 0.f;
#pragma unroll
                    for (int bj = 0; bj < 2; ++bj) { const f32x4 v0 = acc[ai][bj][m][0], v1 = acc[ai][bj][m][1];
                        s += (v0[0] * v0[0] + v0[1] * v0[1]) + (v0[2] * v0[2] + v0[3] * v0[3]) + (v1[0] * v1[0] + v1[1] * v1[1]) + (v1[2] * v1[2] + v1[3] * v1[3]);
                        *(u32x4*)(qlat + (size_t)row * QLORA + c0 + 128 * bj) = pack8(v0, v1); }
                    s += __shfl_xor(s, 16); s += __shfl_xor(s, 32);
                    if (fq_ == 0) ssqq[row * 4 + wc] = s; }
        } else {
#pragma unroll
            for (int ai = 0; ai < 2; ++ai)
#pragma unroll
                for (int m = 0; m < 4; ++m) { const int row = row0 + ai * 128 + m * 16;
                    { const f32x4 v0 = acc[ai][0][m][0], v1 = acc[ai][0][m][1];
                      float s = (v0[0] * v0[0] + v0[1] * v0[1]) + (v0[2] * v0[2] + v0[3] * v0[3]) + (v1[0] * v1[0] + v1[1] * v1[1]) + (v1[2] * v1[2] + v1[3] * v1[3]);
                      *(u32x4*)(kvlat + (size_t)row * KVPAD + c0) = pack8(v0, v1);
                      s += __shfl_xor(s, 16); s += __shfl_xor(s, 32);
                      if (fq_ == 0) ssqkv[row * 4 + wc] = s; }
                    { const f32x4 v0 = acc[ai][1][m][0], v1 = acc[ai][1][m][1];
                      *(u32x4*)(kvlat + (size_t)row * KVPAD + 128 + c0) = (u32x4){0u, 0u, 0u, 0u};
                      if (wc == 0) {
                          const f32x4* tb = (const f32x4*)(ropetab + ((size_t)row * 16 + 4 * fq_) * 2);
                          const f32x4 t0 = tb[0], t1 = tb[1];
                          f32x4 o1, o2;
                          o1[0] = v0[0] * t0[0] - v1[0] * t0[1]; o2[0] = v1[0] * t0[0] + v0[0] * t0[1];
                          o1[1] = v0[1] * t0[2] - v1[1] * t0[3]; o2[1] = v1[1] * t0[2] + v0[1] * t0[3];
                          o1[2] = v0[2] * t1[0] - v1[2] * t1[1]; o2[2] = v1[2] * t1[0] + v0[2] * t1[1];
                          o1[3] = v0[3] * t1[2] - v1[3] * t1[3]; o2[3] = v1[3] * t1[2] + v0[3] * t1[3];
                          *(u32x4*)(kpe + (size_t)row * ROPE + 8 * fq_) = pack8(o1, o2);
                      } else if (wc == 1 && fq_ == 0) {
                          f32x4 l0, l1;
#pragma unroll
                          for (int h = 0; h < 4; ++h) { const float z0 = v0[h] + bforget[h], z1 = v1[h] + bforget[4 + h];
                              l0[h] = -__builtin_amdgcn_logf(1.f + __builtin_amdgcn_exp2f(-LOG2E * z0)); l1[h] = -__builtin_amdgcn_logf(1.f + __builtin_amdgcn_exp2f(-LOG2E * z1)); }
                          *(f32x4*)(logf + (size_t)row * 8) = l0; *(f32x4*)(logf + (size_t)row * 8 + 4) = l1;
                      } } }
        }
        (void)rowmul;
    }
};

struct EpiQup {
    static constexpr bool MIDK = false;
    bf16* q; const float* ssqq; const float* ropetab;
    __device__ __forceinline__ void operator()(const f32x4 (&acc)[2][2][4][2], const Unit& u, int wr, int wc, int fr, int fq_) const {
        const int row0 = u.pm * 256 + wr * 64 + fr, c0 = u.pn * 256 + wc * 32 + 8 * fq_;
#pragma unroll
        for (int ai = 0; ai < 2; ++ai)
#pragma unroll
            for (int m = 0; m < 4; ++m) {
                const int row = row0 + ai * 128 + m * 16;
                const f32x4 sq = *(const f32x4*)(ssqq + row * 4);
                const float rs = rsqrtf(((sq[0] + sq[1]) + (sq[2] + sq[3])) * (1.f / QLORA) + EPS) * C2M;
#pragma unroll
                for (int bj = 0; bj < 2; ++bj) {
                    const int col = c0 + 128 * bj, j = col % MQK;
                    f32x4 v0 = acc[ai][bj][m][0] * rs, v1 = acc[ai][bj][m][1] * rs;
                    if (j >= 64) { const int g = (j - 64) >> 3;
                        const f32x4* tb = (const f32x4*)(ropetab + ((size_t)row * 16 + 4 * g) * 2);
                        const f32x4 t0 = tb[0], t1 = tb[1];
                        f32x4 o1, o2;
                        o1[0] = v0[0] * t0[0] - v1[0] * t0[1]; o2[0] = v1[0] * t0[0] + v0[0] * t0[1];
                        o1[1] = v0[1] * t0[2] - v1[1] * t0[3]; o2[1] = v1[1] * t0[2] + v0[1] * t0[3];
                        o1[2] = v0[2] * t1[0] - v1[2] * t1[1]; o2[2] = v1[2] * t1[0] + v0[2] * t1[1];
                        o1[3] = v0[3] * t1[2] - v1[3] * t1[3]; o2[3] = v1[3] * t1[2] + v0[3] * t1[3];
                        v0 = o1; v1 = o2; }
                    *(u32x4*)(q + (size_t)row * 768 + col) = pack8(v0, v1);
                }
            }
    }
};

struct EpiKVup {
    static constexpr bool MIDK = false;
    bf16 *kn, *vm; const float* ssqkv;
    __device__ __forceinline__ void operator()(const f32x4 (&acc)[2][2][4][2], const Unit& u, int wr, int wc, int fr, int fq_) const {
        const int row0 = u.pm * 256 + wr * 64 + fr, c0 = u.pn * 256 + wc * 32 + 8 * fq_;
        bf16* dst = (u.pn < 2) ? kn : vm; const int cb = (u.pn & 1) * 256 + wc * 32 + 8 * fq_;
        (void)c0;
#pragma unroll
        for (int ai = 0; ai < 2; ++ai)
#pragma unroll
            for (int m = 0; m < 4; ++m) {
                const int row = row0 + ai * 128 + m * 16;
                const f32x4 sq = *(const f32x4*)(ssqkv + row * 4);
                const float rs = rsqrtf(((sq[0] + sq[1]) + (sq[2] + sq[3])) * (1.f / KVLORA) + EPS);
#pragma unroll
                for (int bj = 0; bj < 2; ++bj) *(u32x4*)(dst + (size_t)row * 512 + cb + 128 * bj) = pack8(acc[ai][bj][m][0] * rs, acc[ai][bj][m][1] * rs);
            }
    }
};

struct EpiPartA {
    static constexpr bool MIDK = false;
    float* part; const bf16* gates;
    __device__ __forceinline__ void operator()(const f32x4 (&acc)[2][2][4][2], const Unit& u, int wr, int wc, int fr, int fq_) const {
        const int row0 = u.pm * 256 + wr * 64 + fr, c0 = u.pn * 256 + wc * 32 + 8 * fq_;
#pragma unroll
        for (int ai = 0; ai < 2; ++ai)
#pragma unroll
            for (int m = 0; m < 4; ++m) {
                const int row = row0 + ai * 128 + m * 16;
#pragma unroll
                for (int bj = 0; bj < 2; ++bj) { const int col = c0 + 128 * bj;
                    f32x4 g0, g1; unpack8(*(const u32x4*)(gates + (size_t)row * 2048 + col), g0, g1);
                    *(f32x4*)(part + (size_t)row * D + col) = g0 * acc[ai][bj][m][0]; *(f32x4*)(part + (size_t)row * D + col + 4) = g1 * acc[ai][bj][m][1]; }
            }
    }
};
struct EpiMerged {
    static constexpr bool MIDK = false;
    const float* part; const bf16* gates; bf16* merged;
    __device__ __forceinline__ void operator()(const f32x4 (&acc)[2][2][4][2], const Unit& u, int wr, int wc, int fr, int fq_) const {
        const int row0 = u.pm * 256 + wr * 64 + fr, c0 = u.pn * 256 + wc * 32 + 8 * fq_;
#pragma unroll
        for (int ai = 0; ai < 2; ++ai)
#pragma unroll
            for (int m = 0; m < 4; ++m) {
                const int row = row0 + ai * 128 + m * 16;
#pragma unroll
                for (int bj = 0; bj < 2; ++bj) { const int col = c0 + 128 * bj;
                    f32x4 g0, g1; unpack8(*(const u32x4*)(gates + (size_t)row * 2048 + 1024 + col), g0, g1);
                    const f32x4 p0 = *(const f32x4*)(part + (size_t)row * D + col), p1 = *(const f32x4*)(part + (size_t)row * D + col + 4);
                    *(u32x4*)(merged + (size_t)row * D + col) = pack8(p0 + g0 * acc[ai][bj][m][0], p1 + g1 * acc[ai][bj][m][1]); }
            }
    }
};
struct EpiMergedCat {
    static constexpr bool MIDK = true;
    const bf16* gates; unsigned char* merged; float sc;
    __device__ __forceinline__ void mid(f32x4 (&acc)[2][2][4][2], const Unit& u, int wr, int wc, int fr, int fq_) const {
        int row0 = u.pm * 256 + wr * 64 + fr, c0 = u.pn * 256 + wc * 32 + 8 * fq_;
        asm volatile("" : "+v"(row0), "+v"(c0));
#pragma unroll
        for (int ai = 0; ai < 2; ++ai)
#pragma unroll
            for (int m = 0; m < 4; ++m) { const int row = row0 + ai * 128 + m * 16;
#pragma unroll
                for (int bj = 0; bj < 2; ++bj) { const int col = c0 + 128 * bj;
                    f32x4 a0, a1, b0, b1; unpack8(*(const u32x4*)(gates + (size_t)row * 2048 + col), a0, a1); unpack8(*(const u32x4*)(gates + (size_t)row * 2048 + 1024 + col), b0, b1);
#pragma unroll
                    for (int q = 0; q < 4; ++q) { acc[ai][bj][m][0][q] *= a0[q] * __builtin_amdgcn_rcpf(b0[q]); acc[ai][bj][m][1][q] *= a1[q] * __builtin_amdgcn_rcpf(b1[q]); } }
                asm volatile("" ::: "memory"); }
    }
    __device__ __forceinline__ void operator()(const f32x4 (&acc)[2][2][4][2], const Unit& u, int wr, int wc, int fr, int fq_) const {
        const int row0 = u.pm * 256 + wr * 64 + fr, c0 = u.pn * 256 + wc * 32 + 8 * fq_;
#pragma unroll
        for (int ai = 0; ai < 2; ++ai)
#pragma unroll
            for (int m = 0; m < 4; ++m) { const int row = row0 + ai * 128 + m * 16;
#pragma unroll
                for (int bj = 0; bj < 2; ++bj) { const int col = c0 + 128 * bj;
                    f32x4 b0, b1; unpack8(*(const u32x4*)(gates + (size_t)row * 2048 + 1024 + col), b0, b1);
                    const f32x4 v0 = b0 * acc[ai][bj][m][0] * sc, v1 = b1 * acc[ai][bj][m][1] * sc;
                    u32x2 o; int p_ = __builtin_amdgcn_cvt_pk_fp8_f32(v0[0], v0[1], 0, false); p_ = __builtin_amdgcn_cvt_pk_fp8_f32(v0[2], v0[3], p_, true); o.x = (unsigned)p_;
                    p_ = __builtin_amdgcn_cvt_pk_fp8_f32(v1[0], v1[1], 0, false); p_ = __builtin_amdgcn_cvt_pk_fp8_f32(v1[2], v1[3], p_, true); o.y = (unsigned)p_;
                    *(u32x2*)(merged + (size_t)row * D + col) = o; } }
    }
};
struct EpiOut {
    static constexpr bool MIDK = false;
    const float* x; float* x1; const float* mod; float* ssq1; float sc;
    __device__ __forceinline__ void operator()(const f32x4 (&acc)[2][2][4][2], const Unit& u, int wr, int wc, int fr, int fq_) const {
        const int row0 = u.pm * 256 + wr * 64 + fr, c0 = u.pn * 256 + wc * 32 + 8 * fq_;
        const float* gm = mod + (size_t)((u.pm * 256) / SEQ) * 6 * D + 2 * D;
        f32x4 g[2][2];
#pragma unroll
        for (int bj = 0; bj < 2; ++bj) { g[bj][0] = *(const f32x4*)(gm + c0 + 128 * bj) * sc; g[bj][1] = *(const f32x4*)(gm + c0 + 128 * bj + 4) * sc; }
#pragma unroll
        for (int ai = 0; ai < 2; ++ai)
#pragma unroll
            for (int m = 0; m < 4; ++m) { const int row = row0 + ai * 128 + m * 16; float sq = 0.f;
#pragma unroll
                for (int bj = 0; bj < 2; ++bj) { const int col = c0 + 128 * bj;
                    const f32x4 x0 = __builtin_nontemporal_load((const f32x4*)(x + (size_t)row * D + col)), x1v = __builtin_nontemporal_load((const f32x4*)(x + (size_t)row * D + col + 4));
                    const f32x4 r0 = x0 + g[bj][0] * acc[ai][bj][m][0], r1 = x1v + g[bj][1] * acc[ai][bj][m][1];
                    *(f32x4*)(x1 + (size_t)row * D + col) = r0; *(f32x4*)(x1 + (size_t)row * D + col + 4) = r1;
                    sq += (r0[0] * r0[0] + r0[1] * r0[1]) + (r0[2] * r0[2] + r0[3] * r0[3]) + (r1[0] * r1[0] + r1[1] * r1[1]) + (r1[2] * r1[2] + r1[3] * r1[3]); }
                sq += __shfl_xor(sq, 16); sq += __shfl_xor(sq, 32);
                if (fq_ == 0) ssq1[(size_t)row * 16 + 4 * u.pn + wc] = sq; }
    }
};
struct EpiHb {
    static constexpr bool MIDK = false;
    unsigned char* hb; float sc;
    __device__ __forceinline__ void operator()(const f32x4 (&acc)[2][2][4][2], const Unit& u, int wr, int wc, int fr, int fq_) const {
        const int row0 = u.pm * 256 + wr * 64 + fr, c0 = u.pn * 128 + wc * 32 + 8 * fq_;
#pragma unroll
        for (int ai = 0; ai < 2; ++ai)
#pragma unroll
            for (int m = 0; m < 4; ++m) { const int row = row0 + ai * 128 + m * 16;
                f32x4 h0, h1;
#pragma unroll
                for (int q = 0; q < 4; ++q) { h0[q] = siluf_(acc[ai][0][m][0][q] * sc) * (acc[ai][1][m][0][q] * (sc * HSCALE8)); h1[q] = siluf_(acc[ai][0][m][1][q] * sc) * (acc[ai][1][m][1][q] * (sc * HSCALE8)); }
                u32x2 o; int p_ = __builtin_amdgcn_cvt_pk_fp8_f32(h0[0], h0[1], 0, false); p_ = __builtin_amdgcn_cvt_pk_fp8_f32(h0[2], h0[3], p_, true); o.x = (unsigned)p_;
                p_ = __builtin_amdgcn_cvt_pk_fp8_f32(h1[0], h1[1], 0, false); p_ = __builtin_amdgcn_cvt_pk_fp8_f32(h1[2], h1[3], p_, true); o.y = (unsigned)p_;
                *(u32x2*)(hb + (size_t)row * DEXP + c0) = o; }
    }
};
struct EpiDown {
    static constexpr bool MIDK = false;
    bf16* Y; float* out; float* outw; const float* mod; const unsigned short* list; const unsigned char* eidx; const float* gatew;
    __device__ __forceinline__ void operator()(const f32x4 (&acc)[2][2][4][2], const Unit& u, int wr, int wc, int fr, int fq_) const {
        const int c0 = u.pn * 256 + wc * 32 + 8 * fq_;
#pragma unroll
        for (int ai = 0; ai < 2; ++ai)
#pragma unroll
            for (int m = 0; m < 4; ++m) {
                const int rl = wr * 64 + fr + ai * 128 + m * 16, idx = u.aux * 256 + rl;
                if (u.e == NEXP) {
                    const int t = idx; const float* gf = mod + (size_t)(t / SEQ) * 6 * D + 5 * D;
#pragma unroll
                    for (int bj = 0; bj < 2; ++bj) { const int col = c0 + 128 * bj; const float* o = out + (size_t)t * D + col; float* ow = outw + (size_t)t * D + col;
                        const f32x4 g0 = *(const f32x4*)(gf + col), g1 = *(const f32x4*)(gf + col + 4);
                        const f32x4 x0 = *(const f32x4*)o, x1v = *(const f32x4*)(o + 4);
                        *(f32x4*)ow = x0 + g0 * acc[ai][bj][m][0]; *(f32x4*)(ow + 4) = x1v + g1 * acc[ai][bj][m][1]; }
                } else if (idx < u.n) {
                    const int t = list[(size_t)u.e * LISTCAP + idx];
                    const u32x2 ev = *(const u32x2*)(eidx + (size_t)t * 8);
                    int k = 0;
#pragma unroll
                    for (int q = 1; q < TOPK; ++q) { const unsigned b = (q < 4) ? ((ev.x >> (8 * q)) & 0xffu) : ((ev.y >> (8 * (q - 4))) & 0xffu); if ((int)b == u.e) k = q; }
                    const float w = gatew[(size_t)t * 8 + k];
#pragma unroll
                    for (int bj = 0; bj < 2; ++bj) *(u32x4*)(Y + ((size_t)t * TOPK + k) * D + c0 + 128 * bj) = pack8(acc[ai][bj][m][0] * w, acc[ai][bj][m][1] * w);
                }
            }
    }
};

template <int NT, bool GATHER_>
struct MoeOrder {
    static constexpr bool GATHER = GATHER_;
    const char* A; const char* Bt; const char* Bsh; int K; size_t bstride;
    const unsigned short* list; volatile LAS int* tab;
    int G, c;
    __device__ bool next(int i, Unit& u) const {
        int ti, pn_;
        if ((G & 7) == 0) { const int x = c & 7, j = i * (G >> 3) + (c >> 3); ti = (j / NT) * 8 + x; pn_ = j % NT; if (ti >= tab[65]) return false; }
        else { const int total = tab[65] * NT; const long L = (long)i * G + c; if (L >= total) return false; ti = (int)L / NT; pn_ = (int)L % NT; }
        u.pn = pn_; u.pm = ti;
        const int e = __builtin_amdgcn_readfirstlane(tab[132 + ti]);
        u.e = e; u.aux = __builtin_amdgcn_readfirstlane(ti - tab[e]); u.n = __builtin_amdgcn_readfirstlane(tab[66 + e]); return true;
    }
    __device__ __forceinline__ const char* a_ptr(const Unit& u) const { return GATHER ? A : A + (size_t)u.pm * 256 * K * 2; }
    __device__ __forceinline__ const char* b_ptr(const Unit& u) const { return (u.e == NEXP ? Bsh : Bt + (size_t)u.e * bstride) + (size_t)u.pn * 256 * K * 2; }
    __device__ __forceinline__ unsigned a_row(const Unit& u, int r) const {
        if (!GATHER) return (unsigned)r;
        const int idx = u.aux * 256 + r;
        if (u.e == NEXP) return (unsigned)idx;
        return (idx < u.n) ? (unsigned)list[(size_t)u.e * LISTCAP + idx] : 0u;
    }
};

struct UpOrder {
    static constexpr bool GATHER = false;
    const char* Aq; const char* Bq; const char* Akv; const char* Bkv; int K; int G, c;
    __device__ bool next(int i, Unit& u) const {
        int L = i * G + c; if (L >= 448) return false;
        if (L < 256) { u.e = 1; u.pm = L >> 2; u.pn = L & 3; } else { L -= 256; u.e = 0; u.pm = L / 3; u.pn = L % 3; }
        u.aux = 0; u.n = 256; return true; }
    __device__ __forceinline__ const char* a_ptr(const Unit& u) const { return (u.e ? Akv : Aq) + (size_t)u.pm * 256 * K * 2; }
    __device__ __forceinline__ const char* b_ptr(const Unit& u) const { return (u.e ? Bkv : Bq) + (size_t)u.pn * 256 * K * 2; }
    __device__ __forceinline__ unsigned a_row(const Unit&, int r) const { return (unsigned)r; }
};
struct EpiUp {
    static constexpr bool MIDK = false;
    EpiQup q; EpiKVup kv;
    __device__ __forceinline__ void operator()(const f32x4 (&acc)[2][2][4][2], const Unit& u, int wr, int wc, int fr, int fq_) const { if (u.e) kv(acc, u, wr, wc, fr, fq_); else q(acc, u, wr, wc, fr, fq_); }
};

struct SharedDownOrder {
    static constexpr bool GATHER = false;
    const char* A; const char* Bt; int K; int G, c;
    __device__ bool next(int i, Unit& u) const { const int L = i * G + c; if (L >= (T / 256) * 4) return false; u.pm = L >> 2; u.pn = L & 3; u.e = NEXP; u.aux = L >> 2; u.n = 256; return true; }
    __device__ __forceinline__ const char* a_ptr(const Unit& u) const { return A + (size_t)u.pm * 256 * K * 2; }
    __device__ __forceinline__ const char* b_ptr(const Unit& u) const { return Bt + (size_t)u.pn * 256 * K * 2; }
    __device__ __forceinline__ unsigned a_row(const Unit&, int r) const { return (unsigned)r; }
};

namespace att {
constexpr int KSLOT = 12288, VSLOT = 8192;
constexpr int L_K = 0, L_V = 3 * KSLOT, L_F = L_V + 2 * VSLOT, L_WS = L_F + 3 * 256, L_OST = L_WS + 2048, L_END = L_OST + 8 * 4096;
static_assert(L_END <= RING_BYTES, "attention LDS");
__device__ __forceinline__ int crow(int r, int hi) { return (r & 3) + 8 * (r >> 2) + 4 * hi; }
__device__ __forceinline__ float max3f(float a, float b, float c) { return fmaxf(fmaxf(a, b), c); }
__device__ __forceinline__ float rowmax(const f32x16& p0, const f32x16& p1) {
    float a = max3f(p0[0], p0[1], p1[0]), b = max3f(p0[2], p0[3], p1[1]); a = max3f(a, p1[2], p1[3]);
#pragma unroll
    for (int r = 4; r < 16; r += 4) { a = max3f(a, p0[r], p0[r + 1]); b = max3f(b, p0[r + 2], p0[r + 3]); a = max3f(a, p1[r], p1[r + 1]); b = max3f(b, p1[r + 2], p1[r + 3]); }
    const float m = fmaxf(a, b);
    auto rr = __builtin_amdgcn_permlane32_swap(__float_as_uint(m), __float_as_uint(m), false, false);
    return fmaxf(__uint_as_float(rr[0]), __uint_as_float(rr[1]));
}
__device__ __forceinline__ void cmask(f32x16& p0, f32x16& p1, int jb, int qrel, int hi) {
    const float NEG = -INFINITY; const int kb = 64 * jb + 4 * hi;
#pragma unroll
    for (int r = 0; r < 16; ++r) { const int kv = kb + (r & 3) + 8 * (r >> 2); if (kv > qrel) p0[r] = NEG; if (kv + 32 > qrel) p1[r] = NEG; }
}
__device__ __forceinline__ void pv(f32x16* o, int vb, bf16x8 pa0, bf16x8 pa1, bf16x8 pa2, bf16x8 pa3) {
#pragma unroll
    for (int d0 = 0; d0 < 2; ++d0) { s16x4 lo[4], hi[4];
#pragma unroll
        for (int ks = 0; ks < 4; ++ks) {
            asm volatile("ds_read_b64_tr_b16 %0,%1 offset:%c2" : "=&v"(lo[ks]) : "v"(vb), "i"(d0 * 4096 + ks * 1024) : "memory");
            asm volatile("ds_read_b64_tr_b16 %0,%1 offset:%c2" : "=&v"(hi[ks]) : "v"(vb), "i"(d0 * 4096 + ks * 1024 + 512) : "memory"); }
        asm volatile("s_waitcnt lgkmcnt(0)" ::: "memory"); __builtin_amdgcn_sched_barrier(0);
#define PK(k) (bf16x8){lo[k][0], lo[k][1], lo[k][2], lo[k][3], hi[k][0], hi[k][1], hi[k][2], hi[k][3]}
        o[d0] = __builtin_amdgcn_mfma_f32_32x32x16_bf16(pa0, PK(0), o[d0], 0, 0, 0);
        o[d0] = __builtin_amdgcn_mfma_f32_32x32x16_bf16(pa1, PK(1), o[d0], 0, 0, 0);
        o[d0] = __builtin_amdgcn_mfma_f32_32x32x16_bf16(pa2, PK(2), o[d0], 0, 0, 0);
        o[d0] = __builtin_amdgcn_mfma_f32_32x32x16_bf16(pa3, PK(3), o[d0], 0, 0, 0);
#undef PK
    }
}
__device__ __forceinline__ unsigned cvtpk_s(float lo, float hi) { return cvt_pk_bf16(lo, hi); }

template <int DQK, bool DECAY, int THRL>
__device__ __forceinline__ void attn_unit(int b, int h, int qb, const bf16* Q, int QP, const bf16* Kn, const bf16* Kpe, const bf16* V, const float* cumF, bf16* O, int OP, LAS unsigned char* lds) {
    constexpr int ND0 = DQK / 16;
    int tid = threadIdx.x; asm volatile("" : "+v"(tid));
    const int lane = tid & 63, r32 = lane & 31, hi = lane >> 5; const int wid = __builtin_amdgcn_readfirstlane(tid >> 6);
    const long rowbase = (long)b * SEQ; const int q0 = qb * 256;
    const bf16* Qw = Q + (rowbase + q0 + wid * 32) * QP + h * DQK;
    const bf16* Kh = Kn + rowbase * 512 + h * 64; const bf16* Vh = V + rowbase * 512 + h * 64;
    const bf16* Kp = Kpe + rowbase * ROPE;
    const float* Fh = DECAY ? cumF + ((size_t)b * NHEAD + h) * SEQ : nullptr;
    LAS float* wsf = (LAS float*)(lds + L_WS) + wid * 64;
    const bf16* ksrc0 = Kh + (long)lane * 512 + wid * 8;
    const bf16* ksrc1 = Kp + (long)lane * ROPE + (wid & 3) * 8;
    const bf16* vsrc = Vh + (long)(16 * (wid & 3) + (lane >> 2)) * 512 + (wid >> 2) * 32 + (lane & 3) * 8;
    const int NT = (q0 + 256) / 64;
#define ATT_DMA_K(i_, s) do { const int t_ = NT - 1 - (i_); \
        __builtin_amdgcn_global_load_lds((const unsigned*)(ksrc0 + (long)t_ * 64 * 512), (LAS unsigned*)(lds + L_K + (s) * KSLOT + wid * 1024), 16, 0, 0); \
        if (DQK == 96 && wid < 4) __builtin_amdgcn_global_load_lds((const unsigned*)(ksrc1 + (long)t_ * 64 * ROPE), (LAS unsigned*)(lds + L_K + (s) * KSLOT + (8 + wid) * 1024), 16, 0, 0); \
        if (DECAY && wid == 7) __builtin_amdgcn_global_load_lds((const unsigned*)(Fh + t_ * 64 + lane), (LAS unsigned*)(lds + L_F + (s) * 256), 4, 0, 0); } while (0)
#define ATT_DMA_V(i_, s) do { const int t_ = NT - 1 - (i_); \
        __builtin_amdgcn_global_load_lds((const unsigned*)(vsrc + (long)t_ * 64 * 512), (LAS unsigned*)(lds + L_V + (s) * VSLOT + wid * 1024), 16, 0, 0); } while (0)
    ATT_DMA_K(0, 0); ATT_DMA_V(0, 0); ATT_DMA_K(1, 1);
    bf16x8 qr[ND0];
#pragma unroll
    for (int d0 = 0; d0 < ND0; ++d0) qr[d0] = *(const bf16x8*)(Qw + (long)r32 * QP + d0 * 16 + hi * 8);
    float fq_l = 0.f; if (DECAY) fq_l = Fh[q0 + wid * 32 + r32];
    float mhat = 0.f, l_reg = 0.f; bool started = false; f32x16 o[2]; o[0] = f32x16{}; o[1] = f32x16{};
    const int qrel = wid * 32 + r32;
    const int vb0 = (int)(uintptr_t)(lds + L_V) + ((lane >> 4) & 1) * 32 + (lane & 3) * 8 + (4 * hi + ((lane & 15) >> 2)) * 64;
#define ATT_QK(P0, P1, ks_) do { const float base_ = fq_l - mhat; \
        if (DECAY) { const LAS f32x4* fk_ = (const LAS f32x4*)(lds + L_F + (ks_) * 256); \
            _Pragma("unroll") for (int g = 0; g < 4; ++g) { const f32x4 a_ = fk_[2 * g + hi], c_ = fk_[8 + 2 * g + hi]; \
                _Pragma("unroll") for (int q = 0; q < 4; ++q) { P0[4 * g + q] = base_ - a_[q]; P1[4 * g + q] = base_ - c_[q]; } } } \
        else { _Pragma("unroll") for (int r = 0; r < 16; ++r) { P0[r] = base_; P1[r] = base_; } } \
        const LAS unsigned char* kb_ = lds + L_K + (ks_) * KSLOT + hi * 1024 + r32 * 16; \
        _Pragma("unroll") for (int d0 = 0; d0 < ND0; ++d0) { \
            const bf16x8 b0_ = *(const LAS bf16x8*)(kb_ + d0 * 2048), b1_ = *(const LAS bf16x8*)(kb_ + d0 * 2048 + 512); \
            P0 = __builtin_amdgcn_mfma_f32_32x32x16_bf16(b0_, qr[d0], P0, 0, 0, 0); P1 = __builtin_amdgcn_mfma_f32_32x32x16_bf16(b1_, qr[d0], P1, 0, 0, 0); } } while (0)
    f32x16 p0, p1, n0, n1;
    int ks_cur = 0, ks_nxt = 1, ks_ld = 2;
    for (int i = 0; i < NT; ++i) {
        const int vs = i & 1;
        VM_WAIT(); __syncthreads();
        if (i + 2 < NT) ATT_DMA_K(i + 2, ks_ld);
        if (i + 1 < NT) ATT_DMA_V(i + 1, vs ^ 1);
        if (i == 0) ATT_QK(p0, p1, 0);
        if (i + 1 < NT) ATT_QK(n0, n1, ks_nxt);
        const int jb = 3 - i;
        if (jb >= 0) cmask(p0, p1, jb, qrel, hi);
        const float rm = rowmax(p0, p1);
        bool resc = false; float dl = 0.f; const bool was_started = started;
        if (jb >= 0) {
            const bool fin = rm > -INFINITY;
            dl = started ? fmaxf(rm, 0.f) : (fin ? rm : 0.f); started = started || fin; resc = true;
        } else if (__any(rm > (float)THRL)) { dl = fmaxf(rm, 0.f); resc = true; }
        if (resc) { mhat += dl;
#pragma unroll
            for (int r = 0; r < 16; ++r) { p0[r] -= dl; p1[r] -= dl; }
            if (i + 1 < NT) {
#pragma unroll
                for (int r = 0; r < 16; ++r) { n0[r] -= dl; n1[r] -= dl; } }
            const float f = was_started ? __builtin_amdgcn_exp2f(-dl) : 1.f; l_reg *= f; if (hi == 0) wsf[r32] = f; }
        float sacc = 0.f;
#pragma unroll
        for (int r = 0; r < 16; ++r) { p0[r] = __builtin_amdgcn_exp2f(p0[r]); p1[r] = __builtin_amdgcn_exp2f(p1[r]); sacc += p0[r] + p1[r]; }
        l_reg += sacc;
        if (resc) { LDS_WAIT();
#pragma unroll
            for (int d_ = 0; d_ < 2; ++d_)
#pragma unroll
                for (int r = 0; r < 16; ++r) o[d_][r] *= wsf[crow(r, hi)]; }
        u32x4 pw0, pw1, pw2, pw3;
        pw0 = (u32x4){cvtpk_s(p0[0], p0[1]), cvtpk_s(p0[2], p0[3]), cvtpk_s(p0[4], p0[5]), cvtpk_s(p0[6], p0[7])};
        pw1 = (u32x4){cvtpk_s(p0[8], p0[9]), cvtpk_s(p0[10], p0[11]), cvtpk_s(p0[12], p0[13]), cvtpk_s(p0[14], p0[15])};
        pw2 = (u32x4){cvtpk_s(p1[0], p1[1]), cvtpk_s(p1[2], p1[3]), cvtpk_s(p1[4], p1[5]), cvtpk_s(p1[6], p1[7])};
        pw3 = (u32x4){cvtpk_s(p1[8], p1[9]), cvtpk_s(p1[10], p1[11]), cvtpk_s(p1[12], p1[13]), cvtpk_s(p1[14], p1[15])};
        __builtin_amdgcn_sched_barrier(0);
        pv(o, vb0 + vs * VSLOT, __builtin_bit_cast(bf16x8, pw0), __builtin_bit_cast(bf16x8, pw1), __builtin_bit_cast(bf16x8, pw2), __builtin_bit_cast(bf16x8, pw3));
        p0 = n0; p1 = n1;
        { const int t_ = ks_cur; ks_cur = ks_nxt; ks_nxt = ks_ld; ks_ld = t_; }
    }
    { auto rr = __builtin_amdgcn_permlane32_swap(__float_as_uint(l_reg), __float_as_uint(l_reg), false, false); l_reg = __uint_as_float(rr[0]) + __uint_as_float(rr[1]); }
    if (hi == 0) wsf[32 + r32] = l_reg; LDS_WAIT();
    float rli[16];
#pragma unroll
    for (int r = 0; r < 16; ++r) rli[r] = __builtin_amdgcn_rcpf(wsf[32 + crow(r, hi)]);
    unsigned char* Ow = (unsigned char*)O + (rowbase + q0 + wid * 32) * OP + h * 64;
    { LAS unsigned char* stg = lds + L_OST + wid * 4096;
#pragma unroll
      for (int r = 0; r < 16; ++r) { const int orow = crow(r, hi);
#pragma unroll
          for (int d0 = 0; d0 < 2; ++d0) { const float ov = o[d0][r] * rli[r] * OSCALE8; stg[orow * 64 + d0 * 32 + r32] = (unsigned char)__builtin_amdgcn_cvt_pk_fp8_f32(ov, ov, 0, false); } }
      LDS_WAIT();
#pragma unroll
      for (int i = 0; i < 2; ++i) { const int row = i * 16 + (lane >> 2), ch = lane & 3; const u32x4 v = *(const LAS u32x4*)(stg + row * 64 + ch * 16); *(u32x4*)(Ow + (long)row * OP + ch * 16) = v; } }
    LDS_WAIT(); __syncthreads();
#undef ATT_DMA_K
#undef ATT_DMA_V
#undef ATT_QK
}

constexpr int T_KSLOT = 12288, T_VSLOT = 8192, T_NSLOT = 3;
constexpr int T_K = 0, T_V = T_NSLOT * T_KSLOT, T_F = T_V + T_NSLOT * T_VSLOT, T_WS = T_F + T_NSLOT * 256, T_OST = T_WS + 2048, T_END = T_OST + 8 * 4096;
static_assert(T_END <= RING_BYTES, "attention LDS (hand-interleaved unit)");
typedef __attribute__((address_space(3))) const char* lds_cptr;
typedef short v4i16_t __attribute__((ext_vector_type(4)));
__device__ __forceinline__ s16x4 vtr(lds_cptr p) { return __builtin_bit_cast(s16x4, __builtin_amdgcn_ds_read_tr16_b64_v4i16((__attribute__((address_space(3))) v4i16_t*)p)); }
__device__ __forceinline__ void kload2(bf16x8* kf, lds_cptr kp, int j) { kf[2 * j] = *(const __attribute__((address_space(3))) bf16x8*)(kp + j * 2048); kf[2 * j + 1] = *(const __attribute__((address_space(3))) bf16x8*)(kp + j * 2048 + 512); }
#define TW_BAR(N) asm volatile("s_waitcnt vmcnt(" #N ") lgkmcnt(0)\n\ts_barrier" ::: "memory")
#define TSB() __builtin_amdgcn_sched_barrier(0)

template <int DQK, bool DECAY, int THRL>
__device__ __forceinline__ void attn_unit_t(int b, int h, int qb, const bf16* Q, int QP, const bf16* Kn, const bf16* Kpe, const bf16* V, const float* cumF, float kmax2, bf16* O, int OP, LAS unsigned char* lds) {
    constexpr int ND0 = DQK / 16;
    constexpr bool INPL = DECAY || (DQK == 96);
    int tid = threadIdx.x; asm volatile("" : "+v"(tid));
    const int lane = tid & 63, r32 = lane & 31, hi = lane >> 5; const int wid = __builtin_amdgcn_readfirstlane(tid >> 6);
    const long rowbase = (long)b * SEQ; const int q0 = qb * 256;
    const bf16* Qw = Q + (rowbase + q0 + wid * 32) * QP + h * DQK;
    const bf16* Kh = Kn + rowbase * 512 + h * 64; const bf16* Vh = V + rowbase * 512 + h * 64;
    const bf16* Kp = Kpe + rowbase * ROPE;
    const float* Fh = DECAY ? cumF + ((size_t)b * NHEAD + h) * SEQ : nullptr;
    LAS float* wsf = (LAS float*)(lds + T_WS) + wid * 64;
    const bf16* ksrc0 = Kh + (long)lane * 512 + wid * 8;
    const bf16* ksrc1 = Kp + (long)lane * ROPE + (wid & 3) * 8;
    const bf16* vsrc = Vh + (long)(16 * (wid & 3) + (lane >> 2)) * 512 + (wid >> 2) * 32 + (lane & 3) * 8;
    const int NTS = (q0 + 256) / 64;
#define TDMA_K(i_, sk) do { const int t_ = NTS - 1 - (i_); \
        __builtin_amdgcn_global_load_lds((const unsigned*)(ksrc0 + (long)t_ * 64 * 512), (LAS unsigned*)(lds + T_K + (sk) * T_KSLOT + wid * 1024), 16, 0, 0); \
        if (DECAY) __builtin_amdgcn_global_load_lds((const unsigned*)(Fh + t_ * 64 + lane), (LAS unsigned*)(lds + T_F + (sk) * 256), 4, 0, 0); \
        else __builtin_amdgcn_global_load_lds((const unsigned*)(ksrc1 + (long)t_ * 64 * ROPE), (LAS unsigned*)(lds + T_K + (sk) * T_KSLOT + (8 + (wid & 3)) * 1024), 16, 0, 0); } while (0)
#define TDMA_V(i_, sv) do { const int t_ = NTS - 1 - (i_); \
        __builtin_amdgcn_global_load_lds((const unsigned*)(vsrc + (long)t_ * 64 * 512), (LAS unsigned*)(lds + T_V + (sv) * T_VSLOT + wid * 1024), 16, 0, 0); } while (0)
    TDMA_K(0, 0); TDMA_V(0, 0); TDMA_K(1, 1);
    bf16x8 qr[ND0];
#pragma unroll
    for (int d0 = 0; d0 < ND0; ++d0) qr[d0] = *(const bf16x8*)(Qw + (long)r32 * QP + d0 * 16 + hi * 8);
    float fq_l = 0.f; if (DECAY) fq_l = Fh[q0 + wid * 32 + r32];
    float ftile = 0.f; if (DECAY) ftile = Fh[(lane < NTS ? lane : NTS - 1) * 64 + 63];
    float mhat = 0.f, l_reg = 0.f; f32x16 o[2]; o[0] = f32x16{}; o[1] = f32x16{};
    f32x16 negm = f32x16{}; asm volatile("" : "+v"(negm));
    const int qrel = wid * 32 + r32, i0 = 3 - (wid >> 1);
    const lds_cptr shm3 = (lds_cptr)lds; const lds_cptr kp0 = shm3 + T_K + hi * 1024 + r32 * 16;
    const lds_cptr vp0 = shm3 + T_V + ((lane >> 4) & 1) * 32 + (lane & 3) * 8 + (4 * hi + ((lane & 15) >> 2)) * 64;
    const int vb0 = (int)(uintptr_t)(lds + T_V) + ((lane >> 4) & 1) * 32 + (lane & 3) * 8 + (4 * hi + ((lane & 15) >> 2)) * 64;
    bool resc = false;
    bf16x8 kf[2 * ND0];
    f32x16 pA0, pA1, pB0, pB1;
    int sl_prev = 0, sl_cur = 0, sl_next = 1;
#define TROT() do { sl_prev = sl_cur; sl_cur = sl_next; sl_next = (sl_next == T_NSLOT - 1) ? 0 : sl_next + 1; } while (0)
#define TBIAS(X0, X1, fs_) do { if (DECAY) { const float base_ = fq_l - mhat; const LAS f32x4* fk_ = (const LAS f32x4*)(lds + T_F + (fs_) * 256); \
        _Pragma("unroll") for (int g = 0; g < 4; ++g) { const f32x4 a_ = fk_[2 * g + hi], c_ = fk_[8 + 2 * g + hi]; \
            _Pragma("unroll") for (int q = 0; q < 4; ++q) { X0[4 * g + q] = base_ - a_[q]; X1[4 * g + q] = base_ - c_[q]; } } } \
        else if (INPL) { const float nm_ = -mhat; _Pragma("unroll") for (int r = 0; r < 16; ++r) { X0[r] = nm_; X1[r] = nm_; } } } while (0)
#define TCIN(X) (INPL ? X : negm)
#define TRESC() do { if (resc) { asm volatile("s_waitcnt lgkmcnt(0)" ::: "memory"); \
        _Pragma("unroll") for (int d_ = 0; d_ < 2; ++d_) _Pragma("unroll") for (int r = 0; r < 16; ++r) o[d_][r] *= wsf[crow(r, hi)]; } } while (0)
#define TDECIDE(C0, C1, i_) do { \
        float a_ = max3f(C0[0], C0[1], C1[0]), b_ = max3f(C0[2], C0[3], C1[1]); a_ = max3f(a_, C1[2], C1[3]); \
        _Pragma("unroll") for (int r = 4; r < 16; r += 4) { a_ = max3f(a_, C0[r], C0[r + 1]); b_ = max3f(b_, C0[r + 2], C0[r + 3]); a_ = max3f(a_, C1[r], C1[r + 1]); b_ = max3f(b_, C1[r + 2], C1[r + 3]); } \
        float rm_ = fmaxf(a_, b_); { auto rr_ = __builtin_amdgcn_permlane32_swap(__float_as_uint(rm_), __float_as_uint(rm_), false, false); rm_ = fmaxf(__uint_as_float(rr_[0]), __uint_as_float(rr_[1])); } \
        resc = false; \
        if ((i_) == i0) { const float dl_ = rm_; mhat += dl_; \
            _Pragma("unroll") for (int r = 0; r < 16; ++r) { C0[r] -= dl_; C1[r] -= dl_; } \
            if (!INPL) { _Pragma("unroll") for (int r = 0; r < 16; ++r) negm[r] = -mhat; asm volatile("" : "+v"(negm)); } } \
        else if (__builtin_expect(__any(rm_ > (float)THRL), 0)) { const float dl_ = fmaxf(rm_, 0.f); mhat += dl_; \
            _Pragma("unroll") for (int r = 0; r < 16; ++r) { C0[r] -= dl_; C1[r] -= dl_; } \
            if (!INPL) { _Pragma("unroll") for (int r = 0; r < 16; ++r) negm[r] = -mhat; asm volatile("" : "+v"(negm)); } \
            const float f_ = __builtin_amdgcn_exp2f(-dl_); l_reg *= f_; if (hi == 0) wsf[r32] = f_; resc = true; } } while (0)
    TDMA_K(2, 2);
    TW_BAR(5);
    int NT = NTS;
    if (DECAY) {
        const float bound = 2.f * __builtin_sqrtf(kmax2) * 1.0001f + 1.f + (Fh[q0] - ftile);
        const unsigned long long need = __ballot(lane < NTS && bound >= -160.f);
        const int tmin = need ? (int)__builtin_ctzll(need) : NTS - 1;
        NT = NTS - tmin; NT += NT & 1; if (NT < 8) NT = 8; if (NT > NTS) NT = NTS;
        NT = __builtin_amdgcn_readfirstlane(NT); }
    TBIAS(pA0, pA1, 0);
    { const lds_cptr kb = kp0;
#pragma unroll
      for (int d0 = 0; d0 < ND0; ++d0) { const bf16x8 b0 = *(const __attribute__((address_space(3))) bf16x8*)(kb + d0 * 2048), b1 = *(const __attribute__((address_space(3))) bf16x8*)(kb + d0 * 2048 + 512);
          if (d0 == 0) { pA0 = __builtin_amdgcn_mfma_f32_32x32x16_bf16(b0, qr[0], TCIN(pA0), 0, 0, 0); pA1 = __builtin_amdgcn_mfma_f32_32x32x16_bf16(b1, qr[0], TCIN(pA1), 0, 0, 0); }
          else { pA0 = __builtin_amdgcn_mfma_f32_32x32x16_bf16(b0, qr[d0], pA0, 0, 0, 0); pA1 = __builtin_amdgcn_mfma_f32_32x32x16_bf16(b1, qr[d0], pA1, 0, 0, 0); } } }
    cmask(pA0, pA1, 3, qrel, hi);
    TDECIDE(pA0, pA1, 0);
#pragma unroll
    for (int r = 0; r < 16; ++r) { pA0[r] = __builtin_amdgcn_exp2f(pA0[r]); pA1[r] = __builtin_amdgcn_exp2f(pA1[r]); }
    TW_BAR(0);
    TDMA_K(3, 0); TDMA_V(1, 1);
    TROT();
#pragma unroll
    for (int j = 0; j < ND0; ++j) kload2(kf, kp0 + sl_cur * T_KSLOT, j);
    TBIAS(pB0, pB1, sl_cur);
    TW_BAR(3);
    s16x4 vlo[8], vhi[8]; u32x4 pw0, pw1, pw2, pw3;
#define TPKW(P, B) cvt_pk_bf16(P[B], P[B + 1])
#define TPAF(k) __builtin_bit_cast(bf16x8, pw##k)
#define TVFR(i) (bf16x8){vlo[i][0], vlo[i][1], vlo[i][2], vlo[i][3], vhi[i][0], vhi[i][1], vhi[i][2], vhi[i][3]}
#define TPIN(x) asm volatile("" : "+v"(x))
#define TGAPA(MF, A0, A1, A2, A3, W0, W1, PW) do { MF; sacc += A0; sacc += A1; sacc += A2; sacc += A3; TPIN(sacc); W0; W1; TPIN(PW); TSB(); } while (0)
#define TEX(v) __builtin_amdgcn_exp2f(v)
#define TGAPB(MF, X, B) do { MF; X[B] = TEX(X[B]); X[B + 1] = TEX(X[B + 1]); X[B + 2] = TEX(X[B + 2]); X[B + 3] = TEX(X[B + 3]); TPIN(X); TSB(); } while (0)
#define TVRD(i) do { vlo[i] = vtr(vp_ + (((i) >> 2) * 4096 + ((i) & 3) * 1024)); vhi[i] = vtr(vp_ + (((i) >> 2) * 4096 + ((i) & 3) * 1024 + 512)); } while (0)
#define TKRD(G, j) do { if (G) { kload2(kf, kp0 + sl_next * T_KSLOT, j); TSB(); } } while (0)
#define TMF(a, b, c) __builtin_amdgcn_mfma_f32_32x32x16_bf16(a, b, c, 0, 0, 0)
#define TSTEP(C0, C1, P0, P1, i_, MJB, GK, GV, GL) do { TSB(); \
        const lds_cptr vp_ = vp0 + sl_prev * T_VSLOT; \
        TVRD(0); TSB(); float sacc = (P0[0] + P0[1]); \
        TGAPA(C0 = TMF(kf[0], qr[0], TCIN(C0)), P0[2], P0[3], P0[4], P0[5],     pw0[0] = TPKW(P0, 0), pw0[1] = TPKW(P0, 2), pw0); \
        TVRD(4); TSB(); TGAPA(C1 = TMF(kf[1], qr[0], TCIN(C1)), P0[6], P0[7], P0[8], P0[9],     pw0[2] = TPKW(P0, 4), pw0[3] = TPKW(P0, 6), pw0); \
        TVRD(1); TSB(); TGAPA(C0 = TMF(kf[2], qr[1], C0),   P0[10], P0[11], P0[12], P0[13], pw1[0] = TPKW(P0, 8), pw1[1] = TPKW(P0, 10), pw1); \
        TVRD(5); TSB(); TGAPA(C1 = TMF(kf[3], qr[1], C1),   P0[14], P0[15], P1[0], P1[1],   pw1[2] = TPKW(P0, 12), pw1[3] = TPKW(P0, 14), pw1); \
        TVRD(2); TSB(); TGAPA(C0 = TMF(kf[4], qr[2], C0),   P1[2], P1[3], P1[4], P1[5],     pw2[0] = TPKW(P1, 0), pw2[1] = TPKW(P1, 2), pw2); \
        TVRD(6); TSB(); TGAPA(C1 = TMF(kf[5], qr[2], C1),   P1[6], P1[7], P1[8], P1[9],     pw2[2] = TPKW(P1, 4), pw2[3] = TPKW(P1, 6), pw2); \
        TVRD(3); TSB(); TGAPA(C0 = TMF(kf[6], qr[3], C0),   P1[10], P1[11], P1[12], P1[13], pw3[0] = TPKW(P1, 8), pw3[1] = TPKW(P1, 10), pw3); \
        TVRD(7); TSB(); TGAPA(C1 = TMF(kf[7], qr[3], C1),   P1[14], P1[15], 0.f, 0.f,       pw3[2] = TPKW(P1, 12), pw3[3] = TPKW(P1, 14), pw3); \
        if (ND0 == 6) { C0 = TMF(kf[2 * ND0 - 4], qr[ND0 - 2], C0); C1 = TMF(kf[2 * ND0 - 3], qr[ND0 - 2], C1); C0 = TMF(kf[2 * ND0 - 2], qr[ND0 - 1], C0); C1 = TMF(kf[2 * ND0 - 1], qr[ND0 - 1], C1); TSB(); } \
        l_reg += sacc; \
        if (GK) { TDMA_K((i_) + 3, sl_cur); } if (GV) { TDMA_V((i_) + 1, sl_next); } \
        if ((MJB) >= 0) cmask(C0, C1, (MJB), qrel, hi); \
        TDECIDE(C0, C1, i_); \
        TSB(); \
        TGAPB(o[0] = TMF(TPAF(0), TVFR(0), o[0]), C0, 0); \
        TKRD(GL, 0); TGAPB(o[1] = TMF(TPAF(0), TVFR(4), o[1]), C0, 4); \
        TKRD(GL, 1); TGAPB(o[0] = TMF(TPAF(1), TVFR(1), o[0]), C0, 8); \
        TKRD(GL, 2); TGAPB(o[1] = TMF(TPAF(1), TVFR(5), o[1]), C0, 12); \
        TKRD(GL, 3); TGAPB(o[0] = TMF(TPAF(2), TVFR(2), o[0]), C1, 0); \
        if (ND0 == 6) { TKRD(GL, ND0 - 2); } TGAPB(o[1] = TMF(TPAF(2), TVFR(6), o[1]), C1, 4); \
        if (ND0 == 6) { TKRD(GL, ND0 - 1); } TGAPB(o[0] = TMF(TPAF(3), TVFR(3), o[0]), C1, 8); \
        TGAPB(o[1] = TMF(TPAF(3), TVFR(7), o[1]), C1, 12); \
        if (GL) { TBIAS(P0, P1, sl_next); } \
    } while (0)
#define TENDW(tt) do { if ((tt) + 3 < NT) { TW_BAR(3); } else if ((tt) + 2 < NT) { TW_BAR(1); } else { TW_BAR(0); } } while (0)
    TSTEP(pB0, pB1, pA0, pA1, 1, 2, (1 + 3 < NT), true, true); TENDW(1); TRESC(); TROT();
    TSTEP(pA0, pA1, pB0, pB1, 2, 1, (2 + 3 < NT), true, true); TENDW(2); TRESC(); TROT();
    {
        TSTEP(pB0, pB1, pA0, pA1, 3, 0, (3 + 3 < NT), true, true); TENDW(3); TRESC(); TROT();
        int i = 4;
        for (; i + 2 < NT; i += 2) {
            TSTEP(pA0, pA1, pB0, pB1, i, -1, (i + 3 < NT), true, true);                         TENDW(i);     TRESC(); TROT();
            TSTEP(pB0, pB1, pA0, pA1, i + 1, -1, (i + 4 < NT), (i + 2 < NT), (i + 2 < NT));     TENDW(i + 1); TRESC(); TROT();
        }
        TSTEP(pA0, pA1, pB0, pB1, NT - 2, -1, false, true, true); TENDW(NT - 2); TRESC(); TROT();
        TSTEP(pB0, pB1, pA0, pA1, NT - 1, -1, false, false, false); TRESC();
    }
    { float sacc = pB0[0] + pB0[1];
#pragma unroll
      for (int r = 2; r < 16; ++r) sacc += pB0[r];
#pragma unroll
      for (int r = 0; r < 16; ++r) sacc += pB1[r];
      l_reg += sacc;
      pw0 = (u32x4){TPKW(pB0, 0), TPKW(pB0, 2), TPKW(pB0, 4), TPKW(pB0, 6)}; pw1 = (u32x4){TPKW(pB0, 8), TPKW(pB0, 10), TPKW(pB0, 12), TPKW(pB0, 14)};
      pw2 = (u32x4){TPKW(pB1, 0), TPKW(pB1, 2), TPKW(pB1, 4), TPKW(pB1, 6)}; pw3 = (u32x4){TPKW(pB1, 8), TPKW(pB1, 10), TPKW(pB1, 12), TPKW(pB1, 14)};
      TSB(); pv(o, vb0 + sl_cur * T_VSLOT, TPAF(0), TPAF(1), TPAF(2), TPAF(3)); }
    { auto rr = __builtin_amdgcn_permlane32_swap(__float_as_uint(l_reg), __float_as_uint(l_reg), false, false); l_reg = __uint_as_float(rr[0]) + __uint_as_float(rr[1]); }
    if (hi == 0) wsf[32 + r32] = l_reg; asm volatile("s_waitcnt lgkmcnt(0)" ::: "memory");
    float rli[16];
#pragma unroll
    for (int r = 0; r < 16; ++r) rli[r] = __builtin_amdgcn_rcpf(wsf[32 + crow(r, hi)]);
    unsigned char* Ow = (unsigned char*)O + (rowbase + q0 + wid * 32) * OP + h * 64;
    { LAS unsigned char* stg = lds + T_OST + wid * 4096;
#pragma unroll
      for (int r = 0; r < 16; ++r) { const int orow = crow(r, hi);
#pragma unroll
          for (int d0 = 0; d0 < 2; ++d0) { const float ov = o[d0][r] * rli[r] * OSCALE8; stg[orow * 64 + d0 * 32 + r32] = (unsigned char)__builtin_amdgcn_cvt_pk_fp8_f32(ov, ov, 0, false); } }
      asm volatile("s_waitcnt lgkmcnt(0)" ::: "memory");
#pragma unroll
      for (int i = 0; i < 2; ++i) { const int row = i * 16 + (lane >> 2), ch = lane & 3; const u32x4 v = *(const LAS u32x4*)(stg + row * 64 + ch * 16); *(u32x4*)(Ow + (long)row * OP + ch * 16) = v; } }
    asm volatile("s_waitcnt lgkmcnt(0)\n\ts_barrier" ::: "memory");
#undef TDMA_K
#undef TDMA_V
#undef TROT
#undef TBIAS
#undef TCIN
#undef TRESC
#undef TDECIDE
#undef TPKW
#undef TPAF
#undef TVFR
#undef TPIN
#undef TGAPA
#undef TEX
#undef TGAPB
#undef TVRD
#undef TKRD
#undef TMF
#undef TSTEP
#undef TENDW
}
#undef TW_BAR
#undef TSB
}

namespace dn {
constexpr int CHB = 64 * 256;
constexpr int NSLOT = 8, AHEAD = 7;
__device__ __forceinline__ int nloc(int i) { return 16 * ((i >> 2) & 1) + (i & 3) + 4 * (i >> 3); }
template <bool NOTRAFFIC>
__device__ __forceinline__ void down_phase(LAS unsigned char* lds, const unsigned char* HBp, const unsigned char* Wd, const unsigned char* Wsd, volatile LAS int* tab, const u32x2* meta, unsigned char* Yp, unsigned char* trash, int G, int c) {
    int tid = threadIdx.x; asm volatile("" : "+v"(tid));
    const int wid = __builtin_amdgcn_readfirstlane(tid >> 6), lane = tid & 63, j = lane & 31, hi = lane >> 5;
    const int U = tab[65] * 8;
    const int u_lo = (int)(((long)c * U) / G), u_hi = (int)(((long)(c + 1) * U) / G);
    if (u_lo >= u_hi) return;
#define DN_DEC(u_, e_, hf_, ci_) do { e_ = __builtin_amdgcn_readfirstlane(tab[132 + ((u_) >> 3)]); const int ul_ = __builtin_amdgcn_readfirstlane((u_) - 8 * tab[e_]), nc_ = __builtin_amdgcn_readfirstlane(4 * (tab[e_ + 1] - tab[e_])); hf_ = (ul_ >= nc_) ? 1 : 0; ci_ = ul_ - hf_ * nc_; } while (0)
    unsigned dvo; { const int r_ = lane >> 3, f_ = ((r_ >> 1) & 3) << 1; dvo = (unsigned)(r_ * 256 + (((lane & 7) ^ f_) * 16)); }
#define DN_DMA(u_, buf_) do { int e__, hf__, ci__; DN_DEC(u_, e__, hf__, ci__); (void)hf__; const unsigned char* gb_ = HBp + ((size_t)tab[e__] * 256 + (size_t)ci__ * 64) * DEXP; \
        _Pragma("unroll") for (int i_ = 0; i_ < 2; ++i_) { const int q_ = wid * 2 + i_, kb_ = q_ >> 3, g_ = q_ & 7; \
            __builtin_amdgcn_global_load_lds((const unsigned*)(gb_ + (size_t)(8 * g_) * DEXP + kb_ * 128 + dvo), (LAS unsigned*)(lds + (buf_) * CHB + kb_ * 8192 + g_ * 1024), 16, 0, 0); } } while (0)
    int rowb[2], fx[2];
#pragma unroll
    for (int rt = 0; rt < 2; ++rt) { const int row = 32 * rt + j; rowb[rt] = (int)(uintptr_t)lds + row * 128; fx[rt] = (((row >> 1) & 3) << 1) * 16; }
    unsigned sc1 = 0x7f7f7f7fu; asm volatile("" : "+v"(sc1));
#pragma unroll
    for (int p = 0; p < AHEAD; ++p) { const int un = (u_lo + p < u_hi) ? u_lo + p : u_lo; DN_DMA(un, p); }
    int u = u_lo;
    while (u < u_hi) {
      int e, hf, ci0; DN_DEC(u, e, hf, ci0);
      const int nc = __builtin_amdgcn_readfirstlane(4 * (tab[e + 1] - tab[e])), ne = __builtin_amdgcn_readfirstlane(tab[66 + e]);
      int seg_end = 8 * tab[e] + (hf + 1) * nc; seg_end = __builtin_amdgcn_readfirstlane(seg_end < u_hi ? seg_end : u_hi);
      v8i32_t wfr[2][4];
#pragma unroll
      for (int nt = 0; nt < 2; ++nt) { const unsigned char* wp = ((e == NEXP) ? Wsd : Wd + (size_t)e * D * DEXP) + (size_t)(512 * hf + 64 * wid + 32 * nt + nloc(j)) * DEXP + 32 * hi;
#pragma unroll
          for (int ks = 0; ks < 4; ++ks) { wfr[nt][ks].lo = *(const v4i32_t*)(wp + 64 * ks); wfr[nt][ks].hi = *(const v4i32_t*)(wp + 64 * ks + 16); } }
      bool first = true;
      for (; u < seg_end; ++u) {
        const int buf = (u - u_lo) & (NSLOT - 1); (void)ci0;
        const int cidx = __builtin_amdgcn_readfirstlane((u - 8 * tab[e]) - hf * nc);
        u32x2 mt[2];
#pragma unroll
        for (int rt = 0; rt < 2; ++rt) { int pos = 64 * cidx + 32 * rt + j; const bool in = pos < ne; const int sp = pos; pos = (in && e != NEXP) ? pos : 0; const u32x2 m = meta[(size_t)(e == NEXP ? 0 : e) * LISTCAP + pos];
            mt[rt] = !in ? (u32x2){0xffffffffu, 0u} : (e == NEXP) ? (u32x2){(unsigned)(sp * (TOPK + 1) + TOPK), 0x3f800000u} : m; }
        if (first) { __builtin_amdgcn_s_waitcnt(0x0F70); first = false; }
        else { asm volatile("s_waitcnt vmcnt(54)" ::: "memory"); }
        LDS_WAIT(); __builtin_amdgcn_s_barrier();
        { const int un = (u + AHEAD < u_hi) ? u + AHEAD : u; DN_DMA(un, (buf + AHEAD) & (NSLOT - 1)); }
        f32x16 acc[2][2];
#pragma unroll
        for (int rt = 0; rt < 2; ++rt)
#pragma unroll
            for (int nt = 0; nt < 2; ++nt) asm volatile("v_mov_b32 %0, 0\n\tv_mov_b32 %1, 0\n\tv_mov_b32 %2, 0\n\tv_mov_b32 %3, 0\n\tv_mov_b32 %4, 0\n\tv_mov_b32 %5, 0\n\tv_mov_b32 %6, 0\n\tv_mov_b32 %7, 0\n\tv_mov_b32 %8, 0\n\tv_mov_b32 %9, 0\n\tv_mov_b32 %10, 0\n\tv_mov_b32 %11, 0\n\tv_mov_b32 %12, 0\n\tv_mov_b32 %13, 0\n\tv_mov_b32 %14, 0\n\tv_mov_b32 %15, 0"
                : "=v"(acc[rt][nt][0]), "=v"(acc[rt][nt][1]), "=v"(acc[rt][nt][2]), "=v"(acc[rt][nt][3]), "=v"(acc[rt][nt][4]), "=v"(acc[rt][nt][5]), "=v"(acc[rt][nt][6]), "=v"(acc[rt][nt][7]),
                  "=v"(acc[rt][nt][8]), "=v"(acc[rt][nt][9]), "=v"(acc[rt][nt][10]), "=v"(acc[rt][nt][11]), "=v"(acc[rt][nt][12]), "=v"(acc[rt][nt][13]), "=v"(acc[rt][nt][14]), "=v"(acc[rt][nt][15]));
        v8i32_t ha0, ha1, hb0, hb1;
        const int ad0 = rowb[0] + buf * CHB, ad1 = rowb[1] + buf * CHB;
#define DN_RDA(ks_) do { \
            asm volatile("ds_read_b128 v[192:195], %1 offset:%c2\n\tds_read_b128 v[196:199], %1 offset:%c3" : "={v[192:199]}"(ha0) : "v"(ad0 + ((64 * ((ks_) & 1) + 32 * hi) ^ fx[0])), "i"(((ks_) >> 1) * 8192), "i"(((ks_) >> 1) * 8192 + 16) : "memory"); \
            asm volatile("ds_read_b128 v[200:203], %1 offset:%c2\n\tds_read_b128 v[204:207], %1 offset:%c3" : "={v[200:207]}"(ha1) : "v"(ad1 + ((64 * ((ks_) & 1) + 32 * hi) ^ fx[1])), "i"(((ks_) >> 1) * 8192), "i"(((ks_) >> 1) * 8192 + 16) : "memory"); } while (0)
#define DN_RDB(ks_) do { \
            asm volatile("ds_read_b128 v[208:211], %1 offset:%c2\n\tds_read_b128 v[212:215], %1 offset:%c3" : "={v[208:215]}"(hb0) : "v"(ad0 + ((64 * ((ks_) & 1) + 32 * hi) ^ fx[0])), "i"(((ks_) >> 1) * 8192), "i"(((ks_) >> 1) * 8192 + 16) : "memory"); \
            asm volatile("ds_read_b128 v[216:219], %1 offset:%c2\n\tds_read_b128 v[220:223], %1 offset:%c3" : "={v[216:223]}"(hb1) : "v"(ad1 + ((64 * ((ks_) & 1) + 32 * hi) ^ fx[1])), "i"(((ks_) >> 1) * 8192), "i"(((ks_) >> 1) * 8192 + 16) : "memory"); } while (0)
#define DN_MF(W_, ACC_, H_, REG_, WAIT_) asm volatile(WAIT_ "v_mfma_scale_f32_32x32x64_f8f6f4 %0, %1, %2, %0, %3, %3 op_sel_hi:[0,0,0]" : "+v"(ACC_) : "v"(W_), REG_(H_), "v"(sc1))
        DN_RDA(0);
#pragma unroll
        for (int ks = 0; ks < 4; ks += 2) {
            DN_RDB(ks + 1);
            DN_MF(wfr[0][ks], acc[0][0], ha0, "{v[192:199]}", "s_waitcnt lgkmcnt(4)\n\t"); DN_MF(wfr[1][ks], acc[0][1], ha0, "{v[192:199]}", "");
            DN_MF(wfr[0][ks], acc[1][0], ha1, "{v[200:207]}", ""); DN_MF(wfr[1][ks], acc[1][1], ha1, "{v[200:207]}", "");
            if (ks + 2 < 4) { DN_RDA(ks + 2);
                DN_MF(wfr[0][ks + 1], acc[0][0], hb0, "{v[208:215]}", "s_waitcnt lgkmcnt(4)\n\t"); }
            else { DN_MF(wfr[0][ks + 1], acc[0][0], hb0, "{v[208:215]}", "s_waitcnt lgkmcnt(0)\n\t"); }
            DN_MF(wfr[1][ks + 1], acc[0][1], hb0, "{v[208:215]}", "");
            DN_MF(wfr[0][ks + 1], acc[1][0], hb1, "{v[216:223]}", ""); DN_MF(wfr[1][ks + 1], acc[1][1], hb1, "{v[216:223]}", "");
        }
#undef DN_RDA
#undef DN_RDB
#undef DN_MF
        asm volatile("s_nop 15\n\ts_nop 7" : "+v"(acc[0][0]), "+v"(acc[0][1]), "+v"(acc[1][0]), "+v"(acc[1][1]) :: "memory");
        __builtin_amdgcn_sched_barrier(0);
        const int col0 = 512 * hf + 64 * wid + 16 * hi;
#pragma unroll
        for (int rt = 0; rt < 2; ++rt) { const bool ok = !NOTRAFFIC && mt[rt].x != 0xffffffffu; unsigned char* yd = ok ? Yp + (size_t)mt[rt].x * D : trash; const float w = ok ? __uint_as_float(mt[rt].y) * (1.f / (HSCALE8 * WSCALE8)) : 0.f;
#pragma unroll
            for (int nt = 0; nt < 2; ++nt) { u32x4 o;
#pragma unroll
                for (int q = 0; q < 4; ++q) { int v = __builtin_amdgcn_cvt_pk_fp8_f32(acc[rt][nt][4 * q] * w, acc[rt][nt][4 * q + 1] * w, 0, false);
                    v = __builtin_amdgcn_cvt_pk_fp8_f32(acc[rt][nt][4 * q + 2] * w, acc[rt][nt][4 * q + 3] * w, v, true); o[q] = (unsigned)v; }
                *(u32x4*)(yd + col0 + 32 * nt) = o; } }
      }
    }
    VM_WAIT(); LDS_WAIT(); __builtin_amdgcn_s_barrier();
#undef DN_DMA
#undef DN_DEC
}
}

namespace up {
__device__ __forceinline__ int nloc(int i) { return 16 * ((i >> 2) & 1) + (i & 3) + 4 * (i >> 3); }
__device__ __forceinline__ void up_phase(LAS unsigned char* lds, const bf16* QL, const bf16* KVL, const bf16* Wq, const bf16* Wkv, const float* ssqq, const float* ssqkv, const float* ropetab,
                                         bf16* Qo, bf16* KNo, bf16* VMo, int G, int c) {
    int tid = threadIdx.x; asm volatile("" : "+v"(tid));
    const int wid = __builtin_amdgcn_readfirstlane(tid >> 6), lane = tid & 63, j = lane & 31, hi = lane >> 5;
    for (int grp = c; grp < T / 64; grp += G) {
        const int row0 = grp * 64;
        { const int r_ = lane >> 3, p_ = lane & 7;
#pragma unroll
          for (int i = 0; i < 6; ++i) { const int q_ = wid * 6 + i;
              const bool isq = q_ < 32; const int rem = isq ? q_ : q_ - 32, kb = rem >> 3, g = rem & 7, f_ = (4 * (g & 1) + (r_ >> 1)) & 7;
              __builtin_amdgcn_global_load_lds((const unsigned*)((isq ? QL : KVL) + (size_t)(row0 + 8 * g + r_) * 256 + kb * 64 + ((p_ ^ f_) * 8)), (LAS unsigned*)(lds + (isq ? 0 : 32768) + kb * 8192 + g * 1024), 16, 0, 0); } }
        float rsq[2], rskv[2];
#pragma unroll
        for (int rt = 0; rt < 2; ++rt) { const int row = row0 + 32 * rt + j; const f32x4 a = *(const f32x4*)(ssqq + (size_t)row * 4), b4 = *(const f32x4*)(ssqkv + (size_t)row * 4);
            rsq[rt] = rsqrtf(((a[0] + a[1]) + (a[2] + a[3])) * (1.f / QLORA) + EPS) * C2M; rskv[rt] = rsqrtf(((b4[0] + b4[1]) + (b4[2] + b4[3])) * (1.f / KVLORA) + EPS); }
        const unsigned lane16 = (unsigned)lane * 16u;
        bf16x8 wA[16];
#define UP_LOADW(WB_, Wp_, col_, KS_) do { const char* wb_ = (const char*)(Wp_) + (size_t)__builtin_amdgcn_readfirstlane((col_) >> 5) * (KS_) * 1024;     \
            _Pragma("unroll") for (int ks = 0; ks < (KS_); ++ks) wA[(WB_) + ks] = *(const bf16x8*)(wb_ + ks * 1024 + lane16); } while (0)
#define UP_STEP(WB_, ISQ_, col_, KS_) do { f32x16 acc[2]; acc[0] = f32x16{}; acc[1] = f32x16{}; \
            _Pragma("unroll") for (int ks = 0; ks < (KS_); ++ks) { bf16x8 af[2]; \
                _Pragma("unroll") for (int rt = 0; rt < 2; ++rt) { const int row = 32 * rt + j, cc = 2 * (ks & 3) + hi; \
                    af[rt] = *(const LAS bf16x8*)(lds + ((ISQ_) ? 0 : 32768) + (ks >> 2) * 8192 + row * 128 + ((cc ^ ((row >> 1) & 7)) * 16)); } \
                _Pragma("unroll") for (int rt = 0; rt < 2; ++rt) acc[rt] = __builtin_amdgcn_mfma_f32_32x32x16_bf16(wA[(WB_) + ks], af[rt], acc[rt], 0, 0, 0); } \
            _Pragma("unroll") for (int rt = 0; rt < 2; ++rt) { const int row = row0 + 32 * rt + j; const float r_s = (ISQ_) ? rsq[rt] : rskv[rt]; const int col = (col_) + 16 * hi; \
                float v[16]; _Pragma("unroll") for (int r = 0; r < 16; ++r) v[r] = acc[rt][r] * r_s; \
                bf16* dst; \
                if (ISQ_) { const int jh = col % MQK; \
                    if (jh >= 64) { const int g0 = (jh - 64) >> 3; const f32x4* tb = (const f32x4*)(ropetab + ((size_t)row * 16 + 4 * g0) * 2); \
                        _Pragma("unroll") for (int gg = 0; gg < 2; ++gg) { const f32x4 t0 = tb[2 * gg], t1 = tb[2 * gg + 1]; float* w_ = v + 8 * gg; \
                            const float cs[4] = {t0[0], t0[2], t1[0], t1[2]}, sn[4] = {t0[1], t0[3], t1[1], t1[3]}; \
                            _Pragma("unroll") for (int q = 0; q < 4; ++q) { const float x1 = w_[q], x2 = w_[4 + q]; w_[q] = x1 * cs[q] - x2 * sn[q]; w_[4 + q] = x2 * cs[q] + x1 * sn[q]; } } } \
                    dst = Qo + (size_t)row * 768 + col; } \
                else dst = (col >= 512 ? VMo + (col - 512) : KNo + col) + (size_t)row * 512; \
                *(u32x4*)dst = (u32x4){cvt_pk_bf16(v[0], v[1]), cvt_pk_bf16(v[2], v[3]), cvt_pk_bf16(v[4], v[5]), cvt_pk_bf16(v[6], v[7])}; \
                *(u32x4*)(dst + 8) = (u32x4){cvt_pk_bf16(v[8], v[9]), cvt_pk_bf16(v[10], v[11]), cvt_pk_bf16(v[12], v[13]), cvt_pk_bf16(v[14], v[15])}; } } while (0)
        const int cq = 96 * wid, ckv = 128 * wid;
#define UP_SB() __builtin_amdgcn_sched_barrier(0)
        UP_LOADW(0, Wq, cq, 16);
        VM_WAIT(); __syncthreads();
        UP_STEP(0, true, cq, 16);        UP_SB(); UP_LOADW(0, Wq, cq + 32, 16); UP_SB();
        UP_STEP(0, true, cq + 32, 16);   UP_SB(); UP_LOADW(0, Wq, cq + 64, 16); UP_SB();
        UP_STEP(0, true, cq + 64, 16);   UP_SB(); UP_LOADW(0, Wkv, ckv, 8); UP_LOADW(8, Wkv, ckv + 32, 8); UP_SB();
        UP_STEP(0, false, ckv, 8);       UP_SB(); UP_LOADW(0, Wkv, ckv + 64, 8); UP_SB();
        UP_STEP(8, false, ckv + 32, 8);  UP_SB(); UP_LOADW(8, Wkv, ckv + 96, 8); UP_SB();
        UP_STEP(0, false, ckv + 64, 8);  UP_SB();
        UP_STEP(8, false, ckv + 96, 8);
#undef UP_SB
#undef UP_LOADW
#undef UP_STEP
        __syncthreads();
    }
}
}

#define XB_TMO      128
#define XB_XCNT(j)  (256  + 64 * (j))
#define XB_XSUB(j)  (1280 + 64 * (j))
#define XB_XGEN(j)  (2304 + 64 * (j))
#define XB_TOP      3328
#define XB_TOPGEN   3392
#define XCD_BAR_WORDS 3456
#define XB_SPIN_CAP (1u << 18)
__device__ __forceinline__ unsigned xb_ld(unsigned* p)              { return __hip_atomic_load(p, __ATOMIC_RELAXED, __HIP_MEMORY_SCOPE_AGENT); }
__device__ __forceinline__ unsigned xb_add(unsigned* p, unsigned v) { return __hip_atomic_fetch_add(p, v, __ATOMIC_RELAXED, __HIP_MEMORY_SCOPE_AGENT); }
__device__ __forceinline__ unsigned xb_xcc_id() { return (unsigned)__builtin_amdgcn_s_getreg((3 << 11) | 20) & 0xFu; }
#define XB_SPIN(cond, bar) do { unsigned _sp = 0; while (cond) { __builtin_amdgcn_s_sleep(1); \
    if ((++_sp & 255u) == 0u) { if (xb_ld(&(bar)[XB_TMO])) break; if (_sp > XB_SPIN_CAP) { atomicAdd(&(bar)[XB_TMO], 1u); break; } } } } while (0)
struct XcdBarrier { unsigned* bar; unsigned x; volatile LAS unsigned* st; };
__device__ __forceinline__ XcdBarrier xcd_barrier_post(unsigned* bar, volatile LAS unsigned* st) {
    XcdBarrier b; b.bar = bar; b.x = xb_xcc_id(); b.st = st;
    if (threadIdx.x == 0) (void)xb_add(&bar[XB_XCNT(b.x)], 1u);
    return b;
}
__device__ __forceinline__ void xcd_barrier_complete(unsigned* bar, unsigned x, unsigned& nloc, unsigned& nx) {
    const unsigned G = gridDim.x * gridDim.y * gridDim.z;
    unsigned sum, cnt, mine, sp = 0u;
    for (;;) {
        sum = 0u; cnt = 0u; mine = 0u;
#pragma unroll
        for (unsigned j = 0; j < 16; ++j) { const unsigned c = xb_ld(&bar[XB_XCNT(j)]); sum += c; cnt += (c > 0u) ? 1u : 0u; mine = (j == x) ? c : mine; }
        if (sum == G) break;
        __builtin_amdgcn_s_sleep(1);
        if ((++sp & 255u) == 0u) { if (xb_ld(&bar[XB_TMO])) break; if (sp > XB_SPIN_CAP) { atomicAdd(&bar[XB_TMO], 1u); break; } }
    }
    nloc = mine > 0u ? mine : 1u; nx = cnt > 0u ? cnt : 1u;
}
__device__ __forceinline__ void xcd_barrier(const XcdBarrier& b) {
    asm volatile("s_waitcnt vmcnt(0)" ::: "memory");
    __syncthreads();
    if (threadIdx.x == 0) {
        unsigned* bar = b.bar;
        __builtin_amdgcn_s_waitcnt(0);
        unsigned nloc = b.st[0], nx = b.st[1];
        if (nloc == 0u) { xcd_barrier_complete(bar, b.x, nloc, nx); b.st[0] = nloc; b.st[1] = nx; }
        const unsigned old = xb_add(&bar[XB_XSUB(b.x)], 1u);
        const unsigned gen = old / nloc;
        if (old + 1u == (gen + 1u) * nloc) {
            __builtin_amdgcn_fence(__ATOMIC_RELEASE, "agent");
            asm volatile("s_waitcnt vmcnt(0)" ::: "memory");
            const unsigned og = xb_add(&bar[XB_TOP], 1u);
            const unsigned tg = og / nx;
            if (og + 1u == (tg + 1u) * nx) xb_add(&bar[XB_TOPGEN], 1u);
            else XB_SPIN(xb_ld(&bar[XB_TOPGEN]) == tg, bar);
            __builtin_amdgcn_fence(__ATOMIC_ACQUIRE, "agent");
            xb_add(&bar[XB_XGEN(b.x)], 1u);
            asm volatile("s_waitcnt vmcnt(0)" ::: "memory");
        } else {
            XB_SPIN(xb_ld(&bar[XB_XGEN(b.x)]) == gen, bar);
            __builtin_amdgcn_fence(__ATOMIC_ACQUIRE, "agent");
            asm volatile("s_waitcnt vmcnt(0)" ::: "memory");
        }
    }
    __syncthreads();
}

struct Args { const void* in[25]; float* out; unsigned char* ws; int ph_lo, ph_hi; };

struct Frame {
    LAS unsigned char* lds;
    int tid, lane, wave, vcu, G;
};

template <class ColFn>
__device__ __forceinline__ void cvt_item(int ldw, int Ksrc, const float* kscale, bf16* WT, int Kd, LAS float* scr, int kb, int nb, int lane, ColFn colp) {
    const int k0 = 64 * kb, n0 = 32 * nb;
    const float* cp = colp(n0 + (lane & 31));
    float vv[32], sv[32];
#pragma unroll
    for (int i = 0; i < 32; ++i) { const int k = k0 + 2 * i + (lane >> 5);
        vv[i] = (cp != nullptr && k < Ksrc) ? cp[(size_t)k * ldw] : 0.f;
        sv[i] = (kscale != nullptr && k < Ksrc) ? kscale[k] : 1.f; }
#pragma unroll
    for (int i = 0; i < 32; ++i) scr[(2 * i + (lane >> 5)) * 33 + (lane & 31)] = vv[i] * sv[i];
    LDS_WAIT(); asm volatile("" ::: "memory");
    const int c = lane & 7;
#pragma unroll
    for (int j = 0; j < 4; ++j) { const int n = (lane >> 3) + 8 * j; const LAS float* s = scr + (8 * c) * 33 + n;
        u32x4 o; o.x = pk2(s[0 * 33], s[1 * 33]); o.y = pk2(s[2 * 33], s[3 * 33]); o.z = pk2(s[4 * 33], s[5 * 33]); o.w = pk2(s[6 * 33], s[7 * 33]);
        *(u32x4*)(WT + (size_t)(n0 + n) * Kd + k0 + 8 * c) = o; }
    LDS_WAIT(); asm volatile("" ::: "memory");
}
__device__ __forceinline__ void cvt64_item(const float* src, int ldw, bf16* dst, int Kd, LAS unsigned char* scr, int lane) {
    f32x4 v[16];
    const float* sp = src + (size_t)(lane >> 4) * ldw + 4 * (lane & 15);
#pragma unroll
    for (int i = 0; i < 16; ++i) v[i] = __builtin_nontemporal_load((const f32x4*)(sp + (size_t)(4 * i) * ldw));
#pragma unroll
    for (int i = 0; i < 16; ++i) { const int k = 4 * i + (lane >> 4);
#pragma unroll
        for (int q = 0; q < 4; ++q) { const int n = 4 * (lane & 15) + q; *(LAS bf16*)(scr + n * 128 + (((k >> 3) ^ ((n >> 2) & 7)) << 4) + (k & 7) * 2) = (bf16)f2bf(v[i][q]); } }
    LDS_WAIT(); asm volatile("" ::: "memory");
#pragma unroll
    for (int j = 0; j < 8; ++j) { const int p = j * 64 + lane, n = p >> 3, c = p & 7;
        const u32x4 o = *(const LAS u32x4*)(scr + n * 128 + ((c ^ ((n >> 2) & 7)) << 4));
        __builtin_nontemporal_store(o, (u32x4*)(dst + (size_t)n * Kd + c * 8)); }
    LDS_WAIT(); asm volatile("" ::: "memory");
}
__device__ __forceinline__ void cvt64_item8(const float* src, int ldw, unsigned char* dst, int Kd8, LAS unsigned char* scr, int lane, float scale) {
    f32x4 v[16];
    const float* sp = src + (size_t)(16 * (lane >> 4)) * ldw + 4 * (lane & 15);
#pragma unroll
    for (int i = 0; i < 16; ++i) v[i] = __builtin_nontemporal_load((const f32x4*)(sp + (size_t)i * ldw));
#pragma unroll
    for (int q = 0; q < 4; ++q) { u32x4 o;
#pragma unroll
        for (int g = 0; g < 4; ++g) { int p_ = __builtin_amdgcn_cvt_pk_fp8_f32(v[4 * g][q] * scale, v[4 * g + 1][q] * scale, 0, false); p_ = __builtin_amdgcn_cvt_pk_fp8_f32(v[4 * g + 2][q] * scale, v[4 * g + 3][q] * scale, p_, true); o[g] = (unsigned)p_; }
        *(LAS u32x4*)(scr + (4 * (lane & 15) + q) * 80 + (lane >> 4) * 16) = o; }
    LDS_WAIT(); asm volatile("" ::: "memory");
#pragma unroll
    for (int j = 0; j < 4; ++j) { const int p = j * 64 + lane, n = p >> 2, c = p & 3;
        const u32x4 o = *(const LAS u32x4*)(scr + n * 80 + c * 16);
        __builtin_nontemporal_store(o, (u32x4*)(dst + (size_t)n * Kd8 + c * 16)); }
    LDS_WAIT(); asm volatile("" ::: "memory");
}
__device__ __forceinline__ void cvt128_item8(const float* src, int ldw, unsigned char* dst, int Kd8, LAS unsigned char* scr, int lane, float scale) {
    f32x4 v[32];
    const float* sp = src + (size_t)(32 * (lane >> 4)) * ldw + 4 * (lane & 15);
#pragma unroll
    for (int i = 0; i < 32; ++i) v[i] = __builtin_nontemporal_load((const f32x4*)(sp + (size_t)i * ldw));
#pragma unroll
    for (int q = 0; q < 4; ++q) {
#pragma unroll
        for (int hf = 0; hf < 2; ++hf) { u32x4 o;
#pragma unroll
            for (int g = 0; g < 4; ++g) { const int i0 = 16 * hf + 4 * g; int p_ = __builtin_amdgcn_cvt_pk_fp8_f32(v[i0][q] * scale, v[i0 + 1][q] * scale, 0, false); p_ = __builtin_amdgcn_cvt_pk_fp8_f32(v[i0 + 2][q] * scale, v[i0 + 3][q] * scale, p_, true); o[g] = (unsigned)p_; }
            *(LAS u32x4*)(scr + (4 * (lane & 15) + q) * 144 + (lane >> 4) * 32 + 16 * hf) = o; } }
    LDS_WAIT(); asm volatile("" ::: "memory");
#pragma unroll
    for (int j = 0; j < 8; ++j) { const int p = j * 64 + lane, n = p >> 3, c = p & 7;
        const u32x4 o = *(const LAS u32x4*)(scr + n * 144 + c * 16);
        __builtin_nontemporal_store(o, (u32x4*)(dst + (size_t)n * Kd8 + c * 16)); }
    LDS_WAIT(); asm volatile("" ::: "memory");
}
__device__ __forceinline__ int ropedim(int jj) { const int g = jj >> 3, u = jj & 7; return (u < 4) ? 4 * g + u : 16 + 4 * g + (u - 4); }

__device__ __forceinline__ void sincos_acc(float af, float& sn, float& cs) {
    const double a = (double)af; const double kq = __builtin_rint(a * 0.63661977236758134308);
    const double r = (a - kq * 1.57079632679489655800) - kq * 6.123233995736766036e-17;
    const double r2 = r * r;
    const double sp = r * (1.0 + r2 * (-1.66666666666666324348e-01 + r2 * (8.33333333332248946124e-03 + r2 * (-1.98412698298579493134e-04 + r2 * (2.75573137070700676789e-06 + r2 * (-2.50507602534068634195e-08 + r2 * 1.58969099521155010221e-10))))));
    const double cp = 1.0 + r2 * (-0.5 + r2 * (4.16666666666666019037e-02 + r2 * (-1.38888888888741095749e-03 + r2 * (2.48015872894767294178e-05 + r2 * (-2.75573143513906633035e-07 + r2 * (2.08757232129817482790e-09 + r2 * -1.13596475577881948265e-11))))));
    const int q = (int)((long long)kq & 3);
    const double s_ = (q == 0) ? sp : (q == 1) ? cp : (q == 2) ? -sp : -cp;
    const double c_ = (q == 0) ? cp : (q == 1) ? -sp : (q == 2) ? -cp : sp;
    sn = (float)s_; cs = (float)c_;
}

__global__ void __launch_bounds__(NWAVES * 64, 2) fwd(Args args) {
    extern __shared__ __attribute__((aligned(16))) unsigned char lds_raw[];
    Frame F;
    F.lds = (LAS unsigned char*)lds_raw;
    F.tid = threadIdx.x; F.lane = F.tid & 63; F.wave = __builtin_amdgcn_readfirstlane(F.tid >> 6);
    F.G = gridDim.x; { const int bx = blockIdx.x; F.vcu = (F.G % 8 == 0) ? (bx % 8) * (F.G / 8) + bx / 8 : bx; }
    volatile LAS unsigned* MISC = (volatile LAS unsigned*)(F.lds + MISC_OFF);
    unsigned char* ws = args.ws;
    gu32* ctl = (gu32*)(ws + WS_CTL);
#define X_IN ((const float*)AP->in[0])
#define cvec ((const float*)AP->in[1])
#define positions ((const int*)AP->in[2])
#define w_mod ((const float*)AP->in[3])
#define b_mod ((const float*)AP->in[4])
#define g_mix ((const float*)AP->in[5])
#define w_in ((const float*)AP->in[6])
#define b_forget ((const float*)AP->in[7])
#define g_q_lat ((const float*)AP->in[8])
#define w_q_up ((const float*)AP->in[9])
#define g_kv_lat ((const float*)AP->in[10])
#define w_kv_up ((const float*)AP->in[11])
#define w_o_mla ((const float*)AP->in[12])
#define w_o_fox ((const float*)AP->in[13])
#define w_out ((const float*)AP->in[14])
#define g_ffn ((const float*)AP->in[15])
#define w_router ((const float*)AP->in[16])
#define b_router ((const float*)AP->in[17])
#define w_exp_gate ((const float*)AP->in[18])
#define w_exp_up ((const float*)AP->in[19])
#define w_exp_down ((const float*)AP->in[20])
#define w_sh_gate ((const float*)AP->in[21])
#define w_sh_up ((const float*)AP->in[22])
#define w_sh_down ((const float*)AP->in[23])
#define g_final ((const float*)AP->in[24])
#define Win_t ((bf16*)(ws + WS_WIN))
#define Wq_t ((bf16*)(ws + WS_WQ))
#define Wkv_t ((bf16*)(ws + WS_WKV))
#define Wom_t ((bf16*)(ws + WS_WOM))
#define Wof_t ((bf16*)(ws + WS_WOF))
#define Wout_t ((bf16*)(ws + WS_WOUT))
#define Wsgu_t ((bf16*)(ws + WS_WSGU))
#define Wsd_t ((bf16*)(ws + WS_WSD))
#define Wr_f ((bf16*)(ws + WS_WR))
#define mod ((float*)(ws + WS_MOD))
#define Wd_t ((bf16*)(ws + WS_WD))
#define Wgu_t ((bf16*)(ws + WS_WGU))
#define HB ((bf16*)(ws + WS_HB))
#define FQ ((bf16*)(ws + WS_FQ))
#define FK ((bf16*)(ws + WS_FK))
#define FV ((bf16*)(ws + WS_FV))
#define QLAT ((bf16*)(ws + WS_QLAT))
#define KVLAT ((bf16*)(ws + WS_KVLAT))
#define OFOX ((bf16*)(ws + WS_OFOX))
#define OCAT ((bf16*)((unsigned char*)out + 32 * MiB))
#define OMLA ((bf16*)(ws + WS_OMLA))
#define Y ((bf16*)(ws + WS_Y))
#define H ((bf16*)(ws + WS_H))
#define QMLA ((bf16*)(ws + WS_QMLA))
#define GATES ((bf16*)(ws + WS_GATES))
#define KN ((bf16*)(ws + WS_KN))
#define VM ((bf16*)(ws + WS_VM))
#define KPE ((bf16*)(ws + WS_KPE))
#define MERGED ((bf16*)(ws + WS_MERGED))
#define LIST ((unsigned short*)(ws + WS_LIST))
#define Wgu8 ((unsigned char*)(ws + WS_WGU))
#define Wsgu8 ((unsigned char*)(ws + WS_WSGU))
#define H8 ((unsigned char*)(ws + WS_H))
#define META ((u32x2*)(ws + WS_WIN))
#define EIDX ((unsigned char*)(ws + WS_EIDX))
#define GATEW ((float*)(ws + WS_GATEW))
#define ROPETAB ((float*)((unsigned char*)out + DO_ROPE))
#define LOGF ((float*)((unsigned char*)out + DO_LOGF))
#define CUMF ((float*)((unsigned char*)out + DO_CUMF))
#define SSQQ ((float*)((unsigned char*)out + DO_SSQQ))
#define SSQKV ((float*)((unsigned char*)out + DO_SSQKV))
#define MODP ((float*)((unsigned char*)out + DO_MODP))
#define SSQ1 ((float*)(ws + WS_FQ))
    float* const out = args.out;
#define PHASE_ENV const __attribute__((address_space(4))) Args* AP; { auto kp_ = __builtin_amdgcn_kernarg_segment_ptr(); asm volatile("" : "+s"(kp_)); AP = (const __attribute__((address_space(4))) Args*)kp_; } \
    unsigned char* const ws = AP->ws; float* const out = AP->out; (void)ws; (void)out;
    for (int u = F.tid; u < (LDS_BYTES - LDSCTL_OFF) / 4; u += NWAVES * 64) ((LAS unsigned*)(F.lds + LDSCTL_OFF))[u] = 0u;
    __syncthreads();
    XcdBarrier bar; bar.bar = (unsigned*)(ctl + CW_BAR); bar.x = 0; bar.st = nullptr;
    if (MK_ONE_LAUNCH) bar = xcd_barrier_post((unsigned*)(ctl + CW_BAR), MISC + 8);
    const int lo = args.ph_lo, hi = args.ph_hi;
#define IN(k) (lo <= (k) && (k) < hi)
#define BOTH(k) (IN(k) && IN((k) + 1))
#define GRID_BAR() do { if (MK_ONE_LAUNCH) xcd_barrier(bar); } while (0)
#define DUP_BAR() do { if (dummy) xcd_barrier(bar); } while (0)
    const int gw = F.vcu * NWAVES + F.wave, NGW = F.G * NWAVES;

    for (int rep = 0; rep < ((PROBE_DUP == 0) ? 2 : 1); ++rep) if (IN(0)) { PHASE_ENV const bool dummy = (PROBE_DUP == 0) && rep == 0; (void)dummy;
        if (!(dummy && (PROBE_VAR == 1 || PROBE_VAR == 4 || PROBE_VAR == 5))) {
            LAS float* cond = (LAS float*)F.lds;
            for (int i = F.tid; i < NB * D; i += NWAVES * 64) { const float c = cvec[i]; cond[i] = c / (1.f + __expf(-c)); }
            __syncthreads();
            for (int it = F.wave * F.G + F.vcu; it < 96 * 16; it += NWAVES * F.G) { const int cg = it % 96, kq = it / 96, col = cg * 64 + F.lane;
                float a4[4] = {0.f, 0.f, 0.f, 0.f};
                const float* wp = w_mod + (size_t)(64 * kq) * (6 * D) + col;
                float wv[64];
#pragma unroll
                for (int kk = 0; kk < 64; ++kk) wv[kk] = __builtin_nontemporal_load(wp + (size_t)kk * (6 * D));
#pragma unroll
                for (int kk = 0; kk < 64; ++kk) {
#pragma unroll
                    for (int b = 0; b < 4; ++b) a4[b] += wv[kk] * cond[b * D + 64 * kq + kk]; }
#pragma unroll
                for (int b = 0; b < 4; ++b) MODP[((size_t)kq * 4 + b) * (6 * D) + col] = a4[b]; }
            __syncthreads();
        }
        if (!(dummy && (PROBE_VAR == 1 || PROBE_VAR == 3 || PROBE_VAR == 5))) for (int i = gw * 64 + F.lane; i < T * 16; i += NGW * 64) { const int t = i >> 4, j = i & 15;
            const float invf = (((j >> 2) == 0) ? 1.f : ((j >> 2) == 1) ? 0.1f : ((j >> 2) == 2) ? 0.01f : 0.001f) * (((j & 3) == 0) ? 1.f : ((j & 3) == 1) ? 0.5623413251903491f : ((j & 3) == 2) ? 0.31622776601683794f : 0.17782794100389228f);
            const float ang = (float)positions[t] * invf; float sn, cs; sincos_acc(ang, sn, cs);
            *(f32x2*)(ROPETAB + (size_t)i * 2) = (f32x2){cs, sn}; }
        for (int o = gw * 64 + F.lane; o < NEXP * D; o += NGW * 64) { const int piece = o >> 3, kk = o & 7, ln = piece & 63, grp = piece >> 6, ntl = grp & 3, j = grp >> 2;
            const int n = ntl * 16 + (ln & 15), k = j * 32 + (ln >> 4) * 8 + kk; Wr_f[o] = (bf16)f2bf(w_router[(size_t)k * NEXP + n]); }
        {
            LAS unsigned char* scr8 = F.lds + 32768 + F.wave * 9216;
            constexpr int F_IN = 62 * 16;
            if (!(dummy && PROBE_VAR >= 2)) for (int it = gw; it < F_IN; it += NGW) {
                int nb = it % 62; const int kb = it / 62; if (nb >= 6) nb += 2; const int n0 = 64 * nb;
                const int src = (n0 < 384) ? n0 : (n0 < 2048) ? 416 + (n0 - 512) : 1960 + (n0 - 2048);
                cvt64_item(w_in + (size_t)(64 * kb) * 4008 + src, 4008, Win_t + (size_t)n0 * D + 64 * kb, D, scr8, F.lane);
            }
            LAS float* scr = (LAS float*)(F.lds + 32768 + F.wave * 9216);
            constexpr int I_INS = 4 * (D / 64), NSLOW = I_INS;
            if (!(dummy && (PROBE_VAR == 1 || PROBE_VAR == 3 || PROBE_VAR == 4))) for (int it = F.wave * F.G + F.vcu; it < NSLOW; it += NGW) {
                const int nb = 12 + (it & 3), kb = it >> 2;
                cvt_item(4008, D, nullptr, Win_t, D, scr, kb, nb, F.lane, [&](int n) -> const float* {
                    int src; if (n < 416) src = 384 + ropedim(n - 384); else if (n < 424) src = 1952 + (n - 416); else src = -1;
                    return src < 0 ? nullptr : w_in + src; });
            }
            if (!(dummy && (PROBE_VAR == 1 || PROBE_VAR == 3 || PROBE_VAR == 4))) {
                for (int o = gw * 64 + F.lane; o < 768 * QLORA; o += NGW * 64) { const int cb = o >> 13, rem = o & 8191, ks = rem >> 9, ln = (rem >> 3) & 63, e = rem & 7;
                    const int n = cb * 32 + up::nloc(ln & 31), k = 16 * ks + 8 * (ln >> 5) + e, hh = n / MQK, jj = n % MQK, sc = hh * MQK + (jj < 64 ? jj : 64 + ropedim(jj - 64));
                    Wq_t[o] = (bf16)f2bf(w_q_up[(size_t)k * 768 + sc] * g_q_lat[k]); }
                for (int o = gw * 64 + F.lane; o < 1024 * KVLORA; o += NGW * 64) { const int cb = o >> 12, rem = o & 4095, ks = rem >> 9, ln = (rem >> 3) & 63, e = rem & 7;
                    const int n = cb * 32 + up::nloc(ln & 31), k = 16 * ks + 8 * (ln >> 5) + e, sc = (n < 512) ? (n >> 6) * 128 + (n & 63) : ((n - 512) >> 6) * 128 + 64 + (n & 63);
                    Wkv_t[o] = (bf16)f2bf(w_kv_up[(size_t)k * 1024 + sc] * g_kv_lat[k]); }
            }
        }
        if (BOTH(0)) GRID_BAR();
    }

    for (int rep = 0; rep < ((PROBE_DUP == 1) ? 2 : 1); ++rep) if (IN(1)) { PHASE_ENV const bool dummy = (PROBE_DUP == 1) && rep == 0; (void)dummy;
        if (F.vcu < 48) { const int idx = F.vcu * 512 + F.tid, b = idx / (6 * D), col = idx % (6 * D); float sm = b_mod[col];
#pragma unroll
            for (int p = 0; p < 16; ++p) sm += MODP[((size_t)p * 4 + b) * (6 * D) + col];
            mod[idx] = sm; }
        LAS float* vg1 = (LAS float*)F.lds; LAS float* vs1 = (LAS float*)(F.lds + 4096);
        for (int grp = F.vcu; grp < T / 64; grp += F.G) {
            const int b = (grp * 64) / SEQ;
            __syncthreads();
            for (int k = F.tid; k < D; k += NWAVES * 64) { float s0 = b_mod[k], s1 = b_mod[D + k];
#pragma unroll
                for (int p = 0; p < 16; ++p) { s0 += MODP[((size_t)p * 4 + b) * (6 * D) + k]; s1 += MODP[((size_t)p * 4 + b) * (6 * D) + D + k]; }
                vs1[k] = s0; vg1[k] = g_mix[k] * (1.f + s1); }
            __syncthreads();
#pragma unroll 2
            for (int rr = 0; rr < 8; ++rr) { const int m = grp * 64 + F.wave * 8 + rr;
                const f32x4* xr = (const f32x4*)(X_IN + (size_t)m * D) + F.lane;
                f32x4 v[4]; float s = 0.f;
#pragma unroll
                for (int j = 0; j < 4; ++j) { v[j] = __builtin_nontemporal_load(xr + 64 * j); s += (v[j].x * v[j].x + v[j].y * v[j].y) + (v[j].z * v[j].z + v[j].w * v[j].w); }
                const float rstd = rsqrtf(wave_sum(s) * (1.f / D) + EPS);
                unsigned long long* o8 = (unsigned long long*)(H + (size_t)m * D) + F.lane;
#pragma unroll
                for (int j = 0; j < 4; ++j) { const int c = 4 * F.lane + 256 * j;
                    const f32x4 g = *(const LAS f32x4*)(vg1 + c), d = *(const LAS f32x4*)(vs1 + c);
                    const f32x4 r = v[j] * rstd * g + d;
                    o8[64 * j] = (unsigned long long)pk2(r.x, r.y) | ((unsigned long long)pk2(r.z, r.w) << 32); } }
        }
        if (BOTH(1)) GRID_BAR();
    }

    for (int rep = 0; rep < ((PROBE_DUP == 2) ? 2 : 1); ++rep) if (IN(2)) { PHASE_ENV const bool dummy = (PROBE_DUP == 2) && rep == 0; (void)dummy;
        pg8::StaticOrder S; S.init(H, Win_t, T, NIN, D, F.G, (int)blockIdx.x);
        EpiInProj E{QLAT, KVLAT, KPE, FQ, GATES, LOGF, SSQQ, SSQKV, ROPETAB, b_forget, dummy && (PROBE_VAR == 1), (dummy && PROBE_VAR == 2) ? 0 : (dummy && PROBE_VAR == 3) ? 2 : 1};
        pg8::gemm_phase<EpiInProj, pg8::StaticOrder, true>(F.lds, S, E);
        if (BOTH(2)) GRID_BAR();
    }

    for (int rep = 0; rep < ((PROBE_DUP == 3) ? 2 : 1); ++rep) if (IN(3)) { PHASE_ENV const bool dummy = (PROBE_DUP == 3) && rep == 0; (void)dummy;
        if (!(dummy && (PROBE_VAR == 2 || PROBE_VAR == 3))) {
            const int bb = F.vcu & 3; float mx = 0.f, mq = 0.f;
            for (int r = (F.vcu >> 2) * NWAVES + F.wave; r < SEQ; r += (F.G >> 2) * NWAVES) { f32x4 k0, k1, q0v, q1v; unpack8(*(const u32x4*)(FK + ((size_t)bb * SEQ + r) * 512 + 8 * F.lane), k0, k1);
                unpack8(*(const u32x4*)(FQ + ((size_t)bb * SEQ + r) * 512 + 8 * F.lane), q0v, q1v);
                float sq = (k0[0] * k0[0] + k0[1] * k0[1]) + (k0[2] * k0[2] + k0[3] * k0[3]) + (k1[0] * k1[0] + k1[1] * k1[1]) + (k1[2] * k1[2] + k1[3] * k1[3]);
                float sqq = (q0v[0] * q0v[0] + q0v[1] * q0v[1]) + (q0v[2] * q0v[2] + q0v[3] * q0v[3]) + (q1v[0] * q1v[0] + q1v[1] * q1v[1]) + (q1v[2] * q1v[2] + q1v[3] * q1v[3]);
                sq += dppf<0xB1>(sq); sq += dppf<0x4E>(sq); sq += dppf<0x141>(sq);
                sqq += dppf<0xB1>(sqq); sqq += dppf<0x4E>(sqq); sqq += dppf<0x141>(sqq);
                mx = fmaxf(mx, sq); mq = fmaxf(mq, sqq); }
            LAS float* kml = (LAS float*)F.lds;
            if ((F.lane & 7) == 0) { kml[F.wave * 8 + (F.lane >> 3)] = mx; kml[64 + F.wave * 8 + (F.lane >> 3)] = mq; }
            __syncthreads();
            if (F.tid < 2 * NHEAD) { const int hh = F.tid & 7, qk = F.tid >> 3; float m2 = 0.f;
#pragma unroll
                for (int w = 0; w < NWAVES; ++w) m2 = fmaxf(m2, kml[qk * 64 + w * 8 + hh]);
                atomicMax((unsigned*)(ctl + CW_KM + qk * 32 + bb * NHEAD + hh), __float_as_uint(m2)); }
            __syncthreads();
        }
        if (F.vcu < NB * NHEAD && !(dummy && (PROBE_VAR == 1 || PROBE_VAR == 3))) {
            const int b = F.vcu >> 3, h = F.vcu & 7; const float* src = LOGF + ((size_t)b * SEQ + 8 * F.tid) * 8 + h;
            float v[8]; float run = 0.f;
#pragma unroll
            for (int i = 0; i < 8; ++i) v[i] = src[i * 8];
#pragma unroll
            for (int i = 0; i < 8; ++i) { run += v[i]; v[i] = run; }
            float incl = run;
#pragma unroll
            for (int o = 1; o < 64; o <<= 1) { const float n = __shfl_up(incl, o); if (F.lane >= o) incl += n; }
            LAS float* wt = (LAS float*)F.lds;
            if (F.lane == 63) wt[F.wave] = incl;
            __syncthreads();
            float woff = 0.f;
#pragma unroll
            for (int w = 0; w < NWAVES; ++w) woff += (w < F.wave) ? wt[w] : 0.f;
            const float excl = woff + incl - run;
            float* dst = CUMF + ((size_t)b * NHEAD + h) * SEQ + 8 * F.tid;
            *(f32x4*)dst = (f32x4){v[0] + excl, v[1] + excl, v[2] + excl, v[3] + excl}; *(f32x4*)(dst + 4) = (f32x4){v[4] + excl, v[5] + excl, v[6] + excl, v[7] + excl};
            __syncthreads();
        }
        if (!(dummy && (PROBE_VAR == 1 || PROBE_VAR == 2))) up::up_phase(F.lds, QLAT, KVLAT, Wq_t, Wkv_t, SSQQ, SSQKV, ROPETAB, QMLA, KN, VM, F.G, (int)blockIdx.x);
        if (BOTH(3)) GRID_BAR();
    }

    for (int rep = 0; rep < ((PROBE_DUP == 4) ? 2 : 1); ++rep) if (IN(4)) { PHASE_ENV const bool dummy = (PROBE_DUP == 4) && rep == 0; (void)dummy;
        {
            const bool xq = (F.G % 8) == 0; const int x = xq ? (int)(blockIdx.x & 7) : 0, nunits = xq ? 128 : 1024;
            constexpr int F_O = 16 * 4, F_OUT = 16 * 8, F_SGU = 8 * 8, F_SD = 16 * 2, F_EGU = NEXP * F_SGU, F_ED = NEXP * F_SD;
            constexpr int NCONV = F_EGU + F_ED + 2 * F_O + F_OUT + F_SGU + F_SD, NCBATCH = (NCONV + 31) / 32;
            const int NQ = xq ? 8 : 1, ncb = (NCBATCH - x + NQ - 1) / NQ, A0 = xq ? CONV_A0 : 8 * CONV_A0;
            gu32* qh = ctl + CW_Q + 64 * x + (dummy ? 16 : 0);
            volatile LAS unsigned* qw = (volatile LAS unsigned*)(F.lds + MISC_OFF + 64);
            for (int nit = 0;; ++nit) {
                if (F.tid == 0) qw[nit & 1] = __hip_atomic_fetch_add(qh, 1u, RLX_AGENT);
                __syncthreads();
                int r = __builtin_amdgcn_readfirstlane((int)qw[nit & 1]);
                if (r >= nunits + ncb) break;
                if (r >= A0 && r < A0 + ncb) { const int cb = x + NQ * (r - A0);
                    LAS unsigned char* scr8 = F.lds + 32768 + F.wave * 9216;
                    int ln_ = F.lane; asm volatile("" : "+v"(ln_));
                    for (int kr = 0; kr < 4; ++kr) { int it = 32 * cb + 8 * kr + F.wave; if (it >= NCONV) break;
                        const float* src; unsigned char* dst; int ldw, kd8;
                        if (it < F_EGU) { const int e = it / F_SGU, rr = it % F_SGU, nb = rr & 7, kb = rr >> 3, pn = nb >> 2, c0 = (nb & 3) * 64;
                            src = ((c0 < 128) ? w_exp_gate : w_exp_up) + (size_t)e * D * DEXP + pn * 128 + (c0 & 127) + (size_t)(128 * kb) * DEXP; ldw = DEXP;
                            dst = Wgu8 + (size_t)e * 512 * D + (size_t)(64 * nb) * D + 128 * kb; kd8 = D; }
                        else if ((it -= F_EGU) < F_ED) { const int e = it / F_SD, rr = it % F_SD, nb = rr & 15, kb = rr >> 4;
                            src = w_exp_down + (size_t)e * DEXP * D + (size_t)(128 * kb) * D + 64 * nb; ldw = D; dst = (unsigned char*)Wd_t + (size_t)e * D * DEXP + (size_t)(64 * nb) * DEXP + 128 * kb; kd8 = DEXP; }
                        else if ((it -= F_ED) < 2 * F_O) { const int fx = it >= F_O, i2 = it - (fx ? F_O : 0), nb = i2 & 15, kb = i2 >> 4;
                            src = (fx ? w_o_fox : w_o_mla) + (size_t)(128 * kb) * D + 64 * nb; ldw = D; dst = (unsigned char*)Wom_t + (size_t)(64 * nb) * D + (fx ? 512 : 0) + 128 * kb; kd8 = D; }
                        else if ((it -= 2 * F_O) < F_OUT) { const int nb = it & 15, kb = it >> 4; src = w_out + (size_t)(128 * kb) * D + 64 * nb; ldw = D; dst = (unsigned char*)Wout_t + (size_t)(64 * nb) * D + 128 * kb; kd8 = D; }
                        else if ((it -= F_OUT) < F_SGU) { const int nb = it >> 3, kb = it & 7, pn = nb >> 2, c0 = (nb & 3) * 64;
                            src = ((c0 < 128) ? w_sh_gate : w_sh_up) + pn * 128 + (c0 & 127) + (size_t)(128 * kb) * DEXP; ldw = DEXP; dst = Wsgu8 + (size_t)(64 * nb) * D + 128 * kb; kd8 = D; }
                        else { it -= F_SGU; const int nb = it >> 1, kb = it & 1; src = w_sh_down + (size_t)(128 * kb) * D + 64 * nb; ldw = D; dst = (unsigned char*)Wsd_t + (size_t)(64 * nb) * DEXP + 128 * kb; kd8 = DEXP; }
                        cvt128_item8(src, ldw, dst, kd8, scr8, ln_, WSCALE8);
                    }
                    continue; }
                if (r >= A0) r -= ncb;
                int qb, type, b, h;
                if (xq) { qb = 15 - (r >> 3); type = (r >> 2) & 1; b = r & 3; h = (x + 3 * b) & 7; }
                else { qb = 15 - (r >> 6); type = (r >> 5) & 1; b = (r >> 3) & 3; h = r & 7; }
                if (type == 0) { if (ATT_TUNED_FOX && qb != 0) att::attn_unit_t<64, true, 8>(b, h, qb, FQ, 512, FK, KPE, FV, CUMF, __uint_as_float(__hip_atomic_load((unsigned*)(ctl + CW_KM + b * NHEAD + h), RLX_AGENT)) * __uint_as_float(__hip_atomic_load((unsigned*)(ctl + CW_KM + 32 + b * NHEAD + h), RLX_AGENT)), (bf16*)((unsigned char*)(dummy ? (bf16*)((unsigned char*)out + 4 * MiB) : OCAT) + 512), D, F.lds);
                                 else att::attn_unit<64, true, 8>(b, h, qb, FQ, 512, FK, KPE, FV, CUMF, (bf16*)((unsigned char*)(dummy ? (bf16*)((unsigned char*)out + 4 * MiB) : OCAT) + 512), D, F.lds); }
                else { if (ATT_TUNED_MLA && qb != 0) att::attn_unit_t<96, false, 8>(b, h, qb, QMLA, 768, KN, KPE, VM, nullptr, 0.f, dummy ? (bf16*)((unsigned char*)out + 4 * MiB) : OCAT, D, F.lds);
                       else att::attn_unit<96, false, 8>(b, h, qb, QMLA, 768, KN, KPE, VM, nullptr, dummy ? (bf16*)((unsigned char*)out + 4 * MiB) : OCAT, D, F.lds); }
            }
        }
        if (BOTH(4)) GRID_BAR();
    }

    for (int rep = 0; rep < ((PROBE_DUP == 5) ? 2 : 1); ++rep) if (IN(5)) { PHASE_ENV const bool dummy = (PROBE_DUP == 5) && rep == 0; (void)dummy;
        pg8::StaticOrder S; S.init(OCAT, Wom_t, T, D, D / 2, F.G, (int)blockIdx.x);
        EpiMergedCat E{GATES, (unsigned char*)MERGED, 1.f / WSCALE8};
        pg8::gemm_phase<EpiMergedCat, pg8::StaticOrder, true, true>(F.lds, S, E);
        if (BOTH(5)) GRID_BAR();
    }

    for (int rep = 0; rep < ((PROBE_DUP == 6) ? 2 : 1); ++rep) if (IN(6)) { PHASE_ENV const bool dummy = (PROBE_DUP == 6) && rep == 0; (void)dummy;
        pg8::StaticOrder S; S.init(MERGED, Wout_t, T, D, D / 2, F.G, (int)blockIdx.x);
        EpiOut E{X_IN, out, mod, SSQ1, 1.f / (OSCALE8 * WSCALE8)};
        pg8::gemm_phase<EpiOut, pg8::StaticOrder, true, true>(F.lds, S, E);
        if (BOTH(6)) GRID_BAR();
    }

    for (int rep = 0; rep < ((PROBE_DUP == 7) ? 2 : 1); ++rep) if (IN(7)) { PHASE_ENV const bool dummy = (PROBE_DUP == 7) && rep == 0; (void)dummy;
        LAS unsigned char* wrl = F.lds;
        LAS float* vg = (LAS float*)(F.lds + LDSCTL_OFF + 6144);
        LAS float* vs = (LAS float*)(F.lds + LDSCTL_OFF + 10240);
        LAS int* cntw = (LAS int*)(F.lds + 32768);
        LAS int* basel = (LAS int*)(F.lds + 32768 + 2048);
        static_assert(LDSCTL_OFF + 10240 + 4096 <= LDS_BYTES && MOETAB_OFF + 4700 <= LDSCTL_OFF + 6144, "P7 LDS map");
        const float my_bias = b_router[F.lane];
        for (int grp = F.vcu; grp < T / 64; grp += F.G) {
            const int b = (grp * 64) / SEQ;
            __syncthreads();
#pragma unroll
            for (int i = 0; i < 16; ++i) __builtin_amdgcn_global_load_lds((const unsigned*)((const char*)Wr_f + (F.wave * 16 + i) * 1024 + F.lane * 16), (LAS unsigned*)(wrl + (F.wave * 16 + i) * 1024), 16, 0, 0);
            for (int i = F.tid; i < D; i += NWAVES * 64) { vg[i] = g_ffn[i] * (1.f + mod[(size_t)b * 6 * D + 4 * D + i]); vs[i] = mod[(size_t)b * 6 * D + 3 * D + i]; }
            const int tp = grp * 64 + (F.wave & 3) * 16, kh = F.wave >> 2, t0 = tp + kh * 8;
            const int r16 = F.lane & 15, kg = F.lane >> 4, myrow = tp + r16;
            float rs_mine;
            { const float* sp = SSQ1 + (size_t)myrow * 16; const f32x4 a = *(const f32x4*)sp, b4 = *(const f32x4*)(sp + 4), c4 = *(const f32x4*)(sp + 8), d4 = *(const f32x4*)(sp + 12);
              const float ssum = (((a[0] + a[1]) + (a[2] + a[3])) + ((b4[0] + b4[1]) + (b4[2] + b4[3]))) + (((c4[0] + c4[1]) + (c4[2] + c4[3])) + ((d4[0] + d4[1]) + (d4[2] + d4[3])));
              rs_mine = rsqrtf(ssum * (1.f / D) + EPS); }
            const float* xrow = out + (size_t)myrow * D + 512 * kh + 8 * kg;
            f32x4 lacc[4] = {{0.f, 0.f, 0.f, 0.f}, {0.f, 0.f, 0.f, 0.f}, {0.f, 0.f, 0.f, 0.f}, {0.f, 0.f, 0.f, 0.f}};
            f32x4 xq[8][2];
#pragma unroll
            for (int p = 0; p < 8; ++p) { xq[p][0] = *(const f32x4*)(xrow + 32 * p); xq[p][1] = *(const f32x4*)(xrow + 32 * p + 4); }
            VM_WAIT(); __syncthreads();
#pragma unroll
            for (int p = 0; p < 16; ++p) { const int j = 16 * kh + p, k = 32 * j + 8 * kg;
                const f32x4 x0 = xq[p & 7][0], x1v = xq[p & 7][1];
                if (p + 8 < 16) { xq[p & 7][0] = *(const f32x4*)(xrow + 32 * (p + 8)); xq[p & 7][1] = *(const f32x4*)(xrow + 32 * (p + 8) + 4); }
                const f32x4 g0 = *(const LAS f32x4*)(vg + k), g1 = *(const LAS f32x4*)(vg + k + 4), s0 = *(const LAS f32x4*)(vs + k), s1 = *(const LAS f32x4*)(vs + k + 4);
                const f32x4 h0 = x0 * rs_mine * g0 + s0, h1 = x1v * rs_mine * g1 + s1;
                const u32x4 hw = pack8(h0, h1);
                f32x4 a0, a1; unpack8(hw, a0, a1);
                const u32x4 lw = pack8(h0 - a0, h1 - a1);
                { u32x2 h8; int p_ = __builtin_amdgcn_cvt_pk_fp8_f32(h0[0], h0[1], 0, false); p_ = __builtin_amdgcn_cvt_pk_fp8_f32(h0[2], h0[3], p_, true); h8.x = (unsigned)p_;
                    p_ = __builtin_amdgcn_cvt_pk_fp8_f32(h1[0], h1[1], 0, false); p_ = __builtin_amdgcn_cvt_pk_fp8_f32(h1[2], h1[3], p_, true); h8.y = (unsigned)p_;
                    *(u32x2*)(H8 + (size_t)myrow * D + k) = h8; }
                const bf16x8 Ah = __builtin_bit_cast(bf16x8, hw), Al = __builtin_bit_cast(bf16x8, lw);
#pragma unroll
                for (int ntl = 0; ntl < 4; ++ntl) { const bf16x8 Wf = *(const LAS bf16x8*)(wrl + ((j * 4 + ntl) * 64 + F.lane) * 16);
                    lacc[ntl] = __builtin_amdgcn_mfma_f32_16x16x32_bf16(Wf, Ah, lacc[ntl], 0, 0, 0);
                    lacc[ntl] = __builtin_amdgcn_mfma_f32_16x16x32_bf16(Wf, Al, lacc[ntl], 0, 0, 0); } }
            __syncthreads();
            {   LAS float* stw = (LAS float*)F.lds + (((F.wave & 3) * 2 + kh) * 16 + r16) * 64;
#pragma unroll
                for (int ntl = 0; ntl < 4; ++ntl) *(LAS f32x4*)(stw + 16 * ntl + 4 * kg) = lacc[ntl]; }
            __syncthreads();
            LAS float* stg = (LAS float*)F.lds + ((F.wave & 3) * 32 + kh * 8) * 64;
            int cnt = 0; unsigned selbits = 0u, selks = 0u;
            for (int j = 0; j < 8; ++j) {
                const float logit = stg[j * 64 + F.lane] + stg[(16 + j) * 64 + F.lane];
                const float sc = 1.f / (1.f + expf(-logit));
                const float ch = sc + my_bias;
                const float m1 = max8(ch);
                const unsigned long long eq = __ballot(ch == m1);
                const unsigned gm = (unsigned)(eq >> (F.lane & ~7)) & 0xffu;
                const int first = __builtin_ctz(gm);
                const float c2 = max8(((F.lane & 7) == first) ? -INFINITY : ch);
                const float gs = m1 + c2; const int myg = F.lane >> 3;
                int rank = 0;
#pragma unroll
                for (int g = 0; g < 8; ++g) { const float o = __builtin_bit_cast(float, __builtin_amdgcn_readlane(__builtin_bit_cast(int, gs), 8 * g)); rank += (o > gs || (o == gs && g < myg)) ? 1 : 0; }
                float mc = (rank < 4) ? ch : -1e30f;
                int selk = -1;
#pragma unroll
                for (int k = 0; k < TOPK; ++k) { const float mx = wave_max_f(mc); const unsigned long long bl = __ballot(mc == mx); const int fl = __builtin_ctzll(bl);
                    if (F.lane == fl) { selk = k; mc = -INFINITY; } }
                const float ssum = wave_sum_f(selk >= 0 ? sc : 0.f);
                if (selk >= 0) { const int t = t0 + j; EIDX[(size_t)t * 8 + selk] = (unsigned char)F.lane; GATEW[(size_t)t * 8 + selk] = sc / ssum * 2.5f; ++cnt; selbits |= 1u << j; selks |= (unsigned)selk << (3 * j); }
            }
            cntw[F.wave * 64 + F.lane] = cnt;
            __syncthreads();
            if (F.wave == 0) { int tot = 0;
#pragma unroll
                for (int w = 0; w < 8; ++w) tot += cntw[w * 64 + F.lane];
                basel[F.lane] = (int)__hip_atomic_fetch_add((unsigned*)(ctl + (dummy ? CW_CNT + 2048 : CW_CNT) + 16 * F.lane), (unsigned)tot, RLX_AGENT); }
            __syncthreads();
            int pos = basel[F.lane];
            for (int w = 0; w < F.wave; ++w) pos += cntw[w * 64 + F.lane];
#pragma unroll
            for (int j = 0; j < 8; ++j) if ((selbits >> j) & 1u) { const int k = (selks >> (3 * j)) & 7, t = t0 + j;
                LIST[(size_t)F.lane * LISTCAP + pos] = (unsigned short)t;
                META[(size_t)F.lane * LISTCAP + pos] = (u32x2){(unsigned)(t * (TOPK + 1) + k), __float_as_uint(GATEW[(size_t)t * 8 + k])}; ++pos; }
        }
        __syncthreads();
        if (BOTH(7)) GRID_BAR();
    }

    volatile LAS int* tab = (volatile LAS int*)(F.lds + MOETAB_OFF);
    if (IN(8) || IN(9)) {
        __syncthreads();
        if (F.wave == 0) {
            const int n = (int)__hip_atomic_load((unsigned*)(ctl + CW_CNT + 16 * F.lane), RLX_AGENT);
            const int tiles = (n + 255) >> 8; int incl = tiles;
#pragma unroll
            for (int o = 1; o < 64; o <<= 1) { const int v = __shfl_up(incl, o); if (F.lane >= o) incl += v; }
            tab[F.lane] = incl - tiles; tab[66 + F.lane] = n;
            if (F.lane == 63) { tab[64] = incl; tab[65] = incl + T / 256; tab[66 + 64] = T; }
        }
        __syncthreads();
        { const int ti = F.tid; int e = 0;
          for (int q = 0; q <= NEXP; ++q) if (tab[q] <= ti) e = q;
          tab[132 + ti] = e; }
        __syncthreads();
    }
    for (int rep = 0; rep < ((PROBE_DUP == 8) ? 2 : 1); ++rep) if (IN(8)) { PHASE_ENV const bool dummy = (PROBE_DUP == 8) && rep == 0; (void)dummy;
        MoeOrder<2, true> S{(const char*)H8, (const char*)Wgu8, (const char*)Wsgu8, D / 2, (size_t)512 * D, LIST, tab, F.G, (int)blockIdx.x};
        EpiHb E{(unsigned char*)HB, 1.f / WSCALE8};
        pg8::gemm_phase<EpiHb, MoeOrder<2, true>, true, true>(F.lds, S, E);
        if (BOTH(8)) GRID_BAR();
    }
    for (int rep = 0; rep < ((PROBE_DUP == 9) ? 2 : 1); ++rep) if (IN(9)) { PHASE_ENV const bool dummy = (PROBE_DUP == 9) && rep == 0; (void)dummy;
        if (dummy && PROBE_VAR == 1) dn::down_phase<true>(F.lds, (const unsigned char*)HB, (const unsigned char*)Wd_t, (const unsigned char*)Wsd_t, tab, META, (unsigned char*)Y, (unsigned char*)(ws + WS_CTL + 900 * 1024), F.G, (int)blockIdx.x);
        else dn::down_phase<false>(F.lds, (const unsigned char*)HB, (const unsigned char*)Wd_t, (const unsigned char*)Wsd_t, tab, META, (unsigned char*)Y, (unsigned char*)(ws + WS_CTL + 900 * 1024), F.G, (int)blockIdx.x);
        if (BOTH(9)) GRID_BAR();
    }

    for (int rep = 0; rep < ((PROBE_DUP == 10) ? 2 : 1); ++rep) if (IN(10)) { PHASE_ENV const bool dummy = (PROBE_DUP == 10) && rep == 0; (void)dummy;
        int ln10 = F.lane; asm volatile("" : "+v"(ln10));
        for (int m = gw; m < T; m += NGW) {
            const int b = m / SEQ; const float* gf = mod + (size_t)b * 6 * D + 5 * D;
            f32x4* xr = (f32x4*)(out + (size_t)m * D) + ln10;
            f32x4* xw = dummy ? (f32x4*)((float*)HB + (size_t)m * D) + ln10 : xr;
            f32x4 v[4]; float s = 0.f;
#pragma unroll
            for (int j = 0; j < 4; ++j) { const int c = 4 * ln10 + 256 * j;
                f32x4 y = {0.f, 0.f, 0.f, 0.f};
#pragma unroll
                for (int k = 0; k < TOPK + 1; ++k) { const int w = __builtin_nontemporal_load((const int*)((const unsigned char*)Y + ((size_t)m * (TOPK + 1) + k) * D + c));
                    const f32x2 lo = __builtin_amdgcn_cvt_pk_f32_fp8(w, false), hi2 = __builtin_amdgcn_cvt_pk_f32_fp8(w, true);
                    y += (f32x4){lo.x, lo.y, hi2.x, hi2.y}; }
                v[j] = __builtin_nontemporal_load(xr + 64 * j) + *(const f32x4*)(gf + c) * y;
                s += (v[j].x * v[j].x + v[j].y * v[j].y) + (v[j].z * v[j].z + v[j].w * v[j].w); }
            const float rstd = rsqrtf(wave_sum(s) * (1.f / D) + EPS);
#pragma unroll
            for (int j = 0; j < 4; ++j) __builtin_nontemporal_store(v[j] * rstd * *(const f32x4*)(g_final + 4 * ln10 + 256 * j), xw + 64 * j);
        }
    }
#undef IN
#undef BOTH
#undef GRID_BAR
}

constexpr int NPHASE = 11;
extern "C" void kernel_launch(void* const* d_in, const int* in_sizes, int n_in, void* d_out, int out_size, void* d_ws, size_t ws_size, hipStream_t stream) {
    static int grid = 0;
    if (grid == 0) {
        if (n_in != 25 || out_size != T * D || ws_size < WS_END) { fprintf(stderr, "kernel_launch: unexpected shapes (n_in %d out %d ws %zu need %zu)\n", n_in, out_size, ws_size, (size_t)WS_END); grid = -1; return; }
        int dev = 0, cus = 0;
        if (hipGetDevice(&dev) != hipSuccess || hipDeviceGetAttribute(&cus, hipDeviceAttributeMultiprocessorCount, dev) != hipSuccess) { grid = -1; return; }
        if (hipFuncSetAttribute((const void*)fwd, hipFuncAttributeMaxDynamicSharedMemorySize, LDS_BYTES) != hipSuccess) { fprintf(stderr, "kernel_launch: hipFuncSetAttribute failed\n"); grid = -1; return; }
        int per_cu = 0;
        if (hipOccupancyMaxActiveBlocksPerMultiprocessor(&per_cu, (const void*)fwd, NWAVES * 64, LDS_BYTES) != hipSuccess || per_cu < 1) { fprintf(stderr, "kernel_launch: occupancy query says %d\n", per_cu); }
        (void)hipGetLastError();
        grid = cus;
    }
    if (grid < 0) return;
    (void)in_sizes;
    if (hipMemsetAsync((char*)d_ws + WS_CTL, 0, CTL_ZERO_BYTES, stream) != hipSuccess) return;
    Args a{};
    for (int i = 0; i < 25; ++i) a.in[i] = d_in[i];
    a.out = (float*)d_out; a.ws = (unsigned char*)d_ws;
#if MK_ONE_LAUNCH
    a.ph_lo = 0; a.ph_hi = NPHASE;
    hipLaunchKernelGGL(fwd, dim3(grid), dim3(NWAVES * 64), LDS_BYTES, stream, a);
#else
    for (int p = 0; p < NPHASE; ++p) { a.ph_lo = p; a.ph_hi = p + 1; hipLaunchKernelGGL(fwd, dim3(grid), dim3(NWAVES * 64), LDS_BYTES, stream, a); }
#endif
}
```

```cpp
#include <hip/hip_runtime.h>
#include <cstdio>
#include <cstdint>
#include <type_traits>

#ifndef MK_ONE_LAUNCH
#ifndef CONV_A0
#define CONV_A0 28
#endif
#define MK_ONE_LAUNCH 1
#endif

#ifndef PROBE_DUP
#define PROBE_DUP -1
#endif
#ifndef ATT_TUNED_FOX
#define ATT_TUNED_FOX 1
#endif
#ifndef ATT_TUNED_MLA
#define ATT_TUNED_MLA 1
#endif
#ifndef PROBE_VAR
#define PROBE_VAR 0
#endif
#define GAS __attribute__((address_space(1)))
#define LAS __attribute__((address_space(3)))
typedef unsigned short bf16;
typedef short bf16x8 __attribute__((ext_vector_type(8)));
typedef short s16x4 __attribute__((ext_vector_type(4)));
typedef float f32x2 __attribute__((ext_vector_type(2)));
typedef float f32x4 __attribute__((ext_vector_type(4)));
typedef float f32x16 __attribute__((ext_vector_type(16)));
typedef unsigned u32x2 __attribute__((ext_vector_type(2)));
typedef unsigned u32x4 __attribute__((ext_vector_type(4)));
typedef GAS unsigned gu32;
typedef int v8i32_t __attribute__((ext_vector_type(8)));
typedef int v4i32_t __attribute__((ext_vector_type(4)));

constexpr int NB = 4, SEQ = 4096, T = NB * SEQ, D = 1024;
constexpr int NIN = 4096;
constexpr int QLORA = 256, KVLORA = 128, KVPAD = 256, ROPE = 32, NHEAD = 8, HD = 64, MQK = 96;
constexpr int NEXP = 64, TOPK = 6, DEXP = 256;
constexpr float EPS = 1e-6f;
constexpr float LOG2E = 1.4426950408889634f;
constexpr float C2F = 0.125f * LOG2E;
constexpr float C2M = 0.10206207261596577f * LOG2E;
constexpr int LISTCAP = T;
constexpr float HSCALE8 = 8.f;
constexpr float OSCALE8 = 8.f;
constexpr float WSCALE8 = 64.f;

constexpr size_t MiB = 1u << 20;
constexpr size_t WS_CTL = 0, CTL_ZERO_BYTES = 1 * MiB;
constexpr size_t WS_EIDX = 262144, WS_GATEW = 393216;
constexpr size_t WS_WIN = 1 * MiB, WS_WQ = 9 * MiB, WS_WKV = 9 * MiB + 512 * 1024, WS_WOM = 10 * MiB, WS_WOF = 11 * MiB, WS_WOUT = 12 * MiB;
constexpr size_t WS_WSGU = 14 * MiB, WS_WSD = 15 * MiB, WS_WR = 15 * MiB + 512 * 1024, WS_MOD = 15 * MiB + 640 * 1024;
constexpr size_t WS_WD = 16 * MiB;
constexpr size_t WS_HB = 48 * MiB;
constexpr size_t WS_FQ = 48 * MiB, WS_FK = 64 * MiB, WS_FV = 80 * MiB, WS_QLAT = 96 * MiB, WS_KVLAT = 104 * MiB;
constexpr size_t WS_OFOX = WS_FQ, WS_OMLA = WS_QLAT;
static_assert(WS_FK - WS_FQ == (size_t)T * 512 * 2 && WS_FV - WS_FK == (size_t)T * 512 * 2, "fq|fk|fv contiguous");
constexpr size_t WS_Y = 112 * MiB;
constexpr size_t WS_WGU = 112 * MiB;
constexpr size_t WS_H = 176 * MiB;
constexpr size_t WS_QMLA = WS_H;
constexpr size_t WS_GATES = 208 * MiB;
constexpr size_t WS_KN = 272 * MiB, WS_VM = 288 * MiB, WS_KPE = 304 * MiB;
constexpr size_t WS_MERGED = WS_KN;
constexpr size_t WS_LIST = 304 * MiB;
constexpr size_t WS_X1B = 224 * MiB;
constexpr size_t WS_END = 306 * MiB;
constexpr size_t DO_MODP = 4 * MiB;
constexpr size_t DO_ROPE = 0, DO_LOGF = 2 * MiB, DO_CUMF = 2 * MiB + 512 * 1024, DO_SSQQ = 3 * MiB, DO_SSQKV = 3 * MiB + 256 * 1024;

constexpr int CW_TMO = 0;
constexpr int CW_BAR = 4096;
constexpr int CW_CNT = 8192;
constexpr int CW_KM = 12288;
constexpr int CW_Q = 12544;

constexpr int RING_BYTES = 131072;
constexpr int LDSCTL_OFF = RING_BYTES;
constexpr int MISC_OFF = LDSCTL_OFF + 320;
constexpr int MOETAB_OFF = LDSCTL_OFF + 1024;
constexpr int LDS_BYTES = 147456;

constexpr int NWAVES = 8;

#define LDS_WAIT() asm volatile("s_waitcnt lgkmcnt(0)" ::: "memory")
#define VM_WAIT() asm volatile("s_waitcnt vmcnt(0)" ::: "memory")
#define RLX_AGENT __ATOMIC_RELAXED, __HIP_MEMORY_SCOPE_AGENT
__device__ __forceinline__ unsigned f2bf(float f) { unsigned u = __builtin_bit_cast(unsigned, f); return (u + 0x7fffu + ((u >> 16) & 1u)) >> 16; }
__device__ __forceinline__ float bf2f(unsigned h) { return __builtin_bit_cast(float, h << 16); }
__device__ __forceinline__ unsigned pk2(float lo, float hi) { return f2bf(lo) | (f2bf(hi) << 16); }
__device__ __forceinline__ unsigned cvt_pk_bf16(float lo, float hi) { unsigned r; asm volatile("v_cvt_pk_bf16_f32 %0, %1, %2" : "=v"(r) : "v"(lo), "v"(hi)); return r; }
__device__ __forceinline__ u32x4 pack8(f32x4 a, f32x4 b) { u32x4 w; w.x = cvt_pk_bf16(a[0], a[1]); w.y = cvt_pk_bf16(a[2], a[3]); w.z = cvt_pk_bf16(b[0], b[1]); w.w = cvt_pk_bf16(b[2], b[3]); return w; }
__device__ __forceinline__ void unpack8(u32x4 w, f32x4& a, f32x4& b) {
    a = (f32x4){bf2f(w.x & 0xffffu), bf2f(w.x >> 16), bf2f(w.y & 0xffffu), bf2f(w.y >> 16)};
    b = (f32x4){bf2f(w.z & 0xffffu), bf2f(w.z >> 16), bf2f(w.w & 0xffffu), bf2f(w.w >> 16)};
}
__device__ __forceinline__ float wave_sum(float v) {
#pragma unroll
    for (int o = 1; o < 64; o <<= 1) v += __shfl_xor(v, o);
    return v;
}
__device__ __forceinline__ float wave_max(float v) {
#pragma unroll
    for (int o = 1; o < 64; o <<= 1) v = fmaxf(v, __shfl_xor(v, o));
    return v;
}
template <int CTRL> __device__ __forceinline__ float dppf(float v) { return __builtin_bit_cast(float, __builtin_amdgcn_update_dpp(0, __builtin_bit_cast(int, v), CTRL, 0xf, 0xf, true)); }
__device__ __forceinline__ float max8(float v) { v = fmaxf(v, dppf<0xB1>(v)); v = fmaxf(v, dppf<0x4E>(v)); v = fmaxf(v, dppf<0x141>(v)); return v; }
__device__ __forceinline__ float wave_max_f(float v) { v = max8(v); v = fmaxf(v, dppf<0x140>(v)); v = fmaxf(v, __shfl_xor(v, 16)); v = fmaxf(v, __shfl_xor(v, 32)); return v; }
__device__ __forceinline__ float wave_sum_f(float v) { v += dppf<0xB1>(v); v += dppf<0x4E>(v); v += dppf<0x141>(v); v += dppf<0x140>(v); v += __shfl_xor(v, 16); v += __shfl_xor(v, 32); return v; }
__device__ __forceinline__ float sigmoidf_(float x) { return __builtin_amdgcn_rcpf(1.f + __builtin_amdgcn_exp2f(-LOG2E * x)); }
__device__ __forceinline__ float siluf_(float x) { return x * __builtin_amdgcn_rcpf(1.f + __builtin_amdgcn_exp2f(-LOG2E * x)); }

namespace pg8 {
constexpr int BM = 256, BK = 64, HALF = 128, HTB = HALF * BK * 2, NXCD = 8, WGM = 8;
__host__ __device__ __forceinline__ int lds_byte(int r, int c) { const int st = (r >> 4) * 2 + (c >> 5), rr = r & 15, cc = c & 31, ob = rr * 64 + cc * 2; return st * 1024 + (ob ^ (((ob >> 9) & 1) << 5)); }
__host__ __device__ __forceinline__ void stage_rc(int b, int& R, int& C) { const int st = b / 1024, sb = b % 1024, swz = sb ^ (((sb >> 9) & 1) << 5); R = (st >> 1) * 16 + swz / 64; C = (st & 1) * 32 + (swz % 64) / 2; }
__host__ __device__ __forceinline__ int perm32(int rho) { const int n = rho >> 4, i = rho & 15; return 8 * (i >> 2) + 4 * n + (i & 3); }

struct Unit { int pm, pn, e, aux, n; };

struct StaticOrder {
    static constexpr bool GATHER = false;
    const char* A; const char* Bt; int K;
    int nM, nN, nwg, G, c;
    __device__ void init(const void* A_, const void* Bt_, int M, int N, int K_, int G_, int c_) { A = (const char*)A_; Bt = (const char*)Bt_; K = K_; nM = M / BM; nN = N / BM; nwg = nM * nN; G = G_; c = c_; }
    __device__ bool next(int i, Unit& u) const {
        const long L = (long)i * G + c; if (L >= nwg) return false;
        int wgid = (int)L; { const int q = nwg / NXCD, r = nwg % NXCD, xcd = wgid % NXCD, off = wgid / NXCD; wgid = (xcd < r ? xcd * (q + 1) : r * (q + 1) + (xcd - r) * q) + off; }
        const int nig = WGM * nN, gid = wgid / nig, fm = gid * WGM, gsz = (nM - fm) < WGM ? (nM - fm) : WGM;
        u.pm = fm + ((wgid % nig) % gsz); u.pn = (wgid % nig) / gsz; u.e = 0; u.aux = 0; u.n = BM; return true;
    }
    __device__ __forceinline__ const char* a_ptr(const Unit& u) const { return A + (size_t)u.pm * BM * K * 2; }
    __device__ __forceinline__ const char* b_ptr(const Unit& u) const { return Bt + (size_t)u.pn * BM * K * 2; }
    __device__ __forceinline__ unsigned a_row(const Unit&, int r) const { return (unsigned)r; }
};

template <class Epi, class Sched, bool ALIGN_EPI, bool FP8 = false>
__device__ __forceinline__ void gemm_phase(LAS unsigned char* lds, const Sched& S, const Epi& E) {
    int tid = threadIdx.x; asm volatile("" : "+v"(tid));
    const int wid = __builtin_amdgcn_readfirstlane(tid >> 6), lane = tid & 63, wr = wid >> 2, wc = wid & 3, fr = lane & 15, fq = lane >> 4;
    const int K = S.K, nt = K / BK;
    unsigned voffB[2], voffA[2];
#pragma unroll
    for (int i = 0; i < 2; ++i) { int R, C; stage_rc(tid * 16 + i * 8192, R, C); const int Rb = (R & ~31) + perm32(R & 31);
        voffA[i] = (unsigned)(R * K + C) * 2u; voffB[i] = (unsigned)(Rb * K + C) * 2u; }
    unsigned vA[2][2], vN[2][2];
    const size_t kstep = (size_t)(BK * 2);
    const size_t hstep = (size_t)HALF * K * 2;
    const unsigned ldsw = (unsigned)wid * 1024u;
    const int aoff = lds_byte(wr * 64 + fr, fq * 8), boff = lds_byte(wc * 32 + fr, fq * 8);
#define PG8_SA(b, h) (((b) * 2 + (h)) * HTB)
#define PG8_SB(b, h) ((4 + (b) * 2 + (h)) * HTB)
#define PG8_STAGE(bufoff, gbase, voff) do { _Pragma("unroll") for (int _i = 0; _i < 2; ++_i) \
        __builtin_amdgcn_global_load_lds((const unsigned*)((const char*)(gbase) + (voff)[_i]), (LAS unsigned*)(lds + (bufoff) + ldsw + _i * 8192), 16, 0, 0); } while (0)
#define PG8_STAGE_A(bufoff, gbase, h, nx) do { if constexpr (Sched::GATHER) { const unsigned vs_[2] = {(nx) ? vN[h][0] : vA[h][0], (nx) ? vN[h][1] : vA[h][1]}; PG8_STAGE(bufoff, gbase, vs_); }     \
        else PG8_STAGE(bufoff, (const char*)(gbase) + (h) * hstep, voffA); } while (0)
#define PG8_LDA(dst, b, h) do { _Pragma("unroll") for (int m = 0; m < 4; ++m) { if constexpr (FP8) { dst##8[m].lo = *(const LAS v4i32_t*)(lds + PG8_SA(b, h) + aoff + m * 2048); dst##8[m].hi = *(const LAS v4i32_t*)(lds + PG8_SA(b, h) + aoff + m * 2048 + 1024); } \
        else { _Pragma("unroll") for (int k = 0; k < 2; ++k) dst[m][k] = *(const LAS bf16x8*)(lds + PG8_SA(b, h) + aoff + m * 2048 + k * 1024); } } } while (0)
#define PG8_LDB(dst, b, h) do { _Pragma("unroll") for (int n = 0; n < 2; ++n) { if constexpr (FP8) { dst##8[n].lo = *(const LAS v4i32_t*)(lds + PG8_SB(b, h) + boff + n * 2048); dst##8[n].hi = *(const LAS v4i32_t*)(lds + PG8_SB(b, h) + boff + n * 2048 + 1024); } \
        else { _Pragma("unroll") for (int k = 0; k < 2; ++k) dst[n][k] = *(const LAS bf16x8*)(lds + PG8_SB(b, h) + boff + n * 2048 + k * 1024); } } } while (0)
#define PG8_MMA(ai, bj, At, Bt) do { __builtin_amdgcn_s_setprio(1); _Pragma("unroll") for (int m = 0; m < 4; ++m) _Pragma("unroll") for (int n = 0; n < 2; ++n) { \
        if constexpr (FP8) asm volatile("v_mfma_scale_f32_16x16x128_f8f6f4 %0, %1, %2, %0, %3, %3 op_sel_hi:[0,0,0]" : "+v"(acc[ai][bj][m][n]) : "v"(Bt##8[n]), "v"(At##8[m]), "v"(sc1_));     \
        else { _Pragma("unroll") for (int k = 0; k < 2; ++k) acc[ai][bj][m][n] = __builtin_amdgcn_mfma_f32_16x16x32_bf16(Bt[n][k], At[m][k], acc[ai][bj][m][n], 0, 0, 0); } } \
        __builtin_amdgcn_s_setprio(0); } while (0)
#define PG8_WAIT_V(n) asm volatile("s_waitcnt vmcnt(" #n ")" ::: "memory")
#define PG8_WAIT_L(n) asm volatile("s_waitcnt lgkmcnt(" #n ")" ::: "memory")
#define PG8_BAR __builtin_amdgcn_s_barrier()
#define PG8_SCHED __builtin_amdgcn_sched_barrier(0)
#define PG8_SETV(dst, u) do { _Pragma("unroll") for (int _h = 0; _h < 2; ++_h) _Pragma("unroll") for (int _i = 0; _i < 2; ++_i) { int R_, C_; stage_rc(tid * 16 + _i * 8192, R_, C_); \
        dst[_h][_i] = (S.a_row(u, _h * HALF + R_) * (unsigned)K + (unsigned)C_) * 2u; } } while (0)
    Unit cur, nxt; int ui = 0;
    if (!S.next(0, cur)) return;
    f32x4 acc[2][2][4][2];
#define PG8_ZERO() do { _Pragma("unroll") for (int a = 0; a < 2; ++a) _Pragma("unroll") for (int b = 0; b < 2; ++b) _Pragma("unroll") for (int m = 0; m < 4; ++m) _Pragma("unroll") for (int n = 0; n < 2; ++n) { \
        if constexpr (FP8) asm volatile("v_mov_b32 %0, 0\n\tv_mov_b32 %1, 0\n\tv_mov_b32 %2, 0\n\tv_mov_b32 %3, 0" : "=v"(acc[a][b][m][n][0]), "=v"(acc[a][b][m][n][1]), "=v"(acc[a][b][m][n][2]), "=v"(acc[a][b][m][n][3])); \
        else acc[a][b][m][n] = (f32x4){0.f, 0.f, 0.f, 0.f}; } } while (0)
    PG8_ZERO();
    unsigned sc1_ = 0x7f7f7f7fu; asm volatile("" : "+v"(sc1_));
    (void)sc1_;
    bf16x8 At[4][2], B0[2][2], B1[2][2];
    v8i32_t At8[4], B08[2], B18[2];
    (void)At; (void)B0; (void)B1; (void)At8; (void)B08; (void)B18;
    const char* cA = S.a_ptr(cur); const char* cB = S.b_ptr(cur);
    if constexpr (Sched::GATHER) { PG8_SETV(vA, cur); }
    PG8_STAGE(PG8_SB(0, 0), cB, voffB); PG8_STAGE(PG8_SB(0, 1), cB + hstep, voffB); PG8_STAGE_A(PG8_SA(0, 0), cA, 0, false); PG8_STAGE_A(PG8_SA(0, 1), cA, 1, false);
    if (wr == 1) PG8_BAR;
    PG8_WAIT_V(2); PG8_BAR;
    PG8_STAGE(PG8_SB(1, 0), cB + kstep, voffB); PG8_STAGE_A(PG8_SA(1, 0), cA + kstep, 0, false); PG8_STAGE(PG8_SB(1, 1), cB + hstep + kstep, voffB);
    PG8_WAIT_V(6); PG8_BAR;
    for (;;) {
        const bool has_next = S.next(ui + 1, nxt);
        const char* nA = has_next ? S.a_ptr(nxt) : cA; const char* nB = has_next ? S.b_ptr(nxt) : cB;
        if constexpr (Sched::GATHER) { if (has_next) { PG8_SETV(vN, nxt); } else {
#pragma unroll
            for (int h = 0; h < 2; ++h)
#pragma unroll
                for (int i = 0; i < 2; ++i) vN[h][i] = vA[h][i]; } }
        for (int t = 0; t < nt; t += 2) {
            const bool last = (t == nt - 2);
            if constexpr (Epi::MIDK) { if (t == nt / 2) E.mid(acc, cur, wr, wc, fr, fq); }
            const char* a1 = cA + (size_t)(t + 1) * kstep;
            const char* a2 = last ? nA : cA + (size_t)(t + 2) * kstep; const char* b2 = last ? nB : cB + (size_t)(t + 2) * kstep;
            const char* a3 = a2 + kstep; const char* b3 = b2 + kstep;
            PG8_LDB(B0, 0, 0); PG8_LDB(B1, 0, 1); PG8_SCHED; PG8_LDA(At, 0, 0); PG8_STAGE_A(PG8_SA(1, 1), a1, 1, false);
            PG8_WAIT_V(8); PG8_WAIT_L(0); PG8_BAR; PG8_MMA(0, 0, At, B0); PG8_MMA(0, 1, At, B1); PG8_BAR; PG8_SCHED;
            PG8_LDA(At, 0, 1); PG8_STAGE(PG8_SB(0, 0), b2, voffB); PG8_STAGE(PG8_SB(0, 1), b2 + hstep, voffB); PG8_STAGE_A(PG8_SA(0, 0), a2, 0, last);
            PG8_WAIT_V(8); PG8_WAIT_L(0); PG8_BAR; PG8_MMA(1, 0, At, B0); PG8_MMA(1, 1, At, B1); PG8_BAR; PG8_SCHED;
            PG8_LDB(B0, 1, 0); PG8_LDB(B1, 1, 1); PG8_SCHED; PG8_LDA(At, 1, 0); PG8_STAGE_A(PG8_SA(0, 1), a2, 1, last);
            PG8_WAIT_V(8); PG8_WAIT_L(0); PG8_BAR; PG8_MMA(0, 0, At, B0); PG8_MMA(0, 1, At, B1); PG8_BAR; PG8_SCHED;
            PG8_LDA(At, 1, 1); PG8_STAGE(PG8_SB(1, 0), b3, voffB); PG8_STAGE(PG8_SB(1, 1), b3 + hstep, voffB); PG8_STAGE_A(PG8_SA(1, 0), a3, 0, last);
            PG8_WAIT_V(8); PG8_WAIT_L(0); PG8_BAR; PG8_MMA(1, 0, At, B0); PG8_MMA(1, 1, At, B1); PG8_BAR; PG8_SCHED;
        }
        if constexpr (ALIGN_EPI) { if (wr == 0) PG8_BAR; }
        if constexpr (FP8) { asm volatile("s_nop 15\n\ts_nop 7" ::: "memory"); __builtin_amdgcn_sched_barrier(0); }
        E(acc, cur, wr, wc, fr, fq);
        if (!has_next) break;
        PG8_ZERO();
        cur = nxt; cA = nA; cB = nB; ++ui;
        if constexpr (Sched::GATHER) {
#pragma unroll
            for (int h = 0; h < 2; ++h)
#pragma unroll
                for (int i = 0; i < 2; ++i) vA[h][i] = vN[h][i]; }
        if constexpr (ALIGN_EPI) { if (wr == 1) PG8_BAR; }
    }
    PG8_WAIT_V(0);
    if constexpr (!ALIGN_EPI) { if (wr == 0) PG8_BAR; }
    PG8_BAR;
#undef PG8_SA
#undef PG8_SB
#undef PG8_STAGE
#undef PG8_STAGE_A
#undef PG8_LDA
#undef PG8_LDB
#undef PG8_MMA
#undef PG8_ZERO
#undef PG8_WAIT_V
#undef PG8_WAIT_L
#undef PG8_BAR
#undef PG8_SCHED
#undef PG8_SETV
}
}
using pg8::Unit;

#define EPI_ROWS(ai, m) for (int ai = 0; ai < 2; ++ai) for (int m = 0; m < 4; ++m)

struct EpiInProj {
    static constexpr bool MIDK = false;
    bf16 *qlat, *kvlat, *kpe, *fq, *gates; float *logf, *ssqq, *ssqkv; const float* ropetab; const float* bforget; bool skip; int rowmul;
    __device__ __forceinline__ void operator()(const f32x4 (&acc)[2][2][4][2], const Unit& u, int wr, int wc, int fr, int fq_) const {
        if (skip) return;
        const int pn = u.pn, row0 = u.pm * 256 + wr * 64 + fr, c0 = wc * 32 + 8 * fq_;
        if (pn >= 8) {
            bf16* gp = gates + (size_t)(pn - 8) * 256 + c0;
#pragma unroll
            for (int ai = 0; ai < 2; ++ai)
#pragma unroll
                for (int m = 0; m < 4; ++m) { const int row = row0 + ai * 128 + m * 16;
#pragma unroll
                    for (int bj = 0; bj < 2; ++bj) { f32x4 v0 = acc[ai][bj][m][0], v1 = acc[ai][bj][m][1];
#pragma unroll
                        for (int q = 0; q < 4; ++q) { v0[q] = fmaxf(sigmoidf_(v0[q]), 1e-30f); v1[q] = fmaxf(sigmoidf_(v1[q]), 1e-30f); }
                        *(u32x4*)(gp + (size_t)row * 2048 + 128 * bj) = pack8(v0, v1); } }
        } else if (pn >= 2) {
            bf16* dst = fq + (size_t)((pn - 2) >> 1) * ((size_t)T * 512) + (pn & 1) * 256 + c0; const float sc = (pn < 4) ? C2F : 1.f;
#pragma unroll
            for (int ai = 0; ai < 2; ++ai)
#pragma unroll
                for (int m = 0; m < 4; ++m) { const int row = row0 + ai * 128 + m * 16;
#pragma unroll
                    for (int bj = 0; bj < 2; ++bj) *(u32x4*)(dst + (size_t)row * 512 + 128 * bj) = pack8(acc[ai][bj][m][0] * sc, acc[ai][bj][m][1] * sc); }
        } else if (pn == 0) {
#pragma unroll
            for (int ai = 0; ai < 2; ++ai)
#pragma unroll
                for (int m = 0; m < 4; ++m) { const int row = row0 + ai * 128 + m * 16; float s = 0.f;
#pragma unroll
                    for (int bj = 0; bj < 2; ++bj) { const f32x4 v0 = acc[ai][bj][m][0], v1 = acc[ai][bj][m][1];
                        s += (v0[0] * v0[0] + v0[1] * v0[1]) + (v0[2] * v0[2] + v0[3] * v0[3]) + (v1[0] * v1[0] + v1[1] * v1[1]) + (v1[2] * v1[2] + v1[3] * v1[3]);
                        *(u32x4*)(qlat + (size_t)row * QLORA + c0 + 128 * bj) = pack8(v0, v1); }
                    s += __shfl_xor(s, 16); s += __shfl_xor(s, 32);
                    if (fq_ == 0) ssqq[row * 4 + wc] = s; }
        } else {
#pragma unroll
            for (int ai = 0; ai < 2; ++ai)
#pragma unroll
                for (int m = 0; m < 4; ++m) { const int row = row0 + ai * 128 + m * 16;
                    { const f32x4 v0 = acc[ai][0][m][0], v1 = acc[ai][0][m][1];
                      float s = (v0[0] * v0[0] + v0[1] * v0[1]) + (v0[2] * v0[2] + v0[3] * v0[3]) + (v1[0] * v1[0] + v1[1] * v1[1]) + (v1[2] * v1[2] + v1[3] * v1[3]);
                      *(u32x4*)(kvlat + (size_t)row * KVPAD + c0) = pack8(v0, v1);
                      s += __shfl_xor(s, 16); s += __shfl_xor(s, 32);
                      if (fq_ == 0) ssqkv[row * 4 + wc] = s; }
                    { const f32x4 v0 = acc[ai][1][m][0], v1 = acc[ai][1][m][1];
                      *(u32x4*)(kvlat + (size_t)row * KVPAD + 128 + c0) = (u32x4){0u, 0u, 0u, 0u};
                      if (wc == 0) {
                          const f32x4* tb = (const f32x4*)(ropetab + ((size_t)row * 16 + 4 * fq_) * 2);
                          const f32x4 t0 = tb[0], t1 = tb[1];
                          f32x4 o1, o2;
                          o1[0] = v0[0] * t0[0] - v1[0] * t0[1]; o2[0] = v1[0] * t0[0] + v0[0] * t0[1];
                          o1[1] = v0[1] * t0[2] - v1[1] * t0[3]; o2[1] = v1[1] * t0[2] + v0[1] * t0[3];
                          o1[2] = v0[2] * t1[0] - v1[2] * t1[1]; o2[2] = v1[2] * t1[0] + v0[2] * t1[1];
                          o1[3] = v0[3] * t1[2] - v1[3] * t1[3]; o2[3] = v1[3] * t1[2] + v0[3] * t1[3];
                          *(u32x4*)(kpe + (size_t)row * ROPE + 8 * fq_) = pack8(o1, o2);
                      } else if (wc == 1 && fq_ == 0) {
                          f32x4 l0, l1;
#pragma unroll
                          for (int h = 0; h < 4; ++h) { const float z0 = v0[h] + bforget[h], z1 = v1[h] + bforget[4 + h];
                              l0[h] = -__builtin_amdgcn_logf(1.f + __builtin_amdgcn_exp2f(-LOG2E * z0)); l1[h] = -__builtin_amdgcn_logf(1.f + __builtin_amdgcn_exp2f(-LOG2E * z1)); }
                          *(f32x4*)(logf + (size_t)row * 8) = l0; *(f32x4*)(logf + (size_t)row * 8 + 4) = l1;
                      } } }
        }
        (void)rowmul;
    }
};

struct EpiQup {
    static constexpr bool MIDK = false;
    bf16* q; const float* ssqq; const float* ropetab;
    __device__ __forceinline__ void operator()(const f32x4 (&acc)[2][2][4][2], const Unit& u, int wr, int wc, int fr, int fq_) const {
        const int row0 = u.pm * 256 + wr * 64 + fr, c0 = u.pn * 256 + wc * 32 + 8 * fq_;
#pragma unroll
        for (int ai = 0; ai < 2; ++ai)
#pragma unroll
            for (int m = 0; m < 4; ++m) {
                const int row = row0 + ai * 128 + m * 16;
                const f32x4 sq = *(const f32x4*)(ssqq + row * 4);
                const float rs = rsqrtf(((sq[0] + sq[1]) + (sq[2] + sq[3])) * (1.f / QLORA) + EPS) * C2M;
#pragma unroll
                for (int bj = 0; bj < 2; ++bj) {
                    const int col = c0 + 128 * bj, j = col % MQK;
                    f32x4 v0 = acc[ai][bj][m][0] * rs, v1 = acc[ai][bj][m][1] * rs;
                    if (j >= 64) { const int g = (j - 64) >> 3;
                        const f32x4* tb = (const f32x4*)(ropetab + ((size_t)row * 16 + 4 * g) * 2);
                        const f32x4 t0 = tb[0], t1 = tb[1];
                        f32x4 o1, o2;
                        o1[0] = v0[0] * t0[0] - v1[0] * t0[1]; o2[0] = v1[0] * t0[0] + v0[0] * t0[1];
                        o1[1] = v0[1] * t0[2] - v1[1] * t0[3]; o2[1] = v1[1] * t0[2] + v0[1] * t0[3];
                        o1[2] = v0[2] * t1[0] - v1[2] * t1[1]; o2[2] = v1[2] * t1[0] + v0[2] * t1[1];
                        o1[3] = v0[3] * t1[2] - v1[3] * t1[3]; o2[3] = v1[3] * t1[2] + v0[3] * t1[3];
                        v0 = o1; v1 = o2; }
                    *(u32x4*)(q + (size_t)row * 768 + col) = pack8(v0, v1);
                }
            }
    }
};

struct EpiKVup {
    static constexpr bool MIDK = false;
    bf16 *kn, *vm; const float* ssqkv;
    __device__ __forceinline__ void operator()(const f32x4 (&acc)[2][2][4][2], const Unit& u, int wr, int wc, int fr, int fq_) const {
        const int row0 = u.pm * 256 + wr * 64 + fr, c0 = u.pn * 256 + wc * 32 + 8 * fq_;
        bf16* dst = (u.pn < 2) ? kn : vm; const int cb = (u.pn & 1) * 256 + wc * 32 + 8 * fq_;
        (void)c0;
#pragma unroll
        for (int ai = 0; ai < 2; ++ai)
#pragma unroll
            for (int m = 0; m < 4; ++m) {
                const int row = row0 + ai * 128 + m * 16;
                const f32x4 sq = *(const f32x4*)(ssqkv + row * 4);
                const float rs = rsqrtf(((sq[0] + sq[1]) + (sq[2] + sq[3])) * (1.f / KVLORA) + EPS);
#pragma unroll
                for (int bj = 0; bj < 2; ++bj) *(u32x4*)(dst + (size_t)row * 512 + cb + 128 * bj) = pack8(acc[ai][bj][m][0] * rs, acc[ai][bj][m][1] * rs);
            }
    }
};

struct EpiPartA {
    static constexpr bool MIDK = false;
    float* part; const bf16* gates;
    __device__ __forceinline__ void operator()(const f32x4 (&acc)[2][2][4][2], const Unit& u, int wr, int wc, int fr, int fq_) const {
        const int row0 = u.pm * 256 + wr * 64 + fr, c0 = u.pn * 256 + wc * 32 + 8 * fq_;
#pragma unroll
        for (int ai = 0; ai < 2; ++ai)
#pragma unroll
            for (int m = 0; m < 4; ++m) {
                const int row = row0 + ai * 128 + m * 16;
#pragma unroll
                for (int bj = 0; bj < 2; ++bj) { const int col = c0 + 128 * bj;
                    f32x4 g0, g1; unpack8(*(const u32x4*)(gates + (size_t)row * 2048 + col), g0, g1);
                    *(f32x4*)(part + (size_t)row * D + col) = g0 * acc[ai][bj][m][0]; *(f32x4*)(part + (size_t)row * D + col + 4) = g1 * acc[ai][bj][m][1]; }
            }
    }
};
struct EpiMerged {
    static constexpr bool MIDK = false;
    const float* part; const bf16* gates; bf16* merged;
    __device__ __forceinline__ void operator()(const f32x4 (&acc)[2][2][4][2], const Unit& u, int wr, int wc, int fr, int fq_) const {
        const int row0 = u.pm * 256 + wr * 64 + fr, c0 = u.pn * 256 + wc * 32 + 8 * fq_;
#pragma unroll
        for (int ai = 0; ai < 2; ++ai)
#pragma unroll
            for (int m = 0; m < 4; ++m) {
                const int row = row0 + ai * 128 + m * 16;
#pragma unroll
                for (int bj = 0; bj < 2; ++bj) { const int col = c0 + 128 * bj;
                    f32x4 g0, g1; unpack8(*(const u32x4*)(gates + (size_t)row * 2048 + 1024 + col), g0, g1);
                    const f32x4 p0 = *(const f32x4*)(part + (size_t)row * D + col), p1 = *(const f32x4*)(part + (size_t)row * D + col + 4);
                    *(u32x4*)(merged + (size_t)row * D + col) = pack8(p0 + g0 * acc[ai][bj][m][0], p1 + g1 * acc[ai][bj][m][1]); }
            }
    }
};
struct EpiMergedCat {
    static constexpr bool MIDK = true;
    const bf16* gates; unsigned char* merged; float sc;
    __device__ __forceinline__ void mid(f32x4 (&acc)[2][2][4][2], const Unit& u, int wr, int wc, int fr, int fq_) const {
        int row0 = u.pm * 256 + wr * 64 + fr, c0 = u.pn * 256 + wc * 32 + 8 * fq_;
        asm volatile("" : "+v"(row0), "+v"(c0));
#pragma unroll
        for (int ai = 0; ai < 2; ++ai)
#pragma unroll
            for (int m = 0; m < 4; ++m) { const int row = row0 + ai * 128 + m * 16;
#pragma unroll
                for (int bj = 0; bj < 2; ++bj) { const int col = c0 + 128 * bj;
                    f32x4 a0, a1, b0, b1; unpack8(*(const u32x4*)(gates + (size_t)row * 2048 + col), a0, a1); unpack8(*(const u32x4*)(gates + (size_t)row * 2048 + 1024 + col), b0, b1);
#pragma unroll
                    for (int q = 0; q < 4; ++q) { acc[ai][bj][m][0][q] *= a0[q] * __builtin_amdgcn_rcpf(b0[q]); acc[ai][bj][m][1][q] *= a1[q] * __builtin_amdgcn_rcpf(b1[q]); } }
                asm volatile("" ::: "memory"); }
    }
    __device__ __forceinline__ void operator()(const f32x4 (&acc)[2][2][4][2], const Unit& u, int wr, int wc, int fr, int fq_) const {
        const int row0 = u.pm * 256 + wr * 64 + fr, c0 = u.pn * 256 + wc * 32 + 8 * fq_;
#pragma unroll
        for (int ai = 0; ai < 2; ++ai)
#pragma unroll
            for (int m = 0; m < 4; ++m) { const int row = row0 + ai * 128 + m * 16;
#pragma unroll
                for (int bj = 0; bj < 2; ++bj) { const int col = c0 + 128 * bj;
                    f32x4 b0, b1; unpack8(*(const u32x4*)(gates + (size_t)row * 2048 + 1024 + col), b0, b1);
                    const f32x4 v0 = b0 * acc[ai][bj][m][0] * sc, v1 = b1 * acc[ai][bj][m][1] * sc;
                    u32x2 o; int p_ = __builtin_amdgcn_cvt_pk_fp8_f32(v0[0], v0[1], 0, false); p_ = __builtin_amdgcn_cvt_pk_fp8_f32(v0[2], v0[3], p_, true); o.x = (unsigned)p_;
                    p_ = __builtin_amdgcn_cvt_pk_fp8_f32(v1[0], v1[1], 0, false); p_ = __builtin_amdgcn_cvt_pk_fp8_f32(v1[2], v1[3], p_, true); o.y = (unsigned)p_;
                    *(u32x2*)(merged + (size_t)row * D + col) = o; } }
    }
};
struct EpiOut {
    static constexpr bool MIDK = false;
    const float* x; bf16* x1; const float* mod; float* ssq1; float sc;
    __device__ __forceinline__ void operator()(const f32x4 (&acc)[2][2][4][2], const Unit& u, int wr, int wc, int fr, int fq_) const {
        const int row0 = u.pm * 256 + wr * 64 + fr, c0 = u.pn * 256 + wc * 32 + 8 * fq_;
        const float* gm = mod + (size_t)((u.pm * 256) / SEQ) * 6 * D + 2 * D;
        f32x4 g[2][2];
#pragma unroll
        for (int bj = 0; bj < 2; ++bj) { g[bj][0] = *(const f32x4*)(gm + c0 + 128 * bj) * sc; g[bj][1] = *(const f32x4*)(gm + c0 + 128 * bj + 4) * sc; }
#pragma unroll
        for (int ai = 0; ai < 2; ++ai)
#pragma unroll
            for (int m = 0; m < 4; ++m) { const int row = row0 + ai * 128 + m * 16; float sq = 0.f;
#pragma unroll
                for (int bj = 0; bj < 2; ++bj) { const int col = c0 + 128 * bj;
                    const f32x4 x0 = __builtin_nontemporal_load((const f32x4*)(x + (size_t)row * D + col)), x1v = __builtin_nontemporal_load((const f32x4*)(x + (size_t)row * D + col + 4));
                    f32x4 r0 = x0 + g[bj][0] * acc[ai][bj][m][0], r1 = x1v + g[bj][1] * acc[ai][bj][m][1];
                    const u32x4 pk_ = pack8(r0, r1); unpack8(pk_, r0, r1);
                    *(u32x4*)(x1 + (size_t)row * D + col) = pk_;
                    sq += (r0[0] * r0[0] + r0[1] * r0[1]) + (r0[2] * r0[2] + r0[3] * r0[3]) + (r1[0] * r1[0] + r1[1] * r1[1]) + (r1[2] * r1[2] + r1[3] * r1[3]); }
                sq += __shfl_xor(sq, 16); sq += __shfl_xor(sq, 32);
                if (fq_ == 0) ssq1[(size_t)row * 16 + 4 * u.pn + wc] = sq; }
    }
};
struct EpiHb {
    static constexpr bool MIDK = false;
    unsigned char* hb; float sc;
    __device__ __forceinline__ void operator()(const f32x4 (&acc)[2][2][4][2], const Unit& u, int wr, int wc, int fr, int fq_) const {
        const int row0 = u.pm * 256 + wr * 64 + fr, c0 = u.pn * 128 + wc * 32 + 8 * fq_;
#pragma unroll
        for (int ai = 0; ai < 2; ++ai)
#pragma unroll
            for (int m = 0; m < 4; ++m) { const int row = row0 + ai * 128 + m * 16;
                f32x4 h0, h1;
#pragma unroll
                for (int q = 0; q < 4; ++q) { h0[q] = siluf_(acc[ai][0][m][0][q] * sc) * (acc[ai][1][m][0][q] * (sc * HSCALE8)); h1[q] = siluf_(acc[ai][0][m][1][q] * sc) * (acc[ai][1][m][1][q] * (sc * HSCALE8)); }
                u32x2 o; int p_ = __builtin_amdgcn_cvt_pk_fp8_f32(h0[0], h0[1], 0, false); p_ = __builtin_amdgcn_cvt_pk_fp8_f32(h0[2], h0[3], p_, true); o.x = (unsigned)p_;
                p_ = __builtin_amdgcn_cvt_pk_fp8_f32(h1[0], h1[1], 0, false); p_ = __builtin_amdgcn_cvt_pk_fp8_f32(h1[2], h1[3], p_, true); o.y = (unsigned)p_;
                *(u32x2*)(hb + (size_t)row * DEXP + c0) = o; }
    }
};
struct EpiDown {
    static constexpr bool MIDK = false;
    bf16* Y; float* out; float* outw; const float* mod; const unsigned short* list; const unsigned char* eidx; const float* gatew;
    __device__ __forceinline__ void operator()(const f32x4 (&acc)[2][2][4][2], const Unit& u, int wr, int wc, int fr, int fq_) const {
        const int c0 = u.pn * 256 + wc * 32 + 8 * fq_;
#pragma unroll
        for (int ai = 0; ai < 2; ++ai)
#pragma unroll
            for (int m = 0; m < 4; ++m) {
                const int rl = wr * 64 + fr + ai * 128 + m * 16, idx = u.aux * 256 + rl;
                if (u.e == NEXP) {
                    const int t = idx; const float* gf = mod + (size_t)(t / SEQ) * 6 * D + 5 * D;
#pragma unroll
                    for (int bj = 0; bj < 2; ++bj) { const int col = c0 + 128 * bj; const float* o = out + (size_t)t * D + col; float* ow = outw + (size_t)t * D + col;
                        const f32x4 g0 = *(const f32x4*)(gf + col), g1 = *(const f32x4*)(gf + col + 4);
                        const f32x4 x0 = *(const f32x4*)o, x1v = *(const f32x4*)(o + 4);
                        *(f32x4*)ow = x0 + g0 * acc[ai][bj][m][0]; *(f32x4*)(ow + 4) = x1v + g1 * acc[ai][bj][m][1]; }
                } else if (idx < u.n) {
                    const int t = list[(size_t)u.e * LISTCAP + idx];
                    const u32x2 ev = *(const u32x2*)(eidx + (size_t)t * 8);
                    int k = 0;
#pragma unroll
                    for (int q = 1; q < TOPK; ++q) { const unsigned b = (q < 4) ? ((ev.x >> (8 * q)) & 0xffu) : ((ev.y >> (8 * (q - 4))) & 0xffu); if ((int)b == u.e) k = q; }
                    const float w = gatew[(size_t)t * 8 + k];
#pragma unroll
                    for (int bj = 0; bj < 2; ++bj) *(u32x4*)(Y + ((size_t)t * TOPK + k) * D + c0 + 128 * bj) = pack8(acc[ai][bj][m][0] * w, acc[ai][bj][m][1] * w);
                }
            }
    }
};

template <int NT, bool GATHER_>
struct MoeOrder {
    static constexpr bool GATHER = GATHER_;
    const char* A; const char* Bt; const char* Bsh; int K; size_t bstride;
    const unsigned short* list; volatile LAS int* tab;
    int G, c;
    __device__ bool next(int i, Unit& u) const {
        int ti, pn_;
        if ((G & 7) == 0) { const int x = c & 7, j = i * (G >> 3) + (c >> 3); ti = (j / NT) * 8 + x; pn_ = j % NT; if (ti >= tab[65]) return false; }
        else { const int total = tab[65] * NT; const long L = (long)i * G + c; if (L >= total) return false; ti = (int)L / NT; pn_ = (int)L % NT; }
        u.pn = pn_; u.pm = ti;
        const int e = __builtin_amdgcn_readfirstlane(tab[132 + ti]);
        u.e = e; u.aux = __builtin_amdgcn_readfirstlane(ti - tab[e]); u.n = __builtin_amdgcn_readfirstlane(tab[66 + e]); return true;
    }
    __device__ __forceinline__ const char* a_ptr(const Unit& u) const { return GATHER ? A : A + (size_t)u.pm * 256 * K * 2; }
    __device__ __forceinline__ const char* b_ptr(const Unit& u) const { return (u.e == NEXP ? Bsh : Bt + (size_t)u.e * bstride) + (size_t)u.pn * 256 * K * 2; }
    __device__ __forceinline__ unsigned a_row(const Unit& u, int r) const {
        if (!GATHER) return (unsigned)r;
        const int idx = u.aux * 256 + r;
        if (u.e == NEXP) return (unsigned)idx;
        return (idx < u.n) ? (unsigned)list[(size_t)u.e * LISTCAP + idx] : 0u;
    }
};

struct UpOrder {
    static constexpr bool GATHER = false;
    const char* Aq; const char* Bq; const char* Akv; const char* Bkv; int K; int G, c;
    __device__ bool next(int i, Unit& u) const {
        int L = i * G + c; if (L >= 448) return false;
        if (L < 256) { u.e = 1; u.pm = L >> 2; u.pn = L & 3; } else { L -= 256; u.e = 0; u.pm = L / 3; u.pn = L % 3; }
        u.aux = 0; u.n = 256; return true; }
    __device__ __forceinline__ const char* a_ptr(const Unit& u) const { return (u.e ? Akv : Aq) + (size_t)u.pm * 256 * K * 2; }
    __device__ __forceinline__ const char* b_ptr(const Unit& u) const { return (u.e ? Bkv : Bq) + (size_t)u.pn * 256 * K * 2; }
    __device__ __forceinline__ unsigned a_row(const Unit&, int r) const { return (unsigned)r; }
};
struct EpiUp {
    static constexpr bool MIDK = false;
    EpiQup q; EpiKVup kv;
    __device__ __forceinline__ void operator()(const f32x4 (&acc)[2][2][4][2], const Unit& u, int wr, int wc, int fr, int fq_) const { if (u.e) kv(acc, u, wr, wc, fr, fq_); else q(acc, u, wr, wc, fr, fq_); }
};

struct SharedDownOrder {
    static constexpr bool GATHER = false;
    const char* A; const char* Bt; int K; int G, c;
    __device__ bool next(int i, Unit& u) const { const int L = i * G + c; if (L >= (T / 256) * 4) return false; u.pm = L >> 2; u.pn = L & 3; u.e = NEXP; u.aux = L >> 2; u.n = 256; return true; }
    __device__ __forceinline__ const char* a_ptr(const Unit& u) const { return A + (size_t)u.pm * 256 * K * 2; }
    __device__ __forceinline__ const char* b_ptr(const Unit& u) const { return Bt + (size_t)u.pn * 256 * K * 2; }
    __device__ __forceinline__ unsigned a_row(const Unit&, int r) const { return (unsigned)r; }
};

namespace att {
constexpr int KSLOT = 12288, VSLOT = 8192;
constexpr int L_K = 0, L_V = 3 * KSLOT, L_F = L_V + 2 * VSLOT, L_WS = L_F + 3 * 256, L_OST = L_WS + 2048, L_END = L_OST + 8 * 4096;
static_assert(L_END <= RING_BYTES, "attention LDS");
__device__ __forceinline__ int crow(int r, int hi) { return (r & 3) + 8 * (r >> 2) + 4 * hi; }
__device__ __forceinline__ float max3f(float a, float b, float c) { return fmaxf(fmaxf(a, b), c); }
__device__ __forceinline__ float rowmax(const f32x16& p0, const f32x16& p1) {
    float a = max3f(p0[0], p0[1], p1[0]), b = max3f(p0[2], p0[3], p1[1]); a = max3f(a, p1[2], p1[3]);
#pragma unroll
    for (int r = 4; r < 16; r += 4) { a = max3f(a, p0[r], p0[r + 1]); b = max3f(b, p0[r + 2], p0[r + 3]); a = max3f(a, p1[r], p1[r + 1]); b = max3f(b, p1[r + 2], p1[r + 3]); }
    const float m = fmaxf(a, b);
    auto rr = __builtin_amdgcn_permlane32_swap(__float_as_uint(m), __float_as_uint(m), false, false);
    return fmaxf(__uint_as_float(rr[0]), __uint_as_float(rr[1]));
}
__device__ __forceinline__ void cmask(f32x16& p0, f32x16& p1, int jb, int qrel, int hi) {
    const float NEG = -INFINITY; const int kb = 64 * jb + 4 * hi;
#pragma unroll
    for (int r = 0; r < 16; ++r) { const int kv = kb + (r & 3) + 8 * (r >> 2); if (kv > qrel) p0[r] = NEG; if (kv + 32 > qrel) p1[r] = NEG; }
}
__device__ __forceinline__ void pv(f32x16* o, int vb, bf16x8 pa0, bf16x8 pa1, bf16x8 pa2, bf16x8 pa3) {
#pragma unroll
    for (int d0 = 0; d0 < 2; ++d0) { s16x4 lo[4], hi[4];
#pragma unroll
        for (int ks = 0; ks < 4; ++ks) {
            asm volatile("ds_read_b64_tr_b16 %0,%1 offset:%c2" : "=&v"(lo[ks]) : "v"(vb), "i"(d0 * 4096 + ks * 1024) : "memory");
            asm volatile("ds_read_b64_tr_b16 %0,%1 offset:%c2" : "=&v"(hi[ks]) : "v"(vb), "i"(d0 * 4096 + ks * 1024 + 512) : "memory"); }
        asm volatile("s_waitcnt lgkmcnt(0)" ::: "memory"); __builtin_amdgcn_sched_barrier(0);
#define PK(k) (bf16x8){lo[k][0], lo[k][1], lo[k][2], lo[k][3], hi[k][0], hi[k][1], hi[k][2], hi[k][3]}
        o[d0] = __builtin_amdgcn_mfma_f32_32x32x16_bf16(pa0, PK(0), o[d0], 0, 0, 0);
        o[d0] = __builtin_amdgcn_mfma_f32_32x32x16_bf16(pa1, PK(1), o[d0], 0, 0, 0);
        o[d0] = __builtin_amdgcn_mfma_f32_32x32x16_bf16(pa2, PK(2), o[d0], 0, 0, 0);
        o[d0] = __builtin_amdgcn_mfma_f32_32x32x16_bf16(pa3, PK(3), o[d0], 0, 0, 0);
#undef PK
    }
}
__device__ __forceinline__ unsigned cvtpk_s(float lo, float hi) { return cvt_pk_bf16(lo, hi); }

template <int DQK, bool DECAY, int THRL>
__device__ __forceinline__ void attn_unit(int b, int h, int qb, const bf16* Q, int QP, const bf16* Kn, const bf16* Kpe, const bf16* V, const float* cumF, bf16* O, int OP, LAS unsigned char* lds) {
    constexpr int ND0 = DQK / 16;
    int tid = threadIdx.x; asm volatile("" : "+v"(tid));
    const int lane = tid & 63, r32 = lane & 31, hi = lane >> 5; const int wid = __builtin_amdgcn_readfirstlane(tid >> 6);
    const long rowbase = (long)b * SEQ; const int q0 = qb * 256;
    const bf16* Qw = Q + (rowbase + q0 + wid * 32) * QP + h * DQK;
    const bf16* Kh = Kn + rowbase * 512 + h * 64; const bf16* Vh = V + rowbase * 512 + h * 64;
    const bf16* Kp = Kpe + rowbase * ROPE;
    const float* Fh = DECAY ? cumF + ((size_t)b * NHEAD + h) * SEQ : nullptr;
    LAS float* wsf = (LAS float*)(lds + L_WS) + wid * 64;
    const bf16* ksrc0 = Kh + (long)lane * 512 + wid * 8;
    const bf16* ksrc1 = Kp + (long)lane * ROPE + (wid & 3) * 8;
    const bf16* vsrc = Vh + (long)(16 * (wid & 3) + (lane >> 2)) * 512 + (wid >> 2) * 32 + (lane & 3) * 8;
    const int NT = (q0 + 256) / 64;
#define ATT_DMA_K(i_, s) do { const int t_ = NT - 1 - (i_); \
        __builtin_amdgcn_global_load_lds((const unsigned*)(ksrc0 + (long)t_ * 64 * 512), (LAS unsigned*)(lds + L_K + (s) * KSLOT + wid * 1024), 16, 0, 0); \
        if (DQK == 96 && wid < 4) __builtin_amdgcn_global_load_lds((const unsigned*)(ksrc1 + (long)t_ * 64 * ROPE), (LAS unsigned*)(lds + L_K + (s) * KSLOT + (8 + wid) * 1024), 16, 0, 0); \
        if (DECAY && wid == 7) __builtin_amdgcn_global_load_lds((const unsigned*)(Fh + t_ * 64 + lane), (LAS unsigned*)(lds + L_F + (s) * 256), 4, 0, 0); } while (0)
#define ATT_DMA_V(i_, s) do { const int t_ = NT - 1 - (i_); \
        __builtin_amdgcn_global_load_lds((const unsigned*)(vsrc + (long)t_ * 64 * 512), (LAS unsigned*)(lds + L_V + (s) * VSLOT + wid * 1024), 16, 0, 0); } while (0)
    ATT_DMA_K(0, 0); ATT_DMA_V(0, 0); ATT_DMA_K(1, 1);
    bf16x8 qr[ND0];
#pragma unroll
    for (int d0 = 0; d0 < ND0; ++d0) qr[d0] = *(const bf16x8*)(Qw + (long)r32 * QP + d0 * 16 + hi * 8);
    float fq_l = 0.f; if (DECAY) fq_l = Fh[q0 + wid * 32 + r32];
    float mhat = 0.f, l_reg = 0.f; bool started = false; f32x16 o[2]; o[0] = f32x16{}; o[1] = f32x16{};
    const int qrel = wid * 32 + r32;
    const int vb0 = (int)(uintptr_t)(lds + L_V) + ((lane >> 4) & 1) * 32 + (lane & 3) * 8 + (4 * hi + ((lane & 15) >> 2)) * 64;
#define ATT_QK(P0, P1, ks_) do { const float base_ = fq_l - mhat; \
        if (DECAY) { const LAS f32x4* fk_ = (const LAS f32x4*)(lds + L_F + (ks_) * 256); \
            _Pragma("unroll") for (int g = 0; g < 4; ++g) { const f32x4 a_ = fk_[2 * g + hi], c_ = fk_[8 + 2 * g + hi]; \
                _Pragma("unroll") for (int q = 0; q < 4; ++q) { P0[4 * g + q] = base_ - a_[q]; P1[4 * g + q] = base_ - c_[q]; } } } \
        else { _Pragma("unroll") for (int r = 0; r < 16; ++r) { P0[r] = base_; P1[r] = base_; } } \
        const LAS unsigned char* kb_ = lds + L_K + (ks_) * KSLOT + hi * 1024 + r32 * 16; \
        _Pragma("unroll") for (int d0 = 0; d0 < ND0; ++d0) { \
            const bf16x8 b0_ = *(const LAS bf16x8*)(kb_ + d0 * 2048), b1_ = *(const LAS bf16x8*)(kb_ + d0 * 2048 + 512); \
            P0 = __builtin_amdgcn_mfma_f32_32x32x16_bf16(b0_, qr[d0], P0, 0, 0, 0); P1 = __builtin_amdgcn_mfma_f32_32x32x16_bf16(b1_, qr[d0], P1, 0, 0, 0); } } while (0)
    f32x16 p0, p1, n0, n1;
    int ks_cur = 0, ks_nxt = 1, ks_ld = 2;
    for (int i = 0; i < NT; ++i) {
        const int vs = i & 1;
        VM_WAIT(); __syncthreads();
        if (i + 2 < NT) ATT_DMA_K(i + 2, ks_ld);
        if (i + 1 < NT) ATT_DMA_V(i + 1, vs ^ 1);
        if (i == 0) ATT_QK(p0, p1, 0);
        if (i + 1 < NT) ATT_QK(n0, n1, ks_nxt);
        const int jb = 3 - i;
        if (jb >= 0) cmask(p0, p1, jb, qrel, hi);
        const float rm = rowmax(p0, p1);
        bool resc = false; float dl = 0.f; const bool was_started = started;
        if (jb >= 0) {
            const bool fin = rm > -INFINITY;
            dl = started ? fmaxf(rm, 0.f) : (fin ? rm : 0.f); started = started || fin; resc = true;
        } else if (__any(rm > (float)THRL)) { dl = fmaxf(rm, 0.f); resc = true; }
        if (resc) { mhat += dl;
#pragma unroll
            for (int r = 0; r < 16; ++r) { p0[r] -= dl; p1[r] -= dl; }
            if (i + 1 < NT) {
#pragma unroll
                for (int r = 0; r < 16; ++r) { n0[r] -= dl; n1[r] -= dl; } }
            const float f = was_started ? __builtin_amdgcn_exp2f(-dl) : 1.f; l_reg *= f; if (hi == 0) wsf[r32] = f; }
        float sacc = 0.f;
#pragma unroll
        for (int r = 0; r < 16; ++r) { p0[r] = __builtin_amdgcn_exp2f(p0[r]); p1[r] = __builtin_amdgcn_exp2f(p1[r]); sacc += p0[r] + p1[r]; }
        l_reg += sacc;
        if (resc) { LDS_WAIT();
#pragma unroll
            for (int d_ = 0; d_ < 2; ++d_)
#pragma unroll
                for (int r = 0; r < 16; ++r) o[d_][r] *= wsf[crow(r, hi)]; }
        u32x4 pw0, pw1, pw2, pw3;
        pw0 = (u32x4){cvtpk_s(p0[0], p0[1]), cvtpk_s(p0[2], p0[3]), cvtpk_s(p0[4], p0[5]), cvtpk_s(p0[6], p0[7])};
        pw1 = (u32x4){cvtpk_s(p0[8], p0[9]), cvtpk_s(p0[10], p0[11]), cvtpk_s(p0[12], p0[13]), cvtpk_s(p0[14], p0[15])};
        pw2 = (u32x4){cvtpk_s(p1[0], p1[1]), cvtpk_s(p1[2], p1[3]), cvtpk_s(p1[4], p1[5]), cvtpk_s(p1[6], p1[7])};
        pw3 = (u32x4){cvtpk_s(p1[8], p1[9]), cvtpk_s(p1[10], p1[11]), cvtpk_s(p1[12], p1[13]), cvtpk_s(p1[14], p1[15])};
        __builtin_amdgcn_sched_barrier(0);
        pv(o, vb0 + vs * VSLOT, __builtin_bit_cast(bf16x8, pw0), __builtin_bit_cast(bf16x8, pw1), __builtin_bit_cast(bf16x8, pw2), __builtin_bit_cast(bf16x8, pw3));
        p0 = n0; p1 = n1;
        { const int t_ = ks_cur; ks_cur = ks_nxt; ks_nxt = ks_ld; ks_ld = t_; }
    }
    { auto rr = __builtin_amdgcn_permlane32_swap(__float_as_uint(l_reg), __float_as_uint(l_reg), false, false); l_reg = __uint_as_float(rr[0]) + __uint_as_float(rr[1]); }
    if (hi == 0) wsf[32 + r32] = l_reg; LDS_WAIT();
    float rli[16];
#pragma unroll
    for (int r = 0; r < 16; ++r) rli[r] = __builtin_amdgcn_rcpf(wsf[32 + crow(r, hi)]);
    unsigned char* Ow = (unsigned char*)O + (rowbase + q0 + wid * 32) * OP + h * 64;
    { LAS unsigned char* stg = lds + L_OST + wid * 4096;
#pragma unroll
      for (int r = 0; r < 16; ++r) { const int orow = crow(r, hi);
#pragma unroll
          for (int d0 = 0; d0 < 2; ++d0) { const float ov = o[d0][r] * rli[r] * OSCALE8; stg[orow * 64 + d0 * 32 + r32] = (unsigned char)__builtin_amdgcn_cvt_pk_fp8_f32(ov, ov, 0, false); } }
      LDS_WAIT();
#pragma unroll
      for (int i = 0; i < 2; ++i) { const int row = i * 16 + (lane >> 2), ch = lane & 3; const u32x4 v = *(const LAS u32x4*)(stg + row * 64 + ch * 16); *(u32x4*)(Ow + (long)row * OP + ch * 16) = v; } }
    LDS_WAIT(); __syncthreads();
#undef ATT_DMA_K
#undef ATT_DMA_V
#undef ATT_QK
}

constexpr int T_KSLOT = 12288, T_VSLOT = 8192, T_NSLOT = 3;
constexpr int T_K = 0, T_V = T_NSLOT * T_KSLOT, T_F = T_V + T_NSLOT * T_VSLOT, T_WS = T_F + T_NSLOT * 256, T_OST = T_WS + 2048, T_END = T_OST + 8 * 4096;
static_assert(T_END <= RING_BYTES, "attention LDS (hand-interleaved unit)");
typedef __attribute__((address_space(3))) const char* lds_cptr;
typedef short v4i16_t __attribute__((ext_vector_type(4)));
__device__ __forceinline__ s16x4 vtr(lds_cptr p) { return __builtin_bit_cast(s16x4, __builtin_amdgcn_ds_read_tr16_b64_v4i16((__attribute__((address_space(3))) v4i16_t*)p)); }
__device__ __forceinline__ void kload2(bf16x8* kf, lds_cptr kp, int j) { kf[2 * j] = *(const __attribute__((address_space(3))) bf16x8*)(kp + j * 2048); kf[2 * j + 1] = *(const __attribute__((address_space(3))) bf16x8*)(kp + j * 2048 + 512); }
#define TW_BAR(N) asm volatile("s_waitcnt vmcnt(" #N ") lgkmcnt(0)\n\ts_barrier" ::: "memory")
#define TSB() __builtin_amdgcn_sched_barrier(0)

template <int DQK, bool DECAY, int THRL>
__device__ __forceinline__ void attn_unit_t(int b, int h, int qb, const bf16* Q, int QP, const bf16* Kn, const bf16* Kpe, const bf16* V, const float* cumF, float kmax2, bf16* O, int OP, LAS unsigned char* lds) {
    constexpr int ND0 = DQK / 16;
    constexpr bool INPL = DECAY || (DQK == 96);
    int tid = threadIdx.x; asm volatile("" : "+v"(tid));
    const int lane = tid & 63, r32 = lane & 31, hi = lane >> 5; const int wid = __builtin_amdgcn_readfirstlane(tid >> 6);
    const long rowbase = (long)b * SEQ; const int q0 = qb * 256;
    const bf16* Qw = Q + (rowbase + q0 + wid * 32) * QP + h * DQK;
    const bf16* Kh = Kn + rowbase * 512 + h * 64; const bf16* Vh = V + rowbase * 512 + h * 64;
    const bf16* Kp = Kpe + rowbase * ROPE;
    const float* Fh = DECAY ? cumF + ((size_t)b * NHEAD + h) * SEQ : nullptr;
    LAS float* wsf = (LAS float*)(lds + T_WS) + wid * 64;
    const bf16* ksrc0 = Kh + (long)lane * 512 + wid * 8;
    const bf16* ksrc1 = Kp + (long)lane * ROPE + (wid & 3) * 8;
    const bf16* vsrc = Vh + (long)(16 * (wid & 3) + (lane >> 2)) * 512 + (wid >> 2) * 32 + (lane & 3) * 8;
    const int NTS = (q0 + 256) / 64;
#define TDMA_K(i_, sk) do { const int t_ = NTS - 1 - (i_); \
        __builtin_amdgcn_global_load_lds((const unsigned*)(ksrc0 + (long)t_ * 64 * 512), (LAS unsigned*)(lds + T_K + (sk) * T_KSLOT + wid * 1024), 16, 0, 0); \
        if (DECAY) __builtin_amdgcn_global_load_lds((const unsigned*)(Fh + t_ * 64 + lane), (LAS unsigned*)(lds + T_F + (sk) * 256), 4, 0, 0); \
        else __builtin_amdgcn_global_load_lds((const unsigned*)(ksrc1 + (long)t_ * 64 * ROPE), (LAS unsigned*)(lds + T_K + (sk) * T_KSLOT + (8 + (wid & 3)) * 1024), 16, 0, 0); } while (0)
#define TDMA_V(i_, sv) do { const int t_ = NTS - 1 - (i_); \
        __builtin_amdgcn_global_load_lds((const unsigned*)(vsrc + (long)t_ * 64 * 512), (LAS unsigned*)(lds + T_V + (sv) * T_VSLOT + wid * 1024), 16, 0, 0); } while (0)
    TDMA_K(0, 0); TDMA_V(0, 0); TDMA_K(1, 1);
    bf16x8 qr[ND0];
#pragma unroll
    for (int d0 = 0; d0 < ND0; ++d0) qr[d0] = *(const bf16x8*)(Qw + (long)r32 * QP + d0 * 16 + hi * 8);
    float fq_l = 0.f; if (DECAY) fq_l = Fh[q0 + wid * 32 + r32];
    float ftile = 0.f; if (DECAY) ftile = Fh[(lane < NTS ? lane : NTS - 1) * 64 + 63];
    float mhat = 0.f, l_reg = 0.f; f32x16 o[2]; o[0] = f32x16{}; o[1] = f32x16{};
    f32x16 negm = f32x16{}; asm volatile("" : "+v"(negm));
    const int qrel = wid * 32 + r32, i0 = 3 - (wid >> 1);
    const lds_cptr shm3 = (lds_cptr)lds; const lds_cptr kp0 = shm3 + T_K + hi * 1024 + r32 * 16;
    const lds_cptr vp0 = shm3 + T_V + ((lane >> 4) & 1) * 32 + (lane & 3) * 8 + (4 * hi + ((lane & 15) >> 2)) * 64;
    const int vb0 = (int)(uintptr_t)(lds + T_V) + ((lane >> 4) & 1) * 32 + (lane & 3) * 8 + (4 * hi + ((lane & 15) >> 2)) * 64;
    bool resc = false;
    bf16x8 kf[2 * ND0];
    f32x16 pA0, pA1, pB0, pB1;
    int sl_prev = 0, sl_cur = 0, sl_next = 1;
#define TROT() do { sl_prev = sl_cur; sl_cur = sl_next; sl_next = (sl_next == T_NSLOT - 1) ? 0 : sl_next + 1; } while (0)
#define TBIAS(X0, X1, fs_) do { if (DECAY) { const float base_ = fq_l - mhat; const LAS f32x4* fk_ = (const LAS f32x4*)(lds + T_F + (fs_) * 256); \
        _Pragma("unroll") for (int g = 0; g < 4; ++g) { const f32x4 a_ = fk_[2 * g + hi], c_ = fk_[8 + 2 * g + hi]; \
            _Pragma("unroll") for (int q = 0; q < 4; ++q) { X0[4 * g + q] = base_ - a_[q]; X1[4 * g + q] = base_ - c_[q]; } } } \
        else if (INPL) { const float nm_ = -mhat; _Pragma("unroll") for (int r = 0; r < 16; ++r) { X0[r] = nm_; X1[r] = nm_; } } } while (0)
#define TCIN(X) (INPL ? X : negm)
#define TRESC() do { if (resc) { asm volatile("s_waitcnt lgkmcnt(0)" ::: "memory"); \
        _Pragma("unroll") for (int d_ = 0; d_ < 2; ++d_) _Pragma("unroll") for (int r = 0; r < 16; ++r) o[d_][r] *= wsf[crow(r, hi)]; } } while (0)
#define TDECIDE(C0, C1, i_) do { \
        float a_ = max3f(C0[0], C0[1], C1[0]), b_ = max3f(C0[2], C0[3], C1[1]); a_ = max3f(a_, C1[2], C1[3]); \
        _Pragma("unroll") for (int r = 4; r < 16; r += 4) { a_ = max3f(a_, C0[r], C0[r + 1]); b_ = max3f(b_, C0[r + 2], C0[r + 3]); a_ = max3f(a_, C1[r], C1[r + 1]); b_ = max3f(b_, C1[r + 2], C1[r + 3]); } \
        float rm_ = fmaxf(a_, b_); { auto rr_ = __builtin_amdgcn_permlane32_swap(__float_as_uint(rm_), __float_as_uint(rm_), false, false); rm_ = fmaxf(__uint_as_float(rr_[0]), __uint_as_float(rr_[1])); } \
        resc = false; \
        if ((i_) == i0) { const float dl_ = rm_; mhat += dl_; \
            _Pragma("unroll") for (int r = 0; r < 16; ++r) { C0[r] -= dl_; C1[r] -= dl_; } \
            if (!INPL) { _Pragma("unroll") for (int r = 0; r < 16; ++r) negm[r] = -mhat; asm volatile("" : "+v"(negm)); } } \
        else if (__builtin_expect(__any(rm_ > (float)THRL), 0)) { const float dl_ = fmaxf(rm_, 0.f); mhat += dl_; \
            _Pragma("unroll") for (int r = 0; r < 16; ++r) { C0[r] -= dl_; C1[r] -= dl_; } \
            if (!INPL) { _Pragma("unroll") for (int r = 0; r < 16; ++r) negm[r] = -mhat; asm volatile("" : "+v"(negm)); } \
            const float f_ = __builtin_amdgcn_exp2f(-dl_); l_reg *= f_; if (hi == 0) wsf[r32] = f_; resc = true; } } while (0)
    TDMA_K(2, 2);
    TW_BAR(5);
    int NT = NTS;
    if (DECAY) {
        const float bound = 2.f * __builtin_sqrtf(kmax2) * 1.0001f + 1.f + (Fh[q0] - ftile);
        const unsigned long long need = __ballot(lane < NTS && bound >= -160.f);
        const int tmin = need ? (int)__builtin_ctzll(need) : NTS - 1;
        NT = NTS - tmin; NT += NT & 1; if (NT < 8) NT = 8; if (NT > NTS) NT = NTS;
        NT = __builtin_amdgcn_readfirstlane(NT); }
    TBIAS(pA0, pA1, 0);
    { const lds_cptr kb = kp0;
#pragma unroll
      for (int d0 = 0; d0 < ND0; ++d0) { const bf16x8 b0 = *(const __attribute__((address_space(3))) bf16x8*)(kb + d0 * 2048), b1 = *(const __attribute__((address_space(3))) bf16x8*)(kb + d0 * 2048 + 512);
          if (d0 == 0) { pA0 = __builtin_amdgcn_mfma_f32_32x32x16_bf16(b0, qr[0], TCIN(pA0), 0, 0, 0); pA1 = __builtin_amdgcn_mfma_f32_32x32x16_bf16(b1, qr[0], TCIN(pA1), 0, 0, 0); }
          else { pA0 = __builtin_amdgcn_mfma_f32_32x32x16_bf16(b0, qr[d0], pA0, 0, 0, 0); pA1 = __builtin_amdgcn_mfma_f32_32x32x16_bf16(b1, qr[d0], pA1, 0, 0, 0); } } }
    cmask(pA0, pA1, 3, qrel, hi);
    TDECIDE(pA0, pA1, 0);
#pragma unroll
    for (int r = 0; r < 16; ++r) { pA0[r] = __builtin_amdgcn_exp2f(pA0[r]); pA1[r] = __builtin_amdgcn_exp2f(pA1[r]); }
    TW_BAR(0);
    TDMA_K(3, 0); TDMA_V(1, 1);
    TROT();
#pragma unroll
    for (int j = 0; j < ND0; ++j) kload2(kf, kp0 + sl_cur * T_KSLOT, j);
    TBIAS(pB0, pB1, sl_cur);
    TW_BAR(3);
    s16x4 vlo[8], vhi[8]; u32x4 pw0, pw1, pw2, pw3;
#define TPKW(P, B) cvt_pk_bf16(P[B], P[B + 1])
#define TPAF(k) __builtin_bit_cast(bf16x8, pw##k)
#define TVFR(i) (bf16x8){vlo[i][0], vlo[i][1], vlo[i][2], vlo[i][3], vhi[i][0], vhi[i][1], vhi[i][2], vhi[i][3]}
#define TPIN(x) asm volatile("" : "+v"(x))
#define TGAPA(MF, A0, A1, A2, A3, W0, W1, PW) do { MF; sacc += A0; sacc += A1; sacc += A2; sacc += A3; TPIN(sacc); W0; W1; TPIN(PW); TSB(); } while (0)
#define TEX(v) __builtin_amdgcn_exp2f(v)
#define TGAPB(MF, X, B) do { MF; X[B] = TEX(X[B]); X[B + 1] = TEX(X[B + 1]); X[B + 2] = TEX(X[B + 2]); X[B + 3] = TEX(X[B + 3]); TPIN(X); TSB(); } while (0)
#define TVRD(i) do { vlo[i] = vtr(vp_ + (((i) >> 2) * 4096 + ((i) & 3) * 1024)); vhi[i] = vtr(vp_ + (((i) >> 2) * 4096 + ((i) & 3) * 1024 + 512)); } while (0)
#define TKRD(G, j) do { if (G) { kload2(kf, kp0 + sl_next * T_KSLOT, j); TSB(); } } while (0)
#define TMF(a, b, c) __builtin_amdgcn_mfma_f32_32x32x16_bf16(a, b, c, 0, 0, 0)
#define TSTEP(C0, C1, P0, P1, i_, MJB, GK, GV, GL) do { TSB(); \
        const lds_cptr vp_ = vp0 + sl_prev * T_VSLOT; \
        TVRD(0); TSB(); float sacc = (P0[0] + P0[1]); \
        TGAPA(C0 = TMF(kf[0], qr[0], TCIN(C0)), P0[2], P0[3], P0[4], P0[5],     pw0[0] = TPKW(P0, 0), pw0[1] = TPKW(P0, 2), pw0); \
        TVRD(4); TSB(); TGAPA(C1 = TMF(kf[1], qr[0], TCIN(C1)), P0[6], P0[7], P0[8], P0[9],     pw0[2] = TPKW(P0, 4), pw0[3] = TPKW(P0, 6), pw0); \
        TVRD(1); TSB(); TGAPA(C0 = TMF(kf[2], qr[1], C0),   P0[10], P0[11], P0[12], P0[13], pw1[0] = TPKW(P0, 8), pw1[1] = TPKW(P0, 10), pw1); \
        TVRD(5); TSB(); TGAPA(C1 = TMF(kf[3], qr[1], C1),   P0[14], P0[15], P1[0], P1[1],   pw1[2] = TPKW(P0, 12), pw1[3] = TPKW(P0, 14), pw1); \
        TVRD(2); TSB(); TGAPA(C0 = TMF(kf[4], qr[2], C0),   P1[2], P1[3], P1[4], P1[5],     pw2[0] = TPKW(P1, 0), pw2[1] = TPKW(P1, 2), pw2); \
        TVRD(6); TSB(); TGAPA(C1 = TMF(kf[5], qr[2], C1),   P1[6], P1[7], P1[8], P1[9],     pw2[2] = TPKW(P1, 4), pw2[3] = TPKW(P1, 6), pw2); \
        TVRD(3); TSB(); TGAPA(C0 = TMF(kf[6], qr[3], C0),   P1[10], P1[11], P1[12], P1[13], pw3[0] = TPKW(P1, 8), pw3[1] = TPKW(P1, 10), pw3); \
        TVRD(7); TSB(); TGAPA(C1 = TMF(kf[7], qr[3], C1),   P1[14], P1[15], 0.f, 0.f,       pw3[2] = TPKW(P1, 12), pw3[3] = TPKW(P1, 14), pw3); \
        if (ND0 == 6) { C0 = TMF(kf[2 * ND0 - 4], qr[ND0 - 2], C0); C1 = TMF(kf[2 * ND0 - 3], qr[ND0 - 2], C1); C0 = TMF(kf[2 * ND0 - 2], qr[ND0 - 1], C0); C1 = TMF(kf[2 * ND0 - 1], qr[ND0 - 1], C1); TSB(); } \
        l_reg += sacc; \
        if (GK) { TDMA_K((i_) + 3, sl_cur); } if (GV) { TDMA_V((i_) + 1, sl_next); } \
        if ((MJB) >= 0) cmask(C0, C1, (MJB), qrel, hi); \
        TDECIDE(C0, C1, i_); \
        TSB(); \
        TGAPB(o[0] = TMF(TPAF(0), TVFR(0), o[0]), C0, 0); \
        TKRD(GL, 0); TGAPB(o[1] = TMF(TPAF(0), TVFR(4), o[1]), C0, 4); \
        TKRD(GL, 1); TGAPB(o[0] = TMF(TPAF(1), TVFR(1), o[0]), C0, 8); \
        TKRD(GL, 2); TGAPB(o[1] = TMF(TPAF(1), TVFR(5), o[1]), C0, 12); \
        TKRD(GL, 3); TGAPB(o[0] = TMF(TPAF(2), TVFR(2), o[0]), C1, 0); \
        if (ND0 == 6) { TKRD(GL, ND0 - 2); } TGAPB(o[1] = TMF(TPAF(2), TVFR(6), o[1]), C1, 4); \
        if (ND0 == 6) { TKRD(GL, ND0 - 1); } TGAPB(o[0] = TMF(TPAF(3), TVFR(3), o[0]), C1, 8); \
        TGAPB(o[1] = TMF(TPAF(3), TVFR(7), o[1]), C1, 12); \
        if (GL) { TBIAS(P0, P1, sl_next); } \
    } while (0)
#define TENDW(tt) do { if ((tt) + 3 < NT) { TW_BAR(3); } else if ((tt) + 2 < NT) { TW_BAR(1); } else { TW_BAR(0); } } while (0)
    TSTEP(pB0, pB1, pA0, pA1, 1, 2, (1 + 3 < NT), true, true); TENDW(1); TRESC(); TROT();
    TSTEP(pA0, pA1, pB0, pB1, 2, 1, (2 + 3 < NT), true, true); TENDW(2); TRESC(); TROT();
    {
        TSTEP(pB0, pB1, pA0, pA1, 3, 0, (3 + 3 < NT), true, true); TENDW(3); TRESC(); TROT();
        int i = 4;
        for (; i + 2 < NT; i += 2) {
            TSTEP(pA0, pA1, pB0, pB1, i, -1, (i + 3 < NT), true, true);                         TENDW(i);     TRESC(); TROT();
            TSTEP(pB0, pB1, pA0, pA1, i + 1, -1, (i + 4 < NT), (i + 2 < NT), (i + 2 < NT));     TENDW(i + 1); TRESC(); TROT();
        }
        TSTEP(pA0, pA1, pB0, pB1, NT - 2, -1, false, true, true); TENDW(NT - 2); TRESC(); TROT();
        TSTEP(pB0, pB1, pA0, pA1, NT - 1, -1, false, false, false); TRESC();
    }
    { float sacc = pB0[0] + pB0[1];
#pragma unroll
      for (int r = 2; r < 16; ++r) sacc += pB0[r];
#pragma unroll
      for (int r = 0; r < 16; ++r) sacc += pB1[r];
      l_reg += sacc;
      pw0 = (u32x4){TPKW(pB0, 0), TPKW(pB0, 2), TPKW(pB0, 4), TPKW(pB0, 6)}; pw1 = (u32x4){TPKW(pB0, 8), TPKW(pB0, 10), TPKW(pB0, 12), TPKW(pB0, 14)};
      pw2 = (u32x4){TPKW(pB1, 0), TPKW(pB1, 2), TPKW(pB1, 4), TPKW(pB1, 6)}; pw3 = (u32x4){TPKW(pB1, 8), TPKW(pB1, 10), TPKW(pB1, 12), TPKW(pB1, 14)};
      TSB(); pv(o, vb0 + sl_cur * T_VSLOT, TPAF(0), TPAF(1), TPAF(2), TPAF(3)); }
    { auto rr = __builtin_amdgcn_permlane32_swap(__float_as_uint(l_reg), __float_as_uint(l_reg), false, false); l_reg = __uint_as_float(rr[0]) + __uint_as_float(rr[1]); }
    if (hi == 0) wsf[32 + r32] = l_reg; asm volatile("s_waitcnt lgkmcnt(0)" ::: "memory");
    float rli[16];
#pragma unroll
    for (int r = 0; r < 16; ++r) rli[r] = __builtin_amdgcn_rcpf(wsf[32 + crow(r, hi)]);
    unsigned char* Ow = (unsigned char*)O + (rowbase + q0 + wid * 32) * OP + h * 64;
    { LAS unsigned char* stg = lds + T_OST + wid * 4096;
#pragma unroll
      for (int r = 0; r < 16; ++r) { const int orow = crow(r, hi);
#pragma unroll
          for (int d0 = 0; d0 < 2; ++d0) { const float ov = o[d0][r] * rli[r] * OSCALE8; stg[orow * 64 + d0 * 32 + r32] = (unsigned char)__builtin_amdgcn_cvt_pk_fp8_f32(ov, ov, 0, false); } }
      asm volatile("s_waitcnt lgkmcnt(0)" ::: "memory");
#pragma unroll
      for (int i = 0; i < 2; ++i) { const int row = i * 16 + (lane >> 2), ch = lane & 3; const u32x4 v = *(const LAS u32x4*)(stg + row * 64 + ch * 16); *(u32x4*)(Ow + (long)row * OP + ch * 16) = v; } }
    asm volatile("s_waitcnt lgkmcnt(0)\n\ts_barrier" ::: "memory");
#undef TDMA_K
#undef TDMA_V
#undef TROT
#undef TBIAS
#undef TCIN
#undef TRESC
#undef TDECIDE
#undef TPKW
#undef TPAF
#undef TVFR
#undef TPIN
#undef TGAPA
#undef TEX
#undef TGAPB
#undef TVRD
#undef TKRD
#undef TMF
#undef TSTEP
#undef TENDW
}
#undef TW_BAR
#undef TSB
}

namespace dn {
constexpr int CHB = 64 * 256;
constexpr int NSLOT = 8, AHEAD = 7;
__device__ __forceinline__ int nloc(int i) { return 16 * ((i >> 2) & 1) + (i & 3) + 4 * (i >> 3); }
template <bool NOTRAFFIC>
__device__ __forceinline__ void down_phase(LAS unsigned char* lds, const unsigned char* HBp, const unsigned char* Wd, const unsigned char* Wsd, volatile LAS int* tab, const u32x2* meta, unsigned char* Yp, unsigned char* trash, int G, int c) {
    int tid = threadIdx.x; asm volatile("" : "+v"(tid));
    const int wid = __builtin_amdgcn_readfirstlane(tid >> 6), lane = tid & 63, j = lane & 31, hi = lane >> 5;
    const int U = tab[65] * 8;
    const int u_lo = (int)(((long)c * U) / G), u_hi = (int)(((long)(c + 1) * U) / G);
    if (u_lo >= u_hi) return;
#define DN_DEC(u_, e_, hf_, ci_) do { e_ = __builtin_amdgcn_readfirstlane(tab[132 + ((u_) >> 3)]); const int ul_ = __builtin_amdgcn_readfirstlane((u_) - 8 * tab[e_]), nc_ = __builtin_amdgcn_readfirstlane(4 * (tab[e_ + 1] - tab[e_])); hf_ = (ul_ >= nc_) ? 1 : 0; ci_ = ul_ - hf_ * nc_; } while (0)
    unsigned dvo; { const int r_ = lane >> 3, f_ = ((r_ >> 1) & 3) << 1; dvo = (unsigned)(r_ * 256 + (((lane & 7) ^ f_) * 16)); }
#define DN_DMA(u_, buf_) do { int e__, hf__, ci__; DN_DEC(u_, e__, hf__, ci__); (void)hf__; const unsigned char* gb_ = HBp + ((size_t)tab[e__] * 256 + (size_t)ci__ * 64) * DEXP; \
        _Pragma("unroll") for (int i_ = 0; i_ < 2; ++i_) { const int q_ = wid * 2 + i_, kb_ = q_ >> 3, g_ = q_ & 7; \
            __builtin_amdgcn_global_load_lds((const unsigned*)(gb_ + (size_t)(8 * g_) * DEXP + kb_ * 128 + dvo), (LAS unsigned*)(lds + (buf_) * CHB + kb_ * 8192 + g_ * 1024), 16, 0, 0); } } while (0)
    int rowb[2], fx[2];
#pragma unroll
    for (int rt = 0; rt < 2; ++rt) { const int row = 32 * rt + j; rowb[rt] = (int)(uintptr_t)lds + row * 128; fx[rt] = (((row >> 1) & 3) << 1) * 16; }
    unsigned sc1 = 0x7f7f7f7fu; asm volatile("" : "+v"(sc1));
#pragma unroll
    for (int p = 0; p < AHEAD; ++p) { const int un = (u_lo + p < u_hi) ? u_lo + p : u_lo; DN_DMA(un, p); }
    int u = u_lo;
    while (u < u_hi) {
      int e, hf, ci0; DN_DEC(u, e, hf, ci0);
      const int nc = __builtin_amdgcn_readfirstlane(4 * (tab[e + 1] - tab[e])), ne = __builtin_amdgcn_readfirstlane(tab[66 + e]);
      int seg_end = 8 * tab[e] + (hf + 1) * nc; seg_end = __builtin_amdgcn_readfirstlane(seg_end < u_hi ? seg_end : u_hi);
      v8i32_t wfr[2][4];
#pragma unroll
      for (int nt = 0; nt < 2; ++nt) { const unsigned char* wp = ((e == NEXP) ? Wsd : Wd + (size_t)e * D * DEXP) + (size_t)(512 * hf + 64 * wid + 32 * nt + nloc(j)) * DEXP + 32 * hi;
#pragma unroll
          for (int ks = 0; ks < 4; ++ks) { wfr[nt][ks].lo = *(const v4i32_t*)(wp + 64 * ks); wfr[nt][ks].hi = *(const v4i32_t*)(wp + 64 * ks + 16); } }
      bool first = true;
      for (; u < seg_end; ++u) {
        const int buf = (u - u_lo) & (NSLOT - 1); (void)ci0;
        const int cidx = __builtin_amdgcn_readfirstlane((u - 8 * tab[e]) - hf * nc);
        u32x2 mt[2];
#pragma unroll
        for (int rt = 0; rt < 2; ++rt) { int pos = 64 * cidx + 32 * rt + j; const bool in = pos < ne; const int sp = pos; pos = (in && e != NEXP) ? pos : 0; const u32x2 m = meta[(size_t)(e == NEXP ? 0 : e) * LISTCAP + pos];
            mt[rt] = !in ? (u32x2){0xffffffffu, 0u} : (e == NEXP) ? (u32x2){(unsigned)(sp * (TOPK + 1) + TOPK), 0x3f800000u} : m; }
        if (first) { __builtin_amdgcn_s_waitcnt(0x0F70); first = false; }
        else { asm volatile("s_waitcnt vmcnt(54)" ::: "memory"); }
        LDS_WAIT(); __builtin_amdgcn_s_barrier();
        { const int un = (u + AHEAD < u_hi) ? u + AHEAD : u; DN_DMA(un, (buf + AHEAD) & (NSLOT - 1)); }
        f32x16 acc[2][2];
#pragma unroll
        for (int rt = 0; rt < 2; ++rt)
#pragma unroll
            for (int nt = 0; nt < 2; ++nt) asm volatile("v_mov_b32 %0, 0\n\tv_mov_b32 %1, 0\n\tv_mov_b32 %2, 0\n\tv_mov_b32 %3, 0\n\tv_mov_b32 %4, 0\n\tv_mov_b32 %5, 0\n\tv_mov_b32 %6, 0\n\tv_mov_b32 %7, 0\n\tv_mov_b32 %8, 0\n\tv_mov_b32 %9, 0\n\tv_mov_b32 %10, 0\n\tv_mov_b32 %11, 0\n\tv_mov_b32 %12, 0\n\tv_mov_b32 %13, 0\n\tv_mov_b32 %14, 0\n\tv_mov_b32 %15, 0"
                : "=v"(acc[rt][nt][0]), "=v"(acc[rt][nt][1]), "=v"(acc[rt][nt][2]), "=v"(acc[rt][nt][3]), "=v"(acc[rt][nt][4]), "=v"(acc[rt][nt][5]), "=v"(acc[rt][nt][6]), "=v"(acc[rt][nt][7]),
                  "=v"(acc[rt][nt][8]), "=v"(acc[rt][nt][9]), "=v"(acc[rt][nt][10]), "=v"(acc[rt][nt][11]), "=v"(acc[rt][nt][12]), "=v"(acc[rt][nt][13]), "=v"(acc[rt][nt][14]), "=v"(acc[rt][nt][15]));
        v8i32_t ha0, ha1, hb0, hb1;
        const int ad0 = rowb[0] + buf * CHB, ad1 = rowb[1] + buf * CHB;
#define DN_RDA(ks_) do { \
            asm volatile("ds_read_b128 v[192:195], %1 offset:%c2\n\tds_read_b128 v[196:199], %1 offset:%c3" : "={v[192:199]}"(ha0) : "v"(ad0 + ((64 * ((ks_) & 1) + 32 * hi) ^ fx[0])), "i"(((ks_) >> 1) * 8192), "i"(((ks_) >> 1) * 8192 + 16) : "memory"); \
            asm volatile("ds_read_b128 v[200:203], %1 offset:%c2\n\tds_read_b128 v[204:207], %1 offset:%c3" : "={v[200:207]}"(ha1) : "v"(ad1 + ((64 * ((ks_) & 1) + 32 * hi) ^ fx[1])), "i"(((ks_) >> 1) * 8192), "i"(((ks_) >> 1) * 8192 + 16) : "memory"); } while (0)
#define DN_RDB(ks_) do { \
            asm volatile("ds_read_b128 v[208:211], %1 offset:%c2\n\tds_read_b128 v[212:215], %1 offset:%c3" : "={v[208:215]}"(hb0) : "v"(ad0 + ((64 * ((ks_) & 1) + 32 * hi) ^ fx[0])), "i"(((ks_) >> 1) * 8192), "i"(((ks_) >> 1) * 8192 + 16) : "memory"); \
            asm volatile("ds_read_b128 v[216:219], %1 offset:%c2\n\tds_read_b128 v[220:223], %1 offset:%c3" : "={v[216:223]}"(hb1) : "v"(ad1 + ((64 * ((ks_) & 1) + 32 * hi) ^ fx[1])), "i"(((ks_) >> 1) * 8192), "i"(((ks_) >> 1) * 8192 + 16) : "memory"); } while (0)
#define DN_MF(W_, ACC_, H_, REG_, WAIT_) asm volatile(WAIT_ "v_mfma_scale_f32_32x32x64_f8f6f4 %0, %1, %2, %0, %3, %3 op_sel_hi:[0,0,0]" : "+v"(ACC_) : "v"(W_), REG_(H_), "v"(sc1))
        DN_RDA(0);
#pragma unroll
        for (int ks = 0; ks < 4; ks += 2) {
            DN_RDB(ks + 1);
            DN_MF(wfr[0][ks], acc[0][0], ha0, "{v[192:199]}", "s_waitcnt lgkmcnt(4)\n\t"); DN_MF(wfr[1][ks], acc[0][1], ha0, "{v[192:199]}", "");
            DN_MF(wfr[0][ks], acc[1][0], ha1, "{v[200:207]}", ""); DN_MF(wfr[1][ks], acc[1][1], ha1, "{v[200:207]}", "");
            if (ks + 2 < 4) { DN_RDA(ks + 2);
                DN_MF(wfr[0][ks + 1], acc[0][0], hb0, "{v[208:215]}", "s_waitcnt lgkmcnt(4)\n\t"); }
            else { DN_MF(wfr[0][ks + 1], acc[0][0], hb0, "{v[208:215]}", "s_waitcnt lgkmcnt(0)\n\t"); }
            DN_MF(wfr[1][ks + 1], acc[0][1], hb0, "{v[208:215]}", "");
            DN_MF(wfr[0][ks + 1], acc[1][0], hb1, "{v[216:223]}", ""); DN_MF(wfr[1][ks + 1], acc[1][1], hb1, "{v[216:223]}", "");
        }
#undef DN_RDA
#undef DN_RDB
#undef DN_MF
        asm volatile("s_nop 15\n\ts_nop 7" : "+v"(acc[0][0]), "+v"(acc[0][1]), "+v"(acc[1][0]), "+v"(acc[1][1]) :: "memory");
        __builtin_amdgcn_sched_barrier(0);
        const int col0 = 512 * hf + 64 * wid + 16 * hi;
#pragma unroll
        for (int rt = 0; rt < 2; ++rt) { const bool ok = !NOTRAFFIC && mt[rt].x != 0xffffffffu; unsigned char* yd = ok ? Yp + (size_t)mt[rt].x * D : trash; const float w = ok ? __uint_as_float(mt[rt].y) * (1.f / (HSCALE8 * WSCALE8)) : 0.f;
#pragma unroll
            for (int nt = 0; nt < 2; ++nt) { u32x4 o;
#pragma unroll
                for (int q = 0; q < 4; ++q) { int v = __builtin_amdgcn_cvt_pk_fp8_f32(acc[rt][nt][4 * q] * w, acc[rt][nt][4 * q + 1] * w, 0, false);
                    v = __builtin_amdgcn_cvt_pk_fp8_f32(acc[rt][nt][4 * q + 2] * w, acc[rt][nt][4 * q + 3] * w, v, true); o[q] = (unsigned)v; }
                *(u32x4*)(yd + col0 + 32 * nt) = o; } }
      }
    }
    VM_WAIT(); LDS_WAIT(); __builtin_amdgcn_s_barrier();
#undef DN_DMA
#undef DN_DEC
}
}

namespace up {
__device__ __forceinline__ int nloc(int i) { return 16 * ((i >> 2) & 1) + (i & 3) + 4 * (i >> 3); }
__device__ __forceinline__ void up_phase(LAS unsigned char* lds, const bf16* QL, const bf16* KVL, const bf16* Wq, const bf16* Wkv, const float* ssqq, const float* ssqkv, const float* ropetab,
                                         bf16* Qo, bf16* KNo, bf16* VMo, int G, int c) {
    int tid = threadIdx.x; asm volatile("" : "+v"(tid));
    const int wid = __builtin_amdgcn_readfirstlane(tid >> 6), lane = tid & 63, j = lane & 31, hi = lane >> 5;
    for (int grp = c; grp < T / 64; grp += G) {
        const int row0 = grp * 64;
        { const int r_ = lane >> 3, p_ = lane & 7;
#pragma unroll
          for (int i = 0; i < 6; ++i) { const int q_ = wid * 6 + i;
              const bool isq = q_ < 32; const int rem = isq ? q_ : q_ - 32, kb = rem >> 3, g = rem & 7, f_ = (4 * (g & 1) + (r_ >> 1)) & 7;
              __builtin_amdgcn_global_load_lds((const unsigned*)((isq ? QL : KVL) + (size_t)(row0 + 8 * g + r_) * 256 + kb * 64 + ((p_ ^ f_) * 8)), (LAS unsigned*)(lds + (isq ? 0 : 32768) + kb * 8192 + g * 1024), 16, 0, 0); } }
        float rsq[2], rskv[2];
#pragma unroll
        for (int rt = 0; rt < 2; ++rt) { const int row = row0 + 32 * rt + j; const f32x4 a = *(const f32x4*)(ssqq + (size_t)row * 4), b4 = *(const f32x4*)(ssqkv + (size_t)row * 4);
            rsq[rt] = rsqrtf(((a[0] + a[1]) + (a[2] + a[3])) * (1.f / QLORA) + EPS) * C2M; rskv[rt] = rsqrtf(((b4[0] + b4[1]) + (b4[2] + b4[3])) * (1.f / KVLORA) + EPS); }
        const unsigned lane16 = (unsigned)lane * 16u;
        bf16x8 wA[16];
#define UP_LOADW(WB_, Wp_, col_, KS_) do { const char* wb_ = (const char*)(Wp_) + (size_t)__builtin_amdgcn_readfirstlane((col_) >> 5) * (KS_) * 1024;     \
            _Pragma("unroll") for (int ks = 0; ks < (KS_); ++ks) wA[(WB_) + ks] = *(const bf16x8*)(wb_ + ks * 1024 + lane16); } while (0)
#define UP_STEP(WB_, ISQ_, col_, KS_) do { f32x16 acc[2]; acc[0] = f32x16{}; acc[1] = f32x16{}; \
            _Pragma("unroll") for (int ks = 0; ks < (KS_); ++ks) { bf16x8 af[2]; \
                _Pragma("unroll") for (int rt = 0; rt < 2; ++rt) { const int row = 32 * rt + j, cc = 2 * (ks & 3) + hi; \
                    af[rt] = *(const LAS bf16x8*)(lds + ((ISQ_) ? 0 : 32768) + (ks >> 2) * 8192 + row * 128 + ((cc ^ ((row >> 1) & 7)) * 16)); } \
                _Pragma("unroll") for (int rt = 0; rt < 2; ++rt) acc[rt] = __builtin_amdgcn_mfma_f32_32x32x16_bf16(wA[(WB_) + ks], af[rt], acc[rt], 0, 0, 0); } \
            _Pragma("unroll") for (int rt = 0; rt < 2; ++rt) { const int row = row0 + 32 * rt + j; const float r_s = (ISQ_) ? rsq[rt] : rskv[rt]; const int col = (col_) + 16 * hi; \
                float v[16]; _Pragma("unroll") for (int r = 0; r < 16; ++r) v[r] = acc[rt][r] * r_s; \
                bf16* dst; \
                if (ISQ_) { const int jh = col % MQK; \
                    if (jh >= 64) { const int g0 = (jh - 64) >> 3; const f32x4* tb = (const f32x4*)(ropetab + ((size_t)row * 16 + 4 * g0) * 2); \
                        _Pragma("unroll") for (int gg = 0; gg < 2; ++gg) { const f32x4 t0 = tb[2 * gg], t1 = tb[2 * gg + 1]; float* w_ = v + 8 * gg; \
                            const float cs[4] = {t0[0], t0[2], t1[0], t1[2]}, sn[4] = {t0[1], t0[3], t1[1], t1[3]}; \
                            _Pragma("unroll") for (int q = 0; q < 4; ++q) { const float x1 = w_[q], x2 = w_[4 + q]; w_[q] = x1 * cs[q] - x2 * sn[q]; w_[4 + q] = x2 * cs[q] + x1 * sn[q]; } } } \
                    dst = Qo + (size_t)row * 768 + col; } \
                else dst = (col >= 512 ? VMo + (col - 512) : KNo + col) + (size_t)row * 512; \
                *(u32x4*)dst = (u32x4){cvt_pk_bf16(v[0], v[1]), cvt_pk_bf16(v[2], v[3]), cvt_pk_bf16(v[4], v[5]), cvt_pk_bf16(v[6], v[7])}; \
                *(u32x4*)(dst + 8) = (u32x4){cvt_pk_bf16(v[8], v[9]), cvt_pk_bf16(v[10], v[11]), cvt_pk_bf16(v[12], v[13]), cvt_pk_bf16(v[14], v[15])}; } } while (0)
        const int cq = 96 * wid, ckv = 128 * wid;
#define UP_SB() __builtin_amdgcn_sched_barrier(0)
        UP_LOADW(0, Wq, cq, 16);
        VM_WAIT(); __syncthreads();
        UP_STEP(0, true, cq, 16);        UP_SB(); UP_LOADW(0, Wq, cq + 32, 16); UP_SB();
        UP_STEP(0, true, cq + 32, 16);   UP_SB(); UP_LOADW(0, Wq, cq + 64, 16); UP_SB();
        UP_STEP(0, true, cq + 64, 16);   UP_SB(); UP_LOADW(0, Wkv, ckv, 8); UP_LOADW(8, Wkv, ckv + 32, 8); UP_SB();
        UP_STEP(0, false, ckv, 8);       UP_SB(); UP_LOADW(0, Wkv, ckv + 64, 8); UP_SB();
        UP_STEP(8, false, ckv + 32, 8);  UP_SB(); UP_LOADW(8, Wkv, ckv + 96, 8); UP_SB();
        UP_STEP(0, false, ckv + 64, 8);  UP_SB();
        UP_STEP(8, false, ckv + 96, 8);
#undef UP_SB
#undef UP_LOADW
#undef UP_STEP
        __syncthreads();
    }
}
}

#define XB_TMO      128
#define XB_XCNT(j)  (256  + 64 * (j))
#define XB_XSUB(j)  (1280 + 64 * (j))
#define XB_XGEN(j)  (2304 + 64 * (j))
#define XB_TOP      3328
#define XB_TOPGEN   3392
#define XCD_BAR_WORDS 3456
#define XB_SPIN_CAP (1u << 18)
__device__ __forceinline__ unsigned xb_ld(unsigned* p)              { return __hip_atomic_load(p, __ATOMIC_RELAXED, __HIP_MEMORY_SCOPE_AGENT); }
__device__ __forceinline__ unsigned xb_add(unsigned* p, unsigned v) { return __hip_atomic_fetch_add(p, v, __ATOMIC_RELAXED, __HIP_MEMORY_SCOPE_AGENT); }
__device__ __forceinline__ unsigned xb_xcc_id() { return (unsigned)__builtin_amdgcn_s_getreg((3 << 11) | 20) & 0xFu; }
#define XB_SPIN(cond, bar) do { unsigned _sp = 0; while (cond) { __builtin_amdgcn_s_sleep(1); \
    if ((++_sp & 255u) == 0u) { if (xb_ld(&(bar)[XB_TMO])) break; if (_sp > XB_SPIN_CAP) { atomicAdd(&(bar)[XB_TMO], 1u); break; } } } } while (0)
struct XcdBarrier { unsigned* bar; unsigned x; volatile LAS unsigned* st; };
__device__ __forceinline__ XcdBarrier xcd_barrier_post(unsigned* bar, volatile LAS unsigned* st) {
    XcdBarrier b; b.bar = bar; b.x = xb_xcc_id(); b.st = st;
    if (threadIdx.x == 0) (void)xb_add(&bar[XB_XCNT(b.x)], 1u);
    return b;
}
__device__ __forceinline__ void xcd_barrier_complete(unsigned* bar, unsigned x, unsigned& nloc, unsigned& nx) {
    const unsigned G = gridDim.x * gridDim.y * gridDim.z;
    unsigned sum, cnt, mine, sp = 0u;
    for (;;) {
        sum = 0u; cnt = 0u; mine = 0u;
#pragma unroll
        for (unsigned j = 0; j < 16; ++j) { const unsigned c = xb_ld(&bar[XB_XCNT(j)]); sum += c; cnt += (c > 0u) ? 1u : 0u; mine = (j == x) ? c : mine; }
        if (sum == G) break;
        __builtin_amdgcn_s_sleep(1);
        if ((++sp & 255u) == 0u) { if (xb_ld(&bar[XB_TMO])) break; if (sp > XB_SPIN_CAP) { atomicAdd(&bar[XB_TMO], 1u); break; } }
    }
    nloc = mine > 0u ? mine : 1u; nx = cnt > 0u ? cnt : 1u;
}
__device__ __forceinline__ void xcd_barrier(const XcdBarrier& b) {
    asm volatile("s_waitcnt vmcnt(0)" ::: "memory");
    __syncthreads();
    if (threadIdx.x == 0) {
        unsigned* bar = b.bar;
        __builtin_amdgcn_s_waitcnt(0);
        unsigned nloc = b.st[0], nx = b.st[1];
        if (nloc == 0u) { xcd_barrier_complete(bar, b.x, nloc, nx); b.st[0] = nloc; b.st[1] = nx; }
        const unsigned old = xb_add(&bar[XB_XSUB(b.x)], 1u);
        const unsigned gen = old / nloc;
        if (old + 1u == (gen + 1u) * nloc) {
            __builtin_amdgcn_fence(__ATOMIC_RELEASE, "agent");
            asm volatile("s_waitcnt vmcnt(0)" ::: "memory");
            const unsigned og = xb_add(&bar[XB_TOP], 1u);
            const unsigned tg = og / nx;
            if (og + 1u == (tg + 1u) * nx) xb_add(&bar[XB_TOPGEN], 1u);
            else XB_SPIN(xb_ld(&bar[XB_TOPGEN]) == tg, bar);
            __builtin_amdgcn_fence(__ATOMIC_ACQUIRE, "agent");
            xb_add(&bar[XB_XGEN(b.x)], 1u);
            asm volatile("s_waitcnt vmcnt(0)" ::: "memory");
        } else {
            XB_SPIN(xb_ld(&bar[XB_XGEN(b.x)]) == gen, bar);
            __builtin_amdgcn_fence(__ATOMIC_ACQUIRE, "agent");
            asm volatile("s_waitcnt vmcnt(0)" ::: "memory");
        }
    }
    __syncthreads();
}

struct Args { const void* in[25]; float* out; unsigned char* ws; int ph_lo, ph_hi; };

struct Frame {
    LAS unsigned char* lds;
    int tid, lane, wave, vcu, G;
};

template <class ColFn>
__device__ __forceinline__ void cvt_item(int ldw, int Ksrc, const float* kscale, bf16* WT, int Kd, LAS float* scr, int kb, int nb, int lane, ColFn colp) {
    const int k0 = 64 * kb, n0 = 32 * nb;
    const float* cp = colp(n0 + (lane & 31));
    float vv[32], sv[32];
#pragma unroll
    for (int i = 0; i < 32; ++i) { const int k = k0 + 2 * i + (lane >> 5);
        vv[i] = (cp != nullptr && k < Ksrc) ? cp[(size_t)k * ldw] : 0.f;
        sv[i] = (kscale != nullptr && k < Ksrc) ? kscale[k] : 1.f; }
#pragma unroll
    for (int i = 0; i < 32; ++i) scr[(2 * i + (lane >> 5)) * 33 + (lane & 31)] = vv[i] * sv[i];
    LDS_WAIT(); asm volatile("" ::: "memory");
    const int c = lane & 7;
#pragma unroll
    for (int j = 0; j < 4; ++j) { const int n = (lane >> 3) + 8 * j; const LAS float* s = scr + (8 * c) * 33 + n;
        u32x4 o; o.x = pk2(s[0 * 33], s[1 * 33]); o.y = pk2(s[2 * 33], s[3 * 33]); o.z = pk2(s[4 * 33], s[5 * 33]); o.w = pk2(s[6 * 33], s[7 * 33]);
        *(u32x4*)(WT + (size_t)(n0 + n) * Kd + k0 + 8 * c) = o; }
    LDS_WAIT(); asm volatile("" ::: "memory");
}
__device__ __forceinline__ void cvt64_item(const float* src, int ldw, bf16* dst, int Kd, LAS unsigned char* scr, int lane) {
    f32x4 v[16];
    const float* sp = src + (size_t)(lane >> 4) * ldw + 4 * (lane & 15);
#pragma unroll
    for (int i = 0; i < 16; ++i) v[i] = __builtin_nontemporal_load((const f32x4*)(sp + (size_t)(4 * i) * ldw));
#pragma unroll
    for (int i = 0; i < 16; ++i) { const int k = 4 * i + (lane >> 4);
#pragma unroll
        for (int q = 0; q < 4; ++q) { const int n = 4 * (lane & 15) + q; *(LAS bf16*)(scr + n * 128 + (((k >> 3) ^ ((n >> 2) & 7)) << 4) + (k & 7) * 2) = (bf16)f2bf(v[i][q]); } }
    LDS_WAIT(); asm volatile("" ::: "memory");
#pragma unroll
    for (int j = 0; j < 8; ++j) { const int p = j * 64 + lane, n = p >> 3, c = p & 7;
        const u32x4 o = *(const LAS u32x4*)(scr + n * 128 + ((c ^ ((n >> 2) & 7)) << 4));
        __builtin_nontemporal_store(o, (u32x4*)(dst + (size_t)n * Kd + c * 8)); }
    LDS_WAIT(); asm volatile("" ::: "memory");
}
__device__ __forceinline__ void cvt64_item8(const float* src, int ldw, unsigned char* dst, int Kd8, LAS unsigned char* scr, int lane, float scale) {
    f32x4 v[16];
    const float* sp = src + (size_t)(16 * (lane >> 4)) * ldw + 4 * (lane & 15);
#pragma unroll
    for (int i = 0; i < 16; ++i) v[i] = __builtin_nontemporal_load((const f32x4*)(sp + (size_t)i * ldw));
#pragma unroll
    for (int q = 0; q < 4; ++q) { u32x4 o;
#pragma unroll
        for (int g = 0; g < 4; ++g) { int p_ = __builtin_amdgcn_cvt_pk_fp8_f32(v[4 * g][q] * scale, v[4 * g + 1][q] * scale, 0, false); p_ = __builtin_amdgcn_cvt_pk_fp8_f32(v[4 * g + 2][q] * scale, v[4 * g + 3][q] * scale, p_, true); o[g] = (unsigned)p_; }
        *(LAS u32x4*)(scr + (4 * (lane & 15) + q) * 80 + (lane >> 4) * 16) = o; }
    LDS_WAIT(); asm volatile("" ::: "memory");
#pragma unroll
    for (int j = 0; j < 4; ++j) { const int p = j * 64 + lane, n = p >> 2, c = p & 3;
        const u32x4 o = *(const LAS u32x4*)(scr + n * 80 + c * 16);
        __builtin_nontemporal_store(o, (u32x4*)(dst + (size_t)n * Kd8 + c * 16)); }
    LDS_WAIT(); asm volatile("" ::: "memory");
}
__device__ __forceinline__ void cvt128_item8(const float* src, int ldw, unsigned char* dst, int Kd8, LAS unsigned char* scr, int lane, float scale) {
    f32x4 v[32];
    const float* sp = src + (size_t)(32 * (lane >> 4)) * ldw + 4 * (lane & 15);
#pragma unroll
    for (int i = 0; i < 32; ++i) v[i] = __builtin_nontemporal_load((const f32x4*)(sp + (size_t)i * ldw));
#pragma unroll
    for (int q = 0; q < 4; ++q) {
#pragma unroll
        for (int hf = 0; hf < 2; ++hf) { u32x4 o;
#pragma unroll
            for (int g = 0; g < 4; ++g) { const int i0 = 16 * hf + 4 * g; int p_ = __builtin_amdgcn_cvt_pk_fp8_f32(v[i0][q] * scale, v[i0 + 1][q] * scale, 0, false); p_ = __builtin_amdgcn_cvt_pk_fp8_f32(v[i0 + 2][q] * scale, v[i0 + 3][q] * scale, p_, true); o[g] = (unsigned)p_; }
            *(LAS u32x4*)(scr + (4 * (lane & 15) + q) * 144 + (lane >> 4) * 32 + 16 * hf) = o; } }
    LDS_WAIT(); asm volatile("" ::: "memory");
#pragma unroll
    for (int j = 0; j < 8; ++j) { const int p = j * 64 + lane, n = p >> 3, c = p & 7;
        const u32x4 o = *(const LAS u32x4*)(scr + n * 144 + c * 16);
        __builtin_nontemporal_store(o, (u32x4*)(dst + (size_t)n * Kd8 + c * 16)); }
    LDS_WAIT(); asm volatile("" ::: "memory");
}
__device__ __forceinline__ int ropedim(int jj) { const int g = jj >> 3, u = jj & 7; return (u < 4) ? 4 * g + u : 16 + 4 * g + (u - 4); }

__device__ __forceinline__ void sincos_acc(float af, float& sn, float& cs) {
    const double a = (double)af; const double kq = __builtin_rint(a * 0.63661977236758134308);
    const double r = (a - kq * 1.57079632679489655800) - kq * 6.123233995736766036e-17;
    const double r2 = r * r;
    const double sp = r * (1.0 + r2 * (-1.66666666666666324348e-01 + r2 * (8.33333333332248946124e-03 + r2 * (-1.98412698298579493134e-04 + r2 * (2.75573137070700676789e-06 + r2 * (-2.50507602534068634195e-08 + r2 * 1.58969099521155010221e-10))))));
    const double cp = 1.0 + r2 * (-0.5 + r2 * (4.16666666666666019037e-02 + r2 * (-1.38888888888741095749e-03 + r2 * (2.48015872894767294178e-05 + r2 * (-2.75573143513906633035e-07 + r2 * (2.08757232129817482790e-09 + r2 * -1.13596475577881948265e-11))))));
    const int q = (int)((long long)kq & 3);
    const double s_ = (q == 0) ? sp : (q == 1) ? cp : (q == 2) ? -sp : -cp;
    const double c_ = (q == 0) ? cp : (q == 1) ? -sp : (q == 2) ? -cp : sp;
    sn = (float)s_; cs = (float)c_;
}

__global__ void __launch_bounds__(NWAVES * 64, 2) fwd(Args args) {
    extern __shared__ __attribute__((aligned(16))) unsigned char lds_raw[];
    Frame F;
    F.lds = (LAS unsigned char*)lds_raw;
    F.tid = threadIdx.x; F.lane = F.tid & 63; F.wave = __builtin_amdgcn_readfirstlane(F.tid >> 6);
    F.G = gridDim.x; { const int bx = blockIdx.x; F.vcu = (F.G % 8 == 0) ? (bx % 8) * (F.G / 8) + bx / 8 : bx; }
    volatile LAS unsigned* MISC = (volatile LAS unsigned*)(F.lds + MISC_OFF);
    unsigned char* ws = args.ws;
    gu32* ctl = (gu32*)(ws + WS_CTL);
#define X_IN ((const float*)AP->in[0])
#define cvec ((const float*)AP->in[1])
#define positions ((const int*)AP->in[2])
#define w_mod ((const float*)AP->in[3])
#define b_mod ((const float*)AP->in[4])
#define g_mix ((const float*)AP->in[5])
#define w_in ((const float*)AP->in[6])
#define b_forget ((const float*)AP->in[7])
#define g_q_lat ((const float*)AP->in[8])
#define w_q_up ((const float*)AP->in[9])
#define g_kv_lat ((const float*)AP->in[10])
#define w_kv_up ((const float*)AP->in[11])
#define w_o_mla ((const float*)AP->in[12])
#define w_o_fox ((const float*)AP->in[13])
#define w_out ((const float*)AP->in[14])
#define g_ffn ((const float*)AP->in[15])
#define w_router ((const float*)AP->in[16])
#define b_router ((const float*)AP->in[17])
#define w_exp_gate ((const float*)AP->in[18])
#define w_exp_up ((const float*)AP->in[19])
#define w_exp_down ((const float*)AP->in[20])
#define w_sh_gate ((const float*)AP->in[21])
#define w_sh_up ((const float*)AP->in[22])
#define w_sh_down ((const float*)AP->in[23])
#define g_final ((const float*)AP->in[24])
#define Win_t ((bf16*)(ws + WS_WIN))
#define Wq_t ((bf16*)(ws + WS_WQ))
#define Wkv_t ((bf16*)(ws + WS_WKV))
#define Wom_t ((bf16*)(ws + WS_WOM))
#define Wof_t ((bf16*)(ws + WS_WOF))
#define Wout_t ((bf16*)(ws + WS_WOUT))
#define Wsgu_t ((bf16*)(ws + WS_WSGU))
#define Wsd_t ((bf16*)(ws + WS_WSD))
#define Wr_f ((bf16*)(ws + WS_WR))
#define mod ((float*)(ws + WS_MOD))
#define Wd_t ((bf16*)(ws + WS_WD))
#define Wgu_t ((bf16*)(ws + WS_WGU))
#define HB ((bf16*)(ws + WS_HB))
#define FQ ((bf16*)(ws + WS_FQ))
#define FK ((bf16*)(ws + WS_FK))
#define FV ((bf16*)(ws + WS_FV))
#define QLAT ((bf16*)(ws + WS_QLAT))
#define KVLAT ((bf16*)(ws + WS_KVLAT))
#define OFOX ((bf16*)(ws + WS_OFOX))
#define OCAT ((bf16*)((unsigned char*)out + 32 * MiB))
#define OMLA ((bf16*)(ws + WS_OMLA))
#define Y ((bf16*)(ws + WS_Y))
#define H ((bf16*)(ws + WS_H))
#define QMLA ((bf16*)(ws + WS_QMLA))
#define GATES ((bf16*)(ws + WS_GATES))
#define KN ((bf16*)(ws + WS_KN))
#define VM ((bf16*)(ws + WS_VM))
#define KPE ((bf16*)(ws + WS_KPE))
#define MERGED ((bf16*)(ws + WS_MERGED))
#define LIST ((unsigned short*)(ws + WS_LIST))
#define Wgu8 ((unsigned char*)(ws + WS_WGU))
#define Wsgu8 ((unsigned char*)(ws + WS_WSGU))
#define H8 ((unsigned char*)(ws + WS_H))
#define META ((u32x2*)(ws + WS_WIN))
#define EIDX ((unsigned char*)(ws + WS_EIDX))
#define GATEW ((float*)(ws + WS_GATEW))
#define ROPETAB ((float*)((unsigned char*)out + DO_ROPE))
#define LOGF ((float*)((unsigned char*)out + DO_LOGF))
#define CUMF ((float*)((unsigned char*)out + DO_CUMF))
#define SSQQ ((float*)((unsigned char*)out + DO_SSQQ))
#define SSQKV ((float*)((unsigned char*)out + DO_SSQKV))
#define MODP ((float*)((unsigned char*)out + DO_MODP))
#define X1B ((bf16*)(ws + WS_X1B))
#define SSQ1 ((float*)(ws + WS_FQ))
    float* const out = args.out;
#define PHASE_ENV const __attribute__((address_space(4))) Args* AP; { auto kp_ = __builtin_amdgcn_kernarg_segment_ptr(); asm volatile("" : "+s"(kp_)); AP = (const __attribute__((address_space(4))) Args*)kp_; } \
    unsigned char* const ws = AP->ws; float* const out = AP->out; (void)ws; (void)out;
    for (int u = F.tid; u < (LDS_BYTES - LDSCTL_OFF) / 4; u += NWAVES * 64) ((LAS unsigned*)(F.lds + LDSCTL_OFF))[u] = 0u;
    __syncthreads();
    XcdBarrier bar; bar.bar = (unsigned*)(ctl + CW_BAR); bar.x = 0; bar.st = nullptr;
    if (MK_ONE_LAUNCH) bar = xcd_barrier_post((unsigned*)(ctl + CW_BAR), MISC + 8);
    const int lo = args.ph_lo, hi = args.ph_hi;
#define IN(k) (lo <= (k) && (k) < hi)
#define BOTH(k) (IN(k) && IN((k) + 1))
#define GRID_BAR() do { if (MK_ONE_LAUNCH) xcd_barrier(bar); } while (0)
#define DUP_BAR() do { if (dummy) xcd_barrier(bar); } while (0)
    const int gw = F.vcu * NWAVES + F.wave, NGW = F.G * NWAVES;

    for (int rep = 0; rep < ((PROBE_DUP == 0) ? 2 : 1); ++rep) if (IN(0)) { PHASE_ENV const bool dummy = (PROBE_DUP == 0) && rep == 0; (void)dummy;
        if (!(dummy && (PROBE_VAR == 1 || PROBE_VAR == 4 || PROBE_VAR == 5))) {
            LAS float* cond = (LAS float*)F.lds;
            for (int i = F.tid; i < NB * D; i += NWAVES * 64) { const float c = cvec[i]; cond[i] = c / (1.f + __expf(-c)); }
            __syncthreads();
            for (int it = F.wave * F.G + F.vcu; it < 96 * 16; it += NWAVES * F.G) { const int cg = it % 96, kq = it / 96, col = cg * 64 + F.lane;
                float a4[4] = {0.f, 0.f, 0.f, 0.f};
                const float* wp = w_mod + (size_t)(64 * kq) * (6 * D) + col;
                float wv[64];
#pragma unroll
                for (int kk = 0; kk < 64; ++kk) wv[kk] = __builtin_nontemporal_load(wp + (size_t)kk * (6 * D));
#pragma unroll
                for (int kk = 0; kk < 64; ++kk) {
#pragma unroll
                    for (int b = 0; b < 4; ++b) a4[b] += wv[kk] * cond[b * D + 64 * kq + kk]; }
#pragma unroll
                for (int b = 0; b < 4; ++b) MODP[((size_t)kq * 4 + b) * (6 * D) + col] = a4[b]; }
            __syncthreads();
        }
        if (!(dummy && (PROBE_VAR == 1 || PROBE_VAR == 3 || PROBE_VAR == 5))) for (int i = gw * 64 + F.lane; i < T * 16; i += NGW * 64) { const int t = i >> 4, j = i & 15;
            const float invf = (((j >> 2) == 0) ? 1.f : ((j >> 2) == 1) ? 0.1f : ((j >> 2) == 2) ? 0.01f : 0.001f) * (((j & 3) == 0) ? 1.f : ((j & 3) == 1) ? 0.5623413251903491f : ((j & 3) == 2) ? 0.31622776601683794f : 0.17782794100389228f);
            const float ang = (float)positions[t] * invf; float sn, cs; sincos_acc(ang, sn, cs);
            *(f32x2*)(ROPETAB + (size_t)i * 2) = (f32x2){cs, sn}; }
        for (int o = gw * 64 + F.lane; o < NEXP * D; o += NGW * 64) { const int piece = o >> 3, kk = o & 7, ln = piece & 63, grp = piece >> 6, ntl = grp & 3, j = grp >> 2;
            const int n = ntl * 16 + (ln & 15), k = j * 32 + (ln >> 4) * 8 + kk; Wr_f[o] = (bf16)f2bf(w_router[(size_t)k * NEXP + n]); }
        {
            LAS unsigned char* scr8 = F.lds + 32768 + F.wave * 9216;
            constexpr int F_IN = 62 * 16;
            if (!(dummy && PROBE_VAR >= 2)) for (int it = gw; it < F_IN; it += NGW) {
                int nb = it % 62; const int kb = it / 62; if (nb >= 6) nb += 2; const int n0 = 64 * nb;
                const int src = (n0 < 384) ? n0 : (n0 < 2048) ? 416 + (n0 - 512) : 1960 + (n0 - 2048);
                cvt64_item(w_in + (size_t)(64 * kb) * 4008 + src, 4008, Win_t + (size_t)n0 * D + 64 * kb, D, scr8, F.lane);
            }
            LAS float* scr = (LAS float*)(F.lds + 32768 + F.wave * 9216);
            constexpr int I_INS = 4 * (D / 64), NSLOW = I_INS;
            if (!(dummy && (PROBE_VAR == 1 || PROBE_VAR == 3 || PROBE_VAR == 4))) for (int it = F.wave * F.G + F.vcu; it < NSLOW; it += NGW) {
                const int nb = 12 + (it & 3), kb = it >> 2;
                cvt_item(4008, D, nullptr, Win_t, D, scr, kb, nb, F.lane, [&](int n) -> const float* {
                    int src; if (n < 416) src = 384 + ropedim(n - 384); else if (n < 424) src = 1952 + (n - 416); else src = -1;
                    return src < 0 ? nullptr : w_in + src; });
            }
            if (!(dummy && (PROBE_VAR == 1 || PROBE_VAR == 3 || PROBE_VAR == 4))) {
                for (int o = gw * 64 + F.lane; o < 768 * QLORA; o += NGW * 64) { const int cb = o >> 13, rem = o & 8191, ks = rem >> 9, ln = (rem >> 3) & 63, e = rem & 7;
                    const int n = cb * 32 + up::nloc(ln & 31), k = 16 * ks + 8 * (ln >> 5) + e, hh = n / MQK, jj = n % MQK, sc = hh * MQK + (jj < 64 ? jj : 64 + ropedim(jj - 64));
                    Wq_t[o] = (bf16)f2bf(w_q_up[(size_t)k * 768 + sc] * g_q_lat[k]); }
                for (int o = gw * 64 + F.lane; o < 1024 * KVLORA; o += NGW * 64) { const int cb = o >> 12, rem = o & 4095, ks = rem >> 9, ln = (rem >> 3) & 63, e = rem & 7;
                    const int n = cb * 32 + up::nloc(ln & 31), k = 16 * ks + 8 * (ln >> 5) + e, sc = (n < 512) ? (n >> 6) * 128 + (n & 63) : ((n - 512) >> 6) * 128 + 64 + (n & 63);
                    Wkv_t[o] = (bf16)f2bf(w_kv_up[(size_t)k * 1024 + sc] * g_kv_lat[k]); }
            }
        }
        if (BOTH(0)) GRID_BAR();
    }

    for (int rep = 0; rep < ((PROBE_DUP == 1) ? 2 : 1); ++rep) if (IN(1)) { PHASE_ENV const bool dummy = (PROBE_DUP == 1) && rep == 0; (void)dummy;
        if (F.vcu < 48) { const int idx = F.vcu * 512 + F.tid, b = idx / (6 * D), col = idx % (6 * D); float sm = b_mod[col];
#pragma unroll
            for (int p = 0; p < 16; ++p) sm += MODP[((size_t)p * 4 + b) * (6 * D) + col];
            mod[idx] = sm; }
        LAS float* vg1 = (LAS float*)F.lds; LAS float* vs1 = (LAS float*)(F.lds + 4096);
        for (int grp = F.vcu; grp < T / 64; grp += F.G) {
            const int b = (grp * 64) / SEQ;
            __syncthreads();
            for (int k = F.tid; k < D; k += NWAVES * 64) { float s0 = b_mod[k], s1 = b_mod[D + k];
#pragma unroll
                for (int p = 0; p < 16; ++p) { s0 += MODP[((size_t)p * 4 + b) * (6 * D) + k]; s1 += MODP[((size_t)p * 4 + b) * (6 * D) + D + k]; }
                vs1[k] = s0; vg1[k] = g_mix[k] * (1.f + s1); }
            __syncthreads();
#pragma unroll 2
            for (int rr = 0; rr < 8; ++rr) { const int m = grp * 64 + F.wave * 8 + rr;
                const f32x4* xr = (const f32x4*)(X_IN + (size_t)m * D) + F.lane;
                f32x4 v[4]; float s = 0.f;
#pragma unroll
                for (int j = 0; j < 4; ++j) { v[j] = __builtin_nontemporal_load(xr + 64 * j); s += (v[j].x * v[j].x + v[j].y * v[j].y) + (v[j].z * v[j].z + v[j].w * v[j].w); }
                const float rstd = rsqrtf(wave_sum(s) * (1.f / D) + EPS);
                unsigned long long* o8 = (unsigned long long*)(H + (size_t)m * D) + F.lane;
#pragma unroll
                for (int j = 0; j < 4; ++j) { const int c = 4 * F.lane + 256 * j;
                    const f32x4 g = *(const LAS f32x4*)(vg1 + c), d = *(const LAS f32x4*)(vs1 + c);
                    const f32x4 r = v[j] * rstd * g + d;
                    o8[64 * j] = (unsigned long long)pk2(r.x, r.y) | ((unsigned long long)pk2(r.z, r.w) << 32); } }
        }
        if (BOTH(1)) GRID_BAR();
    }

    for (int rep = 0; rep < ((PROBE_DUP == 2) ? 2 : 1); ++rep) if (IN(2)) { PHASE_ENV const bool dummy = (PROBE_DUP == 2) && rep == 0; (void)dummy;
        pg8::StaticOrder S; S.init(H, Win_t, T, NIN, D, F.G, (int)blockIdx.x);
        EpiInProj E{QLAT, KVLAT, KPE, FQ, GATES, LOGF, SSQQ, SSQKV, ROPETAB, b_forget, dummy && (PROBE_VAR == 1), (dummy && PROBE_VAR == 2) ? 0 : (dummy && PROBE_VAR == 3) ? 2 : 1};
        pg8::gemm_phase<EpiInProj, pg8::StaticOrder, true>(F.lds, S, E);
        if (BOTH(2)) GRID_BAR();
    }

    for (int rep = 0; rep < ((PROBE_DUP == 3) ? 2 : 1); ++rep) if (IN(3)) { PHASE_ENV const bool dummy = (PROBE_DUP == 3) && rep == 0; (void)dummy;
        if (!(dummy && (PROBE_VAR == 2 || PROBE_VAR == 3))) {
            const int bb = F.vcu & 3; float mx = 0.f, mq = 0.f;
            for (int r = (F.vcu >> 2) * NWAVES + F.wave; r < SEQ; r += (F.G >> 2) * NWAVES) { f32x4 k0, k1, q0v, q1v; unpack8(*(const u32x4*)(FK + ((size_t)bb * SEQ + r) * 512 + 8 * F.lane), k0, k1);
                unpack8(*(const u32x4*)(FQ + ((size_t)bb * SEQ + r) * 512 + 8 * F.lane), q0v, q1v);
                float sq = (k0[0] * k0[0] + k0[1] * k0[1]) + (k0[2] * k0[2] + k0[3] * k0[3]) + (k1[0] * k1[0] + k1[1] * k1[1]) + (k1[2] * k1[2] + k1[3] * k1[3]);
                float sqq = (q0v[0] * q0v[0] + q0v[1] * q0v[1]) + (q0v[2] * q0v[2] + q0v[3] * q0v[3]) + (q1v[0] * q1v[0] + q1v[1] * q1v[1]) + (q1v[2] * q1v[2] + q1v[3] * q1v[3]);
                sq += dppf<0xB1>(sq); sq += dppf<0x4E>(sq); sq += dppf<0x141>(sq);
                sqq += dppf<0xB1>(sqq); sqq += dppf<0x4E>(sqq); sqq += dppf<0x141>(sqq);
                mx = fmaxf(mx, sq); mq = fmaxf(mq, sqq); }
            LAS float* kml = (LAS float*)F.lds;
            if ((F.lane & 7) == 0) { kml[F.wave * 8 + (F.lane >> 3)] = mx; kml[64 + F.wave * 8 + (F.lane >> 3)] = mq; }
            __syncthreads();
            if (F.tid < 2 * NHEAD) { const int hh = F.tid & 7, qk = F.tid >> 3; float m2 = 0.f;
#pragma unroll
                for (int w = 0; w < NWAVES; ++w) m2 = fmaxf(m2, kml[qk * 64 + w * 8 + hh]);
                atomicMax((unsigned*)(ctl + CW_KM + qk * 32 + bb * NHEAD + hh), __float_as_uint(m2)); }
            __syncthreads();
        }
        if (F.vcu < NB * NHEAD && !(dummy && (PROBE_VAR == 1 || PROBE_VAR == 3))) {
            const int b = F.vcu >> 3, h = F.vcu & 7; const float* src = LOGF + ((size_t)b * SEQ + 8 * F.tid) * 8 + h;
            float v[8]; float run = 0.f;
#pragma unroll
            for (int i = 0; i < 8; ++i) v[i] = src[i * 8];
#pragma unroll
            for (int i = 0; i < 8; ++i) { run += v[i]; v[i] = run; }
            float incl = run;
#pragma unroll
            for (int o = 1; o < 64; o <<= 1) { const float n = __shfl_up(incl, o); if (F.lane >= o) incl += n; }
            LAS float* wt = (LAS float*)F.lds;
            if (F.lane == 63) wt[F.wave] = incl;
            __syncthreads();
            float woff = 0.f;
#pragma unroll
            for (int w = 0; w < NWAVES; ++w) woff += (w < F.wave) ? wt[w] : 0.f;
            const float excl = woff + incl - run;
            float* dst = CUMF + ((size_t)b * NHEAD + h) * SEQ + 8 * F.tid;
            *(f32x4*)dst = (f32x4){v[0] + excl, v[1] + excl, v[2] + excl, v[3] + excl}; *(f32x4*)(dst + 4) = (f32x4){v[4] + excl, v[5] + excl, v[6] + excl, v[7] + excl};
            __syncthreads();
        }
        if (!(dummy && (PROBE_VAR == 1 || PROBE_VAR == 2))) up::up_phase(F.lds, QLAT, KVLAT, Wq_t, Wkv_t, SSQQ, SSQKV, ROPETAB, QMLA, KN, VM, F.G, (int)blockIdx.x);
        if (BOTH(3)) GRID_BAR();
    }

    for (int rep = 0; rep < ((PROBE_DUP == 4) ? 2 : 1); ++rep) if (IN(4)) { PHASE_ENV const bool dummy = (PROBE_DUP == 4) && rep == 0; (void)dummy;
        {
            const bool xq = (F.G % 8) == 0; const int x = xq ? (int)(blockIdx.x & 7) : 0, nunits = xq ? 128 : 1024;
            constexpr int F_O = 16 * 4, F_OUT = 16 * 8, F_SGU = 8 * 8, F_SD = 16 * 2, F_EGU = NEXP * F_SGU, F_ED = NEXP * F_SD;
            constexpr int NCONV = F_EGU + F_ED + 2 * F_O + F_OUT + F_SGU + F_SD, NCBATCH = (NCONV + 31) / 32;
            const int NQ = xq ? 8 : 1, ncb = (NCBATCH - x + NQ - 1) / NQ, A0 = xq ? CONV_A0 : 8 * CONV_A0;
            gu32* qh = ctl + CW_Q + 64 * x + (dummy ? 16 : 0);
            volatile LAS unsigned* qw = (volatile LAS unsigned*)(F.lds + MISC_OFF + 64);
            for (int nit = 0;; ++nit) {
                if (F.tid == 0) qw[nit & 1] = __hip_atomic_fetch_add(qh, 1u, RLX_AGENT);
                __syncthreads();
                int r = __builtin_amdgcn_readfirstlane((int)qw[nit & 1]);
                if (r >= nunits + ncb) break;
                if (r >= A0 && r < A0 + ncb) { const int cb = x + NQ * (r - A0);
                    LAS unsigned char* scr8 = F.lds + 32768 + F.wave * 9216;
                    int ln_ = F.lane; asm volatile("" : "+v"(ln_));
                    for (int kr = 0; kr < 4; ++kr) { int it = 32 * cb + 8 * kr + F.wave; if (it >= NCONV) break;
                        const float* src; unsigned char* dst; int ldw, kd8;
                        if (it < F_EGU) { const int e = it / F_SGU, rr = it % F_SGU, nb = rr & 7, kb = rr >> 3, pn = nb >> 2, c0 = (nb & 3) * 64;
                            src = ((c0 < 128) ? w_exp_gate : w_exp_up) + (size_t)e * D * DEXP + pn * 128 + (c0 & 127) + (size_t)(128 * kb) * DEXP; ldw = DEXP;
                            dst = Wgu8 + (size_t)e * 512 * D + (size_t)(64 * nb) * D + 128 * kb; kd8 = D; }
                        else if ((it -= F_EGU) < F_ED) { const int e = it / F_SD, rr = it % F_SD, nb = rr & 15, kb = rr >> 4;
                            src = w_exp_down + (size_t)e * DEXP * D + (size_t)(128 * kb) * D + 64 * nb; ldw = D; dst = (unsigned char*)Wd_t + (size_t)e * D * DEXP + (size_t)(64 * nb) * DEXP + 128 * kb; kd8 = DEXP; }
                        else if ((it -= F_ED) < 2 * F_O) { const int fx = it >= F_O, i2 = it - (fx ? F_O : 0), nb = i2 & 15, kb = i2 >> 4;
                            src = (fx ? w_o_fox : w_o_mla) + (size_t)(128 * kb) * D + 64 * nb; ldw = D; dst = (unsigned char*)Wom_t + (size_t)(64 * nb) * D + (fx ? 512 : 0) + 128 * kb; kd8 = D; }
                        else if ((it -= 2 * F_O) < F_OUT) { const int nb = it & 15, kb = it >> 4; src = w_out + (size_t)(128 * kb) * D + 64 * nb; ldw = D; dst = (unsigned char*)Wout_t + (size_t)(64 * nb) * D + 128 * kb; kd8 = D; }
                        else if ((it -= F_OUT) < F_SGU) { const int nb = it >> 3, kb = it & 7, pn = nb >> 2, c0 = (nb & 3) * 64;
                            src = ((c0 < 128) ? w_sh_gate : w_sh_up) + pn * 128 + (c0 & 127) + (size_t)(128 * kb) * DEXP; ldw = DEXP; dst = Wsgu8 + (size_t)(64 * nb) * D + 128 * kb; kd8 = D; }
                        else { it -= F_SGU; const int nb = it >> 1, kb = it & 1; src = w_sh_down + (size_t)(128 * kb) * D + 64 * nb; ldw = D; dst = (unsigned char*)Wsd_t + (size_t)(64 * nb) * DEXP + 128 * kb; kd8 = DEXP; }
                        cvt128_item8(src, ldw, dst, kd8, scr8, ln_, WSCALE8);
                    }
                    continue; }
                if (r >= A0) r -= ncb;
                int qb, type, b, h;
                if (xq) { qb = 15 - (r >> 3); type = (r >> 2) & 1; b = r & 3; h = (x + 3 * b) & 7; }
                else { qb = 15 - (r >> 6); type = (r >> 5) & 1; b = (r >> 3) & 3; h = r & 7; }
                if (type == 0) { if (ATT_TUNED_FOX && qb != 0) att::attn_unit_t<64, true, 8>(b, h, qb, FQ, 512, FK, KPE, FV, CUMF, __uint_as_float(__hip_atomic_load((unsigned*)(ctl + CW_KM + b * NHEAD + h), RLX_AGENT)) * __uint_as_float(__hip_atomic_load((unsigned*)(ctl + CW_KM + 32 + b * NHEAD + h), RLX_AGENT)), (bf16*)((unsigned char*)(dummy ? (bf16*)((unsigned char*)out + 4 * MiB) : OCAT) + 512), D, F.lds);
                                 else att::attn_unit<64, true, 8>(b, h, qb, FQ, 512, FK, KPE, FV, CUMF, (bf16*)((unsigned char*)(dummy ? (bf16*)((unsigned char*)out + 4 * MiB) : OCAT) + 512), D, F.lds); }
                else { if (ATT_TUNED_MLA && qb != 0) att::attn_unit_t<96, false, 8>(b, h, qb, QMLA, 768, KN, KPE, VM, nullptr, 0.f, dummy ? (bf16*)((unsigned char*)out + 4 * MiB) : OCAT, D, F.lds);
                       else att::attn_unit<96, false, 8>(b, h, qb, QMLA, 768, KN, KPE, VM, nullptr, dummy ? (bf16*)((unsigned char*)out + 4 * MiB) : OCAT, D, F.lds); }
            }
        }
        if (BOTH(4)) GRID_BAR();
    }

    for (int rep = 0; rep < ((PROBE_DUP == 5) ? 2 : 1); ++rep) if (IN(5)) { PHASE_ENV const bool dummy = (PROBE_DUP == 5) && rep == 0; (void)dummy;
        pg8::StaticOrder S; S.init(OCAT, Wom_t, T, D, D / 2, F.G, (int)blockIdx.x);
        EpiMergedCat E{GATES, (unsigned char*)MERGED, 1.f / WSCALE8};
        pg8::gemm_phase<EpiMergedCat, pg8::StaticOrder, true, true>(F.lds, S, E);
        if (BOTH(5)) GRID_BAR();
    }

    for (int rep = 0; rep < ((PROBE_DUP == 6) ? 2 : 1); ++rep) if (IN(6)) { PHASE_ENV const bool dummy = (PROBE_DUP == 6) && rep == 0; (void)dummy;
        pg8::StaticOrder S; S.init(MERGED, Wout_t, T, D, D / 2, F.G, (int)blockIdx.x);
        EpiOut E{X_IN, X1B, mod, SSQ1, 1.f / (OSCALE8 * WSCALE8)};
        pg8::gemm_phase<EpiOut, pg8::StaticOrder, true, true>(F.lds, S, E);
        if (BOTH(6)) GRID_BAR();
    }

    for (int rep = 0; rep < ((PROBE_DUP == 7) ? 2 : 1); ++rep) if (IN(7)) { PHASE_ENV const bool dummy = (PROBE_DUP == 7) && rep == 0; (void)dummy;
        LAS unsigned char* wrl = F.lds;
        LAS float* vg = (LAS float*)(F.lds + LDSCTL_OFF + 6144);
        LAS float* vs = (LAS float*)(F.lds + LDSCTL_OFF + 10240);
        LAS int* cntw = (LAS int*)(F.lds + 32768);
        LAS int* basel = (LAS int*)(F.lds + 32768 + 2048);
        static_assert(LDSCTL_OFF + 10240 + 4096 <= LDS_BYTES && MOETAB_OFF + 4700 <= LDSCTL_OFF + 6144, "P7 LDS map");
        const float my_bias = b_router[F.lane];
        for (int grp = F.vcu; grp < T / 64; grp += F.G) {
            const int b = (grp * 64) / SEQ;
            __syncthreads();
#pragma unroll
            for (int i = 0; i < 16; ++i) __builtin_amdgcn_global_load_lds((const unsigned*)((const char*)Wr_f + (F.wave * 16 + i) * 1024 + F.lane * 16), (LAS unsigned*)(wrl + (F.wave * 16 + i) * 1024), 16, 0, 0);
            for (int i = F.tid; i < D; i += NWAVES * 64) { vg[i] = g_ffn[i] * (1.f + mod[(size_t)b * 6 * D + 4 * D + i]); vs[i] = mod[(size_t)b * 6 * D + 3 * D + i]; }
            const int tp = grp * 64 + (F.wave & 3) * 16, kh = F.wave >> 2, t0 = tp + kh * 8;
            const int r16 = F.lane & 15, kg = F.lane >> 4, myrow = tp + r16;
            float rs_mine;
            { const float* sp = SSQ1 + (size_t)myrow * 16; const f32x4 a = *(const f32x4*)sp, b4 = *(const f32x4*)(sp + 4), c4 = *(const f32x4*)(sp + 8), d4 = *(const f32x4*)(sp + 12);
              const float ssum = (((a[0] + a[1]) + (a[2] + a[3])) + ((b4[0] + b4[1]) + (b4[2] + b4[3]))) + (((c4[0] + c4[1]) + (c4[2] + c4[3])) + ((d4[0] + d4[1]) + (d4[2] + d4[3])));
              rs_mine = rsqrtf(ssum * (1.f / D) + EPS); }
            const bf16* xrow = X1B + (size_t)myrow * D + 512 * kh + 8 * kg;
            f32x4 lacc[4] = {{0.f, 0.f, 0.f, 0.f}, {0.f, 0.f, 0.f, 0.f}, {0.f, 0.f, 0.f, 0.f}, {0.f, 0.f, 0.f, 0.f}};
            u32x4 xq[16];
#pragma unroll
            for (int p = 0; p < 16; ++p) xq[p] = *(const u32x4*)(xrow + 32 * p);
            VM_WAIT(); __syncthreads();
#pragma unroll
            for (int p = 0; p < 16; ++p) { const int j = 16 * kh + p, k = 32 * j + 8 * kg;
                f32x4 x0, x1v; unpack8(xq[p], x0, x1v);
                const f32x4 g0 = *(const LAS f32x4*)(vg + k), g1 = *(const LAS f32x4*)(vg + k + 4), s0 = *(const LAS f32x4*)(vs + k), s1 = *(const LAS f32x4*)(vs + k + 4);
                const f32x4 h0 = x0 * rs_mine * g0 + s0, h1 = x1v * rs_mine * g1 + s1;
                const u32x4 hw = pack8(h0, h1);
                f32x4 a0, a1; unpack8(hw, a0, a1);
                const u32x4 lw = pack8(h0 - a0, h1 - a1);
                { u32x2 h8; int p_ = __builtin_amdgcn_cvt_pk_fp8_f32(h0[0], h0[1], 0, false); p_ = __builtin_amdgcn_cvt_pk_fp8_f32(h0[2], h0[3], p_, true); h8.x = (unsigned)p_;
                    p_ = __builtin_amdgcn_cvt_pk_fp8_f32(h1[0], h1[1], 0, false); p_ = __builtin_amdgcn_cvt_pk_fp8_f32(h1[2], h1[3], p_, true); h8.y = (unsigned)p_;
                    *(u32x2*)(H8 + (size_t)myrow * D + k) = h8; }
                const bf16x8 Ah = __builtin_bit_cast(bf16x8, hw), Al = __builtin_bit_cast(bf16x8, lw);
#pragma unroll
                for (int ntl = 0; ntl < 4; ++ntl) { const bf16x8 Wf = *(const LAS bf16x8*)(wrl + ((j * 4 + ntl) * 64 + F.lane) * 16);
                    lacc[ntl] = __builtin_amdgcn_mfma_f32_16x16x32_bf16(Wf, Ah, lacc[ntl], 0, 0, 0);
                    lacc[ntl] = __builtin_amdgcn_mfma_f32_16x16x32_bf16(Wf, Al, lacc[ntl], 0, 0, 0); } }
            __syncthreads();
            {   LAS float* stw = (LAS float*)F.lds + (((F.wave & 3) * 2 + kh) * 16 + r16) * 64;
#pragma unroll
                for (int ntl = 0; ntl < 4; ++ntl) *(LAS f32x4*)(stw + 16 * ntl + 4 * kg) = lacc[ntl]; }
            __syncthreads();
            LAS float* stg = (LAS float*)F.lds + ((F.wave & 3) * 32 + kh * 8) * 64;
            int cnt = 0; unsigned selbits = 0u, selks = 0u;
            for (int j = 0; j < 8; ++j) {
                const float logit = stg[j * 64 + F.lane] + stg[(16 + j) * 64 + F.lane];
                const float sc = 1.f / (1.f + expf(-logit));
                const float ch = sc + my_bias;
                const float m1 = max8(ch);
                const unsigned long long eq = __ballot(ch == m1);
                const unsigned gm = (unsigned)(eq >> (F.lane & ~7)) & 0xffu;
                const int first = __builtin_ctz(gm);
                const float c2 = max8(((F.lane & 7) == first) ? -INFINITY : ch);
                const float gs = m1 + c2; const int myg = F.lane >> 3;
                int rank = 0;
#pragma unroll
                for (int g = 0; g < 8; ++g) { const float o = __builtin_bit_cast(float, __builtin_amdgcn_readlane(__builtin_bit_cast(int, gs), 8 * g)); rank += (o > gs || (o == gs && g < myg)) ? 1 : 0; }
                float mc = (rank < 4) ? ch : -1e30f;
                int selk = -1;
#pragma unroll
                for (int k = 0; k < TOPK; ++k) { const float mx = wave_max_f(mc); const unsigned long long bl = __ballot(mc == mx); const int fl = __builtin_ctzll(bl);
                    if (F.lane == fl) { selk = k; mc = -INFINITY; } }
                const float ssum = wave_sum_f(selk >= 0 ? sc : 0.f);
                if (selk >= 0) { const int t = t0 + j; EIDX[(size_t)t * 8 + selk] = (unsigned char)F.lane; GATEW[(size_t)t * 8 + selk] = sc / ssum * 2.5f; ++cnt; selbits |= 1u << j; selks |= (unsigned)selk << (3 * j); }
            }
            cntw[F.wave * 64 + F.lane] = cnt;
            __syncthreads();
            if (F.wave == 0) { int tot = 0;
#pragma unroll
                for (int w = 0; w < 8; ++w) tot += cntw[w * 64 + F.lane];
                basel[F.lane] = (int)__hip_atomic_fetch_add((unsigned*)(ctl + (dummy ? CW_CNT + 2048 : CW_CNT) + 16 * F.lane), (unsigned)tot, RLX_AGENT); }
            __syncthreads();
            int pos = basel[F.lane];
            for (int w = 0; w < F.wave; ++w) pos += cntw[w * 64 + F.lane];
#pragma unroll
            for (int j = 0; j < 8; ++j) if ((selbits >> j) & 1u) { const int k = (selks >> (3 * j)) & 7, t = t0 + j;
                LIST[(size_t)F.lane * LISTCAP + pos] = (unsigned short)t;
                META[(size_t)F.lane * LISTCAP + pos] = (u32x2){(unsigned)(t * (TOPK + 1) + k), __float_as_uint(GATEW[(size_t)t * 8 + k])}; ++pos; }
        }
        __syncthreads();
        if (BOTH(7)) GRID_BAR();
    }

    volatile LAS int* tab = (volatile LAS int*)(F.lds + MOETAB_OFF);
    if (IN(8) || IN(9)) {
        __syncthreads();
        if (F.wave == 0) {
            const int n = (int)__hip_atomic_load((unsigned*)(ctl + CW_CNT + 16 * F.lane), RLX_AGENT);
            const int tiles = (n + 255) >> 8; int incl = tiles;
#pragma unroll
            for (int o = 1; o < 64; o <<= 1) { const int v = __shfl_up(incl, o); if (F.lane >= o) incl += v; }
            tab[F.lane] = incl - tiles; tab[66 + F.lane] = n;
            if (F.lane == 63) { tab[64] = incl; tab[65] = incl + T / 256; tab[66 + 64] = T; }
        }
        __syncthreads();
        { const int ti = F.tid; int e = 0;
          for (int q = 0; q <= NEXP; ++q) if (tab[q] <= ti) e = q;
          tab[132 + ti] = e; }
        __syncthreads();
    }
    for (int rep = 0; rep < ((PROBE_DUP == 8) ? 2 : 1); ++rep) if (IN(8)) { PHASE_ENV const bool dummy = (PROBE_DUP == 8) && rep == 0; (void)dummy;
        MoeOrder<2, true> S{(const char*)H8, (const char*)Wgu8, (const char*)Wsgu8, D / 2, (size_t)512 * D, LIST, tab, F.G, (int)blockIdx.x};
        EpiHb E{(unsigned char*)HB, 1.f / WSCALE8};
        pg8::gemm_phase<EpiHb, MoeOrder<2, true>, true, true>(F.lds, S, E);
        if (BOTH(8)) GRID_BAR();
    }
    for (int rep = 0; rep < ((PROBE_DUP == 9) ? 2 : 1); ++rep) if (IN(9)) { PHASE_ENV const bool dummy = (PROBE_DUP == 9) && rep == 0; (void)dummy;
        if (dummy && PROBE_VAR == 1) dn::down_phase<true>(F.lds, (const unsigned char*)HB, (const unsigned char*)Wd_t, (const unsigned char*)Wsd_t, tab, META, (unsigned char*)Y, (unsigned char*)(ws + WS_CTL + 900 * 1024), F.G, (int)blockIdx.x);
        else dn::down_phase<false>(F.lds, (const unsigned char*)HB, (const unsigned char*)Wd_t, (const unsigned char*)Wsd_t, tab, META, (unsigned char*)Y, (unsigned char*)(ws + WS_CTL + 900 * 1024), F.G, (int)blockIdx.x);
        if (BOTH(9)) GRID_BAR();
    }

    for (int rep = 0; rep < ((PROBE_DUP == 10) ? 2 : 1); ++rep) if (IN(10)) { PHASE_ENV const bool dummy = (PROBE_DUP == 10) && rep == 0; (void)dummy;
        int ln10 = F.lane; asm volatile("" : "+v"(ln10));
        for (int m = gw; m < T; m += NGW) {
            const int b = m / SEQ; const float* gf = mod + (size_t)b * 6 * D + 5 * D;
            const u32x2* xr = (const u32x2*)(X1B + (size_t)m * D) + ln10;
            f32x4* xw = (f32x4*)((dummy ? (float*)HB : out) + (size_t)m * D) + ln10;
            f32x4 v[4]; float s = 0.f;
#pragma unroll
            for (int j = 0; j < 4; ++j) { const int c = 4 * ln10 + 256 * j;
                f32x4 y = {0.f, 0.f, 0.f, 0.f};
#pragma unroll
                for (int k = 0; k < TOPK + 1; ++k) { const int w = __builtin_nontemporal_load((const int*)((const unsigned char*)Y + ((size_t)m * (TOPK + 1) + k) * D + c));
                    const f32x2 lo = __builtin_amdgcn_cvt_pk_f32_fp8(w, false), hi2 = __builtin_amdgcn_cvt_pk_f32_fp8(w, true);
                    y += (f32x4){lo.x, lo.y, hi2.x, hi2.y}; }
                const u32x2 xb = __builtin_nontemporal_load(xr + 64 * j);
                v[j] = (f32x4){__uint_as_float(xb.x << 16), __uint_as_float(xb.x & 0xffff0000u), __uint_as_float(xb.y << 16), __uint_as_float(xb.y & 0xffff0000u)} + *(const f32x4*)(gf + c) * y;
                s += (v[j].x * v[j].x + v[j].y * v[j].y) + (v[j].z * v[j].z + v[j].w * v[j].w); }
            const float rstd = rsqrtf(wave_sum(s) * (1.f / D) + EPS);
#pragma unroll
            for (int j = 0; j < 4; ++j) __builtin_nontemporal_store(v[j] * rstd * *(const f32x4*)(g_final + 4 * ln10 + 256 * j), xw + 64 * j);
        }
    }
#undef IN
#undef BOTH
#undef GRID_BAR
}

constexpr int NPHASE = 11;
extern "C" void kernel_launch(void* const* d_in, const int* in_sizes, int n_in, void* d_out, int out_size, void* d_ws, size_t ws_size, hipStream_t stream) {
    static int grid = 0;
    if (grid == 0) {
        if (n_in != 25 || out_size != T * D || ws_size < WS_END) { fprintf(stderr, "kernel_launch: unexpected shapes (n_in %d out %d ws %zu need %zu)\n", n_in, out_size, ws_size, (size_t)WS_END); grid = -1; return; }
        int dev = 0, cus = 0;
        if (hipGetDevice(&dev) != hipSuccess || hipDeviceGetAttribute(&cus, hipDeviceAttributeMultiprocessorCount, dev) != hipSuccess) { grid = -1; return; }
        if (hipFuncSetAttribute((const void*)fwd, hipFuncAttributeMaxDynamicSharedMemorySize, LDS_BYTES) != hipSuccess) { fprintf(stderr, "kernel_launch: hipFuncSetAttribute failed\n"); grid = -1; return; }
        int per_cu = 0;
        if (hipOccupancyMaxActiveBlocksPerMultiprocessor(&per_cu, (const void*)fwd, NWAVES * 64, LDS_BYTES) != hipSuccess || per_cu < 1) { fprintf(stderr, "kernel_launch: occupancy query says %d\n", per_cu); }
        (void)hipGetLastError();
        grid = cus;
    }
    if (grid < 0) return;
    (void)in_sizes;
    if (hipMemsetAsync((char*)d_ws + WS_CTL, 0, CTL_ZERO_BYTES, stream) != hipSuccess) return;
    Args a{};
    for (int i = 0; i < 25; ++i) a.in[i] = d_in[i];
    a.out = (float*)d_out; a.ws = (unsigned char*)d_ws;
#if MK_ONE_LAUNCH
    a.ph_lo = 0; a.ph_hi = NPHASE;
    hipLaunchKernelGGL(fwd, dim3(grid), dim3(NWAVES * 64), LDS_BYTES, stream, a);
#else
    for (int p = 0; p < NPHASE; ++p) { a.ph_lo = p; a.ph_hi = p + 1; hipLaunchKernelGGL(fwd, dim3(grid), dim3(NWAVES * 64), LDS_BYTES, stream, a); }
#endif
}
```

```cpp
#include <hip/hip_runtime.h>
#include <cstdio>
#include <cstdint>
#include <type_traits>

#ifndef MK_ONE_LAUNCH
#ifndef CONV_A0
#define CONV_A0 28
#endif
#define MK_ONE_LAUNCH 1
#endif

#ifndef PROBE_DUP
#define PROBE_DUP -1
#endif
#ifndef ATT_TUNED_FOX
#define ATT_TUNED_FOX 1
#endif
#ifndef ATT_TUNED_MLA
#define ATT_TUNED_MLA 1
#endif
#ifndef PROBE_VAR
#define PROBE_VAR 0
#endif
#define GAS __attribute__((address_space(1)))
#define LAS __attribute__((address_space(3)))
typedef unsigned short bf16;
typedef short bf16x8 __attribute__((ext_vector_type(8)));
typedef short s16x4 __attribute__((ext_vector_type(4)));
typedef float f32x2 __attribute__((ext_vector_type(2)));
typedef float f32x4 __attribute__((ext_vector_type(4)));
typedef float f32x16 __attribute__((ext_vector_type(16)));
typedef unsigned u32x2 __attribute__((ext_vector_type(2)));
typedef unsigned u32x4 __attribute__((ext_vector_type(4)));
typedef GAS unsigned gu32;
typedef int v8i32_t __attribute__((ext_vector_type(8)));
typedef int v4i32_t __attribute__((ext_vector_type(4)));

constexpr int NB = 4, SEQ = 4096, T = NB * SEQ, D = 1024;
constexpr int NIN = 4096;
constexpr int QLORA = 256, KVLORA = 128, KVPAD = 256, ROPE = 32, NHEAD = 8, HD = 64, MQK = 96;
constexpr int NEXP = 64, TOPK = 6, DEXP = 256;
constexpr float EPS = 1e-6f;
constexpr float LOG2E = 1.4426950408889634f;
constexpr float C2F = 0.125f * LOG2E;
constexpr float C2M = 0.10206207261596577f * LOG2E;
constexpr int LISTCAP = T;
constexpr float HSCALE8 = 8.f;
constexpr float OSCALE8 = 8.f;
constexpr float WSCALE8 = 64.f;

constexpr size_t MiB = 1u << 20;
constexpr size_t WS_CTL = 0, CTL_ZERO_BYTES = 1 * MiB;
constexpr size_t WS_EIDX = 262144, WS_GATEW = 393216;
constexpr size_t WS_WIN = 1 * MiB, WS_WQ = 9 * MiB, WS_WKV = 9 * MiB + 512 * 1024, WS_WOM = 10 * MiB, WS_WOF = 11 * MiB, WS_WOUT = 12 * MiB;
constexpr size_t WS_WSGU = 14 * MiB, WS_WSD = 15 * MiB, WS_WR = 15 * MiB + 512 * 1024, WS_MOD = 15 * MiB + 640 * 1024;
constexpr size_t WS_WD = 16 * MiB;
constexpr size_t WS_HB = 48 * MiB;
constexpr size_t WS_FQ = 48 * MiB, WS_FK = 64 * MiB, WS_FV = 80 * MiB, WS_QLAT = 96 * MiB, WS_KVLAT = 104 * MiB;
constexpr size_t WS_OFOX = WS_FQ, WS_OMLA = WS_QLAT;
static_assert(WS_FK - WS_FQ == (size_t)T * 512 * 2 && WS_FV - WS_FK == (size_t)T * 512 * 2, "fq|fk|fv contiguous");
constexpr size_t WS_Y = 112 * MiB;
constexpr size_t WS_WGU = 112 * MiB;
constexpr size_t WS_H = 176 * MiB;
constexpr size_t WS_QMLA = WS_H;
constexpr size_t WS_GATES = 208 * MiB;
constexpr size_t WS_KN = 272 * MiB, WS_VM = 288 * MiB, WS_KPE = 304 * MiB;
constexpr size_t WS_MERGED = WS_KN;
constexpr size_t WS_LIST = 304 * MiB;
constexpr size_t WS_X1B = 224 * MiB;
constexpr size_t WS_END = 306 * MiB;
constexpr size_t DO_MODP = 4 * MiB;
constexpr size_t DO_ROPE = 0, DO_LOGF = 2 * MiB, DO_CUMF = 2 * MiB + 512 * 1024, DO_SSQQ = 3 * MiB, DO_SSQKV = 3 * MiB + 256 * 1024;

constexpr int CW_TMO = 0;
constexpr int CW_BAR = 4096;
constexpr int CW_CNT = 8192;
constexpr int CW_KM = 12288;
constexpr int CW_Q = 12544;

constexpr int RING_BYTES = 131072;
constexpr int LDSCTL_OFF = RING_BYTES;
constexpr int MISC_OFF = LDSCTL_OFF + 320;
constexpr int MOETAB_OFF = LDSCTL_OFF + 1024;
constexpr int LDS_BYTES = 147456;

constexpr int NWAVES = 8;

#define LDS_WAIT() asm volatile("s_waitcnt lgkmcnt(0)" ::: "memory")
#define VM_WAIT() asm volatile("s_waitcnt vmcnt(0)" ::: "memory")
#define RLX_AGENT __ATOMIC_RELAXED, __HIP_MEMORY_SCOPE_AGENT
__device__ __forceinline__ unsigned f2bf(float f) { unsigned u = __builtin_bit_cast(unsigned, f); return (u + 0x7fffu + ((u >> 16) & 1u)) >> 16; }
__device__ __forceinline__ float bf2f(unsigned h) { return __builtin_bit_cast(float, h << 16); }
__device__ __forceinline__ unsigned pk2(float lo, float hi) { return f2bf(lo) | (f2bf(hi) << 16); }
__device__ __forceinline__ unsigned cvt_pk_bf16(float lo, float hi) { unsigned r; asm volatile("v_cvt_pk_bf16_f32 %0, %1, %2" : "=v"(r) : "v"(lo), "v"(hi)); return r; }
__device__ __forceinline__ u32x4 pack8(f32x4 a, f32x4 b) { u32x4 w; w.x = cvt_pk_bf16(a[0], a[1]); w.y = cvt_pk_bf16(a[2], a[3]); w.z = cvt_pk_bf16(b[0], b[1]); w.w = cvt_pk_bf16(b[2], b[3]); return w; }
__device__ __forceinline__ unsigned pack4u8(float a, float b, float c, float d) {
    const unsigned lo = __builtin_amdgcn_perm(__float_as_uint(b), __float_as_uint(a), 0x0c0c0400u), hi = __builtin_amdgcn_perm(__float_as_uint(d), __float_as_uint(c), 0x0c0c0400u);
    return __builtin_amdgcn_perm(hi, lo, 0x05040100u);
}
__device__ __forceinline__ float ub(unsigned w, int i) { return (float)((w >> (8 * i)) & 0xffu); }
__device__ __forceinline__ void unpack8(u32x4 w, f32x4& a, f32x4& b) {
    a = (f32x4){bf2f(w.x & 0xffffu), bf2f(w.x >> 16), bf2f(w.y & 0xffffu), bf2f(w.y >> 16)};
    b = (f32x4){bf2f(w.z & 0xffffu), bf2f(w.z >> 16), bf2f(w.w & 0xffffu), bf2f(w.w >> 16)};
}
__device__ __forceinline__ float wave_sum(float v) {
#pragma unroll
    for (int o = 1; o < 64; o <<= 1) v += __shfl_xor(v, o);
    return v;
}
__device__ __forceinline__ float wave_max(float v) {
#pragma unroll
    for (int o = 1; o < 64; o <<= 1) v = fmaxf(v, __shfl_xor(v, o));
    return v;
}
template <int CTRL> __device__ __forceinline__ float dppf(float v) { return __builtin_bit_cast(float, __builtin_amdgcn_update_dpp(0, __builtin_bit_cast(int, v), CTRL, 0xf, 0xf, true)); }
__device__ __forceinline__ float max8(float v) { v = fmaxf(v, dppf<0xB1>(v)); v = fmaxf(v, dppf<0x4E>(v)); v = fmaxf(v, dppf<0x141>(v)); return v; }
__device__ __forceinline__ float wave_max_f(float v) { v = max8(v); v = fmaxf(v, dppf<0x140>(v)); v = fmaxf(v, __shfl_xor(v, 16)); v = fmaxf(v, __shfl_xor(v, 32)); return v; }
__device__ __forceinline__ float wave_sum_f(float v) { v += dppf<0xB1>(v); v += dppf<0x4E>(v); v += dppf<0x141>(v); v += dppf<0x140>(v); v += __shfl_xor(v, 16); v += __shfl_xor(v, 32); return v; }
__device__ __forceinline__ float sigmoidf_(float x) { return __builtin_amdgcn_rcpf(1.f + __builtin_amdgcn_exp2f(-LOG2E * x)); }
__device__ __forceinline__ float siluf_(float x) { return x * __builtin_amdgcn_rcpf(1.f + __builtin_amdgcn_exp2f(-LOG2E * x)); }

namespace pg8 {
constexpr int BM = 256, BK = 64, HALF = 128, HTB = HALF * BK * 2, NXCD = 8, WGM = 8;
__host__ __device__ __forceinline__ int lds_byte(int r, int c) { const int st = (r >> 4) * 2 + (c >> 5), rr = r & 15, cc = c & 31, ob = rr * 64 + cc * 2; return st * 1024 + (ob ^ (((ob >> 9) & 1) << 5)); }
__host__ __device__ __forceinline__ void stage_rc(int b, int& R, int& C) { const int st = b / 1024, sb = b % 1024, swz = sb ^ (((sb >> 9) & 1) << 5); R = (st >> 1) * 16 + swz / 64; C = (st & 1) * 32 + (swz % 64) / 2; }
__host__ __device__ __forceinline__ int perm32(int rho) { const int n = rho >> 4, i = rho & 15; return 8 * (i >> 2) + 4 * n + (i & 3); }

struct Unit { int pm, pn, e, aux, n; };

struct StaticOrder {
    static constexpr bool GATHER = false;
    const char* A; const char* Bt; int K;
    int nM, nN, nwg, G, c;
    __device__ void init(const void* A_, const void* Bt_, int M, int N, int K_, int G_, int c_) { A = (const char*)A_; Bt = (const char*)Bt_; K = K_; nM = M / BM; nN = N / BM; nwg = nM * nN; G = G_; c = c_; }
    __device__ bool next(int i, Unit& u) const {
        const long L = (long)i * G + c; if (L >= nwg) return false;
        int wgid = (int)L; { const int q = nwg / NXCD, r = nwg % NXCD, xcd = wgid % NXCD, off = wgid / NXCD; wgid = (xcd < r ? xcd * (q + 1) : r * (q + 1) + (xcd - r) * q) + off; }
        const int nig = WGM * nN, gid = wgid / nig, fm = gid * WGM, gsz = (nM - fm) < WGM ? (nM - fm) : WGM;
        u.pm = fm + ((wgid % nig) % gsz); u.pn = (wgid % nig) / gsz; u.e = 0; u.aux = 0; u.n = BM; return true;
    }
    __device__ __forceinline__ const char* a_ptr(const Unit& u) const { return A + (size_t)u.pm * BM * K * 2; }
    __device__ __forceinline__ const char* b_ptr(const Unit& u) const { return Bt + (size_t)u.pn * BM * K * 2; }
    __device__ __forceinline__ unsigned a_row(const Unit&, int r) const { return (unsigned)r; }
};

template <class Epi, class Sched, bool ALIGN_EPI, bool FP8 = false>
__device__ __forceinline__ void gemm_phase(LAS unsigned char* lds, const Sched& S, const Epi& E) {
    int tid = threadIdx.x; asm volatile("" : "+v"(tid));
    const int wid = __builtin_amdgcn_readfirstlane(tid >> 6), lane = tid & 63, wr = wid >> 2, wc = wid & 3, fr = lane & 15, fq = lane >> 4;
    const int K = S.K, nt = K / BK;
    unsigned voffB[2], voffA[2];
#pragma unroll
    for (int i = 0; i < 2; ++i) { int R, C; stage_rc(tid * 16 + i * 8192, R, C); const int Rb = (R & ~31) + perm32(R & 31);
        voffA[i] = (unsigned)(R * K + C) * 2u; voffB[i] = (unsigned)(Rb * K + C) * 2u; }
    unsigned vA[2][2], vN[2][2];
    const size_t kstep = (size_t)(BK * 2);
    const size_t hstep = (size_t)HALF * K * 2;
    const unsigned ldsw = (unsigned)wid * 1024u;
    const int aoff = lds_byte(wr * 64 + fr, fq * 8), boff = lds_byte(wc * 32 + fr, fq * 8);
#define PG8_SA(b, h) (((b) * 2 + (h)) * HTB)
#define PG8_SB(b, h) ((4 + (b) * 2 + (h)) * HTB)
#define PG8_STAGE(bufoff, gbase, voff) do { _Pragma("unroll") for (int _i = 0; _i < 2; ++_i) \
        __builtin_amdgcn_global_load_lds((const unsigned*)((const char*)(gbase) + (voff)[_i]), (LAS unsigned*)(lds + (bufoff) + ldsw + _i * 8192), 16, 0, 0); } while (0)
#define PG8_STAGE_A(bufoff, gbase, h, nx) do { if constexpr (Sched::GATHER) { const unsigned vs_[2] = {(nx) ? vN[h][0] : vA[h][0], (nx) ? vN[h][1] : vA[h][1]}; PG8_STAGE(bufoff, gbase, vs_); }     \
        else PG8_STAGE(bufoff, (const char*)(gbase) + (h) * hstep, voffA); } while (0)
#define PG8_LDA(dst, b, h) do { _Pragma("unroll") for (int m = 0; m < 4; ++m) { if constexpr (FP8) { dst##8[m].lo = *(const LAS v4i32_t*)(lds + PG8_SA(b, h) + aoff + m * 2048); dst##8[m].hi = *(const LAS v4i32_t*)(lds + PG8_SA(b, h) + aoff + m * 2048 + 1024); } \
        else { _Pragma("unroll") for (int k = 0; k < 2; ++k) dst[m][k] = *(const LAS bf16x8*)(lds + PG8_SA(b, h) + aoff + m * 2048 + k * 1024); } } } while (0)
#define PG8_LDB(dst, b, h) do { _Pragma("unroll") for (int n = 0; n < 2; ++n) { if constexpr (FP8) { dst##8[n].lo = *(const LAS v4i32_t*)(lds + PG8_SB(b, h) + boff + n * 2048); dst##8[n].hi = *(const LAS v4i32_t*)(lds + PG8_SB(b, h) + boff + n * 2048 + 1024); } \
        else { _Pragma("unroll") for (int k = 0; k < 2; ++k) dst[n][k] = *(const LAS bf16x8*)(lds + PG8_SB(b, h) + boff + n * 2048 + k * 1024); } } } while (0)
#define PG8_MMA(ai, bj, At, Bt) do { __builtin_amdgcn_s_setprio(1); _Pragma("unroll") for (int m = 0; m < 4; ++m) _Pragma("unroll") for (int n = 0; n < 2; ++n) { \
        if constexpr (FP8) asm volatile("v_mfma_scale_f32_16x16x128_f8f6f4 %0, %1, %2, %0, %3, %3 op_sel_hi:[0,0,0]" : "+v"(acc[ai][bj][m][n]) : "v"(Bt##8[n]), "v"(At##8[m]), "v"(sc1_));     \
        else { _Pragma("unroll") for (int k = 0; k < 2; ++k) acc[ai][bj][m][n] = __builtin_amdgcn_mfma_f32_16x16x32_bf16(Bt[n][k], At[m][k], acc[ai][bj][m][n], 0, 0, 0); } } \
        __builtin_amdgcn_s_setprio(0); } while (0)
#define PG8_WAIT_V(n) asm volatile("s_waitcnt vmcnt(" #n ")" ::: "memory")
#define PG8_WAIT_L(n) asm volatile("s_waitcnt lgkmcnt(" #n ")" ::: "memory")
#define PG8_BAR __builtin_amdgcn_s_barrier()
#define PG8_SCHED __builtin_amdgcn_sched_barrier(0)
#define PG8_SETV(dst, u) do { _Pragma("unroll") for (int _h = 0; _h < 2; ++_h) _Pragma("unroll") for (int _i = 0; _i < 2; ++_i) { int R_, C_; stage_rc(tid * 16 + _i * 8192, R_, C_); \
        dst[_h][_i] = (S.a_row(u, _h * HALF + R_) * (unsigned)K + (unsigned)C_) * 2u; } } while (0)
    Unit cur, nxt; int ui = 0;
    if (!S.next(0, cur)) return;
    f32x4 acc[2][2][4][2];
#define PG8_ZERO() do { _Pragma("unroll") for (int a = 0; a < 2; ++a) _Pragma("unroll") for (int b = 0; b < 2; ++b) _Pragma("unroll") for (int m = 0; m < 4; ++m) _Pragma("unroll") for (int n = 0; n < 2; ++n) { \
        if constexpr (FP8) asm volatile("v_mov_b32 %0, 0\n\tv_mov_b32 %1, 0\n\tv_mov_b32 %2, 0\n\tv_mov_b32 %3, 0" : "=v"(acc[a][b][m][n][0]), "=v"(acc[a][b][m][n][1]), "=v"(acc[a][b][m][n][2]), "=v"(acc[a][b][m][n][3])); \
        else acc[a][b][m][n] = (f32x4){0.f, 0.f, 0.f, 0.f}; } } while (0)
    PG8_ZERO();
    unsigned sc1_ = 0x7f7f7f7fu; asm volatile("" : "+v"(sc1_));
    (void)sc1_;
    bf16x8 At[4][2], B0[2][2], B1[2][2];
    v8i32_t At8[4], B08[2], B18[2];
    (void)At; (void)B0; (void)B1; (void)At8; (void)B08; (void)B18;
    const char* cA = S.a_ptr(cur); const char* cB = S.b_ptr(cur);
    if constexpr (Sched::GATHER) { PG8_SETV(vA, cur); }
    PG8_STAGE(PG8_SB(0, 0), cB, voffB); PG8_STAGE(PG8_SB(0, 1), cB + hstep, voffB); PG8_STAGE_A(PG8_SA(0, 0), cA, 0, false); PG8_STAGE_A(PG8_SA(0, 1), cA, 1, false);
    if (wr == 1) PG8_BAR;
    PG8_WAIT_V(2); PG8_BAR;
    PG8_STAGE(PG8_SB(1, 0), cB + kstep, voffB); PG8_STAGE_A(PG8_SA(1, 0), cA + kstep, 0, false); PG8_STAGE(PG8_SB(1, 1), cB + hstep + kstep, voffB);
    PG8_WAIT_V(6); PG8_BAR;
    for (;;) {
        const bool has_next = S.next(ui + 1, nxt);
        const char* nA = has_next ? S.a_ptr(nxt) : cA; const char* nB = has_next ? S.b_ptr(nxt) : cB;
        if constexpr (Sched::GATHER) { if (has_next) { PG8_SETV(vN, nxt); } else {
#pragma unroll
            for (int h = 0; h < 2; ++h)
#pragma unroll
                for (int i = 0; i < 2; ++i) vN[h][i] = vA[h][i]; } }
        for (int t = 0; t < nt; t += 2) {
            const bool last = (t == nt - 2);
            if constexpr (Epi::MIDK) { if (t == nt / 2) E.mid(acc, cur, wr, wc, fr, fq); }
            const char* a1 = cA + (size_t)(t + 1) * kstep;
            const char* a2 = last ? nA : cA + (size_t)(t + 2) * kstep; const char* b2 = last ? nB : cB + (size_t)(t + 2) * kstep;
            const char* a3 = a2 + kstep; const char* b3 = b2 + kstep;
            PG8_LDB(B0, 0, 0); PG8_LDB(B1, 0, 1); PG8_SCHED; PG8_LDA(At, 0, 0); PG8_STAGE_A(PG8_SA(1, 1), a1, 1, false);
            PG8_WAIT_V(8); PG8_WAIT_L(0); PG8_BAR; PG8_MMA(0, 0, At, B0); PG8_MMA(0, 1, At, B1); PG8_BAR; PG8_SCHED;
            PG8_LDA(At, 0, 1); PG8_STAGE(PG8_SB(0, 0), b2, voffB); PG8_STAGE(PG8_SB(0, 1), b2 + hstep, voffB); PG8_STAGE_A(PG8_SA(0, 0), a2, 0, last);
            PG8_WAIT_V(8); PG8_WAIT_L(0); PG8_BAR; PG8_MMA(1, 0, At, B0); PG8_MMA(1, 1, At, B1); PG8_BAR; PG8_SCHED;
            PG8_LDB(B0, 1, 0); PG8_LDB(B1, 1, 1); PG8_SCHED; PG8_LDA(At, 1, 0); PG8_STAGE_A(PG8_SA(0, 1), a2, 1, last);
            PG8_WAIT_V(8); PG8_WAIT_L(0); PG8_BAR; PG8_MMA(0, 0, At, B0); PG8_MMA(0, 1, At, B1); PG8_BAR; PG8_SCHED;
            PG8_LDA(At, 1, 1); PG8_STAGE(PG8_SB(1, 0), b3, voffB); PG8_STAGE(PG8_SB(1, 1), b3 + hstep, voffB); PG8_STAGE_A(PG8_SA(1, 0), a3, 0, last);
            PG8_WAIT_V(8); PG8_WAIT_L(0); PG8_BAR; PG8_MMA(1, 0, At, B0); PG8_MMA(1, 1, At, B1); PG8_BAR; PG8_SCHED;
        }
        if constexpr (ALIGN_EPI) { if (wr == 0) PG8_BAR; }
        if constexpr (FP8) { asm volatile("s_nop 15\n\ts_nop 7" ::: "memory"); __builtin_amdgcn_sched_barrier(0); }
        E(acc, cur, wr, wc, fr, fq);
        if (!has_next) break;
        PG8_ZERO();
        cur = nxt; cA = nA; cB = nB; ++ui;
        if constexpr (Sched::GATHER) {
#pragma unroll
            for (int h = 0; h < 2; ++h)
#pragma unroll
                for (int i = 0; i < 2; ++i) vA[h][i] = vN[h][i]; }
        if constexpr (ALIGN_EPI) { if (wr == 1) PG8_BAR; }
    }
    PG8_WAIT_V(0);
    if constexpr (!ALIGN_EPI) { if (wr == 0) PG8_BAR; }
    PG8_BAR;
#undef PG8_SA
#undef PG8_SB
#undef PG8_STAGE
#undef PG8_STAGE_A
#undef PG8_LDA
#undef PG8_LDB
#undef PG8_MMA
#undef PG8_ZERO
#undef PG8_WAIT_V
#undef PG8_WAIT_L
#undef PG8_BAR
#undef PG8_SCHED
#undef PG8_SETV
}
}
using pg8::Unit;

#define EPI_ROWS(ai, m) for (int ai = 0; ai < 2; ++ai) for (int m = 0; m < 4; ++m)

struct EpiInProj {
    static constexpr bool MIDK = false;
    bf16 *qlat, *kvlat, *kpe, *fq, *gates; float *logf, *ssqq, *ssqkv; const float* ropetab; const float* bforget; bool skip; int rowmul;
    __device__ __forceinline__ void operator()(const f32x4 (&acc)[2][2][4][2], const Unit& u, int wr, int wc, int fr, int fq_) const {
        if (skip) return;
        const int pn = u.pn, row0 = u.pm * 256 + wr * 64 + fr, c0 = wc * 32 + 8 * fq_;
        if (pn >= 8) {
            unsigned char* gp = (unsigned char*)gates + (size_t)(pn - 8) * 256 + wc * 64 + fq_ * 16;
#pragma unroll
            for (int ai = 0; ai < 2; ++ai)
#pragma unroll
                for (int m = 0; m < 4; ++m) { const int row = row0 + ai * 128 + m * 16; u32x4 o;
#pragma unroll
                    for (int bj = 0; bj < 2; ++bj) { f32x4 v0 = acc[ai][bj][m][0], v1 = acc[ai][bj][m][1];
#pragma unroll
                        for (int q = 0; q < 4; ++q) { v0[q] = sigmoidf_(v0[q]) * 255.f + 8388608.f; v1[q] = sigmoidf_(v1[q]) * 255.f + 8388608.f; }
                        o[2 * bj] = pack4u8(v0[0], v0[1], v0[2], v0[3]); o[2 * bj + 1] = pack4u8(v1[0], v1[1], v1[2], v1[3]); }
                    *(u32x4*)(gp + (size_t)row * 2048) = o; }
        } else if (pn >= 2) {
            bf16* dst = fq + (size_t)((pn - 2) >> 1) * ((size_t)T * 512) + (pn & 1) * 256 + c0; const float sc = (pn < 4) ? C2F : 1.f;
#pragma unroll
            for (int ai = 0; ai < 2; ++ai)
#pragma unroll
                for (int m = 0; m < 4; ++m) { const int row = row0 + ai * 128 + m * 16;
#pragma unroll
                    for (int bj = 0; bj < 2; ++bj) *(u32x4*)(dst + (size_t)row * 512 + 128 * bj) = pack8(acc[ai][bj][m][0] * sc, acc[ai][bj][m][1] * sc); }
        } else if (pn == 0) {
#pragma unroll
            for (int ai = 0; ai < 2; ++ai)
#pragma unroll
                for (int m = 0; m < 4; ++m) { const int row = row0 + ai * 128 + m * 16; float s = 0.f;
#pragma unroll
                    for (int bj = 0; bj < 2; ++bj) { const f32x4 v0 = acc[ai][bj][m][0], v1 = acc[ai][bj][m][1];
                        s += (v0[0] * v0[0] + v0[1] * v0[1]) + (v0[2] * v0[2] + v0[3] * v0[3]) + (v1[0] * v1[0] + v1[1] * v1[1]) + (v1[2] * v1[2] + v1[3] * v1[3]);
                        *(u32x4*)(qlat + (size_t)row * QLORA + c0 + 128 * bj) = pack8(v0, v1); }
                    s += __shfl_xor(s, 16); s += __shfl_xor(s, 32);
                    if (fq_ == 0) ssqq[row * 4 + wc] = s; }
        } else {
#pragma unroll
            for (int ai = 0; ai < 2; ++ai)
#pragma unroll
                for (int m = 0; m < 4; ++m) { const int row = row0 + ai * 128 + m * 16;
                    { const f32x4 v0 = acc[ai][0][m][0], v1 = acc[ai][0][m][1];
                      float s = (v0[0] * v0[0] + v0[1] * v0[1]) + (v0[2] * v0[2] + v0[3] * v0[3]) + (v1[0] * v1[0] + v1[1] * v1[1]) + (v1[2] * v1[2] + v1[3] * v1[3]);
                      *(u32x4*)(kvlat + (size_t)row * KVPAD + c0) = pack8(v0, v1);
                      s += __shfl_xor(s, 16); s += __shfl_xor(s, 32);
                      if (fq_ == 0) ssqkv[row * 4 + wc] = s; }
                    { const f32x4 v0 = acc[ai][1][m][0], v1 = acc[ai][1][m][1];
                      *(u32x4*)(kvlat + (size_t)row * KVPAD + 128 + c0) = (u32x4){0u, 0u, 0u, 0u};
                      if (wc == 0) {
                          const f32x4* tb = (const f32x4*)(ropetab + ((size_t)row * 16 + 4 * fq_) * 2);
                          const f32x4 t0 = tb[0], t1 = tb[1];
                          f32x4 o1, o2;
                          o1[0] = v0[0] * t0[0] - v1[0] * t0[1]; o2[0] = v1[0] * t0[0] + v0[0] * t0[1];
                          o1[1] = v0[1] * t0[2] - v1[1] * t0[3]; o2[1] = v1[1] * t0[2] + v0[1] * t0[3];
                          o1[2] = v0[2] * t1[0] - v1[2] * t1[1]; o2[2] = v1[2] * t1[0] + v0[2] * t1[1];
                          o1[3] = v0[3] * t1[2] - v1[3] * t1[3]; o2[3] = v1[3] * t1[2] + v0[3] * t1[3];
                          *(u32x4*)(kpe + (size_t)row * ROPE + 8 * fq_) = pack8(o1, o2);
                      } else if (wc == 1 && fq_ == 0) {
                          f32x4 l0, l1;
#pragma unroll
                          for (int h = 0; h < 4; ++h) { const float z0 = v0[h] + bforget[h], z1 = v1[h] + bforget[4 + h];
                              l0[h] = -__builtin_amdgcn_logf(1.f + __builtin_amdgcn_exp2f(-LOG2E * z0)); l1[h] = -__builtin_amdgcn_logf(1.f + __builtin_amdgcn_exp2f(-LOG2E * z1)); }
                          *(f32x4*)(logf + (size_t)row * 8) = l0; *(f32x4*)(logf + (size_t)row * 8 + 4) = l1;
                      } } }
        }
        (void)rowmul;
    }
};

struct EpiQup {
    static constexpr bool MIDK = false;
    bf16* q; const float* ssqq; const float* ropetab;
    __device__ __forceinline__ void operator()(const f32x4 (&acc)[2][2][4][2], const Unit& u, int wr, int wc, int fr, int fq_) const {
        const int row0 = u.pm * 256 + wr * 64 + fr, c0 = u.pn * 256 + wc * 32 + 8 * fq_;
#pragma unroll
        for (int ai = 0; ai < 2; ++ai)
#pragma unroll
            for (int m = 0; m < 4; ++m) {
                const int row = row0 + ai * 128 + m * 16;
                const f32x4 sq = *(const f32x4*)(ssqq + row * 4);
                const float rs = rsqrtf(((sq[0] + sq[1]) + (sq[2] + sq[3])) * (1.f / QLORA) + EPS) * C2M;
#pragma unroll
                for (int bj = 0; bj < 2; ++bj) {
                    const int col = c0 + 128 * bj, j = col % MQK;
                    f32x4 v0 = acc[ai][bj][m][0] * rs, v1 = acc[ai][bj][m][1] * rs;
                    if (j >= 64) { const int g = (j - 64) >> 3;
                        const f32x4* tb = (const f32x4*)(ropetab + ((size_t)row * 16 + 4 * g) * 2);
                        const f32x4 t0 = tb[0], t1 = tb[1];
                        f32x4 o1, o2;
                        o1[0] = v0[0] * t0[0] - v1[0] * t0[1]; o2[0] = v1[0] * t0[0] + v0[0] * t0[1];
                        o1[1] = v0[1] * t0[2] - v1[1] * t0[3]; o2[1] = v1[1] * t0[2] + v0[1] * t0[3];
                        o1[2] = v0[2] * t1[0] - v1[2] * t1[1]; o2[2] = v1[2] * t1[0] + v0[2] * t1[1];
                        o1[3] = v0[3] * t1[2] - v1[3] * t1[3]; o2[3] = v1[3] * t1[2] + v0[3] * t1[3];
                        v0 = o1; v1 = o2; }
                    *(u32x4*)(q + (size_t)row * 768 + col) = pack8(v0, v1);
                }
            }
    }
};

struct EpiKVup {
    static constexpr bool MIDK = false;
    bf16 *kn, *vm; const float* ssqkv;
    __device__ __forceinline__ void operator()(const f32x4 (&acc)[2][2][4][2], const Unit& u, int wr, int wc, int fr, int fq_) const {
        const int row0 = u.pm * 256 + wr * 64 + fr, c0 = u.pn * 256 + wc * 32 + 8 * fq_;
        bf16* dst = (u.pn < 2) ? kn : vm; const int cb = (u.pn & 1) * 256 + wc * 32 + 8 * fq_;
        (void)c0;
#pragma unroll
        for (int ai = 0; ai < 2; ++ai)
#pragma unroll
            for (int m = 0; m < 4; ++m) {
                const int row = row0 + ai * 128 + m * 16;
                const f32x4 sq = *(const f32x4*)(ssqkv + row * 4);
                const float rs = rsqrtf(((sq[0] + sq[1]) + (sq[2] + sq[3])) * (1.f / KVLORA) + EPS);
#pragma unroll
                for (int bj = 0; bj < 2; ++bj) *(u32x4*)(dst + (size_t)row * 512 + cb + 128 * bj) = pack8(acc[ai][bj][m][0] * rs, acc[ai][bj][m][1] * rs);
            }
    }
};

struct EpiPartA {
    static constexpr bool MIDK = false;
    float* part; const bf16* gates;
    __device__ __forceinline__ void operator()(const f32x4 (&acc)[2][2][4][2], const Unit& u, int wr, int wc, int fr, int fq_) const {
        const int row0 = u.pm * 256 + wr * 64 + fr, c0 = u.pn * 256 + wc * 32 + 8 * fq_;
#pragma unroll
        for (int ai = 0; ai < 2; ++ai)
#pragma unroll
            for (int m = 0; m < 4; ++m) {
                const int row = row0 + ai * 128 + m * 16;
#pragma unroll
                for (int bj = 0; bj < 2; ++bj) { const int col = c0 + 128 * bj;
                    f32x4 g0, g1; unpack8(*(const u32x4*)(gates + (size_t)row * 2048 + col), g0, g1);
                    *(f32x4*)(part + (size_t)row * D + col) = g0 * acc[ai][bj][m][0]; *(f32x4*)(part + (size_t)row * D + col + 4) = g1 * acc[ai][bj][m][1]; }
            }
    }
};
struct EpiMerged {
    static constexpr bool MIDK = false;
    const float* part; const bf16* gates; bf16* merged;
    __device__ __forceinline__ void operator()(const f32x4 (&acc)[2][2][4][2], const Unit& u, int wr, int wc, int fr, int fq_) const {
        const int row0 = u.pm * 256 + wr * 64 + fr, c0 = u.pn * 256 + wc * 32 + 8 * fq_;
#pragma unroll
        for (int ai = 0; ai < 2; ++ai)
#pragma unroll
            for (int m = 0; m < 4; ++m) {
                const int row = row0 + ai * 128 + m * 16;
#pragma unroll
                for (int bj = 0; bj < 2; ++bj) { const int col = c0 + 128 * bj;
                    f32x4 g0, g1; unpack8(*(const u32x4*)(gates + (size_t)row * 2048 + 1024 + col), g0, g1);
                    const f32x4 p0 = *(const f32x4*)(part + (size_t)row * D + col), p1 = *(const f32x4*)(part + (size_t)row * D + col + 4);
                    *(u32x4*)(merged + (size_t)row * D + col) = pack8(p0 + g0 * acc[ai][bj][m][0], p1 + g1 * acc[ai][bj][m][1]); }
            }
    }
};
struct EpiMergedCat {
    static constexpr bool MIDK = true;
    const unsigned char* gates; unsigned char* merged; float sc;
    __device__ __forceinline__ void mid(f32x4 (&acc)[2][2][4][2], const Unit& u, int wr, int wc, int fr, int fq_) const {
        int row0 = u.pm * 256 + wr * 64 + fr, c0 = u.pn * 256 + wc * 64 + fq_ * 16;
        asm volatile("" : "+v"(row0), "+v"(c0));
#pragma unroll
        for (int ai = 0; ai < 2; ++ai)
#pragma unroll
            for (int m = 0; m < 4; ++m) { const int row = row0 + ai * 128 + m * 16;
                const u32x4 ga = *(const u32x4*)(gates + (size_t)row * 2048 + c0), gb = *(const u32x4*)(gates + (size_t)row * 2048 + 1024 + c0);
#pragma unroll
                for (int bj = 0; bj < 2; ++bj)
#pragma unroll
                    for (int q = 0; q < 4; ++q) { acc[ai][bj][m][0][q] *= ub(ga[2 * bj], q) * __builtin_amdgcn_rcpf(fmaxf(ub(gb[2 * bj], q), 1.f)); acc[ai][bj][m][1][q] *= ub(ga[2 * bj + 1], q) * __builtin_amdgcn_rcpf(fmaxf(ub(gb[2 * bj + 1], q), 1.f)); }
                asm volatile("" ::: "memory"); }
    }
    __device__ __forceinline__ void operator()(const f32x4 (&acc)[2][2][4][2], const Unit& u, int wr, int wc, int fr, int fq_) const {
        const int row0 = u.pm * 256 + wr * 64 + fr, c0 = u.pn * 256 + wc * 32 + 8 * fq_, g0 = u.pn * 256 + wc * 64 + fq_ * 16;
#pragma unroll
        for (int ai = 0; ai < 2; ++ai)
#pragma unroll
            for (int m = 0; m < 4; ++m) { const int row = row0 + ai * 128 + m * 16;
                const u32x4 gb = *(const u32x4*)(gates + (size_t)row * 2048 + 1024 + g0);
#pragma unroll
                for (int bj = 0; bj < 2; ++bj) { const int col = c0 + 128 * bj;
                    f32x4 v0, v1;
#pragma unroll
                    for (int q = 0; q < 4; ++q) { v0[q] = fmaxf(ub(gb[2 * bj], q), 1.f) * acc[ai][bj][m][0][q] * sc; v1[q] = fmaxf(ub(gb[2 * bj + 1], q), 1.f) * acc[ai][bj][m][1][q] * sc; }
                    u32x2 o; int p_ = __builtin_amdgcn_cvt_pk_fp8_f32(v0[0], v0[1], 0, false); p_ = __builtin_amdgcn_cvt_pk_fp8_f32(v0[2], v0[3], p_, true); o.x = (unsigned)p_;
                    p_ = __builtin_amdgcn_cvt_pk_fp8_f32(v1[0], v1[1], 0, false); p_ = __builtin_amdgcn_cvt_pk_fp8_f32(v1[2], v1[3], p_, true); o.y = (unsigned)p_;
                    *(u32x2*)(merged + (size_t)row * D + col) = o; } }
    }
};
struct EpiOut {
    static constexpr bool MIDK = false;
    const float* x; bf16* x1; const float* mod; float* ssq1; float sc;
    __device__ __forceinline__ void operator()(const f32x4 (&acc)[2][2][4][2], const Unit& u, int wr, int wc, int fr, int fq_) const {
        const int row0 = u.pm * 256 + wr * 64 + fr, c0 = u.pn * 256 + wc * 32 + 8 * fq_;
        const float* gm = mod + (size_t)((u.pm * 256) / SEQ) * 6 * D + 2 * D;
        f32x4 g[2][2];
#pragma unroll
        for (int bj = 0; bj < 2; ++bj) { g[bj][0] = *(const f32x4*)(gm + c0 + 128 * bj) * sc; g[bj][1] = *(const f32x4*)(gm + c0 + 128 * bj + 4) * sc; }
#pragma unroll
        for (int ai = 0; ai < 2; ++ai)
#pragma unroll
            for (int m = 0; m < 4; ++m) { const int row = row0 + ai * 128 + m * 16; float sq = 0.f;
#pragma unroll
                for (int bj = 0; bj < 2; ++bj) { const int col = c0 + 128 * bj;
                    const f32x4 x0 = __builtin_nontemporal_load((const f32x4*)(x + (size_t)row * D + col)), x1v = __builtin_nontemporal_load((const f32x4*)(x + (size_t)row * D + col + 4));
                    f32x4 r0 = x0 + g[bj][0] * acc[ai][bj][m][0], r1 = x1v + g[bj][1] * acc[ai][bj][m][1];
                    const u32x4 pk_ = pack8(r0, r1); unpack8(pk_, r0, r1);
                    *(u32x4*)(x1 + (size_t)row * D + col) = pk_;
                    sq += (r0[0] * r0[0] + r0[1] * r0[1]) + (r0[2] * r0[2] + r0[3] * r0[3]) + (r1[0] * r1[0] + r1[1] * r1[1]) + (r1[2] * r1[2] + r1[3] * r1[3]); }
                sq += __shfl_xor(sq, 16); sq += __shfl_xor(sq, 32);
                if (fq_ == 0) ssq1[(size_t)row * 16 + 4 * u.pn + wc] = sq; }
    }
};
struct EpiHb {
    static constexpr bool MIDK = false;
    unsigned char* hb; float sc;
    __device__ __forceinline__ void operator()(const f32x4 (&acc)[2][2][4][2], const Unit& u, int wr, int wc, int fr, int fq_) const {
        const int row0 = u.pm * 256 + wr * 64 + fr, c0 = u.pn * 128 + wc * 32 + 8 * fq_;
#pragma unroll
        for (int ai = 0; ai < 2; ++ai)
#pragma unroll
            for (int m = 0; m < 4; ++m) { const int row = row0 + ai * 128 + m * 16;
                f32x4 h0, h1;
#pragma unroll
                for (int q = 0; q < 4; ++q) { h0[q] = siluf_(acc[ai][0][m][0][q] * sc) * (acc[ai][1][m][0][q] * (sc * HSCALE8)); h1[q] = siluf_(acc[ai][0][m][1][q] * sc) * (acc[ai][1][m][1][q] * (sc * HSCALE8)); }
                u32x2 o; int p_ = __builtin_amdgcn_cvt_pk_fp8_f32(h0[0], h0[1], 0, false); p_ = __builtin_amdgcn_cvt_pk_fp8_f32(h0[2], h0[3], p_, true); o.x = (unsigned)p_;
                p_ = __builtin_amdgcn_cvt_pk_fp8_f32(h1[0], h1[1], 0, false); p_ = __builtin_amdgcn_cvt_pk_fp8_f32(h1[2], h1[3], p_, true); o.y = (unsigned)p_;
                *(u32x2*)(hb + (size_t)row * DEXP + c0) = o; }
    }
};
struct EpiDown {
    static constexpr bool MIDK = false;
    bf16* Y; float* out; float* outw; const float* mod; const unsigned short* list; const unsigned char* eidx; const float* gatew;
    __device__ __forceinline__ void operator()(const f32x4 (&acc)[2][2][4][2], const Unit& u, int wr, int wc, int fr, int fq_) const {
        const int c0 = u.pn * 256 + wc * 32 + 8 * fq_;
#pragma unroll
        for (int ai = 0; ai < 2; ++ai)
#pragma unroll
            for (int m = 0; m < 4; ++m) {
                const int rl = wr * 64 + fr + ai * 128 + m * 16, idx = u.aux * 256 + rl;
                if (u.e == NEXP) {
                    const int t = idx; const float* gf = mod + (size_t)(t / SEQ) * 6 * D + 5 * D;
#pragma unroll
                    for (int bj = 0; bj < 2; ++bj) { const int col = c0 + 128 * bj; const float* o = out + (size_t)t * D + col; float* ow = outw + (size_t)t * D + col;
                        const f32x4 g0 = *(const f32x4*)(gf + col), g1 = *(const f32x4*)(gf + col + 4);
                        const f32x4 x0 = *(const f32x4*)o, x1v = *(const f32x4*)(o + 4);
                        *(f32x4*)ow = x0 + g0 * acc[ai][bj][m][0]; *(f32x4*)(ow + 4) = x1v + g1 * acc[ai][bj][m][1]; }
                } else if (idx < u.n) {
                    const int t = list[(size_t)u.e * LISTCAP + idx];
                    const u32x2 ev = *(const u32x2*)(eidx + (size_t)t * 8);
                    int k = 0;
#pragma unroll
                    for (int q = 1; q < TOPK; ++q) { const unsigned b = (q < 4) ? ((ev.x >> (8 * q)) & 0xffu) : ((ev.y >> (8 * (q - 4))) & 0xffu); if ((int)b == u.e) k = q; }
                    const float w = gatew[(size_t)t * 8 + k];
#pragma unroll
                    for (int bj = 0; bj < 2; ++bj) *(u32x4*)(Y + ((size_t)t * TOPK + k) * D + c0 + 128 * bj) = pack8(acc[ai][bj][m][0] * w, acc[ai][bj][m][1] * w);
                }
            }
    }
};

template <int NT, bool GATHER_>
struct MoeOrder {
    static constexpr bool GATHER = GATHER_;
    const char* A; const char* Bt; const char* Bsh; int K; size_t bstride;
    const unsigned short* list; volatile LAS int* tab;
    int G, c;
    __device__ bool next(int i, Unit& u) const {
        int ti, pn_;
        if ((G & 7) == 0) { const int x = c & 7, j = i * (G >> 3) + (c >> 3); ti = (j / NT) * 8 + x; pn_ = j % NT; if (ti >= tab[65]) return false; }
        else { const int total = tab[65] * NT; const long L = (long)i * G + c; if (L >= total) return false; ti = (int)L / NT; pn_ = (int)L % NT; }
        u.pn = pn_; u.pm = ti;
        const int e = __builtin_amdgcn_readfirstlane(tab[132 + ti]);
        u.e = e; u.aux = __builtin_amdgcn_readfirstlane(ti - tab[e]); u.n = __builtin_amdgcn_readfirstlane(tab[66 + e]); return true;
    }
    __device__ __forceinline__ const char* a_ptr(const Unit& u) const { return GATHER ? A : A + (size_t)u.pm * 256 * K * 2; }
    __device__ __forceinline__ const char* b_ptr(const Unit& u) const { return (u.e == NEXP ? Bsh : Bt + (size_t)u.e * bstride) + (size_t)u.pn * 256 * K * 2; }
    __device__ __forceinline__ unsigned a_row(const Unit& u, int r) const {
        if (!GATHER) return (unsigned)r;
        const int idx = u.aux * 256 + r;
        if (u.e == NEXP) return (unsigned)idx;
        return (idx < u.n) ? (unsigned)list[(size_t)u.e * LISTCAP + idx] : 0u;
    }
};

struct UpOrder {
    static constexpr bool GATHER = false;
    const char* Aq; const char* Bq; const char* Akv; const char* Bkv; int K; int G, c;
    __device__ bool next(int i, Unit& u) const {
        int L = i * G + c; if (L >= 448) return false;
        if (L < 256) { u.e = 1; u.pm = L >> 2; u.pn = L & 3; } else { L -= 256; u.e = 0; u.pm = L / 3; u.pn = L % 3; }
        u.aux = 0; u.n = 256; return true; }
    __device__ __forceinline__ const char* a_ptr(const Unit& u) const { return (u.e ? Akv : Aq) + (size_t)u.pm * 256 * K * 2; }
    __device__ __forceinline__ const char* b_ptr(const Unit& u) const { return (u.e ? Bkv : Bq) + (size_t)u.pn * 256 * K * 2; }
    __device__ __forceinline__ unsigned a_row(const Unit&, int r) const { return (unsigned)r; }
};
struct EpiUp {
    static constexpr bool MIDK = false;
    EpiQup q; EpiKVup kv;
    __device__ __forceinline__ void operator()(const f32x4 (&acc)[2][2][4][2], const Unit& u, int wr, int wc, int fr, int fq_) const { if (u.e) kv(acc, u, wr, wc, fr, fq_); else q(acc, u, wr, wc, fr, fq_); }
};

struct SharedDownOrder {
    static constexpr bool GATHER = false;
    const char* A; const char* Bt; int K; int G, c;
    __device__ bool next(int i, Unit& u) const { const int L = i * G + c; if (L >= (T / 256) * 4) return false; u.pm = L >> 2; u.pn = L & 3; u.e = NEXP; u.aux = L >> 2; u.n = 256; return true; }
    __device__ __forceinline__ const char* a_ptr(const Unit& u) const { return A + (size_t)u.pm * 256 * K * 2; }
    __device__ __forceinline__ const char* b_ptr(const Unit& u) const { return Bt + (size_t)u.pn * 256 * K * 2; }
    __device__ __forceinline__ unsigned a_row(const Unit&, int r) const { return (unsigned)r; }
};

namespace att {
constexpr int KSLOT = 12288, VSLOT = 8192;
constexpr int L_K = 0, L_V = 3 * KSLOT, L_F = L_V + 2 * VSLOT, L_WS = L_F + 3 * 256, L_OST = L_WS + 2048, L_END = L_OST + 8 * 4096;
static_assert(L_END <= RING_BYTES, "attention LDS");
__device__ __forceinline__ int crow(int r, int hi) { return (r & 3) + 8 * (r >> 2) + 4 * hi; }
__device__ __forceinline__ float max3f(float a, float b, float c) { return fmaxf(fmaxf(a, b), c); }
__device__ __forceinline__ float rowmax(const f32x16& p0, const f32x16& p1) {
    float a = max3f(p0[0], p0[1], p1[0]), b = max3f(p0[2], p0[3], p1[1]); a = max3f(a, p1[2], p1[3]);
#pragma unroll
    for (int r = 4; r < 16; r += 4) { a = max3f(a, p0[r], p0[r + 1]); b = max3f(b, p0[r + 2], p0[r + 3]); a = max3f(a, p1[r], p1[r + 1]); b = max3f(b, p1[r + 2], p1[r + 3]); }
    const float m = fmaxf(a, b);
    auto rr = __builtin_amdgcn_permlane32_swap(__float_as_uint(m), __float_as_uint(m), false, false);
    return fmaxf(__uint_as_float(rr[0]), __uint_as_float(rr[1]));
}
__device__ __forceinline__ void cmask(f32x16& p0, f32x16& p1, int jb, int qrel, int hi) {
    const float NEG = -INFINITY; const int kb = 64 * jb + 4 * hi;
#pragma unroll
    for (int r = 0; r < 16; ++r) { const int kv = kb + (r & 3) + 8 * (r >> 2); if (kv > qrel) p0[r] = NEG; if (kv + 32 > qrel) p1[r] = NEG; }
}
__device__ __forceinline__ void pv(f32x16* o, int vb, bf16x8 pa0, bf16x8 pa1, bf16x8 pa2, bf16x8 pa3) {
#pragma unroll
    for (int d0 = 0; d0 < 2; ++d0) { s16x4 lo[4], hi[4];
#pragma unroll
        for (int ks = 0; ks < 4; ++ks) {
            asm volatile("ds_read_b64_tr_b16 %0,%1 offset:%c2" : "=&v"(lo[ks]) : "v"(vb), "i"(d0 * 4096 + ks * 1024) : "memory");
            asm volatile("ds_read_b64_tr_b16 %0,%1 offset:%c2" : "=&v"(hi[ks]) : "v"(vb), "i"(d0 * 4096 + ks * 1024 + 512) : "memory"); }
        asm volatile("s_waitcnt lgkmcnt(0)" ::: "memory"); __builtin_amdgcn_sched_barrier(0);
#define PK(k) (bf16x8){lo[k][0], lo[k][1], lo[k][2], lo[k][3], hi[k][0], hi[k][1], hi[k][2], hi[k][3]}
        o[d0] = __builtin_amdgcn_mfma_f32_32x32x16_bf16(pa0, PK(0), o[d0], 0, 0, 0);
        o[d0] = __builtin_amdgcn_mfma_f32_32x32x16_bf16(pa1, PK(1), o[d0], 0, 0, 0);
        o[d0] = __builtin_amdgcn_mfma_f32_32x32x16_bf16(pa2, PK(2), o[d0], 0, 0, 0);
        o[d0] = __builtin_amdgcn_mfma_f32_32x32x16_bf16(pa3, PK(3), o[d0], 0, 0, 0);
#undef PK
    }
}
__device__ __forceinline__ unsigned cvtpk_s(float lo, float hi) { return cvt_pk_bf16(lo, hi); }

template <int DQK, bool DECAY, int THRL>
__device__ __forceinline__ void attn_unit(int b, int h, int qb, const bf16* Q, int QP, const bf16* Kn, const bf16* Kpe, const bf16* V, const float* cumF, bf16* O, int OP, LAS unsigned char* lds) {
    constexpr int ND0 = DQK / 16;
    int tid = threadIdx.x; asm volatile("" : "+v"(tid));
    const int lane = tid & 63, r32 = lane & 31, hi = lane >> 5; const int wid = __builtin_amdgcn_readfirstlane(tid >> 6);
    const long rowbase = (long)b * SEQ; const int q0 = qb * 256;
    const bf16* Qw = Q + (rowbase + q0 + wid * 32) * QP + h * DQK;
    const bf16* Kh = Kn + rowbase * 512 + h * 64; const bf16* Vh = V + rowbase * 512 + h * 64;
    const bf16* Kp = Kpe + rowbase * ROPE;
    const float* Fh = DECAY ? cumF + ((size_t)b * NHEAD + h) * SEQ : nullptr;
    LAS float* wsf = (LAS float*)(lds + L_WS) + wid * 64;
    const bf16* ksrc0 = Kh + (long)lane * 512 + wid * 8;
    const bf16* ksrc1 = Kp + (long)lane * ROPE + (wid & 3) * 8;
    const bf16* vsrc = Vh + (long)(16 * (wid & 3) + (lane >> 2)) * 512 + (wid >> 2) * 32 + (lane & 3) * 8;
    const int NT = (q0 + 256) / 64;
#define ATT_DMA_K(i_, s) do { const int t_ = NT - 1 - (i_); \
        __builtin_amdgcn_global_load_lds((const unsigned*)(ksrc0 + (long)t_ * 64 * 512), (LAS unsigned*)(lds + L_K + (s) * KSLOT + wid * 1024), 16, 0, 0); \
        if (DQK == 96 && wid < 4) __builtin_amdgcn_global_load_lds((const unsigned*)(ksrc1 + (long)t_ * 64 * ROPE), (LAS unsigned*)(lds + L_K + (s) * KSLOT + (8 + wid) * 1024), 16, 0, 0); \
        if (DECAY && wid == 7) __builtin_amdgcn_global_load_lds((const unsigned*)(Fh + t_ * 64 + lane), (LAS unsigned*)(lds + L_F + (s) * 256), 4, 0, 0); } while (0)
#define ATT_DMA_V(i_, s) do { const int t_ = NT - 1 - (i_); \
        __builtin_amdgcn_global_load_lds((const unsigned*)(vsrc + (long)t_ * 64 * 512), (LAS unsigned*)(lds + L_V + (s) * VSLOT + wid * 1024), 16, 0, 0); } while (0)
    ATT_DMA_K(0, 0); ATT_DMA_V(0, 0); ATT_DMA_K(1, 1);
    bf16x8 qr[ND0];
#pragma unroll
    for (int d0 = 0; d0 < ND0; ++d0) qr[d0] = *(const bf16x8*)(Qw + (long)r32 * QP + d0 * 16 + hi * 8);
    float fq_l = 0.f; if (DECAY) fq_l = Fh[q0 + wid * 32 + r32];
    float mhat = 0.f, l_reg = 0.f; bool started = false; f32x16 o[2]; o[0] = f32x16{}; o[1] = f32x16{};
    const int qrel = wid * 32 + r32;
    const int vb0 = (int)(uintptr_t)(lds + L_V) + ((lane >> 4) & 1) * 32 + (lane & 3) * 8 + (4 * hi + ((lane & 15) >> 2)) * 64;
#define ATT_QK(P0, P1, ks_) do { const float base_ = fq_l - mhat; \
        if (DECAY) { const LAS f32x4* fk_ = (const LAS f32x4*)(lds + L_F + (ks_) * 256); \
            _Pragma("unroll") for (int g = 0; g < 4; ++g) { const f32x4 a_ = fk_[2 * g + hi], c_ = fk_[8 + 2 * g + hi]; \
                _Pragma("unroll") for (int q = 0; q < 4; ++q) { P0[4 * g + q] = base_ - a_[q]; P1[4 * g + q] = base_ - c_[q]; } } } \
        else { _Pragma("unroll") for (int r = 0; r < 16; ++r) { P0[r] = base_; P1[r] = base_; } } \
        const LAS unsigned char* kb_ = lds + L_K + (ks_) * KSLOT + hi * 1024 + r32 * 16; \
        _Pragma("unroll") for (int d0 = 0; d0 < ND0; ++d0) { \
            const bf16x8 b0_ = *(const LAS bf16x8*)(kb_ + d0 * 2048), b1_ = *(const LAS bf16x8*)(kb_ + d0 * 2048 + 512); \
            P0 = __builtin_amdgcn_mfma_f32_32x32x16_bf16(b0_, qr[d0], P0, 0, 0, 0); P1 = __builtin_amdgcn_mfma_f32_32x32x16_bf16(b1_, qr[d0], P1, 0, 0, 0); } } while (0)
    f32x16 p0, p1, n0, n1;
    int ks_cur = 0, ks_nxt = 1, ks_ld = 2;
    for (int i = 0; i < NT; ++i) {
        const int vs = i & 1;
        VM_WAIT(); __syncthreads();
        if (i + 2 < NT) ATT_DMA_K(i + 2, ks_ld);
        if (i + 1 < NT) ATT_DMA_V(i + 1, vs ^ 1);
        if (i == 0) ATT_QK(p0, p1, 0);
        if (i + 1 < NT) ATT_QK(n0, n1, ks_nxt);
        const int jb = 3 - i;
        if (jb >= 0) cmask(p0, p1, jb, qrel, hi);
        const float rm = rowmax(p0, p1);
        bool resc = false; float dl = 0.f; const bool was_started = started;
        if (jb >= 0) {
            const bool fin = rm > -INFINITY;
            dl = started ? fmaxf(rm, 0.f) : (fin ? rm : 0.f); started = started || fin; resc = true;
        } else if (__any(rm > (float)THRL)) { dl = fmaxf(rm, 0.f); resc = true; }
        if (resc) { mhat += dl;
#pragma unroll
            for (int r = 0; r < 16; ++r) { p0[r] -= dl; p1[r] -= dl; }
            if (i + 1 < NT) {
#pragma unroll
                for (int r = 0; r < 16; ++r) { n0[r] -= dl; n1[r] -= dl; } }
            const float f = was_started ? __builtin_amdgcn_exp2f(-dl) : 1.f; l_reg *= f; if (hi == 0) wsf[r32] = f; }
        float sacc = 0.f;
#pragma unroll
        for (int r = 0; r < 16; ++r) { p0[r] = __builtin_amdgcn_exp2f(p0[r]); p1[r] = __builtin_amdgcn_exp2f(p1[r]); sacc += p0[r] + p1[r]; }
        l_reg += sacc;
        if (resc) { LDS_WAIT();
#pragma unroll
            for (int d_ = 0; d_ < 2; ++d_)
#pragma unroll
                for (int r = 0; r < 16; ++r) o[d_][r] *= wsf[crow(r, hi)]; }
        u32x4 pw0, pw1, pw2, pw3;
        pw0 = (u32x4){cvtpk_s(p0[0], p0[1]), cvtpk_s(p0[2], p0[3]), cvtpk_s(p0[4], p0[5]), cvtpk_s(p0[6], p0[7])};
        pw1 = (u32x4){cvtpk_s(p0[8], p0[9]), cvtpk_s(p0[10], p0[11]), cvtpk_s(p0[12], p0[13]), cvtpk_s(p0[14], p0[15])};
        pw2 = (u32x4){cvtpk_s(p1[0], p1[1]), cvtpk_s(p1[2], p1[3]), cvtpk_s(p1[4], p1[5]), cvtpk_s(p1[6], p1[7])};
        pw3 = (u32x4){cvtpk_s(p1[8], p1[9]), cvtpk_s(p1[10], p1[11]), cvtpk_s(p1[12], p1[13]), cvtpk_s(p1[14], p1[15])};
        __builtin_amdgcn_sched_barrier(0);
        pv(o, vb0 + vs * VSLOT, __builtin_bit_cast(bf16x8, pw0), __builtin_bit_cast(bf16x8, pw1), __builtin_bit_cast(bf16x8, pw2), __builtin_bit_cast(bf16x8, pw3));
        p0 = n0; p1 = n1;
        { const int t_ = ks_cur; ks_cur = ks_nxt; ks_nxt = ks_ld; ks_ld = t_; }
    }
    { auto rr = __builtin_amdgcn_permlane32_swap(__float_as_uint(l_reg), __float_as_uint(l_reg), false, false); l_reg = __uint_as_float(rr[0]) + __uint_as_float(rr[1]); }
    if (hi == 0) wsf[32 + r32] = l_reg; LDS_WAIT();
    float rli[16];
#pragma unroll
    for (int r = 0; r < 16; ++r) rli[r] = __builtin_amdgcn_rcpf(wsf[32 + crow(r, hi)]);
    unsigned char* Ow = (unsigned char*)O + (rowbase + q0 + wid * 32) * OP + h * 64;
    { LAS unsigned char* stg = lds + L_OST + wid * 4096;
#pragma unroll
      for (int r = 0; r < 16; ++r) { const int orow = crow(r, hi);
#pragma unroll
          for (int d0 = 0; d0 < 2; ++d0) { const float ov = o[d0][r] * rli[r] * OSCALE8; stg[orow * 64 + d0 * 32 + r32] = (unsigned char)__builtin_amdgcn_cvt_pk_fp8_f32(ov, ov, 0, false); } }
      LDS_WAIT();
#pragma unroll
      for (int i = 0; i < 2; ++i) { const int row = i * 16 + (lane >> 2), ch = lane & 3; const u32x4 v = *(const LAS u32x4*)(stg + row * 64 + ch * 16); *(u32x4*)(Ow + (long)row * OP + ch * 16) = v; } }
    LDS_WAIT(); __syncthreads();
#undef ATT_DMA_K
#undef ATT_DMA_V
#undef ATT_QK
}

constexpr int T_KSLOT = 12288, T_VSLOT = 8192, T_NSLOT = 3;
constexpr int T_K = 0, T_V = T_NSLOT * T_KSLOT, T_F = T_V + T_NSLOT * T_VSLOT, T_WS = T_F + T_NSLOT * 256, T_OST = T_WS + 2048, T_END = T_OST + 8 * 4096;
static_assert(T_END <= RING_BYTES, "attention LDS (hand-interleaved unit)");
typedef __attribute__((address_space(3))) const char* lds_cptr;
typedef short v4i16_t __attribute__((ext_vector_type(4)));
__device__ __forceinline__ s16x4 vtr(lds_cptr p) { return __builtin_bit_cast(s16x4, __builtin_amdgcn_ds_read_tr16_b64_v4i16((__attribute__((address_space(3))) v4i16_t*)p)); }
__device__ __forceinline__ void kload2(bf16x8* kf, lds_cptr kp, int j) { kf[2 * j] = *(const __attribute__((address_space(3))) bf16x8*)(kp + j * 2048); kf[2 * j + 1] = *(const __attribute__((address_space(3))) bf16x8*)(kp + j * 2048 + 512); }
#define TW_BAR(N) asm volatile("s_waitcnt vmcnt(" #N ") lgkmcnt(0)\n\ts_barrier" ::: "memory")
#define TSB() __builtin_amdgcn_sched_barrier(0)

template <int DQK, bool DECAY, int THRL>
__device__ __forceinline__ void attn_unit_t(int b, int h, int qb, const bf16* Q, int QP, const bf16* Kn, const bf16* Kpe, const bf16* V, const float* cumF, float kmax2, bf16* O, int OP, LAS unsigned char* lds) {
    constexpr int ND0 = DQK / 16;
    constexpr bool INPL = DECAY || (DQK == 96);
    int tid = threadIdx.x; asm volatile("" : "+v"(tid));
    const int lane = tid & 63, r32 = lane & 31, hi = lane >> 5; const int wid = __builtin_amdgcn_readfirstlane(tid >> 6);
    const long rowbase = (long)b * SEQ; const int q0 = qb * 256;
    const bf16* Qw = Q + (rowbase + q0 + wid * 32) * QP + h * DQK;
    const bf16* Kh = Kn + rowbase * 512 + h * 64; const bf16* Vh = V + rowbase * 512 + h * 64;
    const bf16* Kp = Kpe + rowbase * ROPE;
    const float* Fh = DECAY ? cumF + ((size_t)b * NHEAD + h) * SEQ : nullptr;
    LAS float* wsf = (LAS float*)(lds + T_WS) + wid * 64;
    const bf16* ksrc0 = Kh + (long)lane * 512 + wid * 8;
    const bf16* ksrc1 = Kp + (long)lane * ROPE + (wid & 3) * 8;
    const bf16* vsrc = Vh + (long)(16 * (wid & 3) + (lane >> 2)) * 512 + (wid >> 2) * 32 + (lane & 3) * 8;
    const int NTS = (q0 + 256) / 64;
#define TDMA_K(i_, sk) do { const int t_ = NTS - 1 - (i_); \
        __builtin_amdgcn_global_load_lds((const unsigned*)(ksrc0 + (long)t_ * 64 * 512), (LAS unsigned*)(lds + T_K + (sk) * T_KSLOT + wid * 1024), 16, 0, 0); \
        if (DECAY) __builtin_amdgcn_global_load_lds((const unsigned*)(Fh + t_ * 64 + lane), (LAS unsigned*)(lds + T_F + (sk) * 256), 4, 0, 0); \
        else __builtin_amdgcn_global_load_lds((const unsigned*)(ksrc1 + (long)t_ * 64 * ROPE), (LAS unsigned*)(lds + T_K + (sk) * T_KSLOT + (8 + (wid & 3)) * 1024), 16, 0, 0); } while (0)
#define TDMA_V(i_, sv) do { const int t_ = NTS - 1 - (i_); \
        __builtin_amdgcn_global_load_lds((const unsigned*)(vsrc + (long)t_ * 64 * 512), (LAS unsigned*)(lds + T_V + (sv) * T_VSLOT + wid * 1024), 16, 0, 0); } while (0)
    TDMA_K(0, 0); TDMA_V(0, 0); TDMA_K(1, 1);
    bf16x8 qr[ND0];
#pragma unroll
    for (int d0 = 0; d0 < ND0; ++d0) qr[d0] = *(const bf16x8*)(Qw + (long)r32 * QP + d0 * 16 + hi * 8);
    float fq_l = 0.f; if (DECAY) fq_l = Fh[q0 + wid * 32 + r32];
    float ftile = 0.f; if (DECAY) ftile = Fh[(lane < NTS ? lane : NTS - 1) * 64 + 63];
    float mhat = 0.f, l_reg = 0.f; f32x16 o[2]; o[0] = f32x16{}; o[1] = f32x16{};
    f32x16 negm = f32x16{}; asm volatile("" : "+v"(negm));
    const int qrel = wid * 32 + r32, i0 = 3 - (wid >> 1);
    const lds_cptr shm3 = (lds_cptr)lds; const lds_cptr kp0 = shm3 + T_K + hi * 1024 + r32 * 16;
    const lds_cptr vp0 = shm3 + T_V + ((lane >> 4) & 1) * 32 + (lane & 3) * 8 + (4 * hi + ((lane & 15) >> 2)) * 64;
    const int vb0 = (int)(uintptr_t)(lds + T_V) + ((lane >> 4) & 1) * 32 + (lane & 3) * 8 + (4 * hi + ((lane & 15) >> 2)) * 64;
    bool resc = false;
    bf16x8 kf[2 * ND0];
    f32x16 pA0, pA1, pB0, pB1;
    int sl_prev = 0, sl_cur = 0, sl_next = 1;
#define TROT() do { sl_prev = sl_cur; sl_cur = sl_next; sl_next = (sl_next == T_NSLOT - 1) ? 0 : sl_next + 1; } while (0)
#define TBIAS(X0, X1, fs_) do { if (DECAY) { const float base_ = fq_l - mhat; const LAS f32x4* fk_ = (const LAS f32x4*)(lds + T_F + (fs_) * 256); \
        _Pragma("unroll") for (int g = 0; g < 4; ++g) { const f32x4 a_ = fk_[2 * g + hi], c_ = fk_[8 + 2 * g + hi]; \
            _Pragma("unroll") for (int q = 0; q < 4; ++q) { X0[4 * g + q] = base_ - a_[q]; X1[4 * g + q] = base_ - c_[q]; } } } \
        else if (INPL) { const float nm_ = -mhat; _Pragma("unroll") for (int r = 0; r < 16; ++r) { X0[r] = nm_; X1[r] = nm_; } } } while (0)
#define TCIN(X) (INPL ? X : negm)
#define TRESC() do { if (resc) { asm volatile("s_waitcnt lgkmcnt(0)" ::: "memory"); \
        _Pragma("unroll") for (int d_ = 0; d_ < 2; ++d_) _Pragma("unroll") for (int r = 0; r < 16; ++r) o[d_][r] *= wsf[crow(r, hi)]; } } while (0)
#define TDECIDE(C0, C1, i_) do { \
        float a_ = max3f(C0[0], C0[1], C1[0]), b_ = max3f(C0[2], C0[3], C1[1]); a_ = max3f(a_, C1[2], C1[3]); \
        _Pragma("unroll") for (int r = 4; r < 16; r += 4) { a_ = max3f(a_, C0[r], C0[r + 1]); b_ = max3f(b_, C0[r + 2], C0[r + 3]); a_ = max3f(a_, C1[r], C1[r + 1]); b_ = max3f(b_, C1[r + 2], C1[r + 3]); } \
        float rm_ = fmaxf(a_, b_); { auto rr_ = __builtin_amdgcn_permlane32_swap(__float_as_uint(rm_), __float_as_uint(rm_), false, false); rm_ = fmaxf(__uint_as_float(rr_[0]), __uint_as_float(rr_[1])); } \
        resc = false; \
        if ((i_) == i0) { const float dl_ = rm_; mhat += dl_; \
            _Pragma("unroll") for (int r = 0; r < 16; ++r) { C0[r] -= dl_; C1[r] -= dl_; } \
            if (!INPL) { _Pragma("unroll") for (int r = 0; r < 16; ++r) negm[r] = -mhat; asm volatile("" : "+v"(negm)); } } \
        else if (__builtin_expect(__any(rm_ > (float)THRL), 0)) { const float dl_ = fmaxf(rm_, 0.f); mhat += dl_; \
            _Pragma("unroll") for (int r = 0; r < 16; ++r) { C0[r] -= dl_; C1[r] -= dl_; } \
            if (!INPL) { _Pragma("unroll") for (int r = 0; r < 16; ++r) negm[r] = -mhat; asm volatile("" : "+v"(negm)); } \
            const float f_ = __builtin_amdgcn_exp2f(-dl_); l_reg *= f_; if (hi == 0) wsf[r32] = f_; resc = true; } } while (0)
    TDMA_K(2, 2);
    TW_BAR(5);
    int NT = NTS;
    if (DECAY) {
        const float bound = 2.f * __builtin_sqrtf(kmax2) * 1.0001f + 1.f + (Fh[q0] - ftile);
        const unsigned long long need = __ballot(lane < NTS && bound >= -160.f);
        const int tmin = need ? (int)__builtin_ctzll(need) : NTS - 1;
        NT = NTS - tmin; NT += NT & 1; if (NT < 8) NT = 8; if (NT > NTS) NT = NTS;
        NT = __builtin_amdgcn_readfirstlane(NT); }
    TBIAS(pA0, pA1, 0);
    { const lds_cptr kb = kp0;
#pragma unroll
      for (int d0 = 0; d0 < ND0; ++d0) { const bf16x8 b0 = *(const __attribute__((address_space(3))) bf16x8*)(kb + d0 * 2048), b1 = *(const __attribute__((address_space(3))) bf16x8*)(kb + d0 * 2048 + 512);
          if (d0 == 0) { pA0 = __builtin_amdgcn_mfma_f32_32x32x16_bf16(b0, qr[0], TCIN(pA0), 0, 0, 0); pA1 = __builtin_amdgcn_mfma_f32_32x32x16_bf16(b1, qr[0], TCIN(pA1), 0, 0, 0); }
          else { pA0 = __builtin_amdgcn_mfma_f32_32x32x16_bf16(b0, qr[d0], pA0, 0, 0, 0); pA1 = __builtin_amdgcn_mfma_f32_32x32x16_bf16(b1, qr[d0], pA1, 0, 0, 0); } } }
    cmask(pA0, pA1, 3, qrel, hi);
    TDECIDE(pA0, pA1, 0);
#pragma unroll
    for (int r = 0; r < 16; ++r) { pA0[r] = __builtin_amdgcn_exp2f(pA0[r]); pA1[r] = __builtin_amdgcn_exp2f(pA1[r]); }
    TW_BAR(0);
    TDMA_K(3, 0); TDMA_V(1, 1);
    TROT();
#pragma unroll
    for (int j = 0; j < ND0; ++j) kload2(kf, kp0 + sl_cur * T_KSLOT, j);
    TBIAS(pB0, pB1, sl_cur);
    TW_BAR(3);
    s16x4 vlo[8], vhi[8]; u32x4 pw0, pw1, pw2, pw3;
#define TPKW(P, B) cvt_pk_bf16(P[B], P[B + 1])
#define TPAF(k) __builtin_bit_cast(bf16x8, pw##k)
#define TVFR(i) (bf16x8){vlo[i][0], vlo[i][1], vlo[i][2], vlo[i][3], vhi[i][0], vhi[i][1], vhi[i][2], vhi[i][3]}
#define TPIN(x) asm volatile("" : "+v"(x))
#define TGAPA(MF, A0, A1, A2, A3, W0, W1, PW) do { MF; sacc += A0; sacc += A1; sacc += A2; sacc += A3; TPIN(sacc); W0; W1; TPIN(PW); TSB(); } while (0)
#define TEX(v) __builtin_amdgcn_exp2f(v)
#define TGAPB(MF, X, B) do { MF; X[B] = TEX(X[B]); X[B + 1] = TEX(X[B + 1]); X[B + 2] = TEX(X[B + 2]); X[B + 3] = TEX(X[B + 3]); TPIN(X); TSB(); } while (0)
#define TVRD(i) do { vlo[i] = vtr(vp_ + (((i) >> 2) * 4096 + ((i) & 3) * 1024)); vhi[i] = vtr(vp_ + (((i) >> 2) * 4096 + ((i) & 3) * 1024 + 512)); } while (0)
#define TKRD(G, j) do { if (G) { kload2(kf, kp0 + sl_next * T_KSLOT, j); TSB(); } } while (0)
#define TMF(a, b, c) __builtin_amdgcn_mfma_f32_32x32x16_bf16(a, b, c, 0, 0, 0)
#define TSTEP(C0, C1, P0, P1, i_, MJB, GK, GV, GL) do { TSB(); \
        const lds_cptr vp_ = vp0 + sl_prev * T_VSLOT; \
        TVRD(0); TSB(); float sacc = (P0[0] + P0[1]); \
        TGAPA(C0 = TMF(kf[0], qr[0], TCIN(C0)), P0[2], P0[3], P0[4], P0[5],     pw0[0] = TPKW(P0, 0), pw0[1] = TPKW(P0, 2), pw0); \
        TVRD(4); TSB(); TGAPA(C1 = TMF(kf[1], qr[0], TCIN(C1)), P0[6], P0[7], P0[8], P0[9],     pw0[2] = TPKW(P0, 4), pw0[3] = TPKW(P0, 6), pw0); \
        TVRD(1); TSB(); TGAPA(C0 = TMF(kf[2], qr[1], C0),   P0[10], P0[11], P0[12], P0[13], pw1[0] = TPKW(P0, 8), pw1[1] = TPKW(P0, 10), pw1); \
        TVRD(5); TSB(); TGAPA(C1 = TMF(kf[3], qr[1], C1),   P0[14], P0[15], P1[0], P1[1],   pw1[2] = TPKW(P0, 12), pw1[3] = TPKW(P0, 14), pw1); \
        TVRD(2); TSB(); TGAPA(C0 = TMF(kf[4], qr[2], C0),   P1[2], P1[3], P1[4], P1[5],     pw2[0] = TPKW(P1, 0), pw2[1] = TPKW(P1, 2), pw2); \
        TVRD(6); TSB(); TGAPA(C1 = TMF(kf[5], qr[2], C1),   P1[6], P1[7], P1[8], P1[9],     pw2[2] = TPKW(P1, 4), pw2[3] = TPKW(P1, 6), pw2); \
        TVRD(3); TSB(); TGAPA(C0 = TMF(kf[6], qr[3], C0),   P1[10], P1[11], P1[12], P1[13], pw3[0] = TPKW(P1, 8), pw3[1] = TPKW(P1, 10), pw3); \
        TVRD(7); TSB(); TGAPA(C1 = TMF(kf[7], qr[3], C1),   P1[14], P1[15], 0.f, 0.f,       pw3[2] = TPKW(P1, 12), pw3[3] = TPKW(P1, 14), pw3); \
        if (ND0 == 6) { C0 = TMF(kf[2 * ND0 - 4], qr[ND0 - 2], C0); C1 = TMF(kf[2 * ND0 - 3], qr[ND0 - 2], C1); C0 = TMF(kf[2 * ND0 - 2], qr[ND0 - 1], C0); C1 = TMF(kf[2 * ND0 - 1], qr[ND0 - 1], C1); TSB(); } \
        l_reg += sacc; \
        if (GK) { TDMA_K((i_) + 3, sl_cur); } if (GV) { TDMA_V((i_) + 1, sl_next); } \
        if ((MJB) >= 0) cmask(C0, C1, (MJB), qrel, hi); \
        TDECIDE(C0, C1, i_); \
        TSB(); \
        TGAPB(o[0] = TMF(TPAF(0), TVFR(0), o[0]), C0, 0); \
        TKRD(GL, 0); TGAPB(o[1] = TMF(TPAF(0), TVFR(4), o[1]), C0, 4); \
        TKRD(GL, 1); TGAPB(o[0] = TMF(TPAF(1), TVFR(1), o[0]), C0, 8); \
        TKRD(GL, 2); TGAPB(o[1] = TMF(TPAF(1), TVFR(5), o[1]), C0, 12); \
        TKRD(GL, 3); TGAPB(o[0] = TMF(TPAF(2), TVFR(2), o[0]), C1, 0); \
        if (ND0 == 6) { TKRD(GL, ND0 - 2); } TGAPB(o[1] = TMF(TPAF(2), TVFR(6), o[1]), C1, 4); \
        if (ND0 == 6) { TKRD(GL, ND0 - 1); } TGAPB(o[0] = TMF(TPAF(3), TVFR(3), o[0]), C1, 8); \
        TGAPB(o[1] = TMF(TPAF(3), TVFR(7), o[1]), C1, 12); \
        if (GL) { TBIAS(P0, P1, sl_next); } \
    } while (0)
#define TENDW(tt) do { if ((tt) + 3 < NT) { TW_BAR(3); } else if ((tt) + 2 < NT) { TW_BAR(1); } else { TW_BAR(0); } } while (0)
    TSTEP(pB0, pB1, pA0, pA1, 1, 2, (1 + 3 < NT), true, true); TENDW(1); TRESC(); TROT();
    TSTEP(pA0, pA1, pB0, pB1, 2, 1, (2 + 3 < NT), true, true); TENDW(2); TRESC(); TROT();
    {
        TSTEP(pB0, pB1, pA0, pA1, 3, 0, (3 + 3 < NT), true, true); TENDW(3); TRESC(); TROT();
        int i = 4;
        for (; i + 2 < NT; i += 2) {
            TSTEP(pA0, pA1, pB0, pB1, i, -1, (i + 3 < NT), true, true);                         TENDW(i);     TRESC(); TROT();
            TSTEP(pB0, pB1, pA0, pA1, i + 1, -1, (i + 4 < NT), (i + 2 < NT), (i + 2 < NT));     TENDW(i + 1); TRESC(); TROT();
        }
        TSTEP(pA0, pA1, pB0, pB1, NT - 2, -1, false, true, true); TENDW(NT - 2); TRESC(); TROT();
        TSTEP(pB0, pB1, pA0, pA1, NT - 1, -1, false, false, false); TRESC();
    }
    { float sacc = pB0[0] + pB0[1];
#pragma unroll
      for (int r = 2; r < 16; ++r) sacc += pB0[r];
#pragma unroll
      for (int r = 0; r < 16; ++r) sacc += pB1[r];
      l_reg += sacc;
      pw0 = (u32x4){TPKW(pB0, 0), TPKW(pB0, 2), TPKW(pB0, 4), TPKW(pB0, 6)}; pw1 = (u32x4){TPKW(pB0, 8), TPKW(pB0, 10), TPKW(pB0, 12), TPKW(pB0, 14)};
      pw2 = (u32x4){TPKW(pB1, 0), TPKW(pB1, 2), TPKW(pB1, 4), TPKW(pB1, 6)}; pw3 = (u32x4){TPKW(pB1, 8), TPKW(pB1, 10), TPKW(pB1, 12), TPKW(pB1, 14)};
      TSB(); pv(o, vb0 + sl_cur * T_VSLOT, TPAF(0), TPAF(1), TPAF(2), TPAF(3)); }
    { auto rr = __builtin_amdgcn_permlane32_swap(__float_as_uint(l_reg), __float_as_uint(l_reg), false, false); l_reg = __uint_as_float(rr[0]) + __uint_as_float(rr[1]); }
    if (hi == 0) wsf[32 + r32] = l_reg; asm volatile("s_waitcnt lgkmcnt(0)" ::: "memory");
    float rli[16];
#pragma unroll
    for (int r = 0; r < 16; ++r) rli[r] = __builtin_amdgcn_rcpf(wsf[32 + crow(r, hi)]);
    unsigned char* Ow = (unsigned char*)O + (rowbase + q0 + wid * 32) * OP + h * 64;
    { LAS unsigned char* stg = lds + T_OST + wid * 4096;
#pragma unroll
      for (int r = 0; r < 16; ++r) { const int orow = crow(r, hi);
#pragma unroll
          for (int d0 = 0; d0 < 2; ++d0) { const float ov = o[d0][r] * rli[r] * OSCALE8; stg[orow * 64 + d0 * 32 + r32] = (unsigned char)__builtin_amdgcn_cvt_pk_fp8_f32(ov, ov, 0, false); } }
      asm volatile("s_waitcnt lgkmcnt(0)" ::: "memory");
#pragma unroll
      for (int i = 0; i < 2; ++i) { const int row = i * 16 + (lane >> 2), ch = lane & 3; const u32x4 v = *(const LAS u32x4*)(stg + row * 64 + ch * 16); *(u32x4*)(Ow + (long)row * OP + ch * 16) = v; } }
    asm volatile("s_waitcnt lgkmcnt(0)\n\ts_barrier" ::: "memory");
#undef TDMA_K
#undef TDMA_V
#undef TROT
#undef TBIAS
#undef TCIN
#undef TRESC
#undef TDECIDE
#undef TPKW
#undef TPAF
#undef TVFR
#undef TPIN
#undef TGAPA
#undef TEX
#undef TGAPB
#undef TVRD
#undef TKRD
#undef TMF
#undef TSTEP
#undef TENDW
}
#undef TW_BAR
#undef TSB
}

namespace dn {
constexpr int CHB = 64 * 256;
constexpr int NSLOT = 8, AHEAD = 7;
__device__ __forceinline__ int nloc(int i) { return 16 * ((i >> 2) & 1) + (i & 3) + 4 * (i >> 3); }
template <bool NOTRAFFIC>
__device__ __forceinline__ void down_phase(LAS unsigned char* lds, const unsigned char* HBp, const unsigned char* Wd, const unsigned char* Wsd, volatile LAS int* tab, const u32x2* meta, unsigned char* Yp, unsigned char* trash, int G, int c) {
    int tid = threadIdx.x; asm volatile("" : "+v"(tid));
    const int wid = __builtin_amdgcn_readfirstlane(tid >> 6), lane = tid & 63, j = lane & 31, hi = lane >> 5;
    const int U = tab[65] * 8;
    const int u_lo = (int)(((long)c * U) / G), u_hi = (int)(((long)(c + 1) * U) / G);
    if (u_lo >= u_hi) return;
#define DN_DEC(u_, e_, hf_, ci_) do { e_ = __builtin_amdgcn_readfirstlane(tab[132 + ((u_) >> 3)]); const int ul_ = __builtin_amdgcn_readfirstlane((u_) - 8 * tab[e_]), nc_ = __builtin_amdgcn_readfirstlane(4 * (tab[e_ + 1] - tab[e_])); hf_ = (ul_ >= nc_) ? 1 : 0; ci_ = ul_ - hf_ * nc_; } while (0)
    unsigned dvo; { const int r_ = lane >> 3, f_ = ((r_ >> 1) & 3) << 1; dvo = (unsigned)(r_ * 256 + (((lane & 7) ^ f_) * 16)); }
#define DN_DMA(u_, buf_) do { int e__, hf__, ci__; DN_DEC(u_, e__, hf__, ci__); (void)hf__; const unsigned char* gb_ = HBp + ((size_t)tab[e__] * 256 + (size_t)ci__ * 64) * DEXP; \
        _Pragma("unroll") for (int i_ = 0; i_ < 2; ++i_) { const int q_ = wid * 2 + i_, kb_ = q_ >> 3, g_ = q_ & 7; \
            __builtin_amdgcn_global_load_lds((const unsigned*)(gb_ + (size_t)(8 * g_) * DEXP + kb_ * 128 + dvo), (LAS unsigned*)(lds + (buf_) * CHB + kb_ * 8192 + g_ * 1024), 16, 0, 0); } } while (0)
    int rowb[2], fx[2];
#pragma unroll
    for (int rt = 0; rt < 2; ++rt) { const int row = 32 * rt + j; rowb[rt] = (int)(uintptr_t)lds + row * 128; fx[rt] = (((row >> 1) & 3) << 1) * 16; }
    unsigned sc1 = 0x7f7f7f7fu; asm volatile("" : "+v"(sc1));
#pragma unroll
    for (int p = 0; p < AHEAD; ++p) { const int un = (u_lo + p < u_hi) ? u_lo + p : u_lo; DN_DMA(un, p); }
    int u = u_lo;
    while (u < u_hi) {
      int e, hf, ci0; DN_DEC(u, e, hf, ci0);
      const int nc = __builtin_amdgcn_readfirstlane(4 * (tab[e + 1] - tab[e])), ne = __builtin_amdgcn_readfirstlane(tab[66 + e]);
      int seg_end = 8 * tab[e] + (hf + 1) * nc; seg_end = __builtin_amdgcn_readfirstlane(seg_end < u_hi ? seg_end : u_hi);
      v8i32_t wfr[2][4];
#pragma unroll
      for (int nt = 0; nt < 2; ++nt) { const unsigned char* wp = ((e == NEXP) ? Wsd : Wd + (size_t)e * D * DEXP) + (size_t)(512 * hf + 64 * wid + 32 * nt + nloc(j)) * DEXP + 32 * hi;
#pragma unroll
          for (int ks = 0; ks < 4; ++ks) { wfr[nt][ks].lo = *(const v4i32_t*)(wp + 64 * ks); wfr[nt][ks].hi = *(const v4i32_t*)(wp + 64 * ks + 16); } }
      bool first = true;
      for (; u < seg_end; ++u) {
        const int buf = (u - u_lo) & (NSLOT - 1); (void)ci0;
        const int cidx = __builtin_amdgcn_readfirstlane((u - 8 * tab[e]) - hf * nc);
        u32x2 mt[2];
#pragma unroll
        for (int rt = 0; rt < 2; ++rt) { int pos = 64 * cidx + 32 * rt + j; const bool in = pos < ne; const int sp = pos; pos = (in && e != NEXP) ? pos : 0; const u32x2 m = meta[(size_t)(e == NEXP ? 0 : e) * LISTCAP + pos];
            mt[rt] = !in ? (u32x2){0xffffffffu, 0u} : (e == NEXP) ? (u32x2){(unsigned)(sp * (TOPK + 1) + TOPK), 0x3f800000u} : m; }
        if (first) { __builtin_amdgcn_s_waitcnt(0x0F70); first = false; }
        else { asm volatile("s_waitcnt vmcnt(54)" ::: "memory"); }
        LDS_WAIT(); __builtin_amdgcn_s_barrier();
        { const int un = (u + AHEAD < u_hi) ? u + AHEAD : u; DN_DMA(un, (buf + AHEAD) & (NSLOT - 1)); }
        f32x16 acc[2][2];
#pragma unroll
        for (int rt = 0; rt < 2; ++rt)
#pragma unroll
            for (int nt = 0; nt < 2; ++nt) asm volatile("v_mov_b32 %0, 0\n\tv_mov_b32 %1, 0\n\tv_mov_b32 %2, 0\n\tv_mov_b32 %3, 0\n\tv_mov_b32 %4, 0\n\tv_mov_b32 %5, 0\n\tv_mov_b32 %6, 0\n\tv_mov_b32 %7, 0\n\tv_mov_b32 %8, 0\n\tv_mov_b32 %9, 0\n\tv_mov_b32 %10, 0\n\tv_mov_b32 %11, 0\n\tv_mov_b32 %12, 0\n\tv_mov_b32 %13, 0\n\tv_mov_b32 %14, 0\n\tv_mov_b32 %15, 0"
                : "=v"(acc[rt][nt][0]), "=v"(acc[rt][nt][1]), "=v"(acc[rt][nt][2]), "=v"(acc[rt][nt][3]), "=v"(acc[rt][nt][4]), "=v"(acc[rt][nt][5]), "=v"(acc[rt][nt][6]), "=v"(acc[rt][nt][7]),
                  "=v"(acc[rt][nt][8]), "=v"(acc[rt][nt][9]), "=v"(acc[rt][nt][10]), "=v"(acc[rt][nt][11]), "=v"(acc[rt][nt][12]), "=v"(acc[rt][nt][13]), "=v"(acc[rt][nt][14]), "=v"(acc[rt][nt][15]));
        v8i32_t ha0, ha1, hb0, hb1;
        const int ad0 = rowb[0] + buf * CHB, ad1 = rowb[1] + buf * CHB;
#define DN_RDA(ks_) do { \
            asm volatile("ds_read_b128 v[192:195], %1 offset:%c2\n\tds_read_b128 v[196:199], %1 offset:%c3" : "={v[192:199]}"(ha0) : "v"(ad0 + ((64 * ((ks_) & 1) + 32 * hi) ^ fx[0])), "i"(((ks_) >> 1) * 8192), "i"(((ks_) >> 1) * 8192 + 16) : "memory"); \
            asm volatile("ds_read_b128 v[200:203], %1 offset:%c2\n\tds_read_b128 v[204:207], %1 offset:%c3" : "={v[200:207]}"(ha1) : "v"(ad1 + ((64 * ((ks_) & 1) + 32 * hi) ^ fx[1])), "i"(((ks_) >> 1) * 8192), "i"(((ks_) >> 1) * 8192 + 16) : "memory"); } while (0)
#define DN_RDB(ks_) do { \
            asm volatile("ds_read_b128 v[208:211], %1 offset:%c2\n\tds_read_b128 v[212:215], %1 offset:%c3" : "={v[208:215]}"(hb0) : "v"(ad0 + ((64 * ((ks_) & 1) + 32 * hi) ^ fx[0])), "i"(((ks_) >> 1) * 8192), "i"(((ks_) >> 1) * 8192 + 16) : "memory"); \
            asm volatile("ds_read_b128 v[216:219], %1 offset:%c2\n\tds_read_b128 v[220:223], %1 offset:%c3" : "={v[216:223]}"(hb1) : "v"(ad1 + ((64 * ((ks_) & 1) + 32 * hi) ^ fx[1])), "i"(((ks_) >> 1) * 8192), "i"(((ks_) >> 1) * 8192 + 16) : "memory"); } while (0)
#define DN_MF(W_, ACC_, H_, REG_, WAIT_) asm volatile(WAIT_ "v_mfma_scale_f32_32x32x64_f8f6f4 %0, %1, %2, %0, %3, %3 op_sel_hi:[0,0,0]" : "+v"(ACC_) : "v"(W_), REG_(H_), "v"(sc1))
        DN_RDA(0);
#pragma unroll
        for (int ks = 0; ks < 4; ks += 2) {
            DN_RDB(ks + 1);
            DN_MF(wfr[0][ks], acc[0][0], ha0, "{v[192:199]}", "s_waitcnt lgkmcnt(4)\n\t"); DN_MF(wfr[1][ks], acc[0][1], ha0, "{v[192:199]}", "");
            DN_MF(wfr[0][ks], acc[1][0], ha1, "{v[200:207]}", ""); DN_MF(wfr[1][ks], acc[1][1], ha1, "{v[200:207]}", "");
            if (ks + 2 < 4) { DN_RDA(ks + 2);
                DN_MF(wfr[0][ks + 1], acc[0][0], hb0, "{v[208:215]}", "s_waitcnt lgkmcnt(4)\n\t"); }
            else { DN_MF(wfr[0][ks + 1], acc[0][0], hb0, "{v[208:215]}", "s_waitcnt lgkmcnt(0)\n\t"); }
            DN_MF(wfr[1][ks + 1], acc[0][1], hb0, "{v[208:215]}", "");
            DN_MF(wfr[0][ks + 1], acc[1][0], hb1, "{v[216:223]}", ""); DN_MF(wfr[1][ks + 1], acc[1][1], hb1, "{v[216:223]}", "");
        }
#undef DN_RDA
#undef DN_RDB
#undef DN_MF
        asm volatile("s_nop 15\n\ts_nop 7" : "+v"(acc[0][0]), "+v"(acc[0][1]), "+v"(acc[1][0]), "+v"(acc[1][1]) :: "memory");
        __builtin_amdgcn_sched_barrier(0);
        const int col0 = 512 * hf + 64 * wid + 16 * hi;
#pragma unroll
        for (int rt = 0; rt < 2; ++rt) { const bool ok = !NOTRAFFIC && mt[rt].x != 0xffffffffu; unsigned char* yd = ok ? Yp + (size_t)mt[rt].x * D : trash; const float w = ok ? __uint_as_float(mt[rt].y) * (1.f / (HSCALE8 * WSCALE8)) : 0.f;
#pragma unroll
            for (int nt = 0; nt < 2; ++nt) { u32x4 o;
#pragma unroll
                for (int q = 0; q < 4; ++q) { int v = __builtin_amdgcn_cvt_pk_fp8_f32(acc[rt][nt][4 * q] * w, acc[rt][nt][4 * q + 1] * w, 0, false);
                    v = __builtin_amdgcn_cvt_pk_fp8_f32(acc[rt][nt][4 * q + 2] * w, acc[rt][nt][4 * q + 3] * w, v, true); o[q] = (unsigned)v; }
                *(u32x4*)(yd + col0 + 32 * nt) = o; } }
      }
    }
    VM_WAIT(); LDS_WAIT(); __builtin_amdgcn_s_barrier();
#undef DN_DMA
#undef DN_DEC
}
}

namespace up {
__device__ __forceinline__ int nloc(int i) { return 16 * ((i >> 2) & 1) + (i & 3) + 4 * (i >> 3); }
__device__ __forceinline__ void up_phase(LAS unsigned char* lds, const bf16* QL, const bf16* KVL, const bf16* Wq, const bf16* Wkv, const float* ssqq, const float* ssqkv, const float* ropetab,
                                         bf16* Qo, bf16* KNo, bf16* VMo, int G, int c) {
    int tid = threadIdx.x; asm volatile("" : "+v"(tid));
    const int wid = __builtin_amdgcn_readfirstlane(tid >> 6), lane = tid & 63, j = lane & 31, hi = lane >> 5;
    for (int grp = c; grp < T / 64; grp += G) {
        const int row0 = grp * 64;
        { const int r_ = lane >> 3, p_ = lane & 7;
#pragma unroll
          for (int i = 0; i < 6; ++i) { const int q_ = wid * 6 + i;
              const bool isq = q_ < 32; const int rem = isq ? q_ : q_ - 32, kb = rem >> 3, g = rem & 7, f_ = (4 * (g & 1) + (r_ >> 1)) & 7;
              __builtin_amdgcn_global_load_lds((const unsigned*)((isq ? QL : KVL) + (size_t)(row0 + 8 * g + r_) * 256 + kb * 64 + ((p_ ^ f_) * 8)), (LAS unsigned*)(lds + (isq ? 0 : 32768) + kb * 8192 + g * 1024), 16, 0, 0); } }
        float rsq[2], rskv[2];
#pragma unroll
        for (int rt = 0; rt < 2; ++rt) { const int row = row0 + 32 * rt + j; const f32x4 a = *(const f32x4*)(ssqq + (size_t)row * 4), b4 = *(const f32x4*)(ssqkv + (size_t)row * 4);
            rsq[rt] = rsqrtf(((a[0] + a[1]) + (a[2] + a[3])) * (1.f / QLORA) + EPS) * C2M; rskv[rt] = rsqrtf(((b4[0] + b4[1]) + (b4[2] + b4[3])) * (1.f / KVLORA) + EPS); }
        const unsigned lane16 = (unsigned)lane * 16u;
        bf16x8 wA[16];
#define UP_LOADW(WB_, Wp_, col_, KS_) do { const char* wb_ = (const char*)(Wp_) + (size_t)__builtin_amdgcn_readfirstlane((col_) >> 5) * (KS_) * 1024;     \
            _Pragma("unroll") for (int ks = 0; ks < (KS_); ++ks) wA[(WB_) + ks] = *(const bf16x8*)(wb_ + ks * 1024 + lane16); } while (0)
#define UP_STEP(WB_, ISQ_, col_, KS_) do { f32x16 acc[2]; acc[0] = f32x16{}; acc[1] = f32x16{}; \
            _Pragma("unroll") for (int ks = 0; ks < (KS_); ++ks) { bf16x8 af[2]; \
                _Pragma("unroll") for (int rt = 0; rt < 2; ++rt) { const int row = 32 * rt + j, cc = 2 * (ks & 3) + hi; \
                    af[rt] = *(const LAS bf16x8*)(lds + ((ISQ_) ? 0 : 32768) + (ks >> 2) * 8192 + row * 128 + ((cc ^ ((row >> 1) & 7)) * 16)); } \
                _Pragma("unroll") for (int rt = 0; rt < 2; ++rt) acc[rt] = __builtin_amdgcn_mfma_f32_32x32x16_bf16(wA[(WB_) + ks], af[rt], acc[rt], 0, 0, 0); } \
            _Pragma("unroll") for (int rt = 0; rt < 2; ++rt) { const int row = row0 + 32 * rt + j; const float r_s = (ISQ_) ? rsq[rt] : rskv[rt]; const int col = (col_) + 16 * hi; \
                float v[16]; _Pragma("unroll") for (int r = 0; r < 16; ++r) v[r] = acc[rt][r] * r_s; \
                bf16* dst; \
                if (ISQ_) { const int jh = col % MQK; \
                    if (jh >= 64) { const int g0 = (jh - 64) >> 3; const f32x4* tb = (const f32x4*)(ropetab + ((size_t)row * 16 + 4 * g0) * 2); \
                        _Pragma("unroll") for (int gg = 0; gg < 2; ++gg) { const f32x4 t0 = tb[2 * gg], t1 = tb[2 * gg + 1]; float* w_ = v + 8 * gg; \
                            const float cs[4] = {t0[0], t0[2], t1[0], t1[2]}, sn[4] = {t0[1], t0[3], t1[1], t1[3]}; \
                            _Pragma("unroll") for (int q = 0; q < 4; ++q) { const float x1 = w_[q], x2 = w_[4 + q]; w_[q] = x1 * cs[q] - x2 * sn[q]; w_[4 + q] = x2 * cs[q] + x1 * sn[q]; } } } \
                    dst = Qo + (size_t)row * 768 + col; } \
                else dst = (col >= 512 ? VMo + (col - 512) : KNo + col) + (size_t)row * 512; \
                *(u32x4*)dst = (u32x4){cvt_pk_bf16(v[0], v[1]), cvt_pk_bf16(v[2], v[3]), cvt_pk_bf16(v[4], v[5]), cvt_pk_bf16(v[6], v[7])}; \
                *(u32x4*)(dst + 8) = (u32x4){cvt_pk_bf16(v[8], v[9]), cvt_pk_bf16(v[10], v[11]), cvt_pk_bf16(v[12], v[13]), cvt_pk_bf16(v[14], v[15])}; } } while (0)
        const int cq = 96 * wid, ckv = 128 * wid;
#define UP_SB() __builtin_amdgcn_sched_barrier(0)
        UP_LOADW(0, Wq, cq, 16);
        VM_WAIT(); __syncthreads();
        UP_STEP(0, true, cq, 16);        UP_SB(); UP_LOADW(0, Wq, cq + 32, 16); UP_SB();
        UP_STEP(0, true, cq + 32, 16);   UP_SB(); UP_LOADW(0, Wq, cq + 64, 16); UP_SB();
        UP_STEP(0, true, cq + 64, 16);   UP_SB(); UP_LOADW(0, Wkv, ckv, 8); UP_LOADW(8, Wkv, ckv + 32, 8); UP_SB();
        UP_STEP(0, false, ckv, 8);       UP_SB(); UP_LOADW(0, Wkv, ckv + 64, 8); UP_SB();
        UP_STEP(8, false, ckv + 32, 8);  UP_SB(); UP_LOADW(8, Wkv, ckv + 96, 8); UP_SB();
        UP_STEP(0, false, ckv + 64, 8);  UP_SB();
        UP_STEP(8, false, ckv + 96, 8);
#undef UP_SB
#undef UP_LOADW
#undef UP_STEP
        __syncthreads();
    }
}
}

#define XB_TMO      128
#define XB_XCNT(j)  (256  + 64 * (j))
#define XB_XSUB(j)  (1280 + 64 * (j))
#define XB_XGEN(j)  (2304 + 64 * (j))
#define XB_TOP      3328
#define XB_TOPGEN   3392
#define XCD_BAR_WORDS 3456
#define XB_SPIN_CAP (1u << 18)
__device__ __forceinline__ unsigned xb_ld(unsigned* p)              { return __hip_atomic_load(p, __ATOMIC_RELAXED, __HIP_MEMORY_SCOPE_AGENT); }
__device__ __forceinline__ unsigned xb_add(unsigned* p, unsigned v) { return __hip_atomic_fetch_add(p, v, __ATOMIC_RELAXED, __HIP_MEMORY_SCOPE_AGENT); }
__device__ __forceinline__ unsigned xb_xcc_id() { return (unsigned)__builtin_amdgcn_s_getreg((3 << 11) | 20) & 0xFu; }
#define XB_SPIN(cond, bar) do { unsigned _sp = 0; while (cond) { __builtin_amdgcn_s_sleep(1); \
    if ((++_sp & 255u) == 0u) { if (xb_ld(&(bar)[XB_TMO])) break; if (_sp > XB_SPIN_CAP) { atomicAdd(&(bar)[XB_TMO], 1u); break; } } } } while (0)
struct XcdBarrier { unsigned* bar; unsigned x; volatile LAS unsigned* st; };
__device__ __forceinline__ XcdBarrier xcd_barrier_post(unsigned* bar, volatile LAS unsigned* st) {
    XcdBarrier b; b.bar = bar; b.x = xb_xcc_id(); b.st = st;
    if (threadIdx.x == 0) (void)xb_add(&bar[XB_XCNT(b.x)], 1u);
    return b;
}
__device__ __forceinline__ void xcd_barrier_complete(unsigned* bar, unsigned x, unsigned& nloc, unsigned& nx) {
    const unsigned G = gridDim.x * gridDim.y * gridDim.z;
    unsigned sum, cnt, mine, sp = 0u;
    for (;;) {
        sum = 0u; cnt = 0u; mine = 0u;
#pragma unroll
        for (unsigned j = 0; j < 16; ++j) { const unsigned c = xb_ld(&bar[XB_XCNT(j)]); sum += c; cnt += (c > 0u) ? 1u : 0u; mine = (j == x) ? c : mine; }
        if (sum == G) break;
        __builtin_amdgcn_s_sleep(1);
        if ((++sp & 255u) == 0u) { if (xb_ld(&bar[XB_TMO])) break; if (sp > XB_SPIN_CAP) { atomicAdd(&bar[XB_TMO], 1u); break; } }
    }
    nloc = mine > 0u ? mine : 1u; nx = cnt > 0u ? cnt : 1u;
}
__device__ __forceinline__ void xcd_barrier(const XcdBarrier& b) {
    asm volatile("s_waitcnt vmcnt(0)" ::: "memory");
    __syncthreads();
    if (threadIdx.x == 0) {
        unsigned* bar = b.bar;
        __builtin_amdgcn_s_waitcnt(0);
        unsigned nloc = b.st[0], nx = b.st[1];
        if (nloc == 0u) { xcd_barrier_complete(bar, b.x, nloc, nx); b.st[0] = nloc; b.st[1] = nx; }
        const unsigned old = xb_add(&bar[XB_XSUB(b.x)], 1u);
        const unsigned gen = old / nloc;
        if (old + 1u == (gen + 1u) * nloc) {
            __builtin_amdgcn_fence(__ATOMIC_RELEASE, "agent");
            asm volatile("s_waitcnt vmcnt(0)" ::: "memory");
            const unsigned og = xb_add(&bar[XB_TOP], 1u);
            const unsigned tg = og / nx;
            if (og + 1u == (tg + 1u) * nx) xb_add(&bar[XB_TOPGEN], 1u);
            else XB_SPIN(xb_ld(&bar[XB_TOPGEN]) == tg, bar);
            __builtin_amdgcn_fence(__ATOMIC_ACQUIRE, "agent");
            xb_add(&bar[XB_XGEN(b.x)], 1u);
            asm volatile("s_waitcnt vmcnt(0)" ::: "memory");
        } else {
            XB_SPIN(xb_ld(&bar[XB_XGEN(b.x)]) == gen, bar);
            __builtin_amdgcn_fence(__ATOMIC_ACQUIRE, "agent");
            asm volatile("s_waitcnt vmcnt(0)" ::: "memory");
        }
    }
    __syncthreads();
}

struct Args { const void* in[25]; float* out; unsigned char* ws; int ph_lo, ph_hi; };

struct Frame {
    LAS unsigned char* lds;
    int tid, lane, wave, vcu, G;
};

template <class ColFn>
__device__ __forceinline__ void cvt_item(int ldw, int Ksrc, const float* kscale, bf16* WT, int Kd, LAS float* scr, int kb, int nb, int lane, ColFn colp) {
    const int k0 = 64 * kb, n0 = 32 * nb;
    const float* cp = colp(n0 + (lane & 31));
    float vv[32], sv[32];
#pragma unroll
    for (int i = 0; i < 32; ++i) { const int k = k0 + 2 * i + (lane >> 5);
        vv[i] = (cp != nullptr && k < Ksrc) ? cp[(size_t)k * ldw] : 0.f;
        sv[i] = (kscale != nullptr && k < Ksrc) ? kscale[k] : 1.f; }
#pragma unroll
    for (int i = 0; i < 32; ++i) scr[(2 * i + (lane >> 5)) * 33 + (lane & 31)] = vv[i] * sv[i];
    LDS_WAIT(); asm volatile("" ::: "memory");
    const int c = lane & 7;
#pragma unroll
    for (int j = 0; j < 4; ++j) { const int n = (lane >> 3) + 8 * j; const LAS float* s = scr + (8 * c) * 33 + n;
        u32x4 o; o.x = pk2(s[0 * 33], s[1 * 33]); o.y = pk2(s[2 * 33], s[3 * 33]); o.z = pk2(s[4 * 33], s[5 * 33]); o.w = pk2(s[6 * 33], s[7 * 33]);
        *(u32x4*)(WT + (size_t)(n0 + n) * Kd + k0 + 8 * c) = o; }
    LDS_WAIT(); asm volatile("" ::: "memory");
}
__device__ __forceinline__ void cvt64_item(const float* src, int ldw, bf16* dst, int Kd, LAS unsigned char* scr, int lane) {
    f32x4 v[16];
    const float* sp = src + (size_t)(lane >> 4) * ldw + 4 * (lane & 15);
#pragma unroll
    for (int i = 0; i < 16; ++i) v[i] = __builtin_nontemporal_load((const f32x4*)(sp + (size_t)(4 * i) * ldw));
#pragma unroll
    for (int i = 0; i < 16; ++i) { const int k = 4 * i + (lane >> 4);
#pragma unroll
        for (int q = 0; q < 4; ++q) { const int n = 4 * (lane & 15) + q; *(LAS bf16*)(scr + n * 128 + (((k >> 3) ^ ((n >> 2) & 7)) << 4) + (k & 7) * 2) = (bf16)f2bf(v[i][q]); } }
    LDS_WAIT(); asm volatile("" ::: "memory");
#pragma unroll
    for (int j = 0; j < 8; ++j) { const int p = j * 64 + lane, n = p >> 3, c = p & 7;
        const u32x4 o = *(const LAS u32x4*)(scr + n * 128 + ((c ^ ((n >> 2) & 7)) << 4));
        __builtin_nontemporal_store(o, (u32x4*)(dst + (size_t)n * Kd + c * 8)); }
    LDS_WAIT(); asm volatile("" ::: "memory");
}
__device__ __forceinline__ void cvt64_item8(const float* src, int ldw, unsigned char* dst, int Kd8, LAS unsigned char* scr, int lane, float scale) {
    f32x4 v[16];
    const float* sp = src + (size_t)(16 * (lane >> 4)) * ldw + 4 * (lane & 15);
#pragma unroll
    for (int i = 0; i < 16; ++i) v[i] = __builtin_nontemporal_load((const f32x4*)(sp + (size_t)i * ldw));
#pragma unroll
    for (int q = 0; q < 4; ++q) { u32x4 o;
#pragma unroll
        for (int g = 0; g < 4; ++g) { int p_ = __builtin_amdgcn_cvt_pk_fp8_f32(v[4 * g][q] * scale, v[4 * g + 1][q] * scale, 0, false); p_ = __builtin_amdgcn_cvt_pk_fp8_f32(v[4 * g + 2][q] * scale, v[4 * g + 3][q] * scale, p_, true); o[g] = (unsigned)p_; }
        *(LAS u32x4*)(scr + (4 * (lane & 15) + q) * 80 + (lane >> 4) * 16) = o; }
    LDS_WAIT(); asm volatile("" ::: "memory");
#pragma unroll
    for (int j = 0; j < 4; ++j) { const int p = j * 64 + lane, n = p >> 2, c = p & 3;
        const u32x4 o = *(const LAS u32x4*)(scr + n * 80 + c * 16);
        __builtin_nontemporal_store(o, (u32x4*)(dst + (size_t)n * Kd8 + c * 16)); }
    LDS_WAIT(); asm volatile("" ::: "memory");
}
__device__ __forceinline__ void cvt128_item8(const float* src, int ldw, unsigned char* dst, int Kd8, LAS unsigned char* scr, int lane, float scale) {
    f32x4 v[32];
    const float* sp = src + (size_t)(32 * (lane >> 4)) * ldw + 4 * (lane & 15);
#pragma unroll
    for (int i = 0; i < 32; ++i) v[i] = __builtin_nontemporal_load((const f32x4*)(sp + (size_t)i * ldw));
#pragma unroll
    for (int q = 0; q < 4; ++q) {
#pragma unroll
        for (int hf = 0; hf < 2; ++hf) { u32x4 o;
#pragma unroll
            for (int g = 0; g < 4; ++g) { const int i0 = 16 * hf + 4 * g; int p_ = __builtin_amdgcn_cvt_pk_fp8_f32(v[i0][q] * scale, v[i0 + 1][q] * scale, 0, false); p_ = __builtin_amdgcn_cvt_pk_fp8_f32(v[i0 + 2][q] * scale, v[i0 + 3][q] * scale, p_, true); o[g] = (unsigned)p_; }
            *(LAS u32x4*)(scr + (4 * (lane & 15) + q) * 144 + (lane >> 4) * 32 + 16 * hf) = o; } }
    LDS_WAIT(); asm volatile("" ::: "memory");
#pragma unroll
    for (int j = 0; j < 8; ++j) { const int p = j * 64 + lane, n = p >> 3, c = p & 7;
        const u32x4 o = *(const LAS u32x4*)(scr + n * 144 + c * 16);
        __builtin_nontemporal_store(o, (u32x4*)(dst + (size_t)n * Kd8 + c * 16)); }
    LDS_WAIT(); asm volatile("" ::: "memory");
}
__device__ __forceinline__ int ropedim(int jj) { const int g = jj >> 3, u = jj & 7; return (u < 4) ? 4 * g + u : 16 + 4 * g + (u - 4); }

__device__ __forceinline__ void sincos_acc(float af, float& sn, float& cs) {
    const double a = (double)af; const double kq = __builtin_rint(a * 0.63661977236758134308);
    const double r = (a - kq * 1.57079632679489655800) - kq * 6.123233995736766036e-17;
    const double r2 = r * r;
    const double sp = r * (1.0 + r2 * (-1.66666666666666324348e-01 + r2 * (8.33333333332248946124e-03 + r2 * (-1.98412698298579493134e-04 + r2 * (2.75573137070700676789e-06 + r2 * (-2.50507602534068634195e-08 + r2 * 1.58969099521155010221e-10))))));
    const double cp = 1.0 + r2 * (-0.5 + r2 * (4.16666666666666019037e-02 + r2 * (-1.38888888888741095749e-03 + r2 * (2.48015872894767294178e-05 + r2 * (-2.75573143513906633035e-07 + r2 * (2.08757232129817482790e-09 + r2 * -1.13596475577881948265e-11))))));
    const int q = (int)((long long)kq & 3);
    const double s_ = (q == 0) ? sp : (q == 1) ? cp : (q == 2) ? -sp : -cp;
    const double c_ = (q == 0) ? cp : (q == 1) ? -sp : (q == 2) ? -cp : sp;
    sn = (float)s_; cs = (float)c_;
}

__global__ void __launch_bounds__(NWAVES * 64, 2) fwd(Args args) {
    extern __shared__ __attribute__((aligned(16))) unsigned char lds_raw[];
    Frame F;
    F.lds = (LAS unsigned char*)lds_raw;
    F.tid = threadIdx.x; F.lane = F.tid & 63; F.wave = __builtin_amdgcn_readfirstlane(F.tid >> 6);
    F.G = gridDim.x; { const int bx = blockIdx.x; F.vcu = (F.G % 8 == 0) ? (bx % 8) * (F.G / 8) + bx / 8 : bx; }
    volatile LAS unsigned* MISC = (volatile LAS unsigned*)(F.lds + MISC_OFF);
    unsigned char* ws = args.ws;
    gu32* ctl = (gu32*)(ws + WS_CTL);
#define X_IN ((const float*)AP->in[0])
#define cvec ((const float*)AP->in[1])
#define positions ((const int*)AP->in[2])
#define w_mod ((const float*)AP->in[3])
#define b_mod ((const float*)AP->in[4])
#define g_mix ((const float*)AP->in[5])
#define w_in ((const float*)AP->in[6])
#define b_forget ((const float*)AP->in[7])
#define g_q_lat ((const float*)AP->in[8])
#define w_q_up ((const float*)AP->in[9])
#define g_kv_lat ((const float*)AP->in[10])
#define w_kv_up ((const float*)AP->in[11])
#define w_o_mla ((const float*)AP->in[12])
#define w_o_fox ((const float*)AP->in[13])
#define w_out ((const float*)AP->in[14])
#define g_ffn ((const float*)AP->in[15])
#define w_router ((const float*)AP->in[16])
#define b_router ((const float*)AP->in[17])
#define w_exp_gate ((const float*)AP->in[18])
#define w_exp_up ((const float*)AP->in[19])
#define w_exp_down ((const float*)AP->in[20])
#define w_sh_gate ((const float*)AP->in[21])
#define w_sh_up ((const float*)AP->in[22])
#define w_sh_down ((const float*)AP->in[23])
#define g_final ((const float*)AP->in[24])
#define Win_t ((bf16*)(ws + WS_WIN))
#define Wq_t ((bf16*)(ws + WS_WQ))
#define Wkv_t ((bf16*)(ws + WS_WKV))
#define Wom_t ((bf16*)(ws + WS_WOM))
#define Wof_t ((bf16*)(ws + WS_WOF))
#define Wout_t ((bf16*)(ws + WS_WOUT))
#define Wsgu_t ((bf16*)(ws + WS_WSGU))
#define Wsd_t ((bf16*)(ws + WS_WSD))
#define Wr_f ((bf16*)(ws + WS_WR))
#define mod ((float*)(ws + WS_MOD))
#define Wd_t ((bf16*)(ws + WS_WD))
#define Wgu_t ((bf16*)(ws + WS_WGU))
#define HB ((bf16*)(ws + WS_HB))
#define FQ ((bf16*)(ws + WS_FQ))
#define FK ((bf16*)(ws + WS_FK))
#define FV ((bf16*)(ws + WS_FV))
#define QLAT ((bf16*)(ws + WS_QLAT))
#define KVLAT ((bf16*)(ws + WS_KVLAT))
#define OFOX ((bf16*)(ws + WS_OFOX))
#define OCAT ((bf16*)((unsigned char*)out + 32 * MiB))
#define OMLA ((bf16*)(ws + WS_OMLA))
#define Y ((bf16*)(ws + WS_Y))
#define H ((bf16*)(ws + WS_H))
#define QMLA ((bf16*)(ws + WS_QMLA))
#define GATES ((bf16*)(ws + WS_GATES))
#define KN ((bf16*)(ws + WS_KN))
#define VM ((bf16*)(ws + WS_VM))
#define KPE ((bf16*)(ws + WS_KPE))
#define MERGED ((bf16*)(ws + WS_MERGED))
#define LIST ((unsigned short*)(ws + WS_LIST))
#define Wgu8 ((unsigned char*)(ws + WS_WGU))
#define Wsgu8 ((unsigned char*)(ws + WS_WSGU))
#define H8 ((unsigned char*)(ws + WS_H))
#define META ((u32x2*)(ws + WS_WIN))
#define EIDX ((unsigned char*)(ws + WS_EIDX))
#define GATEW ((float*)(ws + WS_GATEW))
#define ROPETAB ((float*)((unsigned char*)out + DO_ROPE))
#define LOGF ((float*)((unsigned char*)out + DO_LOGF))
#define CUMF ((float*)((unsigned char*)out + DO_CUMF))
#define SSQQ ((float*)((unsigned char*)out + DO_SSQQ))
#define SSQKV ((float*)((unsigned char*)out + DO_SSQKV))
#define MODP ((float*)((unsigned char*)out + DO_MODP))
#define X1B ((bf16*)(ws + WS_X1B))
#define SSQ1 ((float*)(ws + WS_FQ))
    float* const out = args.out;
#define PHASE_ENV const __attribute__((address_space(4))) Args* AP; { auto kp_ = __builtin_amdgcn_kernarg_segment_ptr(); asm volatile("" : "+s"(kp_)); AP = (const __attribute__((address_space(4))) Args*)kp_; } \
    unsigned char* const ws = AP->ws; float* const out = AP->out; (void)ws; (void)out;
    for (int u = F.tid; u < (LDS_BYTES - LDSCTL_OFF) / 4; u += NWAVES * 64) ((LAS unsigned*)(F.lds + LDSCTL_OFF))[u] = 0u;
    __syncthreads();
    XcdBarrier bar; bar.bar = (unsigned*)(ctl + CW_BAR); bar.x = 0; bar.st = nullptr;
    if (MK_ONE_LAUNCH) bar = xcd_barrier_post((unsigned*)(ctl + CW_BAR), MISC + 8);
    const int lo = args.ph_lo, hi = args.ph_hi;
#define IN(k) (lo <= (k) && (k) < hi)
#define BOTH(k) (IN(k) && IN((k) + 1))
#define GRID_BAR() do { if (MK_ONE_LAUNCH) xcd_barrier(bar); } while (0)
#define DUP_BAR() do { if (dummy) xcd_barrier(bar); } while (0)
    const int gw = F.vcu * NWAVES + F.wave, NGW = F.G * NWAVES;

    for (int rep = 0; rep < ((PROBE_DUP == 0) ? 2 : 1); ++rep) if (IN(0)) { PHASE_ENV const bool dummy = (PROBE_DUP == 0) && rep == 0; (void)dummy;
        if (!(dummy && (PROBE_VAR == 1 || PROBE_VAR == 4 || PROBE_VAR == 5))) {
            LAS float* cond = (LAS float*)F.lds;
            for (int i = F.tid; i < NB * D; i += NWAVES * 64) { const float c = cvec[i]; cond[i] = c / (1.f + __expf(-c)); }
            __syncthreads();
            for (int it = F.wave * F.G + F.vcu; it < 96 * 16; it += NWAVES * F.G) { const int cg = it % 96, kq = it / 96, col = cg * 64 + F.lane;
                float a4[4] = {0.f, 0.f, 0.f, 0.f};
                const float* wp = w_mod + (size_t)(64 * kq) * (6 * D) + col;
                float wv[64];
#pragma unroll
                for (int kk = 0; kk < 64; ++kk) wv[kk] = __builtin_nontemporal_load(wp + (size_t)kk * (6 * D));
#pragma unroll
                for (int kk = 0; kk < 64; ++kk) {
#pragma unroll
                    for (int b = 0; b < 4; ++b) a4[b] += wv[kk] * cond[b * D + 64 * kq + kk]; }
#pragma unroll
                for (int b = 0; b < 4; ++b) MODP[((size_t)kq * 4 + b) * (6 * D) + col] = a4[b]; }
            __syncthreads();
        }
        if (!(dummy && (PROBE_VAR == 1 || PROBE_VAR == 3 || PROBE_VAR == 5))) for (int i = gw * 64 + F.lane; i < T * 16; i += NGW * 64) { const int t = i >> 4, j = i & 15;
            const float invf = (((j >> 2) == 0) ? 1.f : ((j >> 2) == 1) ? 0.1f : ((j >> 2) == 2) ? 0.01f : 0.001f) * (((j & 3) == 0) ? 1.f : ((j & 3) == 1) ? 0.5623413251903491f : ((j & 3) == 2) ? 0.31622776601683794f : 0.17782794100389228f);
            const float ang = (float)positions[t] * invf; float sn, cs; sincos_acc(ang, sn, cs);
            *(f32x2*)(ROPETAB + (size_t)i * 2) = (f32x2){cs, sn}; }
        for (int o = gw * 64 + F.lane; o < NEXP * D; o += NGW * 64) { const int piece = o >> 3, kk = o & 7, ln = piece & 63, grp = piece >> 6, ntl = grp & 3, j = grp >> 2;
            const int n = ntl * 16 + (ln & 15), k = j * 32 + (ln >> 4) * 8 + kk; Wr_f[o] = (bf16)f2bf(w_router[(size_t)k * NEXP + n]); }
        {
            LAS unsigned char* scr8 = F.lds + 32768 + F.wave * 9216;
            constexpr int F_IN = 62 * 16;
            if (!(dummy && PROBE_VAR >= 2)) for (int it = gw; it < F_IN; it += NGW) {
                int nb = it % 62; const int kb = it / 62; if (nb >= 6) nb += 2; const int n0 = 64 * nb;
                const int src = (n0 < 384) ? n0 : (n0 < 2048) ? 416 + (n0 - 512) : 1960 + (n0 - 2048);
                cvt64_item(w_in + (size_t)(64 * kb) * 4008 + src, 4008, Win_t + (size_t)n0 * D + 64 * kb, D, scr8, F.lane);
            }
            LAS float* scr = (LAS float*)(F.lds + 32768 + F.wave * 9216);
            constexpr int I_INS = 4 * (D / 64), NSLOW = I_INS;
            if (!(dummy && (PROBE_VAR == 1 || PROBE_VAR == 3 || PROBE_VAR == 4))) for (int it = F.wave * F.G + F.vcu; it < NSLOW; it += NGW) {
                const int nb = 12 + (it & 3), kb = it >> 2;
                cvt_item(4008, D, nullptr, Win_t, D, scr, kb, nb, F.lane, [&](int n) -> const float* {
                    int src; if (n < 416) src = 384 + ropedim(n - 384); else if (n < 424) src = 1952 + (n - 416); else src = -1;
                    return src < 0 ? nullptr : w_in + src; });
            }
            if (!(dummy && (PROBE_VAR == 1 || PROBE_VAR == 3 || PROBE_VAR == 4))) {
                for (int o = gw * 64 + F.lane; o < 768 * QLORA; o += NGW * 64) { const int cb = o >> 13, rem = o & 8191, ks = rem >> 9, ln = (rem >> 3) & 63, e = rem & 7;
                    const int n = cb * 32 + up::nloc(ln & 31), k = 16 * ks + 8 * (ln >> 5) + e, hh = n / MQK, jj = n % MQK, sc = hh * MQK + (jj < 64 ? jj : 64 + ropedim(jj - 64));
                    Wq_t[o] = (bf16)f2bf(w_q_up[(size_t)k * 768 + sc] * g_q_lat[k]); }
                for (int o = gw * 64 + F.lane; o < 1024 * KVLORA; o += NGW * 64) { const int cb = o >> 12, rem = o & 4095, ks = rem >> 9, ln = (rem >> 3) & 63, e = rem & 7;
                    const int n = cb * 32 + up::nloc(ln & 31), k = 16 * ks + 8 * (ln >> 5) + e, sc = (n < 512) ? (n >> 6) * 128 + (n & 63) : ((n - 512) >> 6) * 128 + 64 + (n & 63);
                    Wkv_t[o] = (bf16)f2bf(w_kv_up[(size_t)k * 1024 + sc] * g_kv_lat[k]); }
            }
        }
        if (BOTH(0)) GRID_BAR();
    }

    for (int rep = 0; rep < ((PROBE_DUP == 1) ? 2 : 1); ++rep) if (IN(1)) { PHASE_ENV const bool dummy = (PROBE_DUP == 1) && rep == 0; (void)dummy;
        if (F.vcu < 48) { const int idx = F.vcu * 512 + F.tid, b = idx / (6 * D), col = idx % (6 * D); float sm = b_mod[col];
#pragma unroll
            for (int p = 0; p < 16; ++p) sm += MODP[((size_t)p * 4 + b) * (6 * D) + col];
            mod[idx] = sm; }
        LAS float* vg1 = (LAS float*)F.lds; LAS float* vs1 = (LAS float*)(F.lds + 4096);
        for (int grp = F.vcu; grp < T / 64; grp += F.G) {
            const int b = (grp * 64) / SEQ;
            __syncthreads();
            for (int k = F.tid; k < D; k += NWAVES * 64) { float s0 = b_mod[k], s1 = b_mod[D + k];
#pragma unroll
                for (int p = 0; p < 16; ++p) { s0 += MODP[((size_t)p * 4 + b) * (6 * D) + k]; s1 += MODP[((size_t)p * 4 + b) * (6 * D) + D + k]; }
                vs1[k] = s0; vg1[k] = g_mix[k] * (1.f + s1); }
            __syncthreads();
#pragma unroll 2
            for (int rr = 0; rr < 8; ++rr) { const int m = grp * 64 + F.wave * 8 + rr;
                const f32x4* xr = (const f32x4*)(X_IN + (size_t)m * D) + F.lane;
                f32x4 v[4]; float s = 0.f;
#pragma unroll
                for (int j = 0; j < 4; ++j) { v[j] = __builtin_nontemporal_load(xr + 64 * j); s += (v[j].x * v[j].x + v[j].y * v[j].y) + (v[j].z * v[j].z + v[j].w * v[j].w); }
                const float rstd = rsqrtf(wave_sum(s) * (1.f / D) + EPS);
                unsigned long long* o8 = (unsigned long long*)(H + (size_t)m * D) + F.lane;
#pragma unroll
                for (int j = 0; j < 4; ++j) { const int c = 4 * F.lane + 256 * j;
                    const f32x4 g = *(const LAS f32x4*)(vg1 + c), d = *(const LAS f32x4*)(vs1 + c);
                    const f32x4 r = v[j] * rstd * g + d;
                    o8[64 * j] = (unsigned long long)pk2(r.x, r.y) | ((unsigned long long)pk2(r.z, r.w) << 32); } }
        }
        if (BOTH(1)) GRID_BAR();
    }

    for (int rep = 0; rep < ((PROBE_DUP == 2) ? 2 : 1); ++rep) if (IN(2)) { PHASE_ENV const bool dummy = (PROBE_DUP == 2) && rep == 0; (void)dummy;
        pg8::StaticOrder S; S.init(H, Win_t, T, NIN, D, F.G, (int)blockIdx.x);
        EpiInProj E{QLAT, KVLAT, KPE, FQ, GATES, LOGF, SSQQ, SSQKV, ROPETAB, b_forget, dummy && (PROBE_VAR == 1), (dummy && PROBE_VAR == 2) ? 0 : (dummy && PROBE_VAR == 3) ? 2 : 1};
        pg8::gemm_phase<EpiInProj, pg8::StaticOrder, true>(F.lds, S, E);
        if (BOTH(2)) GRID_BAR();
    }

    for (int rep = 0; rep < ((PROBE_DUP == 3) ? 2 : 1); ++rep) if (IN(3)) { PHASE_ENV const bool dummy = (PROBE_DUP == 3) && rep == 0; (void)dummy;
        if (!(dummy && (PROBE_VAR == 2 || PROBE_VAR == 3))) {
            const int bb = F.vcu & 3; float mx = 0.f, mq = 0.f;
            for (int r = (F.vcu >> 2) * NWAVES + F.wave; r < SEQ; r += (F.G >> 2) * NWAVES) { f32x4 k0, k1, q0v, q1v; unpack8(*(const u32x4*)(FK + ((size_t)bb * SEQ + r) * 512 + 8 * F.lane), k0, k1);
                unpack8(*(const u32x4*)(FQ + ((size_t)bb * SEQ + r) * 512 + 8 * F.lane), q0v, q1v);
                float sq = (k0[0] * k0[0] + k0[1] * k0[1]) + (k0[2] * k0[2] + k0[3] * k0[3]) + (k1[0] * k1[0] + k1[1] * k1[1]) + (k1[2] * k1[2] + k1[3] * k1[3]);
                float sqq = (q0v[0] * q0v[0] + q0v[1] * q0v[1]) + (q0v[2] * q0v[2] + q0v[3] * q0v[3]) + (q1v[0] * q1v[0] + q1v[1] * q1v[1]) + (q1v[2] * q1v[2] + q1v[3] * q1v[3]);
                sq += dppf<0xB1>(sq); sq += dppf<0x4E>(sq); sq += dppf<0x141>(sq);
                sqq += dppf<0xB1>(sqq); sqq += dppf<0x4E>(sqq); sqq += dppf<0x141>(sqq);
                mx = fmaxf(mx, sq); mq = fmaxf(mq, sqq); }
            LAS float* kml = (LAS float*)F.lds;
            if ((F.lane & 7) == 0) { kml[F.wave * 8 + (F.lane >> 3)] = mx; kml[64 + F.wave * 8 + (F.lane >> 3)] = mq; }
            __syncthreads();
            if (F.tid < 2 * NHEAD) { const int hh = F.tid & 7, qk = F.tid >> 3; float m2 = 0.f;
#pragma unroll
                for (int w = 0; w < NWAVES; ++w) m2 = fmaxf(m2, kml[qk * 64 + w * 8 + hh]);
                atomicMax((unsigned*)(ctl + CW_KM + qk * 32 + bb * NHEAD + hh), __float_as_uint(m2)); }
            __syncthreads();
        }
        if (F.vcu < NB * NHEAD && !(dummy && (PROBE_VAR == 1 || PROBE_VAR == 3))) {
            const int b = F.vcu >> 3, h = F.vcu & 7; const float* src = LOGF + ((size_t)b * SEQ + 8 * F.tid) * 8 + h;
            float v[8]; float run = 0.f;
#pragma unroll
            for (int i = 0; i < 8; ++i) v[i] = src[i * 8];
#pragma unroll
            for (int i = 0; i < 8; ++i) { run += v[i]; v[i] = run; }
            float incl = run;
#pragma unroll
            for (int o = 1; o < 64; o <<= 1) { const float n = __shfl_up(incl, o); if (F.lane >= o) incl += n; }
            LAS float* wt = (LAS float*)F.lds;
            if (F.lane == 63) wt[F.wave] = incl;
            __syncthreads();
            float woff = 0.f;
#pragma unroll
            for (int w = 0; w < NWAVES; ++w) woff += (w < F.wave) ? wt[w] : 0.f;
            const float excl = woff + incl - run;
            float* dst = CUMF + ((size_t)b * NHEAD + h) * SEQ + 8 * F.tid;
            *(f32x4*)dst = (f32x4){v[0] + excl, v[1] + excl, v[2] + excl, v[3] + excl}; *(f32x4*)(dst + 4) = (f32x4){v[4] + excl, v[5] + excl, v[6] + excl, v[7] + excl};
            __syncthreads();
        }
        if (!(dummy && (PROBE_VAR == 1 || PROBE_VAR == 2))) up::up_phase(F.lds, QLAT, KVLAT, Wq_t, Wkv_t, SSQQ, SSQKV, ROPETAB, QMLA, KN, VM, F.G, (int)blockIdx.x);
        if (BOTH(3)) GRID_BAR();
    }

    for (int rep = 0; rep < ((PROBE_DUP == 4) ? 2 : 1); ++rep) if (IN(4)) { PHASE_ENV const bool dummy = (PROBE_DUP == 4) && rep == 0; (void)dummy;
        {
            const bool xq = (F.G % 8) == 0; const int x = xq ? (int)(blockIdx.x & 7) : 0, nunits = xq ? 128 : 1024;
            constexpr int F_O = 16 * 4, F_OUT = 16 * 8, F_SGU = 8 * 8, F_SD = 16 * 2, F_EGU = NEXP * F_SGU, F_ED = NEXP * F_SD;
            constexpr int NCONV = F_EGU + F_ED + 2 * F_O + F_OUT + F_SGU + F_SD, NCBATCH = (NCONV + 31) / 32;
            const int NQ = xq ? 8 : 1, ncb = (NCBATCH - x + NQ - 1) / NQ, A0 = xq ? CONV_A0 : 8 * CONV_A0;
            gu32* qh = ctl + CW_Q + 64 * x + (dummy ? 16 : 0);
            volatile LAS unsigned* qw = (volatile LAS unsigned*)(F.lds + MISC_OFF + 64);
            for (int nit = 0;; ++nit) {
                if (F.tid == 0) qw[nit & 1] = __hip_atomic_fetch_add(qh, 1u, RLX_AGENT);
                __syncthreads();
                int r = __builtin_amdgcn_readfirstlane((int)qw[nit & 1]);
                if (r >= nunits + ncb) break;
                if (r >= A0 && r < A0 + ncb) { const int cb = x + NQ * (r - A0);
                    LAS unsigned char* scr8 = F.lds + 32768 + F.wave * 9216;
                    int ln_ = F.lane; asm volatile("" : "+v"(ln_));
                    for (int kr = 0; kr < 4; ++kr) { int it = 32 * cb + 8 * kr + F.wave; if (it >= NCONV) break;
                        const float* src; unsigned char* dst; int ldw, kd8;
                        if (it < F_EGU) { const int e = it / F_SGU, rr = it % F_SGU, nb = rr & 7, kb = rr >> 3, pn = nb >> 2, c0 = (nb & 3) * 64;
                            src = ((c0 < 128) ? w_exp_gate : w_exp_up) + (size_t)e * D * DEXP + pn * 128 + (c0 & 127) + (size_t)(128 * kb) * DEXP; ldw = DEXP;
                            dst = Wgu8 + (size_t)e * 512 * D + (size_t)(64 * nb) * D + 128 * kb; kd8 = D; }
                        else if ((it -= F_EGU) < F_ED) { const int e = it / F_SD, rr = it % F_SD, nb = rr & 15, kb = rr >> 4;
                            src = w_exp_down + (size_t)e * DEXP * D + (size_t)(128 * kb) * D + 64 * nb; ldw = D; dst = (unsigned char*)Wd_t + (size_t)e * D * DEXP + (size_t)(64 * nb) * DEXP + 128 * kb; kd8 = DEXP; }
                        else if ((it -= F_ED) < 2 * F_O) { const int fx = it >= F_O, i2 = it - (fx ? F_O : 0), nb = i2 & 15, kb = i2 >> 4;
                            src = (fx ? w_o_fox : w_o_mla) + (size_t)(128 * kb) * D + 64 * nb; ldw = D; dst = (unsigned char*)Wom_t + (size_t)(64 * nb) * D + (fx ? 512 : 0) + 128 * kb; kd8 = D; }
                        else if ((it -= 2 * F_O) < F_OUT) { const int nb = it & 15, kb = it >> 4; src = w_out + (size_t)(128 * kb) * D + 64 * nb; ldw = D; dst = (unsigned char*)Wout_t + (size_t)(64 * nb) * D + 128 * kb; kd8 = D; }
                        else if ((it -= F_OUT) < F_SGU) { const int nb = it >> 3, kb = it & 7, pn = nb >> 2, c0 = (nb & 3) * 64;
                            src = ((c0 < 128) ? w_sh_gate : w_sh_up) + pn * 128 + (c0 & 127) + (size_t)(128 * kb) * DEXP; ldw = DEXP; dst = Wsgu8 + (size_t)(64 * nb) * D + 128 * kb; kd8 = D; }
                        else { it -= F_SGU; const int nb = it >> 1, kb = it & 1; src = w_sh_down + (size_t)(128 * kb) * D + 64 * nb; ldw = D; dst = (unsigned char*)Wsd_t + (size_t)(64 * nb) * DEXP + 128 * kb; kd8 = DEXP; }
                        cvt128_item8(src, ldw, dst, kd8, scr8, ln_, WSCALE8);
                    }
                    continue; }
                if (r >= A0) r -= ncb;
                int qb, type, b, h;
                if (xq) { qb = 15 - (r >> 3); type = (r >> 2) & 1; b = r & 3; h = (x + 3 * b) & 7; }
                else { qb = 15 - (r >> 6); type = (r >> 5) & 1; b = (r >> 3) & 3; h = r & 7; }
                if (type == 0) { if (ATT_TUNED_FOX && qb != 0) att::attn_unit_t<64, true, 8>(b, h, qb, FQ, 512, FK, KPE, FV, CUMF, __uint_as_float(__hip_atomic_load((unsigned*)(ctl + CW_KM + b * NHEAD + h), RLX_AGENT)) * __uint_as_float(__hip_atomic_load((unsigned*)(ctl + CW_KM + 32 + b * NHEAD + h), RLX_AGENT)), (bf16*)((unsigned char*)(dummy ? (bf16*)((unsigned char*)out + 4 * MiB) : OCAT) + 512), D, F.lds);
                                 else att::attn_unit<64, true, 8>(b, h, qb, FQ, 512, FK, KPE, FV, CUMF, (bf16*)((unsigned char*)(dummy ? (bf16*)((unsigned char*)out + 4 * MiB) : OCAT) + 512), D, F.lds); }
                else { if (ATT_TUNED_MLA && qb != 0) att::attn_unit_t<96, false, 8>(b, h, qb, QMLA, 768, KN, KPE, VM, nullptr, 0.f, dummy ? (bf16*)((unsigned char*)out + 4 * MiB) : OCAT, D, F.lds);
                       else att::attn_unit<96, false, 8>(b, h, qb, QMLA, 768, KN, KPE, VM, nullptr, dummy ? (bf16*)((unsigned char*)out + 4 * MiB) : OCAT, D, F.lds); }
            }
        }
        if (BOTH(4)) GRID_BAR();
    }

    for (int rep = 0; rep < ((PROBE_DUP == 5) ? 2 : 1); ++rep) if (IN(5)) { PHASE_ENV const bool dummy = (PROBE_DUP == 5) && rep == 0; (void)dummy;
        pg8::StaticOrder S; S.init(OCAT, Wom_t, T, D, D / 2, F.G, (int)blockIdx.x);
        EpiMergedCat E{(const unsigned char*)GATES, (unsigned char*)MERGED, 1.f / (WSCALE8 * 255.f)};
        pg8::gemm_phase<EpiMergedCat, pg8::StaticOrder, true, true>(F.lds, S, E);
        if (BOTH(5)) GRID_BAR();
    }

    for (int rep = 0; rep < ((PROBE_DUP == 6) ? 2 : 1); ++rep) if (IN(6)) { PHASE_ENV const bool dummy = (PROBE_DUP == 6) && rep == 0; (void)dummy;
        pg8::StaticOrder S; S.init(MERGED, Wout_t, T, D, D / 2, F.G, (int)blockIdx.x);
        EpiOut E{X_IN, X1B, mod, SSQ1, 1.f / (OSCALE8 * WSCALE8)};
        pg8::gemm_phase<EpiOut, pg8::StaticOrder, true, true>(F.lds, S, E);
        if (BOTH(6)) GRID_BAR();
    }

    for (int rep = 0; rep < ((PROBE_DUP == 7) ? 2 : 1); ++rep) if (IN(7)) { PHASE_ENV const bool dummy = (PROBE_DUP == 7) && rep == 0; (void)dummy;
        LAS unsigned char* wrl = F.lds;
        LAS float* vg = (LAS float*)(F.lds + LDSCTL_OFF + 6144);
        LAS float* vs = (LAS float*)(F.lds + LDSCTL_OFF + 10240);
        LAS int* cntw = (LAS int*)(F.lds + 32768);
        LAS int* basel = (LAS int*)(F.lds + 32768 + 2048);
        static_assert(LDSCTL_OFF + 10240 + 4096 <= LDS_BYTES && MOETAB_OFF + 4700 <= LDSCTL_OFF + 6144, "P7 LDS map");
        const float my_bias = b_router[F.lane];
        for (int grp = F.vcu; grp < T / 64; grp += F.G) {
            const int b = (grp * 64) / SEQ;
            __syncthreads();
#pragma unroll
            for (int i = 0; i < 16; ++i) __builtin_amdgcn_global_load_lds((const unsigned*)((const char*)Wr_f + (F.wave * 16 + i) * 1024 + F.lane * 16), (LAS unsigned*)(wrl + (F.wave * 16 + i) * 1024), 16, 0, 0);
            for (int i = F.tid; i < D; i += NWAVES * 64) { vg[i] = g_ffn[i] * (1.f + mod[(size_t)b * 6 * D + 4 * D + i]); vs[i] = mod[(size_t)b * 6 * D + 3 * D + i]; }
            const int tp = grp * 64 + (F.wave & 3) * 16, kh = F.wave >> 2, t0 = tp + kh * 8;
            const int r16 = F.lane & 15, kg = F.lane >> 4, myrow = tp + r16;
            float rs_mine;
            { const float* sp = SSQ1 + (size_t)myrow * 16; const f32x4 a = *(const f32x4*)sp, b4 = *(const f32x4*)(sp + 4), c4 = *(const f32x4*)(sp + 8), d4 = *(const f32x4*)(sp + 12);
              const float ssum = (((a[0] + a[1]) + (a[2] + a[3])) + ((b4[0] + b4[1]) + (b4[2] + b4[3]))) + (((c4[0] + c4[1]) + (c4[2] + c4[3])) + ((d4[0] + d4[1]) + (d4[2] + d4[3])));
              rs_mine = rsqrtf(ssum * (1.f / D) + EPS); }
            const bf16* xrow = X1B + (size_t)myrow * D + 512 * kh + 8 * kg;
            f32x4 lacc[4] = {{0.f, 0.f, 0.f, 0.f}, {0.f, 0.f, 0.f, 0.f}, {0.f, 0.f, 0.f, 0.f}, {0.f, 0.f, 0.f, 0.f}};
            u32x4 xq[16];
#pragma unroll
            for (int p = 0; p < 16; ++p) xq[p] = *(const u32x4*)(xrow + 32 * p);
            VM_WAIT(); __syncthreads();
#pragma unroll
            for (int p = 0; p < 16; ++p) { const int j = 16 * kh + p, k = 32 * j + 8 * kg;
                f32x4 x0, x1v; unpack8(xq[p], x0, x1v);
                const f32x4 g0 = *(const LAS f32x4*)(vg + k), g1 = *(const LAS f32x4*)(vg + k + 4), s0 = *(const LAS f32x4*)(vs + k), s1 = *(const LAS f32x4*)(vs + k + 4);
                const f32x4 h0 = x0 * rs_mine * g0 + s0, h1 = x1v * rs_mine * g1 + s1;
                const u32x4 hw = pack8(h0, h1);
                f32x4 a0, a1; unpack8(hw, a0, a1);
                const u32x4 lw = pack8(h0 - a0, h1 - a1);
                { u32x2 h8; int p_ = __builtin_amdgcn_cvt_pk_fp8_f32(h0[0], h0[1], 0, false); p_ = __builtin_amdgcn_cvt_pk_fp8_f32(h0[2], h0[3], p_, true); h8.x = (unsigned)p_;
                    p_ = __builtin_amdgcn_cvt_pk_fp8_f32(h1[0], h1[1], 0, false); p_ = __builtin_amdgcn_cvt_pk_fp8_f32(h1[2], h1[3], p_, true); h8.y = (unsigned)p_;
                    *(u32x2*)(H8 + (size_t)myrow * D + k) = h8; }
                const bf16x8 Ah = __builtin_bit_cast(bf16x8, hw), Al = __builtin_bit_cast(bf16x8, lw);
#pragma unroll
                for (int ntl = 0; ntl < 4; ++ntl) { const bf16x8 Wf = *(const LAS bf16x8*)(wrl + ((j * 4 + ntl) * 64 + F.lane) * 16);
                    lacc[ntl] = __builtin_amdgcn_mfma_f32_16x16x32_bf16(Wf, Ah, lacc[ntl], 0, 0, 0);
                    lacc[ntl] = __builtin_amdgcn_mfma_f32_16x16x32_bf16(Wf, Al, lacc[ntl], 0, 0, 0); } }
            __syncthreads();
            {   LAS float* stw = (LAS float*)F.lds + (((F.wave & 3) * 2 + kh) * 16 + r16) * 64;
#pragma unroll
                for (int ntl = 0; ntl < 4; ++ntl) *(LAS f32x4*)(stw + 16 * ntl + 4 * kg) = lacc[ntl]; }
            __syncthreads();
            LAS float* stg = (LAS float*)F.lds + ((F.wave & 3) * 32 + kh * 8) * 64;
            int cnt = 0; unsigned selbits = 0u, selks = 0u;
            for (int j = 0; j < 8; ++j) {
                const float logit = stg[j * 64 + F.lane] + stg[(16 + j) * 64 + F.lane];
                const float sc = 1.f / (1.f + expf(-logit));
                const float ch = sc + my_bias;
                const float m1 = max8(ch);
                const unsigned long long eq = __ballot(ch == m1);
                const unsigned gm = (unsigned)(eq >> (F.lane & ~7)) & 0xffu;
                const int first = __builtin_ctz(gm);
                const float c2 = max8(((F.lane & 7) == first) ? -INFINITY : ch);
                const float gs = m1 + c2; const int myg = F.lane >> 3;
                int rank = 0;
#pragma unroll
                for (int g = 0; g < 8; ++g) { const float o = __builtin_bit_cast(float, __builtin_amdgcn_readlane(__builtin_bit_cast(int, gs), 8 * g)); rank += (o > gs || (o == gs && g < myg)) ? 1 : 0; }
                float mc = (rank < 4) ? ch : -1e30f;
                int selk = -1;
#pragma unroll
                for (int k = 0; k < TOPK; ++k) { const float mx = wave_max_f(mc); const unsigned long long bl = __ballot(mc == mx); const int fl = __builtin_ctzll(bl);
                    if (F.lane == fl) { selk = k; mc = -INFINITY; } }
                const float ssum = wave_sum_f(selk >= 0 ? sc : 0.f);
                if (selk >= 0) { const int t = t0 + j; EIDX[(size_t)t * 8 + selk] = (unsigned char)F.lane; GATEW[(size_t)t * 8 + selk] = sc / ssum * 2.5f; ++cnt; selbits |= 1u << j; selks |= (unsigned)selk << (3 * j); }
            }
            cntw[F.wave * 64 + F.lane] = cnt;
            __syncthreads();
            if (F.wave == 0) { int tot = 0;
#pragma unroll
                for (int w = 0; w < 8; ++w) tot += cntw[w * 64 + F.lane];
                basel[F.lane] = (int)__hip_atomic_fetch_add((unsigned*)(ctl + (dummy ? CW_CNT + 2048 : CW_CNT) + 16 * F.lane), (unsigned)tot, RLX_AGENT); }
            __syncthreads();
            int pos = basel[F.lane];
            for (int w = 0; w < F.wave; ++w) pos += cntw[w * 64 + F.lane];
#pragma unroll
            for (int j = 0; j < 8; ++j) if ((selbits >> j) & 1u) { const int k = (selks >> (3 * j)) & 7, t = t0 + j;
                LIST[(size_t)F.lane * LISTCAP + pos] = (unsigned short)t;
                META[(size_t)F.lane * LISTCAP + pos] = (u32x2){(unsigned)(t * (TOPK + 1) + k), __float_as_uint(GATEW[(size_t)t * 8 + k])}; ++pos; }
        }
        __syncthreads();
        if (BOTH(7)) GRID_BAR();
    }

    volatile LAS int* tab = (volatile LAS int*)(F.lds + MOETAB_OFF);
    if (IN(8) || IN(9)) {
        __syncthreads();
        if (F.wave == 0) {
            const int n = (int)__hip_atomic_load((unsigned*)(ctl + CW_CNT + 16 * F.lane), RLX_AGENT);
            const int tiles = (n + 255) >> 8; int incl = tiles;
#pragma unroll
            for (int o = 1; o < 64; o <<= 1) { const int v = __shfl_up(incl, o); if (F.lane >= o) incl += v; }
            tab[F.lane] = incl - tiles; tab[66 + F.lane] = n;
            if (F.lane == 63) { tab[64] = incl; tab[65] = incl + T / 256; tab[66 + 64] = T; }
        }
        __syncthreads();
        { const int ti = F.tid; int e = 0;
          for (int q = 0; q <= NEXP; ++q) if (tab[q] <= ti) e = q;
          tab[132 + ti] = e; }
        __syncthreads();
    }
    for (int rep = 0; rep < ((PROBE_DUP == 8) ? 2 : 1); ++rep) if (IN(8)) { PHASE_ENV const bool dummy = (PROBE_DUP == 8) && rep == 0; (void)dummy;
        MoeOrder<2, true> S{(const char*)H8, (const char*)Wgu8, (const char*)Wsgu8, D / 2, (size_t)512 * D, LIST, tab, F.G, (int)blockIdx.x};
        EpiHb E{(unsigned char*)HB, 1.f / WSCALE8};
        pg8::gemm_phase<EpiHb, MoeOrder<2, true>, true, true>(F.lds, S, E);
        if (BOTH(8)) GRID_BAR();
    }
    for (int rep = 0; rep < ((PROBE_DUP == 9) ? 2 : 1); ++rep) if (IN(9)) { PHASE_ENV const bool dummy = (PROBE_DUP == 9) && rep == 0; (void)dummy;
        if (dummy && PROBE_VAR == 1) dn::down_phase<true>(F.lds, (const unsigned char*)HB, (const unsigned char*)Wd_t, (const unsigned char*)Wsd_t, tab, META, (unsigned char*)Y, (unsigned char*)(ws + WS_CTL + 900 * 1024), F.G, (int)blockIdx.x);
        else dn::down_phase<false>(F.lds, (const unsigned char*)HB, (const unsigned char*)Wd_t, (const unsigned char*)Wsd_t, tab, META, (unsigned char*)Y, (unsigned char*)(ws + WS_CTL + 900 * 1024), F.G, (int)blockIdx.x);
        if (BOTH(9)) GRID_BAR();
    }

    for (int rep = 0; rep < ((PROBE_DUP == 10) ? 2 : 1); ++rep) if (IN(10)) { PHASE_ENV const bool dummy = (PROBE_DUP == 10) && rep == 0; (void)dummy;
        int ln10 = F.lane; asm volatile("" : "+v"(ln10));
        for (int m = gw; m < T; m += NGW) {
            const int b = m / SEQ; const float* gf = mod + (size_t)b * 6 * D + 5 * D;
            const u32x2* xr = (const u32x2*)(X1B + (size_t)m * D) + ln10;
            f32x4* xw = (f32x4*)((dummy ? (float*)HB : out) + (size_t)m * D) + ln10;
            f32x4 v[4]; float s = 0.f;
#pragma unroll
            for (int j = 0; j < 4; ++j) { const int c = 4 * ln10 + 256 * j;
                f32x4 y = {0.f, 0.f, 0.f, 0.f};
#pragma unroll
                for (int k = 0; k < TOPK + 1; ++k) { const int w = __builtin_nontemporal_load((const int*)((const unsigned char*)Y + ((size_t)m * (TOPK + 1) + k) * D + c));
                    const f32x2 lo = __builtin_amdgcn_cvt_pk_f32_fp8(w, false), hi2 = __builtin_amdgcn_cvt_pk_f32_fp8(w, true);
                    y += (f32x4){lo.x, lo.y, hi2.x, hi2.y}; }
                const u32x2 xb = __builtin_nontemporal_load(xr + 64 * j);
                v[j] = (f32x4){__uint_as_float(xb.x << 16), __uint_as_float(xb.x & 0xffff0000u), __uint_as_float(xb.y << 16), __uint_as_float(xb.y & 0xffff0000u)} + *(const f32x4*)(gf + c) * y;
                s += (v[j].x * v[j].x + v[j].y * v[j].y) + (v[j].z * v[j].z + v[j].w * v[j].w); }
            const float rstd = rsqrtf(wave_sum(s) * (1.f / D) + EPS);
#pragma unroll
            for (int j = 0; j < 4; ++j) __builtin_nontemporal_store(v[j] * rstd * *(const f32x4*)(g_final + 4 * ln10 + 256 * j), xw + 64 * j);
        }
    }
#undef IN
#undef BOTH
#undef GRID_BAR
}

constexpr int NPHASE = 11;
extern "C" void kernel_launch(void* const* d_in, const int* in_sizes, int n_in, void* d_out, int out_size, void* d_ws, size_t ws_size, hipStream_t stream) {
    static int grid = 0;
    if (grid == 0) {
        if (n_in != 25 || out_size != T * D || ws_size < WS_END) { fprintf(stderr, "kernel_launch: unexpected shapes (n_in %d out %d ws %zu need %zu)\n", n_in, out_size, ws_size, (size_t)WS_END); grid = -1; return; }
        int dev = 0, cus = 0;
        if (hipGetDevice(&dev) != hipSuccess || hipDeviceGetAttribute(&cus, hipDeviceAttributeMultiprocessorCount, dev) != hipSuccess) { grid = -1; return; }
        if (hipFuncSetAttribute((const void*)fwd, hipFuncAttributeMaxDynamicSharedMemorySize, LDS_BYTES) != hipSuccess) { fprintf(stderr, "kernel_launch: hipFuncSetAttribute failed\n"); grid = -1; return; }
        int per_cu = 0;
        if (hipOccupancyMaxActiveBlocksPerMultiprocessor(&per_cu, (const void*)fwd, NWAVES * 64, LDS_BYTES) != hipSuccess || per_cu < 1) { fprintf(stderr, "kernel_launch: occupancy query says %d\n", per_cu); }
        (void)hipGetLastError();
        grid = cus;
    }
    if (grid < 0) return;
    (void)in_sizes;
    if (hipMemsetAsync((char*)d_ws + WS_CTL, 0, CTL_ZERO_BYTES, stream) != hipSuccess) return;
    Args a{};
    for (int i = 0; i < 25; ++i) a.in[i] = d_in[i];
    a.out = (float*)d_out; a.ws = (unsigned char*)d_ws;
#if MK_ONE_LAUNCH
    a.ph_lo = 0; a.ph_hi = NPHASE;
    hipLaunchKernelGGL(fwd, dim3(grid), dim3(NWAVES * 64), LDS_BYTES, stream, a);
#else
    for (int p = 0; p < NPHASE; ++p) { a.ph_lo = p; a.ph_hi = p + 1; hipLaunchKernelGGL(fwd, dim3(grid), dim3(NWAVES * 64), LDS_BYTES, stream, a); }
#endif
}
```

```cpp
#include <hip/hip_runtime.h>
#include <cstdio>
#include <cstdint>
#include <type_traits>

#ifndef MK_ONE_LAUNCH
#ifndef CONV_A0
#define CONV_A0 28
#endif
#define MK_ONE_LAUNCH 1
#endif

#ifndef PROBE_DUP
#define PROBE_DUP -1
#endif
#ifndef ATT_TUNED_FOX
#define ATT_TUNED_FOX 1
#endif
#ifndef ATT_TUNED_MLA
#define ATT_TUNED_MLA 1
#endif
#ifndef PROBE_VAR
#define PROBE_VAR 0
#endif
#define GAS __attribute__((address_space(1)))
#define LAS __attribute__((address_space(3)))
typedef unsigned short bf16;
typedef short bf16x8 __attribute__((ext_vector_type(8)));
typedef short s16x4 __attribute__((ext_vector_type(4)));
typedef float f32x2 __attribute__((ext_vector_type(2)));
typedef float f32x4 __attribute__((ext_vector_type(4)));
typedef float f32x16 __attribute__((ext_vector_type(16)));
typedef unsigned u32x2 __attribute__((ext_vector_type(2)));
typedef unsigned u32x4 __attribute__((ext_vector_type(4)));
typedef GAS unsigned gu32;
typedef int v8i32_t __attribute__((ext_vector_type(8)));
typedef int v4i32_t __attribute__((ext_vector_type(4)));

constexpr int NB = 4, SEQ = 4096, T = NB * SEQ, D = 1024;
constexpr int NIN = 4096;
constexpr int QLORA = 256, KVLORA = 128, KVPAD = 256, ROPE = 32, NHEAD = 8, HD = 64, MQK = 96;
constexpr int NEXP = 64, TOPK = 6, DEXP = 256;
constexpr float EPS = 1e-6f;
constexpr float LOG2E = 1.4426950408889634f;
constexpr float C2F = 0.125f * LOG2E;
constexpr float C2M = 0.10206207261596577f * LOG2E;
constexpr int LISTCAP = T;
constexpr float HSCALE8 = 8.f;
constexpr float OSCALE8 = 8.f;
constexpr float WSCALE8 = 64.f;

constexpr size_t MiB = 1u << 20;
constexpr size_t WS_CTL = 0, CTL_ZERO_BYTES = 1 * MiB;
constexpr size_t WS_EIDX = 262144, WS_GATEW = 393216;
constexpr size_t WS_WIN = 1 * MiB, WS_WQ = 9 * MiB, WS_WKV = 9 * MiB + 512 * 1024, WS_WOM = 10 * MiB, WS_WOF = 11 * MiB, WS_WOUT = 12 * MiB;
constexpr size_t WS_WSGU = 14 * MiB, WS_WSD = 15 * MiB, WS_WR = 15 * MiB + 512 * 1024, WS_MOD = 15 * MiB + 640 * 1024;
constexpr size_t WS_WD = 16 * MiB;
constexpr size_t WS_HB = 48 * MiB;
constexpr size_t WS_FQ = 48 * MiB, WS_FK = 64 * MiB, WS_FV = 80 * MiB, WS_QLAT = 96 * MiB, WS_KVLAT = 104 * MiB;
constexpr size_t WS_OFOX = WS_FQ, WS_OMLA = WS_QLAT;
static_assert(WS_FK - WS_FQ == (size_t)T * 512 * 2 && WS_FV - WS_FK == (size_t)T * 512 * 2, "fq|fk|fv contiguous");
constexpr size_t WS_Y = 112 * MiB;
constexpr size_t WS_WGU = 112 * MiB;
constexpr size_t WS_H = 176 * MiB;
constexpr size_t WS_QMLA = WS_H;
constexpr size_t WS_GATES = 208 * MiB;
constexpr size_t WS_KN = 272 * MiB, WS_VM = 288 * MiB, WS_KPE = 304 * MiB;
constexpr size_t WS_MERGED = WS_KN;
constexpr size_t WS_LIST = 304 * MiB;
constexpr size_t WS_X1B = 224 * MiB;
constexpr size_t WS_END = 306 * MiB;
constexpr size_t DO_MODP = 4 * MiB;
constexpr size_t DO_ROPE = 0, DO_LOGF = 2 * MiB, DO_CUMF = 2 * MiB + 512 * 1024, DO_SSQQ = 3 * MiB, DO_SSQKV = 3 * MiB + 256 * 1024;

constexpr int CW_TMO = 0;
constexpr int CW_BAR = 4096;
constexpr int CW_CNT = 8192;
constexpr int CW_KM = 12288;
constexpr int CW_Q = 12544;

constexpr int RING_BYTES = 131072;
constexpr int LDSCTL_OFF = RING_BYTES;
constexpr int MISC_OFF = LDSCTL_OFF + 320;
constexpr int MOETAB_OFF = LDSCTL_OFF + 1024;
constexpr int LDS_BYTES = 147456;

constexpr int NWAVES = 8;

#define LDS_WAIT() asm volatile("s_waitcnt lgkmcnt(0)" ::: "memory")
#define VM_WAIT() asm volatile("s_waitcnt vmcnt(0)" ::: "memory")
#define RLX_AGENT __ATOMIC_RELAXED, __HIP_MEMORY_SCOPE_AGENT
__device__ __forceinline__ unsigned f2bf(float f) { unsigned u = __builtin_bit_cast(unsigned, f); return (u + 0x7fffu + ((u >> 16) & 1u)) >> 16; }
__device__ __forceinline__ float bf2f(unsigned h) { return __builtin_bit_cast(float, h << 16); }
__device__ __forceinline__ unsigned pk2(float lo, float hi) { return f2bf(lo) | (f2bf(hi) << 16); }
__device__ __forceinline__ unsigned cvt_pk_bf16(float lo, float hi) { unsigned r; asm volatile("v_cvt_pk_bf16_f32 %0, %1, %2" : "=v"(r) : "v"(lo), "v"(hi)); return r; }
__device__ __forceinline__ u32x4 pack8(f32x4 a, f32x4 b) { u32x4 w; w.x = cvt_pk_bf16(a[0], a[1]); w.y = cvt_pk_bf16(a[2], a[3]); w.z = cvt_pk_bf16(b[0], b[1]); w.w = cvt_pk_bf16(b[2], b[3]); return w; }
__device__ __forceinline__ unsigned pack4u8(float a, float b, float c, float d) {
    const unsigned lo = __builtin_amdgcn_perm(__float_as_uint(b), __float_as_uint(a), 0x0c0c0400u), hi = __builtin_amdgcn_perm(__float_as_uint(d), __float_as_uint(c), 0x0c0c0400u);
    return __builtin_amdgcn_perm(hi, lo, 0x05040100u);
}
__device__ __forceinline__ float ub(unsigned w, int i) { return (float)((w >> (8 * i)) & 0xffu); }
__device__ __forceinline__ void unpack8(u32x4 w, f32x4& a, f32x4& b) {
    a = (f32x4){bf2f(w.x & 0xffffu), bf2f(w.x >> 16), bf2f(w.y & 0xffffu), bf2f(w.y >> 16)};
    b = (f32x4){bf2f(w.z & 0xffffu), bf2f(w.z >> 16), bf2f(w.w & 0xffffu), bf2f(w.w >> 16)};
}
__device__ __forceinline__ float wave_sum(float v) {
#pragma unroll
    for (int o = 1; o < 64; o <<= 1) v += __shfl_xor(v, o);
    return v;
}
__device__ __forceinline__ float wave_max(float v) {
#pragma unroll
    for (int o = 1; o < 64; o <<= 1) v = fmaxf(v, __shfl_xor(v, o));
    return v;
}
template <int CTRL> __device__ __forceinline__ float dppf(float v) { return __builtin_bit_cast(float, __builtin_amdgcn_update_dpp(0, __builtin_bit_cast(int, v), CTRL, 0xf, 0xf, true)); }
__device__ __forceinline__ float max8(float v) { v = fmaxf(v, dppf<0xB1>(v)); v = fmaxf(v, dppf<0x4E>(v)); v = fmaxf(v, dppf<0x141>(v)); return v; }
__device__ __forceinline__ float wave_max_f(float v) { v = max8(v); v = fmaxf(v, dppf<0x140>(v)); v = fmaxf(v, __shfl_xor(v, 16)); v = fmaxf(v, __shfl_xor(v, 32)); return v; }
__device__ __forceinline__ float wave_sum_f(float v) { v += dppf<0xB1>(v); v += dppf<0x4E>(v); v += dppf<0x141>(v); v += dppf<0x140>(v); v += __shfl_xor(v, 16); v += __shfl_xor(v, 32); return v; }
__device__ __forceinline__ float sigmoidf_(float x) { return __builtin_amdgcn_rcpf(1.f + __builtin_amdgcn_exp2f(-LOG2E * x)); }
__device__ __forceinline__ float siluf_(float x) { return x * __builtin_amdgcn_rcpf(1.f + __builtin_amdgcn_exp2f(-LOG2E * x)); }

namespace pg8 {
constexpr int BM = 256, BK = 64, HALF = 128, HTB = HALF * BK * 2, NXCD = 8, WGM = 8;
__host__ __device__ __forceinline__ int lds_byte(int r, int c) { const int st = (r >> 4) * 2 + (c >> 5), rr = r & 15, cc = c & 31, ob = rr * 64 + cc * 2; return st * 1024 + (ob ^ (((ob >> 9) & 1) << 5)); }
__host__ __device__ __forceinline__ void stage_rc(int b, int& R, int& C) { const int st = b / 1024, sb = b % 1024, swz = sb ^ (((sb >> 9) & 1) << 5); R = (st >> 1) * 16 + swz / 64; C = (st & 1) * 32 + (swz % 64) / 2; }
__host__ __device__ __forceinline__ int perm32(int rho) { const int n = rho >> 4, i = rho & 15; return 8 * (i >> 2) + 4 * n + (i & 3); }

struct Unit { int pm, pn, e, aux, n; };

struct StaticOrder {
    static constexpr bool GATHER = false;
    const char* A; const char* Bt; int K;
    int nM, nN, nwg, G, c;
    __device__ void init(const void* A_, const void* Bt_, int M, int N, int K_, int G_, int c_) { A = (const char*)A_; Bt = (const char*)Bt_; K = K_; nM = M / BM; nN = N / BM; nwg = nM * nN; G = G_; c = c_; }
    __device__ bool next(int i, Unit& u) const {
        const long L = (long)i * G + c; if (L >= nwg) return false;
        int wgid = (int)L; { const int q = nwg / NXCD, r = nwg % NXCD, xcd = wgid % NXCD, off = wgid / NXCD; wgid = (xcd < r ? xcd * (q + 1) : r * (q + 1) + (xcd - r) * q) + off; }
        const int nig = WGM * nN, gid = wgid / nig, fm = gid * WGM, gsz = (nM - fm) < WGM ? (nM - fm) : WGM;
        u.pm = fm + ((wgid % nig) % gsz); u.pn = (wgid % nig) / gsz; u.e = 0; u.aux = 0; u.n = BM; return true;
    }
    __device__ __forceinline__ const char* a_ptr(const Unit& u) const { return A + (size_t)u.pm * BM * K * 2; }
    __device__ __forceinline__ const char* b_ptr(const Unit& u) const { return Bt + (size_t)u.pn * BM * K * 2; }
    __device__ __forceinline__ unsigned a_row(const Unit&, int r) const { return (unsigned)r; }
};

template <class Epi, class Sched, bool ALIGN_EPI, bool FP8 = false>
__device__ __forceinline__ void gemm_phase(LAS unsigned char* lds, const Sched& S, const Epi& E) {
    int tid = threadIdx.x; asm volatile("" : "+v"(tid));
    const int wid = __builtin_amdgcn_readfirstlane(tid >> 6), lane = tid & 63, wr = wid >> 2, wc = wid & 3, fr = lane & 15, fq = lane >> 4;
    const int K = S.K, nt = K / BK;
    unsigned voffB[2], voffA[2];
#pragma unroll
    for (int i = 0; i < 2; ++i) { int R, C; stage_rc(tid * 16 + i * 8192, R, C); const int Rb = (R & ~31) + perm32(R & 31);
        voffA[i] = (unsigned)(R * K + C) * 2u; voffB[i] = (unsigned)(Rb * K + C) * 2u; }
    unsigned vA[2][2], vN[2][2];
    const size_t kstep = (size_t)(BK * 2);
    const size_t hstep = (size_t)HALF * K * 2;
    const unsigned ldsw = (unsigned)wid * 1024u;
    const int aoff = lds_byte(wr * 64 + fr, fq * 8), boff = lds_byte(wc * 32 + fr, fq * 8);
#define PG8_SA(b, h) (((b) * 2 + (h)) * HTB)
#define PG8_SB(b, h) ((4 + (b) * 2 + (h)) * HTB)
#define PG8_STAGE(bufoff, gbase, voff) do { _Pragma("unroll") for (int _i = 0; _i < 2; ++_i) \
        __builtin_amdgcn_global_load_lds((const unsigned*)((const char*)(gbase) + (voff)[_i]), (LAS unsigned*)(lds + (bufoff) + ldsw + _i * 8192), 16, 0, 0); } while (0)
#define PG8_STAGE_A(bufoff, gbase, h, nx) do { if constexpr (Sched::GATHER) { const unsigned vs_[2] = {(nx) ? vN[h][0] : vA[h][0], (nx) ? vN[h][1] : vA[h][1]}; PG8_STAGE(bufoff, gbase, vs_); }     \
        else PG8_STAGE(bufoff, (const char*)(gbase) + (h) * hstep, voffA); } while (0)
#define PG8_LDA(dst, b, h) do { _Pragma("unroll") for (int m = 0; m < 4; ++m) { if constexpr (FP8) { dst##8[m].lo = *(const LAS v4i32_t*)(lds + PG8_SA(b, h) + aoff + m * 2048); dst##8[m].hi = *(const LAS v4i32_t*)(lds + PG8_SA(b, h) + aoff + m * 2048 + 1024); } \
        else { _Pragma("unroll") for (int k = 0; k < 2; ++k) dst[m][k] = *(const LAS bf16x8*)(lds + PG8_SA(b, h) + aoff + m * 2048 + k * 1024); } } } while (0)
#define PG8_LDB(dst, b, h) do { _Pragma("unroll") for (int n = 0; n < 2; ++n) { if constexpr (FP8) { dst##8[n].lo = *(const LAS v4i32_t*)(lds + PG8_SB(b, h) + boff + n * 2048); dst##8[n].hi = *(const LAS v4i32_t*)(lds + PG8_SB(b, h) + boff + n * 2048 + 1024); } \
        else { _Pragma("unroll") for (int k = 0; k < 2; ++k) dst[n][k] = *(const LAS bf16x8*)(lds + PG8_SB(b, h) + boff + n * 2048 + k * 1024); } } } while (0)
#define PG8_MMA(ai, bj, At, Bt) do { __builtin_amdgcn_s_setprio(1); _Pragma("unroll") for (int m = 0; m < 4; ++m) _Pragma("unroll") for (int n = 0; n < 2; ++n) { \
        if constexpr (FP8) asm volatile("v_mfma_scale_f32_16x16x128_f8f6f4 %0, %1, %2, %0, %3, %3 op_sel_hi:[0,0,0]" : "+v"(acc[ai][bj][m][n]) : "v"(Bt##8[n]), "v"(At##8[m]), "v"(sc1_));     \
        else { _Pragma("unroll") for (int k = 0; k < 2; ++k) acc[ai][bj][m][n] = __builtin_amdgcn_mfma_f32_16x16x32_bf16(Bt[n][k], At[m][k], acc[ai][bj][m][n], 0, 0, 0); } } \
        __builtin_amdgcn_s_setprio(0); } while (0)
#define PG8_WAIT_V(n) asm volatile("s_waitcnt vmcnt(" #n ")" ::: "memory")
#define PG8_WAIT_L(n) asm volatile("s_waitcnt lgkmcnt(" #n ")" ::: "memory")
#define PG8_BAR __builtin_amdgcn_s_barrier()
#define PG8_SCHED __builtin_amdgcn_sched_barrier(0)
#define PG8_SETV(dst, u) do { _Pragma("unroll") for (int _h = 0; _h < 2; ++_h) _Pragma("unroll") for (int _i = 0; _i < 2; ++_i) { int R_, C_; stage_rc(tid * 16 + _i * 8192, R_, C_); \
        dst[_h][_i] = (S.a_row(u, _h * HALF + R_) * (unsigned)K + (unsigned)C_) * 2u; } } while (0)
    Unit cur, nxt; int ui = 0;
    if (!S.next(0, cur)) return;
    f32x4 acc[2][2][4][2];
#define PG8_ZERO() do { _Pragma("unroll") for (int a = 0; a < 2; ++a) _Pragma("unroll") for (int b = 0; b < 2; ++b) _Pragma("unroll") for (int m = 0; m < 4; ++m) _Pragma("unroll") for (int n = 0; n < 2; ++n) { \
        if constexpr (FP8) asm volatile("v_mov_b32 %0, 0\n\tv_mov_b32 %1, 0\n\tv_mov_b32 %2, 0\n\tv_mov_b32 %3, 0" : "=v"(acc[a][b][m][n][0]), "=v"(acc[a][b][m][n][1]), "=v"(acc[a][b][m][n][2]), "=v"(acc[a][b][m][n][3])); \
        else acc[a][b][m][n] = (f32x4){0.f, 0.f, 0.f, 0.f}; } } while (0)
    PG8_ZERO();
    unsigned sc1_ = 0x7f7f7f7fu; asm volatile("" : "+v"(sc1_));
    (void)sc1_;
    bf16x8 At[4][2], B0[2][2], B1[2][2];
    v8i32_t At8[4], B08[2], B18[2];
    (void)At; (void)B0; (void)B1; (void)At8; (void)B08; (void)B18;
    const char* cA = S.a_ptr(cur); const char* cB = S.b_ptr(cur);
    if constexpr (Sched::GATHER) { PG8_SETV(vA, cur); }
    PG8_STAGE(PG8_SB(0, 0), cB, voffB); PG8_STAGE(PG8_SB(0, 1), cB + hstep, voffB); PG8_STAGE_A(PG8_SA(0, 0), cA, 0, false); PG8_STAGE_A(PG8_SA(0, 1), cA, 1, false);
    if (wr == 1) PG8_BAR;
    PG8_WAIT_V(2); PG8_BAR;
    PG8_STAGE(PG8_SB(1, 0), cB + kstep, voffB); PG8_STAGE_A(PG8_SA(1, 0), cA + kstep, 0, false); PG8_STAGE(PG8_SB(1, 1), cB + hstep + kstep, voffB);
    PG8_WAIT_V(6); PG8_BAR;
    for (;;) {
        const bool has_next = S.next(ui + 1, nxt);
        const char* nA = has_next ? S.a_ptr(nxt) : cA; const char* nB = has_next ? S.b_ptr(nxt) : cB;
        if constexpr (Sched::GATHER) { if (has_next) { PG8_SETV(vN, nxt); } else {
#pragma unroll
            for (int h = 0; h < 2; ++h)
#pragma unroll
                for (int i = 0; i < 2; ++i) vN[h][i] = vA[h][i]; } }
        for (int t = 0; t < nt; t += 2) {
            const bool last = (t == nt - 2);
            if constexpr (Epi::MIDK) { if (t == nt / 2) E.mid(acc, cur, wr, wc, fr, fq); }
            const char* a1 = cA + (size_t)(t + 1) * kstep;
            const char* a2 = last ? nA : cA + (size_t)(t + 2) * kstep; const char* b2 = last ? nB : cB + (size_t)(t + 2) * kstep;
            const char* a3 = a2 + kstep; const char* b3 = b2 + kstep;
            PG8_LDB(B0, 0, 0); PG8_LDB(B1, 0, 1); PG8_SCHED; PG8_LDA(At, 0, 0); PG8_STAGE_A(PG8_SA(1, 1), a1, 1, false);
            PG8_WAIT_V(8); PG8_WAIT_L(0); PG8_BAR; PG8_MMA(0, 0, At, B0); PG8_MMA(0, 1, At, B1); PG8_BAR; PG8_SCHED;
            PG8_LDA(At, 0, 1); PG8_STAGE(PG8_SB(0, 0), b2, voffB); PG8_STAGE(PG8_SB(0, 1), b2 + hstep, voffB); PG8_STAGE_A(PG8_SA(0, 0), a2, 0, last);
            PG8_WAIT_V(8); PG8_WAIT_L(0); PG8_BAR; PG8_MMA(1, 0, At, B0); PG8_MMA(1, 1, At, B1); PG8_BAR; PG8_SCHED;
            PG8_LDB(B0, 1, 0); PG8_LDB(B1, 1, 1); PG8_SCHED; PG8_LDA(At, 1, 0); PG8_STAGE_A(PG8_SA(0, 1), a2, 1, last);
            PG8_WAIT_V(8); PG8_WAIT_L(0); PG8_BAR; PG8_MMA(0, 0, At, B0); PG8_MMA(0, 1, At, B1); PG8_BAR; PG8_SCHED;
            PG8_LDA(At, 1, 1); PG8_STAGE(PG8_SB(1, 0), b3, voffB); PG8_STAGE(PG8_SB(1, 1), b3 + hstep, voffB); PG8_STAGE_A(PG8_SA(1, 0), a3, 0, last);
            PG8_WAIT_V(8); PG8_WAIT_L(0); PG8_BAR; PG8_MMA(1, 0, At, B0); PG8_MMA(1, 1, At, B1); PG8_BAR; PG8_SCHED;
        }
        if constexpr (ALIGN_EPI) { if (wr == 0) PG8_BAR; }
        if constexpr (FP8) { asm volatile("s_nop 15\n\ts_nop 7" ::: "memory"); __builtin_amdgcn_sched_barrier(0); }
        E(acc, cur, wr, wc, fr, fq);
        if (!has_next) break;
        PG8_ZERO();
        cur = nxt; cA = nA; cB = nB; ++ui;
        if constexpr (Sched::GATHER) {
#pragma unroll
            for (int h = 0; h < 2; ++h)
#pragma unroll
                for (int i = 0; i < 2; ++i) vA[h][i] = vN[h][i]; }
        if constexpr (ALIGN_EPI) { if (wr == 1) PG8_BAR; }
    }
    PG8_WAIT_V(0);
    if constexpr (!ALIGN_EPI) { if (wr == 0) PG8_BAR; }
    PG8_BAR;
#undef PG8_SA
#undef PG8_SB
#undef PG8_STAGE
#undef PG8_STAGE_A
#undef PG8_LDA
#undef PG8_LDB
#undef PG8_MMA
#undef PG8_ZERO
#undef PG8_WAIT_V
#undef PG8_WAIT_L
#undef PG8_BAR
#undef PG8_SCHED
#undef PG8_SETV
}
}
using pg8::Unit;

#define EPI_ROWS(ai, m) for (int ai = 0; ai < 2; ++ai) for (int m = 0; m < 4; ++m)

struct EpiInProj {
    static constexpr bool MIDK = false;
    bf16 *qlat, *kvlat, *kpe, *fq, *gates; float *logf, *ssqq, *ssqkv; const float* ropetab; const float* bforget; bool skip; int rowmul;
    __device__ __forceinline__ void operator()(const f32x4 (&acc)[2][2][4][2], const Unit& u, int wr, int wc, int fr, int fq_) const {
        if (skip) return;
        const int pn = u.pn, row0 = u.pm * 256 + wr * 64 + fr, c0 = wc * 32 + 8 * fq_;
        if (pn >= 8) {
            unsigned char* gp = (unsigned char*)gates + (size_t)(pn - 8) * 256 + wc * 64 + fq_ * 16;
#pragma unroll
            for (int ai = 0; ai < 2; ++ai)
#pragma unroll
                for (int m = 0; m < 4; ++m) { const int row = row0 + ai * 128 + m * 16; u32x4 o;
#pragma unroll
                    for (int bj = 0; bj < 2; ++bj) { f32x4 v0 = acc[ai][bj][m][0], v1 = acc[ai][bj][m][1];
#pragma unroll
                        for (int q = 0; q < 4; ++q) { v0[q] = sigmoidf_(v0[q]) * 255.f + 8388608.f; v1[q] = sigmoidf_(v1[q]) * 255.f + 8388608.f; }
                        o[2 * bj] = pack4u8(v0[0], v0[1], v0[2], v0[3]); o[2 * bj + 1] = pack4u8(v1[0], v1[1], v1[2], v1[3]); }
                    *(u32x4*)(gp + (size_t)row * 2048) = o; }
        } else if (pn >= 2) {
            bf16* dst = fq + (size_t)((pn - 2) >> 1) * ((size_t)T * 512) + (pn & 1) * 256 + c0; const float sc = (pn < 4) ? C2F : 1.f;
#pragma unroll
            for (int ai = 0; ai < 2; ++ai)
#pragma unroll
                for (int m = 0; m < 4; ++m) { const int row = row0 + ai * 128 + m * 16;
#pragma unroll
                    for (int bj = 0; bj < 2; ++bj) *(u32x4*)(dst + (size_t)row * 512 + 128 * bj) = pack8(acc[ai][bj][m][0] * sc, acc[ai][bj][m][1] * sc); }
        } else if (pn == 0) {
#pragma unroll
            for (int ai = 0; ai < 2; ++ai)
#pragma unroll
                for (int m = 0; m < 4; ++m) { const int row = row0 + ai * 128 + m * 16; float s = 0.f;
#pragma unroll
                    for (int bj = 0; bj < 2; ++bj) { const f32x4 v0 = acc[ai][bj][m][0], v1 = acc[ai][bj][m][1];
                        s += (v0[0] * v0[0] + v0[1] * v0[1]) + (v0[2] * v0[2] + v0[3] * v0[3]) + (v1[0] * v1[0] + v1[1] * v1[1]) + (v1[2] * v1[2] + v1[3] * v1[3]);
                        *(u32x4*)(qlat + (size_t)row * QLORA + c0 + 128 * bj) = pack8(v0, v1); }
                    s += __shfl_xor(s, 16); s += __shfl_xor(s, 32);
                    if (fq_ == 0) ssqq[row * 4 + wc] = s; }
        } else {
#pragma unroll
            for (int ai = 0; ai < 2; ++ai)
#pragma unroll
                for (int m = 0; m < 4; ++m) { const int row = row0 + ai * 128 + m * 16;
                    { const f32x4 v0 = acc[ai][0][m][0], v1 = acc[ai][0][m][1];
                      float s = (v0[0] * v0[0] + v0[1] * v0[1]) + (v0[2] * v0[2] + v0[3] * v0[3]) + (v1[0] * v1[0] + v1[1] * v1[1]) + (v1[2] * v1[2] + v1[3] * v1[3]);
                      *(u32x4*)(kvlat + (size_t)row * KVPAD + c0) = pack8(v0, v1);
                      s += __shfl_xor(s, 16); s += __shfl_xor(s, 32);
                      if (fq_ == 0) ssqkv[row * 4 + wc] = s; }
                    { const f32x4 v0 = acc[ai][1][m][0], v1 = acc[ai][1][m][1];
                      *(u32x4*)(kvlat + (size_t)row * KVPAD + 128 + c0) = (u32x4){0u, 0u, 0u, 0u};
                      if (wc == 0) {
                          const f32x4* tb = (const f32x4*)(ropetab + ((size_t)row * 16 + 4 * fq_) * 2);
                          const f32x4 t0 = tb[0], t1 = tb[1];
                          f32x4 o1, o2;
                          o1[0] = v0[0] * t0[0] - v1[0] * t0[1]; o2[0] = v1[0] * t0[0] + v0[0] * t0[1];
                          o1[1] = v0[1] * t0[2] - v1[1] * t0[3]; o2[1] = v1[1] * t0[2] + v0[1] * t0[3];
                          o1[2] = v0[2] * t1[0] - v1[2] * t1[1]; o2[2] = v1[2] * t1[0] + v0[2] * t1[1];
                          o1[3] = v0[3] * t1[2] - v1[3] * t1[3]; o2[3] = v1[3] * t1[2] + v0[3] * t1[3];
                          *(u32x4*)(kpe + (size_t)row * ROPE + 8 * fq_) = pack8(o1, o2);
                      } else if (wc == 1 && fq_ == 0) {
                          f32x4 l0, l1;
#pragma unroll
                          for (int h = 0; h < 4; ++h) { const float z0 = v0[h] + bforget[h], z1 = v1[h] + bforget[4 + h];
                              l0[h] = -__builtin_amdgcn_logf(1.f + __builtin_amdgcn_exp2f(-LOG2E * z0)); l1[h] = -__builtin_amdgcn_logf(1.f + __builtin_amdgcn_exp2f(-LOG2E * z1)); }
                          *(f32x4*)(logf + (size_t)row * 8) = l0; *(f32x4*)(logf + (size_t)row * 8 + 4) = l1;
                      } } }
        }
        (void)rowmul;
    }
};

struct EpiQup {
    static constexpr bool MIDK = false;
    bf16* q; const float* ssqq; const float* ropetab;
    __device__ __forceinline__ void operator()(const f32x4 (&acc)[2][2][4][2], const Unit& u, int wr, int wc, int fr, int fq_) const {
        const int row0 = u.pm * 256 + wr * 64 + fr, c0 = u.pn * 256 + wc * 32 + 8 * fq_;
#pragma unroll
        for (int ai = 0; ai < 2; ++ai)
#pragma unroll
            for (int m = 0; m < 4; ++m) {
                const int row = row0 + ai * 128 + m * 16;
                const f32x4 sq = *(const f32x4*)(ssqq + row * 4);
                const float rs = rsqrtf(((sq[0] + sq[1]) + (sq[2] + sq[3])) * (1.f / QLORA) + EPS) * C2M;
#pragma unroll
                for (int bj = 0; bj < 2; ++bj) {
                    const int col = c0 + 128 * bj, j = col % MQK;
                    f32x4 v0 = acc[ai][bj][m][0] * rs, v1 = acc[ai][bj][m][1] * rs;
                    if (j >= 64) { const int g = (j - 64) >> 3;
                        const f32x4* tb = (const f32x4*)(ropetab + ((size_t)row * 16 + 4 * g) * 2);
                        const f32x4 t0 = tb[0], t1 = tb[1];
                        f32x4 o1, o2;
                        o1[0] = v0[0] * t0[0] - v1[0] * t0[1]; o2[0] = v1[0] * t0[0] + v0[0] * t0[1];
                        o1[1] = v0[1] * t0[2] - v1[1] * t0[3]; o2[1] = v1[1] * t0[2] + v0[1] * t0[3];
                        o1[2] = v0[2] * t1[0] - v1[2] * t1[1]; o2[2] = v1[2] * t1[0] + v0[2] * t1[1];
                        o1[3] = v0[3] * t1[2] - v1[3] * t1[3]; o2[3] = v1[3] * t1[2] + v0[3] * t1[3];
                        v0 = o1; v1 = o2; }
                    *(u32x4*)(q + (size_t)row * 768 + col) = pack8(v0, v1);
                }
            }
    }
};

struct EpiKVup {
    static constexpr bool MIDK = false;
    bf16 *kn, *vm; const float* ssqkv;
    __device__ __forceinline__ void operator()(const f32x4 (&acc)[2][2][4][2], const Unit& u, int wr, int wc, int fr, int fq_) const {
        const int row0 = u.pm * 256 + wr * 64 + fr, c0 = u.pn * 256 + wc * 32 + 8 * fq_;
        bf16* dst = (u.pn < 2) ? kn : vm; const int cb = (u.pn & 1) * 256 + wc * 32 + 8 * fq_;
        (void)c0;
#pragma unroll
        for (int ai = 0; ai < 2; ++ai)
#pragma unroll
            for (int m = 0; m < 4; ++m) {
                const int row = row0 + ai * 128 + m * 16;
                const f32x4 sq = *(const f32x4*)(ssqkv + row * 4);
                const float rs = rsqrtf(((sq[0] + sq[1]) + (sq[2] + sq[3])) * (1.f / KVLORA) + EPS);
#pragma unroll
                for (int bj = 0; bj < 2; ++bj) *(u32x4*)(dst + (size_t)row * 512 + cb + 128 * bj) = pack8(acc[ai][bj][m][0] * rs, acc[ai][bj][m][1] * rs);
            }
    }
};

struct EpiPartA {
    static constexpr bool MIDK = false;
    float* part; const bf16* gates;
    __device__ __forceinline__ void operator()(const f32x4 (&acc)[2][2][4][2], const Unit& u, int wr, int wc, int fr, int fq_) const {
        const int row0 = u.pm * 256 + wr * 64 + fr, c0 = u.pn * 256 + wc * 32 + 8 * fq_;
#pragma unroll
        for (int ai = 0; ai < 2; ++ai)
#pragma unroll
            for (int m = 0; m < 4; ++m) {
                const int row = row0 + ai * 128 + m * 16;
#pragma unroll
                for (int bj = 0; bj < 2; ++bj) { const int col = c0 + 128 * bj;
                    f32x4 g0, g1; unpack8(*(const u32x4*)(gates + (size_t)row * 2048 + col), g0, g1);
                    *(f32x4*)(part + (size_t)row * D + col) = g0 * acc[ai][bj][m][0]; *(f32x4*)(part + (size_t)row * D + col + 4) = g1 * acc[ai][bj][m][1]; }
            }
    }
};
struct EpiMerged {
    static constexpr bool MIDK = false;
    const float* part; const bf16* gates; bf16* merged;
    __device__ __forceinline__ void operator()(const f32x4 (&acc)[2][2][4][2], const Unit& u, int wr, int wc, int fr, int fq_) const {
        const int row0 = u.pm * 256 + wr * 64 + fr, c0 = u.pn * 256 + wc * 32 + 8 * fq_;
#pragma unroll
        for (int ai = 0; ai < 2; ++ai)
#pragma unroll
            for (int m = 0; m < 4; ++m) {
                const int row = row0 + ai * 128 + m * 16;
#pragma unroll
                for (int bj = 0; bj < 2; ++bj) { const int col = c0 + 128 * bj;
                    f32x4 g0, g1; unpack8(*(const u32x4*)(gates + (size_t)row * 2048 + 1024 + col), g0, g1);
                    const f32x4 p0 = *(const f32x4*)(part + (size_t)row * D + col), p1 = *(const f32x4*)(part + (size_t)row * D + col + 4);
                    *(u32x4*)(merged + (size_t)row * D + col) = pack8(p0 + g0 * acc[ai][bj][m][0], p1 + g1 * acc[ai][bj][m][1]); }
            }
    }
};
struct EpiMergedCat {
    static constexpr bool MIDK = true;
    const unsigned char* gates; unsigned char* merged; float sc;
    __device__ __forceinline__ void mid(f32x4 (&acc)[2][2][4][2], const Unit& u, int wr, int wc, int fr, int fq_) const {
        int row0 = u.pm * 256 + wr * 64 + fr, c0 = u.pn * 256 + wc * 64 + fq_ * 16;
        asm volatile("" : "+v"(row0), "+v"(c0));
#pragma unroll
        for (int ai = 0; ai < 2; ++ai)
#pragma unroll
            for (int m = 0; m < 4; ++m) { const int row = row0 + ai * 128 + m * 16;
                const u32x4 ga = *(const u32x4*)(gates + (size_t)row * 2048 + c0), gb = *(const u32x4*)(gates + (size_t)row * 2048 + 1024 + c0);
#pragma unroll
                for (int bj = 0; bj < 2; ++bj)
#pragma unroll
                    for (int q = 0; q < 4; ++q) { acc[ai][bj][m][0][q] *= ub(ga[2 * bj], q) * __builtin_amdgcn_rcpf(fmaxf(ub(gb[2 * bj], q), 1.f)); acc[ai][bj][m][1][q] *= ub(ga[2 * bj + 1], q) * __builtin_amdgcn_rcpf(fmaxf(ub(gb[2 * bj + 1], q), 1.f)); }
                asm volatile("" ::: "memory"); }
    }
    __device__ __forceinline__ void operator()(const f32x4 (&acc)[2][2][4][2], const Unit& u, int wr, int wc, int fr, int fq_) const {
        const int row0 = u.pm * 256 + wr * 64 + fr, c0 = u.pn * 256 + wc * 32 + 8 * fq_, g0 = u.pn * 256 + wc * 64 + fq_ * 16;
#pragma unroll
        for (int ai = 0; ai < 2; ++ai)
#pragma unroll
            for (int m = 0; m < 4; ++m) { const int row = row0 + ai * 128 + m * 16;
                const u32x4 gb = *(const u32x4*)(gates + (size_t)row * 2048 + 1024 + g0);
#pragma unroll
                for (int bj = 0; bj < 2; ++bj) { const int col = c0 + 128 * bj;
                    f32x4 v0, v1;
#pragma unroll
                    for (int q = 0; q < 4; ++q) { v0[q] = fmaxf(ub(gb[2 * bj], q), 1.f) * acc[ai][bj][m][0][q] * sc; v1[q] = fmaxf(ub(gb[2 * bj + 1], q), 1.f) * acc[ai][bj][m][1][q] * sc; }
                    u32x2 o; int p_ = __builtin_amdgcn_cvt_pk_fp8_f32(v0[0], v0[1], 0, false); p_ = __builtin_amdgcn_cvt_pk_fp8_f32(v0[2], v0[3], p_, true); o.x = (unsigned)p_;
                    p_ = __builtin_amdgcn_cvt_pk_fp8_f32(v1[0], v1[1], 0, false); p_ = __builtin_amdgcn_cvt_pk_fp8_f32(v1[2], v1[3], p_, true); o.y = (unsigned)p_;
                    *(u32x2*)(merged + (size_t)row * D + col) = o; } }
    }
};
struct EpiOut {
    static constexpr bool MIDK = false;
    const float* x; bf16* x1; const float* mod; float* ssq1; float sc;
    __device__ __forceinline__ void operator()(const f32x4 (&acc)[2][2][4][2], const Unit& u, int wr, int wc, int fr, int fq_) const {
        const int row0 = u.pm * 256 + wr * 64 + fr, c0 = u.pn * 256 + wc * 32 + 8 * fq_;
        const float* gm = mod + (size_t)((u.pm * 256) / SEQ) * 6 * D + 2 * D;
        f32x4 g[2][2];
#pragma unroll
        for (int bj = 0; bj < 2; ++bj) { g[bj][0] = *(const f32x4*)(gm + c0 + 128 * bj) * sc; g[bj][1] = *(const f32x4*)(gm + c0 + 128 * bj + 4) * sc; }
#pragma unroll
        for (int ai = 0; ai < 2; ++ai)
#pragma unroll
            for (int m = 0; m < 4; ++m) { const int row = row0 + ai * 128 + m * 16; float sq = 0.f;
#pragma unroll
                for (int bj = 0; bj < 2; ++bj) { const int col = c0 + 128 * bj;
                    const f32x4 x0 = __builtin_nontemporal_load((const f32x4*)(x + (size_t)row * D + col)), x1v = __builtin_nontemporal_load((const f32x4*)(x + (size_t)row * D + col + 4));
                    f32x4 r0 = x0 + g[bj][0] * acc[ai][bj][m][0], r1 = x1v + g[bj][1] * acc[ai][bj][m][1];
                    const u32x4 pk_ = pack8(r0, r1); unpack8(pk_, r0, r1);
                    *(u32x4*)(x1 + (size_t)row * D + col) = pk_;
                    sq += (r0[0] * r0[0] + r0[1] * r0[1]) + (r0[2] * r0[2] + r0[3] * r0[3]) + (r1[0] * r1[0] + r1[1] * r1[1]) + (r1[2] * r1[2] + r1[3] * r1[3]); }
                sq += __shfl_xor(sq, 16); sq += __shfl_xor(sq, 32);
                if (fq_ == 0) ssq1[(size_t)row * 16 + 4 * u.pn + wc] = sq; }
    }
};
struct EpiHb {
    static constexpr bool MIDK = false;
    unsigned char* hb; float sc;
    __device__ __forceinline__ void operator()(const f32x4 (&acc)[2][2][4][2], const Unit& u, int wr, int wc, int fr, int fq_) const {
        const int row0 = u.pm * 256 + wr * 64 + fr, c0 = u.pn * 128 + wc * 32 + 8 * fq_;
#pragma unroll
        for (int ai = 0; ai < 2; ++ai)
#pragma unroll
            for (int m = 0; m < 4; ++m) { const int row = row0 + ai * 128 + m * 16;
                f32x4 h0, h1;
#pragma unroll
                for (int q = 0; q < 4; ++q) { h0[q] = siluf_(acc[ai][0][m][0][q] * sc) * (acc[ai][1][m][0][q] * (sc * HSCALE8)); h1[q] = siluf_(acc[ai][0][m][1][q] * sc) * (acc[ai][1][m][1][q] * (sc * HSCALE8)); }
                u32x2 o; int p_ = __builtin_amdgcn_cvt_pk_fp8_f32(h0[0], h0[1], 0, false); p_ = __builtin_amdgcn_cvt_pk_fp8_f32(h0[2], h0[3], p_, true); o.x = (unsigned)p_;
                p_ = __builtin_amdgcn_cvt_pk_fp8_f32(h1[0], h1[1], 0, false); p_ = __builtin_amdgcn_cvt_pk_fp8_f32(h1[2], h1[3], p_, true); o.y = (unsigned)p_;
                *(u32x2*)(hb + (size_t)row * DEXP + c0) = o; }
    }
};
struct EpiDown {
    static constexpr bool MIDK = false;
    bf16* Y; float* out; float* outw; const float* mod; const unsigned short* list; const unsigned char* eidx; const float* gatew;
    __device__ __forceinline__ void operator()(const f32x4 (&acc)[2][2][4][2], const Unit& u, int wr, int wc, int fr, int fq_) const {
        const int c0 = u.pn * 256 + wc * 32 + 8 * fq_;
#pragma unroll
        for (int ai = 0; ai < 2; ++ai)
#pragma unroll
            for (int m = 0; m < 4; ++m) {
                const int rl = wr * 64 + fr + ai * 128 + m * 16, idx = u.aux * 256 + rl;
                if (u.e == NEXP) {
                    const int t = idx; const float* gf = mod + (size_t)(t / SEQ) * 6 * D + 5 * D;
#pragma unroll
                    for (int bj = 0; bj < 2; ++bj) { const int col = c0 + 128 * bj; const float* o = out + (size_t)t * D + col; float* ow = outw + (size_t)t * D + col;
                        const f32x4 g0 = *(const f32x4*)(gf + col), g1 = *(const f32x4*)(gf + col + 4);
                        const f32x4 x0 = *(const f32x4*)o, x1v = *(const f32x4*)(o + 4);
                        *(f32x4*)ow = x0 + g0 * acc[ai][bj][m][0]; *(f32x4*)(ow + 4) = x1v + g1 * acc[ai][bj][m][1]; }
                } else if (idx < u.n) {
                    const int t = list[(size_t)u.e * LISTCAP + idx];
                    const u32x2 ev = *(const u32x2*)(eidx + (size_t)t * 8);
                    int k = 0;
#pragma unroll
                    for (int q = 1; q < TOPK; ++q) { const unsigned b = (q < 4) ? ((ev.x >> (8 * q)) & 0xffu) : ((ev.y >> (8 * (q - 4))) & 0xffu); if ((int)b == u.e) k = q; }
                    const float w = gatew[(size_t)t * 8 + k];
#pragma unroll
                    for (int bj = 0; bj < 2; ++bj) *(u32x4*)(Y + ((size_t)t * TOPK + k) * D + c0 + 128 * bj) = pack8(acc[ai][bj][m][0] * w, acc[ai][bj][m][1] * w);
                }
            }
    }
};

template <int NT, bool GATHER_>
struct MoeOrder {
    static constexpr bool GATHER = GATHER_;
    const char* A; const char* Bt; const char* Bsh; int K; size_t bstride;
    const unsigned short* list; volatile LAS int* tab;
    int G, c;
    __device__ bool next(int i, Unit& u) const {
        int ti, pn_;
        if ((G & 7) == 0) { const int x = c & 7, j = i * (G >> 3) + (c >> 3); ti = (j / NT) * 8 + x; pn_ = j % NT; if (ti >= tab[65]) return false; }
        else { const int total = tab[65] * NT; const long L = (long)i * G + c; if (L >= total) return false; ti = (int)L / NT; pn_ = (int)L % NT; }
        u.pn = pn_; u.pm = ti;
        const int e = __builtin_amdgcn_readfirstlane(tab[132 + ti]);
        u.e = e; u.aux = __builtin_amdgcn_readfirstlane(ti - tab[e]); u.n = __builtin_amdgcn_readfirstlane(tab[66 + e]); return true;
    }
    __device__ __forceinline__ const char* a_ptr(const Unit& u) const { return GATHER ? A : A + (size_t)u.pm * 256 * K * 2; }
    __device__ __forceinline__ const char* b_ptr(const Unit& u) const { return (u.e == NEXP ? Bsh : Bt + (size_t)u.e * bstride) + (size_t)u.pn * 256 * K * 2; }
    __device__ __forceinline__ unsigned a_row(const Unit& u, int r) const {
        if (!GATHER) return (unsigned)r;
        const int idx = u.aux * 256 + r;
        if (u.e == NEXP) return (unsigned)idx;
        return (idx < u.n) ? (unsigned)list[(size_t)u.e * LISTCAP + idx] : 0u;
    }
};

struct UpOrder {
    static constexpr bool GATHER = false;
    const char* Aq; const char* Bq; const char* Akv; const char* Bkv; int K; int G, c;
    __device__ bool next(int i, Unit& u) const {
        int L = i * G + c; if (L >= 448) return false;
        if (L < 256) { u.e = 1; u.pm = L >> 2; u.pn = L & 3; } else { L -= 256; u.e = 0; u.pm = L / 3; u.pn = L % 3; }
        u.aux = 0; u.n = 256; return true; }
    __device__ __forceinline__ const char* a_ptr(const Unit& u) const { return (u.e ? Akv : Aq) + (size_t)u.pm * 256 * K * 2; }
    __device__ __forceinline__ const char* b_ptr(const Unit& u) const { return (u.e ? Bkv : Bq) + (size_t)u.pn * 256 * K * 2; }
    __device__ __forceinline__ unsigned a_row(const Unit&, int r) const { return (unsigned)r; }
};
struct EpiUp {
    static constexpr bool MIDK = false;
    EpiQup q; EpiKVup kv;
    __device__ __forceinline__ void operator()(const f32x4 (&acc)[2][2][4][2], const Unit& u, int wr, int wc, int fr, int fq_) const { if (u.e) kv(acc, u, wr, wc, fr, fq_); else q(acc, u, wr, wc, fr, fq_); }
};

struct SharedDownOrder {
    static constexpr bool GATHER = false;
    const char* A; const char* Bt; int K; int G, c;
    __device__ bool next(int i, Unit& u) const { const int L = i * G + c; if (L >= (T / 256) * 4) return false; u.pm = L >> 2; u.pn = L & 3; u.e = NEXP; u.aux = L >> 2; u.n = 256; return true; }
    __device__ __forceinline__ const char* a_ptr(const Unit& u) const { return A + (size_t)u.pm * 256 * K * 2; }
    __device__ __forceinline__ const char* b_ptr(const Unit& u) const { return Bt + (size_t)u.pn * 256 * K * 2; }
    __device__ __forceinline__ unsigned a_row(const Unit&, int r) const { return (unsigned)r; }
};

namespace att {
constexpr int KSLOT = 12288, VSLOT = 8192;
constexpr int L_K = 0, L_V = 3 * KSLOT, L_F = L_V + 2 * VSLOT, L_WS = L_F + 3 * 256, L_OST = L_WS + 2048, L_END = L_OST + 8 * 4096;
static_assert(L_END <= RING_BYTES, "attention LDS");
__device__ __forceinline__ int crow(int r, int hi) { return (r & 3) + 8 * (r >> 2) + 4 * hi; }
__device__ __forceinline__ float max3f(float a, float b, float c) { return fmaxf(fmaxf(a, b), c); }
__device__ __forceinline__ float rowmax(const f32x16& p0, const f32x16& p1) {
    float a = max3f(p0[0], p0[1], p1[0]), b = max3f(p0[2], p0[3], p1[1]); a = max3f(a, p1[2], p1[3]);
#pragma unroll
    for (int r = 4; r < 16; r += 4) { a = max3f(a, p0[r], p0[r + 1]); b = max3f(b, p0[r + 2], p0[r + 3]); a = max3f(a, p1[r], p1[r + 1]); b = max3f(b, p1[r + 2], p1[r + 3]); }
    const float m = fmaxf(a, b);
    auto rr = __builtin_amdgcn_permlane32_swap(__float_as_uint(m), __float_as_uint(m), false, false);
    return fmaxf(__uint_as_float(rr[0]), __uint_as_float(rr[1]));
}
__device__ __forceinline__ void cmask(f32x16& p0, f32x16& p1, int jb, int qrel, int hi) {
    const float NEG = -INFINITY; const int kb = 64 * jb + 4 * hi;
#pragma unroll
    for (int r = 0; r < 16; ++r) { const int kv = kb + (r & 3) + 8 * (r >> 2); if (kv > qrel) p0[r] = NEG; if (kv + 32 > qrel) p1[r] = NEG; }
}
__device__ __forceinline__ void pv(f32x16* o, int vb, bf16x8 pa0, bf16x8 pa1, bf16x8 pa2, bf16x8 pa3) {
#pragma unroll
    for (int d0 = 0; d0 < 2; ++d0) { s16x4 lo[4], hi[4];
#pragma unroll
        for (int ks = 0; ks < 4; ++ks) {
            asm volatile("ds_read_b64_tr_b16 %0,%1 offset:%c2" : "=&v"(lo[ks]) : "v"(vb), "i"(d0 * 4096 + ks * 1024) : "memory");
            asm volatile("ds_read_b64_tr_b16 %0,%1 offset:%c2" : "=&v"(hi[ks]) : "v"(vb), "i"(d0 * 4096 + ks * 1024 + 512) : "memory"); }
        asm volatile("s_waitcnt lgkmcnt(0)" ::: "memory"); __builtin_amdgcn_sched_barrier(0);
#define PK(k) (bf16x8){lo[k][0], lo[k][1], lo[k][2], lo[k][3], hi[k][0], hi[k][1], hi[k][2], hi[k][3]}
        o[d0] = __builtin_amdgcn_mfma_f32_32x32x16_bf16(pa0, PK(0), o[d0], 0, 0, 0);
        o[d0] = __builtin_amdgcn_mfma_f32_32x32x16_bf16(pa1, PK(1), o[d0], 0, 0, 0);
        o[d0] = __builtin_amdgcn_mfma_f32_32x32x16_bf16(pa2, PK(2), o[d0], 0, 0, 0);
        o[d0] = __builtin_amdgcn_mfma_f32_32x32x16_bf16(pa3, PK(3), o[d0], 0, 0, 0);
#undef PK
    }
}
__device__ __forceinline__ unsigned cvtpk_s(float lo, float hi) { return cvt_pk_bf16(lo, hi); }

template <int DQK, bool DECAY, int THRL>
__device__ __forceinline__ void attn_unit(int b, int h, int qb, const bf16* Q, int QP, const bf16* Kn, const bf16* Kpe, const bf16* V, const float* cumF, bf16* O, int OP, LAS unsigned char* lds) {
    constexpr int ND0 = DQK / 16;
    int tid = threadIdx.x; asm volatile("" : "+v"(tid));
    const int lane = tid & 63, r32 = lane & 31, hi = lane >> 5; const int wid = __builtin_amdgcn_readfirstlane(tid >> 6);
    const long rowbase = (long)b * SEQ; const int q0 = qb * 256;
    const bf16* Qw = Q + (rowbase + q0 + wid * 32) * QP + h * DQK;
    const bf16* Kh = Kn + rowbase * 512 + h * 64; const bf16* Vh = V + rowbase * 512 + h * 64;
    const bf16* Kp = Kpe + rowbase * ROPE;
    const float* Fh = DECAY ? cumF + ((size_t)b * NHEAD + h) * SEQ : nullptr;
    LAS float* wsf = (LAS float*)(lds + L_WS) + wid * 64;
    const bf16* ksrc0 = Kh + (long)lane * 512 + wid * 8;
    const bf16* ksrc1 = Kp + (long)lane * ROPE + (wid & 3) * 8;
    const bf16* vsrc = Vh + (long)(16 * (wid & 3) + (lane >> 2)) * 512 + (wid >> 2) * 32 + (lane & 3) * 8;
    const int NT = (q0 + 256) / 64;
#define ATT_DMA_K(i_, s) do { const int t_ = NT - 1 - (i_); \
        __builtin_amdgcn_global_load_lds((const unsigned*)(ksrc0 + (long)t_ * 64 * 512), (LAS unsigned*)(lds + L_K + (s) * KSLOT + wid * 1024), 16, 0, 0); \
        if (DQK == 96 && wid < 4) __builtin_amdgcn_global_load_lds((const unsigned*)(ksrc1 + (long)t_ * 64 * ROPE), (LAS unsigned*)(lds + L_K + (s) * KSLOT + (8 + wid) * 1024), 16, 0, 0); \
        if (DECAY && wid == 7) __builtin_amdgcn_global_load_lds((const unsigned*)(Fh + t_ * 64 + lane), (LAS unsigned*)(lds + L_F + (s) * 256), 4, 0, 0); } while (0)
#define ATT_DMA_V(i_, s) do { const int t_ = NT - 1 - (i_); \
        __builtin_amdgcn_global_load_lds((const unsigned*)(vsrc + (long)t_ * 64 * 512), (LAS unsigned*)(lds + L_V + (s) * VSLOT + wid * 1024), 16, 0, 0); } while (0)
    ATT_DMA_K(0, 0); ATT_DMA_V(0, 0); ATT_DMA_K(1, 1);
    bf16x8 qr[ND0];
#pragma unroll
    for (int d0 = 0; d0 < ND0; ++d0) qr[d0] = *(const bf16x8*)(Qw + (long)r32 * QP + d0 * 16 + hi * 8);
    float fq_l = 0.f; if (DECAY) fq_l = Fh[q0 + wid * 32 + r32];
    float mhat = 0.f, l_reg = 0.f; bool started = false; f32x16 o[2]; o[0] = f32x16{}; o[1] = f32x16{};
    const int qrel = wid * 32 + r32;
    const int vb0 = (int)(uintptr_t)(lds + L_V) + ((lane >> 4) & 1) * 32 + (lane & 3) * 8 + (4 * hi + ((lane & 15) >> 2)) * 64;
#define ATT_QK(P0, P1, ks_) do { const float base_ = fq_l - mhat; \
        if (DECAY) { const LAS f32x4* fk_ = (const LAS f32x4*)(lds + L_F + (ks_) * 256); \
            _Pragma("unroll") for (int g = 0; g < 4; ++g) { const f32x4 a_ = fk_[2 * g + hi], c_ = fk_[8 + 2 * g + hi]; \
                _Pragma("unroll") for (int q = 0; q < 4; ++q) { P0[4 * g + q] = base_ - a_[q]; P1[4 * g + q] = base_ - c_[q]; } } } \
        else { _Pragma("unroll") for (int r = 0; r < 16; ++r) { P0[r] = base_; P1[r] = base_; } } \
        const LAS unsigned char* kb_ = lds + L_K + (ks_) * KSLOT + hi * 1024 + r32 * 16; \
        _Pragma("unroll") for (int d0 = 0; d0 < ND0; ++d0) { \
            const bf16x8 b0_ = *(const LAS bf16x8*)(kb_ + d0 * 2048), b1_ = *(const LAS bf16x8*)(kb_ + d0 * 2048 + 512); \
            P0 = __builtin_amdgcn_mfma_f32_32x32x16_bf16(b0_, qr[d0], P0, 0, 0, 0); P1 = __builtin_amdgcn_mfma_f32_32x32x16_bf16(b1_, qr[d0], P1, 0, 0, 0); } } while (0)
    f32x16 p0, p1, n0, n1;
    int ks_cur = 0, ks_nxt = 1, ks_ld = 2;
    for (int i = 0; i < NT; ++i) {
        const int vs = i & 1;
        VM_WAIT(); __syncthreads();
        if (i + 2 < NT) ATT_DMA_K(i + 2, ks_ld);
        if (i + 1 < NT) ATT_DMA_V(i + 1, vs ^ 1);
        if (i == 0) ATT_QK(p0, p1, 0);
        if (i + 1 < NT) ATT_QK(n0, n1, ks_nxt);
        const int jb = 3 - i;
        if (jb >= 0) cmask(p0, p1, jb, qrel, hi);
        const float rm = rowmax(p0, p1);
        bool resc = false; float dl = 0.f; const bool was_started = started;
        if (jb >= 0) {
            const bool fin = rm > -INFINITY;
            dl = started ? fmaxf(rm, 0.f) : (fin ? rm : 0.f); started = started || fin; resc = true;
        } else if (__any(rm > (float)THRL)) { dl = fmaxf(rm, 0.f); resc = true; }
        if (resc) { mhat += dl;
#pragma unroll
            for (int r = 0; r < 16; ++r) { p0[r] -= dl; p1[r] -= dl; }
            if (i + 1 < NT) {
#pragma unroll
                for (int r = 0; r < 16; ++r) { n0[r] -= dl; n1[r] -= dl; } }
            const float f = was_started ? __builtin_amdgcn_exp2f(-dl) : 1.f; l_reg *= f; if (hi == 0) wsf[r32] = f; }
        float sacc = 0.f;
#pragma unroll
        for (int r = 0; r < 16; ++r) { p0[r] = __builtin_amdgcn_exp2f(p0[r]); p1[r] = __builtin_amdgcn_exp2f(p1[r]); sacc += p0[r] + p1[r]; }
        l_reg += sacc;
        if (resc) { LDS_WAIT();
#pragma unroll
            for (int d_ = 0; d_ < 2; ++d_)
#pragma unroll
                for (int r = 0; r < 16; ++r) o[d_][r] *= wsf[crow(r, hi)]; }
        u32x4 pw0, pw1, pw2, pw3;
        pw0 = (u32x4){cvtpk_s(p0[0], p0[1]), cvtpk_s(p0[2], p0[3]), cvtpk_s(p0[4], p0[5]), cvtpk_s(p0[6], p0[7])};
        pw1 = (u32x4){cvtpk_s(p0[8], p0[9]), cvtpk_s(p0[10], p0[11]), cvtpk_s(p0[12], p0[13]), cvtpk_s(p0[14], p0[15])};
        pw2 = (u32x4){cvtpk_s(p1[0], p1[1]), cvtpk_s(p1[2], p1[3]), cvtpk_s(p1[4], p1[5]), cvtpk_s(p1[6], p1[7])};
        pw3 = (u32x4){cvtpk_s(p1[8], p1[9]), cvtpk_s(p1[10], p1[11]), cvtpk_s(p1[12], p1[13]), cvtpk_s(p1[14], p1[15])};
        __builtin_amdgcn_sched_barrier(0);
        pv(o, vb0 + vs * VSLOT, __builtin_bit_cast(bf16x8, pw0), __builtin_bit_cast(bf16x8, pw1), __builtin_bit_cast(bf16x8, pw2), __builtin_bit_cast(bf16x8, pw3));
        p0 = n0; p1 = n1;
        { const int t_ = ks_cur; ks_cur = ks_nxt; ks_nxt = ks_ld; ks_ld = t_; }
    }
    { auto rr = __builtin_amdgcn_permlane32_swap(__float_as_uint(l_reg), __float_as_uint(l_reg), false, false); l_reg = __uint_as_float(rr[0]) + __uint_as_float(rr[1]); }
    if (hi == 0) wsf[32 + r32] = l_reg; LDS_WAIT();
    float rli[16];
#pragma unroll
    for (int r = 0; r < 16; ++r) rli[r] = __builtin_amdgcn_rcpf(wsf[32 + crow(r, hi)]);
    unsigned char* Ow = (unsigned char*)O + (rowbase + q0 + wid * 32) * OP + h * 64;
    { LAS unsigned char* stg = lds + L_OST + wid * 4096;
#pragma unroll
      for (int r = 0; r < 16; ++r) { const int orow = crow(r, hi);
#pragma unroll
          for (int d0 = 0; d0 < 2; ++d0) { const float ov = o[d0][r] * rli[r] * OSCALE8; stg[orow * 64 + d0 * 32 + r32] = (unsigned char)__builtin_amdgcn_cvt_pk_fp8_f32(ov, ov, 0, false); } }
      LDS_WAIT();
#pragma unroll
      for (int i = 0; i < 2; ++i) { const int row = i * 16 + (lane >> 2), ch = lane & 3; const u32x4 v = *(const LAS u32x4*)(stg + row * 64 + ch * 16); *(u32x4*)(Ow + (long)row * OP + ch * 16) = v; } }
    LDS_WAIT(); __syncthreads();
#undef ATT_DMA_K
#undef ATT_DMA_V
#undef ATT_QK
}

constexpr int T_KSLOT = 12288, T_VSLOT = 8192, T_NSLOT = 3;
constexpr int T_K = 0, T_V = T_NSLOT * T_KSLOT, T_F = T_V + T_NSLOT * T_VSLOT, T_WS = T_F + T_NSLOT * 256, T_OST = T_WS + 2048, T_END = T_OST + 8 * 4096;
static_assert(T_END <= RING_BYTES, "attention LDS (hand-interleaved unit)");
typedef __attribute__((address_space(3))) const char* lds_cptr;
typedef short v4i16_t __attribute__((ext_vector_type(4)));
__device__ __forceinline__ s16x4 vtr(lds_cptr p) { return __builtin_bit_cast(s16x4, __builtin_amdgcn_ds_read_tr16_b64_v4i16((__attribute__((address_space(3))) v4i16_t*)p)); }
__device__ __forceinline__ void kload2(bf16x8* kf, lds_cptr kp, int j) { kf[2 * j] = *(const __attribute__((address_space(3))) bf16x8*)(kp + j * 2048); kf[2 * j + 1] = *(const __attribute__((address_space(3))) bf16x8*)(kp + j * 2048 + 512); }
#define TW_BAR(N) asm volatile("s_waitcnt vmcnt(" #N ") lgkmcnt(0)\n\ts_barrier" ::: "memory")
#define TSB() __builtin_amdgcn_sched_barrier(0)

template <int DQK, bool DECAY, int THRL>
__device__ __forceinline__ void attn_unit_t(int b, int h, int qb, const bf16* Q, int QP, const bf16* Kn, const bf16* Kpe, const bf16* V, const float* cumF, float kmax2, bf16* O, int OP, LAS unsigned char* lds) {
    constexpr int ND0 = DQK / 16;
    constexpr bool INPL = DECAY || (DQK == 96);
    int tid = threadIdx.x; asm volatile("" : "+v"(tid));
    const int lane = tid & 63, r32 = lane & 31, hi = lane >> 5; const int wid = __builtin_amdgcn_readfirstlane(tid >> 6);
    const long rowbase = (long)b * SEQ; const int q0 = qb * 256;
    const bf16* Qw = Q + (rowbase + q0 + wid * 32) * QP + h * DQK;
    const bf16* Kh = Kn + rowbase * 512 + h * 64; const bf16* Vh = V + rowbase * 512 + h * 64;
    const bf16* Kp = Kpe + rowbase * ROPE;
    const float* Fh = DECAY ? cumF + ((size_t)b * NHEAD + h) * SEQ : nullptr;
    LAS float* wsf = (LAS float*)(lds + T_WS) + wid * 64;
    const bf16* ksrc0 = Kh + (long)lane * 512 + wid * 8;
    const bf16* ksrc1 = Kp + (long)lane * ROPE + (wid & 3) * 8;
    const bf16* vsrc = Vh + (long)(16 * (wid & 3) + (lane >> 2)) * 512 + (wid >> 2) * 32 + (lane & 3) * 8;
    const int NTS = (q0 + 256) / 64;
#define TDMA_K(i_, sk) do { const int t_ = NTS - 1 - (i_); \
        __builtin_amdgcn_global_load_lds((const unsigned*)(ksrc0 + (long)t_ * 64 * 512), (LAS unsigned*)(lds + T_K + (sk) * T_KSLOT + wid * 1024), 16, 0, 0); \
        if (DECAY) __builtin_amdgcn_global_load_lds((const unsigned*)(Fh + t_ * 64 + lane), (LAS unsigned*)(lds + T_F + (sk) * 256), 4, 0, 0); \
        else __builtin_amdgcn_global_load_lds((const unsigned*)(ksrc1 + (long)t_ * 64 * ROPE), (LAS unsigned*)(lds + T_K + (sk) * T_KSLOT + (8 + (wid & 3)) * 1024), 16, 0, 0); } while (0)
#define TDMA_V(i_, sv) do { const int t_ = NTS - 1 - (i_); \
        __builtin_amdgcn_global_load_lds((const unsigned*)(vsrc + (long)t_ * 64 * 512), (LAS unsigned*)(lds + T_V + (sv) * T_VSLOT + wid * 1024), 16, 0, 0); } while (0)
    TDMA_K(0, 0); TDMA_V(0, 0); TDMA_K(1, 1);
    bf16x8 qr[ND0];
#pragma unroll
    for (int d0 = 0; d0 < ND0; ++d0) qr[d0] = *(const bf16x8*)(Qw + (long)r32 * QP + d0 * 16 + hi * 8);
    float fq_l = 0.f; if (DECAY) fq_l = Fh[q0 + wid * 32 + r32];
    float ftile = 0.f; if (DECAY) ftile = Fh[(lane < NTS ? lane : NTS - 1) * 64 + 63];
    float mhat = 0.f, l_reg = 0.f; f32x16 o[2]; o[0] = f32x16{}; o[1] = f32x16{};
    f32x16 negm = f32x16{}; asm volatile("" : "+v"(negm));
    const int qrel = wid * 32 + r32, i0 = 3 - (wid >> 1);
    const lds_cptr shm3 = (lds_cptr)lds; const lds_cptr kp0 = shm3 + T_K + hi * 1024 + r32 * 16;
    const lds_cptr vp0 = shm3 + T_V + ((lane >> 4) & 1) * 32 + (lane & 3) * 8 + (4 * hi + ((lane & 15) >> 2)) * 64;
    const int vb0 = (int)(uintptr_t)(lds + T_V) + ((lane >> 4) & 1) * 32 + (lane & 3) * 8 + (4 * hi + ((lane & 15) >> 2)) * 64;
    bool resc = false;
    bf16x8 kf[2 * ND0];
    f32x16 pA0, pA1, pB0, pB1;
    int sl_prev = 0, sl_cur = 0, sl_next = 1;
#define TROT() do { sl_prev = sl_cur; sl_cur = sl_next; sl_next = (sl_next == T_NSLOT - 1) ? 0 : sl_next + 1; } while (0)
#define TBIAS(X0, X1, fs_) do { if (DECAY) { const float base_ = fq_l - mhat; const LAS f32x4* fk_ = (const LAS f32x4*)(lds + T_F + (fs_) * 256); \
        _Pragma("unroll") for (int g = 0; g < 4; ++g) { const f32x4 a_ = fk_[2 * g + hi], c_ = fk_[8 + 2 * g + hi]; \
            _Pragma("unroll") for (int q = 0; q < 4; ++q) { X0[4 * g + q] = base_ - a_[q]; X1[4 * g + q] = base_ - c_[q]; } } } \
        else if (INPL) { const float nm_ = -mhat; _Pragma("unroll") for (int r = 0; r < 16; ++r) { X0[r] = nm_; X1[r] = nm_; } } } while (0)
#define TCIN(X) (INPL ? X : negm)
#define TRESC() do { if (resc) { asm volatile("s_waitcnt lgkmcnt(0)" ::: "memory"); \
        _Pragma("unroll") for (int d_ = 0; d_ < 2; ++d_) _Pragma("unroll") for (int r = 0; r < 16; ++r) o[d_][r] *= wsf[crow(r, hi)]; } } while (0)
#define TDECIDE(C0, C1, i_) do { \
        float a_ = max3f(C0[0], C0[1], C1[0]), b_ = max3f(C0[2], C0[3], C1[1]); a_ = max3f(a_, C1[2], C1[3]); \
        _Pragma("unroll") for (int r = 4; r < 16; r += 4) { a_ = max3f(a_, C0[r], C0[r + 1]); b_ = max3f(b_, C0[r + 2], C0[r + 3]); a_ = max3f(a_, C1[r], C1[r + 1]); b_ = max3f(b_, C1[r + 2], C1[r + 3]); } \
        float rm_ = fmaxf(a_, b_); { auto rr_ = __builtin_amdgcn_permlane32_swap(__float_as_uint(rm_), __float_as_uint(rm_), false, false); rm_ = fmaxf(__uint_as_float(rr_[0]), __uint_as_float(rr_[1])); } \
        resc = false; \
        if ((i_) == i0) { const float dl_ = rm_; mhat += dl_; \
            _Pragma("unroll") for (int r = 0; r < 16; ++r) { C0[r] -= dl_; C1[r] -= dl_; } \
            if (!INPL) { _Pragma("unroll") for (int r = 0; r < 16; ++r) negm[r] = -mhat; asm volatile("" : "+v"(negm)); } } \
        else if (__builtin_expect(__any(rm_ > (float)THRL), 0)) { const float dl_ = fmaxf(rm_, 0.f); mhat += dl_; \
            _Pragma("unroll") for (int r = 0; r < 16; ++r) { C0[r] -= dl_; C1[r] -= dl_; } \
            if (!INPL) { _Pragma("unroll") for (int r = 0; r < 16; ++r) negm[r] = -mhat; asm volatile("" : "+v"(negm)); } \
            const float f_ = __builtin_amdgcn_exp2f(-dl_); l_reg *= f_; if (hi == 0) wsf[r32] = f_; resc = true; } } while (0)
    TDMA_K(2, 2);
    TW_BAR(5);
    int NT = NTS;
    if (DECAY) {
        const float bound = 2.f * __builtin_sqrtf(kmax2) * 1.0001f + 1.f + (Fh[q0] - ftile);
        const unsigned long long need = __ballot(lane < NTS && bound >= -160.f);
        const int tmin = need ? (int)__builtin_ctzll(need) : NTS - 1;
        NT = NTS - tmin; NT += NT & 1; if (NT < 8) NT = 8; if (NT > NTS) NT = NTS;
        NT = __builtin_amdgcn_readfirstlane(NT); }
    TBIAS(pA0, pA1, 0);
    { const lds_cptr kb = kp0;
#pragma unroll
      for (int d0 = 0; d0 < ND0; ++d0) { const bf16x8 b0 = *(const __attribute__((address_space(3))) bf16x8*)(kb + d0 * 2048), b1 = *(const __attribute__((address_space(3))) bf16x8*)(kb + d0 * 2048 + 512);
          if (d0 == 0) { pA0 = __builtin_amdgcn_mfma_f32_32x32x16_bf16(b0, qr[0], TCIN(pA0), 0, 0, 0); pA1 = __builtin_amdgcn_mfma_f32_32x32x16_bf16(b1, qr[0], TCIN(pA1), 0, 0, 0); }
          else { pA0 = __builtin_amdgcn_mfma_f32_32x32x16_bf16(b0, qr[d0], pA0, 0, 0, 0); pA1 = __builtin_amdgcn_mfma_f32_32x32x16_bf16(b1, qr[d0], pA1, 0, 0, 0); } } }
    cmask(pA0, pA1, 3, qrel, hi);
    TDECIDE(pA0, pA1, 0);
#pragma unroll
    for (int r = 0; r < 16; ++r) { pA0[r] = __builtin_amdgcn_exp2f(pA0[r]); pA1[r] = __builtin_amdgcn_exp2f(pA1[r]); }
    TW_BAR(0);
    TDMA_K(3, 0); TDMA_V(1, 1);
    TROT();
#pragma unroll
    for (int j = 0; j < ND0; ++j) kload2(kf, kp0 + sl_cur * T_KSLOT, j);
    TBIAS(pB0, pB1, sl_cur);
    TW_BAR(3);
    s16x4 vlo[8], vhi[8]; u32x4 pw0, pw1, pw2, pw3;
#define TPKW(P, B) cvt_pk_bf16(P[B], P[B + 1])
#define TPAF(k) __builtin_bit_cast(bf16x8, pw##k)
#define TVFR(i) (bf16x8){vlo[i][0], vlo[i][1], vlo[i][2], vlo[i][3], vhi[i][0], vhi[i][1], vhi[i][2], vhi[i][3]}
#define TPIN(x) asm volatile("" : "+v"(x))
#define TGAPA(MF, A0, A1, A2, A3, W0, W1, PW) do { MF; sacc += A0; sacc += A1; sacc += A2; sacc += A3; TPIN(sacc); W0; W1; TPIN(PW); TSB(); } while (0)
#define TEX(v) __builtin_amdgcn_exp2f(v)
#define TGAPB(MF, X, B) do { MF; X[B] = TEX(X[B]); X[B + 1] = TEX(X[B + 1]); X[B + 2] = TEX(X[B + 2]); X[B + 3] = TEX(X[B + 3]); TPIN(X); TSB(); } while (0)
#define TVRD(i) do { vlo[i] = vtr(vp_ + (((i) >> 2) * 4096 + ((i) & 3) * 1024)); vhi[i] = vtr(vp_ + (((i) >> 2) * 4096 + ((i) & 3) * 1024 + 512)); } while (0)
#define TKRD(G, j) do { if (G) { kload2(kf, kp0 + sl_next * T_KSLOT, j); TSB(); } } while (0)
#define TMF(a, b, c) __builtin_amdgcn_mfma_f32_32x32x16_bf16(a, b, c, 0, 0, 0)
#define TSTEP(C0, C1, P0, P1, i_, MJB, GK, GV, GL) do { TSB(); \
        const lds_cptr vp_ = vp0 + sl_prev * T_VSLOT; \
        TVRD(0); TSB(); float sacc = (P0[0] + P0[1]); \
        TGAPA(C0 = TMF(kf[0], qr[0], TCIN(C0)), P0[2], P0[3], P0[4], P0[5],     pw0[0] = TPKW(P0, 0), pw0[1] = TPKW(P0, 2), pw0); \
        TVRD(4); TSB(); TGAPA(C1 = TMF(kf[1], qr[0], TCIN(C1)), P0[6], P0[7], P0[8], P0[9],     pw0[2] = TPKW(P0, 4), pw0[3] = TPKW(P0, 6), pw0); \
        TVRD(1); TSB(); TGAPA(C0 = TMF(kf[2], qr[1], C0),   P0[10], P0[11], P0[12], P0[13], pw1[0] = TPKW(P0, 8), pw1[1] = TPKW(P0, 10), pw1); \
        TVRD(5); TSB(); TGAPA(C1 = TMF(kf[3], qr[1], C1),   P0[14], P0[15], P1[0], P1[1],   pw1[2] = TPKW(P0, 12), pw1[3] = TPKW(P0, 14), pw1); \
        TVRD(2); TSB(); TGAPA(C0 = TMF(kf[4], qr[2], C0),   P1[2], P1[3], P1[4], P1[5],     pw2[0] = TPKW(P1, 0), pw2[1] = TPKW(P1, 2), pw2); \
        TVRD(6); TSB(); TGAPA(C1 = TMF(kf[5], qr[2], C1),   P1[6], P1[7], P1[8], P1[9],     pw2[2] = TPKW(P1, 4), pw2[3] = TPKW(P1, 6), pw2); \
        TVRD(3); TSB(); TGAPA(C0 = TMF(kf[6], qr[3], C0),   P1[10], P1[11], P1[12], P1[13], pw3[0] = TPKW(P1, 8), pw3[1] = TPKW(P1, 10), pw3); \
        TVRD(7); TSB(); TGAPA(C1 = TMF(kf[7], qr[3], C1),   P1[14], P1[15], 0.f, 0.f,       pw3[2] = TPKW(P1, 12), pw3[3] = TPKW(P1, 14), pw3); \
        if (ND0 == 6) { C0 = TMF(kf[2 * ND0 - 4], qr[ND0 - 2], C0); C1 = TMF(kf[2 * ND0 - 3], qr[ND0 - 2], C1); C0 = TMF(kf[2 * ND0 - 2], qr[ND0 - 1], C0); C1 = TMF(kf[2 * ND0 - 1], qr[ND0 - 1], C1); TSB(); } \
        l_reg += sacc; \
        if (GK) { TDMA_K((i_) + 3, sl_cur); } if (GV) { TDMA_V((i_) + 1, sl_next); } \
        if ((MJB) >= 0) cmask(C0, C1, (MJB), qrel, hi); \
        TDECIDE(C0, C1, i_); \
        TSB(); \
        TGAPB(o[0] = TMF(TPAF(0), TVFR(0), o[0]), C0, 0); \
        TKRD(GL, 0); TGAPB(o[1] = TMF(TPAF(0), TVFR(4), o[1]), C0, 4); \
        TKRD(GL, 1); TGAPB(o[0] = TMF(TPAF(1), TVFR(1), o[0]), C0, 8); \
        TKRD(GL, 2); TGAPB(o[1] = TMF(TPAF(1), TVFR(5), o[1]), C0, 12); \
        TKRD(GL, 3); TGAPB(o[0] = TMF(TPAF(2), TVFR(2), o[0]), C1, 0); \
        if (ND0 == 6) { TKRD(GL, ND0 - 2); } TGAPB(o[1] = TMF(TPAF(2), TVFR(6), o[1]), C1, 4); \
        if (ND0 == 6) { TKRD(GL, ND0 - 1); } TGAPB(o[0] = TMF(TPAF(3), TVFR(3), o[0]), C1, 8); \
        TGAPB(o[1] = TMF(TPAF(3), TVFR(7), o[1]), C1, 12); \
        if (GL) { TBIAS(P0, P1, sl_next); } \
    } while (0)
#define TENDW(tt) do { if ((tt) + 3 < NT) { TW_BAR(3); } else if ((tt) + 2 < NT) { TW_BAR(1); } else { TW_BAR(0); } } while (0)
    TSTEP(pB0, pB1, pA0, pA1, 1, 2, (1 + 3 < NT), true, true); TENDW(1); TRESC(); TROT();
    TSTEP(pA0, pA1, pB0, pB1, 2, 1, (2 + 3 < NT), true, true); TENDW(2); TRESC(); TROT();
    {
        TSTEP(pB0, pB1, pA0, pA1, 3, 0, (3 + 3 < NT), true, true); TENDW(3); TRESC(); TROT();
        int i = 4;
        for (; i + 2 < NT; i += 2) {
            TSTEP(pA0, pA1, pB0, pB1, i, -1, (i + 3 < NT), true, true);                         TENDW(i);     TRESC(); TROT();
            TSTEP(pB0, pB1, pA0, pA1, i + 1, -1, (i + 4 < NT), (i + 2 < NT), (i + 2 < NT));     TENDW(i + 1); TRESC(); TROT();
        }
        TSTEP(pA0, pA1, pB0, pB1, NT - 2, -1, false, true, true); TENDW(NT - 2); TRESC(); TROT();
        TSTEP(pB0, pB1, pA0, pA1, NT - 1, -1, false, false, false); TRESC();
    }
    { float sacc = pB0[0] + pB0[1];
#pragma unroll
      for (int r = 2; r < 16; ++r) sacc += pB0[r];
#pragma unroll
      for (int r = 0; r < 16; ++r) sacc += pB1[r];
      l_reg += sacc;
      pw0 = (u32x4){TPKW(pB0, 0), TPKW(pB0, 2), TPKW(pB0, 4), TPKW(pB0, 6)}; pw1 = (u32x4){TPKW(pB0, 8), TPKW(pB0, 10), TPKW(pB0, 12), TPKW(pB0, 14)};
      pw2 = (u32x4){TPKW(pB1, 0), TPKW(pB1, 2), TPKW(pB1, 4), TPKW(pB1, 6)}; pw3 = (u32x4){TPKW(pB1, 8), TPKW(pB1, 10), TPKW(pB1, 12), TPKW(pB1, 14)};
      TSB(); pv(o, vb0 + sl_cur * T_VSLOT, TPAF(0), TPAF(1), TPAF(2), TPAF(3)); }
    { auto rr = __builtin_amdgcn_permlane32_swap(__float_as_uint(l_reg), __float_as_uint(l_reg), false, false); l_reg = __uint_as_float(rr[0]) + __uint_as_float(rr[1]); }
    if (hi == 0) wsf[32 + r32] = l_reg; asm volatile("s_waitcnt lgkmcnt(0)" ::: "memory");
    float rli[16];
#pragma unroll
    for (int r = 0; r < 16; ++r) rli[r] = __builtin_amdgcn_rcpf(wsf[32 + crow(r, hi)]);
    unsigned char* Ow = (unsigned char*)O + (rowbase + q0 + wid * 32) * OP + h * 64;
    { LAS unsigned char* stg = lds + T_OST + wid * 4096;
#pragma unroll
      for (int r = 0; r < 16; ++r) { const int orow = crow(r, hi);
#pragma unroll
          for (int d0 = 0; d0 < 2; ++d0) { const float ov = o[d0][r] * rli[r] * OSCALE8; stg[orow * 64 + d0 * 32 + r32] = (unsigned char)__builtin_amdgcn_cvt_pk_fp8_f32(ov, ov, 0, false); } }
      asm volatile("s_waitcnt lgkmcnt(0)" ::: "memory");
#pragma unroll
      for (int i = 0; i < 2; ++i) { const int row = i * 16 + (lane >> 2), ch = lane & 3; const u32x4 v = *(const LAS u32x4*)(stg + row * 64 + ch * 16); *(u32x4*)(Ow + (long)row * OP + ch * 16) = v; } }
    asm volatile("s_waitcnt lgkmcnt(0)\n\ts_barrier" ::: "memory");
#undef TDMA_K
#undef TDMA_V
#undef TROT
#undef TBIAS
#undef TCIN
#undef TRESC
#undef TDECIDE
#undef TPKW
#undef TPAF
#undef TVFR
#undef TPIN
#undef TGAPA
#undef TEX
#undef TGAPB
#undef TVRD
#undef TKRD
#undef TMF
#undef TSTEP
#undef TENDW
}
#undef TW_BAR
#undef TSB
}

namespace dn {
constexpr int CHB = 64 * 256;
constexpr int NSLOT = 8, AHEAD = 7;
__device__ __forceinline__ int nloc(int i) { return 16 * ((i >> 2) & 1) + (i & 3) + 4 * (i >> 3); }
template <bool NOTRAFFIC>
__device__ __forceinline__ void down_phase(LAS unsigned char* lds, const unsigned char* HBp, const unsigned char* Wd, const unsigned char* Wsd, volatile LAS int* tab, const u32x2* meta, unsigned char* Yp, unsigned char* trash, int G, int c) {
    int tid = threadIdx.x; asm volatile("" : "+v"(tid));
    const int wid = __builtin_amdgcn_readfirstlane(tid >> 6), lane = tid & 63, j = lane & 31, hi = lane >> 5;
    const int U = tab[65] * 8;
    const int u_lo = (int)(((long)c * U) / G), u_hi = (int)(((long)(c + 1) * U) / G);
    if (u_lo >= u_hi) return;
#define DN_DEC(u_, e_, hf_, ci_) do { e_ = __builtin_amdgcn_readfirstlane(tab[132 + ((u_) >> 3)]); const int ul_ = __builtin_amdgcn_readfirstlane((u_) - 8 * tab[e_]), nc_ = __builtin_amdgcn_readfirstlane(4 * (tab[e_ + 1] - tab[e_])); hf_ = (ul_ >= nc_) ? 1 : 0; ci_ = ul_ - hf_ * nc_; } while (0)
    unsigned dvo; { const int r_ = lane >> 3, f_ = ((r_ >> 1) & 3) << 1; dvo = (unsigned)(r_ * 256 + (((lane & 7) ^ f_) * 16)); }
#define DN_DMA(u_, buf_) do { int e__, hf__, ci__; DN_DEC(u_, e__, hf__, ci__); (void)hf__; const unsigned char* gb_ = HBp + ((size_t)tab[e__] * 256 + (size_t)ci__ * 64) * DEXP; \
        _Pragma("unroll") for (int i_ = 0; i_ < 2; ++i_) { const int q_ = wid * 2 + i_, kb_ = q_ >> 3, g_ = q_ & 7; \
            __builtin_amdgcn_global_load_lds((const unsigned*)(gb_ + (size_t)(8 * g_) * DEXP + kb_ * 128 + dvo), (LAS unsigned*)(lds + (buf_) * CHB + kb_ * 8192 + g_ * 1024), 16, 0, 0); } } while (0)
    int rowb[2], fx[2];
#pragma unroll
    for (int rt = 0; rt < 2; ++rt) { const int row = 32 * rt + j; rowb[rt] = (int)(uintptr_t)lds + row * 128; fx[rt] = (((row >> 1) & 3) << 1) * 16; }
    unsigned sc1 = 0x7f7f7f7fu; asm volatile("" : "+v"(sc1));
#pragma unroll
    for (int p = 0; p < AHEAD; ++p) { const int un = (u_lo + p < u_hi) ? u_lo + p : u_lo; DN_DMA(un, p); }
    int u = u_lo;
    while (u < u_hi) {
      int e, hf, ci0; DN_DEC(u, e, hf, ci0);
      const int nc = __builtin_amdgcn_readfirstlane(4 * (tab[e + 1] - tab[e])), ne = __builtin_amdgcn_readfirstlane(tab[66 + e]);
      int seg_end = 8 * tab[e] + (hf + 1) * nc; seg_end = __builtin_amdgcn_readfirstlane(seg_end < u_hi ? seg_end : u_hi);
      v8i32_t wfr[2][4];
#pragma unroll
      for (int nt = 0; nt < 2; ++nt) { const unsigned char* wp = ((e == NEXP) ? Wsd : Wd + (size_t)e * D * DEXP) + (size_t)(512 * hf + 64 * wid + 32 * nt + nloc(j)) * DEXP + 32 * hi;
#pragma unroll
          for (int ks = 0; ks < 4; ++ks) { wfr[nt][ks].lo = *(const v4i32_t*)(wp + 64 * ks); wfr[nt][ks].hi = *(const v4i32_t*)(wp + 64 * ks + 16); } }
      bool first = true;
      for (; u < seg_end; ++u) {
        const int buf = (u - u_lo) & (NSLOT - 1); (void)ci0;
        const int cidx = __builtin_amdgcn_readfirstlane((u - 8 * tab[e]) - hf * nc);
        u32x2 mt[2];
#pragma unroll
        for (int rt = 0; rt < 2; ++rt) { int pos = 64 * cidx + 32 * rt + j; const bool in = pos < ne; const int sp = pos; pos = (in && e != NEXP) ? pos : 0; const u32x2 m = meta[(size_t)(e == NEXP ? 0 : e) * LISTCAP + pos];
            mt[rt] = !in ? (u32x2){0xffffffffu, 0u} : (e == NEXP) ? (u32x2){(unsigned)(sp * (TOPK + 1) + TOPK), 0x3f800000u} : m; }
        if (first) { __builtin_amdgcn_s_waitcnt(0x0F70); first = false; }
        else { asm volatile("s_waitcnt vmcnt(54)" ::: "memory"); }
        LDS_WAIT(); __builtin_amdgcn_s_barrier();
        { const int un = (u + AHEAD < u_hi) ? u + AHEAD : u; DN_DMA(un, (buf + AHEAD) & (NSLOT - 1)); }
        f32x16 acc[2][2];
#pragma unroll
        for (int rt = 0; rt < 2; ++rt)
#pragma unroll
            for (int nt = 0; nt < 2; ++nt) asm volatile("v_mov_b32 %0, 0\n\tv_mov_b32 %1, 0\n\tv_mov_b32 %2, 0\n\tv_mov_b32 %3, 0\n\tv_mov_b32 %4, 0\n\tv_mov_b32 %5, 0\n\tv_mov_b32 %6, 0\n\tv_mov_b32 %7, 0\n\tv_mov_b32 %8, 0\n\tv_mov_b32 %9, 0\n\tv_mov_b32 %10, 0\n\tv_mov_b32 %11, 0\n\tv_mov_b32 %12, 0\n\tv_mov_b32 %13, 0\n\tv_mov_b32 %14, 0\n\tv_mov_b32 %15, 0"
                : "=v"(acc[rt][nt][0]), "=v"(acc[rt][nt][1]), "=v"(acc[rt][nt][2]), "=v"(acc[rt][nt][3]), "=v"(acc[rt][nt][4]), "=v"(acc[rt][nt][5]), "=v"(acc[rt][nt][6]), "=v"(acc[rt][nt][7]),
                  "=v"(acc[rt][nt][8]), "=v"(acc[rt][nt][9]), "=v"(acc[rt][nt][10]), "=v"(acc[rt][nt][11]), "=v"(acc[rt][nt][12]), "=v"(acc[rt][nt][13]), "=v"(acc[rt][nt][14]), "=v"(acc[rt][nt][15]));
        v8i32_t ha0, ha1, hb0, hb1;
        const int ad0 = rowb[0] + buf * CHB, ad1 = rowb[1] + buf * CHB;
#define DN_RDA(ks_) do { \
            asm volatile("ds_read_b128 v[192:195], %1 offset:%c2\n\tds_read_b128 v[196:199], %1 offset:%c3" : "={v[192:199]}"(ha0) : "v"(ad0 + ((64 * ((ks_) & 1) + 32 * hi) ^ fx[0])), "i"(((ks_) >> 1) * 8192), "i"(((ks_) >> 1) * 8192 + 16) : "memory"); \
            asm volatile("ds_read_b128 v[200:203], %1 offset:%c2\n\tds_read_b128 v[204:207], %1 offset:%c3" : "={v[200:207]}"(ha1) : "v"(ad1 + ((64 * ((ks_) & 1) + 32 * hi) ^ fx[1])), "i"(((ks_) >> 1) * 8192), "i"(((ks_) >> 1) * 8192 + 16) : "memory"); } while (0)
#define DN_RDB(ks_) do { \
            asm volatile("ds_read_b128 v[208:211], %1 offset:%c2\n\tds_read_b128 v[212:215], %1 offset:%c3" : "={v[208:215]}"(hb0) : "v"(ad0 + ((64 * ((ks_) & 1) + 32 * hi) ^ fx[0])), "i"(((ks_) >> 1) * 8192), "i"(((ks_) >> 1) * 8192 + 16) : "memory"); \
            asm volatile("ds_read_b128 v[216:219], %1 offset:%c2\n\tds_read_b128 v[220:223], %1 offset:%c3" : "={v[216:223]}"(hb1) : "v"(ad1 + ((64 * ((ks_) & 1) + 32 * hi) ^ fx[1])), "i"(((ks_) >> 1) * 8192), "i"(((ks_) >> 1) * 8192 + 16) : "memory"); } while (0)
#define DN_MF(W_, ACC_, H_, REG_, WAIT_) asm volatile(WAIT_ "v_mfma_scale_f32_32x32x64_f8f6f4 %0, %1, %2, %0, %3, %3 op_sel_hi:[0,0,0]" : "+v"(ACC_) : "v"(W_), REG_(H_), "v"(sc1))
        DN_RDA(0);
#pragma unroll
        for (int ks = 0; ks < 4; ks += 2) {
            DN_RDB(ks + 1);
            DN_MF(wfr[0][ks], acc[0][0], ha0, "{v[192:199]}", "s_waitcnt lgkmcnt(4)\n\t"); DN_MF(wfr[1][ks], acc[0][1], ha0, "{v[192:199]}", "");
            DN_MF(wfr[0][ks], acc[1][0], ha1, "{v[200:207]}", ""); DN_MF(wfr[1][ks], acc[1][1], ha1, "{v[200:207]}", "");
            if (ks + 2 < 4) { DN_RDA(ks + 2);
                DN_MF(wfr[0][ks + 1], acc[0][0], hb0, "{v[208:215]}", "s_waitcnt lgkmcnt(4)\n\t"); }
            else { DN_MF(wfr[0][ks + 1], acc[0][0], hb0, "{v[208:215]}", "s_waitcnt lgkmcnt(0)\n\t"); }
            DN_MF(wfr[1][ks + 1], acc[0][1], hb0, "{v[208:215]}", "");
            DN_MF(wfr[0][ks + 1], acc[1][0], hb1, "{v[216:223]}", ""); DN_MF(wfr[1][ks + 1], acc[1][1], hb1, "{v[216:223]}", "");
        }
#undef DN_RDA
#undef DN_RDB
#undef DN_MF
        asm volatile("s_nop 15\n\ts_nop 7" : "+v"(acc[0][0]), "+v"(acc[0][1]), "+v"(acc[1][0]), "+v"(acc[1][1]) :: "memory");
        __builtin_amdgcn_sched_barrier(0);
        const int col0 = 512 * hf + 64 * wid + 16 * hi;
#pragma unroll
        for (int rt = 0; rt < 2; ++rt) { const bool ok = !NOTRAFFIC && mt[rt].x != 0xffffffffu; unsigned char* yd = ok ? Yp + (size_t)mt[rt].x * D : trash; const float w = ok ? __uint_as_float(mt[rt].y) * (1.f / (HSCALE8 * WSCALE8)) : 0.f;
#pragma unroll
            for (int nt = 0; nt < 2; ++nt) { u32x4 o;
#pragma unroll
                for (int q = 0; q < 4; ++q) { int v = __builtin_amdgcn_cvt_pk_fp8_f32(acc[rt][nt][4 * q] * w, acc[rt][nt][4 * q + 1] * w, 0, false);
                    v = __builtin_amdgcn_cvt_pk_fp8_f32(acc[rt][nt][4 * q + 2] * w, acc[rt][nt][4 * q + 3] * w, v, true); o[q] = (unsigned)v; }
                *(u32x4*)(yd + col0 + 32 * nt) = o; } }
      }
    }
    VM_WAIT(); LDS_WAIT(); __builtin_amdgcn_s_barrier();
#undef DN_DMA
#undef DN_DEC
}
}

namespace up {
__device__ __forceinline__ int nloc(int i) { return 16 * ((i >> 2) & 1) + (i & 3) + 4 * (i >> 3); }
__device__ __forceinline__ void up_phase(LAS unsigned char* lds, const bf16* QL, const bf16* KVL, const bf16* Wq, const bf16* Wkv, const float* ssqq, const float* ssqkv, const float* ropetab,
                                         bf16* Qo, bf16* KNo, bf16* VMo, int G, int c) {
    int tid = threadIdx.x; asm volatile("" : "+v"(tid));
    const int wid = __builtin_amdgcn_readfirstlane(tid >> 6), lane = tid & 63, j = lane & 31, hi = lane >> 5;
    for (int grp = c; grp < T / 64; grp += G) {
        const int row0 = grp * 64;
        { const int r_ = lane >> 3, p_ = lane & 7;
#pragma unroll
          for (int i = 0; i < 6; ++i) { const int q_ = wid * 6 + i;
              const bool isq = q_ < 32; const int rem = isq ? q_ : q_ - 32, kb = rem >> 3, g = rem & 7, f_ = (4 * (g & 1) + (r_ >> 1)) & 7;
              __builtin_amdgcn_global_load_lds((const unsigned*)((isq ? QL : KVL) + (size_t)(row0 + 8 * g + r_) * 256 + kb * 64 + ((p_ ^ f_) * 8)), (LAS unsigned*)(lds + (isq ? 0 : 32768) + kb * 8192 + g * 1024), 16, 0, 0); } }
        float rsq[2], rskv[2];
#pragma unroll
        for (int rt = 0; rt < 2; ++rt) { const int row = row0 + 32 * rt + j; const f32x4 a = *(const f32x4*)(ssqq + (size_t)row * 4), b4 = *(const f32x4*)(ssqkv + (size_t)row * 4);
            rsq[rt] = rsqrtf(((a[0] + a[1]) + (a[2] + a[3])) * (1.f / QLORA) + EPS) * C2M; rskv[rt] = rsqrtf(((b4[0] + b4[1]) + (b4[2] + b4[3])) * (1.f / KVLORA) + EPS); }
        const unsigned lane16 = (unsigned)lane * 16u;
        bf16x8 wA[16];
#define UP_LOADW(WB_, Wp_, col_, KS_) do { const char* wb_ = (const char*)(Wp_) + (size_t)__builtin_amdgcn_readfirstlane((col_) >> 5) * (KS_) * 1024;     \
            _Pragma("unroll") for (int ks = 0; ks < (KS_); ++ks) wA[(WB_) + ks] = *(const bf16x8*)(wb_ + ks * 1024 + lane16); } while (0)
#define UP_STEP(WB_, ISQ_, col_, KS_) do { f32x16 acc[2]; acc[0] = f32x16{}; acc[1] = f32x16{}; \
            _Pragma("unroll") for (int ks = 0; ks < (KS_); ++ks) { bf16x8 af[2]; \
                _Pragma("unroll") for (int rt = 0; rt < 2; ++rt) { const int row = 32 * rt + j, cc = 2 * (ks & 3) + hi; \
                    af[rt] = *(const LAS bf16x8*)(lds + ((ISQ_) ? 0 : 32768) + (ks >> 2) * 8192 + row * 128 + ((cc ^ ((row >> 1) & 7)) * 16)); } \
                _Pragma("unroll") for (int rt = 0; rt < 2; ++rt) acc[rt] = __builtin_amdgcn_mfma_f32_32x32x16_bf16(wA[(WB_) + ks], af[rt], acc[rt], 0, 0, 0); } \
            _Pragma("unroll") for (int rt = 0; rt < 2; ++rt) { const int row = row0 + 32 * rt + j; const float r_s = (ISQ_) ? rsq[rt] : rskv[rt]; const int col = (col_) + 16 * hi; \
                float v[16]; _Pragma("unroll") for (int r = 0; r < 16; ++r) v[r] = acc[rt][r] * r_s; \
                bf16* dst; \
                if (ISQ_) { const int jh = col % MQK; \
                    if (jh >= 64) { const int g0 = (jh - 64) >> 3; const f32x4* tb = (const f32x4*)(ropetab + ((size_t)row * 16 + 4 * g0) * 2); \
                        _Pragma("unroll") for (int gg = 0; gg < 2; ++gg) { const f32x4 t0 = tb[2 * gg], t1 = tb[2 * gg + 1]; float* w_ = v + 8 * gg; \
                            const float cs[4] = {t0[0], t0[2], t1[0], t1[2]}, sn[4] = {t0[1], t0[3], t1[1], t1[3]}; \
                            _Pragma("unroll") for (int q = 0; q < 4; ++q) { const float x1 = w_[q], x2 = w_[4 + q]; w_[q] = x1 * cs[q] - x2 * sn[q]; w_[4 + q] = x2 * cs[q] + x1 * sn[q]; } } } \
                    dst = Qo + (size_t)row * 768 + col; } \
                else dst = (col >= 512 ? VMo + (col - 512) : KNo + col) + (size_t)row * 512; \
                *(u32x4*)dst = (u32x4){cvt_pk_bf16(v[0], v[1]), cvt_pk_bf16(v[2], v[3]), cvt_pk_bf16(v[4], v[5]), cvt_pk_bf16(v[6], v[7])}; \
                *(u32x4*)(dst + 8) = (u32x4){cvt_pk_bf16(v[8], v[9]), cvt_pk_bf16(v[10], v[11]), cvt_pk_bf16(v[12], v[13]), cvt_pk_bf16(v[14], v[15])}; } } while (0)
        const int cq = 96 * wid, ckv = 128 * wid;
#define UP_SB() __builtin_amdgcn_sched_barrier(0)
        UP_LOADW(0, Wq, cq, 16);
        VM_WAIT(); __syncthreads();
        UP_STEP(0, true, cq, 16);        UP_SB(); UP_LOADW(0, Wq, cq + 32, 16); UP_SB();
        UP_STEP(0, true, cq + 32, 16);   UP_SB(); UP_LOADW(0, Wq, cq + 64, 16); UP_SB();
        UP_STEP(0, true, cq + 64, 16);   UP_SB(); UP_LOADW(0, Wkv, ckv, 8); UP_LOADW(8, Wkv, ckv + 32, 8); UP_SB();
        UP_STEP(0, false, ckv, 8);       UP_SB(); UP_LOADW(0, Wkv, ckv + 64, 8); UP_SB();
        UP_STEP(8, false, ckv + 32, 8);  UP_SB(); UP_LOADW(8, Wkv, ckv + 96, 8); UP_SB();
        UP_STEP(0, false, ckv + 64, 8);  UP_SB();
        UP_STEP(8, false, ckv + 96, 8);
#undef UP_SB
#undef UP_LOADW
#undef UP_STEP
        __syncthreads();
    }
}
}

#define XB_TMO      128
#define XB_XCNT(j)  (256  + 64 * (j))
#define XB_XSUB(j)  (1280 + 64 * (j))
#define XB_XGEN(j)  (2304 + 64 * (j))
#define XB_TOP      3328
#define XB_TOPGEN   3392
#define XCD_BAR_WORDS 3456
#define XB_SPIN_CAP (1u << 18)
__device__ __forceinline__ unsigned xb_ld(unsigned* p)              { return __hip_atomic_load(p, __ATOMIC_RELAXED, __HIP_MEMORY_SCOPE_AGENT); }
__device__ __forceinline__ unsigned xb_add(unsigned* p, unsigned v) { return __hip_atomic_fetch_add(p, v, __ATOMIC_RELAXED, __HIP_MEMORY_SCOPE_AGENT); }
__device__ __forceinline__ unsigned xb_xcc_id() { return (unsigned)__builtin_amdgcn_s_getreg((3 << 11) | 20) & 0xFu; }
#define XB_SPIN(cond, bar) do { unsigned _sp = 0; while (cond) { __builtin_amdgcn_s_sleep(1); \
    if ((++_sp & 255u) == 0u) { if (xb_ld(&(bar)[XB_TMO])) break; if (_sp > XB_SPIN_CAP) { atomicAdd(&(bar)[XB_TMO], 1u); break; } } } } while (0)
struct XcdBarrier { unsigned* bar; unsigned x; volatile LAS unsigned* st; };
__device__ __forceinline__ XcdBarrier xcd_barrier_post(unsigned* bar, volatile LAS unsigned* st) {
    XcdBarrier b; b.bar = bar; b.x = xb_xcc_id(); b.st = st;
    if (threadIdx.x == 0) (void)xb_add(&bar[XB_XCNT(b.x)], 1u);
    return b;
}
__device__ __forceinline__ void xcd_barrier_complete(unsigned* bar, unsigned x, unsigned& nloc, unsigned& nx) {
    const unsigned G = gridDim.x * gridDim.y * gridDim.z;
    unsigned sum, cnt, mine, sp = 0u;
    for (;;) {
        sum = 0u; cnt = 0u; mine = 0u;
#pragma unroll
        for (unsigned j = 0; j < 16; ++j) { const unsigned c = xb_ld(&bar[XB_XCNT(j)]); sum += c; cnt += (c > 0u) ? 1u : 0u; mine = (j == x) ? c : mine; }
        if (sum == G) break;
        __builtin_amdgcn_s_sleep(1);
        if ((++sp & 255u) == 0u) { if (xb_ld(&bar[XB_TMO])) break; if (sp > XB_SPIN_CAP) { atomicAdd(&bar[XB_TMO], 1u); break; } }
    }
    nloc = mine > 0u ? mine : 1u; nx = cnt > 0u ? cnt : 1u;
}
__device__ __forceinline__ void xcd_barrier(const XcdBarrier& b) {
    asm volatile("s_waitcnt vmcnt(0)" ::: "memory");
    __syncthreads();
    if (threadIdx.x == 0) {
        unsigned* bar = b.bar;
        __builtin_amdgcn_s_waitcnt(0);
        unsigned nloc = b.st[0], nx = b.st[1];
        if (nloc == 0u) { xcd_barrier_complete(bar, b.x, nloc, nx); b.st[0] = nloc; b.st[1] = nx; }
        const unsigned old = xb_add(&bar[XB_XSUB(b.x)], 1u);
        const unsigned gen = old / nloc;
        if (old + 1u == (gen + 1u) * nloc) {
            __builtin_amdgcn_fence(__ATOMIC_RELEASE, "agent");
            asm volatile("s_waitcnt vmcnt(0)" ::: "memory");
            const unsigned og = xb_add(&bar[XB_TOP], 1u);
            const unsigned tg = og / nx;
            if (og + 1u == (tg + 1u) * nx) xb_add(&bar[XB_TOPGEN], 1u);
            else XB_SPIN(xb_ld(&bar[XB_TOPGEN]) == tg, bar);
            __builtin_amdgcn_fence(__ATOMIC_ACQUIRE, "agent");
            xb_add(&bar[XB_XGEN(b.x)], 1u);
            asm volatile("s_waitcnt vmcnt(0)" ::: "memory");
        } else {
            XB_SPIN(xb_ld(&bar[XB_XGEN(b.x)]) == gen, bar);
            __builtin_amdgcn_fence(__ATOMIC_ACQUIRE, "agent");
            asm volatile("s_waitcnt vmcnt(0)" ::: "memory");
        }
    }
    __syncthreads();
}

struct Args { const void* in[25]; float* out; unsigned char* ws; int ph_lo, ph_hi; };

struct Frame {
    LAS unsigned char* lds;
    int tid, lane, wave, vcu, G;
};

template <class ColFn>
__device__ __forceinline__ void cvt_item(int ldw, int Ksrc, const float* kscale, bf16* WT, int Kd, LAS float* scr, int kb, int nb, int lane, ColFn colp) {
    const int k0 = 64 * kb, n0 = 32 * nb;
    const float* cp = colp(n0 + (lane & 31));
    float vv[32], sv[32];
#pragma unroll
    for (int i = 0; i < 32; ++i) { const int k = k0 + 2 * i + (lane >> 5);
        vv[i] = (cp != nullptr && k < Ksrc) ? cp[(size_t)k * ldw] : 0.f;
        sv[i] = (kscale != nullptr && k < Ksrc) ? kscale[k] : 1.f; }
#pragma unroll
    for (int i = 0; i < 32; ++i) scr[(2 * i + (lane >> 5)) * 33 + (lane & 31)] = vv[i] * sv[i];
    LDS_WAIT(); asm volatile("" ::: "memory");
    const int c = lane & 7;
#pragma unroll
    for (int j = 0; j < 4; ++j) { const int n = (lane >> 3) + 8 * j; const LAS float* s = scr + (8 * c) * 33 + n;
        u32x4 o; o.x = pk2(s[0 * 33], s[1 * 33]); o.y = pk2(s[2 * 33], s[3 * 33]); o.z = pk2(s[4 * 33], s[5 * 33]); o.w = pk2(s[6 * 33], s[7 * 33]);
        *(u32x4*)(WT + (size_t)(n0 + n) * Kd + k0 + 8 * c) = o; }
    LDS_WAIT(); asm volatile("" ::: "memory");
}
__device__ __forceinline__ void cvt64_item(const float* src, int ldw, bf16* dst, int Kd, LAS unsigned char* scr, int lane) {
    f32x4 v[16];
    const float* sp = src + (size_t)(lane >> 4) * ldw + 4 * (lane & 15);
#pragma unroll
    for (int i = 0; i < 16; ++i) v[i] = __builtin_nontemporal_load((const f32x4*)(sp + (size_t)(4 * i) * ldw));
#pragma unroll
    for (int i = 0; i < 16; ++i) { const int k = 4 * i + (lane >> 4);
#pragma unroll
        for (int q = 0; q < 4; ++q) { const int n = 4 * (lane & 15) + q; *(LAS bf16*)(scr + n * 128 + (((k >> 3) ^ ((n >> 2) & 7)) << 4) + (k & 7) * 2) = (bf16)f2bf(v[i][q]); } }
    LDS_WAIT(); asm volatile("" ::: "memory");
#pragma unroll
    for (int j = 0; j < 8; ++j) { const int p = j * 64 + lane, n = p >> 3, c = p & 7;
        const u32x4 o = *(const LAS u32x4*)(scr + n * 128 + ((c ^ ((n >> 2) & 7)) << 4));
        __builtin_nontemporal_store(o, (u32x4*)(dst + (size_t)n * Kd + c * 8)); }
    LDS_WAIT(); asm volatile("" ::: "memory");
}
__device__ __forceinline__ void cvt64_item8(const float* src, int ldw, unsigned char* dst, int Kd8, LAS unsigned char* scr, int lane, float scale) {
    f32x4 v[16];
    const float* sp = src + (size_t)(16 * (lane >> 4)) * ldw + 4 * (lane & 15);
#pragma unroll
    for (int i = 0; i < 16; ++i) v[i] = __builtin_nontemporal_load((const f32x4*)(sp + (size_t)i * ldw));
#pragma unroll
    for (int q = 0; q < 4; ++q) { u32x4 o;
#pragma unroll
        for (int g = 0; g < 4; ++g) { int p_ = __builtin_amdgcn_cvt_pk_fp8_f32(v[4 * g][q] * scale, v[4 * g + 1][q] * scale, 0, false); p_ = __builtin_amdgcn_cvt_pk_fp8_f32(v[4 * g + 2][q] * scale, v[4 * g + 3][q] * scale, p_, true); o[g] = (unsigned)p_; }
        *(LAS u32x4*)(scr + (4 * (lane & 15) + q) * 80 + (lane >> 4) * 16) = o; }
    LDS_WAIT(); asm volatile("" ::: "memory");
#pragma unroll
    for (int j = 0; j < 4; ++j) { const int p = j * 64 + lane, n = p >> 2, c = p & 3;
        const u32x4 o = *(const LAS u32x4*)(scr + n * 80 + c * 16);
        __builtin_nontemporal_store(o, (u32x4*)(dst + (size_t)n * Kd8 + c * 16)); }
    LDS_WAIT(); asm volatile("" ::: "memory");
}
__device__ __forceinline__ void cvt128_item8(const float* src, int ldw, unsigned char* dst, int Kd8, LAS unsigned char* scr, int lane, float scale) {
    f32x4 v[32];
    const float* sp = src + (size_t)(32 * (lane >> 4)) * ldw + 4 * (lane & 15);
#pragma unroll
    for (int i = 0; i < 32; ++i) v[i] = __builtin_nontemporal_load((const f32x4*)(sp + (size_t)i * ldw));
#pragma unroll
    for (int q = 0; q < 4; ++q) {
#pragma unroll
        for (int hf = 0; hf < 2; ++hf) { u32x4 o;
#pragma unroll
            for (int g = 0; g < 4; ++g) { const int i0 = 16 * hf + 4 * g; int p_ = __builtin_amdgcn_cvt_pk_fp8_f32(v[i0][q] * scale, v[i0 + 1][q] * scale, 0, false); p_ = __builtin_amdgcn_cvt_pk_fp8_f32(v[i0 + 2][q] * scale, v[i0 + 3][q] * scale, p_, true); o[g] = (unsigned)p_; }
            *(LAS u32x4*)(scr + (4 * (lane & 15) + q) * 144 + (lane >> 4) * 32 + 16 * hf) = o; } }
    LDS_WAIT(); asm volatile("" ::: "memory");
#pragma unroll
    for (int j = 0; j < 8; ++j) { const int p = j * 64 + lane, n = p >> 3, c = p & 7;
        const u32x4 o = *(const LAS u32x4*)(scr + n * 144 + c * 16);
        __builtin_nontemporal_store(o, (u32x4*)(dst + (size_t)n * Kd8 + c * 16)); }
    LDS_WAIT(); asm volatile("" ::: "memory");
}
__device__ __forceinline__ int ropedim(int jj) { const int g = jj >> 3, u = jj & 7; return (u < 4) ? 4 * g + u : 16 + 4 * g + (u - 4); }

__device__ __forceinline__ void sincos_acc(float af, float& sn, float& cs) {
    const double a = (double)af; const double kq = __builtin_rint(a * 0.63661977236758134308);
    const double r = (a - kq * 1.57079632679489655800) - kq * 6.123233995736766036e-17;
    const double r2 = r * r;
    const double sp = r * (1.0 + r2 * (-1.66666666666666324348e-01 + r2 * (8.33333333332248946124e-03 + r2 * (-1.98412698298579493134e-04 + r2 * (2.75573137070700676789e-06 + r2 * (-2.50507602534068634195e-08 + r2 * 1.58969099521155010221e-10))))));
    const double cp = 1.0 + r2 * (-0.5 + r2 * (4.16666666666666019037e-02 + r2 * (-1.38888888888741095749e-03 + r2 * (2.48015872894767294178e-05 + r2 * (-2.75573143513906633035e-07 + r2 * (2.08757232129817482790e-09 + r2 * -1.13596475577881948265e-11))))));
    const int q = (int)((long long)kq & 3);
    const double s_ = (q == 0) ? sp : (q == 1) ? cp : (q == 2) ? -sp : -cp;
    const double c_ = (q == 0) ? cp : (q == 1) ? -sp : (q == 2) ? -cp : sp;
    sn = (float)s_; cs = (float)c_;
}

__global__ void __launch_bounds__(NWAVES * 64, 2) fwd(Args args) {
    extern __shared__ __attribute__((aligned(16))) unsigned char lds_raw[];
    Frame F;
    F.lds = (LAS unsigned char*)lds_raw;
    F.tid = threadIdx.x; F.lane = F.tid & 63; F.wave = __builtin_amdgcn_readfirstlane(F.tid >> 6);
    F.G = gridDim.x; { const int bx = blockIdx.x; F.vcu = (F.G % 8 == 0) ? (bx % 8) * (F.G / 8) + bx / 8 : bx; }
    volatile LAS unsigned* MISC = (volatile LAS unsigned*)(F.lds + MISC_OFF);
    unsigned char* ws = args.ws;
    gu32* ctl = (gu32*)(ws + WS_CTL);
#define X_IN ((const float*)AP->in[0])
#define cvec ((const float*)AP->in[1])
#define positions ((const int*)AP->in[2])
#define w_mod ((const float*)AP->in[3])
#define b_mod ((const float*)AP->in[4])
#define g_mix ((const float*)AP->in[5])
#define w_in ((const float*)AP->in[6])
#define b_forget ((const float*)AP->in[7])
#define g_q_lat ((const float*)AP->in[8])
#define w_q_up ((const float*)AP->in[9])
#define g_kv_lat ((const float*)AP->in[10])
#define w_kv_up ((const float*)AP->in[11])
#define w_o_mla ((const float*)AP->in[12])
#define w_o_fox ((const float*)AP->in[13])
#define w_out ((const float*)AP->in[14])
#define g_ffn ((const float*)AP->in[15])
#define w_router ((const float*)AP->in[16])
#define b_router ((const float*)AP->in[17])
#define w_exp_gate ((const float*)AP->in[18])
#define w_exp_up ((const float*)AP->in[19])
#define w_exp_down ((const float*)AP->in[20])
#define w_sh_gate ((const float*)AP->in[21])
#define w_sh_up ((const float*)AP->in[22])
#define w_sh_down ((const float*)AP->in[23])
#define g_final ((const float*)AP->in[24])
#define Win_t ((bf16*)(ws + WS_WIN))
#define Wq_t ((bf16*)(ws + WS_WQ))
#define Wkv_t ((bf16*)(ws + WS_WKV))
#define Wom_t ((bf16*)(ws + WS_WOM))
#define Wof_t ((bf16*)(ws + WS_WOF))
#define Wout_t ((bf16*)(ws + WS_WOUT))
#define Wsgu_t ((bf16*)(ws + WS_WSGU))
#define Wsd_t ((bf16*)(ws + WS_WSD))
#define Wr_f ((bf16*)(ws + WS_WR))
#define mod ((float*)(ws + WS_MOD))
#define Wd_t ((bf16*)(ws + WS_WD))
#define Wgu_t ((bf16*)(ws + WS_WGU))
#define HB ((bf16*)(ws + WS_HB))
#define FQ ((bf16*)(ws + WS_FQ))
#define FK ((bf16*)(ws + WS_FK))
#define FV ((bf16*)(ws + WS_FV))
#define QLAT ((bf16*)(ws + WS_QLAT))
#define KVLAT ((bf16*)(ws + WS_KVLAT))
#define OFOX ((bf16*)(ws + WS_OFOX))
#define OCAT ((bf16*)((unsigned char*)out + 32 * MiB))
#define OMLA ((bf16*)(ws + WS_OMLA))
#define Y ((bf16*)(ws + WS_Y))
#define H ((bf16*)(ws + WS_H))
#define QMLA ((bf16*)(ws + WS_QMLA))
#define GATES ((bf16*)(ws + WS_GATES))
#define KN ((bf16*)(ws + WS_KN))
#define VM ((bf16*)(ws + WS_VM))
#define KPE ((bf16*)(ws + WS_KPE))
#define MERGED ((bf16*)(ws + WS_MERGED))
#define LIST ((unsigned short*)(ws + WS_LIST))
#define Wgu8 ((unsigned char*)(ws + WS_WGU))
#define Wsgu8 ((unsigned char*)(ws + WS_WSGU))
#define H8 ((unsigned char*)(ws + WS_H))
#define META ((u32x2*)(ws + WS_WIN))
#define EIDX ((unsigned char*)(ws + WS_EIDX))
#define GATEW ((float*)(ws + WS_GATEW))
#define ROPETAB ((float*)((unsigned char*)out + DO_ROPE))
#define LOGF ((float*)((unsigned char*)out + DO_LOGF))
#define CUMF ((float*)((unsigned char*)out + DO_CUMF))
#define SSQQ ((float*)((unsigned char*)out + DO_SSQQ))
#define SSQKV ((float*)((unsigned char*)out + DO_SSQKV))
#define MODP ((float*)((unsigned char*)out + DO_MODP))
#define X1B ((bf16*)(ws + WS_X1B))
#define SSQ1 ((float*)(ws + WS_FQ))
    float* const out = args.out;
#define PHASE_ENV const __attribute__((address_space(4))) Args* AP; { auto kp_ = __builtin_amdgcn_kernarg_segment_ptr(); asm volatile("" : "+s"(kp_)); AP = (const __attribute__((address_space(4))) Args*)kp_; } \
    unsigned char* const ws = AP->ws; float* const out = AP->out; (void)ws; (void)out;
    for (int u = F.tid; u < (LDS_BYTES - LDSCTL_OFF) / 4; u += NWAVES * 64) ((LAS unsigned*)(F.lds + LDSCTL_OFF))[u] = 0u;
    __syncthreads();
    XcdBarrier bar; bar.bar = (unsigned*)(ctl + CW_BAR); bar.x = 0; bar.st = nullptr;
    if (MK_ONE_LAUNCH) bar = xcd_barrier_post((unsigned*)(ctl + CW_BAR), MISC + 8);
    const int lo = args.ph_lo, hi = args.ph_hi;
#define IN(k) (lo <= (k) && (k) < hi)
#define BOTH(k) (IN(k) && IN((k) + 1))
#define GRID_BAR() do { if (MK_ONE_LAUNCH) xcd_barrier(bar); } while (0)
#define DUP_BAR() do { if (dummy) xcd_barrier(bar); } while (0)
    const int gw = F.vcu * NWAVES + F.wave, NGW = F.G * NWAVES;

    for (int rep = 0; rep < ((PROBE_DUP == 0) ? 2 : 1); ++rep) if (IN(0)) { PHASE_ENV const bool dummy = (PROBE_DUP == 0) && rep == 0; (void)dummy;
        if (!(dummy && (PROBE_VAR == 1 || PROBE_VAR == 4 || PROBE_VAR == 5))) {
            LAS float* cond = (LAS float*)F.lds;
            for (int i = F.tid; i < NB * D; i += NWAVES * 64) { const float c = cvec[i]; cond[i] = c / (1.f + __expf(-c)); }
            __syncthreads();
            for (int it = F.wave * F.G + F.vcu; it < 96 * 16; it += NWAVES * F.G) { const int cg = it % 96, kq = it / 96, col = cg * 64 + F.lane;
                float a4[4] = {0.f, 0.f, 0.f, 0.f};
                const float* wp = w_mod + (size_t)(64 * kq) * (6 * D) + col;
                float wv[64];
#pragma unroll
                for (int kk = 0; kk < 64; ++kk) wv[kk] = __builtin_nontemporal_load(wp + (size_t)kk * (6 * D));
#pragma unroll
                for (int kk = 0; kk < 64; ++kk) {
#pragma unroll
                    for (int b = 0; b < 4; ++b) a4[b] += wv[kk] * cond[b * D + 64 * kq + kk]; }
#pragma unroll
                for (int b = 0; b < 4; ++b) MODP[((size_t)kq * 4 + b) * (6 * D) + col] = a4[b]; }
            __syncthreads();
        }
        if (!(dummy && (PROBE_VAR == 1 || PROBE_VAR == 3 || PROBE_VAR == 5))) for (int i = gw * 64 + F.lane; i < T * 16; i += NGW * 64) { const int t = i >> 4, j = i & 15;
            const float invf = (((j >> 2) == 0) ? 1.f : ((j >> 2) == 1) ? 0.1f : ((j >> 2) == 2) ? 0.01f : 0.001f) * (((j & 3) == 0) ? 1.f : ((j & 3) == 1) ? 0.5623413251903491f : ((j & 3) == 2) ? 0.31622776601683794f : 0.17782794100389228f);
            const float ang = (float)positions[t] * invf; float sn, cs; sincos_acc(ang, sn, cs);
            *(f32x2*)(ROPETAB + (size_t)i * 2) = (f32x2){cs, sn}; }
        for (int o = gw * 64 + F.lane; o < NEXP * D; o += NGW * 64) { const int piece = o >> 3, kk = o & 7, ln = piece & 63, grp = piece >> 6, ntl = grp & 3, j = grp >> 2;
            const int n = ntl * 16 + (ln & 15), k = j * 32 + (ln >> 4) * 8 + kk; Wr_f[o] = (bf16)f2bf(w_router[(size_t)k * NEXP + n]); }
        {
            LAS unsigned char* scr8 = F.lds + 32768 + F.wave * 9216;
            constexpr int F_IN = 62 * 16;
            if (!(dummy && PROBE_VAR >= 2)) for (int it = gw; it < F_IN; it += NGW) {
                int nb = it % 62; const int kb = it / 62; if (nb >= 6) nb += 2; const int n0 = 64 * nb;
                const int src = (n0 < 384) ? n0 : (n0 < 2048) ? 416 + (n0 - 512) : 1960 + (n0 - 2048);
                cvt64_item(w_in + (size_t)(64 * kb) * 4008 + src, 4008, Win_t + (size_t)n0 * D + 64 * kb, D, scr8, F.lane);
            }
            LAS float* scr = (LAS float*)(F.lds + 32768 + F.wave * 9216);
            constexpr int I_INS = 4 * (D / 64), NSLOW = I_INS;
            if (!(dummy && (PROBE_VAR == 1 || PROBE_VAR == 3 || PROBE_VAR == 4))) for (int it = F.wave * F.G + F.vcu; it < NSLOW; it += NGW) {
                const int nb = 12 + (it & 3), kb = it >> 2;
                cvt_item(4008, D, nullptr, Win_t, D, scr, kb, nb, F.lane, [&](int n) -> const float* {
                    int src; if (n < 416) src = 384 + ropedim(n - 384); else if (n < 424) src = 1952 + (n - 416); else src = -1;
                    return src < 0 ? nullptr : w_in + src; });
            }
            if (!(dummy && (PROBE_VAR == 1 || PROBE_VAR == 3 || PROBE_VAR == 4))) {
                for (int o = gw * 64 + F.lane; o < 768 * QLORA; o += NGW * 64) { const int cb = o >> 13, rem = o & 8191, ks = rem >> 9, ln = (rem >> 3) & 63, e = rem & 7;
                    const int n = cb * 32 + up::nloc(ln & 31), k = 16 * ks + 8 * (ln >> 5) + e, hh = n / MQK, jj = n % MQK, sc = hh * MQK + (jj < 64 ? jj : 64 + ropedim(jj - 64));
                    Wq_t[o] = (bf16)f2bf(w_q_up[(size_t)k * 768 + sc] * g_q_lat[k]); }
                for (int o = gw * 64 + F.lane; o < 1024 * KVLORA; o += NGW * 64) { const int cb = o >> 12, rem = o & 4095, ks = rem >> 9, ln = (rem >> 3) & 63, e = rem & 7;
                    const int n = cb * 32 + up::nloc(ln & 31), k = 16 * ks + 8 * (ln >> 5) + e, sc = (n < 512) ? (n >> 6) * 128 + (n & 63) : ((n - 512) >> 6) * 128 + 64 + (n & 63);
                    Wkv_t[o] = (bf16)f2bf(w_kv_up[(size_t)k * 1024 + sc] * g_kv_lat[k]); }
            }
        }
        if (BOTH(0)) GRID_BAR();
    }

    for (int rep = 0; rep < ((PROBE_DUP == 1) ? 2 : 1); ++rep) if (IN(1)) { PHASE_ENV const bool dummy = (PROBE_DUP == 1) && rep == 0; (void)dummy;
        if (F.vcu < 48) { const int idx = F.vcu * 512 + F.tid, b = idx / (6 * D), col = idx % (6 * D); float sm = b_mod[col];
#pragma unroll
            for (int p = 0; p < 16; ++p) sm += MODP[((size_t)p * 4 + b) * (6 * D) + col];
            mod[idx] = sm; }
        LAS float* vg1 = (LAS float*)F.lds; LAS float* vs1 = (LAS float*)(F.lds + 4096);
        for (int grp = F.vcu; grp < T / 64; grp += F.G) {
            const int b = (grp * 64) / SEQ;
            __syncthreads();
            for (int k = F.tid; k < D; k += NWAVES * 64) { float s0 = b_mod[k], s1 = b_mod[D + k];
#pragma unroll
                for (int p = 0; p < 16; ++p) { s0 += MODP[((size_t)p * 4 + b) * (6 * D) + k]; s1 += MODP[((size_t)p * 4 + b) * (6 * D) + D + k]; }
                vs1[k] = s0; vg1[k] = g_mix[k] * (1.f + s1); }
            __syncthreads();
#pragma unroll 2
            for (int rr = 0; rr < 8; ++rr) { const int m = grp * 64 + F.wave * 8 + rr;
                const f32x4* xr = (const f32x4*)(X_IN + (size_t)m * D) + F.lane;
                f32x4 v[4]; float s = 0.f;
#pragma unroll
                for (int j = 0; j < 4; ++j) { v[j] = __builtin_nontemporal_load(xr + 64 * j); s += (v[j].x * v[j].x + v[j].y * v[j].y) + (v[j].z * v[j].z + v[j].w * v[j].w); }
                const float rstd = rsqrtf(wave_sum(s) * (1.f / D) + EPS);
                unsigned long long* o8 = (unsigned long long*)(H + (size_t)m * D) + F.lane;
#pragma unroll
                for (int j = 0; j < 4; ++j) { const int c = 4 * F.lane + 256 * j;
                    const f32x4 g = *(const LAS f32x4*)(vg1 + c), d = *(const LAS f32x4*)(vs1 + c);
                    const f32x4 r = v[j] * rstd * g + d;
                    o8[64 * j] = (unsigned long long)pk2(r.x, r.y) | ((unsigned long long)pk2(r.z, r.w) << 32); } }
        }
        if (BOTH(1)) GRID_BAR();
    }

    for (int rep = 0; rep < ((PROBE_DUP == 2) ? 2 : 1); ++rep) if (IN(2)) { PHASE_ENV const bool dummy = (PROBE_DUP == 2) && rep == 0; (void)dummy;
        pg8::StaticOrder S; S.init(H, Win_t, T, NIN, D, F.G, (int)blockIdx.x);
        EpiInProj E{QLAT, KVLAT, KPE, FQ, GATES, LOGF, SSQQ, SSQKV, ROPETAB, b_forget, dummy && (PROBE_VAR == 1), (dummy && PROBE_VAR == 2) ? 0 : (dummy && PROBE_VAR == 3) ? 2 : 1};
        pg8::gemm_phase<EpiInProj, pg8::StaticOrder, true>(F.lds, S, E);
        if (BOTH(2)) GRID_BAR();
    }

    for (int rep = 0; rep < ((PROBE_DUP == 3) ? 2 : 1); ++rep) if (IN(3)) { PHASE_ENV const bool dummy = (PROBE_DUP == 3) && rep == 0; (void)dummy;
        if (!(dummy && (PROBE_VAR == 2 || PROBE_VAR == 3))) {
            const int bb = F.vcu & 3; float mx = 0.f, mq = 0.f;
            for (int r = (F.vcu >> 2) * NWAVES + F.wave; r < SEQ; r += (F.G >> 2) * NWAVES) { f32x4 k0, k1, q0v, q1v; unpack8(*(const u32x4*)(FK + ((size_t)bb * SEQ + r) * 512 + 8 * F.lane), k0, k1);
                unpack8(*(const u32x4*)(FQ + ((size_t)bb * SEQ + r) * 512 + 8 * F.lane), q0v, q1v);
                float sq = (k0[0] * k0[0] + k0[1] * k0[1]) + (k0[2] * k0[2] + k0[3] * k0[3]) + (k1[0] * k1[0] + k1[1] * k1[1]) + (k1[2] * k1[2] + k1[3] * k1[3]);
                float sqq = (q0v[0] * q0v[0] + q0v[1] * q0v[1]) + (q0v[2] * q0v[2] + q0v[3] * q0v[3]) + (q1v[0] * q1v[0] + q1v[1] * q1v[1]) + (q1v[2] * q1v[2] + q1v[3] * q1v[3]);
                sq += dppf<0xB1>(sq); sq += dppf<0x4E>(sq); sq += dppf<0x141>(sq);
                sqq += dppf<0xB1>(sqq); sqq += dppf<0x4E>(sqq); sqq += dppf<0x141>(sqq);
                mx = fmaxf(mx, sq); mq = fmaxf(mq, sqq); }
            LAS float* kml = (LAS float*)F.lds;
            if ((F.lane & 7) == 0) { kml[F.wave * 8 + (F.lane >> 3)] = mx; kml[64 + F.wave * 8 + (F.lane >> 3)] = mq; }
            __syncthreads();
            if (F.tid < 2 * NHEAD) { const int hh = F.tid & 7, qk = F.tid >> 3; float m2 = 0.f;
#pragma unroll
                for (int w = 0; w < NWAVES; ++w) m2 = fmaxf(m2, kml[qk * 64 + w * 8 + hh]);
                atomicMax((unsigned*)(ctl + CW_KM + qk * 32 + bb * NHEAD + hh), __float_as_uint(m2)); }
            __syncthreads();
        }
        if (F.vcu < NB * NHEAD && !(dummy && (PROBE_VAR == 1 || PROBE_VAR == 3))) {
            const int b = F.vcu >> 3, h = F.vcu & 7; const float* src = LOGF + ((size_t)b * SEQ + 8 * F.tid) * 8 + h;
            float v[8]; float run = 0.f;
#pragma unroll
            for (int i = 0; i < 8; ++i) v[i] = src[i * 8];
#pragma unroll
            for (int i = 0; i < 8; ++i) { run += v[i]; v[i] = run; }
            float incl = run;
#pragma unroll
            for (int o = 1; o < 64; o <<= 1) { const float n = __shfl_up(incl, o); if (F.lane >= o) incl += n; }
            LAS float* wt = (LAS float*)F.lds;
            if (F.lane == 63) wt[F.wave] = incl;
            __syncthreads();
            float woff = 0.f;
#pragma unroll
            for (int w = 0; w < NWAVES; ++w) woff += (w < F.wave) ? wt[w] : 0.f;
            const float excl = woff + incl - run;
            float* dst = CUMF + ((size_t)b * NHEAD + h) * SEQ + 8 * F.tid;
            *(f32x4*)dst = (f32x4){v[0] + excl, v[1] + excl, v[2] + excl, v[3] + excl}; *(f32x4*)(dst + 4) = (f32x4){v[4] + excl, v[5] + excl, v[6] + excl, v[7] + excl};
            __syncthreads();
        }
        if (!(dummy && (PROBE_VAR == 1 || PROBE_VAR == 2))) up::up_phase(F.lds, QLAT, KVLAT, Wq_t, Wkv_t, SSQQ, SSQKV, ROPETAB, QMLA, KN, VM, F.G, (int)blockIdx.x);
        if (BOTH(3)) GRID_BAR();
    }

    for (int rep = 0; rep < ((PROBE_DUP == 4) ? 2 : 1); ++rep) if (IN(4)) { PHASE_ENV const bool dummy = (PROBE_DUP == 4) && rep == 0; (void)dummy;
        {
            const bool xq = (F.G % 8) == 0; const int x = xq ? (int)(blockIdx.x & 7) : 0, nunits = xq ? 128 : 1024;
            constexpr int F_O = 16 * 4, F_OUT = 16 * 8, F_SGU = 8 * 8, F_SD = 16 * 2, F_EGU = NEXP * F_SGU, F_ED = NEXP * F_SD;
            constexpr int NCONV = F_EGU + F_ED + 2 * F_O + F_OUT + F_SGU + F_SD, NCBATCH = (NCONV + 31) / 32;
            const int NQ = xq ? 8 : 1, ncb = (NCBATCH - x + NQ - 1) / NQ, A0 = xq ? CONV_A0 : 8 * CONV_A0;
            gu32* qh = ctl + CW_Q + 64 * x + (dummy ? 16 : 0);
            volatile LAS unsigned* qw = (volatile LAS unsigned*)(F.lds + MISC_OFF + 64);
            for (int nit = 0;; ++nit) {
                if (F.tid == 0) qw[nit & 1] = __hip_atomic_fetch_add(qh, 1u, RLX_AGENT);
                __syncthreads();
                int r = __builtin_amdgcn_readfirstlane((int)qw[nit & 1]);
                if (r >= nunits + ncb) break;
                if (r >= A0 && r < A0 + ncb) { const int cb = x + NQ * (r - A0);
                    LAS unsigned char* scr8 = F.lds + 32768 + F.wave * 9216;
                    int ln_ = F.lane; asm volatile("" : "+v"(ln_));
                    for (int kr = 0; kr < 4; ++kr) { int it = 32 * cb + 8 * kr + F.wave; if (it >= NCONV) break;
                        const float* src; unsigned char* dst; int ldw, kd8;
                        if (it < F_EGU) { const int e = it / F_SGU, rr = it % F_SGU, nb = rr & 7, kb = rr >> 3, pn = nb >> 2, c0 = (nb & 3) * 64;
                            src = ((c0 < 128) ? w_exp_gate : w_exp_up) + (size_t)e * D * DEXP + pn * 128 + (c0 & 127) + (size_t)(128 * kb) * DEXP; ldw = DEXP;
                            dst = Wgu8 + (size_t)e * 512 * D + (size_t)(64 * nb) * D + 128 * kb; kd8 = D; }
                        else if ((it -= F_EGU) < F_ED) { const int e = it / F_SD, rr = it % F_SD, nb = rr & 15, kb = rr >> 4;
                            src = w_exp_down + (size_t)e * DEXP * D + (size_t)(128 * kb) * D + 64 * nb; ldw = D; dst = (unsigned char*)Wd_t + (size_t)e * D * DEXP + (size_t)(64 * nb) * DEXP + 128 * kb; kd8 = DEXP; }
                        else if ((it -= F_ED) < 2 * F_O) { const int fx = it >= F_O, i2 = it - (fx ? F_O : 0), nb = i2 & 15, kb = i2 >> 4;
                            src = (fx ? w_o_fox : w_o_mla) + (size_t)(128 * kb) * D + 64 * nb; ldw = D; dst = (unsigned char*)Wom_t + (size_t)(64 * nb) * D + (fx ? 512 : 0) + 128 * kb; kd8 = D; }
                        else if ((it -= 2 * F_O) < F_OUT) { const int nb = it & 15, kb = it >> 4; src = w_out + (size_t)(128 * kb) * D + 64 * nb; ldw = D; dst = (unsigned char*)Wout_t + (size_t)(64 * nb) * D + 128 * kb; kd8 = D; }
                        else if ((it -= F_OUT) < F_SGU) { const int nb = it >> 3, kb = it & 7, pn = nb >> 2, c0 = (nb & 3) * 64;
                            src = ((c0 < 128) ? w_sh_gate : w_sh_up) + pn * 128 + (c0 & 127) + (size_t)(128 * kb) * DEXP; ldw = DEXP; dst = Wsgu8 + (size_t)(64 * nb) * D + 128 * kb; kd8 = D; }
                        else { it -= F_SGU; const int nb = it >> 1, kb = it & 1; src = w_sh_down + (size_t)(128 * kb) * D + 64 * nb; ldw = D; dst = (unsigned char*)Wsd_t + (size_t)(64 * nb) * DEXP + 128 * kb; kd8 = DEXP; }
                        cvt128_item8(src, ldw, dst, kd8, scr8, ln_, WSCALE8);
                    }
                    continue; }
                if (r >= A0) r -= ncb;
                int qb, type, b, h;
                if (xq) { qb = 15 - (r >> 3); type = (r >> 2) & 1; b = r & 3; h = (x + 3 * b) & 7; }
                else { qb = 15 - (r >> 6); type = (r >> 5) & 1; b = (r >> 3) & 3; h = r & 7; }
                if (type == 0) { if (ATT_TUNED_FOX && qb != 0) att::attn_unit_t<64, true, 8>(b, h, qb, FQ, 512, FK, KPE, FV, CUMF, __uint_as_float(__hip_atomic_load((unsigned*)(ctl + CW_KM + b * NHEAD + h), RLX_AGENT)) * __uint_as_float(__hip_atomic_load((unsigned*)(ctl + CW_KM + 32 + b * NHEAD + h), RLX_AGENT)), (bf16*)((unsigned char*)(dummy ? (bf16*)((unsigned char*)out + 4 * MiB) : OCAT) + 512), D, F.lds);
                                 else att::attn_unit<64, true, 8>(b, h, qb, FQ, 512, FK, KPE, FV, CUMF, (bf16*)((unsigned char*)(dummy ? (bf16*)((unsigned char*)out + 4 * MiB) : OCAT) + 512), D, F.lds); }
                else { if (ATT_TUNED_MLA && qb != 0) att::attn_unit_t<96, false, 8>(b, h, qb, QMLA, 768, KN, KPE, VM, nullptr, 0.f, dummy ? (bf16*)((unsigned char*)out + 4 * MiB) : OCAT, D, F.lds);
                       else att::attn_unit<96, false, 8>(b, h, qb, QMLA, 768, KN, KPE, VM, nullptr, dummy ? (bf16*)((unsigned char*)out + 4 * MiB) : OCAT, D, F.lds); }
            }
        }
        if (BOTH(4)) GRID_BAR();
    }

    for (int rep = 0; rep < ((PROBE_DUP == 5) ? 2 : 1); ++rep) if (IN(5)) { PHASE_ENV const bool dummy = (PROBE_DUP == 5) && rep == 0; (void)dummy;
        pg8::StaticOrder S; S.init(OCAT, Wom_t, T, D, D / 2, F.G, (int)blockIdx.x);
        EpiMergedCat E{(const unsigned char*)GATES, (unsigned char*)MERGED, 1.f / (WSCALE8 * 255.f)};
        pg8::gemm_phase<EpiMergedCat, pg8::StaticOrder, true, true>(F.lds, S, E);
        if (BOTH(5)) GRID_BAR();
    }

    for (int rep = 0; rep < ((PROBE_DUP == 6) ? 2 : 1); ++rep) if (IN(6)) { PHASE_ENV const bool dummy = (PROBE_DUP == 6) && rep == 0; (void)dummy;
        pg8::StaticOrder S; S.init(MERGED, Wout_t, T, D, D / 2, F.G, (int)blockIdx.x);
        EpiOut E{X_IN, X1B, mod, SSQ1, 1.f / (OSCALE8 * WSCALE8)};
        pg8::gemm_phase<EpiOut, pg8::StaticOrder, true, true>(F.lds, S, E);
        if (BOTH(6)) GRID_BAR();
    }

    for (int rep = 0; rep < ((PROBE_DUP == 7) ? 2 : 1); ++rep) if (IN(7)) { PHASE_ENV const bool dummy = (PROBE_DUP == 7) && rep == 0; (void)dummy;
        LAS unsigned char* wrl = F.lds;
        LAS float* vg = (LAS float*)(F.lds + LDSCTL_OFF + 6144);
        LAS float* vs = (LAS float*)(F.lds + LDSCTL_OFF + 10240);
        LAS int* cntw = (LAS int*)(F.lds + 32768);
        LAS int* basel = (LAS int*)(F.lds + 32768 + 2048);
        static_assert(LDSCTL_OFF + 10240 + 4096 <= LDS_BYTES && MOETAB_OFF + 4700 <= LDSCTL_OFF + 6144, "P7 LDS map");
        const float my_bias = b_router[F.lane];
        for (int grp = F.vcu; grp < T / 64; grp += F.G) {
            const int b = (grp * 64) / SEQ;
            __syncthreads();
#pragma unroll
            for (int i = 0; i < 16; ++i) __builtin_amdgcn_global_load_lds((const unsigned*)((const char*)Wr_f + (F.wave * 16 + i) * 1024 + F.lane * 16), (LAS unsigned*)(wrl + (F.wave * 16 + i) * 1024), 16, 0, 0);
            for (int i = F.tid; i < D; i += NWAVES * 64) { vg[i] = g_ffn[i] * (1.f + mod[(size_t)b * 6 * D + 4 * D + i]); vs[i] = mod[(size_t)b * 6 * D + 3 * D + i]; }
            const int tp = grp * 64 + (F.wave & 3) * 16, kh = F.wave >> 2, t0 = tp + kh * 8;
            const int r16 = F.lane & 15, kg = F.lane >> 4, myrow = tp + r16;
            float rs_mine;
            { const float* sp = SSQ1 + (size_t)myrow * 16; const f32x4 a = *(const f32x4*)sp, b4 = *(const f32x4*)(sp + 4), c4 = *(const f32x4*)(sp + 8), d4 = *(const f32x4*)(sp + 12);
              const float ssum = (((a[0] + a[1]) + (a[2] + a[3])) + ((b4[0] + b4[1]) + (b4[2] + b4[3]))) + (((c4[0] + c4[1]) + (c4[2] + c4[3])) + ((d4[0] + d4[1]) + (d4[2] + d4[3])));
              rs_mine = rsqrtf(ssum * (1.f / D) + EPS); }
            const bf16* xrow = X1B + (size_t)myrow * D + 512 * kh + 8 * kg;
            f32x4 lacc[4] = {{0.f, 0.f, 0.f, 0.f}, {0.f, 0.f, 0.f, 0.f}, {0.f, 0.f, 0.f, 0.f}, {0.f, 0.f, 0.f, 0.f}};
            u32x4 xq[16];
#pragma unroll
            for (int p = 0; p < 16; ++p) xq[p] = *(const u32x4*)(xrow + 32 * p);
            VM_WAIT(); __syncthreads();
#pragma unroll
            for (int p = 0; p < 16; ++p) { const int j = 16 * kh + p, k = 32 * j + 8 * kg;
                f32x4 x0, x1v; unpack8(xq[p], x0, x1v);
                const f32x4 g0 = *(const LAS f32x4*)(vg + k), g1 = *(const LAS f32x4*)(vg + k + 4), s0 = *(const LAS f32x4*)(vs + k), s1 = *(const LAS f32x4*)(vs + k + 4);
                const f32x4 h0 = x0 * rs_mine * g0 + s0, h1 = x1v * rs_mine * g1 + s1;
                const u32x4 hw = pack8(h0, h1);
                f32x4 a0, a1; unpack8(hw, a0, a1);
                const u32x4 lw = pack8(h0 - a0, h1 - a1);
                { u32x2 h8; int p_ = __builtin_amdgcn_cvt_pk_fp8_f32(h0[0], h0[1], 0, false); p_ = __builtin_amdgcn_cvt_pk_fp8_f32(h0[2], h0[3], p_, true); h8.x = (unsigned)p_;
                    p_ = __builtin_amdgcn_cvt_pk_fp8_f32(h1[0], h1[1], 0, false); p_ = __builtin_amdgcn_cvt_pk_fp8_f32(h1[2], h1[3], p_, true); h8.y = (unsigned)p_;
                    *(u32x2*)(H8 + (size_t)myrow * D + k) = h8; }
                const bf16x8 Ah = __builtin_bit_cast(bf16x8, hw), Al = __builtin_bit_cast(bf16x8, lw);
#pragma unroll
                for (int ntl = 0; ntl < 4; ++ntl) { const bf16x8 Wf = *(const LAS bf16x8*)(wrl + ((j * 4 + ntl) * 64 + F.lane) * 16);
                    lacc[ntl] = __builtin_amdgcn_mfma_f32_16x16x32_bf16(Wf, Ah, lacc[ntl], 0, 0, 0);
                    lacc[ntl] = __builtin_amdgcn_mfma_f32_16x16x32_bf16(Wf, Al, lacc[ntl], 0, 0, 0); } }
            __syncthreads();
            {   LAS float* stw = (LAS float*)F.lds + (((F.wave & 3) * 2 + kh) * 16 + r16) * 64;
#pragma unroll
                for (int ntl = 0; ntl < 4; ++ntl) *(LAS f32x4*)(stw + 16 * ntl + 4 * kg) = lacc[ntl]; }
            __syncthreads();
            LAS float* stg = (LAS float*)F.lds + ((F.wave & 3) * 32 + kh * 8) * 64;
            int cnt = 0; unsigned selbits = 0u, selks = 0u;
            for (int j = 0; j < 8; ++j) {
                const float logit = stg[j * 64 + F.lane] + stg[(16 + j) * 64 + F.lane];
                const float sc = 1.f / (1.f + expf(-logit));
                const float ch = sc + my_bias;
                const float m1 = max8(ch);
                const unsigned long long eq = __ballot(ch == m1);
                const unsigned gm = (unsigned)(eq >> (F.lane & ~7)) & 0xffu;
                const int first = __builtin_ctz(gm);
                const float c2 = max8(((F.lane & 7) == first) ? -INFINITY : ch);
                const float gs = m1 + c2; const int myg = F.lane >> 3;
                int rank = 0;
#pragma unroll
                for (int g = 0; g < 8; ++g) { const float o = __builtin_bit_cast(float, __builtin_amdgcn_readlane(__builtin_bit_cast(int, gs), 8 * g)); rank += (o > gs || (o == gs && g < myg)) ? 1 : 0; }
                float mc = (rank < 4) ? ch : -1e30f;
                int selk = -1;
#pragma unroll
                for (int k = 0; k < TOPK; ++k) { const float mx = wave_max_f(mc); const unsigned long long bl = __ballot(mc == mx); const int fl = __builtin_ctzll(bl);
                    if (F.lane == fl) { selk = k; mc = -INFINITY; } }
                const float ssum = wave_sum_f(selk >= 0 ? sc : 0.f);
                if (selk >= 0) { const int t = t0 + j; EIDX[(size_t)t * 8 + selk] = (unsigned char)F.lane; GATEW[(size_t)t * 8 + selk] = sc / ssum * 2.5f; ++cnt; selbits |= 1u << j; selks |= (unsigned)selk << (3 * j); }
            }
            cntw[F.wave * 64 + F.lane] = cnt;
            __syncthreads();
            if (F.wave == 0) { int tot = 0;
#pragma unroll
                for (int w = 0; w < 8; ++w) tot += cntw[w * 64 + F.lane];
                basel[F.lane] = (int)__hip_atomic_fetch_add((unsigned*)(ctl + (dummy ? CW_CNT + 2048 : CW_CNT) + 16 * F.lane), (unsigned)tot, RLX_AGENT); }
            __syncthreads();
            int pos = basel[F.lane];
            for (int w = 0; w < F.wave; ++w) pos += cntw[w * 64 + F.lane];
#pragma unroll
            for (int j = 0; j < 8; ++j) if ((selbits >> j) & 1u) { const int k = (selks >> (3 * j)) & 7, t = t0 + j;
                LIST[(size_t)F.lane * LISTCAP + pos] = (unsigned short)t;
                META[(size_t)F.lane * LISTCAP + pos] = (u32x2){(unsigned)(t * (TOPK + 1) + k), __float_as_uint(GATEW[(size_t)t * 8 + k])}; ++pos; }
        }
        __syncthreads();
        if (BOTH(7)) GRID_BAR();
    }

    volatile LAS int* tab = (volatile LAS int*)(F.lds + MOETAB_OFF);
    if (IN(8) || IN(9)) {
        __syncthreads();
        if (F.wave == 0) {
            const int n = (int)__hip_atomic_load((unsigned*)(ctl + CW_CNT + 16 * F.lane), RLX_AGENT);
            const int tiles = (n + 255) >> 8; int incl = tiles;
#pragma unroll
            for (int o = 1; o < 64; o <<= 1) { const int v = __shfl_up(incl, o); if (F.lane >= o) incl += v; }
            tab[F.lane] = incl - tiles; tab[66 + F.lane] = n;
            if (F.lane == 63) { tab[64] = incl; tab[65] = incl + T / 256; tab[66 + 64] = T; }
        }
        __syncthreads();
        { const int ti = F.tid; int e = 0;
          for (int q = 0; q <= NEXP; ++q) if (tab[q] <= ti) e = q;
          tab[132 + ti] = e; }
        __syncthreads();
    }
    for (int rep = 0; rep < ((PROBE_DUP == 8) ? 2 : 1); ++rep) if (IN(8)) { PHASE_ENV const bool dummy = (PROBE_DUP == 8) && rep == 0; (void)dummy;
        MoeOrder<2, true> S{(const char*)H8, (const char*)Wgu8, (const char*)Wsgu8, D / 2, (size_t)512 * D, LIST, tab, F.G, (int)blockIdx.x};
        EpiHb E{(unsigned char*)HB, 1.f / WSCALE8};
        pg8::gemm_phase<EpiHb, MoeOrder<2, true>, true, true>(F.lds, S, E);
        if (BOTH(8)) GRID_BAR();
    }
    for (int rep = 0; rep < ((PROBE_DUP == 9) ? 2 : 1); ++rep) if (IN(9)) { PHASE_ENV const bool dummy = (PROBE_DUP == 9) && rep == 0; (void)dummy;
        if (dummy && PROBE_VAR == 1) dn::down_phase<true>(F.lds, (const unsigned char*)HB, (const unsigned char*)Wd_t, (const unsigned char*)Wsd_t, tab, META, (unsigned char*)Y, (unsigned char*)(ws + WS_CTL + 900 * 1024), F.G, (int)blockIdx.x);
        else dn::down_phase<false>(F.lds, (const unsigned char*)HB, (const unsigned char*)Wd_t, (const unsigned char*)Wsd_t, tab, META, (unsigned char*)Y, (unsigned char*)(ws + WS_CTL + 900 * 1024), F.G, (int)blockIdx.x);
        if (BOTH(9)) GRID_BAR();
    }

    for (int rep = 0; rep < ((PROBE_DUP == 10) ? 2 : 1); ++rep) if (IN(10)) { PHASE_ENV const bool dummy = (PROBE_DUP == 10) && rep == 0; (void)dummy;
        int ln10 = F.lane; asm volatile("" : "+v"(ln10));
        for (int mb = gw * 8; mb < T; mb += NGW * 8) {
            const float* gf = mod + (size_t)(mb / SEQ) * 6 * D + 5 * D;
            f32x4 gfv[4], gfin[4];
#pragma unroll
            for (int j = 0; j < 4; ++j) { gfv[j] = *(const f32x4*)(gf + 4 * ln10 + 256 * j); gfin[j] = *(const f32x4*)(g_final + 4 * ln10 + 256 * j); }
            int yw[2][4][TOPK + 1]; u32x2 xb[2][4];
#define P10_LOAD(bf, m_) do { const unsigned char* yp_ = (const unsigned char*)Y + (size_t)(m_) * (TOPK + 1) * D + 4 * ln10; const u32x2* xr_ = (const u32x2*)(X1B + (size_t)(m_) * D) + ln10; \
            _Pragma("unroll") for (int j = 0; j < 4; ++j) { _Pragma("unroll") for (int k = 0; k < TOPK + 1; ++k) yw[bf][j][k] = __builtin_nontemporal_load((const int*)(yp_ + k * D + 256 * j)); \
                xb[bf][j] = __builtin_nontemporal_load(xr_ + 64 * j); } } while (0)
#define P10_ROW(bf, m_) do { f32x4 v[4]; float s = 0.f; \
            _Pragma("unroll") for (int j = 0; j < 4; ++j) { f32x4 y = {0.f, 0.f, 0.f, 0.f}; \
                _Pragma("unroll") for (int k = 0; k < TOPK + 1; ++k) { const f32x2 lo = __builtin_amdgcn_cvt_pk_f32_fp8(yw[bf][j][k], false), hi2 = __builtin_amdgcn_cvt_pk_f32_fp8(yw[bf][j][k], true); y += (f32x4){lo.x, lo.y, hi2.x, hi2.y}; } \
                const u32x2 xv = xb[bf][j]; \
                v[j] = (f32x4){__uint_as_float(xv.x << 16), __uint_as_float(xv.x & 0xffff0000u), __uint_as_float(xv.y << 16), __uint_as_float(xv.y & 0xffff0000u)} + gfv[j] * y; \
                s += (v[j].x * v[j].x + v[j].y * v[j].y) + (v[j].z * v[j].z + v[j].w * v[j].w); } \
            const float rstd = rsqrtf(wave_sum_f(s) * (1.f / D) + EPS); \
            f32x4* xw = (f32x4*)((dummy ? (float*)HB : out) + (size_t)(m_) * D) + ln10; \
            _Pragma("unroll") for (int j = 0; j < 4; ++j) __builtin_nontemporal_store(v[j] * rstd * gfin[j], xw + 64 * j); } while (0)
            P10_LOAD(0, mb);
            for (int i = 0; i < 8; i += 2) {
                P10_LOAD(1, mb + i + 1);
                P10_ROW(0, mb + i);
                if (i + 2 < 8) P10_LOAD(0, mb + i + 2);
                P10_ROW(1, mb + i + 1);
            }
#undef P10_LOAD
#undef P10_ROW
        }
    }
#undef IN
#undef BOTH
#undef GRID_BAR
}

constexpr int NPHASE = 11;
extern "C" void kernel_launch(void* const* d_in, const int* in_sizes, int n_in, void* d_out, int out_size, void* d_ws, size_t ws_size, hipStream_t stream) {
    static int grid = 0;
    if (grid == 0) {
        if (n_in != 25 || out_size != T * D || ws_size < WS_END) { fprintf(stderr, "kernel_launch: unexpected shapes (n_in %d out %d ws %zu need %zu)\n", n_in, out_size, ws_size, (size_t)WS_END); grid = -1; return; }
        int dev = 0, cus = 0;
        if (hipGetDevice(&dev) != hipSuccess || hipDeviceGetAttribute(&cus, hipDeviceAttributeMultiprocessorCount, dev) != hipSuccess) { grid = -1; return; }
        if (hipFuncSetAttribute((const void*)fwd, hipFuncAttributeMaxDynamicSharedMemorySize, LDS_BYTES) != hipSuccess) { fprintf(stderr, "kernel_launch: hipFuncSetAttribute failed\n"); grid = -1; return; }
        int per_cu = 0;
        if (hipOccupancyMaxActiveBlocksPerMultiprocessor(&per_cu, (const void*)fwd, NWAVES * 64, LDS_BYTES) != hipSuccess || per_cu < 1) { fprintf(stderr, "kernel_launch: occupancy query says %d\n", per_cu); }
        (void)hipGetLastError();
        grid = cus;
    }
    if (grid < 0) return;
    (void)in_sizes;
    if (hipMemsetAsync((char*)d_ws + WS_CTL, 0, CTL_ZERO_BYTES, stream) != hipSuccess) return;
    Args a{};
    for (int i = 0; i < 25; ++i) a.in[i] = d_in[i];
    a.out = (float*)d_out; a.ws = (unsigned char*)d_ws;
#if MK_ONE_LAUNCH
    a.ph_lo = 0; a.ph_hi = NPHASE;
    hipLaunchKernelGGL(fwd, dim3(grid), dim3(NWAVES * 64), LDS_BYTES, stream, a);
#else
    for (int p = 0; p < NPHASE; ++p) { a.ph_lo = p; a.ph_hi = p + 1; hipLaunchKernelGGL(fwd, dim3(grid), dim3(NWAVES * 64), LDS_BYTES, stream, a); }
#endif
}
```

```cpp
#include <hip/hip_runtime.h>
#include <cstdio>
#include <cstdint>
#include <type_traits>

#ifndef MK_ONE_LAUNCH
#ifndef CONV_A0
#define CONV_A0 28
#endif
#define MK_ONE_LAUNCH 1
#endif

#ifndef PROBE_DUP
#define PROBE_DUP -1
#endif
#ifndef ATT_TUNED_FOX
#define ATT_TUNED_FOX 1
#endif
#ifndef ATT_TUNED_MLA
#define ATT_TUNED_MLA 1
#endif
#ifndef PROBE_VAR
#define PROBE_VAR 0
#endif
#define GAS __attribute__((address_space(1)))
#define LAS __attribute__((address_space(3)))
typedef unsigned short bf16;
typedef short bf16x8 __attribute__((ext_vector_type(8)));
typedef short s16x4 __attribute__((ext_vector_type(4)));
typedef float f32x2 __attribute__((ext_vector_type(2)));
typedef float f32x4 __attribute__((ext_vector_type(4)));
typedef float f32x16 __attribute__((ext_vector_type(16)));
typedef unsigned u32x2 __attribute__((ext_vector_type(2)));
typedef unsigned u32x4 __attribute__((ext_vector_type(4)));
typedef GAS unsigned gu32;
typedef int v8i32_t __attribute__((ext_vector_type(8)));
typedef int v4i32_t __attribute__((ext_vector_type(4)));

constexpr int NB = 4, SEQ = 4096, T = NB * SEQ, D = 1024;
constexpr int NIN = 4096;
constexpr int QLORA = 256, KVLORA = 128, KVPAD = 256, ROPE = 32, NHEAD = 8, HD = 64, MQK = 96;
constexpr int NEXP = 64, TOPK = 6, DEXP = 256;
constexpr float EPS = 1e-6f;
constexpr float LOG2E = 1.4426950408889634f;
constexpr float C2F = 0.125f * LOG2E;
constexpr float C2M = 0.10206207261596577f * LOG2E;
constexpr int LISTCAP = T;
constexpr float HSCALE8 = 8.f;
constexpr float OSCALE8 = 8.f;
constexpr float WSCALE8 = 64.f;

constexpr size_t MiB = 1u << 20;
constexpr size_t WS_CTL = 0, CTL_ZERO_BYTES = 1 * MiB;
constexpr size_t WS_EIDX = 262144, WS_GATEW = 393216;
constexpr size_t WS_WIN = 1 * MiB, WS_WQ = 9 * MiB, WS_WKV = 9 * MiB + 512 * 1024, WS_WOM = 10 * MiB, WS_WOF = 11 * MiB, WS_WOUT = 12 * MiB;
constexpr size_t WS_WSGU = 14 * MiB, WS_WSD = 15 * MiB, WS_WR = 15 * MiB + 512 * 1024, WS_MOD = 15 * MiB + 640 * 1024;
constexpr size_t WS_WD = 16 * MiB;
constexpr size_t WS_HB = 48 * MiB;
constexpr size_t WS_FQ = 48 * MiB, WS_FK = 64 * MiB, WS_FV = 80 * MiB, WS_QLAT = 96 * MiB, WS_KVLAT = 104 * MiB;
constexpr size_t WS_OFOX = WS_FQ, WS_OMLA = WS_QLAT;
static_assert(WS_FK - WS_FQ == (size_t)T * 512 * 2 && WS_FV - WS_FK == (size_t)T * 512 * 2, "fq|fk|fv contiguous");
constexpr size_t WS_Y = 112 * MiB;
constexpr size_t WS_WGU = 112 * MiB;
constexpr size_t WS_H = 176 * MiB;
constexpr size_t WS_QMLA = WS_H;
constexpr size_t WS_GATES = 208 * MiB;
constexpr size_t WS_KN = 272 * MiB, WS_VM = 288 * MiB, WS_KPE = 304 * MiB;
constexpr size_t WS_MERGED = WS_KN;
constexpr size_t WS_LIST = 304 * MiB;
constexpr size_t WS_X1B = 224 * MiB;
constexpr size_t WS_END = 306 * MiB;
constexpr size_t DO_MODP = 4 * MiB;
constexpr size_t DO_ROPE = 0, DO_LOGF = 2 * MiB, DO_CUMF = 2 * MiB + 512 * 1024, DO_SSQQ = 3 * MiB, DO_SSQKV = 3 * MiB + 256 * 1024;

constexpr int CW_TMO = 0;
constexpr int CW_BAR = 4096;
constexpr int CW_CNT = 8192;
constexpr int CW_KM = 12288;
constexpr int CW_Q = 12544;

constexpr int RING_BYTES = 131072;
constexpr int LDSCTL_OFF = RING_BYTES;
constexpr int MISC_OFF = LDSCTL_OFF + 320;
constexpr int MOETAB_OFF = LDSCTL_OFF + 1024;
constexpr int LDS_BYTES = 147456;

constexpr int NWAVES = 8;

#define LDS_WAIT() asm volatile("s_waitcnt lgkmcnt(0)" ::: "memory")
#define VM_WAIT() asm volatile("s_waitcnt vmcnt(0)" ::: "memory")
#define RLX_AGENT __ATOMIC_RELAXED, __HIP_MEMORY_SCOPE_AGENT
__device__ __forceinline__ unsigned f2bf(float f) { unsigned u = __builtin_bit_cast(unsigned, f); return (u + 0x7fffu + ((u >> 16) & 1u)) >> 16; }
__device__ __forceinline__ float bf2f(unsigned h) { return __builtin_bit_cast(float, h << 16); }
__device__ __forceinline__ unsigned pk2(float lo, float hi) { return f2bf(lo) | (f2bf(hi) << 16); }
__device__ __forceinline__ unsigned cvt_pk_bf16(float lo, float hi) { unsigned r; asm volatile("v_cvt_pk_bf16_f32 %0, %1, %2" : "=v"(r) : "v"(lo), "v"(hi)); return r; }
__device__ __forceinline__ u32x4 pack8(f32x4 a, f32x4 b) { u32x4 w; w.x = cvt_pk_bf16(a[0], a[1]); w.y = cvt_pk_bf16(a[2], a[3]); w.z = cvt_pk_bf16(b[0], b[1]); w.w = cvt_pk_bf16(b[2], b[3]); return w; }
__device__ __forceinline__ unsigned pack4u8(float a, float b, float c, float d) {
    const unsigned lo = __builtin_amdgcn_perm(__float_as_uint(b), __float_as_uint(a), 0x0c0c0400u), hi = __builtin_amdgcn_perm(__float_as_uint(d), __float_as_uint(c), 0x0c0c0400u);
    return __builtin_amdgcn_perm(hi, lo, 0x05040100u);
}
__device__ __forceinline__ float ub(unsigned w, int i) { return (float)((w >> (8 * i)) & 0xffu); }
__device__ __forceinline__ void unpack8(u32x4 w, f32x4& a, f32x4& b) {
    a = (f32x4){bf2f(w.x & 0xffffu), bf2f(w.x >> 16), bf2f(w.y & 0xffffu), bf2f(w.y >> 16)};
    b = (f32x4){bf2f(w.z & 0xffffu), bf2f(w.z >> 16), bf2f(w.w & 0xffffu), bf2f(w.w >> 16)};
}
__device__ __forceinline__ float wave_sum(float v) {
#pragma unroll
    for (int o = 1; o < 64; o <<= 1) v += __shfl_xor(v, o);
    return v;
}
__device__ __forceinline__ float wave_max(float v) {
#pragma unroll
    for (int o = 1; o < 64; o <<= 1) v = fmaxf(v, __shfl_xor(v, o));
    return v;
}
template <int CTRL> __device__ __forceinline__ float dppf(float v) { return __builtin_bit_cast(float, __builtin_amdgcn_update_dpp(0, __builtin_bit_cast(int, v), CTRL, 0xf, 0xf, true)); }
__device__ __forceinline__ float max8(float v) { v = fmaxf(v, dppf<0xB1>(v)); v = fmaxf(v, dppf<0x4E>(v)); v = fmaxf(v, dppf<0x141>(v)); return v; }
__device__ __forceinline__ float wave_max_f(float v) { v = max8(v); v = fmaxf(v, dppf<0x140>(v)); v = fmaxf(v, __shfl_xor(v, 16)); v = fmaxf(v, __shfl_xor(v, 32)); return v; }
__device__ __forceinline__ float wave_sum_f(float v) { v += dppf<0xB1>(v); v += dppf<0x4E>(v); v += dppf<0x141>(v); v += dppf<0x140>(v); v += __shfl_xor(v, 16); v += __shfl_xor(v, 32); return v; }
__device__ __forceinline__ float sigmoidf_(float x) { return __builtin_amdgcn_rcpf(1.f + __builtin_amdgcn_exp2f(-LOG2E * x)); }
__device__ __forceinline__ float siluf_(float x) { return x * __builtin_amdgcn_rcpf(1.f + __builtin_amdgcn_exp2f(-LOG2E * x)); }

namespace pg8 {
constexpr int BM = 256, BK = 64, HALF = 128, HTB = HALF * BK * 2, NXCD = 8, WGM = 8;
__host__ __device__ __forceinline__ int lds_byte(int r, int c) { const int st = (r >> 4) * 2 + (c >> 5), rr = r & 15, cc = c & 31, ob = rr * 64 + cc * 2; return st * 1024 + (ob ^ (((ob >> 9) & 1) << 5)); }
__host__ __device__ __forceinline__ void stage_rc(int b, int& R, int& C) { const int st = b / 1024, sb = b % 1024, swz = sb ^ (((sb >> 9) & 1) << 5); R = (st >> 1) * 16 + swz / 64; C = (st & 1) * 32 + (swz % 64) / 2; }
__host__ __device__ __forceinline__ int perm32(int rho) { const int n = rho >> 4, i = rho & 15; return 8 * (i >> 2) + 4 * n + (i & 3); }

struct Unit { int pm, pn, e, aux, n; };

struct StaticOrder {
    static constexpr bool GATHER = false;
    const char* A; const char* Bt; int K;
    int nM, nN, nwg, G, c;
    __device__ void init(const void* A_, const void* Bt_, int M, int N, int K_, int G_, int c_) { A = (const char*)A_; Bt = (const char*)Bt_; K = K_; nM = M / BM; nN = N / BM; nwg = nM * nN; G = G_; c = c_; }
    __device__ bool next(int i, Unit& u) const {
        const long L = (long)i * G + c; if (L >= nwg) return false;
        int wgid = (int)L; { const int q = nwg / NXCD, r = nwg % NXCD, xcd = wgid % NXCD, off = wgid / NXCD; wgid = (xcd < r ? xcd * (q + 1) : r * (q + 1) + (xcd - r) * q) + off; }
        const int nig = WGM * nN, gid = wgid / nig, fm = gid * WGM, gsz = (nM - fm) < WGM ? (nM - fm) : WGM;
        u.pm = fm + ((wgid % nig) % gsz); u.pn = (wgid % nig) / gsz; u.e = 0; u.aux = 0; u.n = BM; return true;
    }
    __device__ __forceinline__ const char* a_ptr(const Unit& u) const { return A + (size_t)u.pm * BM * K * 2; }
    __device__ __forceinline__ const char* b_ptr(const Unit& u) const { return Bt + (size_t)u.pn * BM * K * 2; }
    __device__ __forceinline__ unsigned a_row(const Unit&, int r) const { return (unsigned)r; }
};

template <class Epi, class Sched, bool ALIGN_EPI, bool FP8 = false>
__device__ __forceinline__ void gemm_phase(LAS unsigned char* lds, const Sched& S, const Epi& E) {
    int tid = threadIdx.x; asm volatile("" : "+v"(tid));
    const int wid = __builtin_amdgcn_readfirstlane(tid >> 6), lane = tid & 63, wr = wid >> 2, wc = wid & 3, fr = lane & 15, fq = lane >> 4;
    const int K = S.K, nt = K / BK;
    unsigned voffB[2], voffA[2];
#pragma unroll
    for (int i = 0; i < 2; ++i) { int R, C; stage_rc(tid * 16 + i * 8192, R, C); const int Rb = (R & ~31) + perm32(R & 31);
        voffA[i] = (unsigned)(R * K + C) * 2u; voffB[i] = (unsigned)(Rb * K + C) * 2u; }
    unsigned vA[2][2], vN[2][2];
    const size_t kstep = (size_t)(BK * 2);
    const size_t hstep = (size_t)HALF * K * 2;
    const unsigned ldsw = (unsigned)wid * 1024u;
    const int aoff = lds_byte(wr * 64 + fr, fq * 8), boff = lds_byte(wc * 32 + fr, fq * 8);
#define PG8_SA(b, h) (((b) * 2 + (h)) * HTB)
#define PG8_SB(b, h) ((4 + (b) * 2 + (h)) * HTB)
#define PG8_STAGE(bufoff, gbase, voff) do { _Pragma("unroll") for (int _i = 0; _i < 2; ++_i) \
        __builtin_amdgcn_global_load_lds((const unsigned*)((const char*)(gbase) + (voff)[_i]), (LAS unsigned*)(lds + (bufoff) + ldsw + _i * 8192), 16, 0, 0); } while (0)
#define PG8_STAGE_A(bufoff, gbase, h, nx) do { if constexpr (Sched::GATHER) { const unsigned vs_[2] = {(nx) ? vN[h][0] : vA[h][0], (nx) ? vN[h][1] : vA[h][1]}; PG8_STAGE(bufoff, gbase, vs_); }     \
        else PG8_STAGE(bufoff, (const char*)(gbase) + (h) * hstep, voffA); } while (0)
#define PG8_LDA(dst, b, h) do { _Pragma("unroll") for (int m = 0; m < 4; ++m) { if constexpr (FP8) { dst##8[m].lo = *(const LAS v4i32_t*)(lds + PG8_SA(b, h) + aoff + m * 2048); dst##8[m].hi = *(const LAS v4i32_t*)(lds + PG8_SA(b, h) + aoff + m * 2048 + 1024); } \
        else { _Pragma("unroll") for (int k = 0; k < 2; ++k) dst[m][k] = *(const LAS bf16x8*)(lds + PG8_SA(b, h) + aoff + m * 2048 + k * 1024); } } } while (0)
#define PG8_LDB(dst, b, h) do { _Pragma("unroll") for (int n = 0; n < 2; ++n) { if constexpr (FP8) { dst##8[n].lo = *(const LAS v4i32_t*)(lds + PG8_SB(b, h) + boff + n * 2048); dst##8[n].hi = *(const LAS v4i32_t*)(lds + PG8_SB(b, h) + boff + n * 2048 + 1024); } \
        else { _Pragma("unroll") for (int k = 0; k < 2; ++k) dst[n][k] = *(const LAS bf16x8*)(lds + PG8_SB(b, h) + boff + n * 2048 + k * 1024); } } } while (0)
#define PG8_MMA(ai, bj, At, Bt) do { __builtin_amdgcn_s_setprio(1); _Pragma("unroll") for (int m = 0; m < 4; ++m) _Pragma("unroll") for (int n = 0; n < 2; ++n) { \
        if constexpr (FP8) asm volatile("v_mfma_scale_f32_16x16x128_f8f6f4 %0, %1, %2, %0, %3, %3 op_sel_hi:[0,0,0]" : "+v"(acc[ai][bj][m][n]) : "v"(Bt##8[n]), "v"(At##8[m]), "v"(sc1_));     \
        else { _Pragma("unroll") for (int k = 0; k < 2; ++k) acc[ai][bj][m][n] = __builtin_amdgcn_mfma_f32_16x16x32_bf16(Bt[n][k], At[m][k], acc[ai][bj][m][n], 0, 0, 0); } } \
        __builtin_amdgcn_s_setprio(0); } while (0)
#define PG8_WAIT_V(n) asm volatile("s_waitcnt vmcnt(" #n ")" ::: "memory")
#define PG8_WAIT_L(n) asm volatile("s_waitcnt lgkmcnt(" #n ")" ::: "memory")
#define PG8_BAR __builtin_amdgcn_s_barrier()
#define PG8_SCHED __builtin_amdgcn_sched_barrier(0)
#define PG8_SETV(dst, u) do { _Pragma("unroll") for (int _h = 0; _h < 2; ++_h) _Pragma("unroll") for (int _i = 0; _i < 2; ++_i) { int R_, C_; stage_rc(tid * 16 + _i * 8192, R_, C_); \
        dst[_h][_i] = (S.a_row(u, _h * HALF + R_) * (unsigned)K + (unsigned)C_) * 2u; } } while (0)
    Unit cur, nxt; int ui = 0;
    if (!S.next(0, cur)) return;
    f32x4 acc[2][2][4][2];
#define PG8_ZERO() do { _Pragma("unroll") for (int a = 0; a < 2; ++a) _Pragma("unroll") for (int b = 0; b < 2; ++b) _Pragma("unroll") for (int m = 0; m < 4; ++m) _Pragma("unroll") for (int n = 0; n < 2; ++n) { \
        if constexpr (FP8) asm volatile("v_mov_b32 %0, 0\n\tv_mov_b32 %1, 0\n\tv_mov_b32 %2, 0\n\tv_mov_b32 %3, 0" : "=v"(acc[a][b][m][n][0]), "=v"(acc[a][b][m][n][1]), "=v"(acc[a][b][m][n][2]), "=v"(acc[a][b][m][n][3])); \
        else acc[a][b][m][n] = (f32x4){0.f, 0.f, 0.f, 0.f}; } } while (0)
    PG8_ZERO();
    unsigned sc1_ = 0x7f7f7f7fu; asm volatile("" : "+v"(sc1_));
    (void)sc1_;
    bf16x8 At[4][2], B0[2][2], B1[2][2];
    v8i32_t At8[4], B08[2], B18[2];
    (void)At; (void)B0; (void)B1; (void)At8; (void)B08; (void)B18;
    const char* cA = S.a_ptr(cur); const char* cB = S.b_ptr(cur);
    if constexpr (Sched::GATHER) { PG8_SETV(vA, cur); }
    PG8_STAGE(PG8_SB(0, 0), cB, voffB); PG8_STAGE(PG8_SB(0, 1), cB + hstep, voffB); PG8_STAGE_A(PG8_SA(0, 0), cA, 0, false); PG8_STAGE_A(PG8_SA(0, 1), cA, 1, false);
    if (wr == 1) PG8_BAR;
    PG8_WAIT_V(2); PG8_BAR;
    PG8_STAGE(PG8_SB(1, 0), cB + kstep, voffB); PG8_STAGE_A(PG8_SA(1, 0), cA + kstep, 0, false); PG8_STAGE(PG8_SB(1, 1), cB + hstep + kstep, voffB);
    PG8_WAIT_V(6); PG8_BAR;
    for (;;) {
        const bool has_next = S.next(ui + 1, nxt);
        const char* nA = has_next ? S.a_ptr(nxt) : cA; const char* nB = has_next ? S.b_ptr(nxt) : cB;
        if constexpr (Sched::GATHER) { if (has_next) { PG8_SETV(vN, nxt); } else {
#pragma unroll
            for (int h = 0; h < 2; ++h)
#pragma unroll
                for (int i = 0; i < 2; ++i) vN[h][i] = vA[h][i]; } }
        for (int t = 0; t < nt; t += 2) {
            const bool last = (t == nt - 2);
            if constexpr (Epi::MIDK) { if (t == nt / 2) E.mid(acc, cur, wr, wc, fr, fq); }
            const char* a1 = cA + (size_t)(t + 1) * kstep;
            const char* a2 = last ? nA : cA + (size_t)(t + 2) * kstep; const char* b2 = last ? nB : cB + (size_t)(t + 2) * kstep;
            const char* a3 = a2 + kstep; const char* b3 = b2 + kstep;
            PG8_LDB(B0, 0, 0); PG8_LDB(B1, 0, 1); PG8_SCHED; PG8_LDA(At, 0, 0); PG8_STAGE_A(PG8_SA(1, 1), a1, 1, false);
            PG8_WAIT_V(8); PG8_WAIT_L(0); PG8_BAR; PG8_MMA(0, 0, At, B0); PG8_MMA(0, 1, At, B1); PG8_BAR; PG8_SCHED;
            PG8_LDA(At, 0, 1); PG8_STAGE(PG8_SB(0, 0), b2, voffB); PG8_STAGE(PG8_SB(0, 1), b2 + hstep, voffB); PG8_STAGE_A(PG8_SA(0, 0), a2, 0, last);
            PG8_WAIT_V(8); PG8_WAIT_L(0); PG8_BAR; PG8_MMA(1, 0, At, B0); PG8_MMA(1, 1, At, B1); PG8_BAR; PG8_SCHED;
            PG8_LDB(B0, 1, 0); PG8_LDB(B1, 1, 1); PG8_SCHED; PG8_LDA(At, 1, 0); PG8_STAGE_A(PG8_SA(0, 1), a2, 1, last);
            PG8_WAIT_V(8); PG8_WAIT_L(0); PG8_BAR; PG8_MMA(0, 0, At, B0); PG8_MMA(0, 1, At, B1); PG8_BAR; PG8_SCHED;
            PG8_LDA(At, 1, 1); PG8_STAGE(PG8_SB(1, 0), b3, voffB); PG8_STAGE(PG8_SB(1, 1), b3 + hstep, voffB); PG8_STAGE_A(PG8_SA(1, 0), a3, 0, last);
            PG8_WAIT_V(8); PG8_WAIT_L(0); PG8_BAR; PG8_MMA(1, 0, At, B0); PG8_MMA(1, 1, At, B1); PG8_BAR; PG8_SCHED;
        }
        if constexpr (ALIGN_EPI) { if (wr == 0) PG8_BAR; }
        if constexpr (FP8) { asm volatile("s_nop 15\n\ts_nop 7" ::: "memory"); __builtin_amdgcn_sched_barrier(0); }
        E(acc, cur, wr, wc, fr, fq);
        if (!has_next) break;
        PG8_ZERO();
        cur = nxt; cA = nA; cB = nB; ++ui;
        if constexpr (Sched::GATHER) {
#pragma unroll
            for (int h = 0; h < 2; ++h)
#pragma unroll
                for (int i = 0; i < 2; ++i) vA[h][i] = vN[h][i]; }
        if constexpr (ALIGN_EPI) { if (wr == 1) PG8_BAR; }
    }
    PG8_WAIT_V(0);
    if constexpr (!ALIGN_EPI) { if (wr == 0) PG8_BAR; }
    PG8_BAR;
#undef PG8_SA
#undef PG8_SB
#undef PG8_STAGE
#undef PG8_STAGE_A
#undef PG8_LDA
#undef PG8_LDB
#undef PG8_MMA
#undef PG8_ZERO
#undef PG8_WAIT_V
#undef PG8_WAIT_L
#undef PG8_BAR
#undef PG8_SCHED
#undef PG8_SETV
}
}
using pg8::Unit;

#define EPI_ROWS(ai, m) for (int ai = 0; ai < 2; ++ai) for (int m = 0; m < 4; ++m)

struct EpiInProj {
    static constexpr bool MIDK = false;
    bf16 *qlat, *kvlat, *kpe, *fq, *gates; float *logf, *ssqq, *ssqkv; const float* ropetab; const float* bforget; bool skip; int rowmul;
    __device__ __forceinline__ void operator()(const f32x4 (&acc)[2][2][4][2], const Unit& u, int wr, int wc, int fr, int fq_) const {
        if (skip) return;
        const int pn = u.pn, row0 = u.pm * 256 + wr * 64 + fr, c0 = wc * 32 + 8 * fq_;
        if (pn >= 8) {
            unsigned char* gp = (unsigned char*)gates + (size_t)(pn - 8) * 256 + wc * 64 + fq_ * 16;
#pragma unroll
            for (int ai = 0; ai < 2; ++ai)
#pragma unroll
                for (int m = 0; m < 4; ++m) { const int row = row0 + ai * 128 + m * 16; u32x4 o;
#pragma unroll
                    for (int bj = 0; bj < 2; ++bj) { f32x4 v0 = acc[ai][bj][m][0], v1 = acc[ai][bj][m][1];
#pragma unroll
                        for (int q = 0; q < 4; ++q) { v0[q] = sigmoidf_(v0[q]) * 255.f + 8388608.f; v1[q] = sigmoidf_(v1[q]) * 255.f + 8388608.f; }
                        o[2 * bj] = pack4u8(v0[0], v0[1], v0[2], v0[3]); o[2 * bj + 1] = pack4u8(v1[0], v1[1], v1[2], v1[3]); }
                    *(u32x4*)(gp + (size_t)row * 2048) = o; }
        } else if (pn >= 2) {
            bf16* dst = fq + (size_t)((pn - 2) >> 1) * ((size_t)T * 512) + (pn & 1) * 256 + c0; const float sc = (pn < 4) ? C2F : 1.f;
#pragma unroll
            for (int ai = 0; ai < 2; ++ai)
#pragma unroll
                for (int m = 0; m < 4; ++m) { const int row = row0 + ai * 128 + m * 16;
#pragma unroll
                    for (int bj = 0; bj < 2; ++bj) *(u32x4*)(dst + (size_t)row * 512 + 128 * bj) = pack8(acc[ai][bj][m][0] * sc, acc[ai][bj][m][1] * sc); }
        } else if (pn == 0) {
#pragma unroll
            for (int ai = 0; ai < 2; ++ai)
#pragma unroll
                for (int m = 0; m < 4; ++m) { const int row = row0 + ai * 128 + m * 16; float s = 0.f;
#pragma unroll
                    for (int bj = 0; bj < 2; ++bj) { const f32x4 v0 = acc[ai][bj][m][0], v1 = acc[ai][bj][m][1];
                        s += (v0[0] * v0[0] + v0[1] * v0[1]) + (v0[2] * v0[2] + v0[3] * v0[3]) + (v1[0] * v1[0] + v1[1] * v1[1]) + (v1[2] * v1[2] + v1[3] * v1[3]);
                        *(u32x4*)(qlat + (size_t)row * QLORA + c0 + 128 * bj) = pack8(v0, v1); }
                    s += __shfl_xor(s, 16); s += __shfl_xor(s, 32);
                    if (fq_ == 0) ssqq[row * 4 + wc] = s; }
        } else {
#pragma unroll
            for (int ai = 0; ai < 2; ++ai)
#pragma unroll
                for (int m = 0; m < 4; ++m) { const int row = row0 + ai * 128 + m * 16;
                    { const f32x4 v0 = acc[ai][0][m][0], v1 = acc[ai][0][m][1];
                      float s = (v0[0] * v0[0] + v0[1] * v0[1]) + (v0[2] * v0[2] + v0[3] * v0[3]) + (v1[0] * v1[0] + v1[1] * v1[1]) + (v1[2] * v1[2] + v1[3] * v1[3]);
                      *(u32x4*)(kvlat + (size_t)row * KVPAD + c0) = pack8(v0, v1);
                      s += __shfl_xor(s, 16); s += __shfl_xor(s, 32);
                      if (fq_ == 0) ssqkv[row * 4 + wc] = s; }
                    { const f32x4 v0 = acc[ai][1][m][0], v1 = acc[ai][1][m][1];
                      *(u32x4*)(kvlat + (size_t)row * KVPAD + 128 + c0) = (u32x4){0u, 0u, 0u, 0u};
                      if (wc == 0) {
                          const f32x4* tb = (const f32x4*)(ropetab + ((size_t)row * 16 + 4 * fq_) * 2);
                          const f32x4 t0 = tb[0], t1 = tb[1];
                          f32x4 o1, o2;
                          o1[0] = v0[0] * t0[0] - v1[0] * t0[1]; o2[0] = v1[0] * t0[0] + v0[0] * t0[1];
                          o1[1] = v0[1] * t0[2] - v1[1] * t0[3]; o2[1] = v1[1] * t0[2] + v0[1] * t0[3];
                          o1[2] = v0[2] * t1[0] - v1[2] * t1[1]; o2[2] = v1[2] * t1[0] + v0[2] * t1[1];
                          o1[3] = v0[3] * t1[2] - v1[3] * t1[3]; o2[3] = v1[3] * t1[2] + v0[3] * t1[3];
                          *(u32x4*)(kpe + (size_t)row * ROPE + 8 * fq_) = pack8(o1, o2);
                      } else if (wc == 1 && fq_ == 0) {
                          f32x4 l0, l1;
#pragma unroll
                          for (int h = 0; h < 4; ++h) { const float z0 = v0[h] + bforget[h], z1 = v1[h] + bforget[4 + h];
                              l0[h] = -__builtin_amdgcn_logf(1.f + __builtin_amdgcn_exp2f(-LOG2E * z0)); l1[h] = -__builtin_amdgcn_logf(1.f + __builtin_amdgcn_exp2f(-LOG2E * z1)); }
                          *(f32x4*)(logf + (size_t)row * 8) = l0; *(f32x4*)(logf + (size_t)row * 8 + 4) = l1;
                      } } }
        }
        (void)rowmul;
    }
};

struct EpiQup {
    static constexpr bool MIDK = false;
    bf16* q; const float* ssqq; const float* ropetab;
    __device__ __forceinline__ void operator()(const f32x4 (&acc)[2][2][4][2], const Unit& u, int wr, int wc, int fr, int fq_) const {
        const int row0 = u.pm * 256 + wr * 64 + fr, c0 = u.pn * 256 + wc * 32 + 8 * fq_;
#pragma unroll
        for (int ai = 0; ai < 2; ++ai)
#pragma unroll
            for (int m = 0; m < 4; ++m) {
                const int row = row0 + ai * 128 + m * 16;
                const f32x4 sq = *(const f32x4*)(ssqq + row * 4);
                const float rs = rsqrtf(((sq[0] + sq[1]) + (sq[2] + sq[3])) * (1.f / QLORA) + EPS) * C2M;
#pragma unroll
                for (int bj = 0; bj < 2; ++bj) {
                    const int col = c0 + 128 * bj, j = col % MQK;
                    f32x4 v0 = acc[ai][bj][m][0] * rs, v1 = acc[ai][bj][m][1] * rs;
                    if (j >= 64) { const int g = (j - 64) >> 3;
                        const f32x4* tb = (const f32x4*)(ropetab + ((size_t)row * 16 + 4 * g) * 2);
                        const f32x4 t0 = tb[0], t1 = tb[1];
                        f32x4 o1, o2;
                        o1[0] = v0[0] * t0[0] - v1[0] * t0[1]; o2[0] = v1[0] * t0[0] + v0[0] * t0[1];
                        o1[1] = v0[1] * t0[2] - v1[1] * t0[3]; o2[1] = v1[1] * t0[2] + v0[1] * t0[3];
                        o1[2] = v0[2] * t1[0] - v1[2] * t1[1]; o2[2] = v1[2] * t1[0] + v0[2] * t1[1];
                        o1[3] = v0[3] * t1[2] - v1[3] * t1[3]; o2[3] = v1[3] * t1[2] + v0[3] * t1[3];
                        v0 = o1; v1 = o2; }
                    *(u32x4*)(q + (size_t)row * 768 + col) = pack8(v0, v1);
                }
            }
    }
};

struct EpiKVup {
    static constexpr bool MIDK = false;
    bf16 *kn, *vm; const float* ssqkv;
    __device__ __forceinline__ void operator()(const f32x4 (&acc)[2][2][4][2], const Unit& u, int wr, int wc, int fr, int fq_) const {
        const int row0 = u.pm * 256 + wr * 64 + fr, c0 = u.pn * 256 + wc * 32 + 8 * fq_;
        bf16* dst = (u.pn < 2) ? kn : vm; const int cb = (u.pn & 1) * 256 + wc * 32 + 8 * fq_;
        (void)c0;
#pragma unroll
        for (int ai = 0; ai < 2; ++ai)
#pragma unroll
            for (int m = 0; m < 4; ++m) {
                const int row = row0 + ai * 128 + m * 16;
                const f32x4 sq = *(const f32x4*)(ssqkv + row * 4);
                const float rs = rsqrtf(((sq[0] + sq[1]) + (sq[2] + sq[3])) * (1.f / KVLORA) + EPS);
#pragma unroll
                for (int bj = 0; bj < 2; ++bj) *(u32x4*)(dst + (size_t)row * 512 + cb + 128 * bj) = pack8(acc[ai][bj][m][0] * rs, acc[ai][bj][m][1] * rs);
            }
    }
};

struct EpiPartA {
    static constexpr bool MIDK = false;
    float* part; const bf16* gates;
    __device__ __forceinline__ void operator()(const f32x4 (&acc)[2][2][4][2], const Unit& u, int wr, int wc, int fr, int fq_) const {
        const int row0 = u.pm * 256 + wr * 64 + fr, c0 = u.pn * 256 + wc * 32 + 8 * fq_;
#pragma unroll
        for (int ai = 0; ai < 2; ++ai)
#pragma unroll
            for (int m = 0; m < 4; ++m) {
                const int row = row0 + ai * 128 + m * 16;
#pragma unroll
                for (int bj = 0; bj < 2; ++bj) { const int col = c0 + 128 * bj;
                    f32x4 g0, g1; unpack8(*(const u32x4*)(gates + (size_t)row * 2048 + col), g0, g1);
                    *(f32x4*)(part + (size_t)row * D + col) = g0 * acc[ai][bj][m][0]; *(f32x4*)(part + (size_t)row * D + col + 4) = g1 * acc[ai][bj][m][1]; }
            }
    }
};
struct EpiMerged {
    static constexpr bool MIDK = false;
    const float* part; const bf16* gates; bf16* merged;
    __device__ __forceinline__ void operator()(const f32x4 (&acc)[2][2][4][2], const Unit& u, int wr, int wc, int fr, int fq_) const {
        const int row0 = u.pm * 256 + wr * 64 + fr, c0 = u.pn * 256 + wc * 32 + 8 * fq_;
#pragma unroll
        for (int ai = 0; ai < 2; ++ai)
#pragma unroll
            for (int m = 0; m < 4; ++m) {
                const int row = row0 + ai * 128 + m * 16;
#pragma unroll
                for (int bj = 0; bj < 2; ++bj) { const int col = c0 + 128 * bj;
                    f32x4 g0, g1; unpack8(*(const u32x4*)(gates + (size_t)row * 2048 + 1024 + col), g0, g1);
                    const f32x4 p0 = *(const f32x4*)(part + (size_t)row * D + col), p1 = *(const f32x4*)(part + (size_t)row * D + col + 4);
                    *(u32x4*)(merged + (size_t)row * D + col) = pack8(p0 + g0 * acc[ai][bj][m][0], p1 + g1 * acc[ai][bj][m][1]); }
            }
    }
};
struct EpiMergedCat {
    static constexpr bool MIDK = true;
    const unsigned char* gates; unsigned char* merged; float sc;
    __device__ __forceinline__ void mid(f32x4 (&acc)[2][2][4][2], const Unit& u, int wr, int wc, int fr, int fq_) const {
        int row0 = u.pm * 256 + wr * 64 + fr, c0 = u.pn * 256 + wc * 64 + fq_ * 16;
        asm volatile("" : "+v"(row0), "+v"(c0));
#pragma unroll
        for (int ai = 0; ai < 2; ++ai)
#pragma unroll
            for (int m = 0; m < 4; ++m) { const int row = row0 + ai * 128 + m * 16;
                const u32x4 ga = *(const u32x4*)(gates + (size_t)row * 2048 + c0), gb = *(const u32x4*)(gates + (size_t)row * 2048 + 1024 + c0);
#pragma unroll
                for (int bj = 0; bj < 2; ++bj)
#pragma unroll
                    for (int q = 0; q < 4; ++q) { acc[ai][bj][m][0][q] *= ub(ga[2 * bj], q) * __builtin_amdgcn_rcpf(fmaxf(ub(gb[2 * bj], q), 1.f)); acc[ai][bj][m][1][q] *= ub(ga[2 * bj + 1], q) * __builtin_amdgcn_rcpf(fmaxf(ub(gb[2 * bj + 1], q), 1.f)); }
                asm volatile("" ::: "memory"); }
    }
    __device__ __forceinline__ void operator()(const f32x4 (&acc)[2][2][4][2], const Unit& u, int wr, int wc, int fr, int fq_) const {
        const int row0 = u.pm * 256 + wr * 64 + fr, c0 = u.pn * 256 + wc * 32 + 8 * fq_, g0 = u.pn * 256 + wc * 64 + fq_ * 16;
#pragma unroll
        for (int ai = 0; ai < 2; ++ai)
#pragma unroll
            for (int m = 0; m < 4; ++m) { const int row = row0 + ai * 128 + m * 16;
                const u32x4 gb = *(const u32x4*)(gates + (size_t)row * 2048 + 1024 + g0);
#pragma unroll
                for (int bj = 0; bj < 2; ++bj) { const int col = c0 + 128 * bj;
                    f32x4 v0, v1;
#pragma unroll
                    for (int q = 0; q < 4; ++q) { v0[q] = fmaxf(ub(gb[2 * bj], q), 1.f) * acc[ai][bj][m][0][q] * sc; v1[q] = fmaxf(ub(gb[2 * bj + 1], q), 1.f) * acc[ai][bj][m][1][q] * sc; }
                    u32x2 o; int p_ = __builtin_amdgcn_cvt_pk_fp8_f32(v0[0], v0[1], 0, false); p_ = __builtin_amdgcn_cvt_pk_fp8_f32(v0[2], v0[3], p_, true); o.x = (unsigned)p_;
                    p_ = __builtin_amdgcn_cvt_pk_fp8_f32(v1[0], v1[1], 0, false); p_ = __builtin_amdgcn_cvt_pk_fp8_f32(v1[2], v1[3], p_, true); o.y = (unsigned)p_;
                    *(u32x2*)(merged + (size_t)row * D + col) = o; } }
    }
};
struct EpiOut {
    static constexpr bool MIDK = false;
    const float* x; bf16* x1; const float* mod; float* ssq1; float sc;
    __device__ __forceinline__ void operator()(const f32x4 (&acc)[2][2][4][2], const Unit& u, int wr, int wc, int fr, int fq_) const {
        const int row0 = u.pm * 256 + wr * 64 + fr, c0 = u.pn * 256 + wc * 32 + 8 * fq_;
        const float* gm = mod + (size_t)((u.pm * 256) / SEQ) * 6 * D + 2 * D;
        f32x4 g[2][2];
#pragma unroll
        for (int bj = 0; bj < 2; ++bj) { g[bj][0] = *(const f32x4*)(gm + c0 + 128 * bj) * sc; g[bj][1] = *(const f32x4*)(gm + c0 + 128 * bj + 4) * sc; }
#pragma unroll
        for (int ai = 0; ai < 2; ++ai)
#pragma unroll
            for (int m = 0; m < 4; ++m) { const int row = row0 + ai * 128 + m * 16; float sq = 0.f;
#pragma unroll
                for (int bj = 0; bj < 2; ++bj) { const int col = c0 + 128 * bj;
                    const f32x4 x0 = __builtin_nontemporal_load((const f32x4*)(x + (size_t)row * D + col)), x1v = __builtin_nontemporal_load((const f32x4*)(x + (size_t)row * D + col + 4));
                    f32x4 r0 = x0 + g[bj][0] * acc[ai][bj][m][0], r1 = x1v + g[bj][1] * acc[ai][bj][m][1];
                    const u32x4 pk_ = pack8(r0, r1); unpack8(pk_, r0, r1);
                    *(u32x4*)(x1 + (size_t)row * D + col) = pk_;
                    sq += (r0[0] * r0[0] + r0[1] * r0[1]) + (r0[2] * r0[2] + r0[3] * r0[3]) + (r1[0] * r1[0] + r1[1] * r1[1]) + (r1[2] * r1[2] + r1[3] * r1[3]); }
                sq += __shfl_xor(sq, 16); sq += __shfl_xor(sq, 32);
                if (fq_ == 0) ssq1[(size_t)row * 16 + 4 * u.pn + wc] = sq; }
    }
};
struct EpiHb {
    static constexpr bool MIDK = false;
    unsigned char* hb; float sc;
    __device__ __forceinline__ void operator()(const f32x4 (&acc)[2][2][4][2], const Unit& u, int wr, int wc, int fr, int fq_) const {
        const int row0 = u.pm * 256 + wr * 64 + fr, c0 = u.pn * 128 + wc * 32 + 8 * fq_;
#pragma unroll
        for (int ai = 0; ai < 2; ++ai)
#pragma unroll
            for (int m = 0; m < 4; ++m) { const int row = row0 + ai * 128 + m * 16;
                f32x4 h0, h1;
#pragma unroll
                for (int q = 0; q < 4; ++q) { h0[q] = siluf_(acc[ai][0][m][0][q] * sc) * (acc[ai][1][m][0][q] * (sc * HSCALE8)); h1[q] = siluf_(acc[ai][0][m][1][q] * sc) * (acc[ai][1][m][1][q] * (sc * HSCALE8)); }
                u32x2 o; int p_ = __builtin_amdgcn_cvt_pk_fp8_f32(h0[0], h0[1], 0, false); p_ = __builtin_amdgcn_cvt_pk_fp8_f32(h0[2], h0[3], p_, true); o.x = (unsigned)p_;
                p_ = __builtin_amdgcn_cvt_pk_fp8_f32(h1[0], h1[1], 0, false); p_ = __builtin_amdgcn_cvt_pk_fp8_f32(h1[2], h1[3], p_, true); o.y = (unsigned)p_;
                *(u32x2*)(hb + (size_t)row * DEXP + c0) = o; }
    }
};
struct EpiDown {
    static constexpr bool MIDK = false;
    bf16* Y; float* out; float* outw; const float* mod; const unsigned short* list; const unsigned char* eidx; const float* gatew;
    __device__ __forceinline__ void operator()(const f32x4 (&acc)[2][2][4][2], const Unit& u, int wr, int wc, int fr, int fq_) const {
        const int c0 = u.pn * 256 + wc * 32 + 8 * fq_;
#pragma unroll
        for (int ai = 0; ai < 2; ++ai)
#pragma unroll
            for (int m = 0; m < 4; ++m) {
                const int rl = wr * 64 + fr + ai * 128 + m * 16, idx = u.aux * 256 + rl;
                if (u.e == NEXP) {
                    const int t = idx; const float* gf = mod + (size_t)(t / SEQ) * 6 * D + 5 * D;
#pragma unroll
                    for (int bj = 0; bj < 2; ++bj) { const int col = c0 + 128 * bj; const float* o = out + (size_t)t * D + col; float* ow = outw + (size_t)t * D + col;
                        const f32x4 g0 = *(const f32x4*)(gf + col), g1 = *(const f32x4*)(gf + col + 4);
                        const f32x4 x0 = *(const f32x4*)o, x1v = *(const f32x4*)(o + 4);
                        *(f32x4*)ow = x0 + g0 * acc[ai][bj][m][0]; *(f32x4*)(ow + 4) = x1v + g1 * acc[ai][bj][m][1]; }
                } else if (idx < u.n) {
                    const int t = list[(size_t)u.e * LISTCAP + idx];
                    const u32x2 ev = *(const u32x2*)(eidx + (size_t)t * 8);
                    int k = 0;
#pragma unroll
                    for (int q = 1; q < TOPK; ++q) { const unsigned b = (q < 4) ? ((ev.x >> (8 * q)) & 0xffu) : ((ev.y >> (8 * (q - 4))) & 0xffu); if ((int)b == u.e) k = q; }
                    const float w = gatew[(size_t)t * 8 + k];
#pragma unroll
                    for (int bj = 0; bj < 2; ++bj) *(u32x4*)(Y + ((size_t)t * TOPK + k) * D + c0 + 128 * bj) = pack8(acc[ai][bj][m][0] * w, acc[ai][bj][m][1] * w);
                }
            }
    }
};

template <int NT, bool GATHER_>
struct MoeOrder {
    static constexpr bool GATHER = GATHER_;
    const char* A; const char* Bt; const char* Bsh; int K; size_t bstride;
    const unsigned short* list; volatile LAS int* tab;
    int G, c;
    __device__ bool next(int i, Unit& u) const {
        int ti, pn_;
        if ((G & 7) == 0) { const int x = c & 7, j = i * (G >> 3) + (c >> 3); ti = (j / NT) * 8 + x; pn_ = j % NT; if (ti >= tab[65]) return false; }
        else { const int total = tab[65] * NT; const long L = (long)i * G + c; if (L >= total) return false; ti = (int)L / NT; pn_ = (int)L % NT; }
        u.pn = pn_; u.pm = ti;
        const int e = __builtin_amdgcn_readfirstlane(tab[132 + ti]);
        u.e = e; u.aux = __builtin_amdgcn_readfirstlane(ti - tab[e]); u.n = __builtin_amdgcn_readfirstlane(tab[66 + e]); return true;
    }
    __device__ __forceinline__ const char* a_ptr(const Unit& u) const { return GATHER ? A : A + (size_t)u.pm * 256 * K * 2; }
    __device__ __forceinline__ const char* b_ptr(const Unit& u) const { return (u.e == NEXP ? Bsh : Bt + (size_t)u.e * bstride) + (size_t)u.pn * 256 * K * 2; }
    __device__ __forceinline__ unsigned a_row(const Unit& u, int r) const {
        if (!GATHER) return (unsigned)r;
        const int idx = u.aux * 256 + r;
        if (u.e == NEXP) return (unsigned)idx;
        return (idx < u.n) ? (unsigned)list[(size_t)u.e * LISTCAP + idx] : 0u;
    }
};

struct UpOrder {
    static constexpr bool GATHER = false;
    const char* Aq; const char* Bq; const char* Akv; const char* Bkv; int K; int G, c;
    __device__ bool next(int i, Unit& u) const {
        int L = i * G + c; if (L >= 448) return false;
        if (L < 256) { u.e = 1; u.pm = L >> 2; u.pn = L & 3; } else { L -= 256; u.e = 0; u.pm = L / 3; u.pn = L % 3; }
        u.aux = 0; u.n = 256; return true; }
    __device__ __forceinline__ const char* a_ptr(const Unit& u) const { return (u.e ? Akv : Aq) + (size_t)u.pm * 256 * K * 2; }
    __device__ __forceinline__ const char* b_ptr(const Unit& u) const { return (u.e ? Bkv : Bq) + (size_t)u.pn * 256 * K * 2; }
    __device__ __forceinline__ unsigned a_row(const Unit&, int r) const { return (unsigned)r; }
};
struct EpiUp {
    static constexpr bool MIDK = false;
    EpiQup q; EpiKVup kv;
    __device__ __forceinline__ void operator()(const f32x4 (&acc)[2][2][4][2], const Unit& u, int wr, int wc, int fr, int fq_) const { if (u.e) kv(acc, u, wr, wc, fr, fq_); else q(acc, u, wr, wc, fr, fq_); }
};

struct SharedDownOrder {
    static constexpr bool GATHER = false;
    const char* A; const char* Bt; int K; int G, c;
    __device__ bool next(int i, Unit& u) const { const int L = i * G + c; if (L >= (T / 256) * 4) return false; u.pm = L >> 2; u.pn = L & 3; u.e = NEXP; u.aux = L >> 2; u.n = 256; return true; }
    __device__ __forceinline__ const char* a_ptr(const Unit& u) const { return A + (size_t)u.pm * 256 * K * 2; }
    __device__ __forceinline__ const char* b_ptr(const Unit& u) const { return Bt + (size_t)u.pn * 256 * K * 2; }
    __device__ __forceinline__ unsigned a_row(const Unit&, int r) const { return (unsigned)r; }
};

namespace att {
constexpr int KSLOT = 12288, VSLOT = 8192;
constexpr int L_K = 0, L_V = 3 * KSLOT, L_F = L_V + 2 * VSLOT, L_WS = L_F + 3 * 256, L_OST = L_WS + 2048, L_END = L_OST + 8 * 4096;
static_assert(L_END <= RING_BYTES, "attention LDS");
__device__ __forceinline__ int crow(int r, int hi) { return (r & 3) + 8 * (r >> 2) + 4 * hi; }
__device__ __forceinline__ float max3f(float a, float b, float c) { return fmaxf(fmaxf(a, b), c); }
__device__ __forceinline__ float rowmax(const f32x16& p0, const f32x16& p1) {
    float a = max3f(p0[0], p0[1], p1[0]), b = max3f(p0[2], p0[3], p1[1]); a = max3f(a, p1[2], p1[3]);
#pragma unroll
    for (int r = 4; r < 16; r += 4) { a = max3f(a, p0[r], p0[r + 1]); b = max3f(b, p0[r + 2], p0[r + 3]); a = max3f(a, p1[r], p1[r + 1]); b = max3f(b, p1[r + 2], p1[r + 3]); }
    const float m = fmaxf(a, b);
    auto rr = __builtin_amdgcn_permlane32_swap(__float_as_uint(m), __float_as_uint(m), false, false);
    return fmaxf(__uint_as_float(rr[0]), __uint_as_float(rr[1]));
}
__device__ __forceinline__ void cmask(f32x16& p0, f32x16& p1, int jb, int qrel, int hi) {
    const float NEG = -INFINITY; const int kb = 64 * jb + 4 * hi;
#pragma unroll
    for (int r = 0; r < 16; ++r) { const int kv = kb + (r & 3) + 8 * (r >> 2); if (kv > qrel) p0[r] = NEG; if (kv + 32 > qrel) p1[r] = NEG; }
}
__device__ __forceinline__ void pv(f32x16* o, int vb, bf16x8 pa0, bf16x8 pa1, bf16x8 pa2, bf16x8 pa3) {
#pragma unroll
    for (int d0 = 0; d0 < 2; ++d0) { s16x4 lo[4], hi[4];
#pragma unroll
        for (int ks = 0; ks < 4; ++ks) {
            asm volatile("ds_read_b64_tr_b16 %0,%1 offset:%c2" : "=&v"(lo[ks]) : "v"(vb), "i"(d0 * 4096 + ks * 1024) : "memory");
            asm volatile("ds_read_b64_tr_b16 %0,%1 offset:%c2" : "=&v"(hi[ks]) : "v"(vb), "i"(d0 * 4096 + ks * 1024 + 512) : "memory"); }
        asm volatile("s_waitcnt lgkmcnt(0)" ::: "memory"); __builtin_amdgcn_sched_barrier(0);
#define PK(k) (bf16x8){lo[k][0], lo[k][1], lo[k][2], lo[k][3], hi[k][0], hi[k][1], hi[k][2], hi[k][3]}
        o[d0] = __builtin_amdgcn_mfma_f32_32x32x16_bf16(pa0, PK(0), o[d0], 0, 0, 0);
        o[d0] = __builtin_amdgcn_mfma_f32_32x32x16_bf16(pa1, PK(1), o[d0], 0, 0, 0);
        o[d0] = __builtin_amdgcn_mfma_f32_32x32x16_bf16(pa2, PK(2), o[d0], 0, 0, 0);
        o[d0] = __builtin_amdgcn_mfma_f32_32x32x16_bf16(pa3, PK(3), o[d0], 0, 0, 0);
#undef PK
    }
}
__device__ __forceinline__ unsigned cvtpk_s(float lo, float hi) { return cvt_pk_bf16(lo, hi); }

template <int DQK, bool DECAY, int THRL>
__device__ __forceinline__ void attn_unit(int b, int h, int qb, const bf16* Q, int QP, const bf16* Kn, const bf16* Kpe, const bf16* V, const float* cumF, bf16* O, int OP, LAS unsigned char* lds) {
    constexpr int ND0 = DQK / 16;
    int tid = threadIdx.x; asm volatile("" : "+v"(tid));
    const int lane = tid & 63, r32 = lane & 31, hi = lane >> 5; const int wid = __builtin_amdgcn_readfirstlane(tid >> 6);
    const long rowbase = (long)b * SEQ; const int q0 = qb * 256;
    const bf16* Qw = Q + (rowbase + q0 + wid * 32) * QP + h * DQK;
    const bf16* Kh = Kn + rowbase * 512 + h * 64; const bf16* Vh = V + rowbase * 512 + h * 64;
    const bf16* Kp = Kpe + rowbase * ROPE;
    const float* Fh = DECAY ? cumF + ((size_t)b * NHEAD + h) * SEQ : nullptr;
    LAS float* wsf = (LAS float*)(lds + L_WS) + wid * 64;
    const bf16* ksrc0 = Kh + (long)lane * 512 + wid * 8;
    const bf16* ksrc1 = Kp + (long)lane * ROPE + (wid & 3) * 8;
    const bf16* vsrc = Vh + (long)(16 * (wid & 3) + (lane >> 2)) * 512 + (wid >> 2) * 32 + (lane & 3) * 8;
    const int NT = (q0 + 256) / 64;
#define ATT_DMA_K(i_, s) do { const int t_ = NT - 1 - (i_); \
        __builtin_amdgcn_global_load_lds((const unsigned*)(ksrc0 + (long)t_ * 64 * 512), (LAS unsigned*)(lds + L_K + (s) * KSLOT + wid * 1024), 16, 0, 0); \
        if (DQK == 96 && wid < 4) __builtin_amdgcn_global_load_lds((const unsigned*)(ksrc1 + (long)t_ * 64 * ROPE), (LAS unsigned*)(lds + L_K + (s) * KSLOT + (8 + wid) * 1024), 16, 0, 0); \
        if (DECAY && wid == 7) __builtin_amdgcn_global_load_lds((const unsigned*)(Fh + t_ * 64 + lane), (LAS unsigned*)(lds + L_F + (s) * 256), 4, 0, 0); } while (0)
#define ATT_DMA_V(i_, s) do { const int t_ = NT - 1 - (i_); \
        __builtin_amdgcn_global_load_lds((const unsigned*)(vsrc + (long)t_ * 64 * 512), (LAS unsigned*)(lds + L_V + (s) * VSLOT + wid * 1024), 16, 0, 0); } while (0)
    ATT_DMA_K(0, 0); ATT_DMA_V(0, 0); ATT_DMA_K(1, 1);
    bf16x8 qr[ND0];
#pragma unroll
    for (int d0 = 0; d0 < ND0; ++d0) qr[d0] = *(const bf16x8*)(Qw + (long)r32 * QP + d0 * 16 + hi * 8);
    float fq_l = 0.f; if (DECAY) fq_l = Fh[q0 + wid * 32 + r32];
    float mhat = 0.f, l_reg = 0.f; bool started = false; f32x16 o[2]; o[0] = f32x16{}; o[1] = f32x16{};
    const int qrel = wid * 32 + r32;
    const int vb0 = (int)(uintptr_t)(lds + L_V) + ((lane >> 4) & 1) * 32 + (lane & 3) * 8 + (4 * hi + ((lane & 15) >> 2)) * 64;
#define ATT_QK(P0, P1, ks_) do { const float base_ = fq_l - mhat; \
        if (DECAY) { const LAS f32x4* fk_ = (const LAS f32x4*)(lds + L_F + (ks_) * 256); \
            _Pragma("unroll") for (int g = 0; g < 4; ++g) { const f32x4 a_ = fk_[2 * g + hi], c_ = fk_[8 + 2 * g + hi]; \
                _Pragma("unroll") for (int q = 0; q < 4; ++q) { P0[4 * g + q] = base_ - a_[q]; P1[4 * g + q] = base_ - c_[q]; } } } \
        else { _Pragma("unroll") for (int r = 0; r < 16; ++r) { P0[r] = base_; P1[r] = base_; } } \
        const LAS unsigned char* kb_ = lds + L_K + (ks_) * KSLOT + hi * 1024 + r32 * 16; \
        _Pragma("unroll") for (int d0 = 0; d0 < ND0; ++d0) { \
            const bf16x8 b0_ = *(const LAS bf16x8*)(kb_ + d0 * 2048), b1_ = *(const LAS bf16x8*)(kb_ + d0 * 2048 + 512); \
            P0 = __builtin_amdgcn_mfma_f32_32x32x16_bf16(b0_, qr[d0], P0, 0, 0, 0); P1 = __builtin_amdgcn_mfma_f32_32x32x16_bf16(b1_, qr[d0], P1, 0, 0, 0); } } while (0)
    f32x16 p0, p1, n0, n1;
    int ks_cur = 0, ks_nxt = 1, ks_ld = 2;
    for (int i = 0; i < NT; ++i) {
        const int vs = i & 1;
        VM_WAIT(); __syncthreads();
        if (i + 2 < NT) ATT_DMA_K(i + 2, ks_ld);
        if (i + 1 < NT) ATT_DMA_V(i + 1, vs ^ 1);
        if (i == 0) ATT_QK(p0, p1, 0);
        if (i + 1 < NT) ATT_QK(n0, n1, ks_nxt);
        const int jb = 3 - i;
        if (jb >= 0) cmask(p0, p1, jb, qrel, hi);
        const float rm = rowmax(p0, p1);
        bool resc = false; float dl = 0.f; const bool was_started = started;
        if (jb >= 0) {
            const bool fin = rm > -INFINITY;
            dl = started ? fmaxf(rm, 0.f) : (fin ? rm : 0.f); started = started || fin; resc = true;
        } else if (__any(rm > (float)THRL)) { dl = fmaxf(rm, 0.f); resc = true; }
        if (resc) { mhat += dl;
#pragma unroll
            for (int r = 0; r < 16; ++r) { p0[r] -= dl; p1[r] -= dl; }
            if (i + 1 < NT) {
#pragma unroll
                for (int r = 0; r < 16; ++r) { n0[r] -= dl; n1[r] -= dl; } }
            const float f = was_started ? __builtin_amdgcn_exp2f(-dl) : 1.f; l_reg *= f; if (hi == 0) wsf[r32] = f; }
        float sacc = 0.f;
#pragma unroll
        for (int r = 0; r < 16; ++r) { p0[r] = __builtin_amdgcn_exp2f(p0[r]); p1[r] = __builtin_amdgcn_exp2f(p1[r]); sacc += p0[r] + p1[r]; }
        l_reg += sacc;
        if (resc) { LDS_WAIT();
#pragma unroll
            for (int d_ = 0; d_ < 2; ++d_)
#pragma unroll
                for (int r = 0; r < 16; ++r) o[d_][r] *= wsf[crow(r, hi)]; }
        u32x4 pw0, pw1, pw2, pw3;
        pw0 = (u32x4){cvtpk_s(p0[0], p0[1]), cvtpk_s(p0[2], p0[3]), cvtpk_s(p0[4], p0[5]), cvtpk_s(p0[6], p0[7])};
        pw1 = (u32x4){cvtpk_s(p0[8], p0[9]), cvtpk_s(p0[10], p0[11]), cvtpk_s(p0[12], p0[13]), cvtpk_s(p0[14], p0[15])};
        pw2 = (u32x4){cvtpk_s(p1[0], p1[1]), cvtpk_s(p1[2], p1[3]), cvtpk_s(p1[4], p1[5]), cvtpk_s(p1[6], p1[7])};
        pw3 = (u32x4){cvtpk_s(p1[8], p1[9]), cvtpk_s(p1[10], p1[11]), cvtpk_s(p1[12], p1[13]), cvtpk_s(p1[14], p1[15])};
        __builtin_amdgcn_sched_barrier(0);
        pv(o, vb0 + vs * VSLOT, __builtin_bit_cast(bf16x8, pw0), __builtin_bit_cast(bf16x8, pw1), __builtin_bit_cast(bf16x8, pw2), __builtin_bit_cast(bf16x8, pw3));
        p0 = n0; p1 = n1;
        { const int t_ = ks_cur; ks_cur = ks_nxt; ks_nxt = ks_ld; ks_ld = t_; }
    }
    { auto rr = __builtin_amdgcn_permlane32_swap(__float_as_uint(l_reg), __float_as_uint(l_reg), false, false); l_reg = __uint_as_float(rr[0]) + __uint_as_float(rr[1]); }
    if (hi == 0) wsf[32 + r32] = l_reg; LDS_WAIT();
    float rli[16];
#pragma unroll
    for (int r = 0; r < 16; ++r) rli[r] = __builtin_amdgcn_rcpf(wsf[32 + crow(r, hi)]);
    unsigned char* Ow = (unsigned char*)O + (rowbase + q0 + wid * 32) * OP + h * 64;
    { LAS unsigned char* stg = lds + L_OST + wid * 4096;
#pragma unroll
      for (int r = 0; r < 16; ++r) { const int orow = crow(r, hi);
#pragma unroll
          for (int d0 = 0; d0 < 2; ++d0) { const float ov = o[d0][r] * rli[r] * OSCALE8; stg[orow * 64 + d0 * 32 + r32] = (unsigned char)__builtin_amdgcn_cvt_pk_fp8_f32(ov, ov, 0, false); } }
      LDS_WAIT();
#pragma unroll
      for (int i = 0; i < 2; ++i) { const int row = i * 16 + (lane >> 2), ch = lane & 3; const u32x4 v = *(const LAS u32x4*)(stg + row * 64 + ch * 16); *(u32x4*)(Ow + (long)row * OP + ch * 16) = v; } }
    LDS_WAIT(); __syncthreads();
#undef ATT_DMA_K
#undef ATT_DMA_V
#undef ATT_QK
}

constexpr int T_KSLOT = 12288, T_VSLOT = 8192, T_NSLOT = 3;
constexpr int T_K = 0, T_V = T_NSLOT * T_KSLOT, T_F = T_V + T_NSLOT * T_VSLOT, T_WS = T_F + T_NSLOT * 256, T_OST = T_WS + 2048, T_END = T_OST + 8 * 4096;
static_assert(T_END <= RING_BYTES, "attention LDS (hand-interleaved unit)");
typedef __attribute__((address_space(3))) const char* lds_cptr;
typedef short v4i16_t __attribute__((ext_vector_type(4)));
__device__ __forceinline__ s16x4 vtr(lds_cptr p) { return __builtin_bit_cast(s16x4, __builtin_amdgcn_ds_read_tr16_b64_v4i16((__attribute__((address_space(3))) v4i16_t*)p)); }
__device__ __forceinline__ void kload2(bf16x8* kf, lds_cptr kp, int j) { kf[2 * j] = *(const __attribute__((address_space(3))) bf16x8*)(kp + j * 2048); kf[2 * j + 1] = *(const __attribute__((address_space(3))) bf16x8*)(kp + j * 2048 + 512); }
#define TW_BAR(N) asm volatile("s_waitcnt vmcnt(" #N ") lgkmcnt(0)\n\ts_barrier" ::: "memory")
#define TSB() __builtin_amdgcn_sched_barrier(0)

template <int DQK, bool DECAY, int THRL>
__device__ __forceinline__ void attn_unit_t(int b, int h, int qb, const bf16* Q, int QP, const bf16* Kn, const bf16* Kpe, const bf16* V, const float* cumF, float kmax2, bf16* O, int OP, LAS unsigned char* lds) {
    constexpr int ND0 = DQK / 16;
    constexpr bool INPL = DECAY || (DQK == 96);
    int tid = threadIdx.x; asm volatile("" : "+v"(tid));
    const int lane = tid & 63, r32 = lane & 31, hi = lane >> 5; const int wid = __builtin_amdgcn_readfirstlane(tid >> 6);
    const long rowbase = (long)b * SEQ; const int q0 = qb * 256;
    const bf16* Qw = Q + (rowbase + q0 + wid * 32) * QP + h * DQK;
    const bf16* Kh = Kn + rowbase * 512 + h * 64; const bf16* Vh = V + rowbase * 512 + h * 64;
    const bf16* Kp = Kpe + rowbase * ROPE;
    const float* Fh = DECAY ? cumF + ((size_t)b * NHEAD + h) * SEQ : nullptr;
    LAS float* wsf = (LAS float*)(lds + T_WS) + wid * 64;
    const bf16* ksrc0 = Kh + (long)lane * 512 + wid * 8;
    const bf16* ksrc1 = Kp + (long)lane * ROPE + (wid & 3) * 8;
    const bf16* vsrc = Vh + (long)(16 * (wid & 3) + (lane >> 2)) * 512 + (wid >> 2) * 32 + (lane & 3) * 8;
    const int NTS = (q0 + 256) / 64;
#define TDMA_K(i_, sk) do { const int t_ = NTS - 1 - (i_); \
        __builtin_amdgcn_global_load_lds((const unsigned*)(ksrc0 + (long)t_ * 64 * 512), (LAS unsigned*)(lds + T_K + (sk) * T_KSLOT + wid * 1024), 16, 0, 0); \
        if (DECAY) __builtin_amdgcn_global_load_lds((const unsigned*)(Fh + t_ * 64 + lane), (LAS unsigned*)(lds + T_F + (sk) * 256), 4, 0, 0); \
        else __builtin_amdgcn_global_load_lds((const unsigned*)(ksrc1 + (long)t_ * 64 * ROPE), (LAS unsigned*)(lds + T_K + (sk) * T_KSLOT + (8 + (wid & 3)) * 1024), 16, 0, 0); } while (0)
#define TDMA_V(i_, sv) do { const int t_ = NTS - 1 - (i_); \
        __builtin_amdgcn_global_load_lds((const unsigned*)(vsrc + (long)t_ * 64 * 512), (LAS unsigned*)(lds + T_V + (sv) * T_VSLOT + wid * 1024), 16, 0, 0); } while (0)
    TDMA_K(0, 0); TDMA_V(0, 0); TDMA_K(1, 1);
    bf16x8 qr[ND0];
#pragma unroll
    for (int d0 = 0; d0 < ND0; ++d0) qr[d0] = *(const bf16x8*)(Qw + (long)r32 * QP + d0 * 16 + hi * 8);
    float fq_l = 0.f; if (DECAY) fq_l = Fh[q0 + wid * 32 + r32];
    float ftile = 0.f; if (DECAY) ftile = Fh[(lane < NTS ? lane : NTS - 1) * 64 + 63];
    float mhat = 0.f, l_reg = 0.f; f32x16 o[2]; o[0] = f32x16{}; o[1] = f32x16{};
    f32x16 negm = f32x16{}; asm volatile("" : "+v"(negm));
    const int qrel = wid * 32 + r32, i0 = 3 - (wid >> 1);
    const lds_cptr shm3 = (lds_cptr)lds; const lds_cptr kp0 = shm3 + T_K + hi * 1024 + r32 * 16;
    const lds_cptr vp0 = shm3 + T_V + ((lane >> 4) & 1) * 32 + (lane & 3) * 8 + (4 * hi + ((lane & 15) >> 2)) * 64;
    const int vb0 = (int)(uintptr_t)(lds + T_V) + ((lane >> 4) & 1) * 32 + (lane & 3) * 8 + (4 * hi + ((lane & 15) >> 2)) * 64;
    bool resc = false;
    bf16x8 kf[2 * ND0];
    f32x16 pA0, pA1, pB0, pB1;
    int sl_prev = 0, sl_cur = 0, sl_next = 1;
#define TROT() do { sl_prev = sl_cur; sl_cur = sl_next; sl_next = (sl_next == T_NSLOT - 1) ? 0 : sl_next + 1; } while (0)
#define TBIAS(X0, X1, fs_) do { if (DECAY) { const float base_ = fq_l - mhat; const LAS f32x4* fk_ = (const LAS f32x4*)(lds + T_F + (fs_) * 256); \
        _Pragma("unroll") for (int g = 0; g < 4; ++g) { const f32x4 a_ = fk_[2 * g + hi], c_ = fk_[8 + 2 * g + hi]; \
            _Pragma("unroll") for (int q = 0; q < 4; ++q) { X0[4 * g + q] = base_ - a_[q]; X1[4 * g + q] = base_ - c_[q]; } } } \
        else if (INPL) { const float nm_ = -mhat; _Pragma("unroll") for (int r = 0; r < 16; ++r) { X0[r] = nm_; X1[r] = nm_; } } } while (0)
#define TCIN(X) (INPL ? X : negm)
#define TRESC() do { if (resc) { asm volatile("s_waitcnt lgkmcnt(0)" ::: "memory"); \
        _Pragma("unroll") for (int d_ = 0; d_ < 2; ++d_) _Pragma("unroll") for (int r = 0; r < 16; ++r) o[d_][r] *= wsf[crow(r, hi)]; } } while (0)
#define TDECIDE(C0, C1, i_) do { \
        float a_ = max3f(C0[0], C0[1], C1[0]), b_ = max3f(C0[2], C0[3], C1[1]); a_ = max3f(a_, C1[2], C1[3]); \
        _Pragma("unroll") for (int r = 4; r < 16; r += 4) { a_ = max3f(a_, C0[r], C0[r + 1]); b_ = max3f(b_, C0[r + 2], C0[r + 3]); a_ = max3f(a_, C1[r], C1[r + 1]); b_ = max3f(b_, C1[r + 2], C1[r + 3]); } \
        float rm_ = fmaxf(a_, b_); { auto rr_ = __builtin_amdgcn_permlane32_swap(__float_as_uint(rm_), __float_as_uint(rm_), false, false); rm_ = fmaxf(__uint_as_float(rr_[0]), __uint_as_float(rr_[1])); } \
        resc = false; \
        if ((i_) == i0) { const float dl_ = rm_; mhat += dl_; \
            _Pragma("unroll") for (int r = 0; r < 16; ++r) { C0[r] -= dl_; C1[r] -= dl_; } \
            if (!INPL) { _Pragma("unroll") for (int r = 0; r < 16; ++r) negm[r] = -mhat; asm volatile("" : "+v"(negm)); } } \
        else if (__builtin_expect(__any(rm_ > (float)THRL), 0)) { const float dl_ = fmaxf(rm_, 0.f); mhat += dl_; \
            _Pragma("unroll") for (int r = 0; r < 16; ++r) { C0[r] -= dl_; C1[r] -= dl_; } \
            if (!INPL) { _Pragma("unroll") for (int r = 0; r < 16; ++r) negm[r] = -mhat; asm volatile("" : "+v"(negm)); } \
            const float f_ = __builtin_amdgcn_exp2f(-dl_); l_reg *= f_; if (hi == 0) wsf[r32] = f_; resc = true; } } while (0)
    TDMA_K(2, 2);
    TW_BAR(5);
    int NT = NTS;
    if (DECAY) {
        const float bound = 2.f * __builtin_sqrtf(kmax2) * 1.0001f + 1.f + (Fh[q0] - ftile);
        const unsigned long long need = __ballot(lane < NTS && bound >= -160.f);
        const int tmin = need ? (int)__builtin_ctzll(need) : NTS - 1;
        NT = NTS - tmin; NT += NT & 1; if (NT < 8) NT = 8; if (NT > NTS) NT = NTS;
        NT = __builtin_amdgcn_readfirstlane(NT); }
    TBIAS(pA0, pA1, 0);
    { const lds_cptr kb = kp0;
#pragma unroll
      for (int d0 = 0; d0 < ND0; ++d0) { const bf16x8 b0 = *(const __attribute__((address_space(3))) bf16x8*)(kb + d0 * 2048), b1 = *(const __attribute__((address_space(3))) bf16x8*)(kb + d0 * 2048 + 512);
          if (d0 == 0) { pA0 = __builtin_amdgcn_mfma_f32_32x32x16_bf16(b0, qr[0], TCIN(pA0), 0, 0, 0); pA1 = __builtin_amdgcn_mfma_f32_32x32x16_bf16(b1, qr[0], TCIN(pA1), 0, 0, 0); }
          else { pA0 = __builtin_amdgcn_mfma_f32_32x32x16_bf16(b0, qr[d0], pA0, 0, 0, 0); pA1 = __builtin_amdgcn_mfma_f32_32x32x16_bf16(b1, qr[d0], pA1, 0, 0, 0); } } }
    cmask(pA0, pA1, 3, qrel, hi);
    TDECIDE(pA0, pA1, 0);
#pragma unroll
    for (int r = 0; r < 16; ++r) { pA0[r] = __builtin_amdgcn_exp2f(pA0[r]); pA1[r] = __builtin_amdgcn_exp2f(pA1[r]); }
    TW_BAR(0);
    TDMA_K(3, 0); TDMA_V(1, 1);
    TROT();
#pragma unroll
    for (int j = 0; j < ND0; ++j) kload2(kf, kp0 + sl_cur * T_KSLOT, j);
    TBIAS(pB0, pB1, sl_cur);
    TW_BAR(3);
    s16x4 vlo[8], vhi[8]; u32x4 pw0, pw1, pw2, pw3;
#define TPKW(P, B) cvt_pk_bf16(P[B], P[B + 1])
#define TPAF(k) __builtin_bit_cast(bf16x8, pw##k)
#define TVFR(i) (bf16x8){vlo[i][0], vlo[i][1], vlo[i][2], vlo[i][3], vhi[i][0], vhi[i][1], vhi[i][2], vhi[i][3]}
#define TPIN(x) asm volatile("" : "+v"(x))
#define TGAPA(MF, A0, A1, A2, A3, W0, W1, PW) do { MF; sacc += A0; sacc += A1; sacc += A2; sacc += A3; TPIN(sacc); W0; W1; TPIN(PW); TSB(); } while (0)
#define TEX(v) __builtin_amdgcn_exp2f(v)
#define TGAPB(MF, X, B) do { MF; X[B] = TEX(X[B]); X[B + 1] = TEX(X[B + 1]); X[B + 2] = TEX(X[B + 2]); X[B + 3] = TEX(X[B + 3]); TPIN(X); TSB(); } while (0)
#define TVRD(i) do { vlo[i] = vtr(vp_ + (((i) >> 2) * 4096 + ((i) & 3) * 1024)); vhi[i] = vtr(vp_ + (((i) >> 2) * 4096 + ((i) & 3) * 1024 + 512)); } while (0)
#define TKRD(G, j) do { if (G) { kload2(kf, kp0 + sl_next * T_KSLOT, j); TSB(); } } while (0)
#define TMF(a, b, c) __builtin_amdgcn_mfma_f32_32x32x16_bf16(a, b, c, 0, 0, 0)
#define TSTEP(C0, C1, P0, P1, i_, MJB, GK, GV, GL) do { TSB(); \
        const lds_cptr vp_ = vp0 + sl_prev * T_VSLOT; \
        TVRD(0); TSB(); float sacc = (P0[0] + P0[1]); \
        TGAPA(C0 = TMF(kf[0], qr[0], TCIN(C0)), P0[2], P0[3], P0[4], P0[5],     pw0[0] = TPKW(P0, 0), pw0[1] = TPKW(P0, 2), pw0); \
        TVRD(4); TSB(); TGAPA(C1 = TMF(kf[1], qr[0], TCIN(C1)), P0[6], P0[7], P0[8], P0[9],     pw0[2] = TPKW(P0, 4), pw0[3] = TPKW(P0, 6), pw0); \
        TVRD(1); TSB(); TGAPA(C0 = TMF(kf[2], qr[1], C0),   P0[10], P0[11], P0[12], P0[13], pw1[0] = TPKW(P0, 8), pw1[1] = TPKW(P0, 10), pw1); \
        TVRD(5); TSB(); TGAPA(C1 = TMF(kf[3], qr[1], C1),   P0[14], P0[15], P1[0], P1[1],   pw1[2] = TPKW(P0, 12), pw1[3] = TPKW(P0, 14), pw1); \
        TVRD(2); TSB(); TGAPA(C0 = TMF(kf[4], qr[2], C0),   P1[2], P1[3], P1[4], P1[5],     pw2[0] = TPKW(P1, 0), pw2[1] = TPKW(P1, 2), pw2); \
        TVRD(6); TSB(); TGAPA(C1 = TMF(kf[5], qr[2], C1),   P1[6], P1[7], P1[8], P1[9],     pw2[2] = TPKW(P1, 4), pw2[3] = TPKW(P1, 6), pw2); \
        TVRD(3); TSB(); TGAPA(C0 = TMF(kf[6], qr[3], C0),   P1[10], P1[11], P1[12], P1[13], pw3[0] = TPKW(P1, 8), pw3[1] = TPKW(P1, 10), pw3); \
        TVRD(7); TSB(); TGAPA(C1 = TMF(kf[7], qr[3], C1),   P1[14], P1[15], 0.f, 0.f,       pw3[2] = TPKW(P1, 12), pw3[3] = TPKW(P1, 14), pw3); \
        if (ND0 == 6) { C0 = TMF(kf[2 * ND0 - 4], qr[ND0 - 2], C0); C1 = TMF(kf[2 * ND0 - 3], qr[ND0 - 2], C1); C0 = TMF(kf[2 * ND0 - 2], qr[ND0 - 1], C0); C1 = TMF(kf[2 * ND0 - 1], qr[ND0 - 1], C1); TSB(); } \
        l_reg += sacc; \
        if (GK) { TDMA_K((i_) + 3, sl_cur); } if (GV) { TDMA_V((i_) + 1, sl_next); } \
        if ((MJB) >= 0) cmask(C0, C1, (MJB), qrel, hi); \
        TDECIDE(C0, C1, i_); \
        TSB(); \
        TGAPB(o[0] = TMF(TPAF(0), TVFR(0), o[0]), C0, 0); \
        TKRD(GL, 0); TGAPB(o[1] = TMF(TPAF(0), TVFR(4), o[1]), C0, 4); \
        TKRD(GL, 1); TGAPB(o[0] = TMF(TPAF(1), TVFR(1), o[0]), C0, 8); \
        TKRD(GL, 2); TGAPB(o[1] = TMF(TPAF(1), TVFR(5), o[1]), C0, 12); \
        TKRD(GL, 3); TGAPB(o[0] = TMF(TPAF(2), TVFR(2), o[0]), C1, 0); \
        if (ND0 == 6) { TKRD(GL, ND0 - 2); } TGAPB(o[1] = TMF(TPAF(2), TVFR(6), o[1]), C1, 4); \
        if (ND0 == 6) { TKRD(GL, ND0 - 1); } TGAPB(o[0] = TMF(TPAF(3), TVFR(3), o[0]), C1, 8); \
        TGAPB(o[1] = TMF(TPAF(3), TVFR(7), o[1]), C1, 12); \
        if (GL) { TBIAS(P0, P1, sl_next); } \
    } while (0)
#define TENDW(tt) do { if ((tt) + 3 < NT) { TW_BAR(3); } else if ((tt) + 2 < NT) { TW_BAR(1); } else { TW_BAR(0); } } while (0)
    TSTEP(pB0, pB1, pA0, pA1, 1, 2, (1 + 3 < NT), true, true); TENDW(1); TRESC(); TROT();
    TSTEP(pA0, pA1, pB0, pB1, 2, 1, (2 + 3 < NT), true, true); TENDW(2); TRESC(); TROT();
    {
        TSTEP(pB0, pB1, pA0, pA1, 3, 0, (3 + 3 < NT), true, true); TENDW(3); TRESC(); TROT();
        int i = 4;
        for (; i + 2 < NT; i += 2) {
            TSTEP(pA0, pA1, pB0, pB1, i, -1, (i + 3 < NT), true, true);                         TENDW(i);     TRESC(); TROT();
            TSTEP(pB0, pB1, pA0, pA1, i + 1, -1, (i + 4 < NT), (i + 2 < NT), (i + 2 < NT));     TENDW(i + 1); TRESC(); TROT();
        }
        TSTEP(pA0, pA1, pB0, pB1, NT - 2, -1, false, true, true); TENDW(NT - 2); TRESC(); TROT();
        TSTEP(pB0, pB1, pA0, pA1, NT - 1, -1, false, false, false); TRESC();
    }
    { float sacc = pB0[0] + pB0[1];
#pragma unroll
      for (int r = 2; r < 16; ++r) sacc += pB0[r];
#pragma unroll
      for (int r = 0; r < 16; ++r) sacc += pB1[r];
      l_reg += sacc;
      pw0 = (u32x4){TPKW(pB0, 0), TPKW(pB0, 2), TPKW(pB0, 4), TPKW(pB0, 6)}; pw1 = (u32x4){TPKW(pB0, 8), TPKW(pB0, 10), TPKW(pB0, 12), TPKW(pB0, 14)};
      pw2 = (u32x4){TPKW(pB1, 0), TPKW(pB1, 2), TPKW(pB1, 4), TPKW(pB1, 6)}; pw3 = (u32x4){TPKW(pB1, 8), TPKW(pB1, 10), TPKW(pB1, 12), TPKW(pB1, 14)};
      TSB(); pv(o, vb0 + sl_cur * T_VSLOT, TPAF(0), TPAF(1), TPAF(2), TPAF(3)); }
    { auto rr = __builtin_amdgcn_permlane32_swap(__float_as_uint(l_reg), __float_as_uint(l_reg), false, false); l_reg = __uint_as_float(rr[0]) + __uint_as_float(rr[1]); }
    if (hi == 0) wsf[32 + r32] = l_reg; asm volatile("s_waitcnt lgkmcnt(0)" ::: "memory");
    float rli[16];
#pragma unroll
    for (int r = 0; r < 16; ++r) rli[r] = __builtin_amdgcn_rcpf(wsf[32 + crow(r, hi)]);
    unsigned char* Ow = (unsigned char*)O + (rowbase + q0 + wid * 32) * OP + h * 64;
    { LAS unsigned char* stg = lds + T_OST + wid * 4096;
#pragma unroll
      for (int r = 0; r < 16; ++r) { const int orow = crow(r, hi);
#pragma unroll
          for (int d0 = 0; d0 < 2; ++d0) { const float ov = o[d0][r] * rli[r] * OSCALE8; stg[orow * 64 + d0 * 32 + r32] = (unsigned char)__builtin_amdgcn_cvt_pk_fp8_f32(ov, ov, 0, false); } }
      asm volatile("s_waitcnt lgkmcnt(0)" ::: "memory");
#pragma unroll
      for (int i = 0; i < 2; ++i) { const int row = i * 16 + (lane >> 2), ch = lane & 3; const u32x4 v = *(const LAS u32x4*)(stg + row * 64 + ch * 16); *(u32x4*)(Ow + (long)row * OP + ch * 16) = v; } }
    asm volatile("s_waitcnt lgkmcnt(0)\n\ts_barrier" ::: "memory");
#undef TDMA_K
#undef TDMA_V
#undef TROT
#undef TBIAS
#undef TCIN
#undef TRESC
#undef TDECIDE
#undef TPKW
#undef TPAF
#undef TVFR
#undef TPIN
#undef TGAPA
#undef TEX
#undef TGAPB
#undef TVRD
#undef TKRD
#undef TMF
#undef TSTEP
#undef TENDW
}
#undef TW_BAR
#undef TSB
}

namespace dn {
constexpr int CHB = 64 * 256;
constexpr int NSLOT = 8, AHEAD = 7;
__device__ __forceinline__ int nloc(int i) { return 16 * ((i >> 2) & 1) + (i & 3) + 4 * (i >> 3); }
template <bool NOTRAFFIC>
__device__ __forceinline__ void down_phase(LAS unsigned char* lds, const unsigned char* HBp, const unsigned char* Wd, const unsigned char* Wsd, volatile LAS int* tab, const u32x2* meta, unsigned char* Yp, unsigned char* trash, int G, int c) {
    int tid = threadIdx.x; asm volatile("" : "+v"(tid));
    const int wid = __builtin_amdgcn_readfirstlane(tid >> 6), lane = tid & 63, j = lane & 31, hi = lane >> 5;
    const int U = tab[65] * 8;
    const int u_lo = (int)(((long)c * U) / G), u_hi = (int)(((long)(c + 1) * U) / G);
    if (u_lo >= u_hi) return;
#define DN_DEC(u_, e_, hf_, ci_) do { e_ = __builtin_amdgcn_readfirstlane(tab[132 + ((u_) >> 3)]); const int ul_ = __builtin_amdgcn_readfirstlane((u_) - 8 * tab[e_]), nc_ = __builtin_amdgcn_readfirstlane(4 * (tab[e_ + 1] - tab[e_])); hf_ = (ul_ >= nc_) ? 1 : 0; ci_ = ul_ - hf_ * nc_; } while (0)
    unsigned dvo; { const int r_ = lane >> 3, f_ = ((r_ >> 1) & 3) << 1; dvo = (unsigned)(r_ * 256 + (((lane & 7) ^ f_) * 16)); }
#define DN_DMA(u_, buf_) do { int e__, hf__, ci__; DN_DEC(u_, e__, hf__, ci__); (void)hf__; const unsigned char* gb_ = HBp + ((size_t)tab[e__] * 256 + (size_t)ci__ * 64) * DEXP; \
        _Pragma("unroll") for (int i_ = 0; i_ < 2; ++i_) { const int q_ = wid * 2 + i_, kb_ = q_ >> 3, g_ = q_ & 7; \
            __builtin_amdgcn_global_load_lds((const unsigned*)(gb_ + (size_t)(8 * g_) * DEXP + kb_ * 128 + dvo), (LAS unsigned*)(lds + (buf_) * CHB + kb_ * 8192 + g_ * 1024), 16, 0, 0); } } while (0)
    int rowb[2], fx[2];
#pragma unroll
    for (int rt = 0; rt < 2; ++rt) { const int row = 32 * rt + j; rowb[rt] = (int)(uintptr_t)lds + row * 128; fx[rt] = (((row >> 1) & 3) << 1) * 16; }
    unsigned sc1 = 0x7f7f7f7fu; asm volatile("" : "+v"(sc1));
#pragma unroll
    for (int p = 0; p < AHEAD; ++p) { const int un = (u_lo + p < u_hi) ? u_lo + p : u_lo; DN_DMA(un, p); }
    if (wid >= 4) __builtin_amdgcn_s_barrier();
    int u = u_lo;
    while (u < u_hi) {
      int e, hf, ci0; DN_DEC(u, e, hf, ci0);
      const int nc = __builtin_amdgcn_readfirstlane(4 * (tab[e + 1] - tab[e])), ne = __builtin_amdgcn_readfirstlane(tab[66 + e]);
      int seg_end = 8 * tab[e] + (hf + 1) * nc; seg_end = __builtin_amdgcn_readfirstlane(seg_end < u_hi ? seg_end : u_hi);
      v8i32_t wfr[2][4];
#pragma unroll
      for (int nt = 0; nt < 2; ++nt) { const unsigned char* wp = ((e == NEXP) ? Wsd : Wd + (size_t)e * D * DEXP) + (size_t)(512 * hf + 64 * wid + 32 * nt + nloc(j)) * DEXP + 32 * hi;
#pragma unroll
          for (int ks = 0; ks < 4; ++ks) { wfr[nt][ks].lo = *(const v4i32_t*)(wp + 64 * ks); wfr[nt][ks].hi = *(const v4i32_t*)(wp + 64 * ks + 16); } }
      bool first = true;
      for (; u < seg_end; ++u) {
        const int buf = (u - u_lo) & (NSLOT - 1); (void)ci0;
        const int cidx = __builtin_amdgcn_readfirstlane((u - 8 * tab[e]) - hf * nc);
        u32x2 mt[2];
#pragma unroll
        for (int rt = 0; rt < 2; ++rt) { int pos = 64 * cidx + 32 * rt + j; const bool in = pos < ne; const int sp = pos; pos = (in && e != NEXP) ? pos : 0; const u32x2 m = meta[(size_t)(e == NEXP ? 0 : e) * LISTCAP + pos];
            mt[rt] = !in ? (u32x2){0xffffffffu, 0u} : (e == NEXP) ? (u32x2){(unsigned)(sp * (TOPK + 1) + TOPK), 0x3f800000u} : m; }
        if (first) { __builtin_amdgcn_s_waitcnt(0x0F70); first = false; }
        LDS_WAIT(); __builtin_amdgcn_s_barrier();
        { const int un = (u + AHEAD < u_hi) ? u + AHEAD : u; DN_DMA(un, (buf + AHEAD) & (NSLOT - 1)); }
        f32x16 acc[2][2];
#pragma unroll
        for (int rt = 0; rt < 2; ++rt)
#pragma unroll
            for (int nt = 0; nt < 2; ++nt) asm volatile("v_mov_b32 %0, 0\n\tv_mov_b32 %1, 0\n\tv_mov_b32 %2, 0\n\tv_mov_b32 %3, 0\n\tv_mov_b32 %4, 0\n\tv_mov_b32 %5, 0\n\tv_mov_b32 %6, 0\n\tv_mov_b32 %7, 0\n\tv_mov_b32 %8, 0\n\tv_mov_b32 %9, 0\n\tv_mov_b32 %10, 0\n\tv_mov_b32 %11, 0\n\tv_mov_b32 %12, 0\n\tv_mov_b32 %13, 0\n\tv_mov_b32 %14, 0\n\tv_mov_b32 %15, 0"
                : "=v"(acc[rt][nt][0]), "=v"(acc[rt][nt][1]), "=v"(acc[rt][nt][2]), "=v"(acc[rt][nt][3]), "=v"(acc[rt][nt][4]), "=v"(acc[rt][nt][5]), "=v"(acc[rt][nt][6]), "=v"(acc[rt][nt][7]),
                  "=v"(acc[rt][nt][8]), "=v"(acc[rt][nt][9]), "=v"(acc[rt][nt][10]), "=v"(acc[rt][nt][11]), "=v"(acc[rt][nt][12]), "=v"(acc[rt][nt][13]), "=v"(acc[rt][nt][14]), "=v"(acc[rt][nt][15]));
        v8i32_t ha0, ha1, hb0, hb1;
        const int ad0 = rowb[0] + buf * CHB, ad1 = rowb[1] + buf * CHB;
#define DN_RDA(ks_) do { \
            asm volatile("ds_read_b128 v[192:195], %1 offset:%c2\n\tds_read_b128 v[196:199], %1 offset:%c3" : "={v[192:199]}"(ha0) : "v"(ad0 + ((64 * ((ks_) & 1) + 32 * hi) ^ fx[0])), "i"(((ks_) >> 1) * 8192), "i"(((ks_) >> 1) * 8192 + 16) : "memory"); \
            asm volatile("ds_read_b128 v[200:203], %1 offset:%c2\n\tds_read_b128 v[204:207], %1 offset:%c3" : "={v[200:207]}"(ha1) : "v"(ad1 + ((64 * ((ks_) & 1) + 32 * hi) ^ fx[1])), "i"(((ks_) >> 1) * 8192), "i"(((ks_) >> 1) * 8192 + 16) : "memory"); } while (0)
#define DN_RDB(ks_) do { \
            asm volatile("ds_read_b128 v[208:211], %1 offset:%c2\n\tds_read_b128 v[212:215], %1 offset:%c3" : "={v[208:215]}"(hb0) : "v"(ad0 + ((64 * ((ks_) & 1) + 32 * hi) ^ fx[0])), "i"(((ks_) >> 1) * 8192), "i"(((ks_) >> 1) * 8192 + 16) : "memory"); \
            asm volatile("ds_read_b128 v[216:219], %1 offset:%c2\n\tds_read_b128 v[220:223], %1 offset:%c3" : "={v[216:223]}"(hb1) : "v"(ad1 + ((64 * ((ks_) & 1) + 32 * hi) ^ fx[1])), "i"(((ks_) >> 1) * 8192), "i"(((ks_) >> 1) * 8192 + 16) : "memory"); } while (0)
#define DN_MF(W_, ACC_, H_, REG_, WAIT_) asm volatile(WAIT_ "v_mfma_scale_f32_32x32x64_f8f6f4 %0, %1, %2, %0, %3, %3 op_sel_hi:[0,0,0]" : "+v"(ACC_) : "v"(W_), REG_(H_), "v"(sc1))
        DN_RDA(0);
#pragma unroll
        for (int ks = 0; ks < 4; ks += 2) {
            DN_RDB(ks + 1);
            DN_MF(wfr[0][ks], acc[0][0], ha0, "{v[192:199]}", "s_waitcnt lgkmcnt(4)\n\t"); DN_MF(wfr[1][ks], acc[0][1], ha0, "{v[192:199]}", "");
            DN_MF(wfr[0][ks], acc[1][0], ha1, "{v[200:207]}", ""); DN_MF(wfr[1][ks], acc[1][1], ha1, "{v[200:207]}", "");
            if (ks + 2 < 4) { DN_RDA(ks + 2);
                DN_MF(wfr[0][ks + 1], acc[0][0], hb0, "{v[208:215]}", "s_waitcnt lgkmcnt(4)\n\t"); }
            else { DN_MF(wfr[0][ks + 1], acc[0][0], hb0, "{v[208:215]}", "s_waitcnt lgkmcnt(0)\n\t"); }
            DN_MF(wfr[1][ks + 1], acc[0][1], hb0, "{v[208:215]}", "");
            DN_MF(wfr[0][ks + 1], acc[1][0], hb1, "{v[216:223]}", ""); DN_MF(wfr[1][ks + 1], acc[1][1], hb1, "{v[216:223]}", "");
        }
#undef DN_RDA
#undef DN_RDB
#undef DN_MF
        asm volatile("s_waitcnt vmcnt(48)" ::: "memory");
        __builtin_amdgcn_s_barrier();
        asm volatile("s_nop 15\n\ts_nop 7" : "+v"(acc[0][0]), "+v"(acc[0][1]), "+v"(acc[1][0]), "+v"(acc[1][1]) :: "memory");
        __builtin_amdgcn_sched_barrier(0);
        const int col0 = 512 * hf + 64 * wid + 16 * hi;
#pragma unroll
        for (int rt = 0; rt < 2; ++rt) { const bool ok = !NOTRAFFIC && mt[rt].x != 0xffffffffu; unsigned char* yd = ok ? Yp + (size_t)mt[rt].x * D : trash; const float w = ok ? __uint_as_float(mt[rt].y) * (1.f / (HSCALE8 * WSCALE8)) : 0.f;
#pragma unroll
            for (int nt = 0; nt < 2; ++nt) { u32x4 o;
#pragma unroll
                for (int q = 0; q < 4; ++q) { int v = __builtin_amdgcn_cvt_pk_fp8_f32(acc[rt][nt][4 * q] * w, acc[rt][nt][4 * q + 1] * w, 0, false);
                    v = __builtin_amdgcn_cvt_pk_fp8_f32(acc[rt][nt][4 * q + 2] * w, acc[rt][nt][4 * q + 3] * w, v, true); o[q] = (unsigned)v; }
                *(u32x4*)(yd + col0 + 32 * nt) = o; } }
      }
    }
    if (wid < 4) __builtin_amdgcn_s_barrier();
    VM_WAIT(); LDS_WAIT(); __builtin_amdgcn_s_barrier();
#undef DN_DMA
#undef DN_DEC
}
}

namespace up {
__device__ __forceinline__ int nloc(int i) { return 16 * ((i >> 2) & 1) + (i & 3) + 4 * (i >> 3); }
__device__ __forceinline__ void up_phase(LAS unsigned char* lds, const bf16* QL, const bf16* KVL, const bf16* Wq, const bf16* Wkv, const float* ssqq, const float* ssqkv, const float* ropetab,
                                         bf16* Qo, bf16* KNo, bf16* VMo, int G, int c) {
    int tid = threadIdx.x; asm volatile("" : "+v"(tid));
    const int wid = __builtin_amdgcn_readfirstlane(tid >> 6), lane = tid & 63, j = lane & 31, hi = lane >> 5;
    for (int grp = c; grp < T / 64; grp += G) {
        const int row0 = grp * 64;
        { const int r_ = lane >> 3, p_ = lane & 7;
#pragma unroll
          for (int i = 0; i < 6; ++i) { const int q_ = wid * 6 + i;
              const bool isq = q_ < 32; const int rem = isq ? q_ : q_ - 32, kb = rem >> 3, g = rem & 7, f_ = (4 * (g & 1) + (r_ >> 1)) & 7;
              __builtin_amdgcn_global_load_lds((const unsigned*)((isq ? QL : KVL) + (size_t)(row0 + 8 * g + r_) * 256 + kb * 64 + ((p_ ^ f_) * 8)), (LAS unsigned*)(lds + (isq ? 0 : 32768) + kb * 8192 + g * 1024), 16, 0, 0); } }
        float rsq[2], rskv[2];
#pragma unroll
        for (int rt = 0; rt < 2; ++rt) { const int row = row0 + 32 * rt + j; const f32x4 a = *(const f32x4*)(ssqq + (size_t)row * 4), b4 = *(const f32x4*)(ssqkv + (size_t)row * 4);
            rsq[rt] = rsqrtf(((a[0] + a[1]) + (a[2] + a[3])) * (1.f / QLORA) + EPS) * C2M; rskv[rt] = rsqrtf(((b4[0] + b4[1]) + (b4[2] + b4[3])) * (1.f / KVLORA) + EPS); }
        const unsigned lane16 = (unsigned)lane * 16u;
        bf16x8 wA[16];
#define UP_LOADW(WB_, Wp_, col_, KS_) do { const char* wb_ = (const char*)(Wp_) + (size_t)__builtin_amdgcn_readfirstlane((col_) >> 5) * (KS_) * 1024;     \
            _Pragma("unroll") for (int ks = 0; ks < (KS_); ++ks) wA[(WB_) + ks] = *(const bf16x8*)(wb_ + ks * 1024 + lane16); } while (0)
#define UP_STEP(WB_, ISQ_, col_, KS_) do { f32x16 acc[2]; acc[0] = f32x16{}; acc[1] = f32x16{}; \
            _Pragma("unroll") for (int ks = 0; ks < (KS_); ++ks) { bf16x8 af[2]; \
                _Pragma("unroll") for (int rt = 0; rt < 2; ++rt) { const int row = 32 * rt + j, cc = 2 * (ks & 3) + hi; \
                    af[rt] = *(const LAS bf16x8*)(lds + ((ISQ_) ? 0 : 32768) + (ks >> 2) * 8192 + row * 128 + ((cc ^ ((row >> 1) & 7)) * 16)); } \
                _Pragma("unroll") for (int rt = 0; rt < 2; ++rt) acc[rt] = __builtin_amdgcn_mfma_f32_32x32x16_bf16(wA[(WB_) + ks], af[rt], acc[rt], 0, 0, 0); } \
            _Pragma("unroll") for (int rt = 0; rt < 2; ++rt) { const int row = row0 + 32 * rt + j; const float r_s = (ISQ_) ? rsq[rt] : rskv[rt]; const int col = (col_) + 16 * hi; \
                float v[16]; _Pragma("unroll") for (int r = 0; r < 16; ++r) v[r] = acc[rt][r] * r_s; \
                bf16* dst; \
                if (ISQ_) { const int jh = col % MQK; \
                    if (jh >= 64) { const int g0 = (jh - 64) >> 3; const f32x4* tb = (const f32x4*)(ropetab + ((size_t)row * 16 + 4 * g0) * 2); \
                        _Pragma("unroll") for (int gg = 0; gg < 2; ++gg) { const f32x4 t0 = tb[2 * gg], t1 = tb[2 * gg + 1]; float* w_ = v + 8 * gg; \
                            const float cs[4] = {t0[0], t0[2], t1[0], t1[2]}, sn[4] = {t0[1], t0[3], t1[1], t1[3]}; \
                            _Pragma("unroll") for (int q = 0; q < 4; ++q) { const float x1 = w_[q], x2 = w_[4 + q]; w_[q] = x1 * cs[q] - x2 * sn[q]; w_[4 + q] = x2 * cs[q] + x1 * sn[q]; } } } \
                    dst = Qo + (size_t)row * 768 + col; } \
                else dst = (col >= 512 ? VMo + (col - 512) : KNo + col) + (size_t)row * 512; \
                *(u32x4*)dst = (u32x4){cvt_pk_bf16(v[0], v[1]), cvt_pk_bf16(v[2], v[3]), cvt_pk_bf16(v[4], v[5]), cvt_pk_bf16(v[6], v[7])}; \
                *(u32x4*)(dst + 8) = (u32x4){cvt_pk_bf16(v[8], v[9]), cvt_pk_bf16(v[10], v[11]), cvt_pk_bf16(v[12], v[13]), cvt_pk_bf16(v[14], v[15])}; } } while (0)
        const int cq = 96 * wid, ckv = 128 * wid;
#define UP_SB() __builtin_amdgcn_sched_barrier(0)
        UP_LOADW(0, Wq, cq, 16);
        VM_WAIT(); __syncthreads();
        UP_STEP(0, true, cq, 16);        UP_SB(); UP_LOADW(0, Wq, cq + 32, 16); UP_SB();
        UP_STEP(0, true, cq + 32, 16);   UP_SB(); UP_LOADW(0, Wq, cq + 64, 16); UP_SB();
        UP_STEP(0, true, cq + 64, 16);   UP_SB(); UP_LOADW(0, Wkv, ckv, 8); UP_LOADW(8, Wkv, ckv + 32, 8); UP_SB();
        UP_STEP(0, false, ckv, 8);       UP_SB(); UP_LOADW(0, Wkv, ckv + 64, 8); UP_SB();
        UP_STEP(8, false, ckv + 32, 8);  UP_SB(); UP_LOADW(8, Wkv, ckv + 96, 8); UP_SB();
        UP_STEP(0, false, ckv + 64, 8);  UP_SB();
        UP_STEP(8, false, ckv + 96, 8);
#undef UP_SB
#undef UP_LOADW
#undef UP_STEP
        __syncthreads();
    }
}
}

#define XB_TMO      128
#define XB_XCNT(j)  (256  + 64 * (j))
#define XB_XSUB(j)  (1280 + 64 * (j))
#define XB_XGEN(j)  (2304 + 64 * (j))
#define XB_TOP      3328
#define XB_TOPGEN   3392
#define XCD_BAR_WORDS 3456
#define XB_SPIN_CAP (1u << 18)
__device__ __forceinline__ unsigned xb_ld(unsigned* p)              { return __hip_atomic_load(p, __ATOMIC_RELAXED, __HIP_MEMORY_SCOPE_AGENT); }
__device__ __forceinline__ unsigned xb_add(unsigned* p, unsigned v) { return __hip_atomic_fetch_add(p, v, __ATOMIC_RELAXED, __HIP_MEMORY_SCOPE_AGENT); }
__device__ __forceinline__ unsigned xb_xcc_id() { return (unsigned)__builtin_amdgcn_s_getreg((3 << 11) | 20) & 0xFu; }
#define XB_SPIN(cond, bar) do { unsigned _sp = 0; while (cond) { __builtin_amdgcn_s_sleep(1); \
    if ((++_sp & 255u) == 0u) { if (xb_ld(&(bar)[XB_TMO])) break; if (_sp > XB_SPIN_CAP) { atomicAdd(&(bar)[XB_TMO], 1u); break; } } } } while (0)
struct XcdBarrier { unsigned* bar; unsigned x; volatile LAS unsigned* st; };
__device__ __forceinline__ XcdBarrier xcd_barrier_post(unsigned* bar, volatile LAS unsigned* st) {
    XcdBarrier b; b.bar = bar; b.x = xb_xcc_id(); b.st = st;
    if (threadIdx.x == 0) (void)xb_add(&bar[XB_XCNT(b.x)], 1u);
    return b;
}
__device__ __forceinline__ void xcd_barrier_complete(unsigned* bar, unsigned x, unsigned& nloc, unsigned& nx) {
    const unsigned G = gridDim.x * gridDim.y * gridDim.z;
    unsigned sum, cnt, mine, sp = 0u;
    for (;;) {
        sum = 0u; cnt = 0u; mine = 0u;
#pragma unroll
        for (unsigned j = 0; j < 16; ++j) { const unsigned c = xb_ld(&bar[XB_XCNT(j)]); sum += c; cnt += (c > 0u) ? 1u : 0u; mine = (j == x) ? c : mine; }
        if (sum == G) break;
        __builtin_amdgcn_s_sleep(1);
        if ((++sp & 255u) == 0u) { if (xb_ld(&bar[XB_TMO])) break; if (sp > XB_SPIN_CAP) { atomicAdd(&bar[XB_TMO], 1u); break; } }
    }
    nloc = mine > 0u ? mine : 1u; nx = cnt > 0u ? cnt : 1u;
}
__device__ __forceinline__ void xcd_barrier(const XcdBarrier& b) {
    asm volatile("s_waitcnt vmcnt(0)" ::: "memory");
    __syncthreads();
    if (threadIdx.x == 0) {
        unsigned* bar = b.bar;
        __builtin_amdgcn_s_waitcnt(0);
        unsigned nloc = b.st[0], nx = b.st[1];
        if (nloc == 0u) { xcd_barrier_complete(bar, b.x, nloc, nx); b.st[0] = nloc; b.st[1] = nx; }
        const unsigned old = xb_add(&bar[XB_XSUB(b.x)], 1u);
        const unsigned gen = old / nloc;
        if (old + 1u == (gen + 1u) * nloc) {
            __builtin_amdgcn_fence(__ATOMIC_RELEASE, "agent");
            asm volatile("s_waitcnt vmcnt(0)" ::: "memory");
            const unsigned og = xb_add(&bar[XB_TOP], 1u);
            const unsigned tg = og / nx;
            if (og + 1u == (tg + 1u) * nx) xb_add(&bar[XB_TOPGEN], 1u);
            else XB_SPIN(xb_ld(&bar[XB_TOPGEN]) == tg, bar);
            __builtin_amdgcn_fence(__ATOMIC_ACQUIRE, "agent");
            xb_add(&bar[XB_XGEN(b.x)], 1u);
            asm volatile("s_waitcnt vmcnt(0)" ::: "memory");
        } else {
            XB_SPIN(xb_ld(&bar[XB_XGEN(b.x)]) == gen, bar);
            __builtin_amdgcn_fence(__ATOMIC_ACQUIRE, "agent");
            asm volatile("s_waitcnt vmcnt(0)" ::: "memory");
        }
    }
    __syncthreads();
}

struct Args { const void* in[25]; float* out; unsigned char* ws; int ph_lo, ph_hi; };

struct Frame {
    LAS unsigned char* lds;
    int tid, lane, wave, vcu, G;
};

template <class ColFn>
__device__ __forceinline__ void cvt_item(int ldw, int Ksrc, const float* kscale, bf16* WT, int Kd, LAS float* scr, int kb, int nb, int lane, ColFn colp) {
    const int k0 = 64 * kb, n0 = 32 * nb;
    const float* cp = colp(n0 + (lane & 31));
    float vv[32], sv[32];
#pragma unroll
    for (int i = 0; i < 32; ++i) { const int k = k0 + 2 * i + (lane >> 5);
        vv[i] = (cp != nullptr && k < Ksrc) ? cp[(size_t)k * ldw] : 0.f;
        sv[i] = (kscale != nullptr && k < Ksrc) ? kscale[k] : 1.f; }
#pragma unroll
    for (int i = 0; i < 32; ++i) scr[(2 * i + (lane >> 5)) * 33 + (lane & 31)] = vv[i] * sv[i];
    LDS_WAIT(); asm volatile("" ::: "memory");
    const int c = lane & 7;
#pragma unroll
    for (int j = 0; j < 4; ++j) { const int n = (lane >> 3) + 8 * j; const LAS float* s = scr + (8 * c) * 33 + n;
        u32x4 o; o.x = pk2(s[0 * 33], s[1 * 33]); o.y = pk2(s[2 * 33], s[3 * 33]); o.z = pk2(s[4 * 33], s[5 * 33]); o.w = pk2(s[6 * 33], s[7 * 33]);
        *(u32x4*)(WT + (size_t)(n0 + n) * Kd + k0 + 8 * c) = o; }
    LDS_WAIT(); asm volatile("" ::: "memory");
}
__device__ __forceinline__ void cvt64_item(const float* src, int ldw, bf16* dst, int Kd, LAS unsigned char* scr, int lane) {
    f32x4 v[16];
    const float* sp = src + (size_t)(lane >> 4) * ldw + 4 * (lane & 15);
#pragma unroll
    for (int i = 0; i < 16; ++i) v[i] = __builtin_nontemporal_load((const f32x4*)(sp + (size_t)(4 * i) * ldw));
#pragma unroll
    for (int i = 0; i < 16; ++i) { const int k = 4 * i + (lane >> 4);
#pragma unroll
        for (int q = 0; q < 4; ++q) { const int n = 4 * (lane & 15) + q; *(LAS bf16*)(scr + n * 128 + (((k >> 3) ^ ((n >> 2) & 7)) << 4) + (k & 7) * 2) = (bf16)f2bf(v[i][q]); } }
    LDS_WAIT(); asm volatile("" ::: "memory");
#pragma unroll
    for (int j = 0; j < 8; ++j) { const int p = j * 64 + lane, n = p >> 3, c = p & 7;
        const u32x4 o = *(const LAS u32x4*)(scr + n * 128 + ((c ^ ((n >> 2) & 7)) << 4));
        __builtin_nontemporal_store(o, (u32x4*)(dst + (size_t)n * Kd + c * 8)); }
    LDS_WAIT(); asm volatile("" ::: "memory");
}
__device__ __forceinline__ void cvt64_item8(const float* src, int ldw, unsigned char* dst, int Kd8, LAS unsigned char* scr, int lane, float scale) {
    f32x4 v[16];
    const float* sp = src + (size_t)(16 * (lane >> 4)) * ldw + 4 * (lane & 15);
#pragma unroll
    for (int i = 0; i < 16; ++i) v[i] = __builtin_nontemporal_load((const f32x4*)(sp + (size_t)i * ldw));
#pragma unroll
    for (int q = 0; q < 4; ++q) { u32x4 o;
#pragma unroll
        for (int g = 0; g < 4; ++g) { int p_ = __builtin_amdgcn_cvt_pk_fp8_f32(v[4 * g][q] * scale, v[4 * g + 1][q] * scale, 0, false); p_ = __builtin_amdgcn_cvt_pk_fp8_f32(v[4 * g + 2][q] * scale, v[4 * g + 3][q] * scale, p_, true); o[g] = (unsigned)p_; }
        *(LAS u32x4*)(scr + (4 * (lane & 15) + q) * 80 + (lane >> 4) * 16) = o; }
    LDS_WAIT(); asm volatile("" ::: "memory");
#pragma unroll
    for (int j = 0; j < 4; ++j) { const int p = j * 64 + lane, n = p >> 2, c = p & 3;
        const u32x4 o = *(const LAS u32x4*)(scr + n * 80 + c * 16);
        __builtin_nontemporal_store(o, (u32x4*)(dst + (size_t)n * Kd8 + c * 16)); }
    LDS_WAIT(); asm volatile("" ::: "memory");
}
__device__ __forceinline__ void cvt128_item8(const float* src, int ldw, unsigned char* dst, int Kd8, LAS unsigned char* scr, int lane, float scale) {
    f32x4 v[32];
    const float* sp = src + (size_t)(32 * (lane >> 4)) * ldw + 4 * (lane & 15);
#pragma unroll
    for (int i = 0; i < 32; ++i) v[i] = __builtin_nontemporal_load((const f32x4*)(sp + (size_t)i * ldw));
#pragma unroll
    for (int q = 0; q < 4; ++q) {
#pragma unroll
        for (int hf = 0; hf < 2; ++hf) { u32x4 o;
#pragma unroll
            for (int g = 0; g < 4; ++g) { const int i0 = 16 * hf + 4 * g; int p_ = __builtin_amdgcn_cvt_pk_fp8_f32(v[i0][q] * scale, v[i0 + 1][q] * scale, 0, false); p_ = __builtin_amdgcn_cvt_pk_fp8_f32(v[i0 + 2][q] * scale, v[i0 + 3][q] * scale, p_, true); o[g] = (unsigned)p_; }
            *(LAS u32x4*)(scr + (4 * (lane & 15) + q) * 144 + (lane >> 4) * 32 + 16 * hf) = o; } }
    LDS_WAIT(); asm volatile("" ::: "memory");
#pragma unroll
    for (int j = 0; j < 8; ++j) { const int p = j * 64 + lane, n = p >> 3, c = p & 7;
        const u32x4 o = *(const LAS u32x4*)(scr + n * 144 + c * 16);
        __builtin_nontemporal_store(o, (u32x4*)(dst + (size_t)n * Kd8 + c * 16)); }
    LDS_WAIT(); asm volatile("" ::: "memory");
}
__device__ __forceinline__ int ropedim(int jj) { const int g = jj >> 3, u = jj & 7; return (u < 4) ? 4 * g + u : 16 + 4 * g + (u - 4); }

__device__ __forceinline__ void sincos_acc(float af, float& sn, float& cs) {
    const double a = (double)af; const double kq = __builtin_rint(a * 0.63661977236758134308);
    const double r = (a - kq * 1.57079632679489655800) - kq * 6.123233995736766036e-17;
    const double r2 = r * r;
    const double sp = r * (1.0 + r2 * (-1.66666666666666324348e-01 + r2 * (8.33333333332248946124e-03 + r2 * (-1.98412698298579493134e-04 + r2 * (2.75573137070700676789e-06 + r2 * (-2.50507602534068634195e-08 + r2 * 1.58969099521155010221e-10))))));
    const double cp = 1.0 + r2 * (-0.5 + r2 * (4.16666666666666019037e-02 + r2 * (-1.38888888888741095749e-03 + r2 * (2.48015872894767294178e-05 + r2 * (-2.75573143513906633035e-07 + r2 * (2.08757232129817482790e-09 + r2 * -1.13596475577881948265e-11))))));
    const int q = (int)((long long)kq & 3);
    const double s_ = (q == 0) ? sp : (q == 1) ? cp : (q == 2) ? -sp : -cp;
    const double c_ = (q == 0) ? cp : (q == 1) ? -sp : (q == 2) ? -cp : sp;
    sn = (float)s_; cs = (float)c_;
}

__global__ void __launch_bounds__(NWAVES * 64, 2) fwd(Args args) {
    extern __shared__ __attribute__((aligned(16))) unsigned char lds_raw[];
    Frame F;
    F.lds = (LAS unsigned char*)lds_raw;
    F.tid = threadIdx.x; F.lane = F.tid & 63; F.wave = __builtin_amdgcn_readfirstlane(F.tid >> 6);
    F.G = gridDim.x; { const int bx = blockIdx.x; F.vcu = (F.G % 8 == 0) ? (bx % 8) * (F.G / 8) + bx / 8 : bx; }
    volatile LAS unsigned* MISC = (volatile LAS unsigned*)(F.lds + MISC_OFF);
    unsigned char* ws = args.ws;
    gu32* ctl = (gu32*)(ws + WS_CTL);
#define X_IN ((const float*)AP->in[0])
#define cvec ((const float*)AP->in[1])
#define positions ((const int*)AP->in[2])
#define w_mod ((const float*)AP->in[3])
#define b_mod ((const float*)AP->in[4])
#define g_mix ((const float*)AP->in[5])
#define w_in ((const float*)AP->in[6])
#define b_forget ((const float*)AP->in[7])
#define g_q_lat ((const float*)AP->in[8])
#define w_q_up ((const float*)AP->in[9])
#define g_kv_lat ((const float*)AP->in[10])
#define w_kv_up ((const float*)AP->in[11])
#define w_o_mla ((const float*)AP->in[12])
#define w_o_fox ((const float*)AP->in[13])
#define w_out ((const float*)AP->in[14])
#define g_ffn ((const float*)AP->in[15])
#define w_router ((const float*)AP->in[16])
#define b_router ((const float*)AP->in[17])
#define w_exp_gate ((const float*)AP->in[18])
#define w_exp_up ((const float*)AP->in[19])
#define w_exp_down ((const float*)AP->in[20])
#define w_sh_gate ((const float*)AP->in[21])
#define w_sh_up ((const float*)AP->in[22])
#define w_sh_down ((const float*)AP->in[23])
#define g_final ((const float*)AP->in[24])
#define Win_t ((bf16*)(ws + WS_WIN))
#define Wq_t ((bf16*)(ws + WS_WQ))
#define Wkv_t ((bf16*)(ws + WS_WKV))
#define Wom_t ((bf16*)(ws + WS_WOM))
#define Wof_t ((bf16*)(ws + WS_WOF))
#define Wout_t ((bf16*)(ws + WS_WOUT))
#define Wsgu_t ((bf16*)(ws + WS_WSGU))
#define Wsd_t ((bf16*)(ws + WS_WSD))
#define Wr_f ((bf16*)(ws + WS_WR))
#define mod ((float*)(ws + WS_MOD))
#define Wd_t ((bf16*)(ws + WS_WD))
#define Wgu_t ((bf16*)(ws + WS_WGU))
#define HB ((bf16*)(ws + WS_HB))
#define FQ ((bf16*)(ws + WS_FQ))
#define FK ((bf16*)(ws + WS_FK))
#define FV ((bf16*)(ws + WS_FV))
#define QLAT ((bf16*)(ws + WS_QLAT))
#define KVLAT ((bf16*)(ws + WS_KVLAT))
#define OFOX ((bf16*)(ws + WS_OFOX))
#define OCAT ((bf16*)((unsigned char*)out + 32 * MiB))
#define OMLA ((bf16*)(ws + WS_OMLA))
#define Y ((bf16*)(ws + WS_Y))
#define H ((bf16*)(ws + WS_H))
#define QMLA ((bf16*)(ws + WS_QMLA))
#define GATES ((bf16*)(ws + WS_GATES))
#define KN ((bf16*)(ws + WS_KN))
#define VM ((bf16*)(ws + WS_VM))
#define KPE ((bf16*)(ws + WS_KPE))
#define MERGED ((bf16*)(ws + WS_MERGED))
#define LIST ((unsigned short*)(ws + WS_LIST))
#define Wgu8 ((unsigned char*)(ws + WS_WGU))
#define Wsgu8 ((unsigned char*)(ws + WS_WSGU))
#define H8 ((unsigned char*)(ws + WS_H))
#define META ((u32x2*)(ws + WS_WIN))
#define EIDX ((unsigned char*)(ws + WS_EIDX))
#define GATEW ((float*)(ws + WS_GATEW))
#define ROPETAB ((float*)((unsigned char*)out + DO_ROPE))
#define LOGF ((float*)((unsigned char*)out + DO_LOGF))
#define CUMF ((float*)((unsigned char*)out + DO_CUMF))
#define SSQQ ((float*)((unsigned char*)out + DO_SSQQ))
#define SSQKV ((float*)((unsigned char*)out + DO_SSQKV))
#define MODP ((float*)((unsigned char*)out + DO_MODP))
#define X1B ((bf16*)(ws + WS_X1B))
#define SSQ1 ((float*)(ws + WS_FQ))
    float* const out = args.out;
#define PHASE_ENV const __attribute__((address_space(4))) Args* AP; { auto kp_ = __builtin_amdgcn_kernarg_segment_ptr(); asm volatile("" : "+s"(kp_)); AP = (const __attribute__((address_space(4))) Args*)kp_; } \
    unsigned char* const ws = AP->ws; float* const out = AP->out; (void)ws; (void)out;
    for (int u = F.tid; u < (LDS_BYTES - LDSCTL_OFF) / 4; u += NWAVES * 64) ((LAS unsigned*)(F.lds + LDSCTL_OFF))[u] = 0u;
    __syncthreads();
    XcdBarrier bar; bar.bar = (unsigned*)(ctl + CW_BAR); bar.x = 0; bar.st = nullptr;
    if (MK_ONE_LAUNCH) bar = xcd_barrier_post((unsigned*)(ctl + CW_BAR), MISC + 8);
    const int lo = args.ph_lo, hi = args.ph_hi;
#define IN(k) (lo <= (k) && (k) < hi)
#define BOTH(k) (IN(k) && IN((k) + 1))
#define GRID_BAR() do { if (MK_ONE_LAUNCH) xcd_barrier(bar); } while (0)
#define DUP_BAR() do { if (dummy) xcd_barrier(bar); } while (0)
    const int gw = F.vcu * NWAVES + F.wave, NGW = F.G * NWAVES;

    for (int rep = 0; rep < ((PROBE_DUP == 0) ? 2 : 1); ++rep) if (IN(0)) { PHASE_ENV const bool dummy = (PROBE_DUP == 0) && rep == 0; (void)dummy;
        if (!(dummy && (PROBE_VAR == 1 || PROBE_VAR == 4 || PROBE_VAR == 5))) {
            LAS float* cond = (LAS float*)F.lds;
            for (int i = F.tid; i < NB * D; i += NWAVES * 64) { const float c = cvec[i]; cond[i] = c / (1.f + __expf(-c)); }
            __syncthreads();
            for (int it = F.wave * F.G + F.vcu; it < 96 * 16; it += NWAVES * F.G) { const int cg = it % 96, kq = it / 96, col = cg * 64 + F.lane;
                float a4[4] = {0.f, 0.f, 0.f, 0.f};
                const float* wp = w_mod + (size_t)(64 * kq) * (6 * D) + col;
                float wv[64];
#pragma unroll
                for (int kk = 0; kk < 64; ++kk) wv[kk] = __builtin_nontemporal_load(wp + (size_t)kk * (6 * D));
#pragma unroll
                for (int kk = 0; kk < 64; ++kk) {
#pragma unroll
                    for (int b = 0; b < 4; ++b) a4[b] += wv[kk] * cond[b * D + 64 * kq + kk]; }
#pragma unroll
                for (int b = 0; b < 4; ++b) MODP[((size_t)kq * 4 + b) * (6 * D) + col] = a4[b]; }
            __syncthreads();
        }
        if (!(dummy && (PROBE_VAR == 1 || PROBE_VAR == 3 || PROBE_VAR == 5))) for (int i = gw * 64 + F.lane; i < T * 16; i += NGW * 64) { const int t = i >> 4, j = i & 15;
            const float invf = (((j >> 2) == 0) ? 1.f : ((j >> 2) == 1) ? 0.1f : ((j >> 2) == 2) ? 0.01f : 0.001f) * (((j & 3) == 0) ? 1.f : ((j & 3) == 1) ? 0.5623413251903491f : ((j & 3) == 2) ? 0.31622776601683794f : 0.17782794100389228f);
            const float ang = (float)positions[t] * invf; float sn, cs; sincos_acc(ang, sn, cs);
            *(f32x2*)(ROPETAB + (size_t)i * 2) = (f32x2){cs, sn}; }
        for (int o = gw * 64 + F.lane; o < NEXP * D; o += NGW * 64) { const int piece = o >> 3, kk = o & 7, ln = piece & 63, grp = piece >> 6, ntl = grp & 3, j = grp >> 2;
            const int n = ntl * 16 + (ln & 15), k = j * 32 + (ln >> 4) * 8 + kk; Wr_f[o] = (bf16)f2bf(w_router[(size_t)k * NEXP + n]); }
        {
            LAS unsigned char* scr8 = F.lds + 32768 + F.wave * 9216;
            constexpr int F_IN = 62 * 16;
            if (!(dummy && PROBE_VAR >= 2)) for (int it = gw; it < F_IN; it += NGW) {
                int nb = it % 62; const int kb = it / 62; if (nb >= 6) nb += 2; const int n0 = 64 * nb;
                const int src = (n0 < 384) ? n0 : (n0 < 2048) ? 416 + (n0 - 512) : 1960 + (n0 - 2048);
                cvt64_item(w_in + (size_t)(64 * kb) * 4008 + src, 4008, Win_t + (size_t)n0 * D + 64 * kb, D, scr8, F.lane);
            }
            LAS float* scr = (LAS float*)(F.lds + 32768 + F.wave * 9216);
            constexpr int I_INS = 4 * (D / 64), NSLOW = I_INS;
            if (!(dummy && (PROBE_VAR == 1 || PROBE_VAR == 3 || PROBE_VAR == 4))) for (int it = F.wave * F.G + F.vcu; it < NSLOW; it += NGW) {
                const int nb = 12 + (it & 3), kb = it >> 2;
                cvt_item(4008, D, nullptr, Win_t, D, scr, kb, nb, F.lane, [&](int n) -> const float* {
                    int src; if (n < 416) src = 384 + ropedim(n - 384); else if (n < 424) src = 1952 + (n - 416); else src = -1;
                    return src < 0 ? nullptr : w_in + src; });
            }
            if (!(dummy && (PROBE_VAR == 1 || PROBE_VAR == 3 || PROBE_VAR == 4))) {
                for (int o = gw * 64 + F.lane; o < 768 * QLORA; o += NGW * 64) { const int cb = o >> 13, rem = o & 8191, ks = rem >> 9, ln = (rem >> 3) & 63, e = rem & 7;
                    const int n = cb * 32 + up::nloc(ln & 31), k = 16 * ks + 8 * (ln >> 5) + e, hh = n / MQK, jj = n % MQK, sc = hh * MQK + (jj < 64 ? jj : 64 + ropedim(jj - 64));
                    Wq_t[o] = (bf16)f2bf(w_q_up[(size_t)k * 768 + sc] * g_q_lat[k]); }
                for (int o = gw * 64 + F.lane; o < 1024 * KVLORA; o += NGW * 64) { const int cb = o >> 12, rem = o & 4095, ks = rem >> 9, ln = (rem >> 3) & 63, e = rem & 7;
                    const int n = cb * 32 + up::nloc(ln & 31), k = 16 * ks + 8 * (ln >> 5) + e, sc = (n < 512) ? (n >> 6) * 128 + (n & 63) : ((n - 512) >> 6) * 128 + 64 + (n & 63);
                    Wkv_t[o] = (bf16)f2bf(w_kv_up[(size_t)k * 1024 + sc] * g_kv_lat[k]); }
            }
        }
        if (BOTH(0)) GRID_BAR();
    }

    for (int rep = 0; rep < ((PROBE_DUP == 1) ? 2 : 1); ++rep) if (IN(1)) { PHASE_ENV const bool dummy = (PROBE_DUP == 1) && rep == 0; (void)dummy;
        if (F.vcu < 48) { const int idx = F.vcu * 512 + F.tid, b = idx / (6 * D), col = idx % (6 * D); float sm = b_mod[col];
#pragma unroll
            for (int p = 0; p < 16; ++p) sm += MODP[((size_t)p * 4 + b) * (6 * D) + col];
            mod[idx] = sm; }
        LAS float* vg1 = (LAS float*)F.lds; LAS float* vs1 = (LAS float*)(F.lds + 4096);
        for (int grp = F.vcu; grp < T / 64; grp += F.G) {
            const int b = (grp * 64) / SEQ;
            __syncthreads();
            for (int k = F.tid; k < D; k += NWAVES * 64) { float s0 = b_mod[k], s1 = b_mod[D + k];
#pragma unroll
                for (int p = 0; p < 16; ++p) { s0 += MODP[((size_t)p * 4 + b) * (6 * D) + k]; s1 += MODP[((size_t)p * 4 + b) * (6 * D) + D + k]; }
                vs1[k] = s0; vg1[k] = g_mix[k] * (1.f + s1); }
            __syncthreads();
#pragma unroll 2
            for (int rr = 0; rr < 8; ++rr) { const int m = grp * 64 + F.wave * 8 + rr;
                const f32x4* xr = (const f32x4*)(X_IN + (size_t)m * D) + F.lane;
                f32x4 v[4]; float s = 0.f;
#pragma unroll
                for (int j = 0; j < 4; ++j) { v[j] = __builtin_nontemporal_load(xr + 64 * j); s += (v[j].x * v[j].x + v[j].y * v[j].y) + (v[j].z * v[j].z + v[j].w * v[j].w); }
                const float rstd = rsqrtf(wave_sum(s) * (1.f / D) + EPS);
                unsigned long long* o8 = (unsigned long long*)(H + (size_t)m * D) + F.lane;
#pragma unroll
                for (int j = 0; j < 4; ++j) { const int c = 4 * F.lane + 256 * j;
                    const f32x4 g = *(const LAS f32x4*)(vg1 + c), d = *(const LAS f32x4*)(vs1 + c);
                    const f32x4 r = v[j] * rstd * g + d;
                    o8[64 * j] = (unsigned long long)pk2(r.x, r.y) | ((unsigned long long)pk2(r.z, r.w) << 32); } }
        }
        if (BOTH(1)) GRID_BAR();
    }

    for (int rep = 0; rep < ((PROBE_DUP == 2) ? 2 : 1); ++rep) if (IN(2)) { PHASE_ENV const bool dummy = (PROBE_DUP == 2) && rep == 0; (void)dummy;
        pg8::StaticOrder S; S.init(H, Win_t, T, NIN, D, F.G, (int)blockIdx.x);
        EpiInProj E{QLAT, KVLAT, KPE, FQ, GATES, LOGF, SSQQ, SSQKV, ROPETAB, b_forget, dummy && (PROBE_VAR == 1), (dummy && PROBE_VAR == 2) ? 0 : (dummy && PROBE_VAR == 3) ? 2 : 1};
        pg8::gemm_phase<EpiInProj, pg8::StaticOrder, true>(F.lds, S, E);
        if (BOTH(2)) GRID_BAR();
    }

    for (int rep = 0; rep < ((PROBE_DUP == 3) ? 2 : 1); ++rep) if (IN(3)) { PHASE_ENV const bool dummy = (PROBE_DUP == 3) && rep == 0; (void)dummy;
        if (!(dummy && (PROBE_VAR == 2 || PROBE_VAR == 3))) {
            const int bb = F.vcu & 3; float mx = 0.f, mq = 0.f;
            for (int r = (F.vcu >> 2) * NWAVES + F.wave; r < SEQ; r += (F.G >> 2) * NWAVES) { f32x4 k0, k1, q0v, q1v; unpack8(*(const u32x4*)(FK + ((size_t)bb * SEQ + r) * 512 + 8 * F.lane), k0, k1);
                unpack8(*(const u32x4*)(FQ + ((size_t)bb * SEQ + r) * 512 + 8 * F.lane), q0v, q1v);
                float sq = (k0[0] * k0[0] + k0[1] * k0[1]) + (k0[2] * k0[2] + k0[3] * k0[3]) + (k1[0] * k1[0] + k1[1] * k1[1]) + (k1[2] * k1[2] + k1[3] * k1[3]);
                float sqq = (q0v[0] * q0v[0] + q0v[1] * q0v[1]) + (q0v[2] * q0v[2] + q0v[3] * q0v[3]) + (q1v[0] * q1v[0] + q1v[1] * q1v[1]) + (q1v[2] * q1v[2] + q1v[3] * q1v[3]);
                sq += dppf<0xB1>(sq); sq += dppf<0x4E>(sq); sq += dppf<0x141>(sq);
                sqq += dppf<0xB1>(sqq); sqq += dppf<0x4E>(sqq); sqq += dppf<0x141>(sqq);
                mx = fmaxf(mx, sq); mq = fmaxf(mq, sqq); }
            LAS float* kml = (LAS float*)F.lds;
            if ((F.lane & 7) == 0) { kml[F.wave * 8 + (F.lane >> 3)] = mx; kml[64 + F.wave * 8 + (F.lane >> 3)] = mq; }
            __syncthreads();
            if (F.tid < 2 * NHEAD) { const int hh = F.tid & 7, qk = F.tid >> 3; float m2 = 0.f;
#pragma unroll
                for (int w = 0; w < NWAVES; ++w) m2 = fmaxf(m2, kml[qk * 64 + w * 8 + hh]);
                atomicMax((unsigned*)(ctl + CW_KM + qk * 32 + bb * NHEAD + hh), __float_as_uint(m2)); }
            __syncthreads();
        }
        if (F.vcu < NB * NHEAD && !(dummy && (PROBE_VAR == 1 || PROBE_VAR == 3))) {
            const int b = F.vcu >> 3, h = F.vcu & 7; const float* src = LOGF + ((size_t)b * SEQ + 8 * F.tid) * 8 + h;
            float v[8]; float run = 0.f;
#pragma unroll
            for (int i = 0; i < 8; ++i) v[i] = src[i * 8];
#pragma unroll
            for (int i = 0; i < 8; ++i) { run += v[i]; v[i] = run; }
            float incl = run;
#pragma unroll
            for (int o = 1; o < 64; o <<= 1) { const float n = __shfl_up(incl, o); if (F.lane >= o) incl += n; }
            LAS float* wt = (LAS float*)F.lds;
            if (F.lane == 63) wt[F.wave] = incl;
            __syncthreads();
            float woff = 0.f;
#pragma unroll
            for (int w = 0; w < NWAVES; ++w) woff += (w < F.wave) ? wt[w] : 0.f;
            const float excl = woff + incl - run;
            float* dst = CUMF + ((size_t)b * NHEAD + h) * SEQ + 8 * F.tid;
            *(f32x4*)dst = (f32x4){v[0] + excl, v[1] + excl, v[2] + excl, v[3] + excl}; *(f32x4*)(dst + 4) = (f32x4){v[4] + excl, v[5] + excl, v[6] + excl, v[7] + excl};
            __syncthreads();
        }
        if (!(dummy && (PROBE_VAR == 1 || PROBE_VAR == 2))) up::up_phase(F.lds, QLAT, KVLAT, Wq_t, Wkv_t, SSQQ, SSQKV, ROPETAB, QMLA, KN, VM, F.G, (int)blockIdx.x);
        if (BOTH(3)) GRID_BAR();
    }

    for (int rep = 0; rep < ((PROBE_DUP == 4) ? 2 : 1); ++rep) if (IN(4)) { PHASE_ENV const bool dummy = (PROBE_DUP == 4) && rep == 0; (void)dummy;
        {
            const bool xq = (F.G % 8) == 0; const int x = xq ? (int)(blockIdx.x & 7) : 0, nunits = xq ? 128 : 1024;
            constexpr int F_O = 16 * 4, F_OUT = 16 * 8, F_SGU = 8 * 8, F_SD = 16 * 2, F_EGU = NEXP * F_SGU, F_ED = NEXP * F_SD;
            constexpr int NCONV = F_EGU + F_ED + 2 * F_O + F_OUT + F_SGU + F_SD, NCBATCH = (NCONV + 31) / 32;
            const int NQ = xq ? 8 : 1, ncb = (NCBATCH - x + NQ - 1) / NQ, A0 = xq ? CONV_A0 : 8 * CONV_A0;
            gu32* qh = ctl + CW_Q + 64 * x + (dummy ? 16 : 0);
            volatile LAS unsigned* qw = (volatile LAS unsigned*)(F.lds + MISC_OFF + 64);
            for (int nit = 0;; ++nit) {
                if (F.tid == 0) qw[nit & 1] = __hip_atomic_fetch_add(qh, 1u, RLX_AGENT);
                __syncthreads();
                int r = __builtin_amdgcn_readfirstlane((int)qw[nit & 1]);
                if (r >= nunits + ncb) break;
                if (r >= A0 && r < A0 + ncb) { const int cb = x + NQ * (r - A0);
                    LAS unsigned char* scr8 = F.lds + 32768 + F.wave * 9216;
                    int ln_ = F.lane; asm volatile("" : "+v"(ln_));
                    for (int kr = 0; kr < 4; ++kr) { int it = 32 * cb + 8 * kr + F.wave; if (it >= NCONV) break;
                        const float* src; unsigned char* dst; int ldw, kd8;
                        if (it < F_EGU) { const int e = it / F_SGU, rr = it % F_SGU, nb = rr & 7, kb = rr >> 3, pn = nb >> 2, c0 = (nb & 3) * 64;
                            src = ((c0 < 128) ? w_exp_gate : w_exp_up) + (size_t)e * D * DEXP + pn * 128 + (c0 & 127) + (size_t)(128 * kb) * DEXP; ldw = DEXP;
                            dst = Wgu8 + (size_t)e * 512 * D + (size_t)(64 * nb) * D + 128 * kb; kd8 = D; }
                        else if ((it -= F_EGU) < F_ED) { const int e = it / F_SD, rr = it % F_SD, nb = rr & 15, kb = rr >> 4;
                            src = w_exp_down + (size_t)e * DEXP * D + (size_t)(128 * kb) * D + 64 * nb; ldw = D; dst = (unsigned char*)Wd_t + (size_t)e * D * DEXP + (size_t)(64 * nb) * DEXP + 128 * kb; kd8 = DEXP; }
                        else if ((it -= F_ED) < 2 * F_O) { const int fx = it >= F_O, i2 = it - (fx ? F_O : 0), nb = i2 & 15, kb = i2 >> 4;
                            src = (fx ? w_o_fox : w_o_mla) + (size_t)(128 * kb) * D + 64 * nb; ldw = D; dst = (unsigned char*)Wom_t + (size_t)(64 * nb) * D + (fx ? 512 : 0) + 128 * kb; kd8 = D; }
                        else if ((it -= 2 * F_O) < F_OUT) { const int nb = it & 15, kb = it >> 4; src = w_out + (size_t)(128 * kb) * D + 64 * nb; ldw = D; dst = (unsigned char*)Wout_t + (size_t)(64 * nb) * D + 128 * kb; kd8 = D; }
                        else if ((it -= F_OUT) < F_SGU) { const int nb = it >> 3, kb = it & 7, pn = nb >> 2, c0 = (nb & 3) * 64;
                            src = ((c0 < 128) ? w_sh_gate : w_sh_up) + pn * 128 + (c0 & 127) + (size_t)(128 * kb) * DEXP; ldw = DEXP; dst = Wsgu8 + (size_t)(64 * nb) * D + 128 * kb; kd8 = D; }
                        else { it -= F_SGU; const int nb = it >> 1, kb = it & 1; src = w_sh_down + (size_t)(128 * kb) * D + 64 * nb; ldw = D; dst = (unsigned char*)Wsd_t + (size_t)(64 * nb) * DEXP + 128 * kb; kd8 = DEXP; }
                        cvt128_item8(src, ldw, dst, kd8, scr8, ln_, WSCALE8);
                    }
                    continue; }
                if (r >= A0) r -= ncb;
                int qb, type, b, h;
                if (xq) { qb = 15 - (r >> 3); type = (r >> 2) & 1; b = r & 3; h = (x + 3 * b) & 7; }
                else { qb = 15 - (r >> 6); type = (r >> 5) & 1; b = (r >> 3) & 3; h = r & 7; }
                if (type == 0) { if (ATT_TUNED_FOX && qb != 0) att::attn_unit_t<64, true, 8>(b, h, qb, FQ, 512, FK, KPE, FV, CUMF, __uint_as_float(__hip_atomic_load((unsigned*)(ctl + CW_KM + b * NHEAD + h), RLX_AGENT)) * __uint_as_float(__hip_atomic_load((unsigned*)(ctl + CW_KM + 32 + b * NHEAD + h), RLX_AGENT)), (bf16*)((unsigned char*)(dummy ? (bf16*)((unsigned char*)out + 4 * MiB) : OCAT) + 512), D, F.lds);
                                 else att::attn_unit<64, true, 8>(b, h, qb, FQ, 512, FK, KPE, FV, CUMF, (bf16*)((unsigned char*)(dummy ? (bf16*)((unsigned char*)out + 4 * MiB) : OCAT) + 512), D, F.lds); }
                else { if (ATT_TUNED_MLA && qb != 0) att::attn_unit_t<96, false, 8>(b, h, qb, QMLA, 768, KN, KPE, VM, nullptr, 0.f, dummy ? (bf16*)((unsigned char*)out + 4 * MiB) : OCAT, D, F.lds);
                       else att::attn_unit<96, false, 8>(b, h, qb, QMLA, 768, KN, KPE, VM, nullptr, dummy ? (bf16*)((unsigned char*)out + 4 * MiB) : OCAT, D, F.lds); }
            }
        }
        if (BOTH(4)) GRID_BAR();
    }

    for (int rep = 0; rep < ((PROBE_DUP == 5) ? 2 : 1); ++rep) if (IN(5)) { PHASE_ENV const bool dummy = (PROBE_DUP == 5) && rep == 0; (void)dummy;
        pg8::StaticOrder S; S.init(OCAT, Wom_t, T, D, D / 2, F.G, (int)blockIdx.x);
        EpiMergedCat E{(const unsigned char*)GATES, (unsigned char*)MERGED, 1.f / (WSCALE8 * 255.f)};
        pg8::gemm_phase<EpiMergedCat, pg8::StaticOrder, true, true>(F.lds, S, E);
        if (BOTH(5)) GRID_BAR();
    }

    for (int rep = 0; rep < ((PROBE_DUP == 6) ? 2 : 1); ++rep) if (IN(6)) { PHASE_ENV const bool dummy = (PROBE_DUP == 6) && rep == 0; (void)dummy;
        pg8::StaticOrder S; S.init(MERGED, Wout_t, T, D, D / 2, F.G, (int)blockIdx.x);
        EpiOut E{X_IN, X1B, mod, SSQ1, 1.f / (OSCALE8 * WSCALE8)};
        pg8::gemm_phase<EpiOut, pg8::StaticOrder, true, true>(F.lds, S, E);
        if (BOTH(6)) GRID_BAR();
    }

    for (int rep = 0; rep < ((PROBE_DUP == 7) ? 2 : 1); ++rep) if (IN(7)) { PHASE_ENV const bool dummy = (PROBE_DUP == 7) && rep == 0; (void)dummy;
        LAS unsigned char* wrl = F.lds;
        LAS float* vg = (LAS float*)(F.lds + LDSCTL_OFF + 6144);
        LAS float* vs = (LAS float*)(F.lds + LDSCTL_OFF + 10240);
        LAS int* cntw = (LAS int*)(F.lds + 32768);
        LAS int* basel = (LAS int*)(F.lds + 32768 + 2048);
        static_assert(LDSCTL_OFF + 10240 + 4096 <= LDS_BYTES && MOETAB_OFF + 4700 <= LDSCTL_OFF + 6144, "P7 LDS map");
        const float my_bias = b_router[F.lane];
        for (int grp = F.vcu; grp < T / 64; grp += F.G) {
            const int b = (grp * 64) / SEQ;
            __syncthreads();
#pragma unroll
            for (int i = 0; i < 16; ++i) __builtin_amdgcn_global_load_lds((const unsigned*)((const char*)Wr_f + (F.wave * 16 + i) * 1024 + F.lane * 16), (LAS unsigned*)(wrl + (F.wave * 16 + i) * 1024), 16, 0, 0);
            for (int i = F.tid; i < D; i += NWAVES * 64) { vg[i] = g_ffn[i] * (1.f + mod[(size_t)b * 6 * D + 4 * D + i]); vs[i] = mod[(size_t)b * 6 * D + 3 * D + i]; }
            const int tp = grp * 64 + (F.wave & 3) * 16, kh = F.wave >> 2, t0 = tp + kh * 8;
            const int r16 = F.lane & 15, kg = F.lane >> 4, myrow = tp + r16;
            float rs_mine;
            { const float* sp = SSQ1 + (size_t)myrow * 16; const f32x4 a = *(const f32x4*)sp, b4 = *(const f32x4*)(sp + 4), c4 = *(const f32x4*)(sp + 8), d4 = *(const f32x4*)(sp + 12);
              const float ssum = (((a[0] + a[1]) + (a[2] + a[3])) + ((b4[0] + b4[1]) + (b4[2] + b4[3]))) + (((c4[0] + c4[1]) + (c4[2] + c4[3])) + ((d4[0] + d4[1]) + (d4[2] + d4[3])));
              rs_mine = rsqrtf(ssum * (1.f / D) + EPS); }
            const bf16* xrow = X1B + (size_t)myrow * D + 512 * kh + 8 * kg;
            f32x4 lacc[4] = {{0.f, 0.f, 0.f, 0.f}, {0.f, 0.f, 0.f, 0.f}, {0.f, 0.f, 0.f, 0.f}, {0.f, 0.f, 0.f, 0.f}};
            u32x4 xq[16];
#pragma unroll
            for (int p = 0; p < 16; ++p) xq[p] = *(const u32x4*)(xrow + 32 * p);
            VM_WAIT(); __syncthreads();
#pragma unroll
            for (int p = 0; p < 16; ++p) { const int j = 16 * kh + p, k = 32 * j + 8 * kg;
                f32x4 x0, x1v; unpack8(xq[p], x0, x1v);
                const f32x4 g0 = *(const LAS f32x4*)(vg + k), g1 = *(const LAS f32x4*)(vg + k + 4), s0 = *(const LAS f32x4*)(vs + k), s1 = *(const LAS f32x4*)(vs + k + 4);
                const f32x4 h0 = x0 * rs_mine * g0 + s0, h1 = x1v * rs_mine * g1 + s1;
                const u32x4 hw = pack8(h0, h1);
                f32x4 a0, a1; unpack8(hw, a0, a1);
                const u32x4 lw = pack8(h0 - a0, h1 - a1);
                { u32x2 h8; int p_ = __builtin_amdgcn_cvt_pk_fp8_f32(h0[0], h0[1], 0, false); p_ = __builtin_amdgcn_cvt_pk_fp8_f32(h0[2], h0[3], p_, true); h8.x = (unsigned)p_;
                    p_ = __builtin_amdgcn_cvt_pk_fp8_f32(h1[0], h1[1], 0, false); p_ = __builtin_amdgcn_cvt_pk_fp8_f32(h1[2], h1[3], p_, true); h8.y = (unsigned)p_;
                    *(u32x2*)(H8 + (size_t)myrow * D + k) = h8; }
                const bf16x8 Ah = __builtin_bit_cast(bf16x8, hw), Al = __builtin_bit_cast(bf16x8, lw);
#pragma unroll
                for (int ntl = 0; ntl < 4; ++ntl) { const bf16x8 Wf = *(const LAS bf16x8*)(wrl + ((j * 4 + ntl) * 64 + F.lane) * 16);
                    lacc[ntl] = __builtin_amdgcn_mfma_f32_16x16x32_bf16(Wf, Ah, lacc[ntl], 0, 0, 0);
                    lacc[ntl] = __builtin_amdgcn_mfma_f32_16x16x32_bf16(Wf, Al, lacc[ntl], 0, 0, 0); } }
            __syncthreads();
            {   LAS float* stw = (LAS float*)F.lds + (((F.wave & 3) * 2 + kh) * 16 + r16) * 64;
#pragma unroll
                for (int ntl = 0; ntl < 4; ++ntl) *(LAS f32x4*)(stw + 16 * ntl + 4 * kg) = lacc[ntl]; }
            __syncthreads();
            LAS float* stg = (LAS float*)F.lds + ((F.wave & 3) * 32 + kh * 8) * 64;
            int cnt = 0; unsigned selbits = 0u, selks = 0u;
            for (int j = 0; j < 8; ++j) {
                const float logit = stg[j * 64 + F.lane] + stg[(16 + j) * 64 + F.lane];
                const float sc = 1.f / (1.f + expf(-logit));
                const float ch = sc + my_bias;
                const float m1 = max8(ch);
                const unsigned long long eq = __ballot(ch == m1);
                const unsigned gm = (unsigned)(eq >> (F.lane & ~7)) & 0xffu;
                const int first = __builtin_ctz(gm);
                const float c2 = max8(((F.lane & 7) == first) ? -INFINITY : ch);
                const float gs = m1 + c2; const int myg = F.lane >> 3;
                int rank = 0;
#pragma unroll
                for (int g = 0; g < 8; ++g) { const float o = __builtin_bit_cast(float, __builtin_amdgcn_readlane(__builtin_bit_cast(int, gs), 8 * g)); rank += (o > gs || (o == gs && g < myg)) ? 1 : 0; }
                float mc = (rank < 4) ? ch : -1e30f;
                int selk = -1;
#pragma unroll
                for (int k = 0; k < TOPK; ++k) { const float mx = wave_max_f(mc); const unsigned long long bl = __ballot(mc == mx); const int fl = __builtin_ctzll(bl);
                    if (F.lane == fl) { selk = k; mc = -INFINITY; } }
                const float ssum = wave_sum_f(selk >= 0 ? sc : 0.f);
                if (selk >= 0) { const int t = t0 + j; EIDX[(size_t)t * 8 + selk] = (unsigned char)F.lane; GATEW[(size_t)t * 8 + selk] = sc / ssum * 2.5f; ++cnt; selbits |= 1u << j; selks |= (unsigned)selk << (3 * j); }
            }
            cntw[F.wave * 64 + F.lane] = cnt;
            __syncthreads();
            if (F.wave == 0) { int tot = 0;
#pragma unroll
                for (int w = 0; w < 8; ++w) tot += cntw[w * 64 + F.lane];
                basel[F.lane] = (int)__hip_atomic_fetch_add((unsigned*)(ctl + (dummy ? CW_CNT + 2048 : CW_CNT) + 16 * F.lane), (unsigned)tot, RLX_AGENT); }
            __syncthreads();
            int pos = basel[F.lane];
            for (int w = 0; w < F.wave; ++w) pos += cntw[w * 64 + F.lane];
#pragma unroll
            for (int j = 0; j < 8; ++j) if ((selbits >> j) & 1u) { const int k = (selks >> (3 * j)) & 7, t = t0 + j;
                LIST[(size_t)F.lane * LISTCAP + pos] = (unsigned short)t;
                META[(size_t)F.lane * LISTCAP + pos] = (u32x2){(unsigned)(t * (TOPK + 1) + k), __float_as_uint(GATEW[(size_t)t * 8 + k])}; ++pos; }
        }
        __syncthreads();
        if (BOTH(7)) GRID_BAR();
    }

    volatile LAS int* tab = (volatile LAS int*)(F.lds + MOETAB_OFF);
    if (IN(8) || IN(9)) {
        __syncthreads();
        if (F.wave == 0) {
            const int n = (int)__hip_atomic_load((unsigned*)(ctl + CW_CNT + 16 * F.lane), RLX_AGENT);
            const int tiles = (n + 255) >> 8; int incl = tiles;
#pragma unroll
            for (int o = 1; o < 64; o <<= 1) { const int v = __shfl_up(incl, o); if (F.lane >= o) incl += v; }
            tab[F.lane] = incl - tiles; tab[66 + F.lane] = n;
            if (F.lane == 63) { tab[64] = incl; tab[65] = incl + T / 256; tab[66 + 64] = T; }
        }
        __syncthreads();
        { const int ti = F.tid; int e = 0;
          for (int q = 0; q <= NEXP; ++q) if (tab[q] <= ti) e = q;
          tab[132 + ti] = e; }
        __syncthreads();
    }
    for (int rep = 0; rep < ((PROBE_DUP == 8) ? 2 : 1); ++rep) if (IN(8)) { PHASE_ENV const bool dummy = (PROBE_DUP == 8) && rep == 0; (void)dummy;
        MoeOrder<2, true> S{(const char*)H8, (const char*)Wgu8, (const char*)Wsgu8, D / 2, (size_t)512 * D, LIST, tab, F.G, (int)blockIdx.x};
        EpiHb E{(unsigned char*)HB, 1.f / WSCALE8};
        pg8::gemm_phase<EpiHb, MoeOrder<2, true>, true, true>(F.lds, S, E);
        if (BOTH(8)) GRID_BAR();
    }
    for (int rep = 0; rep < ((PROBE_DUP == 9) ? 2 : 1); ++rep) if (IN(9)) { PHASE_ENV const bool dummy = (PROBE_DUP == 9) && rep == 0; (void)dummy;
        if (dummy && PROBE_VAR == 1) dn::down_phase<true>(F.lds, (const unsigned char*)HB, (const unsigned char*)Wd_t, (const unsigned char*)Wsd_t, tab, META, (unsigned char*)Y, (unsigned char*)(ws + WS_CTL + 900 * 1024), F.G, (int)blockIdx.x);
        else dn::down_phase<false>(F.lds, (const unsigned char*)HB, (const unsigned char*)Wd_t, (const unsigned char*)Wsd_t, tab, META, (unsigned char*)Y, (unsigned char*)(ws + WS_CTL + 900 * 1024), F.G, (int)blockIdx.x);
        if (BOTH(9)) GRID_BAR();
    }

    for (int rep = 0; rep < ((PROBE_DUP == 10) ? 2 : 1); ++rep) if (IN(10)) { PHASE_ENV const bool dummy = (PROBE_DUP == 10) && rep == 0; (void)dummy;
        int ln10 = F.lane; asm volatile("" : "+v"(ln10));
        for (int mb = gw * 8; mb < T; mb += NGW * 8) {
            const float* gf = mod + (size_t)(mb / SEQ) * 6 * D + 5 * D;
            f32x4 gfv[4], gfin[4];
#pragma unroll
            for (int j = 0; j < 4; ++j) { gfv[j] = *(const f32x4*)(gf + 4 * ln10 + 256 * j); gfin[j] = *(const f32x4*)(g_final + 4 * ln10 + 256 * j); }
            int yw[2][4][TOPK + 1]; u32x2 xb[2][4];
#define P10_LOAD(bf, m_) do { const unsigned char* yp_ = (const unsigned char*)Y + (size_t)(m_) * (TOPK + 1) * D + 4 * ln10; const u32x2* xr_ = (const u32x2*)(X1B + (size_t)(m_) * D) + ln10; \
            _Pragma("unroll") for (int j = 0; j < 4; ++j) { _Pragma("unroll") for (int k = 0; k < TOPK + 1; ++k) yw[bf][j][k] = __builtin_nontemporal_load((const int*)(yp_ + k * D + 256 * j)); \
                xb[bf][j] = __builtin_nontemporal_load(xr_ + 64 * j); } } while (0)
#define P10_ROW(bf, m_) do { f32x4 v[4]; float s = 0.f; \
            _Pragma("unroll") for (int j = 0; j < 4; ++j) { f32x4 y = {0.f, 0.f, 0.f, 0.f}; \
                _Pragma("unroll") for (int k = 0; k < TOPK + 1; ++k) { const f32x2 lo = __builtin_amdgcn_cvt_pk_f32_fp8(yw[bf][j][k], false), hi2 = __builtin_amdgcn_cvt_pk_f32_fp8(yw[bf][j][k], true); y += (f32x4){lo.x, lo.y, hi2.x, hi2.y}; } \
                const u32x2 xv = xb[bf][j]; \
                v[j] = (f32x4){__uint_as_float(xv.x << 16), __uint_as_float(xv.x & 0xffff0000u), __uint_as_float(xv.y << 16), __uint_as_float(xv.y & 0xffff0000u)} + gfv[j] * y; \
                s += (v[j].x * v[j].x + v[j].y * v[j].y) + (v[j].z * v[j].z + v[j].w * v[j].w); } \
            const float rstd = rsqrtf(wave_sum_f(s) * (1.f / D) + EPS); \
            f32x4* xw = (f32x4*)((dummy ? (float*)HB : out) + (size_t)(m_) * D) + ln10; \
            _Pragma("unroll") for (int j = 0; j < 4; ++j) __builtin_nontemporal_store(v[j] * rstd * gfin[j], xw + 64 * j); } while (0)
            P10_LOAD(0, mb);
            for (int i = 0; i < 8; i += 2) {
                P10_LOAD(1, mb + i + 1);
                P10_ROW(0, mb + i);
                if (i + 2 < 8) P10_LOAD(0, mb + i + 2);
                P10_ROW(1, mb + i + 1);
            }
#undef P10_LOAD
#undef P10_ROW
        }
    }
#undef IN
#undef BOTH
#undef GRID_BAR
}

constexpr int NPHASE = 11;
extern "C" void kernel_launch(void* const* d_in, const int* in_sizes, int n_in, void* d_out, int out_size, void* d_ws, size_t ws_size, hipStream_t stream) {
    static int grid = 0;
    if (grid == 0) {
        if (n_in != 25 || out_size != T * D || ws_size < WS_END) { fprintf(stderr, "kernel_launch: unexpected shapes (n_in %d out %d ws %zu need %zu)\n", n_in, out_size, ws_size, (size_t)WS_END); grid = -1; return; }
        int dev = 0, cus = 0;
        if (hipGetDevice(&dev) != hipSuccess || hipDeviceGetAttribute(&cus, hipDeviceAttributeMultiprocessorCount, dev) != hipSuccess) { grid = -1; return; }
        if (hipFuncSetAttribute((const void*)fwd, hipFuncAttributeMaxDynamicSharedMemorySize, LDS_BYTES) != hipSuccess) { fprintf(stderr, "kernel_launch: hipFuncSetAttribute failed\n"); grid = -1; return; }
        int per_cu = 0;
        if (hipOccupancyMaxActiveBlocksPerMultiprocessor(&per_cu, (const void*)fwd, NWAVES * 64, LDS_BYTES) != hipSuccess || per_cu < 1) { fprintf(stderr, "kernel_launch: occupancy query says %d\n", per_cu); }
        (void)hipGetLastError();
        grid = cus;
    }
    if (grid < 0) return;
    (void)in_sizes;
    if (hipMemsetAsync((char*)d_ws + WS_CTL, 0, CTL_ZERO_BYTES, stream) != hipSuccess) return;
    Args a{};
    for (int i = 0; i < 25; ++i) a.in[i] = d_in[i];
    a.out = (float*)d_out; a.ws = (unsigned char*)d_ws;
#if MK_ONE_LAUNCH
    a.ph_lo = 0; a.ph_hi = NPHASE;
    hipLaunchKernelGGL(fwd, dim3(grid), dim3(NWAVES * 64), LDS_BYTES, stream, a);
#else
    for (int p = 0; p < NPHASE; ++p) { a.ph_lo = p; a.ph_hi = p + 1; hipLaunchKernelGGL(fwd, dim3(grid), dim3(NWAVES * 64), LDS_BYTES, stream, a); }
#endif
}
```

```cpp
#include <hip/hip_runtime.h>
#include <cstdio>
#include <cstdint>
#include <type_traits>

#ifndef MK_ONE_LAUNCH
#ifndef CONV_A0
#define CONV_A0 28
#endif
#define MK_ONE_LAUNCH 1
#endif

#ifndef PROBE_DUP
#define PROBE_DUP -1
#endif
#ifndef ATT_TUNED_FOX
#define ATT_TUNED_FOX 1
#endif
#ifndef ATT_TUNED_MLA
#define ATT_TUNED_MLA 1
#endif
#ifndef PROBE_VAR
#define PROBE_VAR 0
#endif
#define GAS __attribute__((address_space(1)))
#define LAS __attribute__((address_space(3)))
typedef unsigned short bf16;
typedef short bf16x8 __attribute__((ext_vector_type(8)));
typedef short s16x4 __attribute__((ext_vector_type(4)));
typedef float f32x2 __attribute__((ext_vector_type(2)));
typedef float f32x4 __attribute__((ext_vector_type(4)));
typedef float f32x16 __attribute__((ext_vector_type(16)));
typedef unsigned u32x2 __attribute__((ext_vector_type(2)));
typedef unsigned u32x4 __attribute__((ext_vector_type(4)));
typedef GAS unsigned gu32;
typedef int v8i32_t __attribute__((ext_vector_type(8)));
typedef int v4i32_t __attribute__((ext_vector_type(4)));

constexpr int NB = 4, SEQ = 4096, T = NB * SEQ, D = 1024;
constexpr int NIN = 4096;
constexpr int QLORA = 256, KVLORA = 128, KVPAD = 256, ROPE = 32, NHEAD = 8, HD = 64, MQK = 96;
constexpr int NEXP = 64, TOPK = 6, DEXP = 256;
constexpr float EPS = 1e-6f;
constexpr float LOG2E = 1.4426950408889634f;
constexpr float C2F = 0.125f * LOG2E;
constexpr float C2M = 0.10206207261596577f * LOG2E;
constexpr int LISTCAP = T;
constexpr float HSCALE8 = 8.f;
constexpr float OSCALE8 = 8.f;
constexpr float WSCALE8 = 64.f;

constexpr size_t MiB = 1u << 20;
constexpr size_t WS_CTL = 0, CTL_ZERO_BYTES = 1 * MiB;
constexpr size_t WS_EIDX = 262144, WS_GATEW = 393216;
constexpr size_t WS_WIN = 1 * MiB, WS_WQ = 9 * MiB, WS_WKV = 9 * MiB + 512 * 1024, WS_WOM = 10 * MiB, WS_WOF = 11 * MiB, WS_WOUT = 12 * MiB;
constexpr size_t WS_WSGU = 14 * MiB, WS_WSD = 15 * MiB, WS_WR = 15 * MiB + 512 * 1024, WS_MOD = 15 * MiB + 640 * 1024;
constexpr size_t WS_WD = 16 * MiB;
constexpr size_t WS_HB = 48 * MiB;
constexpr size_t WS_FQ = 48 * MiB, WS_FK = 64 * MiB, WS_FV = 80 * MiB, WS_QLAT = 96 * MiB, WS_KVLAT = 104 * MiB;
constexpr size_t WS_OFOX = WS_FQ, WS_OMLA = WS_QLAT;
static_assert(WS_FK - WS_FQ == (size_t)T * 512 * 2 && WS_FV - WS_FK == (size_t)T * 512 * 2, "fq|fk|fv contiguous");
constexpr size_t WS_Y = 112 * MiB;
constexpr size_t WS_WGU = 112 * MiB;
constexpr size_t WS_H = 176 * MiB;
constexpr size_t WS_QMLA = WS_H;
constexpr size_t WS_GATES = 208 * MiB;
constexpr size_t WS_KN = 272 * MiB, WS_VM = 288 * MiB, WS_KPE = 304 * MiB;
constexpr size_t WS_MERGED = WS_KN;
constexpr size_t WS_LIST = 304 * MiB;
constexpr size_t WS_X1B = 224 * MiB;
constexpr size_t WS_END = 306 * MiB;
constexpr size_t DO_MODP = 4 * MiB;
constexpr size_t DO_ROPE = 0, DO_LOGF = 2 * MiB, DO_CUMF = 2 * MiB + 512 * 1024, DO_SSQQ = 3 * MiB, DO_SSQKV = 3 * MiB + 256 * 1024;

constexpr int CW_TMO = 0;
constexpr int CW_BAR = 4096;
constexpr int CW_CNT = 8192;
constexpr int CW_KM = 12288;
constexpr int CW_Q = 12544;

constexpr int RING_BYTES = 131072;
constexpr int LDSCTL_OFF = RING_BYTES;
constexpr int MISC_OFF = LDSCTL_OFF + 320;
constexpr int MOETAB_OFF = LDSCTL_OFF + 1024;
constexpr int LDS_BYTES = 147456;

constexpr int NWAVES = 8;

#define LDS_WAIT() asm volatile("s_waitcnt lgkmcnt(0)" ::: "memory")
#define VM_WAIT() asm volatile("s_waitcnt vmcnt(0)" ::: "memory")
#define RLX_AGENT __ATOMIC_RELAXED, __HIP_MEMORY_SCOPE_AGENT
__device__ __forceinline__ unsigned f2bf(float f) { unsigned u = __builtin_bit_cast(unsigned, f); return (u + 0x7fffu + ((u >> 16) & 1u)) >> 16; }
__device__ __forceinline__ float bf2f(unsigned h) { return __builtin_bit_cast(float, h << 16); }
__device__ __forceinline__ unsigned pk2(float lo, float hi) { return f2bf(lo) | (f2bf(hi) << 16); }
__device__ __forceinline__ unsigned cvt_pk_bf16(float lo, float hi) { unsigned r; asm volatile("v_cvt_pk_bf16_f32 %0, %1, %2" : "=v"(r) : "v"(lo), "v"(hi)); return r; }
__device__ __forceinline__ u32x4 pack8(f32x4 a, f32x4 b) { u32x4 w; w.x = cvt_pk_bf16(a[0], a[1]); w.y = cvt_pk_bf16(a[2], a[3]); w.z = cvt_pk_bf16(b[0], b[1]); w.w = cvt_pk_bf16(b[2], b[3]); return w; }
__device__ __forceinline__ unsigned pack4u8(float a, float b, float c, float d) {
    const unsigned lo = __builtin_amdgcn_perm(__float_as_uint(b), __float_as_uint(a), 0x0c0c0400u), hi = __builtin_amdgcn_perm(__float_as_uint(d), __float_as_uint(c), 0x0c0c0400u);
    return __builtin_amdgcn_perm(hi, lo, 0x05040100u);
}
__device__ __forceinline__ float ub(unsigned w, int i) { return (float)((w >> (8 * i)) & 0xffu); }
__device__ __forceinline__ void unpack8(u32x4 w, f32x4& a, f32x4& b) {
    a = (f32x4){bf2f(w.x & 0xffffu), bf2f(w.x >> 16), bf2f(w.y & 0xffffu), bf2f(w.y >> 16)};
    b = (f32x4){bf2f(w.z & 0xffffu), bf2f(w.z >> 16), bf2f(w.w & 0xffffu), bf2f(w.w >> 16)};
}
__device__ __forceinline__ float wave_sum(float v) {
#pragma unroll
    for (int o = 1; o < 64; o <<= 1) v += __shfl_xor(v, o);
    return v;
}
__device__ __forceinline__ float wave_max(float v) {
#pragma unroll
    for (int o = 1; o < 64; o <<= 1) v = fmaxf(v, __shfl_xor(v, o));
    return v;
}
template <int CTRL> __device__ __forceinline__ float dppf(float v) { return __builtin_bit_cast(float, __builtin_amdgcn_update_dpp(0, __builtin_bit_cast(int, v), CTRL, 0xf, 0xf, true)); }
__device__ __forceinline__ float max8(float v) { v = fmaxf(v, dppf<0xB1>(v)); v = fmaxf(v, dppf<0x4E>(v)); v = fmaxf(v, dppf<0x141>(v)); return v; }
__device__ __forceinline__ float wave_max_f(float v) { v = max8(v); v = fmaxf(v, dppf<0x140>(v)); v = fmaxf(v, __shfl_xor(v, 16)); v = fmaxf(v, __shfl_xor(v, 32)); return v; }
__device__ __forceinline__ float wave_sum_f(float v) { v += dppf<0xB1>(v); v += dppf<0x4E>(v); v += dppf<0x141>(v); v += dppf<0x140>(v); v += __shfl_xor(v, 16); v += __shfl_xor(v, 32); return v; }
__device__ __forceinline__ float sigmoidf_(float x) { return __builtin_amdgcn_rcpf(1.f + __builtin_amdgcn_exp2f(-LOG2E * x)); }
__device__ __forceinline__ float siluf_(float x) { return x * __builtin_amdgcn_rcpf(1.f + __builtin_amdgcn_exp2f(-LOG2E * x)); }

namespace pg8 {
constexpr int BM = 256, BK = 64, HALF = 128, HTB = HALF * BK * 2, NXCD = 8, WGM = 8;
__host__ __device__ __forceinline__ int lds_byte(int r, int c) { const int st = (r >> 4) * 2 + (c >> 5), rr = r & 15, cc = c & 31, ob = rr * 64 + cc * 2; return st * 1024 + (ob ^ (((ob >> 9) & 1) << 5)); }
__host__ __device__ __forceinline__ void stage_rc(int b, int& R, int& C) { const int st = b / 1024, sb = b % 1024, swz = sb ^ (((sb >> 9) & 1) << 5); R = (st >> 1) * 16 + swz / 64; C = (st & 1) * 32 + (swz % 64) / 2; }
__host__ __device__ __forceinline__ int perm32(int rho) { const int n = rho >> 4, i = rho & 15; return 8 * (i >> 2) + 4 * n + (i & 3); }

struct Unit { int pm, pn, e, aux, n; };

struct StaticOrder {
    static constexpr bool GATHER = false;
    const char* A; const char* Bt; int K;
    int nM, nN, nwg, G, c;
    __device__ void init(const void* A_, const void* Bt_, int M, int N, int K_, int G_, int c_) { A = (const char*)A_; Bt = (const char*)Bt_; K = K_; nM = M / BM; nN = N / BM; nwg = nM * nN; G = G_; c = c_; }
    __device__ bool next(int i, Unit& u) const {
        const long L = (long)i * G + c; if (L >= nwg) return false;
        int wgid = (int)L; { const int q = nwg / NXCD, r = nwg % NXCD, xcd = wgid % NXCD, off = wgid / NXCD; wgid = (xcd < r ? xcd * (q + 1) : r * (q + 1) + (xcd - r) * q) + off; }
        const int nig = WGM * nN, gid = wgid / nig, fm = gid * WGM, gsz = (nM - fm) < WGM ? (nM - fm) : WGM;
        u.pm = fm + ((wgid % nig) % gsz); u.pn = (wgid % nig) / gsz; u.e = 0; u.aux = 0; u.n = BM; return true;
    }
    __device__ __forceinline__ const char* a_ptr(const Unit& u) const { return A + (size_t)u.pm * BM * K * 2; }
    __device__ __forceinline__ const char* b_ptr(const Unit& u) const { return Bt + (size_t)u.pn * BM * K * 2; }
    __device__ __forceinline__ unsigned a_row(const Unit&, int r) const { return (unsigned)r; }
};

template <class Epi, class Sched, bool ALIGN_EPI, bool FP8 = false>
__device__ __forceinline__ void gemm_phase(LAS unsigned char* lds, const Sched& S, const Epi& E) {
    int tid = threadIdx.x; asm volatile("" : "+v"(tid));
    const int wid = __builtin_amdgcn_readfirstlane(tid >> 6), lane = tid & 63, wr = wid >> 2, wc = wid & 3, fr = lane & 15, fq = lane >> 4;
    const int K = S.K, nt = K / BK;
    unsigned voffB[2], voffA[2];
#pragma unroll
    for (int i = 0; i < 2; ++i) { int R, C; stage_rc(tid * 16 + i * 8192, R, C); const int Rb = (R & ~31) + perm32(R & 31);
        voffA[i] = (unsigned)(R * K + C) * 2u; voffB[i] = (unsigned)(Rb * K + C) * 2u; }
    unsigned vA[2][2], vN[2][2];
    const size_t kstep = (size_t)(BK * 2);
    const size_t hstep = (size_t)HALF * K * 2;
    const unsigned ldsw = (unsigned)wid * 1024u;
    const int aoff = lds_byte(wr * 64 + fr, fq * 8), boff = lds_byte(wc * 32 + fr, fq * 8);
#define PG8_SA(b, h) (((b) * 2 + (h)) * HTB)
#define PG8_SB(b, h) ((4 + (b) * 2 + (h)) * HTB)
#define PG8_STAGE(bufoff, gbase, voff) do { _Pragma("unroll") for (int _i = 0; _i < 2; ++_i) \
        __builtin_amdgcn_global_load_lds((const unsigned*)((const char*)(gbase) + (voff)[_i]), (LAS unsigned*)(lds + (bufoff) + ldsw + _i * 8192), 16, 0, 0); } while (0)
#define PG8_STAGE_A(bufoff, gbase, h, nx) do { if constexpr (Sched::GATHER) { const unsigned vs_[2] = {(nx) ? vN[h][0] : vA[h][0], (nx) ? vN[h][1] : vA[h][1]}; PG8_STAGE(bufoff, gbase, vs_); }     \
        else PG8_STAGE(bufoff, (const char*)(gbase) + (h) * hstep, voffA); } while (0)
#define PG8_LDA(dst, b, h) do { _Pragma("unroll") for (int m = 0; m < 4; ++m) { if constexpr (FP8) { dst##8[m].lo = *(const LAS v4i32_t*)(lds + PG8_SA(b, h) + aoff + m * 2048); dst##8[m].hi = *(const LAS v4i32_t*)(lds + PG8_SA(b, h) + aoff + m * 2048 + 1024); } \
        else { _Pragma("unroll") for (int k = 0; k < 2; ++k) dst[m][k] = *(const LAS bf16x8*)(lds + PG8_SA(b, h) + aoff + m * 2048 + k * 1024); } } } while (0)
#define PG8_LDB(dst, b, h) do { _Pragma("unroll") for (int n = 0; n < 2; ++n) { if constexpr (FP8) { dst##8[n].lo = *(const LAS v4i32_t*)(lds + PG8_SB(b, h) + boff + n * 2048); dst##8[n].hi = *(const LAS v4i32_t*)(lds + PG8_SB(b, h) + boff + n * 2048 + 1024); } \
        else { _Pragma("unroll") for (int k = 0; k < 2; ++k) dst[n][k] = *(const LAS bf16x8*)(lds + PG8_SB(b, h) + boff + n * 2048 + k * 1024); } } } while (0)
#define PG8_MMA(ai, bj, At, Bt) do { __builtin_amdgcn_s_setprio(1); _Pragma("unroll") for (int m = 0; m < 4; ++m) _Pragma("unroll") for (int n = 0; n < 2; ++n) { \
        if constexpr (FP8) asm volatile("v_mfma_scale_f32_16x16x128_f8f6f4 %0, %1, %2, %0, %3, %3 op_sel_hi:[0,0,0]" : "+v"(acc[ai][bj][m][n]) : "v"(Bt##8[n]), "v"(At##8[m]), "v"(sc1_));     \
        else { _Pragma("unroll") for (int k = 0; k < 2; ++k) acc[ai][bj][m][n] = __builtin_amdgcn_mfma_f32_16x16x32_bf16(Bt[n][k], At[m][k], acc[ai][bj][m][n], 0, 0, 0); } } \
        __builtin_amdgcn_s_setprio(0); } while (0)
#define PG8_WAIT_V(n) asm volatile("s_waitcnt vmcnt(" #n ")" ::: "memory")
#define PG8_WAIT_L(n) asm volatile("s_waitcnt lgkmcnt(" #n ")" ::: "memory")
#define PG8_BAR __builtin_amdgcn_s_barrier()
#define PG8_SCHED __builtin_amdgcn_sched_barrier(0)
#define PG8_SETV(dst, u) do { _Pragma("unroll") for (int _h = 0; _h < 2; ++_h) _Pragma("unroll") for (int _i = 0; _i < 2; ++_i) { int R_, C_; stage_rc(tid * 16 + _i * 8192, R_, C_); \
        dst[_h][_i] = (S.a_row(u, _h * HALF + R_) * (unsigned)K + (unsigned)C_) * 2u; } } while (0)
    Unit cur, nxt; int ui = 0;
    if (!S.next(0, cur)) return;
    f32x4 acc[2][2][4][2];
#define PG8_ZERO() do { _Pragma("unroll") for (int a = 0; a < 2; ++a) _Pragma("unroll") for (int b = 0; b < 2; ++b) _Pragma("unroll") for (int m = 0; m < 4; ++m) _Pragma("unroll") for (int n = 0; n < 2; ++n) { \
        if constexpr (FP8) asm volatile("v_mov_b32 %0, 0\n\tv_mov_b32 %1, 0\n\tv_mov_b32 %2, 0\n\tv_mov_b32 %3, 0" : "=v"(acc[a][b][m][n][0]), "=v"(acc[a][b][m][n][1]), "=v"(acc[a][b][m][n][2]), "=v"(acc[a][b][m][n][3])); \
        else acc[a][b][m][n] = (f32x4){0.f, 0.f, 0.f, 0.f}; } } while (0)
    PG8_ZERO();
    unsigned sc1_ = 0x7f7f7f7fu; asm volatile("" : "+v"(sc1_));
    (void)sc1_;
    bf16x8 At[4][2], B0[2][2], B1[2][2];
    v8i32_t At8[4], B08[2], B18[2];
    (void)At; (void)B0; (void)B1; (void)At8; (void)B08; (void)B18;
    const char* cA = S.a_ptr(cur); const char* cB = S.b_ptr(cur);
    if constexpr (Sched::GATHER) { PG8_SETV(vA, cur); }
    PG8_STAGE(PG8_SB(0, 0), cB, voffB); PG8_STAGE(PG8_SB(0, 1), cB + hstep, voffB); PG8_STAGE_A(PG8_SA(0, 0), cA, 0, false); PG8_STAGE_A(PG8_SA(0, 1), cA, 1, false);
    if (wr == 1) PG8_BAR;
    PG8_WAIT_V(2); PG8_BAR;
    PG8_STAGE(PG8_SB(1, 0), cB + kstep, voffB); PG8_STAGE_A(PG8_SA(1, 0), cA + kstep, 0, false); PG8_STAGE(PG8_SB(1, 1), cB + hstep + kstep, voffB);
    PG8_WAIT_V(6); PG8_BAR;
    for (;;) {
        const bool has_next = S.next(ui + 1, nxt);
        const char* nA = has_next ? S.a_ptr(nxt) : cA; const char* nB = has_next ? S.b_ptr(nxt) : cB;
        if constexpr (Sched::GATHER) { if (has_next) { PG8_SETV(vN, nxt); } else {
#pragma unroll
            for (int h = 0; h < 2; ++h)
#pragma unroll
                for (int i = 0; i < 2; ++i) vN[h][i] = vA[h][i]; } }
        for (int t = 0; t < nt; t += 2) {
            const bool last = (t == nt - 2);
            if constexpr (Epi::MIDK) { if (t == nt / 2) E.mid(acc, cur, wr, wc, fr, fq); }
            const char* a1 = cA + (size_t)(t + 1) * kstep;
            const char* a2 = last ? nA : cA + (size_t)(t + 2) * kstep; const char* b2 = last ? nB : cB + (size_t)(t + 2) * kstep;
            const char* a3 = a2 + kstep; const char* b3 = b2 + kstep;
            PG8_LDB(B0, 0, 0); PG8_LDB(B1, 0, 1); PG8_SCHED; PG8_LDA(At, 0, 0); PG8_STAGE_A(PG8_SA(1, 1), a1, 1, false);
            PG8_WAIT_V(8); PG8_WAIT_L(0); PG8_BAR; PG8_MMA(0, 0, At, B0); PG8_MMA(0, 1, At, B1); PG8_BAR; PG8_SCHED;
            PG8_LDA(At, 0, 1); PG8_STAGE(PG8_SB(0, 0), b2, voffB); PG8_STAGE(PG8_SB(0, 1), b2 + hstep, voffB); PG8_STAGE_A(PG8_SA(0, 0), a2, 0, last);
            PG8_WAIT_V(8); PG8_WAIT_L(0); PG8_BAR; PG8_MMA(1, 0, At, B0); PG8_MMA(1, 1, At, B1); PG8_BAR; PG8_SCHED;
            PG8_LDB(B0, 1, 0); PG8_LDB(B1, 1, 1); PG8_SCHED; PG8_LDA(At, 1, 0); PG8_STAGE_A(PG8_SA(0, 1), a2, 1, last);
            PG8_WAIT_V(8); PG8_WAIT_L(0); PG8_BAR; PG8_MMA(0, 0, At, B0); PG8_MMA(0, 1, At, B1); PG8_BAR; PG8_SCHED;
            PG8_LDA(At, 1, 1); PG8_STAGE(PG8_SB(1, 0), b3, voffB); PG8_STAGE(PG8_SB(1, 1), b3 + hstep, voffB); PG8_STAGE_A(PG8_SA(1, 0), a3, 0, last);
            PG8_WAIT_V(8); PG8_WAIT_L(0); PG8_BAR; PG8_MMA(1, 0, At, B0); PG8_MMA(1, 1, At, B1); PG8_BAR; PG8_SCHED;
        }
        if constexpr (ALIGN_EPI) { if (wr == 0) PG8_BAR; }
        if constexpr (FP8) { asm volatile("s_nop 15\n\ts_nop 7" ::: "memory"); __builtin_amdgcn_sched_barrier(0); }
        E(acc, cur, wr, wc, fr, fq);
        if (!has_next) break;
        PG8_ZERO();
        cur = nxt; cA = nA; cB = nB; ++ui;
        if constexpr (Sched::GATHER) {
#pragma unroll
            for (int h = 0; h < 2; ++h)
#pragma unroll
                for (int i = 0; i < 2; ++i) vA[h][i] = vN[h][i]; }
        if constexpr (ALIGN_EPI) { if (wr == 1) PG8_BAR; }
    }
    PG8_WAIT_V(0);
    if constexpr (!ALIGN_EPI) { if (wr == 0) PG8_BAR; }
    PG8_BAR;
#undef PG8_SA
#undef PG8_SB
#undef PG8_STAGE
#undef PG8_STAGE_A
#undef PG8_LDA
#undef PG8_LDB
#undef PG8_MMA
#undef PG8_ZERO
#undef PG8_WAIT_V
#undef PG8_WAIT_L
#undef PG8_BAR
#undef PG8_SCHED
#undef PG8_SETV
}
}
using pg8::Unit;

#define EPI_ROWS(ai, m) for (int ai = 0; ai < 2; ++ai) for (int m = 0; m < 4; ++m)

struct EpiInProj {
    static constexpr bool MIDK = false;
    bf16 *qlat, *kvlat, *kpe, *fq, *gates; float *logf, *ssqq, *ssqkv; const float* ropetab; const float* bforget; bool skip; int rowmul;
    __device__ __forceinline__ void operator()(const f32x4 (&acc)[2][2][4][2], const Unit& u, int wr, int wc, int fr, int fq_) const {
        if (skip) return;
        const int pn = u.pn, row0 = u.pm * 256 + wr * 64 + fr, c0 = wc * 32 + 8 * fq_;
        if (pn >= 8) {
            unsigned char* gp = (unsigned char*)gates + (size_t)(pn - 8) * 256 + wc * 64 + fq_ * 16;
#pragma unroll
            for (int ai = 0; ai < 2; ++ai)
#pragma unroll
                for (int m = 0; m < 4; ++m) { const int row = row0 + ai * 128 + m * 16; u32x4 o;
#pragma unroll
                    for (int bj = 0; bj < 2; ++bj) { f32x4 v0 = acc[ai][bj][m][0], v1 = acc[ai][bj][m][1];
#pragma unroll
                        for (int q = 0; q < 4; ++q) { v0[q] = sigmoidf_(v0[q]) * 255.f + 8388608.f; v1[q] = sigmoidf_(v1[q]) * 255.f + 8388608.f; }
                        o[2 * bj] = pack4u8(v0[0], v0[1], v0[2], v0[3]); o[2 * bj + 1] = pack4u8(v1[0], v1[1], v1[2], v1[3]); }
                    *(u32x4*)(gp + (size_t)row * 2048) = o; }
        } else if (pn >= 2) {
            bf16* dst = fq + (size_t)((pn - 2) >> 1) * ((size_t)T * 512) + (pn & 1) * 256 + c0; const float sc = (pn < 4) ? C2F : 1.f;
#pragma unroll
            for (int ai = 0; ai < 2; ++ai)
#pragma unroll
                for (int m = 0; m < 4; ++m) { const int row = row0 + ai * 128 + m * 16;
#pragma unroll
                    for (int bj = 0; bj < 2; ++bj) *(u32x4*)(dst + (size_t)row * 512 + 128 * bj) = pack8(acc[ai][bj][m][0] * sc, acc[ai][bj][m][1] * sc); }
        } else if (pn == 0) {
#pragma unroll
            for (int ai = 0; ai < 2; ++ai)
#pragma unroll
                for (int m = 0; m < 4; ++m) { const int row = row0 + ai * 128 + m * 16; float s = 0.f;
#pragma unroll
                    for (int bj = 0; bj < 2; ++bj) { const f32x4 v0 = acc[ai][bj][m][0], v1 = acc[ai][bj][m][1];
                        s += (v0[0] * v0[0] + v0[1] * v0[1]) + (v0[2] * v0[2] + v0[3] * v0[3]) + (v1[0] * v1[0] + v1[1] * v1[1]) + (v1[2] * v1[2] + v1[3] * v1[3]);
                        *(u32x4*)(qlat + (size_t)row * QLORA + c0 + 128 * bj) = pack8(v0, v1); }
                    s += __shfl_xor(s, 16); s += __shfl_xor(s, 32);
                    if (fq_ == 0) ssqq[row * 4 + wc] = s; }
        } else {
#pragma unroll
            for (int ai = 0; ai < 2; ++ai)
#pragma unroll
                for (int m = 0; m < 4; ++m) { const int row = row0 + ai * 128 + m * 16;
                    { const f32x4 v0 = acc[ai][0][m][0], v1 = acc[ai][0][m][1];
                      float s = (v0[0] * v0[0] + v0[1] * v0[1]) + (v0[2] * v0[2] + v0[3] * v0[3]) + (v1[0] * v1[0] + v1[1] * v1[1]) + (v1[2] * v1[2] + v1[3] * v1[3]);
                      *(u32x4*)(kvlat + (size_t)row * KVPAD + c0) = pack8(v0, v1);
                      s += __shfl_xor(s, 16); s += __shfl_xor(s, 32);
                      if (fq_ == 0) ssqkv[row * 4 + wc] = s; }
                    { const f32x4 v0 = acc[ai][1][m][0], v1 = acc[ai][1][m][1];
                      *(u32x4*)(kvlat + (size_t)row * KVPAD + 128 + c0) = (u32x4){0u, 0u, 0u, 0u};
                      if (wc == 0) {
                          const f32x4* tb = (const f32x4*)(ropetab + ((size_t)row * 16 + 4 * fq_) * 2);
                          const f32x4 t0 = tb[0], t1 = tb[1];
                          f32x4 o1, o2;
                          o1[0] = v0[0] * t0[0] - v1[0] * t0[1]; o2[0] = v1[0] * t0[0] + v0[0] * t0[1];
                          o1[1] = v0[1] * t0[2] - v1[1] * t0[3]; o2[1] = v1[1] * t0[2] + v0[1] * t0[3];
                          o1[2] = v0[2] * t1[0] - v1[2] * t1[1]; o2[2] = v1[2] * t1[0] + v0[2] * t1[1];
                          o1[3] = v0[3] * t1[2] - v1[3] * t1[3]; o2[3] = v1[3] * t1[2] + v0[3] * t1[3];
                          *(u32x4*)(kpe + (size_t)row * ROPE + 8 * fq_) = pack8(o1, o2);
                      } else if (wc == 1 && fq_ == 0) {
                          f32x4 l0, l1;
#pragma unroll
                          for (int h = 0; h < 4; ++h) { const float z0 = v0[h] + bforget[h], z1 = v1[h] + bforget[4 + h];
                              l0[h] = -__builtin_amdgcn_logf(1.f + __builtin_amdgcn_exp2f(-LOG2E * z0)); l1[h] = -__builtin_amdgcn_logf(1.f + __builtin_amdgcn_exp2f(-LOG2E * z1)); }
                          *(f32x4*)(logf + (size_t)row * 8) = l0; *(f32x4*)(logf + (size_t)row * 8 + 4) = l1;
                      } } }
        }
        (void)rowmul;
    }
};

struct EpiQup {
    static constexpr bool MIDK = false;
    bf16* q; const float* ssqq; const float* ropetab;
    __device__ __forceinline__ void operator()(const f32x4 (&acc)[2][2][4][2], const Unit& u, int wr, int wc, int fr, int fq_) const {
        const int row0 = u.pm * 256 + wr * 64 + fr, c0 = u.pn * 256 + wc * 32 + 8 * fq_;
#pragma unroll
        for (int ai = 0; ai < 2; ++ai)
#pragma unroll
            for (int m = 0; m < 4; ++m) {
                const int row = row0 + ai * 128 + m * 16;
                const f32x4 sq = *(const f32x4*)(ssqq + row * 4);
                const float rs = rsqrtf(((sq[0] + sq[1]) + (sq[2] + sq[3])) * (1.f / QLORA) + EPS) * C2M;
#pragma unroll
                for (int bj = 0; bj < 2; ++bj) {
                    const int col = c0 + 128 * bj, j = col % MQK;
                    f32x4 v0 = acc[ai][bj][m][0] * rs, v1 = acc[ai][bj][m][1] * rs;
                    if (j >= 64) { const int g = (j - 64) >> 3;
                        const f32x4* tb = (const f32x4*)(ropetab + ((size_t)row * 16 + 4 * g) * 2);
                        const f32x4 t0 = tb[0], t1 = tb[1];
                        f32x4 o1, o2;
                        o1[0] = v0[0] * t0[0] - v1[0] * t0[1]; o2[0] = v1[0] * t0[0] + v0[0] * t0[1];
                        o1[1] = v0[1] * t0[2] - v1[1] * t0[3]; o2[1] = v1[1] * t0[2] + v0[1] * t0[3];
                        o1[2] = v0[2] * t1[0] - v1[2] * t1[1]; o2[2] = v1[2] * t1[0] + v0[2] * t1[1];
                        o1[3] = v0[3] * t1[2] - v1[3] * t1[3]; o2[3] = v1[3] * t1[2] + v0[3] * t1[3];
                        v0 = o1; v1 = o2; }
                    *(u32x4*)(q + (size_t)row * 768 + col) = pack8(v0, v1);
                }
            }
    }
};

struct EpiKVup {
    static constexpr bool MIDK = false;
    bf16 *kn, *vm; const float* ssqkv;
    __device__ __forceinline__ void operator()(const f32x4 (&acc)[2][2][4][2], const Unit& u, int wr, int wc, int fr, int fq_) const {
        const int row0 = u.pm * 256 + wr * 64 + fr, c0 = u.pn * 256 + wc * 32 + 8 * fq_;
        bf16* dst = (u.pn < 2) ? kn : vm; const int cb = (u.pn & 1) * 256 + wc * 32 + 8 * fq_;
        (void)c0;
#pragma unroll
        for (int ai = 0; ai < 2; ++ai)
#pragma unroll
            for (int m = 0; m < 4; ++m) {
                const int row = row0 + ai * 128 + m * 16;
                const f32x4 sq = *(const f32x4*)(ssqkv + row * 4);
                const float rs = rsqrtf(((sq[0] + sq[1]) + (sq[2] + sq[3])) * (1.f / KVLORA) + EPS);
#pragma unroll
                for (int bj = 0; bj < 2; ++bj) *(u32x4*)(dst + (size_t)row * 512 + cb + 128 * bj) = pack8(acc[ai][bj][m][0] * rs, acc[ai][bj][m][1] * rs);
            }
    }
};

struct EpiPartA {
    static constexpr bool MIDK = false;
    float* part; const bf16* gates;
    __device__ __forceinline__ void operator()(const f32x4 (&acc)[2][2][4][2], const Unit& u, int wr, int wc, int fr, int fq_) const {
        const int row0 = u.pm * 256 + wr * 64 + fr, c0 = u.pn * 256 + wc * 32 + 8 * fq_;
#pragma unroll
        for (int ai = 0; ai < 2; ++ai)
#pragma unroll
            for (int m = 0; m < 4; ++m) {
                const int row = row0 + ai * 128 + m * 16;
#pragma unroll
                for (int bj = 0; bj < 2; ++bj) { const int col = c0 + 128 * bj;
                    f32x4 g0, g1; unpack8(*(const u32x4*)(gates + (size_t)row * 2048 + col), g0, g1);
                    *(f32x4*)(part + (size_t)row * D + col) = g0 * acc[ai][bj][m][0]; *(f32x4*)(part + (size_t)row * D + col + 4) = g1 * acc[ai][bj][m][1]; }
            }
    }
};
struct EpiMerged {
    static constexpr bool MIDK = false;
    const float* part; const bf16* gates; bf16* merged;
    __device__ __forceinline__ void operator()(const f32x4 (&acc)[2][2][4][2], const Unit& u, int wr, int wc, int fr, int fq_) const {
        const int row0 = u.pm * 256 + wr * 64 + fr, c0 = u.pn * 256 + wc * 32 + 8 * fq_;
#pragma unroll
        for (int ai = 0; ai < 2; ++ai)
#pragma unroll
            for (int m = 0; m < 4; ++m) {
                const int row = row0 + ai * 128 + m * 16;
#pragma unroll
                for (int bj = 0; bj < 2; ++bj) { const int col = c0 + 128 * bj;
                    f32x4 g0, g1; unpack8(*(const u32x4*)(gates + (size_t)row * 2048 + 1024 + col), g0, g1);
                    const f32x4 p0 = *(const f32x4*)(part + (size_t)row * D + col), p1 = *(const f32x4*)(part + (size_t)row * D + col + 4);
                    *(u32x4*)(merged + (size_t)row * D + col) = pack8(p0 + g0 * acc[ai][bj][m][0], p1 + g1 * acc[ai][bj][m][1]); }
            }
    }
};
struct EpiMergedCat {
    static constexpr bool MIDK = true;
    const unsigned char* gates; unsigned char* merged; float sc;
    __device__ __forceinline__ void mid(f32x4 (&acc)[2][2][4][2], const Unit& u, int wr, int wc, int fr, int fq_) const {
        int row0 = u.pm * 256 + wr * 64 + fr, c0 = u.pn * 256 + wc * 64 + fq_ * 16;
        asm volatile("" : "+v"(row0), "+v"(c0));
#pragma unroll
        for (int ai = 0; ai < 2; ++ai)
#pragma unroll
            for (int m = 0; m < 4; ++m) { const int row = row0 + ai * 128 + m * 16;
                const u32x4 ga = *(const u32x4*)(gates + (size_t)row * 2048 + c0), gb = *(const u32x4*)(gates + (size_t)row * 2048 + 1024 + c0);
#pragma unroll
                for (int bj = 0; bj < 2; ++bj)
#pragma unroll
                    for (int q = 0; q < 4; ++q) { acc[ai][bj][m][0][q] *= ub(ga[2 * bj], q) * __builtin_amdgcn_rcpf(fmaxf(ub(gb[2 * bj], q), 1.f)); acc[ai][bj][m][1][q] *= ub(ga[2 * bj + 1], q) * __builtin_amdgcn_rcpf(fmaxf(ub(gb[2 * bj + 1], q), 1.f)); }
                asm volatile("" ::: "memory"); }
    }
    __device__ __forceinline__ void operator()(const f32x4 (&acc)[2][2][4][2], const Unit& u, int wr, int wc, int fr, int fq_) const {
        const int row0 = u.pm * 256 + wr * 64 + fr, c0 = u.pn * 256 + wc * 32 + 8 * fq_, g0 = u.pn * 256 + wc * 64 + fq_ * 16;
#pragma unroll
        for (int ai = 0; ai < 2; ++ai)
#pragma unroll
            for (int m = 0; m < 4; ++m) { const int row = row0 + ai * 128 + m * 16;
                const u32x4 gb = *(const u32x4*)(gates + (size_t)row * 2048 + 1024 + g0);
#pragma unroll
                for (int bj = 0; bj < 2; ++bj) { const int col = c0 + 128 * bj;
                    f32x4 v0, v1;
#pragma unroll
                    for (int q = 0; q < 4; ++q) { v0[q] = fmaxf(ub(gb[2 * bj], q), 1.f) * acc[ai][bj][m][0][q] * sc; v1[q] = fmaxf(ub(gb[2 * bj + 1], q), 1.f) * acc[ai][bj][m][1][q] * sc; }
                    u32x2 o; int p_ = __builtin_amdgcn_cvt_pk_fp8_f32(v0[0], v0[1], 0, false); p_ = __builtin_amdgcn_cvt_pk_fp8_f32(v0[2], v0[3], p_, true); o.x = (unsigned)p_;
                    p_ = __builtin_amdgcn_cvt_pk_fp8_f32(v1[0], v1[1], 0, false); p_ = __builtin_amdgcn_cvt_pk_fp8_f32(v1[2], v1[3], p_, true); o.y = (unsigned)p_;
                    *(u32x2*)(merged + (size_t)row * D + col) = o; } }
    }
};
struct EpiOut {
    static constexpr bool MIDK = false;
    const float* x; bf16* x1; const float* mod; float* ssq1; float sc;
    __device__ __forceinline__ void operator()(const f32x4 (&acc)[2][2][4][2], const Unit& u, int wr, int wc, int fr, int fq_) const {
        const int row0 = u.pm * 256 + wr * 64 + fr, c0 = u.pn * 256 + wc * 32 + 8 * fq_;
        const float* gm = mod + (size_t)((u.pm * 256) / SEQ) * 6 * D + 2 * D;
        f32x4 g[2][2];
#pragma unroll
        for (int bj = 0; bj < 2; ++bj) { g[bj][0] = *(const f32x4*)(gm + c0 + 128 * bj) * sc; g[bj][1] = *(const f32x4*)(gm + c0 + 128 * bj + 4) * sc; }
#pragma unroll
        for (int ai = 0; ai < 2; ++ai)
#pragma unroll
            for (int m = 0; m < 4; ++m) { const int row = row0 + ai * 128 + m * 16; float sq = 0.f;
#pragma unroll
                for (int bj = 0; bj < 2; ++bj) { const int col = c0 + 128 * bj;
                    const f32x4 x0 = __builtin_nontemporal_load((const f32x4*)(x + (size_t)row * D + col)), x1v = __builtin_nontemporal_load((const f32x4*)(x + (size_t)row * D + col + 4));
                    f32x4 r0 = x0 + g[bj][0] * acc[ai][bj][m][0], r1 = x1v + g[bj][1] * acc[ai][bj][m][1];
                    const u32x4 pk_ = pack8(r0, r1); unpack8(pk_, r0, r1);
                    *(u32x4*)(x1 + (size_t)row * D + col) = pk_;
                    sq += (r0[0] * r0[0] + r0[1] * r0[1]) + (r0[2] * r0[2] + r0[3] * r0[3]) + (r1[0] * r1[0] + r1[1] * r1[1]) + (r1[2] * r1[2] + r1[3] * r1[3]); }
                sq += __shfl_xor(sq, 16); sq += __shfl_xor(sq, 32);
                if (fq_ == 0) ssq1[(size_t)row * 16 + 4 * u.pn + wc] = sq; }
    }
};
struct EpiHb {
    static constexpr bool MIDK = false;
    unsigned char* hb; float sc;
    __device__ __forceinline__ void operator()(const f32x4 (&acc)[2][2][4][2], const Unit& u, int wr, int wc, int fr, int fq_) const {
        const int row0 = u.pm * 256 + wr * 64 + fr, c0 = u.pn * 128 + wc * 32 + 8 * fq_;
#pragma unroll
        for (int ai = 0; ai < 2; ++ai)
#pragma unroll
            for (int m = 0; m < 4; ++m) { const int row = row0 + ai * 128 + m * 16;
                f32x4 h0, h1;
#pragma unroll
                for (int q = 0; q < 4; ++q) { h0[q] = siluf_(acc[ai][0][m][0][q] * sc) * (acc[ai][1][m][0][q] * (sc * HSCALE8)); h1[q] = siluf_(acc[ai][0][m][1][q] * sc) * (acc[ai][1][m][1][q] * (sc * HSCALE8)); }
                u32x2 o; int p_ = __builtin_amdgcn_cvt_pk_fp8_f32(h0[0], h0[1], 0, false); p_ = __builtin_amdgcn_cvt_pk_fp8_f32(h0[2], h0[3], p_, true); o.x = (unsigned)p_;
                p_ = __builtin_amdgcn_cvt_pk_fp8_f32(h1[0], h1[1], 0, false); p_ = __builtin_amdgcn_cvt_pk_fp8_f32(h1[2], h1[3], p_, true); o.y = (unsigned)p_;
                *(u32x2*)(hb + (size_t)row * DEXP + c0) = o; }
    }
};
struct EpiDown {
    static constexpr bool MIDK = false;
    bf16* Y; float* out; float* outw; const float* mod; const unsigned short* list; const unsigned char* eidx; const float* gatew;
    __device__ __forceinline__ void operator()(const f32x4 (&acc)[2][2][4][2], const Unit& u, int wr, int wc, int fr, int fq_) const {
        const int c0 = u.pn * 256 + wc * 32 + 8 * fq_;
#pragma unroll
        for (int ai = 0; ai < 2; ++ai)
#pragma unroll
            for (int m = 0; m < 4; ++m) {
                const int rl = wr * 64 + fr + ai * 128 + m * 16, idx = u.aux * 256 + rl;
                if (u.e == NEXP) {
                    const int t = idx; const float* gf = mod + (size_t)(t / SEQ) * 6 * D + 5 * D;
#pragma unroll
                    for (int bj = 0; bj < 2; ++bj) { const int col = c0 + 128 * bj; const float* o = out + (size_t)t * D + col; float* ow = outw + (size_t)t * D + col;
                        const f32x4 g0 = *(const f32x4*)(gf + col), g1 = *(const f32x4*)(gf + col + 4);
                        const f32x4 x0 = *(const f32x4*)o, x1v = *(const f32x4*)(o + 4);
                        *(f32x4*)ow = x0 + g0 * acc[ai][bj][m][0]; *(f32x4*)(ow + 4) = x1v + g1 * acc[ai][bj][m][1]; }
                } else if (idx < u.n) {
                    const int t = list[(size_t)u.e * LISTCAP + idx];
                    const u32x2 ev = *(const u32x2*)(eidx + (size_t)t * 8);
                    int k = 0;
#pragma unroll
                    for (int q = 1; q < TOPK; ++q) { const unsigned b = (q < 4) ? ((ev.x >> (8 * q)) & 0xffu) : ((ev.y >> (8 * (q - 4))) & 0xffu); if ((int)b == u.e) k = q; }
                    const float w = gatew[(size_t)t * 8 + k];
#pragma unroll
                    for (int bj = 0; bj < 2; ++bj) *(u32x4*)(Y + ((size_t)t * TOPK + k) * D + c0 + 128 * bj) = pack8(acc[ai][bj][m][0] * w, acc[ai][bj][m][1] * w);
                }
            }
    }
};

template <int NT, bool GATHER_>
struct MoeOrder {
    static constexpr bool GATHER = GATHER_;
    const char* A; const char* Bt; const char* Bsh; int K; size_t bstride;
    const unsigned short* list; volatile LAS int* tab;
    int G, c;
    __device__ bool next(int i, Unit& u) const {
        int ti, pn_;
        if ((G & 7) == 0) { const int x = c & 7, j = i * (G >> 3) + (c >> 3); ti = (j / NT) * 8 + x; pn_ = j % NT; if (ti >= tab[65]) return false; }
        else { const int total = tab[65] * NT; const long L = (long)i * G + c; if (L >= total) return false; ti = (int)L / NT; pn_ = (int)L % NT; }
        u.pn = pn_; u.pm = ti;
        const int e = __builtin_amdgcn_readfirstlane(tab[132 + ti]);
        u.e = e; u.aux = __builtin_amdgcn_readfirstlane(ti - tab[e]); u.n = __builtin_amdgcn_readfirstlane(tab[66 + e]); return true;
    }
    __device__ __forceinline__ const char* a_ptr(const Unit& u) const { return GATHER ? A : A + (size_t)u.pm * 256 * K * 2; }
    __device__ __forceinline__ const char* b_ptr(const Unit& u) const { return (u.e == NEXP ? Bsh : Bt + (size_t)u.e * bstride) + (size_t)u.pn * 256 * K * 2; }
    __device__ __forceinline__ unsigned a_row(const Unit& u, int r) const {
        if (!GATHER) return (unsigned)r;
        const int idx = u.aux * 256 + r;
        if (u.e == NEXP) return (unsigned)idx;
        return (idx < u.n) ? (unsigned)list[(size_t)u.e * LISTCAP + idx] : 0u;
    }
};

struct UpOrder {
    static constexpr bool GATHER = false;
    const char* Aq; const char* Bq; const char* Akv; const char* Bkv; int K; int G, c;
    __device__ bool next(int i, Unit& u) const {
        int L = i * G + c; if (L >= 448) return false;
        if (L < 256) { u.e = 1; u.pm = L >> 2; u.pn = L & 3; } else { L -= 256; u.e = 0; u.pm = L / 3; u.pn = L % 3; }
        u.aux = 0; u.n = 256; return true; }
    __device__ __forceinline__ const char* a_ptr(const Unit& u) const { return (u.e ? Akv : Aq) + (size_t)u.pm * 256 * K * 2; }
    __device__ __forceinline__ const char* b_ptr(const Unit& u) const { return (u.e ? Bkv : Bq) + (size_t)u.pn * 256 * K * 2; }
    __device__ __forceinline__ unsigned a_row(const Unit&, int r) const { return (unsigned)r; }
};
struct EpiUp {
    static constexpr bool MIDK = false;
    EpiQup q; EpiKVup kv;
    __device__ __forceinline__ void operator()(const f32x4 (&acc)[2][2][4][2], const Unit& u, int wr, int wc, int fr, int fq_) const { if (u.e) kv(acc, u, wr, wc, fr, fq_); else q(acc, u, wr, wc, fr, fq_); }
};

struct SharedDownOrder {
    static constexpr bool GATHER = false;
    const char* A; const char* Bt; int K; int G, c;
    __device__ bool next(int i, Unit& u) const { const int L = i * G + c; if (L >= (T / 256) * 4) return false; u.pm = L >> 2; u.pn = L & 3; u.e = NEXP; u.aux = L >> 2; u.n = 256; return true; }
    __device__ __forceinline__ const char* a_ptr(const Unit& u) const { return A + (size_t)u.pm * 256 * K * 2; }
    __device__ __forceinline__ const char* b_ptr(const Unit& u) const { return Bt + (size_t)u.pn * 256 * K * 2; }
    __device__ __forceinline__ unsigned a_row(const Unit&, int r) const { return (unsigned)r; }
};

namespace att {
constexpr int KSLOT = 12288, VSLOT = 8192;
constexpr int L_K = 0, L_V = 3 * KSLOT, L_F = L_V + 2 * VSLOT, L_WS = L_F + 3 * 256, L_OST = L_WS + 2048, L_END = L_OST + 8 * 4096;
static_assert(L_END <= RING_BYTES, "attention LDS");
__device__ __forceinline__ int crow(int r, int hi) { return (r & 3) + 8 * (r >> 2) + 4 * hi; }
__device__ __forceinline__ float max3f(float a, float b, float c) { return fmaxf(fmaxf(a, b), c); }
__device__ __forceinline__ float rowmax(const f32x16& p0, const f32x16& p1) {
    float a = max3f(p0[0], p0[1], p1[0]), b = max3f(p0[2], p0[3], p1[1]); a = max3f(a, p1[2], p1[3]);
#pragma unroll
    for (int r = 4; r < 16; r += 4) { a = max3f(a, p0[r], p0[r + 1]); b = max3f(b, p0[r + 2], p0[r + 3]); a = max3f(a, p1[r], p1[r + 1]); b = max3f(b, p1[r + 2], p1[r + 3]); }
    const float m = fmaxf(a, b);
    auto rr = __builtin_amdgcn_permlane32_swap(__float_as_uint(m), __float_as_uint(m), false, false);
    return fmaxf(__uint_as_float(rr[0]), __uint_as_float(rr[1]));
}
__device__ __forceinline__ void cmask(f32x16& p0, f32x16& p1, int jb, int qrel, int hi) {
    const float NEG = -INFINITY; const int kb = 64 * jb + 4 * hi;
#pragma unroll
    for (int r = 0; r < 16; ++r) { const int kv = kb + (r & 3) + 8 * (r >> 2); if (kv > qrel) p0[r] = NEG; if (kv + 32 > qrel) p1[r] = NEG; }
}
__device__ __forceinline__ void pv(f32x16* o, int vb, bf16x8 pa0, bf16x8 pa1, bf16x8 pa2, bf16x8 pa3) {
#pragma unroll
    for (int d0 = 0; d0 < 2; ++d0) { s16x4 lo[4], hi[4];
#pragma unroll
        for (int ks = 0; ks < 4; ++ks) {
            asm volatile("ds_read_b64_tr_b16 %0,%1 offset:%c2" : "=&v"(lo[ks]) : "v"(vb), "i"(d0 * 4096 + ks * 1024) : "memory");
            asm volatile("ds_read_b64_tr_b16 %0,%1 offset:%c2" : "=&v"(hi[ks]) : "v"(vb), "i"(d0 * 4096 + ks * 1024 + 512) : "memory"); }
        asm volatile("s_waitcnt lgkmcnt(0)" ::: "memory"); __builtin_amdgcn_sched_barrier(0);
#define PK(k) (bf16x8){lo[k][0], lo[k][1], lo[k][2], lo[k][3], hi[k][0], hi[k][1], hi[k][2], hi[k][3]}
        o[d0] = __builtin_amdgcn_mfma_f32_32x32x16_bf16(pa0, PK(0), o[d0], 0, 0, 0);
        o[d0] = __builtin_amdgcn_mfma_f32_32x32x16_bf16(pa1, PK(1), o[d0], 0, 0, 0);
        o[d0] = __builtin_amdgcn_mfma_f32_32x32x16_bf16(pa2, PK(2), o[d0], 0, 0, 0);
        o[d0] = __builtin_amdgcn_mfma_f32_32x32x16_bf16(pa3, PK(3), o[d0], 0, 0, 0);
#undef PK
    }
}
__device__ __forceinline__ unsigned cvtpk_s(float lo, float hi) { return cvt_pk_bf16(lo, hi); }

template <int DQK, bool DECAY, int THRL>
__device__ __forceinline__ void attn_unit(int b, int h, int qb, const bf16* Q, int QP, const bf16* Kn, const bf16* Kpe, const bf16* V, const float* cumF, bf16* O, int OP, LAS unsigned char* lds) {
    constexpr int ND0 = DQK / 16;
    int tid = threadIdx.x; asm volatile("" : "+v"(tid));
    const int lane = tid & 63, r32 = lane & 31, hi = lane >> 5; const int wid = __builtin_amdgcn_readfirstlane(tid >> 6);
    const long rowbase = (long)b * SEQ; const int q0 = qb * 256;
    const bf16* Qw = Q + (rowbase + q0 + wid * 32) * QP + h * DQK;
    const bf16* Kh = Kn + rowbase * 512 + h * 64; const bf16* Vh = V + rowbase * 512 + h * 64;
    const bf16* Kp = Kpe + rowbase * ROPE;
    const float* Fh = DECAY ? cumF + ((size_t)b * NHEAD + h) * SEQ : nullptr;
    LAS float* wsf = (LAS float*)(lds + L_WS) + wid * 64;
    const bf16* ksrc0 = Kh + (long)lane * 512 + wid * 8;
    const bf16* ksrc1 = Kp + (long)lane * ROPE + (wid & 3) * 8;
    const bf16* vsrc = Vh + (long)(16 * (wid & 3) + (lane >> 2)) * 512 + (wid >> 2) * 32 + (lane & 3) * 8;
    const int NT = (q0 + 256) / 64;
#define ATT_DMA_K(i_, s) do { const int t_ = NT - 1 - (i_); \
        __builtin_amdgcn_global_load_lds((const unsigned*)(ksrc0 + (long)t_ * 64 * 512), (LAS unsigned*)(lds + L_K + (s) * KSLOT + wid * 1024), 16, 0, 0); \
        if (DQK == 96 && wid < 4) __builtin_amdgcn_global_load_lds((const unsigned*)(ksrc1 + (long)t_ * 64 * ROPE), (LAS unsigned*)(lds + L_K + (s) * KSLOT + (8 + wid) * 1024), 16, 0, 0); \
        if (DECAY && wid == 7) __builtin_amdgcn_global_load_lds((const unsigned*)(Fh + t_ * 64 + lane), (LAS unsigned*)(lds + L_F + (s) * 256), 4, 0, 0); } while (0)
#define ATT_DMA_V(i_, s) do { const int t_ = NT - 1 - (i_); \
        __builtin_amdgcn_global_load_lds((const unsigned*)(vsrc + (long)t_ * 64 * 512), (LAS unsigned*)(lds + L_V + (s) * VSLOT + wid * 1024), 16, 0, 0); } while (0)
    ATT_DMA_K(0, 0); ATT_DMA_V(0, 0); ATT_DMA_K(1, 1);
    bf16x8 qr[ND0];
#pragma unroll
    for (int d0 = 0; d0 < ND0; ++d0) qr[d0] = *(const bf16x8*)(Qw + (long)r32 * QP + d0 * 16 + hi * 8);
    float fq_l = 0.f; if (DECAY) fq_l = Fh[q0 + wid * 32 + r32];
    float mhat = 0.f, l_reg = 0.f; bool started = false; f32x16 o[2]; o[0] = f32x16{}; o[1] = f32x16{};
    const int qrel = wid * 32 + r32;
    const int vb0 = (int)(uintptr_t)(lds + L_V) + ((lane >> 4) & 1) * 32 + (lane & 3) * 8 + (4 * hi + ((lane & 15) >> 2)) * 64;
#define ATT_QK(P0, P1, ks_) do { const float base_ = fq_l - mhat; \
        if (DECAY) { const LAS f32x4* fk_ = (const LAS f32x4*)(lds + L_F + (ks_) * 256); \
            _Pragma("unroll") for (int g = 0; g < 4; ++g) { const f32x4 a_ = fk_[2 * g + hi], c_ = fk_[8 + 2 * g + hi]; \
                _Pragma("unroll") for (int q = 0; q < 4; ++q) { P0[4 * g + q] = base_ - a_[q]; P1[4 * g + q] = base_ - c_[q]; } } } \
        else { _Pragma("unroll") for (int r = 0; r < 16; ++r) { P0[r] = base_; P1[r] = base_; } } \
        const LAS unsigned char* kb_ = lds + L_K + (ks_) * KSLOT + hi * 1024 + r32 * 16; \
        _Pragma("unroll") for (int d0 = 0; d0 < ND0; ++d0) { \
            const bf16x8 b0_ = *(const LAS bf16x8*)(kb_ + d0 * 2048), b1_ = *(const LAS bf16x8*)(kb_ + d0 * 2048 + 512); \
            P0 = __builtin_amdgcn_mfma_f32_32x32x16_bf16(b0_, qr[d0], P0, 0, 0, 0); P1 = __builtin_amdgcn_mfma_f32_32x32x16_bf16(b1_, qr[d0], P1, 0, 0, 0); } } while (0)
    f32x16 p0, p1, n0, n1;
    int ks_cur = 0, ks_nxt = 1, ks_ld = 2;
    for (int i = 0; i < NT; ++i) {
        const int vs = i & 1;
        VM_WAIT(); __syncthreads();
        if (i + 2 < NT) ATT_DMA_K(i + 2, ks_ld);
        if (i + 1 < NT) ATT_DMA_V(i + 1, vs ^ 1);
        if (i == 0) ATT_QK(p0, p1, 0);
        if (i + 1 < NT) ATT_QK(n0, n1, ks_nxt);
        const int jb = 3 - i;
        if (jb >= 0) cmask(p0, p1, jb, qrel, hi);
        const float rm = rowmax(p0, p1);
        bool resc = false; float dl = 0.f; const bool was_started = started;
        if (jb >= 0) {
            const bool fin = rm > -INFINITY;
            dl = started ? fmaxf(rm, 0.f) : (fin ? rm : 0.f); started = started || fin; resc = true;
        } else if (__any(rm > (float)THRL)) { dl = fmaxf(rm, 0.f); resc = true; }
        if (resc) { mhat += dl;
#pragma unroll
            for (int r = 0; r < 16; ++r) { p0[r] -= dl; p1[r] -= dl; }
            if (i + 1 < NT) {
#pragma unroll
                for (int r = 0; r < 16; ++r) { n0[r] -= dl; n1[r] -= dl; } }
            const float f = was_started ? __builtin_amdgcn_exp2f(-dl) : 1.f; l_reg *= f; if (hi == 0) wsf[r32] = f; }
        float sacc = 0.f;
#pragma unroll
        for (int r = 0; r < 16; ++r) { p0[r] = __builtin_amdgcn_exp2f(p0[r]); p1[r] = __builtin_amdgcn_exp2f(p1[r]); sacc += p0[r] + p1[r]; }
        l_reg += sacc;
        if (resc) { LDS_WAIT();
#pragma unroll
            for (int d_ = 0; d_ < 2; ++d_)
#pragma unroll
                for (int r = 0; r < 16; ++r) o[d_][r] *= wsf[crow(r, hi)]; }
        u32x4 pw0, pw1, pw2, pw3;
        pw0 = (u32x4){cvtpk_s(p0[0], p0[1]), cvtpk_s(p0[2], p0[3]), cvtpk_s(p0[4], p0[5]), cvtpk_s(p0[6], p0[7])};
        pw1 = (u32x4){cvtpk_s(p0[8], p0[9]), cvtpk_s(p0[10], p0[11]), cvtpk_s(p0[12], p0[13]), cvtpk_s(p0[14], p0[15])};
        pw2 = (u32x4){cvtpk_s(p1[0], p1[1]), cvtpk_s(p1[2], p1[3]), cvtpk_s(p1[4], p1[5]), cvtpk_s(p1[6], p1[7])};
        pw3 = (u32x4){cvtpk_s(p1[8], p1[9]), cvtpk_s(p1[10], p1[11]), cvtpk_s(p1[12], p1[13]), cvtpk_s(p1[14], p1[15])};
        __builtin_amdgcn_sched_barrier(0);
        pv(o, vb0 + vs * VSLOT, __builtin_bit_cast(bf16x8, pw0), __builtin_bit_cast(bf16x8, pw1), __builtin_bit_cast(bf16x8, pw2), __builtin_bit_cast(bf16x8, pw3));
        p0 = n0; p1 = n1;
        { const int t_ = ks_cur; ks_cur = ks_nxt; ks_nxt = ks_ld; ks_ld = t_; }
    }
    { auto rr = __builtin_amdgcn_permlane32_swap(__float_as_uint(l_reg), __float_as_uint(l_reg), false, false); l_reg = __uint_as_float(rr[0]) + __uint_as_float(rr[1]); }
    if (hi == 0) wsf[32 + r32] = l_reg; LDS_WAIT();
    float rli[16];
#pragma unroll
    for (int r = 0; r < 16; ++r) rli[r] = __builtin_amdgcn_rcpf(wsf[32 + crow(r, hi)]);
    unsigned char* Ow = (unsigned char*)O + (rowbase + q0 + wid * 32) * OP + h * 64;
    { LAS unsigned char* stg = lds + L_OST + wid * 4096;
#pragma unroll
      for (int r = 0; r < 16; ++r) { const int orow = crow(r, hi);
#pragma unroll
          for (int d0 = 0; d0 < 2; ++d0) { const float ov = o[d0][r] * rli[r] * OSCALE8; stg[orow * 64 + d0 * 32 + r32] = (unsigned char)__builtin_amdgcn_cvt_pk_fp8_f32(ov, ov, 0, false); } }
      LDS_WAIT();
#pragma unroll
      for (int i = 0; i < 2; ++i) { const int row = i * 16 + (lane >> 2), ch = lane & 3; const u32x4 v = *(const LAS u32x4*)(stg + row * 64 + ch * 16); *(u32x4*)(Ow + (long)row * OP + ch * 16) = v; } }
    LDS_WAIT(); __syncthreads();
#undef ATT_DMA_K
#undef ATT_DMA_V
#undef ATT_QK
}

constexpr int T_KSLOT = 12288, T_VSLOT = 8192, T_NSLOT = 3;
constexpr int T_K = 0, T_V = T_NSLOT * T_KSLOT, T_F = T_V + T_NSLOT * T_VSLOT, T_WS = T_F + T_NSLOT * 256, T_OST = T_WS + 2048, T_END = T_OST + 8 * 4096;
static_assert(T_END <= RING_BYTES, "attention LDS (hand-interleaved unit)");
typedef __attribute__((address_space(3))) const char* lds_cptr;
typedef short v4i16_t __attribute__((ext_vector_type(4)));
__device__ __forceinline__ s16x4 vtr(lds_cptr p) { return __builtin_bit_cast(s16x4, __builtin_amdgcn_ds_read_tr16_b64_v4i16((__attribute__((address_space(3))) v4i16_t*)p)); }
__device__ __forceinline__ void kload2(bf16x8* kf, lds_cptr kp, int j) { kf[2 * j] = *(const __attribute__((address_space(3))) bf16x8*)(kp + j * 2048); kf[2 * j + 1] = *(const __attribute__((address_space(3))) bf16x8*)(kp + j * 2048 + 512); }
#define TW_BAR(N) asm volatile("s_waitcnt vmcnt(" #N ") lgkmcnt(0)\n\ts_barrier" ::: "memory")
#define TSB() __builtin_amdgcn_sched_barrier(0)

template <int DQK, bool DECAY, int THRL>
__device__ __forceinline__ void attn_unit_t(int b, int h, int qb, const bf16* Q, int QP, const bf16* Kn, const bf16* Kpe, const bf16* V, const float* cumF, float kmax2, bf16* O, int OP, LAS unsigned char* lds) {
    constexpr int ND0 = DQK / 16;
    constexpr bool INPL = DECAY || (DQK == 96);
    int tid = threadIdx.x; asm volatile("" : "+v"(tid));
    const int lane = tid & 63, r32 = lane & 31, hi = lane >> 5; const int wid = __builtin_amdgcn_readfirstlane(tid >> 6);
    const long rowbase = (long)b * SEQ; const int q0 = qb * 256;
    const bf16* Qw = Q + (rowbase + q0 + wid * 32) * QP + h * DQK;
    const bf16* Kh = Kn + rowbase * 512 + h * 64; const bf16* Vh = V + rowbase * 512 + h * 64;
    const bf16* Kp = Kpe + rowbase * ROPE;
    const float* Fh = DECAY ? cumF + ((size_t)b * NHEAD + h) * SEQ : nullptr;
    LAS float* wsf = (LAS float*)(lds + T_WS) + wid * 64;
    const bf16* ksrc0 = Kh + (long)lane * 512 + wid * 8;
    const bf16* ksrc1 = Kp + (long)lane * ROPE + (wid & 3) * 8;
    const bf16* vsrc = Vh + (long)(16 * (wid & 3) + (lane >> 2)) * 512 + (wid >> 2) * 32 + (lane & 3) * 8;
    const int NTS = (q0 + 256) / 64;
#define TDMA_K(i_, sk) do { const int t_ = NTS - 1 - (i_); \
        __builtin_amdgcn_global_load_lds((const unsigned*)(ksrc0 + (long)t_ * 64 * 512), (LAS unsigned*)(lds + T_K + (sk) * T_KSLOT + wid * 1024), 16, 0, 0); \
        if (DECAY) __builtin_amdgcn_global_load_lds((const unsigned*)(Fh + t_ * 64 + lane), (LAS unsigned*)(lds + T_F + (sk) * 256), 4, 0, 0); \
        else __builtin_amdgcn_global_load_lds((const unsigned*)(ksrc1 + (long)t_ * 64 * ROPE), (LAS unsigned*)(lds + T_K + (sk) * T_KSLOT + (8 + (wid & 3)) * 1024), 16, 0, 0); } while (0)
#define TDMA_V(i_, sv) do { const int t_ = NTS - 1 - (i_); \
        __builtin_amdgcn_global_load_lds((const unsigned*)(vsrc + (long)t_ * 64 * 512), (LAS unsigned*)(lds + T_V + (sv) * T_VSLOT + wid * 1024), 16, 0, 0); } while (0)
    TDMA_K(0, 0); TDMA_V(0, 0); TDMA_K(1, 1);
    bf16x8 qr[ND0];
#pragma unroll
    for (int d0 = 0; d0 < ND0; ++d0) qr[d0] = *(const bf16x8*)(Qw + (long)r32 * QP + d0 * 16 + hi * 8);
    float fq_l = 0.f; if (DECAY) fq_l = Fh[q0 + wid * 32 + r32];
    float ftile = 0.f; if (DECAY) ftile = Fh[(lane < NTS ? lane : NTS - 1) * 64 + 63];
    float mhat = 0.f, l_reg = 0.f; f32x16 o[2]; o[0] = f32x16{}; o[1] = f32x16{};
    f32x16 negm = f32x16{}; asm volatile("" : "+v"(negm));
    const int qrel = wid * 32 + r32, i0 = 3 - (wid >> 1);
    const lds_cptr shm3 = (lds_cptr)lds; const lds_cptr kp0 = shm3 + T_K + hi * 1024 + r32 * 16;
    const lds_cptr vp0 = shm3 + T_V + ((lane >> 4) & 1) * 32 + (lane & 3) * 8 + (4 * hi + ((lane & 15) >> 2)) * 64;
    const int vb0 = (int)(uintptr_t)(lds + T_V) + ((lane >> 4) & 1) * 32 + (lane & 3) * 8 + (4 * hi + ((lane & 15) >> 2)) * 64;
    bool resc = false;
    bf16x8 kf[2 * ND0];
    f32x16 pA0, pA1, pB0, pB1;
    int sl_prev = 0, sl_cur = 0, sl_next = 1;
#define TROT() do { sl_prev = sl_cur; sl_cur = sl_next; sl_next = (sl_next == T_NSLOT - 1) ? 0 : sl_next + 1; } while (0)
#define TBIAS(X0, X1, fs_) do { if (DECAY) { const float base_ = fq_l - mhat; const LAS f32x4* fk_ = (const LAS f32x4*)(lds + T_F + (fs_) * 256); \
        _Pragma("unroll") for (int g = 0; g < 4; ++g) { const f32x4 a_ = fk_[2 * g + hi], c_ = fk_[8 + 2 * g + hi]; \
            _Pragma("unroll") for (int q = 0; q < 4; ++q) { X0[4 * g + q] = base_ - a_[q]; X1[4 * g + q] = base_ - c_[q]; } } } \
        else if (INPL) { const float nm_ = -mhat; _Pragma("unroll") for (int r = 0; r < 16; ++r) { X0[r] = nm_; X1[r] = nm_; } } } while (0)
#define TCIN(X) (INPL ? X : negm)
#define TRESC() do { if (resc) { asm volatile("s_waitcnt lgkmcnt(0)" ::: "memory"); \
        _Pragma("unroll") for (int d_ = 0; d_ < 2; ++d_) _Pragma("unroll") for (int r = 0; r < 16; ++r) o[d_][r] *= wsf[crow(r, hi)]; } } while (0)
#define TDECIDE(C0, C1, i_) do { \
        float a_ = max3f(C0[0], C0[1], C1[0]), b_ = max3f(C0[2], C0[3], C1[1]); a_ = max3f(a_, C1[2], C1[3]); \
        _Pragma("unroll") for (int r = 4; r < 16; r += 4) { a_ = max3f(a_, C0[r], C0[r + 1]); b_ = max3f(b_, C0[r + 2], C0[r + 3]); a_ = max3f(a_, C1[r], C1[r + 1]); b_ = max3f(b_, C1[r + 2], C1[r + 3]); } \
        float rm_ = fmaxf(a_, b_); { auto rr_ = __builtin_amdgcn_permlane32_swap(__float_as_uint(rm_), __float_as_uint(rm_), false, false); rm_ = fmaxf(__uint_as_float(rr_[0]), __uint_as_float(rr_[1])); } \
        resc = false; \
        if ((i_) == i0) { const float dl_ = rm_; mhat += dl_; \
            _Pragma("unroll") for (int r = 0; r < 16; ++r) { C0[r] -= dl_; C1[r] -= dl_; } \
            if (!INPL) { _Pragma("unroll") for (int r = 0; r < 16; ++r) negm[r] = -mhat; asm volatile("" : "+v"(negm)); } } \
        else if (__builtin_expect(__any(rm_ > (float)THRL), 0)) { const float dl_ = fmaxf(rm_, 0.f); mhat += dl_; \
            _Pragma("unroll") for (int r = 0; r < 16; ++r) { C0[r] -= dl_; C1[r] -= dl_; } \
            if (!INPL) { _Pragma("unroll") for (int r = 0; r < 16; ++r) negm[r] = -mhat; asm volatile("" : "+v"(negm)); } \
            const float f_ = __builtin_amdgcn_exp2f(-dl_); l_reg *= f_; if (hi == 0) wsf[r32] = f_; resc = true; } } while (0)
    TDMA_K(2, 2);
    TW_BAR(5);
    int NT = NTS;
    if (DECAY) {
        const float bound = 2.f * __builtin_sqrtf(kmax2) * 1.0001f + 1.f + (Fh[q0] - ftile);
        const unsigned long long need = __ballot(lane < NTS && bound >= -160.f);
        const int tmin = need ? (int)__builtin_ctzll(need) : NTS - 1;
        NT = NTS - tmin; NT += NT & 1; if (NT < 8) NT = 8; if (NT > NTS) NT = NTS;
        NT = __builtin_amdgcn_readfirstlane(NT); }
    TBIAS(pA0, pA1, 0);
    { const lds_cptr kb = kp0;
#pragma unroll
      for (int d0 = 0; d0 < ND0; ++d0) { const bf16x8 b0 = *(const __attribute__((address_space(3))) bf16x8*)(kb + d0 * 2048), b1 = *(const __attribute__((address_space(3))) bf16x8*)(kb + d0 * 2048 + 512);
          if (d0 == 0) { pA0 = __builtin_amdgcn_mfma_f32_32x32x16_bf16(b0, qr[0], TCIN(pA0), 0, 0, 0); pA1 = __builtin_amdgcn_mfma_f32_32x32x16_bf16(b1, qr[0], TCIN(pA1), 0, 0, 0); }
          else { pA0 = __builtin_amdgcn_mfma_f32_32x32x16_bf16(b0, qr[d0], pA0, 0, 0, 0); pA1 = __builtin_amdgcn_mfma_f32_32x32x16_bf16(b1, qr[d0], pA1, 0, 0, 0); } } }
    cmask(pA0, pA1, 3, qrel, hi);
    TDECIDE(pA0, pA1, 0);
#pragma unroll
    for (int r = 0; r < 16; ++r) { pA0[r] = __builtin_amdgcn_exp2f(pA0[r]); pA1[r] = __builtin_amdgcn_exp2f(pA1[r]); }
    TW_BAR(0);
    TDMA_K(3, 0); TDMA_V(1, 1);
    TROT();
#pragma unroll
    for (int j = 0; j < ND0; ++j) kload2(kf, kp0 + sl_cur * T_KSLOT, j);
    TBIAS(pB0, pB1, sl_cur);
    TW_BAR(3);
    s16x4 vlo[8], vhi[8]; u32x4 pw0, pw1, pw2, pw3;
#define TPKW(P, B) cvt_pk_bf16(P[B], P[B + 1])
#define TPAF(k) __builtin_bit_cast(bf16x8, pw##k)
#define TVFR(i) (bf16x8){vlo[i][0], vlo[i][1], vlo[i][2], vlo[i][3], vhi[i][0], vhi[i][1], vhi[i][2], vhi[i][3]}
#define TPIN(x) asm volatile("" : "+v"(x))
#define TGAPA(MF, A0, A1, A2, A3, W0, W1, PW) do { MF; sacc += A0; sacc += A1; sacc += A2; sacc += A3; TPIN(sacc); W0; W1; TPIN(PW); TSB(); } while (0)
#define TEX(v) __builtin_amdgcn_exp2f(v)
#define TGAPB(MF, X, B) do { MF; X[B] = TEX(X[B]); X[B + 1] = TEX(X[B + 1]); X[B + 2] = TEX(X[B + 2]); X[B + 3] = TEX(X[B + 3]); TPIN(X); TSB(); } while (0)
#define TVRD(i) do { vlo[i] = vtr(vp_ + (((i) >> 2) * 4096 + ((i) & 3) * 1024)); vhi[i] = vtr(vp_ + (((i) >> 2) * 4096 + ((i) & 3) * 1024 + 512)); } while (0)
#define TKRD(G, j) do { if (G) { kload2(kf, kp0 + sl_next * T_KSLOT, j); TSB(); } } while (0)
#define TMF(a, b, c) __builtin_amdgcn_mfma_f32_32x32x16_bf16(a, b, c, 0, 0, 0)
#define TSTEP(C0, C1, P0, P1, i_, MJB, GK, GV, GL) do { TSB(); \
        const lds_cptr vp_ = vp0 + sl_prev * T_VSLOT; \
        TVRD(0); TSB(); float sacc = (P0[0] + P0[1]); \
        TGAPA(C0 = TMF(kf[0], qr[0], TCIN(C0)), P0[2], P0[3], P0[4], P0[5],     pw0[0] = TPKW(P0, 0), pw0[1] = TPKW(P0, 2), pw0); \
        TVRD(4); TSB(); TGAPA(C1 = TMF(kf[1], qr[0], TCIN(C1)), P0[6], P0[7], P0[8], P0[9],     pw0[2] = TPKW(P0, 4), pw0[3] = TPKW(P0, 6), pw0); \
        TVRD(1); TSB(); TGAPA(C0 = TMF(kf[2], qr[1], C0),   P0[10], P0[11], P0[12], P0[13], pw1[0] = TPKW(P0, 8), pw1[1] = TPKW(P0, 10), pw1); \
        TVRD(5); TSB(); TGAPA(C1 = TMF(kf[3], qr[1], C1),   P0[14], P0[15], P1[0], P1[1],   pw1[2] = TPKW(P0, 12), pw1[3] = TPKW(P0, 14), pw1); \
        TVRD(2); TSB(); TGAPA(C0 = TMF(kf[4], qr[2], C0),   P1[2], P1[3], P1[4], P1[5],     pw2[0] = TPKW(P1, 0), pw2[1] = TPKW(P1, 2), pw2); \
        TVRD(6); TSB(); TGAPA(C1 = TMF(kf[5], qr[2], C1),   P1[6], P1[7], P1[8], P1[9],     pw2[2] = TPKW(P1, 4), pw2[3] = TPKW(P1, 6), pw2); \
        TVRD(3); TSB(); TGAPA(C0 = TMF(kf[6], qr[3], C0),   P1[10], P1[11], P1[12], P1[13], pw3[0] = TPKW(P1, 8), pw3[1] = TPKW(P1, 10), pw3); \
        TVRD(7); TSB(); TGAPA(C1 = TMF(kf[7], qr[3], C1),   P1[14], P1[15], 0.f, 0.f,       pw3[2] = TPKW(P1, 12), pw3[3] = TPKW(P1, 14), pw3); \
        if (ND0 == 6) { C0 = TMF(kf[2 * ND0 - 4], qr[ND0 - 2], C0); C1 = TMF(kf[2 * ND0 - 3], qr[ND0 - 2], C1); C0 = TMF(kf[2 * ND0 - 2], qr[ND0 - 1], C0); C1 = TMF(kf[2 * ND0 - 1], qr[ND0 - 1], C1); TSB(); } \
        l_reg += sacc; \
        if (GK) { TDMA_K((i_) + 3, sl_cur); } if (GV) { TDMA_V((i_) + 1, sl_next); } \
        if ((MJB) >= 0) cmask(C0, C1, (MJB), qrel, hi); \
        TDECIDE(C0, C1, i_); \
        TSB(); \
        TGAPB(o[0] = TMF(TPAF(0), TVFR(0), o[0]), C0, 0); \
        TKRD(GL, 0); TGAPB(o[1] = TMF(TPAF(0), TVFR(4), o[1]), C0, 4); \
        TKRD(GL, 1); TGAPB(o[0] = TMF(TPAF(1), TVFR(1), o[0]), C0, 8); \
        TKRD(GL, 2); TGAPB(o[1] = TMF(TPAF(1), TVFR(5), o[1]), C0, 12); \
        TKRD(GL, 3); TGAPB(o[0] = TMF(TPAF(2), TVFR(2), o[0]), C1, 0); \
        if (ND0 == 6) { TKRD(GL, ND0 - 2); } TGAPB(o[1] = TMF(TPAF(2), TVFR(6), o[1]), C1, 4); \
        if (ND0 == 6) { TKRD(GL, ND0 - 1); } TGAPB(o[0] = TMF(TPAF(3), TVFR(3), o[0]), C1, 8); \
        TGAPB(o[1] = TMF(TPAF(3), TVFR(7), o[1]), C1, 12); \
        if (GL) { TBIAS(P0, P1, sl_next); } \
    } while (0)
#define TENDW(tt) do { if ((tt) + 3 < NT) { TW_BAR(3); } else if ((tt) + 2 < NT) { TW_BAR(1); } else { TW_BAR(0); } } while (0)
    TSTEP(pB0, pB1, pA0, pA1, 1, 2, (1 + 3 < NT), true, true); TENDW(1); TRESC(); TROT();
    TSTEP(pA0, pA1, pB0, pB1, 2, 1, (2 + 3 < NT), true, true); TENDW(2); TRESC(); TROT();
    {
        TSTEP(pB0, pB1, pA0, pA1, 3, 0, (3 + 3 < NT), true, true); TENDW(3); TRESC(); TROT();
        int i = 4;
        for (; i + 2 < NT; i += 2) {
            TSTEP(pA0, pA1, pB0, pB1, i, -1, (i + 3 < NT), true, true);                         TENDW(i);     TRESC(); TROT();
            TSTEP(pB0, pB1, pA0, pA1, i + 1, -1, (i + 4 < NT), (i + 2 < NT), (i + 2 < NT));     TENDW(i + 1); TRESC(); TROT();
        }
        TSTEP(pA0, pA1, pB0, pB1, NT - 2, -1, false, true, true); TENDW(NT - 2); TRESC(); TROT();
        TSTEP(pB0, pB1, pA0, pA1, NT - 1, -1, false, false, false); TRESC();
    }
    { float sacc = pB0[0] + pB0[1];
#pragma unroll
      for (int r = 2; r < 16; ++r) sacc += pB0[r];
#pragma unroll
      for (int r = 0; r < 16; ++r) sacc += pB1[r];
      l_reg += sacc;
      pw0 = (u32x4){TPKW(pB0, 0), TPKW(pB0, 2), TPKW(pB0, 4), TPKW(pB0, 6)}; pw1 = (u32x4){TPKW(pB0, 8), TPKW(pB0, 10), TPKW(pB0, 12), TPKW(pB0, 14)};
      pw2 = (u32x4){TPKW(pB1, 0), TPKW(pB1, 2), TPKW(pB1, 4), TPKW(pB1, 6)}; pw3 = (u32x4){TPKW(pB1, 8), TPKW(pB1, 10), TPKW(pB1, 12), TPKW(pB1, 14)};
      TSB(); pv(o, vb0 + sl_cur * T_VSLOT, TPAF(0), TPAF(1), TPAF(2), TPAF(3)); }
    { auto rr = __builtin_amdgcn_permlane32_swap(__float_as_uint(l_reg), __float_as_uint(l_reg), false, false); l_reg = __uint_as_float(rr[0]) + __uint_as_float(rr[1]); }
    if (hi == 0) wsf[32 + r32] = l_reg; asm volatile("s_waitcnt lgkmcnt(0)" ::: "memory");
    float rli[16];
#pragma unroll
    for (int r = 0; r < 16; ++r) rli[r] = __builtin_amdgcn_rcpf(wsf[32 + crow(r, hi)]);
    unsigned char* Ow = (unsigned char*)O + (rowbase + q0 + wid * 32) * OP + h * 64;
    { LAS unsigned char* stg = lds + T_OST + wid * 4096;
#pragma unroll
      for (int r = 0; r < 16; ++r) { const int orow = crow(r, hi);
#pragma unroll
          for (int d0 = 0; d0 < 2; ++d0) { const float ov = o[d0][r] * rli[r] * OSCALE8; stg[orow * 64 + d0 * 32 + r32] = (unsigned char)__builtin_amdgcn_cvt_pk_fp8_f32(ov, ov, 0, false); } }
      asm volatile("s_waitcnt lgkmcnt(0)" ::: "memory");
#pragma unroll
      for (int i = 0; i < 2; ++i) { const int row = i * 16 + (lane >> 2), ch = lane & 3; const u32x4 v = *(const LAS u32x4*)(stg + row * 64 + ch * 16); *(u32x4*)(Ow + (long)row * OP + ch * 16) = v; } }
    asm volatile("s_waitcnt lgkmcnt(0)\n\ts_barrier" ::: "memory");
#undef TDMA_K
#undef TDMA_V
#undef TROT
#undef TBIAS
#undef TCIN
#undef TRESC
#undef TDECIDE
#undef TPKW
#undef TPAF
#undef TVFR
#undef TPIN
#undef TGAPA
#undef TEX
#undef TGAPB
#undef TVRD
#undef TKRD
#undef TMF
#undef TSTEP
#undef TENDW
}
#undef TW_BAR
#undef TSB
}

namespace dn {
constexpr int CHB = 64 * 256;
constexpr int NSLOT = 8, AHEAD = 7;
__device__ __forceinline__ int nloc(int i) { return 16 * ((i >> 2) & 1) + (i & 3) + 4 * (i >> 3); }
template <bool NOTRAFFIC>
__device__ __forceinline__ void down_phase(LAS unsigned char* lds, const unsigned char* HBp, const unsigned char* Wd, const unsigned char* Wsd, volatile LAS int* tab, const u32x2* meta, unsigned char* Yp, unsigned char* trash, int G, int c) {
    int tid = threadIdx.x; asm volatile("" : "+v"(tid));
    const int wid = __builtin_amdgcn_readfirstlane(tid >> 6), lane = tid & 63, j = lane & 31, hi = lane >> 5;
    const int U = tab[65] * 8;
    const int u_lo = (int)(((long)c * U) / G), u_hi = (int)(((long)(c + 1) * U) / G);
    if (u_lo >= u_hi) return;
#define DN_DEC(u_, e_, hf_, ci_) do { e_ = __builtin_amdgcn_readfirstlane(tab[132 + ((u_) >> 3)]); const int ul_ = __builtin_amdgcn_readfirstlane((u_) - 8 * tab[e_]), nc_ = __builtin_amdgcn_readfirstlane(4 * (tab[e_ + 1] - tab[e_])); hf_ = (ul_ >= nc_) ? 1 : 0; ci_ = ul_ - hf_ * nc_; } while (0)
    unsigned dvo; { const int r_ = lane >> 3, f_ = ((r_ >> 1) & 3) << 1; dvo = (unsigned)(r_ * 256 + (((lane & 7) ^ f_) * 16)); }
    volatile LAS int* rowtab = (volatile LAS int*)(lds + NSLOT * CHB + 6144);
    for (int i = tid; i < u_hi - u_lo && i < 2048; i += 512) { const int uu = u_lo + i, e_ = tab[132 + (uu >> 3)], ul_ = uu - 8 * tab[e_], nc_ = 4 * (tab[e_ + 1] - tab[e_]), hf_ = (ul_ >= nc_) ? 1 : 0; rowtab[i] = tab[e_] * 256 + (ul_ - hf_ * nc_) * 64; }
    __syncthreads();
#define DN_DMA(u_, buf_) do { const unsigned char* gb_ = HBp + (size_t)__builtin_amdgcn_readfirstlane(rowtab[(u_) - u_lo]) * DEXP; \
        _Pragma("unroll") for (int i_ = 0; i_ < 2; ++i_) { const int q_ = wid * 2 + i_, kb_ = q_ >> 3, g_ = q_ & 7; \
            __builtin_amdgcn_global_load_lds((const unsigned*)(gb_ + (size_t)(8 * g_) * DEXP + kb_ * 128 + dvo), (LAS unsigned*)(lds + (buf_) * CHB + kb_ * 8192 + g_ * 1024), 16, 0, 0); } } while (0)
    int rowb[2], fx[2];
#pragma unroll
    for (int rt = 0; rt < 2; ++rt) { const int row = 32 * rt + j; rowb[rt] = (int)(uintptr_t)lds + row * 128; fx[rt] = (((row >> 1) & 3) << 1) * 16; }
    unsigned sc1 = 0x7f7f7f7fu; asm volatile("" : "+v"(sc1));
#pragma unroll
    for (int p = 0; p < AHEAD; ++p) { const int un = (u_lo + p < u_hi) ? u_lo + p : u_lo; DN_DMA(un, p); }
    if (wid >= 4) __builtin_amdgcn_s_barrier();
    int u = u_lo;
    while (u < u_hi) {
      int e, hf, ci0; DN_DEC(u, e, hf, ci0);
      const int nc = __builtin_amdgcn_readfirstlane(4 * (tab[e + 1] - tab[e])), ne = __builtin_amdgcn_readfirstlane(tab[66 + e]);
      const int ubase = __builtin_amdgcn_readfirstlane(8 * tab[e] + hf * nc);
      int seg_end = ubase + nc; seg_end = __builtin_amdgcn_readfirstlane(seg_end < u_hi ? seg_end : u_hi);
      v8i32_t wfr[2][4];
#pragma unroll
      for (int nt = 0; nt < 2; ++nt) { const unsigned char* wp = ((e == NEXP) ? Wsd : Wd + (size_t)e * D * DEXP) + (size_t)(512 * hf + 64 * wid + 32 * nt + nloc(j)) * DEXP + 32 * hi;
#pragma unroll
          for (int ks = 0; ks < 4; ++ks) { wfr[nt][ks].lo = *(const v4i32_t*)(wp + 64 * ks); wfr[nt][ks].hi = *(const v4i32_t*)(wp + 64 * ks + 16); } }
      bool first = true;
      for (; u < seg_end; ++u) {
        const int buf = (u - u_lo) & (NSLOT - 1); (void)ci0;
        const int cidx = u - ubase;
        u32x2 mt[2];
#pragma unroll
        for (int rt = 0; rt < 2; ++rt) { int pos = 64 * cidx + 32 * rt + j; const bool in = pos < ne; const int sp = pos; pos = (in && e != NEXP) ? pos : 0; const u32x2 m = meta[(size_t)(e == NEXP ? 0 : e) * LISTCAP + pos];
            mt[rt] = !in ? (u32x2){0xffffffffu, 0u} : (e == NEXP) ? (u32x2){(unsigned)(sp * (TOPK + 1) + TOPK), 0x3f800000u} : m; }
        if (first) { __builtin_amdgcn_s_waitcnt(0x0F70); first = false; }
        LDS_WAIT(); __builtin_amdgcn_s_barrier();
        { const int un = (u + AHEAD < u_hi) ? u + AHEAD : u; DN_DMA(un, (buf + AHEAD) & (NSLOT - 1)); }
        f32x16 acc[2][2];
#pragma unroll
        for (int rt = 0; rt < 2; ++rt)
#pragma unroll
            for (int nt = 0; nt < 2; ++nt) asm volatile("v_mov_b32 %0, 0\n\tv_mov_b32 %1, 0\n\tv_mov_b32 %2, 0\n\tv_mov_b32 %3, 0\n\tv_mov_b32 %4, 0\n\tv_mov_b32 %5, 0\n\tv_mov_b32 %6, 0\n\tv_mov_b32 %7, 0\n\tv_mov_b32 %8, 0\n\tv_mov_b32 %9, 0\n\tv_mov_b32 %10, 0\n\tv_mov_b32 %11, 0\n\tv_mov_b32 %12, 0\n\tv_mov_b32 %13, 0\n\tv_mov_b32 %14, 0\n\tv_mov_b32 %15, 0"
                : "=v"(acc[rt][nt][0]), "=v"(acc[rt][nt][1]), "=v"(acc[rt][nt][2]), "=v"(acc[rt][nt][3]), "=v"(acc[rt][nt][4]), "=v"(acc[rt][nt][5]), "=v"(acc[rt][nt][6]), "=v"(acc[rt][nt][7]),
                  "=v"(acc[rt][nt][8]), "=v"(acc[rt][nt][9]), "=v"(acc[rt][nt][10]), "=v"(acc[rt][nt][11]), "=v"(acc[rt][nt][12]), "=v"(acc[rt][nt][13]), "=v"(acc[rt][nt][14]), "=v"(acc[rt][nt][15]));
        v8i32_t ha0, ha1, hb0, hb1;
        const int ad0 = rowb[0] + buf * CHB, ad1 = rowb[1] + buf * CHB;
#define DN_RDA(ks_) do { \
            asm volatile("ds_read_b128 v[192:195], %1 offset:%c2\n\tds_read_b128 v[196:199], %1 offset:%c3" : "={v[192:199]}"(ha0) : "v"(ad0 + ((64 * ((ks_) & 1) + 32 * hi) ^ fx[0])), "i"(((ks_) >> 1) * 8192), "i"(((ks_) >> 1) * 8192 + 16) : "memory"); \
            asm volatile("ds_read_b128 v[200:203], %1 offset:%c2\n\tds_read_b128 v[204:207], %1 offset:%c3" : "={v[200:207]}"(ha1) : "v"(ad1 + ((64 * ((ks_) & 1) + 32 * hi) ^ fx[1])), "i"(((ks_) >> 1) * 8192), "i"(((ks_) >> 1) * 8192 + 16) : "memory"); } while (0)
#define DN_RDB(ks_) do { \
            asm volatile("ds_read_b128 v[208:211], %1 offset:%c2\n\tds_read_b128 v[212:215], %1 offset:%c3" : "={v[208:215]}"(hb0) : "v"(ad0 + ((64 * ((ks_) & 1) + 32 * hi) ^ fx[0])), "i"(((ks_) >> 1) * 8192), "i"(((ks_) >> 1) * 8192 + 16) : "memory"); \
            asm volatile("ds_read_b128 v[216:219], %1 offset:%c2\n\tds_read_b128 v[220:223], %1 offset:%c3" : "={v[216:223]}"(hb1) : "v"(ad1 + ((64 * ((ks_) & 1) + 32 * hi) ^ fx[1])), "i"(((ks_) >> 1) * 8192), "i"(((ks_) >> 1) * 8192 + 16) : "memory"); } while (0)
#define DN_MF(W_, ACC_, H_, REG_, WAIT_) asm volatile(WAIT_ "v_mfma_scale_f32_32x32x64_f8f6f4 %0, %1, %2, %0, %3, %3 op_sel_hi:[0,0,0]" : "+v"(ACC_) : "v"(W_), REG_(H_), "v"(sc1))
        DN_RDA(0);
#pragma unroll
        for (int ks = 0; ks < 4; ks += 2) {
            DN_RDB(ks + 1);
            DN_MF(wfr[0][ks], acc[0][0], ha0, "{v[192:199]}", "s_waitcnt lgkmcnt(4)\n\t"); DN_MF(wfr[1][ks], acc[0][1], ha0, "{v[192:199]}", "");
            DN_MF(wfr[0][ks], acc[1][0], ha1, "{v[200:207]}", ""); DN_MF(wfr[1][ks], acc[1][1], ha1, "{v[200:207]}", "");
            if (ks + 2 < 4) { DN_RDA(ks + 2);
                DN_MF(wfr[0][ks + 1], acc[0][0], hb0, "{v[208:215]}", "s_waitcnt lgkmcnt(4)\n\t"); }
            else { DN_MF(wfr[0][ks + 1], acc[0][0], hb0, "{v[208:215]}", "s_waitcnt lgkmcnt(0)\n\t"); }
            DN_MF(wfr[1][ks + 1], acc[0][1], hb0, "{v[208:215]}", "");
            DN_MF(wfr[0][ks + 1], acc[1][0], hb1, "{v[216:223]}", ""); DN_MF(wfr[1][ks + 1], acc[1][1], hb1, "{v[216:223]}", "");
        }
#undef DN_RDA
#undef DN_RDB
#undef DN_MF
        asm volatile("s_waitcnt vmcnt(48)" ::: "memory");
        __builtin_amdgcn_s_barrier();
        asm volatile("s_nop 15\n\ts_nop 7" : "+v"(acc[0][0]), "+v"(acc[0][1]), "+v"(acc[1][0]), "+v"(acc[1][1]) :: "memory");
        __builtin_amdgcn_sched_barrier(0);
        const int col0 = 512 * hf + 64 * wid + 16 * hi;
#pragma unroll
        for (int rt = 0; rt < 2; ++rt) { const bool ok = !NOTRAFFIC && mt[rt].x != 0xffffffffu; unsigned char* yd = ok ? Yp + (size_t)mt[rt].x * D : trash; const float w = ok ? __uint_as_float(mt[rt].y) * (1.f / (HSCALE8 * WSCALE8)) : 0.f;
#pragma unroll
            for (int nt = 0; nt < 2; ++nt) { u32x4 o;
#pragma unroll
                for (int q = 0; q < 4; ++q) { int v = __builtin_amdgcn_cvt_pk_fp8_f32(acc[rt][nt][4 * q] * w, acc[rt][nt][4 * q + 1] * w, 0, false);
                    v = __builtin_amdgcn_cvt_pk_fp8_f32(acc[rt][nt][4 * q + 2] * w, acc[rt][nt][4 * q + 3] * w, v, true); o[q] = (unsigned)v; }
                *(u32x4*)(yd + col0 + 32 * nt) = o; } }
      }
    }
    if (wid < 4) __builtin_amdgcn_s_barrier();
    VM_WAIT(); LDS_WAIT(); __builtin_amdgcn_s_barrier();
#undef DN_DMA
#undef DN_DEC
}
}

namespace up {
__device__ __forceinline__ int nloc(int i) { return 16 * ((i >> 2) & 1) + (i & 3) + 4 * (i >> 3); }
__device__ __forceinline__ void up_phase(LAS unsigned char* lds, const bf16* QL, const bf16* KVL, const bf16* Wq, const bf16* Wkv, const float* ssqq, const float* ssqkv, const float* ropetab,
                                         bf16* Qo, bf16* KNo, bf16* VMo, int G, int c) {
    int tid = threadIdx.x; asm volatile("" : "+v"(tid));
    const int wid = __builtin_amdgcn_readfirstlane(tid >> 6), lane = tid & 63, j = lane & 31, hi = lane >> 5;
    for (int grp = c; grp < T / 64; grp += G) {
        const int row0 = grp * 64;
        { const int r_ = lane >> 3, p_ = lane & 7;
#pragma unroll
          for (int i = 0; i < 6; ++i) { const int q_ = wid * 6 + i;
              const bool isq = q_ < 32; const int rem = isq ? q_ : q_ - 32, kb = rem >> 3, g = rem & 7, f_ = (4 * (g & 1) + (r_ >> 1)) & 7;
              __builtin_amdgcn_global_load_lds((const unsigned*)((isq ? QL : KVL) + (size_t)(row0 + 8 * g + r_) * 256 + kb * 64 + ((p_ ^ f_) * 8)), (LAS unsigned*)(lds + (isq ? 0 : 32768) + kb * 8192 + g * 1024), 16, 0, 0); } }
        float rsq[2], rskv[2];
#pragma unroll
        for (int rt = 0; rt < 2; ++rt) { const int row = row0 + 32 * rt + j; const f32x4 a = *(const f32x4*)(ssqq + (size_t)row * 4), b4 = *(const f32x4*)(ssqkv + (size_t)row * 4);
            rsq[rt] = rsqrtf(((a[0] + a[1]) + (a[2] + a[3])) * (1.f / QLORA) + EPS) * C2M; rskv[rt] = rsqrtf(((b4[0] + b4[1]) + (b4[2] + b4[3])) * (1.f / KVLORA) + EPS); }
        const unsigned lane16 = (unsigned)lane * 16u;
        bf16x8 wA[16];
#define UP_LOADW(WB_, Wp_, col_, KS_) do { const char* wb_ = (const char*)(Wp_) + (size_t)__builtin_amdgcn_readfirstlane((col_) >> 5) * (KS_) * 1024;     \
            _Pragma("unroll") for (int ks = 0; ks < (KS_); ++ks) wA[(WB_) + ks] = *(const bf16x8*)(wb_ + ks * 1024 + lane16); } while (0)
#define UP_STEP(WB_, ISQ_, col_, KS_) do { f32x16 acc[2]; acc[0] = f32x16{}; acc[1] = f32x16{}; \
            _Pragma("unroll") for (int ks = 0; ks < (KS_); ++ks) { bf16x8 af[2]; \
                _Pragma("unroll") for (int rt = 0; rt < 2; ++rt) { const int row = 32 * rt + j, cc = 2 * (ks & 3) + hi; \
                    af[rt] = *(const LAS bf16x8*)(lds + ((ISQ_) ? 0 : 32768) + (ks >> 2) * 8192 + row * 128 + ((cc ^ ((row >> 1) & 7)) * 16)); } \
                _Pragma("unroll") for (int rt = 0; rt < 2; ++rt) acc[rt] = __builtin_amdgcn_mfma_f32_32x32x16_bf16(wA[(WB_) + ks], af[rt], acc[rt], 0, 0, 0); } \
            _Pragma("unroll") for (int rt = 0; rt < 2; ++rt) { const int row = row0 + 32 * rt + j; const float r_s = (ISQ_) ? rsq[rt] : rskv[rt]; const int col = (col_) + 16 * hi; \
                float v[16]; _Pragma("unroll") for (int r = 0; r < 16; ++r) v[r] = acc[rt][r] * r_s; \
                bf16* dst; \
                if (ISQ_) { const int jh = col % MQK; \
                    if (jh >= 64) { const int g0 = (jh - 64) >> 3; const f32x4* tb = (const f32x4*)(ropetab + ((size_t)row * 16 + 4 * g0) * 2); \
                        _Pragma("unroll") for (int gg = 0; gg < 2; ++gg) { const f32x4 t0 = tb[2 * gg], t1 = tb[2 * gg + 1]; float* w_ = v + 8 * gg; \
                            const float cs[4] = {t0[0], t0[2], t1[0], t1[2]}, sn[4] = {t0[1], t0[3], t1[1], t1[3]}; \
                            _Pragma("unroll") for (int q = 0; q < 4; ++q) { const float x1 = w_[q], x2 = w_[4 + q]; w_[q] = x1 * cs[q] - x2 * sn[q]; w_[4 + q] = x2 * cs[q] + x1 * sn[q]; } } } \
                    dst = Qo + (size_t)row * 768 + col; } \
                else dst = (col >= 512 ? VMo + (col - 512) : KNo + col) + (size_t)row * 512; \
                *(u32x4*)dst = (u32x4){cvt_pk_bf16(v[0], v[1]), cvt_pk_bf16(v[2], v[3]), cvt_pk_bf16(v[4], v[5]), cvt_pk_bf16(v[6], v[7])}; \
                *(u32x4*)(dst + 8) = (u32x4){cvt_pk_bf16(v[8], v[9]), cvt_pk_bf16(v[10], v[11]), cvt_pk_bf16(v[12], v[13]), cvt_pk_bf16(v[14], v[15])}; } } while (0)
        const int cq = 96 * wid, ckv = 128 * wid;
#define UP_SB() __builtin_amdgcn_sched_barrier(0)
        UP_LOADW(0, Wq, cq, 16);
        VM_WAIT(); __syncthreads();
        UP_STEP(0, true, cq, 16);        UP_SB(); UP_LOADW(0, Wq, cq + 32, 16); UP_SB();
        UP_STEP(0, true, cq + 32, 16);   UP_SB(); UP_LOADW(0, Wq, cq + 64, 16); UP_SB();
        UP_STEP(0, true, cq + 64, 16);   UP_SB(); UP_LOADW(0, Wkv, ckv, 8); UP_LOADW(8, Wkv, ckv + 32, 8); UP_SB();
        UP_STEP(0, false, ckv, 8);       UP_SB(); UP_LOADW(0, Wkv, ckv + 64, 8); UP_SB();
        UP_STEP(8, false, ckv + 32, 8);  UP_SB(); UP_LOADW(8, Wkv, ckv + 96, 8); UP_SB();
        UP_STEP(0, false, ckv + 64, 8);  UP_SB();
        UP_STEP(8, false, ckv + 96, 8);
#undef UP_SB
#undef UP_LOADW
#undef UP_STEP
        __syncthreads();
    }
}
}

#define XB_TMO      128
#define XB_XCNT(j)  (256  + 64 * (j))
#define XB_XSUB(j)  (1280 + 64 * (j))
#define XB_XGEN(j)  (2304 + 64 * (j))
#define XB_TOP      3328
#define XB_TOPGEN   3392
#define XCD_BAR_WORDS 3456
#define XB_SPIN_CAP (1u << 18)
__device__ __forceinline__ unsigned xb_ld(unsigned* p)              { return __hip_atomic_load(p, __ATOMIC_RELAXED, __HIP_MEMORY_SCOPE_AGENT); }
__device__ __forceinline__ unsigned xb_add(unsigned* p, unsigned v) { return __hip_atomic_fetch_add(p, v, __ATOMIC_RELAXED, __HIP_MEMORY_SCOPE_AGENT); }
__device__ __forceinline__ unsigned xb_xcc_id() { return (unsigned)__builtin_amdgcn_s_getreg((3 << 11) | 20) & 0xFu; }
#define XB_SPIN(cond, bar) do { unsigned _sp = 0; while (cond) { __builtin_amdgcn_s_sleep(1); \
    if ((++_sp & 255u) == 0u) { if (xb_ld(&(bar)[XB_TMO])) break; if (_sp > XB_SPIN_CAP) { atomicAdd(&(bar)[XB_TMO], 1u); break; } } } } while (0)
struct XcdBarrier { unsigned* bar; unsigned x; volatile LAS unsigned* st; };
__device__ __forceinline__ XcdBarrier xcd_barrier_post(unsigned* bar, volatile LAS unsigned* st) {
    XcdBarrier b; b.bar = bar; b.x = xb_xcc_id(); b.st = st;
    if (threadIdx.x == 0) (void)xb_add(&bar[XB_XCNT(b.x)], 1u);
    return b;
}
__device__ __forceinline__ void xcd_barrier_complete(unsigned* bar, unsigned x, unsigned& nloc, unsigned& nx) {
    const unsigned G = gridDim.x * gridDim.y * gridDim.z;
    unsigned sum, cnt, mine, sp = 0u;
    for (;;) {
        sum = 0u; cnt = 0u; mine = 0u;
#pragma unroll
        for (unsigned j = 0; j < 16; ++j) { const unsigned c = xb_ld(&bar[XB_XCNT(j)]); sum += c; cnt += (c > 0u) ? 1u : 0u; mine = (j == x) ? c : mine; }
        if (sum == G) break;
        __builtin_amdgcn_s_sleep(1);
        if ((++sp & 255u) == 0u) { if (xb_ld(&bar[XB_TMO])) break; if (sp > XB_SPIN_CAP) { atomicAdd(&bar[XB_TMO], 1u); break; } }
    }
    nloc = mine > 0u ? mine : 1u; nx = cnt > 0u ? cnt : 1u;
}
__device__ __forceinline__ void xcd_barrier(const XcdBarrier& b) {
    asm volatile("s_waitcnt vmcnt(0)" ::: "memory");
    __syncthreads();
    if (threadIdx.x == 0) {
        unsigned* bar = b.bar;
        __builtin_amdgcn_s_waitcnt(0);
        unsigned nloc = b.st[0], nx = b.st[1];
        if (nloc == 0u) { xcd_barrier_complete(bar, b.x, nloc, nx); b.st[0] = nloc; b.st[1] = nx; }
        const unsigned old = xb_add(&bar[XB_XSUB(b.x)], 1u);
        const unsigned gen = old / nloc;
        if (old + 1u == (gen + 1u) * nloc) {
            __builtin_amdgcn_fence(__ATOMIC_RELEASE, "agent");
            asm volatile("s_waitcnt vmcnt(0)" ::: "memory");
            const unsigned og = xb_add(&bar[XB_TOP], 1u);
            const unsigned tg = og / nx;
            if (og + 1u == (tg + 1u) * nx) xb_add(&bar[XB_TOPGEN], 1u);
            else XB_SPIN(xb_ld(&bar[XB_TOPGEN]) == tg, bar);
            __builtin_amdgcn_fence(__ATOMIC_ACQUIRE, "agent");
            xb_add(&bar[XB_XGEN(b.x)], 1u);
            asm volatile("s_waitcnt vmcnt(0)" ::: "memory");
        } else {
            XB_SPIN(xb_ld(&bar[XB_XGEN(b.x)]) == gen, bar);
            __builtin_amdgcn_fence(__ATOMIC_ACQUIRE, "agent");
            asm volatile("s_waitcnt vmcnt(0)" ::: "memory");
        }
    }
    __syncthreads();
}

struct Args { const void* in[25]; float* out; unsigned char* ws; int ph_lo, ph_hi; };

struct Frame {
    LAS unsigned char* lds;
    int tid, lane, wave, vcu, G;
};

template <class ColFn>
__device__ __forceinline__ void cvt_item(int ldw, int Ksrc, const float* kscale, bf16* WT, int Kd, LAS float* scr, int kb, int nb, int lane, ColFn colp) {
    const int k0 = 64 * kb, n0 = 32 * nb;
    const float* cp = colp(n0 + (lane & 31));
    float vv[32], sv[32];
#pragma unroll
    for (int i = 0; i < 32; ++i) { const int k = k0 + 2 * i + (lane >> 5);
        vv[i] = (cp != nullptr && k < Ksrc) ? cp[(size_t)k * ldw] : 0.f;
        sv[i] = (kscale != nullptr && k < Ksrc) ? kscale[k] : 1.f; }
#pragma unroll
    for (int i = 0; i < 32; ++i) scr[(2 * i + (lane >> 5)) * 33 + (lane & 31)] = vv[i] * sv[i];
    LDS_WAIT(); asm volatile("" ::: "memory");
    const int c = lane & 7;
#pragma unroll
    for (int j = 0; j < 4; ++j) { const int n = (lane >> 3) + 8 * j; const LAS float* s = scr + (8 * c) * 33 + n;
        u32x4 o; o.x = pk2(s[0 * 33], s[1 * 33]); o.y = pk2(s[2 * 33], s[3 * 33]); o.z = pk2(s[4 * 33], s[5 * 33]); o.w = pk2(s[6 * 33], s[7 * 33]);
        *(u32x4*)(WT + (size_t)(n0 + n) * Kd + k0 + 8 * c) = o; }
    LDS_WAIT(); asm volatile("" ::: "memory");
}
__device__ __forceinline__ void cvt64_item(const float* src, int ldw, bf16* dst, int Kd, LAS unsigned char* scr, int lane) {
    f32x4 v[16];
    const float* sp = src + (size_t)(lane >> 4) * ldw + 4 * (lane & 15);
#pragma unroll
    for (int i = 0; i < 16; ++i) v[i] = __builtin_nontemporal_load((const f32x4*)(sp + (size_t)(4 * i) * ldw));
#pragma unroll
    for (int i = 0; i < 16; ++i) { const int k = 4 * i + (lane >> 4);
#pragma unroll
        for (int q = 0; q < 4; ++q) { const int n = 4 * (lane & 15) + q; *(LAS bf16*)(scr + n * 128 + (((k >> 3) ^ ((n >> 2) & 7)) << 4) + (k & 7) * 2) = (bf16)f2bf(v[i][q]); } }
    LDS_WAIT(); asm volatile("" ::: "memory");
#pragma unroll
    for (int j = 0; j < 8; ++j) { const int p = j * 64 + lane, n = p >> 3, c = p & 7;
        const u32x4 o = *(const LAS u32x4*)(scr + n * 128 + ((c ^ ((n >> 2) & 7)) << 4));
        __builtin_nontemporal_store(o, (u32x4*)(dst + (size_t)n * Kd + c * 8)); }
    LDS_WAIT(); asm volatile("" ::: "memory");
}
__device__ __forceinline__ void cvt64_item8(const float* src, int ldw, unsigned char* dst, int Kd8, LAS unsigned char* scr, int lane, float scale) {
    f32x4 v[16];
    const float* sp = src + (size_t)(16 * (lane >> 4)) * ldw + 4 * (lane & 15);
#pragma unroll
    for (int i = 0; i < 16; ++i) v[i] = __builtin_nontemporal_load((const f32x4*)(sp + (size_t)i * ldw));
#pragma unroll
    for (int q = 0; q < 4; ++q) { u32x4 o;
#pragma unroll
        for (int g = 0; g < 4; ++g) { int p_ = __builtin_amdgcn_cvt_pk_fp8_f32(v[4 * g][q] * scale, v[4 * g + 1][q] * scale, 0, false); p_ = __builtin_amdgcn_cvt_pk_fp8_f32(v[4 * g + 2][q] * scale, v[4 * g + 3][q] * scale, p_, true); o[g] = (unsigned)p_; }
        *(LAS u32x4*)(scr + (4 * (lane & 15) + q) * 80 + (lane >> 4) * 16) = o; }
    LDS_WAIT(); asm volatile("" ::: "memory");
#pragma unroll
    for (int j = 0; j < 4; ++j) { const int p = j * 64 + lane, n = p >> 2, c = p & 3;
        const u32x4 o = *(const LAS u32x4*)(scr + n * 80 + c * 16);
        __builtin_nontemporal_store(o, (u32x4*)(dst + (size_t)n * Kd8 + c * 16)); }
    LDS_WAIT(); asm volatile("" ::: "memory");
}
__device__ __forceinline__ void cvt128_item8(const float* src, int ldw, unsigned char* dst, int Kd8, LAS unsigned char* scr, int lane, float scale) {
    f32x4 v[32];
    const float* sp = src + (size_t)(32 * (lane >> 4)) * ldw + 4 * (lane & 15);
#pragma unroll
    for (int i = 0; i < 32; ++i) v[i] = __builtin_nontemporal_load((const f32x4*)(sp + (size_t)i * ldw));
#pragma unroll
    for (int q = 0; q < 4; ++q) {
#pragma unroll
        for (int hf = 0; hf < 2; ++hf) { u32x4 o;
#pragma unroll
            for (int g = 0; g < 4; ++g) { const int i0 = 16 * hf + 4 * g; int p_ = __builtin_amdgcn_cvt_pk_fp8_f32(v[i0][q] * scale, v[i0 + 1][q] * scale, 0, false); p_ = __builtin_amdgcn_cvt_pk_fp8_f32(v[i0 + 2][q] * scale, v[i0 + 3][q] * scale, p_, true); o[g] = (unsigned)p_; }
            *(LAS u32x4*)(scr + (4 * (lane & 15) + q) * 144 + (lane >> 4) * 32 + 16 * hf) = o; } }
    LDS_WAIT(); asm volatile("" ::: "memory");
#pragma unroll
    for (int j = 0; j < 8; ++j) { const int p = j * 64 + lane, n = p >> 3, c = p & 7;
        const u32x4 o = *(const LAS u32x4*)(scr + n * 144 + c * 16);
        __builtin_nontemporal_store(o, (u32x4*)(dst + (size_t)n * Kd8 + c * 16)); }
    LDS_WAIT(); asm volatile("" ::: "memory");
}
__device__ __forceinline__ int ropedim(int jj) { const int g = jj >> 3, u = jj & 7; return (u < 4) ? 4 * g + u : 16 + 4 * g + (u - 4); }

__device__ __forceinline__ void sincos_acc(float af, float& sn, float& cs) {
    const double a = (double)af; const double kq = __builtin_rint(a * 0.63661977236758134308);
    const double r = (a - kq * 1.57079632679489655800) - kq * 6.123233995736766036e-17;
    const double r2 = r * r;
    const double sp = r * (1.0 + r2 * (-1.66666666666666324348e-01 + r2 * (8.33333333332248946124e-03 + r2 * (-1.98412698298579493134e-04 + r2 * (2.75573137070700676789e-06 + r2 * (-2.50507602534068634195e-08 + r2 * 1.58969099521155010221e-10))))));
    const double cp = 1.0 + r2 * (-0.5 + r2 * (4.16666666666666019037e-02 + r2 * (-1.38888888888741095749e-03 + r2 * (2.48015872894767294178e-05 + r2 * (-2.75573143513906633035e-07 + r2 * (2.08757232129817482790e-09 + r2 * -1.13596475577881948265e-11))))));
    const int q = (int)((long long)kq & 3);
    const double s_ = (q == 0) ? sp : (q == 1) ? cp : (q == 2) ? -sp : -cp;
    const double c_ = (q == 0) ? cp : (q == 1) ? -sp : (q == 2) ? -cp : sp;
    sn = (float)s_; cs = (float)c_;
}

__global__ void __launch_bounds__(NWAVES * 64, 2) fwd(Args args) {
    extern __shared__ __attribute__((aligned(16))) unsigned char lds_raw[];
    Frame F;
    F.lds = (LAS unsigned char*)lds_raw;
    F.tid = threadIdx.x; F.lane = F.tid & 63; F.wave = __builtin_amdgcn_readfirstlane(F.tid >> 6);
    F.G = gridDim.x; { const int bx = blockIdx.x; F.vcu = (F.G % 8 == 0) ? (bx % 8) * (F.G / 8) + bx / 8 : bx; }
    volatile LAS unsigned* MISC = (volatile LAS unsigned*)(F.lds + MISC_OFF);
    unsigned char* ws = args.ws;
    gu32* ctl = (gu32*)(ws + WS_CTL);
#define X_IN ((const float*)AP->in[0])
#define cvec ((const float*)AP->in[1])
#define positions ((const int*)AP->in[2])
#define w_mod ((const float*)AP->in[3])
#define b_mod ((const float*)AP->in[4])
#define g_mix ((const float*)AP->in[5])
#define w_in ((const float*)AP->in[6])
#define b_forget ((const float*)AP->in[7])
#define g_q_lat ((const float*)AP->in[8])
#define w_q_up ((const float*)AP->in[9])
#define g_kv_lat ((const float*)AP->in[10])
#define w_kv_up ((const float*)AP->in[11])
#define w_o_mla ((const float*)AP->in[12])
#define w_o_fox ((const float*)AP->in[13])
#define w_out ((const float*)AP->in[14])
#define g_ffn ((const float*)AP->in[15])
#define w_router ((const float*)AP->in[16])
#define b_router ((const float*)AP->in[17])
#define w_exp_gate ((const float*)AP->in[18])
#define w_exp_up ((const float*)AP->in[19])
#define w_exp_down ((const float*)AP->in[20])
#define w_sh_gate ((const float*)AP->in[21])
#define w_sh_up ((const float*)AP->in[22])
#define w_sh_down ((const float*)AP->in[23])
#define g_final ((const float*)AP->in[24])
#define Win_t ((bf16*)(ws + WS_WIN))
#define Wq_t ((bf16*)(ws + WS_WQ))
#define Wkv_t ((bf16*)(ws + WS_WKV))
#define Wom_t ((bf16*)(ws + WS_WOM))
#define Wof_t ((bf16*)(ws + WS_WOF))
#define Wout_t ((bf16*)(ws + WS_WOUT))
#define Wsgu_t ((bf16*)(ws + WS_WSGU))
#define Wsd_t ((bf16*)(ws + WS_WSD))
#define Wr_f ((bf16*)(ws + WS_WR))
#define mod ((float*)(ws + WS_MOD))
#define Wd_t ((bf16*)(ws + WS_WD))
#define Wgu_t ((bf16*)(ws + WS_WGU))
#define HB ((bf16*)(ws + WS_HB))
#define FQ ((bf16*)(ws + WS_FQ))
#define FK ((bf16*)(ws + WS_FK))
#define FV ((bf16*)(ws + WS_FV))
#define QLAT ((bf16*)(ws + WS_QLAT))
#define KVLAT ((bf16*)(ws + WS_KVLAT))
#define OFOX ((bf16*)(ws + WS_OFOX))
#define OCAT ((bf16*)((unsigned char*)out + 32 * MiB))
#define OMLA ((bf16*)(ws + WS_OMLA))
#define Y ((bf16*)(ws + WS_Y))
#define H ((bf16*)(ws + WS_H))
#define QMLA ((bf16*)(ws + WS_QMLA))
#define GATES ((bf16*)(ws + WS_GATES))
#define KN ((bf16*)(ws + WS_KN))
#define VM ((bf16*)(ws + WS_VM))
#define KPE ((bf16*)(ws + WS_KPE))
#define MERGED ((bf16*)(ws + WS_MERGED))
#define LIST ((unsigned short*)(ws + WS_LIST))
#define Wgu8 ((unsigned char*)(ws + WS_WGU))
#define Wsgu8 ((unsigned char*)(ws + WS_WSGU))
#define H8 ((unsigned char*)(ws + WS_H))
#define META ((u32x2*)(ws + WS_WIN))
#define EIDX ((unsigned char*)(ws + WS_EIDX))
#define GATEW ((float*)(ws + WS_GATEW))
#define ROPETAB ((float*)((unsigned char*)out + DO_ROPE))
#define LOGF ((float*)((unsigned char*)out + DO_LOGF))
#define CUMF ((float*)((unsigned char*)out + DO_CUMF))
#define SSQQ ((float*)((unsigned char*)out + DO_SSQQ))
#define SSQKV ((float*)((unsigned char*)out + DO_SSQKV))
#define MODP ((float*)((unsigned char*)out + DO_MODP))
#define X1B ((bf16*)(ws + WS_X1B))
#define SSQ1 ((float*)(ws + WS_FQ))
    float* const out = args.out;
#define PHASE_ENV const __attribute__((address_space(4))) Args* AP; { auto kp_ = __builtin_amdgcn_kernarg_segment_ptr(); asm volatile("" : "+s"(kp_)); AP = (const __attribute__((address_space(4))) Args*)kp_; } \
    unsigned char* const ws = AP->ws; float* const out = AP->out; (void)ws; (void)out;
    for (int u = F.tid; u < (LDS_BYTES - LDSCTL_OFF) / 4; u += NWAVES * 64) ((LAS unsigned*)(F.lds + LDSCTL_OFF))[u] = 0u;
    __syncthreads();
    XcdBarrier bar; bar.bar = (unsigned*)(ctl + CW_BAR); bar.x = 0; bar.st = nullptr;
    if (MK_ONE_LAUNCH) bar = xcd_barrier_post((unsigned*)(ctl + CW_BAR), MISC + 8);
    const int lo = args.ph_lo, hi = args.ph_hi;
#define IN(k) (lo <= (k) && (k) < hi)
#define BOTH(k) (IN(k) && IN((k) + 1))
#define GRID_BAR() do { if (MK_ONE_LAUNCH) xcd_barrier(bar); } while (0)
#define DUP_BAR() do { if (dummy) xcd_barrier(bar); } while (0)
    const int gw = F.vcu * NWAVES + F.wave, NGW = F.G * NWAVES;

    for (int rep = 0; rep < ((PROBE_DUP == 0) ? 2 : 1); ++rep) if (IN(0)) { PHASE_ENV const bool dummy = (PROBE_DUP == 0) && rep == 0; (void)dummy;
        if (!(dummy && (PROBE_VAR == 1 || PROBE_VAR == 4 || PROBE_VAR == 5))) {
            LAS float* cond = (LAS float*)F.lds;
            for (int i = F.tid; i < NB * D; i += NWAVES * 64) { const float c = cvec[i]; cond[i] = c / (1.f + __expf(-c)); }
            __syncthreads();
            for (int it = F.wave * F.G + F.vcu; it < 96 * 16; it += NWAVES * F.G) { const int cg = it % 96, kq = it / 96, col = cg * 64 + F.lane;
                float a4[4] = {0.f, 0.f, 0.f, 0.f};
                const float* wp = w_mod + (size_t)(64 * kq) * (6 * D) + col;
                float wv[64];
#pragma unroll
                for (int kk = 0; kk < 64; ++kk) wv[kk] = __builtin_nontemporal_load(wp + (size_t)kk * (6 * D));
#pragma unroll
                for (int kk = 0; kk < 64; ++kk) {
#pragma unroll
                    for (int b = 0; b < 4; ++b) a4[b] += wv[kk] * cond[b * D + 64 * kq + kk]; }
#pragma unroll
                for (int b = 0; b < 4; ++b) MODP[((size_t)kq * 4 + b) * (6 * D) + col] = a4[b]; }
            __syncthreads();
        }
        if (!(dummy && (PROBE_VAR == 1 || PROBE_VAR == 3 || PROBE_VAR == 5))) for (int i = gw * 64 + F.lane; i < T * 16; i += NGW * 64) { const int t = i >> 4, j = i & 15;
            const float invf = (((j >> 2) == 0) ? 1.f : ((j >> 2) == 1) ? 0.1f : ((j >> 2) == 2) ? 0.01f : 0.001f) * (((j & 3) == 0) ? 1.f : ((j & 3) == 1) ? 0.5623413251903491f : ((j & 3) == 2) ? 0.31622776601683794f : 0.17782794100389228f);
            const float ang = (float)positions[t] * invf; float sn, cs; sincos_acc(ang, sn, cs);
            *(f32x2*)(ROPETAB + (size_t)i * 2) = (f32x2){cs, sn}; }
        for (int o = gw * 64 + F.lane; o < NEXP * D; o += NGW * 64) { const int piece = o >> 3, kk = o & 7, ln = piece & 63, grp = piece >> 6, ntl = grp & 3, j = grp >> 2;
            const int n = ntl * 16 + (ln & 15), k = j * 32 + (ln >> 4) * 8 + kk; Wr_f[o] = (bf16)f2bf(w_router[(size_t)k * NEXP + n]); }
        {
            LAS unsigned char* scr8 = F.lds + 32768 + F.wave * 9216;
            constexpr int F_IN = 62 * 16;
            if (!(dummy && PROBE_VAR >= 2)) for (int it = gw; it < F_IN; it += NGW) {
                int nb = it % 62; const int kb = it / 62; if (nb >= 6) nb += 2; const int n0 = 64 * nb;
                const int src = (n0 < 384) ? n0 : (n0 < 2048) ? 416 + (n0 - 512) : 1960 + (n0 - 2048);
                cvt64_item(w_in + (size_t)(64 * kb) * 4008 + src, 4008, Win_t + (size_t)n0 * D + 64 * kb, D, scr8, F.lane);
            }
            LAS float* scr = (LAS float*)(F.lds + 32768 + F.wave * 9216);
            constexpr int I_INS = 4 * (D / 64), NSLOW = I_INS;
            if (!(dummy && (PROBE_VAR == 1 || PROBE_VAR == 3 || PROBE_VAR == 4))) for (int it = F.wave * F.G + F.vcu; it < NSLOW; it += NGW) {
                const int nb = 12 + (it & 3), kb = it >> 2;
                cvt_item(4008, D, nullptr, Win_t, D, scr, kb, nb, F.lane, [&](int n) -> const float* {
                    int src; if (n < 416) src = 384 + ropedim(n - 384); else if (n < 424) src = 1952 + (n - 416); else src = -1;
                    return src < 0 ? nullptr : w_in + src; });
            }
            if (!(dummy && (PROBE_VAR == 1 || PROBE_VAR == 3 || PROBE_VAR == 4))) {
                for (int o = gw * 64 + F.lane; o < 768 * QLORA; o += NGW * 64) { const int cb = o >> 13, rem = o & 8191, ks = rem >> 9, ln = (rem >> 3) & 63, e = rem & 7;
                    const int n = cb * 32 + up::nloc(ln & 31), k = 16 * ks + 8 * (ln >> 5) + e, hh = n / MQK, jj = n % MQK, sc = hh * MQK + (jj < 64 ? jj : 64 + ropedim(jj - 64));
                    Wq_t[o] = (bf16)f2bf(w_q_up[(size_t)k * 768 + sc] * g_q_lat[k]); }
                for (int o = gw * 64 + F.lane; o < 1024 * KVLORA; o += NGW * 64) { const int cb = o >> 12, rem = o & 4095, ks = rem >> 9, ln = (rem >> 3) & 63, e = rem & 7;
                    const int n = cb * 32 + up::nloc(ln & 31), k = 16 * ks + 8 * (ln >> 5) + e, sc = (n < 512) ? (n >> 6) * 128 + (n & 63) : ((n - 512) >> 6) * 128 + 64 + (n & 63);
                    Wkv_t[o] = (bf16)f2bf(w_kv_up[(size_t)k * 1024 + sc] * g_kv_lat[k]); }
            }
        }
        if (BOTH(0)) GRID_BAR();
    }

    for (int rep = 0; rep < ((PROBE_DUP == 1) ? 2 : 1); ++rep) if (IN(1)) { PHASE_ENV const bool dummy = (PROBE_DUP == 1) && rep == 0; (void)dummy;
        if (F.vcu < 48) { const int idx = F.vcu * 512 + F.tid, b = idx / (6 * D), col = idx % (6 * D); float sm = b_mod[col];
#pragma unroll
            for (int p = 0; p < 16; ++p) sm += MODP[((size_t)p * 4 + b) * (6 * D) + col];
            mod[idx] = sm; }
        LAS float* vg1 = (LAS float*)F.lds; LAS float* vs1 = (LAS float*)(F.lds + 4096);
        for (int grp = F.vcu; grp < T / 64; grp += F.G) {
            const int b = (grp * 64) / SEQ;
            __syncthreads();
            for (int k = F.tid; k < D; k += NWAVES * 64) { float s0 = b_mod[k], s1 = b_mod[D + k];
#pragma unroll
                for (int p = 0; p < 16; ++p) { s0 += MODP[((size_t)p * 4 + b) * (6 * D) + k]; s1 += MODP[((size_t)p * 4 + b) * (6 * D) + D + k]; }
                vs1[k] = s0; vg1[k] = g_mix[k] * (1.f + s1); }
            __syncthreads();
#pragma unroll 2
            for (int rr = 0; rr < 8; ++rr) { const int m = grp * 64 + F.wave * 8 + rr;
                const f32x4* xr = (const f32x4*)(X_IN + (size_t)m * D) + F.lane;
                f32x4 v[4]; float s = 0.f;
#pragma unroll
                for (int j = 0; j < 4; ++j) { v[j] = __builtin_nontemporal_load(xr + 64 * j); s += (v[j].x * v[j].x + v[j].y * v[j].y) + (v[j].z * v[j].z + v[j].w * v[j].w); }
                const float rstd = rsqrtf(wave_sum(s) * (1.f / D) + EPS);
                unsigned long long* o8 = (unsigned long long*)(H + (size_t)m * D) + F.lane;
#pragma unroll
                for (int j = 0; j < 4; ++j) { const int c = 4 * F.lane + 256 * j;
                    const f32x4 g = *(const LAS f32x4*)(vg1 + c), d = *(const LAS f32x4*)(vs1 + c);
                    const f32x4 r = v[j] * rstd * g + d;
                    o8[64 * j] = (unsigned long long)pk2(r.x, r.y) | ((unsigned long long)pk2(r.z, r.w) << 32); } }
        }
        if (BOTH(1)) GRID_BAR();
    }

    for (int rep = 0; rep < ((PROBE_DUP == 2) ? 2 : 1); ++rep) if (IN(2)) { PHASE_ENV const bool dummy = (PROBE_DUP == 2) && rep == 0; (void)dummy;
        pg8::StaticOrder S; S.init(H, Win_t, T, NIN, D, F.G, (int)blockIdx.x);
        EpiInProj E{QLAT, KVLAT, KPE, FQ, GATES, LOGF, SSQQ, SSQKV, ROPETAB, b_forget, dummy && (PROBE_VAR == 1), (dummy && PROBE_VAR == 2) ? 0 : (dummy && PROBE_VAR == 3) ? 2 : 1};
        pg8::gemm_phase<EpiInProj, pg8::StaticOrder, true>(F.lds, S, E);
        if (BOTH(2)) GRID_BAR();
    }

    for (int rep = 0; rep < ((PROBE_DUP == 3) ? 2 : 1); ++rep) if (IN(3)) { PHASE_ENV const bool dummy = (PROBE_DUP == 3) && rep == 0; (void)dummy;
        if (!(dummy && (PROBE_VAR == 2 || PROBE_VAR == 3))) {
            const int bb = F.vcu & 3; float mx = 0.f, mq = 0.f;
            for (int r = (F.vcu >> 2) * NWAVES + F.wave; r < SEQ; r += (F.G >> 2) * NWAVES) { f32x4 k0, k1, q0v, q1v; unpack8(*(const u32x4*)(FK + ((size_t)bb * SEQ + r) * 512 + 8 * F.lane), k0, k1);
                unpack8(*(const u32x4*)(FQ + ((size_t)bb * SEQ + r) * 512 + 8 * F.lane), q0v, q1v);
                float sq = (k0[0] * k0[0] + k0[1] * k0[1]) + (k0[2] * k0[2] + k0[3] * k0[3]) + (k1[0] * k1[0] + k1[1] * k1[1]) + (k1[2] * k1[2] + k1[3] * k1[3]);
                float sqq = (q0v[0] * q0v[0] + q0v[1] * q0v[1]) + (q0v[2] * q0v[2] + q0v[3] * q0v[3]) + (q1v[0] * q1v[0] + q1v[1] * q1v[1]) + (q1v[2] * q1v[2] + q1v[3] * q1v[3]);
                sq += dppf<0xB1>(sq); sq += dppf<0x4E>(sq); sq += dppf<0x141>(sq);
                sqq += dppf<0xB1>(sqq); sqq += dppf<0x4E>(sqq); sqq += dppf<0x141>(sqq);
                mx = fmaxf(mx, sq); mq = fmaxf(mq, sqq); }
            LAS float* kml = (LAS float*)F.lds;
            if ((F.lane & 7) == 0) { kml[F.wave * 8 + (F.lane >> 3)] = mx; kml[64 + F.wave * 8 + (F.lane >> 3)] = mq; }
            __syncthreads();
            if (F.tid < 2 * NHEAD) { const int hh = F.tid & 7, qk = F.tid >> 3; float m2 = 0.f;
#pragma unroll
                for (int w = 0; w < NWAVES; ++w) m2 = fmaxf(m2, kml[qk * 64 + w * 8 + hh]);
                atomicMax((unsigned*)(ctl + CW_KM + qk * 32 + bb * NHEAD + hh), __float_as_uint(m2)); }
            __syncthreads();
        }
        if (F.vcu < NB * NHEAD && !(dummy && (PROBE_VAR == 1 || PROBE_VAR == 3))) {
            const int b = F.vcu >> 3, h = F.vcu & 7; const float* src = LOGF + ((size_t)b * SEQ + 8 * F.tid) * 8 + h;
            float v[8]; float run = 0.f;
#pragma unroll
            for (int i = 0; i < 8; ++i) v[i] = src[i * 8];
#pragma unroll
            for (int i = 0; i < 8; ++i) { run += v[i]; v[i] = run; }
            float incl = run;
#pragma unroll
            for (int o = 1; o < 64; o <<= 1) { const float n = __shfl_up(incl, o); if (F.lane >= o) incl += n; }
            LAS float* wt = (LAS float*)F.lds;
            if (F.lane == 63) wt[F.wave] = incl;
            __syncthreads();
            float woff = 0.f;
#pragma unroll
            for (int w = 0; w < NWAVES; ++w) woff += (w < F.wave) ? wt[w] : 0.f;
            const float excl = woff + incl - run;
            float* dst = CUMF + ((size_t)b * NHEAD + h) * SEQ + 8 * F.tid;
            *(f32x4*)dst = (f32x4){v[0] + excl, v[1] + excl, v[2] + excl, v[3] + excl}; *(f32x4*)(dst + 4) = (f32x4){v[4] + excl, v[5] + excl, v[6] + excl, v[7] + excl};
            __syncthreads();
        }
        if (!(dummy && (PROBE_VAR == 1 || PROBE_VAR == 2))) up::up_phase(F.lds, QLAT, KVLAT, Wq_t, Wkv_t, SSQQ, SSQKV, ROPETAB, QMLA, KN, VM, F.G, (int)blockIdx.x);
        if (BOTH(3)) GRID_BAR();
    }

    for (int rep = 0; rep < ((PROBE_DUP == 4) ? 2 : 1); ++rep) if (IN(4)) { PHASE_ENV const bool dummy = (PROBE_DUP == 4) && rep == 0; (void)dummy;
        {
            const bool xq = (F.G % 8) == 0; const int x = xq ? (int)(blockIdx.x & 7) : 0, nunits = xq ? 128 : 1024;
            constexpr int F_O = 16 * 4, F_OUT = 16 * 8, F_SGU = 8 * 8, F_SD = 16 * 2, F_EGU = NEXP * F_SGU, F_ED = NEXP * F_SD;
            constexpr int NCONV = F_EGU + F_ED + 2 * F_O + F_OUT + F_SGU + F_SD, NCBATCH = (NCONV + 31) / 32;
            const int NQ = xq ? 8 : 1, ncb = (NCBATCH - x + NQ - 1) / NQ, A0 = xq ? CONV_A0 : 8 * CONV_A0;
            gu32* qh = ctl + CW_Q + 64 * x + (dummy ? 16 : 0);
            volatile LAS unsigned* qw = (volatile LAS unsigned*)(F.lds + MISC_OFF + 64);
            for (int nit = 0;; ++nit) {
                if (F.tid == 0) qw[nit & 1] = __hip_atomic_fetch_add(qh, 1u, RLX_AGENT);
                __syncthreads();
                int r = __builtin_amdgcn_readfirstlane((int)qw[nit & 1]);
                if (r >= nunits + ncb) break;
                if (r >= A0 && r < A0 + ncb) { const int cb = x + NQ * (r - A0);
                    LAS unsigned char* scr8 = F.lds + 32768 + F.wave * 9216;
                    int ln_ = F.lane; asm volatile("" : "+v"(ln_));
                    for (int kr = 0; kr < 4; ++kr) { int it = 32 * cb + 8 * kr + F.wave; if (it >= NCONV) break;
                        const float* src; unsigned char* dst; int ldw, kd8;
                        if (it < F_EGU) { const int e = it / F_SGU, rr = it % F_SGU, nb = rr & 7, kb = rr >> 3, pn = nb >> 2, c0 = (nb & 3) * 64;
                            src = ((c0 < 128) ? w_exp_gate : w_exp_up) + (size_t)e * D * DEXP + pn * 128 + (c0 & 127) + (size_t)(128 * kb) * DEXP; ldw = DEXP;
                            dst = Wgu8 + (size_t)e * 512 * D + (size_t)(64 * nb) * D + 128 * kb; kd8 = D; }
                        else if ((it -= F_EGU) < F_ED) { const int e = it / F_SD, rr = it % F_SD, nb = rr & 15, kb = rr >> 4;
                            src = w_exp_down + (size_t)e * DEXP * D + (size_t)(128 * kb) * D + 64 * nb; ldw = D; dst = (unsigned char*)Wd_t + (size_t)e * D * DEXP + (size_t)(64 * nb) * DEXP + 128 * kb; kd8 = DEXP; }
                        else if ((it -= F_ED) < 2 * F_O) { const int fx = it >= F_O, i2 = it - (fx ? F_O : 0), nb = i2 & 15, kb = i2 >> 4;
                            src = (fx ? w_o_fox : w_o_mla) + (size_t)(128 * kb) * D + 64 * nb; ldw = D; dst = (unsigned char*)Wom_t + (size_t)(64 * nb) * D + (fx ? 512 : 0) + 128 * kb; kd8 = D; }
                        else if ((it -= 2 * F_O) < F_OUT) { const int nb = it & 15, kb = it >> 4; src = w_out + (size_t)(128 * kb) * D + 64 * nb; ldw = D; dst = (unsigned char*)Wout_t + (size_t)(64 * nb) * D + 128 * kb; kd8 = D; }
                        else if ((it -= F_OUT) < F_SGU) { const int nb = it >> 3, kb = it & 7, pn = nb >> 2, c0 = (nb & 3) * 64;
                            src = ((c0 < 128) ? w_sh_gate : w_sh_up) + pn * 128 + (c0 & 127) + (size_t)(128 * kb) * DEXP; ldw = DEXP; dst = Wsgu8 + (size_t)(64 * nb) * D + 128 * kb; kd8 = D; }
                        else { it -= F_SGU; const int nb = it >> 1, kb = it & 1; src = w_sh_down + (size_t)(128 * kb) * D + 64 * nb; ldw = D; dst = (unsigned char*)Wsd_t + (size_t)(64 * nb) * DEXP + 128 * kb; kd8 = DEXP; }
                        cvt128_item8(src, ldw, dst, kd8, scr8, ln_, WSCALE8);
                    }
                    continue; }
                if (r >= A0) r -= ncb;
                int qb, type, b, h;
                if (xq) { qb = 15 - (r >> 3); type = (r >> 2) & 1; b = r & 3; h = (x + 3 * b) & 7; }
                else { qb = 15 - (r >> 6); type = (r >> 5) & 1; b = (r >> 3) & 3; h = r & 7; }
                if (type == 0) { if (ATT_TUNED_FOX && qb != 0) att::attn_unit_t<64, true, 8>(b, h, qb, FQ, 512, FK, KPE, FV, CUMF, __uint_as_float(__hip_atomic_load((unsigned*)(ctl + CW_KM + b * NHEAD + h), RLX_AGENT)) * __uint_as_float(__hip_atomic_load((unsigned*)(ctl + CW_KM + 32 + b * NHEAD + h), RLX_AGENT)), (bf16*)((unsigned char*)(dummy ? (bf16*)((unsigned char*)out + 4 * MiB) : OCAT) + 512), D, F.lds);
                                 else att::attn_unit<64, true, 8>(b, h, qb, FQ, 512, FK, KPE, FV, CUMF, (bf16*)((unsigned char*)(dummy ? (bf16*)((unsigned char*)out + 4 * MiB) : OCAT) + 512), D, F.lds); }
                else { if (ATT_TUNED_MLA && qb != 0) att::attn_unit_t<96, false, 8>(b, h, qb, QMLA, 768, KN, KPE, VM, nullptr, 0.f, dummy ? (bf16*)((unsigned char*)out + 4 * MiB) : OCAT, D, F.lds);
                       else att::attn_unit<96, false, 8>(b, h, qb, QMLA, 768, KN, KPE, VM, nullptr, dummy ? (bf16*)((unsigned char*)out + 4 * MiB) : OCAT, D, F.lds); }
            }
        }
        if (BOTH(4)) GRID_BAR();
    }

    for (int rep = 0; rep < ((PROBE_DUP == 5) ? 2 : 1); ++rep) if (IN(5)) { PHASE_ENV const bool dummy = (PROBE_DUP == 5) && rep == 0; (void)dummy;
        pg8::StaticOrder S; S.init(OCAT, Wom_t, T, D, D / 2, F.G, (int)blockIdx.x);
        EpiMergedCat E{(const unsigned char*)GATES, (unsigned char*)MERGED, 1.f / (WSCALE8 * 255.f)};
        pg8::gemm_phase<EpiMergedCat, pg8::StaticOrder, true, true>(F.lds, S, E);
        if (BOTH(5)) GRID_BAR();
    }

    for (int rep = 0; rep < ((PROBE_DUP == 6) ? 2 : 1); ++rep) if (IN(6)) { PHASE_ENV const bool dummy = (PROBE_DUP == 6) && rep == 0; (void)dummy;
        pg8::StaticOrder S; S.init(MERGED, Wout_t, T, D, D / 2, F.G, (int)blockIdx.x);
        EpiOut E{X_IN, X1B, mod, SSQ1, 1.f / (OSCALE8 * WSCALE8)};
        pg8::gemm_phase<EpiOut, pg8::StaticOrder, true, true>(F.lds, S, E);
        if (BOTH(6)) GRID_BAR();
    }

    for (int rep = 0; rep < ((PROBE_DUP == 7) ? 2 : 1); ++rep) if (IN(7)) { PHASE_ENV const bool dummy = (PROBE_DUP == 7) && rep == 0; (void)dummy;
        LAS unsigned char* wrl = F.lds;
        LAS float* vg = (LAS float*)(F.lds + LDSCTL_OFF + 6144);
        LAS float* vs = (LAS float*)(F.lds + LDSCTL_OFF + 10240);
        LAS int* cntw = (LAS int*)(F.lds + 32768);
        LAS int* basel = (LAS int*)(F.lds + 32768 + 2048);
        static_assert(LDSCTL_OFF + 10240 + 4096 <= LDS_BYTES && MOETAB_OFF + 4700 <= LDSCTL_OFF + 6144, "P7 LDS map");
        const float my_bias = b_router[F.lane];
        for (int grp = F.vcu; grp < T / 64; grp += F.G) {
            const int b = (grp * 64) / SEQ;
            __syncthreads();
#pragma unroll
            for (int i = 0; i < 16; ++i) __builtin_amdgcn_global_load_lds((const unsigned*)((const char*)Wr_f + (F.wave * 16 + i) * 1024 + F.lane * 16), (LAS unsigned*)(wrl + (F.wave * 16 + i) * 1024), 16, 0, 0);
            for (int i = F.tid; i < D; i += NWAVES * 64) { vg[i] = g_ffn[i] * (1.f + mod[(size_t)b * 6 * D + 4 * D + i]); vs[i] = mod[(size_t)b * 6 * D + 3 * D + i]; }
            const int tp = grp * 64 + (F.wave & 3) * 16, kh = F.wave >> 2, t0 = tp + kh * 8;
            const int r16 = F.lane & 15, kg = F.lane >> 4, myrow = tp + r16;
            float rs_mine;
            { const float* sp = SSQ1 + (size_t)myrow * 16; const f32x4 a = *(const f32x4*)sp, b4 = *(const f32x4*)(sp + 4), c4 = *(const f32x4*)(sp + 8), d4 = *(const f32x4*)(sp + 12);
              const float ssum = (((a[0] + a[1]) + (a[2] + a[3])) + ((b4[0] + b4[1]) + (b4[2] + b4[3]))) + (((c4[0] + c4[1]) + (c4[2] + c4[3])) + ((d4[0] + d4[1]) + (d4[2] + d4[3])));
              rs_mine = rsqrtf(ssum * (1.f / D) + EPS); }
            const bf16* xrow = X1B + (size_t)myrow * D + 512 * kh + 8 * kg;
            f32x4 lacc[4] = {{0.f, 0.f, 0.f, 0.f}, {0.f, 0.f, 0.f, 0.f}, {0.f, 0.f, 0.f, 0.f}, {0.f, 0.f, 0.f, 0.f}};
            u32x4 xq[16];
#pragma unroll
            for (int p = 0; p < 16; ++p) xq[p] = *(const u32x4*)(xrow + 32 * p);
            VM_WAIT(); __syncthreads();
#pragma unroll
            for (int p = 0; p < 16; ++p) { const int j = 16 * kh + p, k = 32 * j + 8 * kg;
                f32x4 x0, x1v; unpack8(xq[p], x0, x1v);
                const f32x4 g0 = *(const LAS f32x4*)(vg + k), g1 = *(const LAS f32x4*)(vg + k + 4), s0 = *(const LAS f32x4*)(vs + k), s1 = *(const LAS f32x4*)(vs + k + 4);
                const f32x4 h0 = x0 * rs_mine * g0 + s0, h1 = x1v * rs_mine * g1 + s1;
                const u32x4 hw = pack8(h0, h1);
                f32x4 a0, a1; unpack8(hw, a0, a1);
                const u32x4 lw = pack8(h0 - a0, h1 - a1);
                { u32x2 h8; int p_ = __builtin_amdgcn_cvt_pk_fp8_f32(h0[0], h0[1], 0, false); p_ = __builtin_amdgcn_cvt_pk_fp8_f32(h0[2], h0[3], p_, true); h8.x = (unsigned)p_;
                    p_ = __builtin_amdgcn_cvt_pk_fp8_f32(h1[0], h1[1], 0, false); p_ = __builtin_amdgcn_cvt_pk_fp8_f32(h1[2], h1[3], p_, true); h8.y = (unsigned)p_;
                    *(u32x2*)(H8 + (size_t)myrow * D + k) = h8; }
                const bf16x8 Ah = __builtin_bit_cast(bf16x8, hw), Al = __builtin_bit_cast(bf16x8, lw);
#pragma unroll
                for (int ntl = 0; ntl < 4; ++ntl) { const bf16x8 Wf = *(const LAS bf16x8*)(wrl + ((j * 4 + ntl) * 64 + F.lane) * 16);
                    lacc[ntl] = __builtin_amdgcn_mfma_f32_16x16x32_bf16(Wf, Ah, lacc[ntl], 0, 0, 0);
                    lacc[ntl] = __builtin_amdgcn_mfma_f32_16x16x32_bf16(Wf, Al, lacc[ntl], 0, 0, 0); } }
            __syncthreads();
            {   LAS float* stw = (LAS float*)F.lds + (((F.wave & 3) * 2 + kh) * 16 + r16) * 64;
#pragma unroll
                for (int ntl = 0; ntl < 4; ++ntl) *(LAS f32x4*)(stw + 16 * ntl + 4 * kg) = lacc[ntl]; }
            __syncthreads();
            LAS float* stg = (LAS float*)F.lds + ((F.wave & 3) * 32 + kh * 8) * 64;
            int cnt = 0; unsigned selbits = 0u, selks = 0u;
            for (int j = 0; j < 8; ++j) {
                const float logit = stg[j * 64 + F.lane] + stg[(16 + j) * 64 + F.lane];
                const float sc = 1.f / (1.f + expf(-logit));
                const float ch = sc + my_bias;
                const float m1 = max8(ch);
                const unsigned long long eq = __ballot(ch == m1);
                const unsigned gm = (unsigned)(eq >> (F.lane & ~7)) & 0xffu;
                const int first = __builtin_ctz(gm);
                const float c2 = max8(((F.lane & 7) == first) ? -INFINITY : ch);
                const float gs = m1 + c2; const int myg = F.lane >> 3;
                int rank = 0;
#pragma unroll
                for (int g = 0; g < 8; ++g) { const float o = __builtin_bit_cast(float, __builtin_amdgcn_readlane(__builtin_bit_cast(int, gs), 8 * g)); rank += (o > gs || (o == gs && g < myg)) ? 1 : 0; }
                float mc = (rank < 4) ? ch : -1e30f;
                int selk = -1;
#pragma unroll
                for (int k = 0; k < TOPK; ++k) { const float mx = wave_max_f(mc); const unsigned long long bl = __ballot(mc == mx); const int fl = __builtin_ctzll(bl);
                    if (F.lane == fl) { selk = k; mc = -INFINITY; } }
                const float ssum = wave_sum_f(selk >= 0 ? sc : 0.f);
                if (selk >= 0) { const int t = t0 + j; EIDX[(size_t)t * 8 + selk] = (unsigned char)F.lane; GATEW[(size_t)t * 8 + selk] = sc / ssum * 2.5f; ++cnt; selbits |= 1u << j; selks |= (unsigned)selk << (3 * j); }
            }
            cntw[F.wave * 64 + F.lane] = cnt;
            __syncthreads();
            if (F.wave == 0) { int tot = 0;
#pragma unroll
                for (int w = 0; w < 8; ++w) tot += cntw[w * 64 + F.lane];
                basel[F.lane] = (int)__hip_atomic_fetch_add((unsigned*)(ctl + (dummy ? CW_CNT + 2048 : CW_CNT) + 16 * F.lane), (unsigned)tot, RLX_AGENT); }
            __syncthreads();
            int pos = basel[F.lane];
            for (int w = 0; w < F.wave; ++w) pos += cntw[w * 64 + F.lane];
#pragma unroll
            for (int j = 0; j < 8; ++j) if ((selbits >> j) & 1u) { const int k = (selks >> (3 * j)) & 7, t = t0 + j;
                LIST[(size_t)F.lane * LISTCAP + pos] = (unsigned short)t;
                META[(size_t)F.lane * LISTCAP + pos] = (u32x2){(unsigned)(t * (TOPK + 1) + k), __float_as_uint(GATEW[(size_t)t * 8 + k])}; ++pos; }
        }
        __syncthreads();
        if (BOTH(7)) GRID_BAR();
    }

    volatile LAS int* tab = (volatile LAS int*)(F.lds + MOETAB_OFF);
    if (IN(8) || IN(9)) {
        __syncthreads();
        if (F.wave == 0) {
            const int n = (int)__hip_atomic_load((unsigned*)(ctl + CW_CNT + 16 * F.lane), RLX_AGENT);
            const int tiles = (n + 255) >> 8; int incl = tiles;
#pragma unroll
            for (int o = 1; o < 64; o <<= 1) { const int v = __shfl_up(incl, o); if (F.lane >= o) incl += v; }
            tab[F.lane] = incl - tiles; tab[66 + F.lane] = n;
            if (F.lane == 63) { tab[64] = incl; tab[65] = incl + T / 256; tab[66 + 64] = T; }
        }
        __syncthreads();
        { const int ti = F.tid; int e = 0;
          for (int q = 0; q <= NEXP; ++q) if (tab[q] <= ti) e = q;
          tab[132 + ti] = e; }
        __syncthreads();
    }
    for (int rep = 0; rep < ((PROBE_DUP == 8) ? 2 : 1); ++rep) if (IN(8)) { PHASE_ENV const bool dummy = (PROBE_DUP == 8) && rep == 0; (void)dummy;
        MoeOrder<2, true> S{(const char*)H8, (const char*)Wgu8, (const char*)Wsgu8, D / 2, (size_t)512 * D, LIST, tab, F.G, (int)blockIdx.x};
        EpiHb E{(unsigned char*)HB, 1.f / WSCALE8};
        pg8::gemm_phase<EpiHb, MoeOrder<2, true>, true, true>(F.lds, S, E);
        if (BOTH(8)) GRID_BAR();
    }
    for (int rep = 0; rep < ((PROBE_DUP == 9) ? 2 : 1); ++rep) if (IN(9)) { PHASE_ENV const bool dummy = (PROBE_DUP == 9) && rep == 0; (void)dummy;
        if (dummy && PROBE_VAR == 1) dn::down_phase<true>(F.lds, (const unsigned char*)HB, (const unsigned char*)Wd_t, (const unsigned char*)Wsd_t, tab, META, (unsigned char*)Y, (unsigned char*)(ws + WS_CTL + 900 * 1024), F.G, (int)blockIdx.x);
        else dn::down_phase<false>(F.lds, (const unsigned char*)HB, (const unsigned char*)Wd_t, (const unsigned char*)Wsd_t, tab, META, (unsigned char*)Y, (unsigned char*)(ws + WS_CTL + 900 * 1024), F.G, (int)blockIdx.x);
        if (BOTH(9)) GRID_BAR();
    }

    for (int rep = 0; rep < ((PROBE_DUP == 10) ? 2 : 1); ++rep) if (IN(10)) { PHASE_ENV const bool dummy = (PROBE_DUP == 10) && rep == 0; (void)dummy;
        int ln10 = F.lane; asm volatile("" : "+v"(ln10));
        for (int mb = gw * 8; mb < T; mb += NGW * 8) {
            const float* gf = mod + (size_t)(mb / SEQ) * 6 * D + 5 * D;
            f32x4 gfv[4], gfin[4];
#pragma unroll
            for (int j = 0; j < 4; ++j) { gfv[j] = *(const f32x4*)(gf + 4 * ln10 + 256 * j); gfin[j] = *(const f32x4*)(g_final + 4 * ln10 + 256 * j); }
            int yw[2][4][TOPK + 1]; u32x2 xb[2][4];
#define P10_LOAD(bf, m_) do { const unsigned char* yp_ = (const unsigned char*)Y + (size_t)(m_) * (TOPK + 1) * D + 4 * ln10; const u32x2* xr_ = (const u32x2*)(X1B + (size_t)(m_) * D) + ln10; \
            _Pragma("unroll") for (int j = 0; j < 4; ++j) { _Pragma("unroll") for (int k = 0; k < TOPK + 1; ++k) yw[bf][j][k] = __builtin_nontemporal_load((const int*)(yp_ + k * D + 256 * j)); \
                xb[bf][j] = __builtin_nontemporal_load(xr_ + 64 * j); } } while (0)
#define P10_ROW(bf, m_) do { f32x4 v[4]; float s = 0.f; \
            _Pragma("unroll") for (int j = 0; j < 4; ++j) { f32x4 y = {0.f, 0.f, 0.f, 0.f}; \
                _Pragma("unroll") for (int k = 0; k < TOPK + 1; ++k) { const f32x2 lo = __builtin_amdgcn_cvt_pk_f32_fp8(yw[bf][j][k], false), hi2 = __builtin_amdgcn_cvt_pk_f32_fp8(yw[bf][j][k], true); y += (f32x4){lo.x, lo.y, hi2.x, hi2.y}; } \
                const u32x2 xv = xb[bf][j]; \
                v[j] = (f32x4){__uint_as_float(xv.x << 16), __uint_as_float(xv.x & 0xffff0000u), __uint_as_float(xv.y << 16), __uint_as_float(xv.y & 0xffff0000u)} + gfv[j] * y; \
                s += (v[j].x * v[j].x + v[j].y * v[j].y) + (v[j].z * v[j].z + v[j].w * v[j].w); } \
            const float rstd = rsqrtf(wave_sum_f(s) * (1.f / D) + EPS); \
            f32x4* xw = (f32x4*)((dummy ? (float*)HB : out) + (size_t)(m_) * D) + ln10; \
            _Pragma("unroll") for (int j = 0; j < 4; ++j) __builtin_nontemporal_store(v[j] * rstd * gfin[j], xw + 64 * j); } while (0)
            P10_LOAD(0, mb);
            for (int i = 0; i < 8; i += 2) {
                P10_LOAD(1, mb + i + 1);
                P10_ROW(0, mb + i);
                if (i + 2 < 8) P10_LOAD(0, mb + i + 2);
                P10_ROW(1, mb + i + 1);
            }
#undef P10_LOAD
#undef P10_ROW
        }
    }
#undef IN
#undef BOTH
#undef GRID_BAR
}

constexpr int NPHASE = 11;
extern "C" void kernel_launch(void* const* d_in, const int* in_sizes, int n_in, void* d_out, int out_size, void* d_ws, size_t ws_size, hipStream_t stream) {
    static int grid = 0;
    if (grid == 0) {
        if (n_in != 25 || out_size != T * D || ws_size < WS_END) { fprintf(stderr, "kernel_launch: unexpected shapes (n_in %d out %d ws %zu need %zu)\n", n_in, out_size, ws_size, (size_t)WS_END); grid = -1; return; }
        int dev = 0, cus = 0;
        if (hipGetDevice(&dev) != hipSuccess || hipDeviceGetAttribute(&cus, hipDeviceAttributeMultiprocessorCount, dev) != hipSuccess) { grid = -1; return; }
        if (hipFuncSetAttribute((const void*)fwd, hipFuncAttributeMaxDynamicSharedMemorySize, LDS_BYTES) != hipSuccess) { fprintf(stderr, "kernel_launch: hipFuncSetAttribute failed\n"); grid = -1; return; }
        int per_cu = 0;
        if (hipOccupancyMaxActiveBlocksPerMultiprocessor(&per_cu, (const void*)fwd, NWAVES * 64, LDS_BYTES) != hipSuccess || per_cu < 1) { fprintf(stderr, "kernel_launch: occupancy query says %d\n", per_cu); }
        (void)hipGetLastError();
        grid = cus;
    }
    if (grid < 0) return;
    (void)in_sizes;
    if (hipMemsetAsync((char*)d_ws + WS_CTL, 0, CTL_ZERO_BYTES, stream) != hipSuccess) return;
    Args a{};
    for (int i = 0; i < 25; ++i) a.in[i] = d_in[i];
    a.out = (float*)d_out; a.ws = (unsigned char*)d_ws;
#if MK_ONE_LAUNCH
    a.ph_lo = 0; a.ph_hi = NPHASE;
    hipLaunchKernelGGL(fwd, dim3(grid), dim3(NWAVES * 64), LDS_BYTES, stream, a);
#else
    for (int p = 0; p < NPHASE; ++p) { a.ph_lo = p; a.ph_hi = p + 1; hipLaunchKernelGGL(fwd, dim3(grid), dim3(NWAVES * 64), LDS_BYTES, stream, a); }
#endif
}
```

```cpp
#include <hip/hip_runtime.h>
#include <cstdio>
#include <cstdint>
#include <type_traits>

#ifndef MK_ONE_LAUNCH
#ifndef CONV_A0
#define CONV_A0 30
#endif
#define MK_ONE_LAUNCH 1
#endif

#ifndef PROBE_DUP
#define PROBE_DUP -1
#endif
#ifndef ATT_TUNED_FOX
#define ATT_TUNED_FOX 1
#endif
#ifndef ATT_TUNED_MLA
#define ATT_TUNED_MLA 1
#endif
#ifndef PROBE_VAR
#define PROBE_VAR 0
#endif
#define GAS __attribute__((address_space(1)))
#define LAS __attribute__((address_space(3)))
typedef unsigned short bf16;
typedef short bf16x8 __attribute__((ext_vector_type(8)));
typedef short s16x4 __attribute__((ext_vector_type(4)));
typedef float f32x2 __attribute__((ext_vector_type(2)));
typedef float f32x4 __attribute__((ext_vector_type(4)));
typedef float f32x16 __attribute__((ext_vector_type(16)));
typedef unsigned u32x2 __attribute__((ext_vector_type(2)));
typedef unsigned u32x4 __attribute__((ext_vector_type(4)));
typedef GAS unsigned gu32;
typedef int v8i32_t __attribute__((ext_vector_type(8)));
typedef int v4i32_t __attribute__((ext_vector_type(4)));

constexpr int NB = 4, SEQ = 4096, T = NB * SEQ, D = 1024;
constexpr int NIN = 4096;
constexpr int QLORA = 256, KVLORA = 128, KVPAD = 256, ROPE = 32, NHEAD = 8, HD = 64, MQK = 96;
constexpr int NEXP = 64, TOPK = 6, DEXP = 256;
constexpr float EPS = 1e-6f;
constexpr float LOG2E = 1.4426950408889634f;
constexpr float C2F = 0.125f * LOG2E;
constexpr float C2M = 0.10206207261596577f * LOG2E;
constexpr int LISTCAP = T;
constexpr float HSCALE8 = 8.f;
constexpr float OSCALE8 = 8.f;
constexpr float WSCALE8 = 64.f;

constexpr size_t MiB = 1u << 20;
constexpr size_t WS_CTL = 0, CTL_ZERO_BYTES = 128 * 1024;
constexpr size_t WS_EIDX = 262144, WS_GATEW = 393216;
constexpr size_t WS_WIN = 1 * MiB, WS_WQ = 9 * MiB, WS_WKV = 9 * MiB + 512 * 1024, WS_WOM = 10 * MiB, WS_WOF = 11 * MiB, WS_WOUT = 12 * MiB;
constexpr size_t WS_WSGU = 14 * MiB, WS_WSD = 15 * MiB, WS_WR = 15 * MiB + 512 * 1024, WS_MOD = 15 * MiB + 640 * 1024;
constexpr size_t WS_WD = 16 * MiB;
constexpr size_t WS_HB = 48 * MiB;
constexpr size_t WS_FQ = 48 * MiB, WS_FK = 64 * MiB, WS_FV = 80 * MiB, WS_QLAT = 96 * MiB, WS_KVLAT = 104 * MiB;
constexpr size_t WS_OFOX = WS_FQ, WS_OMLA = WS_QLAT;
static_assert(WS_FK - WS_FQ == (size_t)T * 512 * 2 && WS_FV - WS_FK == (size_t)T * 512 * 2, "fq|fk|fv contiguous");
constexpr size_t WS_Y = 112 * MiB;
constexpr size_t WS_WGU = 112 * MiB;
constexpr size_t WS_H = 176 * MiB;
constexpr size_t WS_QMLA = WS_H;
constexpr size_t WS_GATES = 208 * MiB;
constexpr size_t WS_KN = 272 * MiB, WS_VM = 288 * MiB, WS_KPE = 304 * MiB;
constexpr size_t WS_MERGED = WS_KN;
constexpr size_t WS_LIST = 304 * MiB;
constexpr size_t WS_X1B = 240 * MiB;
constexpr size_t WS_H18 = 144 * MiB, WS_WG8 = 3 * MiB;
constexpr size_t WS_END = 306 * MiB;
constexpr size_t DO_MODP = 4 * MiB;
constexpr size_t DO_ROPE = 0, DO_LOGF = 2 * MiB, DO_CUMF = 2 * MiB + 512 * 1024, DO_SSQQ = 3 * MiB, DO_SSQKV = 3 * MiB + 256 * 1024;

constexpr int CW_TMO = 0;
constexpr int CW_BAR = 4096;
constexpr int CW_CNT = 8192;
constexpr int CW_KM = 12288;
constexpr int CW_RT = 16384;
constexpr int CW_Q = 12544;

constexpr int RING_BYTES = 131072;
constexpr int LDSCTL_OFF = RING_BYTES;
constexpr int MISC_OFF = LDSCTL_OFF + 320;
constexpr int MOETAB_OFF = LDSCTL_OFF + 1024;
constexpr int LDS_BYTES = 147456;

constexpr int NWAVES = 8;

#define LDS_WAIT() asm volatile("s_waitcnt lgkmcnt(0)" ::: "memory")
#define VM_WAIT() asm volatile("s_waitcnt vmcnt(0)" ::: "memory")
#define RLX_AGENT __ATOMIC_RELAXED, __HIP_MEMORY_SCOPE_AGENT
__device__ __forceinline__ unsigned f2bf(float f) { unsigned u = __builtin_bit_cast(unsigned, f); return (u + 0x7fffu + ((u >> 16) & 1u)) >> 16; }
__device__ __forceinline__ float bf2f(unsigned h) { return __builtin_bit_cast(float, h << 16); }
__device__ __forceinline__ unsigned pk2(float lo, float hi) { return f2bf(lo) | (f2bf(hi) << 16); }
__device__ __forceinline__ unsigned cvt_pk_bf16(float lo, float hi) { unsigned r; asm volatile("v_cvt_pk_bf16_f32 %0, %1, %2" : "=v"(r) : "v"(lo), "v"(hi)); return r; }
__device__ __forceinline__ u32x4 pack8(f32x4 a, f32x4 b) { u32x4 w; w.x = cvt_pk_bf16(a[0], a[1]); w.y = cvt_pk_bf16(a[2], a[3]); w.z = cvt_pk_bf16(b[0], b[1]); w.w = cvt_pk_bf16(b[2], b[3]); return w; }
__device__ __forceinline__ unsigned pack4u8(float a, float b, float c, float d) {
    const unsigned lo = __builtin_amdgcn_perm(__float_as_uint(b), __float_as_uint(a), 0x0c0c0400u), hi = __builtin_amdgcn_perm(__float_as_uint(d), __float_as_uint(c), 0x0c0c0400u);
    return __builtin_amdgcn_perm(hi, lo, 0x05040100u);
}
__device__ __forceinline__ float ub(unsigned w, int i) { return (float)((w >> (8 * i)) & 0xffu); }
__device__ __forceinline__ void unpack8(u32x4 w, f32x4& a, f32x4& b) {
    a = (f32x4){bf2f(w.x & 0xffffu), bf2f(w.x >> 16), bf2f(w.y & 0xffffu), bf2f(w.y >> 16)};
    b = (f32x4){bf2f(w.z & 0xffffu), bf2f(w.z >> 16), bf2f(w.w & 0xffffu), bf2f(w.w >> 16)};
}
__device__ __forceinline__ float wave_sum(float v) {
#pragma unroll
    for (int o = 1; o < 64; o <<= 1) v += __shfl_xor(v, o);
    return v;
}
__device__ __forceinline__ float wave_max(float v) {
#pragma unroll
    for (int o = 1; o < 64; o <<= 1) v = fmaxf(v, __shfl_xor(v, o));
    return v;
}
template <int CTRL> __device__ __forceinline__ float dppf(float v) { return __builtin_bit_cast(float, __builtin_amdgcn_update_dpp(0, __builtin_bit_cast(int, v), CTRL, 0xf, 0xf, true)); }
__device__ __forceinline__ float max8(float v) { v = fmaxf(v, dppf<0xB1>(v)); v = fmaxf(v, dppf<0x4E>(v)); v = fmaxf(v, dppf<0x141>(v)); return v; }
__device__ __forceinline__ float wave_max_f(float v) { v = max8(v); v = fmaxf(v, dppf<0x140>(v)); v = fmaxf(v, __shfl_xor(v, 16)); v = fmaxf(v, __shfl_xor(v, 32)); return v; }
__device__ __forceinline__ float wave_sum_f(float v) { v += dppf<0xB1>(v); v += dppf<0x4E>(v); v += dppf<0x141>(v); v += dppf<0x140>(v); v += __shfl_xor(v, 16); v += __shfl_xor(v, 32); return v; }
__device__ __forceinline__ float sigmoidf_(float x) { return __builtin_amdgcn_rcpf(1.f + __builtin_amdgcn_exp2f(-LOG2E * x)); }
__device__ __forceinline__ f32x4 rden4(f32x4 x, float k) { f32x4 t = x * k;
#pragma unroll
    for (int q = 0; q < 4; ++q) t[q] = __builtin_amdgcn_exp2f(t[q]);
    t = t + 1.f;
#pragma unroll
    for (int q = 0; q < 4; ++q) t[q] = __builtin_amdgcn_rcpf(t[q]);
    return t; }
__device__ __forceinline__ float siluf_(float x) { return x * __builtin_amdgcn_rcpf(1.f + __builtin_amdgcn_exp2f(-LOG2E * x)); }

namespace pg8 {
constexpr int BM = 256, BK = 64, HALF = 128, HTB = HALF * BK * 2, NXCD = 8, WGM = 8;
__host__ __device__ __forceinline__ int lds_byte(int r, int c) { const int st = (r >> 4) * 2 + (c >> 5), rr = r & 15, cc = c & 31, ob = rr * 64 + cc * 2; return st * 1024 + (ob ^ (((ob >> 9) & 1) << 5)); }
__host__ __device__ __forceinline__ void stage_rc(int b, int& R, int& C) { const int st = b / 1024, sb = b % 1024, swz = sb ^ (((sb >> 9) & 1) << 5); R = (st >> 1) * 16 + swz / 64; C = (st & 1) * 32 + (swz % 64) / 2; }
__host__ __device__ __forceinline__ int perm32(int rho) { const int n = rho >> 4, i = rho & 15; return 8 * (i >> 2) + 4 * n + (i & 3); }

struct Unit { int pm, pn, e, aux, n; };

struct StaticOrder {
    static constexpr bool GATHER = false;
    const char* A; const char* Bt; int K;
    int nM, nN, nwg, G, c;
    __device__ void init(const void* A_, const void* Bt_, int M, int N, int K_, int G_, int c_) { A = (const char*)A_; Bt = (const char*)Bt_; K = K_; nM = M / BM; nN = N / BM; nwg = nM * nN; G = G_; c = c_; }
    __device__ bool next(int i, Unit& u) const {
        const long L = (long)i * G + c; if (L >= nwg) return false;
        int wgid = (int)L; { const int q = nwg / NXCD, r = nwg % NXCD, xcd = wgid % NXCD, off = wgid / NXCD; wgid = (xcd < r ? xcd * (q + 1) : r * (q + 1) + (xcd - r) * q) + off; }
        const int nig = WGM * nN, gid = wgid / nig, fm = gid * WGM, gsz = (nM - fm) < WGM ? (nM - fm) : WGM;
        u.pm = fm + ((wgid % nig) % gsz); u.pn = (wgid % nig) / gsz; u.e = 0; u.aux = 0; u.n = BM; return true;
    }
    __device__ __forceinline__ const char* a_ptr(const Unit& u) const { return A + (size_t)u.pm * BM * K * 2; }
    __device__ __forceinline__ const char* b_ptr(const Unit& u) const { return Bt + (size_t)u.pn * BM * K * 2; }
    __device__ __forceinline__ unsigned a_row(const Unit&, int r) const { return (unsigned)r; }
};

template <class Epi, class Sched, bool ALIGN_EPI, bool FP8 = false>
__device__ __forceinline__ void gemm_phase(LAS unsigned char* lds, const Sched& S, const Epi& E) {
    int tid = threadIdx.x; asm volatile("" : "+v"(tid));
    const int wid = __builtin_amdgcn_readfirstlane(tid >> 6), lane = tid & 63, wr = wid >> 2, wc = wid & 3, fr = lane & 15, fq = lane >> 4;
    const int K = S.K, nt = K / BK;
    unsigned voffB[2], voffA[2];
#pragma unroll
    for (int i = 0; i < 2; ++i) { int R, C; stage_rc(tid * 16 + i * 8192, R, C); const int Rb = (R & ~31) + perm32(R & 31);
        voffA[i] = (unsigned)(R * K + C) * 2u; voffB[i] = (unsigned)(Rb * K + C) * 2u; }
    unsigned vA[2][2], vN[2][2];
    const size_t kstep = (size_t)(BK * 2);
    const size_t hstep = (size_t)HALF * K * 2;
    const unsigned ldsw = (unsigned)wid * 1024u;
    const int aoff = lds_byte(wr * 64 + fr, fq * 8), boff = lds_byte(wc * 32 + fr, fq * 8);
#define PG8_SA(b, h) (((b) * 2 + (h)) * HTB)
#define PG8_SB(b, h) ((4 + (b) * 2 + (h)) * HTB)
#define PG8_STAGE(bufoff, gbase, voff) do { _Pragma("unroll") for (int _i = 0; _i < 2; ++_i) \
        __builtin_amdgcn_global_load_lds((const unsigned*)((const char*)(gbase) + (voff)[_i]), (LAS unsigned*)(lds + (bufoff) + ldsw + _i * 8192), 16, 0, 0); } while (0)
#define PG8_STAGE_A(bufoff, gbase, h, nx) do { if constexpr (Sched::GATHER) { const unsigned vs_[2] = {(nx) ? vN[h][0] : vA[h][0], (nx) ? vN[h][1] : vA[h][1]}; PG8_STAGE(bufoff, gbase, vs_); }     \
        else PG8_STAGE(bufoff, (const char*)(gbase) + (h) * hstep, voffA); } while (0)
#define PG8_LDA(dst, b, h) do { _Pragma("unroll") for (int m = 0; m < 4; ++m) { if constexpr (FP8) { dst##8[m].lo = *(const LAS v4i32_t*)(lds + PG8_SA(b, h) + aoff + m * 2048); dst##8[m].hi = *(const LAS v4i32_t*)(lds + PG8_SA(b, h) + aoff + m * 2048 + 1024); } \
        else { _Pragma("unroll") for (int k = 0; k < 2; ++k) dst[m][k] = *(const LAS bf16x8*)(lds + PG8_SA(b, h) + aoff + m * 2048 + k * 1024); } } } while (0)
#define PG8_LDB(dst, b, h) do { _Pragma("unroll") for (int n = 0; n < 2; ++n) { if constexpr (FP8) { dst##8[n].lo = *(const LAS v4i32_t*)(lds + PG8_SB(b, h) + boff + n * 2048); dst##8[n].hi = *(const LAS v4i32_t*)(lds + PG8_SB(b, h) + boff + n * 2048 + 1024); } \
        else { _Pragma("unroll") for (int k = 0; k < 2; ++k) dst[n][k] = *(const LAS bf16x8*)(lds + PG8_SB(b, h) + boff + n * 2048 + k * 1024); } } } while (0)
#define PG8_MMA(ai, bj, At, Bt) do { __builtin_amdgcn_s_setprio(1); _Pragma("unroll") for (int m = 0; m < 4; ++m) _Pragma("unroll") for (int n = 0; n < 2; ++n) { \
        if constexpr (FP8) asm volatile("v_mfma_scale_f32_16x16x128_f8f6f4 %0, %1, %2, %0, %3, %3 op_sel_hi:[0,0,0]" : "+v"(acc[ai][bj][m][n]) : "v"(Bt##8[n]), "v"(At##8[m]), "v"(sc1_));     \
        else { _Pragma("unroll") for (int k = 0; k < 2; ++k) acc[ai][bj][m][n] = __builtin_amdgcn_mfma_f32_16x16x32_bf16(Bt[n][k], At[m][k], acc[ai][bj][m][n], 0, 0, 0); } } \
        __builtin_amdgcn_s_setprio(0); } while (0)
#define PG8_MMA0(ai, bj, At, Bt) do { __builtin_amdgcn_s_setprio(1); _Pragma("unroll") for (int m = 0; m < 4; ++m) _Pragma("unroll") for (int n = 0; n < 2; ++n) { \
        asm volatile("v_mfma_scale_f32_16x16x128_f8f6f4 %0, %1, %2, %4, %3, %3 op_sel_hi:[0,0,0]" : "=&v"(acc[ai][bj][m][n]) : "v"(Bt##8[n]), "v"(At##8[m]), "v"(sc1_), "v"(z4_)); }     \
        __builtin_amdgcn_s_setprio(0); } while (0)
#define PG8_WAIT_V(n) asm volatile("s_waitcnt vmcnt(" #n ")" ::: "memory")
#define PG8_WAIT_L(n) asm volatile("s_waitcnt lgkmcnt(" #n ")" ::: "memory")
#define PG8_BAR __builtin_amdgcn_s_barrier()
#define PG8_SCHED __builtin_amdgcn_sched_barrier(0)
#define PG8_SETV(dst, u) do { _Pragma("unroll") for (int _h = 0; _h < 2; ++_h) _Pragma("unroll") for (int _i = 0; _i < 2; ++_i) { int R_, C_; stage_rc(tid * 16 + _i * 8192, R_, C_); \
        dst[_h][_i] = (S.a_row(u, _h * HALF + R_) * (unsigned)K + (unsigned)C_) * 2u; } } while (0)
    Unit cur, nxt; int ui = 0;
    if (!S.next(0, cur)) return;
    f32x4 acc[2][2][4][2];
#define PG8_ZERO() do { _Pragma("unroll") for (int a = 0; a < 2; ++a) _Pragma("unroll") for (int b = 0; b < 2; ++b) _Pragma("unroll") for (int m = 0; m < 4; ++m) _Pragma("unroll") for (int n = 0; n < 2; ++n) { \
        if constexpr (!FP8) acc[a][b][m][n] = (f32x4){0.f, 0.f, 0.f, 0.f}; } } while (0)
    PG8_ZERO();
    unsigned sc1_ = 0x7f7f7f7fu; asm volatile("" : "+v"(sc1_));
    (void)sc1_;
    f32x4 z4_;
    asm volatile("v_mov_b32 %0, 0\n\tv_mov_b32 %1, 0\n\tv_mov_b32 %2, 0\n\tv_mov_b32 %3, 0" : "=v"(z4_[0]), "=v"(z4_[1]), "=v"(z4_[2]), "=v"(z4_[3])); (void)z4_;
    bf16x8 At[4][2], B0[2][2], B1[2][2];
    v8i32_t At8[4], B08[2], B18[2];
    (void)At; (void)B0; (void)B1; (void)At8; (void)B08; (void)B18;
    const char* cA = S.a_ptr(cur); const char* cB = S.b_ptr(cur);
    if constexpr (Sched::GATHER) { PG8_SETV(vA, cur); }
    PG8_STAGE(PG8_SB(0, 0), cB, voffB); PG8_STAGE(PG8_SB(0, 1), cB + hstep, voffB); PG8_STAGE_A(PG8_SA(0, 0), cA, 0, false); PG8_STAGE_A(PG8_SA(0, 1), cA, 1, false);
    if (wr == 1) PG8_BAR;
    PG8_WAIT_V(2); PG8_BAR;
    PG8_STAGE(PG8_SB(1, 0), cB + kstep, voffB); PG8_STAGE_A(PG8_SA(1, 0), cA + kstep, 0, false); PG8_STAGE(PG8_SB(1, 1), cB + hstep + kstep, voffB);
    PG8_WAIT_V(6); PG8_BAR;
    for (;;) {
        const bool has_next = S.next(ui + 1, nxt);
        const char* nA = has_next ? S.a_ptr(nxt) : cA; const char* nB = has_next ? S.b_ptr(nxt) : cB;
        if constexpr (Sched::GATHER) { if (has_next) { PG8_SETV(vN, nxt); } else {
#pragma unroll
            for (int h = 0; h < 2; ++h)
#pragma unroll
                for (int i = 0; i < 2; ++i) vN[h][i] = vA[h][i]; } }
#define PG8_KBODY(MMAF) do { \
            const bool last = (t == nt - 2); \
            if constexpr (Epi::MIDK) { if (t == nt / 2) E.mid(acc, cur, wr, wc, fr, fq); }        \
            const char* a1 = cA + (size_t)(t + 1) * kstep; \
            const char* a2 = last ? nA : cA + (size_t)(t + 2) * kstep; const char* b2 = last ? nB : cB + (size_t)(t + 2) * kstep; \
            const char* a3 = a2 + kstep; const char* b3 = b2 + kstep; \
              \
            PG8_LDB(B0, 0, 0); PG8_LDB(B1, 0, 1); PG8_SCHED; PG8_LDA(At, 0, 0); PG8_STAGE_A(PG8_SA(1, 1), a1, 1, false); \
            PG8_WAIT_V(8); PG8_WAIT_L(0); PG8_BAR; MMAF(0, 0, At, B0); MMAF(0, 1, At, B1); PG8_BAR; PG8_SCHED; \
              \
            PG8_LDA(At, 0, 1); PG8_STAGE(PG8_SB(0, 0), b2, voffB); PG8_STAGE(PG8_SB(0, 1), b2 + hstep, voffB); PG8_STAGE_A(PG8_SA(0, 0), a2, 0, last); \
            PG8_WAIT_V(8); PG8_WAIT_L(0); PG8_BAR; MMAF(1, 0, At, B0); MMAF(1, 1, At, B1); PG8_BAR; PG8_SCHED; \
              \
            PG8_LDB(B0, 1, 0); PG8_LDB(B1, 1, 1); PG8_SCHED; PG8_LDA(At, 1, 0); PG8_STAGE_A(PG8_SA(0, 1), a2, 1, last); \
            PG8_WAIT_V(8); PG8_WAIT_L(0); PG8_BAR; PG8_MMA(0, 0, At, B0); PG8_MMA(0, 1, At, B1); PG8_BAR; PG8_SCHED; \
              \
            PG8_LDA(At, 1, 1); PG8_STAGE(PG8_SB(1, 0), b3, voffB); PG8_STAGE(PG8_SB(1, 1), b3 + hstep, voffB); PG8_STAGE_A(PG8_SA(1, 0), a3, 0, last); \
            PG8_WAIT_V(8); PG8_WAIT_L(0); PG8_BAR; PG8_MMA(1, 0, At, B0); PG8_MMA(1, 1, At, B1); PG8_BAR; PG8_SCHED; \
        } while (0)
        if constexpr (FP8) { { const int t = 0; PG8_KBODY(PG8_MMA0); }
            for (int t = 2; t < nt; t += 2) PG8_KBODY(PG8_MMA); }
        else { for (int t = 0; t < nt; t += 2) PG8_KBODY(PG8_MMA); }
#undef PG8_KBODY
        if constexpr (ALIGN_EPI) { if (wr == 0) PG8_BAR; }
        if constexpr (FP8) { asm volatile("s_nop 15\n\ts_nop 7" ::: "memory"); __builtin_amdgcn_sched_barrier(0); }
        E(acc, cur, wr, wc, fr, fq);
        if (!has_next) break;
        PG8_ZERO();
        cur = nxt; cA = nA; cB = nB; ++ui;
        if constexpr (Sched::GATHER) {
#pragma unroll
            for (int h = 0; h < 2; ++h)
#pragma unroll
                for (int i = 0; i < 2; ++i) vA[h][i] = vN[h][i]; }
        if constexpr (ALIGN_EPI) { if (wr == 1) PG8_BAR; }
    }
    PG8_WAIT_V(0);
    if constexpr (!ALIGN_EPI) { if (wr == 0) PG8_BAR; }
    PG8_BAR;
#undef PG8_SA
#undef PG8_SB
#undef PG8_STAGE
#undef PG8_STAGE_A
#undef PG8_LDA
#undef PG8_LDB
#undef PG8_MMA
#undef PG8_MMA0
#undef PG8_ZERO
#undef PG8_WAIT_V
#undef PG8_WAIT_L
#undef PG8_BAR
#undef PG8_SCHED
#undef PG8_SETV
}
}
using pg8::Unit;

#define EPI_ROWS(ai, m) for (int ai = 0; ai < 2; ++ai) for (int m = 0; m < 4; ++m)

struct EpiInProj {
    static constexpr bool MIDK = false;
    bf16 *qlat, *kvlat, *kpe, *fq, *gates; float *logf, *ssqq, *ssqkv; const float* ropetab; const float* bforget; bool skip; int rowmul;
    static constexpr float asc = 1.f / WSCALE8;
    __device__ __forceinline__ void operator()(const f32x4 (&acc)[2][2][4][2], const Unit& u, int wr, int wc, int fr, int fq_) const {
        if (skip) return;
        const int pn = u.pn, row0 = u.pm * 256 + wr * 64 + fr, c0 = wc * 32 + 8 * fq_;
        if (pn >= 2) {
            bf16* dst = fq + (size_t)((pn - 2) >> 1) * ((size_t)T * 512) + (pn & 1) * 256 + c0; const float sc = ((pn < 4) ? C2F : 1.f) * asc;
#pragma unroll
            for (int ai = 0; ai < 2; ++ai)
#pragma unroll
                for (int m = 0; m < 4; ++m) { const int row = row0 + ai * 128 + m * 16;
#pragma unroll
                    for (int bj = 0; bj < 2; ++bj) *(u32x4*)(dst + (size_t)row * 512 + 128 * bj) = pack8(acc[ai][bj][m][0] * sc, acc[ai][bj][m][1] * sc); }
        } else if (pn == 0) {
#pragma unroll
            for (int ai = 0; ai < 2; ++ai)
#pragma unroll
                for (int m = 0; m < 4; ++m) { const int row = row0 + ai * 128 + m * 16; float s = 0.f;
#pragma unroll
                    for (int bj = 0; bj < 2; ++bj) { const f32x4 v0 = acc[ai][bj][m][0] * asc, v1 = acc[ai][bj][m][1] * asc;
                        s += (v0[0] * v0[0] + v0[1] * v0[1]) + (v0[2] * v0[2] + v0[3] * v0[3]) + (v1[0] * v1[0] + v1[1] * v1[1]) + (v1[2] * v1[2] + v1[3] * v1[3]);
                        *(u32x4*)(qlat + (size_t)row * QLORA + c0 + 128 * bj) = pack8(v0, v1); }
                    s += __shfl_xor(s, 16); s += __shfl_xor(s, 32);
                    if (fq_ == 0) ssqq[row * 4 + wc] = s; }
        } else {
#pragma unroll
            for (int ai = 0; ai < 2; ++ai)
#pragma unroll
                for (int m = 0; m < 4; ++m) { const int row = row0 + ai * 128 + m * 16;
                    { const f32x4 v0 = acc[ai][0][m][0] * asc, v1 = acc[ai][0][m][1] * asc;
                      float s = (v0[0] * v0[0] + v0[1] * v0[1]) + (v0[2] * v0[2] + v0[3] * v0[3]) + (v1[0] * v1[0] + v1[1] * v1[1]) + (v1[2] * v1[2] + v1[3] * v1[3]);
                      *(u32x4*)(kvlat + (size_t)row * KVPAD + c0) = pack8(v0, v1);
                      s += __shfl_xor(s, 16); s += __shfl_xor(s, 32);
                      if (fq_ == 0) ssqkv[row * 4 + wc] = s; }
                    { const f32x4 v0 = acc[ai][1][m][0] * asc, v1 = acc[ai][1][m][1] * asc;
                      *(u32x4*)(kvlat + (size_t)row * KVPAD + 128 + c0) = (u32x4){0u, 0u, 0u, 0u};
                      if (wc == 0) {
                          const f32x4* tb = (const f32x4*)(ropetab + ((size_t)row * 16 + 4 * fq_) * 2);
                          const f32x4 t0 = tb[0], t1 = tb[1];
                          f32x4 o1, o2;
                          o1[0] = v0[0] * t0[0] - v1[0] * t0[1]; o2[0] = v1[0] * t0[0] + v0[0] * t0[1];
                          o1[1] = v0[1] * t0[2] - v1[1] * t0[3]; o2[1] = v1[1] * t0[2] + v0[1] * t0[3];
                          o1[2] = v0[2] * t1[0] - v1[2] * t1[1]; o2[2] = v1[2] * t1[0] + v0[2] * t1[1];
                          o1[3] = v0[3] * t1[2] - v1[3] * t1[3]; o2[3] = v1[3] * t1[2] + v0[3] * t1[3];
                          *(u32x4*)(kpe + (size_t)row * ROPE + 8 * fq_) = pack8(o1, o2);
                      } else if (wc == 1 && fq_ == 0) {
                          f32x4 l0, l1;
#pragma unroll
                          for (int h = 0; h < 4; ++h) { const float z0 = v0[h] + bforget[h], z1 = v1[h] + bforget[4 + h];
                              l0[h] = -__builtin_amdgcn_logf(1.f + __builtin_amdgcn_exp2f(-LOG2E * z0)); l1[h] = -__builtin_amdgcn_logf(1.f + __builtin_amdgcn_exp2f(-LOG2E * z1)); }
                          *(f32x4*)(logf + (size_t)row * 8) = l0; *(f32x4*)(logf + (size_t)row * 8 + 4) = l1;
                      } }
                    asm volatile("" ::: "memory"); }
        }
        (void)rowmul;
    }
};

struct EpiGates8 {
    static constexpr bool MIDK = false;
    unsigned char* gates; float sc;
    __device__ __forceinline__ void operator()(const f32x4 (&acc)[2][2][4][2], const Unit& u, int wr, int wc, int fr, int fq_) const {
        const int row0 = u.pm * 256 + wr * 64 + fr;
        unsigned char* gp = gates + (size_t)u.pn * 256 + wc * 64 + fq_ * 16;
#pragma unroll
        for (int ai = 0; ai < 2; ++ai)
#pragma unroll
            for (int m = 0; m < 4; ++m) { const int row = row0 + ai * 128 + m * 16; u32x4 o;
#pragma unroll
                for (int bj = 0; bj < 2; ++bj) { const f32x4 v0 = rden4(acc[ai][bj][m][0], -LOG2E * sc) * 255.f + 8388608.f, v1 = rden4(acc[ai][bj][m][1], -LOG2E * sc) * 255.f + 8388608.f;
                    o[2 * bj] = pack4u8(v0[0], v0[1], v0[2], v0[3]); o[2 * bj + 1] = pack4u8(v1[0], v1[1], v1[2], v1[3]); }
                *(u32x4*)(gp + (size_t)row * 2048) = o; }
    }
};
struct EpiInProjAll {
    static constexpr bool MIDK = false;
    EpiInProj a; EpiGates8 g;
    __device__ __forceinline__ void operator()(const f32x4 (&acc)[2][2][4][2], const Unit& u, int wr, int wc, int fr, int fq_) const {
        if (u.pn >= 8) { Unit v = u; v.pn = u.pn - 8; g(acc, v, wr, wc, fr, fq_); } else a(acc, u, wr, wc, fr, fq_);
    }
};
struct EpiQup {
    static constexpr bool MIDK = false;
    bf16* q; const float* ssqq; const float* ropetab;
    __device__ __forceinline__ void operator()(const f32x4 (&acc)[2][2][4][2], const Unit& u, int wr, int wc, int fr, int fq_) const {
        const int row0 = u.pm * 256 + wr * 64 + fr, c0 = u.pn * 256 + wc * 32 + 8 * fq_;
#pragma unroll
        for (int ai = 0; ai < 2; ++ai)
#pragma unroll
            for (int m = 0; m < 4; ++m) {
                const int row = row0 + ai * 128 + m * 16;
                const f32x4 sq = *(const f32x4*)(ssqq + row * 4);
                const float rs = rsqrtf(((sq[0] + sq[1]) + (sq[2] + sq[3])) * (1.f / QLORA) + EPS) * C2M;
#pragma unroll
                for (int bj = 0; bj < 2; ++bj) {
                    const int col = c0 + 128 * bj, j = col % MQK;
                    f32x4 v0 = acc[ai][bj][m][0] * rs, v1 = acc[ai][bj][m][1] * rs;
                    if (j >= 64) { const int g = (j - 64) >> 3;
                        const f32x4* tb = (const f32x4*)(ropetab + ((size_t)row * 16 + 4 * g) * 2);
                        const f32x4 t0 = tb[0], t1 = tb[1];
                        f32x4 o1, o2;
                        o1[0] = v0[0] * t0[0] - v1[0] * t0[1]; o2[0] = v1[0] * t0[0] + v0[0] * t0[1];
                        o1[1] = v0[1] * t0[2] - v1[1] * t0[3]; o2[1] = v1[1] * t0[2] + v0[1] * t0[3];
                        o1[2] = v0[2] * t1[0] - v1[2] * t1[1]; o2[2] = v1[2] * t1[0] + v0[2] * t1[1];
                        o1[3] = v0[3] * t1[2] - v1[3] * t1[3]; o2[3] = v1[3] * t1[2] + v0[3] * t1[3];
                        v0 = o1; v1 = o2; }
                    *(u32x4*)(q + (size_t)row * 768 + col) = pack8(v0, v1);
                }
            }
    }
};

struct EpiKVup {
    static constexpr bool MIDK = false;
    bf16 *kn, *vm; const float* ssqkv;
    __device__ __forceinline__ void operator()(const f32x4 (&acc)[2][2][4][2], const Unit& u, int wr, int wc, int fr, int fq_) const {
        const int row0 = u.pm * 256 + wr * 64 + fr, c0 = u.pn * 256 + wc * 32 + 8 * fq_;
        bf16* dst = (u.pn < 2) ? kn : vm; const int cb = (u.pn & 1) * 256 + wc * 32 + 8 * fq_;
        (void)c0;
#pragma unroll
        for (int ai = 0; ai < 2; ++ai)
#pragma unroll
            for (int m = 0; m < 4; ++m) {
                const int row = row0 + ai * 128 + m * 16;
                const f32x4 sq = *(const f32x4*)(ssqkv + row * 4);
                const float rs = rsqrtf(((sq[0] + sq[1]) + (sq[2] + sq[3])) * (1.f / KVLORA) + EPS);
#pragma unroll
                for (int bj = 0; bj < 2; ++bj) *(u32x4*)(dst + (size_t)row * 512 + cb + 128 * bj) = pack8(acc[ai][bj][m][0] * rs, acc[ai][bj][m][1] * rs);
            }
    }
};

struct EpiPartA {
    static constexpr bool MIDK = false;
    float* part; const bf16* gates;
    __device__ __forceinline__ void operator()(const f32x4 (&acc)[2][2][4][2], const Unit& u, int wr, int wc, int fr, int fq_) const {
        const int row0 = u.pm * 256 + wr * 64 + fr, c0 = u.pn * 256 + wc * 32 + 8 * fq_;
#pragma unroll
        for (int ai = 0; ai < 2; ++ai)
#pragma unroll
            for (int m = 0; m < 4; ++m) {
                const int row = row0 + ai * 128 + m * 16;
#pragma unroll
                for (int bj = 0; bj < 2; ++bj) { const int col = c0 + 128 * bj;
                    f32x4 g0, g1; unpack8(*(const u32x4*)(gates + (size_t)row * 2048 + col), g0, g1);
                    *(f32x4*)(part + (size_t)row * D + col) = g0 * acc[ai][bj][m][0]; *(f32x4*)(part + (size_t)row * D + col + 4) = g1 * acc[ai][bj][m][1]; }
            }
    }
};
struct EpiMerged {
    static constexpr bool MIDK = false;
    const float* part; const bf16* gates; bf16* merged;
    __device__ __forceinline__ void operator()(const f32x4 (&acc)[2][2][4][2], const Unit& u, int wr, int wc, int fr, int fq_) const {
        const int row0 = u.pm * 256 + wr * 64 + fr, c0 = u.pn * 256 + wc * 32 + 8 * fq_;
#pragma unroll
        for (int ai = 0; ai < 2; ++ai)
#pragma unroll
            for (int m = 0; m < 4; ++m) {
                const int row = row0 + ai * 128 + m * 16;
#pragma unroll
                for (int bj = 0; bj < 2; ++bj) { const int col = c0 + 128 * bj;
                    f32x4 g0, g1; unpack8(*(const u32x4*)(gates + (size_t)row * 2048 + 1024 + col), g0, g1);
                    const f32x4 p0 = *(const f32x4*)(part + (size_t)row * D + col), p1 = *(const f32x4*)(part + (size_t)row * D + col + 4);
                    *(u32x4*)(merged + (size_t)row * D + col) = pack8(p0 + g0 * acc[ai][bj][m][0], p1 + g1 * acc[ai][bj][m][1]); }
            }
    }
};
struct EpiMergedCat {
    static constexpr bool MIDK = true;
    const unsigned char* gates; unsigned char* merged; float sc;
    __device__ __forceinline__ void mid(f32x4 (&acc)[2][2][4][2], const Unit& u, int wr, int wc, int fr, int fq_) const {
        int row0 = u.pm * 256 + wr * 64 + fr, c0 = u.pn * 256 + wc * 64 + fq_ * 16;
        asm volatile("" : "+v"(row0), "+v"(c0));
#pragma unroll
        for (int ai = 0; ai < 2; ++ai)
#pragma unroll
            for (int m = 0; m < 4; ++m) { const int row = row0 + ai * 128 + m * 16;
                const u32x4 ga = *(const u32x4*)(gates + (size_t)row * 2048 + c0), gb = *(const u32x4*)(gates + (size_t)row * 2048 + 1024 + c0);
#pragma unroll
                for (int bj = 0; bj < 2; ++bj)
#pragma unroll
                    for (int q = 0; q < 4; ++q) { acc[ai][bj][m][0][q] *= ub(ga[2 * bj], q) * __builtin_amdgcn_rcpf(fmaxf(ub(gb[2 * bj], q), 1.f)); acc[ai][bj][m][1][q] *= ub(ga[2 * bj + 1], q) * __builtin_amdgcn_rcpf(fmaxf(ub(gb[2 * bj + 1], q), 1.f)); }
                asm volatile("" ::: "memory"); }
    }
    __device__ __forceinline__ void operator()(const f32x4 (&acc)[2][2][4][2], const Unit& u, int wr, int wc, int fr, int fq_) const {
        const int row0 = u.pm * 256 + wr * 64 + fr, c0 = u.pn * 256 + wc * 32 + 8 * fq_, g0 = u.pn * 256 + wc * 64 + fq_ * 16;
#pragma unroll
        for (int ai = 0; ai < 2; ++ai)
#pragma unroll
            for (int m = 0; m < 4; ++m) { const int row = row0 + ai * 128 + m * 16;
                const u32x4 gb = *(const u32x4*)(gates + (size_t)row * 2048 + 1024 + g0);
#pragma unroll
                for (int bj = 0; bj < 2; ++bj) { const int col = c0 + 128 * bj;
                    f32x4 v0, v1;
#pragma unroll
                    for (int q = 0; q < 4; ++q) { v0[q] = fmaxf(ub(gb[2 * bj], q), 1.f) * acc[ai][bj][m][0][q] * sc; v1[q] = fmaxf(ub(gb[2 * bj + 1], q), 1.f) * acc[ai][bj][m][1][q] * sc; }
                    u32x2 o; int p_ = __builtin_amdgcn_cvt_pk_fp8_f32(v0[0], v0[1], 0, false); p_ = __builtin_amdgcn_cvt_pk_fp8_f32(v0[2], v0[3], p_, true); o.x = (unsigned)p_;
                    p_ = __builtin_amdgcn_cvt_pk_fp8_f32(v1[0], v1[1], 0, false); p_ = __builtin_amdgcn_cvt_pk_fp8_f32(v1[2], v1[3], p_, true); o.y = (unsigned)p_;
                    *(u32x2*)(merged + (size_t)row * D + col) = o; } }
    }
};
struct EpiOut {
    static constexpr bool MIDK = false;
    const float* x; bf16* x1; const float* mod; float* ssq1; float sc;
    __device__ __forceinline__ void operator()(const f32x4 (&acc)[2][2][4][2], const Unit& u, int wr, int wc, int fr, int fq_) const {
        const int row0 = u.pm * 256 + wr * 64 + fr, c0 = u.pn * 256 + wc * 32 + 8 * fq_;
        const float* gm = mod + (size_t)((u.pm * 256) / SEQ) * 6 * D + 2 * D;
        f32x4 g[2][2];
#pragma unroll
        for (int bj = 0; bj < 2; ++bj) { g[bj][0] = *(const f32x4*)(gm + c0 + 128 * bj) * sc; g[bj][1] = *(const f32x4*)(gm + c0 + 128 * bj + 4) * sc; }
#pragma unroll
        for (int ai = 0; ai < 2; ++ai)
#pragma unroll
            for (int m = 0; m < 4; ++m) { const int row = row0 + ai * 128 + m * 16; float sq = 0.f;
#pragma unroll
                for (int bj = 0; bj < 2; ++bj) { const int col = c0 + 128 * bj;
                    const f32x4 x0 = __builtin_nontemporal_load((const f32x4*)(x + (size_t)row * D + col)), x1v = __builtin_nontemporal_load((const f32x4*)(x + (size_t)row * D + col + 4));
                    f32x4 r0 = x0 + g[bj][0] * acc[ai][bj][m][0], r1 = x1v + g[bj][1] * acc[ai][bj][m][1];
                    const u32x4 pk_ = pack8(r0, r1); unpack8(pk_, r0, r1);
                    *(u32x4*)(x1 + (size_t)row * D + col) = pk_;
                    sq += (r0[0] * r0[0] + r0[1] * r0[1]) + (r0[2] * r0[2] + r0[3] * r0[3]) + (r1[0] * r1[0] + r1[1] * r1[1]) + (r1[2] * r1[2] + r1[3] * r1[3]); }
                sq += __shfl_xor(sq, 16); sq += __shfl_xor(sq, 32);
                if (fq_ == 0) ssq1[(size_t)row * 16 + 4 * u.pn + wc] = sq; }
    }
};
struct EpiHb {
    static constexpr bool MIDK = false;
    unsigned char* hb; float sc;
    __device__ __forceinline__ void operator()(const f32x4 (&acc)[2][2][4][2], const Unit& u, int wr, int wc, int fr, int fq_) const {
        const int row0 = u.pm * 256 + wr * 64 + fr, c0 = u.pn * 128 + wc * 32 + 8 * fq_;
#pragma unroll
        for (int ai = 0; ai < 2; ++ai)
#pragma unroll
            for (int m = 0; m < 4; ++m) { const int row = row0 + ai * 128 + m * 16;
                const f32x4 h0 = (acc[ai][0][m][0] * acc[ai][1][m][0]) * rden4(acc[ai][0][m][0], -LOG2E * sc) * (sc * sc * HSCALE8), h1 = (acc[ai][0][m][1] * acc[ai][1][m][1]) * rden4(acc[ai][0][m][1], -LOG2E * sc) * (sc * sc * HSCALE8);
                u32x2 o; int p_ = __builtin_amdgcn_cvt_pk_fp8_f32(h0[0], h0[1], 0, false); p_ = __builtin_amdgcn_cvt_pk_fp8_f32(h0[2], h0[3], p_, true); o.x = (unsigned)p_;
                p_ = __builtin_amdgcn_cvt_pk_fp8_f32(h1[0], h1[1], 0, false); p_ = __builtin_amdgcn_cvt_pk_fp8_f32(h1[2], h1[3], p_, true); o.y = (unsigned)p_;
                *(u32x2*)(hb + (size_t)row * DEXP + c0) = o; }
    }
};
struct EpiDown {
    static constexpr bool MIDK = false;
    bf16* Y; float* out; float* outw; const float* mod; const unsigned short* list; const unsigned char* eidx; const float* gatew;
    __device__ __forceinline__ void operator()(const f32x4 (&acc)[2][2][4][2], const Unit& u, int wr, int wc, int fr, int fq_) const {
        const int c0 = u.pn * 256 + wc * 32 + 8 * fq_;
#pragma unroll
        for (int ai = 0; ai < 2; ++ai)
#pragma unroll
            for (int m = 0; m < 4; ++m) {
                const int rl = wr * 64 + fr + ai * 128 + m * 16, idx = u.aux * 256 + rl;
                if (u.e == NEXP) {
                    const int t = idx; const float* gf = mod + (size_t)(t / SEQ) * 6 * D + 5 * D;
#pragma unroll
                    for (int bj = 0; bj < 2; ++bj) { const int col = c0 + 128 * bj; const float* o = out + (size_t)t * D + col; float* ow = outw + (size_t)t * D + col;
                        const f32x4 g0 = *(const f32x4*)(gf + col), g1 = *(const f32x4*)(gf + col + 4);
                        const f32x4 x0 = *(const f32x4*)o, x1v = *(const f32x4*)(o + 4);
                        *(f32x4*)ow = x0 + g0 * acc[ai][bj][m][0]; *(f32x4*)(ow + 4) = x1v + g1 * acc[ai][bj][m][1]; }
                } else if (idx < u.n) {
                    const int t = list[(size_t)u.e * LISTCAP + idx];
                    const u32x2 ev = *(const u32x2*)(eidx + (size_t)t * 8);
                    int k = 0;
#pragma unroll
                    for (int q = 1; q < TOPK; ++q) { const unsigned b = (q < 4) ? ((ev.x >> (8 * q)) & 0xffu) : ((ev.y >> (8 * (q - 4))) & 0xffu); if ((int)b == u.e) k = q; }
                    const float w = gatew[(size_t)t * 8 + k];
#pragma unroll
                    for (int bj = 0; bj < 2; ++bj) *(u32x4*)(Y + ((size_t)t * TOPK + k) * D + c0 + 128 * bj) = pack8(acc[ai][bj][m][0] * w, acc[ai][bj][m][1] * w);
                }
            }
    }
};

template <int NT, bool GATHER_>
struct MoeOrder {
    static constexpr bool GATHER = GATHER_;
    const char* A; const char* Bt; const char* Bsh; int K; size_t bstride;
    const unsigned short* list; volatile LAS int* tab;
    int G, c;
    __device__ bool next(int i, Unit& u) const {
        int ti, pn_;
        if ((G & 7) == 0) { const int x = c & 7, j = i * (G >> 3) + (c >> 3), TT = tab[65], tlo = (x * TT) >> 3, thi = ((x + 1) * TT) >> 3; ti = tlo + j / NT; pn_ = j % NT; if (ti >= thi) return false; }
        else { const int total = tab[65] * NT; const long L = (long)i * G + c; if (L >= total) return false; ti = (int)L / NT; pn_ = (int)L % NT; }
        u.pn = pn_; u.pm = ti;
        const int e = __builtin_amdgcn_readfirstlane(tab[132 + ti]);
        u.e = e; u.aux = __builtin_amdgcn_readfirstlane(ti - tab[e]); u.n = __builtin_amdgcn_readfirstlane(tab[66 + e]); return true;
    }
    __device__ __forceinline__ const char* a_ptr(const Unit& u) const { return GATHER ? A : A + (size_t)u.pm * 256 * K * 2; }
    __device__ __forceinline__ const char* b_ptr(const Unit& u) const { return (u.e == NEXP ? Bsh : Bt + (size_t)u.e * bstride) + (size_t)u.pn * 256 * K * 2; }
    __device__ __forceinline__ unsigned a_row(const Unit& u, int r) const {
        if (!GATHER) return (unsigned)r;
        const int idx = u.aux * 256 + r;
        if (u.e == NEXP) return (unsigned)idx;
        return (idx < u.n) ? (unsigned)list[(size_t)u.e * LISTCAP + idx] : 0u;
    }
};

struct UpOrder {
    static constexpr bool GATHER = false;
    const char* Aq; const char* Bq; const char* Akv; const char* Bkv; int K; int G, c;
    __device__ bool next(int i, Unit& u) const {
        int L = i * G + c; if (L >= 448) return false;
        if (L < 256) { u.e = 1; u.pm = L >> 2; u.pn = L & 3; } else { L -= 256; u.e = 0; u.pm = L / 3; u.pn = L % 3; }
        u.aux = 0; u.n = 256; return true; }
    __device__ __forceinline__ const char* a_ptr(const Unit& u) const { return (u.e ? Akv : Aq) + (size_t)u.pm * 256 * K * 2; }
    __device__ __forceinline__ const char* b_ptr(const Unit& u) const { return (u.e ? Bkv : Bq) + (size_t)u.pn * 256 * K * 2; }
    __device__ __forceinline__ unsigned a_row(const Unit&, int r) const { return (unsigned)r; }
};
struct EpiUp {
    static constexpr bool MIDK = false;
    EpiQup q; EpiKVup kv;
    __device__ __forceinline__ void operator()(const f32x4 (&acc)[2][2][4][2], const Unit& u, int wr, int wc, int fr, int fq_) const { if (u.e) kv(acc, u, wr, wc, fr, fq_); else q(acc, u, wr, wc, fr, fq_); }
};

struct SharedDownOrder {
    static constexpr bool GATHER = false;
    const char* A; const char* Bt; int K; int G, c;
    __device__ bool next(int i, Unit& u) const { const int L = i * G + c; if (L >= (T / 256) * 4) return false; u.pm = L >> 2; u.pn = L & 3; u.e = NEXP; u.aux = L >> 2; u.n = 256; return true; }
    __device__ __forceinline__ const char* a_ptr(const Unit& u) const { return A + (size_t)u.pm * 256 * K * 2; }
    __device__ __forceinline__ const char* b_ptr(const Unit& u) const { return Bt + (size_t)u.pn * 256 * K * 2; }
    __device__ __forceinline__ unsigned a_row(const Unit&, int r) const { return (unsigned)r; }
};

namespace att {
constexpr int KSLOT = 12288, VSLOT = 8192;
constexpr int L_K = 0, L_V = 3 * KSLOT, L_F = L_V + 2 * VSLOT, L_WS = L_F + 3 * 256, L_OST = L_WS + 2048, L_END = L_OST + 8 * 4096;
static_assert(L_END <= RING_BYTES, "attention LDS");
__device__ __forceinline__ int crow(int r, int hi) { return (r & 3) + 8 * (r >> 2) + 4 * hi; }
__device__ __forceinline__ float max3f(float a, float b, float c) { return fmaxf(fmaxf(a, b), c); }
__device__ __forceinline__ float rowmax(const f32x16& p0, const f32x16& p1) {
    float a = max3f(p0[0], p0[1], p1[0]), b = max3f(p0[2], p0[3], p1[1]); a = max3f(a, p1[2], p1[3]);
#pragma unroll
    for (int r = 4; r < 16; r += 4) { a = max3f(a, p0[r], p0[r + 1]); b = max3f(b, p0[r + 2], p0[r + 3]); a = max3f(a, p1[r], p1[r + 1]); b = max3f(b, p1[r + 2], p1[r + 3]); }
    const float m = fmaxf(a, b);
    auto rr = __builtin_amdgcn_permlane32_swap(__float_as_uint(m), __float_as_uint(m), false, false);
    return fmaxf(__uint_as_float(rr[0]), __uint_as_float(rr[1]));
}
__device__ __forceinline__ void cmask(f32x16& p0, f32x16& p1, int jb, int qrel, int hi) {
    const float NEG = -INFINITY; const int kb = 64 * jb + 4 * hi;
#pragma unroll
    for (int r = 0; r < 16; ++r) { const int kv = kb + (r & 3) + 8 * (r >> 2); if (kv > qrel) p0[r] = NEG; if (kv + 32 > qrel) p1[r] = NEG; }
}
__device__ __forceinline__ void pv(f32x16* o, int vb, bf16x8 pa0, bf16x8 pa1, bf16x8 pa2, bf16x8 pa3) {
#pragma unroll
    for (int d0 = 0; d0 < 2; ++d0) { s16x4 lo[4], hi[4];
#pragma unroll
        for (int ks = 0; ks < 4; ++ks) {
            asm volatile("ds_read_b64_tr_b16 %0,%1 offset:%c2" : "=&v"(lo[ks]) : "v"(vb), "i"(d0 * 4096 + ks * 1024) : "memory");
            asm volatile("ds_read_b64_tr_b16 %0,%1 offset:%c2" : "=&v"(hi[ks]) : "v"(vb), "i"(d0 * 4096 + ks * 1024 + 512) : "memory"); }
        asm volatile("s_waitcnt lgkmcnt(0)" ::: "memory"); __builtin_amdgcn_sched_barrier(0);
#define PK(k) (bf16x8){lo[k][0], lo[k][1], lo[k][2], lo[k][3], hi[k][0], hi[k][1], hi[k][2], hi[k][3]}
        o[d0] = __builtin_amdgcn_mfma_f32_32x32x16_bf16(pa0, PK(0), o[d0], 0, 0, 0);
        o[d0] = __builtin_amdgcn_mfma_f32_32x32x16_bf16(pa1, PK(1), o[d0], 0, 0, 0);
        o[d0] = __builtin_amdgcn_mfma_f32_32x32x16_bf16(pa2, PK(2), o[d0], 0, 0, 0);
        o[d0] = __builtin_amdgcn_mfma_f32_32x32x16_bf16(pa3, PK(3), o[d0], 0, 0, 0);
#undef PK
    }
}
__device__ __forceinline__ unsigned cvtpk_s(float lo, float hi) { return cvt_pk_bf16(lo, hi); }

template <int DQK, bool DECAY, int THRL>
__device__ __forceinline__ void attn_unit(int b, int h, int qb, const bf16* Q, int QP, const bf16* Kn, const bf16* Kpe, const bf16* V, const float* cumF, bf16* O, int OP, LAS unsigned char* lds) {
    constexpr int ND0 = DQK / 16;
    int tid = threadIdx.x; asm volatile("" : "+v"(tid));
    const int lane = tid & 63, r32 = lane & 31, hi = lane >> 5; const int wid = __builtin_amdgcn_readfirstlane(tid >> 6);
    const long rowbase = (long)b * SEQ; const int q0 = qb * 256;
    const bf16* Qw = Q + (rowbase + q0 + wid * 32) * QP + h * DQK;
    const bf16* Kh = Kn + rowbase * 512 + h * 64; const bf16* Vh = V + rowbase * 512 + h * 64;
    const bf16* Kp = Kpe + rowbase * ROPE;
    const float* Fh = DECAY ? cumF + ((size_t)b * NHEAD + h) * SEQ : nullptr;
    LAS float* wsf = (LAS float*)(lds + L_WS) + wid * 64;
    const bf16* ksrc0 = Kh + (long)lane * 512 + wid * 8;
    const bf16* ksrc1 = Kp + (long)lane * ROPE + (wid & 3) * 8;
    const bf16* vsrc = Vh + (long)(16 * (wid & 3) + (lane >> 2)) * 512 + (wid >> 2) * 32 + (lane & 3) * 8;
    const int NT = (q0 + 256) / 64;
#define ATT_DMA_K(i_, s) do { const int t_ = NT - 1 - (i_); \
        __builtin_amdgcn_global_load_lds((const unsigned*)(ksrc0 + (long)t_ * 64 * 512), (LAS unsigned*)(lds + L_K + (s) * KSLOT + wid * 1024), 16, 0, 0); \
        if (DQK == 96 && wid < 4) __builtin_amdgcn_global_load_lds((const unsigned*)(ksrc1 + (long)t_ * 64 * ROPE), (LAS unsigned*)(lds + L_K + (s) * KSLOT + (8 + wid) * 1024), 16, 0, 0); \
        if (DECAY && wid == 7) __builtin_amdgcn_global_load_lds((const unsigned*)(Fh + t_ * 64 + lane), (LAS unsigned*)(lds + L_F + (s) * 256), 4, 0, 0); } while (0)
#define ATT_DMA_V(i_, s) do { const int t_ = NT - 1 - (i_); \
        __builtin_amdgcn_global_load_lds((const unsigned*)(vsrc + (long)t_ * 64 * 512), (LAS unsigned*)(lds + L_V + (s) * VSLOT + wid * 1024), 16, 0, 0); } while (0)
    ATT_DMA_K(0, 0); ATT_DMA_V(0, 0); ATT_DMA_K(1, 1);
    bf16x8 qr[ND0];
#pragma unroll
    for (int d0 = 0; d0 < ND0; ++d0) qr[d0] = *(const bf16x8*)(Qw + (long)r32 * QP + d0 * 16 + hi * 8);
    float fq_l = 0.f; if (DECAY) fq_l = Fh[q0 + wid * 32 + r32];
    float mhat = 0.f, l_reg = 0.f; bool started = false; f32x16 o[2]; o[0] = f32x16{}; o[1] = f32x16{};
    const int qrel = wid * 32 + r32;
    const int vb0 = (int)(uintptr_t)(lds + L_V) + ((lane >> 4) & 1) * 32 + (lane & 3) * 8 + (4 * hi + ((lane & 15) >> 2)) * 64;
#define ATT_QK(P0, P1, ks_) do { const float base_ = fq_l - mhat; \
        if (DECAY) { const LAS f32x4* fk_ = (const LAS f32x4*)(lds + L_F + (ks_) * 256); \
            _Pragma("unroll") for (int g = 0; g < 4; ++g) { const f32x4 a_ = fk_[2 * g + hi], c_ = fk_[8 + 2 * g + hi]; \
                _Pragma("unroll") for (int q = 0; q < 4; ++q) { P0[4 * g + q] = base_ - a_[q]; P1[4 * g + q] = base_ - c_[q]; } } } \
        else { _Pragma("unroll") for (int r = 0; r < 16; ++r) { P0[r] = base_; P1[r] = base_; } } \
        const LAS unsigned char* kb_ = lds + L_K + (ks_) * KSLOT + hi * 1024 + r32 * 16; \
        _Pragma("unroll") for (int d0 = 0; d0 < ND0; ++d0) { \
            const bf16x8 b0_ = *(const LAS bf16x8*)(kb_ + d0 * 2048), b1_ = *(const LAS bf16x8*)(kb_ + d0 * 2048 + 512); \
            P0 = __builtin_amdgcn_mfma_f32_32x32x16_bf16(b0_, qr[d0], P0, 0, 0, 0); P1 = __builtin_amdgcn_mfma_f32_32x32x16_bf16(b1_, qr[d0], P1, 0, 0, 0); } } while (0)
    f32x16 p0, p1, n0, n1;
    int ks_cur = 0, ks_nxt = 1, ks_ld = 2;
    for (int i = 0; i < NT; ++i) {
        const int vs = i & 1;
        VM_WAIT(); __syncthreads();
        if (i + 2 < NT) ATT_DMA_K(i + 2, ks_ld);
        if (i + 1 < NT) ATT_DMA_V(i + 1, vs ^ 1);
        if (i == 0) ATT_QK(p0, p1, 0);
        if (i + 1 < NT) ATT_QK(n0, n1, ks_nxt);
        const int jb = 3 - i;
        if (jb >= 0) cmask(p0, p1, jb, qrel, hi);
        const float rm = rowmax(p0, p1);
        bool resc = false; float dl = 0.f; const bool was_started = started;
        if (jb >= 0) {
            const bool fin = rm > -INFINITY;
            dl = started ? fmaxf(rm, 0.f) : (fin ? rm : 0.f); started = started || fin; resc = true;
        } else if (__any(rm > (float)THRL)) { dl = fmaxf(rm, 0.f); resc = true; }
        if (resc) { mhat += dl;
#pragma unroll
            for (int r = 0; r < 16; ++r) { p0[r] -= dl; p1[r] -= dl; }
            if (i + 1 < NT) {
#pragma unroll
                for (int r = 0; r < 16; ++r) { n0[r] -= dl; n1[r] -= dl; } }
            const float f = was_started ? __builtin_amdgcn_exp2f(-dl) : 1.f; l_reg *= f; if (hi == 0) wsf[r32] = f; }
        float sacc = 0.f;
#pragma unroll
        for (int r = 0; r < 16; ++r) { p0[r] = __builtin_amdgcn_exp2f(p0[r]); p1[r] = __builtin_amdgcn_exp2f(p1[r]); sacc += p0[r] + p1[r]; }
        l_reg += sacc;
        if (resc) { LDS_WAIT();
#pragma unroll
            for (int d_ = 0; d_ < 2; ++d_)
#pragma unroll
                for (int r = 0; r < 16; ++r) o[d_][r] *= wsf[crow(r, hi)]; }
        u32x4 pw0, pw1, pw2, pw3;
        pw0 = (u32x4){cvtpk_s(p0[0], p0[1]), cvtpk_s(p0[2], p0[3]), cvtpk_s(p0[4], p0[5]), cvtpk_s(p0[6], p0[7])};
        pw1 = (u32x4){cvtpk_s(p0[8], p0[9]), cvtpk_s(p0[10], p0[11]), cvtpk_s(p0[12], p0[13]), cvtpk_s(p0[14], p0[15])};
        pw2 = (u32x4){cvtpk_s(p1[0], p1[1]), cvtpk_s(p1[2], p1[3]), cvtpk_s(p1[4], p1[5]), cvtpk_s(p1[6], p1[7])};
        pw3 = (u32x4){cvtpk_s(p1[8], p1[9]), cvtpk_s(p1[10], p1[11]), cvtpk_s(p1[12], p1[13]), cvtpk_s(p1[14], p1[15])};
        __builtin_amdgcn_sched_barrier(0);
        pv(o, vb0 + vs * VSLOT, __builtin_bit_cast(bf16x8, pw0), __builtin_bit_cast(bf16x8, pw1), __builtin_bit_cast(bf16x8, pw2), __builtin_bit_cast(bf16x8, pw3));
        p0 = n0; p1 = n1;
        { const int t_ = ks_cur; ks_cur = ks_nxt; ks_nxt = ks_ld; ks_ld = t_; }
    }
    { auto rr = __builtin_amdgcn_permlane32_swap(__float_as_uint(l_reg), __float_as_uint(l_reg), false, false); l_reg = __uint_as_float(rr[0]) + __uint_as_float(rr[1]); }
    if (hi == 0) wsf[32 + r32] = l_reg; LDS_WAIT();
    float rli[16];
#pragma unroll
    for (int r = 0; r < 16; ++r) rli[r] = __builtin_amdgcn_rcpf(wsf[32 + crow(r, hi)]);
    unsigned char* Ow = (unsigned char*)O + (rowbase + q0 + wid * 32) * OP + h * 64;
    { LAS unsigned char* stg = lds + L_OST + wid * 4096;
#pragma unroll
      for (int r = 0; r < 16; ++r) { const int orow = crow(r, hi);
#pragma unroll
          for (int d0 = 0; d0 < 2; ++d0) { const float ov = o[d0][r] * rli[r] * OSCALE8; stg[orow * 64 + d0 * 32 + r32] = (unsigned char)__builtin_amdgcn_cvt_pk_fp8_f32(ov, ov, 0, false); } }
      LDS_WAIT();
#pragma unroll
      for (int i = 0; i < 2; ++i) { const int row = i * 16 + (lane >> 2), ch = lane & 3; const u32x4 v = *(const LAS u32x4*)(stg + row * 64 + ch * 16); *(u32x4*)(Ow + (long)row * OP + ch * 16) = v; } }
    LDS_WAIT(); __syncthreads();
#undef ATT_DMA_K
#undef ATT_DMA_V
#undef ATT_QK
}

constexpr int T_KSLOT = 12288, T_VSLOT = 8192, T_NSLOT = 3;
constexpr int T_K = 0, T_V = T_NSLOT * T_KSLOT, T_F = T_V + T_NSLOT * T_VSLOT, T_WS = T_F + T_NSLOT * 256, T_OST = T_WS + 2048, T_END = T_OST + 8 * 4096;
static_assert(T_END <= RING_BYTES, "attention LDS (hand-interleaved unit)");
typedef __attribute__((address_space(3))) const char* lds_cptr;
typedef short v4i16_t __attribute__((ext_vector_type(4)));
__device__ __forceinline__ s16x4 vtr(lds_cptr p) { return __builtin_bit_cast(s16x4, __builtin_amdgcn_ds_read_tr16_b64_v4i16((__attribute__((address_space(3))) v4i16_t*)p)); }
__device__ __forceinline__ void kload2(bf16x8* kf, lds_cptr kp, int j) { kf[2 * j] = *(const __attribute__((address_space(3))) bf16x8*)(kp + j * 2048); kf[2 * j + 1] = *(const __attribute__((address_space(3))) bf16x8*)(kp + j * 2048 + 512); }
#define TW_BAR(N) asm volatile("s_waitcnt vmcnt(" #N ") lgkmcnt(0)\n\ts_barrier" ::: "memory")
#define TSB() __builtin_amdgcn_sched_barrier(0)

template <int DQK, bool DECAY, int THRL>
__device__ __forceinline__ void attn_unit_t(int b, int h, int qb, const bf16* Q, int QP, const bf16* Kn, const bf16* Kpe, const bf16* V, const float* cumF, float kmax2, bf16* O, int OP, LAS unsigned char* lds) {
    constexpr int ND0 = DQK / 16;
    constexpr bool INPL = DECAY || (DQK == 96);
    int tid = threadIdx.x; asm volatile("" : "+v"(tid));
    const int lane = tid & 63, r32 = lane & 31, hi = lane >> 5; const int wid = __builtin_amdgcn_readfirstlane(tid >> 6);
    const long rowbase = (long)b * SEQ; const int q0 = qb * 256;
    const bf16* Qw = Q + (rowbase + q0 + wid * 32) * QP + h * DQK;
    const bf16* Kh = Kn + rowbase * 512 + h * 64; const bf16* Vh = V + rowbase * 512 + h * 64;
    const bf16* Kp = Kpe + rowbase * ROPE;
    const float* Fh = DECAY ? cumF + ((size_t)b * NHEAD + h) * SEQ : nullptr;
    LAS float* wsf = (LAS float*)(lds + T_WS) + wid * 64;
    const bf16* ksrc0 = Kh + (long)lane * 512 + wid * 8;
    const bf16* ksrc1 = Kp + (long)lane * ROPE + (wid & 3) * 8;
    const bf16* vsrc = Vh + (long)(16 * (wid & 3) + (lane >> 2)) * 512 + (wid >> 2) * 32 + (lane & 3) * 8;
    const int NTS = (q0 + 256) / 64;
#define TDMA_K(i_, sk) do { const int t_ = NTS - 1 - (i_); \
        __builtin_amdgcn_global_load_lds((const unsigned*)(ksrc0 + (long)t_ * 64 * 512), (LAS unsigned*)(lds + T_K + (sk) * T_KSLOT + wid * 1024), 16, 0, 0); \
        if (DECAY) __builtin_amdgcn_global_load_lds((const unsigned*)(Fh + t_ * 64 + lane), (LAS unsigned*)(lds + T_F + (sk) * 256), 4, 0, 0); \
        else __builtin_amdgcn_global_load_lds((const unsigned*)(ksrc1 + (long)t_ * 64 * ROPE), (LAS unsigned*)(lds + T_K + (sk) * T_KSLOT + (8 + (wid & 3)) * 1024), 16, 0, 0); } while (0)
#define TDMA_V(i_, sv) do { const int t_ = NTS - 1 - (i_); \
        __builtin_amdgcn_global_load_lds((const unsigned*)(vsrc + (long)t_ * 64 * 512), (LAS unsigned*)(lds + T_V + (sv) * T_VSLOT + wid * 1024), 16, 0, 0); } while (0)
    TDMA_K(0, 0); TDMA_V(0, 0); TDMA_K(1, 1);
    bf16x8 qr[ND0];
#pragma unroll
    for (int d0 = 0; d0 < ND0; ++d0) qr[d0] = *(const bf16x8*)(Qw + (long)r32 * QP + d0 * 16 + hi * 8);
    float fq_l = 0.f; if (DECAY) fq_l = Fh[q0 + wid * 32 + r32];
    float ftile = 0.f; if (DECAY) ftile = Fh[(lane < NTS ? lane : NTS - 1) * 64 + 63];
    float mhat = 0.f, l_reg = 0.f; f32x16 o[2]; o[0] = f32x16{}; o[1] = f32x16{};
    f32x16 negm = f32x16{}; asm volatile("" : "+v"(negm));
    const int qrel = wid * 32 + r32, i0 = 3 - (wid >> 1);
    const lds_cptr shm3 = (lds_cptr)lds; const lds_cptr kp0 = shm3 + T_K + hi * 1024 + r32 * 16;
    const lds_cptr vp0 = shm3 + T_V + ((lane >> 4) & 1) * 32 + (lane & 3) * 8 + (4 * hi + ((lane & 15) >> 2)) * 64;
    const int vb0 = (int)(uintptr_t)(lds + T_V) + ((lane >> 4) & 1) * 32 + (lane & 3) * 8 + (4 * hi + ((lane & 15) >> 2)) * 64;
    bool resc = false;
    bf16x8 kf[2 * ND0];
    f32x16 pA0, pA1, pB0, pB1;
    int sl_prev = 0, sl_cur = 0, sl_next = 1;
#define TROT() do { sl_prev = sl_cur; sl_cur = sl_next; sl_next = (sl_next == T_NSLOT - 1) ? 0 : sl_next + 1; } while (0)
#define TBIAS(X0, X1, fs_) do { if (DECAY) { const float base_ = fq_l - mhat; const LAS f32x4* fk_ = (const LAS f32x4*)(lds + T_F + (fs_) * 256); \
        _Pragma("unroll") for (int g = 0; g < 4; ++g) { const f32x4 a_ = fk_[2 * g + hi], c_ = fk_[8 + 2 * g + hi]; \
            _Pragma("unroll") for (int q = 0; q < 4; ++q) { X0[4 * g + q] = base_ - a_[q]; X1[4 * g + q] = base_ - c_[q]; } } } \
        else if (INPL) { const float nm_ = -mhat; _Pragma("unroll") for (int r = 0; r < 16; ++r) { X0[r] = nm_; X1[r] = nm_; } } } while (0)
#define TCIN(X) (INPL ? X : negm)
#define TRESC() do { if (resc) { asm volatile("s_waitcnt lgkmcnt(0)" ::: "memory"); \
        _Pragma("unroll") for (int d_ = 0; d_ < 2; ++d_) _Pragma("unroll") for (int r = 0; r < 16; ++r) o[d_][r] *= wsf[crow(r, hi)]; } } while (0)
#define TDECIDE(C0, C1, i_) do { \
        float a_ = max3f(C0[0], C0[1], C1[0]), b_ = max3f(C0[2], C0[3], C1[1]); a_ = max3f(a_, C1[2], C1[3]); \
        _Pragma("unroll") for (int r = 4; r < 16; r += 4) { a_ = max3f(a_, C0[r], C0[r + 1]); b_ = max3f(b_, C0[r + 2], C0[r + 3]); a_ = max3f(a_, C1[r], C1[r + 1]); b_ = max3f(b_, C1[r + 2], C1[r + 3]); } \
        float rm_ = fmaxf(a_, b_); { auto rr_ = __builtin_amdgcn_permlane32_swap(__float_as_uint(rm_), __float_as_uint(rm_), false, false); rm_ = fmaxf(__uint_as_float(rr_[0]), __uint_as_float(rr_[1])); } \
        resc = false; \
        if ((i_) == i0) { const float dl_ = rm_; mhat += dl_; \
            _Pragma("unroll") for (int r = 0; r < 16; ++r) { C0[r] -= dl_; C1[r] -= dl_; } \
            if (!INPL) { _Pragma("unroll") for (int r = 0; r < 16; ++r) negm[r] = -mhat; asm volatile("" : "+v"(negm)); } } \
        else if (__builtin_expect(__any(rm_ > (float)THRL), 0)) { const float dl_ = fmaxf(rm_, 0.f); mhat += dl_; \
            _Pragma("unroll") for (int r = 0; r < 16; ++r) { C0[r] -= dl_; C1[r] -= dl_; } \
            if (!INPL) { _Pragma("unroll") for (int r = 0; r < 16; ++r) negm[r] = -mhat; asm volatile("" : "+v"(negm)); } \
            const float f_ = __builtin_amdgcn_exp2f(-dl_); l_reg *= f_; if (hi == 0) wsf[r32] = f_; resc = true; } } while (0)
    TDMA_K(2, 2);
    TW_BAR(5);
    int NT = NTS;
    if (DECAY) {
        const float bound = 2.f * __builtin_sqrtf(kmax2) * 1.0001f + 1.f + (Fh[q0] - ftile);
        const unsigned long long need = __ballot(lane < NTS && bound >= -40.f);
        const int tmin = need ? (int)__builtin_ctzll(need) : NTS - 1;
        NT = NTS - tmin; NT += NT & 1; if (NT < 8) NT = 8; if (NT > NTS) NT = NTS;
        NT = __builtin_amdgcn_readfirstlane(NT); }
    TBIAS(pA0, pA1, 0);
    { const lds_cptr kb = kp0;
#pragma unroll
      for (int d0 = 0; d0 < ND0; ++d0) { const bf16x8 b0 = *(const __attribute__((address_space(3))) bf16x8*)(kb + d0 * 2048), b1 = *(const __attribute__((address_space(3))) bf16x8*)(kb + d0 * 2048 + 512);
          if (d0 == 0) { pA0 = __builtin_amdgcn_mfma_f32_32x32x16_bf16(b0, qr[0], TCIN(pA0), 0, 0, 0); pA1 = __builtin_amdgcn_mfma_f32_32x32x16_bf16(b1, qr[0], TCIN(pA1), 0, 0, 0); }
          else { pA0 = __builtin_amdgcn_mfma_f32_32x32x16_bf16(b0, qr[d0], pA0, 0, 0, 0); pA1 = __builtin_amdgcn_mfma_f32_32x32x16_bf16(b1, qr[d0], pA1, 0, 0, 0); } } }
    cmask(pA0, pA1, 3, qrel, hi);
    TDECIDE(pA0, pA1, 0);
#pragma unroll
    for (int r = 0; r < 16; ++r) { pA0[r] = __builtin_amdgcn_exp2f(pA0[r]); pA1[r] = __builtin_amdgcn_exp2f(pA1[r]); }
    TW_BAR(0);
    TDMA_K(3, 0); TDMA_V(1, 1);
    TROT();
#pragma unroll
    for (int j = 0; j < ND0; ++j) kload2(kf, kp0 + sl_cur * T_KSLOT, j);
    TBIAS(pB0, pB1, sl_cur);
    TW_BAR(3);
    s16x4 vlo[8], vhi[8]; u32x4 pw0, pw1, pw2, pw3;
#define TPKW(P, B) cvt_pk_bf16(P[B], P[B + 1])
#define TPAF(k) __builtin_bit_cast(bf16x8, pw##k)
#define TVFR(i) (bf16x8){vlo[i][0], vlo[i][1], vlo[i][2], vlo[i][3], vhi[i][0], vhi[i][1], vhi[i][2], vhi[i][3]}
#define TPIN(x) asm volatile("" : "+v"(x))
#define TGAPA(MF, A0, A1, A2, A3, W0, W1, PW) do { MF; sacc += A0; sacc += A1; sacc += A2; sacc += A3; TPIN(sacc); W0; W1; TPIN(PW); TSB(); } while (0)
#define TEX(v) __builtin_amdgcn_exp2f(v)
#define TGAPB(MF, X, B) do { MF; X[B] = TEX(X[B]); X[B + 1] = TEX(X[B + 1]); X[B + 2] = TEX(X[B + 2]); X[B + 3] = TEX(X[B + 3]); TPIN(X); TSB(); } while (0)
#define TVRD(i) do { vlo[i] = vtr(vp_ + (((i) >> 2) * 4096 + ((i) & 3) * 1024)); vhi[i] = vtr(vp_ + (((i) >> 2) * 4096 + ((i) & 3) * 1024 + 512)); } while (0)
#define TKRD(G, j) do { if (G) { kload2(kf, kp0 + sl_next * T_KSLOT, j); TSB(); } } while (0)
#define TMF(a, b, c) __builtin_amdgcn_mfma_f32_32x32x16_bf16(a, b, c, 0, 0, 0)
#define TSTEP(C0, C1, P0, P1, i_, MJB, GK, GV, GL) do { TSB(); \
        const lds_cptr vp_ = vp0 + sl_prev * T_VSLOT; \
        TVRD(0); TSB(); float sacc = (P0[0] + P0[1]); \
        TGAPA(C0 = TMF(kf[0], qr[0], TCIN(C0)), P0[2], P0[3], P0[4], P0[5],     pw0[0] = TPKW(P0, 0), pw0[1] = TPKW(P0, 2), pw0); \
        TVRD(4); TSB(); TGAPA(C1 = TMF(kf[1], qr[0], TCIN(C1)), P0[6], P0[7], P0[8], P0[9],     pw0[2] = TPKW(P0, 4), pw0[3] = TPKW(P0, 6), pw0); \
        TVRD(1); TSB(); TGAPA(C0 = TMF(kf[2], qr[1], C0),   P0[10], P0[11], P0[12], P0[13], pw1[0] = TPKW(P0, 8), pw1[1] = TPKW(P0, 10), pw1); \
        TVRD(5); TSB(); TGAPA(C1 = TMF(kf[3], qr[1], C1),   P0[14], P0[15], P1[0], P1[1],   pw1[2] = TPKW(P0, 12), pw1[3] = TPKW(P0, 14), pw1); \
        TVRD(2); TSB(); TGAPA(C0 = TMF(kf[4], qr[2], C0),   P1[2], P1[3], P1[4], P1[5],     pw2[0] = TPKW(P1, 0), pw2[1] = TPKW(P1, 2), pw2); \
        TVRD(6); TSB(); TGAPA(C1 = TMF(kf[5], qr[2], C1),   P1[6], P1[7], P1[8], P1[9],     pw2[2] = TPKW(P1, 4), pw2[3] = TPKW(P1, 6), pw2); \
        TVRD(3); TSB(); TGAPA(C0 = TMF(kf[6], qr[3], C0),   P1[10], P1[11], P1[12], P1[13], pw3[0] = TPKW(P1, 8), pw3[1] = TPKW(P1, 10), pw3); \
        TVRD(7); TSB(); TGAPA(C1 = TMF(kf[7], qr[3], C1),   P1[14], P1[15], 0.f, 0.f,       pw3[2] = TPKW(P1, 12), pw3[3] = TPKW(P1, 14), pw3); \
        if (ND0 == 6) { C0 = TMF(kf[2 * ND0 - 4], qr[ND0 - 2], C0); C1 = TMF(kf[2 * ND0 - 3], qr[ND0 - 2], C1); C0 = TMF(kf[2 * ND0 - 2], qr[ND0 - 1], C0); C1 = TMF(kf[2 * ND0 - 1], qr[ND0 - 1], C1); TSB(); } \
        l_reg += sacc; \
        if (GK) { TDMA_K((i_) + 3, sl_cur); } if (GV) { TDMA_V((i_) + 1, sl_next); } \
        if ((MJB) >= 0) cmask(C0, C1, (MJB), qrel, hi); \
        TDECIDE(C0, C1, i_); \
        TSB(); \
        TGAPB(o[0] = TMF(TPAF(0), TVFR(0), o[0]), C0, 0); \
        TKRD(GL, 0); TGAPB(o[1] = TMF(TPAF(0), TVFR(4), o[1]), C0, 4); \
        TKRD(GL, 1); TGAPB(o[0] = TMF(TPAF(1), TVFR(1), o[0]), C0, 8); \
        TKRD(GL, 2); TGAPB(o[1] = TMF(TPAF(1), TVFR(5), o[1]), C0, 12); \
        TKRD(GL, 3); TGAPB(o[0] = TMF(TPAF(2), TVFR(2), o[0]), C1, 0); \
        if (ND0 == 6) { TKRD(GL, ND0 - 2); } TGAPB(o[1] = TMF(TPAF(2), TVFR(6), o[1]), C1, 4); \
        if (ND0 == 6) { TKRD(GL, ND0 - 1); } TGAPB(o[0] = TMF(TPAF(3), TVFR(3), o[0]), C1, 8); \
        TGAPB(o[1] = TMF(TPAF(3), TVFR(7), o[1]), C1, 12); \
        if (GL) { TBIAS(P0, P1, sl_next); } \
    } while (0)
#define TENDW(tt) do { if ((tt) + 3 < NT) { TW_BAR(3); } else if ((tt) + 2 < NT) { TW_BAR(1); } else { TW_BAR(0); } } while (0)
    TSTEP(pB0, pB1, pA0, pA1, 1, 2, (1 + 3 < NT), true, true); TENDW(1); TRESC(); TROT();
    TSTEP(pA0, pA1, pB0, pB1, 2, 1, (2 + 3 < NT), true, true); TENDW(2); TRESC(); TROT();
    {
        TSTEP(pB0, pB1, pA0, pA1, 3, 0, (3 + 3 < NT), true, true); TENDW(3); TRESC(); TROT();
        int i = 4;
        for (; i + 2 < NT; i += 2) {
            TSTEP(pA0, pA1, pB0, pB1, i, -1, (i + 3 < NT), true, true);                         TENDW(i);     TRESC(); TROT();
            TSTEP(pB0, pB1, pA0, pA1, i + 1, -1, (i + 4 < NT), (i + 2 < NT), (i + 2 < NT));     TENDW(i + 1); TRESC(); TROT();
        }
        TSTEP(pA0, pA1, pB0, pB1, NT - 2, -1, false, true, true); TENDW(NT - 2); TRESC(); TROT();
        TSTEP(pB0, pB1, pA0, pA1, NT - 1, -1, false, false, false); TRESC();
    }
    { float sacc = pB0[0] + pB0[1];
#pragma unroll
      for (int r = 2; r < 16; ++r) sacc += pB0[r];
#pragma unroll
      for (int r = 0; r < 16; ++r) sacc += pB1[r];
      l_reg += sacc;
      pw0 = (u32x4){TPKW(pB0, 0), TPKW(pB0, 2), TPKW(pB0, 4), TPKW(pB0, 6)}; pw1 = (u32x4){TPKW(pB0, 8), TPKW(pB0, 10), TPKW(pB0, 12), TPKW(pB0, 14)};
      pw2 = (u32x4){TPKW(pB1, 0), TPKW(pB1, 2), TPKW(pB1, 4), TPKW(pB1, 6)}; pw3 = (u32x4){TPKW(pB1, 8), TPKW(pB1, 10), TPKW(pB1, 12), TPKW(pB1, 14)};
      TSB(); pv(o, vb0 + sl_cur * T_VSLOT, TPAF(0), TPAF(1), TPAF(2), TPAF(3)); }
    { auto rr = __builtin_amdgcn_permlane32_swap(__float_as_uint(l_reg), __float_as_uint(l_reg), false, false); l_reg = __uint_as_float(rr[0]) + __uint_as_float(rr[1]); }
    if (hi == 0) wsf[32 + r32] = l_reg; asm volatile("s_waitcnt lgkmcnt(0)" ::: "memory");
    float rli[16];
#pragma unroll
    for (int r = 0; r < 16; ++r) rli[r] = __builtin_amdgcn_rcpf(wsf[32 + crow(r, hi)]);
    unsigned char* Ow = (unsigned char*)O + (rowbase + q0 + wid * 32) * OP + h * 64;
    { LAS unsigned char* stg = lds + T_OST + wid * 4096;
#pragma unroll
      for (int r = 0; r < 16; ++r) { const int orow = crow(r, hi);
#pragma unroll
          for (int d0 = 0; d0 < 2; ++d0) { const float ov = o[d0][r] * rli[r] * OSCALE8; stg[orow * 64 + d0 * 32 + r32] = (unsigned char)__builtin_amdgcn_cvt_pk_fp8_f32(ov, ov, 0, false); } }
      asm volatile("s_waitcnt lgkmcnt(0)" ::: "memory");
#pragma unroll
      for (int i = 0; i < 2; ++i) { const int row = i * 16 + (lane >> 2), ch = lane & 3; const u32x4 v = *(const LAS u32x4*)(stg + row * 64 + ch * 16); *(u32x4*)(Ow + (long)row * OP + ch * 16) = v; } }
    asm volatile("s_waitcnt lgkmcnt(0)\n\ts_barrier" ::: "memory");
#undef TDMA_K
#undef TDMA_V
#undef TROT
#undef TBIAS
#undef TCIN
#undef TRESC
#undef TDECIDE
#undef TPKW
#undef TPAF
#undef TVFR
#undef TPIN
#undef TGAPA
#undef TEX
#undef TGAPB
#undef TVRD
#undef TKRD
#undef TMF
#undef TSTEP
#undef TENDW
}
#undef TW_BAR
#undef TSB
}

namespace dn {
constexpr int CHB = 64 * 256;
constexpr int NSLOT = 8, AHEAD = 7;
__device__ __forceinline__ int nloc(int i) { return 16 * ((i >> 2) & 1) + (i & 3) + 4 * (i >> 3); }
template <bool NOTRAFFIC>
__device__ __forceinline__ void down_phase(LAS unsigned char* lds, const unsigned char* HBp, const unsigned char* Wd, const unsigned char* Wsd, volatile LAS int* tab, const u32x2* meta, unsigned char* Yp, unsigned char* trash, int G, int c) {
    int tid = threadIdx.x; asm volatile("" : "+v"(tid));
    const int wid = __builtin_amdgcn_readfirstlane(tid >> 6), lane = tid & 63, j = lane & 31, hi = lane >> 5;
    const int U = tab[65] * 8;
    const int u_lo = (int)(((long)c * U) / G), u_hi = (int)(((long)(c + 1) * U) / G);
    if (u_lo >= u_hi) return;
#define DN_DEC(u_, e_, hf_, ci_) do { e_ = __builtin_amdgcn_readfirstlane(tab[132 + ((u_) >> 3)]); const int ul_ = __builtin_amdgcn_readfirstlane((u_) - 8 * tab[e_]), nc_ = __builtin_amdgcn_readfirstlane(4 * (tab[e_ + 1] - tab[e_])); hf_ = (ul_ >= nc_) ? 1 : 0; ci_ = ul_ - hf_ * nc_; } while (0)
    unsigned dvo; { const int r_ = lane >> 3, f_ = ((r_ >> 1) & 3) << 1; dvo = (unsigned)(r_ * 256 + (((lane & 7) ^ f_) * 16)); }
    volatile LAS int* rowtab = (volatile LAS int*)(lds + NSLOT * CHB + 6144);
    for (int i = tid; i < u_hi - u_lo && i < 2048; i += 512) { const int uu = u_lo + i, e_ = tab[132 + (uu >> 3)], ul_ = uu - 8 * tab[e_], nc_ = 4 * (tab[e_ + 1] - tab[e_]), hf_ = (ul_ >= nc_) ? 1 : 0; rowtab[i] = tab[e_] * 256 + (ul_ - hf_ * nc_) * 64; }
    __syncthreads();
#define DN_DMA(u_, buf_) do { const unsigned char* gb_ = HBp + (size_t)__builtin_amdgcn_readfirstlane(rowtab[(u_) - u_lo]) * DEXP; \
        _Pragma("unroll") for (int i_ = 0; i_ < 2; ++i_) { const int q_ = wid * 2 + i_, kb_ = q_ >> 3, g_ = q_ & 7; \
            __builtin_amdgcn_global_load_lds((const unsigned*)(gb_ + (size_t)(8 * g_) * DEXP + kb_ * 128 + dvo), (LAS unsigned*)(lds + (buf_) * CHB + kb_ * 8192 + g_ * 1024), 16, 0, 0); } } while (0)
    int rowb[2], fx[2];
#pragma unroll
    for (int rt = 0; rt < 2; ++rt) { const int row = 32 * rt + j; rowb[rt] = (int)(uintptr_t)lds + row * 128; fx[rt] = (((row >> 1) & 3) << 1) * 16; }
    unsigned sc1 = 0x7f7f7f7fu; asm volatile("" : "+v"(sc1));
    f32x16 z16;
    asm volatile("v_mov_b32 %0, 0\n\tv_mov_b32 %1, 0\n\tv_mov_b32 %2, 0\n\tv_mov_b32 %3, 0\n\tv_mov_b32 %4, 0\n\tv_mov_b32 %5, 0\n\tv_mov_b32 %6, 0\n\tv_mov_b32 %7, 0\n\tv_mov_b32 %8, 0\n\tv_mov_b32 %9, 0\n\tv_mov_b32 %10, 0\n\tv_mov_b32 %11, 0\n\tv_mov_b32 %12, 0\n\tv_mov_b32 %13, 0\n\tv_mov_b32 %14, 0\n\tv_mov_b32 %15, 0"
        : "=v"(z16[0]), "=v"(z16[1]), "=v"(z16[2]), "=v"(z16[3]), "=v"(z16[4]), "=v"(z16[5]), "=v"(z16[6]), "=v"(z16[7]), "=v"(z16[8]), "=v"(z16[9]), "=v"(z16[10]), "=v"(z16[11]), "=v"(z16[12]), "=v"(z16[13]), "=v"(z16[14]), "=v"(z16[15]));
#pragma unroll
    for (int p = 0; p < AHEAD; ++p) { const int un = (u_lo + p < u_hi) ? u_lo + p : u_lo; DN_DMA(un, p); }
    if (wid >= 4) __builtin_amdgcn_s_barrier();
    int u = u_lo;
    while (u < u_hi) {
      int e, hf, ci0; DN_DEC(u, e, hf, ci0);
      const int nc = __builtin_amdgcn_readfirstlane(4 * (tab[e + 1] - tab[e])), ne = __builtin_amdgcn_readfirstlane(tab[66 + e]);
      const int ubase = __builtin_amdgcn_readfirstlane(8 * tab[e] + hf * nc);
      int seg_end = ubase + nc; seg_end = __builtin_amdgcn_readfirstlane(seg_end < u_hi ? seg_end : u_hi);
      v8i32_t wfr[2][4];
#pragma unroll
      for (int nt = 0; nt < 2; ++nt) { const unsigned char* wp = ((e == NEXP) ? Wsd : Wd + (size_t)e * D * DEXP) + (size_t)(512 * hf + 64 * wid + 32 * nt + nloc(j)) * DEXP + 32 * hi;
#pragma unroll
          for (int ks = 0; ks < 4; ++ks) { wfr[nt][ks].lo = *(const v4i32_t*)(wp + 64 * ks); wfr[nt][ks].hi = *(const v4i32_t*)(wp + 64 * ks + 16); } }
      bool first = true;
      for (; u < seg_end; ++u) {
        const int buf = (u - u_lo) & (NSLOT - 1); (void)ci0;
        const int cidx = u - ubase;
        u32x2 mt[2];
#pragma unroll
        for (int rt = 0; rt < 2; ++rt) { int pos = 64 * cidx + 32 * rt + j; const bool in = pos < ne; const int sp = pos; pos = (in && e != NEXP) ? pos : 0; const u32x2 m = meta[(size_t)(e == NEXP ? 0 : e) * LISTCAP + pos];
            mt[rt] = !in ? (u32x2){0xffffffffu, 0u} : (e == NEXP) ? (u32x2){(unsigned)(sp * (TOPK + 1) + TOPK), 0x3f800000u} : m; }
        if (first) { __builtin_amdgcn_s_waitcnt(0x0F70); first = false; }
        LDS_WAIT(); __builtin_amdgcn_s_barrier();
        { const int un = (u + AHEAD < u_hi) ? u + AHEAD : u; DN_DMA(un, (buf + AHEAD) & (NSLOT - 1)); }
        f32x16 acc[2][2];
        v8i32_t ha0, ha1, hb0, hb1;
        const int ad0 = rowb[0] + buf * CHB, ad1 = rowb[1] + buf * CHB;
#define DN_RDA(ks_) do { \
            asm volatile("ds_read_b128 v[192:195], %1 offset:%c2\n\tds_read_b128 v[196:199], %1 offset:%c3" : "={v[192:199]}"(ha0) : "v"(ad0 + ((64 * ((ks_) & 1) + 32 * hi) ^ fx[0])), "i"(((ks_) >> 1) * 8192), "i"(((ks_) >> 1) * 8192 + 16) : "memory"); \
            asm volatile("ds_read_b128 v[200:203], %1 offset:%c2\n\tds_read_b128 v[204:207], %1 offset:%c3" : "={v[200:207]}"(ha1) : "v"(ad1 + ((64 * ((ks_) & 1) + 32 * hi) ^ fx[1])), "i"(((ks_) >> 1) * 8192), "i"(((ks_) >> 1) * 8192 + 16) : "memory"); } while (0)
#define DN_RDB(ks_) do { \
            asm volatile("ds_read_b128 v[208:211], %1 offset:%c2\n\tds_read_b128 v[212:215], %1 offset:%c3" : "={v[208:215]}"(hb0) : "v"(ad0 + ((64 * ((ks_) & 1) + 32 * hi) ^ fx[0])), "i"(((ks_) >> 1) * 8192), "i"(((ks_) >> 1) * 8192 + 16) : "memory"); \
            asm volatile("ds_read_b128 v[216:219], %1 offset:%c2\n\tds_read_b128 v[220:223], %1 offset:%c3" : "={v[216:223]}"(hb1) : "v"(ad1 + ((64 * ((ks_) & 1) + 32 * hi) ^ fx[1])), "i"(((ks_) >> 1) * 8192), "i"(((ks_) >> 1) * 8192 + 16) : "memory"); } while (0)
#define DN_MFA(W_, ACC_, H_, REG_, WAIT_) asm volatile(WAIT_ "v_mfma_scale_f32_32x32x64_f8f6f4 %0, %1, %2, %0, %3, %3 op_sel_hi:[0,0,0]" : "+v"(ACC_) : "v"(W_), REG_(H_), "v"(sc1))
#define DN_MF0(W_, ACC_, H_, REG_, WAIT_) asm volatile(WAIT_ "v_mfma_scale_f32_32x32x64_f8f6f4 %0, %1, %2, %4, %3, %3 op_sel_hi:[0,0,0]" : "=&v"(ACC_) : "v"(W_), REG_(H_), "v"(sc1), "v"(z16))
#define DN_MF1(W_, ACC_, H_, REG_, WAIT_) do { if (ks == 0) { DN_MF0(W_, ACC_, H_, REG_, WAIT_); } else { DN_MFA(W_, ACC_, H_, REG_, WAIT_); } } while (0)
#define DN_MF(W_, ACC_, H_, REG_, WAIT_) DN_MFA(W_, ACC_, H_, REG_, WAIT_)
        DN_RDA(0);
#pragma unroll
        for (int ks = 0; ks < 4; ks += 2) {
            DN_RDB(ks + 1);
            DN_MF1(wfr[0][ks], acc[0][0], ha0, "{v[192:199]}", "s_waitcnt lgkmcnt(4)\n\t"); DN_MF1(wfr[1][ks], acc[0][1], ha0, "{v[192:199]}", "");
            DN_MF1(wfr[0][ks], acc[1][0], ha1, "{v[200:207]}", ""); DN_MF1(wfr[1][ks], acc[1][1], ha1, "{v[200:207]}", "");
            if (ks + 2 < 4) { DN_RDA(ks + 2);
                DN_MF(wfr[0][ks + 1], acc[0][0], hb0, "{v[208:215]}", "s_waitcnt lgkmcnt(4)\n\t"); }
            else { DN_MF(wfr[0][ks + 1], acc[0][0], hb0, "{v[208:215]}", "s_waitcnt lgkmcnt(0)\n\t"); }
            DN_MF(wfr[1][ks + 1], acc[0][1], hb0, "{v[208:215]}", "");
            DN_MF(wfr[0][ks + 1], acc[1][0], hb1, "{v[216:223]}", ""); DN_MF(wfr[1][ks + 1], acc[1][1], hb1, "{v[216:223]}", "");
        }
#undef DN_RDA
#undef DN_RDB
#undef DN_MF
#undef DN_MF0
#undef DN_MF1
#undef DN_MFA
        asm volatile("s_waitcnt vmcnt(48)" ::: "memory");
        __builtin_amdgcn_s_barrier();
        asm volatile("s_nop 15\n\ts_nop 7" : "+v"(acc[0][0]), "+v"(acc[0][1]), "+v"(acc[1][0]), "+v"(acc[1][1]) :: "memory");
        __builtin_amdgcn_sched_barrier(0);
        const int col0 = 512 * hf + 64 * wid + 16 * hi;
#pragma unroll
        for (int rt = 0; rt < 2; ++rt) { const bool ok = !NOTRAFFIC && mt[rt].x != 0xffffffffu; unsigned char* yd = ok ? Yp + (size_t)mt[rt].x * D : trash; const float w = ok ? __uint_as_float(mt[rt].y) * (1.f / (HSCALE8 * WSCALE8)) : 0.f;
#pragma unroll
            for (int nt = 0; nt < 2; ++nt) { u32x4 o;
#pragma unroll
                for (int q = 0; q < 4; ++q) { int v = __builtin_amdgcn_cvt_pk_fp8_f32(acc[rt][nt][4 * q] * w, acc[rt][nt][4 * q + 1] * w, 0, false);
                    v = __builtin_amdgcn_cvt_pk_fp8_f32(acc[rt][nt][4 * q + 2] * w, acc[rt][nt][4 * q + 3] * w, v, true); o[q] = (unsigned)v; }
                *(u32x4*)(yd + col0 + 32 * nt) = o; } }
      }
    }
    if (wid < 4) __builtin_amdgcn_s_barrier();
    VM_WAIT(); LDS_WAIT(); __builtin_amdgcn_s_barrier();
#undef DN_DMA
#undef DN_DEC
}
}

namespace up {
__device__ __forceinline__ int nloc(int i) { return 16 * ((i >> 2) & 1) + (i & 3) + 4 * (i >> 3); }
__device__ __forceinline__ void up_phase(LAS unsigned char* lds, const bf16* QL, const bf16* KVL, const bf16* Wq, const bf16* Wkv, const float* ssqq, const float* ssqkv, const float* ropetab,
                                         bf16* Qo, bf16* KNo, bf16* VMo, int G, int c) {
    int tid = threadIdx.x; asm volatile("" : "+v"(tid));
    const int wid = __builtin_amdgcn_readfirstlane(tid >> 6), lane = tid & 63, j = lane & 31, hi = lane >> 5;
    for (int grp = c; grp < T / 64; grp += G) {
        const int row0 = grp * 64;
        { const int r_ = lane >> 3, p_ = lane & 7;
#pragma unroll
          for (int i = 0; i < 6; ++i) { const int q_ = wid * 6 + i;
              const bool isq = q_ < 32; const int rem = isq ? q_ : q_ - 32, kb = rem >> 3, g = rem & 7, f_ = (4 * (g & 1) + (r_ >> 1)) & 7;
              __builtin_amdgcn_global_load_lds((const unsigned*)((isq ? QL : KVL) + (size_t)(row0 + 8 * g + r_) * 256 + kb * 64 + ((p_ ^ f_) * 8)), (LAS unsigned*)(lds + (isq ? 0 : 32768) + kb * 8192 + g * 1024), 16, 0, 0); } }
        float rsq[2], rskv[2];
#pragma unroll
        for (int rt = 0; rt < 2; ++rt) { const int row = row0 + 32 * rt + j; const f32x4 a = *(const f32x4*)(ssqq + (size_t)row * 4), b4 = *(const f32x4*)(ssqkv + (size_t)row * 4);
            rsq[rt] = rsqrtf(((a[0] + a[1]) + (a[2] + a[3])) * (1.f / QLORA) + EPS) * C2M; rskv[rt] = rsqrtf(((b4[0] + b4[1]) + (b4[2] + b4[3])) * (1.f / KVLORA) + EPS); }
        const unsigned lane16 = (unsigned)lane * 16u;
        bf16x8 wA[16];
#define UP_LOADW(WB_, Wp_, col_, KS_) do { const char* wb_ = (const char*)(Wp_) + (size_t)__builtin_amdgcn_readfirstlane((col_) >> 5) * (KS_) * 1024;     \
            _Pragma("unroll") for (int ks = 0; ks < (KS_); ++ks) wA[(WB_) + ks] = *(const bf16x8*)(wb_ + ks * 1024 + lane16); } while (0)
#define UP_STEP(WB_, ISQ_, col_, KS_) do { f32x16 acc[2]; acc[0] = f32x16{}; acc[1] = f32x16{}; \
            _Pragma("unroll") for (int ks = 0; ks < (KS_); ++ks) { bf16x8 af[2]; \
                _Pragma("unroll") for (int rt = 0; rt < 2; ++rt) { const int row = 32 * rt + j, cc = 2 * (ks & 3) + hi; \
                    af[rt] = *(const LAS bf16x8*)(lds + ((ISQ_) ? 0 : 32768) + (ks >> 2) * 8192 + row * 128 + ((cc ^ ((row >> 1) & 7)) * 16)); } \
                _Pragma("unroll") for (int rt = 0; rt < 2; ++rt) acc[rt] = __builtin_amdgcn_mfma_f32_32x32x16_bf16(wA[(WB_) + ks], af[rt], acc[rt], 0, 0, 0); } \
            _Pragma("unroll") for (int rt = 0; rt < 2; ++rt) { const int row = row0 + 32 * rt + j; const float r_s = (ISQ_) ? rsq[rt] : rskv[rt]; const int col = (col_) + 16 * hi; \
                float v[16]; _Pragma("unroll") for (int r = 0; r < 16; ++r) v[r] = acc[rt][r] * r_s; \
                bf16* dst; \
                if (ISQ_) { const int jh = col % MQK; \
                    if (jh >= 64) { const int g0 = (jh - 64) >> 3; const f32x4* tb = (const f32x4*)(ropetab + ((size_t)row * 16 + 4 * g0) * 2); \
                        _Pragma("unroll") for (int gg = 0; gg < 2; ++gg) { const f32x4 t0 = tb[2 * gg], t1 = tb[2 * gg + 1]; float* w_ = v + 8 * gg; \
                            const float cs[4] = {t0[0], t0[2], t1[0], t1[2]}, sn[4] = {t0[1], t0[3], t1[1], t1[3]}; \
                            _Pragma("unroll") for (int q = 0; q < 4; ++q) { const float x1 = w_[q], x2 = w_[4 + q]; w_[q] = x1 * cs[q] - x2 * sn[q]; w_[4 + q] = x2 * cs[q] + x1 * sn[q]; } } } \
                    dst = Qo + (size_t)row * 768 + col; } \
                else dst = (col >= 512 ? VMo + (col - 512) : KNo + col) + (size_t)row * 512; \
                *(u32x4*)dst = (u32x4){cvt_pk_bf16(v[0], v[1]), cvt_pk_bf16(v[2], v[3]), cvt_pk_bf16(v[4], v[5]), cvt_pk_bf16(v[6], v[7])}; \
                *(u32x4*)(dst + 8) = (u32x4){cvt_pk_bf16(v[8], v[9]), cvt_pk_bf16(v[10], v[11]), cvt_pk_bf16(v[12], v[13]), cvt_pk_bf16(v[14], v[15])}; } } while (0)
        const int cq = 96 * wid, ckv = 128 * wid;
#define UP_SB() __builtin_amdgcn_sched_barrier(0)
        UP_LOADW(0, Wq, cq, 16);
        VM_WAIT(); __syncthreads();
        UP_STEP(0, true, cq, 16);        UP_SB(); UP_LOADW(0, Wq, cq + 32, 16); UP_SB();
        UP_STEP(0, true, cq + 32, 16);   UP_SB(); UP_LOADW(0, Wq, cq + 64, 16); UP_SB();
        UP_STEP(0, true, cq + 64, 16);   UP_SB(); UP_LOADW(0, Wkv, ckv, 8); UP_LOADW(8, Wkv, ckv + 32, 8); UP_SB();
        UP_STEP(0, false, ckv, 8);       UP_SB(); UP_LOADW(0, Wkv, ckv + 64, 8); UP_SB();
        UP_STEP(8, false, ckv + 32, 8);  UP_SB(); UP_LOADW(8, Wkv, ckv + 96, 8); UP_SB();
        UP_STEP(0, false, ckv + 64, 8);  UP_SB();
        UP_STEP(8, false, ckv + 96, 8);
#undef UP_SB
#undef UP_LOADW
#undef UP_STEP
        __syncthreads();
    }
}
}

#define XB_TMO      128
#define XB_XCNT(j)  (256  + 64 * (j))
#define XB_XSUB(j)  (1280 + 64 * (j))
#define XB_XGEN(j)  (2304 + 64 * (j))
#define XB_TOP      3328
#define XB_TOPGEN   3392
#define XCD_BAR_WORDS 3456
#define XB_SPIN_CAP (1u << 18)
#define XB_MISM     192
__device__ __forceinline__ unsigned xb_ld(unsigned* p)              { return __hip_atomic_load(p, __ATOMIC_RELAXED, __HIP_MEMORY_SCOPE_AGENT); }
__device__ __forceinline__ unsigned xb_add(unsigned* p, unsigned v) { return __hip_atomic_fetch_add(p, v, __ATOMIC_RELAXED, __HIP_MEMORY_SCOPE_AGENT); }
__device__ __forceinline__ unsigned xb_xcc_id() { return (unsigned)__builtin_amdgcn_s_getreg((3 << 11) | 20) & 0xFu; }
#define XB_SPIN(cond, bar) do { unsigned _sp = 0; while (cond) { __builtin_amdgcn_s_sleep(1); \
    if ((++_sp & 255u) == 0u) { if (xb_ld(&(bar)[XB_TMO])) break; if (_sp > XB_SPIN_CAP) { atomicAdd(&(bar)[XB_TMO], 1u); break; } } } } while (0)
struct XcdBarrier { unsigned* bar; unsigned x; volatile LAS unsigned* st; };
__device__ __forceinline__ XcdBarrier xcd_barrier_post(unsigned* bar, volatile LAS unsigned* st) {
    XcdBarrier b; b.bar = bar; b.x = xb_xcc_id(); b.st = st;
    if (threadIdx.x == 0) { (void)__hip_atomic_fetch_or(&bar[XB_MISM + (blockIdx.x & 7u)], 1u << b.x, __ATOMIC_RELAXED, __HIP_MEMORY_SCOPE_AGENT); (void)xb_add(&bar[XB_XCNT(b.x)], 1u); }
    return b;
}
__device__ __forceinline__ void xcd_barrier_complete(unsigned* bar, unsigned x, unsigned& nloc, unsigned& nx) {
    const unsigned G = gridDim.x * gridDim.y * gridDim.z;
    unsigned sum, cnt, mine, sp = 0u;
    for (;;) {
        sum = 0u; cnt = 0u; mine = 0u;
#pragma unroll
        for (unsigned j = 0; j < 16; ++j) { const unsigned c = xb_ld(&bar[XB_XCNT(j)]); sum += c; cnt += (c > 0u) ? 1u : 0u; mine = (j == x) ? c : mine; }
        if (sum == G) break;
        __builtin_amdgcn_s_sleep(1);
        if ((++sp & 255u) == 0u) { if (xb_ld(&bar[XB_TMO])) break; if (sp > XB_SPIN_CAP) { atomicAdd(&bar[XB_TMO], 1u); break; } }
    }
    nloc = mine > 0u ? mine : 1u; nx = cnt > 0u ? cnt : 1u;
}
__device__ __forceinline__ void xcd_barrier(const XcdBarrier& b) {
    asm volatile("s_waitcnt vmcnt(0)" ::: "memory");
    __syncthreads();
    if (threadIdx.x == 0) {
        unsigned* bar = b.bar;
        __builtin_amdgcn_s_waitcnt(0);
        unsigned nloc = b.st[0], nx = b.st[1];
        if (nloc == 0u) { xcd_barrier_complete(bar, b.x, nloc, nx); b.st[0] = nloc; b.st[1] = nx; }
        unsigned xs_ = b.x; asm volatile("" : "+s"(xs_));
        const unsigned old = xb_add(&bar[XB_XSUB(xs_)], 1u);
        const unsigned gen = old / nloc;
        if (old + 1u == (gen + 1u) * nloc) {
            __builtin_amdgcn_fence(__ATOMIC_RELEASE, "agent");
            asm volatile("s_waitcnt vmcnt(0)" ::: "memory");
            const unsigned og = xb_add(&bar[XB_TOP], 1u);
            const unsigned tgt = (og / nx + 1u) * nx;
            if (og + 1u != tgt) XB_SPIN(xb_ld(&bar[XB_TOP]) < tgt, bar);
            __builtin_amdgcn_fence(__ATOMIC_ACQUIRE, "agent");
            asm volatile("s_waitcnt vmcnt(0)" ::: "memory");
        } else {
            const unsigned tgt = (gen + 1u) * nx;
            XB_SPIN(xb_ld(&bar[XB_TOP]) < tgt, bar);
            __builtin_amdgcn_fence(__ATOMIC_ACQUIRE, "agent");
            asm volatile("s_waitcnt vmcnt(0)" ::: "memory");
        }
    }
    __syncthreads();
}

struct Args { const void* in[25]; float* out; unsigned char* ws; int ph_lo, ph_hi; };

struct Frame {
    LAS unsigned char* lds;
    int tid, lane, wave, vcu, G;
};

template <class ColFn>
__device__ __forceinline__ void cvt_item(int ldw, int Ksrc, const float* kscale, bf16* WT, int Kd, LAS float* scr, int kb, int nb, int lane, ColFn colp) {
    const int k0 = 64 * kb, n0 = 32 * nb;
    const float* cp = colp(n0 + (lane & 31));
    float vv[32], sv[32];
#pragma unroll
    for (int i = 0; i < 32; ++i) { const int k = k0 + 2 * i + (lane >> 5);
        vv[i] = (cp != nullptr && k < Ksrc) ? cp[(size_t)k * ldw] : 0.f;
        sv[i] = (kscale != nullptr && k < Ksrc) ? kscale[k] : 1.f; }
#pragma unroll
    for (int i = 0; i < 32; ++i) scr[(2 * i + (lane >> 5)) * 33 + (lane & 31)] = vv[i] * sv[i];
    LDS_WAIT(); asm volatile("" ::: "memory");
    const int c = lane & 7;
#pragma unroll
    for (int j = 0; j < 4; ++j) { const int n = (lane >> 3) + 8 * j; const LAS float* s = scr + (8 * c) * 33 + n;
        u32x4 o; o.x = pk2(s[0 * 33], s[1 * 33]); o.y = pk2(s[2 * 33], s[3 * 33]); o.z = pk2(s[4 * 33], s[5 * 33]); o.w = pk2(s[6 * 33], s[7 * 33]);
        *(u32x4*)(WT + (size_t)(n0 + n) * Kd + k0 + 8 * c) = o; }
    LDS_WAIT(); asm volatile("" ::: "memory");
}
template <class ColFn>
__device__ __forceinline__ void cvt_item8(int ldw, int Ksrc, const float* kscale, unsigned char* WT, int Kd, float scale, LAS float* scr, int kb, int nb, int lane, ColFn colp) {
    const int k0 = 64 * kb, n0 = 32 * nb;
    const float* cp = colp(n0 + (lane & 31));
    float vv[32], sv[32];
#pragma unroll
    for (int i = 0; i < 32; ++i) { const int k = k0 + 2 * i + (lane >> 5);
        vv[i] = (cp != nullptr && k < Ksrc) ? cp[(size_t)k * ldw] : 0.f;
        sv[i] = (kscale != nullptr && k < Ksrc) ? kscale[k] : 1.f; }
#pragma unroll
    for (int i = 0; i < 32; ++i) scr[(2 * i + (lane >> 5)) * 33 + (lane & 31)] = vv[i] * sv[i];
    LDS_WAIT(); asm volatile("" ::: "memory");
    const int c = lane & 7;
#pragma unroll
    for (int j = 0; j < 4; ++j) { const int n = (lane >> 3) + 8 * j; const LAS float* s = scr + (8 * c) * 33 + n;
        u32x2 o; int p_ = __builtin_amdgcn_cvt_pk_fp8_f32(s[0 * 33] * scale, s[1 * 33] * scale, 0, false); p_ = __builtin_amdgcn_cvt_pk_fp8_f32(s[2 * 33] * scale, s[3 * 33] * scale, p_, true); o.x = (unsigned)p_;
        p_ = __builtin_amdgcn_cvt_pk_fp8_f32(s[4 * 33] * scale, s[5 * 33] * scale, 0, false); p_ = __builtin_amdgcn_cvt_pk_fp8_f32(s[6 * 33] * scale, s[7 * 33] * scale, p_, true); o.y = (unsigned)p_;
        *(u32x2*)(WT + (size_t)(n0 + n) * Kd + k0 + 8 * c) = o; }
    LDS_WAIT(); asm volatile("" ::: "memory");
}
__device__ __forceinline__ void cvt64_item(const float* src, int ldw, bf16* dst, int Kd, LAS unsigned char* scr, int lane) {
    f32x4 v[16];
    const float* sp = src + (size_t)(lane >> 4) * ldw + 4 * (lane & 15);
#pragma unroll
    for (int i = 0; i < 16; ++i) v[i] = __builtin_nontemporal_load((const f32x4*)(sp + (size_t)(4 * i) * ldw));
#pragma unroll
    for (int i = 0; i < 16; ++i) { const int k = 4 * i + (lane >> 4);
#pragma unroll
        for (int q = 0; q < 4; ++q) { const int n = 4 * (lane & 15) + q; *(LAS bf16*)(scr + n * 128 + (((k >> 3) ^ ((n >> 2) & 7)) << 4) + (k & 7) * 2) = (bf16)f2bf(v[i][q]); } }
    LDS_WAIT(); asm volatile("" ::: "memory");
#pragma unroll
    for (int j = 0; j < 8; ++j) { const int p = j * 64 + lane, n = p >> 3, c = p & 7;
        const u32x4 o = *(const LAS u32x4*)(scr + n * 128 + ((c ^ ((n >> 2) & 7)) << 4));
        __builtin_nontemporal_store(o, (u32x4*)(dst + (size_t)n * Kd + c * 8)); }
    LDS_WAIT(); asm volatile("" ::: "memory");
}
__device__ __forceinline__ void cvt64_item8(const float* src, int ldw, unsigned char* dst, int Kd8, LAS unsigned char* scr, int lane, float scale) {
    f32x4 v[16];
    const float* sp = src + (size_t)(16 * (lane >> 4)) * ldw + 4 * (lane & 15);
#pragma unroll
    for (int i = 0; i < 16; ++i) v[i] = __builtin_nontemporal_load((const f32x4*)(sp + (size_t)i * ldw));
#pragma unroll
    for (int q = 0; q < 4; ++q) { u32x4 o;
#pragma unroll
        for (int g = 0; g < 4; ++g) { int p_ = __builtin_amdgcn_cvt_pk_fp8_f32(v[4 * g][q] * scale, v[4 * g + 1][q] * scale, 0, false); p_ = __builtin_amdgcn_cvt_pk_fp8_f32(v[4 * g + 2][q] * scale, v[4 * g + 3][q] * scale, p_, true); o[g] = (unsigned)p_; }
        *(LAS u32x4*)(scr + (4 * (lane & 15) + q) * 80 + (lane >> 4) * 16) = o; }
    LDS_WAIT(); asm volatile("" ::: "memory");
#pragma unroll
    for (int j = 0; j < 4; ++j) { const int p = j * 64 + lane, n = p >> 2, c = p & 3;
        const u32x4 o = *(const LAS u32x4*)(scr + n * 80 + c * 16);
        __builtin_nontemporal_store(o, (u32x4*)(dst + (size_t)n * Kd8 + c * 16)); }
    LDS_WAIT(); asm volatile("" ::: "memory");
}
__device__ __forceinline__ void cvt128_item8(const float* src, int ldw, unsigned char* dst, int Kd8, LAS unsigned char* scr, int lane, float scale) {
    f32x4 v[32];
    const float* sp = src + (size_t)(32 * (lane >> 4)) * ldw + 4 * (lane & 15);
#pragma unroll
    for (int i = 0; i < 32; ++i) v[i] = __builtin_nontemporal_load((const f32x4*)(sp + (size_t)i * ldw));
#pragma unroll
    for (int q = 0; q < 4; ++q) {
#pragma unroll
        for (int hf = 0; hf < 2; ++hf) { u32x4 o;
#pragma unroll
            for (int g = 0; g < 4; ++g) { const int i0 = 16 * hf + 4 * g; int p_ = __builtin_amdgcn_cvt_pk_fp8_f32(v[i0][q] * scale, v[i0 + 1][q] * scale, 0, false); p_ = __builtin_amdgcn_cvt_pk_fp8_f32(v[i0 + 2][q] * scale, v[i0 + 3][q] * scale, p_, true); o[g] = (unsigned)p_; }
            *(LAS u32x4*)(scr + (4 * (lane & 15) + q) * 144 + (lane >> 4) * 32 + 16 * hf) = o; } }
    LDS_WAIT(); asm volatile("" ::: "memory");
#pragma unroll
    for (int j = 0; j < 8; ++j) { const int p = j * 64 + lane, n = p >> 3, c = p & 7;
        const u32x4 o = *(const LAS u32x4*)(scr + n * 144 + c * 16);
        __builtin_nontemporal_store(o, (u32x4*)(dst + (size_t)n * Kd8 + c * 16)); }
    LDS_WAIT(); asm volatile("" ::: "memory");
}
__device__ __forceinline__ int ropedim(int jj) { const int g = jj >> 3, u = jj & 7; return (u < 4) ? 4 * g + u : 16 + 4 * g + (u - 4); }

__device__ __forceinline__ void sincos_acc(float af, float& sn, float& cs) {
    const double a = (double)af; const double kq = __builtin_rint(a * 0.63661977236758134308);
    const double r = (a - kq * 1.57079632679489655800) - kq * 6.123233995736766036e-17;
    const double r2 = r * r;
    const double sp = r * (1.0 + r2 * (-1.66666666666666324348e-01 + r2 * (8.33333333332248946124e-03 + r2 * (-1.98412698298579493134e-04 + r2 * (2.75573137070700676789e-06 + r2 * (-2.50507602534068634195e-08 + r2 * 1.58969099521155010221e-10))))));
    const double cp = 1.0 + r2 * (-0.5 + r2 * (4.16666666666666019037e-02 + r2 * (-1.38888888888741095749e-03 + r2 * (2.48015872894767294178e-05 + r2 * (-2.75573143513906633035e-07 + r2 * (2.08757232129817482790e-09 + r2 * -1.13596475577881948265e-11))))));
    const int q = (int)((long long)kq & 3);
    const double s_ = (q == 0) ? sp : (q == 1) ? cp : (q == 2) ? -sp : -cp;
    const double c_ = (q == 0) ? cp : (q == 1) ? -sp : (q == 2) ? -cp : sp;
    sn = (float)s_; cs = (float)c_;
}

__global__ void __launch_bounds__(NWAVES * 64, 2) fwd(Args args) {
    extern __shared__ __attribute__((aligned(16))) unsigned char lds_raw[];
    Frame F;
    F.lds = (LAS unsigned char*)lds_raw;
    F.tid = threadIdx.x; F.lane = F.tid & 63; F.wave = __builtin_amdgcn_readfirstlane(F.tid >> 6);
    F.G = gridDim.x; { const int bx = blockIdx.x; F.vcu = (F.G % 8 == 0) ? (bx % 8) * (F.G / 8) + bx / 8 : bx; }
    volatile LAS unsigned* MISC = (volatile LAS unsigned*)(F.lds + MISC_OFF);
    unsigned char* ws = args.ws;
    gu32* ctl = (gu32*)(ws + WS_CTL);
#define X_IN ((const float*)AP->in[0])
#define cvec ((const float*)AP->in[1])
#define positions ((const int*)AP->in[2])
#define w_mod ((const float*)AP->in[3])
#define b_mod ((const float*)AP->in[4])
#define g_mix ((const float*)AP->in[5])
#define w_in ((const float*)AP->in[6])
#define b_forget ((const float*)AP->in[7])
#define g_q_lat ((const float*)AP->in[8])
#define w_q_up ((const float*)AP->in[9])
#define g_kv_lat ((const float*)AP->in[10])
#define w_kv_up ((const float*)AP->in[11])
#define w_o_mla ((const float*)AP->in[12])
#define w_o_fox ((const float*)AP->in[13])
#define w_out ((const float*)AP->in[14])
#define g_ffn ((const float*)AP->in[15])
#define w_router ((const float*)AP->in[16])
#define b_router ((const float*)AP->in[17])
#define w_exp_gate ((const float*)AP->in[18])
#define w_exp_up ((const float*)AP->in[19])
#define w_exp_down ((const float*)AP->in[20])
#define w_sh_gate ((const float*)AP->in[21])
#define w_sh_up ((const float*)AP->in[22])
#define w_sh_down ((const float*)AP->in[23])
#define g_final ((const float*)AP->in[24])
#define Win_t ((bf16*)(ws + WS_WIN))
#define Win8 ((unsigned char*)(ws + WS_WIN))
#define Wq_t ((bf16*)(ws + WS_WQ))
#define Wkv_t ((bf16*)(ws + WS_WKV))
#define Wom_t ((bf16*)(ws + WS_WOM))
#define Wof_t ((bf16*)(ws + WS_WOF))
#define Wout_t ((bf16*)(ws + WS_WOUT))
#define Wsgu_t ((bf16*)(ws + WS_WSGU))
#define Wsd_t ((bf16*)(ws + WS_WSD))
#define Wr_f ((bf16*)(ws + WS_WR))
#define mod ((float*)(ws + WS_MOD))
#define Wd_t ((bf16*)(ws + WS_WD))
#define Wgu_t ((bf16*)(ws + WS_WGU))
#define HB ((bf16*)(ws + WS_HB))
#define FQ ((bf16*)(ws + WS_FQ))
#define FK ((bf16*)(ws + WS_FK))
#define FV ((bf16*)(ws + WS_FV))
#define QLAT ((bf16*)(ws + WS_QLAT))
#define KVLAT ((bf16*)(ws + WS_KVLAT))
#define OFOX ((bf16*)(ws + WS_OFOX))
#define OCAT ((bf16*)((unsigned char*)out + 32 * MiB))
#define OMLA ((bf16*)(ws + WS_OMLA))
#define Y ((bf16*)(ws + WS_Y))
#define H ((bf16*)(ws + WS_H))
#define QMLA ((bf16*)(ws + WS_QMLA))
#define GATES ((bf16*)(ws + WS_GATES))
#define KN ((bf16*)(ws + WS_KN))
#define VM ((bf16*)(ws + WS_VM))
#define KPE ((bf16*)(ws + WS_KPE))
#define MERGED ((bf16*)(ws + WS_MERGED))
#define LIST ((unsigned short*)(ws + WS_LIST))
#define Wgu8 ((unsigned char*)(ws + WS_WGU))
#define Wsgu8 ((unsigned char*)(ws + WS_WSGU))
#define H18 ((unsigned char*)(ws + WS_H18))
#define Wg8 ((unsigned char*)(ws + WS_WG8))
#define H8 ((unsigned char*)(ws + WS_H))
#define META ((u32x2*)(ws + WS_WIN))
#define EIDX ((unsigned char*)(ws + WS_EIDX))
#define GATEW ((float*)(ws + WS_GATEW))
#define ROPETAB ((float*)((unsigned char*)out + DO_ROPE))
#define LOGF ((float*)((unsigned char*)out + DO_LOGF))
#define CUMF ((float*)((unsigned char*)out + DO_CUMF))
#define SSQQ ((float*)((unsigned char*)out + DO_SSQQ))
#define SSQKV ((float*)((unsigned char*)out + DO_SSQKV))
#define MODP ((float*)((unsigned char*)out + DO_MODP))
#define X1B ((bf16*)(ws + WS_X1B))
#define SSQ1 ((float*)(ws + WS_FQ))
    float* const out = args.out;
#define PHASE_ENV const __attribute__((address_space(4))) Args* AP; { auto kp_ = __builtin_amdgcn_kernarg_segment_ptr(); asm volatile("" : "+s"(kp_)); AP = (const __attribute__((address_space(4))) Args*)kp_; } \
    unsigned char* const ws = AP->ws; float* const out = AP->out; (void)ws; (void)out;
    for (int u = F.tid; u < (LDS_BYTES - LDSCTL_OFF) / 4; u += NWAVES * 64) ((LAS unsigned*)(F.lds + LDSCTL_OFF))[u] = 0u;
    __syncthreads();
    XcdBarrier bar; bar.bar = (unsigned*)(ctl + CW_BAR); bar.x = 0; bar.st = nullptr;
    if (MK_ONE_LAUNCH) bar = xcd_barrier_post((unsigned*)(ctl + CW_BAR), MISC + 8);
    const int lo = args.ph_lo, hi = args.ph_hi;
#define IN(k) (lo <= (k) && (k) < hi)
#define BOTH(k) (IN(k) && IN((k) + 1))
#define GRID_BAR() do { if (MK_ONE_LAUNCH) xcd_barrier(bar); } while (0)
#define RT_OK (MK_ONE_LAUNCH && F.G == 256 && PROBE_DUP == 0)
#define RT_LOCAL() ([&]() -> bool { unsigned f_ = MISC[12]; if (f_ == 0u) { bool ok_ = true; _Pragma("unroll") for (int k_ = 0; k_ < 8; ++k_) { const unsigned m_ = xb_ld(&bar.bar[XB_MISM + k_]); ok_ = ok_ && m_ != 0u && (m_ & (m_ - 1u)) == 0u; } f_ = ok_ ? 1u : 2u; MISC[12] = f_; } return f_ == 1u; }())
#define RT_POST(seam, idx) do { asm volatile("s_waitcnt vmcnt(0)" ::: "memory"); __syncthreads(); \
    if (threadIdx.x == 0) { if (!RT_LOCAL()) { __builtin_amdgcn_fence(__ATOMIC_RELEASE, "agent"); asm volatile("s_waitcnt vmcnt(0)" ::: "memory"); } \
        (void)xb_add((unsigned*)(ctl + CW_RT + 1024 * (seam) + 16 * (idx)), 1u); } } while (0)
#define RT_WAIT(seam, idx) do { if (threadIdx.x == 0) { unsigned* rc_ = (unsigned*)(ctl + CW_RT + 1024 * (seam) + 16 * (idx)); XB_SPIN(xb_ld(rc_) < 4u, bar.bar); \
    __builtin_amdgcn_fence(__ATOMIC_ACQUIRE, "agent"); asm volatile("s_waitcnt vmcnt(0)" ::: "memory"); } __syncthreads(); } while (0)
#define DUP_BAR() do { if (dummy) xcd_barrier(bar); } while (0)
    const int gw = F.vcu * NWAVES + F.wave, NGW = F.G * NWAVES;

    for (int rep = 0; rep < ((PROBE_DUP == 0) ? 2 : 1); ++rep) if (IN(0)) { PHASE_ENV const bool dummy = (PROBE_DUP == 0) && rep == 0; (void)dummy;
        if (!(dummy && (PROBE_VAR == 1 || PROBE_VAR == 4 || PROBE_VAR == 5))) {
            LAS float* cond = (LAS float*)F.lds;
            for (int i = F.tid; i < NB * D; i += NWAVES * 64) { const float c = cvec[i]; cond[i] = c / (1.f + __expf(-c)); }
            __syncthreads();
            for (int it = F.wave * F.G + F.vcu; it < 96 * 16; it += NWAVES * F.G) { const int cg = it % 96, kq = it / 96, col = cg * 64 + F.lane;
                float a4[4] = {0.f, 0.f, 0.f, 0.f};
                const float* wp = w_mod + (size_t)(64 * kq) * (6 * D) + col;
                float wv[64];
#pragma unroll
                for (int kk = 0; kk < 64; ++kk) wv[kk] = __builtin_nontemporal_load(wp + (size_t)kk * (6 * D));
#pragma unroll
                for (int kk = 0; kk < 64; ++kk) {
#pragma unroll
                    for (int b = 0; b < 4; ++b) a4[b] += wv[kk] * cond[b * D + 64 * kq + kk]; }
#pragma unroll
                for (int b = 0; b < 4; ++b) MODP[((size_t)kq * 4 + b) * (6 * D) + col] = a4[b]; }
            __syncthreads();
        }
        if (!(dummy && (PROBE_VAR == 1 || PROBE_VAR == 3 || PROBE_VAR == 5))) for (int i = gw * 64 + F.lane; i < T * 16; i += NGW * 64) { const int t = i >> 4, j = i & 15;
            const float invf = (((j >> 2) == 0) ? 1.f : ((j >> 2) == 1) ? 0.1f : ((j >> 2) == 2) ? 0.01f : 0.001f) * (((j & 3) == 0) ? 1.f : ((j & 3) == 1) ? 0.5623413251903491f : ((j & 3) == 2) ? 0.31622776601683794f : 0.17782794100389228f);
            const float ang = (float)positions[t] * invf; float sn, cs; sincos_acc(ang, sn, cs);
            *(f32x2*)(ROPETAB + (size_t)i * 2) = (f32x2){cs, sn}; }
        for (int o = gw * 64 + F.lane; o < NEXP * D; o += NGW * 64) { const int piece = o >> 3, kk = o & 7, ln = piece & 63, grp = piece >> 6, ntl = grp & 3, j = grp >> 2;
            const int n = ntl * 16 + (ln & 15), k = j * 32 + (ln >> 4) * 8 + kk; Wr_f[o] = (bf16)f2bf(w_router[(size_t)k * NEXP + n]); }
        {
            LAS unsigned char* scr8 = F.lds + 32768 + F.wave * 9216;
            constexpr int F_IN = 30 * 8, F_G8 = 32 * 8;
            if (!(dummy && PROBE_VAR >= 2)) for (int it = gw; it < F_IN + F_G8; it += NGW) {
                const float* srcp; unsigned char* dstp;
                if (it < F_IN) { int nb = it % 30; const int kb = it / 30; if (nb >= 6) nb += 2; const int n0 = 64 * nb;
                    const int src = (n0 < 384) ? n0 : 416 + (n0 - 512);
                    srcp = w_in + (size_t)(128 * kb) * 4008 + src; dstp = Win8 + (size_t)n0 * D + 128 * kb; }
                else { const int i2 = it - F_IN, nb = i2 & 31, kb = i2 >> 5;
                    srcp = w_in + (size_t)(128 * kb) * 4008 + 1960 + 64 * nb; dstp = Wg8 + (size_t)(64 * nb) * D + 128 * kb; }
                int lnF = F.lane; asm volatile("" : "+v"(lnF));
                cvt128_item8(srcp, 4008, dstp, D, scr8, lnF, WSCALE8);
            }
            LAS float* scr = (LAS float*)(F.lds + 32768 + F.wave * 9216);
            constexpr int I_INS = 4 * (D / 64), NSLOW = I_INS;
            if (!(dummy && (PROBE_VAR == 1 || PROBE_VAR == 3 || PROBE_VAR == 4))) for (int it = F.wave * F.G + F.vcu; it < NSLOW; it += NGW) {
                const int nb = 12 + (it & 3), kb = it >> 2;
                int lnS = F.lane; asm volatile("" : "+v"(lnS));
                cvt_item8(4008, D, nullptr, Win8, D, WSCALE8, scr, kb, nb, lnS, [&](int n) -> const float* {
                    int src; if (n < 416) src = 384 + ropedim(n - 384); else if (n < 424) src = 1952 + (n - 416); else src = -1;
                    return src < 0 ? nullptr : w_in + src; });
            }
            if (!(dummy && (PROBE_VAR == 1 || PROBE_VAR == 3 || PROBE_VAR == 4))) {
                for (int o = gw * 64 + F.lane; o < 768 * QLORA; o += NGW * 64) { const int cb = o >> 13, rem = o & 8191, ks = rem >> 9, ln = (rem >> 3) & 63, e = rem & 7;
                    const int n = cb * 32 + up::nloc(ln & 31), k = 16 * ks + 8 * (ln >> 5) + e, hh = n / MQK, jj = n % MQK, sc = hh * MQK + (jj < 64 ? jj : 64 + ropedim(jj - 64));
                    Wq_t[o] = (bf16)f2bf(w_q_up[(size_t)k * 768 + sc] * g_q_lat[k]); }
                for (int o = gw * 64 + F.lane; o < 1024 * KVLORA; o += NGW * 64) { const int cb = o >> 12, rem = o & 4095, ks = rem >> 9, ln = (rem >> 3) & 63, e = rem & 7;
                    const int n = cb * 32 + up::nloc(ln & 31), k = 16 * ks + 8 * (ln >> 5) + e, sc = (n < 512) ? (n >> 6) * 128 + (n & 63) : ((n - 512) >> 6) * 128 + 64 + (n & 63);
                    Wkv_t[o] = (bf16)f2bf(w_kv_up[(size_t)k * 1024 + sc] * g_kv_lat[k]); }
            }
        }
        if (BOTH(0)) GRID_BAR();
    }

    for (int rep = 0; rep < ((PROBE_DUP == 1) ? 2 : 1); ++rep) if (IN(1)) { PHASE_ENV const bool dummy = (PROBE_DUP == 1) && rep == 0; (void)dummy;
        if (F.vcu < 48) { const int idx = F.vcu * 512 + F.tid, b = idx / (6 * D), col = idx % (6 * D); float sm = b_mod[col];
#pragma unroll
            for (int p = 0; p < 16; ++p) sm += MODP[((size_t)p * 4 + b) * (6 * D) + col];
            mod[idx] = sm; }
        int ln1 = F.lane; asm volatile("" : "+v"(ln1));
        LAS float* vg1 = (LAS float*)F.lds; LAS float* vs1 = (LAS float*)(F.lds + 4096);
        for (int grp = F.vcu; grp < T / 64; grp += F.G) {
            const int b = (grp * 64) / SEQ;
            __syncthreads();
            for (int k = F.tid; k < D; k += NWAVES * 64) { float s0 = b_mod[k], s1 = b_mod[D + k];
#pragma unroll
                for (int p = 0; p < 16; ++p) { s0 += MODP[((size_t)p * 4 + b) * (6 * D) + k]; s1 += MODP[((size_t)p * 4 + b) * (6 * D) + D + k]; }
                vs1[k] = s0; vg1[k] = g_mix[k] * (1.f + s1); }
            __syncthreads();
#pragma unroll 2
            for (int rr = 0; rr < 8; ++rr) { const int m = grp * 64 + F.wave * 8 + rr;
                const f32x4* xr = (const f32x4*)(X_IN + (size_t)m * D) + ln1;
                f32x4 v[4]; float s = 0.f;
#pragma unroll
                for (int j = 0; j < 4; ++j) { v[j] = __builtin_nontemporal_load(xr + 64 * j); s += (v[j].x * v[j].x + v[j].y * v[j].y) + (v[j].z * v[j].z + v[j].w * v[j].w); }
                const float rstd = rsqrtf(wave_sum(s) * (1.f / D) + EPS);
#pragma unroll
                for (int j = 0; j < 4; ++j) { const int c = 4 * ln1 + 256 * j;
                    const f32x4 g = *(const LAS f32x4*)(vg1 + c), d = *(const LAS f32x4*)(vs1 + c);
                    const f32x4 r = v[j] * rstd * g + d;
                    { int p_ = __builtin_amdgcn_cvt_pk_fp8_f32(r.x, r.y, 0, false); p_ = __builtin_amdgcn_cvt_pk_fp8_f32(r.z, r.w, p_, true); *(int*)(H18 + (size_t)m * D + c) = p_; } } }
        }
        if (BOTH(1)) GRID_BAR();
    }

    for (int rep = 0; rep < ((PROBE_DUP == 2) ? 2 : 1); ++rep) if (IN(2)) { PHASE_ENV const bool dummy = (PROBE_DUP == 2) && rep == 0; (void)dummy;
        { pg8::StaticOrder S; S.init(H18, Win8, T, NIN, D / 2, F.G, (int)blockIdx.x);
          EpiInProjAll E{EpiInProj{QLAT, KVLAT, KPE, FQ, GATES, LOGF, SSQQ, SSQKV, ROPETAB, b_forget, dummy && (PROBE_VAR == 1), (dummy && PROBE_VAR == 2) ? 0 : (dummy && PROBE_VAR == 3) ? 2 : 1}, EpiGates8{(unsigned char*)GATES, 1.f / WSCALE8}};
          pg8::gemm_phase<EpiInProjAll, pg8::StaticOrder, true, true>(F.lds, S, E); }
        if (BOTH(2)) GRID_BAR();
    }

    for (int rep = 0; rep < ((PROBE_DUP == 3) ? 2 : 1); ++rep) if (IN(3)) { PHASE_ENV const bool dummy = (PROBE_DUP == 3) && rep == 0; (void)dummy;
        float cv[8];
#pragma unroll
        for (int i = 0; i < 8; ++i) cv[i] = 0.f;
        if (F.vcu < NB * NHEAD) { const float* src = LOGF + ((size_t)(F.vcu >> 3) * SEQ + 8 * F.tid) * 8 + (F.vcu & 7);
#pragma unroll
            for (int i = 0; i < 8; ++i) cv[i] = src[i * 8]; }
        if (!(dummy && (PROBE_VAR == 2 || PROBE_VAR == 3))) {
            for (int g64 = F.vcu; g64 < T / 64; g64 += F.G) {
            const int t0_ = g64 * 64 + F.wave * 8, bb = (g64 * 64) / SEQ; float mx = 0.f, mq = 0.f;
            u32x4 kk_[8], qq_[8];
#pragma unroll
            for (int k = 0; k < 8; ++k) { kk_[k] = *(const u32x4*)(FK + (size_t)(t0_ + k) * 512 + 8 * F.lane); qq_[k] = *(const u32x4*)(FQ + (size_t)(t0_ + k) * 512 + 8 * F.lane); }
#pragma unroll
            for (int k = 0; k < 8; ++k) { f32x4 k0, k1, q0v, q1v; unpack8(kk_[k], k0, k1); unpack8(qq_[k], q0v, q1v);
                float sq = (k0[0] * k0[0] + k0[1] * k0[1]) + (k0[2] * k0[2] + k0[3] * k0[3]) + (k1[0] * k1[0] + k1[1] * k1[1]) + (k1[2] * k1[2] + k1[3] * k1[3]);
                float sqq = (q0v[0] * q0v[0] + q0v[1] * q0v[1]) + (q0v[2] * q0v[2] + q0v[3] * q0v[3]) + (q1v[0] * q1v[0] + q1v[1] * q1v[1]) + (q1v[2] * q1v[2] + q1v[3] * q1v[3]);
                sq += dppf<0xB1>(sq); sq += dppf<0x4E>(sq); sq += dppf<0x141>(sq);
                sqq += dppf<0xB1>(sqq); sqq += dppf<0x4E>(sqq); sqq += dppf<0x141>(sqq);
                mx = fmaxf(mx, sq); mq = fmaxf(mq, sqq); }
            LAS float* kml = (LAS float*)F.lds;
            if ((F.lane & 7) == 0) { kml[F.wave * 8 + (F.lane >> 3)] = mx; kml[64 + F.wave * 8 + (F.lane >> 3)] = mq; }
            __syncthreads();
            if (F.tid < 2 * NHEAD) { const int hh = F.tid & 7, qk = F.tid >> 3; float m2 = 0.f;
#pragma unroll
                for (int w = 0; w < NWAVES; ++w) m2 = fmaxf(m2, kml[qk * 64 + w * 8 + hh]);
                atomicMax((unsigned*)(ctl + CW_KM + qk * 32 + bb * NHEAD + hh), __float_as_uint(m2)); }
            __syncthreads();
            }
        }
        if (F.vcu < NB * NHEAD && !(dummy && (PROBE_VAR == 1 || PROBE_VAR == 3))) {
            const int b = F.vcu >> 3, h = F.vcu & 7;
            float v[8]; float run = 0.f;
#pragma unroll
            for (int i = 0; i < 8; ++i) v[i] = cv[i];
#pragma unroll
            for (int i = 0; i < 8; ++i) { run += v[i]; v[i] = run; }
            float incl = run;
#pragma unroll
            for (int o = 1; o < 64; o <<= 1) { const float n = __shfl_up(incl, o); if (F.lane >= o) incl += n; }
            LAS float* wt = (LAS float*)F.lds;
            if (F.lane == 63) wt[F.wave] = incl;
            __syncthreads();
            float woff = 0.f;
#pragma unroll
            for (int w = 0; w < NWAVES; ++w) woff += (w < F.wave) ? wt[w] : 0.f;
            const float excl = woff + incl - run;
            float* dst = CUMF + ((size_t)b * NHEAD + h) * SEQ + 8 * F.tid;
            *(f32x4*)dst = (f32x4){v[0] + excl, v[1] + excl, v[2] + excl, v[3] + excl}; *(f32x4*)(dst + 4) = (f32x4){v[4] + excl, v[5] + excl, v[6] + excl, v[7] + excl};
            __syncthreads();
        }
        if (!(dummy && (PROBE_VAR == 1 || PROBE_VAR == 2))) up::up_phase(F.lds, QLAT, KVLAT, Wq_t, Wkv_t, SSQQ, SSQKV, ROPETAB, QMLA, KN, VM, F.G, F.vcu);
        if (BOTH(3)) GRID_BAR();
    }

    for (int rep = 0; rep < ((PROBE_DUP == 4) ? 2 : 1); ++rep) if (IN(4)) { PHASE_ENV const bool dummy = (PROBE_DUP == 4) && rep == 0; (void)dummy;
        {
            const bool xq = (F.G % 8) == 0; const int x = xq ? (int)(blockIdx.x & 7) : 0, nunits = xq ? 128 : 1024;
            constexpr int F_O = 16 * 4, F_OUT = 16 * 8, F_SGU = 8 * 8, F_SD = 16 * 2, F_EGU = NEXP * F_SGU, F_ED = NEXP * F_SD;
            constexpr int NCONV = F_EGU + F_ED + 2 * F_O + F_OUT + F_SGU + F_SD, NCBATCH = (NCONV + 31) / 32;
            const int NQ = xq ? 8 : 1, ncb = (NCBATCH - x + NQ - 1) / NQ, A0 = xq ? CONV_A0 : 8 * CONV_A0;
            gu32* qh = ctl + CW_Q + 64 * x + (dummy ? 16 : 0);
            volatile LAS unsigned* qw = (volatile LAS unsigned*)(F.lds + MISC_OFF + 64);
            for (int nit = 0;; ++nit) {
                if (F.tid == 0) qw[nit & 1] = __hip_atomic_fetch_add(qh, 1u, RLX_AGENT);
                __syncthreads();
                int r = __builtin_amdgcn_readfirstlane((int)qw[nit & 1]);
                if (r >= nunits + ncb) break;
                if (r >= A0 && r < A0 + ncb) { const int cb = x + NQ * (r - A0);
                    LAS unsigned char* scr8 = F.lds + 32768 + F.wave * 9216;
                    int ln_ = F.lane; asm volatile("" : "+v"(ln_));
                    for (int kr = 0; kr < 4; ++kr) { int it = 32 * cb + 8 * kr + F.wave; if (it >= NCONV) break;
                        const float* src; unsigned char* dst; int ldw, kd8;
                        if (it < F_EGU) { const int e = it / F_SGU, rr = it % F_SGU, nb = rr & 7, kb = rr >> 3, pn = nb >> 2, c0 = (nb & 3) * 64;
                            src = ((c0 < 128) ? w_exp_gate : w_exp_up) + (size_t)e * D * DEXP + pn * 128 + (c0 & 127) + (size_t)(128 * kb) * DEXP; ldw = DEXP;
                            dst = Wgu8 + (size_t)e * 512 * D + (size_t)(64 * nb) * D + 128 * kb; kd8 = D; }
                        else if ((it -= F_EGU) < F_ED) { const int e = it / F_SD, rr = it % F_SD, nb = rr & 15, kb = rr >> 4;
                            src = w_exp_down + (size_t)e * DEXP * D + (size_t)(128 * kb) * D + 64 * nb; ldw = D; dst = (unsigned char*)Wd_t + (size_t)e * D * DEXP + (size_t)(64 * nb) * DEXP + 128 * kb; kd8 = DEXP; }
                        else if ((it -= F_ED) < 2 * F_O) { const int fx = it >= F_O, i2 = it - (fx ? F_O : 0), nb = i2 & 15, kb = i2 >> 4;
                            src = (fx ? w_o_fox : w_o_mla) + (size_t)(128 * kb) * D + 64 * nb; ldw = D; dst = (unsigned char*)Wom_t + (size_t)(64 * nb) * D + (fx ? 512 : 0) + 128 * kb; kd8 = D; }
                        else if ((it -= 2 * F_O) < F_OUT) { const int nb = it & 15, kb = it >> 4; src = w_out + (size_t)(128 * kb) * D + 64 * nb; ldw = D; dst = (unsigned char*)Wout_t + (size_t)(64 * nb) * D + 128 * kb; kd8 = D; }
                        else if ((it -= F_OUT) < F_SGU) { const int nb = it >> 3, kb = it & 7, pn = nb >> 2, c0 = (nb & 3) * 64;
                            src = ((c0 < 128) ? w_sh_gate : w_sh_up) + pn * 128 + (c0 & 127) + (size_t)(128 * kb) * DEXP; ldw = DEXP; dst = Wsgu8 + (size_t)(64 * nb) * D + 128 * kb; kd8 = D; }
                        else { it -= F_SGU; const int nb = it >> 1, kb = it & 1; src = w_sh_down + (size_t)(128 * kb) * D + 64 * nb; ldw = D; dst = (unsigned char*)Wsd_t + (size_t)(64 * nb) * DEXP + 128 * kb; kd8 = DEXP; }
                        cvt128_item8(src, ldw, dst, kd8, scr8, ln_, WSCALE8);
                    }
                    continue; }
                if (r >= A0) r -= ncb;
                int qb, type, b, h;
                if (xq) { qb = 15 - (r >> 3); type = (r >> 2) & 1; b = r & 3; h = (x + 3 * b) & 7; }
                else { qb = 15 - (r >> 6); type = (r >> 5) & 1; b = (r >> 3) & 3; h = r & 7; }
                if (type == 0) { if (ATT_TUNED_FOX && qb != 0) att::attn_unit_t<64, true, 8>(b, h, qb, FQ, 512, FK, KPE, FV, CUMF, __uint_as_float(__hip_atomic_load((unsigned*)(ctl + CW_KM + b * NHEAD + h), RLX_AGENT)) * __uint_as_float(__hip_atomic_load((unsigned*)(ctl + CW_KM + 32 + b * NHEAD + h), RLX_AGENT)), (bf16*)((unsigned char*)(dummy ? (bf16*)((unsigned char*)out + 4 * MiB) : OCAT) + 512), D, F.lds);
                                 else att::attn_unit<64, true, 8>(b, h, qb, FQ, 512, FK, KPE, FV, CUMF, (bf16*)((unsigned char*)(dummy ? (bf16*)((unsigned char*)out + 4 * MiB) : OCAT) + 512), D, F.lds); }
                else { if (ATT_TUNED_MLA && qb != 0) att::attn_unit_t<96, false, 8>(b, h, qb, QMLA, 768, KN, KPE, VM, nullptr, 0.f, dummy ? (bf16*)((unsigned char*)out + 4 * MiB) : OCAT, D, F.lds);
                       else att::attn_unit<96, false, 8>(b, h, qb, QMLA, 768, KN, KPE, VM, nullptr, dummy ? (bf16*)((unsigned char*)out + 4 * MiB) : OCAT, D, F.lds); }
            }
        }
        if (BOTH(4)) GRID_BAR();
    }

    for (int rep = 0; rep < ((PROBE_DUP == 5) ? 2 : 1); ++rep) if (IN(5)) { PHASE_ENV const bool dummy = (PROBE_DUP == 5) && rep == 0; (void)dummy;
        pg8::StaticOrder S; S.init(OCAT, Wom_t, T, D, D / 2, F.G, (int)blockIdx.x);
        EpiMergedCat E{(const unsigned char*)GATES, (unsigned char*)MERGED, 1.f / (WSCALE8 * 255.f)};
        pg8::gemm_phase<EpiMergedCat, pg8::StaticOrder, true, true>(F.lds, S, E);
        if (BOTH(5)) {
            if (RT_OK) {
                pg8::Unit u0; (void)S.next(0, u0);
                RT_POST(0, u0.pm); RT_WAIT(0, u0.pm);
            } else GRID_BAR();
        }
    }

    for (int rep = 0; rep < ((PROBE_DUP == 6) ? 2 : 1); ++rep) if (IN(6)) { PHASE_ENV const bool dummy = (PROBE_DUP == 6) && rep == 0; (void)dummy;
        pg8::StaticOrder S; S.init(MERGED, Wout_t, T, D, D / 2, F.G, (int)blockIdx.x);
        EpiOut E{X_IN, X1B, mod, SSQ1, 1.f / (OSCALE8 * WSCALE8)};
        pg8::gemm_phase<EpiOut, pg8::StaticOrder, true, true>(F.lds, S, E);
        if (BOTH(6)) GRID_BAR();
    }

    for (int rep = 0; rep < ((PROBE_DUP == 7) ? 2 : 1); ++rep) if (IN(7)) { PHASE_ENV const bool dummy = (PROBE_DUP == 7) && rep == 0; (void)dummy;
        LAS unsigned char* wrl = F.lds;
        LAS float* vg = (LAS float*)(F.lds + LDSCTL_OFF + 6144);
        LAS float* vs = (LAS float*)(F.lds + LDSCTL_OFF + 10240);
        LAS int* cntw = (LAS int*)(F.lds + 32768);
        LAS int* basel = (LAS int*)(F.lds + 32768 + 2048);
        static_assert(LDSCTL_OFF + 10240 + 4096 <= LDS_BYTES && MOETAB_OFF + 4700 <= LDSCTL_OFF + 6144, "P7 LDS map");
        float bias8[8];
#pragma unroll
        for (int i = 0; i < 8; ++i) bias8[i] = b_router[8 * (F.lane & 7) + i];
        for (int grp = F.vcu; grp < T / 64; grp += F.G) {
            const int b = (grp * 64) / SEQ;
            __syncthreads();
#pragma unroll
            for (int i = 0; i < 16; ++i) __builtin_amdgcn_global_load_lds((const unsigned*)((const char*)Wr_f + (F.wave * 16 + i) * 1024 + F.lane * 16), (LAS unsigned*)(wrl + (F.wave * 16 + i) * 1024), 16, 0, 0);
            for (int i = F.tid; i < D; i += NWAVES * 64) { vg[i] = g_ffn[i] * (1.f + mod[(size_t)b * 6 * D + 4 * D + i]); vs[i] = mod[(size_t)b * 6 * D + 3 * D + i]; }
            const int tp = grp * 64 + (F.wave & 3) * 16, kh = F.wave >> 2, t0 = tp + kh * 8;
            const int r16 = F.lane & 15, kg = F.lane >> 4, myrow = tp + r16;
            float rs_mine;
            { const float* sp = SSQ1 + (size_t)myrow * 16; const f32x4 a = *(const f32x4*)sp, b4 = *(const f32x4*)(sp + 4), c4 = *(const f32x4*)(sp + 8), d4 = *(const f32x4*)(sp + 12);
              const float ssum = (((a[0] + a[1]) + (a[2] + a[3])) + ((b4[0] + b4[1]) + (b4[2] + b4[3]))) + (((c4[0] + c4[1]) + (c4[2] + c4[3])) + ((d4[0] + d4[1]) + (d4[2] + d4[3])));
              rs_mine = rsqrtf(ssum * (1.f / D) + EPS); }
            const bf16* xrow = X1B + (size_t)myrow * D + 512 * kh + 8 * kg;
            f32x4 lacc[4] = {{0.f, 0.f, 0.f, 0.f}, {0.f, 0.f, 0.f, 0.f}, {0.f, 0.f, 0.f, 0.f}, {0.f, 0.f, 0.f, 0.f}};
            u32x4 xq[16];
#pragma unroll
            for (int p = 0; p < 16; ++p) xq[p] = *(const u32x4*)(xrow + 32 * p);
            VM_WAIT(); __syncthreads();
#pragma unroll
            for (int p = 0; p < 16; ++p) { const int j = 16 * kh + p, k = 32 * j + 8 * kg;
                f32x4 x0, x1v; unpack8(xq[p], x0, x1v);
                const f32x4 g0 = *(const LAS f32x4*)(vg + k), g1 = *(const LAS f32x4*)(vg + k + 4), s0 = *(const LAS f32x4*)(vs + k), s1 = *(const LAS f32x4*)(vs + k + 4);
                const f32x4 h0 = x0 * rs_mine * g0 + s0, h1 = x1v * rs_mine * g1 + s1;
                const u32x4 hw = pack8(h0, h1);
                f32x4 a0, a1; unpack8(hw, a0, a1);
                const u32x4 lw = pack8(h0 - a0, h1 - a1);
                { u32x2 h8; int p_ = __builtin_amdgcn_cvt_pk_fp8_f32(h0[0], h0[1], 0, false); p_ = __builtin_amdgcn_cvt_pk_fp8_f32(h0[2], h0[3], p_, true); h8.x = (unsigned)p_;
                    p_ = __builtin_amdgcn_cvt_pk_fp8_f32(h1[0], h1[1], 0, false); p_ = __builtin_amdgcn_cvt_pk_fp8_f32(h1[2], h1[3], p_, true); h8.y = (unsigned)p_;
                    *(u32x2*)(H8 + (size_t)myrow * D + k) = h8; }
                const bf16x8 Ah = __builtin_bit_cast(bf16x8, hw), Al = __builtin_bit_cast(bf16x8, lw);
#pragma unroll
                for (int ntl = 0; ntl < 4; ++ntl) { const bf16x8 Wf = *(const LAS bf16x8*)(wrl + ((j * 4 + ntl) * 64 + F.lane) * 16);
                    lacc[ntl] = __builtin_amdgcn_mfma_f32_16x16x32_bf16(Wf, Ah, lacc[ntl], 0, 0, 0);
                    lacc[ntl] = __builtin_amdgcn_mfma_f32_16x16x32_bf16(Wf, Al, lacc[ntl], 0, 0, 0); } }
            __syncthreads();
            {   LAS float* stw = (LAS float*)F.lds + (((F.wave & 3) * 2 + kh) * 16 + r16) * 64;
#pragma unroll
                for (int ntl = 0; ntl < 4; ++ntl) *(LAS f32x4*)(stw + 16 * ntl + 4 * kg) = lacc[ntl]; }
            __syncthreads();
            LAS float* stg = (LAS float*)F.lds + ((F.wave & 3) * 32 + kh * 8) * 64;
            int cnt = 0; unsigned selbits = 0u, selks = 0u;
            LAS float* rsc = (LAS float*)(F.lds + 36864 + F.wave * 1024);
            LAS unsigned char* selmap = (LAS unsigned char*)(F.lds + 36864 + F.wave * 1024 + 512);
            {   const int tj = F.lane >> 3, gg = F.lane & 7;
                float sc[8], ch[8], mc[8]; unsigned ksel[8];
                { const LAS float* pa = stg + tj * 64 + 8 * gg; const f32x4 a0 = *(const LAS f32x4*)pa, a1 = *(const LAS f32x4*)(pa + 4), b0 = *(const LAS f32x4*)(pa + 1024), b1 = *(const LAS f32x4*)(pa + 1028);
                  const f32x4 s0 = rden4(a0 + b0, -LOG2E), s1 = rden4(a1 + b1, -LOG2E);
#pragma unroll
                  for (int i = 0; i < 4; ++i) { sc[i] = s0[i]; sc[4 + i] = s1[i]; } }
#pragma unroll
                for (int i = 0; i < 8; ++i) { ch[i] = sc[i] + bias8[i]; ksel[i] = 0u; }
                float m1 = ch[0];
#pragma unroll
                for (int i = 1; i < 8; ++i) m1 = fmaxf(m1, ch[i]);
                int i1 = 7;
#pragma unroll
                for (int i = 6; i >= 0; --i) i1 = (ch[i] == m1) ? i : i1;
                float m2 = -INFINITY;
#pragma unroll
                for (int i = 0; i < 8; ++i) m2 = fmaxf(m2, (i == i1) ? -INFINITY : ch[i]);
                const float gs = m1 + m2;
                rsc[F.lane] = gs; LDS_WAIT();
                const f32x4 g0 = *(const LAS f32x4*)(rsc + tj * 8), g1 = *(const LAS f32x4*)(rsc + tj * 8 + 4);
                int rank = 0;
#pragma unroll
                for (int g = 0; g < 8; ++g) { const float o = (g < 4) ? g0[g & 3] : g1[g & 3]; rank += (o > gs || (o == gs && g < gg)) ? 1 : 0; }
#pragma unroll
                for (int i = 0; i < 8; ++i) mc[i] = (rank < 4) ? ch[i] : -1e30f;
                float ssel = 0.f;
#pragma unroll
                for (int k = 0; k < TOPK; ++k) {
                    float lm = mc[0];
#pragma unroll
                    for (int i = 1; i < 8; ++i) lm = fmaxf(lm, mc[i]);
                    const float gm = max8(lm);
                    const unsigned tb = (unsigned)(__ballot(lm == gm) >> (F.lane & ~7)) & 0xffu;
                    const bool win = (lm == gm) && ((tb & ((1u << gg) - 1u)) == 0u);
                    int li = 7;
#pragma unroll
                    for (int i = 6; i >= 0; --i) li = (mc[i] == lm) ? i : li;
#pragma unroll
                    for (int i = 0; i < 8; ++i) { const bool hit = win && (li == i); mc[i] = hit ? -INFINITY : mc[i]; ksel[i] = hit ? (unsigned)(k + 1) : ksel[i]; ssel += hit ? sc[i] : 0.f; }
                }
                float ssum = ssel; ssum += dppf<0xB1>(ssum); ssum += dppf<0x4E>(ssum); ssum += dppf<0x141>(ssum);
                const float gsc = 2.5f * __builtin_amdgcn_rcpf(ssum);
                *(LAS u32x2*)(selmap + tj * 64 + 8 * gg) = (u32x2){ksel[0] | (ksel[1] << 8) | (ksel[2] << 16) | (ksel[3] << 24), ksel[4] | (ksel[5] << 8) | (ksel[6] << 16) | (ksel[7] << 24)};
#pragma unroll
                for (int i = 0; i < 8; ++i) if (ksel[i]) rsc[tj * 8 + (int)ksel[i] - 1] = sc[i] * gsc;
                LDS_WAIT();
            }
#pragma unroll
            for (int j = 0; j < 8; ++j) { const unsigned kb = selmap[j * 64 + F.lane]; if (kb) { ++cnt; selbits |= 1u << j; selks |= (kb - 1u) << (3 * j); } }
            cntw[F.wave * 64 + F.lane] = cnt;
            __syncthreads();
            if (F.wave == 0) { int tot = 0;
#pragma unroll
                for (int w = 0; w < 8; ++w) tot += cntw[w * 64 + F.lane];
                basel[F.lane] = (int)__hip_atomic_fetch_add((unsigned*)(ctl + (dummy ? CW_CNT + 2048 : CW_CNT) + 16 * F.lane), (unsigned)tot, RLX_AGENT); }
            __syncthreads();
            int pos = basel[F.lane];
            for (int w = 0; w < F.wave; ++w) pos += cntw[w * 64 + F.lane];
#pragma unroll
            for (int j = 0; j < 8; ++j) if ((selbits >> j) & 1u) { const int k = (selks >> (3 * j)) & 7, t = t0 + j;
                LIST[(size_t)F.lane * LISTCAP + pos] = (unsigned short)t;
                META[(size_t)F.lane * LISTCAP + pos] = (u32x2){(unsigned)(t * (TOPK + 1) + k), __float_as_uint(rsc[j * 8 + k])}; ++pos; }
        }
        __syncthreads();
        if (BOTH(7)) GRID_BAR();
    }

    volatile LAS int* tab = (volatile LAS int*)(F.lds + MOETAB_OFF);
    if (IN(8) || IN(9)) {
        __syncthreads();
        if (F.wave == 0) {
            const int n = (int)__hip_atomic_load((unsigned*)(ctl + CW_CNT + 16 * F.lane), RLX_AGENT);
            const int tiles = (n + 255) >> 8; int incl = tiles;
#pragma unroll
            for (int o = 1; o < 64; o <<= 1) { const int v = __shfl_up(incl, o); if (F.lane >= o) incl += v; }
            tab[F.lane] = incl - tiles; tab[66 + F.lane] = n;
            if (F.lane == 63) { tab[64] = incl; tab[65] = incl + T / 256; tab[66 + 64] = T; }
        }
        __syncthreads();
        if (F.tid <= NEXP) { const int t1 = tab[F.tid + 1] < 512 ? tab[F.tid + 1] : 512;
            for (int t = tab[F.tid]; t < t1; ++t) tab[132 + t] = F.tid; }
        __syncthreads();
    }
    for (int rep = 0; rep < ((PROBE_DUP == 8) ? 2 : 1); ++rep) if (IN(8)) { PHASE_ENV const bool dummy = (PROBE_DUP == 8) && rep == 0; (void)dummy;
        MoeOrder<2, true> S{(const char*)H8, (const char*)Wgu8, (const char*)Wsgu8, D / 2, (size_t)512 * D, LIST, tab, F.G, (int)blockIdx.x};
        EpiHb E{(unsigned char*)HB, 1.f / WSCALE8};
        pg8::gemm_phase<EpiHb, MoeOrder<2, true>, true, true>(F.lds, S, E);
        if (BOTH(8)) GRID_BAR();
    }
    for (int rep = 0; rep < ((PROBE_DUP == 9) ? 2 : 1); ++rep) if (IN(9)) { PHASE_ENV const bool dummy = (PROBE_DUP == 9) && rep == 0; (void)dummy;
        if (dummy && PROBE_VAR == 1) dn::down_phase<true>(F.lds, (const unsigned char*)HB, (const unsigned char*)Wd_t, (const unsigned char*)Wsd_t, tab, META, (unsigned char*)Y, (unsigned char*)(ws + WS_CTL + 900 * 1024), F.G, F.vcu);
        else dn::down_phase<false>(F.lds, (const unsigned char*)HB, (const unsigned char*)Wd_t, (const unsigned char*)Wsd_t, tab, META, (unsigned char*)Y, (unsigned char*)(ws + WS_CTL + 900 * 1024), F.G, F.vcu);
        if (BOTH(9)) GRID_BAR();
    }

    for (int rep = 0; rep < ((PROBE_DUP == 10) ? 2 : 1); ++rep) if (IN(10)) { PHASE_ENV const bool dummy = (PROBE_DUP == 10) && rep == 0; (void)dummy;
        int ln10 = F.lane; asm volatile("" : "+v"(ln10));
        for (int mb = gw * 8; mb < T; mb += NGW * 8) {
            const float* gf = mod + (size_t)(mb / SEQ) * 6 * D + 5 * D;
            f32x4 gfv[4], gfin[4];
#pragma unroll
            for (int j = 0; j < 4; ++j) { gfv[j] = *(const f32x4*)(gf + 4 * ln10 + 256 * j); gfin[j] = *(const f32x4*)(g_final + 4 * ln10 + 256 * j); }
            int yw[2][4][TOPK + 1]; u32x2 xb[2][4];
#define P10_LOAD(bf, m_) do { const unsigned char* yp_ = (const unsigned char*)Y + (size_t)(m_) * (TOPK + 1) * D + 4 * ln10; const u32x2* xr_ = (const u32x2*)(X1B + (size_t)(m_) * D) + ln10; \
            _Pragma("unroll") for (int j = 0; j < 4; ++j) { _Pragma("unroll") for (int k = 0; k < TOPK + 1; ++k) yw[bf][j][k] = __builtin_nontemporal_load((const int*)(yp_ + k * D + 256 * j)); \
                xb[bf][j] = __builtin_nontemporal_load(xr_ + 64 * j); } } while (0)
#define P10_ROW(bf, m_) do { f32x4 v[4]; float s = 0.f; \
            _Pragma("unroll") for (int j = 0; j < 4; ++j) { f32x4 y = {0.f, 0.f, 0.f, 0.f}; \
                _Pragma("unroll") for (int k = 0; k < TOPK + 1; ++k) { const f32x2 lo = __builtin_amdgcn_cvt_pk_f32_fp8(yw[bf][j][k], false), hi2 = __builtin_amdgcn_cvt_pk_f32_fp8(yw[bf][j][k], true); y += (f32x4){lo.x, lo.y, hi2.x, hi2.y}; } \
                const u32x2 xv = xb[bf][j]; \
                v[j] = (f32x4){__uint_as_float(xv.x << 16), __uint_as_float(xv.x & 0xffff0000u), __uint_as_float(xv.y << 16), __uint_as_float(xv.y & 0xffff0000u)} + gfv[j] * y; \
                s += (v[j].x * v[j].x + v[j].y * v[j].y) + (v[j].z * v[j].z + v[j].w * v[j].w); } \
            const float rstd = rsqrtf(wave_sum_f(s) * (1.f / D) + EPS); \
            f32x4* xw = (f32x4*)((dummy ? (float*)HB : out) + (size_t)(m_) * D) + ln10; \
            _Pragma("unroll") for (int j = 0; j < 4; ++j) __builtin_nontemporal_store(v[j] * rstd * gfin[j], xw + 64 * j); } while (0)
            P10_LOAD(0, mb);
            for (int i = 0; i < 8; i += 2) {
                P10_LOAD(1, mb + i + 1);
                P10_ROW(0, mb + i);
                if (i + 2 < 8) P10_LOAD(0, mb + i + 2);
                P10_ROW(1, mb + i + 1);
            }
#undef P10_LOAD
#undef P10_ROW
        }
    }
#undef IN
#undef BOTH
#undef GRID_BAR
}

constexpr int NPHASE = 11;
extern "C" void kernel_launch(void* const* d_in, const int* in_sizes, int n_in, void* d_out, int out_size, void* d_ws, size_t ws_size, hipStream_t stream) {
    static int grid = 0;
    if (grid == 0) {
        if (n_in != 25 || out_size != T * D || ws_size < WS_END) { fprintf(stderr, "kernel_launch: unexpected shapes (n_in %d out %d ws %zu need %zu)\n", n_in, out_size, ws_size, (size_t)WS_END); grid = -1; return; }
        int dev = 0, cus = 0;
        if (hipGetDevice(&dev) != hipSuccess || hipDeviceGetAttribute(&cus, hipDeviceAttributeMultiprocessorCount, dev) != hipSuccess) { grid = -1; return; }
        if (hipFuncSetAttribute((const void*)fwd, hipFuncAttributeMaxDynamicSharedMemorySize, LDS_BYTES) != hipSuccess) { fprintf(stderr, "kernel_launch: hipFuncSetAttribute failed\n"); grid = -1; return; }
        int per_cu = 0;
        if (hipOccupancyMaxActiveBlocksPerMultiprocessor(&per_cu, (const void*)fwd, NWAVES * 64, LDS_BYTES) != hipSuccess || per_cu < 1) { fprintf(stderr, "kernel_launch: occupancy query says %d\n", per_cu); }
        (void)hipGetLastError();
        grid = cus;
    }
    if (grid < 0) return;
    (void)in_sizes;
    if (hipMemsetAsync((char*)d_ws + WS_CTL, 0, CTL_ZERO_BYTES, stream) != hipSuccess) return;
    Args a{};
    for (int i = 0; i < 25; ++i) a.in[i] = d_in[i];
    a.out = (float*)d_out; a.ws = (unsigned char*)d_ws;
#if MK_ONE_LAUNCH
    a.ph_lo = 0; a.ph_hi = NPHASE;
    hipLaunchKernelGGL(fwd, dim3(grid), dim3(NWAVES * 64), LDS_BYTES, stream, a);
#else
    for (int p = 0; p < NPHASE; ++p) { a.ph_lo = p; a.ph_hi = p + 1; hipLaunchKernelGGL(fwd, dim3(grid), dim3(NWAVES * 64), LDS_BYTES, stream, a); }
#endif
}
```
